# Optimizing an MI355X kernel written in HIP

```python
import jax, jax.numpy as jnp
from jax import lax
import numpy as np

D_MODEL = 1024
BATCH = 8
SEQ = 4096
DEPTH = 1

CHUNK = 64
EPS = 1e-6
GLA_HEADS = 4
GLA_DK = 128
GLA_DV = 128
GLA_LOWRANK = 16
GLA_TAU = 16.0
GLA_QK = GLA_HEADS * GLA_DK
GLA_V = GLA_HEADS * GLA_DV
SGU_GROUPS = 4
SGU_GROUP_DIM = 128
SGU_BLOCK = 128
SGU_W = SGU_GROUPS * SGU_GROUP_DIM
PEER_HEADS = 8
PEER_DKEY = 256
PEER_NKEYS = 128
PEER_TOPK = 16
PEER_EXPERTS = PEER_NKEYS * PEER_NKEYS
PEER_TOKEN_BLOCK = 128
IN_COLS = (GLA_QK, GLA_QK, GLA_V, GLA_V, GLA_LOWRANK, SGU_W, SGU_W, D_MODEL, D_MODEL)
IN_WIDTH = sum(IN_COLS)

kernel_name = "hybrid_gla_sgu_peer_block"


def rmsnorm(x, g):
    xf = x.astype(jnp.float32)
    y = xf * lax.rsqrt(jnp.mean(xf * xf, axis=-1, keepdims=True) + EPS)
    return (y * g.astype(jnp.float32)).astype(x.dtype)


def gla_branch(q, k, v, r, a_lr, w_a2, b_a, g_out):
    B, S, _ = q.shape
    NC = S // CHUNK
    f32 = jnp.float32
    qc = q.astype(f32).reshape(B, NC, CHUNK, GLA_HEADS, GLA_DK) * (GLA_DK ** -0.5)
    kc = k.astype(f32).reshape(B, NC, CHUNK, GLA_HEADS, GLA_DK)
    vc = v.astype(f32).reshape(B, NC, CHUNK, GLA_HEADS, GLA_DV)
    log_a = jax.nn.log_sigmoid((a_lr @ w_a2 + b_a).astype(f32)) / GLA_TAU
    log_a = log_a.reshape(B, NC, CHUNK, GLA_HEADS, GLA_DK)
    cum = jnp.cumsum(log_a, axis=2)
    total = cum[:, :, -1]
    k_dec = kc * jnp.exp(total[:, :, None] - cum)
    chunk_kv = jnp.einsum('bnchk,bnchv->bnhkv', k_dec, vc)
    decay = jnp.exp(total)

    def step(state, inp):
        dec, kv, qq = inp
        state = dec[..., None] * state + kv
        out = jnp.einsum('bchk,bhkv->bchv', qq, state)
        return state, out

    init = jnp.zeros((B, GLA_HEADS, GLA_DK, GLA_DV), f32)
    _, o = lax.scan(step, init, (jnp.moveaxis(decay, 1, 0), jnp.moveaxis(chunk_kv, 1, 0),
                                 jnp.moveaxis(qc, 1, 0)))
    o = jnp.moveaxis(o, 0, 1).reshape(B, S, GLA_HEADS, GLA_DV)
    o = o * lax.rsqrt(jnp.mean(o * o, axis=-1, keepdims=True) + EPS)
    o = o.reshape(B, S, GLA_V) * g_out.astype(f32)
    return (o * jax.nn.silu(r.astype(f32))).astype(q.dtype)


def sgu_branch(u, v, ln_g, ln_b, w_s, b_s):
    B, S, _ = v.shape
    f32 = jnp.float32
    vf = v.astype(f32)
    mu = jnp.mean(vf, axis=-1, keepdims=True)
    var = jnp.mean(jnp.square(vf - mu), axis=-1, keepdims=True)
    vn = (vf - mu) * lax.rsqrt(var + EPS) * ln_g.astype(f32) + ln_b.astype(f32)
    NB = S // SGU_BLOCK
    vn = vn.reshape(B, NB, SGU_BLOCK, SGU_GROUPS, SGU_GROUP_DIM)
    pos = jnp.arange(SGU_BLOCK) // CHUNK
    mask = pos[:, None] >= pos[None, :]
    w = jnp.where(mask[None], w_s.astype(f32), 0.0)
    mixed = jnp.einsum('gij,bnjgc->bnigc', w, vn) + b_s.astype(f32).T[None, None, :, :, None]
    return (u.astype(f32) * mixed.reshape(B, S, SGU_W)).astype(u.dtype)


def peer(x, w_q, sub_k1, sub_k2, expert_u, expert_v):
    B, S, D = x.shape
    T = B * S
    f32 = jnp.float32
    xt = x.reshape(T, D)
    q = (xt @ w_q).astype(f32).reshape(T, PEER_HEADS, 2, PEER_DKEY // 2)
    s1 = jnp.einsum('thd,kd->thk', q[:, :, 0], sub_k1.astype(f32))
    s2 = jnp.einsum('thd,kd->thk', q[:, :, 1], sub_k2.astype(f32))
    v1, i1 = lax.top_k(s1, PEER_TOPK)
    v2, i2 = lax.top_k(s2, PEER_TOPK)
    cand = (v1[..., :, None] + v2[..., None, :]).reshape(T, PEER_HEADS, PEER_TOPK * PEER_TOPK)
    vals, ci = lax.top_k(cand, PEER_TOPK)
    ia = ci // PEER_TOPK
    ib = ci % PEER_TOPK
    idx = jnp.take_along_axis(i1, ia, axis=-1) * PEER_NKEYS + jnp.take_along_axis(i2, ib, axis=-1)
    gates = jax.nn.softmax(vals, axis=-1)
    NBLK = T // PEER_TOKEN_BLOCK
    HK = PEER_HEADS * PEER_TOPK
    idx = idx.reshape(NBLK, PEER_TOKEN_BLOCK, HK)
    gates = gates.reshape(NBLK, PEER_TOKEN_BLOCK, HK)
    xb = xt.reshape(NBLK, PEER_TOKEN_BLOCK, D)

    def block(args):
        xx, ii, gg = args
        u = expert_u[ii]
        h = jnp.einsum('tkd,td->tk', u, xx).astype(f32)
        a = (jax.nn.gelu(h) * gg).astype(x.dtype)
        return jnp.einsum('tk,tkd->td', a, expert_v[ii])

    out = lax.map(block, (xb, idx, gates))
    return out.reshape(B, S, D)


def setup_inputs(seed: int = 0) -> dict:
    key = jax.random.key(seed)
    ks = jax.random.split(key, 24)
    f32 = jnp.float32
    L, D = DEPTH, D_MODEL
    nrm = lambda k, shape, scale: jax.random.normal(k, shape, f32) * scale
    return {
        "x": jax.random.normal(ks[0], (BATCH, SEQ, D), f32),
        "norm1_g": 1.0 + nrm(ks[1], (L, D), 0.02),
        "w_in": nrm(ks[2], (L, D, IN_WIDTH), D ** -0.5),
        "w_gate_up": nrm(ks[3], (L, GLA_LOWRANK, GLA_QK), GLA_LOWRANK ** -0.5),
        "b_gate": 1.0 + nrm(ks[4], (L, GLA_QK), 0.1),
        "gla_norm_g": 1.0 + nrm(ks[5], (L, GLA_V), 0.02),
        "sgu_ln_g": 1.0 + nrm(ks[6], (L, SGU_W), 0.02),
        "sgu_ln_b": nrm(ks[7], (L, SGU_W), 0.02),
        "sgu_w": nrm(ks[8], (L, SGU_GROUPS, SGU_BLOCK, SGU_BLOCK), 0.5 * SGU_BLOCK ** -0.5),
        "sgu_b": 1.0 + nrm(ks[9], (L, SGU_GROUPS, SGU_BLOCK), 0.02),
        "w_branch_a": nrm(ks[10], (L, GLA_V, D), GLA_V ** -0.5),
        "w_branch_b": nrm(ks[11], (L, SGU_W, D), SGU_W ** -0.5),
        "w_out": nrm(ks[12], (L, D, D), D ** -0.5),
        "norm2_g": 1.0 + nrm(ks[13], (L, D), 0.02),
        "peer_wq": nrm(ks[14], (L, D, PEER_HEADS * PEER_DKEY), D ** -0.5),
        "peer_k1": nrm(ks[15], (L, PEER_NKEYS, PEER_DKEY // 2), (PEER_DKEY // 2) ** -0.5),
        "peer_k2": nrm(ks[16], (L, PEER_NKEYS, PEER_DKEY // 2), (PEER_DKEY // 2) ** -0.5),
        "peer_u": nrm(ks[17], (L, PEER_EXPERTS, D), D ** -0.5),
        "peer_v": nrm(ks[18], (L, PEER_EXPERTS, D), PEER_HEADS ** -0.5),
        "final_g": 1.0 + nrm(ks[19], (D,), 0.02),
    }


def reference(x, norm1_g, w_in, w_gate_up, b_gate, gla_norm_g, sgu_ln_g, sgu_ln_b, sgu_w, sgu_b,
              w_branch_a, w_branch_b, w_out, norm2_g, peer_wq, peer_k1, peer_k2, peer_u, peer_v,
              final_g):
    offs = np.cumsum(IN_COLS)[:-1].tolist()
    h = x
    for l in range(DEPTH):
        n1 = rmsnorm(h, norm1_g[l])
        proj = n1 @ w_in[l]
        q, k, v, r, a_lr, su, sv, ga, gb = jnp.split(proj, offs, axis=-1)
        y_a = gla_branch(q, k, v, r, a_lr, w_gate_up[l], b_gate[l], gla_norm_g[l])
        su = jax.nn.gelu(su)
        sv = jax.nn.gelu(sv)
        y_b = sgu_branch(su, sv, sgu_ln_g[l], sgu_ln_b[l], sgu_w[l], sgu_b[l])
        merged = (jax.nn.sigmoid(ga) * (y_a @ w_branch_a[l])
                  + jax.nn.sigmoid(gb) * (y_b @ w_branch_b[l]))
        h = h + merged @ w_out[l]
        n2 = rmsnorm(h, norm2_g[l])
        h = h + peer(n2, peer_wq[l], peer_k1[l], peer_k2[l], peer_u[l], peer_v[l])
    return rmsnorm(h, final_g)
```

```cpp
#include <hip/hip_runtime.h>
#include <cstdio>
#include <cstdint>


#ifndef MK_N_LAUNCHES
#define MK_N_LAUNCHES 1
#endif

#define LAS __attribute__((address_space(3)))
#define GAS __attribute__((address_space(1)))
typedef unsigned short bf16_t;
typedef short bf16x8 __attribute__((ext_vector_type(8)));
typedef float f32x4 __attribute__((ext_vector_type(4)));
typedef float f32x2 __attribute__((ext_vector_type(2)));
typedef unsigned u32x4 __attribute__((ext_vector_type(4)));
typedef unsigned u32x2 __attribute__((ext_vector_type(2)));
typedef __bf16 bf16x2_t __attribute__((ext_vector_type(2)));

constexpr int T_TOK = 32768, D = 1024, SEQ = 4096, NBATCH = 8;
constexpr int NPROJ = 5376;
constexpr int PLD = 5120;
constexpr int PC_Q = 0, PC_K = 512, PC_V = 1024, PC_R = 1536, PC_SU = 2048, PC_SV = 2560, PC_GA = 3072, PC_GB = 4096;
constexpr int PC_MRG = 512;
constexpr float EPS = 1e-6f;
constexpr int NEXP = 16384;

constexpr size_t MiB = 1u << 20;
constexpr size_t WS_CTL = 0, CTL_ZERO_BYTES = 1 * MiB;
constexpr size_t WS_WIN = 1 * MiB;
constexpr size_t WS_WA = 12 * MiB;
constexpr size_t WS_WB = 13 * MiB;
constexpr size_t WS_WOUT = 14 * MiB;
constexpr size_t WS_WQF = 16 * MiB;
constexpr size_t WS_U = 20 * MiB;
constexpr size_t WS_V = 52 * MiB;
constexpr size_t WS_DEC = 84 * MiB;
constexpr size_t WS_ALR = 85 * MiB;
constexpr size_t WS_N1 = 87 * MiB;
constexpr size_t WS_P = 151 * MiB;
constexpr size_t WS_END = 471 * MiB;
constexpr size_t P_SC = 0, P_IDX = 256 * MiB, P_GATE = 272 * MiB;

constexpr int CW_BAR = 4096;

constexpr int RING_BYTES = 131072;
constexpr int LDSCTL_OFF = RING_BYTES, MISC_OFF = LDSCTL_OFF + 320;
constexpr int LDS_BYTES = 147456;
constexpr int NWAVES = 8;

__device__ __forceinline__ unsigned f2bf(float f) { unsigned u = __builtin_bit_cast(unsigned, f); return (u + 0x7fffu + ((u >> 16) & 1u)) >> 16; }
__device__ __forceinline__ unsigned pk2(float lo, float hi) { return f2bf(lo) | (f2bf(hi) << 16); }
__device__ __forceinline__ float bflo(unsigned w) { return __builtin_bit_cast(float, w << 16); }
__device__ __forceinline__ float bfhi(unsigned w) { return __builtin_bit_cast(float, w & 0xffff0000u); }
__device__ __forceinline__ float bf1(bf16_t h) { return __builtin_bit_cast(float, ((unsigned)h) << 16); }
__device__ __forceinline__ float sigmoidf_(float x) { return __builtin_amdgcn_rcpf(1.f + __expf(-x)); }
__device__ __forceinline__ float gelu_tanh(float x) { const float y = 1.5957691216057308f * (x + 0.044715f * x * x * x); return x * sigmoidf_(y); }
__device__ __forceinline__ float siluf_(float x) { return x * sigmoidf_(x); }
__device__ __forceinline__ float wave_sum(float v) {
#pragma unroll
    for (int o = 1; o < 64; o <<= 1) v += __shfl_xor(v, o);
    return v;
}
#define LDS_WAIT() asm volatile("s_waitcnt lgkmcnt(0)" ::: "memory")
#define VM_WAIT() asm volatile("s_waitcnt vmcnt(0)" ::: "memory")

namespace pg8 {
constexpr int BM = 256, BK = 64, HALF = 128, HTB = HALF * BK * 2, STAGE_BYTES = 8 * HTB, NXCD = 8, WGM = 8;
__host__ __device__ __forceinline__ int lds_byte(int r, int c) { const int st = (r >> 4) * 2 + (c >> 5), rr = r & 15, cc = c & 31, ob = rr * 64 + cc * 2; return st * 1024 + (ob ^ (((ob >> 9) & 1) << 5)); }
__host__ __device__ __forceinline__ void stage_rc(int b, int& R, int& C) { const int st = b / 1024, sb = b % 1024, swz = sb ^ (((sb >> 9) & 1) << 5); R = (st >> 1) * 16 + swz / 64; C = (st & 1) * 32 + (swz % 64) / 2; }
__host__ __device__ __forceinline__ int perm32(int rho) { const int n = rho >> 4, i = rho & 15; return 8 * (i >> 2) + 4 * n + (i & 3); }

struct Unit { int pm, pn; };
struct Gemm { const bf16_t* A; const bf16_t* Bt; int M, N, K, lda; };

struct StaticOrder {
    int nM, nN, nwg, G, c;
    __host__ __device__ void init(int M, int N, int G_, int c_) { nM = M / BM; nN = N / BM; nwg = nM * nN; G = G_; c = c_; }
    __host__ __device__ bool next(int i, Unit& u) const {
        const long L = (long)i * G + c; if (L >= nwg) return false;
        int wgid = (int)L; { const int q = nwg / NXCD, r = nwg % NXCD, xcd = wgid % NXCD, off = wgid / NXCD; wgid = (xcd < r ? xcd * (q + 1) : r * (q + 1) + (xcd - r) * q) + off; }
        const int nig = WGM * nN, gid = wgid / nig, fm = gid * WGM, gsz = (nM - fm) < WGM ? (nM - fm) : WGM;
        u.pm = fm + ((wgid % nig) % gsz); u.pn = (wgid % nig) / gsz; return true;
    }
    __device__ __forceinline__ void a_ready(const Unit&) const {}
    __device__ __forceinline__ void done(const Unit&) const {}
};

template <class Epi, class Sched, bool ALIGN_EPI = false, bool SP2 = false>
__device__ __forceinline__ void gemm_phase(LAS unsigned char* lds, const Gemm g, const Sched& S, const Epi& E) {
    const int tid = threadIdx.x, wid = __builtin_amdgcn_readfirstlane(tid >> 6), lane = tid & 63, wr = wid >> 2, wc = wid & 3, fr = lane & 15, fq = lane >> 4;
    const int K = g.K, nt = K / BK, lda = g.lda;
    unsigned voffA[2], voffB[2];
#pragma unroll
    for (int i = 0; i < 2; ++i) { int R, C; stage_rc(tid * 16 + i * 8192, R, C); const int Rb = Epi::PERM ? ((R & ~31) + perm32(R & 31)) : R;
        voffA[i] = (unsigned)(R * lda + C) * 2u; voffB[i] = (unsigned)(Rb * K + C) * 2u; }
    const size_t kstep = (size_t)(BK * 2);
    const size_t hstepA = (size_t)HALF * lda * 2, hstepB = (size_t)HALF * K * 2;
    const size_t tstepA = 2 * hstepA, tstepB = 2 * hstepB;
    const unsigned ldsw = (unsigned)wid * 1024u;
    const int aoff = lds_byte(wr * 64 + fr, fq * 8), boff = lds_byte(wc * 32 + fr, fq * 8);
#define PG8_SA(b, h) (((b) * 2 + (h)) * HTB)
#define PG8_SB(b, h) ((4 + (b) * 2 + (h)) * HTB)
#define PG8_STAGE(bufoff, gbase, voff) do { _Pragma("unroll") for (int _i = 0; _i < 2; ++_i) \
        __builtin_amdgcn_global_load_lds((const unsigned*)((const char*)(gbase) + (voff)[_i]), (LAS unsigned*)(lds + (bufoff) + ldsw + _i * 8192), 16, 0, 0); } while (0)
#define PG8_LDA(dst, b, h) do { _Pragma("unroll") for (int m = 0; m < 4; ++m) _Pragma("unroll") for (int k = 0; k < 2; ++k) dst[m][k] = *(const LAS bf16x8*)(lds + PG8_SA(b, h) + aoff + m * 2048 + k * 1024); } while (0)
#define PG8_LDB(dst, b, h) do { _Pragma("unroll") for (int n = 0; n < 2; ++n) _Pragma("unroll") for (int k = 0; k < 2; ++k) dst[n][k] = *(const LAS bf16x8*)(lds + PG8_SB(b, h) + boff + n * 2048 + k * 1024); } while (0)
#define PG8_MMA(ai, bj, At, Bt) do { __builtin_amdgcn_s_setprio(1); _Pragma("unroll") for (int m = 0; m < 4; ++m) _Pragma("unroll") for (int n = 0; n < 2; ++n) _Pragma("unroll") for (int k = 0; k < 2; ++k) \
        acc[ai][bj][m][n] = __builtin_amdgcn_mfma_f32_16x16x32_bf16(Bt[n][k], At[m][k], acc[ai][bj][m][n], 0, 0, 0); __builtin_amdgcn_s_setprio(0); } while (0)
#define PG8_WAIT_V(n) asm volatile("s_waitcnt vmcnt(" #n ")" ::: "memory")
#define PG8_WAIT_L(n) asm volatile("s_waitcnt lgkmcnt(" #n ")" ::: "memory")
#define PG8_BAR __builtin_amdgcn_s_barrier()
#define PG8_SCHED __builtin_amdgcn_sched_barrier(0)
    Unit cur, nxt; int ui = 0;
    if (!S.next(0, cur)) return;
    f32x4 acc[2][2][4][2];
#pragma unroll
    for (int a = 0; a < 2; ++a)
#pragma unroll
        for (int b = 0; b < 2; ++b)
#pragma unroll
            for (int m = 0; m < 4; ++m)
#pragma unroll
                for (int n = 0; n < 2; ++n) acc[a][b][m][n] = (f32x4){0.f, 0.f, 0.f, 0.f};
    bf16x8 At[4][2], B0[2][2], B1[2][2];
    const char* cA = (const char*)g.A + (size_t)cur.pm * tstepA; const char* cB = (const char*)g.Bt + (size_t)cur.pn * tstepB;
    S.a_ready(cur);
    if constexpr (SP2) {
        PG8_STAGE(PG8_SB(0, 0), cB, voffB); PG8_STAGE(PG8_SB(0, 1), cB + hstepB, voffB); PG8_STAGE(PG8_SA(0, 0), cA, voffA); PG8_STAGE(PG8_SA(0, 1), cA + hstepA, voffA);
        if (wr == 1) PG8_BAR;
        PG8_WAIT_V(2); PG8_BAR;
        PG8_STAGE(PG8_SB(1, 0), cB + kstep, voffB); PG8_STAGE(PG8_SA(1, 0), cA + kstep, voffA); PG8_STAGE(PG8_SB(1, 1), cB + hstepB + kstep, voffB);
        PG8_WAIT_V(6); PG8_BAR;
    } else {
        PG8_STAGE(PG8_SB(0, 0), cB, voffB); PG8_STAGE(PG8_SA(0, 0), cA, voffA); PG8_STAGE(PG8_SB(0, 1), cB + hstepB, voffB); PG8_STAGE(PG8_SA(0, 1), cA + hstepA, voffA);
        if (wr == 1) PG8_BAR;
        PG8_WAIT_V(4); PG8_BAR;
        PG8_STAGE(PG8_SB(1, 0), cB + kstep, voffB); PG8_STAGE(PG8_SA(1, 0), cA + kstep, voffA); PG8_STAGE(PG8_SB(1, 1), cB + hstepB + kstep, voffB);
        PG8_WAIT_V(6); PG8_BAR;
    }
    for (;;) {
        const bool has_next = S.next(ui + 1, nxt);
        const char* nA = has_next ? (const char*)g.A + (size_t)nxt.pm * tstepA : cA; const char* nB = has_next ? (const char*)g.Bt + (size_t)nxt.pn * tstepB : cB;
        for (int t = 0; t < nt; t += 2) {
            const bool last = (t == nt - 2);
            const char* a1 = cA + (size_t)(t + 1) * kstep;
            const char* a2 = last ? nA : cA + (size_t)(t + 2) * kstep; const char* b2 = last ? nB : cB + (size_t)(t + 2) * kstep;
            const char* a3 = a2 + kstep; const char* b3 = b2 + kstep;
            if (last && has_next) S.a_ready(nxt);
            if constexpr (SP2) {
            PG8_LDB(B0, 0, 0); PG8_LDB(B1, 0, 1); PG8_SCHED; PG8_LDA(At, 0, 0); PG8_STAGE(PG8_SA(1, 1), a1 + hstepA, voffA);
            PG8_WAIT_V(8); PG8_WAIT_L(0); PG8_BAR; PG8_MMA(0, 0, At, B0); PG8_MMA(0, 1, At, B1); PG8_BAR; PG8_SCHED;
            PG8_LDA(At, 0, 1); PG8_STAGE(PG8_SB(0, 0), b2, voffB); PG8_STAGE(PG8_SB(0, 1), b2 + hstepB, voffB); PG8_STAGE(PG8_SA(0, 0), a2, voffA);
            PG8_WAIT_V(8); PG8_WAIT_L(0); PG8_BAR; PG8_MMA(1, 0, At, B0); PG8_MMA(1, 1, At, B1); PG8_BAR; PG8_SCHED;
            PG8_LDB(B0, 1, 0); PG8_LDB(B1, 1, 1); PG8_SCHED; PG8_LDA(At, 1, 0); PG8_STAGE(PG8_SA(0, 1), a2 + hstepA, voffA);
            PG8_WAIT_V(8); PG8_WAIT_L(0); PG8_BAR; PG8_MMA(0, 0, At, B0); PG8_MMA(0, 1, At, B1); PG8_BAR; PG8_SCHED;
            PG8_LDA(At, 1, 1); PG8_STAGE(PG8_SB(1, 0), b3, voffB); PG8_STAGE(PG8_SB(1, 1), b3 + hstepB, voffB); PG8_STAGE(PG8_SA(1, 0), a3, voffA);
            PG8_WAIT_V(8); PG8_WAIT_L(0); PG8_BAR; PG8_MMA(1, 0, At, B0); PG8_MMA(1, 1, At, B1); PG8_BAR; PG8_SCHED;
            } else {
            PG8_LDB(B0, 0, 0); PG8_SCHED; PG8_LDA(At, 0, 0); PG8_STAGE(PG8_SA(1, 1), a1 + hstepA, voffA);
            PG8_WAIT_L(8); PG8_BAR; PG8_WAIT_L(0); PG8_MMA(0, 0, At, B0); PG8_BAR; PG8_SCHED;
            PG8_LDB(B1, 0, 1); PG8_STAGE(PG8_SB(0, 0), b2, voffB);
            PG8_BAR; PG8_WAIT_L(0); PG8_MMA(0, 1, At, B1); PG8_BAR;
            PG8_LDA(At, 0, 1); PG8_STAGE(PG8_SA(0, 0), a2, voffA);
            PG8_BAR; PG8_WAIT_L(0); PG8_MMA(1, 0, At, B0); PG8_BAR; PG8_SCHED;
            PG8_STAGE(PG8_SB(0, 1), b2 + hstepB, voffB);
            PG8_WAIT_V(6); PG8_BAR; PG8_MMA(1, 1, At, B1); PG8_BAR;
            PG8_LDB(B0, 1, 0); PG8_SCHED; PG8_LDA(At, 1, 0); PG8_STAGE(PG8_SA(0, 1), a2 + hstepA, voffA);
            PG8_WAIT_L(8); PG8_BAR; PG8_WAIT_L(0); PG8_MMA(0, 0, At, B0); PG8_BAR; PG8_SCHED;
            PG8_LDB(B1, 1, 1); PG8_STAGE(PG8_SB(1, 0), b3, voffB);
            PG8_BAR; PG8_WAIT_L(0); PG8_MMA(0, 1, At, B1); PG8_BAR;
            PG8_LDA(At, 1, 1); PG8_STAGE(PG8_SA(1, 0), a3, voffA);
            PG8_BAR; PG8_WAIT_L(0); PG8_MMA(1, 0, At, B0); PG8_BAR; PG8_SCHED;
            PG8_STAGE(PG8_SB(1, 1), b3 + hstepB, voffB);
            PG8_WAIT_V(6); PG8_BAR; PG8_MMA(1, 1, At, B1); PG8_BAR;
            }
        }
        if constexpr (ALIGN_EPI) { if (wr == 0) PG8_BAR; }
        E(acc, cur, wr, wc, fr, fq); S.done(cur);
        if (!has_next) break;
#pragma unroll
        for (int a = 0; a < 2; ++a)
#pragma unroll
            for (int b = 0; b < 2; ++b)
#pragma unroll
                for (int m = 0; m < 4; ++m)
#pragma unroll
                    for (int n = 0; n < 2; ++n) acc[a][b][m][n] = (f32x4){0.f, 0.f, 0.f, 0.f};
        cur = nxt; cA = nA; cB = nB; ++ui;
        if constexpr (ALIGN_EPI) { if (wr == 1) PG8_BAR; }
    }
    PG8_WAIT_V(0);
    if constexpr (!ALIGN_EPI) { if (wr == 0) PG8_BAR; }
    PG8_BAR;
#undef PG8_SA
#undef PG8_SB
#undef PG8_STAGE
#undef PG8_LDA
#undef PG8_LDB
#undef PG8_MMA
#undef PG8_WAIT_V
#undef PG8_WAIT_L
#undef PG8_BAR
#undef PG8_SCHED
}

__device__ __forceinline__ u32x4 pack8(f32x4 v0, f32x4 v1) { u32x4 w; w.x = pk2(v0[0], v0[1]); w.y = pk2(v0[2], v0[3]); w.z = pk2(v1[0], v1[1]); w.w = pk2(v1[2], v1[3]); return w; }
__device__ __forceinline__ void unpack8(u32x4 w, f32x4& v0, f32x4& v1) { v0 = (f32x4){bflo(w.x), bfhi(w.x), bflo(w.y), bfhi(w.y)}; v1 = (f32x4){bflo(w.z), bfhi(w.z), bflo(w.w), bfhi(w.w)}; }

struct EpiProj {
    static constexpr bool PERM = true;
    bf16_t* P; float* ALR;
    __device__ __forceinline__ void operator()(const f32x4 (&acc)[2][2][4][2], const Unit& u, int wr, int wc, int fr, int fq) const {
        const int row0 = u.pm * BM + wr * 64 + fr; const int pn = u.pn; const int cl = wc * 32 + 8 * fq;
        if (pn == 20) {
            if (wc == 0 && fq < 2) {
#pragma unroll
                for (int ai = 0; ai < 2; ++ai)
#pragma unroll
                    for (int m = 0; m < 4; ++m) { float* rp = ALR + (size_t)(row0 + ai * HALF + m * 16) * 16 + 8 * fq;
                        *(f32x4*)rp = acc[ai][0][m][0]; *(f32x4*)(rp + 4) = acc[ai][0][m][1]; }
            }
            return;
        }
        const int mode = pn < 8 ? 0 : (pn < 12 ? 1 : 2);
#pragma unroll
        for (int ai = 0; ai < 2; ++ai)
#pragma unroll
            for (int m = 0; m < 4; ++m) { bf16_t* rowp = P + (size_t)(row0 + ai * HALF + m * 16) * PLD + pn * BM + cl;
#pragma unroll
                for (int bj = 0; bj < 2; ++bj) { f32x4 v0 = acc[ai][bj][m][0], v1 = acc[ai][bj][m][1];
                    if (mode == 1) {
#pragma unroll
                        for (int i = 0; i < 4; ++i) { v0[i] = gelu_tanh(v0[i]); v1[i] = gelu_tanh(v1[i]); }
                    } else if (mode == 2) {
#pragma unroll
                        for (int i = 0; i < 4; ++i) { v0[i] = sigmoidf_(v0[i]); v1[i] = sigmoidf_(v1[i]); }
                    }
                    *(u32x4*)(rowp + bj * HALF) = pack8(v0, v1); } }
    }
};
struct EpiBrA {
    static constexpr bool PERM = true;
    bf16_t* P;
    __device__ __forceinline__ void operator()(const f32x4 (&acc)[2][2][4][2], const Unit& u, int wr, int wc, int fr, int fq) const {
        const int row0 = u.pm * BM + wr * 64 + fr; const int c0 = u.pn * BM + wc * 32 + 8 * fq;
#pragma unroll
        for (int ai = 0; ai < 2; ++ai)
#pragma unroll
            for (int m = 0; m < 4; ++m) { bf16_t* rowp = P + (size_t)(row0 + ai * HALF + m * 16) * PLD;
#pragma unroll
                for (int bj = 0; bj < 2; ++bj) { const int c = c0 + bj * HALF; f32x4 g0, g1; unpack8(*(const u32x4*)(rowp + PC_GA + c), g0, g1);
                    *(u32x4*)(rowp + PC_MRG + c) = pack8(acc[ai][bj][m][0] * g0, acc[ai][bj][m][1] * g1); } }
    }
};
struct EpiBrB {
    static constexpr bool PERM = true;
    bf16_t* P;
    __device__ __forceinline__ void operator()(const f32x4 (&acc)[2][2][4][2], const Unit& u, int wr, int wc, int fr, int fq) const {
        const int row0 = u.pm * BM + wr * 64 + fr; const int c0 = u.pn * BM + wc * 32 + 8 * fq;
#pragma unroll
        for (int ai = 0; ai < 2; ++ai)
#pragma unroll
            for (int m = 0; m < 4; ++m) { bf16_t* rowp = P + (size_t)(row0 + ai * HALF + m * 16) * PLD;
#pragma unroll
                for (int bj = 0; bj < 2; ++bj) { const int c = c0 + bj * HALF; f32x4 g0, g1, p0, p1; unpack8(*(const u32x4*)(rowp + PC_GB + c), g0, g1); unpack8(*(const u32x4*)(rowp + PC_MRG + c), p0, p1);
                    *(u32x4*)(rowp + PC_MRG + c) = pack8(p0 + acc[ai][bj][m][0] * g0, p1 + acc[ai][bj][m][1] * g1); } }
    }
};
struct EpiOut {
    static constexpr bool PERM = true;
    const float* X; float* O;
    __device__ __forceinline__ void operator()(const f32x4 (&acc)[2][2][4][2], const Unit& u, int wr, int wc, int fr, int fq) const {
        const int row0 = u.pm * BM + wr * 64 + fr; const int c0 = u.pn * BM + wc * 32 + 8 * fq;
#pragma unroll
        for (int ai = 0; ai < 2; ++ai)
#pragma unroll
            for (int m = 0; m < 4; ++m) { const size_t ro = (size_t)(row0 + ai * HALF + m * 16) * D;
#pragma unroll
                for (int bj = 0; bj < 2; ++bj) { const int c = c0 + bj * HALF;
                    const f32x4 x0 = *(const f32x4*)(X + ro + c), x1 = *(const f32x4*)(X + ro + c + 4);
                    *(f32x4*)(O + ro + c) = x0 + acc[ai][bj][m][0]; *(f32x4*)(O + ro + c + 4) = x1 + acc[ai][bj][m][1]; } }
    }
};
struct EpiScores {
    static constexpr bool PERM = true;
    float* SC;
    __device__ __forceinline__ void operator()(const f32x4 (&acc)[2][2][4][2], const Unit& u, int wr, int wc, int fr, int fq) const {
        const int row0 = u.pm * BM + wr * 64 + fr; const int c0 = u.pn * BM + wc * 32 + 8 * fq;
#pragma unroll
        for (int bj = 0; bj < 2; ++bj)
#pragma unroll
            for (int n = 0; n < 2; ++n)
#pragma unroll
                for (int i = 0; i < 4; ++i) { float* cp = SC + (size_t)(c0 + bj * HALF + 4 * n + i) * T_TOK + row0;
#pragma unroll
                    for (int ai = 0; ai < 2; ++ai)
#pragma unroll
                        for (int m = 0; m < 4; ++m) cp[ai * HALF + m * 16] = acc[ai][bj][m][n][i]; }
    }
};
}

#define XB_TMO      128
#define XB_XCNT(j)  (256  + 64 * (j))
#define XB_XSUB(j)  (1280 + 64 * (j))
#define XB_XGEN(j)  (2304 + 64 * (j))
#define XB_TOP      3328
#define XB_TOPGEN   3392
#define XCD_BAR_WORDS 3456
#define XB_SPIN_CAP (1u << 18)
__device__ __forceinline__ unsigned xb_ld(unsigned* p)              { return __hip_atomic_load(p, __ATOMIC_RELAXED, __HIP_MEMORY_SCOPE_AGENT); }
__device__ __forceinline__ unsigned xb_add(unsigned* p, unsigned v) { return __hip_atomic_fetch_add(p, v, __ATOMIC_RELAXED, __HIP_MEMORY_SCOPE_AGENT); }
__device__ __forceinline__ unsigned xb_xcc_id() { return (unsigned)__builtin_amdgcn_s_getreg((3 << 11) | 20) & 0xFu; }
#define XB_SPIN(cond, bar) do { unsigned _sp = 0; while (cond) { __builtin_amdgcn_s_sleep(1); \
    if ((++_sp & 255u) == 0u) { if (xb_ld(&(bar)[XB_TMO])) break; if (_sp > XB_SPIN_CAP) { atomicAdd(&(bar)[XB_TMO], 1u); break; } } } } while (0)
struct XcdBarrier { unsigned* bar; unsigned x; volatile LAS unsigned* st; };
__device__ __forceinline__ XcdBarrier xcd_barrier_post(unsigned* bar, volatile LAS unsigned* st) {
    XcdBarrier b; b.bar = bar; b.x = xb_xcc_id(); b.st = st;
    if (threadIdx.x == 0) (void)xb_add(&bar[XB_XCNT(b.x)], 1u);
    return b;
}
__device__ __forceinline__ void xcd_barrier_complete(unsigned* bar, unsigned x, unsigned& nloc, unsigned& nx) {
    const unsigned G = gridDim.x * gridDim.y * gridDim.z;
    unsigned sum, cnt, mine, sp = 0u;
    for (;;) {
        sum = 0u; cnt = 0u; mine = 0u;
#pragma unroll
        for (unsigned j = 0; j < 16; ++j) { const unsigned c = xb_ld(&bar[XB_XCNT(j)]); sum += c; cnt += (c > 0u) ? 1u : 0u; mine = (j == x) ? c : mine; }
        if (sum == G) break;
        __builtin_amdgcn_s_sleep(1);
        if ((++sp & 255u) == 0u) { if (xb_ld(&bar[XB_TMO])) break; if (sp > XB_SPIN_CAP) { atomicAdd(&bar[XB_TMO], 1u); break; } }
    }
    nloc = mine > 0u ? mine : 1u; nx = cnt > 0u ? cnt : 1u;
}
__device__ __forceinline__ void xcd_barrier(const XcdBarrier& b) {
    asm volatile("s_waitcnt vmcnt(0)" ::: "memory");
    __syncthreads();
    if (threadIdx.x == 0) {
        unsigned* bar = b.bar;
        __builtin_amdgcn_s_waitcnt(0);
        unsigned nloc = b.st[0], nx = b.st[1];
        if (nloc == 0u) { xcd_barrier_complete(bar, b.x, nloc, nx); b.st[0] = nloc; b.st[1] = nx; }
        const unsigned old = xb_add(&bar[XB_XSUB(b.x)], 1u);
        const unsigned gen = old / nloc;
        if (old + 1u == (gen + 1u) * nloc) {
            __builtin_amdgcn_fence(__ATOMIC_RELEASE, "agent");
            asm volatile("s_waitcnt vmcnt(0)" ::: "memory");
            const unsigned og = xb_add(&bar[XB_TOP], 1u);
            const unsigned tg = og / nx;
            if (og + 1u == (tg + 1u) * nx) xb_add(&bar[XB_TOPGEN], 1u);
            else XB_SPIN(xb_ld(&bar[XB_TOPGEN]) == tg, bar);
            __builtin_amdgcn_fence(__ATOMIC_ACQUIRE, "agent");
            xb_add(&bar[XB_XGEN(b.x)], 1u);
            asm volatile("s_waitcnt vmcnt(0)" ::: "memory");
        } else {
            XB_SPIN(xb_ld(&bar[XB_XGEN(b.x)]) == gen, bar);
            __builtin_amdgcn_fence(__ATOMIC_ACQUIRE, "agent");
            asm volatile("s_waitcnt vmcnt(0)" ::: "memory");
        }
    }
    __syncthreads();
}

struct Args {
    const float* in[20]; float* out; unsigned char* ws; int ph_lo, ph_hi, li, pad;
};
enum { I_X = 0, I_N1G, I_WIN, I_WGU, I_BG, I_GLAG, I_SLNG, I_SLNB, I_SW, I_SB, I_WBA, I_WBB, I_WOUT, I_N2G, I_WQ, I_K1, I_K2, I_PU, I_PV, I_FG };

struct Frame {
    LAS unsigned char* lds;
    int tid, lane, wave, G, bid;
};

template <int MODE>
__device__ __forceinline__ void p0_transpose_item(const float* W, int K, int Nsrc, int Ndst, bf16_t* WT, LAS float* scr, int item, int lane) {
    const int nblk = Ndst / 32, kb = item / nblk, nb = item % nblk, k0 = 64 * kb, n0 = 32 * nb;
    const int nd = n0 + (lane & 31);
    int sc = nd; bool valid = true;
    if (MODE == 1) { if (nd < 2048) sc = nd; else if (nd < 5120) sc = nd + 16; else if (nd < 5136) sc = 2048 + (nd - 5120); else { sc = 0; valid = false; } }
#pragma unroll 8
    for (int i = 0; i < 32; ++i) { const int kk = 2 * i + (lane >> 5); const float v = valid ? W[(size_t)(k0 + kk) * Nsrc + sc] : 0.f; scr[kk * 33 + (lane & 31)] = v; }
    LDS_WAIT(); asm volatile("" ::: "memory");
    const int c = lane & 7;
#pragma unroll
    for (int j = 0; j < 4; ++j) { const int n = (lane >> 3) + 8 * j; const LAS float* s = scr + (8 * c) * 33 + n;
        u32x4 o; o.x = pk2(s[0 * 33], s[1 * 33]); o.y = pk2(s[2 * 33], s[3 * 33]); o.z = pk2(s[4 * 33], s[5 * 33]); o.w = pk2(s[6 * 33], s[7 * 33]);
        *(u32x4*)(WT + (size_t)(n0 + n) * K + k0 + 8 * c) = o; }
    LDS_WAIT(); asm volatile("" ::: "memory");
}
__device__ __forceinline__ void rms_row_to_bf16(int lane, const float* xrow, const float* g, bf16_t* orow) {
    const f32x4* xr = (const f32x4*)xrow + lane; const f32x4* gr = (const f32x4*)g + lane;
    f32x4 v[4]; float s = 0.f;
#pragma unroll
    for (int j = 0; j < 4; ++j) { v[j] = xr[64 * j]; s += (v[j].x * v[j].x + v[j].y * v[j].y) + (v[j].z * v[j].z + v[j].w * v[j].w); }
    const float rstd = 1.f / sqrtf(wave_sum(s) * (1.f / D) + EPS);
    u32x2* o8 = (u32x2*)orow + lane;
#pragma unroll
    for (int j = 0; j < 4; ++j) { const f32x4 gg = gr[64 * j]; u32x2 o; o.x = pk2(v[j].x * rstd * gg.x, v[j].y * rstd * gg.y); o.y = pk2(v[j].z * rstd * gg.z, v[j].w * rstd * gg.w); o8[64 * j] = o; }
}
__device__ __forceinline__ void cvt_row_1024(int lane, const float* src, bf16_t* dst) {
#pragma unroll
    for (int j = 0; j < 2; ++j) { const f32x4 a = *(const f32x4*)(src + j * 512 + lane * 8), b = *(const f32x4*)(src + j * 512 + lane * 8 + 4);
        u32x4 o; o.x = pk2(a.x, a.y); o.y = pk2(a.z, a.w); o.z = pk2(b.x, b.y); o.w = pk2(b.z, b.w); *(u32x4*)(dst + j * 512 + lane * 8) = o; }
}

__device__ __forceinline__ void phase0(const Frame& F, const Args& A) {
    unsigned char* ws = A.ws;
    {
        LAS float* kx = (LAS float*)F.lds;
        LAS float* wt = (LAS float*)(F.lds + 128 * 129 * 4);
        bf16_t* WQF = (bf16_t*)(ws + WS_WQF);
        for (int it = F.bid; it < 512; it += F.G) {
            const int hh = it >> 5, kblk = it & 31, k0 = kblk * 32;
            const float* kX = (hh & 1) ? A.in[I_K2] : A.in[I_K1];
            __syncthreads();
            for (int e = F.tid; e < 128 * 128; e += 512) kx[(e >> 7) * 129 + (e & 127)] = kX[e];
            for (int e = F.tid; e < 32 * 128; e += 512) wt[e] = A.in[I_WQ][(size_t)(k0 + (e >> 7)) * 2048 + hh * 128 + (e & 127)];
            __syncthreads();
            const int key = F.tid & 127, kq = F.tid >> 7;
            float acc[8];
#pragma unroll
            for (int i = 0; i < 8; ++i) acc[i] = 0.f;
            for (int d = 0; d < 128; ++d) { const float b = kx[key * 129 + d];
#pragma unroll
                for (int i = 0; i < 8; ++i) acc[i] += wt[(kq * 8 + i) * 128 + d] * b; }
            u32x4 o; o.x = pk2(acc[0], acc[1]); o.y = pk2(acc[2], acc[3]); o.z = pk2(acc[4], acc[5]); o.w = pk2(acc[6], acc[7]);
            *(u32x4*)(WQF + (size_t)(hh * 128 + key) * 1024 + k0 + kq * 8) = o;
        }
        __syncthreads();
    }
    LAS float* scr = (LAS float*)(F.lds + F.wave * 16384);
    const int gw = F.bid * NWAVES + F.wave, NGW = F.G * NWAVES;
    constexpr int I_IN = 16 * (NPROJ / 32), I_A = 8 * 32, I_B = 8 * 32, I_O = 16 * 32;
    constexpr int NITEMS = I_IN + I_A + I_B + I_O;
    for (int it = gw; it < NITEMS; it += NGW) {
        int r = it;
        if (r < I_IN) { p0_transpose_item<1>(A.in[I_WIN], 1024, 5136, NPROJ, (bf16_t*)(ws + WS_WIN), scr, r, F.lane); continue; } r -= I_IN;
        if (r < I_A) { p0_transpose_item<0>(A.in[I_WBA], 512, 1024, 1024, (bf16_t*)(ws + WS_WA), scr, r, F.lane); continue; } r -= I_A;
        if (r < I_B) { p0_transpose_item<0>(A.in[I_WBB], 512, 1024, 1024, (bf16_t*)(ws + WS_WB), scr, r, F.lane); continue; } r -= I_B;
        p0_transpose_item<0>(A.in[I_WOUT], 1024, 1024, 1024, (bf16_t*)(ws + WS_WOUT), scr, r, F.lane);
    }
    for (int m = gw; m < T_TOK; m += NGW) rms_row_to_bf16(F.lane, A.in[I_X] + (size_t)m * D, A.in[I_N1G], (bf16_t*)(ws + WS_N1) + (size_t)m * D);
    for (int m = gw; m < 2 * NEXP; m += NGW) {
        if (m < NEXP) cvt_row_1024(F.lane, A.in[I_PU] + (size_t)m * D, (bf16_t*)(ws + WS_U) + (size_t)m * D);
        else cvt_row_1024(F.lane, A.in[I_PV] + (size_t)(m - NEXP) * D, (bf16_t*)(ws + WS_V) + (size_t)(m - NEXP) * D);
    }
}

__device__ __forceinline__ float log_sigmoid(float z) { return fminf(z, 0.f) - log1pf(__expf(-fabsf(z))); }

__device__ __forceinline__ void gla_chunk_unit(const Frame& F, const Args& A, int unit) {
    const int h = unit & 3, c = (unit >> 2) & 63, b = unit >> 8;
    const int t0 = b * SEQ + c * 64;
    unsigned char* ws = A.ws;
    const bf16_t* P = (const bf16_t*)(ws + WS_P);
    const float* ALR = (const float*)(ws + WS_ALR);
    LAS float* la = (LAS float*)F.lds;
    LAS float* alr = (LAS float*)(F.lds + 32768);
    LAS float* w2s = (LAS float*)(F.lds + 36864);
    LAS bf16_t* kdT = (LAS bf16_t*)(F.lds + 45056);
    LAS bf16_t* vT = (LAS bf16_t*)(F.lds + 63488);
    const int tid = F.tid;
    __syncthreads();
    for (int e = tid; e < 1024; e += 512) alr[e] = ALR[(size_t)t0 * 16 + e];
    for (int e = tid; e < 2048; e += 512) w2s[e] = A.in[I_WGU][(size_t)(e >> 7) * 512 + h * 128 + (e & 127)];
    __syncthreads();
    {
        const int s = tid >> 3, kb = (tid & 7) * 16;
        float z[16];
#pragma unroll
        for (int i = 0; i < 16; ++i) z[i] = A.in[I_BG][h * 128 + kb + i];
#pragma unroll
        for (int j = 0; j < 16; ++j) { const float a = alr[s * 16 + j];
#pragma unroll
            for (int i = 0; i < 16; ++i) z[i] += a * w2s[j * 128 + kb + i]; }
#pragma unroll
        for (int i = 0; i < 16; ++i) la[s * 128 + kb + i] = log_sigmoid(z[i]) * (1.f / 16.f);
    }
    __syncthreads();
    if (tid < 128) { float a = 0.f; for (int s = 0; s < 64; ++s) { a += la[s * 128 + tid]; la[s * 128 + tid] = a; } }
    __syncthreads();
    {
        const int s = tid >> 3, kb = (tid & 7) * 16;
        const bf16_t* kp = P + (size_t)(t0 + s) * PLD + PC_K + h * 128 + kb;
        const bf16_t* vp = P + (size_t)(t0 + s) * PLD + PC_V + h * 128 + kb;
        const u32x4 k0 = *(const u32x4*)kp, k1 = *(const u32x4*)(kp + 8), v0 = *(const u32x4*)vp, v1 = *(const u32x4*)(vp + 8);
        const unsigned kw[8] = {k0.x, k0.y, k0.z, k0.w, k1.x, k1.y, k1.z, k1.w};
        const unsigned vw[8] = {v0.x, v0.y, v0.z, v0.w, v1.x, v1.y, v1.z, v1.w};
#pragma unroll
        for (int i = 0; i < 8; ++i) {
            const int kk = kb + 2 * i;
            const float e0 = __expf(la[63 * 128 + kk] - la[s * 128 + kk]), e1 = __expf(la[63 * 128 + kk + 1] - la[s * 128 + kk + 1]);
            kdT[kk * 72 + s] = (bf16_t)f2bf(bflo(kw[i]) * e0); kdT[(kk + 1) * 72 + s] = (bf16_t)f2bf(bfhi(kw[i]) * e1);
            vT[kk * 72 + s] = (bf16_t)(vw[i] & 0xffffu); vT[(kk + 1) * 72 + s] = (bf16_t)(vw[i] >> 16);
        }
        if (tid < 128) ((float*)(ws + WS_DEC))[(size_t)unit * 128 + tid] = __expf(la[63 * 128 + tid]);
    }
    __syncthreads();
    {
        const int w = F.wave, l = F.lane, fr = l & 15, fq = l >> 4;
        f32x4 acc[8];
#pragma unroll
        for (int n = 0; n < 8; ++n) acc[n] = (f32x4){0.f, 0.f, 0.f, 0.f};
#pragma unroll
        for (int ks = 0; ks < 2; ++ks) {
            const bf16x8 a = *(const LAS bf16x8*)(kdT + (16 * w + fr) * 72 + 32 * ks + 8 * fq);
#pragma unroll
            for (int n = 0; n < 8; ++n) { const bf16x8 bb = *(const LAS bf16x8*)(vT + (16 * n + fr) * 72 + 32 * ks + 8 * fq);
                acc[n] = __builtin_amdgcn_mfma_f32_16x16x32_bf16(a, bb, acc[n], 0, 0, 0); }
        }
        bf16_t* ST = (bf16_t*)(ws + WS_N1) + (size_t)unit * 16384;
#pragma unroll
        for (int n = 0; n < 8; ++n) { u32x2 o; o.x = pk2(acc[n][0], acc[n][1]); o.y = pk2(acc[n][2], acc[n][3]);
            *(u32x2*)(ST + (size_t)(16 * n + fr) * 128 + 16 * w + 4 * fq) = o; }
    }
}

__device__ __forceinline__ void sgu_unit(const Frame& F, const Args& A, int unit) {
    const int g = unit & 3, blk = (unit >> 2) & 31, b = unit >> 7;
    const int t0 = b * SEQ + blk * 128;
    bf16_t* P = (bf16_t*)(A.ws + WS_P);
    LAS bf16_t* wA = (LAS bf16_t*)F.lds;
    LAS bf16_t* vnT = (LAS bf16_t*)(F.lds + 34816);
    LAS float* st = (LAS float*)(F.lds + 69632);
    const int tid = F.tid;
    __syncthreads();
    {
        const int j = tid >> 2, q = tid & 3;
        const bf16_t* sp = P + (size_t)(t0 + j) * PLD + PC_SV + q * 128;
        float s = 0.f, s2 = 0.f;
#pragma unroll
        for (int i = 0; i < 16; ++i) { const u32x4 w = *(const u32x4*)(sp + 8 * i);
            const float f[8] = {bflo(w.x), bfhi(w.x), bflo(w.y), bfhi(w.y), bflo(w.z), bfhi(w.z), bflo(w.w), bfhi(w.w)};
#pragma unroll
            for (int e = 0; e < 8; ++e) { s += f[e]; s2 += f[e] * f[e]; } }
        s += __shfl_xor(s, 1); s += __shfl_xor(s, 2); s2 += __shfl_xor(s2, 1); s2 += __shfl_xor(s2, 2);
        const float mu = s * (1.f / 512.f); const float var = fmaxf(s2 * (1.f / 512.f) - mu * mu, 0.f);
        if (q == 0) { st[2 * j] = mu; st[2 * j + 1] = 1.f / sqrtf(var + EPS); }
    }
    {
        const int i = tid >> 2, jb = (tid & 3) * 32;
        const float* wp = A.in[I_SW] + (size_t)g * 16384 + (size_t)i * 128 + jb;
#pragma unroll
        for (int q = 0; q < 4; ++q) { const f32x4 a = *(const f32x4*)(wp + 8 * q), bq = *(const f32x4*)(wp + 8 * q + 4);
            const bool z = (i < 64) && (jb + 8 * q >= 64);
            u32x4 o; o.x = pk2(a.x, a.y); o.y = pk2(a.z, a.w); o.z = pk2(bq.x, bq.y); o.w = pk2(bq.z, bq.w);
            if (z) o = (u32x4){0u, 0u, 0u, 0u};
            *(LAS u32x4*)(wA + i * 136 + jb + 8 * q) = o; }
    }
    __syncthreads();
    {
        const int j = tid >> 2, cb = (tid & 3) * 32;
        const float mu = st[2 * j], rs = st[2 * j + 1];
        const bf16_t* sp = P + (size_t)(t0 + j) * PLD + PC_SV + g * 128 + cb;
        const float* lg = A.in[I_SLNG] + g * 128 + cb; const float* lb = A.in[I_SLNB] + g * 128 + cb;
#pragma unroll
        for (int q = 0; q < 4; ++q) { const u32x4 w = *(const u32x4*)(sp + 8 * q);
            const float f[8] = {bflo(w.x), bfhi(w.x), bflo(w.y), bfhi(w.y), bflo(w.z), bfhi(w.z), bflo(w.w), bfhi(w.w)};
#pragma unroll
            for (int e = 0; e < 8; ++e) { const int cc = cb + 8 * q + e; vnT[cc * 136 + j] = (bf16_t)f2bf((f[e] - mu) * rs * lg[8 * q + e] + lb[8 * q + e]); } }
    }
    __syncthreads();
    {
        const int w = F.wave, l = F.lane, fr = l & 15, fq = l >> 4;
        f32x4 acc[8];
#pragma unroll
        for (int n = 0; n < 8; ++n) acc[n] = (f32x4){0.f, 0.f, 0.f, 0.f};
#pragma unroll
        for (int ks = 0; ks < 4; ++ks) {
            const bf16x8 a = *(const LAS bf16x8*)(wA + (16 * w + fr) * 136 + 32 * ks + 8 * fq);
#pragma unroll
            for (int n = 0; n < 8; ++n) { const bf16x8 bb = *(const LAS bf16x8*)(vnT + (16 * n + fr) * 136 + 32 * ks + 8 * fq);
                acc[n] = __builtin_amdgcn_mfma_f32_16x16x32_bf16(a, bb, acc[n], 0, 0, 0); }
        }
#pragma unroll
        for (int jj = 0; jj < 4; ++jj) { const int i = 16 * w + 4 * fq + jj; const float bias = A.in[I_SB][g * 128 + i];
            bf16_t* rp = P + (size_t)(t0 + i) * PLD + PC_SU + g * 128 + fr;
#pragma unroll
            for (int n = 0; n < 8; ++n) { const float su = bf1(rp[16 * n]); rp[16 * n] = (bf16_t)f2bf(su * (acc[n][jj] + bias)); } }
    }
}

__device__ __forceinline__ void gla_scan(const Frame& F, const Args& A) {
    bf16_t* ST = (bf16_t*)(A.ws + WS_N1); const float* DEC = (const float*)(A.ws + WS_DEC);
    for (int gi = F.bid * 512 + F.tid; gi < 131072; gi += F.G * 512) {
        const int k4 = gi & 31, vv = (gi >> 5) & 127, h = (gi >> 12) & 3, b = gi >> 14;
        float s0 = 0.f, s1 = 0.f, s2 = 0.f, s3 = 0.f;
#pragma unroll 8
        for (int c = 0; c < 64; ++c) {
            const size_t u = (size_t)((b * 64 + c) * 4 + h);
            u32x2* sp = (u32x2*)(ST + u * 16384 + (size_t)vv * 128 + k4 * 4);
            const f32x4 d = *(const f32x4*)(DEC + u * 128 + k4 * 4);
            const u32x2 w = *sp;
            s0 = d.x * s0 + bflo(w.x); s1 = d.y * s1 + bfhi(w.x); s2 = d.z * s2 + bflo(w.y); s3 = d.w * s3 + bfhi(w.y);
            u32x2 o; o.x = pk2(s0, s1); o.y = pk2(s2, s3); *sp = o;
        }
    }
}

__device__ __forceinline__ void gla_out_unit(const Frame& F, const Args& A, int unit) {
    const int h = unit & 3, c = (unit >> 2) & 63, b = unit >> 8;
    const int t0 = b * SEQ + c * 64;
    bf16_t* P = (bf16_t*)(A.ws + WS_P);
    const bf16_t* ST = (const bf16_t*)(A.ws + WS_N1) + (size_t)unit * 16384;
    LAS bf16_t* qA = (LAS bf16_t*)F.lds;
    LAS bf16_t* sB = (LAS bf16_t*)(F.lds + 17408);
    LAS float* oF = (LAS float*)(F.lds + 52224);
    const int tid = F.tid;
    __syncthreads();
    {
        const int s = tid >> 3, cb = (tid & 7) * 16;
        const bf16_t* qp = P + (size_t)(t0 + s) * PLD + PC_Q + h * 128 + cb;
        *(LAS u32x4*)(qA + s * 136 + cb) = *(const u32x4*)qp; *(LAS u32x4*)(qA + s * 136 + cb + 8) = *(const u32x4*)(qp + 8);
        const int vv = tid >> 2, kb = (tid & 3) * 32;
#pragma unroll
        for (int q = 0; q < 4; ++q) *(LAS u32x4*)(sB + vv * 136 + kb + 8 * q) = *(const u32x4*)(ST + (size_t)vv * 128 + kb + 8 * q);
    }
    __syncthreads();
    {
        const int w = F.wave, l = F.lane, fr = l & 15, fq = l >> 4, m = w & 3, nh = w >> 2;
        f32x4 acc[4];
#pragma unroll
        for (int n = 0; n < 4; ++n) acc[n] = (f32x4){0.f, 0.f, 0.f, 0.f};
#pragma unroll
        for (int ks = 0; ks < 4; ++ks) {
            const bf16x8 a = *(const LAS bf16x8*)(qA + (16 * m + fr) * 136 + 32 * ks + 8 * fq);
#pragma unroll
            for (int n = 0; n < 4; ++n) { const bf16x8 bb = *(const LAS bf16x8*)(sB + (16 * (4 * nh + n) + fr) * 136 + 32 * ks + 8 * fq);
                acc[n] = __builtin_amdgcn_mfma_f32_16x16x32_bf16(a, bb, acc[n], 0, 0, 0); }
        }
        const float scale = 0.08838834764831845f;
#pragma unroll
        for (int n = 0; n < 4; ++n)
#pragma unroll
            for (int jj = 0; jj < 4; ++jj) oF[(16 * m + 4 * fq + jj) * 132 + 16 * (4 * nh + n) + fr] = acc[n][jj] * scale;
    }
    __syncthreads();
    {
        const int s = tid >> 3, cb = (tid & 7) * 16;
        float o[16]; float ss = 0.f;
#pragma unroll
        for (int i = 0; i < 16; ++i) { o[i] = oF[s * 132 + cb + i]; ss += o[i] * o[i]; }
        ss += __shfl_xor(ss, 1); ss += __shfl_xor(ss, 2); ss += __shfl_xor(ss, 4);
        const float rstd = 1.f / sqrtf(ss * (1.f / 128.f) + EPS);
        const bf16_t* rp = P + (size_t)(t0 + s) * PLD + PC_R + h * 128 + cb;
        const u32x4 r0 = *(const u32x4*)rp, r1 = *(const u32x4*)(rp + 8);
        const unsigned rw[8] = {r0.x, r0.y, r0.z, r0.w, r1.x, r1.y, r1.z, r1.w};
        const float* gg = A.in[I_GLAG] + h * 128 + cb;
        unsigned ow[8];
#pragma unroll
        for (int i = 0; i < 8; ++i) { const float y0 = o[2 * i] * rstd * gg[2 * i] * siluf_(bflo(rw[i])), y1 = o[2 * i + 1] * rstd * gg[2 * i + 1] * siluf_(bfhi(rw[i])); ow[i] = pk2(y0, y1); }
        bf16_t* yp = P + (size_t)(t0 + s) * PLD + PC_Q + h * 128 + cb;
        *(u32x4*)yp = (u32x4){ow[0], ow[1], ow[2], ow[3]}; *(u32x4*)(yp + 8) = (u32x4){ow[4], ow[5], ow[6], ow[7]};
    }
}

__device__ __forceinline__ unsigned ordkey(float v) { const unsigned u = __builtin_bit_cast(unsigned, v); return (u & 0x80000000u) ? ~u : (u | 0x80000000u); }
__device__ __forceinline__ float unord(unsigned k) { const unsigned u = (k & 0x80000000u) ? (k & 0x7fffffffu) : ~k; return __builtin_bit_cast(float, u); }
#define INS16(r, xin) do { unsigned _x = (xin); _Pragma("unroll") for (int _i = 0; _i < 16; ++_i) { const unsigned _h = max((r)[_i], _x); _x = min((r)[_i], _x); (r)[_i] = _h; } } while (0)

__device__ __forceinline__ void peer_topk(const Frame& F, const Args& A) {
    const float* SC = (const float*)(A.ws + WS_P + P_SC);
    int* IDX = (int*)(A.ws + WS_P + P_IDX); float* GATE = (float*)(A.ws + WS_P + P_GATE);
    const int gw = F.bid * NWAVES + F.wave, NGW = F.G * NWAVES;
    for (int it = gw; it < 512 * 8; it += NGW) {
        const int h = it & 7, tb = it >> 3; const int tok = tb * 64 + F.lane;
        unsigned r1[16], r2[16], rc[16];
#pragma unroll
        for (int i = 0; i < 16; ++i) { r1[i] = 0u; r2[i] = 0u; rc[i] = 0u; }
        const float* p1 = SC + (size_t)(h * 256) * T_TOK + tok; const float* p2 = p1 + (size_t)128 * T_TOK;
#pragma unroll 8
        for (int j = 0; j < 128; ++j) { const float v = p1[(size_t)j * T_TOK]; const unsigned k = (ordkey(v) & ~127u) | (unsigned)(127 - j); INS16(r1, k); }
#pragma unroll 8
        for (int j = 0; j < 128; ++j) { const float v = p2[(size_t)j * T_TOK]; const unsigned k = (ordkey(v) & ~127u) | (unsigned)(127 - j); INS16(r2, k); }
        float v1[16], v2[16];
#pragma unroll
        for (int i = 0; i < 16; ++i) { v1[i] = unord((r1[i] & ~127u) | 64u); v2[i] = unord((r2[i] & ~127u) | 64u); }
#pragma unroll
        for (int a = 0; a < 16; ++a)
#pragma unroll
            for (int bq = 0; bq < 16; ++bq) if ((a + 1) * (bq + 1) <= 16) { const unsigned k = (ordkey(v1[a] + v2[bq]) & ~255u) | (unsigned)(a * 16 + bq); INS16(rc, k); }
        float val[16]; int ex[16];
#pragma unroll
        for (int w = 0; w < 16; ++w) {
            const int a = (rc[w] >> 4) & 15, bq = rc[w] & 15;
            unsigned k1 = r1[0], k2 = r2[0];
#pragma unroll
            for (int i = 1; i < 16; ++i) { k1 = (a == i) ? r1[i] : k1; k2 = (bq == i) ? r2[i] : k2; }
            val[w] = unord((k1 & ~127u) | 64u) + unord((k2 & ~127u) | 64u);
            ex[w] = (127 - (int)(k1 & 127u)) * 128 + (127 - (int)(k2 & 127u));
        }
        float mx = val[0];
#pragma unroll
        for (int w = 1; w < 16; ++w) mx = fmaxf(mx, val[w]);
        float sum = 0.f;
#pragma unroll
        for (int w = 0; w < 16; ++w) { val[w] = __expf(val[w] - mx); sum += val[w]; }
        const float inv = 1.f / sum;
        int* ip = IDX + (size_t)tok * 128 + h * 16; float* gp = GATE + (size_t)tok * 128 + h * 16;
#pragma unroll
        for (int q = 0; q < 4; ++q) { *(int4*)(ip + 4 * q) = make_int4(ex[4 * q], ex[4 * q + 1], ex[4 * q + 2], ex[4 * q + 3]);
            *(f32x4*)(gp + 4 * q) = (f32x4){val[4 * q] * inv, val[4 * q + 1] * inv, val[4 * q + 2] * inv, val[4 * q + 3] * inv}; }
    }
}

typedef __bf16 bf16x8_t __attribute__((ext_vector_type(8)));
__device__ __forceinline__ float dot8(bf16x8_t a, bf16x8_t b, float acc) {
    acc = __builtin_amdgcn_fdot2_f32_bf16(__builtin_shufflevector(a, a, 0, 1), __builtin_shufflevector(b, b, 0, 1), acc, false);
    acc = __builtin_amdgcn_fdot2_f32_bf16(__builtin_shufflevector(a, a, 2, 3), __builtin_shufflevector(b, b, 2, 3), acc, false);
    acc = __builtin_amdgcn_fdot2_f32_bf16(__builtin_shufflevector(a, a, 4, 5), __builtin_shufflevector(b, b, 4, 5), acc, false);
    acc = __builtin_amdgcn_fdot2_f32_bf16(__builtin_shufflevector(a, a, 6, 7), __builtin_shufflevector(b, b, 6, 7), acc, false);
    return acc;
}
__device__ __forceinline__ void axpy8(float a, u32x4 v, float* o) {
    o[0] += a * bflo(v.x); o[1] += a * bfhi(v.x); o[2] += a * bflo(v.y); o[3] += a * bfhi(v.y);
    o[4] += a * bflo(v.z); o[5] += a * bfhi(v.z); o[6] += a * bflo(v.w); o[7] += a * bfhi(v.w);
}
__device__ __forceinline__ void peer_experts(const Frame& F, const Args& A) {
    const bf16_t* N2 = (const bf16_t*)(A.ws + WS_N1);
    const bf16x8_t* U = (const bf16x8_t*)(A.ws + WS_U); const u32x4* V = (const u32x4*)(A.ws + WS_V);
    const int* IDX = (const int*)(A.ws + WS_P + P_IDX); const float* GATE = (const float*)(A.ws + WS_P + P_GATE);
    float* out = A.out; const float* fg = A.in[I_FG];
    const int gw = F.bid * NWAVES + F.wave, NGW = F.G * NWAVES, l = F.lane;
    for (int tok = gw; tok < T_TOK; tok += NGW) {
        const bf16x8_t xa = *((const bf16x8_t*)(N2 + (size_t)tok * D) + l), xb = *((const bf16x8_t*)(N2 + (size_t)tok * D) + 64 + l);
        const int e_lo = IDX[(size_t)tok * 128 + l], e_hi = IDX[(size_t)tok * 128 + 64 + l];
        const float g_lo = GATE[(size_t)tok * 128 + l], g_hi = GATE[(size_t)tok * 128 + 64 + l];
        float o[16];
#pragma unroll
        for (int i = 0; i < 16; ++i) o[i] = 0.f;
        for (int kb = 0; kb < 128; kb += 8) {
            int e[8]; float gt[8]; bf16x8_t ua[8], ub[8]; u32x4 va[8], vb[8];
#pragma unroll
            for (int j = 0; j < 8; ++j) { const int k = kb + j;
                e[j] = (kb < 64) ? __builtin_amdgcn_readlane(e_lo, k & 63) : __builtin_amdgcn_readlane(e_hi, k & 63);
                gt[j] = (kb < 64) ? __builtin_bit_cast(float, __builtin_amdgcn_readlane(__builtin_bit_cast(int, g_lo), k & 63)) : __builtin_bit_cast(float, __builtin_amdgcn_readlane(__builtin_bit_cast(int, g_hi), k & 63)); }
#pragma unroll
            for (int j = 0; j < 8; ++j) { ua[j] = U[(size_t)e[j] * 128 + l]; ub[j] = U[(size_t)e[j] * 128 + 64 + l]; }
            float a[8];
#pragma unroll
            for (int j = 0; j < 8; ++j) { float p = dot8(ua[j], xa, 0.f); p = dot8(ub[j], xb, p); a[j] = p; }
#pragma unroll
            for (int j = 0; j < 8; ++j) { va[j] = V[(size_t)e[j] * 128 + l]; vb[j] = V[(size_t)e[j] * 128 + 64 + l]; }
#pragma unroll
            for (int j = 0; j < 8; ++j) { const float hsum = wave_sum(a[j]); a[j] = gelu_tanh(hsum) * gt[j]; }
#pragma unroll
            for (int j = 0; j < 8; ++j) { axpy8(a[j], va[j], o); axpy8(a[j], vb[j], o + 8); }
        }
        float* hp = out + (size_t)tok * D;
        f32x4 h0 = *(const f32x4*)(hp + 8 * l), h1 = *(const f32x4*)(hp + 8 * l + 4), h2 = *(const f32x4*)(hp + 512 + 8 * l), h3 = *(const f32x4*)(hp + 512 + 8 * l + 4);
        h0 += (f32x4){o[0], o[1], o[2], o[3]}; h1 += (f32x4){o[4], o[5], o[6], o[7]}; h2 += (f32x4){o[8], o[9], o[10], o[11]}; h3 += (f32x4){o[12], o[13], o[14], o[15]};
        float ss = 0.f;
#pragma unroll
        for (int i = 0; i < 4; ++i) ss += h0[i] * h0[i] + h1[i] * h1[i] + h2[i] * h2[i] + h3[i] * h3[i];
        const float rstd = 1.f / sqrtf(wave_sum(ss) * (1.f / D) + EPS);
        const f32x4 g0 = *(const f32x4*)(fg + 8 * l), g1 = *(const f32x4*)(fg + 8 * l + 4), g2 = *(const f32x4*)(fg + 512 + 8 * l), g3 = *(const f32x4*)(fg + 512 + 8 * l + 4);
        *(f32x4*)(hp + 8 * l) = h0 * rstd * g0; *(f32x4*)(hp + 8 * l + 4) = h1 * rstd * g1; *(f32x4*)(hp + 512 + 8 * l) = h2 * rstd * g2; *(f32x4*)(hp + 512 + 8 * l + 4) = h3 * rstd * g3;
    }
}


#ifdef DEBUG_CHECK
constexpr size_t WS_DBG = 472 * MiB;
__device__ __forceinline__ int dbg_tok(int i) { return (i * 509 + 3) & 32767; }
__device__ __forceinline__ float gelu_ref(float x) { return 0.5f * x * (1.f + tanhf(0.7978845608028654f * (x + 0.044715f * x * x * x))); }
__global__ void __launch_bounds__(512) dbg_scores(Args a) {
    __shared__ float n2s[1024]; __shared__ float q[2048];
    const int t = dbg_tok(blockIdx.x), tid = threadIdx.x;
    const bf16_t* N2 = (const bf16_t*)(a.ws + WS_N1); const float* SC = (const float*)(a.ws + WS_P + P_SC); unsigned* dbg = (unsigned*)(a.ws + WS_DBG);
    for (int k = tid; k < 1024; k += 512) n2s[k] = bf1(N2[(size_t)t * 1024 + k]);
    __syncthreads();
    for (int r = 0; r < 4; ++r) { const int c = tid + 512 * r; float s = 0.f; for (int k = 0; k < 1024; ++k) s += n2s[k] * a.in[I_WQ][(size_t)k * 2048 + c]; q[c] = s; }
    __syncthreads();
    float md = 0.f;
    for (int r = 0; r < 4; ++r) { const int n = tid + 512 * r, hh = n >> 7, key = n & 127; const float* kX = (hh & 1) ? a.in[I_K2] : a.in[I_K1];
        float s = 0.f; for (int d = 0; d < 128; ++d) s += q[hh * 128 + d] * kX[key * 128 + d];
        md = fmaxf(md, fabsf(s - SC[(size_t)n * T_TOK + t])); }
    atomicMax(&dbg[0], __builtin_bit_cast(unsigned, md));
}
__global__ void __launch_bounds__(64) dbg_topk(Args a) {
    __shared__ float s1[8][128], s2[8][128], cv[8][256]; __shared__ float t1v[8][16], t2v[8][16]; __shared__ int t1i[8][16], t2i[8][16], exi[8][16]; __shared__ float exv[8][16];
    const int t = dbg_tok(blockIdx.x), h = threadIdx.x;
    const float* SC = (const float*)(a.ws + WS_P + P_SC); const int* IDX = (const int*)(a.ws + WS_P + P_IDX); const float* GATE = (const float*)(a.ws + WS_P + P_GATE); unsigned* dbg = (unsigned*)(a.ws + WS_DBG);
    if (h >= 8) return;
    for (int j = 0; j < 128; ++j) { s1[h][j] = SC[(size_t)(h * 256 + j) * T_TOK + t]; s2[h][j] = SC[(size_t)(h * 256 + 128 + j) * T_TOK + t]; }
    for (int r = 0; r < 16; ++r) { int b1 = 0, b2 = 0; for (int j = 1; j < 128; ++j) { if (s1[h][j] > s1[h][b1]) b1 = j; if (s2[h][j] > s2[h][b2]) b2 = j; }
        t1v[h][r] = s1[h][b1]; t1i[h][r] = b1; s1[h][b1] = -1e30f; t2v[h][r] = s2[h][b2]; t2i[h][r] = b2; s2[h][b2] = -1e30f; }
    for (int c = 0; c < 256; ++c) cv[h][c] = t1v[h][c >> 4] + t2v[h][c & 15];
    for (int r = 0; r < 16; ++r) { int bc = 0; for (int c = 1; c < 256; ++c) if (cv[h][c] > cv[h][bc]) bc = c;
        exv[h][r] = cv[h][bc]; exi[h][r] = t1i[h][bc >> 4] * 128 + t2i[h][bc & 15]; cv[h][bc] = -1e30f; }
    float sum = 0.f; const float mx0 = exv[h][0]; for (int r = 0; r < 16; ++r) { exv[h][r] = expf(exv[h][r] - mx0); } for (int r = 0; r < 16; ++r) sum += exv[h][r];
    unsigned miss = 0; float gd = 0.f;
    for (int w = 0; w < 16; ++w) { const int e = IDX[(size_t)t * 128 + h * 16 + w]; const float g = GATE[(size_t)t * 128 + h * 16 + w]; bool found = false;
        for (int r = 0; r < 16; ++r) if (exi[h][r] == e) { found = true; gd = fmaxf(gd, fabsf(g - exv[h][r] / sum)); }
        if (!found) ++miss; }
    atomicAdd(&dbg[1], miss); atomicMax(&dbg[3], __builtin_bit_cast(unsigned, gd));
}
__global__ void __launch_bounds__(512) dbg_experts_pre(Args a) {
    __shared__ float n2s[1024]; __shared__ float ak[128]; __shared__ int ek[128]; __shared__ float red[8];
    const int t = dbg_tok(blockIdx.x), tid = threadIdx.x, lane = tid & 63, wave = tid >> 6;
    const bf16_t* N2 = (const bf16_t*)(a.ws + WS_N1); const int* IDX = (const int*)(a.ws + WS_P + P_IDX); const float* GATE = (const float*)(a.ws + WS_P + P_GATE);
    float* rows = (float*)(a.ws + WS_DBG + MiB);
    for (int k = tid; k < 1024; k += 512) n2s[k] = bf1(N2[(size_t)t * 1024 + k]);
    if (tid < 128) ek[tid] = IDX[(size_t)t * 128 + tid];
    __syncthreads();
    for (int k = wave * 16; k < wave * 16 + 16; ++k) { const float* u = a.in[I_PU] + (size_t)ek[k] * 1024; float s = 0.f; for (int j = lane; j < 1024; j += 64) s += u[j] * n2s[j];
        s = wave_sum(s); if (lane == 0) ak[k] = gelu_ref(s) * GATE[(size_t)t * 128 + k]; }
    __syncthreads();
    float h2[2]; float ss = 0.f;
    for (int r = 0; r < 2; ++r) { const int d = tid + 512 * r; float o = 0.f; for (int k = 0; k < 128; ++k) o += ak[k] * a.in[I_PV][(size_t)ek[k] * 1024 + d]; h2[r] = a.out[(size_t)t * 1024 + d] + o; ss += h2[r] * h2[r]; }
    ss = wave_sum(ss); if (lane == 0) red[wave] = ss; __syncthreads();
    float tot = 0.f; for (int w = 0; w < 8; ++w) tot += red[w];
    const float rstd = 1.f / sqrtf(tot / 1024.f + EPS);
    for (int r = 0; r < 2; ++r) { const int d = tid + 512 * r; rows[(size_t)blockIdx.x * 1024 + d] = h2[r] * rstd * a.in[I_FG][d]; }
}
__global__ void __launch_bounds__(512) dbg_experts_post(Args a) {
    const int t = dbg_tok(blockIdx.x), tid = threadIdx.x; const float* rows = (const float*)(a.ws + WS_DBG + MiB); float* dbgf = (float*)(a.ws + WS_DBG);
    float e = 0.f, n = 0.f;
    for (int r = 0; r < 2; ++r) { const int d = tid + 512 * r; const float x = rows[(size_t)blockIdx.x * 1024 + d], y = a.out[(size_t)t * 1024 + d]; e += (x - y) * (x - y); n += x * x; }
    e = wave_sum(e); n = wave_sum(n); if ((tid & 63) == 0) { atomicAdd(&dbgf[4], e); atomicAdd(&dbgf[5], n); }
}
__global__ void __launch_bounds__(512) dbg_report(Args a, int which) {
    const unsigned* dbg = (const unsigned*)(a.ws + WS_DBG); const float* dbgf = (const float*)(a.ws + WS_DBG);
    const float mA = dbgf[0], gd = dbgf[3]; const unsigned miss = dbg[1]; const float relC = sqrtf(dbgf[4] / fmaxf(dbgf[5], 1e-30f));
    float X;
    if (which == 0) { int mask = 0; if (mA > 0.05f) mask |= 1; if (miss > 400u) mask |= 2; if (relC > 0.05f) mask |= 4; if (gd > 0.02f) mask |= 8; X = 1000.f + 100.f * mask; }
    else if (which == 1) X = 1e6f * mA; else if (which == 2) X = 100.f + (float)miss; else if (which == 3) X = 1e6f * relC; else X = 1e6f * gd;
    for (size_t i = (size_t)blockIdx.x * 512 + threadIdx.x; i < (size_t)T_TOK * D; i += (size_t)gridDim.x * 512) a.out[i] = (i == 0) ? X : 0.f;
}
#endif

constexpr int NPH = 11;
__global__ void __launch_bounds__(NWAVES * 64, 2) fwd_kernel(Args args) {
    extern __shared__ __attribute__((aligned(16))) unsigned char lds_raw[];
    Frame F;
    F.lds = (LAS unsigned char*)lds_raw;
    F.tid = threadIdx.x; F.lane = F.tid & 63; F.wave = __builtin_amdgcn_readfirstlane(F.tid >> 6);
    F.G = gridDim.x; F.bid = blockIdx.x;
    volatile LAS unsigned* MISC = (volatile LAS unsigned*)(F.lds + MISC_OFF);
    for (int u = F.tid; u < (LDS_BYTES - LDSCTL_OFF) / 4; u += NWAVES * 64) ((LAS unsigned*)(F.lds + LDSCTL_OFF))[u] = 0u;
    __syncthreads();
    unsigned* ctl = (unsigned*)(args.ws + WS_CTL);
    const int lo = args.ph_lo, hi = args.ph_hi;
    XcdBarrier bar; bar.bar = ctl + CW_BAR + args.li * XCD_BAR_WORDS; bar.x = 0; bar.st = nullptr;
    if (hi - lo > 1) bar = xcd_barrier_post(ctl + CW_BAR + args.li * XCD_BAR_WORDS, MISC + 8);
#define IN(k) (lo <= (k) && (k) < hi)
#define SEAM(k) do { if (IN(k) && IN((k) + 1)) xcd_barrier(bar); } while (0)
    unsigned char* ws = args.ws;
    bf16_t* P = (bf16_t*)(ws + WS_P);

    if (IN(0)) { phase0(F, args); SEAM(0); }
    if (IN(1)) {
        pg8::Gemm g{(const bf16_t*)(ws + WS_N1), (const bf16_t*)(ws + WS_WIN), T_TOK, NPROJ, D, D}; pg8::StaticOrder S; S.init(T_TOK, NPROJ, F.G, F.bid);
        pg8::EpiProj E{P, (float*)(ws + WS_ALR)};
        pg8::gemm_phase<pg8::EpiProj, pg8::StaticOrder, true, true>(F.lds, g, S, E);
        SEAM(1);
    }
    if (IN(2)) {
        for (int it = F.bid; it < 2048 + 1024; it += F.G) { if (it < 2048) gla_chunk_unit(F, args, it); else sgu_unit(F, args, it - 2048); }
        SEAM(2);
    }
    if (IN(3)) { gla_scan(F, args); SEAM(3); }
    if (IN(4)) { for (int it = F.bid; it < 2048; it += F.G) gla_out_unit(F, args, it); SEAM(4); }
    if (IN(5)) {
        { pg8::Gemm g{P + PC_Q, (const bf16_t*)(ws + WS_WA), T_TOK, D, 512, PLD}; pg8::StaticOrder S; S.init(T_TOK, D, F.G, F.bid);
          pg8::EpiBrA E{P}; pg8::gemm_phase<pg8::EpiBrA, pg8::StaticOrder, true, true>(F.lds, g, S, E); }
        { pg8::Gemm g{P + PC_SU, (const bf16_t*)(ws + WS_WB), T_TOK, D, 512, PLD}; pg8::StaticOrder S; S.init(T_TOK, D, F.G, F.bid);
          pg8::EpiBrB E{P}; pg8::gemm_phase<pg8::EpiBrB, pg8::StaticOrder, true, true>(F.lds, g, S, E); }
        SEAM(5);
    }
    if (IN(6)) {
        pg8::Gemm g{P + PC_MRG, (const bf16_t*)(ws + WS_WOUT), T_TOK, D, D, PLD}; pg8::StaticOrder S; S.init(T_TOK, D, F.G, F.bid);
        pg8::EpiOut E{args.in[I_X], args.out}; pg8::gemm_phase<pg8::EpiOut, pg8::StaticOrder, true, true>(F.lds, g, S, E);
        SEAM(6);
    }
    if (IN(7)) {
        const int gw = F.bid * NWAVES + F.wave, NGW = F.G * NWAVES;
        for (int m = gw; m < T_TOK; m += NGW) rms_row_to_bf16(F.lane, args.out + (size_t)m * D, args.in[I_N2G], (bf16_t*)(ws + WS_N1) + (size_t)m * D);
        SEAM(7);
    }
    if (IN(8)) {
        pg8::Gemm g{(const bf16_t*)(ws + WS_N1), (const bf16_t*)(ws + WS_WQF), T_TOK, 2048, D, D}; pg8::StaticOrder S; S.init(T_TOK, 2048, F.G, F.bid);
        pg8::EpiScores E{(float*)(ws + WS_P + P_SC)}; pg8::gemm_phase<pg8::EpiScores, pg8::StaticOrder, true, true>(F.lds, g, S, E);
        SEAM(8);
    }
    if (IN(9)) { peer_topk(F, args); SEAM(9); }
    if (IN(10)) { peer_experts(F, args); }
#undef IN
#undef SEAM
}

extern "C" void kernel_launch(void* const* d_in, const int* in_sizes, int n_in, void* d_out, int out_size, void* d_ws, size_t ws_size, hipStream_t stream) {
    static int grid = 0;
    if (grid == 0) {
        if (n_in != 20 || in_sizes[0] != T_TOK * D || out_size != T_TOK * D || ws_size < WS_END) {
            fprintf(stderr, "kernel_launch: unexpected shapes: n_in %d in0 %d out %d ws %zu (need %zu)\n", n_in, n_in > 0 ? in_sizes[0] : -1, out_size, ws_size, (size_t)WS_END); grid = -1; return; }
        int dev = 0, cus = 0;
        if (hipGetDevice(&dev) != hipSuccess || hipDeviceGetAttribute(&cus, hipDeviceAttributeMultiprocessorCount, dev) != hipSuccess) { grid = -1; return; }
        if (hipFuncSetAttribute((const void*)fwd_kernel, hipFuncAttributeMaxDynamicSharedMemorySize, LDS_BYTES) != hipSuccess) { fprintf(stderr, "kernel_launch: hipFuncSetAttribute failed\n"); grid = -1; return; }
        int per_cu = 0;
        if (hipOccupancyMaxActiveBlocksPerMultiprocessor(&per_cu, (const void*)fwd_kernel, NWAVES * 64, LDS_BYTES) != hipSuccess || per_cu < 1) fprintf(stderr, "kernel_launch: occupancy query says %d\n", per_cu);
        (void)hipGetLastError();
        grid = cus;
    }
    if (grid < 0) return;
    (void)hipMemsetAsync((char*)d_ws + WS_CTL, 0, CTL_ZERO_BYTES, stream);
    Args a{};
    for (int i = 0; i < 20; ++i) a.in[i] = (const float*)d_in[i];
    a.out = (float*)d_out; a.ws = (unsigned char*)d_ws;
    if (MK_N_LAUNCHES == 1) {
        a.ph_lo = 0; a.ph_hi = NPH; a.li = 0;
        hipLaunchKernelGGL(fwd_kernel, dim3(grid), dim3(NWAVES * 64), LDS_BYTES, stream, a);
    } else {
        for (int li = 0; li < NPH; ++li) { a.ph_lo = li; a.ph_hi = li + 1; a.li = 0;
#ifdef DEBUG_CHECK
            if (li == 0) (void)hipMemsetAsync((char*)d_ws + WS_DBG, 0, 4096, stream);
            if (li == 9) hipLaunchKernelGGL(dbg_scores, dim3(64), dim3(512), 0, stream, a);
            if (li == 10) { hipLaunchKernelGGL(dbg_topk, dim3(64), dim3(64), 0, stream, a); hipLaunchKernelGGL(dbg_experts_pre, dim3(64), dim3(512), 0, stream, a); }
#endif
            hipLaunchKernelGGL(fwd_kernel, dim3(grid), dim3(NWAVES * 64), LDS_BYTES, stream, a); }
#ifdef DEBUG_CHECK
        hipLaunchKernelGGL(dbg_experts_post, dim3(64), dim3(512), 0, stream, a);
        hipLaunchKernelGGL(dbg_report, dim3(1024), dim3(512), 0, stream, a, DEBUG_CHECK - 1);
#endif
    }
}
```

```cpp
#include <hip/hip_runtime.h>
#include <cstdio>
#include <cstdint>


#ifndef XTRA_BAR
#define XTRA_BAR 0
#endif
#ifndef DRY_EXP
#define DRY_EXP 0
#endif
#ifndef DUP_PHASE
#define DUP_PHASE -1
#endif
#ifndef MK_N_LAUNCHES
#define MK_N_LAUNCHES 1
#endif

#define LAS __attribute__((address_space(3)))
#define GAS __attribute__((address_space(1)))
typedef unsigned short bf16_t;
typedef short bf16x8 __attribute__((ext_vector_type(8)));
typedef float f32x4 __attribute__((ext_vector_type(4)));
typedef float f32x2 __attribute__((ext_vector_type(2)));
typedef unsigned u32x4 __attribute__((ext_vector_type(4)));
typedef unsigned u32x2 __attribute__((ext_vector_type(2)));
typedef __bf16 bf16x2_t __attribute__((ext_vector_type(2)));

constexpr int T_TOK = 32768, D = 1024, SEQ = 4096, NBATCH = 8;
constexpr int NPROJ = 5376;
constexpr int PLD = 5120;
constexpr int PC_Q = 0, PC_K = 512, PC_V = 1024, PC_R = 1536, PC_SU = 2048, PC_SV = 2560, PC_GA = 3072, PC_GB = 4096;
constexpr int PC_MRG = 512;
constexpr float EPS = 1e-6f;
constexpr int NEXP = 16384;

constexpr size_t MiB = 1u << 20;
constexpr size_t WS_CTL = 0, CTL_ZERO_BYTES = 64 * 1024;
constexpr size_t WS_WIN = 1 * MiB;
constexpr size_t WS_WA = 12 * MiB;
constexpr size_t WS_WB = 13 * MiB;
constexpr size_t WS_WOUT = 14 * MiB;
constexpr size_t WS_WQF = 16 * MiB;
constexpr size_t WS_U8 = 20 * MiB;
constexpr size_t WS_V8 = 36 * MiB;
constexpr size_t WS_SU = 52 * MiB;
constexpr size_t WS_SV = 52 * MiB + 65536;
constexpr size_t WS_AK = 53 * MiB;
constexpr size_t WS_DEC = 84 * MiB;
constexpr size_t WS_ALR = 85 * MiB;
constexpr size_t WS_N1 = 87 * MiB;
constexpr size_t WS_P = 151 * MiB;
constexpr size_t WS_END = 471 * MiB;
constexpr size_t P_SC = 0, P_IDX = 256 * MiB, P_GATE = 272 * MiB, P_X8 = 288 * MiB;

constexpr int CW_BAR = 4096;

constexpr int RING_BYTES = 131072;
constexpr int LDSCTL_OFF = RING_BYTES, MISC_OFF = LDSCTL_OFF + 320;
constexpr int LDS_BYTES = 147456;
constexpr int NWAVES = 8;

__device__ __forceinline__ unsigned pk2(float lo, float hi) { const f32x2 v = {lo, hi}; const bf16x2_t b = __builtin_convertvector(v, bf16x2_t); return __builtin_bit_cast(unsigned, b); }
__device__ __forceinline__ unsigned f2bf(float f) { return pk2(f, 0.f) & 0xffffu; }
__device__ __forceinline__ float bflo(unsigned w) { return __builtin_bit_cast(float, w << 16); }
__device__ __forceinline__ float bfhi(unsigned w) { return __builtin_bit_cast(float, w & 0xffff0000u); }
__device__ __forceinline__ float bf1(bf16_t h) { return __builtin_bit_cast(float, ((unsigned)h) << 16); }
__device__ __forceinline__ float sigmoidf_(float x) { return __builtin_amdgcn_rcpf(1.f + __expf(-x)); }
__device__ __forceinline__ float gelu_tanh(float x) { const float y = 1.5957691216057308f * (x + 0.044715f * x * x * x); return x * sigmoidf_(y); }
__device__ __forceinline__ float siluf_(float x) { return x * sigmoidf_(x); }
__device__ __forceinline__ float wave_sum(float v) {
#pragma unroll
    for (int o = 1; o < 64; o <<= 1) v += __shfl_xor(v, o);
    return v;
}
#define LDS_WAIT() asm volatile("s_waitcnt lgkmcnt(0)" ::: "memory")
#define VM_WAIT() asm volatile("s_waitcnt vmcnt(0)" ::: "memory")

namespace pg8 {
constexpr int BM = 256, BK = 64, HALF = 128, HTB = HALF * BK * 2, STAGE_BYTES = 8 * HTB, NXCD = 8, WGM = 8;
__host__ __device__ __forceinline__ int lds_byte(int r, int c) { const int st = (r >> 4) * 2 + (c >> 5), rr = r & 15, cc = c & 31, ob = rr * 64 + cc * 2; return st * 1024 + (ob ^ (((ob >> 9) & 1) << 5)); }
__host__ __device__ __forceinline__ void stage_rc(int b, int& R, int& C) { const int st = b / 1024, sb = b % 1024, swz = sb ^ (((sb >> 9) & 1) << 5); R = (st >> 1) * 16 + swz / 64; C = (st & 1) * 32 + (swz % 64) / 2; }
__host__ __device__ __forceinline__ int perm32(int rho) { const int n = rho >> 4, i = rho & 15; return 8 * (i >> 2) + 4 * n + (i & 3); }

struct Unit { int pm, pn; };
struct Gemm { const bf16_t* A; const bf16_t* Bt; int M, N, K, lda; };

struct StaticOrder {
    int nM, nN, nwg, G, c;
    __host__ __device__ void init(int M, int N, int G_, int c_) { nM = M / BM; nN = N / BM; nwg = nM * nN; G = G_; c = c_; }
    __host__ __device__ bool next(int i, Unit& u) const {
        const long L = (long)i * G + c; if (L >= nwg) return false;
        int wgid = (int)L; { const int q = nwg / NXCD, r = nwg % NXCD, xcd = wgid % NXCD, off = wgid / NXCD; wgid = (xcd < r ? xcd * (q + 1) : r * (q + 1) + (xcd - r) * q) + off; }
        const int nig = WGM * nN, gid = wgid / nig, fm = gid * WGM, gsz = (nM - fm) < WGM ? (nM - fm) : WGM;
        u.pm = fm + ((wgid % nig) % gsz); u.pn = (wgid % nig) / gsz; return true;
    }
    __device__ __forceinline__ void a_ready(const Unit&) const {}
    __device__ __forceinline__ void done(const Unit&) const {}
};

template <class Epi, class Sched, bool ALIGN_EPI = false, bool SP2 = false>
__device__ __forceinline__ void gemm_phase(LAS unsigned char* lds, const Gemm g, const Sched& S, const Epi& E) {
    const int tid = threadIdx.x, wid = __builtin_amdgcn_readfirstlane(tid >> 6), lane = tid & 63, wr = wid >> 2, wc = wid & 3, fr = lane & 15, fq = lane >> 4;
    const int K = g.K, nt = K / BK, lda = g.lda;
    unsigned voffA[2], voffB[2];
#pragma unroll
    for (int i = 0; i < 2; ++i) { int R, C; stage_rc(tid * 16 + i * 8192, R, C); const int Rb = Epi::PERM ? ((R & ~31) + perm32(R & 31)) : R;
        voffA[i] = (unsigned)(R * lda + C) * 2u; voffB[i] = (unsigned)(Rb * K + C) * 2u; }
    const size_t kstep = (size_t)(BK * 2);
    const size_t hstepA = (size_t)HALF * lda * 2, hstepB = (size_t)HALF * K * 2;
    const size_t tstepA = 2 * hstepA, tstepB = 2 * hstepB;
    const unsigned ldsw = (unsigned)wid * 1024u;
    const int aoff = lds_byte(wr * 64 + fr, fq * 8), boff = lds_byte(wc * 32 + fr, fq * 8);
#define PG8_SA(b, h) (((b) * 2 + (h)) * HTB)
#define PG8_SB(b, h) ((4 + (b) * 2 + (h)) * HTB)
#define PG8_STAGE(bufoff, gbase, voff) do { _Pragma("unroll") for (int _i = 0; _i < 2; ++_i) \
        __builtin_amdgcn_global_load_lds((const unsigned*)((const char*)(gbase) + (voff)[_i]), (LAS unsigned*)(lds + (bufoff) + ldsw + _i * 8192), 16, 0, 0); } while (0)
#define PG8_LDA(dst, b, h) do { _Pragma("unroll") for (int m = 0; m < 4; ++m) _Pragma("unroll") for (int k = 0; k < 2; ++k) dst[m][k] = *(const LAS bf16x8*)(lds + PG8_SA(b, h) + aoff + m * 2048 + k * 1024); } while (0)
#define PG8_LDB(dst, b, h) do { _Pragma("unroll") for (int n = 0; n < 2; ++n) _Pragma("unroll") for (int k = 0; k < 2; ++k) dst[n][k] = *(const LAS bf16x8*)(lds + PG8_SB(b, h) + boff + n * 2048 + k * 1024); } while (0)
#define PG8_MMA(ai, bj, At, Bt) do { __builtin_amdgcn_s_setprio(1); _Pragma("unroll") for (int m = 0; m < 4; ++m) _Pragma("unroll") for (int n = 0; n < 2; ++n) _Pragma("unroll") for (int k = 0; k < 2; ++k) \
        acc[ai][bj][m][n] = __builtin_amdgcn_mfma_f32_16x16x32_bf16(Bt[n][k], At[m][k], acc[ai][bj][m][n], 0, 0, 0); __builtin_amdgcn_s_setprio(0); } while (0)
#define PG8_WAIT_V(n) asm volatile("s_waitcnt vmcnt(" #n ")" ::: "memory")
#define PG8_WAIT_L(n) asm volatile("s_waitcnt lgkmcnt(" #n ")" ::: "memory")
#define PG8_BAR __builtin_amdgcn_s_barrier()
#define PG8_SCHED __builtin_amdgcn_sched_barrier(0)
    Unit cur, nxt; int ui = 0;
    if (!S.next(0, cur)) return;
    f32x4 acc[2][2][4][2];
#pragma unroll
    for (int a = 0; a < 2; ++a)
#pragma unroll
        for (int b = 0; b < 2; ++b)
#pragma unroll
            for (int m = 0; m < 4; ++m)
#pragma unroll
                for (int n = 0; n < 2; ++n) acc[a][b][m][n] = (f32x4){0.f, 0.f, 0.f, 0.f};
    bf16x8 At[4][2], B0[2][2], B1[2][2];
    const char* cA = (const char*)g.A + (size_t)cur.pm * tstepA; const char* cB = (const char*)g.Bt + (size_t)cur.pn * tstepB;
    S.a_ready(cur);
    if constexpr (SP2) {
        PG8_STAGE(PG8_SB(0, 0), cB, voffB); PG8_STAGE(PG8_SB(0, 1), cB + hstepB, voffB); PG8_STAGE(PG8_SA(0, 0), cA, voffA); PG8_STAGE(PG8_SA(0, 1), cA + hstepA, voffA);
        if (wr == 1) PG8_BAR;
        PG8_WAIT_V(2); PG8_BAR;
        PG8_STAGE(PG8_SB(1, 0), cB + kstep, voffB); PG8_STAGE(PG8_SA(1, 0), cA + kstep, voffA); PG8_STAGE(PG8_SB(1, 1), cB + hstepB + kstep, voffB);
        PG8_WAIT_V(6); PG8_BAR;
    } else {
        PG8_STAGE(PG8_SB(0, 0), cB, voffB); PG8_STAGE(PG8_SA(0, 0), cA, voffA); PG8_STAGE(PG8_SB(0, 1), cB + hstepB, voffB); PG8_STAGE(PG8_SA(0, 1), cA + hstepA, voffA);
        if (wr == 1) PG8_BAR;
        PG8_WAIT_V(4); PG8_BAR;
        PG8_STAGE(PG8_SB(1, 0), cB + kstep, voffB); PG8_STAGE(PG8_SA(1, 0), cA + kstep, voffA); PG8_STAGE(PG8_SB(1, 1), cB + hstepB + kstep, voffB);
        PG8_WAIT_V(6); PG8_BAR;
    }
    for (;;) {
        const bool has_next = S.next(ui + 1, nxt);
        const char* nA = has_next ? (const char*)g.A + (size_t)nxt.pm * tstepA : cA; const char* nB = has_next ? (const char*)g.Bt + (size_t)nxt.pn * tstepB : cB;
        for (int t = 0; t < nt; t += 2) {
            const bool last = (t == nt - 2);
            const char* a1 = cA + (size_t)(t + 1) * kstep;
            const char* a2 = last ? nA : cA + (size_t)(t + 2) * kstep; const char* b2 = last ? nB : cB + (size_t)(t + 2) * kstep;
            const char* a3 = a2 + kstep; const char* b3 = b2 + kstep;
            if (last && has_next) S.a_ready(nxt);
            if constexpr (SP2) {
            PG8_LDB(B0, 0, 0); PG8_LDB(B1, 0, 1); PG8_SCHED; PG8_LDA(At, 0, 0); PG8_STAGE(PG8_SA(1, 1), a1 + hstepA, voffA);
            PG8_WAIT_V(8); PG8_WAIT_L(0); PG8_BAR; PG8_MMA(0, 0, At, B0); PG8_MMA(0, 1, At, B1); PG8_BAR; PG8_SCHED;
            PG8_LDA(At, 0, 1); PG8_STAGE(PG8_SB(0, 0), b2, voffB); PG8_STAGE(PG8_SB(0, 1), b2 + hstepB, voffB); PG8_STAGE(PG8_SA(0, 0), a2, voffA);
            PG8_WAIT_V(8); PG8_WAIT_L(0); PG8_BAR; PG8_MMA(1, 0, At, B0); PG8_MMA(1, 1, At, B1); PG8_BAR; PG8_SCHED;
            PG8_LDB(B0, 1, 0); PG8_LDB(B1, 1, 1); PG8_SCHED; PG8_LDA(At, 1, 0); PG8_STAGE(PG8_SA(0, 1), a2 + hstepA, voffA);
            PG8_WAIT_V(8); PG8_WAIT_L(0); PG8_BAR; PG8_MMA(0, 0, At, B0); PG8_MMA(0, 1, At, B1); PG8_BAR; PG8_SCHED;
            PG8_LDA(At, 1, 1); PG8_STAGE(PG8_SB(1, 0), b3, voffB); PG8_STAGE(PG8_SB(1, 1), b3 + hstepB, voffB); PG8_STAGE(PG8_SA(1, 0), a3, voffA);
            PG8_WAIT_V(8); PG8_WAIT_L(0); PG8_BAR; PG8_MMA(1, 0, At, B0); PG8_MMA(1, 1, At, B1); PG8_BAR; PG8_SCHED;
            } else {
            PG8_LDB(B0, 0, 0); PG8_SCHED; PG8_LDA(At, 0, 0); PG8_STAGE(PG8_SA(1, 1), a1 + hstepA, voffA);
            PG8_WAIT_L(8); PG8_BAR; PG8_WAIT_L(0); PG8_MMA(0, 0, At, B0); PG8_BAR; PG8_SCHED;
            PG8_LDB(B1, 0, 1); PG8_STAGE(PG8_SB(0, 0), b2, voffB);
            PG8_BAR; PG8_WAIT_L(0); PG8_MMA(0, 1, At, B1); PG8_BAR;
            PG8_LDA(At, 0, 1); PG8_STAGE(PG8_SA(0, 0), a2, voffA);
            PG8_BAR; PG8_WAIT_L(0); PG8_MMA(1, 0, At, B0); PG8_BAR; PG8_SCHED;
            PG8_STAGE(PG8_SB(0, 1), b2 + hstepB, voffB);
            PG8_WAIT_V(6); PG8_BAR; PG8_MMA(1, 1, At, B1); PG8_BAR;
            PG8_LDB(B0, 1, 0); PG8_SCHED; PG8_LDA(At, 1, 0); PG8_STAGE(PG8_SA(0, 1), a2 + hstepA, voffA);
            PG8_WAIT_L(8); PG8_BAR; PG8_WAIT_L(0); PG8_MMA(0, 0, At, B0); PG8_BAR; PG8_SCHED;
            PG8_LDB(B1, 1, 1); PG8_STAGE(PG8_SB(1, 0), b3, voffB);
            PG8_BAR; PG8_WAIT_L(0); PG8_MMA(0, 1, At, B1); PG8_BAR;
            PG8_LDA(At, 1, 1); PG8_STAGE(PG8_SA(1, 0), a3, voffA);
            PG8_BAR; PG8_WAIT_L(0); PG8_MMA(1, 0, At, B0); PG8_BAR; PG8_SCHED;
            PG8_STAGE(PG8_SB(1, 1), b3 + hstepB, voffB);
            PG8_WAIT_V(6); PG8_BAR; PG8_MMA(1, 1, At, B1); PG8_BAR;
            }
        }
        if constexpr (ALIGN_EPI) { if (wr == 0) PG8_BAR; }
        E(acc, cur, wr, wc, fr, fq); S.done(cur);
        if (!has_next) break;
#pragma unroll
        for (int a = 0; a < 2; ++a)
#pragma unroll
            for (int b = 0; b < 2; ++b)
#pragma unroll
                for (int m = 0; m < 4; ++m)
#pragma unroll
                    for (int n = 0; n < 2; ++n) acc[a][b][m][n] = (f32x4){0.f, 0.f, 0.f, 0.f};
        cur = nxt; cA = nA; cB = nB; ++ui;
        if constexpr (ALIGN_EPI) { if (wr == 1) PG8_BAR; }
    }
    PG8_WAIT_V(0);
    if constexpr (!ALIGN_EPI) { if (wr == 0) PG8_BAR; }
    PG8_BAR;
#undef PG8_SA
#undef PG8_SB
#undef PG8_STAGE
#undef PG8_LDA
#undef PG8_LDB
#undef PG8_MMA
#undef PG8_WAIT_V
#undef PG8_WAIT_L
#undef PG8_BAR
#undef PG8_SCHED
}

__device__ __forceinline__ u32x4 pack8(f32x4 v0, f32x4 v1) { u32x4 w; w.x = pk2(v0[0], v0[1]); w.y = pk2(v0[2], v0[3]); w.z = pk2(v1[0], v1[1]); w.w = pk2(v1[2], v1[3]); return w; }
__device__ __forceinline__ void unpack8(u32x4 w, f32x4& v0, f32x4& v1) { v0 = (f32x4){bflo(w.x), bfhi(w.x), bflo(w.y), bfhi(w.y)}; v1 = (f32x4){bflo(w.z), bfhi(w.z), bflo(w.w), bfhi(w.w)}; }

struct EpiProj {
    static constexpr bool PERM = true;
    bf16_t* P; float* ALR;
    __device__ __forceinline__ void operator()(const f32x4 (&acc)[2][2][4][2], const Unit& u, int wr, int wc, int fr, int fq) const {
        const int row0 = u.pm * BM + wr * 64 + fr; const int pn = u.pn; const int cl = wc * 32 + 8 * fq;
        if (pn == 20) {
            if (wc == 0 && fq < 2) {
#pragma unroll
                for (int ai = 0; ai < 2; ++ai)
#pragma unroll
                    for (int m = 0; m < 4; ++m) { float* rp = ALR + (size_t)(row0 + ai * HALF + m * 16) * 16 + 8 * fq;
                        *(f32x4*)rp = acc[ai][0][m][0]; *(f32x4*)(rp + 4) = acc[ai][0][m][1]; }
            }
            return;
        }
        const int mode = pn < 8 ? 0 : (pn < 12 ? 1 : 2);
#pragma unroll
        for (int ai = 0; ai < 2; ++ai)
#pragma unroll
            for (int m = 0; m < 4; ++m) { bf16_t* rowp = P + (size_t)(row0 + ai * HALF + m * 16) * PLD + pn * BM + cl;
#pragma unroll
                for (int bj = 0; bj < 2; ++bj) { f32x4 v0 = acc[ai][bj][m][0], v1 = acc[ai][bj][m][1];
                    if (mode == 1) {
#pragma unroll
                        for (int i = 0; i < 4; ++i) { v0[i] = gelu_tanh(v0[i]); v1[i] = gelu_tanh(v1[i]); }
                    } else if (mode == 2) {
#pragma unroll
                        for (int i = 0; i < 4; ++i) { v0[i] = sigmoidf_(v0[i]); v1[i] = sigmoidf_(v1[i]); }
                    }
                    *(u32x4*)(rowp + bj * HALF) = pack8(v0, v1); } }
    }
};
struct EpiBrA {
    static constexpr bool PERM = true;
    bf16_t* P;
    __device__ __forceinline__ void operator()(const f32x4 (&acc)[2][2][4][2], const Unit& u, int wr, int wc, int fr, int fq) const {
        const int row0 = u.pm * BM + wr * 64 + fr; const int c0 = u.pn * BM + wc * 32 + 8 * fq;
#pragma unroll
        for (int ai = 0; ai < 2; ++ai)
#pragma unroll
            for (int m = 0; m < 4; ++m) { bf16_t* rowp = P + (size_t)(row0 + ai * HALF + m * 16) * PLD;
#pragma unroll
                for (int bj = 0; bj < 2; ++bj) { const int c = c0 + bj * HALF; f32x4 g0, g1; unpack8(*(const u32x4*)(rowp + PC_GA + c), g0, g1);
                    *(u32x4*)(rowp + PC_MRG + c) = pack8(acc[ai][bj][m][0] * g0, acc[ai][bj][m][1] * g1); } }
    }
};
struct EpiBrB {
    static constexpr bool PERM = true;
    bf16_t* P;
    __device__ __forceinline__ void operator()(const f32x4 (&acc)[2][2][4][2], const Unit& u, int wr, int wc, int fr, int fq) const {
        const int row0 = u.pm * BM + wr * 64 + fr; const int c0 = u.pn * BM + wc * 32 + 8 * fq;
#pragma unroll
        for (int ai = 0; ai < 2; ++ai)
#pragma unroll
            for (int m = 0; m < 4; ++m) { bf16_t* rowp = P + (size_t)(row0 + ai * HALF + m * 16) * PLD;
#pragma unroll
                for (int bj = 0; bj < 2; ++bj) { const int c = c0 + bj * HALF; f32x4 g0, g1, p0, p1; unpack8(*(const u32x4*)(rowp + PC_GB + c), g0, g1); unpack8(*(const u32x4*)(rowp + PC_MRG + c), p0, p1);
                    *(u32x4*)(rowp + PC_MRG + c) = pack8(p0 + acc[ai][bj][m][0] * g0, p1 + acc[ai][bj][m][1] * g1); } }
    }
};
struct EpiOut {
    static constexpr bool PERM = true;
    const float* X; float* O;
    __device__ __forceinline__ void operator()(const f32x4 (&acc)[2][2][4][2], const Unit& u, int wr, int wc, int fr, int fq) const {
        const int row0 = u.pm * BM + wr * 64 + fr; const int c0 = u.pn * BM + wc * 32 + 8 * fq;
#pragma unroll
        for (int ai = 0; ai < 2; ++ai)
#pragma unroll
            for (int m = 0; m < 4; ++m) { const size_t ro = (size_t)(row0 + ai * HALF + m * 16) * D;
#pragma unroll
                for (int bj = 0; bj < 2; ++bj) { const int c = c0 + bj * HALF;
                    const f32x4 x0 = *(const f32x4*)(X + ro + c), x1 = *(const f32x4*)(X + ro + c + 4);
                    *(f32x4*)(O + ro + c) = x0 + acc[ai][bj][m][0]; *(f32x4*)(O + ro + c + 4) = x1 + acc[ai][bj][m][1]; } }
    }
};
struct EpiScores {
    static constexpr bool PERM = true;
    float* SC;
    __device__ __forceinline__ void operator()(const f32x4 (&acc)[2][2][4][2], const Unit& u, int wr, int wc, int fr, int fq) const {
        const int row0 = u.pm * BM + wr * 64 + fr; const int c0 = u.pn * BM + wc * 32 + 8 * fq;
#pragma unroll
        for (int bj = 0; bj < 2; ++bj)
#pragma unroll
            for (int n = 0; n < 2; ++n)
#pragma unroll
                for (int i = 0; i < 4; ++i) { float* cp = SC + (size_t)(c0 + bj * HALF + 4 * n + i) * T_TOK + row0;
#pragma unroll
                    for (int ai = 0; ai < 2; ++ai)
#pragma unroll
                        for (int m = 0; m < 4; ++m) cp[ai * HALF + m * 16] = acc[ai][bj][m][n][i]; }
    }
};
}

#define XB_TMO      128
#define XB_XCNT(j)  (256  + 64 * (j))
#define XB_XSUB(j)  (1280 + 64 * (j))
#define XB_XGEN(j)  (2304 + 64 * (j))
#define XB_TOP      3328
#define XB_TOPGEN   3392
#define XCD_BAR_WORDS 3456
#define XB_SPIN_CAP (1u << 18)
__device__ __forceinline__ unsigned xb_ld(unsigned* p)              { return __hip_atomic_load(p, __ATOMIC_RELAXED, __HIP_MEMORY_SCOPE_AGENT); }
__device__ __forceinline__ unsigned xb_add(unsigned* p, unsigned v) { return __hip_atomic_fetch_add(p, v, __ATOMIC_RELAXED, __HIP_MEMORY_SCOPE_AGENT); }
__device__ __forceinline__ unsigned xb_xcc_id() { return (unsigned)__builtin_amdgcn_s_getreg((3 << 11) | 20) & 0xFu; }
#define XB_SPIN(cond, bar) do { unsigned _sp = 0; while (cond) { __builtin_amdgcn_s_sleep(1); \
    if ((++_sp & 255u) == 0u) { if (xb_ld(&(bar)[XB_TMO])) break; if (_sp > XB_SPIN_CAP) { atomicAdd(&(bar)[XB_TMO], 1u); break; } } } } while (0)
struct XcdBarrier { unsigned* bar; unsigned x; volatile LAS unsigned* st; };
__device__ __forceinline__ XcdBarrier xcd_barrier_post(unsigned* bar, volatile LAS unsigned* st) {
    XcdBarrier b; b.bar = bar; b.x = xb_xcc_id(); b.st = st;
    if (threadIdx.x == 0) (void)xb_add(&bar[XB_XCNT(b.x)], 1u);
    return b;
}
__device__ __forceinline__ void xcd_barrier_complete(unsigned* bar, unsigned x, unsigned& nloc, unsigned& nx) {
    const unsigned G = gridDim.x * gridDim.y * gridDim.z;
    unsigned sum, cnt, mine, sp = 0u;
    for (;;) {
        sum = 0u; cnt = 0u; mine = 0u;
#pragma unroll
        for (unsigned j = 0; j < 16; ++j) { const unsigned c = xb_ld(&bar[XB_XCNT(j)]); sum += c; cnt += (c > 0u) ? 1u : 0u; mine = (j == x) ? c : mine; }
        if (sum == G) break;
        __builtin_amdgcn_s_sleep(1);
        if ((++sp & 255u) == 0u) { if (xb_ld(&bar[XB_TMO])) break; if (sp > XB_SPIN_CAP) { atomicAdd(&bar[XB_TMO], 1u); break; } }
    }
    nloc = mine > 0u ? mine : 1u; nx = cnt > 0u ? cnt : 1u;
}
__device__ __forceinline__ void xcd_barrier(const XcdBarrier& b) {
    asm volatile("s_waitcnt vmcnt(0)" ::: "memory");
    __syncthreads();
    if (threadIdx.x == 0) {
        unsigned* bar = b.bar;
        __builtin_amdgcn_s_waitcnt(0);
        unsigned nloc = b.st[0], nx = b.st[1];
        if (nloc == 0u) { xcd_barrier_complete(bar, b.x, nloc, nx); b.st[0] = nloc; b.st[1] = nx; }
        const unsigned old = xb_add(&bar[XB_XSUB(b.x)], 1u);
        const unsigned gen = old / nloc;
        if (old + 1u == (gen + 1u) * nloc) {
            __builtin_amdgcn_fence(__ATOMIC_RELEASE, "agent");
            asm volatile("s_waitcnt vmcnt(0)" ::: "memory");
            const unsigned og = xb_add(&bar[XB_TOP], 1u);
            const unsigned tg = og / nx;
            if (og + 1u == (tg + 1u) * nx) xb_add(&bar[XB_TOPGEN], 1u);
            else XB_SPIN(xb_ld(&bar[XB_TOPGEN]) == tg, bar);
            __builtin_amdgcn_fence(__ATOMIC_ACQUIRE, "agent");
            xb_add(&bar[XB_XGEN(b.x)], 1u);
            asm volatile("s_waitcnt vmcnt(0)" ::: "memory");
        } else {
            XB_SPIN(xb_ld(&bar[XB_XGEN(b.x)]) == gen, bar);
            __builtin_amdgcn_fence(__ATOMIC_ACQUIRE, "agent");
            asm volatile("s_waitcnt vmcnt(0)" ::: "memory");
        }
    }
    __syncthreads();
}

struct Args {
    const float* in[20]; float* out; unsigned char* ws; int ph_lo, ph_hi, li, pad;
};
enum { I_X = 0, I_N1G, I_WIN, I_WGU, I_BG, I_GLAG, I_SLNG, I_SLNB, I_SW, I_SB, I_WBA, I_WBB, I_WOUT, I_N2G, I_WQ, I_K1, I_K2, I_PU, I_PV, I_FG };

struct Frame {
    LAS unsigned char* lds;
    int tid, lane, wave, G, bid;
};

template <int MODE>
__device__ __forceinline__ void p0_transpose_item(const float* W, int K, int Nsrc, int Ndst, bf16_t* WT, LAS float* scr, int item, int lane) {
    const int nblk = Ndst / 32, kb = item / nblk, nb = item % nblk, k0 = 64 * kb, n0 = 32 * nb;
    const int nd = n0 + (lane & 31);
    int sc = nd; bool valid = true;
    if (MODE == 1) { if (nd < 2048) sc = nd; else if (nd < 5120) sc = nd + 16; else if (nd < 5136) sc = 2048 + (nd - 5120); else { sc = 0; valid = false; } }
#pragma unroll 8
    for (int i = 0; i < 32; ++i) { const int kk = 2 * i + (lane >> 5); const float v = valid ? W[(size_t)(k0 + kk) * Nsrc + sc] : 0.f; scr[kk * 33 + (lane & 31)] = v; }
    LDS_WAIT(); asm volatile("" ::: "memory");
    const int c = lane & 7;
#pragma unroll
    for (int j = 0; j < 4; ++j) { const int n = (lane >> 3) + 8 * j; const LAS float* s = scr + (8 * c) * 33 + n;
        u32x4 o; o.x = pk2(s[0 * 33], s[1 * 33]); o.y = pk2(s[2 * 33], s[3 * 33]); o.z = pk2(s[4 * 33], s[5 * 33]); o.w = pk2(s[6 * 33], s[7 * 33]);
        *(u32x4*)(WT + (size_t)(n0 + n) * K + k0 + 8 * c) = o; }
    LDS_WAIT(); asm volatile("" ::: "memory");
}
template <bool F8, int NB>
__device__ __forceinline__ void rms_rows_to_bf16(int lane, const float* x0, size_t xstride, const float* g, bf16_t* o0, size_t ostride, unsigned* o80 = nullptr, size_t o8stride = 0) {
    f32x4 v[NB][4]; float s[NB];
#pragma unroll
    for (int b = 0; b < NB; ++b) { const f32x4* xr = (const f32x4*)(x0 + b * xstride) + lane;
#pragma unroll
        for (int j = 0; j < 4; ++j) v[b][j] = xr[64 * j]; }
#pragma unroll
    for (int b = 0; b < NB; ++b) { s[b] = 0.f;
#pragma unroll
        for (int j = 0; j < 4; ++j) s[b] += (v[b][j].x * v[b][j].x + v[b][j].y * v[b][j].y) + (v[b][j].z * v[b][j].z + v[b][j].w * v[b][j].w); }
#pragma unroll
    for (int o = 1; o < 64; o <<= 1) {
#pragma unroll
        for (int b = 0; b < NB; ++b) s[b] += __shfl_xor(s[b], o); }
    const f32x4* gr = (const f32x4*)g + lane;
#pragma unroll
    for (int b = 0; b < NB; ++b) { const float rstd = 1.f / sqrtf(s[b] * (1.f / D) + EPS); u32x2* o8 = (u32x2*)(o0 + b * ostride) + lane;
#pragma unroll
        for (int j = 0; j < 4; ++j) { const f32x4 gg = gr[64 * j]; const f32x4 y = v[b][j] * rstd * gg; u32x2 o; o.x = pk2(y.x, y.y); o.y = pk2(y.z, y.w); o8[64 * j] = o;
            if (F8) { int w = 0; w = __builtin_amdgcn_cvt_pk_fp8_f32(bflo(o.x) * 16.f, bfhi(o.x) * 16.f, w, false); w = __builtin_amdgcn_cvt_pk_fp8_f32(bflo(o.y) * 16.f, bfhi(o.y) * 16.f, w, true); (o80 + b * o8stride)[64 * j + lane] = (unsigned)w; } } }
}
__device__ __forceinline__ float wave_max(float v) {
#pragma unroll
    for (int o = 1; o < 64; o <<= 1) v = fmaxf(v, __shfl_xor(v, o));
    return v;
}
template <int NB>
__device__ __forceinline__ void cvt_rows_fp8(int lane, const float* const (&src)[NB], unsigned char* const (&dst16)[NB], float* const (&scale_out)[NB]) {
    f32x4 v[NB][4]; float m[NB];
#pragma unroll
    for (int b = 0; b < NB; ++b) {
#pragma unroll
        for (int j = 0; j < 4; ++j) v[b][j] = *(const GAS f32x4*)(src[b] + 16 * lane + 4 * j); }
#pragma unroll
    for (int b = 0; b < NB; ++b) { m[b] = 0.f;
#pragma unroll
        for (int j = 0; j < 4; ++j) m[b] = fmaxf(m[b], fmaxf(fmaxf(fabsf(v[b][j].x), fabsf(v[b][j].y)), fmaxf(fabsf(v[b][j].z), fabsf(v[b][j].w)))); }
#pragma unroll
    for (int o = 1; o < 64; o <<= 1) {
#pragma unroll
        for (int b = 0; b < NB; ++b) m[b] = fmaxf(m[b], __shfl_xor(m[b], o)); }
#pragma unroll
    for (int b = 0; b < NB; ++b) { const float inv = m[b] > 0.f ? 224.f / m[b] : 0.f, sc = m[b] > 0.f ? m[b] * (1.f / 224.f) : 1.f;
        u32x4 o;
#pragma unroll
        for (int j = 0; j < 4; ++j) { int w = 0; w = __builtin_amdgcn_cvt_pk_fp8_f32(v[b][j].x * inv, v[b][j].y * inv, w, false); w = __builtin_amdgcn_cvt_pk_fp8_f32(v[b][j].z * inv, v[b][j].w * inv, w, true); o[j] = (unsigned)w; }
        *(GAS u32x4*)dst16[b] = o;
        if (lane == 0) *(GAS float*)scale_out[b] = sc; }
}
__device__ __forceinline__ void convert_tables(const Frame& F, const Args& A, int wi, int nw) {
    unsigned char* ws = A.ws; const int gw = wi, NGW = nw;
    int mc = gw;
    for (; mc + 3 * NGW < 2 * NEXP; mc += 4 * NGW) { const int m = mc;
        const float* src[4]; unsigned char* dst[4]; float* sco[4];
#pragma unroll
        for (int b = 0; b < 4; ++b) { const int mm = m + b * NGW;
            if (mm < NEXP) { const int e = mm; src[b] = A.in[I_PU] + (size_t)e * D; dst[b] = ws + WS_U8 + (size_t)((e & 7) * 2048 + (e >> 3)) * 1024 + 16 * F.lane; sco[b] = (float*)(ws + WS_SU) + e; }
            else { const int e = mm - NEXP; src[b] = A.in[I_PV] + (size_t)e * D; dst[b] = ws + WS_V8 + ((size_t)(F.lane >> 3) * NEXP + e) * 128 + 16 * (F.lane & 7); sco[b] = (float*)(ws + WS_SV) + e; } }
        cvt_rows_fp8<4>(F.lane, src, dst, sco);
    }
    for (; mc < 2 * NEXP; mc += NGW) { const float* src[1]; unsigned char* dst[1]; float* sco[1];
        if (mc < NEXP) { const int e = mc; src[0] = A.in[I_PU] + (size_t)e * D; dst[0] = ws + WS_U8 + (size_t)((e & 7) * 2048 + (e >> 3)) * 1024 + 16 * F.lane; sco[0] = (float*)(ws + WS_SU) + e; }
        else { const int e = mc - NEXP; src[0] = A.in[I_PV] + (size_t)e * D; dst[0] = ws + WS_V8 + ((size_t)(F.lane >> 3) * NEXP + e) * 128 + 16 * (F.lane & 7); sco[0] = (float*)(ws + WS_SV) + e; }
        cvt_rows_fp8<1>(F.lane, src, dst, sco); }
}
__device__ __forceinline__ void phase0(const Frame& F, const Args& A) {
    unsigned char* ws = A.ws;
    {
        LAS float* kx = (LAS float*)F.lds;
        LAS float* wt = (LAS float*)(F.lds + 128 * 129 * 4);
        bf16_t* WQF = (bf16_t*)(ws + WS_WQF);
        for (int it = F.bid; it < 512; it += F.G) {
            const int hh = it >> 5, kblk = it & 31, k0 = kblk * 32;
            const float* kX = (hh & 1) ? A.in[I_K2] : A.in[I_K1];
            __syncthreads();
            for (int e = F.tid; e < 128 * 128; e += 512) kx[(e >> 7) * 129 + (e & 127)] = kX[e];
            for (int e = F.tid; e < 32 * 128; e += 512) wt[e] = A.in[I_WQ][(size_t)(k0 + (e >> 7)) * 2048 + hh * 128 + (e & 127)];
            __syncthreads();
            const int key = F.tid & 127, kq = F.tid >> 7;
            float acc[8];
#pragma unroll
            for (int i = 0; i < 8; ++i) acc[i] = 0.f;
            for (int d = 0; d < 128; ++d) { const float b = kx[key * 129 + d];
#pragma unroll
                for (int i = 0; i < 8; ++i) acc[i] += wt[(kq * 8 + i) * 128 + d] * b; }
            u32x4 o; o.x = pk2(acc[0], acc[1]); o.y = pk2(acc[2], acc[3]); o.z = pk2(acc[4], acc[5]); o.w = pk2(acc[6], acc[7]);
            *(u32x4*)(WQF + (size_t)(hh * 128 + key) * 1024 + k0 + kq * 8) = o;
        }
        __syncthreads();
    }
    LAS float* scr = (LAS float*)(F.lds + F.wave * 16384);
    const int gw = F.bid * NWAVES + F.wave, NGW = F.G * NWAVES;
    constexpr int I_IN = 16 * (NPROJ / 32), I_A = 8 * 32, I_B = 8 * 32, I_O = 16 * 32;
    constexpr int NITEMS = I_IN + I_A + I_B + I_O;
    for (int it = gw; it < NITEMS; it += NGW) {
        int r = it;
        if (r < I_IN) { p0_transpose_item<1>(A.in[I_WIN], 1024, 5136, NPROJ, (bf16_t*)(ws + WS_WIN), scr, r, F.lane); continue; } r -= I_IN;
        if (r < I_A) { p0_transpose_item<0>(A.in[I_WBA], 512, 1024, 1024, (bf16_t*)(ws + WS_WA), scr, r, F.lane); continue; } r -= I_A;
        if (r < I_B) { p0_transpose_item<0>(A.in[I_WBB], 512, 1024, 1024, (bf16_t*)(ws + WS_WB), scr, r, F.lane); continue; } r -= I_B;
        p0_transpose_item<0>(A.in[I_WOUT], 1024, 1024, 1024, (bf16_t*)(ws + WS_WOUT), scr, r, F.lane);
    }
    { int m = gw; for (; m + 3 * NGW < T_TOK; m += 4 * NGW) rms_rows_to_bf16<false, 4>(F.lane, A.in[I_X] + (size_t)m * D, (size_t)NGW * D, A.in[I_N1G], (bf16_t*)(ws + WS_N1) + (size_t)m * D, (size_t)NGW * D);
      for (; m < T_TOK; m += NGW) rms_rows_to_bf16<false, 1>(F.lane, A.in[I_X] + (size_t)m * D, 0, A.in[I_N1G], (bf16_t*)(ws + WS_N1) + (size_t)m * D, 0); }
}

__device__ __forceinline__ float log_sigmoid(float z) { return fminf(z, 0.f) - log1pf(__expf(-fabsf(z))); }

template <bool DRY>
__device__ __forceinline__ void gla_chunk_phase(const Frame& F, const Args& A) {
    unsigned char* ws = A.ws;
    const bf16_t* P = (const bf16_t*)(ws + WS_P);
    const float* ALR = (const float*)(ws + WS_ALR);
    LAS float* alr = (LAS float*)F.lds;
    LAS float* tot = (LAS float*)(F.lds + 4096);
    LAS bf16_t* kdT = (LAS bf16_t*)(F.lds + 8192);
    LAS bf16_t* vT = (LAS bf16_t*)(F.lds + 26624);
    LAS bf16_t* stT = (LAS bf16_t*)(F.lds + 45056);
    const int tid = F.tid, kk = tid & 127, seg = tid >> 7;
    const bool hconst = (F.G & 3) == 0;
    int hcur = -1; float w[16]; float bias = 0.f;
#pragma unroll
    for (int j = 0; j < 16; ++j) w[j] = 0.f;
    float na0, na1; bf16_t nk[16], nv[16];
#define GC_LOAD(unit) do { const int h_ = (unit) & 3, c_ = ((unit) >> 2) & 63, b_ = (unit) >> 8; const int t0_ = b_ * SEQ + c_ * 64; \
        na0 = ALR[(size_t)t0_ * 16 + tid]; na1 = ALR[(size_t)t0_ * 16 + 512 + tid]; \
        const bf16_t* kp_ = P + (size_t)(t0_ + 16 * seg) * PLD + PC_K + h_ * 128 + kk; const bf16_t* vp_ = P + (size_t)(t0_ + 16 * seg) * PLD + PC_V + h_ * 128 + kk; \
        _Pragma("unroll") for (int i_ = 0; i_ < 16; ++i_) { nk[i_] = kp_[(size_t)i_ * PLD]; nv[i_] = vp_[(size_t)i_ * PLD]; } } while (0)
    int unit = F.bid;
    if (unit < 2048) GC_LOAD(unit);
    for (; unit < 2048; unit += F.G) {
        const int h = unit & 3;
        if (h != hcur) { hcur = h;
#pragma unroll
            for (int j = 0; j < 16; ++j) w[j] = A.in[I_WGU][(size_t)j * 512 + h * 128 + kk];
            bias = A.in[I_BG][h * 128 + kk]; }
        __syncthreads();
        alr[tid] = na0; alr[512 + tid] = na1;
        bf16_t kr[16], vr[16];
#pragma unroll
        for (int i = 0; i < 16; ++i) { kr[i] = nk[i]; vr[i] = nv[i]; }
        if (unit + F.G < 2048) GC_LOAD(unit + F.G);
        __syncthreads();
        float cum[16]; float run = 0.f;
#pragma unroll
        for (int i = 0; i < 16; ++i) { const LAS f32x4* ap = (const LAS f32x4*)(alr + (16 * seg + i) * 16); float z = bias;
#pragma unroll
            for (int q = 0; q < 4; ++q) { const f32x4 a4 = ap[q]; z += a4.x * w[4 * q] + a4.y * w[4 * q + 1] + a4.z * w[4 * q + 2] + a4.w * w[4 * q + 3]; }
            const float ls = fminf(z, 0.f) - __logf(1.f + __expf(-fabsf(z)));
            run += ls * (1.f / 16.f); cum[i] = run; }
        tot[seg * 128 + kk] = run;
        __syncthreads();
        {
            const float t0s = tot[kk], t1s = tot[128 + kk], t2s = tot[256 + kk], t3s = tot[384 + kk];
            const float total = (t0s + t1s) + (t2s + t3s);
            const float prefix = seg == 0 ? 0.f : (seg == 1 ? t0s : (seg == 2 ? t0s + t1s : t0s + t1s + t2s));
            unsigned kw[8], vw[8];
#pragma unroll
            for (int i = 0; i < 8; ++i) {
                const float e0 = __expf(total - (prefix + cum[2 * i])), e1 = __expf(total - (prefix + cum[2 * i + 1]));
                kw[i] = pk2(bf1(kr[2 * i]) * e0, bf1(kr[2 * i + 1]) * e1); vw[i] = (unsigned)vr[2 * i] | ((unsigned)vr[2 * i + 1] << 16);
            }
            *(LAS u32x4*)(kdT + kk * 72 + 16 * seg) = (u32x4){kw[0], kw[1], kw[2], kw[3]}; *(LAS u32x4*)(kdT + kk * 72 + 16 * seg + 8) = (u32x4){kw[4], kw[5], kw[6], kw[7]};
            *(LAS u32x4*)(vT + kk * 72 + 16 * seg) = (u32x4){vw[0], vw[1], vw[2], vw[3]}; *(LAS u32x4*)(vT + kk * 72 + 16 * seg + 8) = (u32x4){vw[4], vw[5], vw[6], vw[7]};
            if (seg == 0) ((float*)(DRY ? (unsigned char*)A.out + 96 * MiB : ws + WS_DEC))[(size_t)unit * 128 + kk] = __expf(total);
        }
        __syncthreads();
        {
            const int w8 = F.wave, l = F.lane, fr = l & 15, fq = l >> 4;
            f32x4 acc[8];
#pragma unroll
            for (int n = 0; n < 8; ++n) acc[n] = (f32x4){0.f, 0.f, 0.f, 0.f};
#pragma unroll
            for (int ks = 0; ks < 2; ++ks) {
                const bf16x8 a = *(const LAS bf16x8*)(kdT + (16 * w8 + fr) * 72 + 32 * ks + 8 * fq);
#pragma unroll
                for (int n = 0; n < 8; ++n) { const bf16x8 bb = *(const LAS bf16x8*)(vT + (16 * n + fr) * 72 + 32 * ks + 8 * fq);
                    acc[n] = __builtin_amdgcn_mfma_f32_16x16x32_bf16(a, bb, acc[n], 0, 0, 0); }
            }
#pragma unroll
            for (int n = 0; n < 8; ++n) { u32x2 o; o.x = pk2(acc[n][0], acc[n][1]); o.y = pk2(acc[n][2], acc[n][3]);
                *(LAS u32x2*)(stT + (16 * n + fr) * 136 + 16 * w8 + 4 * fq) = o; }
        }
        __syncthreads();
        {
            bf16_t* ST = (bf16_t*)(DRY ? (unsigned char*)A.out : ws + WS_N1) + (size_t)unit * 16384;
            const int vv = tid >> 2, part = tid & 3;
#pragma unroll
            for (int q = 0; q < 4; ++q) *(u32x4*)(ST + (size_t)vv * 128 + 32 * part + 8 * q) = *(const LAS u32x4*)(stT + vv * 136 + 32 * part + 8 * q);
        }
    }
#undef GC_LOAD
    (void)hconst;
}

template <bool DRY>
__device__ __forceinline__ void sgu_unit(const Frame& F, const Args& A, int unit) {
    const int g = unit & 3, blk = (unit >> 2) & 31, b = unit >> 7;
    const int t0 = b * SEQ + blk * 128;
    bf16_t* P = (bf16_t*)(A.ws + WS_P);
    LAS bf16_t* wA = (LAS bf16_t*)F.lds;
    LAS bf16_t* vnT = (LAS bf16_t*)(F.lds + 34816);
    LAS float* st = (LAS float*)(F.lds + 69632);
    LAS bf16_t* suS = (LAS bf16_t*)(F.lds + 70656);
    const int tid = F.tid;
    __syncthreads();
    {
        const int j = tid >> 2, q = tid & 3;
        const bf16_t* sp = P + (size_t)(t0 + j) * PLD + PC_SV + q * 128;
        float s = 0.f, s2 = 0.f;
#pragma unroll
        for (int i = 0; i < 16; ++i) { const u32x4 w = *(const u32x4*)(sp + 8 * i);
            const float f[8] = {bflo(w.x), bfhi(w.x), bflo(w.y), bfhi(w.y), bflo(w.z), bfhi(w.z), bflo(w.w), bfhi(w.w)};
#pragma unroll
            for (int e = 0; e < 8; ++e) { s += f[e]; s2 += f[e] * f[e]; } }
        s += __shfl_xor(s, 1); s += __shfl_xor(s, 2); s2 += __shfl_xor(s2, 1); s2 += __shfl_xor(s2, 2);
        const float mu = s * (1.f / 512.f); const float var = fmaxf(s2 * (1.f / 512.f) - mu * mu, 0.f);
        if (q == 0) { st[2 * j] = mu; st[2 * j + 1] = 1.f / sqrtf(var + EPS); }
    }
    {
        const int i = tid >> 2, jb = (tid & 3) * 32;
        const float* wp = A.in[I_SW] + (size_t)g * 16384 + (size_t)i * 128 + jb;
        const bf16_t* sup = P + (size_t)(t0 + i) * PLD + PC_SU + g * 128 + jb;
#pragma unroll
        for (int q = 0; q < 4; ++q) { const f32x4 a = *(const f32x4*)(wp + 8 * q), bq = *(const f32x4*)(wp + 8 * q + 4);
            const bool z = (i < 64) && (jb + 8 * q >= 64);
            u32x4 o; o.x = pk2(a.x, a.y); o.y = pk2(a.z, a.w); o.z = pk2(bq.x, bq.y); o.w = pk2(bq.z, bq.w);
            if (z) o = (u32x4){0u, 0u, 0u, 0u};
            *(LAS u32x4*)(wA + i * 136 + jb + 8 * q) = o;
            *(LAS u32x4*)(suS + i * 136 + jb + 8 * q) = *(const u32x4*)(sup + 8 * q); }
    }
    const int cch = tid & 127, seg = tid >> 7;
    bf16_t xr[32];
    { const bf16_t* sp = P + (size_t)(t0 + 32 * seg) * PLD + PC_SV + g * 128 + cch;
#pragma unroll
      for (int i = 0; i < 32; ++i) xr[i] = sp[(size_t)i * PLD]; }
    const float lg = A.in[I_SLNG][g * 128 + cch], lb = A.in[I_SLNB][g * 128 + cch];
    __syncthreads();
    {
        unsigned ow[16];
#pragma unroll
        for (int i = 0; i < 16; ++i) { const int j = 32 * seg + 2 * i; const f32x4 ms = *(const LAS f32x4*)(st + 2 * j);
            ow[i] = pk2((bf1(xr[2 * i]) - ms.x) * ms.y * lg + lb, (bf1(xr[2 * i + 1]) - ms.z) * ms.w * lg + lb); }
#pragma unroll
        for (int q = 0; q < 4; ++q) *(LAS u32x4*)(vnT + cch * 136 + 32 * seg + 8 * q) = (u32x4){ow[4 * q], ow[4 * q + 1], ow[4 * q + 2], ow[4 * q + 3]};
    }
    __syncthreads();
    {
        const int w = F.wave, l = F.lane, fr = l & 15, fq = l >> 4;
        f32x4 acc[8];
#pragma unroll
        for (int n = 0; n < 8; ++n) acc[n] = (f32x4){0.f, 0.f, 0.f, 0.f};
#pragma unroll
        for (int ks = 0; ks < 4; ++ks) {
            const bf16x8 a = *(const LAS bf16x8*)(wA + (16 * w + fr) * 136 + 32 * ks + 8 * fq);
#pragma unroll
            for (int n = 0; n < 8; ++n) { const bf16x8 bb = *(const LAS bf16x8*)(vnT + (16 * n + fr) * 136 + 32 * ks + 8 * fq);
                acc[n] = __builtin_amdgcn_mfma_f32_16x16x32_bf16(a, bb, acc[n], 0, 0, 0); }
        }
#pragma unroll
        for (int jj = 0; jj < 4; ++jj) { const int i = 16 * w + 4 * fq + jj; const float bias = A.in[I_SB][g * 128 + i];
            LAS bf16_t* rp = suS + i * 136 + fr;
#pragma unroll
            for (int n = 0; n < 8; ++n) { const float su = bf1(rp[16 * n]); rp[16 * n] = (bf16_t)f2bf(su * (acc[n][jj] + bias)); } }
    }
    __syncthreads();
    {
        const int i = tid >> 2, jb = (tid & 3) * 32;
        bf16_t* yp = DRY ? (bf16_t*)A.out + (size_t)(t0 + i) * 512 + g * 128 + jb : P + (size_t)(t0 + i) * PLD + PC_SU + g * 128 + jb;
#pragma unroll
        for (int q = 0; q < 4; ++q) *(u32x4*)(yp + 8 * q) = *(const LAS u32x4*)(suS + i * 136 + jb + 8 * q);
    }
}

template <bool DRY>
__device__ __forceinline__ void gla_scan(const Frame& F, const Args& A) {
    bf16_t* ST = (bf16_t*)(A.ws + WS_N1); bf16_t* STO = DRY ? (bf16_t*)A.out : ST; const float* DEC = (const float*)(A.ws + WS_DEC);
    for (int gi = F.bid * 512 + F.tid; gi < 131072; gi += F.G * 512) {
        const int k4 = gi & 31, vv = (gi >> 5) & 127, h = (gi >> 12) & 3, b = gi >> 14;
        float s0 = 0.f, s1 = 0.f, s2 = 0.f, s3 = 0.f;
        u32x2 wa[8], wb[8]; f32x4 da[8], db[8];
#define SCAN_LOAD(W, Dd, c0) do { _Pragma("unroll") for (int i_ = 0; i_ < 8; ++i_) { const size_t u_ = (size_t)((b * 64 + (c0) + i_) * 4 + h); \
            W[i_] = *(const u32x2*)(ST + u_ * 16384 + (size_t)vv * 128 + k4 * 4); Dd[i_] = *(const f32x4*)(DEC + u_ * 128 + k4 * 4); } } while (0)
#define SCAN_STEP(W, Dd, c0) do { _Pragma("unroll") for (int i_ = 0; i_ < 8; ++i_) { const size_t u_ = (size_t)((b * 64 + (c0) + i_) * 4 + h); \
            s0 = Dd[i_].x * s0 + bflo(W[i_].x); s1 = Dd[i_].y * s1 + bfhi(W[i_].x); s2 = Dd[i_].z * s2 + bflo(W[i_].y); s3 = Dd[i_].w * s3 + bfhi(W[i_].y); \
            u32x2 o_; o_.x = pk2(s0, s1); o_.y = pk2(s2, s3); *(u32x2*)(STO + u_ * 16384 + (size_t)vv * 128 + k4 * 4) = o_; } } while (0)
        SCAN_LOAD(wa, da, 0);
#pragma unroll
        for (int c0 = 0; c0 < 64; c0 += 16) {
            SCAN_LOAD(wb, db, c0 + 8);
            SCAN_STEP(wa, da, c0);
            if (c0 + 16 < 64) SCAN_LOAD(wa, da, c0 + 16);
            SCAN_STEP(wb, db, c0 + 8);
        }
#undef SCAN_LOAD
#undef SCAN_STEP
    }
}

template <bool DRY>
__device__ __forceinline__ void gla_out_phase(const Frame& F, const Args& A) {
    bf16_t* P = (bf16_t*)(A.ws + WS_P);
    LAS bf16_t* qA = (LAS bf16_t*)F.lds;
    LAS bf16_t* sB = (LAS bf16_t*)(F.lds + 17408);
    LAS float* oF = (LAS float*)(F.lds + 52224);
    const int tid = F.tid, s = tid >> 3, cb = (tid & 7) * 16, vv = tid >> 2, kb = (tid & 3) * 32;
    u32x4 nq0, nq1, ns0, ns1, ns2, ns3, nr0, nr1;
#define GO_LOAD(unit) do { const int h_ = (unit) & 3, c_ = ((unit) >> 2) & 63, b_ = (unit) >> 8; const int t0_ = b_ * SEQ + c_ * 64; \
        const bf16_t* qp_ = P + (size_t)(t0_ + s) * PLD + PC_Q + h_ * 128 + cb; nq0 = *(const u32x4*)qp_; nq1 = *(const u32x4*)(qp_ + 8); \
        const bf16_t* sp_ = (const bf16_t*)(A.ws + WS_N1) + (size_t)(unit) * 16384 + (size_t)vv * 128 + kb; ns0 = *(const u32x4*)sp_; ns1 = *(const u32x4*)(sp_ + 8); ns2 = *(const u32x4*)(sp_ + 16); ns3 = *(const u32x4*)(sp_ + 24); \
        const bf16_t* rp_ = P + (size_t)(t0_ + s) * PLD + PC_R + h_ * 128 + cb; nr0 = *(const u32x4*)rp_; nr1 = *(const u32x4*)(rp_ + 8); } while (0)
    int unit = F.bid;
    if (unit < 2048) GO_LOAD(unit);
    for (; unit < 2048; unit += F.G) {
        const int h = unit & 3, c = (unit >> 2) & 63, b = unit >> 8;
        const int t0 = b * SEQ + c * 64;
        __syncthreads();
        *(LAS u32x4*)(qA + s * 136 + cb) = nq0; *(LAS u32x4*)(qA + s * 136 + cb + 8) = nq1;
        *(LAS u32x4*)(sB + vv * 136 + kb) = ns0; *(LAS u32x4*)(sB + vv * 136 + kb + 8) = ns1; *(LAS u32x4*)(sB + vv * 136 + kb + 16) = ns2; *(LAS u32x4*)(sB + vv * 136 + kb + 24) = ns3;
        const u32x4 r0 = nr0, r1 = nr1;
        if (unit + F.G < 2048) GO_LOAD(unit + F.G);
        __syncthreads();
        {
            const int w = F.wave, l = F.lane, fr = l & 15, fq = l >> 4, m = w & 3, nh = w >> 2;
            f32x4 acc[4];
#pragma unroll
            for (int n = 0; n < 4; ++n) acc[n] = (f32x4){0.f, 0.f, 0.f, 0.f};
#pragma unroll
            for (int ks = 0; ks < 4; ++ks) {
                const bf16x8 a = *(const LAS bf16x8*)(qA + (16 * m + fr) * 136 + 32 * ks + 8 * fq);
#pragma unroll
                for (int n = 0; n < 4; ++n) { const bf16x8 bb = *(const LAS bf16x8*)(sB + (16 * (4 * nh + n) + fr) * 136 + 32 * ks + 8 * fq);
                    acc[n] = __builtin_amdgcn_mfma_f32_16x16x32_bf16(a, bb, acc[n], 0, 0, 0); }
            }
            const float scale = 0.08838834764831845f;
#pragma unroll
            for (int n = 0; n < 4; ++n)
#pragma unroll
                for (int jj = 0; jj < 4; ++jj) oF[(16 * m + 4 * fq + jj) * 132 + 16 * (4 * nh + n) + fr] = acc[n][jj] * scale;
        }
        __syncthreads();
        {
            float o[16]; float ss = 0.f;
#pragma unroll
            for (int i = 0; i < 16; ++i) { o[i] = oF[s * 132 + cb + i]; ss += o[i] * o[i]; }
            ss += __shfl_xor(ss, 1); ss += __shfl_xor(ss, 2); ss += __shfl_xor(ss, 4);
            const float rstd = 1.f / sqrtf(ss * (1.f / 128.f) + EPS);
            const unsigned rw[8] = {r0.x, r0.y, r0.z, r0.w, r1.x, r1.y, r1.z, r1.w};
            const float* gg = A.in[I_GLAG] + h * 128 + cb;
            unsigned ow[8];
#pragma unroll
            for (int i = 0; i < 8; ++i) { const float y0 = o[2 * i] * rstd * gg[2 * i] * siluf_(bflo(rw[i])), y1 = o[2 * i + 1] * rstd * gg[2 * i + 1] * siluf_(bfhi(rw[i])); ow[i] = pk2(y0, y1); }
            bf16_t* yp = DRY ? (bf16_t*)A.out + (size_t)(t0 + s) * 512 + h * 128 + cb : P + (size_t)(t0 + s) * PLD + PC_Q + h * 128 + cb;
            *(u32x4*)yp = (u32x4){ow[0], ow[1], ow[2], ow[3]}; *(u32x4*)(yp + 8) = (u32x4){ow[4], ow[5], ow[6], ow[7]};
        }
    }
#undef GO_LOAD
}

__device__ __forceinline__ unsigned ordkey(float v) { const unsigned u = __builtin_bit_cast(unsigned, v); return u ^ ((unsigned)((int)u >> 31) | 0x80000000u); }
__device__ __forceinline__ float unord(unsigned k) { const unsigned u = (k & 0x80000000u) ? (k & 0x7fffffffu) : ~k; return __builtin_bit_cast(float, u); }
#define INS16(r, xin) do { unsigned _x = (xin); _Pragma("unroll") for (int _i = 0; _i < 16; ++_i) { const unsigned _h = max((r)[_i], _x); _x = min((r)[_i], _x); (r)[_i] = _h; } } while (0)

#define CE(a, b) do { const unsigned _h = max((a), (b)), _l = min((a), (b)); (a) = _h; (b) = _l; } while (0)
#define SORT16(v) do { CE(v[0], v[1]); CE(v[2], v[3]); CE(v[0], v[2]); CE(v[1], v[3]); CE(v[1], v[2]); CE(v[4], v[5]); CE(v[6], v[7]); CE(v[4], v[6]); CE(v[5], v[7]); CE(v[5], v[6]); CE(v[0], v[4]); CE(v[2], v[6]); CE(v[2], v[4]); CE(v[1], v[5]); CE(v[3], v[7]); CE(v[3], v[5]); CE(v[1], v[2]); CE(v[3], v[4]); CE(v[5], v[6]); CE(v[8], v[9]); CE(v[10], v[11]); CE(v[8], v[10]); CE(v[9], v[11]); CE(v[9], v[10]); CE(v[12], v[13]); CE(v[14], v[15]); CE(v[12], v[14]); CE(v[13], v[15]); CE(v[13], v[14]); CE(v[8], v[12]); CE(v[10], v[14]); CE(v[10], v[12]); CE(v[9], v[13]); CE(v[11], v[15]); CE(v[11], v[13]); CE(v[9], v[10]); CE(v[11], v[12]); CE(v[13], v[14]); CE(v[0], v[8]); CE(v[4], v[12]); CE(v[4], v[8]); CE(v[2], v[10]); CE(v[6], v[14]); CE(v[6], v[10]); CE(v[2], v[4]); CE(v[6], v[8]); CE(v[10], v[12]); CE(v[1], v[9]); CE(v[5], v[13]); CE(v[5], v[9]); CE(v[3], v[11]); CE(v[7], v[15]); CE(v[7], v[11]); CE(v[3], v[5]); CE(v[7], v[9]); CE(v[11], v[13]); CE(v[1], v[2]); CE(v[3], v[4]); CE(v[5], v[6]); CE(v[7], v[8]); CE(v[9], v[10]); CE(v[11], v[12]); CE(v[13], v[14]); } while (0)
#define MERGE16(T, S) do { _Pragma("unroll") for (int _i = 0; _i < 16; ++_i) (T)[_i] = max((T)[_i], (S)[15 - _i]); \
    _Pragma("unroll") for (int _d = 8; _d >= 1; _d >>= 1) { _Pragma("unroll") for (int _i = 0; _i < 16; ++_i) if ((_i & _d) == 0) CE((T)[_i], (T)[_i + _d]); } } while (0)
__device__ __forceinline__ void peer_topk(const Frame& F, const Args& A) {
    const float* SC = (const float*)(A.ws + WS_P + P_SC);
    int* IDX = (int*)(A.ws + WS_P + P_IDX); float* GATE = (float*)(A.ws + WS_P + P_GATE);
    const int gw = F.bid * NWAVES + F.wave, NGW = F.G * NWAVES;
    for (int it = gw; it < 512 * 8; it += NGW) {
        const int h = it & 7, tb = it >> 3; const int tok = tb * 64 + F.lane;
        unsigned r1[16], r2[16], rc[16];
        const float* p1 = SC + (size_t)(h * 256) * T_TOK + tok; const float* p2 = p1 + (size_t)128 * T_TOK;
        {
            float raw[128]; unsigned sg[16];
#pragma unroll
            for (int j = 0; j < 128; ++j) raw[j] = p1[(size_t)j * T_TOK];
#pragma unroll
            for (int j = 0; j < 16; ++j) r1[j] = (ordkey(raw[j]) & ~127u) | (unsigned)(127 - j);
            SORT16(r1);
#pragma unroll
            for (int gq = 1; gq < 8; ++gq) {
#pragma unroll
                for (int j = 0; j < 16; ++j) sg[j] = (ordkey(raw[16 * gq + j]) & ~127u) | (unsigned)(127 - (16 * gq + j));
                SORT16(sg); MERGE16(r1, sg); }
#pragma unroll
            for (int j = 0; j < 128; ++j) raw[j] = p2[(size_t)j * T_TOK];
#pragma unroll
            for (int j = 0; j < 16; ++j) r2[j] = (ordkey(raw[j]) & ~127u) | (unsigned)(127 - j);
            SORT16(r2);
#pragma unroll
            for (int gq = 1; gq < 8; ++gq) {
#pragma unroll
                for (int j = 0; j < 16; ++j) sg[j] = (ordkey(raw[16 * gq + j]) & ~127u) | (unsigned)(127 - (16 * gq + j));
                SORT16(sg); MERGE16(r2, sg); }
        }
        float v1[16], v2[16];
#pragma unroll
        for (int i = 0; i < 16; ++i) { v1[i] = unord((r1[i] & ~127u) | 64u); v2[i] = unord((r2[i] & ~127u) | 64u); }
        {
            unsigned cg[4][16]; int cn = 0;
#pragma unroll
            for (int a = 0; a < 16; ++a)
#pragma unroll
                for (int bq = 0; bq < 16; ++bq) if ((a + 1) * (bq + 1) <= 16) { cg[cn >> 4][cn & 15] = (ordkey(v1[a] + v2[bq]) & ~255u) | (unsigned)(a * 16 + bq); ++cn; }
#pragma unroll
            for (int z = 50; z < 64; ++z) cg[z >> 4][z & 15] = 0u;
            SORT16(cg[0]); SORT16(cg[1]); SORT16(cg[2]); SORT16(cg[3]);
            MERGE16(cg[0], cg[1]); MERGE16(cg[0], cg[2]); MERGE16(cg[0], cg[3]);
#pragma unroll
            for (int i = 0; i < 16; ++i) rc[i] = cg[0][i];
        }
        float val[16]; int ex[16];
        {
            LAS unsigned* t1 = (LAS unsigned*)(F.lds + F.wave * 8704) + F.lane * 17; LAS unsigned* t2 = t1 + 64 * 17;
#pragma unroll
            for (int i = 0; i < 16; ++i) { t1[i] = r1[i]; t2[i] = r2[i]; }
            LDS_WAIT(); asm volatile("" ::: "memory");
#pragma unroll
            for (int w = 0; w < 16; ++w) {
                const int a = (rc[w] >> 4) & 15, bq = rc[w] & 15;
                const unsigned k1 = t1[a], k2 = t2[bq];
                val[w] = unord((k1 & ~127u) | 64u) + unord((k2 & ~127u) | 64u);
                ex[w] = (127 - (int)(k1 & 127u)) * 128 + (127 - (int)(k2 & 127u));
            }
            LDS_WAIT(); asm volatile("" ::: "memory");
        }
        float mx = val[0];
#pragma unroll
        for (int w = 1; w < 16; ++w) mx = fmaxf(mx, val[w]);
        float sum = 0.f;
#pragma unroll
        for (int w = 0; w < 16; ++w) { val[w] = __expf(val[w] - mx); sum += val[w]; }
        const float inv = 1.f / sum;
        int* ip = IDX + (size_t)tok * 128 + h * 16; float* gp = GATE + (size_t)tok * 128 + h * 16;
#pragma unroll
        for (int q = 0; q < 4; ++q) { *(int4*)(ip + 4 * q) = make_int4(ex[4 * q], ex[4 * q + 1], ex[4 * q + 2], ex[4 * q + 3]);
            *(f32x4*)(gp + 4 * q) = (f32x4){val[4 * q] * inv, val[4 * q + 1] * inv, val[4 * q + 2] * inv, val[4 * q + 3] * inv}; }
    }
}

#define DPP_ADD(v, ctrl) ((v) + __builtin_bit_cast(float, __builtin_amdgcn_mov_dpp(__builtin_bit_cast(int, (v)), (ctrl), 0xf, 0xf, true)))
__device__ __forceinline__ void fp8x16_to_f32x2(const u32x4 r, f32x2* f) {
#pragma unroll
    for (int q = 0; q < 4; ++q) { f[2 * q] = __builtin_amdgcn_cvt_pk_f32_fp8((int)r[q], false); f[2 * q + 1] = __builtin_amdgcn_cvt_pk_f32_fp8((int)r[q], true); }
}
__device__ __forceinline__ void fp8x16_to_f32(const u32x4 r, float* f) {
#pragma unroll
    for (int q = 0; q < 4; ++q) { const f32x2 lo = __builtin_amdgcn_cvt_pk_f32_fp8((int)r[q], false), hi = __builtin_amdgcn_cvt_pk_f32_fp8((int)r[q], true);
        f[4 * q] = lo.x; f[4 * q + 1] = lo.y; f[4 * q + 2] = hi.x; f[4 * q + 3] = hi.y; }
}
__device__ __forceinline__ long lo64(u32x4 v) { return (long)(((unsigned long)v.y << 32) | (unsigned long)v.x); }
__device__ __forceinline__ long hi64(u32x4 v) { return (long)(((unsigned long)v.w << 32) | (unsigned long)v.z); }
template <int MODE>
__device__ __forceinline__ void peer_u_phase(const Frame& F, const Args& A) {
    const unsigned char* X8 = A.ws + WS_P + P_X8;
    const unsigned char* U8 = A.ws + WS_U8; const float* SU = (const float*)(A.ws + WS_SU); const float* SV = (const float*)(A.ws + WS_SV);
    const int* IDX = (const int*)(A.ws + WS_P + P_IDX); const float* GATE = (const float*)(A.ws + WS_P + P_GATE); float* AK = (float*)(MODE == 0 ? A.ws + WS_AK : A.ws + WS_P + P_SC);
    const int g = F.bid & 7, nmem = F.G >> 3, l = F.lane, step = nmem * NWAVES;
    const int loff = 64 * (l & 15) + 16 * (l >> 4);
    const bool dg = ((l & 15) >> 2) == (l >> 4); const int dr = l & 3;
    const float dw0 = (dg && dr == 0) ? 1.f : 0.f, dw1 = (dg && dr == 1) ? 1.f : 0.f, dw2 = (dg && dr == 2) ? 1.f : 0.f, dw3 = (dg && dr == 3) ? 1.f : 0.f;
    LAS int* le = (LAS int*)(F.lds + F.wave * 2048); LAS int* lk = le + 256;
    const bool b5 = (l & 32) != 0, b4 = (l & 16) != 0, b3 = (l & 8) != 0;
    int tok = (F.bid >> 3) * NWAVES + F.wave;
    u32x4 nxA, nxB; int neA0, neA1, neB0, neB1; float ngA0, ngA1, ngB0, ngB1;
#define U_PREFETCH(t) do { const size_t _tA = (size_t)(t), _tB = (size_t)(t) + step; if (MODE == 4) { nxA = (u32x4){(unsigned)_tA, 1u, 2u, 3u}; nxB = nxA; neA0 = (int)((_tA * 37 + l * 11) & 16383); neA1 = (int)((_tA * 53 + l * 7) & 16383); neB0 = (int)((_tB * 37 + l * 13) & 16383); neB1 = (int)((_tB * 29 + l * 3) & 16383); ngA0 = ngA1 = ngB0 = ngB1 = 0.01f; break; } nxA = *(const u32x4*)(X8 + _tA * 1024 + loff); nxB = *(const u32x4*)(X8 + _tB * 1024 + loff); \
        neA0 = IDX[_tA * 128 + l]; neA1 = IDX[_tA * 128 + 64 + l]; neB0 = IDX[_tB * 128 + l]; neB1 = IDX[_tB * 128 + 64 + l]; \
        ngA0 = GATE[_tA * 128 + l]; ngA1 = GATE[_tA * 128 + 64 + l]; ngB0 = GATE[_tB * 128 + l]; ngB1 = GATE[_tB * 128 + 64 + l]; } while (0)
    if (tok + step < T_TOK) U_PREFETCH(tok);
    for (; tok + step < T_TOK; tok += 2 * step) {
        const int tokA = tok, tokB = tok + step;
        const u32x4 xA = nxA, xB = nxB;
        const int eA0 = neA0, eA1 = neA1, eB0 = neB0, eB1 = neB1; const float gA0 = ngA0, gA1 = ngA1, gB0 = ngB0, gB1 = ngB1;
        bool pf_done = false;
        const bool oA0 = (eA0 & 7) == g, oA1 = (eA1 & 7) == g, oB0 = (eB0 & 7) == g, oB1 = (eB1 & 7) == g;
        const unsigned long long mA0 = __ballot(oA0), mA1 = __ballot(oA1), mB0 = __ballot(oB0), mB1 = __ballot(oB1);
        const int c0 = __popcll(mA0), c1 = c0 + __popcll(mA1), c2 = c1 + __popcll(mB0), n = c2 + __popcll(mB1);
#define MBC(m) __builtin_amdgcn_mbcnt_hi((unsigned)((m) >> 32), __builtin_amdgcn_mbcnt_lo((unsigned)(m), 0u))
        if (oA0) { const int p = MBC(mA0); le[p] = (eA0 << 8) | l; lk[p] = __builtin_bit_cast(int, gA0); }
        if (oA1) { const int p = c0 + MBC(mA1); le[p] = (eA1 << 8) | (64 + l); lk[p] = __builtin_bit_cast(int, gA1); }
        if (oB0) { const int p = c1 + MBC(mB0); le[p] = (eB0 << 8) | 128 | l; lk[p] = __builtin_bit_cast(int, gB0); }
        if (oB1) { const int p = c2 + MBC(mB1); le[p] = (eB1 << 8) | 128 | (64 + l); lk[p] = __builtin_bit_cast(int, gB1); }
#undef MBC
        LDS_WAIT(); asm volatile("" ::: "memory");
        for (int cb = 0; cb < n || cb == 0; cb += 64) {
        const int nc = min(n, cb + 64);
        const bool fv = (cb + l) < nc;
        const int ent = fv ? le[cb + l] : 0; const float gt = fv ? __builtin_bit_cast(float, lk[cb + l]) : 0.f; float tot = 0.f;
        const float su = SU[ent >> 8], sv = SV[ent >> 8];
        const unsigned long long radr = (unsigned long long)(U8 + (size_t)(((ent >> 8) & 7) * 2048 + (((ent >> 8) >> 3) & (MODE == 2 ? 255 : 2047))) * 1024);
        const int ralo = (int)(unsigned)radr, rahi = (int)(unsigned)(radr >> 32);
        for (int i = cb; i < nc; i += 16) {
            u32x4 row[2][8];
#pragma unroll
            for (int b = 0; b < 2; ++b) if (i + 8 * b < nc) {
#pragma unroll
                for (int j = 0; j < 8; ++j) { const int ln = min(i + 8 * b + j, nc - 1) - cb;
                    const unsigned lo = (unsigned)__builtin_amdgcn_readlane(ralo, ln), hi = (unsigned)__builtin_amdgcn_readlane(rahi, ln);
                    const GAS unsigned char* rp = (const GAS unsigned char*)(((unsigned long long)hi << 32) | lo);
                    row[b][j] = *(const GAS u32x4*)(rp + (unsigned)loff); } }
            if (!pf_done) { pf_done = true; if (tok + 3 * step < T_TOK) U_PREFETCH(tok + 2 * step); }
#pragma unroll
            for (int b = 0; b < 2; ++b) if (i + 8 * b < nc) {
                float p[8];
                f32x4 accj[8];
                const int base0 = i + 8 * b;
                if (base0 + 8 <= c1) {
#pragma unroll
                    for (int j = 0; j < 8; ++j) accj[j] = __builtin_amdgcn_mfma_f32_16x16x32_fp8_fp8(lo64(row[b][j]), lo64(xA), (f32x4){0.f, 0.f, 0.f, 0.f}, 0, 0, 0);
#pragma unroll
                    for (int j = 0; j < 8; ++j) accj[j] = __builtin_amdgcn_mfma_f32_16x16x32_fp8_fp8(hi64(row[b][j]), hi64(xA), accj[j], 0, 0, 0);
                } else if (base0 >= c1) {
#pragma unroll
                    for (int j = 0; j < 8; ++j) accj[j] = __builtin_amdgcn_mfma_f32_16x16x32_fp8_fp8(lo64(row[b][j]), lo64(xB), (f32x4){0.f, 0.f, 0.f, 0.f}, 0, 0, 0);
#pragma unroll
                    for (int j = 0; j < 8; ++j) accj[j] = __builtin_amdgcn_mfma_f32_16x16x32_fp8_fp8(hi64(row[b][j]), hi64(xB), accj[j], 0, 0, 0);
                } else {
#pragma unroll
                    for (int j = 0; j < 8; ++j) { const u32x4 xs = (base0 + j >= c1) ? xB : xA; accj[j] = __builtin_amdgcn_mfma_f32_16x16x32_fp8_fp8(lo64(row[b][j]), lo64(xs), (f32x4){0.f, 0.f, 0.f, 0.f}, 0, 0, 0);
                        accj[j] = __builtin_amdgcn_mfma_f32_16x16x32_fp8_fp8(hi64(row[b][j]), hi64(xs), accj[j], 0, 0, 0); }
                }
#pragma unroll
                for (int j = 0; j < 8; ++j) p[j] = __builtin_fmaf(accj[j][3], dw3, __builtin_fmaf(accj[j][2], dw2, __builtin_fmaf(accj[j][1], dw1, accj[j][0] * dw0)));
                float q4[4], q2[2], q1;
#pragma unroll
                for (int j = 0; j < 4; ++j) { const float keep = b5 ? p[4 + j] : p[j], send = b5 ? p[j] : p[4 + j]; q4[j] = keep + __shfl_xor(send, 32); }
#pragma unroll
                for (int j = 0; j < 2; ++j) { const float keep = b4 ? q4[2 + j] : q4[j], send = b4 ? q4[j] : q4[2 + j]; q2[j] = keep + __shfl_xor(send, 16); }
                { const float keep = b3 ? q2[1] : q2[0], send = b3 ? q2[0] : q2[1]; q1 = keep + __shfl_xor(send, 8); }
                q1 = DPP_ADD(q1, 0xB1); q1 = DPP_ADD(q1, 0x4E); q1 = DPP_ADD(q1, 0x141);
                const float t = __builtin_bit_cast(float, __builtin_amdgcn_ds_bpermute((l & 7) * 32, __builtin_bit_cast(int, q1)));
                const int base = i + 8 * b;
                if ((l >> 3) == ((base - cb) >> 3)) tot = t;
            }
        }
        if (!pf_done) { if (tok + 3 * step < T_TOK) U_PREFETCH(tok + 2 * step); }
        if (fv) { const int tk = (ent & 128) ? tokB : tokA; AK[(size_t)tk * 128 + (ent & 127)] = gelu_tanh(tot * su * (1.f / 16.f)) * gt * sv; }
        if (n == 0) break;
        }
        LDS_WAIT(); asm volatile("" ::: "memory");
    }
#undef U_PREFETCH
}
__device__ __forceinline__ float wave_max_nonneg(float v) {
    unsigned u = __builtin_bit_cast(unsigned, v);
    u = max(u, (unsigned)__builtin_amdgcn_mov_dpp((int)u, 0xB1, 0xf, 0xf, true));
    u = max(u, (unsigned)__builtin_amdgcn_mov_dpp((int)u, 0x4E, 0xf, 0xf, true));
    u = max(u, (unsigned)__builtin_amdgcn_mov_dpp((int)u, 0x141, 0xf, 0xf, true));
    u = max(u, (unsigned)__builtin_amdgcn_mov_dpp((int)u, 0x140, 0xf, 0xf, true));
    const unsigned a = (unsigned)__builtin_amdgcn_readlane((int)u, 0), b = (unsigned)__builtin_amdgcn_readlane((int)u, 16), c = (unsigned)__builtin_amdgcn_readlane((int)u, 32), d = (unsigned)__builtin_amdgcn_readlane((int)u, 48);
    return __builtin_bit_cast(float, max(max(a, b), max(c, d)));
}
template <int MODE>
__device__ __forceinline__ void peer_v_phase(const Frame& F, const Args& A) {
    const unsigned char* V8 = A.ws + WS_V8; const int* IDX = (const int*)(A.ws + WS_P + P_IDX); const float* AK = (const float*)(A.ws + WS_AK);
    float* out = MODE == 0 ? A.out : (float*)(A.ws + WS_P + P_SC);
    const int g = F.bid & 7, nmem = F.G >> 3, l = F.lane, sub = l & 7, rr = l >> 3, n16 = l & 15, q = l >> 4, step = nmem * NWAVES;
    const GAS unsigned char* vb = (const GAS unsigned char*)(V8 + (size_t)g * NEXP * 128);
    LAS unsigned long long* rep = (LAS unsigned long long*)(F.lds + F.wave * 2048);
    const unsigned long long bm = 0xFFull << (8 * (n16 & 7));
    const int repi = 2 * q + (n16 >> 3);
    const bool vl = (n16 < 8) && (q < 2);
    LAS float* stg = (LAS float*)(F.lds + 16384 + F.wave * 512);
    int tok = (F.bid >> 3) * NWAVES + F.wave;
    int ne[4]; float na[4];
#define V_PREFETCH(t) do { const size_t _a = (size_t)(t) * 128, _b = ((size_t)(t) + step) * 128; ne[0] = IDX[_a + l]; ne[1] = IDX[_a + 64 + l]; ne[2] = IDX[_b + l]; ne[3] = IDX[_b + 64 + l]; \
        na[0] = AK[_a + l]; na[1] = AK[_a + 64 + l]; na[2] = AK[_b + l]; na[3] = AK[_b + 64 + l]; } while (0)
    if (tok + step < T_TOK) V_PREFETCH(tok);
    for (; tok + step < T_TOK; tok += 2 * step) {
        const int e0 = ne[0], e1 = ne[1], e2 = ne[2], e3 = ne[3]; const float a0 = na[0], a1 = na[1], a2 = na[2], a3 = na[3];
        u32x4 rowA[16], rowB[16];
#pragma unroll
        for (int i = 0; i < 16; ++i) { const int src = (8 * (i & 7) + rr) * 4;
            const int ea = __builtin_amdgcn_ds_bpermute(src, i < 8 ? e0 : e1), eb = __builtin_amdgcn_ds_bpermute(src, i < 8 ? e2 : e3);
            rowA[i] = *(const GAS u32x4*)(vb + ((unsigned)ea * 128u + 16u * (unsigned)sub)); rowB[i] = *(const GAS u32x4*)(vb + ((unsigned)eb * 128u + 16u * (unsigned)sub)); }
        f32x4 HA = {0.f, 0.f, 0.f, 0.f}, HB = {0.f, 0.f, 0.f, 0.f};
        if (l < 32) { const float* hpa = out + (size_t)tok * D + g * 128 + 4 * l; HA = *(const f32x4*)hpa; HB = *(const f32x4*)(hpa + (size_t)step * D); }
        if (tok + 3 * step < T_TOK) V_PREFETCH(tok + 2 * step);
        const float amA = wave_max_nonneg(fmaxf(fabsf(a0), fabsf(a1))), amB = wave_max_nonneg(fmaxf(fabsf(a2), fabsf(a3)));
        const float scA = amA > 0.f ? 224.f * __builtin_amdgcn_rcpf(amA) : 0.f, invA = amA * (1.f / 224.f), scB = amB > 0.f ? 224.f * __builtin_amdgcn_rcpf(amB) : 0.f, invB = amB * (1.f / 224.f);
        { const unsigned wA = (unsigned)__builtin_amdgcn_cvt_pk_fp8_f32(a0 * scA, a1 * scA, 0, false), wB = (unsigned)__builtin_amdgcn_cvt_pk_fp8_f32(a2 * scB, a3 * scB, 0, false);
          const unsigned r0 = (wA & 0xffu) * 0x01010101u, r1 = ((wA >> 8) & 0xffu) * 0x01010101u, r2 = (wB & 0xffu) * 0x01010101u, r3 = ((wB >> 8) & 0xffu) * 0x01010101u;
          rep[l] = ((unsigned long long)r0 << 32) | r0; rep[64 + l] = ((unsigned long long)r1 << 32) | r1; rep[128 + l] = ((unsigned long long)r2 << 32) | r2; rep[192 + l] = ((unsigned long long)r3 << 32) | r3; }
        LDS_WAIT(); asm volatile("" ::: "memory");
#pragma unroll
        for (int t2 = 0; t2 < 2; ++t2) {
            f32x4 alo = {0.f, 0.f, 0.f, 0.f}, ahi = {0.f, 0.f, 0.f, 0.f};
#pragma unroll
            for (int i = 0; i < 16; ++i) { const long bop = (long)(rep[128 * t2 + 8 * i + repi] & bm); const u32x4 rw = t2 ? rowB[i] : rowA[i];
                alo = __builtin_amdgcn_mfma_f32_16x16x32_fp8_fp8(lo64(rw), bop, alo, 0, 0, 0);
                ahi = __builtin_amdgcn_mfma_f32_16x16x32_fp8_fp8(hi64(rw), bop, ahi, 0, 0, 0); }
            const float inv = t2 ? invB : invA;
            float vlo[4], vhi[4];
#pragma unroll
            for (int r = 0; r < 4; ++r) { const float tl = alo[r], th = ahi[r];
                vlo[r] = (tl + __builtin_bit_cast(float, __builtin_amdgcn_ds_bpermute(((l + 40) & 63) * 4, __builtin_bit_cast(int, tl)))) * inv;
                vhi[r] = (th + __builtin_bit_cast(float, __builtin_amdgcn_ds_bpermute(((l + 40) & 63) * 4, __builtin_bit_cast(int, th)))) * inv; }
            if (vl) {
#pragma unroll
                for (int r = 0; r < 4; ++r) { stg[64 * q + 16 * r + n16] = vlo[r]; stg[64 * q + 16 * r + n16 + 8] = vhi[r]; } }
            LDS_WAIT(); asm volatile("" ::: "memory");
            if (l < 32) { const f32x4 dv = *(const LAS f32x4*)(stg + 4 * l); *(f32x4*)(out + (size_t)(tok + t2 * step) * D + g * 128 + 4 * l) = (t2 ? HB : HA) + dv; }
            LDS_WAIT(); asm volatile("" ::: "memory");
        }
        LDS_WAIT(); asm volatile("" ::: "memory");
    }
#undef V_PREFETCH
}
__device__ __forceinline__ void final_norm_phase(const Frame& F, const Args& A) {
    const int gw = F.bid * NWAVES + F.wave, NGW = F.G * NWAVES, l = F.lane; const float* fg = A.in[I_FG];
    const f32x4* gp = (const f32x4*)fg + l;
    int tok = gw;
    for (; tok + 3 * NGW < T_TOK; tok += 4 * NGW) {
        f32x4 v[4][4]; float ss[4];
#pragma unroll
        for (int b = 0; b < 4; ++b) { const f32x4* hp = (const f32x4*)(A.out + (size_t)(tok + b * NGW) * D) + l;
#pragma unroll
            for (int j = 0; j < 4; ++j) v[b][j] = hp[64 * j]; }
#pragma unroll
        for (int b = 0; b < 4; ++b) { ss[b] = 0.f;
#pragma unroll
            for (int j = 0; j < 4; ++j) ss[b] += (v[b][j].x * v[b][j].x + v[b][j].y * v[b][j].y) + (v[b][j].z * v[b][j].z + v[b][j].w * v[b][j].w); }
#pragma unroll
        for (int o = 1; o < 64; o <<= 1) {
#pragma unroll
            for (int b = 0; b < 4; ++b) ss[b] += __shfl_xor(ss[b], o); }
#pragma unroll
        for (int b = 0; b < 4; ++b) { const float rstd = 1.f / sqrtf(ss[b] * (1.f / D) + EPS); f32x4* hp = (f32x4*)(A.out + (size_t)(tok + b * NGW) * D) + l;
#pragma unroll
            for (int j = 0; j < 4; ++j) hp[64 * j] = v[b][j] * rstd * gp[64 * j]; }
    }
    for (; tok < T_TOK; tok += NGW) { f32x4* hp = (f32x4*)(A.out + (size_t)tok * D) + l; f32x4 v[4]; float ss = 0.f;
#pragma unroll
        for (int j = 0; j < 4; ++j) { v[j] = hp[64 * j]; ss += (v[j].x * v[j].x + v[j].y * v[j].y) + (v[j].z * v[j].z + v[j].w * v[j].w); }
        const float rstd = 1.f / sqrtf(wave_sum(ss) * (1.f / D) + EPS);
#pragma unroll
        for (int j = 0; j < 4; ++j) hp[64 * j] = v[j] * rstd * gp[64 * j]; }
}

#ifdef DEBUG_CHECK
constexpr size_t WS_DBG = 472 * MiB;
__device__ __forceinline__ int dbg_tok(int i) { return (i * 509 + 3) & 32767; }
__device__ __forceinline__ float gelu_ref(float x) { return 0.5f * x * (1.f + tanhf(0.7978845608028654f * (x + 0.044715f * x * x * x))); }
__global__ void __launch_bounds__(512) dbg_scores(Args a) {
    __shared__ float n2s[1024]; __shared__ float q[2048];
    const int t = dbg_tok(blockIdx.x), tid = threadIdx.x;
    const bf16_t* N2 = (const bf16_t*)(a.ws + WS_N1); const float* SC = (const float*)(a.ws + WS_P + P_SC); unsigned* dbg = (unsigned*)(a.ws + WS_DBG);
    for (int k = tid; k < 1024; k += 512) n2s[k] = bf1(N2[(size_t)t * 1024 + k]);
    __syncthreads();
    for (int r = 0; r < 4; ++r) { const int c = tid + 512 * r; float s = 0.f; for (int k = 0; k < 1024; ++k) s += n2s[k] * a.in[I_WQ][(size_t)k * 2048 + c]; q[c] = s; }
    __syncthreads();
    float md = 0.f;
    for (int r = 0; r < 4; ++r) { const int n = tid + 512 * r, hh = n >> 7, key = n & 127; const float* kX = (hh & 1) ? a.in[I_K2] : a.in[I_K1];
        float s = 0.f; for (int d = 0; d < 128; ++d) s += q[hh * 128 + d] * kX[key * 128 + d];
        md = fmaxf(md, fabsf(s - SC[(size_t)n * T_TOK + t])); }
    atomicMax(&dbg[0], __builtin_bit_cast(unsigned, md));
}
__global__ void __launch_bounds__(64) dbg_topk(Args a) {
    __shared__ float s1[8][128], s2[8][128], cv[8][256]; __shared__ float t1v[8][16], t2v[8][16]; __shared__ int t1i[8][16], t2i[8][16], exi[8][16]; __shared__ float exv[8][16];
    const int t = dbg_tok(blockIdx.x), h = threadIdx.x;
    const float* SC = (const float*)(a.ws + WS_P + P_SC); const int* IDX = (const int*)(a.ws + WS_P + P_IDX); const float* GATE = (const float*)(a.ws + WS_P + P_GATE); unsigned* dbg = (unsigned*)(a.ws + WS_DBG);
    if (h >= 8) return;
    for (int j = 0; j < 128; ++j) { s1[h][j] = SC[(size_t)(h * 256 + j) * T_TOK + t]; s2[h][j] = SC[(size_t)(h * 256 + 128 + j) * T_TOK + t]; }
    for (int r = 0; r < 16; ++r) { int b1 = 0, b2 = 0; for (int j = 1; j < 128; ++j) { if (s1[h][j] > s1[h][b1]) b1 = j; if (s2[h][j] > s2[h][b2]) b2 = j; }
        t1v[h][r] = s1[h][b1]; t1i[h][r] = b1; s1[h][b1] = -1e30f; t2v[h][r] = s2[h][b2]; t2i[h][r] = b2; s2[h][b2] = -1e30f; }
    for (int c = 0; c < 256; ++c) cv[h][c] = t1v[h][c >> 4] + t2v[h][c & 15];
    for (int r = 0; r < 16; ++r) { int bc = 0; for (int c = 1; c < 256; ++c) if (cv[h][c] > cv[h][bc]) bc = c;
        exv[h][r] = cv[h][bc]; exi[h][r] = t1i[h][bc >> 4] * 128 + t2i[h][bc & 15]; cv[h][bc] = -1e30f; }
    float sum = 0.f; const float mx0 = exv[h][0]; for (int r = 0; r < 16; ++r) { exv[h][r] = expf(exv[h][r] - mx0); } for (int r = 0; r < 16; ++r) sum += exv[h][r];
    unsigned miss = 0; float gd = 0.f;
    for (int w = 0; w < 16; ++w) { const int e = IDX[(size_t)t * 128 + h * 16 + w]; const float g = GATE[(size_t)t * 128 + h * 16 + w]; bool found = false;
        for (int r = 0; r < 16; ++r) if (exi[h][r] == e) { found = true; gd = fmaxf(gd, fabsf(g - exv[h][r] / sum)); }
        if (!found) ++miss; }
    atomicAdd(&dbg[1], miss); atomicMax(&dbg[3], __builtin_bit_cast(unsigned, gd));
}
__global__ void __launch_bounds__(512) dbg_experts_pre(Args a) {
    __shared__ float n2s[1024]; __shared__ float ak[128]; __shared__ int ek[128]; __shared__ float red[8];
    const int t = dbg_tok(blockIdx.x), tid = threadIdx.x, lane = tid & 63, wave = tid >> 6;
    const bf16_t* N2 = (const bf16_t*)(a.ws + WS_N1); const int* IDX = (const int*)(a.ws + WS_P + P_IDX); const float* GATE = (const float*)(a.ws + WS_P + P_GATE);
    float* rows = (float*)(a.ws + WS_DBG + MiB);
    for (int k = tid; k < 1024; k += 512) n2s[k] = bf1(N2[(size_t)t * 1024 + k]);
    if (tid < 128) ek[tid] = IDX[(size_t)t * 128 + tid];
    __syncthreads();
    for (int k = wave * 16; k < wave * 16 + 16; ++k) { const float* u = a.in[I_PU] + (size_t)ek[k] * 1024; float s = 0.f; for (int j = lane; j < 1024; j += 64) s += u[j] * n2s[j];
        s = wave_sum(s); if (lane == 0) ak[k] = gelu_ref(s) * GATE[(size_t)t * 128 + k]; }
    __syncthreads();
    float h2[2]; float ss = 0.f;
    for (int r = 0; r < 2; ++r) { const int d = tid + 512 * r; float o = 0.f; for (int k = 0; k < 128; ++k) o += ak[k] * a.in[I_PV][(size_t)ek[k] * 1024 + d]; h2[r] = a.out[(size_t)t * 1024 + d] + o; ss += h2[r] * h2[r]; }
    ss = wave_sum(ss); if (lane == 0) red[wave] = ss; __syncthreads();
    float tot = 0.f; for (int w = 0; w < 8; ++w) tot += red[w];
    const float rstd = 1.f / sqrtf(tot / 1024.f + EPS);
    for (int r = 0; r < 2; ++r) { const int d = tid + 512 * r; rows[(size_t)blockIdx.x * 1024 + d] = h2[r] * rstd * a.in[I_FG][d]; }
}
__global__ void __launch_bounds__(512) dbg_experts_post(Args a) {
    const int t = dbg_tok(blockIdx.x), tid = threadIdx.x; const float* rows = (const float*)(a.ws + WS_DBG + MiB); float* dbgf = (float*)(a.ws + WS_DBG);
    float e = 0.f, n = 0.f;
    for (int r = 0; r < 2; ++r) { const int d = tid + 512 * r; const float x = rows[(size_t)blockIdx.x * 1024 + d], y = a.out[(size_t)t * 1024 + d]; e += (x - y) * (x - y); n += x * x; }
    e = wave_sum(e); n = wave_sum(n); if ((tid & 63) == 0) { atomicAdd(&dbgf[4], e); atomicAdd(&dbgf[5], n); }
}
__global__ void __launch_bounds__(512) dbg_report(Args a, int which) {
    const unsigned* dbg = (const unsigned*)(a.ws + WS_DBG); const float* dbgf = (const float*)(a.ws + WS_DBG);
    const float mA = dbgf[0], gd = dbgf[3]; const unsigned miss = dbg[1]; const float relC = sqrtf(dbgf[4] / fmaxf(dbgf[5], 1e-30f));
    float X;
    if (which == 0) { int mask = 0; if (mA > 0.05f) mask |= 1; if (miss > 400u) mask |= 2; if (relC > 0.05f) mask |= 4; if (gd > 0.02f) mask |= 8; X = 1000.f + 100.f * mask; }
    else if (which == 1) X = 1e6f * mA; else if (which == 2) X = 100.f + (float)miss; else if (which == 3) X = 1e6f * relC; else X = 1e6f * gd;
    for (size_t i = (size_t)blockIdx.x * 512 + threadIdx.x; i < (size_t)T_TOK * D; i += (size_t)gridDim.x * 512) a.out[i] = (i == 0) ? X : 0.f;
}
#endif

constexpr int NPH = 13;
__global__ void __launch_bounds__(NWAVES * 64, 2) fwd_kernel(Args args) {
    extern __shared__ __attribute__((aligned(16))) unsigned char lds_raw[];
    Frame F;
    F.lds = (LAS unsigned char*)lds_raw;
    F.tid = threadIdx.x; F.lane = F.tid & 63; F.wave = __builtin_amdgcn_readfirstlane(F.tid >> 6);
    F.G = gridDim.x; F.bid = blockIdx.x;
    volatile LAS unsigned* MISC = (volatile LAS unsigned*)(F.lds + MISC_OFF);
    for (int u = F.tid; u < (LDS_BYTES - LDSCTL_OFF) / 4; u += NWAVES * 64) ((LAS unsigned*)(F.lds + LDSCTL_OFF))[u] = 0u;
    __syncthreads();
    unsigned* ctl = (unsigned*)(args.ws + WS_CTL);
    const int lo = args.ph_lo, hi = args.ph_hi;
    XcdBarrier bar; bar.bar = ctl + CW_BAR + args.li * XCD_BAR_WORDS; bar.x = 0; bar.st = nullptr;
    if (hi - lo > 1) bar = xcd_barrier_post(ctl + CW_BAR + args.li * XCD_BAR_WORDS, MISC + 8);
#define IN(k) (lo <= (k) && (k) < hi)
#ifdef PROBE_TS
#define STAMP(k) do { if (F.bid == 0 && F.tid == 0) ((unsigned long long*)(args.ws + (472u << 20)))[(k)] = __builtin_amdgcn_s_memrealtime(); } while (0)
#else
#define STAMP(k) do { } while (0)
#endif
#define SEAM(k) do { if (IN(k) && IN((k) + 1)) { xcd_barrier(bar); if (XTRA_BAR) xcd_barrier(bar); } STAMP((k) + 1); } while (0)
    unsigned char* ws = args.ws;
    bf16_t* P = (bf16_t*)(ws + WS_P);

    STAMP(0);
    if (IN(0)) { phase0(F, args); SEAM(0); }
    if (IN(1)) {
        pg8::Gemm g{(const bf16_t*)(ws + WS_N1), (const bf16_t*)(ws + WS_WIN), T_TOK, NPROJ, D, D}; pg8::StaticOrder S; S.init(T_TOK, NPROJ, F.G, F.bid);
        pg8::EpiProj E{P, (float*)(ws + WS_ALR)};
        pg8::gemm_phase<pg8::EpiProj, pg8::StaticOrder, false, true>(F.lds, g, S, E);
        {
            const int nwg = (T_TOK / 256) * (NPROJ / 256), rem = nwg % F.G;
            if (rem == 0) convert_tables(F, args, F.bid * NWAVES + F.wave, F.G * NWAVES);
            else if (F.bid >= rem) convert_tables(F, args, (F.bid - rem) * NWAVES + F.wave, (F.G - rem) * NWAVES);
        }
        SEAM(1);
    }
    if (IN(2)) {
        gla_chunk_phase<false>(F, args);
        for (int it = F.bid; it < 1024; it += F.G) sgu_unit<false>(F, args, it);
        SEAM(2);
    }
    if (IN(3)) { if (DRY_EXP == 13) { gla_scan<true>(F, args); __syncthreads(); } gla_scan<false>(F, args); SEAM(3); }
    if (IN(4)) { if (DRY_EXP == 14) { gla_out_phase<true>(F, args); __syncthreads(); } gla_out_phase<false>(F, args); SEAM(4); }
    if (IN(5)) {
        { pg8::Gemm g{P + PC_Q, (const bf16_t*)(ws + WS_WA), T_TOK, D, 512, PLD}; pg8::StaticOrder S; S.init(T_TOK, D, F.G, F.bid);
          pg8::EpiBrA E{P}; pg8::gemm_phase<pg8::EpiBrA, pg8::StaticOrder, true, true>(F.lds, g, S, E); }
        { pg8::Gemm g{P + PC_SU, (const bf16_t*)(ws + WS_WB), T_TOK, D, 512, PLD}; pg8::StaticOrder S; S.init(T_TOK, D, F.G, F.bid);
          pg8::EpiBrB E{P}; pg8::gemm_phase<pg8::EpiBrB, pg8::StaticOrder, true, true>(F.lds, g, S, E); }
        SEAM(5);
    }
    if (IN(6)) {
        pg8::Gemm g{P + PC_MRG, (const bf16_t*)(ws + WS_WOUT), T_TOK, D, D, PLD}; pg8::StaticOrder S; S.init(T_TOK, D, F.G, F.bid);
        pg8::EpiOut E{args.in[I_X], args.out}; pg8::gemm_phase<pg8::EpiOut, pg8::StaticOrder, true, true>(F.lds, g, S, E);
        SEAM(6);
    }
    if (IN(7)) {
        const int gw = F.bid * NWAVES + F.wave, NGW = F.G * NWAVES;
        { int m = gw; for (; m + 3 * NGW < T_TOK; m += 4 * NGW) rms_rows_to_bf16<true, 4>(F.lane, args.out + (size_t)m * D, (size_t)NGW * D, args.in[I_N2G], (bf16_t*)(ws + WS_N1) + (size_t)m * D, (size_t)NGW * D, (unsigned*)(ws + WS_P + P_X8) + (size_t)m * 256, (size_t)NGW * 256);
          for (; m < T_TOK; m += NGW) rms_rows_to_bf16<true, 1>(F.lane, args.out + (size_t)m * D, 0, args.in[I_N2G], (bf16_t*)(ws + WS_N1) + (size_t)m * D, 0, (unsigned*)(ws + WS_P + P_X8) + (size_t)m * 256, 0); }
        SEAM(7);
    }
    if (IN(8)) {
        pg8::Gemm g{(const bf16_t*)(ws + WS_N1), (const bf16_t*)(ws + WS_WQF), T_TOK, 2048, D, D}; pg8::StaticOrder S; S.init(T_TOK, 2048, F.G, F.bid);
        pg8::EpiScores E{(float*)(ws + WS_P + P_SC)}; pg8::gemm_phase<pg8::EpiScores, pg8::StaticOrder, true, true>(F.lds, g, S, E);
        SEAM(8);
    }
    if (IN(9)) { peer_topk(F, args); SEAM(9); }
    if (IN(10)) { if (DRY_EXP == 2) { peer_u_phase<1>(F, args); __syncthreads(); } if (DRY_EXP == 3) { peer_u_phase<2>(F, args); __syncthreads(); } if (DRY_EXP == 4) { peer_u_phase<3>(F, args); __syncthreads(); } if (DRY_EXP == 5) { peer_u_phase<4>(F, args); __syncthreads(); } peer_u_phase<0>(F, args); SEAM(10); }
    if (IN(11)) { if (DRY_EXP == 1) { peer_v_phase<1>(F, args); __syncthreads(); } peer_v_phase<0>(F, args); SEAM(11); }
    if (IN(12)) { final_norm_phase(F, args); }
#undef IN
#undef SEAM
}


#ifdef PROBE_TS
__global__ void __launch_bounds__(512) probe_report(Args a, int pi, int pj) {
    const unsigned long long* ts = (const unsigned long long*)(a.ws + (472u << 20));
    const float X1 = 10.f * (float)(ts[pi + 1] - ts[pi]) * 0.01f, X2 = (float)(ts[pj + 1] - ts[pj]) * 0.01f;
    for (size_t i = (size_t)blockIdx.x * 512 + threadIdx.x; i < (size_t)T_TOK * D; i += (size_t)gridDim.x * 512) a.out[i] = (i == 0) ? X1 : X2;
}
#endif
extern "C" void kernel_launch(void* const* d_in, const int* in_sizes, int n_in, void* d_out, int out_size, void* d_ws, size_t ws_size, hipStream_t stream) {
    static int grid = 0;
    if (grid == 0) {
        if (n_in != 20 || in_sizes[0] != T_TOK * D || out_size != T_TOK * D || ws_size < WS_END) {
            fprintf(stderr, "kernel_launch: unexpected shapes: n_in %d in0 %d out %d ws %zu (need %zu)\n", n_in, n_in > 0 ? in_sizes[0] : -1, out_size, ws_size, (size_t)WS_END); grid = -1; return; }
        int dev = 0, cus = 0;
        if (hipGetDevice(&dev) != hipSuccess || hipDeviceGetAttribute(&cus, hipDeviceAttributeMultiprocessorCount, dev) != hipSuccess) { grid = -1; return; }
        if (hipFuncSetAttribute((const void*)fwd_kernel, hipFuncAttributeMaxDynamicSharedMemorySize, LDS_BYTES) != hipSuccess) { fprintf(stderr, "kernel_launch: hipFuncSetAttribute failed\n"); grid = -1; return; }
        int per_cu = 0;
        if (hipOccupancyMaxActiveBlocksPerMultiprocessor(&per_cu, (const void*)fwd_kernel, NWAVES * 64, LDS_BYTES) != hipSuccess || per_cu < 1) fprintf(stderr, "kernel_launch: occupancy query says %d\n", per_cu);
        (void)hipGetLastError();
        grid = cus;
    }
    if (grid < 0) return;
    (void)hipMemsetAsync((char*)d_ws + WS_CTL, 0, CTL_ZERO_BYTES, stream);
    Args a{};
    for (int i = 0; i < 20; ++i) a.in[i] = (const float*)d_in[i];
    a.out = (float*)d_out; a.ws = (unsigned char*)d_ws;
#ifndef LAUNCH_LIST
#define LAUNCH_LIST {0, NPH}
#endif
    static const int ranges[][2] = { LAUNCH_LIST };
    const int nl = (int)(sizeof(ranges) / sizeof(ranges[0]));
    for (int li = 0; li < nl; ++li) { a.ph_lo = ranges[li][0]; a.ph_hi = ranges[li][1]; a.li = li;
        hipLaunchKernelGGL(fwd_kernel, dim3(grid), dim3(NWAVES * 64), LDS_BYTES, stream, a); }
}
```

```cpp
#include <hip/hip_runtime.h>
#include <cstdio>
#include <cstdint>


#ifndef XTRA_BAR
#define XTRA_BAR 0
#endif
#ifndef DRY_EXP
#define DRY_EXP 0
#endif
#ifndef DUP_PHASE
#define DUP_PHASE -1
#endif
#ifndef MK_N_LAUNCHES
#define MK_N_LAUNCHES 1
#endif

#define LAS __attribute__((address_space(3)))
#define GAS __attribute__((address_space(1)))
typedef unsigned short bf16_t;
typedef short bf16x8 __attribute__((ext_vector_type(8)));
typedef float f32x4 __attribute__((ext_vector_type(4)));
typedef float f32x2 __attribute__((ext_vector_type(2)));
typedef unsigned u32x4 __attribute__((ext_vector_type(4)));
typedef unsigned u32x2 __attribute__((ext_vector_type(2)));
typedef __bf16 bf16x2_t __attribute__((ext_vector_type(2)));

constexpr int T_TOK = 32768, D = 1024, SEQ = 4096, NBATCH = 8;
constexpr int NPROJ = 5376;
constexpr int PLD = 5120;
constexpr int PC_Q = 0, PC_K = 512, PC_V = 1024, PC_R = 1536, PC_SU = 2048, PC_SV = 2560, PC_GA = 3072, PC_GB = 4096;
constexpr int PC_MRG = 512;
constexpr float EPS = 1e-6f;
constexpr int NEXP = 16384;

constexpr size_t MiB = 1u << 20;
constexpr size_t WS_CTL = 0, CTL_ZERO_BYTES = 64 * 1024;
constexpr size_t WS_WIN = 1 * MiB;
constexpr size_t WS_WA = 12 * MiB;
constexpr size_t WS_WB = 13 * MiB;
constexpr size_t WS_WOUT = 14 * MiB;
constexpr size_t WS_WQF = 16 * MiB;
constexpr size_t WS_U8 = 20 * MiB;
constexpr size_t WS_V8 = 36 * MiB;
constexpr size_t WS_SU = 52 * MiB;
constexpr size_t WS_SV = 52 * MiB + 65536;
constexpr size_t WS_AK = 53 * MiB;
constexpr size_t WS_DEC = 84 * MiB;
constexpr size_t WS_ALR = 85 * MiB;
constexpr size_t WS_N1 = 87 * MiB;
constexpr size_t WS_P = 151 * MiB;
constexpr size_t WS_END = 471 * MiB;
constexpr size_t P_SC = 0, P_IDX = 256 * MiB, P_GATE = 272 * MiB, P_X8 = 288 * MiB;

constexpr int CW_BAR = 4096;

constexpr int RING_BYTES = 131072;
constexpr int LDSCTL_OFF = RING_BYTES, MISC_OFF = LDSCTL_OFF + 320;
constexpr int LDS_BYTES = 147456;
constexpr int NWAVES = 8;

__device__ __forceinline__ unsigned pk2(float lo, float hi) { const f32x2 v = {lo, hi}; const bf16x2_t b = __builtin_convertvector(v, bf16x2_t); return __builtin_bit_cast(unsigned, b); }
__device__ __forceinline__ unsigned f2bf(float f) { return pk2(f, 0.f) & 0xffffu; }
__device__ __forceinline__ float bflo(unsigned w) { return __builtin_bit_cast(float, w << 16); }
__device__ __forceinline__ float bfhi(unsigned w) { return __builtin_bit_cast(float, w & 0xffff0000u); }
__device__ __forceinline__ float bf1(bf16_t h) { return __builtin_bit_cast(float, ((unsigned)h) << 16); }
__device__ __forceinline__ float sigmoidf_(float x) { return __builtin_amdgcn_rcpf(1.f + __expf(-x)); }
__device__ __forceinline__ float gelu_tanh(float x) { const float y = 1.5957691216057308f * (x + 0.044715f * x * x * x); return x * sigmoidf_(y); }
__device__ __forceinline__ float siluf_(float x) { return x * sigmoidf_(x); }
__device__ __forceinline__ float wave_sum(float v) {
#pragma unroll
    for (int o = 1; o < 64; o <<= 1) v += __shfl_xor(v, o);
    return v;
}
#define LDS_WAIT() asm volatile("s_waitcnt lgkmcnt(0)" ::: "memory")
#define VM_WAIT() asm volatile("s_waitcnt vmcnt(0)" ::: "memory")

namespace pg8 {
constexpr int BM = 256, BK = 64, HALF = 128, HTB = HALF * BK * 2, STAGE_BYTES = 8 * HTB, NXCD = 8, WGM = 8;
__host__ __device__ __forceinline__ int lds_byte(int r, int c) { const int st = (r >> 4) * 2 + (c >> 5), rr = r & 15, cc = c & 31, ob = rr * 64 + cc * 2; return st * 1024 + (ob ^ (((ob >> 9) & 1) << 5)); }
__host__ __device__ __forceinline__ void stage_rc(int b, int& R, int& C) { const int st = b / 1024, sb = b % 1024, swz = sb ^ (((sb >> 9) & 1) << 5); R = (st >> 1) * 16 + swz / 64; C = (st & 1) * 32 + (swz % 64) / 2; }
__host__ __device__ __forceinline__ int perm32(int rho) { const int n = rho >> 4, i = rho & 15; return 8 * (i >> 2) + 4 * n + (i & 3); }

struct Unit { int pm, pn; };
struct Gemm { const bf16_t* A; const bf16_t* Bt; int M, N, K, lda; };

struct StaticOrder {
    int nM, nN, nwg, G, c;
    __host__ __device__ void init(int M, int N, int G_, int c_) { nM = M / BM; nN = N / BM; nwg = nM * nN; G = G_; c = c_; }
    __host__ __device__ bool next(int i, Unit& u) const {
        const long L = (long)i * G + c; if (L >= nwg) return false;
        int wgid = (int)L; { const int q = nwg / NXCD, r = nwg % NXCD, xcd = wgid % NXCD, off = wgid / NXCD; wgid = (xcd < r ? xcd * (q + 1) : r * (q + 1) + (xcd - r) * q) + off; }
        const int nig = WGM * nN, gid = wgid / nig, fm = gid * WGM, gsz = (nM - fm) < WGM ? (nM - fm) : WGM;
        u.pm = fm + ((wgid % nig) % gsz); u.pn = (wgid % nig) / gsz; return true;
    }
    __device__ __forceinline__ void a_ready(const Unit&) const {}
    __device__ __forceinline__ void done(const Unit&) const {}
};

template <class Epi, class Sched, bool ALIGN_EPI = false, bool SP2 = false>
__device__ __forceinline__ void gemm_phase(LAS unsigned char* lds, const Gemm g, const Sched& S, const Epi& E) {
    const int tid = threadIdx.x, wid = __builtin_amdgcn_readfirstlane(tid >> 6), lane = tid & 63, wr = wid >> 2, wc = wid & 3, fr = lane & 15, fq = lane >> 4;
    const int K = g.K, nt = K / BK, lda = g.lda;
    unsigned voffA[2], voffB[2];
#pragma unroll
    for (int i = 0; i < 2; ++i) { int R, C; stage_rc(tid * 16 + i * 8192, R, C); const int Rb = Epi::PERM ? ((R & ~31) + perm32(R & 31)) : R;
        voffA[i] = (unsigned)(R * lda + C) * 2u; voffB[i] = (unsigned)(Rb * K + C) * 2u; }
    const size_t kstep = (size_t)(BK * 2);
    const size_t hstepA = (size_t)HALF * lda * 2, hstepB = (size_t)HALF * K * 2;
    const size_t tstepA = 2 * hstepA, tstepB = 2 * hstepB;
    const unsigned ldsw = (unsigned)wid * 1024u;
    const int aoff = lds_byte(wr * 64 + fr, fq * 8), boff = lds_byte(wc * 32 + fr, fq * 8);
#define PG8_SA(b, h) (((b) * 2 + (h)) * HTB)
#define PG8_SB(b, h) ((4 + (b) * 2 + (h)) * HTB)
#define PG8_STAGE(bufoff, gbase, voff) do { _Pragma("unroll") for (int _i = 0; _i < 2; ++_i) \
        __builtin_amdgcn_global_load_lds((const unsigned*)((const char*)(gbase) + (voff)[_i]), (LAS unsigned*)(lds + (bufoff) + ldsw + _i * 8192), 16, 0, 0); } while (0)
#define PG8_LDA(dst, b, h) do { _Pragma("unroll") for (int m = 0; m < 4; ++m) _Pragma("unroll") for (int k = 0; k < 2; ++k) dst[m][k] = *(const LAS bf16x8*)(lds + PG8_SA(b, h) + aoff + m * 2048 + k * 1024); } while (0)
#define PG8_LDB(dst, b, h) do { _Pragma("unroll") for (int n = 0; n < 2; ++n) _Pragma("unroll") for (int k = 0; k < 2; ++k) dst[n][k] = *(const LAS bf16x8*)(lds + PG8_SB(b, h) + boff + n * 2048 + k * 1024); } while (0)
#define PG8_MMA(ai, bj, At, Bt) do { __builtin_amdgcn_s_setprio(1); _Pragma("unroll") for (int m = 0; m < 4; ++m) _Pragma("unroll") for (int n = 0; n < 2; ++n) _Pragma("unroll") for (int k = 0; k < 2; ++k) \
        acc[ai][bj][m][n] = __builtin_amdgcn_mfma_f32_16x16x32_bf16(Bt[n][k], At[m][k], acc[ai][bj][m][n], 0, 0, 0); __builtin_amdgcn_s_setprio(0); } while (0)
#define PG8_WAIT_V(n) asm volatile("s_waitcnt vmcnt(" #n ")" ::: "memory")
#define PG8_WAIT_L(n) asm volatile("s_waitcnt lgkmcnt(" #n ")" ::: "memory")
#define PG8_BAR __builtin_amdgcn_s_barrier()
#define PG8_SCHED __builtin_amdgcn_sched_barrier(0)
    Unit cur, nxt; int ui = 0;
    if (!S.next(0, cur)) return;
    f32x4 acc[2][2][4][2];
#pragma unroll
    for (int a = 0; a < 2; ++a)
#pragma unroll
        for (int b = 0; b < 2; ++b)
#pragma unroll
            for (int m = 0; m < 4; ++m)
#pragma unroll
                for (int n = 0; n < 2; ++n) acc[a][b][m][n] = (f32x4){0.f, 0.f, 0.f, 0.f};
    bf16x8 At[4][2], B0[2][2], B1[2][2];
    const char* cA = (const char*)g.A + (size_t)cur.pm * tstepA; const char* cB = (const char*)g.Bt + (size_t)cur.pn * tstepB;
    S.a_ready(cur);
    if constexpr (SP2) {
        PG8_STAGE(PG8_SB(0, 0), cB, voffB); PG8_STAGE(PG8_SB(0, 1), cB + hstepB, voffB); PG8_STAGE(PG8_SA(0, 0), cA, voffA); PG8_STAGE(PG8_SA(0, 1), cA + hstepA, voffA);
        if (wr == 1) PG8_BAR;
        PG8_WAIT_V(2); PG8_BAR;
        PG8_STAGE(PG8_SB(1, 0), cB + kstep, voffB); PG8_STAGE(PG8_SA(1, 0), cA + kstep, voffA); PG8_STAGE(PG8_SB(1, 1), cB + hstepB + kstep, voffB);
        PG8_WAIT_V(6); PG8_BAR;
    } else {
        PG8_STAGE(PG8_SB(0, 0), cB, voffB); PG8_STAGE(PG8_SA(0, 0), cA, voffA); PG8_STAGE(PG8_SB(0, 1), cB + hstepB, voffB); PG8_STAGE(PG8_SA(0, 1), cA + hstepA, voffA);
        if (wr == 1) PG8_BAR;
        PG8_WAIT_V(4); PG8_BAR;
        PG8_STAGE(PG8_SB(1, 0), cB + kstep, voffB); PG8_STAGE(PG8_SA(1, 0), cA + kstep, voffA); PG8_STAGE(PG8_SB(1, 1), cB + hstepB + kstep, voffB);
        PG8_WAIT_V(6); PG8_BAR;
    }
    for (;;) {
        const bool has_next = S.next(ui + 1, nxt);
        const char* nA = has_next ? (const char*)g.A + (size_t)nxt.pm * tstepA : cA; const char* nB = has_next ? (const char*)g.Bt + (size_t)nxt.pn * tstepB : cB;
        for (int t = 0; t < nt; t += 2) {
            const bool last = (t == nt - 2);
            const char* a1 = cA + (size_t)(t + 1) * kstep;
            const char* a2 = last ? nA : cA + (size_t)(t + 2) * kstep; const char* b2 = last ? nB : cB + (size_t)(t + 2) * kstep;
            const char* a3 = a2 + kstep; const char* b3 = b2 + kstep;
            if (last && has_next) S.a_ready(nxt);
            if constexpr (SP2) {
            PG8_LDB(B0, 0, 0); PG8_LDB(B1, 0, 1); PG8_SCHED; PG8_LDA(At, 0, 0); PG8_STAGE(PG8_SA(1, 1), a1 + hstepA, voffA);
            PG8_WAIT_V(8); PG8_WAIT_L(0); PG8_BAR; PG8_MMA(0, 0, At, B0); PG8_MMA(0, 1, At, B1); PG8_BAR; PG8_SCHED;
            PG8_LDA(At, 0, 1); PG8_STAGE(PG8_SB(0, 0), b2, voffB); PG8_STAGE(PG8_SB(0, 1), b2 + hstepB, voffB); PG8_STAGE(PG8_SA(0, 0), a2, voffA);
            PG8_WAIT_V(8); PG8_WAIT_L(0); PG8_BAR; PG8_MMA(1, 0, At, B0); PG8_MMA(1, 1, At, B1); PG8_BAR; PG8_SCHED;
            PG8_LDB(B0, 1, 0); PG8_LDB(B1, 1, 1); PG8_SCHED; PG8_LDA(At, 1, 0); PG8_STAGE(PG8_SA(0, 1), a2 + hstepA, voffA);
            PG8_WAIT_V(8); PG8_WAIT_L(0); PG8_BAR; PG8_MMA(0, 0, At, B0); PG8_MMA(0, 1, At, B1); PG8_BAR; PG8_SCHED;
            PG8_LDA(At, 1, 1); PG8_STAGE(PG8_SB(1, 0), b3, voffB); PG8_STAGE(PG8_SB(1, 1), b3 + hstepB, voffB); PG8_STAGE(PG8_SA(1, 0), a3, voffA);
            PG8_WAIT_V(8); PG8_WAIT_L(0); PG8_BAR; PG8_MMA(1, 0, At, B0); PG8_MMA(1, 1, At, B1); PG8_BAR; PG8_SCHED;
            } else {
            PG8_LDB(B0, 0, 0); PG8_SCHED; PG8_LDA(At, 0, 0); PG8_STAGE(PG8_SA(1, 1), a1 + hstepA, voffA);
            PG8_WAIT_L(8); PG8_BAR; PG8_WAIT_L(0); PG8_MMA(0, 0, At, B0); PG8_BAR; PG8_SCHED;
            PG8_LDB(B1, 0, 1); PG8_STAGE(PG8_SB(0, 0), b2, voffB);
            PG8_BAR; PG8_WAIT_L(0); PG8_MMA(0, 1, At, B1); PG8_BAR;
            PG8_LDA(At, 0, 1); PG8_STAGE(PG8_SA(0, 0), a2, voffA);
            PG8_BAR; PG8_WAIT_L(0); PG8_MMA(1, 0, At, B0); PG8_BAR; PG8_SCHED;
            PG8_STAGE(PG8_SB(0, 1), b2 + hstepB, voffB);
            PG8_WAIT_V(6); PG8_BAR; PG8_MMA(1, 1, At, B1); PG8_BAR;
            PG8_LDB(B0, 1, 0); PG8_SCHED; PG8_LDA(At, 1, 0); PG8_STAGE(PG8_SA(0, 1), a2 + hstepA, voffA);
            PG8_WAIT_L(8); PG8_BAR; PG8_WAIT_L(0); PG8_MMA(0, 0, At, B0); PG8_BAR; PG8_SCHED;
            PG8_LDB(B1, 1, 1); PG8_STAGE(PG8_SB(1, 0), b3, voffB);
            PG8_BAR; PG8_WAIT_L(0); PG8_MMA(0, 1, At, B1); PG8_BAR;
            PG8_LDA(At, 1, 1); PG8_STAGE(PG8_SA(1, 0), a3, voffA);
            PG8_BAR; PG8_WAIT_L(0); PG8_MMA(1, 0, At, B0); PG8_BAR; PG8_SCHED;
            PG8_STAGE(PG8_SB(1, 1), b3 + hstepB, voffB);
            PG8_WAIT_V(6); PG8_BAR; PG8_MMA(1, 1, At, B1); PG8_BAR;
            }
        }
        if constexpr (ALIGN_EPI) { if (wr == 0) PG8_BAR; }
        E(acc, cur, wr, wc, fr, fq); S.done(cur);
        if (!has_next) break;
#pragma unroll
        for (int a = 0; a < 2; ++a)
#pragma unroll
            for (int b = 0; b < 2; ++b)
#pragma unroll
                for (int m = 0; m < 4; ++m)
#pragma unroll
                    for (int n = 0; n < 2; ++n) acc[a][b][m][n] = (f32x4){0.f, 0.f, 0.f, 0.f};
        cur = nxt; cA = nA; cB = nB; ++ui;
        if constexpr (ALIGN_EPI) { if (wr == 1) PG8_BAR; }
    }
    PG8_WAIT_V(0);
    if constexpr (!ALIGN_EPI) { if (wr == 0) PG8_BAR; }
    PG8_BAR;
#undef PG8_SA
#undef PG8_SB
#undef PG8_STAGE
#undef PG8_LDA
#undef PG8_LDB
#undef PG8_MMA
#undef PG8_WAIT_V
#undef PG8_WAIT_L
#undef PG8_BAR
#undef PG8_SCHED
}

__device__ __forceinline__ u32x4 pack8(f32x4 v0, f32x4 v1) { u32x4 w; w.x = pk2(v0[0], v0[1]); w.y = pk2(v0[2], v0[3]); w.z = pk2(v1[0], v1[1]); w.w = pk2(v1[2], v1[3]); return w; }
__device__ __forceinline__ void unpack8(u32x4 w, f32x4& v0, f32x4& v1) { v0 = (f32x4){bflo(w.x), bfhi(w.x), bflo(w.y), bfhi(w.y)}; v1 = (f32x4){bflo(w.z), bfhi(w.z), bflo(w.w), bfhi(w.w)}; }

struct EpiProj {
    static constexpr bool PERM = true;
    bf16_t* P; float* ALR;
    __device__ __forceinline__ void operator()(const f32x4 (&acc)[2][2][4][2], const Unit& u, int wr, int wc, int fr, int fq) const {
        const int row0 = u.pm * BM + wr * 64 + fr; const int pn = u.pn; const int cl = wc * 32 + 8 * fq;
        if (pn == 20) {
            if (wc == 0 && fq < 2) {
#pragma unroll
                for (int ai = 0; ai < 2; ++ai)
#pragma unroll
                    for (int m = 0; m < 4; ++m) { float* rp = ALR + (size_t)(row0 + ai * HALF + m * 16) * 16 + 8 * fq;
                        *(f32x4*)rp = acc[ai][0][m][0]; *(f32x4*)(rp + 4) = acc[ai][0][m][1]; }
            }
            return;
        }
        const int mode = pn < 8 ? 0 : (pn < 12 ? 1 : 2);
#pragma unroll
        for (int ai = 0; ai < 2; ++ai)
#pragma unroll
            for (int m = 0; m < 4; ++m) { bf16_t* rowp = P + (size_t)(row0 + ai * HALF + m * 16) * PLD + pn * BM + cl;
#pragma unroll
                for (int bj = 0; bj < 2; ++bj) { f32x4 v0 = acc[ai][bj][m][0], v1 = acc[ai][bj][m][1];
                    if (mode == 1) {
#pragma unroll
                        for (int i = 0; i < 4; ++i) { v0[i] = gelu_tanh(v0[i]); v1[i] = gelu_tanh(v1[i]); }
                    } else if (mode == 2) {
#pragma unroll
                        for (int i = 0; i < 4; ++i) { v0[i] = sigmoidf_(v0[i]); v1[i] = sigmoidf_(v1[i]); }
                    }
                    *(u32x4*)(rowp + bj * HALF) = pack8(v0, v1); } }
    }
};
struct EpiBrA {
    static constexpr bool PERM = true;
    bf16_t* P;
    __device__ __forceinline__ void operator()(const f32x4 (&acc)[2][2][4][2], const Unit& u, int wr, int wc, int fr, int fq) const {
        const int row0 = u.pm * BM + wr * 64 + fr; const int c0 = u.pn * BM + wc * 32 + 8 * fq;
#pragma unroll
        for (int ai = 0; ai < 2; ++ai)
#pragma unroll
            for (int m = 0; m < 4; ++m) { bf16_t* rowp = P + (size_t)(row0 + ai * HALF + m * 16) * PLD;
#pragma unroll
                for (int bj = 0; bj < 2; ++bj) { const int c = c0 + bj * HALF; f32x4 g0, g1; unpack8(*(const u32x4*)(rowp + PC_GA + c), g0, g1);
                    *(u32x4*)(rowp + PC_MRG + c) = pack8(acc[ai][bj][m][0] * g0, acc[ai][bj][m][1] * g1); } }
    }
};
struct EpiBrB {
    static constexpr bool PERM = true;
    bf16_t* P;
    __device__ __forceinline__ void operator()(const f32x4 (&acc)[2][2][4][2], const Unit& u, int wr, int wc, int fr, int fq) const {
        const int row0 = u.pm * BM + wr * 64 + fr; const int c0 = u.pn * BM + wc * 32 + 8 * fq;
#pragma unroll
        for (int ai = 0; ai < 2; ++ai)
#pragma unroll
            for (int m = 0; m < 4; ++m) { bf16_t* rowp = P + (size_t)(row0 + ai * HALF + m * 16) * PLD;
#pragma unroll
                for (int bj = 0; bj < 2; ++bj) { const int c = c0 + bj * HALF; f32x4 g0, g1, p0, p1; unpack8(*(const u32x4*)(rowp + PC_GB + c), g0, g1); unpack8(*(const u32x4*)(rowp + PC_MRG + c), p0, p1);
                    *(u32x4*)(rowp + PC_MRG + c) = pack8(p0 + acc[ai][bj][m][0] * g0, p1 + acc[ai][bj][m][1] * g1); } }
    }
};
struct EpiOut {
    static constexpr bool PERM = true;
    const float* X; float* O;
    __device__ __forceinline__ void operator()(const f32x4 (&acc)[2][2][4][2], const Unit& u, int wr, int wc, int fr, int fq) const {
        const int row0 = u.pm * BM + wr * 64 + fr; const int c0 = u.pn * BM + wc * 32 + 8 * fq;
#pragma unroll
        for (int ai = 0; ai < 2; ++ai)
#pragma unroll
            for (int m = 0; m < 4; ++m) { const size_t ro = (size_t)(row0 + ai * HALF + m * 16) * D;
#pragma unroll
                for (int bj = 0; bj < 2; ++bj) { const int c = c0 + bj * HALF;
                    const f32x4 x0 = *(const f32x4*)(X + ro + c), x1 = *(const f32x4*)(X + ro + c + 4);
                    *(f32x4*)(O + ro + c) = x0 + acc[ai][bj][m][0]; *(f32x4*)(O + ro + c + 4) = x1 + acc[ai][bj][m][1]; } }
    }
};
struct EpiScores {
    static constexpr bool PERM = true;
    float* SC;
    __device__ __forceinline__ void operator()(const f32x4 (&acc)[2][2][4][2], const Unit& u, int wr, int wc, int fr, int fq) const {
        const int tb0 = u.pm * 16 + wr * 4; const int cq0 = (u.pn * BM + wc * 32 + 8 * fq) >> 2;
#pragma unroll
        for (int ai = 0; ai < 2; ++ai)
#pragma unroll
            for (int m = 0; m < 4; ++m) { float* bp = SC + ((size_t)(tb0 + ai * 8 + m) * 512) * 64 + fr * 4;
#pragma unroll
                for (int bj = 0; bj < 2; ++bj)
#pragma unroll
                    for (int n = 0; n < 2; ++n) *(f32x4*)(bp + (size_t)(cq0 + bj * 32 + n) * 64) = acc[ai][bj][m][n]; }
    }
};
}

#define XB_TMO      128
#define XB_XCNT(j)  (256  + 64 * (j))
#define XB_XSUB(j)  (1280 + 64 * (j))
#define XB_XGEN(j)  (2304 + 64 * (j))
#define XB_TOP      3328
#define XB_TOPGEN   3392
#define XCD_BAR_WORDS 3456
#define XB_SPIN_CAP (1u << 18)
__device__ __forceinline__ unsigned xb_ld(unsigned* p)              { return __hip_atomic_load(p, __ATOMIC_RELAXED, __HIP_MEMORY_SCOPE_AGENT); }
__device__ __forceinline__ unsigned xb_add(unsigned* p, unsigned v) { return __hip_atomic_fetch_add(p, v, __ATOMIC_RELAXED, __HIP_MEMORY_SCOPE_AGENT); }
__device__ __forceinline__ unsigned xb_xcc_id() { return (unsigned)__builtin_amdgcn_s_getreg((3 << 11) | 20) & 0xFu; }
#define XB_SPIN(cond, bar) do { unsigned _sp = 0; while (cond) { __builtin_amdgcn_s_sleep(1); \
    if ((++_sp & 255u) == 0u) { if (xb_ld(&(bar)[XB_TMO])) break; if (_sp > XB_SPIN_CAP) { atomicAdd(&(bar)[XB_TMO], 1u); break; } } } } while (0)
struct XcdBarrier { unsigned* bar; unsigned x; volatile LAS unsigned* st; };
__device__ __forceinline__ XcdBarrier xcd_barrier_post(unsigned* bar, volatile LAS unsigned* st) {
    XcdBarrier b; b.bar = bar; b.x = xb_xcc_id(); b.st = st;
    if (threadIdx.x == 0) (void)xb_add(&bar[XB_XCNT(b.x)], 1u);
    return b;
}
__device__ __forceinline__ void xcd_barrier_complete(unsigned* bar, unsigned x, unsigned& nloc, unsigned& nx) {
    const unsigned G = gridDim.x * gridDim.y * gridDim.z;
    unsigned sum, cnt, mine, sp = 0u;
    for (;;) {
        sum = 0u; cnt = 0u; mine = 0u;
#pragma unroll
        for (unsigned j = 0; j < 16; ++j) { const unsigned c = xb_ld(&bar[XB_XCNT(j)]); sum += c; cnt += (c > 0u) ? 1u : 0u; mine = (j == x) ? c : mine; }
        if (sum == G) break;
        __builtin_amdgcn_s_sleep(1);
        if ((++sp & 255u) == 0u) { if (xb_ld(&bar[XB_TMO])) break; if (sp > XB_SPIN_CAP) { atomicAdd(&bar[XB_TMO], 1u); break; } }
    }
    nloc = mine > 0u ? mine : 1u; nx = cnt > 0u ? cnt : 1u;
}
__device__ __forceinline__ void xcd_barrier(const XcdBarrier& b) {
    asm volatile("s_waitcnt vmcnt(0)" ::: "memory");
    __syncthreads();
    if (threadIdx.x == 0) {
        unsigned* bar = b.bar;
        __builtin_amdgcn_s_waitcnt(0);
        unsigned nloc = b.st[0], nx = b.st[1];
        if (nloc == 0u) { xcd_barrier_complete(bar, b.x, nloc, nx); b.st[0] = nloc; b.st[1] = nx; }
        const unsigned old = xb_add(&bar[XB_XSUB(b.x)], 1u);
        const unsigned gen = old / nloc;
        if (old + 1u == (gen + 1u) * nloc) {
            __builtin_amdgcn_fence(__ATOMIC_RELEASE, "agent");
            asm volatile("s_waitcnt vmcnt(0)" ::: "memory");
            const unsigned og = xb_add(&bar[XB_TOP], 1u);
            const unsigned tg = og / nx;
            if (og + 1u == (tg + 1u) * nx) xb_add(&bar[XB_TOPGEN], 1u);
            else XB_SPIN(xb_ld(&bar[XB_TOPGEN]) == tg, bar);
            __builtin_amdgcn_fence(__ATOMIC_ACQUIRE, "agent");
            xb_add(&bar[XB_XGEN(b.x)], 1u);
            asm volatile("s_waitcnt vmcnt(0)" ::: "memory");
        } else {
            XB_SPIN(xb_ld(&bar[XB_XGEN(b.x)]) == gen, bar);
            __builtin_amdgcn_fence(__ATOMIC_ACQUIRE, "agent");
            asm volatile("s_waitcnt vmcnt(0)" ::: "memory");
        }
    }
    __syncthreads();
}

struct Args {
    const float* in[20]; float* out; unsigned char* ws; int ph_lo, ph_hi, li, pad;
};
enum { I_X = 0, I_N1G, I_WIN, I_WGU, I_BG, I_GLAG, I_SLNG, I_SLNB, I_SW, I_SB, I_WBA, I_WBB, I_WOUT, I_N2G, I_WQ, I_K1, I_K2, I_PU, I_PV, I_FG };

struct Frame {
    LAS unsigned char* lds;
    int tid, lane, wave, G, bid;
};

template <int MODE>
__device__ __forceinline__ void p0_transpose_item(const float* W, int K, int Nsrc, int Ndst, bf16_t* WT, LAS float* scr, int item, int lane) {
    const int nblk = Ndst / 32, kb = item / nblk, nb = item % nblk, k0 = 64 * kb, n0 = 32 * nb;
    const int nd = n0 + (lane & 31);
    int sc = nd; bool valid = true;
    if (MODE == 1) { if (nd < 2048) sc = nd; else if (nd < 5120) sc = nd + 16; else if (nd < 5136) sc = 2048 + (nd - 5120); else { sc = 0; valid = false; } }
#pragma unroll 8
    for (int i = 0; i < 32; ++i) { const int kk = 2 * i + (lane >> 5); const float v = valid ? W[(size_t)(k0 + kk) * Nsrc + sc] : 0.f; scr[kk * 33 + (lane & 31)] = v; }
    LDS_WAIT(); asm volatile("" ::: "memory");
    const int c = lane & 7;
#pragma unroll
    for (int j = 0; j < 4; ++j) { const int n = (lane >> 3) + 8 * j; const LAS float* s = scr + (8 * c) * 33 + n;
        u32x4 o; o.x = pk2(s[0 * 33], s[1 * 33]); o.y = pk2(s[2 * 33], s[3 * 33]); o.z = pk2(s[4 * 33], s[5 * 33]); o.w = pk2(s[6 * 33], s[7 * 33]);
        *(u32x4*)(WT + (size_t)(n0 + n) * K + k0 + 8 * c) = o; }
    LDS_WAIT(); asm volatile("" ::: "memory");
}
template <bool F8, int NB>
__device__ __forceinline__ void rms_rows_to_bf16(int lane, const float* x0, size_t xstride, const float* g, bf16_t* o0, size_t ostride, unsigned* o80 = nullptr, size_t o8stride = 0) {
    f32x4 v[NB][4]; float s[NB];
#pragma unroll
    for (int b = 0; b < NB; ++b) { const f32x4* xr = (const f32x4*)(x0 + b * xstride) + lane;
#pragma unroll
        for (int j = 0; j < 4; ++j) v[b][j] = xr[64 * j]; }
#pragma unroll
    for (int b = 0; b < NB; ++b) { s[b] = 0.f;
#pragma unroll
        for (int j = 0; j < 4; ++j) s[b] += (v[b][j].x * v[b][j].x + v[b][j].y * v[b][j].y) + (v[b][j].z * v[b][j].z + v[b][j].w * v[b][j].w); }
#pragma unroll
    for (int o = 1; o < 64; o <<= 1) {
#pragma unroll
        for (int b = 0; b < NB; ++b) s[b] += __shfl_xor(s[b], o); }
    const f32x4* gr = (const f32x4*)g + lane;
#pragma unroll
    for (int b = 0; b < NB; ++b) { const float rstd = 1.f / sqrtf(s[b] * (1.f / D) + EPS); u32x2* o8 = (u32x2*)(o0 + b * ostride) + lane;
#pragma unroll
        for (int j = 0; j < 4; ++j) { const f32x4 gg = gr[64 * j]; const f32x4 y = v[b][j] * rstd * gg; u32x2 o; o.x = pk2(y.x, y.y); o.y = pk2(y.z, y.w); o8[64 * j] = o;
            if (F8) { int w = 0; w = __builtin_amdgcn_cvt_pk_fp8_f32(bflo(o.x) * 16.f, bfhi(o.x) * 16.f, w, false); w = __builtin_amdgcn_cvt_pk_fp8_f32(bflo(o.y) * 16.f, bfhi(o.y) * 16.f, w, true); (o80 + b * o8stride)[64 * j + lane] = (unsigned)w; } } }
}
__device__ __forceinline__ float wave_max(float v) {
#pragma unroll
    for (int o = 1; o < 64; o <<= 1) v = fmaxf(v, __shfl_xor(v, o));
    return v;
}
template <int NB>
__device__ __forceinline__ void cvt_rows_fp8(int lane, const float* const (&src)[NB], unsigned char* const (&dst16)[NB], float* const (&scale_out)[NB]) {
    f32x4 v[NB][4]; float m[NB];
#pragma unroll
    for (int b = 0; b < NB; ++b) {
#pragma unroll
        for (int j = 0; j < 4; ++j) v[b][j] = *(const GAS f32x4*)(src[b] + 16 * lane + 4 * j); }
#pragma unroll
    for (int b = 0; b < NB; ++b) { m[b] = 0.f;
#pragma unroll
        for (int j = 0; j < 4; ++j) m[b] = fmaxf(m[b], fmaxf(fmaxf(fabsf(v[b][j].x), fabsf(v[b][j].y)), fmaxf(fabsf(v[b][j].z), fabsf(v[b][j].w)))); }
#pragma unroll
    for (int o = 1; o < 64; o <<= 1) {
#pragma unroll
        for (int b = 0; b < NB; ++b) m[b] = fmaxf(m[b], __shfl_xor(m[b], o)); }
#pragma unroll
    for (int b = 0; b < NB; ++b) { const float inv = m[b] > 0.f ? 224.f / m[b] : 0.f, sc = m[b] > 0.f ? m[b] * (1.f / 224.f) : 1.f;
        u32x4 o;
#pragma unroll
        for (int j = 0; j < 4; ++j) { int w = 0; w = __builtin_amdgcn_cvt_pk_fp8_f32(v[b][j].x * inv, v[b][j].y * inv, w, false); w = __builtin_amdgcn_cvt_pk_fp8_f32(v[b][j].z * inv, v[b][j].w * inv, w, true); o[j] = (unsigned)w; }
        *(GAS u32x4*)dst16[b] = o;
        if (lane == 0) *(GAS float*)scale_out[b] = sc; }
}
__device__ __forceinline__ void convert_tables(const Frame& F, const Args& A, int wi, int nw) {
    unsigned char* ws = A.ws; const int gw = wi, NGW = nw;
    int mc = gw;
    for (; mc + 3 * NGW < 2 * NEXP; mc += 4 * NGW) { const int m = mc;
        const float* src[4]; unsigned char* dst[4]; float* sco[4];
#pragma unroll
        for (int b = 0; b < 4; ++b) { const int mm = m + b * NGW;
            if (mm < NEXP) { const int e = mm; src[b] = A.in[I_PU] + (size_t)e * D; dst[b] = ws + WS_U8 + (size_t)((e & 7) * 2048 + (e >> 3)) * 1024 + 16 * F.lane; sco[b] = (float*)(ws + WS_SU) + e; }
            else { const int e = mm - NEXP; src[b] = A.in[I_PV] + (size_t)e * D; dst[b] = ws + WS_V8 + ((size_t)(F.lane >> 3) * NEXP + e) * 128 + 16 * (F.lane & 7); sco[b] = (float*)(ws + WS_SV) + e; } }
        cvt_rows_fp8<4>(F.lane, src, dst, sco);
    }
    for (; mc < 2 * NEXP; mc += NGW) { const float* src[1]; unsigned char* dst[1]; float* sco[1];
        if (mc < NEXP) { const int e = mc; src[0] = A.in[I_PU] + (size_t)e * D; dst[0] = ws + WS_U8 + (size_t)((e & 7) * 2048 + (e >> 3)) * 1024 + 16 * F.lane; sco[0] = (float*)(ws + WS_SU) + e; }
        else { const int e = mc - NEXP; src[0] = A.in[I_PV] + (size_t)e * D; dst[0] = ws + WS_V8 + ((size_t)(F.lane >> 3) * NEXP + e) * 128 + 16 * (F.lane & 7); sco[0] = (float*)(ws + WS_SV) + e; }
        cvt_rows_fp8<1>(F.lane, src, dst, sco); }
}
__device__ __forceinline__ void phase0(const Frame& F, const Args& A) {
    unsigned char* ws = A.ws;
    {
        LAS float* kx = (LAS float*)F.lds;
        LAS float* wt = (LAS float*)(F.lds + 128 * 129 * 4);
        bf16_t* WQF = (bf16_t*)(ws + WS_WQF);
        for (int it = F.bid; it < 512; it += F.G) {
            const int hh = it >> 5, kblk = it & 31, k0 = kblk * 32;
            const float* kX = (hh & 1) ? A.in[I_K2] : A.in[I_K1];
            __syncthreads();
            for (int e = F.tid; e < 128 * 128; e += 512) kx[(e >> 7) * 129 + (e & 127)] = kX[e];
            for (int e = F.tid; e < 32 * 128; e += 512) wt[e] = A.in[I_WQ][(size_t)(k0 + (e >> 7)) * 2048 + hh * 128 + (e & 127)];
            __syncthreads();
            const int key = F.tid & 127, kq = F.tid >> 7;
            float acc[8];
#pragma unroll
            for (int i = 0; i < 8; ++i) acc[i] = 0.f;
            for (int d = 0; d < 128; ++d) { const float b = kx[key * 129 + d];
#pragma unroll
                for (int i = 0; i < 8; ++i) acc[i] += wt[(kq * 8 + i) * 128 + d] * b; }
            u32x4 o; o.x = pk2(acc[0], acc[1]); o.y = pk2(acc[2], acc[3]); o.z = pk2(acc[4], acc[5]); o.w = pk2(acc[6], acc[7]);
            *(u32x4*)(WQF + (size_t)(hh * 128 + key) * 1024 + k0 + kq * 8) = o;
        }
        __syncthreads();
    }
    LAS float* scr = (LAS float*)(F.lds + F.wave * 16384);
    const int gw = F.bid * NWAVES + F.wave, NGW = F.G * NWAVES;
    constexpr int I_IN = 16 * (NPROJ / 32), I_A = 8 * 32, I_B = 8 * 32, I_O = 16 * 32;
    constexpr int NITEMS = I_IN + I_A + I_B + I_O;
    for (int it = gw; it < NITEMS; it += NGW) {
        int r = it;
        if (r < I_IN) { p0_transpose_item<1>(A.in[I_WIN], 1024, 5136, NPROJ, (bf16_t*)(ws + WS_WIN), scr, r, F.lane); continue; } r -= I_IN;
        if (r < I_A) { p0_transpose_item<0>(A.in[I_WBA], 512, 1024, 1024, (bf16_t*)(ws + WS_WA), scr, r, F.lane); continue; } r -= I_A;
        if (r < I_B) { p0_transpose_item<0>(A.in[I_WBB], 512, 1024, 1024, (bf16_t*)(ws + WS_WB), scr, r, F.lane); continue; } r -= I_B;
        p0_transpose_item<0>(A.in[I_WOUT], 1024, 1024, 1024, (bf16_t*)(ws + WS_WOUT), scr, r, F.lane);
    }
    { int m = gw; for (; m + 3 * NGW < T_TOK; m += 4 * NGW) rms_rows_to_bf16<false, 4>(F.lane, A.in[I_X] + (size_t)m * D, (size_t)NGW * D, A.in[I_N1G], (bf16_t*)(ws + WS_N1) + (size_t)m * D, (size_t)NGW * D);
      for (; m < T_TOK; m += NGW) rms_rows_to_bf16<false, 1>(F.lane, A.in[I_X] + (size_t)m * D, 0, A.in[I_N1G], (bf16_t*)(ws + WS_N1) + (size_t)m * D, 0); }
}

__device__ __forceinline__ float log_sigmoid(float z) { return fminf(z, 0.f) - log1pf(__expf(-fabsf(z))); }

template <bool DRY>
__device__ __forceinline__ void gla_chunk_phase(const Frame& F, const Args& A) {
    unsigned char* ws = A.ws;
    const bf16_t* P = (const bf16_t*)(ws + WS_P);
    const float* ALR = (const float*)(ws + WS_ALR);
    LAS float* alr = (LAS float*)F.lds;
    LAS float* tot = (LAS float*)(F.lds + 4096);
    LAS bf16_t* kdT = (LAS bf16_t*)(F.lds + 8192);
    LAS bf16_t* vT = (LAS bf16_t*)(F.lds + 26624);
    LAS bf16_t* stT = (LAS bf16_t*)(F.lds + 45056);
    const int tid = F.tid, kk = tid & 127, seg = tid >> 7;
    const bool hconst = (F.G & 3) == 0;
    int hcur = -1; float w[16]; float bias = 0.f;
#pragma unroll
    for (int j = 0; j < 16; ++j) w[j] = 0.f;
    float na0, na1; bf16_t nk[16], nv[16];
#define GC_LOAD(unit) do { const int h_ = (unit) & 3, c_ = ((unit) >> 2) & 63, b_ = (unit) >> 8; const int t0_ = b_ * SEQ + c_ * 64; \
        na0 = ALR[(size_t)t0_ * 16 + tid]; na1 = ALR[(size_t)t0_ * 16 + 512 + tid]; \
        const bf16_t* kp_ = P + (size_t)(t0_ + 16 * seg) * PLD + PC_K + h_ * 128 + kk; const bf16_t* vp_ = P + (size_t)(t0_ + 16 * seg) * PLD + PC_V + h_ * 128 + kk; \
        _Pragma("unroll") for (int i_ = 0; i_ < 16; ++i_) { nk[i_] = kp_[(size_t)i_ * PLD]; nv[i_] = vp_[(size_t)i_ * PLD]; } } while (0)
    int unit = F.bid;
    if (unit < 2048) GC_LOAD(unit);
    for (; unit < 2048; unit += F.G) {
        const int h = unit & 3;
        if (h != hcur) { hcur = h;
#pragma unroll
            for (int j = 0; j < 16; ++j) w[j] = A.in[I_WGU][(size_t)j * 512 + h * 128 + kk];
            bias = A.in[I_BG][h * 128 + kk]; }
        __syncthreads();
        alr[tid] = na0; alr[512 + tid] = na1;
        bf16_t kr[16], vr[16];
#pragma unroll
        for (int i = 0; i < 16; ++i) { kr[i] = nk[i]; vr[i] = nv[i]; }
        if (unit + F.G < 2048) GC_LOAD(unit + F.G);
        __syncthreads();
        float cum[16]; float run = 0.f;
#pragma unroll
        for (int i = 0; i < 16; ++i) { const LAS f32x4* ap = (const LAS f32x4*)(alr + (16 * seg + i) * 16); float z = bias;
#pragma unroll
            for (int q = 0; q < 4; ++q) { const f32x4 a4 = ap[q]; z += a4.x * w[4 * q] + a4.y * w[4 * q + 1] + a4.z * w[4 * q + 2] + a4.w * w[4 * q + 3]; }
            const float ls = fminf(z, 0.f) - __logf(1.f + __expf(-fabsf(z)));
            run += ls * (1.f / 16.f); cum[i] = run; }
        tot[seg * 128 + kk] = run;
        __syncthreads();
        {
            const float t0s = tot[kk], t1s = tot[128 + kk], t2s = tot[256 + kk], t3s = tot[384 + kk];
            const float total = (t0s + t1s) + (t2s + t3s);
            const float prefix = seg == 0 ? 0.f : (seg == 1 ? t0s : (seg == 2 ? t0s + t1s : t0s + t1s + t2s));
            unsigned kw[8], vw[8];
#pragma unroll
            for (int i = 0; i < 8; ++i) {
                const float e0 = __expf(total - (prefix + cum[2 * i])), e1 = __expf(total - (prefix + cum[2 * i + 1]));
                kw[i] = pk2(bf1(kr[2 * i]) * e0, bf1(kr[2 * i + 1]) * e1); vw[i] = (unsigned)vr[2 * i] | ((unsigned)vr[2 * i + 1] << 16);
            }
            *(LAS u32x4*)(kdT + kk * 72 + 16 * seg) = (u32x4){kw[0], kw[1], kw[2], kw[3]}; *(LAS u32x4*)(kdT + kk * 72 + 16 * seg + 8) = (u32x4){kw[4], kw[5], kw[6], kw[7]};
            *(LAS u32x4*)(vT + kk * 72 + 16 * seg) = (u32x4){vw[0], vw[1], vw[2], vw[3]}; *(LAS u32x4*)(vT + kk * 72 + 16 * seg + 8) = (u32x4){vw[4], vw[5], vw[6], vw[7]};
            if (seg == 0) ((float*)(DRY ? (unsigned char*)A.out + 96 * MiB : ws + WS_DEC))[(size_t)unit * 128 + kk] = __expf(total);
        }
        __syncthreads();
        {
            const int w8 = F.wave, l = F.lane, fr = l & 15, fq = l >> 4;
            f32x4 acc[8];
#pragma unroll
            for (int n = 0; n < 8; ++n) acc[n] = (f32x4){0.f, 0.f, 0.f, 0.f};
#pragma unroll
            for (int ks = 0; ks < 2; ++ks) {
                const bf16x8 a = *(const LAS bf16x8*)(kdT + (16 * w8 + fr) * 72 + 32 * ks + 8 * fq);
#pragma unroll
                for (int n = 0; n < 8; ++n) { const bf16x8 bb = *(const LAS bf16x8*)(vT + (16 * n + fr) * 72 + 32 * ks + 8 * fq);
                    acc[n] = __builtin_amdgcn_mfma_f32_16x16x32_bf16(a, bb, acc[n], 0, 0, 0); }
            }
#pragma unroll
            for (int n = 0; n < 8; ++n) { u32x2 o; o.x = pk2(acc[n][0], acc[n][1]); o.y = pk2(acc[n][2], acc[n][3]);
                *(LAS u32x2*)(stT + (16 * n + fr) * 136 + 16 * w8 + 4 * fq) = o; }
        }
        __syncthreads();
        {
            bf16_t* ST = (bf16_t*)(DRY ? (unsigned char*)A.out : ws + WS_N1) + (size_t)unit * 16384;
            const int vv = tid >> 2, part = tid & 3;
#pragma unroll
            for (int q = 0; q < 4; ++q) *(u32x4*)(ST + (size_t)vv * 128 + 32 * part + 8 * q) = *(const LAS u32x4*)(stT + vv * 136 + 32 * part + 8 * q);
        }
    }
#undef GC_LOAD
    (void)hconst;
}

template <bool DRY>
__device__ __forceinline__ void sgu_unit(const Frame& F, const Args& A, int unit) {
    const int g = unit & 3, blk = (unit >> 2) & 31, b = unit >> 7;
    const int t0 = b * SEQ + blk * 128;
    bf16_t* P = (bf16_t*)(A.ws + WS_P);
    LAS bf16_t* wA = (LAS bf16_t*)F.lds;
    LAS bf16_t* vnT = (LAS bf16_t*)(F.lds + 34816);
    LAS float* st = (LAS float*)(F.lds + 69632);
    LAS bf16_t* suS = (LAS bf16_t*)(F.lds + 70656);
    const int tid = F.tid;
    __syncthreads();
    {
        const int j = tid >> 2, q = tid & 3;
        const bf16_t* sp = P + (size_t)(t0 + j) * PLD + PC_SV + q * 128;
        float s = 0.f, s2 = 0.f;
#pragma unroll
        for (int i = 0; i < 16; ++i) { const u32x4 w = *(const u32x4*)(sp + 8 * i);
            const float f[8] = {bflo(w.x), bfhi(w.x), bflo(w.y), bfhi(w.y), bflo(w.z), bfhi(w.z), bflo(w.w), bfhi(w.w)};
#pragma unroll
            for (int e = 0; e < 8; ++e) { s += f[e]; s2 += f[e] * f[e]; } }
        s += __shfl_xor(s, 1); s += __shfl_xor(s, 2); s2 += __shfl_xor(s2, 1); s2 += __shfl_xor(s2, 2);
        const float mu = s * (1.f / 512.f); const float var = fmaxf(s2 * (1.f / 512.f) - mu * mu, 0.f);
        if (q == 0) { st[2 * j] = mu; st[2 * j + 1] = 1.f / sqrtf(var + EPS); }
    }
    {
        const int i = tid >> 2, jb = (tid & 3) * 32;
        const float* wp = A.in[I_SW] + (size_t)g * 16384 + (size_t)i * 128 + jb;
        const bf16_t* sup = P + (size_t)(t0 + i) * PLD + PC_SU + g * 128 + jb;
#pragma unroll
        for (int q = 0; q < 4; ++q) { const f32x4 a = *(const f32x4*)(wp + 8 * q), bq = *(const f32x4*)(wp + 8 * q + 4);
            const bool z = (i < 64) && (jb + 8 * q >= 64);
            u32x4 o; o.x = pk2(a.x, a.y); o.y = pk2(a.z, a.w); o.z = pk2(bq.x, bq.y); o.w = pk2(bq.z, bq.w);
            if (z) o = (u32x4){0u, 0u, 0u, 0u};
            *(LAS u32x4*)(wA + i * 136 + jb + 8 * q) = o;
            *(LAS u32x4*)(suS + i * 136 + jb + 8 * q) = *(const u32x4*)(sup + 8 * q); }
    }
    const int cch = tid & 127, seg = tid >> 7;
    bf16_t xr[32];
    { const bf16_t* sp = P + (size_t)(t0 + 32 * seg) * PLD + PC_SV + g * 128 + cch;
#pragma unroll
      for (int i = 0; i < 32; ++i) xr[i] = sp[(size_t)i * PLD]; }
    const float lg = A.in[I_SLNG][g * 128 + cch], lb = A.in[I_SLNB][g * 128 + cch];
    __syncthreads();
    {
        unsigned ow[16];
#pragma unroll
        for (int i = 0; i < 16; ++i) { const int j = 32 * seg + 2 * i; const f32x4 ms = *(const LAS f32x4*)(st + 2 * j);
            ow[i] = pk2((bf1(xr[2 * i]) - ms.x) * ms.y * lg + lb, (bf1(xr[2 * i + 1]) - ms.z) * ms.w * lg + lb); }
#pragma unroll
        for (int q = 0; q < 4; ++q) *(LAS u32x4*)(vnT + cch * 136 + 32 * seg + 8 * q) = (u32x4){ow[4 * q], ow[4 * q + 1], ow[4 * q + 2], ow[4 * q + 3]};
    }
    __syncthreads();
    {
        const int w = F.wave, l = F.lane, fr = l & 15, fq = l >> 4;
        f32x4 acc[8];
#pragma unroll
        for (int n = 0; n < 8; ++n) acc[n] = (f32x4){0.f, 0.f, 0.f, 0.f};
#pragma unroll
        for (int ks = 0; ks < 4; ++ks) {
            const bf16x8 a = *(const LAS bf16x8*)(wA + (16 * w + fr) * 136 + 32 * ks + 8 * fq);
#pragma unroll
            for (int n = 0; n < 8; ++n) { const bf16x8 bb = *(const LAS bf16x8*)(vnT + (16 * n + fr) * 136 + 32 * ks + 8 * fq);
                acc[n] = __builtin_amdgcn_mfma_f32_16x16x32_bf16(a, bb, acc[n], 0, 0, 0); }
        }
#pragma unroll
        for (int jj = 0; jj < 4; ++jj) { const int i = 16 * w + 4 * fq + jj; const float bias = A.in[I_SB][g * 128 + i];
            LAS bf16_t* rp = suS + i * 136 + fr;
#pragma unroll
            for (int n = 0; n < 8; ++n) { const float su = bf1(rp[16 * n]); rp[16 * n] = (bf16_t)f2bf(su * (acc[n][jj] + bias)); } }
    }
    __syncthreads();
    {
        const int i = tid >> 2, jb = (tid & 3) * 32;
        bf16_t* yp = DRY ? (bf16_t*)A.out + (size_t)(t0 + i) * 512 + g * 128 + jb : P + (size_t)(t0 + i) * PLD + PC_SU + g * 128 + jb;
#pragma unroll
        for (int q = 0; q < 4; ++q) *(u32x4*)(yp + 8 * q) = *(const LAS u32x4*)(suS + i * 136 + jb + 8 * q);
    }
}

template <bool DRY>
__device__ __forceinline__ void gla_scan(const Frame& F, const Args& A) {
    bf16_t* ST = (bf16_t*)(A.ws + WS_N1); bf16_t* STO = DRY ? (bf16_t*)A.out : ST; const float* DEC = (const float*)(A.ws + WS_DEC);
    for (int gi = F.bid * 512 + F.tid; gi < 131072; gi += F.G * 512) {
        const int k4 = gi & 31, vv = (gi >> 5) & 127, h = (gi >> 12) & 3, b = gi >> 14;
        float s0 = 0.f, s1 = 0.f, s2 = 0.f, s3 = 0.f;
        u32x2 wa[8], wb[8]; f32x4 da[8], db[8];
#define SCAN_LOAD(W, Dd, c0) do { _Pragma("unroll") for (int i_ = 0; i_ < 8; ++i_) { const size_t u_ = (size_t)((b * 64 + (c0) + i_) * 4 + h); \
            W[i_] = *(const u32x2*)(ST + u_ * 16384 + (size_t)vv * 128 + k4 * 4); Dd[i_] = *(const f32x4*)(DEC + u_ * 128 + k4 * 4); } } while (0)
#define SCAN_STEP(W, Dd, c0) do { _Pragma("unroll") for (int i_ = 0; i_ < 8; ++i_) { const size_t u_ = (size_t)((b * 64 + (c0) + i_) * 4 + h); \
            s0 = Dd[i_].x * s0 + bflo(W[i_].x); s1 = Dd[i_].y * s1 + bfhi(W[i_].x); s2 = Dd[i_].z * s2 + bflo(W[i_].y); s3 = Dd[i_].w * s3 + bfhi(W[i_].y); \
            u32x2 o_; o_.x = pk2(s0, s1); o_.y = pk2(s2, s3); *(u32x2*)(STO + u_ * 16384 + (size_t)vv * 128 + k4 * 4) = o_; } } while (0)
        SCAN_LOAD(wa, da, 0);
#pragma unroll
        for (int c0 = 0; c0 < 64; c0 += 16) {
            SCAN_LOAD(wb, db, c0 + 8);
            SCAN_STEP(wa, da, c0);
            if (c0 + 16 < 64) SCAN_LOAD(wa, da, c0 + 16);
            SCAN_STEP(wb, db, c0 + 8);
        }
#undef SCAN_LOAD
#undef SCAN_STEP
    }
}

template <bool DRY>
__device__ __forceinline__ void gla_out_phase(const Frame& F, const Args& A) {
    bf16_t* P = (bf16_t*)(A.ws + WS_P);
    LAS bf16_t* qA = (LAS bf16_t*)F.lds;
    LAS bf16_t* sB = (LAS bf16_t*)(F.lds + 17408);
    LAS float* oF = (LAS float*)(F.lds + 52224);
    const int tid = F.tid, s = tid >> 3, cb = (tid & 7) * 16, vv = tid >> 2, kb = (tid & 3) * 32;
    u32x4 nq0, nq1, ns0, ns1, ns2, ns3, nr0, nr1;
#define GO_LOAD(unit) do { const int h_ = (unit) & 3, c_ = ((unit) >> 2) & 63, b_ = (unit) >> 8; const int t0_ = b_ * SEQ + c_ * 64; \
        const bf16_t* qp_ = P + (size_t)(t0_ + s) * PLD + PC_Q + h_ * 128 + cb; nq0 = *(const u32x4*)qp_; nq1 = *(const u32x4*)(qp_ + 8); \
        const bf16_t* sp_ = (const bf16_t*)(A.ws + WS_N1) + (size_t)(unit) * 16384 + (size_t)vv * 128 + kb; ns0 = *(const u32x4*)sp_; ns1 = *(const u32x4*)(sp_ + 8); ns2 = *(const u32x4*)(sp_ + 16); ns3 = *(const u32x4*)(sp_ + 24); \
        const bf16_t* rp_ = P + (size_t)(t0_ + s) * PLD + PC_R + h_ * 128 + cb; nr0 = *(const u32x4*)rp_; nr1 = *(const u32x4*)(rp_ + 8); } while (0)
    int unit = F.bid;
    if (unit < 2048) GO_LOAD(unit);
    for (; unit < 2048; unit += F.G) {
        const int h = unit & 3, c = (unit >> 2) & 63, b = unit >> 8;
        const int t0 = b * SEQ + c * 64;
        __syncthreads();
        *(LAS u32x4*)(qA + s * 136 + cb) = nq0; *(LAS u32x4*)(qA + s * 136 + cb + 8) = nq1;
        *(LAS u32x4*)(sB + vv * 136 + kb) = ns0; *(LAS u32x4*)(sB + vv * 136 + kb + 8) = ns1; *(LAS u32x4*)(sB + vv * 136 + kb + 16) = ns2; *(LAS u32x4*)(sB + vv * 136 + kb + 24) = ns3;
        const u32x4 r0 = nr0, r1 = nr1;
        if (unit + F.G < 2048) GO_LOAD(unit + F.G);
        __syncthreads();
        {
            const int w = F.wave, l = F.lane, fr = l & 15, fq = l >> 4, m = w & 3, nh = w >> 2;
            f32x4 acc[4];
#pragma unroll
            for (int n = 0; n < 4; ++n) acc[n] = (f32x4){0.f, 0.f, 0.f, 0.f};
#pragma unroll
            for (int ks = 0; ks < 4; ++ks) {
                const bf16x8 a = *(const LAS bf16x8*)(qA + (16 * m + fr) * 136 + 32 * ks + 8 * fq);
#pragma unroll
                for (int n = 0; n < 4; ++n) { const bf16x8 bb = *(const LAS bf16x8*)(sB + (16 * (4 * nh + n) + fr) * 136 + 32 * ks + 8 * fq);
                    acc[n] = __builtin_amdgcn_mfma_f32_16x16x32_bf16(a, bb, acc[n], 0, 0, 0); }
            }
            const float scale = 0.08838834764831845f;
#pragma unroll
            for (int n = 0; n < 4; ++n)
#pragma unroll
                for (int jj = 0; jj < 4; ++jj) oF[(16 * m + 4 * fq + jj) * 132 + 16 * (4 * nh + n) + fr] = acc[n][jj] * scale;
        }
        __syncthreads();
        {
            float o[16]; float ss = 0.f;
#pragma unroll
            for (int i = 0; i < 16; ++i) { o[i] = oF[s * 132 + cb + i]; ss += o[i] * o[i]; }
            ss += __shfl_xor(ss, 1); ss += __shfl_xor(ss, 2); ss += __shfl_xor(ss, 4);
            const float rstd = 1.f / sqrtf(ss * (1.f / 128.f) + EPS);
            const unsigned rw[8] = {r0.x, r0.y, r0.z, r0.w, r1.x, r1.y, r1.z, r1.w};
            const float* gg = A.in[I_GLAG] + h * 128 + cb;
            unsigned ow[8];
#pragma unroll
            for (int i = 0; i < 8; ++i) { const float y0 = o[2 * i] * rstd * gg[2 * i] * siluf_(bflo(rw[i])), y1 = o[2 * i + 1] * rstd * gg[2 * i + 1] * siluf_(bfhi(rw[i])); ow[i] = pk2(y0, y1); }
            bf16_t* yp = DRY ? (bf16_t*)A.out + (size_t)(t0 + s) * 512 + h * 128 + cb : P + (size_t)(t0 + s) * PLD + PC_Q + h * 128 + cb;
            *(u32x4*)yp = (u32x4){ow[0], ow[1], ow[2], ow[3]}; *(u32x4*)(yp + 8) = (u32x4){ow[4], ow[5], ow[6], ow[7]};
        }
    }
#undef GO_LOAD
}

__device__ __forceinline__ unsigned ordkey(float v) { const unsigned u = __builtin_bit_cast(unsigned, v); return u ^ ((unsigned)((int)u >> 31) | 0x80000000u); }
__device__ __forceinline__ float unord(unsigned k) { const unsigned u = (k & 0x80000000u) ? (k & 0x7fffffffu) : ~k; return __builtin_bit_cast(float, u); }
#define INS16(r, xin) do { unsigned _x = (xin); _Pragma("unroll") for (int _i = 0; _i < 16; ++_i) { const unsigned _h = max((r)[_i], _x); _x = min((r)[_i], _x); (r)[_i] = _h; } } while (0)

#define CE(a, b) do { const unsigned _h = max((a), (b)), _l = min((a), (b)); (a) = _h; (b) = _l; } while (0)
#define SORT16(v) do { CE(v[0], v[1]); CE(v[2], v[3]); CE(v[0], v[2]); CE(v[1], v[3]); CE(v[1], v[2]); CE(v[4], v[5]); CE(v[6], v[7]); CE(v[4], v[6]); CE(v[5], v[7]); CE(v[5], v[6]); CE(v[0], v[4]); CE(v[2], v[6]); CE(v[2], v[4]); CE(v[1], v[5]); CE(v[3], v[7]); CE(v[3], v[5]); CE(v[1], v[2]); CE(v[3], v[4]); CE(v[5], v[6]); CE(v[8], v[9]); CE(v[10], v[11]); CE(v[8], v[10]); CE(v[9], v[11]); CE(v[9], v[10]); CE(v[12], v[13]); CE(v[14], v[15]); CE(v[12], v[14]); CE(v[13], v[15]); CE(v[13], v[14]); CE(v[8], v[12]); CE(v[10], v[14]); CE(v[10], v[12]); CE(v[9], v[13]); CE(v[11], v[15]); CE(v[11], v[13]); CE(v[9], v[10]); CE(v[11], v[12]); CE(v[13], v[14]); CE(v[0], v[8]); CE(v[4], v[12]); CE(v[4], v[8]); CE(v[2], v[10]); CE(v[6], v[14]); CE(v[6], v[10]); CE(v[2], v[4]); CE(v[6], v[8]); CE(v[10], v[12]); CE(v[1], v[9]); CE(v[5], v[13]); CE(v[5], v[9]); CE(v[3], v[11]); CE(v[7], v[15]); CE(v[7], v[11]); CE(v[3], v[5]); CE(v[7], v[9]); CE(v[11], v[13]); CE(v[1], v[2]); CE(v[3], v[4]); CE(v[5], v[6]); CE(v[7], v[8]); CE(v[9], v[10]); CE(v[11], v[12]); CE(v[13], v[14]); } while (0)
#define MERGE16(T, S) do { _Pragma("unroll") for (int _i = 0; _i < 16; ++_i) (T)[_i] = max((T)[_i], (S)[15 - _i]); \
    _Pragma("unroll") for (int _d = 8; _d >= 1; _d >>= 1) { _Pragma("unroll") for (int _i = 0; _i < 16; ++_i) if ((_i & _d) == 0) CE((T)[_i], (T)[_i + _d]); } } while (0)
__device__ __forceinline__ void peer_topk(const Frame& F, const Args& A) {
    const float* SC = (const float*)(A.ws + WS_P + P_SC);
    int* IDX = (int*)(A.ws + WS_P + P_IDX); float* GATE = (float*)(A.ws + WS_P + P_GATE);
    const int gw = F.bid * NWAVES + F.wave, NGW = F.G * NWAVES;
    for (int it = gw; it < 512 * 8; it += NGW) {
        const int h = it & 7, tb = it >> 3; const int tok = tb * 64 + F.lane;
        unsigned r1[16], r2[16], rc[16];
        const float* p1 = SC + ((size_t)(tok >> 4) * 512 + h * 64) * 64 + (tok & 15) * 4; const float* p2 = p1 + 32 * 64;
        {
            float raw[128]; unsigned sg[16];
#pragma unroll
            for (int jq = 0; jq < 32; ++jq) { const f32x4 t4 = *(const f32x4*)(p1 + jq * 64); raw[4 * jq] = t4.x; raw[4 * jq + 1] = t4.y; raw[4 * jq + 2] = t4.z; raw[4 * jq + 3] = t4.w; }
#pragma unroll
            for (int j = 0; j < 16; ++j) r1[j] = (ordkey(raw[j]) & ~127u) | (unsigned)(127 - j);
            SORT16(r1);
#pragma unroll
            for (int gq = 1; gq < 8; ++gq) {
#pragma unroll
                for (int j = 0; j < 16; ++j) sg[j] = (ordkey(raw[16 * gq + j]) & ~127u) | (unsigned)(127 - (16 * gq + j));
                SORT16(sg); MERGE16(r1, sg); }
#pragma unroll
            for (int jq = 0; jq < 32; ++jq) { const f32x4 t4 = *(const f32x4*)(p2 + jq * 64); raw[4 * jq] = t4.x; raw[4 * jq + 1] = t4.y; raw[4 * jq + 2] = t4.z; raw[4 * jq + 3] = t4.w; }
#pragma unroll
            for (int j = 0; j < 16; ++j) r2[j] = (ordkey(raw[j]) & ~127u) | (unsigned)(127 - j);
            SORT16(r2);
#pragma unroll
            for (int gq = 1; gq < 8; ++gq) {
#pragma unroll
                for (int j = 0; j < 16; ++j) sg[j] = (ordkey(raw[16 * gq + j]) & ~127u) | (unsigned)(127 - (16 * gq + j));
                SORT16(sg); MERGE16(r2, sg); }
        }
        float v1[16], v2[16];
#pragma unroll
        for (int i = 0; i < 16; ++i) { v1[i] = unord((r1[i] & ~127u) | 64u); v2[i] = unord((r2[i] & ~127u) | 64u); }
        {
            unsigned cg[4][16]; int cn = 0;
#pragma unroll
            for (int a = 0; a < 16; ++a)
#pragma unroll
                for (int bq = 0; bq < 16; ++bq) if ((a + 1) * (bq + 1) <= 16) { cg[cn >> 4][cn & 15] = (ordkey(v1[a] + v2[bq]) & ~255u) | (unsigned)(a * 16 + bq); ++cn; }
#pragma unroll
            for (int z = 50; z < 64; ++z) cg[z >> 4][z & 15] = 0u;
            SORT16(cg[0]); SORT16(cg[1]); SORT16(cg[2]); SORT16(cg[3]);
            MERGE16(cg[0], cg[1]); MERGE16(cg[0], cg[2]); MERGE16(cg[0], cg[3]);
#pragma unroll
            for (int i = 0; i < 16; ++i) rc[i] = cg[0][i];
        }
        float val[16]; int ex[16];
        {
            LAS unsigned* t1 = (LAS unsigned*)(F.lds + F.wave * 8704) + F.lane * 17; LAS unsigned* t2 = t1 + 64 * 17;
#pragma unroll
            for (int i = 0; i < 16; ++i) { t1[i] = r1[i]; t2[i] = r2[i]; }
            LDS_WAIT(); asm volatile("" ::: "memory");
#pragma unroll
            for (int w = 0; w < 16; ++w) {
                const int a = (rc[w] >> 4) & 15, bq = rc[w] & 15;
                const unsigned k1 = t1[a], k2 = t2[bq];
                val[w] = unord((k1 & ~127u) | 64u) + unord((k2 & ~127u) | 64u);
                ex[w] = (127 - (int)(k1 & 127u)) * 128 + (127 - (int)(k2 & 127u));
            }
            LDS_WAIT(); asm volatile("" ::: "memory");
        }
        float mx = val[0];
#pragma unroll
        for (int w = 1; w < 16; ++w) mx = fmaxf(mx, val[w]);
        float sum = 0.f;
#pragma unroll
        for (int w = 0; w < 16; ++w) { val[w] = __expf(val[w] - mx); sum += val[w]; }
        const float inv = 1.f / sum;
        int* ip = IDX + (size_t)tok * 128 + h * 16; float* gp = GATE + (size_t)tok * 128 + h * 16;
#pragma unroll
        for (int q = 0; q < 4; ++q) { *(int4*)(ip + 4 * q) = make_int4(ex[4 * q], ex[4 * q + 1], ex[4 * q + 2], ex[4 * q + 3]);
            *(f32x4*)(gp + 4 * q) = (f32x4){val[4 * q] * inv, val[4 * q + 1] * inv, val[4 * q + 2] * inv, val[4 * q + 3] * inv}; }
    }
}

#define DPP_ADD(v, ctrl) ((v) + __builtin_bit_cast(float, __builtin_amdgcn_mov_dpp(__builtin_bit_cast(int, (v)), (ctrl), 0xf, 0xf, true)))
__device__ __forceinline__ void fp8x16_to_f32x2(const u32x4 r, f32x2* f) {
#pragma unroll
    for (int q = 0; q < 4; ++q) { f[2 * q] = __builtin_amdgcn_cvt_pk_f32_fp8((int)r[q], false); f[2 * q + 1] = __builtin_amdgcn_cvt_pk_f32_fp8((int)r[q], true); }
}
__device__ __forceinline__ void fp8x16_to_f32(const u32x4 r, float* f) {
#pragma unroll
    for (int q = 0; q < 4; ++q) { const f32x2 lo = __builtin_amdgcn_cvt_pk_f32_fp8((int)r[q], false), hi = __builtin_amdgcn_cvt_pk_f32_fp8((int)r[q], true);
        f[4 * q] = lo.x; f[4 * q + 1] = lo.y; f[4 * q + 2] = hi.x; f[4 * q + 3] = hi.y; }
}
__device__ __forceinline__ long lo64(u32x4 v) { return (long)(((unsigned long)v.y << 32) | (unsigned long)v.x); }
__device__ __forceinline__ long hi64(u32x4 v) { return (long)(((unsigned long)v.w << 32) | (unsigned long)v.z); }
template <int MODE>
__device__ __forceinline__ void peer_u_phase(const Frame& F, const Args& A) {
    const unsigned char* X8 = A.ws + WS_P + P_X8;
    const unsigned char* U8 = A.ws + WS_U8; const float* SU = (const float*)(A.ws + WS_SU); const float* SV = (const float*)(A.ws + WS_SV);
    const int* IDX = (const int*)(A.ws + WS_P + P_IDX); const float* GATE = (const float*)(A.ws + WS_P + P_GATE); float* AK = (float*)(MODE == 0 ? A.ws + WS_AK : A.ws + WS_P + P_SC);
    const int g = F.bid & 7, nmem = F.G >> 3, l = F.lane, step = nmem * NWAVES;
    const int loff = 64 * (l & 15) + 16 * (l >> 4);
    const bool dg = ((l & 15) >> 2) == (l >> 4); const int dr = l & 3;
    const float dw0 = (dg && dr == 0) ? 1.f : 0.f, dw1 = (dg && dr == 1) ? 1.f : 0.f, dw2 = (dg && dr == 2) ? 1.f : 0.f, dw3 = (dg && dr == 3) ? 1.f : 0.f;
    LAS int* le = (LAS int*)(F.lds + F.wave * 2048); LAS int* lk = le + 256;
    const bool b5 = (l & 32) != 0, b4 = (l & 16) != 0, b3 = (l & 8) != 0;
    int tok = (F.bid >> 3) * NWAVES + F.wave;
    u32x4 nxA, nxB; int neA0, neA1, neB0, neB1; float ngA0, ngA1, ngB0, ngB1;
#define U_PREFETCH(t) do { const size_t _tA = (size_t)(t), _tB = (size_t)(t) + step; if (MODE == 4) { nxA = (u32x4){(unsigned)_tA, 1u, 2u, 3u}; nxB = nxA; neA0 = (int)((_tA * 37 + l * 11) & 16383); neA1 = (int)((_tA * 53 + l * 7) & 16383); neB0 = (int)((_tB * 37 + l * 13) & 16383); neB1 = (int)((_tB * 29 + l * 3) & 16383); ngA0 = ngA1 = ngB0 = ngB1 = 0.01f; break; } nxA = *(const u32x4*)(X8 + _tA * 1024 + loff); nxB = *(const u32x4*)(X8 + _tB * 1024 + loff); \
        neA0 = IDX[_tA * 128 + l]; neA1 = IDX[_tA * 128 + 64 + l]; neB0 = IDX[_tB * 128 + l]; neB1 = IDX[_tB * 128 + 64 + l]; \
        ngA0 = GATE[_tA * 128 + l]; ngA1 = GATE[_tA * 128 + 64 + l]; ngB0 = GATE[_tB * 128 + l]; ngB1 = GATE[_tB * 128 + 64 + l]; } while (0)
    if (tok + step < T_TOK) U_PREFETCH(tok);
    for (; tok + step < T_TOK; tok += 2 * step) {
        const int tokA = tok, tokB = tok + step;
        const u32x4 xA = nxA, xB = nxB;
        const int eA0 = neA0, eA1 = neA1, eB0 = neB0, eB1 = neB1; const float gA0 = ngA0, gA1 = ngA1, gB0 = ngB0, gB1 = ngB1;
        bool pf_done = false;
        const bool oA0 = (eA0 & 7) == g, oA1 = (eA1 & 7) == g, oB0 = (eB0 & 7) == g, oB1 = (eB1 & 7) == g;
        const unsigned long long mA0 = __ballot(oA0), mA1 = __ballot(oA1), mB0 = __ballot(oB0), mB1 = __ballot(oB1);
        const int c0 = __popcll(mA0), c1 = c0 + __popcll(mA1), c2 = c1 + __popcll(mB0), n = c2 + __popcll(mB1);
#define MBC(m) __builtin_amdgcn_mbcnt_hi((unsigned)((m) >> 32), __builtin_amdgcn_mbcnt_lo((unsigned)(m), 0u))
        if (oA0) { const int p = MBC(mA0); le[p] = (eA0 << 8) | l; lk[p] = __builtin_bit_cast(int, gA0); }
        if (oA1) { const int p = c0 + MBC(mA1); le[p] = (eA1 << 8) | (64 + l); lk[p] = __builtin_bit_cast(int, gA1); }
        if (oB0) { const int p = c1 + MBC(mB0); le[p] = (eB0 << 8) | 128 | l; lk[p] = __builtin_bit_cast(int, gB0); }
        if (oB1) { const int p = c2 + MBC(mB1); le[p] = (eB1 << 8) | 128 | (64 + l); lk[p] = __builtin_bit_cast(int, gB1); }
#undef MBC
        LDS_WAIT(); asm volatile("" ::: "memory");
        for (int cb = 0; cb < n || cb == 0; cb += 64) {
        const int nc = min(n, cb + 64);
        const bool fv = (cb + l) < nc;
        const int ent = fv ? le[cb + l] : 0; const float gt = fv ? __builtin_bit_cast(float, lk[cb + l]) : 0.f; float tot = 0.f;
        const float su = SU[ent >> 8], sv = SV[ent >> 8];
        const unsigned long long radr = (unsigned long long)(U8 + (size_t)(((ent >> 8) & 7) * 2048 + (((ent >> 8) >> 3) & (MODE == 2 ? 255 : 2047))) * 1024);
        const int ralo = (int)(unsigned)radr, rahi = (int)(unsigned)(radr >> 32);
        for (int i = cb; i < nc; i += 16) {
            u32x4 row[2][8];
#pragma unroll
            for (int b = 0; b < 2; ++b) if (i + 8 * b < nc) {
#pragma unroll
                for (int j = 0; j < 8; ++j) { const int ln = min(i + 8 * b + j, nc - 1) - cb;
                    const unsigned lo = (unsigned)__builtin_amdgcn_readlane(ralo, ln), hi = (unsigned)__builtin_amdgcn_readlane(rahi, ln);
                    const GAS unsigned char* rp = (const GAS unsigned char*)(((unsigned long long)hi << 32) | lo);
                    row[b][j] = *(const GAS u32x4*)(rp + (unsigned)loff); } }
            if (!pf_done) { pf_done = true; if (tok + 3 * step < T_TOK) U_PREFETCH(tok + 2 * step); }
#pragma unroll
            for (int b = 0; b < 2; ++b) if (i + 8 * b < nc) {
                float p[8];
                f32x4 accj[8];
                const int base0 = i + 8 * b;
                if (base0 + 8 <= c1) {
#pragma unroll
                    for (int j = 0; j < 8; ++j) accj[j] = __builtin_amdgcn_mfma_f32_16x16x32_fp8_fp8(lo64(row[b][j]), lo64(xA), (f32x4){0.f, 0.f, 0.f, 0.f}, 0, 0, 0);
#pragma unroll
                    for (int j = 0; j < 8; ++j) accj[j] = __builtin_amdgcn_mfma_f32_16x16x32_fp8_fp8(hi64(row[b][j]), hi64(xA), accj[j], 0, 0, 0);
                } else if (base0 >= c1) {
#pragma unroll
                    for (int j = 0; j < 8; ++j) accj[j] = __builtin_amdgcn_mfma_f32_16x16x32_fp8_fp8(lo64(row[b][j]), lo64(xB), (f32x4){0.f, 0.f, 0.f, 0.f}, 0, 0, 0);
#pragma unroll
                    for (int j = 0; j < 8; ++j) accj[j] = __builtin_amdgcn_mfma_f32_16x16x32_fp8_fp8(hi64(row[b][j]), hi64(xB), accj[j], 0, 0, 0);
                } else {
#pragma unroll
                    for (int j = 0; j < 8; ++j) { const u32x4 xs = (base0 + j >= c1) ? xB : xA; accj[j] = __builtin_amdgcn_mfma_f32_16x16x32_fp8_fp8(lo64(row[b][j]), lo64(xs), (f32x4){0.f, 0.f, 0.f, 0.f}, 0, 0, 0);
                        accj[j] = __builtin_amdgcn_mfma_f32_16x16x32_fp8_fp8(hi64(row[b][j]), hi64(xs), accj[j], 0, 0, 0); }
                }
#pragma unroll
                for (int j = 0; j < 8; ++j) p[j] = __builtin_fmaf(accj[j][3], dw3, __builtin_fmaf(accj[j][2], dw2, __builtin_fmaf(accj[j][1], dw1, accj[j][0] * dw0)));
                float q4[4], q2[2], q1;
#pragma unroll
                for (int j = 0; j < 4; ++j) { const float keep = b5 ? p[4 + j] : p[j], send = b5 ? p[j] : p[4 + j]; q4[j] = keep + __shfl_xor(send, 32); }
#pragma unroll
                for (int j = 0; j < 2; ++j) { const float keep = b4 ? q4[2 + j] : q4[j], send = b4 ? q4[j] : q4[2 + j]; q2[j] = keep + __shfl_xor(send, 16); }
                { const float keep = b3 ? q2[1] : q2[0], send = b3 ? q2[0] : q2[1]; q1 = keep + __shfl_xor(send, 8); }
                q1 = DPP_ADD(q1, 0xB1); q1 = DPP_ADD(q1, 0x4E); q1 = DPP_ADD(q1, 0x141);
                const float t = __builtin_bit_cast(float, __builtin_amdgcn_ds_bpermute((l & 7) * 32, __builtin_bit_cast(int, q1)));
                const int base = i + 8 * b;
                if ((l >> 3) == ((base - cb) >> 3)) tot = t;
            }
        }
        if (!pf_done) { if (tok + 3 * step < T_TOK) U_PREFETCH(tok + 2 * step); }
        if (fv) { const int tk = (ent & 128) ? tokB : tokA; AK[(size_t)tk * 128 + (ent & 127)] = gelu_tanh(tot * su * (1.f / 16.f)) * gt * sv; }
        if (n == 0) break;
        }
        LDS_WAIT(); asm volatile("" ::: "memory");
    }
#undef U_PREFETCH
}
__device__ __forceinline__ float wave_max_nonneg(float v) {
    unsigned u = __builtin_bit_cast(unsigned, v);
    u = max(u, (unsigned)__builtin_amdgcn_mov_dpp((int)u, 0xB1, 0xf, 0xf, true));
    u = max(u, (unsigned)__builtin_amdgcn_mov_dpp((int)u, 0x4E, 0xf, 0xf, true));
    u = max(u, (unsigned)__builtin_amdgcn_mov_dpp((int)u, 0x141, 0xf, 0xf, true));
    u = max(u, (unsigned)__builtin_amdgcn_mov_dpp((int)u, 0x140, 0xf, 0xf, true));
    const unsigned a = (unsigned)__builtin_amdgcn_readlane((int)u, 0), b = (unsigned)__builtin_amdgcn_readlane((int)u, 16), c = (unsigned)__builtin_amdgcn_readlane((int)u, 32), d = (unsigned)__builtin_amdgcn_readlane((int)u, 48);
    return __builtin_bit_cast(float, max(max(a, b), max(c, d)));
}
template <int MODE>
__device__ __forceinline__ void peer_v_phase(const Frame& F, const Args& A) {
    const unsigned char* V8 = A.ws + WS_V8; const int* IDX = (const int*)(A.ws + WS_P + P_IDX); const float* AK = (const float*)(A.ws + WS_AK);
    float* out = MODE == 0 ? A.out : (float*)(A.ws + WS_P + P_SC);
    const int g = F.bid & 7, nmem = F.G >> 3, l = F.lane, sub = l & 7, rr = l >> 3, n16 = l & 15, q = l >> 4, step = nmem * NWAVES;
    const GAS unsigned char* vb = (const GAS unsigned char*)(V8 + (size_t)g * NEXP * 128);
    LAS unsigned long long* rep = (LAS unsigned long long*)(F.lds + F.wave * 2048);
    const unsigned long long bm = 0xFFull << (8 * (n16 & 7));
    const int repi = 2 * q + (n16 >> 3);
    const bool vl = (n16 < 8) && (q < 2);
    LAS float* stg = (LAS float*)(F.lds + 16384 + F.wave * 512);
    int tok = (F.bid >> 3) * NWAVES + F.wave;
    int ne[4]; float na[4];
#define V_PREFETCH(t) do { const size_t _a = (size_t)(t) * 128, _b = ((size_t)(t) + step) * 128; ne[0] = IDX[_a + l]; ne[1] = IDX[_a + 64 + l]; ne[2] = IDX[_b + l]; ne[3] = IDX[_b + 64 + l]; \
        na[0] = AK[_a + l]; na[1] = AK[_a + 64 + l]; na[2] = AK[_b + l]; na[3] = AK[_b + 64 + l]; } while (0)
    if (tok + step < T_TOK) V_PREFETCH(tok);
    for (; tok + step < T_TOK; tok += 2 * step) {
        const int e0 = ne[0], e1 = ne[1], e2 = ne[2], e3 = ne[3]; const float a0 = na[0], a1 = na[1], a2 = na[2], a3 = na[3];
        u32x4 rowA[16], rowB[16];
#pragma unroll
        for (int i = 0; i < 16; ++i) { const int src = (8 * (i & 7) + rr) * 4;
            const int ea = __builtin_amdgcn_ds_bpermute(src, i < 8 ? e0 : e1), eb = __builtin_amdgcn_ds_bpermute(src, i < 8 ? e2 : e3);
            rowA[i] = *(const GAS u32x4*)(vb + ((unsigned)ea * 128u + 16u * (unsigned)sub)); rowB[i] = *(const GAS u32x4*)(vb + ((unsigned)eb * 128u + 16u * (unsigned)sub)); }
        f32x4 HA = {0.f, 0.f, 0.f, 0.f}, HB = {0.f, 0.f, 0.f, 0.f};
        if (l < 32) { const float* hpa = out + (size_t)tok * D + g * 128 + 4 * l; HA = *(const f32x4*)hpa; HB = *(const f32x4*)(hpa + (size_t)step * D); }
        if (tok + 3 * step < T_TOK) V_PREFETCH(tok + 2 * step);
        const float amA = wave_max_nonneg(fmaxf(fabsf(a0), fabsf(a1))), amB = wave_max_nonneg(fmaxf(fabsf(a2), fabsf(a3)));
        const float scA = amA > 0.f ? 224.f * __builtin_amdgcn_rcpf(amA) : 0.f, invA = amA * (1.f / 224.f), scB = amB > 0.f ? 224.f * __builtin_amdgcn_rcpf(amB) : 0.f, invB = amB * (1.f / 224.f);
        { const unsigned wA = (unsigned)__builtin_amdgcn_cvt_pk_fp8_f32(a0 * scA, a1 * scA, 0, false), wB = (unsigned)__builtin_amdgcn_cvt_pk_fp8_f32(a2 * scB, a3 * scB, 0, false);
          const unsigned r0 = (wA & 0xffu) * 0x01010101u, r1 = ((wA >> 8) & 0xffu) * 0x01010101u, r2 = (wB & 0xffu) * 0x01010101u, r3 = ((wB >> 8) & 0xffu) * 0x01010101u;
          rep[l] = ((unsigned long long)r0 << 32) | r0; rep[64 + l] = ((unsigned long long)r1 << 32) | r1; rep[128 + l] = ((unsigned long long)r2 << 32) | r2; rep[192 + l] = ((unsigned long long)r3 << 32) | r3; }
        LDS_WAIT(); asm volatile("" ::: "memory");
#pragma unroll
        for (int t2 = 0; t2 < 2; ++t2) {
            f32x4 alo = {0.f, 0.f, 0.f, 0.f}, ahi = {0.f, 0.f, 0.f, 0.f};
#pragma unroll
            for (int i = 0; i < 16; ++i) { const long bop = (long)(rep[128 * t2 + 8 * i + repi] & bm); const u32x4 rw = t2 ? rowB[i] : rowA[i];
                alo = __builtin_amdgcn_mfma_f32_16x16x32_fp8_fp8(lo64(rw), bop, alo, 0, 0, 0);
                ahi = __builtin_amdgcn_mfma_f32_16x16x32_fp8_fp8(hi64(rw), bop, ahi, 0, 0, 0); }
            const float inv = t2 ? invB : invA;
            float vlo[4], vhi[4];
#pragma unroll
            for (int r = 0; r < 4; ++r) { const float tl = alo[r], th = ahi[r];
                vlo[r] = (tl + __builtin_bit_cast(float, __builtin_amdgcn_ds_bpermute(((l + 40) & 63) * 4, __builtin_bit_cast(int, tl)))) * inv;
                vhi[r] = (th + __builtin_bit_cast(float, __builtin_amdgcn_ds_bpermute(((l + 40) & 63) * 4, __builtin_bit_cast(int, th)))) * inv; }
            if (vl) {
#pragma unroll
                for (int r = 0; r < 4; ++r) { stg[64 * q + 16 * r + n16] = vlo[r]; stg[64 * q + 16 * r + n16 + 8] = vhi[r]; } }
            LDS_WAIT(); asm volatile("" ::: "memory");
            if (l < 32) { const f32x4 dv = *(const LAS f32x4*)(stg + 4 * l); *(f32x4*)(out + (size_t)(tok + t2 * step) * D + g * 128 + 4 * l) = (t2 ? HB : HA) + dv; }
            LDS_WAIT(); asm volatile("" ::: "memory");
        }
        LDS_WAIT(); asm volatile("" ::: "memory");
    }
#undef V_PREFETCH
}
__device__ __forceinline__ void final_norm_phase(const Frame& F, const Args& A) {
    const int gw = F.bid * NWAVES + F.wave, NGW = F.G * NWAVES, l = F.lane; const float* fg = A.in[I_FG];
    const f32x4* gp = (const f32x4*)fg + l;
    int tok = gw;
    for (; tok + 3 * NGW < T_TOK; tok += 4 * NGW) {
        f32x4 v[4][4]; float ss[4];
#pragma unroll
        for (int b = 0; b < 4; ++b) { const f32x4* hp = (const f32x4*)(A.out + (size_t)(tok + b * NGW) * D) + l;
#pragma unroll
            for (int j = 0; j < 4; ++j) v[b][j] = hp[64 * j]; }
#pragma unroll
        for (int b = 0; b < 4; ++b) { ss[b] = 0.f;
#pragma unroll
            for (int j = 0; j < 4; ++j) ss[b] += (v[b][j].x * v[b][j].x + v[b][j].y * v[b][j].y) + (v[b][j].z * v[b][j].z + v[b][j].w * v[b][j].w); }
#pragma unroll
        for (int o = 1; o < 64; o <<= 1) {
#pragma unroll
            for (int b = 0; b < 4; ++b) ss[b] += __shfl_xor(ss[b], o); }
#pragma unroll
        for (int b = 0; b < 4; ++b) { const float rstd = 1.f / sqrtf(ss[b] * (1.f / D) + EPS); f32x4* hp = (f32x4*)(A.out + (size_t)(tok + b * NGW) * D) + l;
#pragma unroll
            for (int j = 0; j < 4; ++j) hp[64 * j] = v[b][j] * rstd * gp[64 * j]; }
    }
    for (; tok < T_TOK; tok += NGW) { f32x4* hp = (f32x4*)(A.out + (size_t)tok * D) + l; f32x4 v[4]; float ss = 0.f;
#pragma unroll
        for (int j = 0; j < 4; ++j) { v[j] = hp[64 * j]; ss += (v[j].x * v[j].x + v[j].y * v[j].y) + (v[j].z * v[j].z + v[j].w * v[j].w); }
        const float rstd = 1.f / sqrtf(wave_sum(ss) * (1.f / D) + EPS);
#pragma unroll
        for (int j = 0; j < 4; ++j) hp[64 * j] = v[j] * rstd * gp[64 * j]; }
}

#ifdef DEBUG_CHECK
constexpr size_t WS_DBG = 472 * MiB;
__device__ __forceinline__ int dbg_tok(int i) { return (i * 509 + 3) & 32767; }
__device__ __forceinline__ float gelu_ref(float x) { return 0.5f * x * (1.f + tanhf(0.7978845608028654f * (x + 0.044715f * x * x * x))); }
__global__ void __launch_bounds__(512) dbg_scores(Args a) {
    __shared__ float n2s[1024]; __shared__ float q[2048];
    const int t = dbg_tok(blockIdx.x), tid = threadIdx.x;
    const bf16_t* N2 = (const bf16_t*)(a.ws + WS_N1); const float* SC = (const float*)(a.ws + WS_P + P_SC); unsigned* dbg = (unsigned*)(a.ws + WS_DBG);
    for (int k = tid; k < 1024; k += 512) n2s[k] = bf1(N2[(size_t)t * 1024 + k]);
    __syncthreads();
    for (int r = 0; r < 4; ++r) { const int c = tid + 512 * r; float s = 0.f; for (int k = 0; k < 1024; ++k) s += n2s[k] * a.in[I_WQ][(size_t)k * 2048 + c]; q[c] = s; }
    __syncthreads();
    float md = 0.f;
    for (int r = 0; r < 4; ++r) { const int n = tid + 512 * r, hh = n >> 7, key = n & 127; const float* kX = (hh & 1) ? a.in[I_K2] : a.in[I_K1];
        float s = 0.f; for (int d = 0; d < 128; ++d) s += q[hh * 128 + d] * kX[key * 128 + d];
        md = fmaxf(md, fabsf(s - SC[(size_t)n * T_TOK + t])); }
    atomicMax(&dbg[0], __builtin_bit_cast(unsigned, md));
}
__global__ void __launch_bounds__(64) dbg_topk(Args a) {
    __shared__ float s1[8][128], s2[8][128], cv[8][256]; __shared__ float t1v[8][16], t2v[8][16]; __shared__ int t1i[8][16], t2i[8][16], exi[8][16]; __shared__ float exv[8][16];
    const int t = dbg_tok(blockIdx.x), h = threadIdx.x;
    const float* SC = (const float*)(a.ws + WS_P + P_SC); const int* IDX = (const int*)(a.ws + WS_P + P_IDX); const float* GATE = (const float*)(a.ws + WS_P + P_GATE); unsigned* dbg = (unsigned*)(a.ws + WS_DBG);
    if (h >= 8) return;
    for (int j = 0; j < 128; ++j) { s1[h][j] = SC[(size_t)(h * 256 + j) * T_TOK + t]; s2[h][j] = SC[(size_t)(h * 256 + 128 + j) * T_TOK + t]; }
    for (int r = 0; r < 16; ++r) { int b1 = 0, b2 = 0; for (int j = 1; j < 128; ++j) { if (s1[h][j] > s1[h][b1]) b1 = j; if (s2[h][j] > s2[h][b2]) b2 = j; }
        t1v[h][r] = s1[h][b1]; t1i[h][r] = b1; s1[h][b1] = -1e30f; t2v[h][r] = s2[h][b2]; t2i[h][r] = b2; s2[h][b2] = -1e30f; }
    for (int c = 0; c < 256; ++c) cv[h][c] = t1v[h][c >> 4] + t2v[h][c & 15];
    for (int r = 0; r < 16; ++r) { int bc = 0; for (int c = 1; c < 256; ++c) if (cv[h][c] > cv[h][bc]) bc = c;
        exv[h][r] = cv[h][bc]; exi[h][r] = t1i[h][bc >> 4] * 128 + t2i[h][bc & 15]; cv[h][bc] = -1e30f; }
    float sum = 0.f; const float mx0 = exv[h][0]; for (int r = 0; r < 16; ++r) { exv[h][r] = expf(exv[h][r] - mx0); } for (int r = 0; r < 16; ++r) sum += exv[h][r];
    unsigned miss = 0; float gd = 0.f;
    for (int w = 0; w < 16; ++w) { const int e = IDX[(size_t)t * 128 + h * 16 + w]; const float g = GATE[(size_t)t * 128 + h * 16 + w]; bool found = false;
        for (int r = 0; r < 16; ++r) if (exi[h][r] == e) { found = true; gd = fmaxf(gd, fabsf(g - exv[h][r] / sum)); }
        if (!found) ++miss; }
    atomicAdd(&dbg[1], miss); atomicMax(&dbg[3], __builtin_bit_cast(unsigned, gd));
}
__global__ void __launch_bounds__(512) dbg_experts_pre(Args a) {
    __shared__ float n2s[1024]; __shared__ float ak[128]; __shared__ int ek[128]; __shared__ float red[8];
    const int t = dbg_tok(blockIdx.x), tid = threadIdx.x, lane = tid & 63, wave = tid >> 6;
    const bf16_t* N2 = (const bf16_t*)(a.ws + WS_N1); const int* IDX = (const int*)(a.ws + WS_P + P_IDX); const float* GATE = (const float*)(a.ws + WS_P + P_GATE);
    float* rows = (float*)(a.ws + WS_DBG + MiB);
    for (int k = tid; k < 1024; k += 512) n2s[k] = bf1(N2[(size_t)t * 1024 + k]);
    if (tid < 128) ek[tid] = IDX[(size_t)t * 128 + tid];
    __syncthreads();
    for (int k = wave * 16; k < wave * 16 + 16; ++k) { const float* u = a.in[I_PU] + (size_t)ek[k] * 1024; float s = 0.f; for (int j = lane; j < 1024; j += 64) s += u[j] * n2s[j];
        s = wave_sum(s); if (lane == 0) ak[k] = gelu_ref(s) * GATE[(size_t)t * 128 + k]; }
    __syncthreads();
    float h2[2]; float ss = 0.f;
    for (int r = 0; r < 2; ++r) { const int d = tid + 512 * r; float o = 0.f; for (int k = 0; k < 128; ++k) o += ak[k] * a.in[I_PV][(size_t)ek[k] * 1024 + d]; h2[r] = a.out[(size_t)t * 1024 + d] + o; ss += h2[r] * h2[r]; }
    ss = wave_sum(ss); if (lane == 0) red[wave] = ss; __syncthreads();
    float tot = 0.f; for (int w = 0; w < 8; ++w) tot += red[w];
    const float rstd = 1.f / sqrtf(tot / 1024.f + EPS);
    for (int r = 0; r < 2; ++r) { const int d = tid + 512 * r; rows[(size_t)blockIdx.x * 1024 + d] = h2[r] * rstd * a.in[I_FG][d]; }
}
__global__ void __launch_bounds__(512) dbg_experts_post(Args a) {
    const int t = dbg_tok(blockIdx.x), tid = threadIdx.x; const float* rows = (const float*)(a.ws + WS_DBG + MiB); float* dbgf = (float*)(a.ws + WS_DBG);
    float e = 0.f, n = 0.f;
    for (int r = 0; r < 2; ++r) { const int d = tid + 512 * r; const float x = rows[(size_t)blockIdx.x * 1024 + d], y = a.out[(size_t)t * 1024 + d]; e += (x - y) * (x - y); n += x * x; }
    e = wave_sum(e); n = wave_sum(n); if ((tid & 63) == 0) { atomicAdd(&dbgf[4], e); atomicAdd(&dbgf[5], n); }
}
__global__ void __launch_bounds__(512) dbg_report(Args a, int which) {
    const unsigned* dbg = (const unsigned*)(a.ws + WS_DBG); const float* dbgf = (const float*)(a.ws + WS_DBG);
    const float mA = dbgf[0], gd = dbgf[3]; const unsigned miss = dbg[1]; const float relC = sqrtf(dbgf[4] / fmaxf(dbgf[5], 1e-30f));
    float X;
    if (which == 0) { int mask = 0; if (mA > 0.05f) mask |= 1; if (miss > 400u) mask |= 2; if (relC > 0.05f) mask |= 4; if (gd > 0.02f) mask |= 8; X = 1000.f + 100.f * mask; }
    else if (which == 1) X = 1e6f * mA; else if (which == 2) X = 100.f + (float)miss; else if (which == 3) X = 1e6f * relC; else X = 1e6f * gd;
    for (size_t i = (size_t)blockIdx.x * 512 + threadIdx.x; i < (size_t)T_TOK * D; i += (size_t)gridDim.x * 512) a.out[i] = (i == 0) ? X : 0.f;
}
#endif

constexpr int NPH = 13;
__global__ void __launch_bounds__(NWAVES * 64, 2) fwd_kernel(Args args) {
    extern __shared__ __attribute__((aligned(16))) unsigned char lds_raw[];
    Frame F;
    F.lds = (LAS unsigned char*)lds_raw;
    F.tid = threadIdx.x; F.lane = F.tid & 63; F.wave = __builtin_amdgcn_readfirstlane(F.tid >> 6);
    F.G = gridDim.x; F.bid = blockIdx.x;
    volatile LAS unsigned* MISC = (volatile LAS unsigned*)(F.lds + MISC_OFF);
    for (int u = F.tid; u < (LDS_BYTES - LDSCTL_OFF) / 4; u += NWAVES * 64) ((LAS unsigned*)(F.lds + LDSCTL_OFF))[u] = 0u;
    __syncthreads();
    unsigned* ctl = (unsigned*)(args.ws + WS_CTL);
    const int lo = args.ph_lo, hi = args.ph_hi;
    XcdBarrier bar; bar.bar = ctl + CW_BAR + args.li * XCD_BAR_WORDS; bar.x = 0; bar.st = nullptr;
    if (hi - lo > 1) bar = xcd_barrier_post(ctl + CW_BAR + args.li * XCD_BAR_WORDS, MISC + 8);
#define IN(k) (lo <= (k) && (k) < hi)
#ifdef PROBE_TS
#define STAMP(k) do { if (F.bid == 0 && F.tid == 0) ((unsigned long long*)(args.ws + (472u << 20)))[(k)] = __builtin_amdgcn_s_memrealtime(); } while (0)
#else
#define STAMP(k) do { } while (0)
#endif
#define SEAM(k) do { if (IN(k) && IN((k) + 1)) { xcd_barrier(bar); if (XTRA_BAR) xcd_barrier(bar); } STAMP((k) + 1); } while (0)
    unsigned char* ws = args.ws;
    bf16_t* P = (bf16_t*)(ws + WS_P);

    STAMP(0);
    if (IN(0)) { phase0(F, args); SEAM(0); }
    if (IN(1)) {
        pg8::Gemm g{(const bf16_t*)(ws + WS_N1), (const bf16_t*)(ws + WS_WIN), T_TOK, NPROJ, D, D}; pg8::StaticOrder S; S.init(T_TOK, NPROJ, F.G, F.bid);
        pg8::EpiProj E{P, (float*)(ws + WS_ALR)};
        pg8::gemm_phase<pg8::EpiProj, pg8::StaticOrder, false, true>(F.lds, g, S, E);
        {
            const int nwg = (T_TOK / 256) * (NPROJ / 256), rem = nwg % F.G;
            if (rem == 0) convert_tables(F, args, F.bid * NWAVES + F.wave, F.G * NWAVES);
            else if (F.bid >= rem) convert_tables(F, args, (F.bid - rem) * NWAVES + F.wave, (F.G - rem) * NWAVES);
        }
        SEAM(1);
    }
    if (IN(2)) {
        gla_chunk_phase<false>(F, args);
        for (int it = F.bid; it < 1024; it += F.G) sgu_unit<false>(F, args, it);
        SEAM(2);
    }
    if (IN(3)) { if (DRY_EXP == 13) { gla_scan<true>(F, args); __syncthreads(); } gla_scan<false>(F, args); SEAM(3); }
    if (IN(4)) { if (DRY_EXP == 14) { gla_out_phase<true>(F, args); __syncthreads(); } gla_out_phase<false>(F, args); SEAM(4); }
    if (IN(5)) {
        { pg8::Gemm g{P + PC_Q, (const bf16_t*)(ws + WS_WA), T_TOK, D, 512, PLD}; pg8::StaticOrder S; S.init(T_TOK, D, F.G, F.bid);
          pg8::EpiBrA E{P}; pg8::gemm_phase<pg8::EpiBrA, pg8::StaticOrder, true, true>(F.lds, g, S, E); }
        { pg8::Gemm g{P + PC_SU, (const bf16_t*)(ws + WS_WB), T_TOK, D, 512, PLD}; pg8::StaticOrder S; S.init(T_TOK, D, F.G, F.bid);
          pg8::EpiBrB E{P}; pg8::gemm_phase<pg8::EpiBrB, pg8::StaticOrder, true, true>(F.lds, g, S, E); }
        SEAM(5);
    }
    if (IN(6)) {
        pg8::Gemm g{P + PC_MRG, (const bf16_t*)(ws + WS_WOUT), T_TOK, D, D, PLD}; pg8::StaticOrder S; S.init(T_TOK, D, F.G, F.bid);
        pg8::EpiOut E{args.in[I_X], args.out}; pg8::gemm_phase<pg8::EpiOut, pg8::StaticOrder, true, true>(F.lds, g, S, E);
        SEAM(6);
    }
    if (IN(7)) {
        const int gw = F.bid * NWAVES + F.wave, NGW = F.G * NWAVES;
        { int m = gw; for (; m + 3 * NGW < T_TOK; m += 4 * NGW) rms_rows_to_bf16<true, 4>(F.lane, args.out + (size_t)m * D, (size_t)NGW * D, args.in[I_N2G], (bf16_t*)(ws + WS_N1) + (size_t)m * D, (size_t)NGW * D, (unsigned*)(ws + WS_P + P_X8) + (size_t)m * 256, (size_t)NGW * 256);
          for (; m < T_TOK; m += NGW) rms_rows_to_bf16<true, 1>(F.lane, args.out + (size_t)m * D, 0, args.in[I_N2G], (bf16_t*)(ws + WS_N1) + (size_t)m * D, 0, (unsigned*)(ws + WS_P + P_X8) + (size_t)m * 256, 0); }
        SEAM(7);
    }
    if (IN(8)) {
        pg8::Gemm g{(const bf16_t*)(ws + WS_N1), (const bf16_t*)(ws + WS_WQF), T_TOK, 2048, D, D}; pg8::StaticOrder S; S.init(T_TOK, 2048, F.G, F.bid);
        pg8::EpiScores E{(float*)(ws + WS_P + P_SC)}; pg8::gemm_phase<pg8::EpiScores, pg8::StaticOrder, true, true>(F.lds, g, S, E);
        SEAM(8);
    }
    if (IN(9)) { peer_topk(F, args); SEAM(9); }
    if (IN(10)) { if (DRY_EXP == 2) { peer_u_phase<1>(F, args); __syncthreads(); } if (DRY_EXP == 3) { peer_u_phase<2>(F, args); __syncthreads(); } if (DRY_EXP == 4) { peer_u_phase<3>(F, args); __syncthreads(); } if (DRY_EXP == 5) { peer_u_phase<4>(F, args); __syncthreads(); } peer_u_phase<0>(F, args); SEAM(10); }
    if (IN(11)) { if (DRY_EXP == 1) { peer_v_phase<1>(F, args); __syncthreads(); } peer_v_phase<0>(F, args); SEAM(11); }
    if (IN(12)) { final_norm_phase(F, args); }
#undef IN
#undef SEAM
}


#ifdef PROBE_TS
__global__ void __launch_bounds__(512) probe_report(Args a, int pi, int pj) {
    const unsigned long long* ts = (const unsigned long long*)(a.ws + (472u << 20));
    const float X1 = 10.f * (float)(ts[pi + 1] - ts[pi]) * 0.01f, X2 = (float)(ts[pj + 1] - ts[pj]) * 0.01f;
    for (size_t i = (size_t)blockIdx.x * 512 + threadIdx.x; i < (size_t)T_TOK * D; i += (size_t)gridDim.x * 512) a.out[i] = (i == 0) ? X1 : X2;
}
#endif
extern "C" void kernel_launch(void* const* d_in, const int* in_sizes, int n_in, void* d_out, int out_size, void* d_ws, size_t ws_size, hipStream_t stream) {
    static int grid = 0;
    if (grid == 0) {
        if (n_in != 20 || in_sizes[0] != T_TOK * D || out_size != T_TOK * D || ws_size < WS_END) {
            fprintf(stderr, "kernel_launch: unexpected shapes: n_in %d in0 %d out %d ws %zu (need %zu)\n", n_in, n_in > 0 ? in_sizes[0] : -1, out_size, ws_size, (size_t)WS_END); grid = -1; return; }
        int dev = 0, cus = 0;
        if (hipGetDevice(&dev) != hipSuccess || hipDeviceGetAttribute(&cus, hipDeviceAttributeMultiprocessorCount, dev) != hipSuccess) { grid = -1; return; }
        if (hipFuncSetAttribute((const void*)fwd_kernel, hipFuncAttributeMaxDynamicSharedMemorySize, LDS_BYTES) != hipSuccess) { fprintf(stderr, "kernel_launch: hipFuncSetAttribute failed\n"); grid = -1; return; }
        int per_cu = 0;
        if (hipOccupancyMaxActiveBlocksPerMultiprocessor(&per_cu, (const void*)fwd_kernel, NWAVES * 64, LDS_BYTES) != hipSuccess || per_cu < 1) fprintf(stderr, "kernel_launch: occupancy query says %d\n", per_cu);
        (void)hipGetLastError();
        grid = cus;
    }
    if (grid < 0) return;
    (void)hipMemsetAsync((char*)d_ws + WS_CTL, 0, CTL_ZERO_BYTES, stream);
    Args a{};
    for (int i = 0; i < 20; ++i) a.in[i] = (const float*)d_in[i];
    a.out = (float*)d_out; a.ws = (unsigned char*)d_ws;
#ifndef LAUNCH_LIST
#define LAUNCH_LIST {0, NPH}
#endif
    static const int ranges[][2] = { LAUNCH_LIST };
    const int nl = (int)(sizeof(ranges) / sizeof(ranges[0]));
    for (int li = 0; li < nl; ++li) { a.ph_lo = ranges[li][0]; a.ph_hi = ranges[li][1]; a.li = li;
        hipLaunchKernelGGL(fwd_kernel, dim3(grid), dim3(NWAVES * 64), LDS_BYTES, stream, a); }
}
```

```cpp
#include <hip/hip_runtime.h>
#include <cstdio>
#include <cstdint>


#ifndef XTRA_BAR
#define XTRA_BAR 0
#endif
#ifndef DRY_EXP
#define DRY_EXP 0
#endif
#ifndef DUP_PHASE
#define DUP_PHASE -1
#endif
#ifndef MK_N_LAUNCHES
#define MK_N_LAUNCHES 1
#endif

#define LAS __attribute__((address_space(3)))
#define GAS __attribute__((address_space(1)))
typedef unsigned short bf16_t;
typedef short bf16x8 __attribute__((ext_vector_type(8)));
typedef float f32x4 __attribute__((ext_vector_type(4)));
typedef float f32x2 __attribute__((ext_vector_type(2)));
typedef unsigned u32x4 __attribute__((ext_vector_type(4)));
typedef unsigned u32x2 __attribute__((ext_vector_type(2)));
typedef __bf16 bf16x2_t __attribute__((ext_vector_type(2)));

constexpr int T_TOK = 32768, D = 1024, SEQ = 4096, NBATCH = 8;
constexpr int NPROJ = 5376;
constexpr int PLD = 5120;
constexpr int PC_Q = 0, PC_K = 512, PC_V = 1024, PC_R = 1536, PC_SU = 2048, PC_SV = 2560, PC_GA = 3072, PC_GB = 4096;
constexpr int PC_MRG = 512;
constexpr float EPS = 1e-6f;
constexpr int NEXP = 16384;

constexpr size_t MiB = 1u << 20;
constexpr size_t WS_CTL = 0, CTL_ZERO_BYTES = 64 * 1024;
constexpr size_t WS_WIN = 1 * MiB;
constexpr size_t WS_WA = 12 * MiB;
constexpr size_t WS_WB = 13 * MiB;
constexpr size_t WS_WOUT = 14 * MiB;
constexpr size_t WS_WQF = 16 * MiB;
constexpr size_t WS_U8 = 20 * MiB;
constexpr size_t WS_V8 = 36 * MiB;
constexpr size_t WS_SU = 52 * MiB;
constexpr size_t WS_SV = 52 * MiB + 65536;
constexpr size_t WS_AK = 53 * MiB;
constexpr size_t WS_DEC = 84 * MiB;
constexpr size_t WS_ALR = 85 * MiB;
constexpr size_t WS_N1 = 87 * MiB;
constexpr size_t WS_P = 151 * MiB;
constexpr size_t WS_END = 471 * MiB;
constexpr size_t P_SC = 0, P_IDX = 256 * MiB, P_GATE = 272 * MiB, P_X8 = 288 * MiB;

constexpr int CW_BAR = 4096;

constexpr int RING_BYTES = 131072;
constexpr int LDSCTL_OFF = RING_BYTES, MISC_OFF = LDSCTL_OFF + 320;
constexpr int LDS_BYTES = 147456;
constexpr int NWAVES = 8;

__device__ __forceinline__ unsigned pk2(float lo, float hi) { const f32x2 v = {lo, hi}; const bf16x2_t b = __builtin_convertvector(v, bf16x2_t); return __builtin_bit_cast(unsigned, b); }
__device__ __forceinline__ unsigned f2bf(float f) { return pk2(f, 0.f) & 0xffffu; }
__device__ __forceinline__ float bflo(unsigned w) { return __builtin_bit_cast(float, w << 16); }
__device__ __forceinline__ float bfhi(unsigned w) { return __builtin_bit_cast(float, w & 0xffff0000u); }
__device__ __forceinline__ float bf1(bf16_t h) { return __builtin_bit_cast(float, ((unsigned)h) << 16); }
__device__ __forceinline__ float sigmoidf_(float x) { return __builtin_amdgcn_rcpf(1.f + __expf(-x)); }
__device__ __forceinline__ float gelu_tanh(float x) { const float y = 1.5957691216057308f * (x + 0.044715f * x * x * x); return x * sigmoidf_(y); }
__device__ __forceinline__ float siluf_(float x) { return x * sigmoidf_(x); }
__device__ __forceinline__ float wave_sum(float v) {
#pragma unroll
    for (int o = 1; o < 64; o <<= 1) v += __shfl_xor(v, o);
    return v;
}
#define LDS_WAIT() asm volatile("s_waitcnt lgkmcnt(0)" ::: "memory")
#define VM_WAIT() asm volatile("s_waitcnt vmcnt(0)" ::: "memory")

namespace pg8 {
constexpr int BM = 256, BK = 64, HALF = 128, HTB = HALF * BK * 2, STAGE_BYTES = 8 * HTB, NXCD = 8, WGM = 8;
__host__ __device__ __forceinline__ int lds_byte(int r, int c) { const int st = (r >> 4) * 2 + (c >> 5), rr = r & 15, cc = c & 31, ob = rr * 64 + cc * 2; return st * 1024 + (ob ^ (((ob >> 9) & 1) << 5)); }
__host__ __device__ __forceinline__ void stage_rc(int b, int& R, int& C) { const int st = b / 1024, sb = b % 1024, swz = sb ^ (((sb >> 9) & 1) << 5); R = (st >> 1) * 16 + swz / 64; C = (st & 1) * 32 + (swz % 64) / 2; }
__host__ __device__ __forceinline__ int perm32(int rho) { const int n = rho >> 4, i = rho & 15; return 8 * (i >> 2) + 4 * n + (i & 3); }

struct Unit { int pm, pn; };
struct Gemm { const bf16_t* A; const bf16_t* Bt; int M, N, K, lda; };

struct StaticOrder {
    int nM, nN, nwg, G, c;
    __host__ __device__ void init(int M, int N, int G_, int c_) { nM = M / BM; nN = N / BM; nwg = nM * nN; G = G_; c = c_; }
    __host__ __device__ bool next(int i, Unit& u) const {
        const long L = (long)i * G + c; if (L >= nwg) return false;
        int wgid = (int)L; { const int q = nwg / NXCD, r = nwg % NXCD, xcd = wgid % NXCD, off = wgid / NXCD; wgid = (xcd < r ? xcd * (q + 1) : r * (q + 1) + (xcd - r) * q) + off; }
        const int nig = WGM * nN, gid = wgid / nig, fm = gid * WGM, gsz = (nM - fm) < WGM ? (nM - fm) : WGM;
        u.pm = fm + ((wgid % nig) % gsz); u.pn = (wgid % nig) / gsz; return true;
    }
    __device__ __forceinline__ void a_ready(const Unit&) const {}
    __device__ __forceinline__ void done(const Unit&) const {}
};

template <class Epi, class Sched, bool ALIGN_EPI = false, bool SP2 = false>
__device__ __forceinline__ void gemm_phase(LAS unsigned char* lds, const Gemm g, const Sched& S, const Epi& E) {
    const int tid = threadIdx.x, wid = __builtin_amdgcn_readfirstlane(tid >> 6), lane = tid & 63, wr = wid >> 2, wc = wid & 3, fr = lane & 15, fq = lane >> 4;
    const int K = g.K, nt = K / BK, lda = g.lda;
    unsigned voffA[2], voffB[2];
#pragma unroll
    for (int i = 0; i < 2; ++i) { int R, C; stage_rc(tid * 16 + i * 8192, R, C); const int Rb = Epi::PERM ? ((R & ~31) + perm32(R & 31)) : R;
        voffA[i] = (unsigned)(R * lda + C) * 2u; voffB[i] = (unsigned)(Rb * K + C) * 2u; }
    const size_t kstep = (size_t)(BK * 2);
    const size_t hstepA = (size_t)HALF * lda * 2, hstepB = (size_t)HALF * K * 2;
    const size_t tstepA = 2 * hstepA, tstepB = 2 * hstepB;
    const unsigned ldsw = (unsigned)wid * 1024u;
    const int aoff = lds_byte(wr * 64 + fr, fq * 8), boff = lds_byte(wc * 32 + fr, fq * 8);
#define PG8_SA(b, h) (((b) * 2 + (h)) * HTB)
#define PG8_SB(b, h) ((4 + (b) * 2 + (h)) * HTB)
#define PG8_STAGE(bufoff, gbase, voff) do { _Pragma("unroll") for (int _i = 0; _i < 2; ++_i) \
        __builtin_amdgcn_global_load_lds((const unsigned*)((const char*)(gbase) + (voff)[_i]), (LAS unsigned*)(lds + (bufoff) + ldsw + _i * 8192), 16, 0, 0); } while (0)
#define PG8_LDA(dst, b, h) do { _Pragma("unroll") for (int m = 0; m < 4; ++m) _Pragma("unroll") for (int k = 0; k < 2; ++k) dst[m][k] = *(const LAS bf16x8*)(lds + PG8_SA(b, h) + aoff + m * 2048 + k * 1024); } while (0)
#define PG8_LDB(dst, b, h) do { _Pragma("unroll") for (int n = 0; n < 2; ++n) _Pragma("unroll") for (int k = 0; k < 2; ++k) dst[n][k] = *(const LAS bf16x8*)(lds + PG8_SB(b, h) + boff + n * 2048 + k * 1024); } while (0)
#define PG8_MMA(ai, bj, At, Bt) do { __builtin_amdgcn_s_setprio(1); _Pragma("unroll") for (int m = 0; m < 4; ++m) _Pragma("unroll") for (int n = 0; n < 2; ++n) _Pragma("unroll") for (int k = 0; k < 2; ++k) \
        acc[ai][bj][m][n] = __builtin_amdgcn_mfma_f32_16x16x32_bf16(Bt[n][k], At[m][k], acc[ai][bj][m][n], 0, 0, 0); __builtin_amdgcn_s_setprio(0); } while (0)
#define PG8_WAIT_V(n) asm volatile("s_waitcnt vmcnt(" #n ")" ::: "memory")
#define PG8_WAIT_L(n) asm volatile("s_waitcnt lgkmcnt(" #n ")" ::: "memory")
#define PG8_BAR __builtin_amdgcn_s_barrier()
#define PG8_SCHED __builtin_amdgcn_sched_barrier(0)
    Unit cur, nxt; int ui = 0;
    if (!S.next(0, cur)) return;
    f32x4 acc[2][2][4][2];
#pragma unroll
    for (int a = 0; a < 2; ++a)
#pragma unroll
        for (int b = 0; b < 2; ++b)
#pragma unroll
            for (int m = 0; m < 4; ++m)
#pragma unroll
                for (int n = 0; n < 2; ++n) acc[a][b][m][n] = (f32x4){0.f, 0.f, 0.f, 0.f};
    bf16x8 At[4][2], B0[2][2], B1[2][2];
    const char* cA = (const char*)g.A + (size_t)cur.pm * tstepA; const char* cB = (const char*)g.Bt + (size_t)cur.pn * tstepB;
    S.a_ready(cur);
    if constexpr (SP2) {
        PG8_STAGE(PG8_SB(0, 0), cB, voffB); PG8_STAGE(PG8_SB(0, 1), cB + hstepB, voffB); PG8_STAGE(PG8_SA(0, 0), cA, voffA); PG8_STAGE(PG8_SA(0, 1), cA + hstepA, voffA);
        if (wr == 1) PG8_BAR;
        PG8_WAIT_V(2); PG8_BAR;
        PG8_STAGE(PG8_SB(1, 0), cB + kstep, voffB); PG8_STAGE(PG8_SA(1, 0), cA + kstep, voffA); PG8_STAGE(PG8_SB(1, 1), cB + hstepB + kstep, voffB);
        PG8_WAIT_V(6); PG8_BAR;
    } else {
        PG8_STAGE(PG8_SB(0, 0), cB, voffB); PG8_STAGE(PG8_SA(0, 0), cA, voffA); PG8_STAGE(PG8_SB(0, 1), cB + hstepB, voffB); PG8_STAGE(PG8_SA(0, 1), cA + hstepA, voffA);
        if (wr == 1) PG8_BAR;
        PG8_WAIT_V(4); PG8_BAR;
        PG8_STAGE(PG8_SB(1, 0), cB + kstep, voffB); PG8_STAGE(PG8_SA(1, 0), cA + kstep, voffA); PG8_STAGE(PG8_SB(1, 1), cB + hstepB + kstep, voffB);
        PG8_WAIT_V(6); PG8_BAR;
    }
    for (;;) {
        const bool has_next = S.next(ui + 1, nxt);
        const char* nA = has_next ? (const char*)g.A + (size_t)nxt.pm * tstepA : cA; const char* nB = has_next ? (const char*)g.Bt + (size_t)nxt.pn * tstepB : cB;
        for (int t = 0; t < nt; t += 2) {
            const bool last = (t == nt - 2);
            const char* a1 = cA + (size_t)(t + 1) * kstep;
            const char* a2 = last ? nA : cA + (size_t)(t + 2) * kstep; const char* b2 = last ? nB : cB + (size_t)(t + 2) * kstep;
            const char* a3 = a2 + kstep; const char* b3 = b2 + kstep;
            if (last && has_next) S.a_ready(nxt);
            if constexpr (SP2) {
            PG8_LDB(B0, 0, 0); PG8_LDB(B1, 0, 1); PG8_SCHED; PG8_LDA(At, 0, 0); PG8_STAGE(PG8_SA(1, 1), a1 + hstepA, voffA);
            PG8_WAIT_V(8); PG8_WAIT_L(0); PG8_BAR; PG8_MMA(0, 0, At, B0); PG8_MMA(0, 1, At, B1); PG8_BAR; PG8_SCHED;
            PG8_LDA(At, 0, 1); PG8_STAGE(PG8_SB(0, 0), b2, voffB); PG8_STAGE(PG8_SB(0, 1), b2 + hstepB, voffB); PG8_STAGE(PG8_SA(0, 0), a2, voffA);
            PG8_WAIT_V(8); PG8_WAIT_L(0); PG8_BAR; PG8_MMA(1, 0, At, B0); PG8_MMA(1, 1, At, B1); PG8_BAR; PG8_SCHED;
            PG8_LDB(B0, 1, 0); PG8_LDB(B1, 1, 1); PG8_SCHED; PG8_LDA(At, 1, 0); PG8_STAGE(PG8_SA(0, 1), a2 + hstepA, voffA);
            PG8_WAIT_V(8); PG8_WAIT_L(0); PG8_BAR; PG8_MMA(0, 0, At, B0); PG8_MMA(0, 1, At, B1); PG8_BAR; PG8_SCHED;
            PG8_LDA(At, 1, 1); PG8_STAGE(PG8_SB(1, 0), b3, voffB); PG8_STAGE(PG8_SB(1, 1), b3 + hstepB, voffB); PG8_STAGE(PG8_SA(1, 0), a3, voffA);
            PG8_WAIT_V(8); PG8_WAIT_L(0); PG8_BAR; PG8_MMA(1, 0, At, B0); PG8_MMA(1, 1, At, B1); PG8_BAR; PG8_SCHED;
            } else {
            PG8_LDB(B0, 0, 0); PG8_SCHED; PG8_LDA(At, 0, 0); PG8_STAGE(PG8_SA(1, 1), a1 + hstepA, voffA);
            PG8_WAIT_L(8); PG8_BAR; PG8_WAIT_L(0); PG8_MMA(0, 0, At, B0); PG8_BAR; PG8_SCHED;
            PG8_LDB(B1, 0, 1); PG8_STAGE(PG8_SB(0, 0), b2, voffB);
            PG8_BAR; PG8_WAIT_L(0); PG8_MMA(0, 1, At, B1); PG8_BAR;
            PG8_LDA(At, 0, 1); PG8_STAGE(PG8_SA(0, 0), a2, voffA);
            PG8_BAR; PG8_WAIT_L(0); PG8_MMA(1, 0, At, B0); PG8_BAR; PG8_SCHED;
            PG8_STAGE(PG8_SB(0, 1), b2 + hstepB, voffB);
            PG8_WAIT_V(6); PG8_BAR; PG8_MMA(1, 1, At, B1); PG8_BAR;
            PG8_LDB(B0, 1, 0); PG8_SCHED; PG8_LDA(At, 1, 0); PG8_STAGE(PG8_SA(0, 1), a2 + hstepA, voffA);
            PG8_WAIT_L(8); PG8_BAR; PG8_WAIT_L(0); PG8_MMA(0, 0, At, B0); PG8_BAR; PG8_SCHED;
            PG8_LDB(B1, 1, 1); PG8_STAGE(PG8_SB(1, 0), b3, voffB);
            PG8_BAR; PG8_WAIT_L(0); PG8_MMA(0, 1, At, B1); PG8_BAR;
            PG8_LDA(At, 1, 1); PG8_STAGE(PG8_SA(1, 0), a3, voffA);
            PG8_BAR; PG8_WAIT_L(0); PG8_MMA(1, 0, At, B0); PG8_BAR; PG8_SCHED;
            PG8_STAGE(PG8_SB(1, 1), b3 + hstepB, voffB);
            PG8_WAIT_V(6); PG8_BAR; PG8_MMA(1, 1, At, B1); PG8_BAR;
            }
        }
        if constexpr (ALIGN_EPI) { if (wr == 0) PG8_BAR; }
        E(acc, cur, wr, wc, fr, fq); S.done(cur);
        if (!has_next) break;
#pragma unroll
        for (int a = 0; a < 2; ++a)
#pragma unroll
            for (int b = 0; b < 2; ++b)
#pragma unroll
                for (int m = 0; m < 4; ++m)
#pragma unroll
                    for (int n = 0; n < 2; ++n) acc[a][b][m][n] = (f32x4){0.f, 0.f, 0.f, 0.f};
        cur = nxt; cA = nA; cB = nB; ++ui;
        if constexpr (ALIGN_EPI) { if (wr == 1) PG8_BAR; }
    }
    PG8_WAIT_V(0);
    if constexpr (!ALIGN_EPI) { if (wr == 0) PG8_BAR; }
    PG8_BAR;
#undef PG8_SA
#undef PG8_SB
#undef PG8_STAGE
#undef PG8_LDA
#undef PG8_LDB
#undef PG8_MMA
#undef PG8_WAIT_V
#undef PG8_WAIT_L
#undef PG8_BAR
#undef PG8_SCHED
}

__device__ __forceinline__ u32x4 pack8(f32x4 v0, f32x4 v1) { u32x4 w; w.x = pk2(v0[0], v0[1]); w.y = pk2(v0[2], v0[3]); w.z = pk2(v1[0], v1[1]); w.w = pk2(v1[2], v1[3]); return w; }
__device__ __forceinline__ void unpack8(u32x4 w, f32x4& v0, f32x4& v1) { v0 = (f32x4){bflo(w.x), bfhi(w.x), bflo(w.y), bfhi(w.y)}; v1 = (f32x4){bflo(w.z), bfhi(w.z), bflo(w.w), bfhi(w.w)}; }

struct EpiProj {
    static constexpr bool PERM = true;
    bf16_t* P; float* ALR;
    __device__ __forceinline__ void operator()(const f32x4 (&acc)[2][2][4][2], const Unit& u, int wr, int wc, int fr, int fq) const {
        const int row0 = u.pm * BM + wr * 64 + fr; const int pn = u.pn; const int cl = wc * 32 + 8 * fq;
        if (pn == 20) {
            if (wc == 0 && fq < 2) {
#pragma unroll
                for (int ai = 0; ai < 2; ++ai)
#pragma unroll
                    for (int m = 0; m < 4; ++m) { float* rp = ALR + (size_t)(row0 + ai * HALF + m * 16) * 16 + 8 * fq;
                        *(f32x4*)rp = acc[ai][0][m][0]; *(f32x4*)(rp + 4) = acc[ai][0][m][1]; }
            }
            return;
        }
        const int mode = pn < 8 ? 0 : (pn < 12 ? 1 : 2);
#pragma unroll
        for (int ai = 0; ai < 2; ++ai)
#pragma unroll
            for (int m = 0; m < 4; ++m) { bf16_t* rowp = P + (size_t)(row0 + ai * HALF + m * 16) * PLD + pn * BM + cl;
#pragma unroll
                for (int bj = 0; bj < 2; ++bj) { f32x4 v0 = acc[ai][bj][m][0], v1 = acc[ai][bj][m][1];
                    if (mode == 1) {
#pragma unroll
                        for (int i = 0; i < 4; ++i) { v0[i] = gelu_tanh(v0[i]); v1[i] = gelu_tanh(v1[i]); }
                    } else if (mode == 2) {
#pragma unroll
                        for (int i = 0; i < 4; ++i) { v0[i] = sigmoidf_(v0[i]); v1[i] = sigmoidf_(v1[i]); }
                    }
                    *(u32x4*)(rowp + bj * HALF) = pack8(v0, v1); } }
    }
};
struct EpiBrA {
    static constexpr bool PERM = true;
    bf16_t* P;
    __device__ __forceinline__ void operator()(const f32x4 (&acc)[2][2][4][2], const Unit& u, int wr, int wc, int fr, int fq) const {
        const int row0 = u.pm * BM + wr * 64 + fr; const int c0 = u.pn * BM + wc * 32 + 8 * fq;
#pragma unroll
        for (int ai = 0; ai < 2; ++ai)
#pragma unroll
            for (int m = 0; m < 4; ++m) { bf16_t* rowp = P + (size_t)(row0 + ai * HALF + m * 16) * PLD;
#pragma unroll
                for (int bj = 0; bj < 2; ++bj) { const int c = c0 + bj * HALF; f32x4 g0, g1; unpack8(*(const u32x4*)(rowp + PC_GA + c), g0, g1);
                    *(u32x4*)(rowp + PC_MRG + c) = pack8(acc[ai][bj][m][0] * g0, acc[ai][bj][m][1] * g1); } }
    }
};
struct EpiBrB {
    static constexpr bool PERM = true;
    bf16_t* P;
    __device__ __forceinline__ void operator()(const f32x4 (&acc)[2][2][4][2], const Unit& u, int wr, int wc, int fr, int fq) const {
        const int row0 = u.pm * BM + wr * 64 + fr; const int c0 = u.pn * BM + wc * 32 + 8 * fq;
#pragma unroll
        for (int ai = 0; ai < 2; ++ai)
#pragma unroll
            for (int m = 0; m < 4; ++m) { bf16_t* rowp = P + (size_t)(row0 + ai * HALF + m * 16) * PLD;
#pragma unroll
                for (int bj = 0; bj < 2; ++bj) { const int c = c0 + bj * HALF; f32x4 g0, g1, p0, p1; unpack8(*(const u32x4*)(rowp + PC_GB + c), g0, g1); unpack8(*(const u32x4*)(rowp + PC_MRG + c), p0, p1);
                    *(u32x4*)(rowp + PC_MRG + c) = pack8(p0 + acc[ai][bj][m][0] * g0, p1 + acc[ai][bj][m][1] * g1); } }
    }
};
struct EpiOut {
    static constexpr bool PERM = true;
    const float* X; float* O;
    __device__ __forceinline__ void operator()(const f32x4 (&acc)[2][2][4][2], const Unit& u, int wr, int wc, int fr, int fq) const {
        const int row0 = u.pm * BM + wr * 64 + fr; const int c0 = u.pn * BM + wc * 32 + 8 * fq;
#pragma unroll
        for (int ai = 0; ai < 2; ++ai)
#pragma unroll
            for (int m = 0; m < 4; ++m) { const size_t ro = (size_t)(row0 + ai * HALF + m * 16) * D;
#pragma unroll
                for (int bj = 0; bj < 2; ++bj) { const int c = c0 + bj * HALF;
                    const f32x4 x0 = *(const f32x4*)(X + ro + c), x1 = *(const f32x4*)(X + ro + c + 4);
                    *(f32x4*)(O + ro + c) = x0 + acc[ai][bj][m][0]; *(f32x4*)(O + ro + c + 4) = x1 + acc[ai][bj][m][1]; } }
    }
};
struct EpiScores {
    static constexpr bool PERM = true;
    float* SC;
    __device__ __forceinline__ void operator()(const f32x4 (&acc)[2][2][4][2], const Unit& u, int wr, int wc, int fr, int fq) const {
        const int tb0 = u.pm * 16 + wr * 4; const int cq0 = (u.pn * BM + wc * 32 + 8 * fq) >> 2;
#pragma unroll
        for (int ai = 0; ai < 2; ++ai)
#pragma unroll
            for (int m = 0; m < 4; ++m) { float* bp = SC + ((size_t)(tb0 + ai * 8 + m) * 512) * 64 + fr * 4;
#pragma unroll
                for (int bj = 0; bj < 2; ++bj)
#pragma unroll
                    for (int n = 0; n < 2; ++n) *(f32x4*)(bp + (size_t)(cq0 + bj * 32 + n) * 64) = acc[ai][bj][m][n]; }
    }
};
}

#define XB_TMO      128
#define XB_XCNT(j)  (256  + 64 * (j))
#define XB_XSUB(j)  (1280 + 64 * (j))
#define XB_XGEN(j)  (2304 + 64 * (j))
#define XB_TOP      3328
#define XB_TOPGEN   3392
#define XCD_BAR_WORDS 3456
#define XB_SPIN_CAP (1u << 18)
__device__ __forceinline__ unsigned xb_ld(unsigned* p)              { return __hip_atomic_load(p, __ATOMIC_RELAXED, __HIP_MEMORY_SCOPE_AGENT); }
__device__ __forceinline__ unsigned xb_add(unsigned* p, unsigned v) { return __hip_atomic_fetch_add(p, v, __ATOMIC_RELAXED, __HIP_MEMORY_SCOPE_AGENT); }
__device__ __forceinline__ unsigned xb_xcc_id() { return (unsigned)__builtin_amdgcn_s_getreg((3 << 11) | 20) & 0xFu; }
#define XB_SPIN(cond, bar) do { unsigned _sp = 0; while (cond) { __builtin_amdgcn_s_sleep(1); \
    if ((++_sp & 255u) == 0u) { if (xb_ld(&(bar)[XB_TMO])) break; if (_sp > XB_SPIN_CAP) { atomicAdd(&(bar)[XB_TMO], 1u); break; } } } } while (0)
struct XcdBarrier { unsigned* bar; unsigned x; volatile LAS unsigned* st; };
__device__ __forceinline__ XcdBarrier xcd_barrier_post(unsigned* bar, volatile LAS unsigned* st) {
    XcdBarrier b; b.bar = bar; b.x = xb_xcc_id(); b.st = st;
    if (threadIdx.x == 0) (void)xb_add(&bar[XB_XCNT(b.x)], 1u);
    return b;
}
__device__ __forceinline__ void xcd_barrier_complete(unsigned* bar, unsigned x, unsigned& nloc, unsigned& nx) {
    const unsigned G = gridDim.x * gridDim.y * gridDim.z;
    unsigned sum, cnt, mine, sp = 0u;
    for (;;) {
        sum = 0u; cnt = 0u; mine = 0u;
#pragma unroll
        for (unsigned j = 0; j < 16; ++j) { const unsigned c = xb_ld(&bar[XB_XCNT(j)]); sum += c; cnt += (c > 0u) ? 1u : 0u; mine = (j == x) ? c : mine; }
        if (sum == G) break;
        __builtin_amdgcn_s_sleep(1);
        if ((++sp & 255u) == 0u) { if (xb_ld(&bar[XB_TMO])) break; if (sp > XB_SPIN_CAP) { atomicAdd(&bar[XB_TMO], 1u); break; } }
    }
    nloc = mine > 0u ? mine : 1u; nx = cnt > 0u ? cnt : 1u;
}
__device__ __forceinline__ void xcd_barrier(const XcdBarrier& b) {
    asm volatile("s_waitcnt vmcnt(0)" ::: "memory");
    __syncthreads();
    if (threadIdx.x == 0) {
        unsigned* bar = b.bar;
        __builtin_amdgcn_s_waitcnt(0);
        unsigned nloc = b.st[0], nx = b.st[1];
        if (nloc == 0u) { xcd_barrier_complete(bar, b.x, nloc, nx); b.st[0] = nloc; b.st[1] = nx; }
        const unsigned old = xb_add(&bar[XB_XSUB(b.x)], 1u);
        const unsigned gen = old / nloc;
        if (old + 1u == (gen + 1u) * nloc) {
            __builtin_amdgcn_fence(__ATOMIC_RELEASE, "agent");
            asm volatile("s_waitcnt vmcnt(0)" ::: "memory");
            const unsigned og = xb_add(&bar[XB_TOP], 1u);
            const unsigned tg = og / nx;
            if (og + 1u == (tg + 1u) * nx) xb_add(&bar[XB_TOPGEN], 1u);
            else XB_SPIN(xb_ld(&bar[XB_TOPGEN]) == tg, bar);
            __builtin_amdgcn_fence(__ATOMIC_ACQUIRE, "agent");
            xb_add(&bar[XB_XGEN(b.x)], 1u);
            asm volatile("s_waitcnt vmcnt(0)" ::: "memory");
        } else {
            XB_SPIN(xb_ld(&bar[XB_XGEN(b.x)]) == gen, bar);
            __builtin_amdgcn_fence(__ATOMIC_ACQUIRE, "agent");
            asm volatile("s_waitcnt vmcnt(0)" ::: "memory");
        }
    }
    __syncthreads();
}

struct Args {
    const float* in[20]; float* out; unsigned char* ws; int ph_lo, ph_hi, li, pad;
};
enum { I_X = 0, I_N1G, I_WIN, I_WGU, I_BG, I_GLAG, I_SLNG, I_SLNB, I_SW, I_SB, I_WBA, I_WBB, I_WOUT, I_N2G, I_WQ, I_K1, I_K2, I_PU, I_PV, I_FG };

struct Frame {
    LAS unsigned char* lds;
    int tid, lane, wave, G, bid;
};

template <int MODE>
__device__ __forceinline__ void p0_transpose_item(const float* W, int K, int Nsrc, int Ndst, bf16_t* WT, LAS float* scr, int item, int lane) {
    const int nblk = Ndst / 32, kb = item / nblk, nb = item % nblk, k0 = 64 * kb, n0 = 32 * nb;
    const int nd = n0 + (lane & 31);
    int sc = nd; bool valid = true;
    if (MODE == 1) { if (nd < 2048) sc = nd; else if (nd < 5120) sc = nd + 16; else if (nd < 5136) sc = 2048 + (nd - 5120); else { sc = 0; valid = false; } }
#pragma unroll 8
    for (int i = 0; i < 32; ++i) { const int kk = 2 * i + (lane >> 5); const float v = valid ? W[(size_t)(k0 + kk) * Nsrc + sc] : 0.f; scr[kk * 33 + (lane & 31)] = v; }
    LDS_WAIT(); asm volatile("" ::: "memory");
    const int c = lane & 7;
#pragma unroll
    for (int j = 0; j < 4; ++j) { const int n = (lane >> 3) + 8 * j; const LAS float* s = scr + (8 * c) * 33 + n;
        u32x4 o; o.x = pk2(s[0 * 33], s[1 * 33]); o.y = pk2(s[2 * 33], s[3 * 33]); o.z = pk2(s[4 * 33], s[5 * 33]); o.w = pk2(s[6 * 33], s[7 * 33]);
        *(u32x4*)(WT + (size_t)(n0 + n) * K + k0 + 8 * c) = o; }
    LDS_WAIT(); asm volatile("" ::: "memory");
}
template <bool F8, int NB>
__device__ __forceinline__ void rms_rows_to_bf16(int lane, const float* x0, size_t xstride, const float* g, bf16_t* o0, size_t ostride, unsigned* o80 = nullptr, size_t o8stride = 0) {
    f32x4 v[NB][4]; float s[NB];
#pragma unroll
    for (int b = 0; b < NB; ++b) { const f32x4* xr = (const f32x4*)(x0 + b * xstride) + lane;
#pragma unroll
        for (int j = 0; j < 4; ++j) v[b][j] = xr[64 * j]; }
#pragma unroll
    for (int b = 0; b < NB; ++b) { s[b] = 0.f;
#pragma unroll
        for (int j = 0; j < 4; ++j) s[b] += (v[b][j].x * v[b][j].x + v[b][j].y * v[b][j].y) + (v[b][j].z * v[b][j].z + v[b][j].w * v[b][j].w); }
#pragma unroll
    for (int o = 1; o < 64; o <<= 1) {
#pragma unroll
        for (int b = 0; b < NB; ++b) s[b] += __shfl_xor(s[b], o); }
    const f32x4* gr = (const f32x4*)g + lane;
#pragma unroll
    for (int b = 0; b < NB; ++b) { const float rstd = 1.f / sqrtf(s[b] * (1.f / D) + EPS); u32x2* o8 = (u32x2*)(o0 + b * ostride) + lane;
#pragma unroll
        for (int j = 0; j < 4; ++j) { const f32x4 gg = gr[64 * j]; const f32x4 y = v[b][j] * rstd * gg; u32x2 o; o.x = pk2(y.x, y.y); o.y = pk2(y.z, y.w); o8[64 * j] = o;
            if (F8) { int w = 0; w = __builtin_amdgcn_cvt_pk_fp8_f32(bflo(o.x) * 16.f, bfhi(o.x) * 16.f, w, false); w = __builtin_amdgcn_cvt_pk_fp8_f32(bflo(o.y) * 16.f, bfhi(o.y) * 16.f, w, true); (o80 + b * o8stride)[64 * j + lane] = (unsigned)w; } } }
}
__device__ __forceinline__ float wave_max(float v) {
#pragma unroll
    for (int o = 1; o < 64; o <<= 1) v = fmaxf(v, __shfl_xor(v, o));
    return v;
}
template <int NB>
__device__ __forceinline__ void cvt_rows_fp8(int lane, const float* const (&src)[NB], unsigned char* const (&dst16)[NB], float* const (&scale_out)[NB]) {
    f32x4 v[NB][4]; float m[NB];
#pragma unroll
    for (int b = 0; b < NB; ++b) {
#pragma unroll
        for (int j = 0; j < 4; ++j) v[b][j] = *(const GAS f32x4*)(src[b] + 16 * lane + 4 * j); }
#pragma unroll
    for (int b = 0; b < NB; ++b) { m[b] = 0.f;
#pragma unroll
        for (int j = 0; j < 4; ++j) m[b] = fmaxf(m[b], fmaxf(fmaxf(fabsf(v[b][j].x), fabsf(v[b][j].y)), fmaxf(fabsf(v[b][j].z), fabsf(v[b][j].w)))); }
#pragma unroll
    for (int o = 1; o < 64; o <<= 1) {
#pragma unroll
        for (int b = 0; b < NB; ++b) m[b] = fmaxf(m[b], __shfl_xor(m[b], o)); }
#pragma unroll
    for (int b = 0; b < NB; ++b) { const float inv = m[b] > 0.f ? 224.f / m[b] : 0.f, sc = m[b] > 0.f ? m[b] * (1.f / 224.f) : 1.f;
        u32x4 o;
#pragma unroll
        for (int j = 0; j < 4; ++j) { int w = 0; w = __builtin_amdgcn_cvt_pk_fp8_f32(v[b][j].x * inv, v[b][j].y * inv, w, false); w = __builtin_amdgcn_cvt_pk_fp8_f32(v[b][j].z * inv, v[b][j].w * inv, w, true); o[j] = (unsigned)w; }
        *(GAS u32x4*)dst16[b] = o;
        if (lane == 0) *(GAS float*)scale_out[b] = sc; }
}
__device__ __forceinline__ void convert_tables(const Frame& F, const Args& A, int wi, int nw) {
    unsigned char* ws = A.ws; const int gw = wi, NGW = nw;
    int mc = gw;
    for (; mc + 3 * NGW < 2 * NEXP; mc += 4 * NGW) { const int m = mc;
        const float* src[4]; unsigned char* dst[4]; float* sco[4];
#pragma unroll
        for (int b = 0; b < 4; ++b) { const int mm = m + b * NGW;
            if (mm < NEXP) { const int e = mm; src[b] = A.in[I_PU] + (size_t)e * D; dst[b] = ws + WS_U8 + (size_t)((e & 7) * 2048 + (e >> 3)) * 1024 + 16 * F.lane; sco[b] = (float*)(ws + WS_SU) + e; }
            else { const int e = mm - NEXP; src[b] = A.in[I_PV] + (size_t)e * D; dst[b] = ws + WS_V8 + ((size_t)(F.lane >> 3) * NEXP + e) * 128 + 16 * (F.lane & 7); sco[b] = (float*)(ws + WS_SV) + e; } }
        cvt_rows_fp8<4>(F.lane, src, dst, sco);
    }
    for (; mc < 2 * NEXP; mc += NGW) { const float* src[1]; unsigned char* dst[1]; float* sco[1];
        if (mc < NEXP) { const int e = mc; src[0] = A.in[I_PU] + (size_t)e * D; dst[0] = ws + WS_U8 + (size_t)((e & 7) * 2048 + (e >> 3)) * 1024 + 16 * F.lane; sco[0] = (float*)(ws + WS_SU) + e; }
        else { const int e = mc - NEXP; src[0] = A.in[I_PV] + (size_t)e * D; dst[0] = ws + WS_V8 + ((size_t)(F.lane >> 3) * NEXP + e) * 128 + 16 * (F.lane & 7); sco[0] = (float*)(ws + WS_SV) + e; }
        cvt_rows_fp8<1>(F.lane, src, dst, sco); }
}
__device__ __forceinline__ void phase0(const Frame& F, const Args& A) {
    unsigned char* ws = A.ws;
    {
        LAS float* kx = (LAS float*)F.lds;
        LAS float* wt = (LAS float*)(F.lds + 128 * 129 * 4);
        bf16_t* WQF = (bf16_t*)(ws + WS_WQF);
        for (int it = F.bid; it < 512; it += F.G) {
            const int hh = it >> 5, kblk = it & 31, k0 = kblk * 32;
            const float* kX = (hh & 1) ? A.in[I_K2] : A.in[I_K1];
            __syncthreads();
            for (int e = F.tid; e < 128 * 128; e += 512) kx[(e >> 7) * 129 + (e & 127)] = kX[e];
            for (int e = F.tid; e < 32 * 128; e += 512) wt[e] = A.in[I_WQ][(size_t)(k0 + (e >> 7)) * 2048 + hh * 128 + (e & 127)];
            __syncthreads();
            const int key = F.tid & 127, kq = F.tid >> 7;
            float acc[8];
#pragma unroll
            for (int i = 0; i < 8; ++i) acc[i] = 0.f;
            for (int d = 0; d < 128; ++d) { const float b = kx[key * 129 + d];
#pragma unroll
                for (int i = 0; i < 8; ++i) acc[i] += wt[(kq * 8 + i) * 128 + d] * b; }
            u32x4 o; o.x = pk2(acc[0], acc[1]); o.y = pk2(acc[2], acc[3]); o.z = pk2(acc[4], acc[5]); o.w = pk2(acc[6], acc[7]);
            *(u32x4*)(WQF + (size_t)(hh * 128 + key) * 1024 + k0 + kq * 8) = o;
        }
        __syncthreads();
    }
    LAS float* scr = (LAS float*)(F.lds + F.wave * 16384);
    const int gw = F.bid * NWAVES + F.wave, NGW = F.G * NWAVES;
    constexpr int I_IN = 16 * (NPROJ / 32), I_A = 8 * 32, I_B = 8 * 32, I_O = 16 * 32;
    constexpr int NITEMS = I_IN + I_A + I_B + I_O;
    for (int it = gw; it < NITEMS; it += NGW) {
        int r = it;
        if (r < I_IN) { p0_transpose_item<1>(A.in[I_WIN], 1024, 5136, NPROJ, (bf16_t*)(ws + WS_WIN), scr, r, F.lane); continue; } r -= I_IN;
        if (r < I_A) { p0_transpose_item<0>(A.in[I_WBA], 512, 1024, 1024, (bf16_t*)(ws + WS_WA), scr, r, F.lane); continue; } r -= I_A;
        if (r < I_B) { p0_transpose_item<0>(A.in[I_WBB], 512, 1024, 1024, (bf16_t*)(ws + WS_WB), scr, r, F.lane); continue; } r -= I_B;
        p0_transpose_item<0>(A.in[I_WOUT], 1024, 1024, 1024, (bf16_t*)(ws + WS_WOUT), scr, r, F.lane);
    }
    { int m = gw; for (; m + 3 * NGW < T_TOK; m += 4 * NGW) rms_rows_to_bf16<false, 4>(F.lane, A.in[I_X] + (size_t)m * D, (size_t)NGW * D, A.in[I_N1G], (bf16_t*)(ws + WS_N1) + (size_t)m * D, (size_t)NGW * D);
      for (; m < T_TOK; m += NGW) rms_rows_to_bf16<false, 1>(F.lane, A.in[I_X] + (size_t)m * D, 0, A.in[I_N1G], (bf16_t*)(ws + WS_N1) + (size_t)m * D, 0); }
}

__device__ __forceinline__ float log_sigmoid(float z) { return fminf(z, 0.f) - log1pf(__expf(-fabsf(z))); }

template <bool DRY>
__device__ __forceinline__ void gla_chunk_phase(const Frame& F, const Args& A) {
    unsigned char* ws = A.ws;
    const bf16_t* P = (const bf16_t*)(ws + WS_P);
    const float* ALR = (const float*)(ws + WS_ALR);
    LAS float* alr = (LAS float*)F.lds;
    LAS float* tot = (LAS float*)(F.lds + 4096);
    LAS bf16_t* kdT = (LAS bf16_t*)(F.lds + 8192);
    LAS bf16_t* vT = (LAS bf16_t*)(F.lds + 26624);
    LAS bf16_t* stT = (LAS bf16_t*)(F.lds + 45056);
    const int tid = F.tid, kk = tid & 127, seg = tid >> 7;
    const bool hconst = (F.G & 3) == 0;
    int hcur = -1; float w[16]; float bias = 0.f;
#pragma unroll
    for (int j = 0; j < 16; ++j) w[j] = 0.f;
    float na0, na1; bf16_t nk[16], nv[16];
#define GC_LOAD(unit) do { const int h_ = (unit) & 3, c_ = ((unit) >> 2) & 63, b_ = (unit) >> 8; const int t0_ = b_ * SEQ + c_ * 64; \
        na0 = ALR[(size_t)t0_ * 16 + tid]; na1 = ALR[(size_t)t0_ * 16 + 512 + tid]; \
        const bf16_t* kp_ = P + (size_t)(t0_ + 16 * seg) * PLD + PC_K + h_ * 128 + kk; const bf16_t* vp_ = P + (size_t)(t0_ + 16 * seg) * PLD + PC_V + h_ * 128 + kk; \
        _Pragma("unroll") for (int i_ = 0; i_ < 16; ++i_) { nk[i_] = kp_[(size_t)i_ * PLD]; nv[i_] = vp_[(size_t)i_ * PLD]; } } while (0)
    int unit = F.bid;
    if (unit < 2048) GC_LOAD(unit);
    for (; unit < 2048; unit += F.G) {
        const int h = unit & 3;
        if (h != hcur) { hcur = h;
#pragma unroll
            for (int j = 0; j < 16; ++j) w[j] = A.in[I_WGU][(size_t)j * 512 + h * 128 + kk];
            bias = A.in[I_BG][h * 128 + kk]; }
        __syncthreads();
        alr[tid] = na0; alr[512 + tid] = na1;
        bf16_t kr[16], vr[16];
#pragma unroll
        for (int i = 0; i < 16; ++i) { kr[i] = nk[i]; vr[i] = nv[i]; }
        if (unit + F.G < 2048) GC_LOAD(unit + F.G);
        __syncthreads();
        float cum[16]; float run = 0.f;
#pragma unroll
        for (int i = 0; i < 16; ++i) { const LAS f32x4* ap = (const LAS f32x4*)(alr + (16 * seg + i) * 16); float z = bias;
#pragma unroll
            for (int q = 0; q < 4; ++q) { const f32x4 a4 = ap[q]; z += a4.x * w[4 * q] + a4.y * w[4 * q + 1] + a4.z * w[4 * q + 2] + a4.w * w[4 * q + 3]; }
            const float ls = fminf(z, 0.f) - __logf(1.f + __expf(-fabsf(z)));
            run += ls * (1.f / 16.f); cum[i] = run; }
        tot[seg * 128 + kk] = run;
        __syncthreads();
        {
            const float t0s = tot[kk], t1s = tot[128 + kk], t2s = tot[256 + kk], t3s = tot[384 + kk];
            const float total = (t0s + t1s) + (t2s + t3s);
            const float prefix = seg == 0 ? 0.f : (seg == 1 ? t0s : (seg == 2 ? t0s + t1s : t0s + t1s + t2s));
            unsigned kw[8], vw[8];
#pragma unroll
            for (int i = 0; i < 8; ++i) {
                const float e0 = __expf(total - (prefix + cum[2 * i])), e1 = __expf(total - (prefix + cum[2 * i + 1]));
                kw[i] = pk2(bf1(kr[2 * i]) * e0, bf1(kr[2 * i + 1]) * e1); vw[i] = (unsigned)vr[2 * i] | ((unsigned)vr[2 * i + 1] << 16);
            }
            *(LAS u32x4*)(kdT + kk * 72 + 16 * seg) = (u32x4){kw[0], kw[1], kw[2], kw[3]}; *(LAS u32x4*)(kdT + kk * 72 + 16 * seg + 8) = (u32x4){kw[4], kw[5], kw[6], kw[7]};
            *(LAS u32x4*)(vT + kk * 72 + 16 * seg) = (u32x4){vw[0], vw[1], vw[2], vw[3]}; *(LAS u32x4*)(vT + kk * 72 + 16 * seg + 8) = (u32x4){vw[4], vw[5], vw[6], vw[7]};
            if (seg == 0) ((float*)(DRY ? (unsigned char*)A.out + 96 * MiB : ws + WS_DEC))[(size_t)unit * 128 + kk] = __expf(total);
        }
        __syncthreads();
        {
            const int w8 = F.wave, l = F.lane, fr = l & 15, fq = l >> 4;
            f32x4 acc[8];
#pragma unroll
            for (int n = 0; n < 8; ++n) acc[n] = (f32x4){0.f, 0.f, 0.f, 0.f};
#pragma unroll
            for (int ks = 0; ks < 2; ++ks) {
                const bf16x8 a = *(const LAS bf16x8*)(kdT + (16 * w8 + fr) * 72 + 32 * ks + 8 * fq);
#pragma unroll
                for (int n = 0; n < 8; ++n) { const bf16x8 bb = *(const LAS bf16x8*)(vT + (16 * n + fr) * 72 + 32 * ks + 8 * fq);
                    acc[n] = __builtin_amdgcn_mfma_f32_16x16x32_bf16(a, bb, acc[n], 0, 0, 0); }
            }
#pragma unroll
            for (int n = 0; n < 8; ++n) { u32x2 o; o.x = pk2(acc[n][0], acc[n][1]); o.y = pk2(acc[n][2], acc[n][3]);
                *(LAS u32x2*)(stT + (16 * n + fr) * 136 + 16 * w8 + 4 * fq) = o; }
        }
        __syncthreads();
        {
            bf16_t* ST = (bf16_t*)(DRY ? (unsigned char*)A.out : ws + WS_N1) + (size_t)unit * 16384;
            const int vv = tid >> 2, part = tid & 3;
#pragma unroll
            for (int q = 0; q < 4; ++q) *(u32x4*)(ST + (size_t)vv * 128 + 32 * part + 8 * q) = *(const LAS u32x4*)(stT + vv * 136 + 32 * part + 8 * q);
        }
    }
#undef GC_LOAD
    (void)hconst;
}

template <bool DRY>
__device__ __forceinline__ void sgu_unit(const Frame& F, const Args& A, int unit) {
    const int g = unit & 3, blk = (unit >> 2) & 31, b = unit >> 7;
    const int t0 = b * SEQ + blk * 128;
    bf16_t* P = (bf16_t*)(A.ws + WS_P);
    LAS bf16_t* wA = (LAS bf16_t*)F.lds;
    LAS bf16_t* vnT = (LAS bf16_t*)(F.lds + 34816);
    LAS float* st = (LAS float*)(F.lds + 69632);
    LAS bf16_t* suS = (LAS bf16_t*)(F.lds + 70656);
    const int tid = F.tid;
    __syncthreads();
    {
        const int j = tid >> 2, q = tid & 3;
        const bf16_t* sp = P + (size_t)(t0 + j) * PLD + PC_SV + q * 128;
        float s = 0.f, s2 = 0.f;
#pragma unroll
        for (int i = 0; i < 16; ++i) { const u32x4 w = *(const u32x4*)(sp + 8 * i);
            const float f[8] = {bflo(w.x), bfhi(w.x), bflo(w.y), bfhi(w.y), bflo(w.z), bfhi(w.z), bflo(w.w), bfhi(w.w)};
#pragma unroll
            for (int e = 0; e < 8; ++e) { s += f[e]; s2 += f[e] * f[e]; } }
        s += __shfl_xor(s, 1); s += __shfl_xor(s, 2); s2 += __shfl_xor(s2, 1); s2 += __shfl_xor(s2, 2);
        const float mu = s * (1.f / 512.f); const float var = fmaxf(s2 * (1.f / 512.f) - mu * mu, 0.f);
        if (q == 0) { st[2 * j] = mu; st[2 * j + 1] = 1.f / sqrtf(var + EPS); }
    }
    {
        const int i = tid >> 2, jb = (tid & 3) * 32;
        const float* wp = A.in[I_SW] + (size_t)g * 16384 + (size_t)i * 128 + jb;
        const bf16_t* sup = P + (size_t)(t0 + i) * PLD + PC_SU + g * 128 + jb;
#pragma unroll
        for (int q = 0; q < 4; ++q) { const f32x4 a = *(const f32x4*)(wp + 8 * q), bq = *(const f32x4*)(wp + 8 * q + 4);
            const bool z = (i < 64) && (jb + 8 * q >= 64);
            u32x4 o; o.x = pk2(a.x, a.y); o.y = pk2(a.z, a.w); o.z = pk2(bq.x, bq.y); o.w = pk2(bq.z, bq.w);
            if (z) o = (u32x4){0u, 0u, 0u, 0u};
            *(LAS u32x4*)(wA + i * 136 + jb + 8 * q) = o;
            *(LAS u32x4*)(suS + i * 136 + jb + 8 * q) = *(const u32x4*)(sup + 8 * q); }
    }
    const int cch = tid & 127, seg = tid >> 7;
    bf16_t xr[32];
    { const bf16_t* sp = P + (size_t)(t0 + 32 * seg) * PLD + PC_SV + g * 128 + cch;
#pragma unroll
      for (int i = 0; i < 32; ++i) xr[i] = sp[(size_t)i * PLD]; }
    const float lg = A.in[I_SLNG][g * 128 + cch], lb = A.in[I_SLNB][g * 128 + cch];
    __syncthreads();
    {
        unsigned ow[16];
#pragma unroll
        for (int i = 0; i < 16; ++i) { const int j = 32 * seg + 2 * i; const f32x4 ms = *(const LAS f32x4*)(st + 2 * j);
            ow[i] = pk2((bf1(xr[2 * i]) - ms.x) * ms.y * lg + lb, (bf1(xr[2 * i + 1]) - ms.z) * ms.w * lg + lb); }
#pragma unroll
        for (int q = 0; q < 4; ++q) *(LAS u32x4*)(vnT + cch * 136 + 32 * seg + 8 * q) = (u32x4){ow[4 * q], ow[4 * q + 1], ow[4 * q + 2], ow[4 * q + 3]};
    }
    __syncthreads();
    {
        const int w = F.wave, l = F.lane, fr = l & 15, fq = l >> 4;
        f32x4 acc[8];
#pragma unroll
        for (int n = 0; n < 8; ++n) acc[n] = (f32x4){0.f, 0.f, 0.f, 0.f};
#pragma unroll
        for (int ks = 0; ks < 4; ++ks) {
            const bf16x8 a = *(const LAS bf16x8*)(wA + (16 * w + fr) * 136 + 32 * ks + 8 * fq);
#pragma unroll
            for (int n = 0; n < 8; ++n) { const bf16x8 bb = *(const LAS bf16x8*)(vnT + (16 * n + fr) * 136 + 32 * ks + 8 * fq);
                acc[n] = __builtin_amdgcn_mfma_f32_16x16x32_bf16(a, bb, acc[n], 0, 0, 0); }
        }
#pragma unroll
        for (int jj = 0; jj < 4; ++jj) { const int i = 16 * w + 4 * fq + jj; const float bias = A.in[I_SB][g * 128 + i];
            LAS bf16_t* rp = suS + i * 136 + fr;
#pragma unroll
            for (int n = 0; n < 8; ++n) { const float su = bf1(rp[16 * n]); rp[16 * n] = (bf16_t)f2bf(su * (acc[n][jj] + bias)); } }
    }
    __syncthreads();
    {
        const int i = tid >> 2, jb = (tid & 3) * 32;
        bf16_t* yp = DRY ? (bf16_t*)A.out + (size_t)(t0 + i) * 512 + g * 128 + jb : P + (size_t)(t0 + i) * PLD + PC_SU + g * 128 + jb;
#pragma unroll
        for (int q = 0; q < 4; ++q) *(u32x4*)(yp + 8 * q) = *(const LAS u32x4*)(suS + i * 136 + jb + 8 * q);
    }
}

template <bool DRY>
__device__ __forceinline__ void gla_scan(const Frame& F, const Args& A) {
    bf16_t* ST = (bf16_t*)(A.ws + WS_N1); bf16_t* STO = DRY ? (bf16_t*)A.out : ST; const float* DEC = (const float*)(A.ws + WS_DEC);
    for (int gi = F.bid * 512 + F.tid; gi < 131072; gi += F.G * 512) {
        const int k4 = gi & 31, vv = (gi >> 5) & 127, h = (gi >> 12) & 3, b = gi >> 14;
        float s0 = 0.f, s1 = 0.f, s2 = 0.f, s3 = 0.f;
        u32x2 wa[8], wb[8]; f32x4 da[8], db[8];
#define SCAN_LOAD(W, Dd, c0) do { _Pragma("unroll") for (int i_ = 0; i_ < 8; ++i_) { const size_t u_ = (size_t)((b * 64 + (c0) + i_) * 4 + h); \
            W[i_] = *(const u32x2*)(ST + u_ * 16384 + (size_t)vv * 128 + k4 * 4); Dd[i_] = *(const f32x4*)(DEC + u_ * 128 + k4 * 4); } } while (0)
#define SCAN_STEP(W, Dd, c0) do { _Pragma("unroll") for (int i_ = 0; i_ < 8; ++i_) { const size_t u_ = (size_t)((b * 64 + (c0) + i_) * 4 + h); \
            s0 = Dd[i_].x * s0 + bflo(W[i_].x); s1 = Dd[i_].y * s1 + bfhi(W[i_].x); s2 = Dd[i_].z * s2 + bflo(W[i_].y); s3 = Dd[i_].w * s3 + bfhi(W[i_].y); \
            u32x2 o_; o_.x = pk2(s0, s1); o_.y = pk2(s2, s3); *(u32x2*)(STO + u_ * 16384 + (size_t)vv * 128 + k4 * 4) = o_; } } while (0)
        SCAN_LOAD(wa, da, 0);
#pragma unroll
        for (int c0 = 0; c0 < 64; c0 += 16) {
            SCAN_LOAD(wb, db, c0 + 8);
            SCAN_STEP(wa, da, c0);
            if (c0 + 16 < 64) SCAN_LOAD(wa, da, c0 + 16);
            SCAN_STEP(wb, db, c0 + 8);
        }
#undef SCAN_LOAD
#undef SCAN_STEP
    }
}

template <bool DRY>
__device__ __forceinline__ void gla_out_phase(const Frame& F, const Args& A) {
    bf16_t* P = (bf16_t*)(A.ws + WS_P);
    LAS bf16_t* qA = (LAS bf16_t*)F.lds;
    LAS bf16_t* sB = (LAS bf16_t*)(F.lds + 17408);
    LAS float* oF = (LAS float*)(F.lds + 52224);
    const int tid = F.tid, s = tid >> 3, cb = (tid & 7) * 16, vv = tid >> 2, kb = (tid & 3) * 32;
    u32x4 nq0, nq1, ns0, ns1, ns2, ns3, nr0, nr1;
#define GO_LOAD(unit) do { const int h_ = (unit) & 3, c_ = ((unit) >> 2) & 63, b_ = (unit) >> 8; const int t0_ = b_ * SEQ + c_ * 64; \
        const bf16_t* qp_ = P + (size_t)(t0_ + s) * PLD + PC_Q + h_ * 128 + cb; nq0 = *(const u32x4*)qp_; nq1 = *(const u32x4*)(qp_ + 8); \
        const bf16_t* sp_ = (const bf16_t*)(A.ws + WS_N1) + (size_t)(unit) * 16384 + (size_t)vv * 128 + kb; ns0 = *(const u32x4*)sp_; ns1 = *(const u32x4*)(sp_ + 8); ns2 = *(const u32x4*)(sp_ + 16); ns3 = *(const u32x4*)(sp_ + 24); \
        const bf16_t* rp_ = P + (size_t)(t0_ + s) * PLD + PC_R + h_ * 128 + cb; nr0 = *(const u32x4*)rp_; nr1 = *(const u32x4*)(rp_ + 8); } while (0)
    int unit = F.bid;
    if (unit < 2048) GO_LOAD(unit);
    for (; unit < 2048; unit += F.G) {
        const int h = unit & 3, c = (unit >> 2) & 63, b = unit >> 8;
        const int t0 = b * SEQ + c * 64;
        __syncthreads();
        *(LAS u32x4*)(qA + s * 136 + cb) = nq0; *(LAS u32x4*)(qA + s * 136 + cb + 8) = nq1;
        *(LAS u32x4*)(sB + vv * 136 + kb) = ns0; *(LAS u32x4*)(sB + vv * 136 + kb + 8) = ns1; *(LAS u32x4*)(sB + vv * 136 + kb + 16) = ns2; *(LAS u32x4*)(sB + vv * 136 + kb + 24) = ns3;
        const u32x4 r0 = nr0, r1 = nr1;
        if (unit + F.G < 2048) GO_LOAD(unit + F.G);
        __syncthreads();
        {
            const int w = F.wave, l = F.lane, fr = l & 15, fq = l >> 4, m = w & 3, nh = w >> 2;
            f32x4 acc[4];
#pragma unroll
            for (int n = 0; n < 4; ++n) acc[n] = (f32x4){0.f, 0.f, 0.f, 0.f};
#pragma unroll
            for (int ks = 0; ks < 4; ++ks) {
                const bf16x8 a = *(const LAS bf16x8*)(qA + (16 * m + fr) * 136 + 32 * ks + 8 * fq);
#pragma unroll
                for (int n = 0; n < 4; ++n) { const bf16x8 bb = *(const LAS bf16x8*)(sB + (16 * (4 * nh + n) + fr) * 136 + 32 * ks + 8 * fq);
                    acc[n] = __builtin_amdgcn_mfma_f32_16x16x32_bf16(a, bb, acc[n], 0, 0, 0); }
            }
            const float scale = 0.08838834764831845f;
#pragma unroll
            for (int n = 0; n < 4; ++n)
#pragma unroll
                for (int jj = 0; jj < 4; ++jj) oF[(16 * m + 4 * fq + jj) * 132 + 16 * (4 * nh + n) + fr] = acc[n][jj] * scale;
        }
        __syncthreads();
        {
            float o[16]; float ss = 0.f;
#pragma unroll
            for (int i = 0; i < 16; ++i) { o[i] = oF[s * 132 + cb + i]; ss += o[i] * o[i]; }
            ss += __shfl_xor(ss, 1); ss += __shfl_xor(ss, 2); ss += __shfl_xor(ss, 4);
            const float rstd = 1.f / sqrtf(ss * (1.f / 128.f) + EPS);
            const unsigned rw[8] = {r0.x, r0.y, r0.z, r0.w, r1.x, r1.y, r1.z, r1.w};
            const float* gg = A.in[I_GLAG] + h * 128 + cb;
            unsigned ow[8];
#pragma unroll
            for (int i = 0; i < 8; ++i) { const float y0 = o[2 * i] * rstd * gg[2 * i] * siluf_(bflo(rw[i])), y1 = o[2 * i + 1] * rstd * gg[2 * i + 1] * siluf_(bfhi(rw[i])); ow[i] = pk2(y0, y1); }
            bf16_t* yp = DRY ? (bf16_t*)A.out + (size_t)(t0 + s) * 512 + h * 128 + cb : P + (size_t)(t0 + s) * PLD + PC_Q + h * 128 + cb;
            *(u32x4*)yp = (u32x4){ow[0], ow[1], ow[2], ow[3]}; *(u32x4*)(yp + 8) = (u32x4){ow[4], ow[5], ow[6], ow[7]};
        }
    }
#undef GO_LOAD
}

__device__ __forceinline__ unsigned ordkey(float v) { const unsigned u = __builtin_bit_cast(unsigned, v); return u ^ ((unsigned)((int)u >> 31) | 0x80000000u); }
__device__ __forceinline__ float unord(unsigned k) { const unsigned u = (k & 0x80000000u) ? (k & 0x7fffffffu) : ~k; return __builtin_bit_cast(float, u); }
#define INS16(r, xin) do { unsigned _x = (xin); _Pragma("unroll") for (int _i = 0; _i < 16; ++_i) { const unsigned _h = max((r)[_i], _x); _x = min((r)[_i], _x); (r)[_i] = _h; } } while (0)

#define CE(a, b) do { const unsigned _h = max((a), (b)), _l = min((a), (b)); (a) = _h; (b) = _l; } while (0)
#define SORT16(v) do { CE(v[0], v[1]); CE(v[2], v[3]); CE(v[0], v[2]); CE(v[1], v[3]); CE(v[1], v[2]); CE(v[4], v[5]); CE(v[6], v[7]); CE(v[4], v[6]); CE(v[5], v[7]); CE(v[5], v[6]); CE(v[0], v[4]); CE(v[2], v[6]); CE(v[2], v[4]); CE(v[1], v[5]); CE(v[3], v[7]); CE(v[3], v[5]); CE(v[1], v[2]); CE(v[3], v[4]); CE(v[5], v[6]); CE(v[8], v[9]); CE(v[10], v[11]); CE(v[8], v[10]); CE(v[9], v[11]); CE(v[9], v[10]); CE(v[12], v[13]); CE(v[14], v[15]); CE(v[12], v[14]); CE(v[13], v[15]); CE(v[13], v[14]); CE(v[8], v[12]); CE(v[10], v[14]); CE(v[10], v[12]); CE(v[9], v[13]); CE(v[11], v[15]); CE(v[11], v[13]); CE(v[9], v[10]); CE(v[11], v[12]); CE(v[13], v[14]); CE(v[0], v[8]); CE(v[4], v[12]); CE(v[4], v[8]); CE(v[2], v[10]); CE(v[6], v[14]); CE(v[6], v[10]); CE(v[2], v[4]); CE(v[6], v[8]); CE(v[10], v[12]); CE(v[1], v[9]); CE(v[5], v[13]); CE(v[5], v[9]); CE(v[3], v[11]); CE(v[7], v[15]); CE(v[7], v[11]); CE(v[3], v[5]); CE(v[7], v[9]); CE(v[11], v[13]); CE(v[1], v[2]); CE(v[3], v[4]); CE(v[5], v[6]); CE(v[7], v[8]); CE(v[9], v[10]); CE(v[11], v[12]); CE(v[13], v[14]); } while (0)
#define MERGE16(T, S) do { _Pragma("unroll") for (int _i = 0; _i < 16; ++_i) (T)[_i] = max((T)[_i], (S)[15 - _i]); \
    _Pragma("unroll") for (int _d = 8; _d >= 1; _d >>= 1) { _Pragma("unroll") for (int _i = 0; _i < 16; ++_i) if ((_i & _d) == 0) CE((T)[_i], (T)[_i + _d]); } } while (0)
__device__ __forceinline__ void peer_topk(const Frame& F, const Args& A) {
    const float* SC = (const float*)(A.ws + WS_P + P_SC);
    int* IDX = (int*)(A.ws + WS_P + P_IDX); float* GATE = (float*)(A.ws + WS_P + P_GATE);
    const int gw = F.bid * NWAVES + F.wave, NGW = F.G * NWAVES;
    for (int it = gw; it < 512 * 8; it += NGW) {
        const int h = it & 7, tb = it >> 3; const int tok = tb * 64 + F.lane;
        unsigned r1[16], r2[16], rc[16];
        const float* p1 = SC + ((size_t)(tok >> 4) * 512 + h * 64) * 64 + (tok & 15) * 4; const float* p2 = p1 + 32 * 64;
        {
            float raw[128]; unsigned sg[16];
#pragma unroll
            for (int jq = 0; jq < 32; ++jq) { const f32x4 t4 = *(const f32x4*)(p1 + jq * 64); raw[4 * jq] = t4.x; raw[4 * jq + 1] = t4.y; raw[4 * jq + 2] = t4.z; raw[4 * jq + 3] = t4.w; }
#pragma unroll
            for (int j = 0; j < 16; ++j) r1[j] = (ordkey(raw[j]) & ~127u) | (unsigned)(127 - j);
            SORT16(r1);
#pragma unroll
            for (int gq = 1; gq < 8; ++gq) {
#pragma unroll
                for (int j = 0; j < 16; ++j) sg[j] = (ordkey(raw[16 * gq + j]) & ~127u) | (unsigned)(127 - (16 * gq + j));
                SORT16(sg); MERGE16(r1, sg); }
#pragma unroll
            for (int jq = 0; jq < 32; ++jq) { const f32x4 t4 = *(const f32x4*)(p2 + jq * 64); raw[4 * jq] = t4.x; raw[4 * jq + 1] = t4.y; raw[4 * jq + 2] = t4.z; raw[4 * jq + 3] = t4.w; }
#pragma unroll
            for (int j = 0; j < 16; ++j) r2[j] = (ordkey(raw[j]) & ~127u) | (unsigned)(127 - j);
            SORT16(r2);
#pragma unroll
            for (int gq = 1; gq < 8; ++gq) {
#pragma unroll
                for (int j = 0; j < 16; ++j) sg[j] = (ordkey(raw[16 * gq + j]) & ~127u) | (unsigned)(127 - (16 * gq + j));
                SORT16(sg); MERGE16(r2, sg); }
        }
        float v1[16], v2[16];
#pragma unroll
        for (int i = 0; i < 16; ++i) { v1[i] = unord((r1[i] & ~127u) | 64u); v2[i] = unord((r2[i] & ~127u) | 64u); }
        {
            unsigned cg[4][16]; int cn = 0;
#pragma unroll
            for (int a = 0; a < 16; ++a)
#pragma unroll
                for (int bq = 0; bq < 16; ++bq) if ((a + 1) * (bq + 1) <= 16) { cg[cn >> 4][cn & 15] = (ordkey(v1[a] + v2[bq]) & ~255u) | (unsigned)(a * 16 + bq); ++cn; }
#pragma unroll
            for (int z = 50; z < 64; ++z) cg[z >> 4][z & 15] = 0u;
            SORT16(cg[0]); SORT16(cg[1]); SORT16(cg[2]); SORT16(cg[3]);
            MERGE16(cg[0], cg[1]); MERGE16(cg[0], cg[2]); MERGE16(cg[0], cg[3]);
#pragma unroll
            for (int i = 0; i < 16; ++i) rc[i] = cg[0][i];
        }
        float val[16]; int ex[16];
        {
            LAS unsigned* t1 = (LAS unsigned*)(F.lds + F.wave * 8704) + F.lane * 17; LAS unsigned* t2 = t1 + 64 * 17;
#pragma unroll
            for (int i = 0; i < 16; ++i) { t1[i] = r1[i]; t2[i] = r2[i]; }
            LDS_WAIT(); asm volatile("" ::: "memory");
#pragma unroll
            for (int w = 0; w < 16; ++w) {
                const int a = (rc[w] >> 4) & 15, bq = rc[w] & 15;
                const unsigned k1 = t1[a], k2 = t2[bq];
                val[w] = unord((k1 & ~127u) | 64u) + unord((k2 & ~127u) | 64u);
                ex[w] = (127 - (int)(k1 & 127u)) * 128 + (127 - (int)(k2 & 127u));
            }
            LDS_WAIT(); asm volatile("" ::: "memory");
        }
        float mx = val[0];
#pragma unroll
        for (int w = 1; w < 16; ++w) mx = fmaxf(mx, val[w]);
        float sum = 0.f;
#pragma unroll
        for (int w = 0; w < 16; ++w) { val[w] = __expf(val[w] - mx); sum += val[w]; }
        const float inv = 1.f / sum;
        int* ip = IDX + (size_t)tok * 128 + h * 16; float* gp = GATE + (size_t)tok * 128 + h * 16;
#pragma unroll
        for (int q = 0; q < 4; ++q) { *(int4*)(ip + 4 * q) = make_int4(ex[4 * q], ex[4 * q + 1], ex[4 * q + 2], ex[4 * q + 3]);
            *(f32x4*)(gp + 4 * q) = (f32x4){val[4 * q] * inv, val[4 * q + 1] * inv, val[4 * q + 2] * inv, val[4 * q + 3] * inv}; }
    }
}

#define DPP_ADD(v, ctrl) ((v) + __builtin_bit_cast(float, __builtin_amdgcn_mov_dpp(__builtin_bit_cast(int, (v)), (ctrl), 0xf, 0xf, true)))
__device__ __forceinline__ void fp8x16_to_f32x2(const u32x4 r, f32x2* f) {
#pragma unroll
    for (int q = 0; q < 4; ++q) { f[2 * q] = __builtin_amdgcn_cvt_pk_f32_fp8((int)r[q], false); f[2 * q + 1] = __builtin_amdgcn_cvt_pk_f32_fp8((int)r[q], true); }
}
__device__ __forceinline__ void fp8x16_to_f32(const u32x4 r, float* f) {
#pragma unroll
    for (int q = 0; q < 4; ++q) { const f32x2 lo = __builtin_amdgcn_cvt_pk_f32_fp8((int)r[q], false), hi = __builtin_amdgcn_cvt_pk_f32_fp8((int)r[q], true);
        f[4 * q] = lo.x; f[4 * q + 1] = lo.y; f[4 * q + 2] = hi.x; f[4 * q + 3] = hi.y; }
}
__device__ __forceinline__ long lo64(u32x4 v) { return (long)(((unsigned long)v.y << 32) | (unsigned long)v.x); }
__device__ __forceinline__ long hi64(u32x4 v) { return (long)(((unsigned long)v.w << 32) | (unsigned long)v.z); }
template <int MODE>
__device__ __forceinline__ void peer_u_phase(const Frame& F, const Args& A) {
    const unsigned char* X8 = A.ws + WS_P + P_X8;
    const unsigned char* U8 = A.ws + WS_U8; const float* SU = (const float*)(A.ws + WS_SU); const float* SV = (const float*)(A.ws + WS_SV);
    const int* IDX = (const int*)(A.ws + WS_P + P_IDX); const float* GATE = (const float*)(A.ws + WS_P + P_GATE); float* AK = (float*)(MODE == 0 ? A.ws + WS_AK : A.ws + WS_P + P_SC);
    const int g = F.bid & 7, nmem = F.G >> 3, l = F.lane, step = nmem * NWAVES;
    const int loff = 64 * (l & 15) + 16 * (l >> 4);
    const bool dg = ((l & 15) >> 2) == (l >> 4); const int dr = l & 3;
    const float dw0 = (dg && dr == 0) ? 1.f : 0.f, dw1 = (dg && dr == 1) ? 1.f : 0.f, dw2 = (dg && dr == 2) ? 1.f : 0.f, dw3 = (dg && dr == 3) ? 1.f : 0.f;
    LAS int* le = (LAS int*)(F.lds + F.wave * 2048); LAS int* lk = le + 256;
    const bool b5 = (l & 32) != 0, b4 = (l & 16) != 0, b3 = (l & 8) != 0;
    int tok = 2 * ((F.bid >> 3) * NWAVES + F.wave);
    u32x4 nxA, nxB; int neA0, neA1, neB0, neB1; float ngA0, ngA1, ngB0, ngB1;
#define U_PREFETCH(t) do { const size_t _tA = (size_t)(t), _tB = (size_t)(t) + 1; if (MODE == 4) { nxA = (u32x4){(unsigned)_tA, 1u, 2u, 3u}; nxB = nxA; neA0 = (int)((_tA * 37 + l * 11) & 16383); neA1 = (int)((_tA * 53 + l * 7) & 16383); neB0 = (int)((_tB * 37 + l * 13) & 16383); neB1 = (int)((_tB * 29 + l * 3) & 16383); ngA0 = ngA1 = ngB0 = ngB1 = 0.01f; break; } nxA = *(const u32x4*)(X8 + _tA * 1024 + loff); nxB = *(const u32x4*)(X8 + _tB * 1024 + loff); \
        neA0 = IDX[_tA * 128 + l]; neA1 = IDX[_tA * 128 + 64 + l]; neB0 = IDX[_tB * 128 + l]; neB1 = IDX[_tB * 128 + 64 + l]; \
        ngA0 = GATE[_tA * 128 + l]; ngA1 = GATE[_tA * 128 + 64 + l]; ngB0 = GATE[_tB * 128 + l]; ngB1 = GATE[_tB * 128 + 64 + l]; } while (0)
    if (tok + 1 < T_TOK) U_PREFETCH(tok);
    for (; tok + 1 < T_TOK; tok += 2 * step) {
        const int tokA = tok, tokB = tok + 1;
        const u32x4 xA = nxA, xB = nxB;
        const int eA0 = neA0, eA1 = neA1, eB0 = neB0, eB1 = neB1; const float gA0 = ngA0, gA1 = ngA1, gB0 = ngB0, gB1 = ngB1;
        bool pf_done = false;
        const bool oA0 = (eA0 & 7) == g, oA1 = (eA1 & 7) == g, oB0 = (eB0 & 7) == g, oB1 = (eB1 & 7) == g;
        const unsigned long long mA0 = __ballot(oA0), mA1 = __ballot(oA1), mB0 = __ballot(oB0), mB1 = __ballot(oB1);
        const int c0 = __popcll(mA0), c1 = c0 + __popcll(mA1), c2 = c1 + __popcll(mB0), n = c2 + __popcll(mB1);
#define MBC(m) __builtin_amdgcn_mbcnt_hi((unsigned)((m) >> 32), __builtin_amdgcn_mbcnt_lo((unsigned)(m), 0u))
        if (oA0) { const int p = MBC(mA0); le[p] = (eA0 << 8) | l; lk[p] = __builtin_bit_cast(int, gA0); }
        if (oA1) { const int p = c0 + MBC(mA1); le[p] = (eA1 << 8) | (64 + l); lk[p] = __builtin_bit_cast(int, gA1); }
        if (oB0) { const int p = c1 + MBC(mB0); le[p] = (eB0 << 8) | 128 | l; lk[p] = __builtin_bit_cast(int, gB0); }
        if (oB1) { const int p = c2 + MBC(mB1); le[p] = (eB1 << 8) | 128 | (64 + l); lk[p] = __builtin_bit_cast(int, gB1); }
#undef MBC
        LDS_WAIT(); asm volatile("" ::: "memory");
        for (int cb = 0; cb < n || cb == 0; cb += 64) {
        const int nc = min(n, cb + 64);
        const bool fv = (cb + l) < nc;
        const int ent = fv ? le[cb + l] : 0; const float gt = fv ? __builtin_bit_cast(float, lk[cb + l]) : 0.f; float tot = 0.f;
        const float su = SU[ent >> 8], sv = SV[ent >> 8];
        const unsigned long long radr = (unsigned long long)(U8 + (size_t)(((ent >> 8) & 7) * 2048 + (((ent >> 8) >> 3) & (MODE == 2 ? 255 : 2047))) * 1024);
        const int ralo = (int)(unsigned)radr, rahi = (int)(unsigned)(radr >> 32);
        for (int i = cb; i < nc; i += 16) {
            u32x4 row[2][8];
#pragma unroll
            for (int b = 0; b < 2; ++b) if (i + 8 * b < nc) {
#pragma unroll
                for (int j = 0; j < 8; ++j) { const int ln = min(i + 8 * b + j, nc - 1) - cb;
                    const unsigned lo = (unsigned)__builtin_amdgcn_readlane(ralo, ln), hi = (unsigned)__builtin_amdgcn_readlane(rahi, ln);
                    const GAS unsigned char* rp = (const GAS unsigned char*)(((unsigned long long)hi << 32) | lo);
                    row[b][j] = *(const GAS u32x4*)(rp + (unsigned)loff); } }
            if (!pf_done) { pf_done = true; if (tok + 2 * step + 1 < T_TOK) U_PREFETCH(tok + 2 * step); }
#pragma unroll
            for (int b = 0; b < 2; ++b) if (i + 8 * b < nc) {
                float p[8];
                f32x4 accj[8];
                const int base0 = i + 8 * b;
                if (base0 + 8 <= c1) {
#pragma unroll
                    for (int j = 0; j < 8; ++j) accj[j] = __builtin_amdgcn_mfma_f32_16x16x32_fp8_fp8(lo64(row[b][j]), lo64(xA), (f32x4){0.f, 0.f, 0.f, 0.f}, 0, 0, 0);
#pragma unroll
                    for (int j = 0; j < 8; ++j) accj[j] = __builtin_amdgcn_mfma_f32_16x16x32_fp8_fp8(hi64(row[b][j]), hi64(xA), accj[j], 0, 0, 0);
                } else if (base0 >= c1) {
#pragma unroll
                    for (int j = 0; j < 8; ++j) accj[j] = __builtin_amdgcn_mfma_f32_16x16x32_fp8_fp8(lo64(row[b][j]), lo64(xB), (f32x4){0.f, 0.f, 0.f, 0.f}, 0, 0, 0);
#pragma unroll
                    for (int j = 0; j < 8; ++j) accj[j] = __builtin_amdgcn_mfma_f32_16x16x32_fp8_fp8(hi64(row[b][j]), hi64(xB), accj[j], 0, 0, 0);
                } else {
#pragma unroll
                    for (int j = 0; j < 8; ++j) { const u32x4 xs = (base0 + j >= c1) ? xB : xA; accj[j] = __builtin_amdgcn_mfma_f32_16x16x32_fp8_fp8(lo64(row[b][j]), lo64(xs), (f32x4){0.f, 0.f, 0.f, 0.f}, 0, 0, 0);
                        accj[j] = __builtin_amdgcn_mfma_f32_16x16x32_fp8_fp8(hi64(row[b][j]), hi64(xs), accj[j], 0, 0, 0); }
                }
#pragma unroll
                for (int j = 0; j < 8; ++j) p[j] = __builtin_fmaf(accj[j][3], dw3, __builtin_fmaf(accj[j][2], dw2, __builtin_fmaf(accj[j][1], dw1, accj[j][0] * dw0)));
                float q4[4], q2[2], q1;
#pragma unroll
                for (int j = 0; j < 4; ++j) { const float keep = b5 ? p[4 + j] : p[j], send = b5 ? p[j] : p[4 + j]; q4[j] = keep + __shfl_xor(send, 32); }
#pragma unroll
                for (int j = 0; j < 2; ++j) { const float keep = b4 ? q4[2 + j] : q4[j], send = b4 ? q4[j] : q4[2 + j]; q2[j] = keep + __shfl_xor(send, 16); }
                { const float keep = b3 ? q2[1] : q2[0], send = b3 ? q2[0] : q2[1]; q1 = keep + __shfl_xor(send, 8); }
                q1 = DPP_ADD(q1, 0xB1); q1 = DPP_ADD(q1, 0x4E); q1 = DPP_ADD(q1, 0x141);
                const float t = __builtin_bit_cast(float, __builtin_amdgcn_ds_bpermute((l & 7) * 32, __builtin_bit_cast(int, q1)));
                const int base = i + 8 * b;
                if ((l >> 3) == ((base - cb) >> 3)) tot = t;
            }
        }
        if (!pf_done) { if (tok + 2 * step + 1 < T_TOK) U_PREFETCH(tok + 2 * step); }
        if (fv) { const int tk = (ent & 128) ? tokB : tokA; AK[(size_t)tk * 128 + (ent & 127)] = gelu_tanh(tot * su * (1.f / 16.f)) * gt * sv; }
        if (n == 0) break;
        }
        LDS_WAIT(); asm volatile("" ::: "memory");
    }
#undef U_PREFETCH
}
__device__ __forceinline__ float wave_max_nonneg(float v) {
    unsigned u = __builtin_bit_cast(unsigned, v);
    u = max(u, (unsigned)__builtin_amdgcn_mov_dpp((int)u, 0xB1, 0xf, 0xf, true));
    u = max(u, (unsigned)__builtin_amdgcn_mov_dpp((int)u, 0x4E, 0xf, 0xf, true));
    u = max(u, (unsigned)__builtin_amdgcn_mov_dpp((int)u, 0x141, 0xf, 0xf, true));
    u = max(u, (unsigned)__builtin_amdgcn_mov_dpp((int)u, 0x140, 0xf, 0xf, true));
    const unsigned a = (unsigned)__builtin_amdgcn_readlane((int)u, 0), b = (unsigned)__builtin_amdgcn_readlane((int)u, 16), c = (unsigned)__builtin_amdgcn_readlane((int)u, 32), d = (unsigned)__builtin_amdgcn_readlane((int)u, 48);
    return __builtin_bit_cast(float, max(max(a, b), max(c, d)));
}
template <int MODE>
__device__ __forceinline__ void peer_v_phase(const Frame& F, const Args& A) {
    const unsigned char* V8 = A.ws + WS_V8; const int* IDX = (const int*)(A.ws + WS_P + P_IDX); const float* AK = (const float*)(A.ws + WS_AK);
    float* out = MODE == 0 ? A.out : (float*)(A.ws + WS_P + P_SC);
    const int g = F.bid & 7, nmem = F.G >> 3, l = F.lane, sub = l & 7, rr = l >> 3, n16 = l & 15, q = l >> 4, step = nmem * NWAVES;
    const GAS unsigned char* vb = (const GAS unsigned char*)(V8 + (size_t)g * NEXP * 128);
    LAS unsigned long long* rep = (LAS unsigned long long*)(F.lds + F.wave * 2048);
    const unsigned long long bm = 0xFFull << (8 * (n16 & 7));
    const int repi = 2 * q + (n16 >> 3);
    const bool vl = (n16 < 8) && (q < 2);
    LAS float* stg = (LAS float*)(F.lds + 16384 + F.wave * 512);
    int tok = 2 * ((F.bid >> 3) * NWAVES + F.wave);
    int ne[4]; float na[4];
#define V_PREFETCH(t) do { const size_t _a = (size_t)(t) * 128, _b = ((size_t)(t) + 1) * 128; ne[0] = IDX[_a + l]; ne[1] = IDX[_a + 64 + l]; ne[2] = IDX[_b + l]; ne[3] = IDX[_b + 64 + l]; \
        na[0] = AK[_a + l]; na[1] = AK[_a + 64 + l]; na[2] = AK[_b + l]; na[3] = AK[_b + 64 + l]; } while (0)
    if (tok + 1 < T_TOK) V_PREFETCH(tok);
    for (; tok + 1 < T_TOK; tok += 2 * step) {
        const int e0 = ne[0], e1 = ne[1], e2 = ne[2], e3 = ne[3]; const float a0 = na[0], a1 = na[1], a2 = na[2], a3 = na[3];
        u32x4 rowA[16], rowB[16];
#pragma unroll
        for (int i = 0; i < 16; ++i) { const int src = (8 * (i & 7) + rr) * 4;
            const int ea = __builtin_amdgcn_ds_bpermute(src, i < 8 ? e0 : e1), eb = __builtin_amdgcn_ds_bpermute(src, i < 8 ? e2 : e3);
            rowA[i] = *(const GAS u32x4*)(vb + ((unsigned)ea * 128u + 16u * (unsigned)sub)); rowB[i] = *(const GAS u32x4*)(vb + ((unsigned)eb * 128u + 16u * (unsigned)sub)); }
        f32x4 HA = {0.f, 0.f, 0.f, 0.f}, HB = {0.f, 0.f, 0.f, 0.f};
        if (l < 32) { const float* hpa = out + (size_t)tok * D + g * 128 + 4 * l; HA = *(const f32x4*)hpa; HB = *(const f32x4*)(hpa + D); }
        if (tok + 2 * step + 1 < T_TOK) V_PREFETCH(tok + 2 * step);
        const float amA = wave_max_nonneg(fmaxf(fabsf(a0), fabsf(a1))), amB = wave_max_nonneg(fmaxf(fabsf(a2), fabsf(a3)));
        const float scA = amA > 0.f ? 224.f * __builtin_amdgcn_rcpf(amA) : 0.f, invA = amA * (1.f / 224.f), scB = amB > 0.f ? 224.f * __builtin_amdgcn_rcpf(amB) : 0.f, invB = amB * (1.f / 224.f);
        { const unsigned wA = (unsigned)__builtin_amdgcn_cvt_pk_fp8_f32(a0 * scA, a1 * scA, 0, false), wB = (unsigned)__builtin_amdgcn_cvt_pk_fp8_f32(a2 * scB, a3 * scB, 0, false);
          const unsigned r0 = (wA & 0xffu) * 0x01010101u, r1 = ((wA >> 8) & 0xffu) * 0x01010101u, r2 = (wB & 0xffu) * 0x01010101u, r3 = ((wB >> 8) & 0xffu) * 0x01010101u;
          rep[l] = ((unsigned long long)r0 << 32) | r0; rep[64 + l] = ((unsigned long long)r1 << 32) | r1; rep[128 + l] = ((unsigned long long)r2 << 32) | r2; rep[192 + l] = ((unsigned long long)r3 << 32) | r3; }
        LDS_WAIT(); asm volatile("" ::: "memory");
#pragma unroll
        for (int t2 = 0; t2 < 2; ++t2) {
            f32x4 alo = {0.f, 0.f, 0.f, 0.f}, ahi = {0.f, 0.f, 0.f, 0.f};
#pragma unroll
            for (int i = 0; i < 16; ++i) { const long bop = (long)(rep[128 * t2 + 8 * i + repi] & bm); const u32x4 rw = t2 ? rowB[i] : rowA[i];
                alo = __builtin_amdgcn_mfma_f32_16x16x32_fp8_fp8(lo64(rw), bop, alo, 0, 0, 0);
                ahi = __builtin_amdgcn_mfma_f32_16x16x32_fp8_fp8(hi64(rw), bop, ahi, 0, 0, 0); }
            const float inv = t2 ? invB : invA;
            float vlo[4], vhi[4];
#pragma unroll
            for (int r = 0; r < 4; ++r) { const float tl = alo[r], th = ahi[r];
                vlo[r] = (tl + __builtin_bit_cast(float, __builtin_amdgcn_ds_bpermute(((l + 40) & 63) * 4, __builtin_bit_cast(int, tl)))) * inv;
                vhi[r] = (th + __builtin_bit_cast(float, __builtin_amdgcn_ds_bpermute(((l + 40) & 63) * 4, __builtin_bit_cast(int, th)))) * inv; }
            if (vl) {
#pragma unroll
                for (int r = 0; r < 4; ++r) { stg[64 * q + 16 * r + n16] = vlo[r]; stg[64 * q + 16 * r + n16 + 8] = vhi[r]; } }
            LDS_WAIT(); asm volatile("" ::: "memory");
            if (l < 32) { const f32x4 dv = *(const LAS f32x4*)(stg + 4 * l); *(f32x4*)(out + (size_t)(tok + t2) * D + g * 128 + 4 * l) = (t2 ? HB : HA) + dv; }
            LDS_WAIT(); asm volatile("" ::: "memory");
        }
        LDS_WAIT(); asm volatile("" ::: "memory");
    }
#undef V_PREFETCH
}
__device__ __forceinline__ void final_norm_phase(const Frame& F, const Args& A) {
    const int gw = F.bid * NWAVES + F.wave, NGW = F.G * NWAVES, l = F.lane; const float* fg = A.in[I_FG];
    const f32x4* gp = (const f32x4*)fg + l;
    int tok = gw;
    for (; tok + 3 * NGW < T_TOK; tok += 4 * NGW) {
        f32x4 v[4][4]; float ss[4];
#pragma unroll
        for (int b = 0; b < 4; ++b) { const f32x4* hp = (const f32x4*)(A.out + (size_t)(tok + b * NGW) * D) + l;
#pragma unroll
            for (int j = 0; j < 4; ++j) v[b][j] = hp[64 * j]; }
#pragma unroll
        for (int b = 0; b < 4; ++b) { ss[b] = 0.f;
#pragma unroll
            for (int j = 0; j < 4; ++j) ss[b] += (v[b][j].x * v[b][j].x + v[b][j].y * v[b][j].y) + (v[b][j].z * v[b][j].z + v[b][j].w * v[b][j].w); }
#pragma unroll
        for (int o = 1; o < 64; o <<= 1) {
#pragma unroll
            for (int b = 0; b < 4; ++b) ss[b] += __shfl_xor(ss[b], o); }
#pragma unroll
        for (int b = 0; b < 4; ++b) { const float rstd = 1.f / sqrtf(ss[b] * (1.f / D) + EPS); f32x4* hp = (f32x4*)(A.out + (size_t)(tok + b * NGW) * D) + l;
#pragma unroll
            for (int j = 0; j < 4; ++j) hp[64 * j] = v[b][j] * rstd * gp[64 * j]; }
    }
    for (; tok < T_TOK; tok += NGW) { f32x4* hp = (f32x4*)(A.out + (size_t)tok * D) + l; f32x4 v[4]; float ss = 0.f;
#pragma unroll
        for (int j = 0; j < 4; ++j) { v[j] = hp[64 * j]; ss += (v[j].x * v[j].x + v[j].y * v[j].y) + (v[j].z * v[j].z + v[j].w * v[j].w); }
        const float rstd = 1.f / sqrtf(wave_sum(ss) * (1.f / D) + EPS);
#pragma unroll
        for (int j = 0; j < 4; ++j) hp[64 * j] = v[j] * rstd * gp[64 * j]; }
}

#ifdef DEBUG_CHECK
constexpr size_t WS_DBG = 472 * MiB;
__device__ __forceinline__ int dbg_tok(int i) { return (i * 509 + 3) & 32767; }
__device__ __forceinline__ float gelu_ref(float x) { return 0.5f * x * (1.f + tanhf(0.7978845608028654f * (x + 0.044715f * x * x * x))); }
__global__ void __launch_bounds__(512) dbg_scores(Args a) {
    __shared__ float n2s[1024]; __shared__ float q[2048];
    const int t = dbg_tok(blockIdx.x), tid = threadIdx.x;
    const bf16_t* N2 = (const bf16_t*)(a.ws + WS_N1); const float* SC = (const float*)(a.ws + WS_P + P_SC); unsigned* dbg = (unsigned*)(a.ws + WS_DBG);
    for (int k = tid; k < 1024; k += 512) n2s[k] = bf1(N2[(size_t)t * 1024 + k]);
    __syncthreads();
    for (int r = 0; r < 4; ++r) { const int c = tid + 512 * r; float s = 0.f; for (int k = 0; k < 1024; ++k) s += n2s[k] * a.in[I_WQ][(size_t)k * 2048 + c]; q[c] = s; }
    __syncthreads();
    float md = 0.f;
    for (int r = 0; r < 4; ++r) { const int n = tid + 512 * r, hh = n >> 7, key = n & 127; const float* kX = (hh & 1) ? a.in[I_K2] : a.in[I_K1];
        float s = 0.f; for (int d = 0; d < 128; ++d) s += q[hh * 128 + d] * kX[key * 128 + d];
        md = fmaxf(md, fabsf(s - SC[(size_t)n * T_TOK + t])); }
    atomicMax(&dbg[0], __builtin_bit_cast(unsigned, md));
}
__global__ void __launch_bounds__(64) dbg_topk(Args a) {
    __shared__ float s1[8][128], s2[8][128], cv[8][256]; __shared__ float t1v[8][16], t2v[8][16]; __shared__ int t1i[8][16], t2i[8][16], exi[8][16]; __shared__ float exv[8][16];
    const int t = dbg_tok(blockIdx.x), h = threadIdx.x;
    const float* SC = (const float*)(a.ws + WS_P + P_SC); const int* IDX = (const int*)(a.ws + WS_P + P_IDX); const float* GATE = (const float*)(a.ws + WS_P + P_GATE); unsigned* dbg = (unsigned*)(a.ws + WS_DBG);
    if (h >= 8) return;
    for (int j = 0; j < 128; ++j) { s1[h][j] = SC[(size_t)(h * 256 + j) * T_TOK + t]; s2[h][j] = SC[(size_t)(h * 256 + 128 + j) * T_TOK + t]; }
    for (int r = 0; r < 16; ++r) { int b1 = 0, b2 = 0; for (int j = 1; j < 128; ++j) { if (s1[h][j] > s1[h][b1]) b1 = j; if (s2[h][j] > s2[h][b2]) b2 = j; }
        t1v[h][r] = s1[h][b1]; t1i[h][r] = b1; s1[h][b1] = -1e30f; t2v[h][r] = s2[h][b2]; t2i[h][r] = b2; s2[h][b2] = -1e30f; }
    for (int c = 0; c < 256; ++c) cv[h][c] = t1v[h][c >> 4] + t2v[h][c & 15];
    for (int r = 0; r < 16; ++r) { int bc = 0; for (int c = 1; c < 256; ++c) if (cv[h][c] > cv[h][bc]) bc = c;
        exv[h][r] = cv[h][bc]; exi[h][r] = t1i[h][bc >> 4] * 128 + t2i[h][bc & 15]; cv[h][bc] = -1e30f; }
    float sum = 0.f; const float mx0 = exv[h][0]; for (int r = 0; r < 16; ++r) { exv[h][r] = expf(exv[h][r] - mx0); } for (int r = 0; r < 16; ++r) sum += exv[h][r];
    unsigned miss = 0; float gd = 0.f;
    for (int w = 0; w < 16; ++w) { const int e = IDX[(size_t)t * 128 + h * 16 + w]; const float g = GATE[(size_t)t * 128 + h * 16 + w]; bool found = false;
        for (int r = 0; r < 16; ++r) if (exi[h][r] == e) { found = true; gd = fmaxf(gd, fabsf(g - exv[h][r] / sum)); }
        if (!found) ++miss; }
    atomicAdd(&dbg[1], miss); atomicMax(&dbg[3], __builtin_bit_cast(unsigned, gd));
}
__global__ void __launch_bounds__(512) dbg_experts_pre(Args a) {
    __shared__ float n2s[1024]; __shared__ float ak[128]; __shared__ int ek[128]; __shared__ float red[8];
    const int t = dbg_tok(blockIdx.x), tid = threadIdx.x, lane = tid & 63, wave = tid >> 6;
    const bf16_t* N2 = (const bf16_t*)(a.ws + WS_N1); const int* IDX = (const int*)(a.ws + WS_P + P_IDX); const float* GATE = (const float*)(a.ws + WS_P + P_GATE);
    float* rows = (float*)(a.ws + WS_DBG + MiB);
    for (int k = tid; k < 1024; k += 512) n2s[k] = bf1(N2[(size_t)t * 1024 + k]);
    if (tid < 128) ek[tid] = IDX[(size_t)t * 128 + tid];
    __syncthreads();
    for (int k = wave * 16; k < wave * 16 + 16; ++k) { const float* u = a.in[I_PU] + (size_t)ek[k] * 1024; float s = 0.f; for (int j = lane; j < 1024; j += 64) s += u[j] * n2s[j];
        s = wave_sum(s); if (lane == 0) ak[k] = gelu_ref(s) * GATE[(size_t)t * 128 + k]; }
    __syncthreads();
    float h2[2]; float ss = 0.f;
    for (int r = 0; r < 2; ++r) { const int d = tid + 512 * r; float o = 0.f; for (int k = 0; k < 128; ++k) o += ak[k] * a.in[I_PV][(size_t)ek[k] * 1024 + d]; h2[r] = a.out[(size_t)t * 1024 + d] + o; ss += h2[r] * h2[r]; }
    ss = wave_sum(ss); if (lane == 0) red[wave] = ss; __syncthreads();
    float tot = 0.f; for (int w = 0; w < 8; ++w) tot += red[w];
    const float rstd = 1.f / sqrtf(tot / 1024.f + EPS);
    for (int r = 0; r < 2; ++r) { const int d = tid + 512 * r; rows[(size_t)blockIdx.x * 1024 + d] = h2[r] * rstd * a.in[I_FG][d]; }
}
__global__ void __launch_bounds__(512) dbg_experts_post(Args a) {
    const int t = dbg_tok(blockIdx.x), tid = threadIdx.x; const float* rows = (const float*)(a.ws + WS_DBG + MiB); float* dbgf = (float*)(a.ws + WS_DBG);
    float e = 0.f, n = 0.f;
    for (int r = 0; r < 2; ++r) { const int d = tid + 512 * r; const float x = rows[(size_t)blockIdx.x * 1024 + d], y = a.out[(size_t)t * 1024 + d]; e += (x - y) * (x - y); n += x * x; }
    e = wave_sum(e); n = wave_sum(n); if ((tid & 63) == 0) { atomicAdd(&dbgf[4], e); atomicAdd(&dbgf[5], n); }
}
__global__ void __launch_bounds__(512) dbg_report(Args a, int which) {
    const unsigned* dbg = (const unsigned*)(a.ws + WS_DBG); const float* dbgf = (const float*)(a.ws + WS_DBG);
    const float mA = dbgf[0], gd = dbgf[3]; const unsigned miss = dbg[1]; const float relC = sqrtf(dbgf[4] / fmaxf(dbgf[5], 1e-30f));
    float X;
    if (which == 0) { int mask = 0; if (mA > 0.05f) mask |= 1; if (miss > 400u) mask |= 2; if (relC > 0.05f) mask |= 4; if (gd > 0.02f) mask |= 8; X = 1000.f + 100.f * mask; }
    else if (which == 1) X = 1e6f * mA; else if (which == 2) X = 100.f + (float)miss; else if (which == 3) X = 1e6f * relC; else X = 1e6f * gd;
    for (size_t i = (size_t)blockIdx.x * 512 + threadIdx.x; i < (size_t)T_TOK * D; i += (size_t)gridDim.x * 512) a.out[i] = (i == 0) ? X : 0.f;
}
#endif

constexpr int NPH = 13;
__global__ void __launch_bounds__(NWAVES * 64, 2) fwd_kernel(Args args) {
    extern __shared__ __attribute__((aligned(16))) unsigned char lds_raw[];
    Frame F;
    F.lds = (LAS unsigned char*)lds_raw;
    F.tid = threadIdx.x; F.lane = F.tid & 63; F.wave = __builtin_amdgcn_readfirstlane(F.tid >> 6);
    F.G = gridDim.x; F.bid = blockIdx.x;
    volatile LAS unsigned* MISC = (volatile LAS unsigned*)(F.lds + MISC_OFF);
    for (int u = F.tid; u < (LDS_BYTES - LDSCTL_OFF) / 4; u += NWAVES * 64) ((LAS unsigned*)(F.lds + LDSCTL_OFF))[u] = 0u;
    __syncthreads();
    unsigned* ctl = (unsigned*)(args.ws + WS_CTL);
    const int lo = args.ph_lo, hi = args.ph_hi;
    XcdBarrier bar; bar.bar = ctl + CW_BAR + args.li * XCD_BAR_WORDS; bar.x = 0; bar.st = nullptr;
    if (hi - lo > 1) bar = xcd_barrier_post(ctl + CW_BAR + args.li * XCD_BAR_WORDS, MISC + 8);
#define IN(k) (lo <= (k) && (k) < hi)
#ifdef PROBE_TS
#define STAMP(k) do { if (F.bid == 0 && F.tid == 0) ((unsigned long long*)(args.ws + (472u << 20)))[(k)] = __builtin_amdgcn_s_memrealtime(); } while (0)
#else
#define STAMP(k) do { } while (0)
#endif
#define SEAM(k) do { if (IN(k) && IN((k) + 1)) { xcd_barrier(bar); if (XTRA_BAR) xcd_barrier(bar); } STAMP((k) + 1); } while (0)
    unsigned char* ws = args.ws;
    bf16_t* P = (bf16_t*)(ws + WS_P);

    STAMP(0);
    if (IN(0)) { phase0(F, args); SEAM(0); }
    if (IN(1)) {
        pg8::Gemm g{(const bf16_t*)(ws + WS_N1), (const bf16_t*)(ws + WS_WIN), T_TOK, NPROJ, D, D}; pg8::StaticOrder S; S.init(T_TOK, NPROJ, F.G, F.bid);
        pg8::EpiProj E{P, (float*)(ws + WS_ALR)};
        pg8::gemm_phase<pg8::EpiProj, pg8::StaticOrder, false, true>(F.lds, g, S, E);
        {
            const int nwg = (T_TOK / 256) * (NPROJ / 256), rem = nwg % F.G;
            if (rem == 0) convert_tables(F, args, F.bid * NWAVES + F.wave, F.G * NWAVES);
            else if (F.bid >= rem) convert_tables(F, args, (F.bid - rem) * NWAVES + F.wave, (F.G - rem) * NWAVES);
        }
        SEAM(1);
    }
    if (IN(2)) {
        gla_chunk_phase<false>(F, args);
        for (int it = F.bid; it < 1024; it += F.G) sgu_unit<false>(F, args, it);
        SEAM(2);
    }
    if (IN(3)) { if (DRY_EXP == 13) { gla_scan<true>(F, args); __syncthreads(); } gla_scan<false>(F, args); SEAM(3); }
    if (IN(4)) { if (DRY_EXP == 14) { gla_out_phase<true>(F, args); __syncthreads(); } gla_out_phase<false>(F, args); SEAM(4); }
    if (IN(5)) {
        { pg8::Gemm g{P + PC_Q, (const bf16_t*)(ws + WS_WA), T_TOK, D, 512, PLD}; pg8::StaticOrder S; S.init(T_TOK, D, F.G, F.bid);
          pg8::EpiBrA E{P}; pg8::gemm_phase<pg8::EpiBrA, pg8::StaticOrder, true, true>(F.lds, g, S, E); }
        { pg8::Gemm g{P + PC_SU, (const bf16_t*)(ws + WS_WB), T_TOK, D, 512, PLD}; pg8::StaticOrder S; S.init(T_TOK, D, F.G, F.bid);
          pg8::EpiBrB E{P}; pg8::gemm_phase<pg8::EpiBrB, pg8::StaticOrder, true, true>(F.lds, g, S, E); }
        SEAM(5);
    }
    if (IN(6)) {
        pg8::Gemm g{P + PC_MRG, (const bf16_t*)(ws + WS_WOUT), T_TOK, D, D, PLD}; pg8::StaticOrder S; S.init(T_TOK, D, F.G, F.bid);
        pg8::EpiOut E{args.in[I_X], args.out}; pg8::gemm_phase<pg8::EpiOut, pg8::StaticOrder, true, true>(F.lds, g, S, E);
        SEAM(6);
    }
    if (IN(7)) {
        const int gw = F.bid * NWAVES + F.wave, NGW = F.G * NWAVES;
        { int m = gw; for (; m + 3 * NGW < T_TOK; m += 4 * NGW) rms_rows_to_bf16<true, 4>(F.lane, args.out + (size_t)m * D, (size_t)NGW * D, args.in[I_N2G], (bf16_t*)(ws + WS_N1) + (size_t)m * D, (size_t)NGW * D, (unsigned*)(ws + WS_P + P_X8) + (size_t)m * 256, (size_t)NGW * 256);
          for (; m < T_TOK; m += NGW) rms_rows_to_bf16<true, 1>(F.lane, args.out + (size_t)m * D, 0, args.in[I_N2G], (bf16_t*)(ws + WS_N1) + (size_t)m * D, 0, (unsigned*)(ws + WS_P + P_X8) + (size_t)m * 256, 0); }
        SEAM(7);
    }
    if (IN(8)) {
        pg8::Gemm g{(const bf16_t*)(ws + WS_N1), (const bf16_t*)(ws + WS_WQF), T_TOK, 2048, D, D}; pg8::StaticOrder S; S.init(T_TOK, 2048, F.G, F.bid);
        pg8::EpiScores E{(float*)(ws + WS_P + P_SC)}; pg8::gemm_phase<pg8::EpiScores, pg8::StaticOrder, true, true>(F.lds, g, S, E);
        SEAM(8);
    }
    if (IN(9)) { peer_topk(F, args); SEAM(9); }
    if (IN(10)) { if (DRY_EXP == 2) { peer_u_phase<1>(F, args); __syncthreads(); } if (DRY_EXP == 3) { peer_u_phase<2>(F, args); __syncthreads(); } if (DRY_EXP == 4) { peer_u_phase<3>(F, args); __syncthreads(); } if (DRY_EXP == 5) { peer_u_phase<4>(F, args); __syncthreads(); } peer_u_phase<0>(F, args); SEAM(10); }
    if (IN(11)) { if (DRY_EXP == 1) { peer_v_phase<1>(F, args); __syncthreads(); } peer_v_phase<0>(F, args); SEAM(11); }
    if (IN(12)) { final_norm_phase(F, args); }
#undef IN
#undef SEAM
}


#ifdef PROBE_TS
__global__ void __launch_bounds__(512) probe_report(Args a, int pi, int pj) {
    const unsigned long long* ts = (const unsigned long long*)(a.ws + (472u << 20));
    const float X1 = 10.f * (float)(ts[pi + 1] - ts[pi]) * 0.01f, X2 = (float)(ts[pj + 1] - ts[pj]) * 0.01f;
    for (size_t i = (size_t)blockIdx.x * 512 + threadIdx.x; i < (size_t)T_TOK * D; i += (size_t)gridDim.x * 512) a.out[i] = (i == 0) ? X1 : X2;
}
#endif
extern "C" void kernel_launch(void* const* d_in, const int* in_sizes, int n_in, void* d_out, int out_size, void* d_ws, size_t ws_size, hipStream_t stream) {
    static int grid = 0;
    if (grid == 0) {
        if (n_in != 20 || in_sizes[0] != T_TOK * D || out_size != T_TOK * D || ws_size < WS_END) {
            fprintf(stderr, "kernel_launch: unexpected shapes: n_in %d in0 %d out %d ws %zu (need %zu)\n", n_in, n_in > 0 ? in_sizes[0] : -1, out_size, ws_size, (size_t)WS_END); grid = -1; return; }
        int dev = 0, cus = 0;
        if (hipGetDevice(&dev) != hipSuccess || hipDeviceGetAttribute(&cus, hipDeviceAttributeMultiprocessorCount, dev) != hipSuccess) { grid = -1; return; }
        if (hipFuncSetAttribute((const void*)fwd_kernel, hipFuncAttributeMaxDynamicSharedMemorySize, LDS_BYTES) != hipSuccess) { fprintf(stderr, "kernel_launch: hipFuncSetAttribute failed\n"); grid = -1; return; }
        int per_cu = 0;
        if (hipOccupancyMaxActiveBlocksPerMultiprocessor(&per_cu, (const void*)fwd_kernel, NWAVES * 64, LDS_BYTES) != hipSuccess || per_cu < 1) fprintf(stderr, "kernel_launch: occupancy query says %d\n", per_cu);
        (void)hipGetLastError();
        grid = cus;
    }
    if (grid < 0) return;
    (void)hipMemsetAsync((char*)d_ws + WS_CTL, 0, CTL_ZERO_BYTES, stream);
    Args a{};
    for (int i = 0; i < 20; ++i) a.in[i] = (const float*)d_in[i];
    a.out = (float*)d_out; a.ws = (unsigned char*)d_ws;
#ifndef LAUNCH_LIST
#define LAUNCH_LIST {0, NPH}
#endif
    static const int ranges[][2] = { LAUNCH_LIST };
    const int nl = (int)(sizeof(ranges) / sizeof(ranges[0]));
    for (int li = 0; li < nl; ++li) { a.ph_lo = ranges[li][0]; a.ph_hi = ranges[li][1]; a.li = li;
        hipLaunchKernelGGL(fwd_kernel, dim3(grid), dim3(NWAVES * 64), LDS_BYTES, stream, a); }
}
```

```cpp
#include <hip/hip_runtime.h>
#include <cstdio>
#include <cstdint>


#ifndef XTRA_BAR
#define XTRA_BAR 0
#endif
#ifndef DRY_EXP
#define DRY_EXP 0
#endif
#ifndef DUP_PHASE
#define DUP_PHASE -1
#endif
#ifndef MK_N_LAUNCHES
#define MK_N_LAUNCHES 1
#endif

#define LAS __attribute__((address_space(3)))
#define GAS __attribute__((address_space(1)))
typedef unsigned short bf16_t;
typedef short bf16x8 __attribute__((ext_vector_type(8)));
typedef float f32x4 __attribute__((ext_vector_type(4)));
typedef float f32x2 __attribute__((ext_vector_type(2)));
typedef unsigned u32x4 __attribute__((ext_vector_type(4)));
typedef unsigned u32x2 __attribute__((ext_vector_type(2)));
typedef __bf16 bf16x2_t __attribute__((ext_vector_type(2)));

constexpr int T_TOK = 32768, D = 1024, SEQ = 4096, NBATCH = 8;
constexpr int NPROJ = 5376;
constexpr int PLD = 5120;
constexpr int PC_Q = 0, PC_K = 512, PC_V = 1024, PC_R = 1536, PC_SU = 2048, PC_SV = 2560, PC_GA = 3072, PC_GB = 4096;
constexpr int PC_MRG = 512;
constexpr float EPS = 1e-6f;
constexpr int NEXP = 16384;
#ifndef U_NG
#define U_NG 4
#endif
constexpr int UNG = U_NG, UNG_SH = (U_NG == 8 ? 3 : (U_NG == 4 ? 2 : 1));

constexpr size_t MiB = 1u << 20;
constexpr size_t WS_CTL = 0, CTL_ZERO_BYTES = 64 * 1024;
constexpr size_t WS_WIN = 1 * MiB;
constexpr size_t WS_WA = 12 * MiB;
constexpr size_t WS_WB = 13 * MiB;
constexpr size_t WS_WOUT = 14 * MiB;
constexpr size_t WS_WQF = 16 * MiB;
constexpr size_t WS_U8 = 20 * MiB;
constexpr size_t WS_V8 = 36 * MiB;
constexpr size_t WS_SU = 52 * MiB;
constexpr size_t WS_SV = 52 * MiB + 65536;
constexpr size_t WS_AK = 53 * MiB;
constexpr size_t WS_DEC = 84 * MiB;
constexpr size_t WS_ALR = 85 * MiB;
constexpr size_t WS_N1 = 87 * MiB;
constexpr size_t WS_P = 151 * MiB;
constexpr size_t WS_END = 471 * MiB;
constexpr size_t P_SC = 0, P_IDX = 256 * MiB, P_GATE = 272 * MiB, P_X8 = 288 * MiB;

constexpr int CW_BAR = 4096;

constexpr int RING_BYTES = 131072;
constexpr int LDSCTL_OFF = RING_BYTES, MISC_OFF = LDSCTL_OFF + 320;
constexpr int LDS_BYTES = 147456;
constexpr int NWAVES = 8;

__device__ __forceinline__ unsigned pk2(float lo, float hi) { const f32x2 v = {lo, hi}; const bf16x2_t b = __builtin_convertvector(v, bf16x2_t); return __builtin_bit_cast(unsigned, b); }
__device__ __forceinline__ unsigned f2bf(float f) { return pk2(f, 0.f) & 0xffffu; }
__device__ __forceinline__ float bflo(unsigned w) { return __builtin_bit_cast(float, w << 16); }
__device__ __forceinline__ float bfhi(unsigned w) { return __builtin_bit_cast(float, w & 0xffff0000u); }
__device__ __forceinline__ float bf1(bf16_t h) { return __builtin_bit_cast(float, ((unsigned)h) << 16); }
__device__ __forceinline__ float sigmoidf_(float x) { return __builtin_amdgcn_rcpf(1.f + __expf(-x)); }
__device__ __forceinline__ float gelu_tanh(float x) { const float y = 1.5957691216057308f * (x + 0.044715f * x * x * x); return x * sigmoidf_(y); }
__device__ __forceinline__ float siluf_(float x) { return x * sigmoidf_(x); }
__device__ __forceinline__ float wave_sum(float v) {
#pragma unroll
    for (int o = 1; o < 64; o <<= 1) v += __shfl_xor(v, o);
    return v;
}
#define LDS_WAIT() asm volatile("s_waitcnt lgkmcnt(0)" ::: "memory")
#define VM_WAIT() asm volatile("s_waitcnt vmcnt(0)" ::: "memory")

namespace pg8 {
constexpr int BM = 256, BK = 64, HALF = 128, HTB = HALF * BK * 2, STAGE_BYTES = 8 * HTB, NXCD = 8, WGM = 8;
__host__ __device__ __forceinline__ int lds_byte(int r, int c) { const int st = (r >> 4) * 2 + (c >> 5), rr = r & 15, cc = c & 31, ob = rr * 64 + cc * 2; return st * 1024 + (ob ^ (((ob >> 9) & 1) << 5)); }
__host__ __device__ __forceinline__ void stage_rc(int b, int& R, int& C) { const int st = b / 1024, sb = b % 1024, swz = sb ^ (((sb >> 9) & 1) << 5); R = (st >> 1) * 16 + swz / 64; C = (st & 1) * 32 + (swz % 64) / 2; }
__host__ __device__ __forceinline__ int perm32(int rho) { const int n = rho >> 4, i = rho & 15; return 8 * (i >> 2) + 4 * n + (i & 3); }

struct Unit { int pm, pn; };
struct Gemm { const bf16_t* A; const bf16_t* Bt; int M, N, K, lda; };

struct StaticOrder {
    int nM, nN, nwg, G, c;
    __host__ __device__ void init(int M, int N, int G_, int c_) { nM = M / BM; nN = N / BM; nwg = nM * nN; G = G_; c = c_; }
    __host__ __device__ bool next(int i, Unit& u) const {
        const long L = (long)i * G + c; if (L >= nwg) return false;
        int wgid = (int)L; { const int q = nwg / NXCD, r = nwg % NXCD, xcd = wgid % NXCD, off = wgid / NXCD; wgid = (xcd < r ? xcd * (q + 1) : r * (q + 1) + (xcd - r) * q) + off; }
        const int nig = WGM * nN, gid = wgid / nig, fm = gid * WGM, gsz = (nM - fm) < WGM ? (nM - fm) : WGM;
        u.pm = fm + ((wgid % nig) % gsz); u.pn = (wgid % nig) / gsz; return true;
    }
    __device__ __forceinline__ void a_ready(const Unit&) const {}
    __device__ __forceinline__ void done(const Unit&) const {}
};

template <class Epi, class Sched, bool ALIGN_EPI = false, bool SP2 = false>
__device__ __forceinline__ void gemm_phase(LAS unsigned char* lds, const Gemm g, const Sched& S, const Epi& E) {
    const int tid = threadIdx.x, wid = __builtin_amdgcn_readfirstlane(tid >> 6), lane = tid & 63, wr = wid >> 2, wc = wid & 3, fr = lane & 15, fq = lane >> 4;
    const int K = g.K, nt = K / BK, lda = g.lda;
    unsigned voffA[2], voffB[2];
#pragma unroll
    for (int i = 0; i < 2; ++i) { int R, C; stage_rc(tid * 16 + i * 8192, R, C); const int Rb = Epi::PERM ? ((R & ~31) + perm32(R & 31)) : R;
        voffA[i] = (unsigned)(R * lda + C) * 2u; voffB[i] = (unsigned)(Rb * K + C) * 2u; }
    const size_t kstep = (size_t)(BK * 2);
    const size_t hstepA = (size_t)HALF * lda * 2, hstepB = (size_t)HALF * K * 2;
    const size_t tstepA = 2 * hstepA, tstepB = 2 * hstepB;
    const unsigned ldsw = (unsigned)wid * 1024u;
    const int aoff = lds_byte(wr * 64 + fr, fq * 8), boff = lds_byte(wc * 32 + fr, fq * 8);
#define PG8_SA(b, h) (((b) * 2 + (h)) * HTB)
#define PG8_SB(b, h) ((4 + (b) * 2 + (h)) * HTB)
#define PG8_STAGE(bufoff, gbase, voff) do { _Pragma("unroll") for (int _i = 0; _i < 2; ++_i) \
        __builtin_amdgcn_global_load_lds((const unsigned*)((const char*)(gbase) + (voff)[_i]), (LAS unsigned*)(lds + (bufoff) + ldsw + _i * 8192), 16, 0, 0); } while (0)
#define PG8_LDA(dst, b, h) do { _Pragma("unroll") for (int m = 0; m < 4; ++m) _Pragma("unroll") for (int k = 0; k < 2; ++k) dst[m][k] = *(const LAS bf16x8*)(lds + PG8_SA(b, h) + aoff + m * 2048 + k * 1024); } while (0)
#define PG8_LDB(dst, b, h) do { _Pragma("unroll") for (int n = 0; n < 2; ++n) _Pragma("unroll") for (int k = 0; k < 2; ++k) dst[n][k] = *(const LAS bf16x8*)(lds + PG8_SB(b, h) + boff + n * 2048 + k * 1024); } while (0)
#define PG8_MMA(ai, bj, At, Bt) do { __builtin_amdgcn_s_setprio(1); _Pragma("unroll") for (int m = 0; m < 4; ++m) _Pragma("unroll") for (int n = 0; n < 2; ++n) _Pragma("unroll") for (int k = 0; k < 2; ++k) \
        acc[ai][bj][m][n] = __builtin_amdgcn_mfma_f32_16x16x32_bf16(Bt[n][k], At[m][k], acc[ai][bj][m][n], 0, 0, 0); __builtin_amdgcn_s_setprio(0); } while (0)
#define PG8_WAIT_V(n) asm volatile("s_waitcnt vmcnt(" #n ")" ::: "memory")
#define PG8_WAIT_L(n) asm volatile("s_waitcnt lgkmcnt(" #n ")" ::: "memory")
#define PG8_BAR __builtin_amdgcn_s_barrier()
#define PG8_SCHED __builtin_amdgcn_sched_barrier(0)
    Unit cur, nxt; int ui = 0;
    if (!S.next(0, cur)) return;
    f32x4 acc[2][2][4][2];
#pragma unroll
    for (int a = 0; a < 2; ++a)
#pragma unroll
        for (int b = 0; b < 2; ++b)
#pragma unroll
            for (int m = 0; m < 4; ++m)
#pragma unroll
                for (int n = 0; n < 2; ++n) acc[a][b][m][n] = (f32x4){0.f, 0.f, 0.f, 0.f};
    bf16x8 At[4][2], B0[2][2], B1[2][2];
    const char* cA = (const char*)g.A + (size_t)cur.pm * tstepA; const char* cB = (const char*)g.Bt + (size_t)cur.pn * tstepB;
    S.a_ready(cur);
    if constexpr (SP2) {
        PG8_STAGE(PG8_SB(0, 0), cB, voffB); PG8_STAGE(PG8_SB(0, 1), cB + hstepB, voffB); PG8_STAGE(PG8_SA(0, 0), cA, voffA); PG8_STAGE(PG8_SA(0, 1), cA + hstepA, voffA);
        if (wr == 1) PG8_BAR;
        PG8_WAIT_V(2); PG8_BAR;
        PG8_STAGE(PG8_SB(1, 0), cB + kstep, voffB); PG8_STAGE(PG8_SA(1, 0), cA + kstep, voffA); PG8_STAGE(PG8_SB(1, 1), cB + hstepB + kstep, voffB);
        PG8_WAIT_V(6); PG8_BAR;
    } else {
        PG8_STAGE(PG8_SB(0, 0), cB, voffB); PG8_STAGE(PG8_SA(0, 0), cA, voffA); PG8_STAGE(PG8_SB(0, 1), cB + hstepB, voffB); PG8_STAGE(PG8_SA(0, 1), cA + hstepA, voffA);
        if (wr == 1) PG8_BAR;
        PG8_WAIT_V(4); PG8_BAR;
        PG8_STAGE(PG8_SB(1, 0), cB + kstep, voffB); PG8_STAGE(PG8_SA(1, 0), cA + kstep, voffA); PG8_STAGE(PG8_SB(1, 1), cB + hstepB + kstep, voffB);
        PG8_WAIT_V(6); PG8_BAR;
    }
    for (;;) {
        const bool has_next = S.next(ui + 1, nxt);
        const char* nA = has_next ? (const char*)g.A + (size_t)nxt.pm * tstepA : cA; const char* nB = has_next ? (const char*)g.Bt + (size_t)nxt.pn * tstepB : cB;
        for (int t = 0; t < nt; t += 2) {
            const bool last = (t == nt - 2);
            const char* a1 = cA + (size_t)(t + 1) * kstep;
            const char* a2 = last ? nA : cA + (size_t)(t + 2) * kstep; const char* b2 = last ? nB : cB + (size_t)(t + 2) * kstep;
            const char* a3 = a2 + kstep; const char* b3 = b2 + kstep;
            if (last && has_next) S.a_ready(nxt);
            if constexpr (SP2) {
            PG8_LDB(B0, 0, 0); PG8_LDB(B1, 0, 1); PG8_SCHED; PG8_LDA(At, 0, 0); PG8_STAGE(PG8_SA(1, 1), a1 + hstepA, voffA);
            PG8_WAIT_V(8); PG8_WAIT_L(0); PG8_BAR; PG8_MMA(0, 0, At, B0); PG8_MMA(0, 1, At, B1); PG8_BAR; PG8_SCHED;
            PG8_LDA(At, 0, 1); PG8_STAGE(PG8_SB(0, 0), b2, voffB); PG8_STAGE(PG8_SB(0, 1), b2 + hstepB, voffB); PG8_STAGE(PG8_SA(0, 0), a2, voffA);
            PG8_WAIT_V(8); PG8_WAIT_L(0); PG8_BAR; PG8_MMA(1, 0, At, B0); PG8_MMA(1, 1, At, B1); PG8_BAR; PG8_SCHED;
            PG8_LDB(B0, 1, 0); PG8_LDB(B1, 1, 1); PG8_SCHED; PG8_LDA(At, 1, 0); PG8_STAGE(PG8_SA(0, 1), a2 + hstepA, voffA);
            PG8_WAIT_V(8); PG8_WAIT_L(0); PG8_BAR; PG8_MMA(0, 0, At, B0); PG8_MMA(0, 1, At, B1); PG8_BAR; PG8_SCHED;
            PG8_LDA(At, 1, 1); PG8_STAGE(PG8_SB(1, 0), b3, voffB); PG8_STAGE(PG8_SB(1, 1), b3 + hstepB, voffB); PG8_STAGE(PG8_SA(1, 0), a3, voffA);
            PG8_WAIT_V(8); PG8_WAIT_L(0); PG8_BAR; PG8_MMA(1, 0, At, B0); PG8_MMA(1, 1, At, B1); PG8_BAR; PG8_SCHED;
            } else {
            PG8_LDB(B0, 0, 0); PG8_SCHED; PG8_LDA(At, 0, 0); PG8_STAGE(PG8_SA(1, 1), a1 + hstepA, voffA);
            PG8_WAIT_L(8); PG8_BAR; PG8_WAIT_L(0); PG8_MMA(0, 0, At, B0); PG8_BAR; PG8_SCHED;
            PG8_LDB(B1, 0, 1); PG8_STAGE(PG8_SB(0, 0), b2, voffB);
            PG8_BAR; PG8_WAIT_L(0); PG8_MMA(0, 1, At, B1); PG8_BAR;
            PG8_LDA(At, 0, 1); PG8_STAGE(PG8_SA(0, 0), a2, voffA);
            PG8_BAR; PG8_WAIT_L(0); PG8_MMA(1, 0, At, B0); PG8_BAR; PG8_SCHED;
            PG8_STAGE(PG8_SB(0, 1), b2 + hstepB, voffB);
            PG8_WAIT_V(6); PG8_BAR; PG8_MMA(1, 1, At, B1); PG8_BAR;
            PG8_LDB(B0, 1, 0); PG8_SCHED; PG8_LDA(At, 1, 0); PG8_STAGE(PG8_SA(0, 1), a2 + hstepA, voffA);
            PG8_WAIT_L(8); PG8_BAR; PG8_WAIT_L(0); PG8_MMA(0, 0, At, B0); PG8_BAR; PG8_SCHED;
            PG8_LDB(B1, 1, 1); PG8_STAGE(PG8_SB(1, 0), b3, voffB);
            PG8_BAR; PG8_WAIT_L(0); PG8_MMA(0, 1, At, B1); PG8_BAR;
            PG8_LDA(At, 1, 1); PG8_STAGE(PG8_SA(1, 0), a3, voffA);
            PG8_BAR; PG8_WAIT_L(0); PG8_MMA(1, 0, At, B0); PG8_BAR; PG8_SCHED;
            PG8_STAGE(PG8_SB(1, 1), b3 + hstepB, voffB);
            PG8_WAIT_V(6); PG8_BAR; PG8_MMA(1, 1, At, B1); PG8_BAR;
            }
        }
        if constexpr (ALIGN_EPI) { if (wr == 0) PG8_BAR; }
        E(acc, cur, wr, wc, fr, fq); S.done(cur);
        if (!has_next) break;
#pragma unroll
        for (int a = 0; a < 2; ++a)
#pragma unroll
            for (int b = 0; b < 2; ++b)
#pragma unroll
                for (int m = 0; m < 4; ++m)
#pragma unroll
                    for (int n = 0; n < 2; ++n) acc[a][b][m][n] = (f32x4){0.f, 0.f, 0.f, 0.f};
        cur = nxt; cA = nA; cB = nB; ++ui;
        if constexpr (ALIGN_EPI) { if (wr == 1) PG8_BAR; }
    }
    PG8_WAIT_V(0);
    if constexpr (!ALIGN_EPI) { if (wr == 0) PG8_BAR; }
    PG8_BAR;
#undef PG8_SA
#undef PG8_SB
#undef PG8_STAGE
#undef PG8_LDA
#undef PG8_LDB
#undef PG8_MMA
#undef PG8_WAIT_V
#undef PG8_WAIT_L
#undef PG8_BAR
#undef PG8_SCHED
}

__device__ __forceinline__ u32x4 pack8(f32x4 v0, f32x4 v1) { u32x4 w; w.x = pk2(v0[0], v0[1]); w.y = pk2(v0[2], v0[3]); w.z = pk2(v1[0], v1[1]); w.w = pk2(v1[2], v1[3]); return w; }
__device__ __forceinline__ void unpack8(u32x4 w, f32x4& v0, f32x4& v1) { v0 = (f32x4){bflo(w.x), bfhi(w.x), bflo(w.y), bfhi(w.y)}; v1 = (f32x4){bflo(w.z), bfhi(w.z), bflo(w.w), bfhi(w.w)}; }

struct EpiProj {
    static constexpr bool PERM = true;
    bf16_t* P; float* ALR;
    __device__ __forceinline__ void operator()(const f32x4 (&acc)[2][2][4][2], const Unit& u, int wr, int wc, int fr, int fq) const {
        const int row0 = u.pm * BM + wr * 64 + fr; const int pn = u.pn; const int cl = wc * 32 + 8 * fq;
        if (pn == 20) {
            if (wc == 0 && fq < 2) {
#pragma unroll
                for (int ai = 0; ai < 2; ++ai)
#pragma unroll
                    for (int m = 0; m < 4; ++m) { float* rp = ALR + (size_t)(row0 + ai * HALF + m * 16) * 16 + 8 * fq;
                        *(f32x4*)rp = acc[ai][0][m][0]; *(f32x4*)(rp + 4) = acc[ai][0][m][1]; }
            }
            return;
        }
        const int mode = pn < 8 ? 0 : (pn < 12 ? 1 : 2);
#pragma unroll
        for (int ai = 0; ai < 2; ++ai)
#pragma unroll
            for (int m = 0; m < 4; ++m) { bf16_t* rowp = P + (size_t)(row0 + ai * HALF + m * 16) * PLD + pn * BM + cl;
#pragma unroll
                for (int bj = 0; bj < 2; ++bj) { f32x4 v0 = acc[ai][bj][m][0], v1 = acc[ai][bj][m][1];
                    if (mode == 1) {
#pragma unroll
                        for (int i = 0; i < 4; ++i) { v0[i] = gelu_tanh(v0[i]); v1[i] = gelu_tanh(v1[i]); }
                    } else if (mode == 2) {
#pragma unroll
                        for (int i = 0; i < 4; ++i) { v0[i] = sigmoidf_(v0[i]); v1[i] = sigmoidf_(v1[i]); }
                    }
                    *(u32x4*)(rowp + bj * HALF) = pack8(v0, v1); } }
    }
};
struct EpiBrA {
    static constexpr bool PERM = true;
    bf16_t* P;
    __device__ __forceinline__ void operator()(const f32x4 (&acc)[2][2][4][2], const Unit& u, int wr, int wc, int fr, int fq) const {
        const int row0 = u.pm * BM + wr * 64 + fr; const int c0 = u.pn * BM + wc * 32 + 8 * fq;
#pragma unroll
        for (int ai = 0; ai < 2; ++ai)
#pragma unroll
            for (int m = 0; m < 4; ++m) { bf16_t* rowp = P + (size_t)(row0 + ai * HALF + m * 16) * PLD;
#pragma unroll
                for (int bj = 0; bj < 2; ++bj) { const int c = c0 + bj * HALF; f32x4 g0, g1; unpack8(*(const u32x4*)(rowp + PC_GA + c), g0, g1);
                    *(u32x4*)(rowp + PC_MRG + c) = pack8(acc[ai][bj][m][0] * g0, acc[ai][bj][m][1] * g1); } }
    }
};
struct EpiBrB {
    static constexpr bool PERM = true;
    bf16_t* P;
    __device__ __forceinline__ void operator()(const f32x4 (&acc)[2][2][4][2], const Unit& u, int wr, int wc, int fr, int fq) const {
        const int row0 = u.pm * BM + wr * 64 + fr; const int c0 = u.pn * BM + wc * 32 + 8 * fq;
#pragma unroll
        for (int ai = 0; ai < 2; ++ai)
#pragma unroll
            for (int m = 0; m < 4; ++m) { bf16_t* rowp = P + (size_t)(row0 + ai * HALF + m * 16) * PLD;
#pragma unroll
                for (int bj = 0; bj < 2; ++bj) { const int c = c0 + bj * HALF; f32x4 g0, g1, p0, p1; unpack8(*(const u32x4*)(rowp + PC_GB + c), g0, g1); unpack8(*(const u32x4*)(rowp + PC_MRG + c), p0, p1);
                    *(u32x4*)(rowp + PC_MRG + c) = pack8(p0 + acc[ai][bj][m][0] * g0, p1 + acc[ai][bj][m][1] * g1); } }
    }
};
struct EpiOut {
    static constexpr bool PERM = true;
    const float* X; float* O;
    __device__ __forceinline__ void operator()(const f32x4 (&acc)[2][2][4][2], const Unit& u, int wr, int wc, int fr, int fq) const {
        const int row0 = u.pm * BM + wr * 64 + fr; const int c0 = u.pn * BM + wc * 32 + 8 * fq;
#pragma unroll
        for (int ai = 0; ai < 2; ++ai)
#pragma unroll
            for (int m = 0; m < 4; ++m) { const size_t ro = (size_t)(row0 + ai * HALF + m * 16) * D;
#pragma unroll
                for (int bj = 0; bj < 2; ++bj) { const int c = c0 + bj * HALF;
                    const f32x4 x0 = *(const f32x4*)(X + ro + c), x1 = *(const f32x4*)(X + ro + c + 4);
                    *(f32x4*)(O + ro + c) = x0 + acc[ai][bj][m][0]; *(f32x4*)(O + ro + c + 4) = x1 + acc[ai][bj][m][1]; } }
    }
};
struct EpiScores {
    static constexpr bool PERM = true;
    float* SC;
    __device__ __forceinline__ void operator()(const f32x4 (&acc)[2][2][4][2], const Unit& u, int wr, int wc, int fr, int fq) const {
        const int tb0 = u.pm * 16 + wr * 4; const int cq0 = (u.pn * BM + wc * 32 + 8 * fq) >> 2;
#pragma unroll
        for (int ai = 0; ai < 2; ++ai)
#pragma unroll
            for (int m = 0; m < 4; ++m) { float* bp = SC + ((size_t)(tb0 + ai * 8 + m) * 512) * 64 + fr * 4;
#pragma unroll
                for (int bj = 0; bj < 2; ++bj)
#pragma unroll
                    for (int n = 0; n < 2; ++n) *(f32x4*)(bp + (size_t)(cq0 + bj * 32 + n) * 64) = acc[ai][bj][m][n]; }
    }
};
}

#define XB_TMO      128
#define XB_XCNT(j)  (256  + 64 * (j))
#define XB_XSUB(j)  (1280 + 64 * (j))
#define XB_XGEN(j)  (2304 + 64 * (j))
#define XB_TOP      3328
#define XB_TOPGEN   3392
#define XCD_BAR_WORDS 3456
#define XB_SPIN_CAP (1u << 18)
__device__ __forceinline__ unsigned xb_ld(unsigned* p)              { return __hip_atomic_load(p, __ATOMIC_RELAXED, __HIP_MEMORY_SCOPE_AGENT); }
__device__ __forceinline__ unsigned xb_add(unsigned* p, unsigned v) { return __hip_atomic_fetch_add(p, v, __ATOMIC_RELAXED, __HIP_MEMORY_SCOPE_AGENT); }
__device__ __forceinline__ unsigned xb_xcc_id() { return (unsigned)__builtin_amdgcn_s_getreg((3 << 11) | 20) & 0xFu; }
#define XB_SPIN(cond, bar) do { unsigned _sp = 0; while (cond) { __builtin_amdgcn_s_sleep(1); \
    if ((++_sp & 255u) == 0u) { if (xb_ld(&(bar)[XB_TMO])) break; if (_sp > XB_SPIN_CAP) { atomicAdd(&(bar)[XB_TMO], 1u); break; } } } } while (0)
struct XcdBarrier { unsigned* bar; unsigned x; volatile LAS unsigned* st; };
__device__ __forceinline__ XcdBarrier xcd_barrier_post(unsigned* bar, volatile LAS unsigned* st) {
    XcdBarrier b; b.bar = bar; b.x = xb_xcc_id(); b.st = st;
    if (threadIdx.x == 0) (void)xb_add(&bar[XB_XCNT(b.x)], 1u);
    return b;
}
__device__ __forceinline__ void xcd_barrier_complete(unsigned* bar, unsigned x, unsigned& nloc, unsigned& nx) {
    const unsigned G = gridDim.x * gridDim.y * gridDim.z;
    unsigned sum, cnt, mine, sp = 0u;
    for (;;) {
        sum = 0u; cnt = 0u; mine = 0u;
#pragma unroll
        for (unsigned j = 0; j < 16; ++j) { const unsigned c = xb_ld(&bar[XB_XCNT(j)]); sum += c; cnt += (c > 0u) ? 1u : 0u; mine = (j == x) ? c : mine; }
        if (sum == G) break;
        __builtin_amdgcn_s_sleep(1);
        if ((++sp & 255u) == 0u) { if (xb_ld(&bar[XB_TMO])) break; if (sp > XB_SPIN_CAP) { atomicAdd(&bar[XB_TMO], 1u); break; } }
    }
    nloc = mine > 0u ? mine : 1u; nx = cnt > 0u ? cnt : 1u;
}
__device__ __forceinline__ void xcd_barrier(const XcdBarrier& b) {
    asm volatile("s_waitcnt vmcnt(0)" ::: "memory");
    __syncthreads();
    if (threadIdx.x == 0) {
        unsigned* bar = b.bar;
        __builtin_amdgcn_s_waitcnt(0);
        unsigned nloc = b.st[0], nx = b.st[1];
        if (nloc == 0u) { xcd_barrier_complete(bar, b.x, nloc, nx); b.st[0] = nloc; b.st[1] = nx; }
        const unsigned old = xb_add(&bar[XB_XSUB(b.x)], 1u);
        const unsigned gen = old / nloc;
        if (old + 1u == (gen + 1u) * nloc) {
            __builtin_amdgcn_fence(__ATOMIC_RELEASE, "agent");
            asm volatile("s_waitcnt vmcnt(0)" ::: "memory");
            const unsigned og = xb_add(&bar[XB_TOP], 1u);
            const unsigned tg = og / nx;
            if (og + 1u == (tg + 1u) * nx) xb_add(&bar[XB_TOPGEN], 1u);
            else XB_SPIN(xb_ld(&bar[XB_TOPGEN]) == tg, bar);
            __builtin_amdgcn_fence(__ATOMIC_ACQUIRE, "agent");
            xb_add(&bar[XB_XGEN(b.x)], 1u);
            asm volatile("s_waitcnt vmcnt(0)" ::: "memory");
        } else {
            XB_SPIN(xb_ld(&bar[XB_XGEN(b.x)]) == gen, bar);
            __builtin_amdgcn_fence(__ATOMIC_ACQUIRE, "agent");
            asm volatile("s_waitcnt vmcnt(0)" ::: "memory");
        }
    }
    __syncthreads();
}

struct Args {
    const float* in[20]; float* out; unsigned char* ws; int ph_lo, ph_hi, li, pad;
};
enum { I_X = 0, I_N1G, I_WIN, I_WGU, I_BG, I_GLAG, I_SLNG, I_SLNB, I_SW, I_SB, I_WBA, I_WBB, I_WOUT, I_N2G, I_WQ, I_K1, I_K2, I_PU, I_PV, I_FG };

struct Frame {
    LAS unsigned char* lds;
    int tid, lane, wave, G, bid;
};

template <int MODE>
__device__ __forceinline__ void p0_transpose_item(const float* W, int K, int Nsrc, int Ndst, bf16_t* WT, LAS float* scr, int item, int lane) {
    const int nblk = Ndst / 32, kb = item / nblk, nb = item % nblk, k0 = 64 * kb, n0 = 32 * nb;
    const int nd = n0 + (lane & 31);
    int sc = nd; bool valid = true;
    if (MODE == 1) { if (nd < 2048) sc = nd; else if (nd < 5120) sc = nd + 16; else if (nd < 5136) sc = 2048 + (nd - 5120); else { sc = 0; valid = false; } }
#pragma unroll 8
    for (int i = 0; i < 32; ++i) { const int kk = 2 * i + (lane >> 5); const float v = valid ? W[(size_t)(k0 + kk) * Nsrc + sc] : 0.f; scr[kk * 33 + (lane & 31)] = v; }
    LDS_WAIT(); asm volatile("" ::: "memory");
    const int c = lane & 7;
#pragma unroll
    for (int j = 0; j < 4; ++j) { const int n = (lane >> 3) + 8 * j; const LAS float* s = scr + (8 * c) * 33 + n;
        u32x4 o; o.x = pk2(s[0 * 33], s[1 * 33]); o.y = pk2(s[2 * 33], s[3 * 33]); o.z = pk2(s[4 * 33], s[5 * 33]); o.w = pk2(s[6 * 33], s[7 * 33]);
        *(u32x4*)(WT + (size_t)(n0 + n) * K + k0 + 8 * c) = o; }
    LDS_WAIT(); asm volatile("" ::: "memory");
}
template <bool F8, int NB>
__device__ __forceinline__ void rms_rows_to_bf16(int lane, const float* x0, size_t xstride, const float* g, bf16_t* o0, size_t ostride, unsigned* o80 = nullptr, size_t o8stride = 0) {
    f32x4 v[NB][4]; float s[NB];
#pragma unroll
    for (int b = 0; b < NB; ++b) { const f32x4* xr = (const f32x4*)(x0 + b * xstride) + lane;
#pragma unroll
        for (int j = 0; j < 4; ++j) v[b][j] = xr[64 * j]; }
#pragma unroll
    for (int b = 0; b < NB; ++b) { s[b] = 0.f;
#pragma unroll
        for (int j = 0; j < 4; ++j) s[b] += (v[b][j].x * v[b][j].x + v[b][j].y * v[b][j].y) + (v[b][j].z * v[b][j].z + v[b][j].w * v[b][j].w); }
#pragma unroll
    for (int o = 1; o < 64; o <<= 1) {
#pragma unroll
        for (int b = 0; b < NB; ++b) s[b] += __shfl_xor(s[b], o); }
    const f32x4* gr = (const f32x4*)g + lane;
#pragma unroll
    for (int b = 0; b < NB; ++b) { const float rstd = 1.f / sqrtf(s[b] * (1.f / D) + EPS); u32x2* o8 = (u32x2*)(o0 + b * ostride) + lane;
#pragma unroll
        for (int j = 0; j < 4; ++j) { const f32x4 gg = gr[64 * j]; const f32x4 y = v[b][j] * rstd * gg; u32x2 o; o.x = pk2(y.x, y.y); o.y = pk2(y.z, y.w); o8[64 * j] = o;
            if (F8) { int w = 0; w = __builtin_amdgcn_cvt_pk_fp8_f32(bflo(o.x) * 16.f, bfhi(o.x) * 16.f, w, false); w = __builtin_amdgcn_cvt_pk_fp8_f32(bflo(o.y) * 16.f, bfhi(o.y) * 16.f, w, true); (o80 + b * o8stride)[64 * j + lane] = (unsigned)w; } } }
}
__device__ __forceinline__ float wave_max(float v) {
#pragma unroll
    for (int o = 1; o < 64; o <<= 1) v = fmaxf(v, __shfl_xor(v, o));
    return v;
}
template <int NB>
__device__ __forceinline__ void cvt_rows_fp8(int lane, const float* const (&src)[NB], unsigned char* const (&dst16)[NB], float* const (&scale_out)[NB]) {
    f32x4 v[NB][4]; float m[NB];
#pragma unroll
    for (int b = 0; b < NB; ++b) {
#pragma unroll
        for (int j = 0; j < 4; ++j) v[b][j] = *(const GAS f32x4*)(src[b] + 16 * lane + 4 * j); }
#pragma unroll
    for (int b = 0; b < NB; ++b) { m[b] = 0.f;
#pragma unroll
        for (int j = 0; j < 4; ++j) m[b] = fmaxf(m[b], fmaxf(fmaxf(fabsf(v[b][j].x), fabsf(v[b][j].y)), fmaxf(fabsf(v[b][j].z), fabsf(v[b][j].w)))); }
#pragma unroll
    for (int o = 1; o < 64; o <<= 1) {
#pragma unroll
        for (int b = 0; b < NB; ++b) m[b] = fmaxf(m[b], __shfl_xor(m[b], o)); }
#pragma unroll
    for (int b = 0; b < NB; ++b) { const float inv = m[b] > 0.f ? 224.f / m[b] : 0.f, sc = m[b] > 0.f ? m[b] * (1.f / 224.f) : 1.f;
        u32x4 o;
#pragma unroll
        for (int j = 0; j < 4; ++j) { int w = 0; w = __builtin_amdgcn_cvt_pk_fp8_f32(v[b][j].x * inv, v[b][j].y * inv, w, false); w = __builtin_amdgcn_cvt_pk_fp8_f32(v[b][j].z * inv, v[b][j].w * inv, w, true); o[j] = (unsigned)w; }
        *(GAS u32x4*)dst16[b] = o;
        if (lane == 0) *(GAS float*)scale_out[b] = sc; }
}
__device__ __forceinline__ void convert_tables(const Frame& F, const Args& A, int wi, int nw) {
    unsigned char* ws = A.ws; const int gw = wi, NGW = nw;
    int mc = gw;
    for (; mc + 3 * NGW < 2 * NEXP; mc += 4 * NGW) { const int m = mc;
        const float* src[4]; unsigned char* dst[4]; float* sco[4];
#pragma unroll
        for (int b = 0; b < 4; ++b) { const int mm = m + b * NGW;
            if (mm < NEXP) { const int e = mm; src[b] = A.in[I_PU] + (size_t)e * D; dst[b] = ws + WS_U8 + (size_t)((e & (UNG - 1)) * (NEXP / UNG) + (e >> UNG_SH)) * 1024 + 16 * F.lane; sco[b] = (float*)(ws + WS_SU) + e; }
            else { const int e = mm - NEXP; src[b] = A.in[I_PV] + (size_t)e * D; dst[b] = ws + WS_V8 + ((size_t)(F.lane >> 3) * NEXP + e) * 128 + 16 * (F.lane & 7); sco[b] = (float*)(ws + WS_SV) + e; } }
        cvt_rows_fp8<4>(F.lane, src, dst, sco);
    }
    for (; mc < 2 * NEXP; mc += NGW) { const float* src[1]; unsigned char* dst[1]; float* sco[1];
        if (mc < NEXP) { const int e = mc; src[0] = A.in[I_PU] + (size_t)e * D; dst[0] = ws + WS_U8 + (size_t)((e & (UNG - 1)) * (NEXP / UNG) + (e >> UNG_SH)) * 1024 + 16 * F.lane; sco[0] = (float*)(ws + WS_SU) + e; }
        else { const int e = mc - NEXP; src[0] = A.in[I_PV] + (size_t)e * D; dst[0] = ws + WS_V8 + ((size_t)(F.lane >> 3) * NEXP + e) * 128 + 16 * (F.lane & 7); sco[0] = (float*)(ws + WS_SV) + e; }
        cvt_rows_fp8<1>(F.lane, src, dst, sco); }
}
__device__ __forceinline__ void phase0(const Frame& F, const Args& A) {
    unsigned char* ws = A.ws;
    {
        LAS float* kx = (LAS float*)F.lds;
        LAS float* wt = (LAS float*)(F.lds + 128 * 129 * 4);
        bf16_t* WQF = (bf16_t*)(ws + WS_WQF);
        for (int it = F.bid; it < 512; it += F.G) {
            const int hh = it >> 5, kblk = it & 31, k0 = kblk * 32;
            const float* kX = (hh & 1) ? A.in[I_K2] : A.in[I_K1];
            __syncthreads();
            for (int e = F.tid; e < 128 * 128; e += 512) kx[(e >> 7) * 129 + (e & 127)] = kX[e];
            for (int e = F.tid; e < 32 * 128; e += 512) wt[e] = A.in[I_WQ][(size_t)(k0 + (e >> 7)) * 2048 + hh * 128 + (e & 127)];
            __syncthreads();
            const int key = F.tid & 127, kq = F.tid >> 7;
            float acc[8];
#pragma unroll
            for (int i = 0; i < 8; ++i) acc[i] = 0.f;
            for (int d = 0; d < 128; ++d) { const float b = kx[key * 129 + d];
#pragma unroll
                for (int i = 0; i < 8; ++i) acc[i] += wt[(kq * 8 + i) * 128 + d] * b; }
            u32x4 o; o.x = pk2(acc[0], acc[1]); o.y = pk2(acc[2], acc[3]); o.z = pk2(acc[4], acc[5]); o.w = pk2(acc[6], acc[7]);
            *(u32x4*)(WQF + (size_t)(hh * 128 + key) * 1024 + k0 + kq * 8) = o;
        }
        __syncthreads();
    }
    LAS float* scr = (LAS float*)(F.lds + F.wave * 16384);
    const int gw = F.bid * NWAVES + F.wave, NGW = F.G * NWAVES;
    constexpr int I_IN = 16 * (NPROJ / 32), I_A = 8 * 32, I_B = 8 * 32, I_O = 16 * 32;
    constexpr int NITEMS = I_IN + I_A + I_B + I_O;
    for (int it = gw; it < NITEMS; it += NGW) {
        int r = it;
        if (r < I_IN) { p0_transpose_item<1>(A.in[I_WIN], 1024, 5136, NPROJ, (bf16_t*)(ws + WS_WIN), scr, r, F.lane); continue; } r -= I_IN;
        if (r < I_A) { p0_transpose_item<0>(A.in[I_WBA], 512, 1024, 1024, (bf16_t*)(ws + WS_WA), scr, r, F.lane); continue; } r -= I_A;
        if (r < I_B) { p0_transpose_item<0>(A.in[I_WBB], 512, 1024, 1024, (bf16_t*)(ws + WS_WB), scr, r, F.lane); continue; } r -= I_B;
        p0_transpose_item<0>(A.in[I_WOUT], 1024, 1024, 1024, (bf16_t*)(ws + WS_WOUT), scr, r, F.lane);
    }
    { int m = gw; for (; m + 3 * NGW < T_TOK; m += 4 * NGW) rms_rows_to_bf16<false, 4>(F.lane, A.in[I_X] + (size_t)m * D, (size_t)NGW * D, A.in[I_N1G], (bf16_t*)(ws + WS_N1) + (size_t)m * D, (size_t)NGW * D);
      for (; m < T_TOK; m += NGW) rms_rows_to_bf16<false, 1>(F.lane, A.in[I_X] + (size_t)m * D, 0, A.in[I_N1G], (bf16_t*)(ws + WS_N1) + (size_t)m * D, 0); }
}

__device__ __forceinline__ float log_sigmoid(float z) { return fminf(z, 0.f) - log1pf(__expf(-fabsf(z))); }

template <bool DRY>
__device__ __forceinline__ void gla_chunk_phase(const Frame& F, const Args& A) {
    unsigned char* ws = A.ws;
    const bf16_t* P = (const bf16_t*)(ws + WS_P);
    const float* ALR = (const float*)(ws + WS_ALR);
    LAS float* alr = (LAS float*)F.lds;
    LAS float* tot = (LAS float*)(F.lds + 4096);
    LAS bf16_t* kdT = (LAS bf16_t*)(F.lds + 8192);
    LAS bf16_t* vT = (LAS bf16_t*)(F.lds + 26624);
    LAS bf16_t* stT = (LAS bf16_t*)(F.lds + 45056);
    const int tid = F.tid, kk = tid & 127, seg = tid >> 7;
    const bool hconst = (F.G & 3) == 0;
    int hcur = -1; float w[16]; float bias = 0.f;
#pragma unroll
    for (int j = 0; j < 16; ++j) w[j] = 0.f;
    float na0, na1; bf16_t nk[16], nv[16];
#define GC_LOAD(unit) do { const int h_ = (unit) & 3, c_ = ((unit) >> 2) & 63, b_ = (unit) >> 8; const int t0_ = b_ * SEQ + c_ * 64; \
        na0 = ALR[(size_t)t0_ * 16 + tid]; na1 = ALR[(size_t)t0_ * 16 + 512 + tid]; \
        const bf16_t* kp_ = P + (size_t)(t0_ + 16 * seg) * PLD + PC_K + h_ * 128 + kk; const bf16_t* vp_ = P + (size_t)(t0_ + 16 * seg) * PLD + PC_V + h_ * 128 + kk; \
        _Pragma("unroll") for (int i_ = 0; i_ < 16; ++i_) { nk[i_] = kp_[(size_t)i_ * PLD]; nv[i_] = vp_[(size_t)i_ * PLD]; } } while (0)
    int unit = F.bid;
    if (unit < 2048) GC_LOAD(unit);
    for (; unit < 2048; unit += F.G) {
        const int h = unit & 3;
        if (h != hcur) { hcur = h;
#pragma unroll
            for (int j = 0; j < 16; ++j) w[j] = A.in[I_WGU][(size_t)j * 512 + h * 128 + kk];
            bias = A.in[I_BG][h * 128 + kk]; }
        __syncthreads();
        alr[tid] = na0; alr[512 + tid] = na1;
        bf16_t kr[16], vr[16];
#pragma unroll
        for (int i = 0; i < 16; ++i) { kr[i] = nk[i]; vr[i] = nv[i]; }
        if (unit + F.G < 2048) GC_LOAD(unit + F.G);
        __syncthreads();
        float cum[16]; float run = 0.f;
#pragma unroll
        for (int i = 0; i < 16; ++i) { const LAS f32x4* ap = (const LAS f32x4*)(alr + (16 * seg + i) * 16); float z = bias;
#pragma unroll
            for (int q = 0; q < 4; ++q) { const f32x4 a4 = ap[q]; z += a4.x * w[4 * q] + a4.y * w[4 * q + 1] + a4.z * w[4 * q + 2] + a4.w * w[4 * q + 3]; }
            const float ls = fminf(z, 0.f) - __logf(1.f + __expf(-fabsf(z)));
            run += ls * (1.f / 16.f); cum[i] = run; }
        tot[seg * 128 + kk] = run;
        __syncthreads();
        {
            const float t0s = tot[kk], t1s = tot[128 + kk], t2s = tot[256 + kk], t3s = tot[384 + kk];
            const float total = (t0s + t1s) + (t2s + t3s);
            const float prefix = seg == 0 ? 0.f : (seg == 1 ? t0s : (seg == 2 ? t0s + t1s : t0s + t1s + t2s));
            unsigned kw[8], vw[8];
#pragma unroll
            for (int i = 0; i < 8; ++i) {
                const float e0 = __expf(total - (prefix + cum[2 * i])), e1 = __expf(total - (prefix + cum[2 * i + 1]));
                kw[i] = pk2(bf1(kr[2 * i]) * e0, bf1(kr[2 * i + 1]) * e1); vw[i] = (unsigned)vr[2 * i] | ((unsigned)vr[2 * i + 1] << 16);
            }
            *(LAS u32x4*)(kdT + kk * 72 + 16 * seg) = (u32x4){kw[0], kw[1], kw[2], kw[3]}; *(LAS u32x4*)(kdT + kk * 72 + 16 * seg + 8) = (u32x4){kw[4], kw[5], kw[6], kw[7]};
            *(LAS u32x4*)(vT + kk * 72 + 16 * seg) = (u32x4){vw[0], vw[1], vw[2], vw[3]}; *(LAS u32x4*)(vT + kk * 72 + 16 * seg + 8) = (u32x4){vw[4], vw[5], vw[6], vw[7]};
            if (seg == 0) ((float*)(DRY ? (unsigned char*)A.out + 96 * MiB : ws + WS_DEC))[(size_t)unit * 128 + kk] = __expf(total);
        }
        __syncthreads();
        {
            const int w8 = F.wave, l = F.lane, fr = l & 15, fq = l >> 4;
            f32x4 acc[8];
#pragma unroll
            for (int n = 0; n < 8; ++n) acc[n] = (f32x4){0.f, 0.f, 0.f, 0.f};
#pragma unroll
            for (int ks = 0; ks < 2; ++ks) {
                const bf16x8 a = *(const LAS bf16x8*)(kdT + (16 * w8 + fr) * 72 + 32 * ks + 8 * fq);
#pragma unroll
                for (int n = 0; n < 8; ++n) { const bf16x8 bb = *(const LAS bf16x8*)(vT + (16 * n + fr) * 72 + 32 * ks + 8 * fq);
                    acc[n] = __builtin_amdgcn_mfma_f32_16x16x32_bf16(a, bb, acc[n], 0, 0, 0); }
            }
#pragma unroll
            for (int n = 0; n < 8; ++n) { u32x2 o; o.x = pk2(acc[n][0], acc[n][1]); o.y = pk2(acc[n][2], acc[n][3]);
                *(LAS u32x2*)(stT + (16 * n + fr) * 136 + 16 * w8 + 4 * fq) = o; }
        }
        __syncthreads();
        {
            bf16_t* ST = (bf16_t*)(DRY ? (unsigned char*)A.out : ws + WS_N1) + (size_t)unit * 16384;
            const int vv = tid >> 2, part = tid & 3;
#pragma unroll
            for (int q = 0; q < 4; ++q) *(u32x4*)(ST + (size_t)vv * 128 + 32 * part + 8 * q) = *(const LAS u32x4*)(stT + vv * 136 + 32 * part + 8 * q);
        }
    }
#undef GC_LOAD
    (void)hconst;
}

template <bool DRY>
__device__ __forceinline__ void sgu_unit(const Frame& F, const Args& A, int unit) {
    const int g = unit & 3, blk = (unit >> 2) & 31, b = unit >> 7;
    const int t0 = b * SEQ + blk * 128;
    bf16_t* P = (bf16_t*)(A.ws + WS_P);
    LAS bf16_t* wA = (LAS bf16_t*)F.lds;
    LAS bf16_t* vnT = (LAS bf16_t*)(F.lds + 34816);
    LAS float* st = (LAS float*)(F.lds + 69632);
    LAS bf16_t* suS = (LAS bf16_t*)(F.lds + 70656);
    const int tid = F.tid;
    __syncthreads();
    {
        const int j = tid >> 2, q = tid & 3;
        const bf16_t* sp = P + (size_t)(t0 + j) * PLD + PC_SV + q * 128;
        float s = 0.f, s2 = 0.f;
#pragma unroll
        for (int i = 0; i < 16; ++i) { const u32x4 w = *(const u32x4*)(sp + 8 * i);
            const float f[8] = {bflo(w.x), bfhi(w.x), bflo(w.y), bfhi(w.y), bflo(w.z), bfhi(w.z), bflo(w.w), bfhi(w.w)};
#pragma unroll
            for (int e = 0; e < 8; ++e) { s += f[e]; s2 += f[e] * f[e]; } }
        s += __shfl_xor(s, 1); s += __shfl_xor(s, 2); s2 += __shfl_xor(s2, 1); s2 += __shfl_xor(s2, 2);
        const float mu = s * (1.f / 512.f); const float var = fmaxf(s2 * (1.f / 512.f) - mu * mu, 0.f);
        if (q == 0) { st[2 * j] = mu; st[2 * j + 1] = 1.f / sqrtf(var + EPS); }
    }
    {
        const int i = tid >> 2, jb = (tid & 3) * 32;
        const float* wp = A.in[I_SW] + (size_t)g * 16384 + (size_t)i * 128 + jb;
        const bf16_t* sup = P + (size_t)(t0 + i) * PLD + PC_SU + g * 128 + jb;
#pragma unroll
        for (int q = 0; q < 4; ++q) { const f32x4 a = *(const f32x4*)(wp + 8 * q), bq = *(const f32x4*)(wp + 8 * q + 4);
            const bool z = (i < 64) && (jb + 8 * q >= 64);
            u32x4 o; o.x = pk2(a.x, a.y); o.y = pk2(a.z, a.w); o.z = pk2(bq.x, bq.y); o.w = pk2(bq.z, bq.w);
            if (z) o = (u32x4){0u, 0u, 0u, 0u};
            *(LAS u32x4*)(wA + i * 136 + jb + 8 * q) = o;
            *(LAS u32x4*)(suS + i * 136 + jb + 8 * q) = *(const u32x4*)(sup + 8 * q); }
    }
    const int cch = tid & 127, seg = tid >> 7;
    bf16_t xr[32];
    { const bf16_t* sp = P + (size_t)(t0 + 32 * seg) * PLD + PC_SV + g * 128 + cch;
#pragma unroll
      for (int i = 0; i < 32; ++i) xr[i] = sp[(size_t)i * PLD]; }
    const float lg = A.in[I_SLNG][g * 128 + cch], lb = A.in[I_SLNB][g * 128 + cch];
    __syncthreads();
    {
        unsigned ow[16];
#pragma unroll
        for (int i = 0; i < 16; ++i) { const int j = 32 * seg + 2 * i; const f32x4 ms = *(const LAS f32x4*)(st + 2 * j);
            ow[i] = pk2((bf1(xr[2 * i]) - ms.x) * ms.y * lg + lb, (bf1(xr[2 * i + 1]) - ms.z) * ms.w * lg + lb); }
#pragma unroll
        for (int q = 0; q < 4; ++q) *(LAS u32x4*)(vnT + cch * 136 + 32 * seg + 8 * q) = (u32x4){ow[4 * q], ow[4 * q + 1], ow[4 * q + 2], ow[4 * q + 3]};
    }
    __syncthreads();
    {
        const int w = F.wave, l = F.lane, fr = l & 15, fq = l >> 4;
        f32x4 acc[8];
#pragma unroll
        for (int n = 0; n < 8; ++n) acc[n] = (f32x4){0.f, 0.f, 0.f, 0.f};
#pragma unroll
        for (int ks = 0; ks < 4; ++ks) {
            const bf16x8 a = *(const LAS bf16x8*)(wA + (16 * w + fr) * 136 + 32 * ks + 8 * fq);
#pragma unroll
            for (int n = 0; n < 8; ++n) { const bf16x8 bb = *(const LAS bf16x8*)(vnT + (16 * n + fr) * 136 + 32 * ks + 8 * fq);
                acc[n] = __builtin_amdgcn_mfma_f32_16x16x32_bf16(a, bb, acc[n], 0, 0, 0); }
        }
#pragma unroll
        for (int jj = 0; jj < 4; ++jj) { const int i = 16 * w + 4 * fq + jj; const float bias = A.in[I_SB][g * 128 + i];
            LAS bf16_t* rp = suS + i * 136 + fr;
#pragma unroll
            for (int n = 0; n < 8; ++n) { const float su = bf1(rp[16 * n]); rp[16 * n] = (bf16_t)f2bf(su * (acc[n][jj] + bias)); } }
    }
    __syncthreads();
    {
        const int i = tid >> 2, jb = (tid & 3) * 32;
        bf16_t* yp = DRY ? (bf16_t*)A.out + (size_t)(t0 + i) * 512 + g * 128 + jb : P + (size_t)(t0 + i) * PLD + PC_SU + g * 128 + jb;
#pragma unroll
        for (int q = 0; q < 4; ++q) *(u32x4*)(yp + 8 * q) = *(const LAS u32x4*)(suS + i * 136 + jb + 8 * q);
    }
}

template <bool DRY>
__device__ __forceinline__ void gla_scan(const Frame& F, const Args& A) {
    bf16_t* ST = (bf16_t*)(A.ws + WS_N1); bf16_t* STO = DRY ? (bf16_t*)A.out : ST; const float* DEC = (const float*)(A.ws + WS_DEC);
    for (int gi = F.bid * 512 + F.tid; gi < 131072; gi += F.G * 512) {
        const int k4 = gi & 31, vv = (gi >> 5) & 127, h = (gi >> 12) & 3, b = gi >> 14;
        float s0 = 0.f, s1 = 0.f, s2 = 0.f, s3 = 0.f;
        u32x2 wa[8], wb[8]; f32x4 da[8], db[8];
#define SCAN_LOAD(W, Dd, c0) do { _Pragma("unroll") for (int i_ = 0; i_ < 8; ++i_) { const size_t u_ = (size_t)((b * 64 + (c0) + i_) * 4 + h); \
            W[i_] = *(const u32x2*)(ST + u_ * 16384 + (size_t)vv * 128 + k4 * 4); Dd[i_] = *(const f32x4*)(DEC + u_ * 128 + k4 * 4); } } while (0)
#define SCAN_STEP(W, Dd, c0) do { _Pragma("unroll") for (int i_ = 0; i_ < 8; ++i_) { const size_t u_ = (size_t)((b * 64 + (c0) + i_) * 4 + h); \
            s0 = Dd[i_].x * s0 + bflo(W[i_].x); s1 = Dd[i_].y * s1 + bfhi(W[i_].x); s2 = Dd[i_].z * s2 + bflo(W[i_].y); s3 = Dd[i_].w * s3 + bfhi(W[i_].y); \
            u32x2 o_; o_.x = pk2(s0, s1); o_.y = pk2(s2, s3); *(u32x2*)(STO + u_ * 16384 + (size_t)vv * 128 + k4 * 4) = o_; } } while (0)
        SCAN_LOAD(wa, da, 0);
#pragma unroll
        for (int c0 = 0; c0 < 64; c0 += 16) {
            SCAN_LOAD(wb, db, c0 + 8);
            SCAN_STEP(wa, da, c0);
            if (c0 + 16 < 64) SCAN_LOAD(wa, da, c0 + 16);
            SCAN_STEP(wb, db, c0 + 8);
        }
#undef SCAN_LOAD
#undef SCAN_STEP
    }
}

template <bool DRY>
__device__ __forceinline__ void gla_out_phase(const Frame& F, const Args& A) {
    bf16_t* P = (bf16_t*)(A.ws + WS_P);
    LAS bf16_t* qA = (LAS bf16_t*)F.lds;
    LAS bf16_t* sB = (LAS bf16_t*)(F.lds + 17408);
    LAS float* oF = (LAS float*)(F.lds + 52224);
    const int tid = F.tid, s = tid >> 3, cb = (tid & 7) * 16, vv = tid >> 2, kb = (tid & 3) * 32;
    u32x4 nq0, nq1, ns0, ns1, ns2, ns3, nr0, nr1;
#define GO_LOAD(unit) do { const int h_ = (unit) & 3, c_ = ((unit) >> 2) & 63, b_ = (unit) >> 8; const int t0_ = b_ * SEQ + c_ * 64; \
        const bf16_t* qp_ = P + (size_t)(t0_ + s) * PLD + PC_Q + h_ * 128 + cb; nq0 = *(const u32x4*)qp_; nq1 = *(const u32x4*)(qp_ + 8); \
        const bf16_t* sp_ = (const bf16_t*)(A.ws + WS_N1) + (size_t)(unit) * 16384 + (size_t)vv * 128 + kb; ns0 = *(const u32x4*)sp_; ns1 = *(const u32x4*)(sp_ + 8); ns2 = *(const u32x4*)(sp_ + 16); ns3 = *(const u32x4*)(sp_ + 24); \
        const bf16_t* rp_ = P + (size_t)(t0_ + s) * PLD + PC_R + h_ * 128 + cb; nr0 = *(const u32x4*)rp_; nr1 = *(const u32x4*)(rp_ + 8); } while (0)
    int unit = F.bid;
    if (unit < 2048) GO_LOAD(unit);
    for (; unit < 2048; unit += F.G) {
        const int h = unit & 3, c = (unit >> 2) & 63, b = unit >> 8;
        const int t0 = b * SEQ + c * 64;
        __syncthreads();
        *(LAS u32x4*)(qA + s * 136 + cb) = nq0; *(LAS u32x4*)(qA + s * 136 + cb + 8) = nq1;
        *(LAS u32x4*)(sB + vv * 136 + kb) = ns0; *(LAS u32x4*)(sB + vv * 136 + kb + 8) = ns1; *(LAS u32x4*)(sB + vv * 136 + kb + 16) = ns2; *(LAS u32x4*)(sB + vv * 136 + kb + 24) = ns3;
        const u32x4 r0 = nr0, r1 = nr1;
        if (unit + F.G < 2048) GO_LOAD(unit + F.G);
        __syncthreads();
        {
            const int w = F.wave, l = F.lane, fr = l & 15, fq = l >> 4, m = w & 3, nh = w >> 2;
            f32x4 acc[4];
#pragma unroll
            for (int n = 0; n < 4; ++n) acc[n] = (f32x4){0.f, 0.f, 0.f, 0.f};
#pragma unroll
            for (int ks = 0; ks < 4; ++ks) {
                const bf16x8 a = *(const LAS bf16x8*)(qA + (16 * m + fr) * 136 + 32 * ks + 8 * fq);
#pragma unroll
                for (int n = 0; n < 4; ++n) { const bf16x8 bb = *(const LAS bf16x8*)(sB + (16 * (4 * nh + n) + fr) * 136 + 32 * ks + 8 * fq);
                    acc[n] = __builtin_amdgcn_mfma_f32_16x16x32_bf16(a, bb, acc[n], 0, 0, 0); }
            }
            const float scale = 0.08838834764831845f;
#pragma unroll
            for (int n = 0; n < 4; ++n)
#pragma unroll
                for (int jj = 0; jj < 4; ++jj) oF[(16 * m + 4 * fq + jj) * 132 + 16 * (4 * nh + n) + fr] = acc[n][jj] * scale;
        }
        __syncthreads();
        {
            float o[16]; float ss = 0.f;
#pragma unroll
            for (int i = 0; i < 16; ++i) { o[i] = oF[s * 132 + cb + i]; ss += o[i] * o[i]; }
            ss += __shfl_xor(ss, 1); ss += __shfl_xor(ss, 2); ss += __shfl_xor(ss, 4);
            const float rstd = 1.f / sqrtf(ss * (1.f / 128.f) + EPS);
            const unsigned rw[8] = {r0.x, r0.y, r0.z, r0.w, r1.x, r1.y, r1.z, r1.w};
            const float* gg = A.in[I_GLAG] + h * 128 + cb;
            unsigned ow[8];
#pragma unroll
            for (int i = 0; i < 8; ++i) { const float y0 = o[2 * i] * rstd * gg[2 * i] * siluf_(bflo(rw[i])), y1 = o[2 * i + 1] * rstd * gg[2 * i + 1] * siluf_(bfhi(rw[i])); ow[i] = pk2(y0, y1); }
            bf16_t* yp = DRY ? (bf16_t*)A.out + (size_t)(t0 + s) * 512 + h * 128 + cb : P + (size_t)(t0 + s) * PLD + PC_Q + h * 128 + cb;
            *(u32x4*)yp = (u32x4){ow[0], ow[1], ow[2], ow[3]}; *(u32x4*)(yp + 8) = (u32x4){ow[4], ow[5], ow[6], ow[7]};
        }
    }
#undef GO_LOAD
}

__device__ __forceinline__ unsigned ordkey(float v) { const unsigned u = __builtin_bit_cast(unsigned, v); return u ^ ((unsigned)((int)u >> 31) | 0x80000000u); }
__device__ __forceinline__ float unord(unsigned k) { const unsigned u = (k & 0x80000000u) ? (k & 0x7fffffffu) : ~k; return __builtin_bit_cast(float, u); }
#define INS16(r, xin) do { unsigned _x = (xin); _Pragma("unroll") for (int _i = 0; _i < 16; ++_i) { const unsigned _h = max((r)[_i], _x); _x = min((r)[_i], _x); (r)[_i] = _h; } } while (0)

#define CE(a, b) do { const unsigned _h = max((a), (b)), _l = min((a), (b)); (a) = _h; (b) = _l; } while (0)
#define SORT16(v) do { CE(v[0], v[1]); CE(v[2], v[3]); CE(v[0], v[2]); CE(v[1], v[3]); CE(v[1], v[2]); CE(v[4], v[5]); CE(v[6], v[7]); CE(v[4], v[6]); CE(v[5], v[7]); CE(v[5], v[6]); CE(v[0], v[4]); CE(v[2], v[6]); CE(v[2], v[4]); CE(v[1], v[5]); CE(v[3], v[7]); CE(v[3], v[5]); CE(v[1], v[2]); CE(v[3], v[4]); CE(v[5], v[6]); CE(v[8], v[9]); CE(v[10], v[11]); CE(v[8], v[10]); CE(v[9], v[11]); CE(v[9], v[10]); CE(v[12], v[13]); CE(v[14], v[15]); CE(v[12], v[14]); CE(v[13], v[15]); CE(v[13], v[14]); CE(v[8], v[12]); CE(v[10], v[14]); CE(v[10], v[12]); CE(v[9], v[13]); CE(v[11], v[15]); CE(v[11], v[13]); CE(v[9], v[10]); CE(v[11], v[12]); CE(v[13], v[14]); CE(v[0], v[8]); CE(v[4], v[12]); CE(v[4], v[8]); CE(v[2], v[10]); CE(v[6], v[14]); CE(v[6], v[10]); CE(v[2], v[4]); CE(v[6], v[8]); CE(v[10], v[12]); CE(v[1], v[9]); CE(v[5], v[13]); CE(v[5], v[9]); CE(v[3], v[11]); CE(v[7], v[15]); CE(v[7], v[11]); CE(v[3], v[5]); CE(v[7], v[9]); CE(v[11], v[13]); CE(v[1], v[2]); CE(v[3], v[4]); CE(v[5], v[6]); CE(v[7], v[8]); CE(v[9], v[10]); CE(v[11], v[12]); CE(v[13], v[14]); } while (0)
#define MERGE16(T, S) do { _Pragma("unroll") for (int _i = 0; _i < 16; ++_i) (T)[_i] = max((T)[_i], (S)[15 - _i]); \
    _Pragma("unroll") for (int _d = 8; _d >= 1; _d >>= 1) { _Pragma("unroll") for (int _i = 0; _i < 16; ++_i) if ((_i & _d) == 0) CE((T)[_i], (T)[_i + _d]); } } while (0)
__device__ __forceinline__ void peer_topk(const Frame& F, const Args& A) {
    const float* SC = (const float*)(A.ws + WS_P + P_SC);
    int* IDX = (int*)(A.ws + WS_P + P_IDX); float* GATE = (float*)(A.ws + WS_P + P_GATE);
    const int gw = F.bid * NWAVES + F.wave, NGW = F.G * NWAVES;
    for (int it = gw; it < 512 * 8; it += NGW) {
        const int h = it & 7, tb = it >> 3; const int tok = tb * 64 + F.lane;
        unsigned r1[16], r2[16], rc[16];
        const float* p1 = SC + ((size_t)(tok >> 4) * 512 + h * 64) * 64 + (tok & 15) * 4; const float* p2 = p1 + 32 * 64;
        {
            float raw[128]; unsigned sg[16];
#pragma unroll
            for (int jq = 0; jq < 32; ++jq) { const f32x4 t4 = *(const f32x4*)(p1 + jq * 64); raw[4 * jq] = t4.x; raw[4 * jq + 1] = t4.y; raw[4 * jq + 2] = t4.z; raw[4 * jq + 3] = t4.w; }
#pragma unroll
            for (int j = 0; j < 16; ++j) r1[j] = (ordkey(raw[j]) & ~127u) | (unsigned)(127 - j);
            SORT16(r1);
#pragma unroll
            for (int gq = 1; gq < 8; ++gq) {
#pragma unroll
                for (int j = 0; j < 16; ++j) sg[j] = (ordkey(raw[16 * gq + j]) & ~127u) | (unsigned)(127 - (16 * gq + j));
                SORT16(sg); MERGE16(r1, sg); }
#pragma unroll
            for (int jq = 0; jq < 32; ++jq) { const f32x4 t4 = *(const f32x4*)(p2 + jq * 64); raw[4 * jq] = t4.x; raw[4 * jq + 1] = t4.y; raw[4 * jq + 2] = t4.z; raw[4 * jq + 3] = t4.w; }
#pragma unroll
            for (int j = 0; j < 16; ++j) r2[j] = (ordkey(raw[j]) & ~127u) | (unsigned)(127 - j);
            SORT16(r2);
#pragma unroll
            for (int gq = 1; gq < 8; ++gq) {
#pragma unroll
                for (int j = 0; j < 16; ++j) sg[j] = (ordkey(raw[16 * gq + j]) & ~127u) | (unsigned)(127 - (16 * gq + j));
                SORT16(sg); MERGE16(r2, sg); }
        }
        float v1[16], v2[16];
#pragma unroll
        for (int i = 0; i < 16; ++i) { v1[i] = unord((r1[i] & ~127u) | 64u); v2[i] = unord((r2[i] & ~127u) | 64u); }
        {
            unsigned cg[4][16]; int cn = 0;
#pragma unroll
            for (int a = 0; a < 16; ++a)
#pragma unroll
                for (int bq = 0; bq < 16; ++bq) if ((a + 1) * (bq + 1) <= 16) { cg[cn >> 4][cn & 15] = (ordkey(v1[a] + v2[bq]) & ~255u) | (unsigned)(a * 16 + bq); ++cn; }
#pragma unroll
            for (int z = 50; z < 64; ++z) cg[z >> 4][z & 15] = 0u;
            SORT16(cg[0]); SORT16(cg[1]); SORT16(cg[2]); SORT16(cg[3]);
            MERGE16(cg[0], cg[1]); MERGE16(cg[0], cg[2]); MERGE16(cg[0], cg[3]);
#pragma unroll
            for (int i = 0; i < 16; ++i) rc[i] = cg[0][i];
        }
        float val[16]; int ex[16];
        {
            LAS unsigned* t1 = (LAS unsigned*)(F.lds + F.wave * 8704) + F.lane * 17; LAS unsigned* t2 = t1 + 64 * 17;
#pragma unroll
            for (int i = 0; i < 16; ++i) { t1[i] = r1[i]; t2[i] = r2[i]; }
            LDS_WAIT(); asm volatile("" ::: "memory");
#pragma unroll
            for (int w = 0; w < 16; ++w) {
                const int a = (rc[w] >> 4) & 15, bq = rc[w] & 15;
                const unsigned k1 = t1[a], k2 = t2[bq];
                val[w] = unord((k1 & ~127u) | 64u) + unord((k2 & ~127u) | 64u);
                ex[w] = (127 - (int)(k1 & 127u)) * 128 + (127 - (int)(k2 & 127u));
            }
            LDS_WAIT(); asm volatile("" ::: "memory");
        }
        float mx = val[0];
#pragma unroll
        for (int w = 1; w < 16; ++w) mx = fmaxf(mx, val[w]);
        float sum = 0.f;
#pragma unroll
        for (int w = 0; w < 16; ++w) { val[w] = __expf(val[w] - mx); sum += val[w]; }
        const float inv = 1.f / sum;
        int* ip = IDX + (size_t)tok * 128 + h * 16; float* gp = GATE + (size_t)tok * 128 + h * 16;
#pragma unroll
        for (int q = 0; q < 4; ++q) { *(int4*)(ip + 4 * q) = make_int4(ex[4 * q], ex[4 * q + 1], ex[4 * q + 2], ex[4 * q + 3]);
            *(f32x4*)(gp + 4 * q) = (f32x4){val[4 * q] * inv, val[4 * q + 1] * inv, val[4 * q + 2] * inv, val[4 * q + 3] * inv}; }
    }
}

#define DPP_ADD(v, ctrl) ((v) + __builtin_bit_cast(float, __builtin_amdgcn_mov_dpp(__builtin_bit_cast(int, (v)), (ctrl), 0xf, 0xf, true)))
__device__ __forceinline__ void fp8x16_to_f32x2(const u32x4 r, f32x2* f) {
#pragma unroll
    for (int q = 0; q < 4; ++q) { f[2 * q] = __builtin_amdgcn_cvt_pk_f32_fp8((int)r[q], false); f[2 * q + 1] = __builtin_amdgcn_cvt_pk_f32_fp8((int)r[q], true); }
}
__device__ __forceinline__ void fp8x16_to_f32(const u32x4 r, float* f) {
#pragma unroll
    for (int q = 0; q < 4; ++q) { const f32x2 lo = __builtin_amdgcn_cvt_pk_f32_fp8((int)r[q], false), hi = __builtin_amdgcn_cvt_pk_f32_fp8((int)r[q], true);
        f[4 * q] = lo.x; f[4 * q + 1] = lo.y; f[4 * q + 2] = hi.x; f[4 * q + 3] = hi.y; }
}
__device__ __forceinline__ long lo64(u32x4 v) { return (long)(((unsigned long)v.y << 32) | (unsigned long)v.x); }
__device__ __forceinline__ long hi64(u32x4 v) { return (long)(((unsigned long)v.w << 32) | (unsigned long)v.z); }
template <int MODE>
__device__ __forceinline__ void peer_u_phase(const Frame& F, const Args& A) {
    const unsigned char* X8 = A.ws + WS_P + P_X8;
    const unsigned char* U8 = A.ws + WS_U8; const float* SU = (const float*)(A.ws + WS_SU); const float* SV = (const float*)(A.ws + WS_SV);
    const int* IDX = (const int*)(A.ws + WS_P + P_IDX); const float* GATE = (const float*)(A.ws + WS_P + P_GATE); float* AK = (float*)(MODE == 0 ? A.ws + WS_AK : A.ws + WS_P + P_SC);
    const int g = F.bid & 7, nmem = F.G >> 3, l = F.lane, step = nmem * NWAVES;
    const int loff = 64 * (l & 15) + 16 * (l >> 4);
    const bool dg = ((l & 15) >> 2) == (l >> 4); const int dr = l & 3;
    const float dw0 = (dg && dr == 0) ? 1.f : 0.f, dw1 = (dg && dr == 1) ? 1.f : 0.f, dw2 = (dg && dr == 2) ? 1.f : 0.f, dw3 = (dg && dr == 3) ? 1.f : 0.f;
    LAS int* le = (LAS int*)(F.lds + F.wave * 2048); LAS int* lk = le + 256;
    const bool b5 = (l & 32) != 0, b4 = (l & 16) != 0, b3 = (l & 8) != 0;
    int tok = 2 * ((F.bid >> 3) * NWAVES + F.wave);
    u32x4 nxA, nxB; int neA0, neA1, neB0, neB1; float ngA0, ngA1, ngB0, ngB1;
#define U_PREFETCH(t) do { const size_t _tA = (size_t)(t), _tB = (size_t)(t) + 1; if (MODE == 4) { nxA = (u32x4){(unsigned)_tA, 1u, 2u, 3u}; nxB = nxA; neA0 = (int)((_tA * 37 + l * 11) & 16383); neA1 = (int)((_tA * 53 + l * 7) & 16383); neB0 = (int)((_tB * 37 + l * 13) & 16383); neB1 = (int)((_tB * 29 + l * 3) & 16383); ngA0 = ngA1 = ngB0 = ngB1 = 0.01f; break; } nxA = *(const u32x4*)(X8 + _tA * 1024 + loff); nxB = *(const u32x4*)(X8 + _tB * 1024 + loff); \
        neA0 = IDX[_tA * 128 + l]; neA1 = IDX[_tA * 128 + 64 + l]; neB0 = IDX[_tB * 128 + l]; neB1 = IDX[_tB * 128 + 64 + l]; \
        ngA0 = GATE[_tA * 128 + l]; ngA1 = GATE[_tA * 128 + 64 + l]; ngB0 = GATE[_tB * 128 + l]; ngB1 = GATE[_tB * 128 + 64 + l]; } while (0)
    if (tok + 1 < T_TOK) U_PREFETCH(tok);
    for (; tok + 1 < T_TOK; tok += 2 * step) {
        const int tokA = tok, tokB = tok + 1;
        const u32x4 xA = nxA, xB = nxB;
        const int eA0 = neA0, eA1 = neA1, eB0 = neB0, eB1 = neB1; const float gA0 = ngA0, gA1 = ngA1, gB0 = ngB0, gB1 = ngB1;
        bool pf_done = false;
        const bool oA0 = (eA0 & 7) == g, oA1 = (eA1 & 7) == g, oB0 = (eB0 & 7) == g, oB1 = (eB1 & 7) == g;
        const unsigned long long mA0 = __ballot(oA0), mA1 = __ballot(oA1), mB0 = __ballot(oB0), mB1 = __ballot(oB1);
        const int c0 = __popcll(mA0), c1 = c0 + __popcll(mA1), c2 = c1 + __popcll(mB0), n = c2 + __popcll(mB1);
#define MBC(m) __builtin_amdgcn_mbcnt_hi((unsigned)((m) >> 32), __builtin_amdgcn_mbcnt_lo((unsigned)(m), 0u))
        if (oA0) { const int p = MBC(mA0); le[p] = (eA0 << 8) | l; lk[p] = __builtin_bit_cast(int, gA0); }
        if (oA1) { const int p = c0 + MBC(mA1); le[p] = (eA1 << 8) | (64 + l); lk[p] = __builtin_bit_cast(int, gA1); }
        if (oB0) { const int p = c1 + MBC(mB0); le[p] = (eB0 << 8) | 128 | l; lk[p] = __builtin_bit_cast(int, gB0); }
        if (oB1) { const int p = c2 + MBC(mB1); le[p] = (eB1 << 8) | 128 | (64 + l); lk[p] = __builtin_bit_cast(int, gB1); }
#undef MBC
        LDS_WAIT(); asm volatile("" ::: "memory");
        for (int cb = 0; cb < n || cb == 0; cb += 64) {
        const int nc = min(n, cb + 64);
        const bool fv = (cb + l) < nc;
        const int ent = fv ? le[cb + l] : 0; const float gt = fv ? __builtin_bit_cast(float, lk[cb + l]) : 0.f; float tot = 0.f;
        const float su = SU[ent >> 8], sv = SV[ent >> 8];
        const unsigned long long radr = (unsigned long long)(U8 + (size_t)(((ent >> 8) & 7) * 2048 + (((ent >> 8) >> 3) & (MODE == 2 ? 255 : 2047))) * 1024);
        const int ralo = (int)(unsigned)radr, rahi = (int)(unsigned)(radr >> 32);
        for (int i = cb; i < nc; i += 16) {
            u32x4 row[2][8];
#pragma unroll
            for (int b = 0; b < 2; ++b) if (i + 8 * b < nc) {
#pragma unroll
                for (int j = 0; j < 8; ++j) { const int ln = min(i + 8 * b + j, nc - 1) - cb;
                    const unsigned lo = (unsigned)__builtin_amdgcn_readlane(ralo, ln), hi = (unsigned)__builtin_amdgcn_readlane(rahi, ln);
                    const GAS unsigned char* rp = (const GAS unsigned char*)(((unsigned long long)hi << 32) | lo);
                    row[b][j] = *(const GAS u32x4*)(rp + (unsigned)loff); } }
            if (!pf_done) { pf_done = true; if (tok + 2 * step + 1 < T_TOK) U_PREFETCH(tok + 2 * step); }
#pragma unroll
            for (int b = 0; b < 2; ++b) if (i + 8 * b < nc) {
                float p[8];
                f32x4 accj[8];
                const int base0 = i + 8 * b;
                if (base0 + 8 <= c1) {
#pragma unroll
                    for (int j = 0; j < 8; ++j) accj[j] = __builtin_amdgcn_mfma_f32_16x16x32_fp8_fp8(lo64(row[b][j]), lo64(xA), (f32x4){0.f, 0.f, 0.f, 0.f}, 0, 0, 0);
#pragma unroll
                    for (int j = 0; j < 8; ++j) accj[j] = __builtin_amdgcn_mfma_f32_16x16x32_fp8_fp8(hi64(row[b][j]), hi64(xA), accj[j], 0, 0, 0);
                } else if (base0 >= c1) {
#pragma unroll
                    for (int j = 0; j < 8; ++j) accj[j] = __builtin_amdgcn_mfma_f32_16x16x32_fp8_fp8(lo64(row[b][j]), lo64(xB), (f32x4){0.f, 0.f, 0.f, 0.f}, 0, 0, 0);
#pragma unroll
                    for (int j = 0; j < 8; ++j) accj[j] = __builtin_amdgcn_mfma_f32_16x16x32_fp8_fp8(hi64(row[b][j]), hi64(xB), accj[j], 0, 0, 0);
                } else {
#pragma unroll
                    for (int j = 0; j < 8; ++j) { const u32x4 xs = (base0 + j >= c1) ? xB : xA; accj[j] = __builtin_amdgcn_mfma_f32_16x16x32_fp8_fp8(lo64(row[b][j]), lo64(xs), (f32x4){0.f, 0.f, 0.f, 0.f}, 0, 0, 0);
                        accj[j] = __builtin_amdgcn_mfma_f32_16x16x32_fp8_fp8(hi64(row[b][j]), hi64(xs), accj[j], 0, 0, 0); }
                }
#pragma unroll
                for (int j = 0; j < 8; ++j) p[j] = __builtin_fmaf(accj[j][3], dw3, __builtin_fmaf(accj[j][2], dw2, __builtin_fmaf(accj[j][1], dw1, accj[j][0] * dw0)));
                float q4[4], q2[2], q1;
#pragma unroll
                for (int j = 0; j < 4; ++j) { const float keep = b5 ? p[4 + j] : p[j], send = b5 ? p[j] : p[4 + j]; q4[j] = keep + __shfl_xor(send, 32); }
#pragma unroll
                for (int j = 0; j < 2; ++j) { const float keep = b4 ? q4[2 + j] : q4[j], send = b4 ? q4[j] : q4[2 + j]; q2[j] = keep + __shfl_xor(send, 16); }
                { const float keep = b3 ? q2[1] : q2[0], send = b3 ? q2[0] : q2[1]; q1 = keep + __shfl_xor(send, 8); }
                q1 = DPP_ADD(q1, 0xB1); q1 = DPP_ADD(q1, 0x4E); q1 = DPP_ADD(q1, 0x141);
                const float t = __builtin_bit_cast(float, __builtin_amdgcn_ds_bpermute((l & 7) * 32, __builtin_bit_cast(int, q1)));
                const int base = i + 8 * b;
                if ((l >> 3) == ((base - cb) >> 3)) tot = t;
            }
        }
        if (!pf_done) { if (tok + 2 * step + 1 < T_TOK) U_PREFETCH(tok + 2 * step); }
        if (fv) { const int tk = (ent & 128) ? tokB : tokA; AK[(size_t)tk * 128 + (ent & 127)] = gelu_tanh(tot * su * (1.f / 16.f)) * gt * sv; }
        if (n == 0) break;
        }
        LDS_WAIT(); asm volatile("" ::: "memory");
    }
#undef U_PREFETCH
}
template <int MODE>
__device__ __forceinline__ void peer_u_phase1(const Frame& F, const Args& A) {
    const unsigned char* X8 = A.ws + WS_P + P_X8;
    const unsigned char* U8 = A.ws + WS_U8; const float* SU = (const float*)(A.ws + WS_SU); const float* SV = (const float*)(A.ws + WS_SV);
    const int* IDX = (const int*)(A.ws + WS_P + P_IDX); const float* GATE = (const float*)(A.ws + WS_P + P_GATE); float* AK = (float*)(MODE == 0 ? A.ws + WS_AK : A.ws + WS_P + P_SC);
    const int g = F.bid & (UNG - 1), nmem = F.G >> UNG_SH, l = F.lane, step = nmem * NWAVES;
    const int loff = 64 * (l & 15) + 16 * (l >> 4);
    const bool dg = ((l & 15) >> 2) == (l >> 4); const int dr = l & 3;
    const float dw0 = (dg && dr == 0) ? 1.f : 0.f, dw1 = (dg && dr == 1) ? 1.f : 0.f, dw2 = (dg && dr == 2) ? 1.f : 0.f, dw3 = (dg && dr == 3) ? 1.f : 0.f;
    LAS int* le = (LAS int*)(F.lds + F.wave * 2048); LAS int* lk = le + 256;
    const bool b5 = (l & 32) != 0, b4 = (l & 16) != 0, b3 = (l & 8) != 0;
    int tok = (F.bid >> UNG_SH) * NWAVES + F.wave;
    u32x4 nxA; int neA0, neA1; float ngA0, ngA1;
#define U1_PREFETCH(t) do { const size_t _tA = (size_t)(t); nxA = *(const u32x4*)(X8 + _tA * 1024 + loff); \
        neA0 = IDX[_tA * 128 + l]; neA1 = IDX[_tA * 128 + 64 + l]; ngA0 = GATE[_tA * 128 + l]; ngA1 = GATE[_tA * 128 + 64 + l]; } while (0)
    if (tok < T_TOK) U1_PREFETCH(tok);
    for (; tok < T_TOK; tok += step) {
        const u32x4 xA = nxA;
        const int eA0 = neA0, eA1 = neA1; const float gA0 = ngA0, gA1 = ngA1;
        bool pf_done = false;
        const bool oA0 = (eA0 & (UNG - 1)) == g, oA1 = (eA1 & (UNG - 1)) == g;
        const unsigned long long mA0 = __ballot(oA0), mA1 = __ballot(oA1);
        const int c0 = __popcll(mA0), n = c0 + __popcll(mA1);
#define MBC(m) __builtin_amdgcn_mbcnt_hi((unsigned)((m) >> 32), __builtin_amdgcn_mbcnt_lo((unsigned)(m), 0u))
        if (oA0) { const int p = MBC(mA0); le[p] = (eA0 << 8) | l; lk[p] = __builtin_bit_cast(int, gA0); }
        if (oA1) { const int p = c0 + MBC(mA1); le[p] = (eA1 << 8) | (64 + l); lk[p] = __builtin_bit_cast(int, gA1); }
#undef MBC
        LDS_WAIT(); asm volatile("" ::: "memory");
        for (int cb = 0; cb < n || cb == 0; cb += 64) {
        const int nc = min(n, cb + 64);
        const bool fv = (cb + l) < nc;
        const int ent = fv ? le[cb + l] : 0; const float gt = fv ? __builtin_bit_cast(float, lk[cb + l]) : 0.f; float tot = 0.f;
        const float su = SU[ent >> 8], sv = SV[ent >> 8];
        const unsigned long long radr = (unsigned long long)(U8 + (size_t)(((ent >> 8) & (UNG - 1)) * (NEXP / UNG) + ((ent >> 8) >> UNG_SH)) * 1024);
        const int ralo = (int)(unsigned)radr, rahi = (int)(unsigned)(radr >> 32);
        for (int i = cb; i < nc; i += 16) {
            u32x4 row[2][8];
#pragma unroll
            for (int b = 0; b < 2; ++b) if (i + 8 * b < nc) {
#pragma unroll
                for (int j = 0; j < 8; ++j) { const int ln = min(i + 8 * b + j, nc - 1) - cb;
                    const unsigned lo = (unsigned)__builtin_amdgcn_readlane(ralo, ln), hi = (unsigned)__builtin_amdgcn_readlane(rahi, ln);
                    const GAS unsigned char* rp = (const GAS unsigned char*)(((unsigned long long)hi << 32) | lo);
                    row[b][j] = *(const GAS u32x4*)(rp + (unsigned)loff); } }
            if (!pf_done) { pf_done = true; if (tok + step < T_TOK) U1_PREFETCH(tok + step); }
#pragma unroll
            for (int b = 0; b < 2; ++b) if (i + 8 * b < nc) {
                float p[8]; f32x4 accj[8];
#pragma unroll
                for (int j = 0; j < 8; ++j) accj[j] = __builtin_amdgcn_mfma_f32_16x16x32_fp8_fp8(lo64(row[b][j]), lo64(xA), (f32x4){0.f, 0.f, 0.f, 0.f}, 0, 0, 0);
#pragma unroll
                for (int j = 0; j < 8; ++j) accj[j] = __builtin_amdgcn_mfma_f32_16x16x32_fp8_fp8(hi64(row[b][j]), hi64(xA), accj[j], 0, 0, 0);
#pragma unroll
                for (int j = 0; j < 8; ++j) p[j] = __builtin_fmaf(accj[j][3], dw3, __builtin_fmaf(accj[j][2], dw2, __builtin_fmaf(accj[j][1], dw1, accj[j][0] * dw0)));
                float q4[4], q2[2], q1;
#pragma unroll
                for (int j = 0; j < 4; ++j) { const float keep = b5 ? p[4 + j] : p[j], send = b5 ? p[j] : p[4 + j]; q4[j] = keep + __shfl_xor(send, 32); }
#pragma unroll
                for (int j = 0; j < 2; ++j) { const float keep = b4 ? q4[2 + j] : q4[j], send = b4 ? q4[j] : q4[2 + j]; q2[j] = keep + __shfl_xor(send, 16); }
                { const float keep = b3 ? q2[1] : q2[0], send = b3 ? q2[0] : q2[1]; q1 = keep + __shfl_xor(send, 8); }
                q1 = DPP_ADD(q1, 0xB1); q1 = DPP_ADD(q1, 0x4E); q1 = DPP_ADD(q1, 0x141);
                const float t = __builtin_bit_cast(float, __builtin_amdgcn_ds_bpermute((l & 7) * 32, __builtin_bit_cast(int, q1)));
                const int base = i + 8 * b;
                if ((l >> 3) == ((base - cb) >> 3)) tot = t;
            }
        }
        if (!pf_done) { pf_done = true; if (tok + step < T_TOK) U1_PREFETCH(tok + step); }
        if (fv) AK[(size_t)tok * 128 + (ent & 127)] = gelu_tanh(tot * su * (1.f / 16.f)) * gt * sv;
        if (n == 0) break;
        }
        LDS_WAIT(); asm volatile("" ::: "memory");
    }
#undef U1_PREFETCH
}
__device__ __forceinline__ float wave_max_nonneg(float v) {
    unsigned u = __builtin_bit_cast(unsigned, v);
    u = max(u, (unsigned)__builtin_amdgcn_mov_dpp((int)u, 0xB1, 0xf, 0xf, true));
    u = max(u, (unsigned)__builtin_amdgcn_mov_dpp((int)u, 0x4E, 0xf, 0xf, true));
    u = max(u, (unsigned)__builtin_amdgcn_mov_dpp((int)u, 0x141, 0xf, 0xf, true));
    u = max(u, (unsigned)__builtin_amdgcn_mov_dpp((int)u, 0x140, 0xf, 0xf, true));
    const unsigned a = (unsigned)__builtin_amdgcn_readlane((int)u, 0), b = (unsigned)__builtin_amdgcn_readlane((int)u, 16), c = (unsigned)__builtin_amdgcn_readlane((int)u, 32), d = (unsigned)__builtin_amdgcn_readlane((int)u, 48);
    return __builtin_bit_cast(float, max(max(a, b), max(c, d)));
}
template <int MODE>
__device__ __forceinline__ void peer_v_phase(const Frame& F, const Args& A) {
    const unsigned char* V8 = A.ws + WS_V8; const int* IDX = (const int*)(A.ws + WS_P + P_IDX); const float* AK = (const float*)(A.ws + WS_AK);
    float* out = MODE == 0 ? A.out : (float*)(A.ws + WS_P + P_SC);
    const int g = F.bid & 7, nmem = F.G >> 3, l = F.lane, sub = l & 7, rr = l >> 3, n16 = l & 15, q = l >> 4, step = nmem * NWAVES;
    const GAS unsigned char* vb = (const GAS unsigned char*)(V8 + (size_t)g * NEXP * 128);
    LAS unsigned long long* rep = (LAS unsigned long long*)(F.lds + F.wave * 2048);
    const unsigned long long bm = 0xFFull << (8 * (n16 & 7));
    const int repi = 2 * q + (n16 >> 3);
    const bool vl = (n16 < 8) && (q < 2);
    LAS float* stg = (LAS float*)(F.lds + 16384 + F.wave * 512);
    int tok = 2 * ((F.bid >> 3) * NWAVES + F.wave);
    int ne[4]; float na[4];
#define V_PREFETCH(t) do { const size_t _a = (size_t)(t) * 128, _b = ((size_t)(t) + 1) * 128; ne[0] = IDX[_a + l]; ne[1] = IDX[_a + 64 + l]; ne[2] = IDX[_b + l]; ne[3] = IDX[_b + 64 + l]; \
        na[0] = AK[_a + l]; na[1] = AK[_a + 64 + l]; na[2] = AK[_b + l]; na[3] = AK[_b + 64 + l]; } while (0)
    if (tok + 1 < T_TOK) V_PREFETCH(tok);
    for (; tok + 1 < T_TOK; tok += 2 * step) {
        const int e0 = ne[0], e1 = ne[1], e2 = ne[2], e3 = ne[3]; const float a0 = na[0], a1 = na[1], a2 = na[2], a3 = na[3];
        u32x4 rowA[16], rowB[16];
#pragma unroll
        for (int i = 0; i < 16; ++i) { const int src = (8 * (i & 7) + rr) * 4;
            const int ea = __builtin_amdgcn_ds_bpermute(src, i < 8 ? e0 : e1), eb = __builtin_amdgcn_ds_bpermute(src, i < 8 ? e2 : e3);
            rowA[i] = *(const GAS u32x4*)(vb + ((unsigned)ea * 128u + 16u * (unsigned)sub)); rowB[i] = *(const GAS u32x4*)(vb + ((unsigned)eb * 128u + 16u * (unsigned)sub)); }
        f32x4 HA = {0.f, 0.f, 0.f, 0.f}, HB = {0.f, 0.f, 0.f, 0.f};
        if (l < 32) { const float* hpa = out + (size_t)tok * D + g * 128 + 4 * l; HA = *(const f32x4*)hpa; HB = *(const f32x4*)(hpa + D); }
        if (tok + 2 * step + 1 < T_TOK) V_PREFETCH(tok + 2 * step);
        const float amA = wave_max_nonneg(fmaxf(fabsf(a0), fabsf(a1))), amB = wave_max_nonneg(fmaxf(fabsf(a2), fabsf(a3)));
        const float scA = amA > 0.f ? 224.f * __builtin_amdgcn_rcpf(amA) : 0.f, invA = amA * (1.f / 224.f), scB = amB > 0.f ? 224.f * __builtin_amdgcn_rcpf(amB) : 0.f, invB = amB * (1.f / 224.f);
        { const unsigned wA = (unsigned)__builtin_amdgcn_cvt_pk_fp8_f32(a0 * scA, a1 * scA, 0, false), wB = (unsigned)__builtin_amdgcn_cvt_pk_fp8_f32(a2 * scB, a3 * scB, 0, false);
          const unsigned r0 = (wA & 0xffu) * 0x01010101u, r1 = ((wA >> 8) & 0xffu) * 0x01010101u, r2 = (wB & 0xffu) * 0x01010101u, r3 = ((wB >> 8) & 0xffu) * 0x01010101u;
          rep[l] = ((unsigned long long)r0 << 32) | r0; rep[64 + l] = ((unsigned long long)r1 << 32) | r1; rep[128 + l] = ((unsigned long long)r2 << 32) | r2; rep[192 + l] = ((unsigned long long)r3 << 32) | r3; }
        LDS_WAIT(); asm volatile("" ::: "memory");
#pragma unroll
        for (int t2 = 0; t2 < 2; ++t2) {
            f32x4 alo = {0.f, 0.f, 0.f, 0.f}, ahi = {0.f, 0.f, 0.f, 0.f};
#pragma unroll
            for (int i = 0; i < 16; ++i) { const long bop = (long)(rep[128 * t2 + 8 * i + repi] & bm); const u32x4 rw = t2 ? rowB[i] : rowA[i];
                alo = __builtin_amdgcn_mfma_f32_16x16x32_fp8_fp8(lo64(rw), bop, alo, 0, 0, 0);
                ahi = __builtin_amdgcn_mfma_f32_16x16x32_fp8_fp8(hi64(rw), bop, ahi, 0, 0, 0); }
            const float inv = t2 ? invB : invA;
            float vlo[4], vhi[4];
#pragma unroll
            for (int r = 0; r < 4; ++r) { const float tl = alo[r], th = ahi[r];
                vlo[r] = (tl + __builtin_bit_cast(float, __builtin_amdgcn_ds_bpermute(((l + 40) & 63) * 4, __builtin_bit_cast(int, tl)))) * inv;
                vhi[r] = (th + __builtin_bit_cast(float, __builtin_amdgcn_ds_bpermute(((l + 40) & 63) * 4, __builtin_bit_cast(int, th)))) * inv; }
            if (vl) {
#pragma unroll
                for (int r = 0; r < 4; ++r) { stg[64 * q + 16 * r + n16] = vlo[r]; stg[64 * q + 16 * r + n16 + 8] = vhi[r]; } }
            LDS_WAIT(); asm volatile("" ::: "memory");
            if (l < 32) { const f32x4 dv = *(const LAS f32x4*)(stg + 4 * l); *(f32x4*)(out + (size_t)(tok + t2) * D + g * 128 + 4 * l) = (t2 ? HB : HA) + dv; }
            LDS_WAIT(); asm volatile("" ::: "memory");
        }
        LDS_WAIT(); asm volatile("" ::: "memory");
    }
#undef V_PREFETCH
}
__device__ __forceinline__ void final_norm_phase(const Frame& F, const Args& A) {
    const int gw = F.bid * NWAVES + F.wave, NGW = F.G * NWAVES, l = F.lane; const float* fg = A.in[I_FG];
    const f32x4* gp = (const f32x4*)fg + l;
    int tok = gw;
    for (; tok + 3 * NGW < T_TOK; tok += 4 * NGW) {
        f32x4 v[4][4]; float ss[4];
#pragma unroll
        for (int b = 0; b < 4; ++b) { const f32x4* hp = (const f32x4*)(A.out + (size_t)(tok + b * NGW) * D) + l;
#pragma unroll
            for (int j = 0; j < 4; ++j) v[b][j] = hp[64 * j]; }
#pragma unroll
        for (int b = 0; b < 4; ++b) { ss[b] = 0.f;
#pragma unroll
            for (int j = 0; j < 4; ++j) ss[b] += (v[b][j].x * v[b][j].x + v[b][j].y * v[b][j].y) + (v[b][j].z * v[b][j].z + v[b][j].w * v[b][j].w); }
#pragma unroll
        for (int o = 1; o < 64; o <<= 1) {
#pragma unroll
            for (int b = 0; b < 4; ++b) ss[b] += __shfl_xor(ss[b], o); }
#pragma unroll
        for (int b = 0; b < 4; ++b) { const float rstd = 1.f / sqrtf(ss[b] * (1.f / D) + EPS); f32x4* hp = (f32x4*)(A.out + (size_t)(tok + b * NGW) * D) + l;
#pragma unroll
            for (int j = 0; j < 4; ++j) hp[64 * j] = v[b][j] * rstd * gp[64 * j]; }
    }
    for (; tok < T_TOK; tok += NGW) { f32x4* hp = (f32x4*)(A.out + (size_t)tok * D) + l; f32x4 v[4]; float ss = 0.f;
#pragma unroll
        for (int j = 0; j < 4; ++j) { v[j] = hp[64 * j]; ss += (v[j].x * v[j].x + v[j].y * v[j].y) + (v[j].z * v[j].z + v[j].w * v[j].w); }
        const float rstd = 1.f / sqrtf(wave_sum(ss) * (1.f / D) + EPS);
#pragma unroll
        for (int j = 0; j < 4; ++j) hp[64 * j] = v[j] * rstd * gp[64 * j]; }
}

#ifdef DEBUG_CHECK
constexpr size_t WS_DBG = 472 * MiB;
__device__ __forceinline__ int dbg_tok(int i) { return (i * 509 + 3) & 32767; }
__device__ __forceinline__ float gelu_ref(float x) { return 0.5f * x * (1.f + tanhf(0.7978845608028654f * (x + 0.044715f * x * x * x))); }
__global__ void __launch_bounds__(512) dbg_scores(Args a) {
    __shared__ float n2s[1024]; __shared__ float q[2048];
    const int t = dbg_tok(blockIdx.x), tid = threadIdx.x;
    const bf16_t* N2 = (const bf16_t*)(a.ws + WS_N1); const float* SC = (const float*)(a.ws + WS_P + P_SC); unsigned* dbg = (unsigned*)(a.ws + WS_DBG);
    for (int k = tid; k < 1024; k += 512) n2s[k] = bf1(N2[(size_t)t * 1024 + k]);
    __syncthreads();
    for (int r = 0; r < 4; ++r) { const int c = tid + 512 * r; float s = 0.f; for (int k = 0; k < 1024; ++k) s += n2s[k] * a.in[I_WQ][(size_t)k * 2048 + c]; q[c] = s; }
    __syncthreads();
    float md = 0.f;
    for (int r = 0; r < 4; ++r) { const int n = tid + 512 * r, hh = n >> 7, key = n & 127; const float* kX = (hh & 1) ? a.in[I_K2] : a.in[I_K1];
        float s = 0.f; for (int d = 0; d < 128; ++d) s += q[hh * 128 + d] * kX[key * 128 + d];
        md = fmaxf(md, fabsf(s - SC[(size_t)n * T_TOK + t])); }
    atomicMax(&dbg[0], __builtin_bit_cast(unsigned, md));
}
__global__ void __launch_bounds__(64) dbg_topk(Args a) {
    __shared__ float s1[8][128], s2[8][128], cv[8][256]; __shared__ float t1v[8][16], t2v[8][16]; __shared__ int t1i[8][16], t2i[8][16], exi[8][16]; __shared__ float exv[8][16];
    const int t = dbg_tok(blockIdx.x), h = threadIdx.x;
    const float* SC = (const float*)(a.ws + WS_P + P_SC); const int* IDX = (const int*)(a.ws + WS_P + P_IDX); const float* GATE = (const float*)(a.ws + WS_P + P_GATE); unsigned* dbg = (unsigned*)(a.ws + WS_DBG);
    if (h >= 8) return;
    for (int j = 0; j < 128; ++j) { s1[h][j] = SC[(size_t)(h * 256 + j) * T_TOK + t]; s2[h][j] = SC[(size_t)(h * 256 + 128 + j) * T_TOK + t]; }
    for (int r = 0; r < 16; ++r) { int b1 = 0, b2 = 0; for (int j = 1; j < 128; ++j) { if (s1[h][j] > s1[h][b1]) b1 = j; if (s2[h][j] > s2[h][b2]) b2 = j; }
        t1v[h][r] = s1[h][b1]; t1i[h][r] = b1; s1[h][b1] = -1e30f; t2v[h][r] = s2[h][b2]; t2i[h][r] = b2; s2[h][b2] = -1e30f; }
    for (int c = 0; c < 256; ++c) cv[h][c] = t1v[h][c >> 4] + t2v[h][c & 15];
    for (int r = 0; r < 16; ++r) { int bc = 0; for (int c = 1; c < 256; ++c) if (cv[h][c] > cv[h][bc]) bc = c;
        exv[h][r] = cv[h][bc]; exi[h][r] = t1i[h][bc >> 4] * 128 + t2i[h][bc & 15]; cv[h][bc] = -1e30f; }
    float sum = 0.f; const float mx0 = exv[h][0]; for (int r = 0; r < 16; ++r) { exv[h][r] = expf(exv[h][r] - mx0); } for (int r = 0; r < 16; ++r) sum += exv[h][r];
    unsigned miss = 0; float gd = 0.f;
    for (int w = 0; w < 16; ++w) { const int e = IDX[(size_t)t * 128 + h * 16 + w]; const float g = GATE[(size_t)t * 128 + h * 16 + w]; bool found = false;
        for (int r = 0; r < 16; ++r) if (exi[h][r] == e) { found = true; gd = fmaxf(gd, fabsf(g - exv[h][r] / sum)); }
        if (!found) ++miss; }
    atomicAdd(&dbg[1], miss); atomicMax(&dbg[3], __builtin_bit_cast(unsigned, gd));
}
__global__ void __launch_bounds__(512) dbg_experts_pre(Args a) {
    __shared__ float n2s[1024]; __shared__ float ak[128]; __shared__ int ek[128]; __shared__ float red[8];
    const int t = dbg_tok(blockIdx.x), tid = threadIdx.x, lane = tid & 63, wave = tid >> 6;
    const bf16_t* N2 = (const bf16_t*)(a.ws + WS_N1); const int* IDX = (const int*)(a.ws + WS_P + P_IDX); const float* GATE = (const float*)(a.ws + WS_P + P_GATE);
    float* rows = (float*)(a.ws + WS_DBG + MiB);
    for (int k = tid; k < 1024; k += 512) n2s[k] = bf1(N2[(size_t)t * 1024 + k]);
    if (tid < 128) ek[tid] = IDX[(size_t)t * 128 + tid];
    __syncthreads();
    for (int k = wave * 16; k < wave * 16 + 16; ++k) { const float* u = a.in[I_PU] + (size_t)ek[k] * 1024; float s = 0.f; for (int j = lane; j < 1024; j += 64) s += u[j] * n2s[j];
        s = wave_sum(s); if (lane == 0) ak[k] = gelu_ref(s) * GATE[(size_t)t * 128 + k]; }
    __syncthreads();
    float h2[2]; float ss = 0.f;
    for (int r = 0; r < 2; ++r) { const int d = tid + 512 * r; float o = 0.f; for (int k = 0; k < 128; ++k) o += ak[k] * a.in[I_PV][(size_t)ek[k] * 1024 + d]; h2[r] = a.out[(size_t)t * 1024 + d] + o; ss += h2[r] * h2[r]; }
    ss = wave_sum(ss); if (lane == 0) red[wave] = ss; __syncthreads();
    float tot = 0.f; for (int w = 0; w < 8; ++w) tot += red[w];
    const float rstd = 1.f / sqrtf(tot / 1024.f + EPS);
    for (int r = 0; r < 2; ++r) { const int d = tid + 512 * r; rows[(size_t)blockIdx.x * 1024 + d] = h2[r] * rstd * a.in[I_FG][d]; }
}
__global__ void __launch_bounds__(512) dbg_experts_post(Args a) {
    const int t = dbg_tok(blockIdx.x), tid = threadIdx.x; const float* rows = (const float*)(a.ws + WS_DBG + MiB); float* dbgf = (float*)(a.ws + WS_DBG);
    float e = 0.f, n = 0.f;
    for (int r = 0; r < 2; ++r) { const int d = tid + 512 * r; const float x = rows[(size_t)blockIdx.x * 1024 + d], y = a.out[(size_t)t * 1024 + d]; e += (x - y) * (x - y); n += x * x; }
    e = wave_sum(e); n = wave_sum(n); if ((tid & 63) == 0) { atomicAdd(&dbgf[4], e); atomicAdd(&dbgf[5], n); }
}
__global__ void __launch_bounds__(512) dbg_report(Args a, int which) {
    const unsigned* dbg = (const unsigned*)(a.ws + WS_DBG); const float* dbgf = (const float*)(a.ws + WS_DBG);
    const float mA = dbgf[0], gd = dbgf[3]; const unsigned miss = dbg[1]; const float relC = sqrtf(dbgf[4] / fmaxf(dbgf[5], 1e-30f));
    float X;
    if (which == 0) { int mask = 0; if (mA > 0.05f) mask |= 1; if (miss > 400u) mask |= 2; if (relC > 0.05f) mask |= 4; if (gd > 0.02f) mask |= 8; X = 1000.f + 100.f * mask; }
    else if (which == 1) X = 1e6f * mA; else if (which == 2) X = 100.f + (float)miss; else if (which == 3) X = 1e6f * relC; else X = 1e6f * gd;
    for (size_t i = (size_t)blockIdx.x * 512 + threadIdx.x; i < (size_t)T_TOK * D; i += (size_t)gridDim.x * 512) a.out[i] = (i == 0) ? X : 0.f;
}
#endif

constexpr int NPH = 13;
__global__ void __launch_bounds__(NWAVES * 64, 2) fwd_kernel(Args args) {
    extern __shared__ __attribute__((aligned(16))) unsigned char lds_raw[];
    Frame F;
    F.lds = (LAS unsigned char*)lds_raw;
    F.tid = threadIdx.x; F.lane = F.tid & 63; F.wave = __builtin_amdgcn_readfirstlane(F.tid >> 6);
    F.G = gridDim.x; F.bid = blockIdx.x;
    volatile LAS unsigned* MISC = (volatile LAS unsigned*)(F.lds + MISC_OFF);
    for (int u = F.tid; u < (LDS_BYTES - LDSCTL_OFF) / 4; u += NWAVES * 64) ((LAS unsigned*)(F.lds + LDSCTL_OFF))[u] = 0u;
    __syncthreads();
    unsigned* ctl = (unsigned*)(args.ws + WS_CTL);
    const int lo = args.ph_lo, hi = args.ph_hi;
    XcdBarrier bar; bar.bar = ctl + CW_BAR + args.li * XCD_BAR_WORDS; bar.x = 0; bar.st = nullptr;
    if (hi - lo > 1) bar = xcd_barrier_post(ctl + CW_BAR + args.li * XCD_BAR_WORDS, MISC + 8);
#define IN(k) (lo <= (k) && (k) < hi)
#ifdef PROBE_TS
#define STAMP(k) do { if (F.bid == 0 && F.tid == 0) ((unsigned long long*)(args.ws + (472u << 20)))[(k)] = __builtin_amdgcn_s_memrealtime(); } while (0)
#else
#define STAMP(k) do { } while (0)
#endif
#define SEAM(k) do { if (IN(k) && IN((k) + 1)) { xcd_barrier(bar); if (XTRA_BAR) xcd_barrier(bar); } STAMP((k) + 1); } while (0)
    unsigned char* ws = args.ws;
    bf16_t* P = (bf16_t*)(ws + WS_P);

    STAMP(0);
    if (IN(0)) { phase0(F, args); SEAM(0); }
    if (IN(1)) {
        pg8::Gemm g{(const bf16_t*)(ws + WS_N1), (const bf16_t*)(ws + WS_WIN), T_TOK, NPROJ, D, D}; pg8::StaticOrder S; S.init(T_TOK, NPROJ, F.G, F.bid);
        pg8::EpiProj E{P, (float*)(ws + WS_ALR)};
        pg8::gemm_phase<pg8::EpiProj, pg8::StaticOrder, false, true>(F.lds, g, S, E);
        {
            const int nwg = (T_TOK / 256) * (NPROJ / 256), rem = nwg % F.G;
            if (rem == 0) convert_tables(F, args, F.bid * NWAVES + F.wave, F.G * NWAVES);
            else if (F.bid >= rem) convert_tables(F, args, (F.bid - rem) * NWAVES + F.wave, (F.G - rem) * NWAVES);
        }
        SEAM(1);
    }
    if (IN(2)) {
        gla_chunk_phase<false>(F, args);
        for (int it = F.bid; it < 1024; it += F.G) sgu_unit<false>(F, args, it);
        SEAM(2);
    }
    if (IN(3)) { if (DRY_EXP == 13) { gla_scan<true>(F, args); __syncthreads(); } gla_scan<false>(F, args); SEAM(3); }
    if (IN(4)) { if (DRY_EXP == 14) { gla_out_phase<true>(F, args); __syncthreads(); } gla_out_phase<false>(F, args); SEAM(4); }
    if (IN(5)) {
        { pg8::Gemm g{P + PC_Q, (const bf16_t*)(ws + WS_WA), T_TOK, D, 512, PLD}; pg8::StaticOrder S; S.init(T_TOK, D, F.G, F.bid);
          pg8::EpiBrA E{P}; pg8::gemm_phase<pg8::EpiBrA, pg8::StaticOrder, true, true>(F.lds, g, S, E); }
        { pg8::Gemm g{P + PC_SU, (const bf16_t*)(ws + WS_WB), T_TOK, D, 512, PLD}; pg8::StaticOrder S; S.init(T_TOK, D, F.G, F.bid);
          pg8::EpiBrB E{P}; pg8::gemm_phase<pg8::EpiBrB, pg8::StaticOrder, true, true>(F.lds, g, S, E); }
        SEAM(5);
    }
    if (IN(6)) {
        pg8::Gemm g{P + PC_MRG, (const bf16_t*)(ws + WS_WOUT), T_TOK, D, D, PLD}; pg8::StaticOrder S; S.init(T_TOK, D, F.G, F.bid);
        pg8::EpiOut E{args.in[I_X], args.out}; pg8::gemm_phase<pg8::EpiOut, pg8::StaticOrder, true, true>(F.lds, g, S, E);
        SEAM(6);
    }
    if (IN(7)) {
        const int gw = F.bid * NWAVES + F.wave, NGW = F.G * NWAVES;
        { int m = gw; for (; m + 3 * NGW < T_TOK; m += 4 * NGW) rms_rows_to_bf16<true, 4>(F.lane, args.out + (size_t)m * D, (size_t)NGW * D, args.in[I_N2G], (bf16_t*)(ws + WS_N1) + (size_t)m * D, (size_t)NGW * D, (unsigned*)(ws + WS_P + P_X8) + (size_t)m * 256, (size_t)NGW * 256);
          for (; m < T_TOK; m += NGW) rms_rows_to_bf16<true, 1>(F.lane, args.out + (size_t)m * D, 0, args.in[I_N2G], (bf16_t*)(ws + WS_N1) + (size_t)m * D, 0, (unsigned*)(ws + WS_P + P_X8) + (size_t)m * 256, 0); }
        SEAM(7);
    }
    if (IN(8)) {
        pg8::Gemm g{(const bf16_t*)(ws + WS_N1), (const bf16_t*)(ws + WS_WQF), T_TOK, 2048, D, D}; pg8::StaticOrder S; S.init(T_TOK, 2048, F.G, F.bid);
        pg8::EpiScores E{(float*)(ws + WS_P + P_SC)}; pg8::gemm_phase<pg8::EpiScores, pg8::StaticOrder, true, true>(F.lds, g, S, E);
        SEAM(8);
    }
    if (IN(9)) { peer_topk(F, args); SEAM(9); }
    if (IN(10)) { if (DRY_EXP == 2) { peer_u_phase<1>(F, args); __syncthreads(); } if (DRY_EXP == 3) { peer_u_phase<2>(F, args); __syncthreads(); } if (DRY_EXP == 4) { peer_u_phase<3>(F, args); __syncthreads(); } if (DRY_EXP == 5) { peer_u_phase<4>(F, args); __syncthreads(); } if (UNG == 8) peer_u_phase<0>(F, args); else peer_u_phase1<0>(F, args); SEAM(10); }
    if (IN(11)) { if (DRY_EXP == 1) { peer_v_phase<1>(F, args); __syncthreads(); } peer_v_phase<0>(F, args); SEAM(11); }
    if (IN(12)) { final_norm_phase(F, args); }
#undef IN
#undef SEAM
}


#ifdef PROBE_TS
__global__ void __launch_bounds__(512) probe_report(Args a, int pi, int pj) {
    const unsigned long long* ts = (const unsigned long long*)(a.ws + (472u << 20));
    const float X1 = 10.f * (float)(ts[pi + 1] - ts[pi]) * 0.01f, X2 = (float)(ts[pj + 1] - ts[pj]) * 0.01f;
    for (size_t i = (size_t)blockIdx.x * 512 + threadIdx.x; i < (size_t)T_TOK * D; i += (size_t)gridDim.x * 512) a.out[i] = (i == 0) ? X1 : X2;
}
#endif
extern "C" void kernel_launch(void* const* d_in, const int* in_sizes, int n_in, void* d_out, int out_size, void* d_ws, size_t ws_size, hipStream_t stream) {
    static int grid = 0;
    if (grid == 0) {
        if (n_in != 20 || in_sizes[0] != T_TOK * D || out_size != T_TOK * D || ws_size < WS_END) {
            fprintf(stderr, "kernel_launch: unexpected shapes: n_in %d in0 %d out %d ws %zu (need %zu)\n", n_in, n_in > 0 ? in_sizes[0] : -1, out_size, ws_size, (size_t)WS_END); grid = -1; return; }
        int dev = 0, cus = 0;
        if (hipGetDevice(&dev) != hipSuccess || hipDeviceGetAttribute(&cus, hipDeviceAttributeMultiprocessorCount, dev) != hipSuccess) { grid = -1; return; }
        if (hipFuncSetAttribute((const void*)fwd_kernel, hipFuncAttributeMaxDynamicSharedMemorySize, LDS_BYTES) != hipSuccess) { fprintf(stderr, "kernel_launch: hipFuncSetAttribute failed\n"); grid = -1; return; }
        int per_cu = 0;
        if (hipOccupancyMaxActiveBlocksPerMultiprocessor(&per_cu, (const void*)fwd_kernel, NWAVES * 64, LDS_BYTES) != hipSuccess || per_cu < 1) fprintf(stderr, "kernel_launch: occupancy query says %d\n", per_cu);
        (void)hipGetLastError();
        grid = cus;
    }
    if (grid < 0) return;
    (void)hipMemsetAsync((char*)d_ws + WS_CTL, 0, CTL_ZERO_BYTES, stream);
    Args a{};
    for (int i = 0; i < 20; ++i) a.in[i] = (const float*)d_in[i];
    a.out = (float*)d_out; a.ws = (unsigned char*)d_ws;
#ifndef LAUNCH_LIST
#define LAUNCH_LIST {0, NPH}
#endif
    static const int ranges[][2] = { LAUNCH_LIST };
    const int nl = (int)(sizeof(ranges) / sizeof(ranges[0]));
    for (int li = 0; li < nl; ++li) { a.ph_lo = ranges[li][0]; a.ph_hi = ranges[li][1]; a.li = li;
        hipLaunchKernelGGL(fwd_kernel, dim3(grid), dim3(NWAVES * 64), LDS_BYTES, stream, a); }
}
```

```cpp
#include <hip/hip_runtime.h>
#include <cstdio>
#include <cstdint>


#ifndef XTRA_BAR
#define XTRA_BAR 0
#endif
#ifndef DRY_EXP
#define DRY_EXP 0
#endif
#ifndef DUP_PHASE
#define DUP_PHASE -1
#endif
#ifndef MK_N_LAUNCHES
#define MK_N_LAUNCHES 1
#endif

#define LAS __attribute__((address_space(3)))
#define GAS __attribute__((address_space(1)))
typedef unsigned short bf16_t;
typedef short bf16x8 __attribute__((ext_vector_type(8)));
typedef float f32x4 __attribute__((ext_vector_type(4)));
typedef float f32x2 __attribute__((ext_vector_type(2)));
typedef unsigned u32x4 __attribute__((ext_vector_type(4)));
typedef unsigned u32x2 __attribute__((ext_vector_type(2)));
typedef __bf16 bf16x2_t __attribute__((ext_vector_type(2)));

constexpr int T_TOK = 32768, D = 1024, SEQ = 4096, NBATCH = 8;
constexpr int NPROJ = 5376;
constexpr int PLD = 5120;
constexpr int PC_Q = 0, PC_K = 512, PC_V = 1024, PC_R = 1536, PC_SU = 2048, PC_SV = 2560, PC_GA = 3072, PC_GB = 4096;
constexpr int PC_MRG = 512;
constexpr float EPS = 1e-6f;
constexpr int NEXP = 16384;
#ifndef U_NG
#define U_NG 2
#endif
constexpr int UNG = U_NG, UNG_SH = (U_NG == 8 ? 3 : (U_NG == 4 ? 2 : (U_NG == 2 ? 1 : 0)));

constexpr size_t MiB = 1u << 20;
constexpr size_t WS_CTL = 0, CTL_ZERO_BYTES = 64 * 1024;
constexpr size_t WS_WIN = 1 * MiB;
constexpr size_t WS_WA = 12 * MiB;
constexpr size_t WS_WB = 13 * MiB;
constexpr size_t WS_WOUT = 14 * MiB;
constexpr size_t WS_WQF = 16 * MiB;
constexpr size_t WS_U8 = 20 * MiB;
constexpr size_t WS_V8 = 36 * MiB;
constexpr size_t WS_SU = 52 * MiB;
constexpr size_t WS_SV = 52 * MiB + 65536;
constexpr size_t WS_AK = 53 * MiB;
constexpr size_t WS_DEC = 84 * MiB;
constexpr size_t WS_ALR = 85 * MiB;
constexpr size_t WS_N1 = 87 * MiB;
constexpr size_t WS_P = 151 * MiB;
constexpr size_t WS_END = 471 * MiB;
constexpr size_t P_SC = 0, P_IDX = 256 * MiB, P_GATE = 272 * MiB, P_X8 = 288 * MiB;

constexpr int CW_BAR = 4096;

constexpr int RING_BYTES = 131072;
constexpr int LDSCTL_OFF = RING_BYTES, MISC_OFF = LDSCTL_OFF + 320;
constexpr int LDS_BYTES = 147456;
constexpr int NWAVES = 8;

__device__ __forceinline__ unsigned pk2(float lo, float hi) { const f32x2 v = {lo, hi}; const bf16x2_t b = __builtin_convertvector(v, bf16x2_t); return __builtin_bit_cast(unsigned, b); }
__device__ __forceinline__ unsigned f2bf(float f) { return pk2(f, 0.f) & 0xffffu; }
__device__ __forceinline__ float bflo(unsigned w) { return __builtin_bit_cast(float, w << 16); }
__device__ __forceinline__ float bfhi(unsigned w) { return __builtin_bit_cast(float, w & 0xffff0000u); }
__device__ __forceinline__ float bf1(bf16_t h) { return __builtin_bit_cast(float, ((unsigned)h) << 16); }
__device__ __forceinline__ float sigmoidf_(float x) { return __builtin_amdgcn_rcpf(1.f + __expf(-x)); }
__device__ __forceinline__ float gelu_tanh(float x) { const float y = 1.5957691216057308f * (x + 0.044715f * x * x * x); return x * sigmoidf_(y); }
__device__ __forceinline__ float siluf_(float x) { return x * sigmoidf_(x); }
__device__ __forceinline__ float wave_sum(float v) {
#pragma unroll
    for (int o = 1; o < 64; o <<= 1) v += __shfl_xor(v, o);
    return v;
}
#define LDS_WAIT() asm volatile("s_waitcnt lgkmcnt(0)" ::: "memory")
#define VM_WAIT() asm volatile("s_waitcnt vmcnt(0)" ::: "memory")

namespace pg8 {
constexpr int BM = 256, BK = 64, HALF = 128, HTB = HALF * BK * 2, STAGE_BYTES = 8 * HTB, NXCD = 8, WGM = 8;
__host__ __device__ __forceinline__ int lds_byte(int r, int c) { const int st = (r >> 4) * 2 + (c >> 5), rr = r & 15, cc = c & 31, ob = rr * 64 + cc * 2; return st * 1024 + (ob ^ (((ob >> 9) & 1) << 5)); }
__host__ __device__ __forceinline__ void stage_rc(int b, int& R, int& C) { const int st = b / 1024, sb = b % 1024, swz = sb ^ (((sb >> 9) & 1) << 5); R = (st >> 1) * 16 + swz / 64; C = (st & 1) * 32 + (swz % 64) / 2; }
__host__ __device__ __forceinline__ int perm32(int rho) { const int n = rho >> 4, i = rho & 15; return 8 * (i >> 2) + 4 * n + (i & 3); }

struct Unit { int pm, pn; };
struct Gemm { const bf16_t* A; const bf16_t* Bt; int M, N, K, lda; };

struct StaticOrder {
    int nM, nN, nwg, G, c;
    __host__ __device__ void init(int M, int N, int G_, int c_) { nM = M / BM; nN = N / BM; nwg = nM * nN; G = G_; c = c_; }
    __host__ __device__ bool next(int i, Unit& u) const {
        const long L = (long)i * G + c; if (L >= nwg) return false;
        int wgid = (int)L; { const int q = nwg / NXCD, r = nwg % NXCD, xcd = wgid % NXCD, off = wgid / NXCD; wgid = (xcd < r ? xcd * (q + 1) : r * (q + 1) + (xcd - r) * q) + off; }
        const int nig = WGM * nN, gid = wgid / nig, fm = gid * WGM, gsz = (nM - fm) < WGM ? (nM - fm) : WGM;
        u.pm = fm + ((wgid % nig) % gsz); u.pn = (wgid % nig) / gsz; return true;
    }
    __device__ __forceinline__ void a_ready(const Unit&) const {}
    __device__ __forceinline__ void done(const Unit&) const {}
};

template <class Epi, class Sched, bool ALIGN_EPI = false, bool SP2 = false>
__device__ __forceinline__ void gemm_phase(LAS unsigned char* lds, const Gemm g, const Sched& S, const Epi& E) {
    const int tid = threadIdx.x, wid = __builtin_amdgcn_readfirstlane(tid >> 6), lane = tid & 63, wr = wid >> 2, wc = wid & 3, fr = lane & 15, fq = lane >> 4;
    const int K = g.K, nt = K / BK, lda = g.lda;
    unsigned voffA[2], voffB[2];
#pragma unroll
    for (int i = 0; i < 2; ++i) { int R, C; stage_rc(tid * 16 + i * 8192, R, C); const int Rb = Epi::PERM ? ((R & ~31) + perm32(R & 31)) : R;
        voffA[i] = (unsigned)(R * lda + C) * 2u; voffB[i] = (unsigned)(Rb * K + C) * 2u; }
    const size_t kstep = (size_t)(BK * 2);
    const size_t hstepA = (size_t)HALF * lda * 2, hstepB = (size_t)HALF * K * 2;
    const size_t tstepA = 2 * hstepA, tstepB = 2 * hstepB;
    const unsigned ldsw = (unsigned)wid * 1024u;
    const int aoff = lds_byte(wr * 64 + fr, fq * 8), boff = lds_byte(wc * 32 + fr, fq * 8);
#define PG8_SA(b, h) (((b) * 2 + (h)) * HTB)
#define PG8_SB(b, h) ((4 + (b) * 2 + (h)) * HTB)
#define PG8_STAGE(bufoff, gbase, voff) do { _Pragma("unroll") for (int _i = 0; _i < 2; ++_i) \
        __builtin_amdgcn_global_load_lds((const unsigned*)((const char*)(gbase) + (voff)[_i]), (LAS unsigned*)(lds + (bufoff) + ldsw + _i * 8192), 16, 0, 0); } while (0)
#define PG8_LDA(dst, b, h) do { _Pragma("unroll") for (int m = 0; m < 4; ++m) _Pragma("unroll") for (int k = 0; k < 2; ++k) dst[m][k] = *(const LAS bf16x8*)(lds + PG8_SA(b, h) + aoff + m * 2048 + k * 1024); } while (0)
#define PG8_LDB(dst, b, h) do { _Pragma("unroll") for (int n = 0; n < 2; ++n) _Pragma("unroll") for (int k = 0; k < 2; ++k) dst[n][k] = *(const LAS bf16x8*)(lds + PG8_SB(b, h) + boff + n * 2048 + k * 1024); } while (0)
#define PG8_MMA(ai, bj, At, Bt) do { __builtin_amdgcn_s_setprio(1); _Pragma("unroll") for (int m = 0; m < 4; ++m) _Pragma("unroll") for (int n = 0; n < 2; ++n) _Pragma("unroll") for (int k = 0; k < 2; ++k) \
        acc[ai][bj][m][n] = __builtin_amdgcn_mfma_f32_16x16x32_bf16(Bt[n][k], At[m][k], acc[ai][bj][m][n], 0, 0, 0); __builtin_amdgcn_s_setprio(0); } while (0)
#define PG8_WAIT_V(n) asm volatile("s_waitcnt vmcnt(" #n ")" ::: "memory")
#define PG8_WAIT_L(n) asm volatile("s_waitcnt lgkmcnt(" #n ")" ::: "memory")
#define PG8_BAR __builtin_amdgcn_s_barrier()
#define PG8_SCHED __builtin_amdgcn_sched_barrier(0)
    Unit cur, nxt; int ui = 0;
    if (!S.next(0, cur)) return;
    f32x4 acc[2][2][4][2];
#pragma unroll
    for (int a = 0; a < 2; ++a)
#pragma unroll
        for (int b = 0; b < 2; ++b)
#pragma unroll
            for (int m = 0; m < 4; ++m)
#pragma unroll
                for (int n = 0; n < 2; ++n) acc[a][b][m][n] = (f32x4){0.f, 0.f, 0.f, 0.f};
    bf16x8 At[4][2], B0[2][2], B1[2][2];
    const char* cA = (const char*)g.A + (size_t)cur.pm * tstepA; const char* cB = (const char*)g.Bt + (size_t)cur.pn * tstepB;
    S.a_ready(cur);
    if constexpr (SP2) {
        PG8_STAGE(PG8_SB(0, 0), cB, voffB); PG8_STAGE(PG8_SB(0, 1), cB + hstepB, voffB); PG8_STAGE(PG8_SA(0, 0), cA, voffA); PG8_STAGE(PG8_SA(0, 1), cA + hstepA, voffA);
        if (wr == 1) PG8_BAR;
        PG8_WAIT_V(2); PG8_BAR;
        PG8_STAGE(PG8_SB(1, 0), cB + kstep, voffB); PG8_STAGE(PG8_SA(1, 0), cA + kstep, voffA); PG8_STAGE(PG8_SB(1, 1), cB + hstepB + kstep, voffB);
        PG8_WAIT_V(6); PG8_BAR;
    } else {
        PG8_STAGE(PG8_SB(0, 0), cB, voffB); PG8_STAGE(PG8_SA(0, 0), cA, voffA); PG8_STAGE(PG8_SB(0, 1), cB + hstepB, voffB); PG8_STAGE(PG8_SA(0, 1), cA + hstepA, voffA);
        if (wr == 1) PG8_BAR;
        PG8_WAIT_V(4); PG8_BAR;
        PG8_STAGE(PG8_SB(1, 0), cB + kstep, voffB); PG8_STAGE(PG8_SA(1, 0), cA + kstep, voffA); PG8_STAGE(PG8_SB(1, 1), cB + hstepB + kstep, voffB);
        PG8_WAIT_V(6); PG8_BAR;
    }
    for (;;) {
        const bool has_next = S.next(ui + 1, nxt);
        const char* nA = has_next ? (const char*)g.A + (size_t)nxt.pm * tstepA : cA; const char* nB = has_next ? (const char*)g.Bt + (size_t)nxt.pn * tstepB : cB;
        for (int t = 0; t < nt; t += 2) {
            const bool last = (t == nt - 2);
            const char* a1 = cA + (size_t)(t + 1) * kstep;
            const char* a2 = last ? nA : cA + (size_t)(t + 2) * kstep; const char* b2 = last ? nB : cB + (size_t)(t + 2) * kstep;
            const char* a3 = a2 + kstep; const char* b3 = b2 + kstep;
            if (last && has_next) S.a_ready(nxt);
            if constexpr (SP2) {
            PG8_LDB(B0, 0, 0); PG8_LDB(B1, 0, 1); PG8_SCHED; PG8_LDA(At, 0, 0); PG8_STAGE(PG8_SA(1, 1), a1 + hstepA, voffA);
            PG8_WAIT_V(8); PG8_WAIT_L(0); PG8_BAR; PG8_MMA(0, 0, At, B0); PG8_MMA(0, 1, At, B1); PG8_BAR; PG8_SCHED;
            PG8_LDA(At, 0, 1); PG8_STAGE(PG8_SB(0, 0), b2, voffB); PG8_STAGE(PG8_SB(0, 1), b2 + hstepB, voffB); PG8_STAGE(PG8_SA(0, 0), a2, voffA);
            PG8_WAIT_V(8); PG8_WAIT_L(0); PG8_BAR; PG8_MMA(1, 0, At, B0); PG8_MMA(1, 1, At, B1); PG8_BAR; PG8_SCHED;
            PG8_LDB(B0, 1, 0); PG8_LDB(B1, 1, 1); PG8_SCHED; PG8_LDA(At, 1, 0); PG8_STAGE(PG8_SA(0, 1), a2 + hstepA, voffA);
            PG8_WAIT_V(8); PG8_WAIT_L(0); PG8_BAR; PG8_MMA(0, 0, At, B0); PG8_MMA(0, 1, At, B1); PG8_BAR; PG8_SCHED;
            PG8_LDA(At, 1, 1); PG8_STAGE(PG8_SB(1, 0), b3, voffB); PG8_STAGE(PG8_SB(1, 1), b3 + hstepB, voffB); PG8_STAGE(PG8_SA(1, 0), a3, voffA);
            PG8_WAIT_V(8); PG8_WAIT_L(0); PG8_BAR; PG8_MMA(1, 0, At, B0); PG8_MMA(1, 1, At, B1); PG8_BAR; PG8_SCHED;
            } else {
            PG8_LDB(B0, 0, 0); PG8_SCHED; PG8_LDA(At, 0, 0); PG8_STAGE(PG8_SA(1, 1), a1 + hstepA, voffA);
            PG8_WAIT_L(8); PG8_BAR; PG8_WAIT_L(0); PG8_MMA(0, 0, At, B0); PG8_BAR; PG8_SCHED;
            PG8_LDB(B1, 0, 1); PG8_STAGE(PG8_SB(0, 0), b2, voffB);
            PG8_BAR; PG8_WAIT_L(0); PG8_MMA(0, 1, At, B1); PG8_BAR;
            PG8_LDA(At, 0, 1); PG8_STAGE(PG8_SA(0, 0), a2, voffA);
            PG8_BAR; PG8_WAIT_L(0); PG8_MMA(1, 0, At, B0); PG8_BAR; PG8_SCHED;
            PG8_STAGE(PG8_SB(0, 1), b2 + hstepB, voffB);
            PG8_WAIT_V(6); PG8_BAR; PG8_MMA(1, 1, At, B1); PG8_BAR;
            PG8_LDB(B0, 1, 0); PG8_SCHED; PG8_LDA(At, 1, 0); PG8_STAGE(PG8_SA(0, 1), a2 + hstepA, voffA);
            PG8_WAIT_L(8); PG8_BAR; PG8_WAIT_L(0); PG8_MMA(0, 0, At, B0); PG8_BAR; PG8_SCHED;
            PG8_LDB(B1, 1, 1); PG8_STAGE(PG8_SB(1, 0), b3, voffB);
            PG8_BAR; PG8_WAIT_L(0); PG8_MMA(0, 1, At, B1); PG8_BAR;
            PG8_LDA(At, 1, 1); PG8_STAGE(PG8_SA(1, 0), a3, voffA);
            PG8_BAR; PG8_WAIT_L(0); PG8_MMA(1, 0, At, B0); PG8_BAR; PG8_SCHED;
            PG8_STAGE(PG8_SB(1, 1), b3 + hstepB, voffB);
            PG8_WAIT_V(6); PG8_BAR; PG8_MMA(1, 1, At, B1); PG8_BAR;
            }
        }
        if constexpr (ALIGN_EPI) { if (wr == 0) PG8_BAR; }
        E(acc, cur, wr, wc, fr, fq); S.done(cur);
        if (!has_next) break;
#pragma unroll
        for (int a = 0; a < 2; ++a)
#pragma unroll
            for (int b = 0; b < 2; ++b)
#pragma unroll
                for (int m = 0; m < 4; ++m)
#pragma unroll
                    for (int n = 0; n < 2; ++n) acc[a][b][m][n] = (f32x4){0.f, 0.f, 0.f, 0.f};
        cur = nxt; cA = nA; cB = nB; ++ui;
        if constexpr (ALIGN_EPI) { if (wr == 1) PG8_BAR; }
    }
    PG8_WAIT_V(0);
    if constexpr (!ALIGN_EPI) { if (wr == 0) PG8_BAR; }
    PG8_BAR;
#undef PG8_SA
#undef PG8_SB
#undef PG8_STAGE
#undef PG8_LDA
#undef PG8_LDB
#undef PG8_MMA
#undef PG8_WAIT_V
#undef PG8_WAIT_L
#undef PG8_BAR
#undef PG8_SCHED
}

__device__ __forceinline__ u32x4 pack8(f32x4 v0, f32x4 v1) { u32x4 w; w.x = pk2(v0[0], v0[1]); w.y = pk2(v0[2], v0[3]); w.z = pk2(v1[0], v1[1]); w.w = pk2(v1[2], v1[3]); return w; }
__device__ __forceinline__ void unpack8(u32x4 w, f32x4& v0, f32x4& v1) { v0 = (f32x4){bflo(w.x), bfhi(w.x), bflo(w.y), bfhi(w.y)}; v1 = (f32x4){bflo(w.z), bfhi(w.z), bflo(w.w), bfhi(w.w)}; }

struct EpiProj {
    static constexpr bool PERM = true;
    bf16_t* P; float* ALR;
    __device__ __forceinline__ void operator()(const f32x4 (&acc)[2][2][4][2], const Unit& u, int wr, int wc, int fr, int fq) const {
        const int row0 = u.pm * BM + wr * 64 + fr; const int pn = u.pn; const int cl = wc * 32 + 8 * fq;
        if (pn == 20) {
            if (wc == 0 && fq < 2) {
#pragma unroll
                for (int ai = 0; ai < 2; ++ai)
#pragma unroll
                    for (int m = 0; m < 4; ++m) { float* rp = ALR + (size_t)(row0 + ai * HALF + m * 16) * 16 + 8 * fq;
                        *(f32x4*)rp = acc[ai][0][m][0]; *(f32x4*)(rp + 4) = acc[ai][0][m][1]; }
            }
            return;
        }
        const int mode = pn < 8 ? 0 : (pn < 12 ? 1 : 2);
#pragma unroll
        for (int ai = 0; ai < 2; ++ai)
#pragma unroll
            for (int m = 0; m < 4; ++m) { bf16_t* rowp = P + (size_t)(row0 + ai * HALF + m * 16) * PLD + pn * BM + cl;
#pragma unroll
                for (int bj = 0; bj < 2; ++bj) { f32x4 v0 = acc[ai][bj][m][0], v1 = acc[ai][bj][m][1];
                    if (mode == 1) {
#pragma unroll
                        for (int i = 0; i < 4; ++i) { v0[i] = gelu_tanh(v0[i]); v1[i] = gelu_tanh(v1[i]); }
                    } else if (mode == 2) {
#pragma unroll
                        for (int i = 0; i < 4; ++i) { v0[i] = sigmoidf_(v0[i]); v1[i] = sigmoidf_(v1[i]); }
                    }
                    *(u32x4*)(rowp + bj * HALF) = pack8(v0, v1); } }
    }
};
struct EpiBrA {
    static constexpr bool PERM = true;
    bf16_t* P;
    __device__ __forceinline__ void operator()(const f32x4 (&acc)[2][2][4][2], const Unit& u, int wr, int wc, int fr, int fq) const {
        const int row0 = u.pm * BM + wr * 64 + fr; const int c0 = u.pn * BM + wc * 32 + 8 * fq;
#pragma unroll
        for (int ai = 0; ai < 2; ++ai)
#pragma unroll
            for (int m = 0; m < 4; ++m) { bf16_t* rowp = P + (size_t)(row0 + ai * HALF + m * 16) * PLD;
#pragma unroll
                for (int bj = 0; bj < 2; ++bj) { const int c = c0 + bj * HALF; f32x4 g0, g1; unpack8(*(const u32x4*)(rowp + PC_GA + c), g0, g1);
                    *(u32x4*)(rowp + PC_MRG + c) = pack8(acc[ai][bj][m][0] * g0, acc[ai][bj][m][1] * g1); } }
    }
};
struct EpiBrB {
    static constexpr bool PERM = true;
    bf16_t* P;
    __device__ __forceinline__ void operator()(const f32x4 (&acc)[2][2][4][2], const Unit& u, int wr, int wc, int fr, int fq) const {
        const int row0 = u.pm * BM + wr * 64 + fr; const int c0 = u.pn * BM + wc * 32 + 8 * fq;
#pragma unroll
        for (int ai = 0; ai < 2; ++ai)
#pragma unroll
            for (int m = 0; m < 4; ++m) { bf16_t* rowp = P + (size_t)(row0 + ai * HALF + m * 16) * PLD;
#pragma unroll
                for (int bj = 0; bj < 2; ++bj) { const int c = c0 + bj * HALF; f32x4 g0, g1, p0, p1; unpack8(*(const u32x4*)(rowp + PC_GB + c), g0, g1); unpack8(*(const u32x4*)(rowp + PC_MRG + c), p0, p1);
                    *(u32x4*)(rowp + PC_MRG + c) = pack8(p0 + acc[ai][bj][m][0] * g0, p1 + acc[ai][bj][m][1] * g1); } }
    }
};
struct EpiOut {
    static constexpr bool PERM = true;
    const float* X; float* O;
    __device__ __forceinline__ void operator()(const f32x4 (&acc)[2][2][4][2], const Unit& u, int wr, int wc, int fr, int fq) const {
        const int row0 = u.pm * BM + wr * 64 + fr; const int c0 = u.pn * BM + wc * 32 + 8 * fq;
#pragma unroll
        for (int ai = 0; ai < 2; ++ai)
#pragma unroll
            for (int m = 0; m < 4; ++m) { const size_t ro = (size_t)(row0 + ai * HALF + m * 16) * D;
#pragma unroll
                for (int bj = 0; bj < 2; ++bj) { const int c = c0 + bj * HALF;
                    const f32x4 x0 = *(const f32x4*)(X + ro + c), x1 = *(const f32x4*)(X + ro + c + 4);
                    *(f32x4*)(O + ro + c) = x0 + acc[ai][bj][m][0]; *(f32x4*)(O + ro + c + 4) = x1 + acc[ai][bj][m][1]; } }
    }
};
struct EpiScores {
    static constexpr bool PERM = true;
    float* SC;
    __device__ __forceinline__ void operator()(const f32x4 (&acc)[2][2][4][2], const Unit& u, int wr, int wc, int fr, int fq) const {
        const int tb0 = u.pm * 16 + wr * 4; const int cq0 = (u.pn * BM + wc * 32 + 8 * fq) >> 2;
#pragma unroll
        for (int ai = 0; ai < 2; ++ai)
#pragma unroll
            for (int m = 0; m < 4; ++m) { float* bp = SC + ((size_t)(tb0 + ai * 8 + m) * 512) * 64 + fr * 4;
#pragma unroll
                for (int bj = 0; bj < 2; ++bj)
#pragma unroll
                    for (int n = 0; n < 2; ++n) *(f32x4*)(bp + (size_t)(cq0 + bj * 32 + n) * 64) = acc[ai][bj][m][n]; }
    }
};
}

#define XB_TMO      128
#define XB_XCNT(j)  (256  + 64 * (j))
#define XB_XSUB(j)  (1280 + 64 * (j))
#define XB_XGEN(j)  (2304 + 64 * (j))
#define XB_TOP      3328
#define XB_TOPGEN   3392
#define XCD_BAR_WORDS 3456
#define XB_SPIN_CAP (1u << 18)
__device__ __forceinline__ unsigned xb_ld(unsigned* p)              { return __hip_atomic_load(p, __ATOMIC_RELAXED, __HIP_MEMORY_SCOPE_AGENT); }
__device__ __forceinline__ unsigned xb_add(unsigned* p, unsigned v) { return __hip_atomic_fetch_add(p, v, __ATOMIC_RELAXED, __HIP_MEMORY_SCOPE_AGENT); }
__device__ __forceinline__ unsigned xb_xcc_id() { return (unsigned)__builtin_amdgcn_s_getreg((3 << 11) | 20) & 0xFu; }
#define XB_SPIN(cond, bar) do { unsigned _sp = 0; while (cond) { __builtin_amdgcn_s_sleep(1); \
    if ((++_sp & 255u) == 0u) { if (xb_ld(&(bar)[XB_TMO])) break; if (_sp > XB_SPIN_CAP) { atomicAdd(&(bar)[XB_TMO], 1u); break; } } } } while (0)
struct XcdBarrier { unsigned* bar; unsigned x; volatile LAS unsigned* st; };
__device__ __forceinline__ XcdBarrier xcd_barrier_post(unsigned* bar, volatile LAS unsigned* st) {
    XcdBarrier b; b.bar = bar; b.x = xb_xcc_id(); b.st = st;
    if (threadIdx.x == 0) (void)xb_add(&bar[XB_XCNT(b.x)], 1u);
    return b;
}
__device__ __forceinline__ void xcd_barrier_complete(unsigned* bar, unsigned x, unsigned& nloc, unsigned& nx) {
    const unsigned G = gridDim.x * gridDim.y * gridDim.z;
    unsigned sum, cnt, mine, sp = 0u;
    for (;;) {
        sum = 0u; cnt = 0u; mine = 0u;
#pragma unroll
        for (unsigned j = 0; j < 16; ++j) { const unsigned c = xb_ld(&bar[XB_XCNT(j)]); sum += c; cnt += (c > 0u) ? 1u : 0u; mine = (j == x) ? c : mine; }
        if (sum == G) break;
        __builtin_amdgcn_s_sleep(1);
        if ((++sp & 255u) == 0u) { if (xb_ld(&bar[XB_TMO])) break; if (sp > XB_SPIN_CAP) { atomicAdd(&bar[XB_TMO], 1u); break; } }
    }
    nloc = mine > 0u ? mine : 1u; nx = cnt > 0u ? cnt : 1u;
}
__device__ __forceinline__ void xcd_barrier(const XcdBarrier& b) {
    asm volatile("s_waitcnt vmcnt(0)" ::: "memory");
    __syncthreads();
    if (threadIdx.x == 0) {
        unsigned* bar = b.bar;
        __builtin_amdgcn_s_waitcnt(0);
        unsigned nloc = b.st[0], nx = b.st[1];
        if (nloc == 0u) { xcd_barrier_complete(bar, b.x, nloc, nx); b.st[0] = nloc; b.st[1] = nx; }
        const unsigned old = xb_add(&bar[XB_XSUB(b.x)], 1u);
        const unsigned gen = old / nloc;
        if (old + 1u == (gen + 1u) * nloc) {
            __builtin_amdgcn_fence(__ATOMIC_RELEASE, "agent");
            asm volatile("s_waitcnt vmcnt(0)" ::: "memory");
            const unsigned og = xb_add(&bar[XB_TOP], 1u);
            const unsigned tg = og / nx;
            if (og + 1u == (tg + 1u) * nx) xb_add(&bar[XB_TOPGEN], 1u);
            else XB_SPIN(xb_ld(&bar[XB_TOPGEN]) == tg, bar);
            __builtin_amdgcn_fence(__ATOMIC_ACQUIRE, "agent");
            xb_add(&bar[XB_XGEN(b.x)], 1u);
            asm volatile("s_waitcnt vmcnt(0)" ::: "memory");
        } else {
            XB_SPIN(xb_ld(&bar[XB_XGEN(b.x)]) == gen, bar);
            __builtin_amdgcn_fence(__ATOMIC_ACQUIRE, "agent");
            asm volatile("s_waitcnt vmcnt(0)" ::: "memory");
        }
    }
    __syncthreads();
}

struct Args {
    const float* in[20]; float* out; unsigned char* ws; int ph_lo, ph_hi, li, pad;
};
enum { I_X = 0, I_N1G, I_WIN, I_WGU, I_BG, I_GLAG, I_SLNG, I_SLNB, I_SW, I_SB, I_WBA, I_WBB, I_WOUT, I_N2G, I_WQ, I_K1, I_K2, I_PU, I_PV, I_FG };

struct Frame {
    LAS unsigned char* lds;
    int tid, lane, wave, G, bid;
};

template <int MODE>
__device__ __forceinline__ void p0_transpose_item(const float* W, int K, int Nsrc, int Ndst, bf16_t* WT, LAS float* scr, int item, int lane) {
    const int nblk = Ndst / 32, kb = item / nblk, nb = item % nblk, k0 = 64 * kb, n0 = 32 * nb;
    const int nd = n0 + (lane & 31);
    int sc = nd; bool valid = true;
    if (MODE == 1) { if (nd < 2048) sc = nd; else if (nd < 5120) sc = nd + 16; else if (nd < 5136) sc = 2048 + (nd - 5120); else { sc = 0; valid = false; } }
#pragma unroll 8
    for (int i = 0; i < 32; ++i) { const int kk = 2 * i + (lane >> 5); const float v = valid ? W[(size_t)(k0 + kk) * Nsrc + sc] : 0.f; scr[kk * 33 + (lane & 31)] = v; }
    LDS_WAIT(); asm volatile("" ::: "memory");
    const int c = lane & 7;
#pragma unroll
    for (int j = 0; j < 4; ++j) { const int n = (lane >> 3) + 8 * j; const LAS float* s = scr + (8 * c) * 33 + n;
        u32x4 o; o.x = pk2(s[0 * 33], s[1 * 33]); o.y = pk2(s[2 * 33], s[3 * 33]); o.z = pk2(s[4 * 33], s[5 * 33]); o.w = pk2(s[6 * 33], s[7 * 33]);
        *(u32x4*)(WT + (size_t)(n0 + n) * K + k0 + 8 * c) = o; }
    LDS_WAIT(); asm volatile("" ::: "memory");
}
template <bool F8, int NB>
__device__ __forceinline__ void rms_rows_to_bf16(int lane, const float* x0, size_t xstride, const float* g, bf16_t* o0, size_t ostride, unsigned* o80 = nullptr, size_t o8stride = 0) {
    f32x4 v[NB][4]; float s[NB];
#pragma unroll
    for (int b = 0; b < NB; ++b) { const f32x4* xr = (const f32x4*)(x0 + b * xstride) + lane;
#pragma unroll
        for (int j = 0; j < 4; ++j) v[b][j] = xr[64 * j]; }
#pragma unroll
    for (int b = 0; b < NB; ++b) { s[b] = 0.f;
#pragma unroll
        for (int j = 0; j < 4; ++j) s[b] += (v[b][j].x * v[b][j].x + v[b][j].y * v[b][j].y) + (v[b][j].z * v[b][j].z + v[b][j].w * v[b][j].w); }
#pragma unroll
    for (int o = 1; o < 64; o <<= 1) {
#pragma unroll
        for (int b = 0; b < NB; ++b) s[b] += __shfl_xor(s[b], o); }
    const f32x4* gr = (const f32x4*)g + lane;
#pragma unroll
    for (int b = 0; b < NB; ++b) { const float rstd = 1.f / sqrtf(s[b] * (1.f / D) + EPS); u32x2* o8 = (u32x2*)(o0 + b * ostride) + lane;
#pragma unroll
        for (int j = 0; j < 4; ++j) { const f32x4 gg = gr[64 * j]; const f32x4 y = v[b][j] * rstd * gg; u32x2 o; o.x = pk2(y.x, y.y); o.y = pk2(y.z, y.w); o8[64 * j] = o;
            if (F8) { int w = 0; w = __builtin_amdgcn_cvt_pk_fp8_f32(bflo(o.x) * 16.f, bfhi(o.x) * 16.f, w, false); w = __builtin_amdgcn_cvt_pk_fp8_f32(bflo(o.y) * 16.f, bfhi(o.y) * 16.f, w, true); (o80 + b * o8stride)[64 * j + lane] = (unsigned)w; } } }
}
__device__ __forceinline__ float wave_max(float v) {
#pragma unroll
    for (int o = 1; o < 64; o <<= 1) v = fmaxf(v, __shfl_xor(v, o));
    return v;
}
template <int NB>
__device__ __forceinline__ void cvt_rows_fp8(int lane, const float* const (&src)[NB], unsigned char* const (&dst16)[NB], float* const (&scale_out)[NB]) {
    f32x4 v[NB][4]; float m[NB];
#pragma unroll
    for (int b = 0; b < NB; ++b) {
#pragma unroll
        for (int j = 0; j < 4; ++j) v[b][j] = *(const GAS f32x4*)(src[b] + 16 * lane + 4 * j); }
#pragma unroll
    for (int b = 0; b < NB; ++b) { m[b] = 0.f;
#pragma unroll
        for (int j = 0; j < 4; ++j) m[b] = fmaxf(m[b], fmaxf(fmaxf(fabsf(v[b][j].x), fabsf(v[b][j].y)), fmaxf(fabsf(v[b][j].z), fabsf(v[b][j].w)))); }
#pragma unroll
    for (int o = 1; o < 64; o <<= 1) {
#pragma unroll
        for (int b = 0; b < NB; ++b) m[b] = fmaxf(m[b], __shfl_xor(m[b], o)); }
#pragma unroll
    for (int b = 0; b < NB; ++b) { const float inv = m[b] > 0.f ? 224.f / m[b] : 0.f, sc = m[b] > 0.f ? m[b] * (1.f / 224.f) : 1.f;
        u32x4 o;
#pragma unroll
        for (int j = 0; j < 4; ++j) { int w = 0; w = __builtin_amdgcn_cvt_pk_fp8_f32(v[b][j].x * inv, v[b][j].y * inv, w, false); w = __builtin_amdgcn_cvt_pk_fp8_f32(v[b][j].z * inv, v[b][j].w * inv, w, true); o[j] = (unsigned)w; }
        *(GAS u32x4*)dst16[b] = o;
        if (lane == 0) *(GAS float*)scale_out[b] = sc; }
}
__device__ __forceinline__ void convert_tables(const Frame& F, const Args& A, int wi, int nw) {
    unsigned char* ws = A.ws; const int gw = wi, NGW = nw;
    int mc = gw;
    for (; mc + 3 * NGW < 2 * NEXP; mc += 4 * NGW) { const int m = mc;
        const float* src[4]; unsigned char* dst[4]; float* sco[4];
#pragma unroll
        for (int b = 0; b < 4; ++b) { const int mm = m + b * NGW;
            if (mm < NEXP) { const int e = mm; src[b] = A.in[I_PU] + (size_t)e * D; dst[b] = ws + WS_U8 + (size_t)((e & (UNG - 1)) * (NEXP / UNG) + (e >> UNG_SH)) * 1024 + 16 * F.lane; sco[b] = (float*)(ws + WS_SU) + e; }
            else { const int e = mm - NEXP; src[b] = A.in[I_PV] + (size_t)e * D; dst[b] = ws + WS_V8 + ((size_t)(F.lane >> 3) * NEXP + e) * 128 + 16 * (F.lane & 7); sco[b] = (float*)(ws + WS_SV) + e; } }
        cvt_rows_fp8<4>(F.lane, src, dst, sco);
    }
    for (; mc < 2 * NEXP; mc += NGW) { const float* src[1]; unsigned char* dst[1]; float* sco[1];
        if (mc < NEXP) { const int e = mc; src[0] = A.in[I_PU] + (size_t)e * D; dst[0] = ws + WS_U8 + (size_t)((e & (UNG - 1)) * (NEXP / UNG) + (e >> UNG_SH)) * 1024 + 16 * F.lane; sco[0] = (float*)(ws + WS_SU) + e; }
        else { const int e = mc - NEXP; src[0] = A.in[I_PV] + (size_t)e * D; dst[0] = ws + WS_V8 + ((size_t)(F.lane >> 3) * NEXP + e) * 128 + 16 * (F.lane & 7); sco[0] = (float*)(ws + WS_SV) + e; }
        cvt_rows_fp8<1>(F.lane, src, dst, sco); }
}
__device__ __forceinline__ void phase0(const Frame& F, const Args& A) {
    unsigned char* ws = A.ws;
    {
        LAS float* kx = (LAS float*)F.lds;
        LAS float* wt = (LAS float*)(F.lds + 128 * 129 * 4);
        bf16_t* WQF = (bf16_t*)(ws + WS_WQF);
        for (int it = F.bid; it < 512; it += F.G) {
            const int hh = it >> 5, kblk = it & 31, k0 = kblk * 32;
            const float* kX = (hh & 1) ? A.in[I_K2] : A.in[I_K1];
            __syncthreads();
            for (int e = F.tid; e < 128 * 128; e += 512) kx[(e >> 7) * 129 + (e & 127)] = kX[e];
            for (int e = F.tid; e < 32 * 128; e += 512) wt[e] = A.in[I_WQ][(size_t)(k0 + (e >> 7)) * 2048 + hh * 128 + (e & 127)];
            __syncthreads();
            const int key = F.tid & 127, kq = F.tid >> 7;
            float acc[8];
#pragma unroll
            for (int i = 0; i < 8; ++i) acc[i] = 0.f;
            for (int d = 0; d < 128; ++d) { const float b = kx[key * 129 + d];
#pragma unroll
                for (int i = 0; i < 8; ++i) acc[i] += wt[(kq * 8 + i) * 128 + d] * b; }
            u32x4 o; o.x = pk2(acc[0], acc[1]); o.y = pk2(acc[2], acc[3]); o.z = pk2(acc[4], acc[5]); o.w = pk2(acc[6], acc[7]);
            *(u32x4*)(WQF + (size_t)(hh * 128 + key) * 1024 + k0 + kq * 8) = o;
        }
        __syncthreads();
    }
    LAS float* scr = (LAS float*)(F.lds + F.wave * 16384);
    const int gw = F.bid * NWAVES + F.wave, NGW = F.G * NWAVES;
    constexpr int I_IN = 16 * (NPROJ / 32), I_A = 8 * 32, I_B = 8 * 32, I_O = 16 * 32;
    constexpr int NITEMS = I_IN + I_A + I_B + I_O;
    for (int it = gw; it < NITEMS; it += NGW) {
        int r = it;
        if (r < I_IN) { p0_transpose_item<1>(A.in[I_WIN], 1024, 5136, NPROJ, (bf16_t*)(ws + WS_WIN), scr, r, F.lane); continue; } r -= I_IN;
        if (r < I_A) { p0_transpose_item<0>(A.in[I_WBA], 512, 1024, 1024, (bf16_t*)(ws + WS_WA), scr, r, F.lane); continue; } r -= I_A;
        if (r < I_B) { p0_transpose_item<0>(A.in[I_WBB], 512, 1024, 1024, (bf16_t*)(ws + WS_WB), scr, r, F.lane); continue; } r -= I_B;
        p0_transpose_item<0>(A.in[I_WOUT], 1024, 1024, 1024, (bf16_t*)(ws + WS_WOUT), scr, r, F.lane);
    }
    { int m = gw; for (; m + 3 * NGW < T_TOK; m += 4 * NGW) rms_rows_to_bf16<false, 4>(F.lane, A.in[I_X] + (size_t)m * D, (size_t)NGW * D, A.in[I_N1G], (bf16_t*)(ws + WS_N1) + (size_t)m * D, (size_t)NGW * D);
      for (; m < T_TOK; m += NGW) rms_rows_to_bf16<false, 1>(F.lane, A.in[I_X] + (size_t)m * D, 0, A.in[I_N1G], (bf16_t*)(ws + WS_N1) + (size_t)m * D, 0); }
}

__device__ __forceinline__ float log_sigmoid(float z) { return fminf(z, 0.f) - log1pf(__expf(-fabsf(z))); }

template <bool DRY>
__device__ __forceinline__ void gla_chunk_phase(const Frame& F, const Args& A) {
    unsigned char* ws = A.ws;
    const bf16_t* P = (const bf16_t*)(ws + WS_P);
    const float* ALR = (const float*)(ws + WS_ALR);
    LAS float* alr = (LAS float*)F.lds;
    LAS float* tot = (LAS float*)(F.lds + 4096);
    LAS bf16_t* kdT = (LAS bf16_t*)(F.lds + 8192);
    LAS bf16_t* vT = (LAS bf16_t*)(F.lds + 26624);
    LAS bf16_t* stT = (LAS bf16_t*)(F.lds + 45056);
    const int tid = F.tid, kk = tid & 127, seg = tid >> 7;
    const bool hconst = (F.G & 3) == 0;
    int hcur = -1; float w[16]; float bias = 0.f;
#pragma unroll
    for (int j = 0; j < 16; ++j) w[j] = 0.f;
    float na0, na1; bf16_t nk[16], nv[16];
#define GC_LOAD(unit) do { const int h_ = (unit) & 3, c_ = ((unit) >> 2) & 63, b_ = (unit) >> 8; const int t0_ = b_ * SEQ + c_ * 64; \
        na0 = ALR[(size_t)t0_ * 16 + tid]; na1 = ALR[(size_t)t0_ * 16 + 512 + tid]; \
        const bf16_t* kp_ = P + (size_t)(t0_ + 16 * seg) * PLD + PC_K + h_ * 128 + kk; const bf16_t* vp_ = P + (size_t)(t0_ + 16 * seg) * PLD + PC_V + h_ * 128 + kk; \
        _Pragma("unroll") for (int i_ = 0; i_ < 16; ++i_) { nk[i_] = kp_[(size_t)i_ * PLD]; nv[i_] = vp_[(size_t)i_ * PLD]; } } while (0)
    int unit = F.bid;
    if (unit < 2048) GC_LOAD(unit);
    for (; unit < 2048; unit += F.G) {
        const int h = unit & 3;
        if (h != hcur) { hcur = h;
#pragma unroll
            for (int j = 0; j < 16; ++j) w[j] = A.in[I_WGU][(size_t)j * 512 + h * 128 + kk];
            bias = A.in[I_BG][h * 128 + kk]; }
        __syncthreads();
        alr[tid] = na0; alr[512 + tid] = na1;
        bf16_t kr[16], vr[16];
#pragma unroll
        for (int i = 0; i < 16; ++i) { kr[i] = nk[i]; vr[i] = nv[i]; }
        if (unit + F.G < 2048) GC_LOAD(unit + F.G);
        __syncthreads();
        float cum[16]; float run = 0.f;
#pragma unroll
        for (int i = 0; i < 16; ++i) { const LAS f32x4* ap = (const LAS f32x4*)(alr + (16 * seg + i) * 16); float z = bias;
#pragma unroll
            for (int q = 0; q < 4; ++q) { const f32x4 a4 = ap[q]; z += a4.x * w[4 * q] + a4.y * w[4 * q + 1] + a4.z * w[4 * q + 2] + a4.w * w[4 * q + 3]; }
            const float ls = fminf(z, 0.f) - __logf(1.f + __expf(-fabsf(z)));
            run += ls * (1.f / 16.f); cum[i] = run; }
        tot[seg * 128 + kk] = run;
        __syncthreads();
        {
            const float t0s = tot[kk], t1s = tot[128 + kk], t2s = tot[256 + kk], t3s = tot[384 + kk];
            const float total = (t0s + t1s) + (t2s + t3s);
            const float prefix = seg == 0 ? 0.f : (seg == 1 ? t0s : (seg == 2 ? t0s + t1s : t0s + t1s + t2s));
            unsigned kw[8], vw[8];
#pragma unroll
            for (int i = 0; i < 8; ++i) {
                const float e0 = __expf(total - (prefix + cum[2 * i])), e1 = __expf(total - (prefix + cum[2 * i + 1]));
                kw[i] = pk2(bf1(kr[2 * i]) * e0, bf1(kr[2 * i + 1]) * e1); vw[i] = (unsigned)vr[2 * i] | ((unsigned)vr[2 * i + 1] << 16);
            }
            *(LAS u32x4*)(kdT + kk * 72 + 16 * seg) = (u32x4){kw[0], kw[1], kw[2], kw[3]}; *(LAS u32x4*)(kdT + kk * 72 + 16 * seg + 8) = (u32x4){kw[4], kw[5], kw[6], kw[7]};
            *(LAS u32x4*)(vT + kk * 72 + 16 * seg) = (u32x4){vw[0], vw[1], vw[2], vw[3]}; *(LAS u32x4*)(vT + kk * 72 + 16 * seg + 8) = (u32x4){vw[4], vw[5], vw[6], vw[7]};
            if (seg == 0) ((float*)(DRY ? (unsigned char*)A.out + 96 * MiB : ws + WS_DEC))[(size_t)unit * 128 + kk] = __expf(total);
        }
        __syncthreads();
        {
            const int w8 = F.wave, l = F.lane, fr = l & 15, fq = l >> 4;
            f32x4 acc[8];
#pragma unroll
            for (int n = 0; n < 8; ++n) acc[n] = (f32x4){0.f, 0.f, 0.f, 0.f};
#pragma unroll
            for (int ks = 0; ks < 2; ++ks) {
                const bf16x8 a = *(const LAS bf16x8*)(kdT + (16 * w8 + fr) * 72 + 32 * ks + 8 * fq);
#pragma unroll
                for (int n = 0; n < 8; ++n) { const bf16x8 bb = *(const LAS bf16x8*)(vT + (16 * n + fr) * 72 + 32 * ks + 8 * fq);
                    acc[n] = __builtin_amdgcn_mfma_f32_16x16x32_bf16(a, bb, acc[n], 0, 0, 0); }
            }
#pragma unroll
            for (int n = 0; n < 8; ++n) { u32x2 o; o.x = pk2(acc[n][0], acc[n][1]); o.y = pk2(acc[n][2], acc[n][3]);
                *(LAS u32x2*)(stT + (16 * n + fr) * 136 + 16 * w8 + 4 * fq) = o; }
        }
        __syncthreads();
        {
            bf16_t* ST = (bf16_t*)(DRY ? (unsigned char*)A.out : ws + WS_N1) + (size_t)unit * 16384;
            const int vv = tid >> 2, part = tid & 3;
#pragma unroll
            for (int q = 0; q < 4; ++q) *(u32x4*)(ST + (size_t)vv * 128 + 32 * part + 8 * q) = *(const LAS u32x4*)(stT + vv * 136 + 32 * part + 8 * q);
        }
    }
#undef GC_LOAD
    (void)hconst;
}

template <bool DRY>
__device__ __forceinline__ void sgu_unit(const Frame& F, const Args& A, int unit) {
    const int g = unit & 3, blk = (unit >> 2) & 31, b = unit >> 7;
    const int t0 = b * SEQ + blk * 128;
    bf16_t* P = (bf16_t*)(A.ws + WS_P);
    LAS bf16_t* wA = (LAS bf16_t*)F.lds;
    LAS bf16_t* vnT = (LAS bf16_t*)(F.lds + 34816);
    LAS float* st = (LAS float*)(F.lds + 69632);
    LAS bf16_t* suS = (LAS bf16_t*)(F.lds + 70656);
    const int tid = F.tid;
    __syncthreads();
    {
        const int j = tid >> 2, q = tid & 3;
        const bf16_t* sp = P + (size_t)(t0 + j) * PLD + PC_SV + q * 128;
        float s = 0.f, s2 = 0.f;
#pragma unroll
        for (int i = 0; i < 16; ++i) { const u32x4 w = *(const u32x4*)(sp + 8 * i);
            const float f[8] = {bflo(w.x), bfhi(w.x), bflo(w.y), bfhi(w.y), bflo(w.z), bfhi(w.z), bflo(w.w), bfhi(w.w)};
#pragma unroll
            for (int e = 0; e < 8; ++e) { s += f[e]; s2 += f[e] * f[e]; } }
        s += __shfl_xor(s, 1); s += __shfl_xor(s, 2); s2 += __shfl_xor(s2, 1); s2 += __shfl_xor(s2, 2);
        const float mu = s * (1.f / 512.f); const float var = fmaxf(s2 * (1.f / 512.f) - mu * mu, 0.f);
        if (q == 0) { st[2 * j] = mu; st[2 * j + 1] = 1.f / sqrtf(var + EPS); }
    }
    {
        const int i = tid >> 2, jb = (tid & 3) * 32;
        const float* wp = A.in[I_SW] + (size_t)g * 16384 + (size_t)i * 128 + jb;
        const bf16_t* sup = P + (size_t)(t0 + i) * PLD + PC_SU + g * 128 + jb;
#pragma unroll
        for (int q = 0; q < 4; ++q) { const f32x4 a = *(const f32x4*)(wp + 8 * q), bq = *(const f32x4*)(wp + 8 * q + 4);
            const bool z = (i < 64) && (jb + 8 * q >= 64);
            u32x4 o; o.x = pk2(a.x, a.y); o.y = pk2(a.z, a.w); o.z = pk2(bq.x, bq.y); o.w = pk2(bq.z, bq.w);
            if (z) o = (u32x4){0u, 0u, 0u, 0u};
            *(LAS u32x4*)(wA + i * 136 + jb + 8 * q) = o;
            *(LAS u32x4*)(suS + i * 136 + jb + 8 * q) = *(const u32x4*)(sup + 8 * q); }
    }
    const int cch = tid & 127, seg = tid >> 7;
    bf16_t xr[32];
    { const bf16_t* sp = P + (size_t)(t0 + 32 * seg) * PLD + PC_SV + g * 128 + cch;
#pragma unroll
      for (int i = 0; i < 32; ++i) xr[i] = sp[(size_t)i * PLD]; }
    const float lg = A.in[I_SLNG][g * 128 + cch], lb = A.in[I_SLNB][g * 128 + cch];
    __syncthreads();
    {
        unsigned ow[16];
#pragma unroll
        for (int i = 0; i < 16; ++i) { const int j = 32 * seg + 2 * i; const f32x4 ms = *(const LAS f32x4*)(st + 2 * j);
            ow[i] = pk2((bf1(xr[2 * i]) - ms.x) * ms.y * lg + lb, (bf1(xr[2 * i + 1]) - ms.z) * ms.w * lg + lb); }
#pragma unroll
        for (int q = 0; q < 4; ++q) *(LAS u32x4*)(vnT + cch * 136 + 32 * seg + 8 * q) = (u32x4){ow[4 * q], ow[4 * q + 1], ow[4 * q + 2], ow[4 * q + 3]};
    }
    __syncthreads();
    {
        const int w = F.wave, l = F.lane, fr = l & 15, fq = l >> 4;
        f32x4 acc[8];
#pragma unroll
        for (int n = 0; n < 8; ++n) acc[n] = (f32x4){0.f, 0.f, 0.f, 0.f};
#pragma unroll
        for (int ks = 0; ks < 4; ++ks) {
            const bf16x8 a = *(const LAS bf16x8*)(wA + (16 * w + fr) * 136 + 32 * ks + 8 * fq);
#pragma unroll
            for (int n = 0; n < 8; ++n) { const bf16x8 bb = *(const LAS bf16x8*)(vnT + (16 * n + fr) * 136 + 32 * ks + 8 * fq);
                acc[n] = __builtin_amdgcn_mfma_f32_16x16x32_bf16(a, bb, acc[n], 0, 0, 0); }
        }
#pragma unroll
        for (int jj = 0; jj < 4; ++jj) { const int i = 16 * w + 4 * fq + jj; const float bias = A.in[I_SB][g * 128 + i];
            LAS bf16_t* rp = suS + i * 136 + fr;
#pragma unroll
            for (int n = 0; n < 8; ++n) { const float su = bf1(rp[16 * n]); rp[16 * n] = (bf16_t)f2bf(su * (acc[n][jj] + bias)); } }
    }
    __syncthreads();
    {
        const int i = tid >> 2, jb = (tid & 3) * 32;
        bf16_t* yp = DRY ? (bf16_t*)A.out + (size_t)(t0 + i) * 512 + g * 128 + jb : P + (size_t)(t0 + i) * PLD + PC_SU + g * 128 + jb;
#pragma unroll
        for (int q = 0; q < 4; ++q) *(u32x4*)(yp + 8 * q) = *(const LAS u32x4*)(suS + i * 136 + jb + 8 * q);
    }
}

template <bool DRY>
__device__ __forceinline__ void gla_scan(const Frame& F, const Args& A) {
    bf16_t* ST = (bf16_t*)(A.ws + WS_N1); bf16_t* STO = DRY ? (bf16_t*)A.out : ST; const float* DEC = (const float*)(A.ws + WS_DEC);
    for (int gi = F.bid * 512 + F.tid; gi < 131072; gi += F.G * 512) {
        const int k4 = gi & 31, vv = (gi >> 5) & 127, h = (gi >> 12) & 3, b = gi >> 14;
        float s0 = 0.f, s1 = 0.f, s2 = 0.f, s3 = 0.f;
        u32x2 wa[8], wb[8]; f32x4 da[8], db[8];
#define SCAN_LOAD(W, Dd, c0) do { _Pragma("unroll") for (int i_ = 0; i_ < 8; ++i_) { const size_t u_ = (size_t)((b * 64 + (c0) + i_) * 4 + h); \
            W[i_] = *(const u32x2*)(ST + u_ * 16384 + (size_t)vv * 128 + k4 * 4); Dd[i_] = *(const f32x4*)(DEC + u_ * 128 + k4 * 4); } } while (0)
#define SCAN_STEP(W, Dd, c0) do { _Pragma("unroll") for (int i_ = 0; i_ < 8; ++i_) { const size_t u_ = (size_t)((b * 64 + (c0) + i_) * 4 + h); \
            s0 = Dd[i_].x * s0 + bflo(W[i_].x); s1 = Dd[i_].y * s1 + bfhi(W[i_].x); s2 = Dd[i_].z * s2 + bflo(W[i_].y); s3 = Dd[i_].w * s3 + bfhi(W[i_].y); \
            u32x2 o_; o_.x = pk2(s0, s1); o_.y = pk2(s2, s3); *(u32x2*)(STO + u_ * 16384 + (size_t)vv * 128 + k4 * 4) = o_; } } while (0)
        SCAN_LOAD(wa, da, 0);
#pragma unroll
        for (int c0 = 0; c0 < 64; c0 += 16) {
            SCAN_LOAD(wb, db, c0 + 8);
            SCAN_STEP(wa, da, c0);
            if (c0 + 16 < 64) SCAN_LOAD(wa, da, c0 + 16);
            SCAN_STEP(wb, db, c0 + 8);
        }
#undef SCAN_LOAD
#undef SCAN_STEP
    }
}

template <bool DRY>
__device__ __forceinline__ void gla_out_phase(const Frame& F, const Args& A) {
    bf16_t* P = (bf16_t*)(A.ws + WS_P);
    LAS bf16_t* qA = (LAS bf16_t*)F.lds;
    LAS bf16_t* sB = (LAS bf16_t*)(F.lds + 17408);
    LAS float* oF = (LAS float*)(F.lds + 52224);
    const int tid = F.tid, s = tid >> 3, cb = (tid & 7) * 16, vv = tid >> 2, kb = (tid & 3) * 32;
    u32x4 nq0, nq1, ns0, ns1, ns2, ns3, nr0, nr1;
#define GO_LOAD(unit) do { const int h_ = (unit) & 3, c_ = ((unit) >> 2) & 63, b_ = (unit) >> 8; const int t0_ = b_ * SEQ + c_ * 64; \
        const bf16_t* qp_ = P + (size_t)(t0_ + s) * PLD + PC_Q + h_ * 128 + cb; nq0 = *(const u32x4*)qp_; nq1 = *(const u32x4*)(qp_ + 8); \
        const bf16_t* sp_ = (const bf16_t*)(A.ws + WS_N1) + (size_t)(unit) * 16384 + (size_t)vv * 128 + kb; ns0 = *(const u32x4*)sp_; ns1 = *(const u32x4*)(sp_ + 8); ns2 = *(const u32x4*)(sp_ + 16); ns3 = *(const u32x4*)(sp_ + 24); \
        const bf16_t* rp_ = P + (size_t)(t0_ + s) * PLD + PC_R + h_ * 128 + cb; nr0 = *(const u32x4*)rp_; nr1 = *(const u32x4*)(rp_ + 8); } while (0)
    int unit = F.bid;
    if (unit < 2048) GO_LOAD(unit);
    for (; unit < 2048; unit += F.G) {
        const int h = unit & 3, c = (unit >> 2) & 63, b = unit >> 8;
        const int t0 = b * SEQ + c * 64;
        __syncthreads();
        *(LAS u32x4*)(qA + s * 136 + cb) = nq0; *(LAS u32x4*)(qA + s * 136 + cb + 8) = nq1;
        *(LAS u32x4*)(sB + vv * 136 + kb) = ns0; *(LAS u32x4*)(sB + vv * 136 + kb + 8) = ns1; *(LAS u32x4*)(sB + vv * 136 + kb + 16) = ns2; *(LAS u32x4*)(sB + vv * 136 + kb + 24) = ns3;
        const u32x4 r0 = nr0, r1 = nr1;
        if (unit + F.G < 2048) GO_LOAD(unit + F.G);
        __syncthreads();
        {
            const int w = F.wave, l = F.lane, fr = l & 15, fq = l >> 4, m = w & 3, nh = w >> 2;
            f32x4 acc[4];
#pragma unroll
            for (int n = 0; n < 4; ++n) acc[n] = (f32x4){0.f, 0.f, 0.f, 0.f};
#pragma unroll
            for (int ks = 0; ks < 4; ++ks) {
                const bf16x8 a = *(const LAS bf16x8*)(qA + (16 * m + fr) * 136 + 32 * ks + 8 * fq);
#pragma unroll
                for (int n = 0; n < 4; ++n) { const bf16x8 bb = *(const LAS bf16x8*)(sB + (16 * (4 * nh + n) + fr) * 136 + 32 * ks + 8 * fq);
                    acc[n] = __builtin_amdgcn_mfma_f32_16x16x32_bf16(a, bb, acc[n], 0, 0, 0); }
            }
            const float scale = 0.08838834764831845f;
#pragma unroll
            for (int n = 0; n < 4; ++n)
#pragma unroll
                for (int jj = 0; jj < 4; ++jj) oF[(16 * m + 4 * fq + jj) * 132 + 16 * (4 * nh + n) + fr] = acc[n][jj] * scale;
        }
        __syncthreads();
        {
            float o[16]; float ss = 0.f;
#pragma unroll
            for (int i = 0; i < 16; ++i) { o[i] = oF[s * 132 + cb + i]; ss += o[i] * o[i]; }
            ss += __shfl_xor(ss, 1); ss += __shfl_xor(ss, 2); ss += __shfl_xor(ss, 4);
            const float rstd = 1.f / sqrtf(ss * (1.f / 128.f) + EPS);
            const unsigned rw[8] = {r0.x, r0.y, r0.z, r0.w, r1.x, r1.y, r1.z, r1.w};
            const float* gg = A.in[I_GLAG] + h * 128 + cb;
            unsigned ow[8];
#pragma unroll
            for (int i = 0; i < 8; ++i) { const float y0 = o[2 * i] * rstd * gg[2 * i] * siluf_(bflo(rw[i])), y1 = o[2 * i + 1] * rstd * gg[2 * i + 1] * siluf_(bfhi(rw[i])); ow[i] = pk2(y0, y1); }
            bf16_t* yp = DRY ? (bf16_t*)A.out + (size_t)(t0 + s) * 512 + h * 128 + cb : P + (size_t)(t0 + s) * PLD + PC_Q + h * 128 + cb;
            *(u32x4*)yp = (u32x4){ow[0], ow[1], ow[2], ow[3]}; *(u32x4*)(yp + 8) = (u32x4){ow[4], ow[5], ow[6], ow[7]};
        }
    }
#undef GO_LOAD
}

__device__ __forceinline__ unsigned ordkey(float v) { const unsigned u = __builtin_bit_cast(unsigned, v); return u ^ ((unsigned)((int)u >> 31) | 0x80000000u); }
__device__ __forceinline__ float unord(unsigned k) { const unsigned u = (k & 0x80000000u) ? (k & 0x7fffffffu) : ~k; return __builtin_bit_cast(float, u); }
#define INS16(r, xin) do { unsigned _x = (xin); _Pragma("unroll") for (int _i = 0; _i < 16; ++_i) { const unsigned _h = max((r)[_i], _x); _x = min((r)[_i], _x); (r)[_i] = _h; } } while (0)

#define CE(a, b) do { const unsigned _h = max((a), (b)), _l = min((a), (b)); (a) = _h; (b) = _l; } while (0)
#define SORT16(v) do { CE(v[0], v[1]); CE(v[2], v[3]); CE(v[0], v[2]); CE(v[1], v[3]); CE(v[1], v[2]); CE(v[4], v[5]); CE(v[6], v[7]); CE(v[4], v[6]); CE(v[5], v[7]); CE(v[5], v[6]); CE(v[0], v[4]); CE(v[2], v[6]); CE(v[2], v[4]); CE(v[1], v[5]); CE(v[3], v[7]); CE(v[3], v[5]); CE(v[1], v[2]); CE(v[3], v[4]); CE(v[5], v[6]); CE(v[8], v[9]); CE(v[10], v[11]); CE(v[8], v[10]); CE(v[9], v[11]); CE(v[9], v[10]); CE(v[12], v[13]); CE(v[14], v[15]); CE(v[12], v[14]); CE(v[13], v[15]); CE(v[13], v[14]); CE(v[8], v[12]); CE(v[10], v[14]); CE(v[10], v[12]); CE(v[9], v[13]); CE(v[11], v[15]); CE(v[11], v[13]); CE(v[9], v[10]); CE(v[11], v[12]); CE(v[13], v[14]); CE(v[0], v[8]); CE(v[4], v[12]); CE(v[4], v[8]); CE(v[2], v[10]); CE(v[6], v[14]); CE(v[6], v[10]); CE(v[2], v[4]); CE(v[6], v[8]); CE(v[10], v[12]); CE(v[1], v[9]); CE(v[5], v[13]); CE(v[5], v[9]); CE(v[3], v[11]); CE(v[7], v[15]); CE(v[7], v[11]); CE(v[3], v[5]); CE(v[7], v[9]); CE(v[11], v[13]); CE(v[1], v[2]); CE(v[3], v[4]); CE(v[5], v[6]); CE(v[7], v[8]); CE(v[9], v[10]); CE(v[11], v[12]); CE(v[13], v[14]); } while (0)
#define MERGE16(T, S) do { _Pragma("unroll") for (int _i = 0; _i < 16; ++_i) (T)[_i] = max((T)[_i], (S)[15 - _i]); \
    _Pragma("unroll") for (int _d = 8; _d >= 1; _d >>= 1) { _Pragma("unroll") for (int _i = 0; _i < 16; ++_i) if ((_i & _d) == 0) CE((T)[_i], (T)[_i + _d]); } } while (0)
__device__ __forceinline__ void peer_topk(const Frame& F, const Args& A) {
    const float* SC = (const float*)(A.ws + WS_P + P_SC);
    int* IDX = (int*)(A.ws + WS_P + P_IDX); float* GATE = (float*)(A.ws + WS_P + P_GATE);
    const int gw = F.bid * NWAVES + F.wave, NGW = F.G * NWAVES;
    for (int it = gw; it < 512 * 8; it += NGW) {
        const int h = it & 7, tb = it >> 3; const int tok = tb * 64 + F.lane;
        unsigned r1[16], r2[16], rc[16];
        const float* p1 = SC + ((size_t)(tok >> 4) * 512 + h * 64) * 64 + (tok & 15) * 4; const float* p2 = p1 + 32 * 64;
        {
            float raw[128]; unsigned sg[16];
#pragma unroll
            for (int jq = 0; jq < 32; ++jq) { const f32x4 t4 = *(const f32x4*)(p1 + jq * 64); raw[4 * jq] = t4.x; raw[4 * jq + 1] = t4.y; raw[4 * jq + 2] = t4.z; raw[4 * jq + 3] = t4.w; }
#pragma unroll
            for (int j = 0; j < 16; ++j) r1[j] = (ordkey(raw[j]) & ~127u) | (unsigned)(127 - j);
            SORT16(r1);
#pragma unroll
            for (int gq = 1; gq < 8; ++gq) {
#pragma unroll
                for (int j = 0; j < 16; ++j) sg[j] = (ordkey(raw[16 * gq + j]) & ~127u) | (unsigned)(127 - (16 * gq + j));
                SORT16(sg); MERGE16(r1, sg); }
#pragma unroll
            for (int jq = 0; jq < 32; ++jq) { const f32x4 t4 = *(const f32x4*)(p2 + jq * 64); raw[4 * jq] = t4.x; raw[4 * jq + 1] = t4.y; raw[4 * jq + 2] = t4.z; raw[4 * jq + 3] = t4.w; }
#pragma unroll
            for (int j = 0; j < 16; ++j) r2[j] = (ordkey(raw[j]) & ~127u) | (unsigned)(127 - j);
            SORT16(r2);
#pragma unroll
            for (int gq = 1; gq < 8; ++gq) {
#pragma unroll
                for (int j = 0; j < 16; ++j) sg[j] = (ordkey(raw[16 * gq + j]) & ~127u) | (unsigned)(127 - (16 * gq + j));
                SORT16(sg); MERGE16(r2, sg); }
        }
        float v1[16], v2[16];
#pragma unroll
        for (int i = 0; i < 16; ++i) { v1[i] = unord((r1[i] & ~127u) | 64u); v2[i] = unord((r2[i] & ~127u) | 64u); }
        {
            unsigned cg[4][16]; int cn = 0;
#pragma unroll
            for (int a = 0; a < 16; ++a)
#pragma unroll
                for (int bq = 0; bq < 16; ++bq) if ((a + 1) * (bq + 1) <= 16) { cg[cn >> 4][cn & 15] = (ordkey(v1[a] + v2[bq]) & ~255u) | (unsigned)(a * 16 + bq); ++cn; }
#pragma unroll
            for (int z = 50; z < 64; ++z) cg[z >> 4][z & 15] = 0u;
            SORT16(cg[0]); SORT16(cg[1]); SORT16(cg[2]); SORT16(cg[3]);
            MERGE16(cg[0], cg[1]); MERGE16(cg[0], cg[2]); MERGE16(cg[0], cg[3]);
#pragma unroll
            for (int i = 0; i < 16; ++i) rc[i] = cg[0][i];
        }
        float val[16]; int ex[16];
        {
            LAS unsigned* t1 = (LAS unsigned*)(F.lds + F.wave * 8704) + F.lane * 17; LAS unsigned* t2 = t1 + 64 * 17;
#pragma unroll
            for (int i = 0; i < 16; ++i) { t1[i] = r1[i]; t2[i] = r2[i]; }
            LDS_WAIT(); asm volatile("" ::: "memory");
#pragma unroll
            for (int w = 0; w < 16; ++w) {
                const int a = (rc[w] >> 4) & 15, bq = rc[w] & 15;
                const unsigned k1 = t1[a], k2 = t2[bq];
                val[w] = unord((k1 & ~127u) | 64u) + unord((k2 & ~127u) | 64u);
                ex[w] = (127 - (int)(k1 & 127u)) * 128 + (127 - (int)(k2 & 127u));
            }
            LDS_WAIT(); asm volatile("" ::: "memory");
        }
        float mx = val[0];
#pragma unroll
        for (int w = 1; w < 16; ++w) mx = fmaxf(mx, val[w]);
        float sum = 0.f;
#pragma unroll
        for (int w = 0; w < 16; ++w) { val[w] = __expf(val[w] - mx); sum += val[w]; }
        const float inv = 1.f / sum;
        int* ip = IDX + (size_t)tok * 128 + h * 16; float* gp = GATE + (size_t)tok * 128 + h * 16;
#pragma unroll
        for (int q = 0; q < 4; ++q) { *(int4*)(ip + 4 * q) = make_int4(ex[4 * q], ex[4 * q + 1], ex[4 * q + 2], ex[4 * q + 3]);
            *(f32x4*)(gp + 4 * q) = (f32x4){val[4 * q] * inv, val[4 * q + 1] * inv, val[4 * q + 2] * inv, val[4 * q + 3] * inv}; }
    }
}

#define DPP_ADD(v, ctrl) ((v) + __builtin_bit_cast(float, __builtin_amdgcn_mov_dpp(__builtin_bit_cast(int, (v)), (ctrl), 0xf, 0xf, true)))
__device__ __forceinline__ void fp8x16_to_f32x2(const u32x4 r, f32x2* f) {
#pragma unroll
    for (int q = 0; q < 4; ++q) { f[2 * q] = __builtin_amdgcn_cvt_pk_f32_fp8((int)r[q], false); f[2 * q + 1] = __builtin_amdgcn_cvt_pk_f32_fp8((int)r[q], true); }
}
__device__ __forceinline__ void fp8x16_to_f32(const u32x4 r, float* f) {
#pragma unroll
    for (int q = 0; q < 4; ++q) { const f32x2 lo = __builtin_amdgcn_cvt_pk_f32_fp8((int)r[q], false), hi = __builtin_amdgcn_cvt_pk_f32_fp8((int)r[q], true);
        f[4 * q] = lo.x; f[4 * q + 1] = lo.y; f[4 * q + 2] = hi.x; f[4 * q + 3] = hi.y; }
}
__device__ __forceinline__ long lo64(u32x4 v) { return (long)(((unsigned long)v.y << 32) | (unsigned long)v.x); }
__device__ __forceinline__ long hi64(u32x4 v) { return (long)(((unsigned long)v.w << 32) | (unsigned long)v.z); }
template <int MODE>
__device__ __forceinline__ void peer_u_phase(const Frame& F, const Args& A) {
    const unsigned char* X8 = A.ws + WS_P + P_X8;
    const unsigned char* U8 = A.ws + WS_U8; const float* SU = (const float*)(A.ws + WS_SU); const float* SV = (const float*)(A.ws + WS_SV);
    const int* IDX = (const int*)(A.ws + WS_P + P_IDX); const float* GATE = (const float*)(A.ws + WS_P + P_GATE); float* AK = (float*)(MODE == 0 ? A.ws + WS_AK : A.ws + WS_P + P_SC);
    const int g = F.bid & 7, nmem = F.G >> 3, l = F.lane, step = nmem * NWAVES;
    const int loff = 64 * (l & 15) + 16 * (l >> 4);
    const bool dg = ((l & 15) >> 2) == (l >> 4); const int dr = l & 3;
    const float dw0 = (dg && dr == 0) ? 1.f : 0.f, dw1 = (dg && dr == 1) ? 1.f : 0.f, dw2 = (dg && dr == 2) ? 1.f : 0.f, dw3 = (dg && dr == 3) ? 1.f : 0.f;
    LAS int* le = (LAS int*)(F.lds + F.wave * 2048); LAS int* lk = le + 256;
    const bool b5 = (l & 32) != 0, b4 = (l & 16) != 0, b3 = (l & 8) != 0;
    int tok = 2 * ((F.bid >> 3) * NWAVES + F.wave);
    u32x4 nxA, nxB; int neA0, neA1, neB0, neB1; float ngA0, ngA1, ngB0, ngB1;
#define U_PREFETCH(t) do { const size_t _tA = (size_t)(t), _tB = (size_t)(t) + 1; if (MODE == 4) { nxA = (u32x4){(unsigned)_tA, 1u, 2u, 3u}; nxB = nxA; neA0 = (int)((_tA * 37 + l * 11) & 16383); neA1 = (int)((_tA * 53 + l * 7) & 16383); neB0 = (int)((_tB * 37 + l * 13) & 16383); neB1 = (int)((_tB * 29 + l * 3) & 16383); ngA0 = ngA1 = ngB0 = ngB1 = 0.01f; break; } nxA = *(const u32x4*)(X8 + _tA * 1024 + loff); nxB = *(const u32x4*)(X8 + _tB * 1024 + loff); \
        neA0 = IDX[_tA * 128 + l]; neA1 = IDX[_tA * 128 + 64 + l]; neB0 = IDX[_tB * 128 + l]; neB1 = IDX[_tB * 128 + 64 + l]; \
        ngA0 = GATE[_tA * 128 + l]; ngA1 = GATE[_tA * 128 + 64 + l]; ngB0 = GATE[_tB * 128 + l]; ngB1 = GATE[_tB * 128 + 64 + l]; } while (0)
    if (tok + 1 < T_TOK) U_PREFETCH(tok);
    for (; tok + 1 < T_TOK; tok += 2 * step) {
        const int tokA = tok, tokB = tok + 1;
        const u32x4 xA = nxA, xB = nxB;
        const int eA0 = neA0, eA1 = neA1, eB0 = neB0, eB1 = neB1; const float gA0 = ngA0, gA1 = ngA1, gB0 = ngB0, gB1 = ngB1;
        bool pf_done = false;
        const bool oA0 = (eA0 & 7) == g, oA1 = (eA1 & 7) == g, oB0 = (eB0 & 7) == g, oB1 = (eB1 & 7) == g;
        const unsigned long long mA0 = __ballot(oA0), mA1 = __ballot(oA1), mB0 = __ballot(oB0), mB1 = __ballot(oB1);
        const int c0 = __popcll(mA0), c1 = c0 + __popcll(mA1), c2 = c1 + __popcll(mB0), n = c2 + __popcll(mB1);
#define MBC(m) __builtin_amdgcn_mbcnt_hi((unsigned)((m) >> 32), __builtin_amdgcn_mbcnt_lo((unsigned)(m), 0u))
        if (oA0) { const int p = MBC(mA0); le[p] = (eA0 << 8) | l; lk[p] = __builtin_bit_cast(int, gA0); }
        if (oA1) { const int p = c0 + MBC(mA1); le[p] = (eA1 << 8) | (64 + l); lk[p] = __builtin_bit_cast(int, gA1); }
        if (oB0) { const int p = c1 + MBC(mB0); le[p] = (eB0 << 8) | 128 | l; lk[p] = __builtin_bit_cast(int, gB0); }
        if (oB1) { const int p = c2 + MBC(mB1); le[p] = (eB1 << 8) | 128 | (64 + l); lk[p] = __builtin_bit_cast(int, gB1); }
#undef MBC
        LDS_WAIT(); asm volatile("" ::: "memory");
        for (int cb = 0; cb < n || cb == 0; cb += 64) {
        const int nc = min(n, cb + 64);
        const bool fv = (cb + l) < nc;
        const int ent = fv ? le[cb + l] : 0; const float gt = fv ? __builtin_bit_cast(float, lk[cb + l]) : 0.f; float tot = 0.f;
        const float su = SU[ent >> 8], sv = SV[ent >> 8];
        const unsigned long long radr = (unsigned long long)(U8 + (size_t)(((ent >> 8) & 7) * 2048 + (((ent >> 8) >> 3) & (MODE == 2 ? 255 : 2047))) * 1024);
        const int ralo = (int)(unsigned)radr, rahi = (int)(unsigned)(radr >> 32);
        for (int i = cb; i < nc; i += 16) {
            u32x4 row[2][8];
#pragma unroll
            for (int b = 0; b < 2; ++b) if (i + 8 * b < nc) {
#pragma unroll
                for (int j = 0; j < 8; ++j) { const int ln = min(i + 8 * b + j, nc - 1) - cb;
                    const unsigned lo = (unsigned)__builtin_amdgcn_readlane(ralo, ln), hi = (unsigned)__builtin_amdgcn_readlane(rahi, ln);
                    const GAS unsigned char* rp = (const GAS unsigned char*)(((unsigned long long)hi << 32) | lo);
                    row[b][j] = *(const GAS u32x4*)(rp + (unsigned)loff); } }
            if (!pf_done) { pf_done = true; if (tok + 2 * step + 1 < T_TOK) U_PREFETCH(tok + 2 * step); }
#pragma unroll
            for (int b = 0; b < 2; ++b) if (i + 8 * b < nc) {
                float p[8];
                f32x4 accj[8];
                const int base0 = i + 8 * b;
                if (base0 + 8 <= c1) {
#pragma unroll
                    for (int j = 0; j < 8; ++j) accj[j] = __builtin_amdgcn_mfma_f32_16x16x32_fp8_fp8(lo64(row[b][j]), lo64(xA), (f32x4){0.f, 0.f, 0.f, 0.f}, 0, 0, 0);
#pragma unroll
                    for (int j = 0; j < 8; ++j) accj[j] = __builtin_amdgcn_mfma_f32_16x16x32_fp8_fp8(hi64(row[b][j]), hi64(xA), accj[j], 0, 0, 0);
                } else if (base0 >= c1) {
#pragma unroll
                    for (int j = 0; j < 8; ++j) accj[j] = __builtin_amdgcn_mfma_f32_16x16x32_fp8_fp8(lo64(row[b][j]), lo64(xB), (f32x4){0.f, 0.f, 0.f, 0.f}, 0, 0, 0);
#pragma unroll
                    for (int j = 0; j < 8; ++j) accj[j] = __builtin_amdgcn_mfma_f32_16x16x32_fp8_fp8(hi64(row[b][j]), hi64(xB), accj[j], 0, 0, 0);
                } else {
#pragma unroll
                    for (int j = 0; j < 8; ++j) { const u32x4 xs = (base0 + j >= c1) ? xB : xA; accj[j] = __builtin_amdgcn_mfma_f32_16x16x32_fp8_fp8(lo64(row[b][j]), lo64(xs), (f32x4){0.f, 0.f, 0.f, 0.f}, 0, 0, 0);
                        accj[j] = __builtin_amdgcn_mfma_f32_16x16x32_fp8_fp8(hi64(row[b][j]), hi64(xs), accj[j], 0, 0, 0); }
                }
#pragma unroll
                for (int j = 0; j < 8; ++j) p[j] = __builtin_fmaf(accj[j][3], dw3, __builtin_fmaf(accj[j][2], dw2, __builtin_fmaf(accj[j][1], dw1, accj[j][0] * dw0)));
                float q4[4], q2[2], q1;
#pragma unroll
                for (int j = 0; j < 4; ++j) { const float keep = b5 ? p[4 + j] : p[j], send = b5 ? p[j] : p[4 + j]; q4[j] = keep + __shfl_xor(send, 32); }
#pragma unroll
                for (int j = 0; j < 2; ++j) { const float keep = b4 ? q4[2 + j] : q4[j], send = b4 ? q4[j] : q4[2 + j]; q2[j] = keep + __shfl_xor(send, 16); }
                { const float keep = b3 ? q2[1] : q2[0], send = b3 ? q2[0] : q2[1]; q1 = keep + __shfl_xor(send, 8); }
                q1 = DPP_ADD(q1, 0xB1); q1 = DPP_ADD(q1, 0x4E); q1 = DPP_ADD(q1, 0x141);
                const float t = __builtin_bit_cast(float, __builtin_amdgcn_ds_bpermute((l & 7) * 32, __builtin_bit_cast(int, q1)));
                const int base = i + 8 * b;
                if ((l >> 3) == ((base - cb) >> 3)) tot = t;
            }
        }
        if (!pf_done) { if (tok + 2 * step + 1 < T_TOK) U_PREFETCH(tok + 2 * step); }
        if (fv) { const int tk = (ent & 128) ? tokB : tokA; AK[(size_t)tk * 128 + (ent & 127)] = gelu_tanh(tot * su * (1.f / 16.f)) * gt * sv; }
        if (n == 0) break;
        }
        LDS_WAIT(); asm volatile("" ::: "memory");
    }
#undef U_PREFETCH
}
template <int MODE>
__device__ __forceinline__ void peer_u_phase1(const Frame& F, const Args& A) {
    const unsigned char* X8 = A.ws + WS_P + P_X8;
    const unsigned char* U8 = A.ws + WS_U8; const float* SU = (const float*)(A.ws + WS_SU); const float* SV = (const float*)(A.ws + WS_SV);
    const int* IDX = (const int*)(A.ws + WS_P + P_IDX); const float* GATE = (const float*)(A.ws + WS_P + P_GATE); float* AK = (float*)(MODE == 0 ? A.ws + WS_AK : A.ws + WS_P + P_SC);
    const int g = F.bid & (UNG - 1), nmem = F.G >> UNG_SH, l = F.lane, step = nmem * NWAVES;
    const int loff = 64 * (l & 15) + 16 * (l >> 4);
    const bool dg = ((l & 15) >> 2) == (l >> 4); const int dr = l & 3;
    const float dw0 = (dg && dr == 0) ? 1.f : 0.f, dw1 = (dg && dr == 1) ? 1.f : 0.f, dw2 = (dg && dr == 2) ? 1.f : 0.f, dw3 = (dg && dr == 3) ? 1.f : 0.f;
    LAS int* le = (LAS int*)(F.lds + F.wave * 2048); LAS int* lk = le + 256;
    const bool b5 = (l & 32) != 0, b4 = (l & 16) != 0, b3 = (l & 8) != 0;
    int tok = (F.bid >> UNG_SH) * NWAVES + F.wave;
    u32x4 nxA; int neA0, neA1; float ngA0, ngA1;
#define U1_PREFETCH(t) do { const size_t _tA = (size_t)(t); nxA = *(const u32x4*)(X8 + _tA * 1024 + loff); \
        neA0 = IDX[_tA * 128 + l]; neA1 = IDX[_tA * 128 + 64 + l]; ngA0 = GATE[_tA * 128 + l]; ngA1 = GATE[_tA * 128 + 64 + l]; } while (0)
    if (tok < T_TOK) U1_PREFETCH(tok);
    for (; tok < T_TOK; tok += step) {
        const u32x4 xA = nxA;
        const int eA0 = neA0, eA1 = neA1; const float gA0 = ngA0, gA1 = ngA1;
        bool pf_done = false;
        const bool oA0 = (eA0 & (UNG - 1)) == g, oA1 = (eA1 & (UNG - 1)) == g;
        const unsigned long long mA0 = __ballot(oA0), mA1 = __ballot(oA1);
        const int c0 = __popcll(mA0), n = c0 + __popcll(mA1);
#define MBC(m) __builtin_amdgcn_mbcnt_hi((unsigned)((m) >> 32), __builtin_amdgcn_mbcnt_lo((unsigned)(m), 0u))
        if (oA0) { const int p = MBC(mA0); le[p] = (eA0 << 8) | l; lk[p] = __builtin_bit_cast(int, gA0); }
        if (oA1) { const int p = c0 + MBC(mA1); le[p] = (eA1 << 8) | (64 + l); lk[p] = __builtin_bit_cast(int, gA1); }
#undef MBC
        LDS_WAIT(); asm volatile("" ::: "memory");
        for (int cb = 0; cb < n || cb == 0; cb += 64) {
        const int nc = min(n, cb + 64);
        const bool fv = (cb + l) < nc;
        const int ent = fv ? le[cb + l] : 0; const float gt = fv ? __builtin_bit_cast(float, lk[cb + l]) : 0.f; float tot = 0.f;
        const float su = SU[ent >> 8], sv = SV[ent >> 8];
        const unsigned long long radr = (unsigned long long)(U8 + (size_t)(((ent >> 8) & (UNG - 1)) * (NEXP / UNG) + ((ent >> 8) >> UNG_SH)) * 1024);
        const int ralo = (int)(unsigned)radr, rahi = (int)(unsigned)(radr >> 32);
        for (int i = cb; i < nc; i += 16) {
            u32x4 row[2][8];
#pragma unroll
            for (int b = 0; b < 2; ++b) if (i + 8 * b < nc) {
#pragma unroll
                for (int j = 0; j < 8; ++j) { const int ln = min(i + 8 * b + j, nc - 1) - cb;
                    const unsigned lo = (unsigned)__builtin_amdgcn_readlane(ralo, ln), hi = (unsigned)__builtin_amdgcn_readlane(rahi, ln);
                    const GAS unsigned char* rp = (const GAS unsigned char*)(((unsigned long long)hi << 32) | lo);
                    row[b][j] = *(const GAS u32x4*)(rp + (unsigned)loff); } }
            if (!pf_done) { pf_done = true; if (tok + step < T_TOK) U1_PREFETCH(tok + step); }
#pragma unroll
            for (int b = 0; b < 2; ++b) if (i + 8 * b < nc) {
                float p[8]; f32x4 accj[8];
#pragma unroll
                for (int j = 0; j < 8; ++j) accj[j] = __builtin_amdgcn_mfma_f32_16x16x32_fp8_fp8(lo64(row[b][j]), lo64(xA), (f32x4){0.f, 0.f, 0.f, 0.f}, 0, 0, 0);
#pragma unroll
                for (int j = 0; j < 8; ++j) accj[j] = __builtin_amdgcn_mfma_f32_16x16x32_fp8_fp8(hi64(row[b][j]), hi64(xA), accj[j], 0, 0, 0);
#pragma unroll
                for (int j = 0; j < 8; ++j) p[j] = __builtin_fmaf(accj[j][3], dw3, __builtin_fmaf(accj[j][2], dw2, __builtin_fmaf(accj[j][1], dw1, accj[j][0] * dw0)));
                float q4[4], q2[2], q1;
#pragma unroll
                for (int j = 0; j < 4; ++j) { const float keep = b5 ? p[4 + j] : p[j], send = b5 ? p[j] : p[4 + j]; q4[j] = keep + __shfl_xor(send, 32); }
#pragma unroll
                for (int j = 0; j < 2; ++j) { const float keep = b4 ? q4[2 + j] : q4[j], send = b4 ? q4[j] : q4[2 + j]; q2[j] = keep + __shfl_xor(send, 16); }
                { const float keep = b3 ? q2[1] : q2[0], send = b3 ? q2[0] : q2[1]; q1 = keep + __shfl_xor(send, 8); }
                q1 = DPP_ADD(q1, 0xB1); q1 = DPP_ADD(q1, 0x4E); q1 = DPP_ADD(q1, 0x141);
                const float t = __builtin_bit_cast(float, __builtin_amdgcn_ds_bpermute((l & 7) * 32, __builtin_bit_cast(int, q1)));
                const int base = i + 8 * b;
                if ((l >> 3) == ((base - cb) >> 3)) tot = t;
            }
        }
        if (!pf_done) { pf_done = true; if (tok + step < T_TOK) U1_PREFETCH(tok + step); }
        if (fv) AK[(size_t)tok * 128 + (ent & 127)] = gelu_tanh(tot * su * (1.f / 16.f)) * gt * sv;
        if (n == 0) break;
        }
        LDS_WAIT(); asm volatile("" ::: "memory");
    }
#undef U1_PREFETCH
}
__device__ __forceinline__ float wave_max_nonneg(float v) {
    unsigned u = __builtin_bit_cast(unsigned, v);
    u = max(u, (unsigned)__builtin_amdgcn_mov_dpp((int)u, 0xB1, 0xf, 0xf, true));
    u = max(u, (unsigned)__builtin_amdgcn_mov_dpp((int)u, 0x4E, 0xf, 0xf, true));
    u = max(u, (unsigned)__builtin_amdgcn_mov_dpp((int)u, 0x141, 0xf, 0xf, true));
    u = max(u, (unsigned)__builtin_amdgcn_mov_dpp((int)u, 0x140, 0xf, 0xf, true));
    const unsigned a = (unsigned)__builtin_amdgcn_readlane((int)u, 0), b = (unsigned)__builtin_amdgcn_readlane((int)u, 16), c = (unsigned)__builtin_amdgcn_readlane((int)u, 32), d = (unsigned)__builtin_amdgcn_readlane((int)u, 48);
    return __builtin_bit_cast(float, max(max(a, b), max(c, d)));
}
template <int MODE>
__device__ __forceinline__ void peer_v_phase(const Frame& F, const Args& A) {
    const unsigned char* V8 = A.ws + WS_V8; const int* IDX = (const int*)(A.ws + WS_P + P_IDX); const float* AK = (const float*)(A.ws + WS_AK);
    float* out = MODE == 0 ? A.out : (float*)(A.ws + WS_P + P_SC);
    const int g = F.bid & 7, nmem = F.G >> 3, l = F.lane, sub = l & 7, rr = l >> 3, n16 = l & 15, q = l >> 4, step = nmem * NWAVES;
    const GAS unsigned char* vb = (const GAS unsigned char*)(V8 + (size_t)g * NEXP * 128);
    LAS unsigned long long* rep = (LAS unsigned long long*)(F.lds + F.wave * 2048);
    const unsigned long long bm = 0xFFull << (8 * (n16 & 7));
    const int repi = 2 * q + (n16 >> 3);
    const bool vl = (n16 < 8) && (q < 2);
    LAS float* stg = (LAS float*)(F.lds + 16384 + F.wave * 512);
    int tok = 2 * ((F.bid >> 3) * NWAVES + F.wave);
    int ne[4]; float na[4];
#define V_PREFETCH(t) do { const size_t _a = (size_t)(t) * 128, _b = ((size_t)(t) + 1) * 128; ne[0] = IDX[_a + l]; ne[1] = IDX[_a + 64 + l]; ne[2] = IDX[_b + l]; ne[3] = IDX[_b + 64 + l]; \
        na[0] = AK[_a + l]; na[1] = AK[_a + 64 + l]; na[2] = AK[_b + l]; na[3] = AK[_b + 64 + l]; } while (0)
    if (tok + 1 < T_TOK) V_PREFETCH(tok);
    for (; tok + 1 < T_TOK; tok += 2 * step) {
        const int e0 = ne[0], e1 = ne[1], e2 = ne[2], e3 = ne[3]; const float a0 = na[0], a1 = na[1], a2 = na[2], a3 = na[3];
        u32x4 rowA[16], rowB[16];
#pragma unroll
        for (int i = 0; i < 16; ++i) { const int src = (8 * (i & 7) + rr) * 4;
            const int ea = __builtin_amdgcn_ds_bpermute(src, i < 8 ? e0 : e1), eb = __builtin_amdgcn_ds_bpermute(src, i < 8 ? e2 : e3);
            rowA[i] = *(const GAS u32x4*)(vb + ((unsigned)ea * 128u + 16u * (unsigned)sub)); rowB[i] = *(const GAS u32x4*)(vb + ((unsigned)eb * 128u + 16u * (unsigned)sub)); }
        f32x4 HA = {0.f, 0.f, 0.f, 0.f}, HB = {0.f, 0.f, 0.f, 0.f};
        if (l < 32) { const float* hpa = out + (size_t)tok * D + g * 128 + 4 * l; HA = *(const f32x4*)hpa; HB = *(const f32x4*)(hpa + D); }
        if (tok + 2 * step + 1 < T_TOK) V_PREFETCH(tok + 2 * step);
        const float amA = wave_max_nonneg(fmaxf(fabsf(a0), fabsf(a1))), amB = wave_max_nonneg(fmaxf(fabsf(a2), fabsf(a3)));
        const float scA = amA > 0.f ? 224.f * __builtin_amdgcn_rcpf(amA) : 0.f, invA = amA * (1.f / 224.f), scB = amB > 0.f ? 224.f * __builtin_amdgcn_rcpf(amB) : 0.f, invB = amB * (1.f / 224.f);
        { const unsigned wA = (unsigned)__builtin_amdgcn_cvt_pk_fp8_f32(a0 * scA, a1 * scA, 0, false), wB = (unsigned)__builtin_amdgcn_cvt_pk_fp8_f32(a2 * scB, a3 * scB, 0, false);
          const unsigned r0 = (wA & 0xffu) * 0x01010101u, r1 = ((wA >> 8) & 0xffu) * 0x01010101u, r2 = (wB & 0xffu) * 0x01010101u, r3 = ((wB >> 8) & 0xffu) * 0x01010101u;
          rep[l] = ((unsigned long long)r0 << 32) | r0; rep[64 + l] = ((unsigned long long)r1 << 32) | r1; rep[128 + l] = ((unsigned long long)r2 << 32) | r2; rep[192 + l] = ((unsigned long long)r3 << 32) | r3; }
        LDS_WAIT(); asm volatile("" ::: "memory");
#pragma unroll
        for (int t2 = 0; t2 < 2; ++t2) {
            f32x4 alo = {0.f, 0.f, 0.f, 0.f}, ahi = {0.f, 0.f, 0.f, 0.f};
#pragma unroll
            for (int i = 0; i < 16; ++i) { const long bop = (long)(rep[128 * t2 + 8 * i + repi] & bm); const u32x4 rw = t2 ? rowB[i] : rowA[i];
                alo = __builtin_amdgcn_mfma_f32_16x16x32_fp8_fp8(lo64(rw), bop, alo, 0, 0, 0);
                ahi = __builtin_amdgcn_mfma_f32_16x16x32_fp8_fp8(hi64(rw), bop, ahi, 0, 0, 0); }
            const float inv = t2 ? invB : invA;
            float vlo[4], vhi[4];
#pragma unroll
            for (int r = 0; r < 4; ++r) { const float tl = alo[r], th = ahi[r];
                vlo[r] = (tl + __builtin_bit_cast(float, __builtin_amdgcn_ds_bpermute(((l + 40) & 63) * 4, __builtin_bit_cast(int, tl)))) * inv;
                vhi[r] = (th + __builtin_bit_cast(float, __builtin_amdgcn_ds_bpermute(((l + 40) & 63) * 4, __builtin_bit_cast(int, th)))) * inv; }
            if (vl) {
#pragma unroll
                for (int r = 0; r < 4; ++r) { stg[64 * q + 16 * r + n16] = vlo[r]; stg[64 * q + 16 * r + n16 + 8] = vhi[r]; } }
            LDS_WAIT(); asm volatile("" ::: "memory");
            if (l < 32) { const f32x4 dv = *(const LAS f32x4*)(stg + 4 * l); *(f32x4*)(out + (size_t)(tok + t2) * D + g * 128 + 4 * l) = (t2 ? HB : HA) + dv; }
            LDS_WAIT(); asm volatile("" ::: "memory");
        }
        LDS_WAIT(); asm volatile("" ::: "memory");
    }
#undef V_PREFETCH
}
__device__ __forceinline__ void final_norm_phase(const Frame& F, const Args& A) {
    const int gw = F.bid * NWAVES + F.wave, NGW = F.G * NWAVES, l = F.lane; const float* fg = A.in[I_FG];
    const f32x4* gp = (const f32x4*)fg + l;
    int tok = gw;
    for (; tok + 3 * NGW < T_TOK; tok += 4 * NGW) {
        f32x4 v[4][4]; float ss[4];
#pragma unroll
        for (int b = 0; b < 4; ++b) { const f32x4* hp = (const f32x4*)(A.out + (size_t)(tok + b * NGW) * D) + l;
#pragma unroll
            for (int j = 0; j < 4; ++j) v[b][j] = hp[64 * j]; }
#pragma unroll
        for (int b = 0; b < 4; ++b) { ss[b] = 0.f;
#pragma unroll
            for (int j = 0; j < 4; ++j) ss[b] += (v[b][j].x * v[b][j].x + v[b][j].y * v[b][j].y) + (v[b][j].z * v[b][j].z + v[b][j].w * v[b][j].w); }
#pragma unroll
        for (int o = 1; o < 64; o <<= 1) {
#pragma unroll
            for (int b = 0; b < 4; ++b) ss[b] += __shfl_xor(ss[b], o); }
#pragma unroll
        for (int b = 0; b < 4; ++b) { const float rstd = 1.f / sqrtf(ss[b] * (1.f / D) + EPS); f32x4* hp = (f32x4*)(A.out + (size_t)(tok + b * NGW) * D) + l;
#pragma unroll
            for (int j = 0; j < 4; ++j) hp[64 * j] = v[b][j] * rstd * gp[64 * j]; }
    }
    for (; tok < T_TOK; tok += NGW) { f32x4* hp = (f32x4*)(A.out + (size_t)tok * D) + l; f32x4 v[4]; float ss = 0.f;
#pragma unroll
        for (int j = 0; j < 4; ++j) { v[j] = hp[64 * j]; ss += (v[j].x * v[j].x + v[j].y * v[j].y) + (v[j].z * v[j].z + v[j].w * v[j].w); }
        const float rstd = 1.f / sqrtf(wave_sum(ss) * (1.f / D) + EPS);
#pragma unroll
        for (int j = 0; j < 4; ++j) hp[64 * j] = v[j] * rstd * gp[64 * j]; }
}

#ifdef DEBUG_CHECK
constexpr size_t WS_DBG = 472 * MiB;
__device__ __forceinline__ int dbg_tok(int i) { return (i * 509 + 3) & 32767; }
__device__ __forceinline__ float gelu_ref(float x) { return 0.5f * x * (1.f + tanhf(0.7978845608028654f * (x + 0.044715f * x * x * x))); }
__global__ void __launch_bounds__(512) dbg_scores(Args a) {
    __shared__ float n2s[1024]; __shared__ float q[2048];
    const int t = dbg_tok(blockIdx.x), tid = threadIdx.x;
    const bf16_t* N2 = (const bf16_t*)(a.ws + WS_N1); const float* SC = (const float*)(a.ws + WS_P + P_SC); unsigned* dbg = (unsigned*)(a.ws + WS_DBG);
    for (int k = tid; k < 1024; k += 512) n2s[k] = bf1(N2[(size_t)t * 1024 + k]);
    __syncthreads();
    for (int r = 0; r < 4; ++r) { const int c = tid + 512 * r; float s = 0.f; for (int k = 0; k < 1024; ++k) s += n2s[k] * a.in[I_WQ][(size_t)k * 2048 + c]; q[c] = s; }
    __syncthreads();
    float md = 0.f;
    for (int r = 0; r < 4; ++r) { const int n = tid + 512 * r, hh = n >> 7, key = n & 127; const float* kX = (hh & 1) ? a.in[I_K2] : a.in[I_K1];
        float s = 0.f; for (int d = 0; d < 128; ++d) s += q[hh * 128 + d] * kX[key * 128 + d];
        md = fmaxf(md, fabsf(s - SC[(size_t)n * T_TOK + t])); }
    atomicMax(&dbg[0], __builtin_bit_cast(unsigned, md));
}
__global__ void __launch_bounds__(64) dbg_topk(Args a) {
    __shared__ float s1[8][128], s2[8][128], cv[8][256]; __shared__ float t1v[8][16], t2v[8][16]; __shared__ int t1i[8][16], t2i[8][16], exi[8][16]; __shared__ float exv[8][16];
    const int t = dbg_tok(blockIdx.x), h = threadIdx.x;
    const float* SC = (const float*)(a.ws + WS_P + P_SC); const int* IDX = (const int*)(a.ws + WS_P + P_IDX); const float* GATE = (const float*)(a.ws + WS_P + P_GATE); unsigned* dbg = (unsigned*)(a.ws + WS_DBG);
    if (h >= 8) return;
    for (int j = 0; j < 128; ++j) { s1[h][j] = SC[(size_t)(h * 256 + j) * T_TOK + t]; s2[h][j] = SC[(size_t)(h * 256 + 128 + j) * T_TOK + t]; }
    for (int r = 0; r < 16; ++r) { int b1 = 0, b2 = 0; for (int j = 1; j < 128; ++j) { if (s1[h][j] > s1[h][b1]) b1 = j; if (s2[h][j] > s2[h][b2]) b2 = j; }
        t1v[h][r] = s1[h][b1]; t1i[h][r] = b1; s1[h][b1] = -1e30f; t2v[h][r] = s2[h][b2]; t2i[h][r] = b2; s2[h][b2] = -1e30f; }
    for (int c = 0; c < 256; ++c) cv[h][c] = t1v[h][c >> 4] + t2v[h][c & 15];
    for (int r = 0; r < 16; ++r) { int bc = 0; for (int c = 1; c < 256; ++c) if (cv[h][c] > cv[h][bc]) bc = c;
        exv[h][r] = cv[h][bc]; exi[h][r] = t1i[h][bc >> 4] * 128 + t2i[h][bc & 15]; cv[h][bc] = -1e30f; }
    float sum = 0.f; const float mx0 = exv[h][0]; for (int r = 0; r < 16; ++r) { exv[h][r] = expf(exv[h][r] - mx0); } for (int r = 0; r < 16; ++r) sum += exv[h][r];
    unsigned miss = 0; float gd = 0.f;
    for (int w = 0; w < 16; ++w) { const int e = IDX[(size_t)t * 128 + h * 16 + w]; const float g = GATE[(size_t)t * 128 + h * 16 + w]; bool found = false;
        for (int r = 0; r < 16; ++r) if (exi[h][r] == e) { found = true; gd = fmaxf(gd, fabsf(g - exv[h][r] / sum)); }
        if (!found) ++miss; }
    atomicAdd(&dbg[1], miss); atomicMax(&dbg[3], __builtin_bit_cast(unsigned, gd));
}
__global__ void __launch_bounds__(512) dbg_experts_pre(Args a) {
    __shared__ float n2s[1024]; __shared__ float ak[128]; __shared__ int ek[128]; __shared__ float red[8];
    const int t = dbg_tok(blockIdx.x), tid = threadIdx.x, lane = tid & 63, wave = tid >> 6;
    const bf16_t* N2 = (const bf16_t*)(a.ws + WS_N1); const int* IDX = (const int*)(a.ws + WS_P + P_IDX); const float* GATE = (const float*)(a.ws + WS_P + P_GATE);
    float* rows = (float*)(a.ws + WS_DBG + MiB);
    for (int k = tid; k < 1024; k += 512) n2s[k] = bf1(N2[(size_t)t * 1024 + k]);
    if (tid < 128) ek[tid] = IDX[(size_t)t * 128 + tid];
    __syncthreads();
    for (int k = wave * 16; k < wave * 16 + 16; ++k) { const float* u = a.in[I_PU] + (size_t)ek[k] * 1024; float s = 0.f; for (int j = lane; j < 1024; j += 64) s += u[j] * n2s[j];
        s = wave_sum(s); if (lane == 0) ak[k] = gelu_ref(s) * GATE[(size_t)t * 128 + k]; }
    __syncthreads();
    float h2[2]; float ss = 0.f;
    for (int r = 0; r < 2; ++r) { const int d = tid + 512 * r; float o = 0.f; for (int k = 0; k < 128; ++k) o += ak[k] * a.in[I_PV][(size_t)ek[k] * 1024 + d]; h2[r] = a.out[(size_t)t * 1024 + d] + o; ss += h2[r] * h2[r]; }
    ss = wave_sum(ss); if (lane == 0) red[wave] = ss; __syncthreads();
    float tot = 0.f; for (int w = 0; w < 8; ++w) tot += red[w];
    const float rstd = 1.f / sqrtf(tot / 1024.f + EPS);
    for (int r = 0; r < 2; ++r) { const int d = tid + 512 * r; rows[(size_t)blockIdx.x * 1024 + d] = h2[r] * rstd * a.in[I_FG][d]; }
}
__global__ void __launch_bounds__(512) dbg_experts_post(Args a) {
    const int t = dbg_tok(blockIdx.x), tid = threadIdx.x; const float* rows = (const float*)(a.ws + WS_DBG + MiB); float* dbgf = (float*)(a.ws + WS_DBG);
    float e = 0.f, n = 0.f;
    for (int r = 0; r < 2; ++r) { const int d = tid + 512 * r; const float x = rows[(size_t)blockIdx.x * 1024 + d], y = a.out[(size_t)t * 1024 + d]; e += (x - y) * (x - y); n += x * x; }
    e = wave_sum(e); n = wave_sum(n); if ((tid & 63) == 0) { atomicAdd(&dbgf[4], e); atomicAdd(&dbgf[5], n); }
}
__global__ void __launch_bounds__(512) dbg_report(Args a, int which) {
    const unsigned* dbg = (const unsigned*)(a.ws + WS_DBG); const float* dbgf = (const float*)(a.ws + WS_DBG);
    const float mA = dbgf[0], gd = dbgf[3]; const unsigned miss = dbg[1]; const float relC = sqrtf(dbgf[4] / fmaxf(dbgf[5], 1e-30f));
    float X;
    if (which == 0) { int mask = 0; if (mA > 0.05f) mask |= 1; if (miss > 400u) mask |= 2; if (relC > 0.05f) mask |= 4; if (gd > 0.02f) mask |= 8; X = 1000.f + 100.f * mask; }
    else if (which == 1) X = 1e6f * mA; else if (which == 2) X = 100.f + (float)miss; else if (which == 3) X = 1e6f * relC; else X = 1e6f * gd;
    for (size_t i = (size_t)blockIdx.x * 512 + threadIdx.x; i < (size_t)T_TOK * D; i += (size_t)gridDim.x * 512) a.out[i] = (i == 0) ? X : 0.f;
}
#endif

constexpr int NPH = 13;
__global__ void __launch_bounds__(NWAVES * 64, 2) fwd_kernel(Args args) {
    extern __shared__ __attribute__((aligned(16))) unsigned char lds_raw[];
    Frame F;
    F.lds = (LAS unsigned char*)lds_raw;
    F.tid = threadIdx.x; F.lane = F.tid & 63; F.wave = __builtin_amdgcn_readfirstlane(F.tid >> 6);
    F.G = gridDim.x; F.bid = blockIdx.x;
    volatile LAS unsigned* MISC = (volatile LAS unsigned*)(F.lds + MISC_OFF);
    for (int u = F.tid; u < (LDS_BYTES - LDSCTL_OFF) / 4; u += NWAVES * 64) ((LAS unsigned*)(F.lds + LDSCTL_OFF))[u] = 0u;
    __syncthreads();
    unsigned* ctl = (unsigned*)(args.ws + WS_CTL);
    const int lo = args.ph_lo, hi = args.ph_hi;
    XcdBarrier bar; bar.bar = ctl + CW_BAR + args.li * XCD_BAR_WORDS; bar.x = 0; bar.st = nullptr;
    if (hi - lo > 1) bar = xcd_barrier_post(ctl + CW_BAR + args.li * XCD_BAR_WORDS, MISC + 8);
#define IN(k) (lo <= (k) && (k) < hi)
#ifdef PROBE_TS
#define STAMP(k) do { if (F.bid == 0 && F.tid == 0) ((unsigned long long*)(args.ws + (472u << 20)))[(k)] = __builtin_amdgcn_s_memrealtime(); } while (0)
#else
#define STAMP(k) do { } while (0)
#endif
#define SEAM(k) do { if (IN(k) && IN((k) + 1)) { xcd_barrier(bar); if (XTRA_BAR) xcd_barrier(bar); } STAMP((k) + 1); } while (0)
    unsigned char* ws = args.ws;
    bf16_t* P = (bf16_t*)(ws + WS_P);

    STAMP(0);
    if (IN(0)) { phase0(F, args); SEAM(0); }
    if (IN(1)) {
        pg8::Gemm g{(const bf16_t*)(ws + WS_N1), (const bf16_t*)(ws + WS_WIN), T_TOK, NPROJ, D, D}; pg8::StaticOrder S; S.init(T_TOK, NPROJ, F.G, F.bid);
        pg8::EpiProj E{P, (float*)(ws + WS_ALR)};
        pg8::gemm_phase<pg8::EpiProj, pg8::StaticOrder, false, true>(F.lds, g, S, E);
        {
            const int nwg = (T_TOK / 256) * (NPROJ / 256), rem = nwg % F.G;
            if (rem == 0) convert_tables(F, args, F.bid * NWAVES + F.wave, F.G * NWAVES);
            else if (F.bid >= rem) convert_tables(F, args, (F.bid - rem) * NWAVES + F.wave, (F.G - rem) * NWAVES);
        }
        SEAM(1);
    }
    if (IN(2)) {
        gla_chunk_phase<false>(F, args);
        for (int it = F.bid; it < 1024; it += F.G) sgu_unit<false>(F, args, it);
        SEAM(2);
    }
    if (IN(3)) { if (DRY_EXP == 13) { gla_scan<true>(F, args); __syncthreads(); } gla_scan<false>(F, args); SEAM(3); }
    if (IN(4)) { if (DRY_EXP == 14) { gla_out_phase<true>(F, args); __syncthreads(); } gla_out_phase<false>(F, args); SEAM(4); }
    if (IN(5)) {
        { pg8::Gemm g{P + PC_Q, (const bf16_t*)(ws + WS_WA), T_TOK, D, 512, PLD}; pg8::StaticOrder S; S.init(T_TOK, D, F.G, F.bid);
          pg8::EpiBrA E{P}; pg8::gemm_phase<pg8::EpiBrA, pg8::StaticOrder, true, true>(F.lds, g, S, E); }
        { pg8::Gemm g{P + PC_SU, (const bf16_t*)(ws + WS_WB), T_TOK, D, 512, PLD}; pg8::StaticOrder S; S.init(T_TOK, D, F.G, F.bid);
          pg8::EpiBrB E{P}; pg8::gemm_phase<pg8::EpiBrB, pg8::StaticOrder, true, true>(F.lds, g, S, E); }
        SEAM(5);
    }
    if (IN(6)) {
        pg8::Gemm g{P + PC_MRG, (const bf16_t*)(ws + WS_WOUT), T_TOK, D, D, PLD}; pg8::StaticOrder S; S.init(T_TOK, D, F.G, F.bid);
        pg8::EpiOut E{args.in[I_X], args.out}; pg8::gemm_phase<pg8::EpiOut, pg8::StaticOrder, true, true>(F.lds, g, S, E);
        SEAM(6);
    }
    if (IN(7)) {
        const int gw = F.bid * NWAVES + F.wave, NGW = F.G * NWAVES;
        { int m = gw; for (; m + 3 * NGW < T_TOK; m += 4 * NGW) rms_rows_to_bf16<true, 4>(F.lane, args.out + (size_t)m * D, (size_t)NGW * D, args.in[I_N2G], (bf16_t*)(ws + WS_N1) + (size_t)m * D, (size_t)NGW * D, (unsigned*)(ws + WS_P + P_X8) + (size_t)m * 256, (size_t)NGW * 256);
          for (; m < T_TOK; m += NGW) rms_rows_to_bf16<true, 1>(F.lane, args.out + (size_t)m * D, 0, args.in[I_N2G], (bf16_t*)(ws + WS_N1) + (size_t)m * D, 0, (unsigned*)(ws + WS_P + P_X8) + (size_t)m * 256, 0); }
        SEAM(7);
    }
    if (IN(8)) {
        pg8::Gemm g{(const bf16_t*)(ws + WS_N1), (const bf16_t*)(ws + WS_WQF), T_TOK, 2048, D, D}; pg8::StaticOrder S; S.init(T_TOK, 2048, F.G, F.bid);
        pg8::EpiScores E{(float*)(ws + WS_P + P_SC)}; pg8::gemm_phase<pg8::EpiScores, pg8::StaticOrder, true, true>(F.lds, g, S, E);
        SEAM(8);
    }
    if (IN(9)) { peer_topk(F, args); SEAM(9); }
    if (IN(10)) { if (DRY_EXP == 2) { peer_u_phase<1>(F, args); __syncthreads(); } if (DRY_EXP == 3) { peer_u_phase<2>(F, args); __syncthreads(); } if (DRY_EXP == 4) { peer_u_phase<3>(F, args); __syncthreads(); } if (DRY_EXP == 5) { peer_u_phase<4>(F, args); __syncthreads(); } if (UNG == 8) peer_u_phase<0>(F, args); else peer_u_phase1<0>(F, args); SEAM(10); }
    if (IN(11)) { if (DRY_EXP == 1) { peer_v_phase<1>(F, args); __syncthreads(); } peer_v_phase<0>(F, args); SEAM(11); }
    if (IN(12)) { final_norm_phase(F, args); }
#undef IN
#undef SEAM
}


#ifdef PROBE_TS
__global__ void __launch_bounds__(512) probe_report(Args a, int pi, int pj) {
    const unsigned long long* ts = (const unsigned long long*)(a.ws + (472u << 20));
    const float X1 = 10.f * (float)(ts[pi + 1] - ts[pi]) * 0.01f, X2 = (float)(ts[pj + 1] - ts[pj]) * 0.01f;
    for (size_t i = (size_t)blockIdx.x * 512 + threadIdx.x; i < (size_t)T_TOK * D; i += (size_t)gridDim.x * 512) a.out[i] = (i == 0) ? X1 : X2;
}
#endif
extern "C" void kernel_launch(void* const* d_in, const int* in_sizes, int n_in, void* d_out, int out_size, void* d_ws, size_t ws_size, hipStream_t stream) {
    static int grid = 0;
    if (grid == 0) {
        if (n_in != 20 || in_sizes[0] != T_TOK * D || out_size != T_TOK * D || ws_size < WS_END) {
            fprintf(stderr, "kernel_launch: unexpected shapes: n_in %d in0 %d out %d ws %zu (need %zu)\n", n_in, n_in > 0 ? in_sizes[0] : -1, out_size, ws_size, (size_t)WS_END); grid = -1; return; }
        int dev = 0, cus = 0;
        if (hipGetDevice(&dev) != hipSuccess || hipDeviceGetAttribute(&cus, hipDeviceAttributeMultiprocessorCount, dev) != hipSuccess) { grid = -1; return; }
        if (hipFuncSetAttribute((const void*)fwd_kernel, hipFuncAttributeMaxDynamicSharedMemorySize, LDS_BYTES) != hipSuccess) { fprintf(stderr, "kernel_launch: hipFuncSetAttribute failed\n"); grid = -1; return; }
        int per_cu = 0;
        if (hipOccupancyMaxActiveBlocksPerMultiprocessor(&per_cu, (const void*)fwd_kernel, NWAVES * 64, LDS_BYTES) != hipSuccess || per_cu < 1) fprintf(stderr, "kernel_launch: occupancy query says %d\n", per_cu);
        (void)hipGetLastError();
        grid = cus;
    }
    if (grid < 0) return;
    (void)hipMemsetAsync((char*)d_ws + WS_CTL, 0, CTL_ZERO_BYTES, stream);
    Args a{};
    for (int i = 0; i < 20; ++i) a.in[i] = (const float*)d_in[i];
    a.out = (float*)d_out; a.ws = (unsigned char*)d_ws;
#ifndef LAUNCH_LIST
#define LAUNCH_LIST {0, NPH}
#endif
    static const int ranges[][2] = { LAUNCH_LIST };
    const int nl = (int)(sizeof(ranges) / sizeof(ranges[0]));
    for (int li = 0; li < nl; ++li) { a.ph_lo = ranges[li][0]; a.ph_hi = ranges[li][1]; a.li = li;
        hipLaunchKernelGGL(fwd_kernel, dim3(grid), dim3(NWAVES * 64), LDS_BYTES, stream, a); }
}
```

```cpp
#include <hip/hip_runtime.h>
#include <cstdio>
#include <cstdint>


#ifndef XTRA_BAR
#define XTRA_BAR 0
#endif
#ifndef DRY_EXP
#define DRY_EXP 0
#endif
#ifndef DUP_PHASE
#define DUP_PHASE -1
#endif
#ifndef MK_N_LAUNCHES
#define MK_N_LAUNCHES 1
#endif

#define LAS __attribute__((address_space(3)))
#define GAS __attribute__((address_space(1)))
typedef unsigned short bf16_t;
typedef short bf16x8 __attribute__((ext_vector_type(8)));
typedef float f32x4 __attribute__((ext_vector_type(4)));
typedef float f32x2 __attribute__((ext_vector_type(2)));
typedef unsigned u32x4 __attribute__((ext_vector_type(4)));
typedef unsigned u32x2 __attribute__((ext_vector_type(2)));
typedef int i32x4 __attribute__((ext_vector_type(4)));
typedef int i32x8 __attribute__((ext_vector_type(8)));
typedef __bf16 bf16x2_t __attribute__((ext_vector_type(2)));

constexpr int T_TOK = 32768, D = 1024, SEQ = 4096, NBATCH = 8;
constexpr int NPROJ = 5376;
constexpr int PLD = 5120;
constexpr int PC_Q = 0, PC_K = 512, PC_V = 1024, PC_R = 1536, PC_SU = 2048, PC_SV = 2560, PC_GA = 3072, PC_GB = 4096;
constexpr int PC_MRG = 512;
constexpr float EPS = 1e-6f;
constexpr int NEXP = 16384;
#ifndef U_NG
#define U_NG 2
#endif
constexpr int UNG = U_NG, UNG_SH = (U_NG == 8 ? 3 : (U_NG == 4 ? 2 : (U_NG == 2 ? 1 : 0)));

constexpr size_t MiB = 1u << 20;
constexpr size_t WS_CTL = 0, CTL_ZERO_BYTES = 64 * 1024;
constexpr size_t WS_WIN = 1 * MiB;
constexpr size_t WS_WA = 12 * MiB;
constexpr size_t WS_WB = 13 * MiB;
constexpr size_t WS_WOUT = 14 * MiB;
constexpr size_t WS_WQF = 16 * MiB;
constexpr size_t WS_U8 = 20 * MiB;
constexpr size_t WS_V8 = 36 * MiB;
constexpr size_t WS_SU = 52 * MiB;
constexpr size_t WS_SV = 52 * MiB + 65536;
constexpr size_t WS_AK = 53 * MiB;
constexpr size_t WS_DEC = 84 * MiB;
constexpr size_t WS_ALR = 85 * MiB;
constexpr size_t WS_N1 = 87 * MiB;
constexpr size_t WS_P = 151 * MiB;
constexpr size_t WS_END = 471 * MiB;
constexpr size_t P_SC = 0, P_IDX = 256 * MiB, P_GATE = 272 * MiB, P_X8 = 288 * MiB;

constexpr int CW_BAR = 4096;

constexpr int RING_BYTES = 131072;
constexpr int LDSCTL_OFF = RING_BYTES, MISC_OFF = LDSCTL_OFF + 320;
constexpr int LDS_BYTES = 147456;
constexpr int NWAVES = 8;

__device__ __forceinline__ unsigned pk2(float lo, float hi) { const f32x2 v = {lo, hi}; const bf16x2_t b = __builtin_convertvector(v, bf16x2_t); return __builtin_bit_cast(unsigned, b); }
__device__ __forceinline__ unsigned f2bf(float f) { return pk2(f, 0.f) & 0xffffu; }
__device__ __forceinline__ float bflo(unsigned w) { return __builtin_bit_cast(float, w << 16); }
__device__ __forceinline__ float bfhi(unsigned w) { return __builtin_bit_cast(float, w & 0xffff0000u); }
__device__ __forceinline__ float bf1(bf16_t h) { return __builtin_bit_cast(float, ((unsigned)h) << 16); }
__device__ __forceinline__ float sigmoidf_(float x) { return __builtin_amdgcn_rcpf(1.f + __expf(-x)); }
__device__ __forceinline__ float gelu_tanh(float x) { const float y = 1.5957691216057308f * (x + 0.044715f * x * x * x); return x * sigmoidf_(y); }
__device__ __forceinline__ float siluf_(float x) { return x * sigmoidf_(x); }
__device__ __forceinline__ float wave_sum(float v) {
#pragma unroll
    for (int o = 1; o < 64; o <<= 1) v += __shfl_xor(v, o);
    return v;
}
#define LDS_WAIT() asm volatile("s_waitcnt lgkmcnt(0)" ::: "memory")
#define VM_WAIT() asm volatile("s_waitcnt vmcnt(0)" ::: "memory")

namespace pg8 {
constexpr int BM = 256, BK = 64, HALF = 128, HTB = HALF * BK * 2, STAGE_BYTES = 8 * HTB, NXCD = 8, WGM = 8;
__host__ __device__ __forceinline__ int lds_byte(int r, int c) { const int st = (r >> 4) * 2 + (c >> 5), rr = r & 15, cc = c & 31, ob = rr * 64 + cc * 2; return st * 1024 + (ob ^ (((ob >> 9) & 1) << 5)); }
__host__ __device__ __forceinline__ void stage_rc(int b, int& R, int& C) { const int st = b / 1024, sb = b % 1024, swz = sb ^ (((sb >> 9) & 1) << 5); R = (st >> 1) * 16 + swz / 64; C = (st & 1) * 32 + (swz % 64) / 2; }
__host__ __device__ __forceinline__ int perm32(int rho) { const int n = rho >> 4, i = rho & 15; return 8 * (i >> 2) + 4 * n + (i & 3); }

struct Unit { int pm, pn; };
struct Gemm { const bf16_t* A; const bf16_t* Bt; int M, N, K, lda; int sa = 0, sb = 0; };

struct StaticOrder {
    int nM, nN, nwg, G, c;
    __host__ __device__ void init(int M, int N, int G_, int c_) { nM = M / BM; nN = N / BM; nwg = nM * nN; G = G_; c = c_; }
    __host__ __device__ bool next(int i, Unit& u) const {
        const long L = (long)i * G + c; if (L >= nwg) return false;
        int wgid = (int)L; { const int q = nwg / NXCD, r = nwg % NXCD, xcd = wgid % NXCD, off = wgid / NXCD; wgid = (xcd < r ? xcd * (q + 1) : r * (q + 1) + (xcd - r) * q) + off; }
        const int nig = WGM * nN, gid = wgid / nig, fm = gid * WGM, gsz = (nM - fm) < WGM ? (nM - fm) : WGM;
        u.pm = fm + ((wgid % nig) % gsz); u.pn = (wgid % nig) / gsz; return true;
    }
    __device__ __forceinline__ void a_ready(const Unit&) const {}
    __device__ __forceinline__ void done(const Unit&) const {}
};

template <class Epi, class Sched, bool ALIGN_EPI = false, bool SP2 = false, bool F8 = false>
__device__ __forceinline__ void gemm_phase(LAS unsigned char* lds, const Gemm g, const Sched& S, const Epi& E) {
    const int tid = threadIdx.x, wid = __builtin_amdgcn_readfirstlane(tid >> 6), lane = tid & 63, wr = wid >> 2, wc = wid & 3, fr = lane & 15, fq = lane >> 4;
    const int K = g.K, nt = K / BK, lda = g.lda; const int scA = g.sa, scB = g.sb; (void)scA; (void)scB;
    unsigned voffA[2], voffB[2];
#pragma unroll
    for (int i = 0; i < 2; ++i) { int R, C; stage_rc(tid * 16 + i * 8192, R, C); const int Rb = Epi::PERM ? ((R & ~31) + perm32(R & 31)) : R;
        voffA[i] = (unsigned)(R * lda + C) * 2u; voffB[i] = (unsigned)(Rb * K + C) * 2u; }
    const size_t kstep = (size_t)(BK * 2);
    const size_t hstepA = (size_t)HALF * lda * 2, hstepB = (size_t)HALF * K * 2;
    const size_t tstepA = 2 * hstepA, tstepB = 2 * hstepB;
    const unsigned ldsw = (unsigned)wid * 1024u; const unsigned ldsbase = (unsigned)(__UINTPTR_TYPE__)lds + ldsw;
    const int aoff = lds_byte(wr * 64 + fr, fq * 8), boff = lds_byte(wc * 32 + fr, fq * 8);
#define PG8_SA(b, h) (((b) * 2 + (h)) * HTB)
#define PG8_SB(b, h) ((4 + (b) * 2 + (h)) * HTB)
#define PG8_STAGE(bufoff, gbase, voff) do { _Pragma("unroll") for (int _i = 0; _i < 2; ++_i) \
        asm volatile("s_mov_b32 m0, %2\n\ts_nop 0\n\tglobal_load_lds_dwordx4 %0, %1" :: "v"((voff)[_i]), "s"((const char*)(gbase)), "s"(ldsbase + (unsigned)((bufoff) + _i * 8192)) : "memory", "m0"); } while (0)
#define PG8_LDA(dst, b, h) do { _Pragma("unroll") for (int m = 0; m < 4; ++m) _Pragma("unroll") for (int k = 0; k < 2; ++k) dst[m][k] = *(const LAS bf16x8*)(lds + PG8_SA(b, h) + aoff + m * 2048 + k * 1024); } while (0)
#define PG8_LDB(dst, b, h) do { _Pragma("unroll") for (int n = 0; n < 2; ++n) _Pragma("unroll") for (int k = 0; k < 2; ++k) dst[n][k] = *(const LAS bf16x8*)(lds + PG8_SB(b, h) + boff + n * 2048 + k * 1024); } while (0)
#define PG8_CAT(x) __builtin_shufflevector(__builtin_bit_cast(i32x4, (x)[0]), __builtin_bit_cast(i32x4, (x)[1]), 0, 1, 2, 3, 4, 5, 6, 7)
#define PG8_MMA(ai, bj, At, Bt) do { __builtin_amdgcn_s_setprio(1); if constexpr (F8) { _Pragma("unroll") for (int m = 0; m < 4; ++m) _Pragma("unroll") for (int n = 0; n < 2; ++n) \
        acc[ai][bj][m][n] = __builtin_amdgcn_mfma_scale_f32_16x16x128_f8f6f4(PG8_CAT(Bt[n]), PG8_CAT(At[m]), acc[ai][bj][m][n], 0, 0, 0, scB, 0, scA); } else { \
        _Pragma("unroll") for (int m = 0; m < 4; ++m) _Pragma("unroll") for (int n = 0; n < 2; ++n) _Pragma("unroll") for (int k = 0; k < 2; ++k) \
        acc[ai][bj][m][n] = __builtin_amdgcn_mfma_f32_16x16x32_bf16(Bt[n][k], At[m][k], acc[ai][bj][m][n], 0, 0, 0); } __builtin_amdgcn_s_setprio(0); } while (0)
#define PG8_WAIT_V(n) asm volatile("s_waitcnt vmcnt(" #n ")" ::: "memory")
#define PG8_WAIT_L(n) asm volatile("s_waitcnt lgkmcnt(" #n ")" ::: "memory")
#define PG8_BAR __builtin_amdgcn_s_barrier()
#define PG8_SCHED __builtin_amdgcn_sched_barrier(0)
    Unit cur, nxt; int ui = 0;
    if (!S.next(0, cur)) return;
    f32x4 acc[2][2][4][2];
#pragma unroll
    for (int a = 0; a < 2; ++a)
#pragma unroll
        for (int b = 0; b < 2; ++b)
#pragma unroll
            for (int m = 0; m < 4; ++m)
#pragma unroll
                for (int n = 0; n < 2; ++n) acc[a][b][m][n] = (f32x4){0.f, 0.f, 0.f, 0.f};
    bf16x8 At[4][2], B0[2][2], B1[2][2];
    const char* cA = (const char*)g.A + (size_t)cur.pm * tstepA; const char* cB = (const char*)g.Bt + (size_t)cur.pn * tstepB;
    S.a_ready(cur);
    if constexpr (SP2) {
        PG8_STAGE(PG8_SB(0, 0), cB, voffB); PG8_STAGE(PG8_SB(0, 1), cB + hstepB, voffB); PG8_STAGE(PG8_SA(0, 0), cA, voffA); PG8_STAGE(PG8_SA(0, 1), cA + hstepA, voffA);
        if (wr == 1) PG8_BAR;
        PG8_WAIT_V(2); PG8_BAR;
        PG8_STAGE(PG8_SB(1, 0), cB + kstep, voffB); PG8_STAGE(PG8_SA(1, 0), cA + kstep, voffA); PG8_STAGE(PG8_SB(1, 1), cB + hstepB + kstep, voffB);
        PG8_WAIT_V(6); PG8_BAR;
    } else {
        PG8_STAGE(PG8_SB(0, 0), cB, voffB); PG8_STAGE(PG8_SA(0, 0), cA, voffA); PG8_STAGE(PG8_SB(0, 1), cB + hstepB, voffB); PG8_STAGE(PG8_SA(0, 1), cA + hstepA, voffA);
        if (wr == 1) PG8_BAR;
        PG8_WAIT_V(4); PG8_BAR;
        PG8_STAGE(PG8_SB(1, 0), cB + kstep, voffB); PG8_STAGE(PG8_SA(1, 0), cA + kstep, voffA); PG8_STAGE(PG8_SB(1, 1), cB + hstepB + kstep, voffB);
        PG8_WAIT_V(6); PG8_BAR;
    }
    for (;;) {
        const bool has_next = S.next(ui + 1, nxt);
        const char* nA = has_next ? (const char*)g.A + (size_t)nxt.pm * tstepA : cA; const char* nB = has_next ? (const char*)g.Bt + (size_t)nxt.pn * tstepB : cB;
#pragma nounroll
        for (int t = 0; t < nt; t += 2) {
            const bool last = (t == nt - 2);
            const char* a1 = cA + (size_t)(t + 1) * kstep;
            const char* a2 = last ? nA : cA + (size_t)(t + 2) * kstep; const char* b2 = last ? nB : cB + (size_t)(t + 2) * kstep;
            const char* a3 = a2 + kstep; const char* b3 = b2 + kstep;
            if (last && has_next) S.a_ready(nxt);
            if constexpr (SP2) {
            PG8_LDB(B0, 0, 0); PG8_LDB(B1, 0, 1); PG8_SCHED; PG8_LDA(At, 0, 0); PG8_STAGE(PG8_SA(1, 1), a1 + hstepA, voffA);
            PG8_WAIT_V(8); PG8_WAIT_L(0); PG8_BAR; PG8_MMA(0, 0, At, B0); PG8_MMA(0, 1, At, B1); PG8_BAR; PG8_SCHED;
            PG8_LDA(At, 0, 1); PG8_STAGE(PG8_SB(0, 0), b2, voffB); PG8_STAGE(PG8_SB(0, 1), b2 + hstepB, voffB); PG8_STAGE(PG8_SA(0, 0), a2, voffA);
            PG8_WAIT_V(8); PG8_WAIT_L(0); PG8_BAR; PG8_MMA(1, 0, At, B0); PG8_MMA(1, 1, At, B1); PG8_BAR; PG8_SCHED;
            PG8_LDB(B0, 1, 0); PG8_LDB(B1, 1, 1); PG8_SCHED; PG8_LDA(At, 1, 0); PG8_STAGE(PG8_SA(0, 1), a2 + hstepA, voffA);
            PG8_WAIT_V(8); PG8_WAIT_L(0); PG8_BAR; PG8_MMA(0, 0, At, B0); PG8_MMA(0, 1, At, B1); PG8_BAR; PG8_SCHED;
            PG8_LDA(At, 1, 1); PG8_STAGE(PG8_SB(1, 0), b3, voffB); PG8_STAGE(PG8_SB(1, 1), b3 + hstepB, voffB); PG8_STAGE(PG8_SA(1, 0), a3, voffA);
            PG8_WAIT_V(8); PG8_WAIT_L(0); PG8_BAR; PG8_MMA(1, 0, At, B0); PG8_MMA(1, 1, At, B1); PG8_BAR; PG8_SCHED;
            } else {
            PG8_LDB(B0, 0, 0); PG8_SCHED; PG8_LDA(At, 0, 0); PG8_STAGE(PG8_SA(1, 1), a1 + hstepA, voffA);
            PG8_WAIT_L(8); PG8_BAR; PG8_WAIT_L(0); PG8_MMA(0, 0, At, B0); PG8_BAR; PG8_SCHED;
            PG8_LDB(B1, 0, 1); PG8_STAGE(PG8_SB(0, 0), b2, voffB);
            PG8_BAR; PG8_WAIT_L(0); PG8_MMA(0, 1, At, B1); PG8_BAR;
            PG8_LDA(At, 0, 1); PG8_STAGE(PG8_SA(0, 0), a2, voffA);
            PG8_BAR; PG8_WAIT_L(0); PG8_MMA(1, 0, At, B0); PG8_BAR; PG8_SCHED;
            PG8_STAGE(PG8_SB(0, 1), b2 + hstepB, voffB);
            PG8_WAIT_V(6); PG8_BAR; PG8_MMA(1, 1, At, B1); PG8_BAR;
            PG8_LDB(B0, 1, 0); PG8_SCHED; PG8_LDA(At, 1, 0); PG8_STAGE(PG8_SA(0, 1), a2 + hstepA, voffA);
            PG8_WAIT_L(8); PG8_BAR; PG8_WAIT_L(0); PG8_MMA(0, 0, At, B0); PG8_BAR; PG8_SCHED;
            PG8_LDB(B1, 1, 1); PG8_STAGE(PG8_SB(1, 0), b3, voffB);
            PG8_BAR; PG8_WAIT_L(0); PG8_MMA(0, 1, At, B1); PG8_BAR;
            PG8_LDA(At, 1, 1); PG8_STAGE(PG8_SA(1, 0), a3, voffA);
            PG8_BAR; PG8_WAIT_L(0); PG8_MMA(1, 0, At, B0); PG8_BAR; PG8_SCHED;
            PG8_STAGE(PG8_SB(1, 1), b3 + hstepB, voffB);
            PG8_WAIT_V(6); PG8_BAR; PG8_MMA(1, 1, At, B1); PG8_BAR;
            }
        }
        if constexpr (ALIGN_EPI) { if (wr == 0) PG8_BAR; }
        E(acc, cur, wr, wc, fr, fq); S.done(cur);
        if (!has_next) break;
#pragma unroll
        for (int a = 0; a < 2; ++a)
#pragma unroll
            for (int b = 0; b < 2; ++b)
#pragma unroll
                for (int m = 0; m < 4; ++m)
#pragma unroll
                    for (int n = 0; n < 2; ++n) acc[a][b][m][n] = (f32x4){0.f, 0.f, 0.f, 0.f};
        cur = nxt; cA = nA; cB = nB; ++ui;
        if constexpr (ALIGN_EPI) { if (wr == 1) PG8_BAR; }
    }
    PG8_WAIT_V(0);
    if constexpr (!ALIGN_EPI) { if (wr == 0) PG8_BAR; }
    PG8_BAR;
#undef PG8_SA
#undef PG8_SB
#undef PG8_STAGE
#undef PG8_LDA
#undef PG8_LDB
#undef PG8_MMA
#undef PG8_CAT
#undef PG8_WAIT_V
#undef PG8_WAIT_L
#undef PG8_BAR
#undef PG8_SCHED
}

__device__ __forceinline__ u32x4 pack8(f32x4 v0, f32x4 v1) { u32x4 w; w.x = pk2(v0[0], v0[1]); w.y = pk2(v0[2], v0[3]); w.z = pk2(v1[0], v1[1]); w.w = pk2(v1[2], v1[3]); return w; }
__device__ __forceinline__ void unpack8(u32x4 w, f32x4& v0, f32x4& v1) { v0 = (f32x4){bflo(w.x), bfhi(w.x), bflo(w.y), bfhi(w.y)}; v1 = (f32x4){bflo(w.z), bfhi(w.z), bflo(w.w), bfhi(w.w)}; }

struct EpiProj {
    static constexpr bool PERM = true;
    bf16_t* P; float* ALR;
    __device__ __forceinline__ void operator()(const f32x4 (&acc)[2][2][4][2], const Unit& u, int wr, int wc, int fr, int fq) const {
        asm volatile("" : "+v"(fr), "+v"(fq));
        const int row0 = u.pm * BM + wr * 64 + fr; const int pn = u.pn; const int cl = wc * 32 + 8 * fq;
        if (pn == 20) {
            if (wc == 0 && fq < 2) {
#pragma unroll
                for (int ai = 0; ai < 2; ++ai)
#pragma unroll
                    for (int m = 0; m < 4; ++m) { float* rp = ALR + (size_t)(row0 + ai * HALF + m * 16) * 16 + 8 * fq;
                        *(f32x4*)rp = acc[ai][0][m][0]; *(f32x4*)(rp + 4) = acc[ai][0][m][1]; }
            }
            return;
        }
        const int mode = pn < 8 ? 0 : (pn < 12 ? 1 : 2);
#pragma unroll
        for (int ai = 0; ai < 2; ++ai)
#pragma unroll
            for (int m = 0; m < 4; ++m) { bf16_t* rowp = P + (size_t)(row0 + ai * HALF + m * 16) * PLD + pn * BM + cl;
#pragma unroll
                for (int bj = 0; bj < 2; ++bj) { f32x4 v0 = acc[ai][bj][m][0], v1 = acc[ai][bj][m][1];
                    if (mode == 1) {
#pragma unroll
                        for (int i = 0; i < 4; ++i) { v0[i] = gelu_tanh(v0[i]); v1[i] = gelu_tanh(v1[i]); }
                    } else if (mode == 2) {
#pragma unroll
                        for (int i = 0; i < 4; ++i) { v0[i] = sigmoidf_(v0[i]); v1[i] = sigmoidf_(v1[i]); }
                    }
                    *(u32x4*)(rowp + bj * HALF) = pack8(v0, v1); } }
    }
};
struct EpiBrA {
    static constexpr bool PERM = true;
    bf16_t* P;
    __device__ __forceinline__ void operator()(const f32x4 (&acc)[2][2][4][2], const Unit& u, int wr, int wc, int fr, int fq) const {
        const int row0 = u.pm * BM + wr * 64 + fr; const int c0 = u.pn * BM + wc * 32 + 8 * fq;
#pragma unroll
        for (int ai = 0; ai < 2; ++ai)
#pragma unroll
            for (int m = 0; m < 4; ++m) { bf16_t* rowp = P + (size_t)(row0 + ai * HALF + m * 16) * PLD;
#pragma unroll
                for (int bj = 0; bj < 2; ++bj) { const int c = c0 + bj * HALF; f32x4 g0, g1; unpack8(*(const u32x4*)(rowp + PC_GA + c), g0, g1);
                    *(u32x4*)(rowp + PC_MRG + c) = pack8(acc[ai][bj][m][0] * g0, acc[ai][bj][m][1] * g1); } }
    }
};
struct EpiBrB {
    static constexpr bool PERM = true;
    bf16_t* P;
    __device__ __forceinline__ void operator()(const f32x4 (&acc)[2][2][4][2], const Unit& u, int wr, int wc, int fr, int fq) const {
        const int row0 = u.pm * BM + wr * 64 + fr; const int c0 = u.pn * BM + wc * 32 + 8 * fq;
#pragma unroll
        for (int ai = 0; ai < 2; ++ai)
#pragma unroll
            for (int m = 0; m < 4; ++m) { bf16_t* rowp = P + (size_t)(row0 + ai * HALF + m * 16) * PLD;
#pragma unroll
                for (int bj = 0; bj < 2; ++bj) { const int c = c0 + bj * HALF; f32x4 g0, g1, p0, p1; unpack8(*(const u32x4*)(rowp + PC_GB + c), g0, g1); unpack8(*(const u32x4*)(rowp + PC_MRG + c), p0, p1);
                    *(u32x4*)(rowp + PC_MRG + c) = pack8(p0 + acc[ai][bj][m][0] * g0, p1 + acc[ai][bj][m][1] * g1); } }
    }
};
struct EpiOut {
    static constexpr bool PERM = true;
    const float* X; float* O;
    __device__ __forceinline__ void operator()(const f32x4 (&acc)[2][2][4][2], const Unit& u, int wr, int wc, int fr, int fq) const {
        const int row0 = u.pm * BM + wr * 64 + fr; const int c0 = u.pn * BM + wc * 32 + 8 * fq;
#pragma unroll
        for (int ai = 0; ai < 2; ++ai)
#pragma unroll
            for (int m = 0; m < 4; ++m) { const size_t ro = (size_t)(row0 + ai * HALF + m * 16) * D;
#pragma unroll
                for (int bj = 0; bj < 2; ++bj) { const int c = c0 + bj * HALF;
                    const f32x4 x0 = *(const f32x4*)(X + ro + c), x1 = *(const f32x4*)(X + ro + c + 4);
                    *(f32x4*)(O + ro + c) = x0 + acc[ai][bj][m][0]; *(f32x4*)(O + ro + c + 4) = x1 + acc[ai][bj][m][1]; } }
    }
};
struct EpiScores {
    static constexpr bool PERM = true;
    float* SC;
    __device__ __forceinline__ void operator()(const f32x4 (&acc)[2][2][4][2], const Unit& u, int wr, int wc, int fr, int fq) const {
        const int tb0 = u.pm * 16 + wr * 4; const int cq0 = (u.pn * BM + wc * 32 + 8 * fq) >> 2;
#pragma unroll
        for (int ai = 0; ai < 2; ++ai)
#pragma unroll
            for (int m = 0; m < 4; ++m) { float* bp = SC + ((size_t)(tb0 + ai * 8 + m) * 512) * 64 + fr * 4;
#pragma unroll
                for (int bj = 0; bj < 2; ++bj)
#pragma unroll
                    for (int n = 0; n < 2; ++n) *(f32x4*)(bp + (size_t)(cq0 + bj * 32 + n) * 64) = acc[ai][bj][m][n]; }
    }
};
}

#define XB_TMO      128
#define XB_XCNT(j)  (256  + 64 * (j))
#define XB_XSUB(j)  (1280 + 64 * (j))
#define XB_XGEN(j)  (2304 + 64 * (j))
#define XB_TOP      3328
#define XB_TOPGEN   3392
#define XCD_BAR_WORDS 3456
#define XB_SPIN_CAP (1u << 18)
__device__ __forceinline__ unsigned xb_ld(unsigned* p)              { return __hip_atomic_load(p, __ATOMIC_RELAXED, __HIP_MEMORY_SCOPE_AGENT); }
__device__ __forceinline__ unsigned xb_add(unsigned* p, unsigned v) { return __hip_atomic_fetch_add(p, v, __ATOMIC_RELAXED, __HIP_MEMORY_SCOPE_AGENT); }
__device__ __forceinline__ unsigned xb_xcc_id() { return (unsigned)__builtin_amdgcn_s_getreg((3 << 11) | 20) & 0xFu; }
#define XB_SPIN(cond, bar) do { unsigned _sp = 0; while (cond) { __builtin_amdgcn_s_sleep(1); \
    if ((++_sp & 255u) == 0u) { if (xb_ld(&(bar)[XB_TMO])) break; if (_sp > XB_SPIN_CAP) { atomicAdd(&(bar)[XB_TMO], 1u); break; } } } } while (0)
struct XcdBarrier { unsigned* bar; unsigned x; volatile LAS unsigned* st; };
__device__ __forceinline__ XcdBarrier xcd_barrier_post(unsigned* bar, volatile LAS unsigned* st) {
    XcdBarrier b; b.bar = bar; b.x = xb_xcc_id(); b.st = st;
    if (threadIdx.x == 0) (void)xb_add(&bar[XB_XCNT(b.x)], 1u);
    return b;
}
__device__ __forceinline__ void xcd_barrier_complete(unsigned* bar, unsigned x, unsigned& nloc, unsigned& nx) {
    const unsigned G = gridDim.x * gridDim.y * gridDim.z;
    unsigned sum, cnt, mine, sp = 0u;
    for (;;) {
        sum = 0u; cnt = 0u; mine = 0u;
#pragma unroll
        for (unsigned j = 0; j < 16; ++j) { const unsigned c = xb_ld(&bar[XB_XCNT(j)]); sum += c; cnt += (c > 0u) ? 1u : 0u; mine = (j == x) ? c : mine; }
        if (sum == G) break;
        __builtin_amdgcn_s_sleep(1);
        if ((++sp & 255u) == 0u) { if (xb_ld(&bar[XB_TMO])) break; if (sp > XB_SPIN_CAP) { atomicAdd(&bar[XB_TMO], 1u); break; } }
    }
    nloc = mine > 0u ? mine : 1u; nx = cnt > 0u ? cnt : 1u;
}
__device__ __forceinline__ void xcd_barrier(const XcdBarrier& b) {
    asm volatile("s_waitcnt vmcnt(0)" ::: "memory");
    __syncthreads();
    if (threadIdx.x == 0) {
        unsigned* bar = b.bar;
        __builtin_amdgcn_s_waitcnt(0);
        unsigned nloc = b.st[0], nx = b.st[1];
        if (nloc == 0u) { xcd_barrier_complete(bar, b.x, nloc, nx); b.st[0] = nloc; b.st[1] = nx; }
        const unsigned old = xb_add(&bar[XB_XSUB(b.x)], 1u);
        const unsigned gen = old / nloc;
        if (old + 1u == (gen + 1u) * nloc) {
            __builtin_amdgcn_fence(__ATOMIC_RELEASE, "agent");
            asm volatile("s_waitcnt vmcnt(0)" ::: "memory");
            const unsigned og = xb_add(&bar[XB_TOP], 1u);
            const unsigned tg = og / nx;
            if (og + 1u == (tg + 1u) * nx) xb_add(&bar[XB_TOPGEN], 1u);
            else XB_SPIN(xb_ld(&bar[XB_TOPGEN]) == tg, bar);
            __builtin_amdgcn_fence(__ATOMIC_ACQUIRE, "agent");
            xb_add(&bar[XB_XGEN(b.x)], 1u);
            asm volatile("s_waitcnt vmcnt(0)" ::: "memory");
        } else {
            XB_SPIN(xb_ld(&bar[XB_XGEN(b.x)]) == gen, bar);
            __builtin_amdgcn_fence(__ATOMIC_ACQUIRE, "agent");
            asm volatile("s_waitcnt vmcnt(0)" ::: "memory");
        }
    }
    __syncthreads();
}

struct Args {
    const float* in[20]; float* out; unsigned char* ws; int ph_lo, ph_hi, li, pad;
};
enum { I_X = 0, I_N1G, I_WIN, I_WGU, I_BG, I_GLAG, I_SLNG, I_SLNB, I_SW, I_SB, I_WBA, I_WBB, I_WOUT, I_N2G, I_WQ, I_K1, I_K2, I_PU, I_PV, I_FG };

struct Frame {
    LAS unsigned char* lds;
    int tid, lane, wave, G, bid;
};

__device__ __forceinline__ float clamp448(float v) { return __builtin_amdgcn_fmed3f(v, -448.f, 448.f); }
template <int MODE, bool F8 = false>
__device__ __forceinline__ void p0_transpose_item(const float* W, int K, int Nsrc, int Ndst, bf16_t* WT, LAS float* scr, int item, int lane, float sc8 = 1.f) {
    const int nblk = Ndst / 32, kb = item / nblk, nb = item % nblk, k0 = 64 * kb, n0 = 32 * nb;
    const int nd = n0 + (lane & 31);
    int sc = nd; bool valid = true;
    if (MODE == 1) { if (nd < 2048) sc = nd; else if (nd < 5120) sc = nd + 16; else if (nd < 5136) sc = 2048 + (nd - 5120); else { sc = 0; valid = false; } }
#pragma unroll 8
    for (int i = 0; i < 32; ++i) { const int kk = 2 * i + (lane >> 5); const float v = valid ? W[(size_t)(k0 + kk) * Nsrc + sc] : 0.f; scr[kk * 33 + (lane & 31)] = v; }
    LDS_WAIT(); asm volatile("" ::: "memory");
    if (F8) {
        const int c = lane & 3;
#pragma unroll
        for (int j = 0; j < 2; ++j) { const int n = (lane >> 2) + 16 * j; const LAS float* s = scr + (16 * c) * 33 + n; u32x4 o;
#pragma unroll
            for (int q = 0; q < 4; ++q) { int w = 0; w = __builtin_amdgcn_cvt_pk_fp8_f32(clamp448(s[(4 * q) * 33] * sc8), clamp448(s[(4 * q + 1) * 33] * sc8), w, false);
                w = __builtin_amdgcn_cvt_pk_fp8_f32(clamp448(s[(4 * q + 2) * 33] * sc8), clamp448(s[(4 * q + 3) * 33] * sc8), w, true); o[q] = (unsigned)w; }
            *(u32x4*)((unsigned char*)WT + (size_t)(n0 + n) * K + k0 + 16 * c) = o; }
    } else {
    const int c = lane & 7;
#pragma unroll
    for (int j = 0; j < 4; ++j) { const int n = (lane >> 3) + 8 * j; const LAS float* s = scr + (8 * c) * 33 + n;
        u32x4 o; o.x = pk2(s[0 * 33], s[1 * 33]); o.y = pk2(s[2 * 33], s[3 * 33]); o.z = pk2(s[4 * 33], s[5 * 33]); o.w = pk2(s[6 * 33], s[7 * 33]);
        *(u32x4*)(WT + (size_t)(n0 + n) * K + k0 + 8 * c) = o; }
    }
    LDS_WAIT(); asm volatile("" ::: "memory");
}
template <int OM, int NB>
__device__ __forceinline__ void rms_rows_to_bf16(int lane, const float* x0, size_t xstride, const float* g, bf16_t* o0, size_t ostride, unsigned* o80 = nullptr, size_t o8stride = 0) {
    f32x4 v[NB][4]; float s[NB];
#pragma unroll
    for (int b = 0; b < NB; ++b) { const f32x4* xr = (const f32x4*)(x0 + b * xstride) + lane;
#pragma unroll
        for (int j = 0; j < 4; ++j) v[b][j] = xr[64 * j]; }
#pragma unroll
    for (int b = 0; b < NB; ++b) { s[b] = 0.f;
#pragma unroll
        for (int j = 0; j < 4; ++j) s[b] += (v[b][j].x * v[b][j].x + v[b][j].y * v[b][j].y) + (v[b][j].z * v[b][j].z + v[b][j].w * v[b][j].w); }
#pragma unroll
    for (int o = 1; o < 64; o <<= 1) {
#pragma unroll
        for (int b = 0; b < NB; ++b) s[b] += __shfl_xor(s[b], o); }
    const f32x4* gr = (const f32x4*)g + lane;
#pragma unroll
    for (int b = 0; b < NB; ++b) { const float rstd = 1.f / sqrtf(s[b] * (1.f / D) + EPS); u32x2* o8 = (u32x2*)(o0 + b * ostride) + lane;
#pragma unroll
        for (int j = 0; j < 4; ++j) { const f32x4 gg = gr[64 * j]; const f32x4 y = v[b][j] * rstd * gg; u32x2 o; o.x = pk2(y.x, y.y); o.y = pk2(y.z, y.w); if (OM & 1) o8[64 * j] = o;
            if (OM == 3) { int w = 0; w = __builtin_amdgcn_cvt_pk_fp8_f32(bflo(o.x) * 16.f, bfhi(o.x) * 16.f, w, false); w = __builtin_amdgcn_cvt_pk_fp8_f32(bflo(o.y) * 16.f, bfhi(o.y) * 16.f, w, true); (o80 + b * o8stride)[64 * j + lane] = (unsigned)w; }
            if (OM == 2) { int w = 0; w = __builtin_amdgcn_cvt_pk_fp8_f32(clamp448(y.x * 16.f), clamp448(y.y * 16.f), w, false); w = __builtin_amdgcn_cvt_pk_fp8_f32(clamp448(y.z * 16.f), clamp448(y.w * 16.f), w, true); (o80 + b * o8stride)[64 * j + lane] = (unsigned)w; } } }
}
__device__ __forceinline__ float wave_max(float v) {
#pragma unroll
    for (int o = 1; o < 64; o <<= 1) v = fmaxf(v, __shfl_xor(v, o));
    return v;
}
template <int NB>
__device__ __forceinline__ void cvt_rows_fp8(int lane, const float* const (&src)[NB], unsigned char* const (&dst16)[NB], float* const (&scale_out)[NB]) {
    f32x4 v[NB][4]; float m[NB];
#pragma unroll
    for (int b = 0; b < NB; ++b) {
#pragma unroll
        for (int j = 0; j < 4; ++j) v[b][j] = *(const GAS f32x4*)(src[b] + 16 * lane + 4 * j); }
#pragma unroll
    for (int b = 0; b < NB; ++b) { m[b] = 0.f;
#pragma unroll
        for (int j = 0; j < 4; ++j) m[b] = fmaxf(m[b], fmaxf(fmaxf(fabsf(v[b][j].x), fabsf(v[b][j].y)), fmaxf(fabsf(v[b][j].z), fabsf(v[b][j].w)))); }
#pragma unroll
    for (int o = 1; o < 64; o <<= 1) {
#pragma unroll
        for (int b = 0; b < NB; ++b) m[b] = fmaxf(m[b], __shfl_xor(m[b], o)); }
#pragma unroll
    for (int b = 0; b < NB; ++b) { const float inv = m[b] > 0.f ? 224.f / m[b] : 0.f, sc = m[b] > 0.f ? m[b] * (1.f / 224.f) : 1.f;
        u32x4 o;
#pragma unroll
        for (int j = 0; j < 4; ++j) { int w = 0; w = __builtin_amdgcn_cvt_pk_fp8_f32(v[b][j].x * inv, v[b][j].y * inv, w, false); w = __builtin_amdgcn_cvt_pk_fp8_f32(v[b][j].z * inv, v[b][j].w * inv, w, true); o[j] = (unsigned)w; }
        *(GAS u32x4*)dst16[b] = o;
        if (lane == 0) *(GAS float*)scale_out[b] = sc; }
}
__device__ __forceinline__ void convert_tables(const Frame& F, const Args& A, int wi, int nw) {
    unsigned char* ws = A.ws; const int gw = wi, NGW = nw;
    int mc = gw;
    for (; mc + 3 * NGW < 2 * NEXP; mc += 4 * NGW) { const int m = mc;
        const float* src[4]; unsigned char* dst[4]; float* sco[4];
#pragma unroll
        for (int b = 0; b < 4; ++b) { const int mm = m + b * NGW;
            if (mm < NEXP) { const int e = mm; src[b] = A.in[I_PU] + (size_t)e * D; dst[b] = ws + WS_U8 + (size_t)((e & (UNG - 1)) * (NEXP / UNG) + (e >> UNG_SH)) * 1024 + 16 * F.lane; sco[b] = (float*)(ws + WS_SU) + e; }
            else { const int e = mm - NEXP; src[b] = A.in[I_PV] + (size_t)e * D; dst[b] = ws + WS_V8 + ((size_t)(F.lane >> 3) * NEXP + e) * 128 + 16 * (F.lane & 7); sco[b] = (float*)(ws + WS_SV) + e; } }
        cvt_rows_fp8<4>(F.lane, src, dst, sco);
    }
    for (; mc < 2 * NEXP; mc += NGW) { const float* src[1]; unsigned char* dst[1]; float* sco[1];
        if (mc < NEXP) { const int e = mc; src[0] = A.in[I_PU] + (size_t)e * D; dst[0] = ws + WS_U8 + (size_t)((e & (UNG - 1)) * (NEXP / UNG) + (e >> UNG_SH)) * 1024 + 16 * F.lane; sco[0] = (float*)(ws + WS_SU) + e; }
        else { const int e = mc - NEXP; src[0] = A.in[I_PV] + (size_t)e * D; dst[0] = ws + WS_V8 + ((size_t)(F.lane >> 3) * NEXP + e) * 128 + 16 * (F.lane & 7); sco[0] = (float*)(ws + WS_SV) + e; }
        cvt_rows_fp8<1>(F.lane, src, dst, sco); }
}
__device__ __forceinline__ void phase0(const Frame& F, const Args& A) {
    unsigned char* ws = A.ws;
    {
        LAS float* kx = (LAS float*)F.lds;
        LAS float* wt = (LAS float*)(F.lds + 128 * 129 * 4);
        bf16_t* WQF = (bf16_t*)(ws + WS_WQF);
        for (int it = F.bid; it < 512; it += F.G) {
            const int hh = it >> 5, kblk = it & 31, k0 = kblk * 32;
            const float* kX = (hh & 1) ? A.in[I_K2] : A.in[I_K1];
            __syncthreads();
            for (int e = F.tid; e < 128 * 128; e += 512) kx[(e >> 7) * 129 + (e & 127)] = kX[e];
            for (int e = F.tid; e < 32 * 128; e += 512) wt[e] = A.in[I_WQ][(size_t)(k0 + (e >> 7)) * 2048 + hh * 128 + (e & 127)];
            __syncthreads();
            const int key = F.tid & 127, kq = F.tid >> 7;
            float acc[8];
#pragma unroll
            for (int i = 0; i < 8; ++i) acc[i] = 0.f;
            for (int d = 0; d < 128; ++d) { const float b = kx[key * 129 + d];
#pragma unroll
                for (int i = 0; i < 8; ++i) acc[i] += wt[(kq * 8 + i) * 128 + d] * b; }
            u32x4 o; o.x = pk2(acc[0], acc[1]); o.y = pk2(acc[2], acc[3]); o.z = pk2(acc[4], acc[5]); o.w = pk2(acc[6], acc[7]);
            *(u32x4*)(WQF + (size_t)(hh * 128 + key) * 1024 + k0 + kq * 8) = o;
        }
        __syncthreads();
    }
    LAS float* scr = (LAS float*)(F.lds + F.wave * 16384);
    const int gw = F.bid * NWAVES + F.wave, NGW = F.G * NWAVES;
    constexpr int I_IN = 16 * (NPROJ / 32), I_A = 8 * 32, I_B = 8 * 32, I_O = 16 * 32;
    constexpr int NITEMS = I_IN + I_A + I_B + I_O;
    for (int it = gw; it < NITEMS; it += NGW) {
        int r = it;
        if (r < I_IN) { p0_transpose_item<1, true>(A.in[I_WIN], 1024, 5136, NPROJ, (bf16_t*)(ws + WS_WIN), scr, r, F.lane, 1024.f); continue; } r -= I_IN;
        if (r < I_A) { p0_transpose_item<0>(A.in[I_WBA], 512, 1024, 1024, (bf16_t*)(ws + WS_WA), scr, r, F.lane); continue; } r -= I_A;
        if (r < I_B) { p0_transpose_item<0>(A.in[I_WBB], 512, 1024, 1024, (bf16_t*)(ws + WS_WB), scr, r, F.lane); continue; } r -= I_B;
        p0_transpose_item<0>(A.in[I_WOUT], 1024, 1024, 1024, (bf16_t*)(ws + WS_WOUT), scr, r, F.lane);
    }
    { int m = gw; for (; m + 3 * NGW < T_TOK; m += 4 * NGW) rms_rows_to_bf16<2, 4>(F.lane, A.in[I_X] + (size_t)m * D, (size_t)NGW * D, A.in[I_N1G], nullptr, 0, (unsigned*)(ws + WS_N1) + (size_t)m * 256, (size_t)NGW * 256);
      for (; m < T_TOK; m += NGW) rms_rows_to_bf16<2, 1>(F.lane, A.in[I_X] + (size_t)m * D, 0, A.in[I_N1G], nullptr, 0, (unsigned*)(ws + WS_N1) + (size_t)m * 256, 0); }
}

__device__ __forceinline__ float log_sigmoid(float z) { return fminf(z, 0.f) - log1pf(__expf(-fabsf(z))); }

template <bool DRY>
__device__ __forceinline__ void gla_chunk_phase(const Frame& F, const Args& A) {
    unsigned char* ws = A.ws;
    const bf16_t* P = (const bf16_t*)(ws + WS_P);
    const float* ALR = (const float*)(ws + WS_ALR);
    LAS float* alr = (LAS float*)F.lds;
    LAS float* tot = (LAS float*)(F.lds + 4096);
    LAS bf16_t* kdT = (LAS bf16_t*)(F.lds + 8192);
    LAS bf16_t* vT = (LAS bf16_t*)(F.lds + 26624);
    LAS bf16_t* stT = (LAS bf16_t*)(F.lds + 45056);
    const int tid = F.tid, kk = tid & 127, seg = tid >> 7;
    const bool hconst = (F.G & 3) == 0;
    int hcur = -1; float w[16]; float bias = 0.f;
#pragma unroll
    for (int j = 0; j < 16; ++j) w[j] = 0.f;
    float na0, na1; bf16_t nk[16], nv[16];
#define GC_LOAD(unit) do { const int h_ = (unit) & 3, c_ = ((unit) >> 2) & 63, b_ = (unit) >> 8; const int t0_ = b_ * SEQ + c_ * 64; \
        na0 = ALR[(size_t)t0_ * 16 + tid]; na1 = ALR[(size_t)t0_ * 16 + 512 + tid]; \
        const bf16_t* kp_ = P + (size_t)(t0_ + 16 * seg) * PLD + PC_K + h_ * 128 + kk; const bf16_t* vp_ = P + (size_t)(t0_ + 16 * seg) * PLD + PC_V + h_ * 128 + kk; \
        _Pragma("unroll") for (int i_ = 0; i_ < 16; ++i_) { nk[i_] = kp_[(size_t)i_ * PLD]; nv[i_] = vp_[(size_t)i_ * PLD]; } } while (0)
    int unit = F.bid;
    if (unit < 2048) GC_LOAD(unit);
    for (; unit < 2048; unit += F.G) {
        const int h = unit & 3;
        if (h != hcur) { hcur = h;
#pragma unroll
            for (int j = 0; j < 16; ++j) w[j] = A.in[I_WGU][(size_t)j * 512 + h * 128 + kk];
            bias = A.in[I_BG][h * 128 + kk]; }
        __syncthreads();
        alr[tid] = na0; alr[512 + tid] = na1;
        bf16_t kr[16], vr[16];
#pragma unroll
        for (int i = 0; i < 16; ++i) { kr[i] = nk[i]; vr[i] = nv[i]; }
        if (unit + F.G < 2048) GC_LOAD(unit + F.G);
        __syncthreads();
        float cum[16]; float run = 0.f;
#pragma unroll
        for (int i = 0; i < 16; ++i) { const LAS f32x4* ap = (const LAS f32x4*)(alr + (16 * seg + i) * 16); float z = bias;
#pragma unroll
            for (int q = 0; q < 4; ++q) { const f32x4 a4 = ap[q]; z += a4.x * w[4 * q] + a4.y * w[4 * q + 1] + a4.z * w[4 * q + 2] + a4.w * w[4 * q + 3]; }
            const float ls = fminf(z, 0.f) - __logf(1.f + __expf(-fabsf(z)));
            run += ls * (1.f / 16.f); cum[i] = run; }
        tot[seg * 128 + kk] = run;
        __syncthreads();
        {
            const float t0s = tot[kk], t1s = tot[128 + kk], t2s = tot[256 + kk], t3s = tot[384 + kk];
            const float total = (t0s + t1s) + (t2s + t3s);
            const float prefix = seg == 0 ? 0.f : (seg == 1 ? t0s : (seg == 2 ? t0s + t1s : t0s + t1s + t2s));
            unsigned kw[8], vw[8];
#pragma unroll
            for (int i = 0; i < 8; ++i) {
                const float e0 = __expf(total - (prefix + cum[2 * i])), e1 = __expf(total - (prefix + cum[2 * i + 1]));
                kw[i] = pk2(bf1(kr[2 * i]) * e0, bf1(kr[2 * i + 1]) * e1); vw[i] = (unsigned)vr[2 * i] | ((unsigned)vr[2 * i + 1] << 16);
            }
            *(LAS u32x4*)(kdT + kk * 72 + 16 * seg) = (u32x4){kw[0], kw[1], kw[2], kw[3]}; *(LAS u32x4*)(kdT + kk * 72 + 16 * seg + 8) = (u32x4){kw[4], kw[5], kw[6], kw[7]};
            *(LAS u32x4*)(vT + kk * 72 + 16 * seg) = (u32x4){vw[0], vw[1], vw[2], vw[3]}; *(LAS u32x4*)(vT + kk * 72 + 16 * seg + 8) = (u32x4){vw[4], vw[5], vw[6], vw[7]};
            if (seg == 0) ((float*)(DRY ? (unsigned char*)A.out + 96 * MiB : ws + WS_DEC))[(size_t)unit * 128 + kk] = __expf(total);
        }
        __syncthreads();
        {
            const int w8 = F.wave, l = F.lane, fr = l & 15, fq = l >> 4;
            f32x4 acc[8];
#pragma unroll
            for (int n = 0; n < 8; ++n) acc[n] = (f32x4){0.f, 0.f, 0.f, 0.f};
#pragma unroll
            for (int ks = 0; ks < 2; ++ks) {
                const bf16x8 a = *(const LAS bf16x8*)(kdT + (16 * w8 + fr) * 72 + 32 * ks + 8 * fq);
#pragma unroll
                for (int n = 0; n < 8; ++n) { const bf16x8 bb = *(const LAS bf16x8*)(vT + (16 * n + fr) * 72 + 32 * ks + 8 * fq);
                    acc[n] = __builtin_amdgcn_mfma_f32_16x16x32_bf16(a, bb, acc[n], 0, 0, 0); }
            }
#pragma unroll
            for (int n = 0; n < 8; ++n) { u32x2 o; o.x = pk2(acc[n][0], acc[n][1]); o.y = pk2(acc[n][2], acc[n][3]);
                *(LAS u32x2*)(stT + (16 * n + fr) * 136 + 16 * w8 + 4 * fq) = o; }
        }
        __syncthreads();
        {
            bf16_t* ST = (bf16_t*)(DRY ? (unsigned char*)A.out : ws + WS_N1) + (size_t)unit * 16384;
            const int vv = tid >> 2, part = tid & 3;
#pragma unroll
            for (int q = 0; q < 4; ++q) *(u32x4*)(ST + (size_t)vv * 128 + 32 * part + 8 * q) = *(const LAS u32x4*)(stT + vv * 136 + 32 * part + 8 * q);
        }
    }
#undef GC_LOAD
    (void)hconst;
}

template <bool DRY>
__device__ __forceinline__ void sgu_unit(const Frame& F, const Args& A, int unit) {
    const int g = unit & 3, blk = (unit >> 2) & 31, b = unit >> 7;
    const int t0 = b * SEQ + blk * 128;
    bf16_t* P = (bf16_t*)(A.ws + WS_P);
    LAS bf16_t* wA = (LAS bf16_t*)F.lds;
    LAS bf16_t* vnT = (LAS bf16_t*)(F.lds + 34816);
    LAS float* st = (LAS float*)(F.lds + 69632);
    LAS bf16_t* suS = (LAS bf16_t*)(F.lds + 70656);
    const int tid = F.tid;
    __syncthreads();
    {
        const int j = tid >> 2, q = tid & 3;
        const bf16_t* sp = P + (size_t)(t0 + j) * PLD + PC_SV + q * 128;
        float s = 0.f, s2 = 0.f;
#pragma unroll
        for (int i = 0; i < 16; ++i) { const u32x4 w = *(const u32x4*)(sp + 8 * i);
            const float f[8] = {bflo(w.x), bfhi(w.x), bflo(w.y), bfhi(w.y), bflo(w.z), bfhi(w.z), bflo(w.w), bfhi(w.w)};
#pragma unroll
            for (int e = 0; e < 8; ++e) { s += f[e]; s2 += f[e] * f[e]; } }
        s += __shfl_xor(s, 1); s += __shfl_xor(s, 2); s2 += __shfl_xor(s2, 1); s2 += __shfl_xor(s2, 2);
        const float mu = s * (1.f / 512.f); const float var = fmaxf(s2 * (1.f / 512.f) - mu * mu, 0.f);
        if (q == 0) { st[2 * j] = mu; st[2 * j + 1] = 1.f / sqrtf(var + EPS); }
    }
    {
        const int i = tid >> 2, jb = (tid & 3) * 32;
        const float* wp = A.in[I_SW] + (size_t)g * 16384 + (size_t)i * 128 + jb;
        const bf16_t* sup = P + (size_t)(t0 + i) * PLD + PC_SU + g * 128 + jb;
#pragma unroll
        for (int q = 0; q < 4; ++q) { const f32x4 a = *(const f32x4*)(wp + 8 * q), bq = *(const f32x4*)(wp + 8 * q + 4);
            const bool z = (i < 64) && (jb + 8 * q >= 64);
            u32x4 o; o.x = pk2(a.x, a.y); o.y = pk2(a.z, a.w); o.z = pk2(bq.x, bq.y); o.w = pk2(bq.z, bq.w);
            if (z) o = (u32x4){0u, 0u, 0u, 0u};
            *(LAS u32x4*)(wA + i * 136 + jb + 8 * q) = o;
            *(LAS u32x4*)(suS + i * 136 + jb + 8 * q) = *(const u32x4*)(sup + 8 * q); }
    }
    const int cch = tid & 127, seg = tid >> 7;
    bf16_t xr[32];
    { const bf16_t* sp = P + (size_t)(t0 + 32 * seg) * PLD + PC_SV + g * 128 + cch;
#pragma unroll
      for (int i = 0; i < 32; ++i) xr[i] = sp[(size_t)i * PLD]; }
    const float lg = A.in[I_SLNG][g * 128 + cch], lb = A.in[I_SLNB][g * 128 + cch];
    __syncthreads();
    {
        unsigned ow[16];
#pragma unroll
        for (int i = 0; i < 16; ++i) { const int j = 32 * seg + 2 * i; const f32x4 ms = *(const LAS f32x4*)(st + 2 * j);
            ow[i] = pk2((bf1(xr[2 * i]) - ms.x) * ms.y * lg + lb, (bf1(xr[2 * i + 1]) - ms.z) * ms.w * lg + lb); }
#pragma unroll
        for (int q = 0; q < 4; ++q) *(LAS u32x4*)(vnT + cch * 136 + 32 * seg + 8 * q) = (u32x4){ow[4 * q], ow[4 * q + 1], ow[4 * q + 2], ow[4 * q + 3]};
    }
    __syncthreads();
    {
        const int w = F.wave, l = F.lane, fr = l & 15, fq = l >> 4;
        f32x4 acc[8];
#pragma unroll
        for (int n = 0; n < 8; ++n) acc[n] = (f32x4){0.f, 0.f, 0.f, 0.f};
#pragma unroll
        for (int ks = 0; ks < 4; ++ks) {
            const bf16x8 a = *(const LAS bf16x8*)(wA + (16 * w + fr) * 136 + 32 * ks + 8 * fq);
#pragma unroll
            for (int n = 0; n < 8; ++n) { const bf16x8 bb = *(const LAS bf16x8*)(vnT + (16 * n + fr) * 136 + 32 * ks + 8 * fq);
                acc[n] = __builtin_amdgcn_mfma_f32_16x16x32_bf16(a, bb, acc[n], 0, 0, 0); }
        }
#pragma unroll
        for (int jj = 0; jj < 4; ++jj) { const int i = 16 * w + 4 * fq + jj; const float bias = A.in[I_SB][g * 128 + i];
            LAS bf16_t* rp = suS + i * 136 + fr;
#pragma unroll
            for (int n = 0; n < 8; ++n) { const float su = bf1(rp[16 * n]); rp[16 * n] = (bf16_t)f2bf(su * (acc[n][jj] + bias)); } }
    }
    __syncthreads();
    {
        const int i = tid >> 2, jb = (tid & 3) * 32;
        bf16_t* yp = DRY ? (bf16_t*)A.out + (size_t)(t0 + i) * 512 + g * 128 + jb : P + (size_t)(t0 + i) * PLD + PC_SU + g * 128 + jb;
#pragma unroll
        for (int q = 0; q < 4; ++q) *(u32x4*)(yp + 8 * q) = *(const LAS u32x4*)(suS + i * 136 + jb + 8 * q);
    }
}

template <bool DRY>
__device__ __forceinline__ void gla_scan(const Frame& F, const Args& A) {
    bf16_t* ST = (bf16_t*)(A.ws + WS_N1); bf16_t* STO = DRY ? (bf16_t*)A.out : ST; const float* DEC = (const float*)(A.ws + WS_DEC);
    for (int gi = F.bid * 512 + F.tid; gi < 131072; gi += F.G * 512) {
        const int k4 = gi & 31, vv = (gi >> 5) & 127, h = (gi >> 12) & 3, b = gi >> 14;
        float s0 = 0.f, s1 = 0.f, s2 = 0.f, s3 = 0.f;
        u32x2 wa[8], wb[8]; f32x4 da[8], db[8];
#define SCAN_LOAD(W, Dd, c0) do { _Pragma("unroll") for (int i_ = 0; i_ < 8; ++i_) { const size_t u_ = (size_t)((b * 64 + (c0) + i_) * 4 + h); \
            W[i_] = *(const u32x2*)(ST + u_ * 16384 + (size_t)vv * 128 + k4 * 4); Dd[i_] = *(const f32x4*)(DEC + u_ * 128 + k4 * 4); } } while (0)
#define SCAN_STEP(W, Dd, c0) do { _Pragma("unroll") for (int i_ = 0; i_ < 8; ++i_) { const size_t u_ = (size_t)((b * 64 + (c0) + i_) * 4 + h); \
            s0 = Dd[i_].x * s0 + bflo(W[i_].x); s1 = Dd[i_].y * s1 + bfhi(W[i_].x); s2 = Dd[i_].z * s2 + bflo(W[i_].y); s3 = Dd[i_].w * s3 + bfhi(W[i_].y); \
            u32x2 o_; o_.x = pk2(s0, s1); o_.y = pk2(s2, s3); *(u32x2*)(STO + u_ * 16384 + (size_t)vv * 128 + k4 * 4) = o_; } } while (0)
        SCAN_LOAD(wa, da, 0);
#pragma unroll
        for (int c0 = 0; c0 < 64; c0 += 16) {
            SCAN_LOAD(wb, db, c0 + 8);
            SCAN_STEP(wa, da, c0);
            if (c0 + 16 < 64) SCAN_LOAD(wa, da, c0 + 16);
            SCAN_STEP(wb, db, c0 + 8);
        }
#undef SCAN_LOAD
#undef SCAN_STEP
    }
}

template <bool DRY>
__device__ __forceinline__ void gla_out_phase(const Frame& F, const Args& A) {
    bf16_t* P = (bf16_t*)(A.ws + WS_P);
    LAS bf16_t* qA = (LAS bf16_t*)F.lds;
    LAS bf16_t* sB = (LAS bf16_t*)(F.lds + 17408);
    LAS float* oF = (LAS float*)(F.lds + 52224);
    const int tid = F.tid, s = tid >> 3, cb = (tid & 7) * 16, vv = tid >> 2, kb = (tid & 3) * 32;
    u32x4 nq0, nq1, ns0, ns1, ns2, ns3, nr0, nr1;
#define GO_LOAD(unit) do { const int h_ = (unit) & 3, c_ = ((unit) >> 2) & 63, b_ = (unit) >> 8; const int t0_ = b_ * SEQ + c_ * 64; \
        const bf16_t* qp_ = P + (size_t)(t0_ + s) * PLD + PC_Q + h_ * 128 + cb; nq0 = *(const u32x4*)qp_; nq1 = *(const u32x4*)(qp_ + 8); \
        const bf16_t* sp_ = (const bf16_t*)(A.ws + WS_N1) + (size_t)(unit) * 16384 + (size_t)vv * 128 + kb; ns0 = *(const u32x4*)sp_; ns1 = *(const u32x4*)(sp_ + 8); ns2 = *(const u32x4*)(sp_ + 16); ns3 = *(const u32x4*)(sp_ + 24); \
        const bf16_t* rp_ = P + (size_t)(t0_ + s) * PLD + PC_R + h_ * 128 + cb; nr0 = *(const u32x4*)rp_; nr1 = *(const u32x4*)(rp_ + 8); } while (0)
    int unit = F.bid;
    if (unit < 2048) GO_LOAD(unit);
    for (; unit < 2048; unit += F.G) {
        const int h = unit & 3, c = (unit >> 2) & 63, b = unit >> 8;
        const int t0 = b * SEQ + c * 64;
        __syncthreads();
        *(LAS u32x4*)(qA + s * 136 + cb) = nq0; *(LAS u32x4*)(qA + s * 136 + cb + 8) = nq1;
        *(LAS u32x4*)(sB + vv * 136 + kb) = ns0; *(LAS u32x4*)(sB + vv * 136 + kb + 8) = ns1; *(LAS u32x4*)(sB + vv * 136 + kb + 16) = ns2; *(LAS u32x4*)(sB + vv * 136 + kb + 24) = ns3;
        const u32x4 r0 = nr0, r1 = nr1;
        if (unit + F.G < 2048) GO_LOAD(unit + F.G);
        __syncthreads();
        {
            const int w = F.wave, l = F.lane, fr = l & 15, fq = l >> 4, m = w & 3, nh = w >> 2;
            f32x4 acc[4];
#pragma unroll
            for (int n = 0; n < 4; ++n) acc[n] = (f32x4){0.f, 0.f, 0.f, 0.f};
#pragma unroll
            for (int ks = 0; ks < 4; ++ks) {
                const bf16x8 a = *(const LAS bf16x8*)(qA + (16 * m + fr) * 136 + 32 * ks + 8 * fq);
#pragma unroll
                for (int n = 0; n < 4; ++n) { const bf16x8 bb = *(const LAS bf16x8*)(sB + (16 * (4 * nh + n) + fr) * 136 + 32 * ks + 8 * fq);
                    acc[n] = __builtin_amdgcn_mfma_f32_16x16x32_bf16(a, bb, acc[n], 0, 0, 0); }
            }
            const float scale = 0.08838834764831845f;
#pragma unroll
            for (int n = 0; n < 4; ++n)
#pragma unroll
                for (int jj = 0; jj < 4; ++jj) oF[(16 * m + 4 * fq + jj) * 132 + 16 * (4 * nh + n) + fr] = acc[n][jj] * scale;
        }
        __syncthreads();
        {
            float o[16]; float ss = 0.f;
#pragma unroll
            for (int i = 0; i < 16; ++i) { o[i] = oF[s * 132 + cb + i]; ss += o[i] * o[i]; }
            ss += __shfl_xor(ss, 1); ss += __shfl_xor(ss, 2); ss += __shfl_xor(ss, 4);
            const float rstd = 1.f / sqrtf(ss * (1.f / 128.f) + EPS);
            const unsigned rw[8] = {r0.x, r0.y, r0.z, r0.w, r1.x, r1.y, r1.z, r1.w};
            const float* gg = A.in[I_GLAG] + h * 128 + cb;
            unsigned ow[8];
#pragma unroll
            for (int i = 0; i < 8; ++i) { const float y0 = o[2 * i] * rstd * gg[2 * i] * siluf_(bflo(rw[i])), y1 = o[2 * i + 1] * rstd * gg[2 * i + 1] * siluf_(bfhi(rw[i])); ow[i] = pk2(y0, y1); }
            bf16_t* yp = DRY ? (bf16_t*)A.out + (size_t)(t0 + s) * 512 + h * 128 + cb : P + (size_t)(t0 + s) * PLD + PC_Q + h * 128 + cb;
            *(u32x4*)yp = (u32x4){ow[0], ow[1], ow[2], ow[3]}; *(u32x4*)(yp + 8) = (u32x4){ow[4], ow[5], ow[6], ow[7]};
        }
    }
#undef GO_LOAD
}

__device__ __forceinline__ unsigned ordkey(float v) { const unsigned u = __builtin_bit_cast(unsigned, v); return u ^ ((unsigned)((int)u >> 31) | 0x80000000u); }
__device__ __forceinline__ float unord(unsigned k) { const unsigned u = (k & 0x80000000u) ? (k & 0x7fffffffu) : ~k; return __builtin_bit_cast(float, u); }
#define INS16(r, xin) do { unsigned _x = (xin); _Pragma("unroll") for (int _i = 0; _i < 16; ++_i) { const unsigned _h = max((r)[_i], _x); _x = min((r)[_i], _x); (r)[_i] = _h; } } while (0)

#define CE(a, b) do { const unsigned _h = max((a), (b)), _l = min((a), (b)); (a) = _h; (b) = _l; } while (0)
#define SORT16(v) do { CE(v[0], v[1]); CE(v[2], v[3]); CE(v[0], v[2]); CE(v[1], v[3]); CE(v[1], v[2]); CE(v[4], v[5]); CE(v[6], v[7]); CE(v[4], v[6]); CE(v[5], v[7]); CE(v[5], v[6]); CE(v[0], v[4]); CE(v[2], v[6]); CE(v[2], v[4]); CE(v[1], v[5]); CE(v[3], v[7]); CE(v[3], v[5]); CE(v[1], v[2]); CE(v[3], v[4]); CE(v[5], v[6]); CE(v[8], v[9]); CE(v[10], v[11]); CE(v[8], v[10]); CE(v[9], v[11]); CE(v[9], v[10]); CE(v[12], v[13]); CE(v[14], v[15]); CE(v[12], v[14]); CE(v[13], v[15]); CE(v[13], v[14]); CE(v[8], v[12]); CE(v[10], v[14]); CE(v[10], v[12]); CE(v[9], v[13]); CE(v[11], v[15]); CE(v[11], v[13]); CE(v[9], v[10]); CE(v[11], v[12]); CE(v[13], v[14]); CE(v[0], v[8]); CE(v[4], v[12]); CE(v[4], v[8]); CE(v[2], v[10]); CE(v[6], v[14]); CE(v[6], v[10]); CE(v[2], v[4]); CE(v[6], v[8]); CE(v[10], v[12]); CE(v[1], v[9]); CE(v[5], v[13]); CE(v[5], v[9]); CE(v[3], v[11]); CE(v[7], v[15]); CE(v[7], v[11]); CE(v[3], v[5]); CE(v[7], v[9]); CE(v[11], v[13]); CE(v[1], v[2]); CE(v[3], v[4]); CE(v[5], v[6]); CE(v[7], v[8]); CE(v[9], v[10]); CE(v[11], v[12]); CE(v[13], v[14]); } while (0)
#define MERGE16(T, S) do { _Pragma("unroll") for (int _i = 0; _i < 16; ++_i) (T)[_i] = max((T)[_i], (S)[15 - _i]); \
    _Pragma("unroll") for (int _d = 8; _d >= 1; _d >>= 1) { _Pragma("unroll") for (int _i = 0; _i < 16; ++_i) if ((_i & _d) == 0) CE((T)[_i], (T)[_i + _d]); } } while (0)
__device__ __forceinline__ void peer_topk(const Frame& F, const Args& A) {
    const float* SC = (const float*)(A.ws + WS_P + P_SC);
    int* IDX = (int*)(A.ws + WS_P + P_IDX); float* GATE = (float*)(A.ws + WS_P + P_GATE);
    const int gw = F.bid * NWAVES + F.wave, NGW = F.G * NWAVES;
    for (int it = gw; it < 512 * 8; it += NGW) {
        const int h = it & 7, tb = it >> 3; const int tok = tb * 64 + F.lane;
        unsigned r1[16], r2[16], rc[16];
        const float* p1 = SC + ((size_t)(tok >> 4) * 512 + h * 64) * 64 + (tok & 15) * 4; const float* p2 = p1 + 32 * 64;
        {
            float raw[128]; unsigned sg[16];
#pragma unroll
            for (int jq = 0; jq < 32; ++jq) { const f32x4 t4 = *(const f32x4*)(p1 + jq * 64); raw[4 * jq] = t4.x; raw[4 * jq + 1] = t4.y; raw[4 * jq + 2] = t4.z; raw[4 * jq + 3] = t4.w; }
#pragma unroll
            for (int j = 0; j < 16; ++j) r1[j] = (ordkey(raw[j]) & ~127u) | (unsigned)(127 - j);
            SORT16(r1);
#pragma unroll
            for (int gq = 1; gq < 8; ++gq) {
#pragma unroll
                for (int j = 0; j < 16; ++j) sg[j] = (ordkey(raw[16 * gq + j]) & ~127u) | (unsigned)(127 - (16 * gq + j));
                SORT16(sg); MERGE16(r1, sg); }
#pragma unroll
            for (int jq = 0; jq < 32; ++jq) { const f32x4 t4 = *(const f32x4*)(p2 + jq * 64); raw[4 * jq] = t4.x; raw[4 * jq + 1] = t4.y; raw[4 * jq + 2] = t4.z; raw[4 * jq + 3] = t4.w; }
#pragma unroll
            for (int j = 0; j < 16; ++j) r2[j] = (ordkey(raw[j]) & ~127u) | (unsigned)(127 - j);
            SORT16(r2);
#pragma unroll
            for (int gq = 1; gq < 8; ++gq) {
#pragma unroll
                for (int j = 0; j < 16; ++j) sg[j] = (ordkey(raw[16 * gq + j]) & ~127u) | (unsigned)(127 - (16 * gq + j));
                SORT16(sg); MERGE16(r2, sg); }
        }
        float v1[16], v2[16];
#pragma unroll
        for (int i = 0; i < 16; ++i) { v1[i] = unord((r1[i] & ~127u) | 64u); v2[i] = unord((r2[i] & ~127u) | 64u); }
        {
            unsigned cg[4][16]; int cn = 0;
#pragma unroll
            for (int a = 0; a < 16; ++a)
#pragma unroll
                for (int bq = 0; bq < 16; ++bq) if ((a + 1) * (bq + 1) <= 16) { cg[cn >> 4][cn & 15] = (ordkey(v1[a] + v2[bq]) & ~255u) | (unsigned)(a * 16 + bq); ++cn; }
#pragma unroll
            for (int z = 50; z < 64; ++z) cg[z >> 4][z & 15] = 0u;
            SORT16(cg[0]); SORT16(cg[1]); SORT16(cg[2]); SORT16(cg[3]);
            MERGE16(cg[0], cg[1]); MERGE16(cg[0], cg[2]); MERGE16(cg[0], cg[3]);
#pragma unroll
            for (int i = 0; i < 16; ++i) rc[i] = cg[0][i];
        }
        float val[16]; int ex[16];
        {
            LAS unsigned* t1 = (LAS unsigned*)(F.lds + F.wave * 8704) + F.lane * 17; LAS unsigned* t2 = t1 + 64 * 17;
#pragma unroll
            for (int i = 0; i < 16; ++i) { t1[i] = r1[i]; t2[i] = r2[i]; }
            LDS_WAIT(); asm volatile("" ::: "memory");
#pragma unroll
            for (int w = 0; w < 16; ++w) {
                const int a = (rc[w] >> 4) & 15, bq = rc[w] & 15;
                const unsigned k1 = t1[a], k2 = t2[bq];
                val[w] = unord((k1 & ~127u) | 64u) + unord((k2 & ~127u) | 64u);
                ex[w] = (127 - (int)(k1 & 127u)) * 128 + (127 - (int)(k2 & 127u));
            }
            LDS_WAIT(); asm volatile("" ::: "memory");
        }
        float mx = val[0];
#pragma unroll
        for (int w = 1; w < 16; ++w) mx = fmaxf(mx, val[w]);
        float sum = 0.f;
#pragma unroll
        for (int w = 0; w < 16; ++w) { val[w] = __expf(val[w] - mx); sum += val[w]; }
        const float inv = 1.f / sum;
        int* ip = IDX + (size_t)tok * 128 + h * 16; float* gp = GATE + (size_t)tok * 128 + h * 16;
#pragma unroll
        for (int q = 0; q < 4; ++q) { *(int4*)(ip + 4 * q) = make_int4(ex[4 * q], ex[4 * q + 1], ex[4 * q + 2], ex[4 * q + 3]);
            *(f32x4*)(gp + 4 * q) = (f32x4){val[4 * q] * inv, val[4 * q + 1] * inv, val[4 * q + 2] * inv, val[4 * q + 3] * inv}; }
    }
}

#define DPP_ADD(v, ctrl) ((v) + __builtin_bit_cast(float, __builtin_amdgcn_mov_dpp(__builtin_bit_cast(int, (v)), (ctrl), 0xf, 0xf, true)))
__device__ __forceinline__ void fp8x16_to_f32x2(const u32x4 r, f32x2* f) {
#pragma unroll
    for (int q = 0; q < 4; ++q) { f[2 * q] = __builtin_amdgcn_cvt_pk_f32_fp8((int)r[q], false); f[2 * q + 1] = __builtin_amdgcn_cvt_pk_f32_fp8((int)r[q], true); }
}
__device__ __forceinline__ void fp8x16_to_f32(const u32x4 r, float* f) {
#pragma unroll
    for (int q = 0; q < 4; ++q) { const f32x2 lo = __builtin_amdgcn_cvt_pk_f32_fp8((int)r[q], false), hi = __builtin_amdgcn_cvt_pk_f32_fp8((int)r[q], true);
        f[4 * q] = lo.x; f[4 * q + 1] = lo.y; f[4 * q + 2] = hi.x; f[4 * q + 3] = hi.y; }
}
__device__ __forceinline__ long lo64(u32x4 v) { return (long)(((unsigned long)v.y << 32) | (unsigned long)v.x); }
__device__ __forceinline__ long hi64(u32x4 v) { return (long)(((unsigned long)v.w << 32) | (unsigned long)v.z); }
template <int MODE>
__device__ __forceinline__ void peer_u_phase(const Frame& F, const Args& A) {
    const unsigned char* X8 = A.ws + WS_P + P_X8;
    const unsigned char* U8 = A.ws + WS_U8; const float* SU = (const float*)(A.ws + WS_SU); const float* SV = (const float*)(A.ws + WS_SV);
    const int* IDX = (const int*)(A.ws + WS_P + P_IDX); const float* GATE = (const float*)(A.ws + WS_P + P_GATE); float* AK = (float*)(MODE == 0 ? A.ws + WS_AK : A.ws + WS_P + P_SC);
    const int g = F.bid & 7, nmem = F.G >> 3, l = F.lane, step = nmem * NWAVES;
    const int loff = 64 * (l & 15) + 16 * (l >> 4);
    const bool dg = ((l & 15) >> 2) == (l >> 4); const int dr = l & 3;
    const float dw0 = (dg && dr == 0) ? 1.f : 0.f, dw1 = (dg && dr == 1) ? 1.f : 0.f, dw2 = (dg && dr == 2) ? 1.f : 0.f, dw3 = (dg && dr == 3) ? 1.f : 0.f;
    LAS int* le = (LAS int*)(F.lds + F.wave * 2048); LAS int* lk = le + 256;
    const bool b5 = (l & 32) != 0, b4 = (l & 16) != 0, b3 = (l & 8) != 0;
    int tok = 2 * ((F.bid >> 3) * NWAVES + F.wave);
    u32x4 nxA, nxB; int neA0, neA1, neB0, neB1; float ngA0, ngA1, ngB0, ngB1;
#define U_PREFETCH(t) do { const size_t _tA = (size_t)(t), _tB = (size_t)(t) + 1; if (MODE == 4) { nxA = (u32x4){(unsigned)_tA, 1u, 2u, 3u}; nxB = nxA; neA0 = (int)((_tA * 37 + l * 11) & 16383); neA1 = (int)((_tA * 53 + l * 7) & 16383); neB0 = (int)((_tB * 37 + l * 13) & 16383); neB1 = (int)((_tB * 29 + l * 3) & 16383); ngA0 = ngA1 = ngB0 = ngB1 = 0.01f; break; } nxA = *(const u32x4*)(X8 + _tA * 1024 + loff); nxB = *(const u32x4*)(X8 + _tB * 1024 + loff); \
        neA0 = IDX[_tA * 128 + l]; neA1 = IDX[_tA * 128 + 64 + l]; neB0 = IDX[_tB * 128 + l]; neB1 = IDX[_tB * 128 + 64 + l]; \
        ngA0 = GATE[_tA * 128 + l]; ngA1 = GATE[_tA * 128 + 64 + l]; ngB0 = GATE[_tB * 128 + l]; ngB1 = GATE[_tB * 128 + 64 + l]; } while (0)
    if (tok + 1 < T_TOK) U_PREFETCH(tok);
    for (; tok + 1 < T_TOK; tok += 2 * step) {
        const int tokA = tok, tokB = tok + 1;
        const u32x4 xA = nxA, xB = nxB;
        const int eA0 = neA0, eA1 = neA1, eB0 = neB0, eB1 = neB1; const float gA0 = ngA0, gA1 = ngA1, gB0 = ngB0, gB1 = ngB1;
        bool pf_done = false;
        const bool oA0 = (eA0 & 7) == g, oA1 = (eA1 & 7) == g, oB0 = (eB0 & 7) == g, oB1 = (eB1 & 7) == g;
        const unsigned long long mA0 = __ballot(oA0), mA1 = __ballot(oA1), mB0 = __ballot(oB0), mB1 = __ballot(oB1);
        const int c0 = __popcll(mA0), c1 = c0 + __popcll(mA1), c2 = c1 + __popcll(mB0), n = c2 + __popcll(mB1);
#define MBC(m) __builtin_amdgcn_mbcnt_hi((unsigned)((m) >> 32), __builtin_amdgcn_mbcnt_lo((unsigned)(m), 0u))
        if (oA0) { const int p = MBC(mA0); le[p] = (eA0 << 8) | l; lk[p] = __builtin_bit_cast(int, gA0); }
        if (oA1) { const int p = c0 + MBC(mA1); le[p] = (eA1 << 8) | (64 + l); lk[p] = __builtin_bit_cast(int, gA1); }
        if (oB0) { const int p = c1 + MBC(mB0); le[p] = (eB0 << 8) | 128 | l; lk[p] = __builtin_bit_cast(int, gB0); }
        if (oB1) { const int p = c2 + MBC(mB1); le[p] = (eB1 << 8) | 128 | (64 + l); lk[p] = __builtin_bit_cast(int, gB1); }
#undef MBC
        LDS_WAIT(); asm volatile("" ::: "memory");
        for (int cb = 0; cb < n || cb == 0; cb += 64) {
        const int nc = min(n, cb + 64);
        const bool fv = (cb + l) < nc;
        const int ent = fv ? le[cb + l] : 0; const float gt = fv ? __builtin_bit_cast(float, lk[cb + l]) : 0.f; float tot = 0.f;
        const float su = SU[ent >> 8], sv = SV[ent >> 8];
        const unsigned long long radr = (unsigned long long)(U8 + (size_t)(((ent >> 8) & 7) * 2048 + (((ent >> 8) >> 3) & (MODE == 2 ? 255 : 2047))) * 1024);
        const int ralo = (int)(unsigned)radr, rahi = (int)(unsigned)(radr >> 32);
        for (int i = cb; i < nc; i += 16) {
            u32x4 row[2][8];
#pragma unroll
            for (int b = 0; b < 2; ++b) if (i + 8 * b < nc) {
#pragma unroll
                for (int j = 0; j < 8; ++j) { const int ln = min(i + 8 * b + j, nc - 1) - cb;
                    const unsigned lo = (unsigned)__builtin_amdgcn_readlane(ralo, ln), hi = (unsigned)__builtin_amdgcn_readlane(rahi, ln);
                    const GAS unsigned char* rp = (const GAS unsigned char*)(((unsigned long long)hi << 32) | lo);
                    row[b][j] = *(const GAS u32x4*)(rp + (unsigned)loff); } }
            if (!pf_done) { pf_done = true; if (tok + 2 * step + 1 < T_TOK) U_PREFETCH(tok + 2 * step); }
#pragma unroll
            for (int b = 0; b < 2; ++b) if (i + 8 * b < nc) {
                float p[8];
                f32x4 accj[8];
                const int base0 = i + 8 * b;
                if (base0 + 8 <= c1) {
#pragma unroll
                    for (int j = 0; j < 8; ++j) accj[j] = __builtin_amdgcn_mfma_f32_16x16x32_fp8_fp8(lo64(row[b][j]), lo64(xA), (f32x4){0.f, 0.f, 0.f, 0.f}, 0, 0, 0);
#pragma unroll
                    for (int j = 0; j < 8; ++j) accj[j] = __builtin_amdgcn_mfma_f32_16x16x32_fp8_fp8(hi64(row[b][j]), hi64(xA), accj[j], 0, 0, 0);
                } else if (base0 >= c1) {
#pragma unroll
                    for (int j = 0; j < 8; ++j) accj[j] = __builtin_amdgcn_mfma_f32_16x16x32_fp8_fp8(lo64(row[b][j]), lo64(xB), (f32x4){0.f, 0.f, 0.f, 0.f}, 0, 0, 0);
#pragma unroll
                    for (int j = 0; j < 8; ++j) accj[j] = __builtin_amdgcn_mfma_f32_16x16x32_fp8_fp8(hi64(row[b][j]), hi64(xB), accj[j], 0, 0, 0);
                } else {
#pragma unroll
                    for (int j = 0; j < 8; ++j) { const u32x4 xs = (base0 + j >= c1) ? xB : xA; accj[j] = __builtin_amdgcn_mfma_f32_16x16x32_fp8_fp8(lo64(row[b][j]), lo64(xs), (f32x4){0.f, 0.f, 0.f, 0.f}, 0, 0, 0);
                        accj[j] = __builtin_amdgcn_mfma_f32_16x16x32_fp8_fp8(hi64(row[b][j]), hi64(xs), accj[j], 0, 0, 0); }
                }
#pragma unroll
                for (int j = 0; j < 8; ++j) p[j] = __builtin_fmaf(accj[j][3], dw3, __builtin_fmaf(accj[j][2], dw2, __builtin_fmaf(accj[j][1], dw1, accj[j][0] * dw0)));
                float q4[4], q2[2], q1;
#pragma unroll
                for (int j = 0; j < 4; ++j) { const float keep = b5 ? p[4 + j] : p[j], send = b5 ? p[j] : p[4 + j]; q4[j] = keep + __shfl_xor(send, 32); }
#pragma unroll
                for (int j = 0; j < 2; ++j) { const float keep = b4 ? q4[2 + j] : q4[j], send = b4 ? q4[j] : q4[2 + j]; q2[j] = keep + __shfl_xor(send, 16); }
                { const float keep = b3 ? q2[1] : q2[0], send = b3 ? q2[0] : q2[1]; q1 = keep + __shfl_xor(send, 8); }
                q1 = DPP_ADD(q1, 0xB1); q1 = DPP_ADD(q1, 0x4E); q1 = DPP_ADD(q1, 0x141);
                const float t = __builtin_bit_cast(float, __builtin_amdgcn_ds_bpermute((l & 7) * 32, __builtin_bit_cast(int, q1)));
                const int base = i + 8 * b;
                if ((l >> 3) == ((base - cb) >> 3)) tot = t;
            }
        }
        if (!pf_done) { if (tok + 2 * step + 1 < T_TOK) U_PREFETCH(tok + 2 * step); }
        if (fv) { const int tk = (ent & 128) ? tokB : tokA; AK[(size_t)tk * 128 + (ent & 127)] = gelu_tanh(tot * su * (1.f / 16.f)) * gt * sv; }
        if (n == 0) break;
        }
        LDS_WAIT(); asm volatile("" ::: "memory");
    }
#undef U_PREFETCH
}
template <int MODE>
__device__ __forceinline__ void peer_u_phase1(const Frame& F, const Args& A) {
    const unsigned char* X8 = A.ws + WS_P + P_X8;
    const unsigned char* U8 = A.ws + WS_U8; const float* SU = (const float*)(A.ws + WS_SU); const float* SV = (const float*)(A.ws + WS_SV);
    const int* IDX = (const int*)(A.ws + WS_P + P_IDX); const float* GATE = (const float*)(A.ws + WS_P + P_GATE); float* AK = (float*)(MODE == 0 ? A.ws + WS_AK : A.ws + WS_P + P_SC);
    const int g = F.bid & (UNG - 1), nmem = F.G >> UNG_SH, l = F.lane, step = nmem * NWAVES;
    const int loff = 64 * (l & 15) + 16 * (l >> 4);
    const bool dg = ((l & 15) >> 2) == (l >> 4); const int dr = l & 3;
    const float dw0 = (dg && dr == 0) ? 1.f : 0.f, dw1 = (dg && dr == 1) ? 1.f : 0.f, dw2 = (dg && dr == 2) ? 1.f : 0.f, dw3 = (dg && dr == 3) ? 1.f : 0.f;
    LAS int* le = (LAS int*)(F.lds + F.wave * 2048); LAS int* lk = le + 256;
    const bool b5 = (l & 32) != 0, b4 = (l & 16) != 0, b3 = (l & 8) != 0;
    int tok = (F.bid >> UNG_SH) * NWAVES + F.wave;
    u32x4 nxA; int neA0, neA1; float ngA0, ngA1;
#define U1_PREFETCH(t) do { const size_t _tA = (size_t)(t); nxA = *(const u32x4*)(X8 + _tA * 1024 + loff); \
        neA0 = IDX[_tA * 128 + l]; neA1 = IDX[_tA * 128 + 64 + l]; ngA0 = GATE[_tA * 128 + l]; ngA1 = GATE[_tA * 128 + 64 + l]; } while (0)
    if (tok < T_TOK) U1_PREFETCH(tok);
    for (; tok < T_TOK; tok += step) {
        const u32x4 xA = nxA;
        const int eA0 = neA0, eA1 = neA1; const float gA0 = ngA0, gA1 = ngA1;
        bool pf_done = false;
        const bool oA0 = (eA0 & (UNG - 1)) == g, oA1 = (eA1 & (UNG - 1)) == g;
        const unsigned long long mA0 = __ballot(oA0), mA1 = __ballot(oA1);
        const int c0 = __popcll(mA0), n = c0 + __popcll(mA1);
#define MBC(m) __builtin_amdgcn_mbcnt_hi((unsigned)((m) >> 32), __builtin_amdgcn_mbcnt_lo((unsigned)(m), 0u))
        if (oA0) { const int p = MBC(mA0); le[p] = (eA0 << 8) | l; lk[p] = __builtin_bit_cast(int, gA0); }
        if (oA1) { const int p = c0 + MBC(mA1); le[p] = (eA1 << 8) | (64 + l); lk[p] = __builtin_bit_cast(int, gA1); }
#undef MBC
        LDS_WAIT(); asm volatile("" ::: "memory");
        for (int cb = 0; cb < n || cb == 0; cb += 64) {
        const int nc = min(n, cb + 64);
        const bool fv = (cb + l) < nc;
        const int ent = fv ? le[cb + l] : 0; const float gt = fv ? __builtin_bit_cast(float, lk[cb + l]) : 0.f; float tot = 0.f;
        const float su = SU[ent >> 8], sv = SV[ent >> 8];
        const unsigned long long radr = (unsigned long long)(U8 + (size_t)(((ent >> 8) & (UNG - 1)) * (NEXP / UNG) + ((ent >> 8) >> UNG_SH)) * 1024);
        const int ralo = (int)(unsigned)radr, rahi = (int)(unsigned)(radr >> 32);
        for (int i = cb; i < nc; i += 16) {
            u32x4 row[2][8];
#pragma unroll
            for (int b = 0; b < 2; ++b) if (i + 8 * b < nc) {
#pragma unroll
                for (int j = 0; j < 8; ++j) { const int ln = min(i + 8 * b + j, nc - 1) - cb;
                    const unsigned lo = (unsigned)__builtin_amdgcn_readlane(ralo, ln), hi = (unsigned)__builtin_amdgcn_readlane(rahi, ln);
                    const GAS unsigned char* rp = (const GAS unsigned char*)(((unsigned long long)hi << 32) | lo);
                    row[b][j] = *(const GAS u32x4*)(rp + (unsigned)loff); } }
            if (!pf_done) { pf_done = true; if (tok + step < T_TOK) U1_PREFETCH(tok + step); }
#pragma unroll
            for (int b = 0; b < 2; ++b) if (i + 8 * b < nc) {
                float p[8]; f32x4 accj[8];
#pragma unroll
                for (int j = 0; j < 8; ++j) accj[j] = __builtin_amdgcn_mfma_f32_16x16x32_fp8_fp8(lo64(row[b][j]), lo64(xA), (f32x4){0.f, 0.f, 0.f, 0.f}, 0, 0, 0);
#pragma unroll
                for (int j = 0; j < 8; ++j) accj[j] = __builtin_amdgcn_mfma_f32_16x16x32_fp8_fp8(hi64(row[b][j]), hi64(xA), accj[j], 0, 0, 0);
#pragma unroll
                for (int j = 0; j < 8; ++j) p[j] = __builtin_fmaf(accj[j][3], dw3, __builtin_fmaf(accj[j][2], dw2, __builtin_fmaf(accj[j][1], dw1, accj[j][0] * dw0)));
                float q4[4], q2[2], q1;
#pragma unroll
                for (int j = 0; j < 4; ++j) { const float keep = b5 ? p[4 + j] : p[j], send = b5 ? p[j] : p[4 + j]; q4[j] = keep + __shfl_xor(send, 32); }
#pragma unroll
                for (int j = 0; j < 2; ++j) { const float keep = b4 ? q4[2 + j] : q4[j], send = b4 ? q4[j] : q4[2 + j]; q2[j] = keep + __shfl_xor(send, 16); }
                { const float keep = b3 ? q2[1] : q2[0], send = b3 ? q2[0] : q2[1]; q1 = keep + __shfl_xor(send, 8); }
                q1 = DPP_ADD(q1, 0xB1); q1 = DPP_ADD(q1, 0x4E); q1 = DPP_ADD(q1, 0x141);
                const float t = __builtin_bit_cast(float, __builtin_amdgcn_ds_bpermute((l & 7) * 32, __builtin_bit_cast(int, q1)));
                const int base = i + 8 * b;
                if ((l >> 3) == ((base - cb) >> 3)) tot = t;
            }
        }
        if (!pf_done) { pf_done = true; if (tok + step < T_TOK) U1_PREFETCH(tok + step); }
        if (fv) AK[(size_t)tok * 128 + (ent & 127)] = gelu_tanh(tot * su * (1.f / 16.f)) * gt * sv;
        if (n == 0) break;
        }
        LDS_WAIT(); asm volatile("" ::: "memory");
    }
#undef U1_PREFETCH
}
__device__ __forceinline__ float wave_max_nonneg(float v) {
    unsigned u = __builtin_bit_cast(unsigned, v);
    u = max(u, (unsigned)__builtin_amdgcn_mov_dpp((int)u, 0xB1, 0xf, 0xf, true));
    u = max(u, (unsigned)__builtin_amdgcn_mov_dpp((int)u, 0x4E, 0xf, 0xf, true));
    u = max(u, (unsigned)__builtin_amdgcn_mov_dpp((int)u, 0x141, 0xf, 0xf, true));
    u = max(u, (unsigned)__builtin_amdgcn_mov_dpp((int)u, 0x140, 0xf, 0xf, true));
    const unsigned a = (unsigned)__builtin_amdgcn_readlane((int)u, 0), b = (unsigned)__builtin_amdgcn_readlane((int)u, 16), c = (unsigned)__builtin_amdgcn_readlane((int)u, 32), d = (unsigned)__builtin_amdgcn_readlane((int)u, 48);
    return __builtin_bit_cast(float, max(max(a, b), max(c, d)));
}
template <int MODE>
__device__ __forceinline__ void peer_v_phase(const Frame& F, const Args& A) {
    const unsigned char* V8 = A.ws + WS_V8; const int* IDX = (const int*)(A.ws + WS_P + P_IDX); const float* AK = (const float*)(A.ws + WS_AK);
    float* out = MODE == 0 ? A.out : (float*)(A.ws + WS_P + P_SC);
    const int g = F.bid & 7, nmem = F.G >> 3, l = F.lane, sub = l & 7, rr = l >> 3, n16 = l & 15, q = l >> 4, step = nmem * NWAVES;
    const GAS unsigned char* vb = (const GAS unsigned char*)(V8 + (size_t)g * NEXP * 128);
    LAS unsigned long long* rep = (LAS unsigned long long*)(F.lds + F.wave * 2048);
    const unsigned long long bm = 0xFFull << (8 * (n16 & 7));
    const int repi = 2 * q + (n16 >> 3);
    const bool vl = (n16 < 8) && (q < 2);
    LAS float* stg = (LAS float*)(F.lds + 16384 + F.wave * 512);
    int tok = 2 * ((F.bid >> 3) * NWAVES + F.wave);
    int ne[4]; float na[4];
#define V_PREFETCH(t) do { const size_t _a = (size_t)(t) * 128, _b = ((size_t)(t) + 1) * 128; ne[0] = IDX[_a + l]; ne[1] = IDX[_a + 64 + l]; ne[2] = IDX[_b + l]; ne[3] = IDX[_b + 64 + l]; \
        na[0] = AK[_a + l]; na[1] = AK[_a + 64 + l]; na[2] = AK[_b + l]; na[3] = AK[_b + 64 + l]; } while (0)
    if (tok + 1 < T_TOK) V_PREFETCH(tok);
    for (; tok + 1 < T_TOK; tok += 2 * step) {
        const int e0 = ne[0], e1 = ne[1], e2 = ne[2], e3 = ne[3]; const float a0 = na[0], a1 = na[1], a2 = na[2], a3 = na[3];
        u32x4 rowA[16], rowB[16];
#pragma unroll
        for (int i = 0; i < 16; ++i) { const int src = (8 * (i & 7) + rr) * 4;
            const int ea = __builtin_amdgcn_ds_bpermute(src, i < 8 ? e0 : e1), eb = __builtin_amdgcn_ds_bpermute(src, i < 8 ? e2 : e3);
            rowA[i] = *(const GAS u32x4*)(vb + ((unsigned)ea * 128u + 16u * (unsigned)sub)); rowB[i] = *(const GAS u32x4*)(vb + ((unsigned)eb * 128u + 16u * (unsigned)sub)); }
        f32x4 HA = {0.f, 0.f, 0.f, 0.f}, HB = {0.f, 0.f, 0.f, 0.f};
        if (l < 32) { const float* hpa = out + (size_t)tok * D + g * 128 + 4 * l; HA = *(const f32x4*)hpa; HB = *(const f32x4*)(hpa + D); }
        if (tok + 2 * step + 1 < T_TOK) V_PREFETCH(tok + 2 * step);
        const float amA = wave_max_nonneg(fmaxf(fabsf(a0), fabsf(a1))), amB = wave_max_nonneg(fmaxf(fabsf(a2), fabsf(a3)));
        const float scA = amA > 0.f ? 224.f * __builtin_amdgcn_rcpf(amA) : 0.f, invA = amA * (1.f / 224.f), scB = amB > 0.f ? 224.f * __builtin_amdgcn_rcpf(amB) : 0.f, invB = amB * (1.f / 224.f);
        { const unsigned wA = (unsigned)__builtin_amdgcn_cvt_pk_fp8_f32(a0 * scA, a1 * scA, 0, false), wB = (unsigned)__builtin_amdgcn_cvt_pk_fp8_f32(a2 * scB, a3 * scB, 0, false);
          const unsigned r0 = (wA & 0xffu) * 0x01010101u, r1 = ((wA >> 8) & 0xffu) * 0x01010101u, r2 = (wB & 0xffu) * 0x01010101u, r3 = ((wB >> 8) & 0xffu) * 0x01010101u;
          rep[l] = ((unsigned long long)r0 << 32) | r0; rep[64 + l] = ((unsigned long long)r1 << 32) | r1; rep[128 + l] = ((unsigned long long)r2 << 32) | r2; rep[192 + l] = ((unsigned long long)r3 << 32) | r3; }
        LDS_WAIT(); asm volatile("" ::: "memory");
#pragma unroll
        for (int t2 = 0; t2 < 2; ++t2) {
            f32x4 alo = {0.f, 0.f, 0.f, 0.f}, ahi = {0.f, 0.f, 0.f, 0.f};
#pragma unroll
            for (int i = 0; i < 16; ++i) { const long bop = (long)(rep[128 * t2 + 8 * i + repi] & bm); const u32x4 rw = t2 ? rowB[i] : rowA[i];
                alo = __builtin_amdgcn_mfma_f32_16x16x32_fp8_fp8(lo64(rw), bop, alo, 0, 0, 0);
                ahi = __builtin_amdgcn_mfma_f32_16x16x32_fp8_fp8(hi64(rw), bop, ahi, 0, 0, 0); }
            const float inv = t2 ? invB : invA;
            float vlo[4], vhi[4];
#pragma unroll
            for (int r = 0; r < 4; ++r) { const float tl = alo[r], th = ahi[r];
                vlo[r] = (tl + __builtin_bit_cast(float, __builtin_amdgcn_ds_bpermute(((l + 40) & 63) * 4, __builtin_bit_cast(int, tl)))) * inv;
                vhi[r] = (th + __builtin_bit_cast(float, __builtin_amdgcn_ds_bpermute(((l + 40) & 63) * 4, __builtin_bit_cast(int, th)))) * inv; }
            if (vl) {
#pragma unroll
                for (int r = 0; r < 4; ++r) { stg[64 * q + 16 * r + n16] = vlo[r]; stg[64 * q + 16 * r + n16 + 8] = vhi[r]; } }
            LDS_WAIT(); asm volatile("" ::: "memory");
            if (l < 32) { const f32x4 dv = *(const LAS f32x4*)(stg + 4 * l); *(f32x4*)(out + (size_t)(tok + t2) * D + g * 128 + 4 * l) = (t2 ? HB : HA) + dv; }
            LDS_WAIT(); asm volatile("" ::: "memory");
        }
        LDS_WAIT(); asm volatile("" ::: "memory");
    }
#undef V_PREFETCH
}
__device__ __forceinline__ void final_norm_phase(const Frame& F, const Args& A) {
    const int gw = F.bid * NWAVES + F.wave, NGW = F.G * NWAVES, l = F.lane; const float* fg = A.in[I_FG];
    const f32x4* gp = (const f32x4*)fg + l;
    int tok = gw;
    for (; tok + 3 * NGW < T_TOK; tok += 4 * NGW) {
        f32x4 v[4][4]; float ss[4];
#pragma unroll
        for (int b = 0; b < 4; ++b) { const f32x4* hp = (const f32x4*)(A.out + (size_t)(tok + b * NGW) * D) + l;
#pragma unroll
            for (int j = 0; j < 4; ++j) v[b][j] = hp[64 * j]; }
#pragma unroll
        for (int b = 0; b < 4; ++b) { ss[b] = 0.f;
#pragma unroll
            for (int j = 0; j < 4; ++j) ss[b] += (v[b][j].x * v[b][j].x + v[b][j].y * v[b][j].y) + (v[b][j].z * v[b][j].z + v[b][j].w * v[b][j].w); }
#pragma unroll
        for (int o = 1; o < 64; o <<= 1) {
#pragma unroll
            for (int b = 0; b < 4; ++b) ss[b] += __shfl_xor(ss[b], o); }
#pragma unroll
        for (int b = 0; b < 4; ++b) { const float rstd = 1.f / sqrtf(ss[b] * (1.f / D) + EPS); f32x4* hp = (f32x4*)(A.out + (size_t)(tok + b * NGW) * D) + l;
#pragma unroll
            for (int j = 0; j < 4; ++j) hp[64 * j] = v[b][j] * rstd * gp[64 * j]; }
    }
    for (; tok < T_TOK; tok += NGW) { f32x4* hp = (f32x4*)(A.out + (size_t)tok * D) + l; f32x4 v[4]; float ss = 0.f;
#pragma unroll
        for (int j = 0; j < 4; ++j) { v[j] = hp[64 * j]; ss += (v[j].x * v[j].x + v[j].y * v[j].y) + (v[j].z * v[j].z + v[j].w * v[j].w); }
        const float rstd = 1.f / sqrtf(wave_sum(ss) * (1.f / D) + EPS);
#pragma unroll
        for (int j = 0; j < 4; ++j) hp[64 * j] = v[j] * rstd * gp[64 * j]; }
}

#ifdef DEBUG_CHECK
constexpr size_t WS_DBG = 472 * MiB;
__device__ __forceinline__ int dbg_tok(int i) { return (i * 509 + 3) & 32767; }
__device__ __forceinline__ float gelu_ref(float x) { return 0.5f * x * (1.f + tanhf(0.7978845608028654f * (x + 0.044715f * x * x * x))); }
__global__ void __launch_bounds__(512) dbg_scores(Args a) {
    __shared__ float n2s[1024]; __shared__ float q[2048];
    const int t = dbg_tok(blockIdx.x), tid = threadIdx.x;
    const bf16_t* N2 = (const bf16_t*)(a.ws + WS_N1); const float* SC = (const float*)(a.ws + WS_P + P_SC); unsigned* dbg = (unsigned*)(a.ws + WS_DBG);
    for (int k = tid; k < 1024; k += 512) n2s[k] = bf1(N2[(size_t)t * 1024 + k]);
    __syncthreads();
    for (int r = 0; r < 4; ++r) { const int c = tid + 512 * r; float s = 0.f; for (int k = 0; k < 1024; ++k) s += n2s[k] * a.in[I_WQ][(size_t)k * 2048 + c]; q[c] = s; }
    __syncthreads();
    float md = 0.f;
    for (int r = 0; r < 4; ++r) { const int n = tid + 512 * r, hh = n >> 7, key = n & 127; const float* kX = (hh & 1) ? a.in[I_K2] : a.in[I_K1];
        float s = 0.f; for (int d = 0; d < 128; ++d) s += q[hh * 128 + d] * kX[key * 128 + d];
        md = fmaxf(md, fabsf(s - SC[(size_t)n * T_TOK + t])); }
    atomicMax(&dbg[0], __builtin_bit_cast(unsigned, md));
}
__global__ void __launch_bounds__(64) dbg_topk(Args a) {
    __shared__ float s1[8][128], s2[8][128], cv[8][256]; __shared__ float t1v[8][16], t2v[8][16]; __shared__ int t1i[8][16], t2i[8][16], exi[8][16]; __shared__ float exv[8][16];
    const int t = dbg_tok(blockIdx.x), h = threadIdx.x;
    const float* SC = (const float*)(a.ws + WS_P + P_SC); const int* IDX = (const int*)(a.ws + WS_P + P_IDX); const float* GATE = (const float*)(a.ws + WS_P + P_GATE); unsigned* dbg = (unsigned*)(a.ws + WS_DBG);
    if (h >= 8) return;
    for (int j = 0; j < 128; ++j) { s1[h][j] = SC[(size_t)(h * 256 + j) * T_TOK + t]; s2[h][j] = SC[(size_t)(h * 256 + 128 + j) * T_TOK + t]; }
    for (int r = 0; r < 16; ++r) { int b1 = 0, b2 = 0; for (int j = 1; j < 128; ++j) { if (s1[h][j] > s1[h][b1]) b1 = j; if (s2[h][j] > s2[h][b2]) b2 = j; }
        t1v[h][r] = s1[h][b1]; t1i[h][r] = b1; s1[h][b1] = -1e30f; t2v[h][r] = s2[h][b2]; t2i[h][r] = b2; s2[h][b2] = -1e30f; }
    for (int c = 0; c < 256; ++c) cv[h][c] = t1v[h][c >> 4] + t2v[h][c & 15];
    for (int r = 0; r < 16; ++r) { int bc = 0; for (int c = 1; c < 256; ++c) if (cv[h][c] > cv[h][bc]) bc = c;
        exv[h][r] = cv[h][bc]; exi[h][r] = t1i[h][bc >> 4] * 128 + t2i[h][bc & 15]; cv[h][bc] = -1e30f; }
    float sum = 0.f; const float mx0 = exv[h][0]; for (int r = 0; r < 16; ++r) { exv[h][r] = expf(exv[h][r] - mx0); } for (int r = 0; r < 16; ++r) sum += exv[h][r];
    unsigned miss = 0; float gd = 0.f;
    for (int w = 0; w < 16; ++w) { const int e = IDX[(size_t)t * 128 + h * 16 + w]; const float g = GATE[(size_t)t * 128 + h * 16 + w]; bool found = false;
        for (int r = 0; r < 16; ++r) if (exi[h][r] == e) { found = true; gd = fmaxf(gd, fabsf(g - exv[h][r] / sum)); }
        if (!found) ++miss; }
    atomicAdd(&dbg[1], miss); atomicMax(&dbg[3], __builtin_bit_cast(unsigned, gd));
}
__global__ void __launch_bounds__(512) dbg_experts_pre(Args a) {
    __shared__ float n2s[1024]; __shared__ float ak[128]; __shared__ int ek[128]; __shared__ float red[8];
    const int t = dbg_tok(blockIdx.x), tid = threadIdx.x, lane = tid & 63, wave = tid >> 6;
    const bf16_t* N2 = (const bf16_t*)(a.ws + WS_N1); const int* IDX = (const int*)(a.ws + WS_P + P_IDX); const float* GATE = (const float*)(a.ws + WS_P + P_GATE);
    float* rows = (float*)(a.ws + WS_DBG + MiB);
    for (int k = tid; k < 1024; k += 512) n2s[k] = bf1(N2[(size_t)t * 1024 + k]);
    if (tid < 128) ek[tid] = IDX[(size_t)t * 128 + tid];
    __syncthreads();
    for (int k = wave * 16; k < wave * 16 + 16; ++k) { const float* u = a.in[I_PU] + (size_t)ek[k] * 1024; float s = 0.f; for (int j = lane; j < 1024; j += 64) s += u[j] * n2s[j];
        s = wave_sum(s); if (lane == 0) ak[k] = gelu_ref(s) * GATE[(size_t)t * 128 + k]; }
    __syncthreads();
    float h2[2]; float ss = 0.f;
    for (int r = 0; r < 2; ++r) { const int d = tid + 512 * r; float o = 0.f; for (int k = 0; k < 128; ++k) o += ak[k] * a.in[I_PV][(size_t)ek[k] * 1024 + d]; h2[r] = a.out[(size_t)t * 1024 + d] + o; ss += h2[r] * h2[r]; }
    ss = wave_sum(ss); if (lane == 0) red[wave] = ss; __syncthreads();
    float tot = 0.f; for (int w = 0; w < 8; ++w) tot += red[w];
    const float rstd = 1.f / sqrtf(tot / 1024.f + EPS);
    for (int r = 0; r < 2; ++r) { const int d = tid + 512 * r; rows[(size_t)blockIdx.x * 1024 + d] = h2[r] * rstd * a.in[I_FG][d]; }
}
__global__ void __launch_bounds__(512) dbg_experts_post(Args a) {
    const int t = dbg_tok(blockIdx.x), tid = threadIdx.x; const float* rows = (const float*)(a.ws + WS_DBG + MiB); float* dbgf = (float*)(a.ws + WS_DBG);
    float e = 0.f, n = 0.f;
    for (int r = 0; r < 2; ++r) { const int d = tid + 512 * r; const float x = rows[(size_t)blockIdx.x * 1024 + d], y = a.out[(size_t)t * 1024 + d]; e += (x - y) * (x - y); n += x * x; }
    e = wave_sum(e); n = wave_sum(n); if ((tid & 63) == 0) { atomicAdd(&dbgf[4], e); atomicAdd(&dbgf[5], n); }
}
__global__ void __launch_bounds__(512) dbg_report(Args a, int which) {
    const unsigned* dbg = (const unsigned*)(a.ws + WS_DBG); const float* dbgf = (const float*)(a.ws + WS_DBG);
    const float mA = dbgf[0], gd = dbgf[3]; const unsigned miss = dbg[1]; const float relC = sqrtf(dbgf[4] / fmaxf(dbgf[5], 1e-30f));
    float X;
    if (which == 0) { int mask = 0; if (mA > 0.05f) mask |= 1; if (miss > 400u) mask |= 2; if (relC > 0.05f) mask |= 4; if (gd > 0.02f) mask |= 8; X = 1000.f + 100.f * mask; }
    else if (which == 1) X = 1e6f * mA; else if (which == 2) X = 100.f + (float)miss; else if (which == 3) X = 1e6f * relC; else X = 1e6f * gd;
    for (size_t i = (size_t)blockIdx.x * 512 + threadIdx.x; i < (size_t)T_TOK * D; i += (size_t)gridDim.x * 512) a.out[i] = (i == 0) ? X : 0.f;
}
#endif

constexpr int NPH = 13;
__global__ void __launch_bounds__(NWAVES * 64, 2) fwd_kernel(Args args) {
    extern __shared__ __attribute__((aligned(16))) unsigned char lds_raw[];
    Frame F;
    F.lds = (LAS unsigned char*)lds_raw;
    F.tid = threadIdx.x; F.lane = F.tid & 63; F.wave = __builtin_amdgcn_readfirstlane(F.tid >> 6);
    F.G = gridDim.x; F.bid = blockIdx.x;
    volatile LAS unsigned* MISC = (volatile LAS unsigned*)(F.lds + MISC_OFF);
    for (int u = F.tid; u < (LDS_BYTES - LDSCTL_OFF) / 4; u += NWAVES * 64) ((LAS unsigned*)(F.lds + LDSCTL_OFF))[u] = 0u;
    __syncthreads();
    unsigned* ctl = (unsigned*)(args.ws + WS_CTL);
    const int lo = args.ph_lo, hi = args.ph_hi;
    XcdBarrier bar; bar.bar = ctl + CW_BAR + args.li * XCD_BAR_WORDS; bar.x = 0; bar.st = nullptr;
    if (hi - lo > 1) bar = xcd_barrier_post(ctl + CW_BAR + args.li * XCD_BAR_WORDS, MISC + 8);
#define IN(k) (lo <= (k) && (k) < hi)
#ifdef PROBE_TS
#define STAMP(k) do { if (F.bid == 0 && F.tid == 0) ((unsigned long long*)(args.ws + (472u << 20)))[(k)] = __builtin_amdgcn_s_memrealtime(); } while (0)
#else
#define STAMP(k) do { } while (0)
#endif
#define SEAM(k) do { if (IN(k) && IN((k) + 1)) { xcd_barrier(bar); if (XTRA_BAR) xcd_barrier(bar); } STAMP((k) + 1); } while (0)
    unsigned char* ws = args.ws;
    bf16_t* P = (bf16_t*)(ws + WS_P);

    STAMP(0);
    if (IN(0)) { phase0(F, args); SEAM(0); }
    if (IN(1)) {
        pg8::Gemm g{(const bf16_t*)(ws + WS_N1), (const bf16_t*)(ws + WS_WIN), T_TOK, NPROJ, D / 2, D / 2, 0x7B7B7B7B, 0x75757575}; pg8::StaticOrder S; S.init(T_TOK, NPROJ, F.G, F.bid);
        pg8::EpiProj E{P, (float*)(ws + WS_ALR)};
        pg8::gemm_phase<pg8::EpiProj, pg8::StaticOrder, false, true, true>(F.lds, g, S, E);
        {
            const int nwg = (T_TOK / 256) * (NPROJ / 256), rem = nwg % F.G;
            if (rem == 0) convert_tables(F, args, F.bid * NWAVES + F.wave, F.G * NWAVES);
            else if (F.bid >= rem) convert_tables(F, args, (F.bid - rem) * NWAVES + F.wave, (F.G - rem) * NWAVES);
        }
        SEAM(1);
    }
    if (IN(2)) {
        gla_chunk_phase<false>(F, args);
        for (int it = F.bid; it < 1024; it += F.G) sgu_unit<false>(F, args, it);
        SEAM(2);
    }
    if (IN(3)) { if (DRY_EXP == 13) { gla_scan<true>(F, args); __syncthreads(); } gla_scan<false>(F, args); SEAM(3); }
    if (IN(4)) { if (DRY_EXP == 14) { gla_out_phase<true>(F, args); __syncthreads(); } gla_out_phase<false>(F, args); SEAM(4); }
    if (IN(5)) {
        { pg8::Gemm g{P + PC_Q, (const bf16_t*)(ws + WS_WA), T_TOK, D, 512, PLD}; pg8::StaticOrder S; S.init(T_TOK, D, F.G, F.bid);
          pg8::EpiBrA E{P}; pg8::gemm_phase<pg8::EpiBrA, pg8::StaticOrder, true, true>(F.lds, g, S, E); }
        { pg8::Gemm g{P + PC_SU, (const bf16_t*)(ws + WS_WB), T_TOK, D, 512, PLD}; pg8::StaticOrder S; S.init(T_TOK, D, F.G, F.bid);
          pg8::EpiBrB E{P}; pg8::gemm_phase<pg8::EpiBrB, pg8::StaticOrder, true, true>(F.lds, g, S, E); }
        SEAM(5);
    }
    if (IN(6)) {
        pg8::Gemm g{P + PC_MRG, (const bf16_t*)(ws + WS_WOUT), T_TOK, D, D, PLD}; pg8::StaticOrder S; S.init(T_TOK, D, F.G, F.bid);
        pg8::EpiOut E{args.in[I_X], args.out}; pg8::gemm_phase<pg8::EpiOut, pg8::StaticOrder, true, true>(F.lds, g, S, E);
        SEAM(6);
    }
    if (IN(7)) {
        const int gw = F.bid * NWAVES + F.wave, NGW = F.G * NWAVES;
        { int m = gw; for (; m + 3 * NGW < T_TOK; m += 4 * NGW) rms_rows_to_bf16<3, 4>(F.lane, args.out + (size_t)m * D, (size_t)NGW * D, args.in[I_N2G], (bf16_t*)(ws + WS_N1) + (size_t)m * D, (size_t)NGW * D, (unsigned*)(ws + WS_P + P_X8) + (size_t)m * 256, (size_t)NGW * 256);
          for (; m < T_TOK; m += NGW) rms_rows_to_bf16<3, 1>(F.lane, args.out + (size_t)m * D, 0, args.in[I_N2G], (bf16_t*)(ws + WS_N1) + (size_t)m * D, 0, (unsigned*)(ws + WS_P + P_X8) + (size_t)m * 256, 0); }
        SEAM(7);
    }
    if (IN(8)) {
        pg8::Gemm g{(const bf16_t*)(ws + WS_N1), (const bf16_t*)(ws + WS_WQF), T_TOK, 2048, D, D}; pg8::StaticOrder S; S.init(T_TOK, 2048, F.G, F.bid);
        pg8::EpiScores E{(float*)(ws + WS_P + P_SC)}; pg8::gemm_phase<pg8::EpiScores, pg8::StaticOrder, true, true>(F.lds, g, S, E);
        SEAM(8);
    }
    if (IN(9)) { peer_topk(F, args); SEAM(9); }
    if (IN(10)) { if (DRY_EXP == 2) { peer_u_phase<1>(F, args); __syncthreads(); } if (DRY_EXP == 3) { peer_u_phase<2>(F, args); __syncthreads(); } if (DRY_EXP == 4) { peer_u_phase<3>(F, args); __syncthreads(); } if (DRY_EXP == 5) { peer_u_phase<4>(F, args); __syncthreads(); } if (UNG == 8) peer_u_phase<0>(F, args); else peer_u_phase1<0>(F, args); SEAM(10); }
    if (IN(11)) { if (DRY_EXP == 1) { peer_v_phase<1>(F, args); __syncthreads(); } peer_v_phase<0>(F, args); SEAM(11); }
    if (IN(12)) { final_norm_phase(F, args); }
#undef IN
#undef SEAM
}


#ifdef PROBE_TS
__global__ void __launch_bounds__(512) probe_report(Args a, int pi, int pj) {
    const unsigned long long* ts = (const unsigned long long*)(a.ws + (472u << 20));
    const float X1 = 10.f * (float)(ts[pi + 1] - ts[pi]) * 0.01f, X2 = (float)(ts[pj + 1] - ts[pj]) * 0.01f;
    for (size_t i = (size_t)blockIdx.x * 512 + threadIdx.x; i < (size_t)T_TOK * D; i += (size_t)gridDim.x * 512) a.out[i] = (i == 0) ? X1 : X2;
}
#endif
extern "C" void kernel_launch(void* const* d_in, const int* in_sizes, int n_in, void* d_out, int out_size, void* d_ws, size_t ws_size, hipStream_t stream) {
    static int grid = 0;
    if (grid == 0) {
        if (n_in != 20 || in_sizes[0] != T_TOK * D || out_size != T_TOK * D || ws_size < WS_END) {
            fprintf(stderr, "kernel_launch: unexpected shapes: n_in %d in0 %d out %d ws %zu (need %zu)\n", n_in, n_in > 0 ? in_sizes[0] : -1, out_size, ws_size, (size_t)WS_END); grid = -1; return; }
        int dev = 0, cus = 0;
        if (hipGetDevice(&dev) != hipSuccess || hipDeviceGetAttribute(&cus, hipDeviceAttributeMultiprocessorCount, dev) != hipSuccess) { grid = -1; return; }
        if (hipFuncSetAttribute((const void*)fwd_kernel, hipFuncAttributeMaxDynamicSharedMemorySize, LDS_BYTES) != hipSuccess) { fprintf(stderr, "kernel_launch: hipFuncSetAttribute failed\n"); grid = -1; return; }
        int per_cu = 0;
        if (hipOccupancyMaxActiveBlocksPerMultiprocessor(&per_cu, (const void*)fwd_kernel, NWAVES * 64, LDS_BYTES) != hipSuccess || per_cu < 1) fprintf(stderr, "kernel_launch: occupancy query says %d\n", per_cu);
        (void)hipGetLastError();
        grid = cus;
    }
    if (grid < 0) return;
    (void)hipMemsetAsync((char*)d_ws + WS_CTL, 0, CTL_ZERO_BYTES, stream);
    Args a{};
    for (int i = 0; i < 20; ++i) a.in[i] = (const float*)d_in[i];
    a.out = (float*)d_out; a.ws = (unsigned char*)d_ws;
#ifndef LAUNCH_LIST
#define LAUNCH_LIST {0, NPH}
#endif
    static const int ranges[][2] = { LAUNCH_LIST };
    const int nl = (int)(sizeof(ranges) / sizeof(ranges[0]));
    for (int li = 0; li < nl; ++li) { a.ph_lo = ranges[li][0]; a.ph_hi = ranges[li][1]; a.li = li;
        hipLaunchKernelGGL(fwd_kernel, dim3(grid), dim3(NWAVES * 64), LDS_BYTES, stream, a); }
}
```

```cpp
#include <hip/hip_runtime.h>
#include <cstdio>
#include <cstdint>


#ifndef XTRA_BAR
#define XTRA_BAR 0
#endif
#ifndef DRY_EXP
#define DRY_EXP 0
#endif
#ifndef DUP_PHASE
#define DUP_PHASE -1
#endif
#ifndef MK_N_LAUNCHES
#define MK_N_LAUNCHES 1
#endif

#define LAS __attribute__((address_space(3)))
#define GAS __attribute__((address_space(1)))
typedef unsigned short bf16_t;
typedef short bf16x8 __attribute__((ext_vector_type(8)));
typedef float f32x4 __attribute__((ext_vector_type(4)));
typedef float f32x2 __attribute__((ext_vector_type(2)));
typedef unsigned u32x4 __attribute__((ext_vector_type(4)));
typedef unsigned u32x2 __attribute__((ext_vector_type(2)));
typedef int i32x4 __attribute__((ext_vector_type(4)));
typedef int i32x8 __attribute__((ext_vector_type(8)));
typedef __bf16 bf16x2_t __attribute__((ext_vector_type(2)));

constexpr int T_TOK = 32768, D = 1024, SEQ = 4096, NBATCH = 8;
constexpr int NPROJ = 5376;
constexpr int PLD = 5120;
constexpr int PC_Q = 0, PC_K = 512, PC_V = 1024, PC_R = 1536, PC_SU = 2048, PC_SV = 2560, PC_GA = 3072, PC_GB = 4096;
constexpr int PC_MRG = 512;
constexpr float EPS = 1e-6f;
constexpr int NEXP = 16384;
#ifndef U_NG
#define U_NG 4
#endif
#ifndef F8_LO
#define F8_LO 11
#endif
constexpr int UNG = U_NG, UNG_SH = (U_NG == 8 ? 3 : (U_NG == 4 ? 2 : (U_NG == 2 ? 1 : 0)));

constexpr size_t MiB = 1u << 20;
constexpr size_t WS_CTL = 0, CTL_ZERO_BYTES = 64 * 1024;
constexpr size_t WS_WIN = 1 * MiB;
constexpr size_t WS_WA = 12 * MiB;
constexpr size_t WS_WB = 13 * MiB;
constexpr size_t WS_WOUT = 14 * MiB;
constexpr size_t WS_WQF = 16 * MiB;
constexpr size_t WS_U8 = 20 * MiB;
constexpr size_t WS_V8 = 36 * MiB;
constexpr size_t WS_SU = 52 * MiB;
constexpr size_t WS_SV = 52 * MiB + 65536;
constexpr size_t WS_AK = 53 * MiB;
constexpr size_t WS_DEC = 84 * MiB;
constexpr size_t WS_ALR = 85 * MiB;
constexpr size_t WS_N1 = 87 * MiB;
constexpr size_t WS_P = 151 * MiB;
constexpr size_t WS_W8 = 472 * MiB;
constexpr size_t WS_N18 = 478 * MiB;
constexpr size_t WS_END = 510 * MiB;
constexpr size_t P_SC = 0, P_IDX = 256 * MiB, P_GATE = 272 * MiB, P_X8 = 288 * MiB;

constexpr int CW_BAR = 4096;

constexpr int RING_BYTES = 131072;
constexpr int LDSCTL_OFF = RING_BYTES, MISC_OFF = LDSCTL_OFF + 320;
constexpr int LDS_BYTES = 147456;
constexpr int NWAVES = 8;

__device__ __forceinline__ unsigned pk2(float lo, float hi) { const f32x2 v = {lo, hi}; const bf16x2_t b = __builtin_convertvector(v, bf16x2_t); return __builtin_bit_cast(unsigned, b); }
__device__ __forceinline__ unsigned f2bf(float f) { return pk2(f, 0.f) & 0xffffu; }
__device__ __forceinline__ float bflo(unsigned w) { return __builtin_bit_cast(float, w << 16); }
__device__ __forceinline__ float bfhi(unsigned w) { return __builtin_bit_cast(float, w & 0xffff0000u); }
__device__ __forceinline__ float bf1(bf16_t h) { return __builtin_bit_cast(float, ((unsigned)h) << 16); }
__device__ __forceinline__ float sigmoidf_(float x) { return __builtin_amdgcn_rcpf(1.f + __expf(-x)); }
__device__ __forceinline__ float gelu_tanh(float x) { const float y = 1.5957691216057308f * (x + 0.044715f * x * x * x); return x * sigmoidf_(y); }
__device__ __forceinline__ float siluf_(float x) { return x * sigmoidf_(x); }
__device__ __forceinline__ float wave_sum(float v) {
#pragma unroll
    for (int o = 1; o < 64; o <<= 1) v += __shfl_xor(v, o);
    return v;
}
#define LDS_WAIT() asm volatile("s_waitcnt lgkmcnt(0)" ::: "memory")
#define VM_WAIT() asm volatile("s_waitcnt vmcnt(0)" ::: "memory")

namespace pg8 {
constexpr int BM = 256, BK = 64, HALF = 128, HTB = HALF * BK * 2, STAGE_BYTES = 8 * HTB, NXCD = 8, WGM = 8;
__host__ __device__ __forceinline__ int lds_byte(int r, int c) { const int st = (r >> 4) * 2 + (c >> 5), rr = r & 15, cc = c & 31, ob = rr * 64 + cc * 2; return st * 1024 + (ob ^ (((ob >> 9) & 1) << 5)); }
__host__ __device__ __forceinline__ void stage_rc(int b, int& R, int& C) { const int st = b / 1024, sb = b % 1024, swz = sb ^ (((sb >> 9) & 1) << 5); R = (st >> 1) * 16 + swz / 64; C = (st & 1) * 32 + (swz % 64) / 2; }
__host__ __device__ __forceinline__ int perm32(int rho) { const int n = rho >> 4, i = rho & 15; return 8 * (i >> 2) + 4 * n + (i & 3); }

struct Unit { int pm, pn; };
struct Gemm { const bf16_t* A; const bf16_t* Bt; int M, N, K, lda; int sa = 0, sb = 0; };

struct StaticOrder {
    int nM, nN, nwg, G, c;
    __host__ __device__ void init(int M, int N, int G_, int c_) { nM = M / BM; nN = N / BM; nwg = nM * nN; G = G_; c = c_; }
    __host__ __device__ bool next(int i, Unit& u) const {
        const long L = (long)i * G + c; if (L >= nwg) return false;
        int wgid = (int)L; { const int q = nwg / NXCD, r = nwg % NXCD, xcd = wgid % NXCD, off = wgid / NXCD; wgid = (xcd < r ? xcd * (q + 1) : r * (q + 1) + (xcd - r) * q) + off; }
        const int nig = WGM * nN, gid = wgid / nig, fm = gid * WGM, gsz = (nM - fm) < WGM ? (nM - fm) : WGM;
        u.pm = fm + ((wgid % nig) % gsz); u.pn = (wgid % nig) / gsz; return true;
    }
    __device__ __forceinline__ void a_ready(const Unit&) const {}
    __device__ __forceinline__ void done(const Unit&) const {}
};

template <class Epi, class Sched, bool ALIGN_EPI = false, bool SP2 = false, bool F8 = false>
__device__ __forceinline__ void gemm_phase(LAS unsigned char* lds, const Gemm g, const Sched& S, const Epi& E) {
    const int tid = threadIdx.x, wid = __builtin_amdgcn_readfirstlane(tid >> 6), lane = tid & 63, wr = wid >> 2, wc = wid & 3, fr = lane & 15, fq = lane >> 4;
    const int K = g.K, nt = K / BK, lda = g.lda; const int scA = g.sa, scB = g.sb; (void)scA; (void)scB;
    unsigned voffA[2], voffB[2];
#pragma unroll
    for (int i = 0; i < 2; ++i) { int R, C; stage_rc(tid * 16 + i * 8192, R, C); const int Rb = Epi::PERM ? ((R & ~31) + perm32(R & 31)) : R;
        voffA[i] = (unsigned)(R * lda + C) * 2u; voffB[i] = (unsigned)(Rb * K + C) * 2u; }
    const size_t kstep = (size_t)(BK * 2);
    const size_t hstepA = (size_t)HALF * lda * 2, hstepB = (size_t)HALF * K * 2;
    const size_t tstepA = 2 * hstepA, tstepB = 2 * hstepB;
    const unsigned ldsw = (unsigned)wid * 1024u; const unsigned ldsbase = (unsigned)(__UINTPTR_TYPE__)lds + ldsw;
    const int aoff = lds_byte(wr * 64 + fr, fq * 8), boff = lds_byte(wc * 32 + fr, fq * 8);
#define PG8_SA(b, h) (((b) * 2 + (h)) * HTB)
#define PG8_SB(b, h) ((4 + (b) * 2 + (h)) * HTB)
#define PG8_STAGE(bufoff, gbase, voff) do { _Pragma("unroll") for (int _i = 0; _i < 2; ++_i) \
        asm volatile("s_mov_b32 m0, %2\n\ts_nop 0\n\tglobal_load_lds_dwordx4 %0, %1" :: "v"((voff)[_i]), "s"((const char*)(gbase)), "s"(ldsbase + (unsigned)((bufoff) + _i * 8192)) : "memory", "m0"); } while (0)
#define PG8_LDA(dst, b, h) do { _Pragma("unroll") for (int m = 0; m < 4; ++m) _Pragma("unroll") for (int k = 0; k < 2; ++k) dst[m][k] = *(const LAS bf16x8*)(lds + PG8_SA(b, h) + aoff + m * 2048 + k * 1024); } while (0)
#define PG8_LDB(dst, b, h) do { _Pragma("unroll") for (int n = 0; n < 2; ++n) _Pragma("unroll") for (int k = 0; k < 2; ++k) dst[n][k] = *(const LAS bf16x8*)(lds + PG8_SB(b, h) + boff + n * 2048 + k * 1024); } while (0)
#define PG8_CAT(x) __builtin_shufflevector(__builtin_bit_cast(i32x4, (x)[0]), __builtin_bit_cast(i32x4, (x)[1]), 0, 1, 2, 3, 4, 5, 6, 7)
#define PG8_MMA(ai, bj, At, Bt) do { __builtin_amdgcn_s_setprio(1); if constexpr (F8) { _Pragma("unroll") for (int m = 0; m < 4; ++m) _Pragma("unroll") for (int n = 0; n < 2; ++n) \
        acc[ai][bj][m][n] = __builtin_amdgcn_mfma_scale_f32_16x16x128_f8f6f4(PG8_CAT(Bt[n]), PG8_CAT(At[m]), acc[ai][bj][m][n], 0, 0, 0, scB, 0, scA); } else { \
        _Pragma("unroll") for (int m = 0; m < 4; ++m) _Pragma("unroll") for (int n = 0; n < 2; ++n) _Pragma("unroll") for (int k = 0; k < 2; ++k) \
        acc[ai][bj][m][n] = __builtin_amdgcn_mfma_f32_16x16x32_bf16(Bt[n][k], At[m][k], acc[ai][bj][m][n], 0, 0, 0); } __builtin_amdgcn_s_setprio(0); } while (0)
#define PG8_WAIT_V(n) asm volatile("s_waitcnt vmcnt(" #n ")" ::: "memory")
#define PG8_WAIT_L(n) asm volatile("s_waitcnt lgkmcnt(" #n ")" ::: "memory")
#define PG8_BAR __builtin_amdgcn_s_barrier()
#define PG8_SCHED __builtin_amdgcn_sched_barrier(0)
    Unit cur, nxt; int ui = 0;
    if (!S.next(0, cur)) return;
    f32x4 acc[2][2][4][2];
#pragma unroll
    for (int a = 0; a < 2; ++a)
#pragma unroll
        for (int b = 0; b < 2; ++b)
#pragma unroll
            for (int m = 0; m < 4; ++m)
#pragma unroll
                for (int n = 0; n < 2; ++n) acc[a][b][m][n] = (f32x4){0.f, 0.f, 0.f, 0.f};
    bf16x8 At[4][2], B0[2][2], B1[2][2];
    const char* cA = (const char*)g.A + (size_t)cur.pm * tstepA; const char* cB = (const char*)g.Bt + (size_t)cur.pn * tstepB;
    S.a_ready(cur);
    if constexpr (SP2) {
        PG8_STAGE(PG8_SB(0, 0), cB, voffB); PG8_STAGE(PG8_SB(0, 1), cB + hstepB, voffB); PG8_STAGE(PG8_SA(0, 0), cA, voffA); PG8_STAGE(PG8_SA(0, 1), cA + hstepA, voffA);
        if (wr == 1) PG8_BAR;
        PG8_WAIT_V(2); PG8_BAR;
        PG8_STAGE(PG8_SB(1, 0), cB + kstep, voffB); PG8_STAGE(PG8_SA(1, 0), cA + kstep, voffA); PG8_STAGE(PG8_SB(1, 1), cB + hstepB + kstep, voffB);
        PG8_WAIT_V(6); PG8_BAR;
    } else {
        PG8_STAGE(PG8_SB(0, 0), cB, voffB); PG8_STAGE(PG8_SA(0, 0), cA, voffA); PG8_STAGE(PG8_SB(0, 1), cB + hstepB, voffB); PG8_STAGE(PG8_SA(0, 1), cA + hstepA, voffA);
        if (wr == 1) PG8_BAR;
        PG8_WAIT_V(4); PG8_BAR;
        PG8_STAGE(PG8_SB(1, 0), cB + kstep, voffB); PG8_STAGE(PG8_SA(1, 0), cA + kstep, voffA); PG8_STAGE(PG8_SB(1, 1), cB + hstepB + kstep, voffB);
        PG8_WAIT_V(6); PG8_BAR;
    }
    for (;;) {
        const bool has_next = S.next(ui + 1, nxt);
        const char* nA = has_next ? (const char*)g.A + (size_t)nxt.pm * tstepA : cA; const char* nB = has_next ? (const char*)g.Bt + (size_t)nxt.pn * tstepB : cB;
#pragma nounroll
        for (int t = 0; t < nt; t += 2) {
            const bool last = (t == nt - 2);
            const char* a1 = cA + (size_t)(t + 1) * kstep;
            const char* a2 = last ? nA : cA + (size_t)(t + 2) * kstep; const char* b2 = last ? nB : cB + (size_t)(t + 2) * kstep;
            const char* a3 = a2 + kstep; const char* b3 = b2 + kstep;
            if (last && has_next) S.a_ready(nxt);
            if constexpr (SP2) {
            PG8_LDB(B0, 0, 0); PG8_LDB(B1, 0, 1); PG8_SCHED; PG8_LDA(At, 0, 0); PG8_STAGE(PG8_SA(1, 1), a1 + hstepA, voffA);
            PG8_WAIT_V(8); PG8_WAIT_L(0); PG8_BAR; PG8_MMA(0, 0, At, B0); PG8_MMA(0, 1, At, B1); PG8_BAR; PG8_SCHED;
            PG8_LDA(At, 0, 1); PG8_STAGE(PG8_SB(0, 0), b2, voffB); PG8_STAGE(PG8_SB(0, 1), b2 + hstepB, voffB); PG8_STAGE(PG8_SA(0, 0), a2, voffA);
            PG8_WAIT_V(8); PG8_WAIT_L(0); PG8_BAR; PG8_MMA(1, 0, At, B0); PG8_MMA(1, 1, At, B1); PG8_BAR; PG8_SCHED;
            PG8_LDB(B0, 1, 0); PG8_LDB(B1, 1, 1); PG8_SCHED; PG8_LDA(At, 1, 0); PG8_STAGE(PG8_SA(0, 1), a2 + hstepA, voffA);
            PG8_WAIT_V(8); PG8_WAIT_L(0); PG8_BAR; PG8_MMA(0, 0, At, B0); PG8_MMA(0, 1, At, B1); PG8_BAR; PG8_SCHED;
            PG8_LDA(At, 1, 1); PG8_STAGE(PG8_SB(1, 0), b3, voffB); PG8_STAGE(PG8_SB(1, 1), b3 + hstepB, voffB); PG8_STAGE(PG8_SA(1, 0), a3, voffA);
            PG8_WAIT_V(8); PG8_WAIT_L(0); PG8_BAR; PG8_MMA(1, 0, At, B0); PG8_MMA(1, 1, At, B1); PG8_BAR; PG8_SCHED;
            } else {
            PG8_LDB(B0, 0, 0); PG8_SCHED; PG8_LDA(At, 0, 0); PG8_STAGE(PG8_SA(1, 1), a1 + hstepA, voffA);
            PG8_WAIT_L(8); PG8_BAR; PG8_WAIT_L(0); PG8_MMA(0, 0, At, B0); PG8_BAR; PG8_SCHED;
            PG8_LDB(B1, 0, 1); PG8_STAGE(PG8_SB(0, 0), b2, voffB);
            PG8_BAR; PG8_WAIT_L(0); PG8_MMA(0, 1, At, B1); PG8_BAR;
            PG8_LDA(At, 0, 1); PG8_STAGE(PG8_SA(0, 0), a2, voffA);
            PG8_BAR; PG8_WAIT_L(0); PG8_MMA(1, 0, At, B0); PG8_BAR; PG8_SCHED;
            PG8_STAGE(PG8_SB(0, 1), b2 + hstepB, voffB);
            PG8_WAIT_V(6); PG8_BAR; PG8_MMA(1, 1, At, B1); PG8_BAR;
            PG8_LDB(B0, 1, 0); PG8_SCHED; PG8_LDA(At, 1, 0); PG8_STAGE(PG8_SA(0, 1), a2 + hstepA, voffA);
            PG8_WAIT_L(8); PG8_BAR; PG8_WAIT_L(0); PG8_MMA(0, 0, At, B0); PG8_BAR; PG8_SCHED;
            PG8_LDB(B1, 1, 1); PG8_STAGE(PG8_SB(1, 0), b3, voffB);
            PG8_BAR; PG8_WAIT_L(0); PG8_MMA(0, 1, At, B1); PG8_BAR;
            PG8_LDA(At, 1, 1); PG8_STAGE(PG8_SA(1, 0), a3, voffA);
            PG8_BAR; PG8_WAIT_L(0); PG8_MMA(1, 0, At, B0); PG8_BAR; PG8_SCHED;
            PG8_STAGE(PG8_SB(1, 1), b3 + hstepB, voffB);
            PG8_WAIT_V(6); PG8_BAR; PG8_MMA(1, 1, At, B1); PG8_BAR;
            }
        }
        if constexpr (ALIGN_EPI) { if (wr == 0) PG8_BAR; }
        E(acc, cur, wr, wc, fr, fq); S.done(cur);
        if (!has_next) break;
#pragma unroll
        for (int a = 0; a < 2; ++a)
#pragma unroll
            for (int b = 0; b < 2; ++b)
#pragma unroll
                for (int m = 0; m < 4; ++m)
#pragma unroll
                    for (int n = 0; n < 2; ++n) acc[a][b][m][n] = (f32x4){0.f, 0.f, 0.f, 0.f};
        cur = nxt; cA = nA; cB = nB; ++ui;
        if constexpr (ALIGN_EPI) { if (wr == 1) PG8_BAR; }
    }
    PG8_WAIT_V(0);
    if constexpr (!ALIGN_EPI) { if (wr == 0) PG8_BAR; }
    PG8_BAR;
#undef PG8_SA
#undef PG8_SB
#undef PG8_STAGE
#undef PG8_LDA
#undef PG8_LDB
#undef PG8_MMA
#undef PG8_CAT
#undef PG8_WAIT_V
#undef PG8_WAIT_L
#undef PG8_BAR
#undef PG8_SCHED
}

__device__ __forceinline__ u32x4 pack8(f32x4 v0, f32x4 v1) { u32x4 w; w.x = pk2(v0[0], v0[1]); w.y = pk2(v0[2], v0[3]); w.z = pk2(v1[0], v1[1]); w.w = pk2(v1[2], v1[3]); return w; }
__device__ __forceinline__ void unpack8(u32x4 w, f32x4& v0, f32x4& v1) { v0 = (f32x4){bflo(w.x), bfhi(w.x), bflo(w.y), bfhi(w.y)}; v1 = (f32x4){bflo(w.z), bfhi(w.z), bflo(w.w), bfhi(w.w)}; }

struct EpiProj {
    static constexpr bool PERM = true;
    bf16_t* P; float* ALR; int pn0;
    __device__ __forceinline__ void operator()(const f32x4 (&acc)[2][2][4][2], const Unit& u, int wr, int wc, int fr, int fq) const {
        asm volatile("" : "+v"(fr), "+v"(fq));
        const int row0 = u.pm * BM + wr * 64 + fr; int pn = u.pn + pn0; const int cl = wc * 32 + 8 * fq;
        if (pn == 10) {
            if (wc == 0 && fq < 2) {
#pragma unroll
                for (int ai = 0; ai < 2; ++ai)
#pragma unroll
                    for (int m = 0; m < 4; ++m) { float* rp = ALR + (size_t)(row0 + ai * HALF + m * 16) * 16 + 8 * fq;
                        *(f32x4*)rp = acc[ai][0][m][0]; *(f32x4*)(rp + 4) = acc[ai][0][m][1]; }
            }
            return;
        }
        if (pn > 10) --pn;
        const int mode = pn < 8 ? 0 : (pn < 12 ? 1 : 2);
#pragma unroll
        for (int ai = 0; ai < 2; ++ai)
#pragma unroll
            for (int m = 0; m < 4; ++m) { bf16_t* rowp = P + (size_t)(row0 + ai * HALF + m * 16) * PLD + pn * BM + cl;
#pragma unroll
                for (int bj = 0; bj < 2; ++bj) { f32x4 v0 = acc[ai][bj][m][0], v1 = acc[ai][bj][m][1];
                    if (mode == 1) {
#pragma unroll
                        for (int i = 0; i < 4; ++i) { v0[i] = gelu_tanh(v0[i]); v1[i] = gelu_tanh(v1[i]); }
                    } else if (mode == 2) {
#pragma unroll
                        for (int i = 0; i < 4; ++i) { v0[i] = sigmoidf_(v0[i]); v1[i] = sigmoidf_(v1[i]); }
                    }
                    *(u32x4*)(rowp + bj * HALF) = pack8(v0, v1); } }
    }
};
struct EpiBrA {
    static constexpr bool PERM = true;
    bf16_t* P;
    __device__ __forceinline__ void operator()(const f32x4 (&acc)[2][2][4][2], const Unit& u, int wr, int wc, int fr, int fq) const {
        const int row0 = u.pm * BM + wr * 64 + fr; const int c0 = u.pn * BM + wc * 32 + 8 * fq;
#pragma unroll
        for (int ai = 0; ai < 2; ++ai)
#pragma unroll
            for (int m = 0; m < 4; ++m) { bf16_t* rowp = P + (size_t)(row0 + ai * HALF + m * 16) * PLD;
#pragma unroll
                for (int bj = 0; bj < 2; ++bj) { const int c = c0 + bj * HALF; f32x4 g0, g1; unpack8(*(const u32x4*)(rowp + PC_GA + c), g0, g1);
                    *(u32x4*)(rowp + PC_MRG + c) = pack8(acc[ai][bj][m][0] * g0, acc[ai][bj][m][1] * g1); } }
    }
};
struct EpiBrB {
    static constexpr bool PERM = true;
    bf16_t* P;
    __device__ __forceinline__ void operator()(const f32x4 (&acc)[2][2][4][2], const Unit& u, int wr, int wc, int fr, int fq) const {
        const int row0 = u.pm * BM + wr * 64 + fr; const int c0 = u.pn * BM + wc * 32 + 8 * fq;
#pragma unroll
        for (int ai = 0; ai < 2; ++ai)
#pragma unroll
            for (int m = 0; m < 4; ++m) { bf16_t* rowp = P + (size_t)(row0 + ai * HALF + m * 16) * PLD;
#pragma unroll
                for (int bj = 0; bj < 2; ++bj) { const int c = c0 + bj * HALF; f32x4 g0, g1, p0, p1; unpack8(*(const u32x4*)(rowp + PC_GB + c), g0, g1); unpack8(*(const u32x4*)(rowp + PC_MRG + c), p0, p1);
                    *(u32x4*)(rowp + PC_MRG + c) = pack8(p0 + acc[ai][bj][m][0] * g0, p1 + acc[ai][bj][m][1] * g1); } }
    }
};
struct EpiOut {
    static constexpr bool PERM = true;
    const float* X; float* O;
    __device__ __forceinline__ void operator()(const f32x4 (&acc)[2][2][4][2], const Unit& u, int wr, int wc, int fr, int fq) const {
        const int row0 = u.pm * BM + wr * 64 + fr; const int c0 = u.pn * BM + wc * 32 + 8 * fq;
#pragma unroll
        for (int ai = 0; ai < 2; ++ai)
#pragma unroll
            for (int m = 0; m < 4; ++m) { const size_t ro = (size_t)(row0 + ai * HALF + m * 16) * D;
#pragma unroll
                for (int bj = 0; bj < 2; ++bj) { const int c = c0 + bj * HALF;
                    const f32x4 x0 = *(const f32x4*)(X + ro + c), x1 = *(const f32x4*)(X + ro + c + 4);
                    *(f32x4*)(O + ro + c) = x0 + acc[ai][bj][m][0]; *(f32x4*)(O + ro + c + 4) = x1 + acc[ai][bj][m][1]; } }
    }
};
struct EpiScores {
    static constexpr bool PERM = true;
    float* SC;
    __device__ __forceinline__ void operator()(const f32x4 (&acc)[2][2][4][2], const Unit& u, int wr, int wc, int fr, int fq) const {
        const int tb0 = u.pm * 16 + wr * 4; const int cq0 = (u.pn * BM + wc * 32 + 8 * fq) >> 2;
#pragma unroll
        for (int ai = 0; ai < 2; ++ai)
#pragma unroll
            for (int m = 0; m < 4; ++m) { float* bp = SC + ((size_t)(tb0 + ai * 8 + m) * 512) * 64 + fr * 4;
#pragma unroll
                for (int bj = 0; bj < 2; ++bj)
#pragma unroll
                    for (int n = 0; n < 2; ++n) *(f32x4*)(bp + (size_t)(cq0 + bj * 32 + n) * 64) = acc[ai][bj][m][n]; }
    }
};
}

#define XB_TMO      128
#define XB_XCNT(j)  (256  + 64 * (j))
#define XB_XSUB(j)  (1280 + 64 * (j))
#define XB_XGEN(j)  (2304 + 64 * (j))
#define XB_TOP      3328
#define XB_TOPGEN   3392
#define XCD_BAR_WORDS 3456
#define XB_SPIN_CAP (1u << 18)
__device__ __forceinline__ unsigned xb_ld(unsigned* p)              { return __hip_atomic_load(p, __ATOMIC_RELAXED, __HIP_MEMORY_SCOPE_AGENT); }
__device__ __forceinline__ unsigned xb_add(unsigned* p, unsigned v) { return __hip_atomic_fetch_add(p, v, __ATOMIC_RELAXED, __HIP_MEMORY_SCOPE_AGENT); }
__device__ __forceinline__ unsigned xb_xcc_id() { return (unsigned)__builtin_amdgcn_s_getreg((3 << 11) | 20) & 0xFu; }
#define XB_SPIN(cond, bar) do { unsigned _sp = 0; while (cond) { __builtin_amdgcn_s_sleep(1); \
    if ((++_sp & 255u) == 0u) { if (xb_ld(&(bar)[XB_TMO])) break; if (_sp > XB_SPIN_CAP) { atomicAdd(&(bar)[XB_TMO], 1u); break; } } } } while (0)
struct XcdBarrier { unsigned* bar; unsigned x; volatile LAS unsigned* st; };
__device__ __forceinline__ XcdBarrier xcd_barrier_post(unsigned* bar, volatile LAS unsigned* st) {
    XcdBarrier b; b.bar = bar; b.x = xb_xcc_id(); b.st = st;
    if (threadIdx.x == 0) (void)xb_add(&bar[XB_XCNT(b.x)], 1u);
    return b;
}
__device__ __forceinline__ void xcd_barrier_complete(unsigned* bar, unsigned x, unsigned& nloc, unsigned& nx) {
    const unsigned G = gridDim.x * gridDim.y * gridDim.z;
    unsigned sum, cnt, mine, sp = 0u;
    for (;;) {
        sum = 0u; cnt = 0u; mine = 0u;
#pragma unroll
        for (unsigned j = 0; j < 16; ++j) { const unsigned c = xb_ld(&bar[XB_XCNT(j)]); sum += c; cnt += (c > 0u) ? 1u : 0u; mine = (j == x) ? c : mine; }
        if (sum == G) break;
        __builtin_amdgcn_s_sleep(1);
        if ((++sp & 255u) == 0u) { if (xb_ld(&bar[XB_TMO])) break; if (sp > XB_SPIN_CAP) { atomicAdd(&bar[XB_TMO], 1u); break; } }
    }
    nloc = mine > 0u ? mine : 1u; nx = cnt > 0u ? cnt : 1u;
}
__device__ __forceinline__ void xcd_barrier(const XcdBarrier& b) {
    asm volatile("s_waitcnt vmcnt(0)" ::: "memory");
    __syncthreads();
    if (threadIdx.x == 0) {
        unsigned* bar = b.bar;
        __builtin_amdgcn_s_waitcnt(0);
        unsigned nloc = b.st[0], nx = b.st[1];
        if (nloc == 0u) { xcd_barrier_complete(bar, b.x, nloc, nx); b.st[0] = nloc; b.st[1] = nx; }
        const unsigned old = xb_add(&bar[XB_XSUB(b.x)], 1u);
        const unsigned gen = old / nloc;
        if (old + 1u == (gen + 1u) * nloc) {
            __builtin_amdgcn_fence(__ATOMIC_RELEASE, "agent");
            asm volatile("s_waitcnt vmcnt(0)" ::: "memory");
            const unsigned og = xb_add(&bar[XB_TOP], 1u);
            const unsigned tg = og / nx;
            if (og + 1u == (tg + 1u) * nx) xb_add(&bar[XB_TOPGEN], 1u);
            else XB_SPIN(xb_ld(&bar[XB_TOPGEN]) == tg, bar);
            __builtin_amdgcn_fence(__ATOMIC_ACQUIRE, "agent");
            xb_add(&bar[XB_XGEN(b.x)], 1u);
            asm volatile("s_waitcnt vmcnt(0)" ::: "memory");
        } else {
            XB_SPIN(xb_ld(&bar[XB_XGEN(b.x)]) == gen, bar);
            __builtin_amdgcn_fence(__ATOMIC_ACQUIRE, "agent");
            asm volatile("s_waitcnt vmcnt(0)" ::: "memory");
        }
    }
    __syncthreads();
}

struct Args {
    const float* in[20]; float* out; unsigned char* ws; int ph_lo, ph_hi, li, pad;
};
enum { I_X = 0, I_N1G, I_WIN, I_WGU, I_BG, I_GLAG, I_SLNG, I_SLNB, I_SW, I_SB, I_WBA, I_WBB, I_WOUT, I_N2G, I_WQ, I_K1, I_K2, I_PU, I_PV, I_FG };

struct Frame {
    LAS unsigned char* lds;
    int tid, lane, wave, G, bid;
};

__device__ __forceinline__ float clamp448(float v) { return __builtin_amdgcn_fmed3f(v, -448.f, 448.f); }
template <int MODE, bool F8 = false>
__device__ __forceinline__ void p0_transpose_item(const float* W, int K, int Nsrc, int Ndst, bf16_t* WT, LAS float* scr, int item, int lane, float sc8 = 1.f) {
    const int nblk = Ndst / 32, kb = item / nblk, nb = item % nblk, k0 = 64 * kb, n0 = 32 * nb;
    const int nd = n0 + (lane & 31);
    int sc = nd; bool valid = true;
    if (MODE == 1) { if (nd < 2048) sc = nd; else if (nd < 2560) sc = nd + 16; else if (nd < 2576) sc = 2048 + (nd - 2560); else if (nd < 2816) { sc = 0; valid = false; } else sc = nd - 240; }
#pragma unroll 8
    for (int i = 0; i < 32; ++i) { const int kk = 2 * i + (lane >> 5); const float v = valid ? W[(size_t)(k0 + kk) * Nsrc + sc] : 0.f; scr[kk * 33 + (lane & 31)] = v; }
    LDS_WAIT(); asm volatile("" ::: "memory");
    if (F8) {
        const int c = lane & 3;
#pragma unroll
        for (int j = 0; j < 2; ++j) { const int n = (lane >> 2) + 16 * j; const LAS float* s = scr + (16 * c) * 33 + n; u32x4 o;
#pragma unroll
            for (int q = 0; q < 4; ++q) { int w = 0; w = __builtin_amdgcn_cvt_pk_fp8_f32(clamp448(s[(4 * q) * 33] * sc8), clamp448(s[(4 * q + 1) * 33] * sc8), w, false);
                w = __builtin_amdgcn_cvt_pk_fp8_f32(clamp448(s[(4 * q + 2) * 33] * sc8), clamp448(s[(4 * q + 3) * 33] * sc8), w, true); o[q] = (unsigned)w; }
            *(u32x4*)((unsigned char*)WT + (size_t)(n0 + n) * K + k0 + 16 * c) = o; }
    } else {
    const int c = lane & 7;
#pragma unroll
    for (int j = 0; j < 4; ++j) { const int n = (lane >> 3) + 8 * j; const LAS float* s = scr + (8 * c) * 33 + n;
        u32x4 o; o.x = pk2(s[0 * 33], s[1 * 33]); o.y = pk2(s[2 * 33], s[3 * 33]); o.z = pk2(s[4 * 33], s[5 * 33]); o.w = pk2(s[6 * 33], s[7 * 33]);
        *(u32x4*)(WT + (size_t)(n0 + n) * K + k0 + 8 * c) = o; }
    }
    LDS_WAIT(); asm volatile("" ::: "memory");
}
template <int OM, int NB>
__device__ __forceinline__ void rms_rows_to_bf16(int lane, const float* x0, size_t xstride, const float* g, bf16_t* o0, size_t ostride, unsigned* o80 = nullptr, size_t o8stride = 0) {
    f32x4 v[NB][4]; float s[NB];
#pragma unroll
    for (int b = 0; b < NB; ++b) { const f32x4* xr = (const f32x4*)(x0 + b * xstride) + lane;
#pragma unroll
        for (int j = 0; j < 4; ++j) v[b][j] = xr[64 * j]; }
#pragma unroll
    for (int b = 0; b < NB; ++b) { s[b] = 0.f;
#pragma unroll
        for (int j = 0; j < 4; ++j) s[b] += (v[b][j].x * v[b][j].x + v[b][j].y * v[b][j].y) + (v[b][j].z * v[b][j].z + v[b][j].w * v[b][j].w); }
#pragma unroll
    for (int o = 1; o < 64; o <<= 1) {
#pragma unroll
        for (int b = 0; b < NB; ++b) s[b] += __shfl_xor(s[b], o); }
    const f32x4* gr = (const f32x4*)g + lane;
#pragma unroll
    for (int b = 0; b < NB; ++b) { const float rstd = 1.f / sqrtf(s[b] * (1.f / D) + EPS); u32x2* o8 = (u32x2*)(o0 + b * ostride) + lane;
#pragma unroll
        for (int j = 0; j < 4; ++j) { const f32x4 gg = gr[64 * j]; const f32x4 y = v[b][j] * rstd * gg; u32x2 o; o.x = pk2(y.x, y.y); o.y = pk2(y.z, y.w); if (OM & 1) o8[64 * j] = o;
            if (OM == 3) { int w = 0; w = __builtin_amdgcn_cvt_pk_fp8_f32(clamp448(bflo(o.x) * 16.f), clamp448(bfhi(o.x) * 16.f), w, false); w = __builtin_amdgcn_cvt_pk_fp8_f32(clamp448(bflo(o.y) * 16.f), clamp448(bfhi(o.y) * 16.f), w, true); (o80 + b * o8stride)[64 * j + lane] = (unsigned)w; }
            if (OM == 2) { int w = 0; w = __builtin_amdgcn_cvt_pk_fp8_f32(clamp448(y.x * 16.f), clamp448(y.y * 16.f), w, false); w = __builtin_amdgcn_cvt_pk_fp8_f32(clamp448(y.z * 16.f), clamp448(y.w * 16.f), w, true); (o80 + b * o8stride)[64 * j + lane] = (unsigned)w; } } }
}
__device__ __forceinline__ float wave_max(float v) {
#pragma unroll
    for (int o = 1; o < 64; o <<= 1) v = fmaxf(v, __shfl_xor(v, o));
    return v;
}
template <int NB>
__device__ __forceinline__ void cvt_rows_fp8(int lane, const float* const (&src)[NB], unsigned char* const (&dst16)[NB], float* const (&scale_out)[NB]) {
    f32x4 v[NB][4]; float m[NB];
#pragma unroll
    for (int b = 0; b < NB; ++b) {
#pragma unroll
        for (int j = 0; j < 4; ++j) v[b][j] = *(const GAS f32x4*)(src[b] + 16 * lane + 4 * j); }
#pragma unroll
    for (int b = 0; b < NB; ++b) { m[b] = 0.f;
#pragma unroll
        for (int j = 0; j < 4; ++j) m[b] = fmaxf(m[b], fmaxf(fmaxf(fabsf(v[b][j].x), fabsf(v[b][j].y)), fmaxf(fabsf(v[b][j].z), fabsf(v[b][j].w)))); }
#pragma unroll
    for (int o = 1; o < 64; o <<= 1) {
#pragma unroll
        for (int b = 0; b < NB; ++b) m[b] = fmaxf(m[b], __shfl_xor(m[b], o)); }
#pragma unroll
    for (int b = 0; b < NB; ++b) { const float inv = m[b] > 0.f ? 224.f / m[b] : 0.f, sc = m[b] > 0.f ? m[b] * (1.f / 224.f) : 1.f;
        u32x4 o;
#pragma unroll
        for (int j = 0; j < 4; ++j) { int w = 0; w = __builtin_amdgcn_cvt_pk_fp8_f32(v[b][j].x * inv, v[b][j].y * inv, w, false); w = __builtin_amdgcn_cvt_pk_fp8_f32(v[b][j].z * inv, v[b][j].w * inv, w, true); o[j] = (unsigned)w; }
        *(GAS u32x4*)dst16[b] = o;
        if (lane == 0) *(GAS float*)scale_out[b] = sc; }
}
__device__ __forceinline__ unsigned fp4_code(float t) { const float a = fabsf(t);
    const unsigned c = (unsigned)(a >= 0.25f) + (unsigned)(a >= 0.75f) + (unsigned)(a >= 1.25f) + (unsigned)(a >= 1.75f) + (unsigned)(a >= 2.5f) + (unsigned)(a >= 3.5f) + (unsigned)(a >= 5.f);
    return c | (t < 0.f ? 8u : 0u); }
template <int NB>
__device__ __forceinline__ void cvt_rows_fp4(int lane, const float* const (&src)[NB], unsigned char* const (&dst8)[NB], float* const (&scale_out)[NB]) {
    f32x4 v[NB][4]; float m[NB];
#pragma unroll
    for (int b = 0; b < NB; ++b) {
#pragma unroll
        for (int j = 0; j < 4; ++j) v[b][j] = *(const GAS f32x4*)(src[b] + 16 * lane + 4 * j); }
#pragma unroll
    for (int b = 0; b < NB; ++b) { m[b] = 0.f;
#pragma unroll
        for (int j = 0; j < 4; ++j) m[b] = fmaxf(m[b], fmaxf(fmaxf(fabsf(v[b][j].x), fabsf(v[b][j].y)), fmaxf(fabsf(v[b][j].z), fabsf(v[b][j].w)))); }
#pragma unroll
    for (int o = 1; o < 64; o <<= 1) {
#pragma unroll
        for (int b = 0; b < NB; ++b) m[b] = fmaxf(m[b], __shfl_xor(m[b], o)); }
#pragma unroll
    for (int b = 0; b < NB; ++b) { const float inv = m[b] > 0.f ? 6.f / m[b] : 0.f, sc = m[b] > 0.f ? m[b] * (1.f / 6.f) : 1.f;
        u32x2 o;
#pragma unroll
        for (int h = 0; h < 2; ++h) { unsigned w = 0;
#pragma unroll
            for (int j = 0; j < 2; ++j) { const f32x4 t = v[b][2 * h + j] * inv;
                w |= (fp4_code(t.x) | (fp4_code(t.y) << 4) | (fp4_code(t.z) << 8) | (fp4_code(t.w) << 12)) << (16 * j); }
            o[h] = w; }
        *(GAS u32x2*)dst8[b] = o;
        if (lane == 0) *(GAS float*)scale_out[b] = sc; }
}
__device__ __forceinline__ void convert_tables(const Frame& F, const Args& A, int wi, int nw) {
    unsigned char* ws = A.ws; const int gw = wi, NGW = nw;
    {
        int mc = gw;
        for (; mc + 3 * NGW < NEXP; mc += 4 * NGW) { const float* src[4]; unsigned char* dst[4]; float* sco[4];
#pragma unroll
            for (int b = 0; b < 4; ++b) { const int e = mc + b * NGW; src[b] = A.in[I_PU] + (size_t)e * D; dst[b] = ws + WS_U8 + (size_t)((e & (UNG - 1)) * (NEXP / UNG) + (e >> UNG_SH)) * 512 + 8 * F.lane; sco[b] = (float*)(ws + WS_SU) + e; }
            cvt_rows_fp4<4>(F.lane, src, dst, sco); }
        for (; mc < NEXP; mc += NGW) { const float* src[1]; unsigned char* dst[1]; float* sco[1];
            const int e = mc; src[0] = A.in[I_PU] + (size_t)e * D; dst[0] = ws + WS_U8 + (size_t)((e & (UNG - 1)) * (NEXP / UNG) + (e >> UNG_SH)) * 512 + 8 * F.lane; sco[0] = (float*)(ws + WS_SU) + e;
            cvt_rows_fp4<1>(F.lane, src, dst, sco); }
    }
    {
        int mc = gw;
        for (; mc + 3 * NGW < NEXP; mc += 4 * NGW) { const float* src[4]; unsigned char* dst[4]; float* sco[4];
#pragma unroll
            for (int b = 0; b < 4; ++b) { const int e = mc + b * NGW; src[b] = A.in[I_PV] + (size_t)e * D; dst[b] = ws + WS_V8 + ((size_t)(F.lane >> 3) * NEXP + e) * 128 + 16 * (F.lane & 7); sco[b] = (float*)(ws + WS_SV) + e; }
            cvt_rows_fp8<4>(F.lane, src, dst, sco); }
        for (; mc < NEXP; mc += NGW) { const float* src[1]; unsigned char* dst[1]; float* sco[1];
            const int e = mc; src[0] = A.in[I_PV] + (size_t)e * D; dst[0] = ws + WS_V8 + ((size_t)(F.lane >> 3) * NEXP + e) * 128 + 16 * (F.lane & 7); sco[0] = (float*)(ws + WS_SV) + e;
            cvt_rows_fp8<1>(F.lane, src, dst, sco); }
    }
}
__device__ __forceinline__ void phase0(const Frame& F, const Args& A) {
    unsigned char* ws = A.ws;
    {
        LAS float* kx = (LAS float*)F.lds;
        LAS float* wt = (LAS float*)(F.lds + 128 * 129 * 4);
        bf16_t* WQF = (bf16_t*)(ws + WS_WQF);
        for (int it = F.bid; it < 512; it += F.G) {
            const int hh = it >> 5, kblk = it & 31, k0 = kblk * 32;
            const float* kX = (hh & 1) ? A.in[I_K2] : A.in[I_K1];
            __syncthreads();
            for (int e = F.tid; e < 128 * 128; e += 512) kx[(e >> 7) * 129 + (e & 127)] = kX[e];
            for (int e = F.tid; e < 32 * 128; e += 512) wt[e] = A.in[I_WQ][(size_t)(k0 + (e >> 7)) * 2048 + hh * 128 + (e & 127)];
            __syncthreads();
            const int key = F.tid & 127, kq = F.tid >> 7;
            float acc[8];
#pragma unroll
            for (int i = 0; i < 8; ++i) acc[i] = 0.f;
            for (int d = 0; d < 128; ++d) { const float b = kx[key * 129 + d];
#pragma unroll
                for (int i = 0; i < 8; ++i) acc[i] += wt[(kq * 8 + i) * 128 + d] * b; }
            u32x4 o; o.x = pk2(acc[0], acc[1]); o.y = pk2(acc[2], acc[3]); o.z = pk2(acc[4], acc[5]); o.w = pk2(acc[6], acc[7]);
            *(u32x4*)(WQF + (size_t)(hh * 128 + key) * 1024 + k0 + kq * 8) = o;
        }
        __syncthreads();
    }
    LAS float* scr = (LAS float*)(F.lds + F.wave * 16384);
    const int gw = F.bid * NWAVES + F.wave, NGW = F.G * NWAVES;
    constexpr int I_IN = 16 * (NPROJ / 32), I_A = 8 * 32, I_B = 8 * 32, I_O = 16 * 32;
    constexpr int NITEMS = I_IN + I_A + I_B + I_O;
    for (int it = gw; it < NITEMS; it += NGW) {
        int r = it;
        if (r < I_IN) { if ((r % (NPROJ / 32)) * 32 >= F8_LO * 256) p0_transpose_item<1, true>(A.in[I_WIN], 1024, 5136, NPROJ, (bf16_t*)(ws + WS_W8), scr, r, F.lane, 1024.f);
                        else p0_transpose_item<1, false>(A.in[I_WIN], 1024, 5136, NPROJ, (bf16_t*)(ws + WS_WIN), scr, r, F.lane); continue; } r -= I_IN;
        if (r < I_A) { p0_transpose_item<0>(A.in[I_WBA], 512, 1024, 1024, (bf16_t*)(ws + WS_WA), scr, r, F.lane); continue; } r -= I_A;
        if (r < I_B) { p0_transpose_item<0>(A.in[I_WBB], 512, 1024, 1024, (bf16_t*)(ws + WS_WB), scr, r, F.lane); continue; } r -= I_B;
        p0_transpose_item<0>(A.in[I_WOUT], 1024, 1024, 1024, (bf16_t*)(ws + WS_WOUT), scr, r, F.lane);
    }
    constexpr int OM1 = F8_LO <= 0 ? 2 : (F8_LO >= 21 ? 1 : 3);
    { int m = gw; for (; m + 3 * NGW < T_TOK; m += 4 * NGW) rms_rows_to_bf16<OM1, 4>(F.lane, A.in[I_X] + (size_t)m * D, (size_t)NGW * D, A.in[I_N1G], (bf16_t*)(ws + WS_N1) + (size_t)m * D, (size_t)NGW * D, (unsigned*)(ws + WS_N18) + (size_t)m * 256, (size_t)NGW * 256);
      for (; m < T_TOK; m += NGW) rms_rows_to_bf16<OM1, 1>(F.lane, A.in[I_X] + (size_t)m * D, 0, A.in[I_N1G], (bf16_t*)(ws + WS_N1) + (size_t)m * D, 0, (unsigned*)(ws + WS_N18) + (size_t)m * 256, 0); }
}

__device__ __forceinline__ float log_sigmoid(float z) { return fminf(z, 0.f) - log1pf(__expf(-fabsf(z))); }

template <bool DRY>
__device__ __forceinline__ void gla_chunk_phase(const Frame& F, const Args& A) {
    unsigned char* ws = A.ws;
    const bf16_t* P = (const bf16_t*)(ws + WS_P);
    const float* ALR = (const float*)(ws + WS_ALR);
    LAS float* alr = (LAS float*)F.lds;
    LAS float* tot = (LAS float*)(F.lds + 4096);
    LAS bf16_t* kdT = (LAS bf16_t*)(F.lds + 8192);
    LAS bf16_t* vT = (LAS bf16_t*)(F.lds + 26624);
    LAS bf16_t* stT = (LAS bf16_t*)(F.lds + 45056);
    const int tid = F.tid, kk = tid & 127, seg = tid >> 7;
    const bool hconst = (F.G & 3) == 0;
    int hcur = -1; float w[16]; float bias = 0.f;
#pragma unroll
    for (int j = 0; j < 16; ++j) w[j] = 0.f;
    float na0, na1; bf16_t nk[16], nv[16];
#define GC_LOAD(unit) do { const int h_ = (unit) & 3, c_ = ((unit) >> 2) & 63, b_ = (unit) >> 8; const int t0_ = b_ * SEQ + c_ * 64; \
        na0 = ALR[(size_t)t0_ * 16 + tid]; na1 = ALR[(size_t)t0_ * 16 + 512 + tid]; \
        const bf16_t* kp_ = P + (size_t)(t0_ + 16 * seg) * PLD + PC_K + h_ * 128 + kk; const bf16_t* vp_ = P + (size_t)(t0_ + 16 * seg) * PLD + PC_V + h_ * 128 + kk; \
        _Pragma("unroll") for (int i_ = 0; i_ < 16; ++i_) { nk[i_] = kp_[(size_t)i_ * PLD]; nv[i_] = vp_[(size_t)i_ * PLD]; } } while (0)
    int unit = F.bid;
    if (unit < 2048) GC_LOAD(unit);
    for (; unit < 2048; unit += F.G) {
        const int h = unit & 3;
        if (h != hcur) { hcur = h;
#pragma unroll
            for (int j = 0; j < 16; ++j) w[j] = A.in[I_WGU][(size_t)j * 512 + h * 128 + kk];
            bias = A.in[I_BG][h * 128 + kk]; }
        __syncthreads();
        alr[tid] = na0; alr[512 + tid] = na1;
        bf16_t kr[16], vr[16];
#pragma unroll
        for (int i = 0; i < 16; ++i) { kr[i] = nk[i]; vr[i] = nv[i]; }
        if (unit + F.G < 2048) GC_LOAD(unit + F.G);
        __syncthreads();
        float cum[16]; float run = 0.f;
#pragma unroll
        for (int i = 0; i < 16; ++i) { const LAS f32x4* ap = (const LAS f32x4*)(alr + (16 * seg + i) * 16); float z = bias;
#pragma unroll
            for (int q = 0; q < 4; ++q) { const f32x4 a4 = ap[q]; z += a4.x * w[4 * q] + a4.y * w[4 * q + 1] + a4.z * w[4 * q + 2] + a4.w * w[4 * q + 3]; }
            const float ls = fminf(z, 0.f) - __logf(1.f + __expf(-fabsf(z)));
            run += ls * (1.f / 16.f); cum[i] = run; }
        tot[seg * 128 + kk] = run;
        __syncthreads();
        {
            const float t0s = tot[kk], t1s = tot[128 + kk], t2s = tot[256 + kk], t3s = tot[384 + kk];
            const float total = (t0s + t1s) + (t2s + t3s);
            const float prefix = seg == 0 ? 0.f : (seg == 1 ? t0s : (seg == 2 ? t0s + t1s : t0s + t1s + t2s));
            unsigned kw[8], vw[8];
#pragma unroll
            for (int i = 0; i < 8; ++i) {
                const float e0 = __expf(total - (prefix + cum[2 * i])), e1 = __expf(total - (prefix + cum[2 * i + 1]));
                kw[i] = pk2(bf1(kr[2 * i]) * e0, bf1(kr[2 * i + 1]) * e1); vw[i] = (unsigned)vr[2 * i] | ((unsigned)vr[2 * i + 1] << 16);
            }
            *(LAS u32x4*)(kdT + kk * 72 + 16 * seg) = (u32x4){kw[0], kw[1], kw[2], kw[3]}; *(LAS u32x4*)(kdT + kk * 72 + 16 * seg + 8) = (u32x4){kw[4], kw[5], kw[6], kw[7]};
            *(LAS u32x4*)(vT + kk * 72 + 16 * seg) = (u32x4){vw[0], vw[1], vw[2], vw[3]}; *(LAS u32x4*)(vT + kk * 72 + 16 * seg + 8) = (u32x4){vw[4], vw[5], vw[6], vw[7]};
            if (seg == 0) ((float*)(DRY ? (unsigned char*)A.out + 96 * MiB : ws + WS_DEC))[(size_t)unit * 128 + kk] = __expf(total);
        }
        __syncthreads();
        {
            const int w8 = F.wave, l = F.lane, fr = l & 15, fq = l >> 4;
            f32x4 acc[8];
#pragma unroll
            for (int n = 0; n < 8; ++n) acc[n] = (f32x4){0.f, 0.f, 0.f, 0.f};
#pragma unroll
            for (int ks = 0; ks < 2; ++ks) {
                const bf16x8 a = *(const LAS bf16x8*)(kdT + (16 * w8 + fr) * 72 + 32 * ks + 8 * fq);
#pragma unroll
                for (int n = 0; n < 8; ++n) { const bf16x8 bb = *(const LAS bf16x8*)(vT + (16 * n + fr) * 72 + 32 * ks + 8 * fq);
                    acc[n] = __builtin_amdgcn_mfma_f32_16x16x32_bf16(a, bb, acc[n], 0, 0, 0); }
            }
#pragma unroll
            for (int n = 0; n < 8; ++n) { u32x2 o; o.x = pk2(acc[n][0], acc[n][1]); o.y = pk2(acc[n][2], acc[n][3]);
                *(LAS u32x2*)(stT + (16 * n + fr) * 136 + 16 * w8 + 4 * fq) = o; }
        }
        __syncthreads();
        {
            bf16_t* ST = (bf16_t*)(DRY ? (unsigned char*)A.out : ws + WS_N1) + (size_t)unit * 16384;
            const int vv = tid >> 2, part = tid & 3;
#pragma unroll
            for (int q = 0; q < 4; ++q) *(u32x4*)(ST + (size_t)vv * 128 + 32 * part + 8 * q) = *(const LAS u32x4*)(stT + vv * 136 + 32 * part + 8 * q);
        }
    }
#undef GC_LOAD
    (void)hconst;
}

template <bool DRY>
__device__ __forceinline__ void sgu_unit(const Frame& F, const Args& A, int unit) {
    const int g = unit & 3, blk = (unit >> 2) & 31, b = unit >> 7;
    const int t0 = b * SEQ + blk * 128;
    bf16_t* P = (bf16_t*)(A.ws + WS_P);
    LAS bf16_t* wA = (LAS bf16_t*)F.lds;
    LAS bf16_t* vnT = (LAS bf16_t*)(F.lds + 34816);
    LAS float* st = (LAS float*)(F.lds + 69632);
    LAS bf16_t* suS = (LAS bf16_t*)(F.lds + 70656);
    const int tid = F.tid;
    __syncthreads();
    {
        const int j = tid >> 2, q = tid & 3;
        const bf16_t* sp = P + (size_t)(t0 + j) * PLD + PC_SV + q * 128;
        float s = 0.f, s2 = 0.f;
#pragma unroll
        for (int i = 0; i < 16; ++i) { const u32x4 w = *(const u32x4*)(sp + 8 * i);
            const float f[8] = {bflo(w.x), bfhi(w.x), bflo(w.y), bfhi(w.y), bflo(w.z), bfhi(w.z), bflo(w.w), bfhi(w.w)};
#pragma unroll
            for (int e = 0; e < 8; ++e) { s += f[e]; s2 += f[e] * f[e]; } }
        s += __shfl_xor(s, 1); s += __shfl_xor(s, 2); s2 += __shfl_xor(s2, 1); s2 += __shfl_xor(s2, 2);
        const float mu = s * (1.f / 512.f); const float var = fmaxf(s2 * (1.f / 512.f) - mu * mu, 0.f);
        if (q == 0) { st[2 * j] = mu; st[2 * j + 1] = 1.f / sqrtf(var + EPS); }
    }
    {
        const int i = tid >> 2, jb = (tid & 3) * 32;
        const float* wp = A.in[I_SW] + (size_t)g * 16384 + (size_t)i * 128 + jb;
        const bf16_t* sup = P + (size_t)(t0 + i) * PLD + PC_SU + g * 128 + jb;
#pragma unroll
        for (int q = 0; q < 4; ++q) { const f32x4 a = *(const f32x4*)(wp + 8 * q), bq = *(const f32x4*)(wp + 8 * q + 4);
            const bool z = (i < 64) && (jb + 8 * q >= 64);
            u32x4 o; o.x = pk2(a.x, a.y); o.y = pk2(a.z, a.w); o.z = pk2(bq.x, bq.y); o.w = pk2(bq.z, bq.w);
            if (z) o = (u32x4){0u, 0u, 0u, 0u};
            *(LAS u32x4*)(wA + i * 136 + jb + 8 * q) = o;
            *(LAS u32x4*)(suS + i * 136 + jb + 8 * q) = *(const u32x4*)(sup + 8 * q); }
    }
    const int cch = tid & 127, seg = tid >> 7;
    bf16_t xr[32];
    { const bf16_t* sp = P + (size_t)(t0 + 32 * seg) * PLD + PC_SV + g * 128 + cch;
#pragma unroll
      for (int i = 0; i < 32; ++i) xr[i] = sp[(size_t)i * PLD]; }
    const float lg = A.in[I_SLNG][g * 128 + cch], lb = A.in[I_SLNB][g * 128 + cch];
    __syncthreads();
    {
        unsigned ow[16];
#pragma unroll
        for (int i = 0; i < 16; ++i) { const int j = 32 * seg + 2 * i; const f32x4 ms = *(const LAS f32x4*)(st + 2 * j);
            ow[i] = pk2((bf1(xr[2 * i]) - ms.x) * ms.y * lg + lb, (bf1(xr[2 * i + 1]) - ms.z) * ms.w * lg + lb); }
#pragma unroll
        for (int q = 0; q < 4; ++q) *(LAS u32x4*)(vnT + cch * 136 + 32 * seg + 8 * q) = (u32x4){ow[4 * q], ow[4 * q + 1], ow[4 * q + 2], ow[4 * q + 3]};
    }
    __syncthreads();
    {
        const int w = F.wave, l = F.lane, fr = l & 15, fq = l >> 4;
        f32x4 acc[8];
#pragma unroll
        for (int n = 0; n < 8; ++n) acc[n] = (f32x4){0.f, 0.f, 0.f, 0.f};
#pragma unroll
        for (int ks = 0; ks < 4; ++ks) {
            const bf16x8 a = *(const LAS bf16x8*)(wA + (16 * w + fr) * 136 + 32 * ks + 8 * fq);
#pragma unroll
            for (int n = 0; n < 8; ++n) { const bf16x8 bb = *(const LAS bf16x8*)(vnT + (16 * n + fr) * 136 + 32 * ks + 8 * fq);
                acc[n] = __builtin_amdgcn_mfma_f32_16x16x32_bf16(a, bb, acc[n], 0, 0, 0); }
        }
#pragma unroll
        for (int jj = 0; jj < 4; ++jj) { const int i = 16 * w + 4 * fq + jj; const float bias = A.in[I_SB][g * 128 + i];
            LAS bf16_t* rp = suS + i * 136 + fr;
#pragma unroll
            for (int n = 0; n < 8; ++n) { const float su = bf1(rp[16 * n]); rp[16 * n] = (bf16_t)f2bf(su * (acc[n][jj] + bias)); } }
    }
    __syncthreads();
    {
        const int i = tid >> 2, jb = (tid & 3) * 32;
        bf16_t* yp = DRY ? (bf16_t*)A.out + (size_t)(t0 + i) * 512 + g * 128 + jb : P + (size_t)(t0 + i) * PLD + PC_SU + g * 128 + jb;
#pragma unroll
        for (int q = 0; q < 4; ++q) *(u32x4*)(yp + 8 * q) = *(const LAS u32x4*)(suS + i * 136 + jb + 8 * q);
    }
}

template <bool DRY>
__device__ __forceinline__ void gla_scan(const Frame& F, const Args& A) {
    bf16_t* ST = (bf16_t*)(A.ws + WS_N1); bf16_t* STO = DRY ? (bf16_t*)A.out : ST; const float* DEC = (const float*)(A.ws + WS_DEC);
    for (int gi = F.bid * 512 + F.tid; gi < 131072; gi += F.G * 512) {
        const int k4 = gi & 31, vv = (gi >> 5) & 127, h = (gi >> 12) & 3, b = gi >> 14;
        float s0 = 0.f, s1 = 0.f, s2 = 0.f, s3 = 0.f;
        u32x2 wa[8], wb[8]; f32x4 da[8], db[8];
#define SCAN_LOAD(W, Dd, c0) do { _Pragma("unroll") for (int i_ = 0; i_ < 8; ++i_) { const size_t u_ = (size_t)((b * 64 + (c0) + i_) * 4 + h); \
            W[i_] = *(const u32x2*)(ST + u_ * 16384 + (size_t)vv * 128 + k4 * 4); Dd[i_] = *(const f32x4*)(DEC + u_ * 128 + k4 * 4); } } while (0)
#define SCAN_STEP(W, Dd, c0) do { _Pragma("unroll") for (int i_ = 0; i_ < 8; ++i_) { const size_t u_ = (size_t)((b * 64 + (c0) + i_) * 4 + h); \
            s0 = Dd[i_].x * s0 + bflo(W[i_].x); s1 = Dd[i_].y * s1 + bfhi(W[i_].x); s2 = Dd[i_].z * s2 + bflo(W[i_].y); s3 = Dd[i_].w * s3 + bfhi(W[i_].y); \
            u32x2 o_; o_.x = pk2(s0, s1); o_.y = pk2(s2, s3); *(u32x2*)(STO + u_ * 16384 + (size_t)vv * 128 + k4 * 4) = o_; } } while (0)
        SCAN_LOAD(wa, da, 0);
#pragma unroll
        for (int c0 = 0; c0 < 64; c0 += 16) {
            SCAN_LOAD(wb, db, c0 + 8);
            SCAN_STEP(wa, da, c0);
            if (c0 + 16 < 64) SCAN_LOAD(wa, da, c0 + 16);
            SCAN_STEP(wb, db, c0 + 8);
        }
#undef SCAN_LOAD
#undef SCAN_STEP
    }
}

template <bool DRY>
__device__ __forceinline__ void gla_out_phase(const Frame& F, const Args& A) {
    bf16_t* P = (bf16_t*)(A.ws + WS_P);
    LAS bf16_t* qA = (LAS bf16_t*)F.lds;
    LAS bf16_t* sB = (LAS bf16_t*)(F.lds + 17408);
    LAS float* oF = (LAS float*)(F.lds + 52224);
    const int tid = F.tid, s = tid >> 3, cb = (tid & 7) * 16, vv = tid >> 2, kb = (tid & 3) * 32;
    u32x4 nq0, nq1, ns0, ns1, ns2, ns3, nr0, nr1;
#define GO_LOAD(unit) do { const int h_ = (unit) & 3, c_ = ((unit) >> 2) & 63, b_ = (unit) >> 8; const int t0_ = b_ * SEQ + c_ * 64; \
        const bf16_t* qp_ = P + (size_t)(t0_ + s) * PLD + PC_Q + h_ * 128 + cb; nq0 = *(const u32x4*)qp_; nq1 = *(const u32x4*)(qp_ + 8); \
        const bf16_t* sp_ = (const bf16_t*)(A.ws + WS_N1) + (size_t)(unit) * 16384 + (size_t)vv * 128 + kb; ns0 = *(const u32x4*)sp_; ns1 = *(const u32x4*)(sp_ + 8); ns2 = *(const u32x4*)(sp_ + 16); ns3 = *(const u32x4*)(sp_ + 24); \
        const bf16_t* rp_ = P + (size_t)(t0_ + s) * PLD + PC_R + h_ * 128 + cb; nr0 = *(const u32x4*)rp_; nr1 = *(const u32x4*)(rp_ + 8); } while (0)
    int unit = F.bid;
    if (unit < 2048) GO_LOAD(unit);
    for (; unit < 2048; unit += F.G) {
        const int h = unit & 3, c = (unit >> 2) & 63, b = unit >> 8;
        const int t0 = b * SEQ + c * 64;
        __syncthreads();
        *(LAS u32x4*)(qA + s * 136 + cb) = nq0; *(LAS u32x4*)(qA + s * 136 + cb + 8) = nq1;
        *(LAS u32x4*)(sB + vv * 136 + kb) = ns0; *(LAS u32x4*)(sB + vv * 136 + kb + 8) = ns1; *(LAS u32x4*)(sB + vv * 136 + kb + 16) = ns2; *(LAS u32x4*)(sB + vv * 136 + kb + 24) = ns3;
        const u32x4 r0 = nr0, r1 = nr1;
        if (unit + F.G < 2048) GO_LOAD(unit + F.G);
        __syncthreads();
        {
            const int w = F.wave, l = F.lane, fr = l & 15, fq = l >> 4, m = w & 3, nh = w >> 2;
            f32x4 acc[4];
#pragma unroll
            for (int n = 0; n < 4; ++n) acc[n] = (f32x4){0.f, 0.f, 0.f, 0.f};
#pragma unroll
            for (int ks = 0; ks < 4; ++ks) {
                const bf16x8 a = *(const LAS bf16x8*)(qA + (16 * m + fr) * 136 + 32 * ks + 8 * fq);
#pragma unroll
                for (int n = 0; n < 4; ++n) { const bf16x8 bb = *(const LAS bf16x8*)(sB + (16 * (4 * nh + n) + fr) * 136 + 32 * ks + 8 * fq);
                    acc[n] = __builtin_amdgcn_mfma_f32_16x16x32_bf16(a, bb, acc[n], 0, 0, 0); }
            }
            const float scale = 0.08838834764831845f;
#pragma unroll
            for (int n = 0; n < 4; ++n)
#pragma unroll
                for (int jj = 0; jj < 4; ++jj) oF[(16 * m + 4 * fq + jj) * 132 + 16 * (4 * nh + n) + fr] = acc[n][jj] * scale;
        }
        __syncthreads();
        {
            float o[16]; float ss = 0.f;
#pragma unroll
            for (int i = 0; i < 16; ++i) { o[i] = oF[s * 132 + cb + i]; ss += o[i] * o[i]; }
            ss += __shfl_xor(ss, 1); ss += __shfl_xor(ss, 2); ss += __shfl_xor(ss, 4);
            const float rstd = 1.f / sqrtf(ss * (1.f / 128.f) + EPS);
            const unsigned rw[8] = {r0.x, r0.y, r0.z, r0.w, r1.x, r1.y, r1.z, r1.w};
            const float* gg = A.in[I_GLAG] + h * 128 + cb;
            unsigned ow[8];
#pragma unroll
            for (int i = 0; i < 8; ++i) { const float y0 = o[2 * i] * rstd * gg[2 * i] * siluf_(bflo(rw[i])), y1 = o[2 * i + 1] * rstd * gg[2 * i + 1] * siluf_(bfhi(rw[i])); ow[i] = pk2(y0, y1); }
            bf16_t* yp = DRY ? (bf16_t*)A.out + (size_t)(t0 + s) * 512 + h * 128 + cb : P + (size_t)(t0 + s) * PLD + PC_Q + h * 128 + cb;
            *(u32x4*)yp = (u32x4){ow[0], ow[1], ow[2], ow[3]}; *(u32x4*)(yp + 8) = (u32x4){ow[4], ow[5], ow[6], ow[7]};
        }
    }
#undef GO_LOAD
}

__device__ __forceinline__ unsigned ordkey(float v) { const unsigned u = __builtin_bit_cast(unsigned, v); return u ^ ((unsigned)((int)u >> 31) | 0x80000000u); }
__device__ __forceinline__ float unord(unsigned k) { const unsigned u = (k & 0x80000000u) ? (k & 0x7fffffffu) : ~k; return __builtin_bit_cast(float, u); }
#define INS16(r, xin) do { unsigned _x = (xin); _Pragma("unroll") for (int _i = 0; _i < 16; ++_i) { const unsigned _h = max((r)[_i], _x); _x = min((r)[_i], _x); (r)[_i] = _h; } } while (0)

#define CE(a, b) do { const unsigned _h = max((a), (b)), _l = min((a), (b)); (a) = _h; (b) = _l; } while (0)
#define SORT16(v) do { CE(v[0], v[1]); CE(v[2], v[3]); CE(v[0], v[2]); CE(v[1], v[3]); CE(v[1], v[2]); CE(v[4], v[5]); CE(v[6], v[7]); CE(v[4], v[6]); CE(v[5], v[7]); CE(v[5], v[6]); CE(v[0], v[4]); CE(v[2], v[6]); CE(v[2], v[4]); CE(v[1], v[5]); CE(v[3], v[7]); CE(v[3], v[5]); CE(v[1], v[2]); CE(v[3], v[4]); CE(v[5], v[6]); CE(v[8], v[9]); CE(v[10], v[11]); CE(v[8], v[10]); CE(v[9], v[11]); CE(v[9], v[10]); CE(v[12], v[13]); CE(v[14], v[15]); CE(v[12], v[14]); CE(v[13], v[15]); CE(v[13], v[14]); CE(v[8], v[12]); CE(v[10], v[14]); CE(v[10], v[12]); CE(v[9], v[13]); CE(v[11], v[15]); CE(v[11], v[13]); CE(v[9], v[10]); CE(v[11], v[12]); CE(v[13], v[14]); CE(v[0], v[8]); CE(v[4], v[12]); CE(v[4], v[8]); CE(v[2], v[10]); CE(v[6], v[14]); CE(v[6], v[10]); CE(v[2], v[4]); CE(v[6], v[8]); CE(v[10], v[12]); CE(v[1], v[9]); CE(v[5], v[13]); CE(v[5], v[9]); CE(v[3], v[11]); CE(v[7], v[15]); CE(v[7], v[11]); CE(v[3], v[5]); CE(v[7], v[9]); CE(v[11], v[13]); CE(v[1], v[2]); CE(v[3], v[4]); CE(v[5], v[6]); CE(v[7], v[8]); CE(v[9], v[10]); CE(v[11], v[12]); CE(v[13], v[14]); } while (0)
#define MERGE16(T, S) do { _Pragma("unroll") for (int _i = 0; _i < 16; ++_i) (T)[_i] = max((T)[_i], (S)[15 - _i]); \
    _Pragma("unroll") for (int _d = 8; _d >= 1; _d >>= 1) { _Pragma("unroll") for (int _i = 0; _i < 16; ++_i) if ((_i & _d) == 0) CE((T)[_i], (T)[_i + _d]); } } while (0)
__device__ __forceinline__ void peer_topk(const Frame& F, const Args& A) {
    const float* SC = (const float*)(A.ws + WS_P + P_SC);
    int* IDX = (int*)(A.ws + WS_P + P_IDX); float* GATE = (float*)(A.ws + WS_P + P_GATE);
    const int gw = F.bid * NWAVES + F.wave, NGW = F.G * NWAVES;
    for (int it = gw; it < 512 * 8; it += NGW) {
        const int h = it & 7, tb = it >> 3; const int tok = tb * 64 + F.lane;
        unsigned r1[16], r2[16], rc[16];
        const float* p1 = SC + ((size_t)(tok >> 4) * 512 + h * 64) * 64 + (tok & 15) * 4; const float* p2 = p1 + 32 * 64;
        {
            float raw[128]; unsigned sg[16];
#pragma unroll
            for (int jq = 0; jq < 32; ++jq) { const f32x4 t4 = *(const f32x4*)(p1 + jq * 64); raw[4 * jq] = t4.x; raw[4 * jq + 1] = t4.y; raw[4 * jq + 2] = t4.z; raw[4 * jq + 3] = t4.w; }
#pragma unroll
            for (int j = 0; j < 16; ++j) r1[j] = (ordkey(raw[j]) & ~127u) | (unsigned)(127 - j);
            SORT16(r1);
#pragma unroll
            for (int gq = 1; gq < 8; ++gq) {
#pragma unroll
                for (int j = 0; j < 16; ++j) sg[j] = (ordkey(raw[16 * gq + j]) & ~127u) | (unsigned)(127 - (16 * gq + j));
                SORT16(sg); MERGE16(r1, sg); }
#pragma unroll
            for (int jq = 0; jq < 32; ++jq) { const f32x4 t4 = *(const f32x4*)(p2 + jq * 64); raw[4 * jq] = t4.x; raw[4 * jq + 1] = t4.y; raw[4 * jq + 2] = t4.z; raw[4 * jq + 3] = t4.w; }
#pragma unroll
            for (int j = 0; j < 16; ++j) r2[j] = (ordkey(raw[j]) & ~127u) | (unsigned)(127 - j);
            SORT16(r2);
#pragma unroll
            for (int gq = 1; gq < 8; ++gq) {
#pragma unroll
                for (int j = 0; j < 16; ++j) sg[j] = (ordkey(raw[16 * gq + j]) & ~127u) | (unsigned)(127 - (16 * gq + j));
                SORT16(sg); MERGE16(r2, sg); }
        }
        float v1[16], v2[16];
#pragma unroll
        for (int i = 0; i < 16; ++i) { v1[i] = unord((r1[i] & ~127u) | 64u); v2[i] = unord((r2[i] & ~127u) | 64u); }
        {
            unsigned cg[4][16]; int cn = 0;
#pragma unroll
            for (int a = 0; a < 16; ++a)
#pragma unroll
                for (int bq = 0; bq < 16; ++bq) if ((a + 1) * (bq + 1) <= 16) { cg[cn >> 4][cn & 15] = (ordkey(v1[a] + v2[bq]) & ~255u) | (unsigned)(a * 16 + bq); ++cn; }
#pragma unroll
            for (int z = 50; z < 64; ++z) cg[z >> 4][z & 15] = 0u;
            SORT16(cg[0]); SORT16(cg[1]); SORT16(cg[2]); SORT16(cg[3]);
            MERGE16(cg[0], cg[1]); MERGE16(cg[0], cg[2]); MERGE16(cg[0], cg[3]);
#pragma unroll
            for (int i = 0; i < 16; ++i) rc[i] = cg[0][i];
        }
        float val[16]; int ex[16];
        {
            LAS unsigned* t1 = (LAS unsigned*)(F.lds + F.wave * 8704) + F.lane * 17; LAS unsigned* t2 = t1 + 64 * 17;
#pragma unroll
            for (int i = 0; i < 16; ++i) { t1[i] = r1[i]; t2[i] = r2[i]; }
            LDS_WAIT(); asm volatile("" ::: "memory");
#pragma unroll
            for (int w = 0; w < 16; ++w) {
                const int a = (rc[w] >> 4) & 15, bq = rc[w] & 15;
                const unsigned k1 = t1[a], k2 = t2[bq];
                val[w] = unord((k1 & ~127u) | 64u) + unord((k2 & ~127u) | 64u);
                ex[w] = (127 - (int)(k1 & 127u)) * 128 + (127 - (int)(k2 & 127u));
            }
            LDS_WAIT(); asm volatile("" ::: "memory");
        }
        float mx = val[0];
#pragma unroll
        for (int w = 1; w < 16; ++w) mx = fmaxf(mx, val[w]);
        float sum = 0.f;
#pragma unroll
        for (int w = 0; w < 16; ++w) { val[w] = __expf(val[w] - mx); sum += val[w]; }
        const float inv = 1.f / sum;
        int* ip = IDX + (size_t)tok * 128 + h * 16; float* gp = GATE + (size_t)tok * 128 + h * 16;
#pragma unroll
        for (int q = 0; q < 4; ++q) { *(int4*)(ip + 4 * q) = make_int4(ex[4 * q], ex[4 * q + 1], ex[4 * q + 2], ex[4 * q + 3]);
            *(f32x4*)(gp + 4 * q) = (f32x4){val[4 * q] * inv, val[4 * q + 1] * inv, val[4 * q + 2] * inv, val[4 * q + 3] * inv}; }
    }
}

#define DPP_ADD(v, ctrl) ((v) + __builtin_bit_cast(float, __builtin_amdgcn_mov_dpp(__builtin_bit_cast(int, (v)), (ctrl), 0xf, 0xf, true)))
__device__ __forceinline__ void fp8x16_to_f32x2(const u32x4 r, f32x2* f) {
#pragma unroll
    for (int q = 0; q < 4; ++q) { f[2 * q] = __builtin_amdgcn_cvt_pk_f32_fp8((int)r[q], false); f[2 * q + 1] = __builtin_amdgcn_cvt_pk_f32_fp8((int)r[q], true); }
}
__device__ __forceinline__ void fp8x16_to_f32(const u32x4 r, float* f) {
#pragma unroll
    for (int q = 0; q < 4; ++q) { const f32x2 lo = __builtin_amdgcn_cvt_pk_f32_fp8((int)r[q], false), hi = __builtin_amdgcn_cvt_pk_f32_fp8((int)r[q], true);
        f[4 * q] = lo.x; f[4 * q + 1] = lo.y; f[4 * q + 2] = hi.x; f[4 * q + 3] = hi.y; }
}
__device__ __forceinline__ long lo64(u32x4 v) { return (long)(((unsigned long)v.y << 32) | (unsigned long)v.x); }
__device__ __forceinline__ long hi64(u32x4 v) { return (long)(((unsigned long)v.w << 32) | (unsigned long)v.z); }
template <int MODE>
__device__ __forceinline__ void peer_u_phase(const Frame& F, const Args& A) {
    const unsigned char* X8 = A.ws + WS_P + P_X8;
    const unsigned char* U8 = A.ws + WS_U8; const float* SU = (const float*)(A.ws + WS_SU); const float* SV = (const float*)(A.ws + WS_SV);
    const int* IDX = (const int*)(A.ws + WS_P + P_IDX); const float* GATE = (const float*)(A.ws + WS_P + P_GATE); float* AK = (float*)(MODE == 0 ? A.ws + WS_AK : A.ws + WS_P + P_SC);
    const int g = F.bid & 7, nmem = F.G >> 3, l = F.lane, step = nmem * NWAVES;
    const int loff = 64 * (l & 15) + 16 * (l >> 4);
    const bool dg = ((l & 15) >> 2) == (l >> 4); const int dr = l & 3;
    const float dw0 = (dg && dr == 0) ? 1.f : 0.f, dw1 = (dg && dr == 1) ? 1.f : 0.f, dw2 = (dg && dr == 2) ? 1.f : 0.f, dw3 = (dg && dr == 3) ? 1.f : 0.f;
    LAS int* le = (LAS int*)(F.lds + F.wave * 2048); LAS int* lk = le + 256;
    const bool b5 = (l & 32) != 0, b4 = (l & 16) != 0, b3 = (l & 8) != 0;
    int tok = 2 * ((F.bid >> 3) * NWAVES + F.wave);
    u32x4 nxA, nxB; int neA0, neA1, neB0, neB1; float ngA0, ngA1, ngB0, ngB1;
#define U_PREFETCH(t) do { const size_t _tA = (size_t)(t), _tB = (size_t)(t) + 1; if (MODE == 4) { nxA = (u32x4){(unsigned)_tA, 1u, 2u, 3u}; nxB = nxA; neA0 = (int)((_tA * 37 + l * 11) & 16383); neA1 = (int)((_tA * 53 + l * 7) & 16383); neB0 = (int)((_tB * 37 + l * 13) & 16383); neB1 = (int)((_tB * 29 + l * 3) & 16383); ngA0 = ngA1 = ngB0 = ngB1 = 0.01f; break; } nxA = *(const u32x4*)(X8 + _tA * 1024 + loff); nxB = *(const u32x4*)(X8 + _tB * 1024 + loff); \
        neA0 = IDX[_tA * 128 + l]; neA1 = IDX[_tA * 128 + 64 + l]; neB0 = IDX[_tB * 128 + l]; neB1 = IDX[_tB * 128 + 64 + l]; \
        ngA0 = GATE[_tA * 128 + l]; ngA1 = GATE[_tA * 128 + 64 + l]; ngB0 = GATE[_tB * 128 + l]; ngB1 = GATE[_tB * 128 + 64 + l]; } while (0)
    if (tok + 1 < T_TOK) U_PREFETCH(tok);
    for (; tok + 1 < T_TOK; tok += 2 * step) {
        const int tokA = tok, tokB = tok + 1;
        const u32x4 xA = nxA, xB = nxB;
        const int eA0 = neA0, eA1 = neA1, eB0 = neB0, eB1 = neB1; const float gA0 = ngA0, gA1 = ngA1, gB0 = ngB0, gB1 = ngB1;
        bool pf_done = false;
        const bool oA0 = (eA0 & 7) == g, oA1 = (eA1 & 7) == g, oB0 = (eB0 & 7) == g, oB1 = (eB1 & 7) == g;
        const unsigned long long mA0 = __ballot(oA0), mA1 = __ballot(oA1), mB0 = __ballot(oB0), mB1 = __ballot(oB1);
        const int c0 = __popcll(mA0), c1 = c0 + __popcll(mA1), c2 = c1 + __popcll(mB0), n = c2 + __popcll(mB1);
#define MBC(m) __builtin_amdgcn_mbcnt_hi((unsigned)((m) >> 32), __builtin_amdgcn_mbcnt_lo((unsigned)(m), 0u))
        if (oA0) { const int p = MBC(mA0); le[p] = (eA0 << 8) | l; lk[p] = __builtin_bit_cast(int, gA0); }
        if (oA1) { const int p = c0 + MBC(mA1); le[p] = (eA1 << 8) | (64 + l); lk[p] = __builtin_bit_cast(int, gA1); }
        if (oB0) { const int p = c1 + MBC(mB0); le[p] = (eB0 << 8) | 128 | l; lk[p] = __builtin_bit_cast(int, gB0); }
        if (oB1) { const int p = c2 + MBC(mB1); le[p] = (eB1 << 8) | 128 | (64 + l); lk[p] = __builtin_bit_cast(int, gB1); }
#undef MBC
        LDS_WAIT(); asm volatile("" ::: "memory");
        for (int cb = 0; cb < n || cb == 0; cb += 64) {
        const int nc = min(n, cb + 64);
        const bool fv = (cb + l) < nc;
        const int ent = fv ? le[cb + l] : 0; const float gt = fv ? __builtin_bit_cast(float, lk[cb + l]) : 0.f; float tot = 0.f;
        const float su = SU[ent >> 8], sv = SV[ent >> 8];
        const unsigned long long radr = (unsigned long long)(U8 + (size_t)(((ent >> 8) & 7) * 2048 + (((ent >> 8) >> 3) & (MODE == 2 ? 255 : 2047))) * 1024);
        const int ralo = (int)(unsigned)radr, rahi = (int)(unsigned)(radr >> 32);
        for (int i = cb; i < nc; i += 16) {
            u32x4 row[2][8];
#pragma unroll
            for (int b = 0; b < 2; ++b) if (i + 8 * b < nc) {
#pragma unroll
                for (int j = 0; j < 8; ++j) { const int ln = min(i + 8 * b + j, nc - 1) - cb;
                    const unsigned lo = (unsigned)__builtin_amdgcn_readlane(ralo, ln), hi = (unsigned)__builtin_amdgcn_readlane(rahi, ln);
                    const GAS unsigned char* rp = (const GAS unsigned char*)(((unsigned long long)hi << 32) | lo);
                    row[b][j] = *(const GAS u32x4*)(rp + (unsigned)loff); } }
            if (!pf_done) { pf_done = true; if (tok + 2 * step + 1 < T_TOK) U_PREFETCH(tok + 2 * step); }
#pragma unroll
            for (int b = 0; b < 2; ++b) if (i + 8 * b < nc) {
                float p[8];
                f32x4 accj[8];
                const int base0 = i + 8 * b;
                if (base0 + 8 <= c1) {
#pragma unroll
                    for (int j = 0; j < 8; ++j) accj[j] = __builtin_amdgcn_mfma_f32_16x16x32_fp8_fp8(lo64(row[b][j]), lo64(xA), (f32x4){0.f, 0.f, 0.f, 0.f}, 0, 0, 0);
#pragma unroll
                    for (int j = 0; j < 8; ++j) accj[j] = __builtin_amdgcn_mfma_f32_16x16x32_fp8_fp8(hi64(row[b][j]), hi64(xA), accj[j], 0, 0, 0);
                } else if (base0 >= c1) {
#pragma unroll
                    for (int j = 0; j < 8; ++j) accj[j] = __builtin_amdgcn_mfma_f32_16x16x32_fp8_fp8(lo64(row[b][j]), lo64(xB), (f32x4){0.f, 0.f, 0.f, 0.f}, 0, 0, 0);
#pragma unroll
                    for (int j = 0; j < 8; ++j) accj[j] = __builtin_amdgcn_mfma_f32_16x16x32_fp8_fp8(hi64(row[b][j]), hi64(xB), accj[j], 0, 0, 0);
                } else {
#pragma unroll
                    for (int j = 0; j < 8; ++j) { const u32x4 xs = (base0 + j >= c1) ? xB : xA; accj[j] = __builtin_amdgcn_mfma_f32_16x16x32_fp8_fp8(lo64(row[b][j]), lo64(xs), (f32x4){0.f, 0.f, 0.f, 0.f}, 0, 0, 0);
                        accj[j] = __builtin_amdgcn_mfma_f32_16x16x32_fp8_fp8(hi64(row[b][j]), hi64(xs), accj[j], 0, 0, 0); }
                }
#pragma unroll
                for (int j = 0; j < 8; ++j) p[j] = __builtin_fmaf(accj[j][3], dw3, __builtin_fmaf(accj[j][2], dw2, __builtin_fmaf(accj[j][1], dw1, accj[j][0] * dw0)));
                float q4[4], q2[2], q1;
#pragma unroll
                for (int j = 0; j < 4; ++j) { const float keep = b5 ? p[4 + j] : p[j], send = b5 ? p[j] : p[4 + j]; q4[j] = keep + __shfl_xor(send, 32); }
#pragma unroll
                for (int j = 0; j < 2; ++j) { const float keep = b4 ? q4[2 + j] : q4[j], send = b4 ? q4[j] : q4[2 + j]; q2[j] = keep + __shfl_xor(send, 16); }
                { const float keep = b3 ? q2[1] : q2[0], send = b3 ? q2[0] : q2[1]; q1 = keep + __shfl_xor(send, 8); }
                q1 = DPP_ADD(q1, 0xB1); q1 = DPP_ADD(q1, 0x4E); q1 = DPP_ADD(q1, 0x141);
                const float t = __builtin_bit_cast(float, __builtin_amdgcn_ds_bpermute((l & 7) * 32, __builtin_bit_cast(int, q1)));
                const int base = i + 8 * b;
                if ((l >> 3) == ((base - cb) >> 3)) tot = t;
            }
        }
        if (!pf_done) { if (tok + 2 * step + 1 < T_TOK) U_PREFETCH(tok + 2 * step); }
        if (fv) { const int tk = (ent & 128) ? tokB : tokA; AK[(size_t)tk * 128 + (ent & 127)] = gelu_tanh(tot * su * (1.f / 16.f)) * gt * sv; }
        if (n == 0) break;
        }
        LDS_WAIT(); asm volatile("" ::: "memory");
    }
#undef U_PREFETCH
}
template <int MODE>
__device__ __forceinline__ void peer_u_phase1(const Frame& F, const Args& A) {
    const unsigned char* X8 = A.ws + WS_P + P_X8;
    const unsigned char* U8 = A.ws + WS_U8; const float* SU = (const float*)(A.ws + WS_SU); const float* SV = (const float*)(A.ws + WS_SV);
    const int* IDX = (const int*)(A.ws + WS_P + P_IDX); const float* GATE = (const float*)(A.ws + WS_P + P_GATE); float* AK = (float*)(MODE == 0 ? A.ws + WS_AK : A.ws + WS_P + P_SC);
    const int g = F.bid & (UNG - 1), nmem = F.G >> UNG_SH, l = F.lane, step = nmem * NWAVES;
    const int loff = 64 * (l & 15) + 16 * (l >> 4);
    const bool dg = ((l & 15) >> 2) == (l >> 4); const int dr = l & 3;
    const float dw0 = (dg && dr == 0) ? 1.f : 0.f, dw1 = (dg && dr == 1) ? 1.f : 0.f, dw2 = (dg && dr == 2) ? 1.f : 0.f, dw3 = (dg && dr == 3) ? 1.f : 0.f;
    LAS int* le = (LAS int*)(F.lds + F.wave * 2048); LAS int* lk = le + 256;
    const bool b5 = (l & 32) != 0, b4 = (l & 16) != 0, b3 = (l & 8) != 0;
    int tok = (F.bid >> UNG_SH) * NWAVES + F.wave;
    u32x4 nxA; int neA0, neA1; float ngA0, ngA1;
#define U1_PREFETCH(t) do { const size_t _tA = (size_t)(t); nxA = *(const u32x4*)(X8 + _tA * 1024 + loff); \
        neA0 = IDX[_tA * 128 + l]; neA1 = IDX[_tA * 128 + 64 + l]; ngA0 = GATE[_tA * 128 + l]; ngA1 = GATE[_tA * 128 + 64 + l]; } while (0)
    if (tok < T_TOK) U1_PREFETCH(tok);
    for (; tok < T_TOK; tok += step) {
        const u32x4 xA = nxA;
        const int eA0 = neA0, eA1 = neA1; const float gA0 = ngA0, gA1 = ngA1;
        bool pf_done = false;
        const bool oA0 = (eA0 & (UNG - 1)) == g, oA1 = (eA1 & (UNG - 1)) == g;
        const unsigned long long mA0 = __ballot(oA0), mA1 = __ballot(oA1);
        const int c0 = __popcll(mA0), n = c0 + __popcll(mA1);
#define MBC(m) __builtin_amdgcn_mbcnt_hi((unsigned)((m) >> 32), __builtin_amdgcn_mbcnt_lo((unsigned)(m), 0u))
        if (oA0) { const int p = MBC(mA0); le[p] = (eA0 << 8) | l; lk[p] = __builtin_bit_cast(int, gA0); }
        if (oA1) { const int p = c0 + MBC(mA1); le[p] = (eA1 << 8) | (64 + l); lk[p] = __builtin_bit_cast(int, gA1); }
#undef MBC
        LDS_WAIT(); asm volatile("" ::: "memory");
        for (int cb = 0; cb < n || cb == 0; cb += 64) {
        const int nc = min(n, cb + 64);
        const bool fv = (cb + l) < nc;
        const int ent = fv ? le[cb + l] : 0; const float gt = fv ? __builtin_bit_cast(float, lk[cb + l]) : 0.f; float tot = 0.f;
        const float su = SU[ent >> 8], sv = SV[ent >> 8];
        const unsigned long long radr = (unsigned long long)(U8 + (size_t)(((ent >> 8) & (UNG - 1)) * (NEXP / UNG) + ((ent >> 8) >> UNG_SH)) * 1024);
        const int ralo = (int)(unsigned)radr, rahi = (int)(unsigned)(radr >> 32);
        for (int i = cb; i < nc; i += 16) {
            u32x4 row[2][8];
#pragma unroll
            for (int b = 0; b < 2; ++b) if (i + 8 * b < nc) {
#pragma unroll
                for (int j = 0; j < 8; ++j) { const int ln = min(i + 8 * b + j, nc - 1) - cb;
                    const unsigned lo = (unsigned)__builtin_amdgcn_readlane(ralo, ln), hi = (unsigned)__builtin_amdgcn_readlane(rahi, ln);
                    const GAS unsigned char* rp = (const GAS unsigned char*)(((unsigned long long)hi << 32) | lo);
                    row[b][j] = *(const GAS u32x4*)(rp + (unsigned)loff); } }
            if (!pf_done) { pf_done = true; if (tok + step < T_TOK) U1_PREFETCH(tok + step); }
#pragma unroll
            for (int b = 0; b < 2; ++b) if (i + 8 * b < nc) {
                float p[8]; f32x4 accj[8];
#pragma unroll
                for (int j = 0; j < 8; ++j) accj[j] = __builtin_amdgcn_mfma_f32_16x16x32_fp8_fp8(lo64(row[b][j]), lo64(xA), (f32x4){0.f, 0.f, 0.f, 0.f}, 0, 0, 0);
#pragma unroll
                for (int j = 0; j < 8; ++j) accj[j] = __builtin_amdgcn_mfma_f32_16x16x32_fp8_fp8(hi64(row[b][j]), hi64(xA), accj[j], 0, 0, 0);
#pragma unroll
                for (int j = 0; j < 8; ++j) p[j] = __builtin_fmaf(accj[j][3], dw3, __builtin_fmaf(accj[j][2], dw2, __builtin_fmaf(accj[j][1], dw1, accj[j][0] * dw0)));
                float q4[4], q2[2], q1;
#pragma unroll
                for (int j = 0; j < 4; ++j) { const float keep = b5 ? p[4 + j] : p[j], send = b5 ? p[j] : p[4 + j]; q4[j] = keep + __shfl_xor(send, 32); }
#pragma unroll
                for (int j = 0; j < 2; ++j) { const float keep = b4 ? q4[2 + j] : q4[j], send = b4 ? q4[j] : q4[2 + j]; q2[j] = keep + __shfl_xor(send, 16); }
                { const float keep = b3 ? q2[1] : q2[0], send = b3 ? q2[0] : q2[1]; q1 = keep + __shfl_xor(send, 8); }
                q1 = DPP_ADD(q1, 0xB1); q1 = DPP_ADD(q1, 0x4E); q1 = DPP_ADD(q1, 0x141);
                const float t = __builtin_bit_cast(float, __builtin_amdgcn_ds_bpermute((l & 7) * 32, __builtin_bit_cast(int, q1)));
                const int base = i + 8 * b;
                if ((l >> 3) == ((base - cb) >> 3)) tot = t;
            }
        }
        if (!pf_done) { pf_done = true; if (tok + step < T_TOK) U1_PREFETCH(tok + step); }
        if (fv) AK[(size_t)tok * 128 + (ent & 127)] = gelu_tanh(tot * su * (1.f / 16.f)) * gt * sv;
        if (n == 0) break;
        }
        LDS_WAIT(); asm volatile("" ::: "memory");
    }
#undef U1_PREFETCH
}
template <int MODE>
__device__ __forceinline__ void peer_u4_phase(const Frame& F, const Args& A) {
    const unsigned char* X8 = A.ws + WS_P + P_X8;
    const float* SU = (const float*)(A.ws + WS_SU); const float* SV = (const float*)(A.ws + WS_SV);
    const int* IDX = (const int*)(A.ws + WS_P + P_IDX); const float* GATE = (const float*)(A.ws + WS_P + P_GATE); float* AK = (float*)(MODE == 0 ? A.ws + WS_AK : A.ws + WS_P + P_SC);
    const int g = F.bid & (UNG - 1), nmem = F.G >> UNG_SH, l = F.lane, step = nmem * NWAVES;
    const int m = l & 15, q = l >> 4;
    const GAS unsigned char* ub = (const GAS unsigned char*)(A.ws + WS_U8 + (size_t)g * (NEXP / UNG) * 512);
    const unsigned lconst = 16u * (unsigned)(4 * (m & 7) + q);
    const int xoff = 128 * (m & 7) + 16 * q;
    const bool dg = (m < 8) && ((m >> 2) == (q & 1)); const int dr = m & 3;
    const float dw0 = (dg && dr == 0) ? 1.f : 0.f, dw1 = (dg && dr == 1) ? 1.f : 0.f, dw2 = (dg && dr == 2) ? 1.f : 0.f, dw3 = (dg && dr == 3) ? 1.f : 0.f;
    const int rsel = 4 * (m >> 3);
    const int osrc = 4 * (32 * (l & 1) + 4 * ((l & 15) >> 1));
    const int sc1 = 0x7F7F7F7F;
    LAS int* le = (LAS int*)(F.lds + F.wave * 2048); LAS int* lk = le + 256;
    const bool b4 = (l & 16) != 0, b3 = (l & 8) != 0, b2 = (l & 4) != 0;
    int tok = (F.bid >> UNG_SH) * NWAVES + F.wave;
    u32x4 nx0, nx1; int ne0, ne1; float ng0, ng1;
#define U4_PREFETCH(t) do { const size_t _t = (size_t)(t); nx0 = *(const u32x4*)(X8 + _t * 1024 + xoff); nx1 = *(const u32x4*)(X8 + _t * 1024 + xoff + 64); \
        ne0 = IDX[_t * 128 + l]; ne1 = IDX[_t * 128 + 64 + l]; ng0 = GATE[_t * 128 + l]; ng1 = GATE[_t * 128 + 64 + l]; } while (0)
    if (tok < T_TOK) U4_PREFETCH(tok);
    for (; tok < T_TOK; tok += step) {
        const i32x8 xb = __builtin_shufflevector(__builtin_bit_cast(i32x4, nx0), __builtin_bit_cast(i32x4, nx1), 0, 1, 2, 3, 4, 5, 6, 7);
        const int e0 = ne0, e1 = ne1; const float g0 = ng0, g1 = ng1;
        bool pf_done = false;
        const bool o0 = (e0 & (UNG - 1)) == g, o1 = (e1 & (UNG - 1)) == g;
        const unsigned long long m0 = __ballot(o0), m1 = __ballot(o1);
        const int c0 = __popcll(m0), n = c0 + __popcll(m1);
#define MBC(mm) __builtin_amdgcn_mbcnt_hi((unsigned)((mm) >> 32), __builtin_amdgcn_mbcnt_lo((unsigned)(mm), 0u))
        if (o0) { const int p = MBC(m0); le[p] = (e0 << 8) | l; lk[p] = __builtin_bit_cast(int, g0); }
        if (o1) { const int p = c0 + MBC(m1); le[p] = (e1 << 8) | (64 + l); lk[p] = __builtin_bit_cast(int, g1); }
#undef MBC
        LDS_WAIT(); asm volatile("" ::: "memory");
        for (int cb = 0; cb < n || cb == 0; cb += 64) {
            const int nc = min(n, cb + 64);
            const bool fv = (cb + l) < nc;
            const int ent = fv ? le[cb + l] : 0; const float gt = fv ? __builtin_bit_cast(float, lk[cb + l]) : 0.f; float tot = 0.f;
            const float su = SU[ent >> 8], sv = SV[ent >> 8];
            const int roff = fv ? ((ent >> 8) >> UNG_SH) * 512 : 0;
            for (int i = cb; i < nc; i += 32) {
                u32x4 row[2][8];
#pragma unroll
                for (int b = 0; b < 2; ++b) if (i + 16 * b < nc) {
#pragma unroll
                    for (int j = 0; j < 8; ++j) { const int ro = __builtin_amdgcn_ds_bpermute(rsel + 4 * (i - cb + 16 * b + 2 * j), roff);
                        row[b][j] = *(const GAS u32x4*)(ub + ((unsigned)ro + lconst)); } }
                if (!pf_done) { pf_done = true; if (tok + step < T_TOK) U4_PREFETCH(tok + step); }
#pragma unroll
                for (int b = 0; b < 2; ++b) if (i + 16 * b < nc) {
                    float p[8];
#pragma unroll
                    for (int j = 0; j < 8; ++j) { const i32x4 r4 = __builtin_bit_cast(i32x4, row[b][j]);
                        const f32x4 d = __builtin_amdgcn_mfma_scale_f32_16x16x128_f8f6f4(__builtin_shufflevector(r4, r4, 0, 1, 2, 3, -1, -1, -1, -1), xb, (f32x4){0.f, 0.f, 0.f, 0.f}, 4, 0, 0, sc1, 0, sc1);
                        p[j] = __builtin_fmaf(d[3], dw3, __builtin_fmaf(d[2], dw2, __builtin_fmaf(d[1], dw1, d[0] * dw0))); }
                    float q4[4], q2[2], q1;
#pragma unroll
                    for (int j = 0; j < 4; ++j) { const float keep = b4 ? p[4 + j] : p[j], send = b4 ? p[j] : p[4 + j]; q4[j] = keep + __shfl_xor(send, 16); }
#pragma unroll
                    for (int j = 0; j < 2; ++j) { const float keep = b3 ? q4[2 + j] : q4[j], send = b3 ? q4[j] : q4[2 + j]; q2[j] = keep + __shfl_xor(send, 8); }
                    { const float keep = b2 ? q2[1] : q2[0], send = b2 ? q2[0] : q2[1]; q1 = keep + __shfl_xor(send, 4); }
                    q1 = DPP_ADD(q1, 0xB1); q1 = DPP_ADD(q1, 0x4E);
                    const float t = __builtin_bit_cast(float, __builtin_amdgcn_ds_bpermute(osrc, __builtin_bit_cast(int, q1)));
                    if ((l >> 4) == ((i - cb + 16 * b) >> 4)) tot = t;
                }
            }
            if (!pf_done) { pf_done = true; if (tok + step < T_TOK) U4_PREFETCH(tok + step); }
            if (fv) AK[(size_t)tok * 128 + (ent & 127)] = gelu_tanh(tot * su * (1.f / 16.f)) * gt * sv;
            if (n == 0) break;
        }
        LDS_WAIT(); asm volatile("" ::: "memory");
    }
#undef U4_PREFETCH
}
__device__ __forceinline__ float wave_max_nonneg(float v) {
    unsigned u = __builtin_bit_cast(unsigned, v);
    u = max(u, (unsigned)__builtin_amdgcn_mov_dpp((int)u, 0xB1, 0xf, 0xf, true));
    u = max(u, (unsigned)__builtin_amdgcn_mov_dpp((int)u, 0x4E, 0xf, 0xf, true));
    u = max(u, (unsigned)__builtin_amdgcn_mov_dpp((int)u, 0x141, 0xf, 0xf, true));
    u = max(u, (unsigned)__builtin_amdgcn_mov_dpp((int)u, 0x140, 0xf, 0xf, true));
    const unsigned a = (unsigned)__builtin_amdgcn_readlane((int)u, 0), b = (unsigned)__builtin_amdgcn_readlane((int)u, 16), c = (unsigned)__builtin_amdgcn_readlane((int)u, 32), d = (unsigned)__builtin_amdgcn_readlane((int)u, 48);
    return __builtin_bit_cast(float, max(max(a, b), max(c, d)));
}
template <int MODE>
__device__ __forceinline__ void peer_v_phase(const Frame& F, const Args& A) {
    const unsigned char* V8 = A.ws + WS_V8; const int* IDX = (const int*)(A.ws + WS_P + P_IDX); const float* AK = (const float*)(A.ws + WS_AK);
    float* out = MODE == 0 ? A.out : (float*)(A.ws + WS_P + P_SC);
    const int g = F.bid & 7, nmem = F.G >> 3, l = F.lane, sub = l & 7, rr = l >> 3, n16 = l & 15, q = l >> 4, step = nmem * NWAVES;
    const GAS unsigned char* vb = (const GAS unsigned char*)(V8 + (size_t)g * NEXP * 128);
    LAS unsigned long long* rep = (LAS unsigned long long*)(F.lds + F.wave * 2048);
    const unsigned long long bm = 0xFFull << (8 * (n16 & 7));
    const int repi = 2 * q + (n16 >> 3);
    const bool vl = (n16 < 8) && (q < 2);
    LAS float* stg = (LAS float*)(F.lds + 16384 + F.wave * 512);
    int tok = 2 * ((F.bid >> 3) * NWAVES + F.wave);
    int ne[4]; float na[4];
#define V_PREFETCH(t) do { const size_t _a = (size_t)(t) * 128, _b = ((size_t)(t) + 1) * 128; ne[0] = IDX[_a + l]; ne[1] = IDX[_a + 64 + l]; ne[2] = IDX[_b + l]; ne[3] = IDX[_b + 64 + l]; \
        na[0] = AK[_a + l]; na[1] = AK[_a + 64 + l]; na[2] = AK[_b + l]; na[3] = AK[_b + 64 + l]; } while (0)
    if (tok + 1 < T_TOK) V_PREFETCH(tok);
    for (; tok + 1 < T_TOK; tok += 2 * step) {
        const int e0 = ne[0], e1 = ne[1], e2 = ne[2], e3 = ne[3]; const float a0 = na[0], a1 = na[1], a2 = na[2], a3 = na[3];
        u32x4 rowA[16], rowB[16];
#pragma unroll
        for (int i = 0; i < 16; ++i) { const int src = (8 * (i & 7) + rr) * 4;
            const int ea = __builtin_amdgcn_ds_bpermute(src, i < 8 ? e0 : e1), eb = __builtin_amdgcn_ds_bpermute(src, i < 8 ? e2 : e3);
            rowA[i] = *(const GAS u32x4*)(vb + ((unsigned)ea * 128u + 16u * (unsigned)sub)); rowB[i] = *(const GAS u32x4*)(vb + ((unsigned)eb * 128u + 16u * (unsigned)sub)); }
        f32x4 HA = {0.f, 0.f, 0.f, 0.f}, HB = {0.f, 0.f, 0.f, 0.f};
        if (l < 32) { const float* hpa = out + (size_t)tok * D + g * 128 + 4 * l; HA = *(const f32x4*)hpa; HB = *(const f32x4*)(hpa + D); }
        if (tok + 2 * step + 1 < T_TOK) V_PREFETCH(tok + 2 * step);
        const float amA = wave_max_nonneg(fmaxf(fabsf(a0), fabsf(a1))), amB = wave_max_nonneg(fmaxf(fabsf(a2), fabsf(a3)));
        const float scA = amA > 0.f ? 224.f * __builtin_amdgcn_rcpf(amA) : 0.f, invA = amA * (1.f / 224.f), scB = amB > 0.f ? 224.f * __builtin_amdgcn_rcpf(amB) : 0.f, invB = amB * (1.f / 224.f);
        { const unsigned wA = (unsigned)__builtin_amdgcn_cvt_pk_fp8_f32(a0 * scA, a1 * scA, 0, false), wB = (unsigned)__builtin_amdgcn_cvt_pk_fp8_f32(a2 * scB, a3 * scB, 0, false);
          const unsigned r0 = (wA & 0xffu) * 0x01010101u, r1 = ((wA >> 8) & 0xffu) * 0x01010101u, r2 = (wB & 0xffu) * 0x01010101u, r3 = ((wB >> 8) & 0xffu) * 0x01010101u;
          rep[l] = ((unsigned long long)r0 << 32) | r0; rep[64 + l] = ((unsigned long long)r1 << 32) | r1; rep[128 + l] = ((unsigned long long)r2 << 32) | r2; rep[192 + l] = ((unsigned long long)r3 << 32) | r3; }
        LDS_WAIT(); asm volatile("" ::: "memory");
#pragma unroll
        for (int t2 = 0; t2 < 2; ++t2) {
            f32x4 alo = {0.f, 0.f, 0.f, 0.f}, ahi = {0.f, 0.f, 0.f, 0.f};
#pragma unroll
            for (int i = 0; i < 16; ++i) { const long bop = (long)(rep[128 * t2 + 8 * i + repi] & bm); const u32x4 rw = t2 ? rowB[i] : rowA[i];
                alo = __builtin_amdgcn_mfma_f32_16x16x32_fp8_fp8(lo64(rw), bop, alo, 0, 0, 0);
                ahi = __builtin_amdgcn_mfma_f32_16x16x32_fp8_fp8(hi64(rw), bop, ahi, 0, 0, 0); }
            const float inv = t2 ? invB : invA;
            float vlo[4], vhi[4];
#pragma unroll
            for (int r = 0; r < 4; ++r) { const float tl = alo[r], th = ahi[r];
                vlo[r] = (tl + __builtin_bit_cast(float, __builtin_amdgcn_ds_bpermute(((l + 40) & 63) * 4, __builtin_bit_cast(int, tl)))) * inv;
                vhi[r] = (th + __builtin_bit_cast(float, __builtin_amdgcn_ds_bpermute(((l + 40) & 63) * 4, __builtin_bit_cast(int, th)))) * inv; }
            if (vl) {
#pragma unroll
                for (int r = 0; r < 4; ++r) { stg[64 * q + 16 * r + n16] = vlo[r]; stg[64 * q + 16 * r + n16 + 8] = vhi[r]; } }
            LDS_WAIT(); asm volatile("" ::: "memory");
            if (l < 32) { const f32x4 dv = *(const LAS f32x4*)(stg + 4 * l); *(f32x4*)(out + (size_t)(tok + t2) * D + g * 128 + 4 * l) = (t2 ? HB : HA) + dv; }
            LDS_WAIT(); asm volatile("" ::: "memory");
        }
        LDS_WAIT(); asm volatile("" ::: "memory");
    }
#undef V_PREFETCH
}
__device__ __forceinline__ void final_norm_phase(const Frame& F, const Args& A) {
    const int gw = F.bid * NWAVES + F.wave, NGW = F.G * NWAVES, l = F.lane; const float* fg = A.in[I_FG];
    const f32x4* gp = (const f32x4*)fg + l;
    int tok = gw;
    for (; tok + 3 * NGW < T_TOK; tok += 4 * NGW) {
        f32x4 v[4][4]; float ss[4];
#pragma unroll
        for (int b = 0; b < 4; ++b) { const f32x4* hp = (const f32x4*)(A.out + (size_t)(tok + b * NGW) * D) + l;
#pragma unroll
            for (int j = 0; j < 4; ++j) v[b][j] = hp[64 * j]; }
#pragma unroll
        for (int b = 0; b < 4; ++b) { ss[b] = 0.f;
#pragma unroll
            for (int j = 0; j < 4; ++j) ss[b] += (v[b][j].x * v[b][j].x + v[b][j].y * v[b][j].y) + (v[b][j].z * v[b][j].z + v[b][j].w * v[b][j].w); }
#pragma unroll
        for (int o = 1; o < 64; o <<= 1) {
#pragma unroll
            for (int b = 0; b < 4; ++b) ss[b] += __shfl_xor(ss[b], o); }
#pragma unroll
        for (int b = 0; b < 4; ++b) { const float rstd = 1.f / sqrtf(ss[b] * (1.f / D) + EPS); f32x4* hp = (f32x4*)(A.out + (size_t)(tok + b * NGW) * D) + l;
#pragma unroll
            for (int j = 0; j < 4; ++j) hp[64 * j] = v[b][j] * rstd * gp[64 * j]; }
    }
    for (; tok < T_TOK; tok += NGW) { f32x4* hp = (f32x4*)(A.out + (size_t)tok * D) + l; f32x4 v[4]; float ss = 0.f;
#pragma unroll
        for (int j = 0; j < 4; ++j) { v[j] = hp[64 * j]; ss += (v[j].x * v[j].x + v[j].y * v[j].y) + (v[j].z * v[j].z + v[j].w * v[j].w); }
        const float rstd = 1.f / sqrtf(wave_sum(ss) * (1.f / D) + EPS);
#pragma unroll
        for (int j = 0; j < 4; ++j) hp[64 * j] = v[j] * rstd * gp[64 * j]; }
}

#ifdef DEBUG_CHECK
constexpr size_t WS_DBG = 472 * MiB;
__device__ __forceinline__ int dbg_tok(int i) { return (i * 509 + 3) & 32767; }
__device__ __forceinline__ float gelu_ref(float x) { return 0.5f * x * (1.f + tanhf(0.7978845608028654f * (x + 0.044715f * x * x * x))); }
__global__ void __launch_bounds__(512) dbg_scores(Args a) {
    __shared__ float n2s[1024]; __shared__ float q[2048];
    const int t = dbg_tok(blockIdx.x), tid = threadIdx.x;
    const bf16_t* N2 = (const bf16_t*)(a.ws + WS_N1); const float* SC = (const float*)(a.ws + WS_P + P_SC); unsigned* dbg = (unsigned*)(a.ws + WS_DBG);
    for (int k = tid; k < 1024; k += 512) n2s[k] = bf1(N2[(size_t)t * 1024 + k]);
    __syncthreads();
    for (int r = 0; r < 4; ++r) { const int c = tid + 512 * r; float s = 0.f; for (int k = 0; k < 1024; ++k) s += n2s[k] * a.in[I_WQ][(size_t)k * 2048 + c]; q[c] = s; }
    __syncthreads();
    float md = 0.f;
    for (int r = 0; r < 4; ++r) { const int n = tid + 512 * r, hh = n >> 7, key = n & 127; const float* kX = (hh & 1) ? a.in[I_K2] : a.in[I_K1];
        float s = 0.f; for (int d = 0; d < 128; ++d) s += q[hh * 128 + d] * kX[key * 128 + d];
        md = fmaxf(md, fabsf(s - SC[(size_t)n * T_TOK + t])); }
    atomicMax(&dbg[0], __builtin_bit_cast(unsigned, md));
}
__global__ void __launch_bounds__(64) dbg_topk(Args a) {
    __shared__ float s1[8][128], s2[8][128], cv[8][256]; __shared__ float t1v[8][16], t2v[8][16]; __shared__ int t1i[8][16], t2i[8][16], exi[8][16]; __shared__ float exv[8][16];
    const int t = dbg_tok(blockIdx.x), h = threadIdx.x;
    const float* SC = (const float*)(a.ws + WS_P + P_SC); const int* IDX = (const int*)(a.ws + WS_P + P_IDX); const float* GATE = (const float*)(a.ws + WS_P + P_GATE); unsigned* dbg = (unsigned*)(a.ws + WS_DBG);
    if (h >= 8) return;
    for (int j = 0; j < 128; ++j) { s1[h][j] = SC[(size_t)(h * 256 + j) * T_TOK + t]; s2[h][j] = SC[(size_t)(h * 256 + 128 + j) * T_TOK + t]; }
    for (int r = 0; r < 16; ++r) { int b1 = 0, b2 = 0; for (int j = 1; j < 128; ++j) { if (s1[h][j] > s1[h][b1]) b1 = j; if (s2[h][j] > s2[h][b2]) b2 = j; }
        t1v[h][r] = s1[h][b1]; t1i[h][r] = b1; s1[h][b1] = -1e30f; t2v[h][r] = s2[h][b2]; t2i[h][r] = b2; s2[h][b2] = -1e30f; }
    for (int c = 0; c < 256; ++c) cv[h][c] = t1v[h][c >> 4] + t2v[h][c & 15];
    for (int r = 0; r < 16; ++r) { int bc = 0; for (int c = 1; c < 256; ++c) if (cv[h][c] > cv[h][bc]) bc = c;
        exv[h][r] = cv[h][bc]; exi[h][r] = t1i[h][bc >> 4] * 128 + t2i[h][bc & 15]; cv[h][bc] = -1e30f; }
    float sum = 0.f; const float mx0 = exv[h][0]; for (int r = 0; r < 16; ++r) { exv[h][r] = expf(exv[h][r] - mx0); } for (int r = 0; r < 16; ++r) sum += exv[h][r];
    unsigned miss = 0; float gd = 0.f;
    for (int w = 0; w < 16; ++w) { const int e = IDX[(size_t)t * 128 + h * 16 + w]; const float g = GATE[(size_t)t * 128 + h * 16 + w]; bool found = false;
        for (int r = 0; r < 16; ++r) if (exi[h][r] == e) { found = true; gd = fmaxf(gd, fabsf(g - exv[h][r] / sum)); }
        if (!found) ++miss; }
    atomicAdd(&dbg[1], miss); atomicMax(&dbg[3], __builtin_bit_cast(unsigned, gd));
}
__global__ void __launch_bounds__(512) dbg_experts_pre(Args a) {
    __shared__ float n2s[1024]; __shared__ float ak[128]; __shared__ int ek[128]; __shared__ float red[8];
    const int t = dbg_tok(blockIdx.x), tid = threadIdx.x, lane = tid & 63, wave = tid >> 6;
    const bf16_t* N2 = (const bf16_t*)(a.ws + WS_N1); const int* IDX = (const int*)(a.ws + WS_P + P_IDX); const float* GATE = (const float*)(a.ws + WS_P + P_GATE);
    float* rows = (float*)(a.ws + WS_DBG + MiB);
    for (int k = tid; k < 1024; k += 512) n2s[k] = bf1(N2[(size_t)t * 1024 + k]);
    if (tid < 128) ek[tid] = IDX[(size_t)t * 128 + tid];
    __syncthreads();
    for (int k = wave * 16; k < wave * 16 + 16; ++k) { const float* u = a.in[I_PU] + (size_t)ek[k] * 1024; float s = 0.f; for (int j = lane; j < 1024; j += 64) s += u[j] * n2s[j];
        s = wave_sum(s); if (lane == 0) ak[k] = gelu_ref(s) * GATE[(size_t)t * 128 + k]; }
    __syncthreads();
    float h2[2]; float ss = 0.f;
    for (int r = 0; r < 2; ++r) { const int d = tid + 512 * r; float o = 0.f; for (int k = 0; k < 128; ++k) o += ak[k] * a.in[I_PV][(size_t)ek[k] * 1024 + d]; h2[r] = a.out[(size_t)t * 1024 + d] + o; ss += h2[r] * h2[r]; }
    ss = wave_sum(ss); if (lane == 0) red[wave] = ss; __syncthreads();
    float tot = 0.f; for (int w = 0; w < 8; ++w) tot += red[w];
    const float rstd = 1.f / sqrtf(tot / 1024.f + EPS);
    for (int r = 0; r < 2; ++r) { const int d = tid + 512 * r; rows[(size_t)blockIdx.x * 1024 + d] = h2[r] * rstd * a.in[I_FG][d]; }
}
__global__ void __launch_bounds__(512) dbg_experts_post(Args a) {
    const int t = dbg_tok(blockIdx.x), tid = threadIdx.x; const float* rows = (const float*)(a.ws + WS_DBG + MiB); float* dbgf = (float*)(a.ws + WS_DBG);
    float e = 0.f, n = 0.f;
    for (int r = 0; r < 2; ++r) { const int d = tid + 512 * r; const float x = rows[(size_t)blockIdx.x * 1024 + d], y = a.out[(size_t)t * 1024 + d]; e += (x - y) * (x - y); n += x * x; }
    e = wave_sum(e); n = wave_sum(n); if ((tid & 63) == 0) { atomicAdd(&dbgf[4], e); atomicAdd(&dbgf[5], n); }
}
__global__ void __launch_bounds__(512) dbg_report(Args a, int which) {
    const unsigned* dbg = (const unsigned*)(a.ws + WS_DBG); const float* dbgf = (const float*)(a.ws + WS_DBG);
    const float mA = dbgf[0], gd = dbgf[3]; const unsigned miss = dbg[1]; const float relC = sqrtf(dbgf[4] / fmaxf(dbgf[5], 1e-30f));
    float X;
    if (which == 0) { int mask = 0; if (mA > 0.05f) mask |= 1; if (miss > 400u) mask |= 2; if (relC > 0.05f) mask |= 4; if (gd > 0.02f) mask |= 8; X = 1000.f + 100.f * mask; }
    else if (which == 1) X = 1e6f * mA; else if (which == 2) X = 100.f + (float)miss; else if (which == 3) X = 1e6f * relC; else X = 1e6f * gd;
    for (size_t i = (size_t)blockIdx.x * 512 + threadIdx.x; i < (size_t)T_TOK * D; i += (size_t)gridDim.x * 512) a.out[i] = (i == 0) ? X : 0.f;
}
#endif

constexpr int NPH = 13;
__global__ void __launch_bounds__(NWAVES * 64, 2) fwd_kernel(Args args) {
    extern __shared__ __attribute__((aligned(16))) unsigned char lds_raw[];
    Frame F;
    F.lds = (LAS unsigned char*)lds_raw;
    F.tid = threadIdx.x; F.lane = F.tid & 63; F.wave = __builtin_amdgcn_readfirstlane(F.tid >> 6);
    F.G = gridDim.x; F.bid = blockIdx.x;
    volatile LAS unsigned* MISC = (volatile LAS unsigned*)(F.lds + MISC_OFF);
    for (int u = F.tid; u < (LDS_BYTES - LDSCTL_OFF) / 4; u += NWAVES * 64) ((LAS unsigned*)(F.lds + LDSCTL_OFF))[u] = 0u;
    __syncthreads();
    unsigned* ctl = (unsigned*)(args.ws + WS_CTL);
    const int lo = args.ph_lo, hi = args.ph_hi;
    XcdBarrier bar; bar.bar = ctl + CW_BAR + args.li * XCD_BAR_WORDS; bar.x = 0; bar.st = nullptr;
    if (hi - lo > 1) bar = xcd_barrier_post(ctl + CW_BAR + args.li * XCD_BAR_WORDS, MISC + 8);
#define IN(k) (lo <= (k) && (k) < hi)
#ifdef PROBE_TS
#define STAMP(k) do { if (F.bid == 0 && F.tid == 0) ((unsigned long long*)(args.ws + (472u << 20)))[(k)] = __builtin_amdgcn_s_memrealtime(); } while (0)
#else
#define STAMP(k) do { } while (0)
#endif
#define SEAM(k) do { if (IN(k) && IN((k) + 1)) { xcd_barrier(bar); if (XTRA_BAR) xcd_barrier(bar); } STAMP((k) + 1); } while (0)
    unsigned char* ws = args.ws;
    bf16_t* P = (bf16_t*)(ws + WS_P);

    STAMP(0);
    if (IN(0)) { phase0(F, args); SEAM(0); }
    if (IN(1)) {
        if (F8_LO > 0) { pg8::Gemm g{(const bf16_t*)(ws + WS_N1), (const bf16_t*)(ws + WS_WIN), T_TOK, F8_LO * 256, D, D}; pg8::StaticOrder S; S.init(T_TOK, F8_LO * 256, F.G, F.bid);
            pg8::EpiProj E{P, (float*)(ws + WS_ALR), 0}; pg8::gemm_phase<pg8::EpiProj, pg8::StaticOrder, false, true, false>(F.lds, g, S, E); }
        if (F8_LO < 21) {
            pg8::Gemm g{(const bf16_t*)(ws + WS_N18), (const bf16_t*)(ws + WS_W8 + (size_t)F8_LO * 256 * 1024), T_TOK, (21 - F8_LO) * 256, D / 2, D / 2, 0x7B7B7B7B, 0x75757575};
            pg8::StaticOrder S; S.init(T_TOK, (21 - F8_LO) * 256, F.G, F.G - 1 - F.bid);
            pg8::EpiProj E{P, (float*)(ws + WS_ALR), F8_LO}; pg8::gemm_phase<pg8::EpiProj, pg8::StaticOrder, false, true, true>(F.lds, g, S, E); }
        {
            const int nwg = (T_TOK / 256) * (NPROJ / 256), rem = nwg % F.G;
            if (rem == 0) convert_tables(F, args, F.bid * NWAVES + F.wave, F.G * NWAVES);
            else if (F.bid >= rem) convert_tables(F, args, (F.bid - rem) * NWAVES + F.wave, (F.G - rem) * NWAVES);
        }
        SEAM(1);
    }
    if (IN(2)) {
        gla_chunk_phase<false>(F, args);
        for (int it = F.bid; it < 1024; it += F.G) sgu_unit<false>(F, args, it);
        SEAM(2);
    }
    if (IN(3)) { if (DRY_EXP == 13) { gla_scan<true>(F, args); __syncthreads(); } gla_scan<false>(F, args); SEAM(3); }
    if (IN(4)) { if (DRY_EXP == 14) { gla_out_phase<true>(F, args); __syncthreads(); } gla_out_phase<false>(F, args); SEAM(4); }
    if (IN(5)) {
        { pg8::Gemm g{P + PC_Q, (const bf16_t*)(ws + WS_WA), T_TOK, D, 512, PLD}; pg8::StaticOrder S; S.init(T_TOK, D, F.G, F.bid);
          pg8::EpiBrA E{P}; pg8::gemm_phase<pg8::EpiBrA, pg8::StaticOrder, true, true>(F.lds, g, S, E); }
        { pg8::Gemm g{P + PC_SU, (const bf16_t*)(ws + WS_WB), T_TOK, D, 512, PLD}; pg8::StaticOrder S; S.init(T_TOK, D, F.G, F.bid);
          pg8::EpiBrB E{P}; pg8::gemm_phase<pg8::EpiBrB, pg8::StaticOrder, true, true>(F.lds, g, S, E); }
        SEAM(5);
    }
    if (IN(6)) {
        pg8::Gemm g{P + PC_MRG, (const bf16_t*)(ws + WS_WOUT), T_TOK, D, D, PLD}; pg8::StaticOrder S; S.init(T_TOK, D, F.G, F.bid);
        pg8::EpiOut E{args.in[I_X], args.out}; pg8::gemm_phase<pg8::EpiOut, pg8::StaticOrder, true, true>(F.lds, g, S, E);
        SEAM(6);
    }
    if (IN(7)) {
        const int gw = F.bid * NWAVES + F.wave, NGW = F.G * NWAVES;
        { int m = gw; for (; m + 3 * NGW < T_TOK; m += 4 * NGW) rms_rows_to_bf16<3, 4>(F.lane, args.out + (size_t)m * D, (size_t)NGW * D, args.in[I_N2G], (bf16_t*)(ws + WS_N1) + (size_t)m * D, (size_t)NGW * D, (unsigned*)(ws + WS_P + P_X8) + (size_t)m * 256, (size_t)NGW * 256);
          for (; m < T_TOK; m += NGW) rms_rows_to_bf16<3, 1>(F.lane, args.out + (size_t)m * D, 0, args.in[I_N2G], (bf16_t*)(ws + WS_N1) + (size_t)m * D, 0, (unsigned*)(ws + WS_P + P_X8) + (size_t)m * 256, 0); }
        SEAM(7);
    }
    if (IN(8)) {
        pg8::Gemm g{(const bf16_t*)(ws + WS_N1), (const bf16_t*)(ws + WS_WQF), T_TOK, 2048, D, D}; pg8::StaticOrder S; S.init(T_TOK, 2048, F.G, F.bid);
        pg8::EpiScores E{(float*)(ws + WS_P + P_SC)}; pg8::gemm_phase<pg8::EpiScores, pg8::StaticOrder, true, true>(F.lds, g, S, E);
        SEAM(8);
    }
    if (IN(9)) { peer_topk(F, args); SEAM(9); }
    if (IN(10)) { peer_u4_phase<0>(F, args); SEAM(10); }
    if (IN(11)) { if (DRY_EXP == 1) { peer_v_phase<1>(F, args); __syncthreads(); } peer_v_phase<0>(F, args); SEAM(11); }
    if (IN(12)) { final_norm_phase(F, args); }
#undef IN
#undef SEAM
}


#ifdef PROBE_TS
__global__ void __launch_bounds__(512) probe_report(Args a, int pi, int pj) {
    const unsigned long long* ts = (const unsigned long long*)(a.ws + (472u << 20));
    const float X1 = 10.f * (float)(ts[pi + 1] - ts[pi]) * 0.01f, X2 = (float)(ts[pj + 1] - ts[pj]) * 0.01f;
    for (size_t i = (size_t)blockIdx.x * 512 + threadIdx.x; i < (size_t)T_TOK * D; i += (size_t)gridDim.x * 512) a.out[i] = (i == 0) ? X1 : X2;
}
#endif
#ifdef PROBE_MFMA
__global__ void __launch_bounds__(64) probe_mfma(Args a) {
    const int l = threadIdx.x;
    i32x4 av = {0, 0, 0, 0};
    if (l == PROBE_L) av[PROBE_P >> 3] = 0x2 << (4 * (PROBE_P & 7));
    i32x8 b1, b2;
    for (int r = 0; r < 8; ++r) { unsigned w1 = 0, w2 = 0;
        for (int c = 0; c < 4; ++c) { const int b = 4 * r + c; int t = 0;
            t = __builtin_amdgcn_cvt_pk_fp8_f32((float)((b & 15) + 1), (float)(1 + (b >> 4) + 2 * (l >> 4)), 0, false);
            w1 |= ((unsigned)t & 0xffu) << (8 * c); w2 |= (((unsigned)t >> 8) & 0xffu) << (8 * c); }
        b1[r] = (int)w1; b2[r] = (int)w2; }
    const f32x4 z = {0.f, 0.f, 0.f, 0.f};
    const f32x4 d1 = __builtin_amdgcn_mfma_scale_f32_16x16x128_f8f6f4(__builtin_shufflevector(av, av, 0, 1, 2, 3, -1, -1, -1, -1), b1, z, 4, 0, 0, 0x7F7F7F7F, 0, 0x7F7F7F7F);
    const f32x4 d2 = __builtin_amdgcn_mfma_scale_f32_16x16x128_f8f6f4(__builtin_shufflevector(av, av, 0, 1, 2, 3, -1, -1, -1, -1), b2, z, 4, 0, 0, 0x7F7F7F7F, 0, 0x7F7F7F7F);
    float* st = (float*)(a.ws + (472u << 20));
    *(f32x4*)(st + 8 * l) = d1; *(f32x4*)(st + 8 * l + 4) = d2;
}
__global__ void __launch_bounds__(512) probe_mfma_report(Args a) {
    const int row = PROBE_L & 15;
    const float* st = (const float*)(a.ws + (472u << 20)) + 8 * (16 * (row >> 2)) + (row & 3); const float X1 = 10.f * st[0], X2 = st[4];
    for (size_t i = (size_t)blockIdx.x * 512 + threadIdx.x; i < (size_t)T_TOK * D; i += (size_t)gridDim.x * 512) a.out[i] = (i == 0) ? X1 : X2;
}
#endif
extern "C" void kernel_launch(void* const* d_in, const int* in_sizes, int n_in, void* d_out, int out_size, void* d_ws, size_t ws_size, hipStream_t stream) {
    static int grid = 0;
    if (grid == 0) {
        if (n_in != 20 || in_sizes[0] != T_TOK * D || out_size != T_TOK * D || ws_size < WS_END) {
            fprintf(stderr, "kernel_launch: unexpected shapes: n_in %d in0 %d out %d ws %zu (need %zu)\n", n_in, n_in > 0 ? in_sizes[0] : -1, out_size, ws_size, (size_t)WS_END); grid = -1; return; }
        int dev = 0, cus = 0;
        if (hipGetDevice(&dev) != hipSuccess || hipDeviceGetAttribute(&cus, hipDeviceAttributeMultiprocessorCount, dev) != hipSuccess) { grid = -1; return; }
        if (hipFuncSetAttribute((const void*)fwd_kernel, hipFuncAttributeMaxDynamicSharedMemorySize, LDS_BYTES) != hipSuccess) { fprintf(stderr, "kernel_launch: hipFuncSetAttribute failed\n"); grid = -1; return; }
        int per_cu = 0;
        if (hipOccupancyMaxActiveBlocksPerMultiprocessor(&per_cu, (const void*)fwd_kernel, NWAVES * 64, LDS_BYTES) != hipSuccess || per_cu < 1) fprintf(stderr, "kernel_launch: occupancy query says %d\n", per_cu);
        (void)hipGetLastError();
        grid = cus;
    }
    if (grid < 0) return;
    (void)hipMemsetAsync((char*)d_ws + WS_CTL, 0, CTL_ZERO_BYTES, stream);
    Args a{};
    for (int i = 0; i < 20; ++i) a.in[i] = (const float*)d_in[i];
    a.out = (float*)d_out; a.ws = (unsigned char*)d_ws;
#ifdef PROBE_MFMA
    hipLaunchKernelGGL(probe_mfma, dim3(1), dim3(64), 0, stream, a);
    hipLaunchKernelGGL(probe_mfma_report, dim3(1024), dim3(512), 0, stream, a);
    return;
#endif
#ifndef LAUNCH_LIST
#define LAUNCH_LIST {0, NPH}
#endif
    static const int ranges[][2] = { LAUNCH_LIST };
    const int nl = (int)(sizeof(ranges) / sizeof(ranges[0]));
    for (int li = 0; li < nl; ++li) { a.ph_lo = ranges[li][0]; a.ph_hi = ranges[li][1]; a.li = li;
        hipLaunchKernelGGL(fwd_kernel, dim3(grid), dim3(NWAVES * 64), LDS_BYTES, stream, a); }
}
```

```cpp
#include <hip/hip_runtime.h>
#include <cstdio>
#include <cstdint>


#ifndef XTRA_BAR
#define XTRA_BAR 0
#endif
#ifndef DRY_EXP
#define DRY_EXP 0
#endif
#ifndef DUP_PHASE
#define DUP_PHASE -1
#endif
#ifndef MK_N_LAUNCHES
#define MK_N_LAUNCHES 1
#endif

#define LAS __attribute__((address_space(3)))
#define GAS __attribute__((address_space(1)))
typedef unsigned short bf16_t;
typedef short bf16x8 __attribute__((ext_vector_type(8)));
typedef float f32x4 __attribute__((ext_vector_type(4)));
typedef float f32x2 __attribute__((ext_vector_type(2)));
typedef unsigned u32x4 __attribute__((ext_vector_type(4)));
typedef unsigned u32x2 __attribute__((ext_vector_type(2)));
typedef int i32x4 __attribute__((ext_vector_type(4)));
typedef int i32x8 __attribute__((ext_vector_type(8)));
typedef __bf16 bf16x2_t __attribute__((ext_vector_type(2)));

constexpr int T_TOK = 32768, D = 1024, SEQ = 4096, NBATCH = 8;
constexpr int NPROJ = 5376;
constexpr int PLD = 5120;
constexpr int PC_Q = 0, PC_K = 512, PC_V = 1024, PC_R = 1536, PC_SU = 2048, PC_SV = 2560, PC_GA = 3072, PC_GB = 4096;
constexpr int PC_MRG = 512;
constexpr float EPS = 1e-6f;
constexpr int NEXP = 16384;
#ifndef U_NG
#define U_NG 1
#endif
#ifndef SC_F8
#define SC_F8 0
#endif
#ifndef F8_LO
#define F8_LO 11
#endif
constexpr int UNG = U_NG, UNG_SH = (U_NG == 8 ? 3 : (U_NG == 4 ? 2 : (U_NG == 2 ? 1 : 0)));

constexpr size_t MiB = 1u << 20;
constexpr size_t WS_CTL = 0, CTL_ZERO_BYTES = 64 * 1024;
constexpr size_t WS_WIN = 1 * MiB;
constexpr size_t WS_WA = 12 * MiB;
constexpr size_t WS_WB = 13 * MiB;
constexpr size_t WS_WOUT = 14 * MiB;
constexpr size_t WS_WQF = 16 * MiB;
constexpr size_t WS_U8 = 20 * MiB;
constexpr size_t WS_V8 = 36 * MiB;
constexpr size_t WS_SU = 52 * MiB;
constexpr size_t WS_SV = 52 * MiB + 65536;
constexpr size_t WS_AK = 53 * MiB;
constexpr size_t WS_DEC = 84 * MiB;
constexpr size_t WS_ALR = 85 * MiB;
constexpr size_t WS_N1 = 87 * MiB;
constexpr size_t WS_P = 151 * MiB;
constexpr size_t WS_W8 = 472 * MiB;
constexpr size_t WS_N18 = 478 * MiB;
constexpr size_t WS_END = 510 * MiB;
constexpr size_t P_SC = 0, P_IDX = 256 * MiB, P_GATE = 272 * MiB, P_X8 = 288 * MiB;

constexpr int CW_BAR = 4096;

constexpr int RING_BYTES = 131072;
constexpr int LDSCTL_OFF = RING_BYTES, MISC_OFF = LDSCTL_OFF + 320;
constexpr int LDS_BYTES = 147456;
constexpr int NWAVES = 8;

__device__ __forceinline__ unsigned pk2(float lo, float hi) { const f32x2 v = {lo, hi}; const bf16x2_t b = __builtin_convertvector(v, bf16x2_t); return __builtin_bit_cast(unsigned, b); }
__device__ __forceinline__ unsigned f2bf(float f) { return pk2(f, 0.f) & 0xffffu; }
__device__ __forceinline__ float bflo(unsigned w) { return __builtin_bit_cast(float, w << 16); }
__device__ __forceinline__ float bfhi(unsigned w) { return __builtin_bit_cast(float, w & 0xffff0000u); }
__device__ __forceinline__ float bf1(bf16_t h) { return __builtin_bit_cast(float, ((unsigned)h) << 16); }
__device__ __forceinline__ float sigmoidf_(float x) { return __builtin_amdgcn_rcpf(1.f + __expf(-x)); }
__device__ __forceinline__ float gelu_tanh(float x) { const float y = 1.5957691216057308f * (x + 0.044715f * x * x * x); return x * sigmoidf_(y); }
__device__ __forceinline__ float siluf_(float x) { return x * sigmoidf_(x); }
__device__ __forceinline__ float wave_sum(float v) {
#pragma unroll
    for (int o = 1; o < 64; o <<= 1) v += __shfl_xor(v, o);
    return v;
}
#define LDS_WAIT() asm volatile("s_waitcnt lgkmcnt(0)" ::: "memory")
#define VM_WAIT() asm volatile("s_waitcnt vmcnt(0)" ::: "memory")

__device__ __forceinline__ int lane_now() { int z = 0; asm volatile("" : "+s"(z)); return (int)__builtin_amdgcn_mbcnt_hi(~0u, __builtin_amdgcn_mbcnt_lo(~0u, (unsigned)z)); }
namespace pg8 {
constexpr int BM = 256, BK = 64, HALF = 128, HTB = HALF * BK * 2, STAGE_BYTES = 8 * HTB, NXCD = 8, WGM = 8;
__host__ __device__ __forceinline__ int lds_byte(int r, int c) { const int st = (r >> 4) * 2 + (c >> 5), rr = r & 15, cc = c & 31, ob = rr * 64 + cc * 2; return st * 1024 + (ob ^ (((ob >> 9) & 1) << 5)); }
__host__ __device__ __forceinline__ void stage_rc(int b, int& R, int& C) { const int st = b / 1024, sb = b % 1024, swz = sb ^ (((sb >> 9) & 1) << 5); R = (st >> 1) * 16 + swz / 64; C = (st & 1) * 32 + (swz % 64) / 2; }
__host__ __device__ __forceinline__ int perm32(int rho) { const int n = rho >> 4, i = rho & 15; return 8 * (i >> 2) + 4 * n + (i & 3); }

struct Unit { int pm, pn; };
struct Gemm { const bf16_t* A; const bf16_t* Bt; int M, N, K, lda; int sa = 0, sb = 0; };

struct StaticOrder {
    int nM, nN, nwg, G, c;
    __host__ __device__ void init(int M, int N, int G_, int c_) { nM = M / BM; nN = N / BM; nwg = nM * nN; G = G_; c = c_; }
    __host__ __device__ bool next(int i, Unit& u) const {
        const long L = (long)i * G + c; if (L >= nwg) return false;
        int wgid = (int)L; { const int q = nwg / NXCD, r = nwg % NXCD, xcd = wgid % NXCD, off = wgid / NXCD; wgid = (xcd < r ? xcd * (q + 1) : r * (q + 1) + (xcd - r) * q) + off; }
        const int nig = WGM * nN, gid = wgid / nig, fm = gid * WGM, gsz = (nM - fm) < WGM ? (nM - fm) : WGM;
        u.pm = fm + ((wgid % nig) % gsz); u.pn = (wgid % nig) / gsz; return true;
    }
    __device__ __forceinline__ void a_ready(const Unit&) const {}
    __device__ __forceinline__ void done(const Unit&) const {}
};

template <class Epi, class Sched, bool ALIGN_EPI = false, bool SP2 = false, bool F8 = false>
__device__ __forceinline__ void gemm_phase(LAS unsigned char* lds, const Gemm g, const Sched& S, const Epi& E, int wave_id) {
    const int wid = wave_id, lane = lane_now(), tid = wid * 64 + lane, wr = wid >> 2, wc = wid & 3, fr = lane & 15, fq = lane >> 4;
    const int K = g.K, nt = K / BK, lda = g.lda; const int scA = g.sa, scB = g.sb; (void)scA; (void)scB;
    unsigned voffA[2], voffB[2];
#pragma unroll
    for (int i = 0; i < 2; ++i) { int R, C; stage_rc(tid * 16 + i * 8192, R, C); const int Rb = Epi::PERM ? ((R & ~31) + perm32(R & 31)) : R;
        voffA[i] = (unsigned)(R * lda + C) * 2u; voffB[i] = (unsigned)(Rb * K + C) * 2u; }
    const size_t kstep = (size_t)(BK * 2);
    const size_t hstepA = (size_t)HALF * lda * 2, hstepB = (size_t)HALF * K * 2;
    const size_t tstepA = 2 * hstepA, tstepB = 2 * hstepB;
    const unsigned ldsw = (unsigned)wid * 1024u; const unsigned ldsbase = (unsigned)(__UINTPTR_TYPE__)lds + ldsw;
    const int aoff = lds_byte(wr * 64 + fr, fq * 8), boff = lds_byte(wc * 32 + fr, fq * 8);
#define PG8_SA(b, h) (((b) * 2 + (h)) * HTB)
#define PG8_SB(b, h) ((4 + (b) * 2 + (h)) * HTB)
#define PG8_STAGE(bufoff, gbase, voff) do { _Pragma("unroll") for (int _i = 0; _i < 2; ++_i) \
        asm volatile("s_mov_b32 m0, %2\n\ts_nop 0\n\tglobal_load_lds_dwordx4 %0, %1" :: "v"((voff)[_i]), "s"((const char*)(gbase)), "s"(ldsbase + (unsigned)((bufoff) + _i * 8192)) : "memory", "m0"); } while (0)
#define PG8_LDA(dst, b, h) do { _Pragma("unroll") for (int m = 0; m < 4; ++m) _Pragma("unroll") for (int k = 0; k < 2; ++k) dst[m][k] = *(const LAS bf16x8*)(lds + PG8_SA(b, h) + aoff + m * 2048 + k * 1024); } while (0)
#define PG8_LDB(dst, b, h) do { _Pragma("unroll") for (int n = 0; n < 2; ++n) _Pragma("unroll") for (int k = 0; k < 2; ++k) dst[n][k] = *(const LAS bf16x8*)(lds + PG8_SB(b, h) + boff + n * 2048 + k * 1024); } while (0)
#define PG8_CAT(x) __builtin_shufflevector(__builtin_bit_cast(i32x4, (x)[0]), __builtin_bit_cast(i32x4, (x)[1]), 0, 1, 2, 3, 4, 5, 6, 7)
#define PG8_MMA(ai, bj, At, Bt) do { __builtin_amdgcn_s_setprio(1); if constexpr (F8) { _Pragma("unroll") for (int m = 0; m < 4; ++m) _Pragma("unroll") for (int n = 0; n < 2; ++n) \
        acc[ai][bj][m][n] = __builtin_amdgcn_mfma_scale_f32_16x16x128_f8f6f4(PG8_CAT(Bt[n]), PG8_CAT(At[m]), acc[ai][bj][m][n], 0, 0, 0, scB, 0, scA); } else { \
        _Pragma("unroll") for (int m = 0; m < 4; ++m) _Pragma("unroll") for (int n = 0; n < 2; ++n) _Pragma("unroll") for (int k = 0; k < 2; ++k) \
        acc[ai][bj][m][n] = __builtin_amdgcn_mfma_f32_16x16x32_bf16(Bt[n][k], At[m][k], acc[ai][bj][m][n], 0, 0, 0); } __builtin_amdgcn_s_setprio(0); } while (0)
#define PG8_WAIT_V(n) asm volatile("s_waitcnt vmcnt(" #n ")" ::: "memory")
#define PG8_WAIT_L(n) asm volatile("s_waitcnt lgkmcnt(" #n ")" ::: "memory")
#define PG8_BAR __builtin_amdgcn_s_barrier()
#define PG8_SCHED __builtin_amdgcn_sched_barrier(0)
    Unit cur, nxt; int ui = 0;
    if (!S.next(0, cur)) return;
    f32x4 acc[2][2][4][2];
#pragma unroll
    for (int a = 0; a < 2; ++a)
#pragma unroll
        for (int b = 0; b < 2; ++b)
#pragma unroll
            for (int m = 0; m < 4; ++m)
#pragma unroll
                for (int n = 0; n < 2; ++n) acc[a][b][m][n] = (f32x4){0.f, 0.f, 0.f, 0.f};
    bf16x8 At[4][2], B0[2][2], B1[2][2];
    const char* cA = (const char*)g.A + (size_t)cur.pm * tstepA; const char* cB = (const char*)g.Bt + (size_t)cur.pn * tstepB;
    S.a_ready(cur);
    if constexpr (SP2) {
        PG8_STAGE(PG8_SB(0, 0), cB, voffB); PG8_STAGE(PG8_SB(0, 1), cB + hstepB, voffB); PG8_STAGE(PG8_SA(0, 0), cA, voffA); PG8_STAGE(PG8_SA(0, 1), cA + hstepA, voffA);
        if (wr == 1) PG8_BAR;
        PG8_WAIT_V(2); PG8_BAR;
        PG8_STAGE(PG8_SB(1, 0), cB + kstep, voffB); PG8_STAGE(PG8_SA(1, 0), cA + kstep, voffA); PG8_STAGE(PG8_SB(1, 1), cB + hstepB + kstep, voffB);
        PG8_WAIT_V(6); PG8_BAR;
    } else {
        PG8_STAGE(PG8_SB(0, 0), cB, voffB); PG8_STAGE(PG8_SA(0, 0), cA, voffA); PG8_STAGE(PG8_SB(0, 1), cB + hstepB, voffB); PG8_STAGE(PG8_SA(0, 1), cA + hstepA, voffA);
        if (wr == 1) PG8_BAR;
        PG8_WAIT_V(4); PG8_BAR;
        PG8_STAGE(PG8_SB(1, 0), cB + kstep, voffB); PG8_STAGE(PG8_SA(1, 0), cA + kstep, voffA); PG8_STAGE(PG8_SB(1, 1), cB + hstepB + kstep, voffB);
        PG8_WAIT_V(6); PG8_BAR;
    }
    for (;;) {
        const bool has_next = S.next(ui + 1, nxt);
        const char* nA = has_next ? (const char*)g.A + (size_t)nxt.pm * tstepA : cA; const char* nB = has_next ? (const char*)g.Bt + (size_t)nxt.pn * tstepB : cB;
#pragma nounroll
        for (int t = 0; t < nt; t += 2) {
            const bool last = (t == nt - 2);
            const char* a1 = cA + (size_t)(t + 1) * kstep;
            const char* a2 = last ? nA : cA + (size_t)(t + 2) * kstep; const char* b2 = last ? nB : cB + (size_t)(t + 2) * kstep;
            const char* a3 = a2 + kstep; const char* b3 = b2 + kstep;
            if (last && has_next) S.a_ready(nxt);
            if constexpr (SP2) {
            PG8_LDB(B0, 0, 0); PG8_LDB(B1, 0, 1); PG8_SCHED; PG8_LDA(At, 0, 0); PG8_STAGE(PG8_SA(1, 1), a1 + hstepA, voffA);
            PG8_WAIT_V(8); PG8_WAIT_L(0); PG8_BAR; PG8_MMA(0, 0, At, B0); PG8_MMA(0, 1, At, B1); PG8_BAR; PG8_SCHED;
            PG8_LDA(At, 0, 1); PG8_STAGE(PG8_SB(0, 0), b2, voffB); PG8_STAGE(PG8_SB(0, 1), b2 + hstepB, voffB); PG8_STAGE(PG8_SA(0, 0), a2, voffA);
            PG8_WAIT_V(8); PG8_WAIT_L(0); PG8_BAR; PG8_MMA(1, 0, At, B0); PG8_MMA(1, 1, At, B1); PG8_BAR; PG8_SCHED;
            PG8_LDB(B0, 1, 0); PG8_LDB(B1, 1, 1); PG8_SCHED; PG8_LDA(At, 1, 0); PG8_STAGE(PG8_SA(0, 1), a2 + hstepA, voffA);
            PG8_WAIT_V(8); PG8_WAIT_L(0); PG8_BAR; PG8_MMA(0, 0, At, B0); PG8_MMA(0, 1, At, B1); PG8_BAR; PG8_SCHED;
            PG8_LDA(At, 1, 1); PG8_STAGE(PG8_SB(1, 0), b3, voffB); PG8_STAGE(PG8_SB(1, 1), b3 + hstepB, voffB); PG8_STAGE(PG8_SA(1, 0), a3, voffA);
            PG8_WAIT_V(8); PG8_WAIT_L(0); PG8_BAR; PG8_MMA(1, 0, At, B0); PG8_MMA(1, 1, At, B1); PG8_BAR; PG8_SCHED;
            } else {
            PG8_LDB(B0, 0, 0); PG8_SCHED; PG8_LDA(At, 0, 0); PG8_STAGE(PG8_SA(1, 1), a1 + hstepA, voffA);
            PG8_WAIT_L(8); PG8_BAR; PG8_WAIT_L(0); PG8_MMA(0, 0, At, B0); PG8_BAR; PG8_SCHED;
            PG8_LDB(B1, 0, 1); PG8_STAGE(PG8_SB(0, 0), b2, voffB);
            PG8_BAR; PG8_WAIT_L(0); PG8_MMA(0, 1, At, B1); PG8_BAR;
            PG8_LDA(At, 0, 1); PG8_STAGE(PG8_SA(0, 0), a2, voffA);
            PG8_BAR; PG8_WAIT_L(0); PG8_MMA(1, 0, At, B0); PG8_BAR; PG8_SCHED;
            PG8_STAGE(PG8_SB(0, 1), b2 + hstepB, voffB);
            PG8_WAIT_V(6); PG8_BAR; PG8_MMA(1, 1, At, B1); PG8_BAR;
            PG8_LDB(B0, 1, 0); PG8_SCHED; PG8_LDA(At, 1, 0); PG8_STAGE(PG8_SA(0, 1), a2 + hstepA, voffA);
            PG8_WAIT_L(8); PG8_BAR; PG8_WAIT_L(0); PG8_MMA(0, 0, At, B0); PG8_BAR; PG8_SCHED;
            PG8_LDB(B1, 1, 1); PG8_STAGE(PG8_SB(1, 0), b3, voffB);
            PG8_BAR; PG8_WAIT_L(0); PG8_MMA(0, 1, At, B1); PG8_BAR;
            PG8_LDA(At, 1, 1); PG8_STAGE(PG8_SA(1, 0), a3, voffA);
            PG8_BAR; PG8_WAIT_L(0); PG8_MMA(1, 0, At, B0); PG8_BAR; PG8_SCHED;
            PG8_STAGE(PG8_SB(1, 1), b3 + hstepB, voffB);
            PG8_WAIT_V(6); PG8_BAR; PG8_MMA(1, 1, At, B1); PG8_BAR;
            }
        }
        if constexpr (ALIGN_EPI) { if (wr == 0) PG8_BAR; }
        E(acc, cur, wr, wc, fr, fq); S.done(cur);
        if (!has_next) break;
#pragma unroll
        for (int a = 0; a < 2; ++a)
#pragma unroll
            for (int b = 0; b < 2; ++b)
#pragma unroll
                for (int m = 0; m < 4; ++m)
#pragma unroll
                    for (int n = 0; n < 2; ++n) acc[a][b][m][n] = (f32x4){0.f, 0.f, 0.f, 0.f};
        cur = nxt; cA = nA; cB = nB; ++ui;
        if constexpr (ALIGN_EPI) { if (wr == 1) PG8_BAR; }
    }
    PG8_WAIT_V(0);
    if constexpr (!ALIGN_EPI) { if (wr == 0) PG8_BAR; }
    PG8_BAR;
#undef PG8_SA
#undef PG8_SB
#undef PG8_STAGE
#undef PG8_LDA
#undef PG8_LDB
#undef PG8_MMA
#undef PG8_CAT
#undef PG8_WAIT_V
#undef PG8_WAIT_L
#undef PG8_BAR
#undef PG8_SCHED
}

__device__ __forceinline__ u32x4 pack8(f32x4 v0, f32x4 v1) { u32x4 w; w.x = pk2(v0[0], v0[1]); w.y = pk2(v0[2], v0[3]); w.z = pk2(v1[0], v1[1]); w.w = pk2(v1[2], v1[3]); return w; }
__device__ __forceinline__ void unpack8(u32x4 w, f32x4& v0, f32x4& v1) { v0 = (f32x4){bflo(w.x), bfhi(w.x), bflo(w.y), bfhi(w.y)}; v1 = (f32x4){bflo(w.z), bfhi(w.z), bflo(w.w), bfhi(w.w)}; }

struct EpiProj {
    static constexpr bool PERM = true;
    bf16_t* P; float* ALR; int pn0;
    __device__ __forceinline__ void operator()(const f32x4 (&acc)[2][2][4][2], const Unit& u, int wr, int wc, int fr, int fq) const {
        asm volatile("" : "+v"(fr), "+v"(fq));
        const int row0 = u.pm * BM + wr * 64 + fr; int pn = u.pn + pn0; const int cl = wc * 32 + 8 * fq;
        if (pn == 10) {
            if (wc == 0 && fq < 2) {
#pragma unroll
                for (int ai = 0; ai < 2; ++ai)
#pragma unroll
                    for (int m = 0; m < 4; ++m) { float* rp = ALR + (size_t)(row0 + ai * HALF + m * 16) * 16 + 8 * fq;
                        *(f32x4*)rp = acc[ai][0][m][0]; *(f32x4*)(rp + 4) = acc[ai][0][m][1]; }
            }
            return;
        }
        if (pn > 10) --pn;
        const int mode = pn < 8 ? 0 : (pn < 12 ? 1 : 2);
#pragma unroll
        for (int ai = 0; ai < 2; ++ai)
#pragma unroll
            for (int m = 0; m < 4; ++m) { bf16_t* rowp = P + (size_t)(row0 + ai * HALF + m * 16) * PLD + pn * BM + cl;
#pragma unroll
                for (int bj = 0; bj < 2; ++bj) { f32x4 v0 = acc[ai][bj][m][0], v1 = acc[ai][bj][m][1];
                    if (mode == 1) {
#pragma unroll
                        for (int i = 0; i < 4; ++i) { v0[i] = gelu_tanh(v0[i]); v1[i] = gelu_tanh(v1[i]); }
                    } else if (mode == 2) {
#pragma unroll
                        for (int i = 0; i < 4; ++i) { v0[i] = sigmoidf_(v0[i]); v1[i] = sigmoidf_(v1[i]); }
                    }
                    *(u32x4*)(rowp + bj * HALF) = pack8(v0, v1); } }
    }
};
struct EpiBrA {
    static constexpr bool PERM = true;
    bf16_t* P;
    __device__ __forceinline__ void operator()(const f32x4 (&acc)[2][2][4][2], const Unit& u, int wr, int wc, int fr, int fq) const {
        const int row0 = u.pm * BM + wr * 64 + fr; const int c0 = u.pn * BM + wc * 32 + 8 * fq;
#pragma unroll
        for (int ai = 0; ai < 2; ++ai)
#pragma unroll
            for (int m = 0; m < 4; ++m) { bf16_t* rowp = P + (size_t)(row0 + ai * HALF + m * 16) * PLD;
#pragma unroll
                for (int bj = 0; bj < 2; ++bj) { const int c = c0 + bj * HALF; f32x4 g0, g1; unpack8(*(const u32x4*)(rowp + PC_GA + c), g0, g1);
                    *(u32x4*)(rowp + PC_MRG + c) = pack8(acc[ai][bj][m][0] * g0, acc[ai][bj][m][1] * g1); } }
    }
};
struct EpiBrB {
    static constexpr bool PERM = true;
    bf16_t* P;
    __device__ __forceinline__ void operator()(const f32x4 (&acc)[2][2][4][2], const Unit& u, int wr, int wc, int fr, int fq) const {
        const int row0 = u.pm * BM + wr * 64 + fr; const int c0 = u.pn * BM + wc * 32 + 8 * fq;
#pragma unroll
        for (int ai = 0; ai < 2; ++ai)
#pragma unroll
            for (int m = 0; m < 4; ++m) { bf16_t* rowp = P + (size_t)(row0 + ai * HALF + m * 16) * PLD;
#pragma unroll
                for (int bj = 0; bj < 2; ++bj) { const int c = c0 + bj * HALF; f32x4 g0, g1, p0, p1; unpack8(*(const u32x4*)(rowp + PC_GB + c), g0, g1); unpack8(*(const u32x4*)(rowp + PC_MRG + c), p0, p1);
                    *(u32x4*)(rowp + PC_MRG + c) = pack8(p0 + acc[ai][bj][m][0] * g0, p1 + acc[ai][bj][m][1] * g1); } }
    }
};
struct EpiOut {
    static constexpr bool PERM = true;
    const float* X; float* O;
    __device__ __forceinline__ void operator()(const f32x4 (&acc)[2][2][4][2], const Unit& u, int wr, int wc, int fr, int fq) const {
        const int row0 = u.pm * BM + wr * 64 + fr; const int c0 = u.pn * BM + wc * 32 + 8 * fq;
#pragma unroll
        for (int ai = 0; ai < 2; ++ai)
#pragma unroll
            for (int m = 0; m < 4; ++m) { const size_t ro = (size_t)(row0 + ai * HALF + m * 16) * D;
#pragma unroll
                for (int bj = 0; bj < 2; ++bj) { const int c = c0 + bj * HALF;
                    const f32x4 x0 = *(const f32x4*)(X + ro + c), x1 = *(const f32x4*)(X + ro + c + 4);
                    *(f32x4*)(O + ro + c) = x0 + acc[ai][bj][m][0]; *(f32x4*)(O + ro + c + 4) = x1 + acc[ai][bj][m][1]; } }
    }
};
struct EpiScores {
    static constexpr bool PERM = true;
    bf16_t* SC;
    __device__ __forceinline__ void operator()(const f32x4 (&acc)[2][2][4][2], const Unit& u, int wr, int wc, int fr, int fq) const {
        const int tb0 = u.pm * 16 + wr * 4; const int cq0 = (u.pn * BM + wc * 32 + 8 * fq) >> 3;
#pragma unroll
        for (int ai = 0; ai < 2; ++ai)
#pragma unroll
            for (int m = 0; m < 4; ++m) { bf16_t* bp = SC + ((size_t)(tb0 + ai * 8 + m) * 256) * 128 + fr * 8;
#pragma unroll
                for (int bj = 0; bj < 2; ++bj) *(u32x4*)(bp + (size_t)(cq0 + bj * 16) * 128) = pack8(acc[ai][bj][m][0], acc[ai][bj][m][1]); }
    }
};
}

#define XB_TMO      128
#define XB_XCNT(j)  (256  + 64 * (j))
#define XB_XSUB(j)  (1280 + 64 * (j))
#define XB_XGEN(j)  (2304 + 64 * (j))
#define XB_TOP      3328
#define XB_TOPGEN   3392
#define XCD_BAR_WORDS 3456
#define XB_SPIN_CAP (1u << 18)
__device__ __forceinline__ unsigned xb_ld(unsigned* p)              { return __hip_atomic_load(p, __ATOMIC_RELAXED, __HIP_MEMORY_SCOPE_AGENT); }
__device__ __forceinline__ unsigned xb_add(unsigned* p, unsigned v) { return __hip_atomic_fetch_add(p, v, __ATOMIC_RELAXED, __HIP_MEMORY_SCOPE_AGENT); }
__device__ __forceinline__ unsigned xb_xcc_id() { return (unsigned)__builtin_amdgcn_s_getreg((3 << 11) | 20) & 0xFu; }
#define XB_SPIN(cond, bar) do { unsigned _sp = 0; while (cond) { __builtin_amdgcn_s_sleep(1); \
    if ((++_sp & 255u) == 0u) { if (xb_ld(&(bar)[XB_TMO])) break; if (_sp > XB_SPIN_CAP) { atomicAdd(&(bar)[XB_TMO], 1u); break; } } } } while (0)
struct XcdBarrier { unsigned* bar; unsigned x; volatile LAS unsigned* st; int wave; };
__device__ __forceinline__ XcdBarrier xcd_barrier_post(unsigned* bar, volatile LAS unsigned* st, int wave) {
    XcdBarrier b; b.bar = bar; b.x = xb_xcc_id(); b.st = st; b.wave = wave;
    if (wave == 0 && lane_now() == 0) (void)xb_add(&bar[XB_XCNT(b.x)], 1u);
    return b;
}
__device__ __forceinline__ void xcd_barrier_complete(unsigned* bar, unsigned x, unsigned& nloc, unsigned& nx) {
    const unsigned G = gridDim.x * gridDim.y * gridDim.z;
    unsigned sum, cnt, mine, sp = 0u;
    for (;;) {
        sum = 0u; cnt = 0u; mine = 0u;
#pragma unroll
        for (unsigned j = 0; j < 16; ++j) { const unsigned c = xb_ld(&bar[XB_XCNT(j)]); sum += c; cnt += (c > 0u) ? 1u : 0u; mine = (j == x) ? c : mine; }
        if (sum == G) break;
        __builtin_amdgcn_s_sleep(1);
        if ((++sp & 255u) == 0u) { if (xb_ld(&bar[XB_TMO])) break; if (sp > XB_SPIN_CAP) { atomicAdd(&bar[XB_TMO], 1u); break; } }
    }
    nloc = mine > 0u ? mine : 1u; nx = cnt > 0u ? cnt : 1u;
}
__device__ __forceinline__ void xcd_barrier(const XcdBarrier& b) {
    asm volatile("s_waitcnt vmcnt(0)" ::: "memory");
    __syncthreads();
    if (b.wave == 0 && lane_now() == 0) {
        unsigned* bar = b.bar;
        __builtin_amdgcn_s_waitcnt(0);
        unsigned nloc = b.st[0], nx = b.st[1];
        if (nloc == 0u) { xcd_barrier_complete(bar, b.x, nloc, nx); b.st[0] = nloc; b.st[1] = nx; }
        const unsigned old = xb_add(&bar[XB_XSUB(b.x)], 1u);
        const unsigned gen = old / nloc;
        if (old + 1u == (gen + 1u) * nloc) {
            __builtin_amdgcn_fence(__ATOMIC_RELEASE, "agent");
            asm volatile("s_waitcnt vmcnt(0)" ::: "memory");
            const unsigned og = xb_add(&bar[XB_TOP], 1u);
            const unsigned tg = og / nx;
            if (og + 1u == (tg + 1u) * nx) xb_add(&bar[XB_TOPGEN], 1u);
            else XB_SPIN(xb_ld(&bar[XB_TOPGEN]) == tg, bar);
            __builtin_amdgcn_fence(__ATOMIC_ACQUIRE, "agent");
            xb_add(&bar[XB_XGEN(b.x)], 1u);
            asm volatile("s_waitcnt vmcnt(0)" ::: "memory");
        } else {
            XB_SPIN(xb_ld(&bar[XB_XGEN(b.x)]) == gen, bar);
            __builtin_amdgcn_fence(__ATOMIC_ACQUIRE, "agent");
            asm volatile("s_waitcnt vmcnt(0)" ::: "memory");
        }
    }
    __syncthreads();
}

struct Args {
    const float* in[20]; float* out; unsigned char* ws; int ph_lo, ph_hi, li, pad;
};
enum { I_X = 0, I_N1G, I_WIN, I_WGU, I_BG, I_GLAG, I_SLNG, I_SLNB, I_SW, I_SB, I_WBA, I_WBB, I_WOUT, I_N2G, I_WQ, I_K1, I_K2, I_PU, I_PV, I_FG };

struct Frame {
    LAS unsigned char* lds;
    int tid, lane, wave, G, bid;
};

__device__ __forceinline__ float clamp448(float v) { return __builtin_amdgcn_fmed3f(v, -448.f, 448.f); }
template <int MODE, bool F8 = false>
__device__ __forceinline__ void p0_transpose_item(const float* W, int K, int Nsrc, int Ndst, bf16_t* WT, LAS float* scr, int item, int lane, float sc8 = 1.f) {
    const int nblk = Ndst / 32, kb = item / nblk, nb = item % nblk, k0 = 64 * kb, n0 = 32 * nb;
    const int nd = n0 + (lane & 31);
    int sc = nd; bool valid = true;
    if (MODE == 1) { if (nd < 2048) sc = nd; else if (nd < 2560) sc = nd + 16; else if (nd < 2576) sc = 2048 + (nd - 2560); else if (nd < 2816) { sc = 0; valid = false; } else sc = nd - 240; }
#pragma unroll 8
    for (int i = 0; i < 32; ++i) { const int kk = 2 * i + (lane >> 5); const float v = valid ? W[(size_t)(k0 + kk) * Nsrc + sc] : 0.f; scr[kk * 33 + (lane & 31)] = v; }
    LDS_WAIT(); asm volatile("" ::: "memory");
    if (F8) {
        const int c = lane & 3;
#pragma unroll
        for (int j = 0; j < 2; ++j) { const int n = (lane >> 2) + 16 * j; const LAS float* s = scr + (16 * c) * 33 + n; u32x4 o;
#pragma unroll
            for (int q = 0; q < 4; ++q) { int w = 0; w = __builtin_amdgcn_cvt_pk_fp8_f32(clamp448(s[(4 * q) * 33] * sc8), clamp448(s[(4 * q + 1) * 33] * sc8), w, false);
                w = __builtin_amdgcn_cvt_pk_fp8_f32(clamp448(s[(4 * q + 2) * 33] * sc8), clamp448(s[(4 * q + 3) * 33] * sc8), w, true); o[q] = (unsigned)w; }
            *(u32x4*)((unsigned char*)WT + (size_t)(n0 + n) * K + k0 + 16 * c) = o; }
    } else {
    const int c = lane & 7;
#pragma unroll
    for (int j = 0; j < 4; ++j) { const int n = (lane >> 3) + 8 * j; const LAS float* s = scr + (8 * c) * 33 + n;
        u32x4 o; o.x = pk2(s[0 * 33], s[1 * 33]); o.y = pk2(s[2 * 33], s[3 * 33]); o.z = pk2(s[4 * 33], s[5 * 33]); o.w = pk2(s[6 * 33], s[7 * 33]);
        *(u32x4*)(WT + (size_t)(n0 + n) * K + k0 + 8 * c) = o; }
    }
    LDS_WAIT(); asm volatile("" ::: "memory");
}
template <int OM, int NB>
__device__ __forceinline__ void rms_rows_to_bf16(int lane, const float* x0, size_t xstride, const float* g, bf16_t* o0, size_t ostride, unsigned* o80 = nullptr, size_t o8stride = 0) {
    f32x4 v[NB][4]; float s[NB];
#pragma unroll
    for (int b = 0; b < NB; ++b) { const f32x4* xr = (const f32x4*)(x0 + b * xstride) + lane;
#pragma unroll
        for (int j = 0; j < 4; ++j) v[b][j] = xr[64 * j]; }
#pragma unroll
    for (int b = 0; b < NB; ++b) { s[b] = 0.f;
#pragma unroll
        for (int j = 0; j < 4; ++j) s[b] += (v[b][j].x * v[b][j].x + v[b][j].y * v[b][j].y) + (v[b][j].z * v[b][j].z + v[b][j].w * v[b][j].w); }
#pragma unroll
    for (int o = 1; o < 64; o <<= 1) {
#pragma unroll
        for (int b = 0; b < NB; ++b) s[b] += __shfl_xor(s[b], o); }
    const f32x4* gr = (const f32x4*)g + lane;
#pragma unroll
    for (int b = 0; b < NB; ++b) { const float rstd = 1.f / sqrtf(s[b] * (1.f / D) + EPS); u32x2* o8 = (u32x2*)(o0 + b * ostride) + lane;
#pragma unroll
        for (int j = 0; j < 4; ++j) { const f32x4 gg = gr[64 * j]; const f32x4 y = v[b][j] * rstd * gg; u32x2 o; o.x = pk2(y.x, y.y); o.y = pk2(y.z, y.w); if (OM & 1) o8[64 * j] = o;
            if (OM == 3) { int w = 0; w = __builtin_amdgcn_cvt_pk_fp8_f32(clamp448(bflo(o.x) * 16.f), clamp448(bfhi(o.x) * 16.f), w, false); w = __builtin_amdgcn_cvt_pk_fp8_f32(clamp448(bflo(o.y) * 16.f), clamp448(bfhi(o.y) * 16.f), w, true); (o80 + b * o8stride)[64 * j + lane] = (unsigned)w; }
            if (OM == 2) { int w = 0; w = __builtin_amdgcn_cvt_pk_fp8_f32(clamp448(y.x * 16.f), clamp448(y.y * 16.f), w, false); w = __builtin_amdgcn_cvt_pk_fp8_f32(clamp448(y.z * 16.f), clamp448(y.w * 16.f), w, true); (o80 + b * o8stride)[64 * j + lane] = (unsigned)w; } } }
}
__device__ __forceinline__ float wave_max(float v) {
#pragma unroll
    for (int o = 1; o < 64; o <<= 1) v = fmaxf(v, __shfl_xor(v, o));
    return v;
}
template <int NB>
__device__ __forceinline__ void cvt_rows_fp8(int lane, const float* const (&src)[NB], unsigned char* const (&dst16)[NB], float* const (&scale_out)[NB]) {
    f32x4 v[NB][4]; float m[NB];
#pragma unroll
    for (int b = 0; b < NB; ++b) {
#pragma unroll
        for (int j = 0; j < 4; ++j) v[b][j] = *(const GAS f32x4*)(src[b] + 16 * lane + 4 * j); }
#pragma unroll
    for (int b = 0; b < NB; ++b) { m[b] = 0.f;
#pragma unroll
        for (int j = 0; j < 4; ++j) m[b] = fmaxf(m[b], fmaxf(fmaxf(fabsf(v[b][j].x), fabsf(v[b][j].y)), fmaxf(fabsf(v[b][j].z), fabsf(v[b][j].w)))); }
#pragma unroll
    for (int o = 1; o < 64; o <<= 1) {
#pragma unroll
        for (int b = 0; b < NB; ++b) m[b] = fmaxf(m[b], __shfl_xor(m[b], o)); }
#pragma unroll
    for (int b = 0; b < NB; ++b) { const float inv = m[b] > 0.f ? 224.f / m[b] : 0.f, sc = m[b] > 0.f ? m[b] * (1.f / 224.f) : 1.f;
        u32x4 o;
#pragma unroll
        for (int j = 0; j < 4; ++j) { int w = 0; w = __builtin_amdgcn_cvt_pk_fp8_f32(v[b][j].x * inv, v[b][j].y * inv, w, false); w = __builtin_amdgcn_cvt_pk_fp8_f32(v[b][j].z * inv, v[b][j].w * inv, w, true); o[j] = (unsigned)w; }
        *(GAS u32x4*)dst16[b] = o;
        if (lane == 0) *(GAS float*)scale_out[b] = sc; }
}
__device__ __forceinline__ unsigned fp4_code(float t) { const float a = fabsf(t);
    const unsigned c = (unsigned)(a >= 0.25f) + (unsigned)(a >= 0.75f) + (unsigned)(a >= 1.25f) + (unsigned)(a >= 1.75f) + (unsigned)(a >= 2.5f) + (unsigned)(a >= 3.5f) + (unsigned)(a >= 5.f);
    return c | (t < 0.f ? 8u : 0u); }
template <int NB>
__device__ __forceinline__ void cvt_rows_fp4(int lane, const float* const (&src)[NB], unsigned char* const (&dst8)[NB], float* const (&scale_out)[NB]) {
    f32x4 v[NB][4]; float m[NB];
#pragma unroll
    for (int b = 0; b < NB; ++b) {
#pragma unroll
        for (int j = 0; j < 4; ++j) v[b][j] = *(const GAS f32x4*)(src[b] + 16 * lane + 4 * j); }
#pragma unroll
    for (int b = 0; b < NB; ++b) { m[b] = 0.f;
#pragma unroll
        for (int j = 0; j < 4; ++j) m[b] = fmaxf(m[b], fmaxf(fmaxf(fabsf(v[b][j].x), fabsf(v[b][j].y)), fmaxf(fabsf(v[b][j].z), fabsf(v[b][j].w)))); }
#pragma unroll
    for (int o = 1; o < 64; o <<= 1) {
#pragma unroll
        for (int b = 0; b < NB; ++b) m[b] = fmaxf(m[b], __shfl_xor(m[b], o)); }
#pragma unroll
    for (int b = 0; b < NB; ++b) { const float inv = m[b] > 0.f ? 6.f / m[b] : 0.f, sc = m[b] > 0.f ? m[b] * (1.f / 6.f) : 1.f;
        u32x2 o;
#pragma unroll
        for (int h = 0; h < 2; ++h) { unsigned w = 0;
#pragma unroll
            for (int j = 0; j < 2; ++j) { const f32x4 t = v[b][2 * h + j] * inv;
                w |= (fp4_code(t.x) | (fp4_code(t.y) << 4) | (fp4_code(t.z) << 8) | (fp4_code(t.w) << 12)) << (16 * j); }
            o[h] = w; }
        *(GAS u32x2*)dst8[b] = o;
        if (lane == 0) *(GAS float*)scale_out[b] = sc; }
}
__device__ __forceinline__ void convert_tables(const Frame& F, const Args& A, int wi, int nw) {
    unsigned char* ws = A.ws; const int gw = wi, NGW = nw;
    {
        int mc = gw;
        for (; mc + 3 * NGW < NEXP; mc += 4 * NGW) { const float* src[4]; unsigned char* dst[4]; float* sco[4];
#pragma unroll
            for (int b = 0; b < 4; ++b) { const int e = mc + b * NGW; src[b] = A.in[I_PU] + (size_t)e * D; dst[b] = ws + WS_U8 + (size_t)((e & (UNG - 1)) * (NEXP / UNG) + (e >> UNG_SH)) * 512 + 8 * F.lane; sco[b] = (float*)(ws + WS_SU) + e; }
            cvt_rows_fp4<4>(F.lane, src, dst, sco); }
        for (; mc < NEXP; mc += NGW) { const float* src[1]; unsigned char* dst[1]; float* sco[1];
            const int e = mc; src[0] = A.in[I_PU] + (size_t)e * D; dst[0] = ws + WS_U8 + (size_t)((e & (UNG - 1)) * (NEXP / UNG) + (e >> UNG_SH)) * 512 + 8 * F.lane; sco[0] = (float*)(ws + WS_SU) + e;
            cvt_rows_fp4<1>(F.lane, src, dst, sco); }
    }
    {
        int mc = gw;
        for (; mc + 3 * NGW < NEXP; mc += 4 * NGW) { const float* src[4]; unsigned char* dst[4]; float* sco[4];
#pragma unroll
            for (int b = 0; b < 4; ++b) { const int e = mc + b * NGW; src[b] = A.in[I_PV] + (size_t)e * D; dst[b] = ws + WS_V8 + ((size_t)(F.lane >> 3) * NEXP + e) * 128 + 16 * (F.lane & 7); sco[b] = (float*)(ws + WS_SV) + e; }
            cvt_rows_fp8<4>(F.lane, src, dst, sco); }
        for (; mc < NEXP; mc += NGW) { const float* src[1]; unsigned char* dst[1]; float* sco[1];
            const int e = mc; src[0] = A.in[I_PV] + (size_t)e * D; dst[0] = ws + WS_V8 + ((size_t)(F.lane >> 3) * NEXP + e) * 128 + 16 * (F.lane & 7); sco[0] = (float*)(ws + WS_SV) + e;
            cvt_rows_fp8<1>(F.lane, src, dst, sco); }
    }
}
__device__ __forceinline__ void phase0(const Frame& F, const Args& A) {
    unsigned char* ws = A.ws;
    {
        LAS float* kx = (LAS float*)F.lds;
        LAS float* wt = (LAS float*)(F.lds + 128 * 129 * 4);
        bf16_t* WQF = (bf16_t*)(ws + WS_WQF);
        for (int it = F.bid; it < 512; it += F.G) {
            const int hh = it >> 5, kblk = it & 31, k0 = kblk * 32;
            const float* kX = (hh & 1) ? A.in[I_K2] : A.in[I_K1];
            __syncthreads();
            for (int e = F.tid; e < 128 * 128; e += 512) kx[(e >> 7) * 129 + (e & 127)] = kX[e];
            for (int e = F.tid; e < 32 * 128; e += 512) wt[e] = A.in[I_WQ][(size_t)(k0 + (e >> 7)) * 2048 + hh * 128 + (e & 127)];
            __syncthreads();
            const int key = F.tid & 127, kq = F.tid >> 7;
            float acc[8];
#pragma unroll
            for (int i = 0; i < 8; ++i) acc[i] = 0.f;
            for (int d = 0; d < 128; ++d) { const float b = kx[key * 129 + d];
#pragma unroll
                for (int i = 0; i < 8; ++i) acc[i] += wt[(kq * 8 + i) * 128 + d] * b; }
            if (SC_F8) { u32x2 o;
#pragma unroll
                for (int h2 = 0; h2 < 2; ++h2) { int w = 0; w = __builtin_amdgcn_cvt_pk_fp8_f32(clamp448(acc[4 * h2] * 1024.f), clamp448(acc[4 * h2 + 1] * 1024.f), w, false);
                    w = __builtin_amdgcn_cvt_pk_fp8_f32(clamp448(acc[4 * h2 + 2] * 1024.f), clamp448(acc[4 * h2 + 3] * 1024.f), w, true); o[h2] = (unsigned)w; }
                *(u32x2*)((unsigned char*)WQF + (size_t)(hh * 128 + key) * 1024 + k0 + kq * 8) = o;
            } else {
            u32x4 o; o.x = pk2(acc[0], acc[1]); o.y = pk2(acc[2], acc[3]); o.z = pk2(acc[4], acc[5]); o.w = pk2(acc[6], acc[7]);
            *(u32x4*)(WQF + (size_t)(hh * 128 + key) * 1024 + k0 + kq * 8) = o; }
        }
        __syncthreads();
    }
    LAS float* scr = (LAS float*)(F.lds + F.wave * 16384);
    const int gw = F.bid * NWAVES + F.wave, NGW = F.G * NWAVES;
    constexpr int I_IN = 16 * (NPROJ / 32), I_A = 8 * 32, I_B = 8 * 32, I_O = 16 * 32;
    constexpr int NITEMS = I_IN + I_A + I_B + I_O;
    for (int it = gw; it < NITEMS; it += NGW) {
        int r = it;
        if (r < I_IN) { if ((r % (NPROJ / 32)) * 32 >= F8_LO * 256) p0_transpose_item<1, true>(A.in[I_WIN], 1024, 5136, NPROJ, (bf16_t*)(ws + WS_W8), scr, r, F.lane, 1024.f);
                        else p0_transpose_item<1, false>(A.in[I_WIN], 1024, 5136, NPROJ, (bf16_t*)(ws + WS_WIN), scr, r, F.lane); continue; } r -= I_IN;
        if (r < I_A) { p0_transpose_item<0>(A.in[I_WBA], 512, 1024, 1024, (bf16_t*)(ws + WS_WA), scr, r, F.lane); continue; } r -= I_A;
        if (r < I_B) { p0_transpose_item<0>(A.in[I_WBB], 512, 1024, 1024, (bf16_t*)(ws + WS_WB), scr, r, F.lane); continue; } r -= I_B;
        p0_transpose_item<0>(A.in[I_WOUT], 1024, 1024, 1024, (bf16_t*)(ws + WS_WOUT), scr, r, F.lane);
    }
    constexpr int OM1 = F8_LO <= 0 ? 2 : (F8_LO >= 21 ? 1 : 3);
    { int m = gw; for (; m + 3 * NGW < T_TOK; m += 4 * NGW) rms_rows_to_bf16<OM1, 4>(F.lane, A.in[I_X] + (size_t)m * D, (size_t)NGW * D, A.in[I_N1G], (bf16_t*)(ws + WS_N1) + (size_t)m * D, (size_t)NGW * D, (unsigned*)(ws + WS_N18) + (size_t)m * 256, (size_t)NGW * 256);
      for (; m < T_TOK; m += NGW) rms_rows_to_bf16<OM1, 1>(F.lane, A.in[I_X] + (size_t)m * D, 0, A.in[I_N1G], (bf16_t*)(ws + WS_N1) + (size_t)m * D, 0, (unsigned*)(ws + WS_N18) + (size_t)m * 256, 0); }
}

__device__ __forceinline__ float log_sigmoid(float z) { return fminf(z, 0.f) - log1pf(__expf(-fabsf(z))); }

template <bool DRY>
__device__ __forceinline__ void gla_chunk_phase(const Frame& F, const Args& A) {
    unsigned char* ws = A.ws;
    const bf16_t* P = (const bf16_t*)(ws + WS_P);
    const float* ALR = (const float*)(ws + WS_ALR);
    LAS float* alr = (LAS float*)F.lds;
    LAS float* tot = (LAS float*)(F.lds + 4096);
    LAS bf16_t* kdT = (LAS bf16_t*)(F.lds + 8192);
    LAS bf16_t* vT = (LAS bf16_t*)(F.lds + 26624);
    LAS bf16_t* stT = (LAS bf16_t*)(F.lds + 45056);
    const int tid = F.tid, kk = tid & 127, seg = tid >> 7;
    const bool hconst = (F.G & 3) == 0;
    int hcur = -1; float w[16]; float bias = 0.f;
#pragma unroll
    for (int j = 0; j < 16; ++j) w[j] = 0.f;
    float na0, na1; bf16_t nk[16], nv[16];
#define GC_LOAD(unit) do { const int h_ = (unit) & 3, c_ = ((unit) >> 2) & 63, b_ = (unit) >> 8; const int t0_ = b_ * SEQ + c_ * 64; \
        na0 = ALR[(size_t)t0_ * 16 + tid]; na1 = ALR[(size_t)t0_ * 16 + 512 + tid]; \
        const bf16_t* kp_ = P + (size_t)(t0_ + 16 * seg) * PLD + PC_K + h_ * 128 + kk; const bf16_t* vp_ = P + (size_t)(t0_ + 16 * seg) * PLD + PC_V + h_ * 128 + kk; \
        _Pragma("unroll") for (int i_ = 0; i_ < 16; ++i_) { nk[i_] = kp_[(size_t)i_ * PLD]; nv[i_] = vp_[(size_t)i_ * PLD]; } } while (0)
    int unit = F.bid;
    if (unit < 2048) GC_LOAD(unit);
    for (; unit < 2048; unit += F.G) {
        const int h = unit & 3;
        if (h != hcur) { hcur = h;
#pragma unroll
            for (int j = 0; j < 16; ++j) w[j] = A.in[I_WGU][(size_t)j * 512 + h * 128 + kk];
            bias = A.in[I_BG][h * 128 + kk]; }
        __syncthreads();
        alr[tid] = na0; alr[512 + tid] = na1;
        bf16_t kr[16], vr[16];
#pragma unroll
        for (int i = 0; i < 16; ++i) { kr[i] = nk[i]; vr[i] = nv[i]; }
        if (unit + F.G < 2048) GC_LOAD(unit + F.G);
        __syncthreads();
        float cum[16]; float run = 0.f;
#pragma unroll
        for (int i = 0; i < 16; ++i) { const LAS f32x4* ap = (const LAS f32x4*)(alr + (16 * seg + i) * 16); float z = bias;
#pragma unroll
            for (int q = 0; q < 4; ++q) { const f32x4 a4 = ap[q]; z += a4.x * w[4 * q] + a4.y * w[4 * q + 1] + a4.z * w[4 * q + 2] + a4.w * w[4 * q + 3]; }
            const float ls = fminf(z, 0.f) - __logf(1.f + __expf(-fabsf(z)));
            run += ls * (1.f / 16.f); cum[i] = run; }
        tot[seg * 128 + kk] = run;
        __syncthreads();
        {
            const float t0s = tot[kk], t1s = tot[128 + kk], t2s = tot[256 + kk], t3s = tot[384 + kk];
            const float total = (t0s + t1s) + (t2s + t3s);
            const float prefix = seg == 0 ? 0.f : (seg == 1 ? t0s : (seg == 2 ? t0s + t1s : t0s + t1s + t2s));
            unsigned kw[8], vw[8];
#pragma unroll
            for (int i = 0; i < 8; ++i) {
                const float e0 = __expf(total - (prefix + cum[2 * i])), e1 = __expf(total - (prefix + cum[2 * i + 1]));
                kw[i] = pk2(bf1(kr[2 * i]) * e0, bf1(kr[2 * i + 1]) * e1); vw[i] = (unsigned)vr[2 * i] | ((unsigned)vr[2 * i + 1] << 16);
            }
            *(LAS u32x4*)(kdT + kk * 72 + 16 * seg) = (u32x4){kw[0], kw[1], kw[2], kw[3]}; *(LAS u32x4*)(kdT + kk * 72 + 16 * seg + 8) = (u32x4){kw[4], kw[5], kw[6], kw[7]};
            *(LAS u32x4*)(vT + kk * 72 + 16 * seg) = (u32x4){vw[0], vw[1], vw[2], vw[3]}; *(LAS u32x4*)(vT + kk * 72 + 16 * seg + 8) = (u32x4){vw[4], vw[5], vw[6], vw[7]};
            if (seg == 0) ((float*)(DRY ? (unsigned char*)A.out + 96 * MiB : ws + WS_DEC))[(size_t)unit * 128 + kk] = __expf(total);
        }
        __syncthreads();
        {
            const int w8 = F.wave, l = F.lane, fr = l & 15, fq = l >> 4;
            f32x4 acc[8];
#pragma unroll
            for (int n = 0; n < 8; ++n) acc[n] = (f32x4){0.f, 0.f, 0.f, 0.f};
#pragma unroll
            for (int ks = 0; ks < 2; ++ks) {
                const bf16x8 a = *(const LAS bf16x8*)(kdT + (16 * w8 + fr) * 72 + 32 * ks + 8 * fq);
#pragma unroll
                for (int n = 0; n < 8; ++n) { const bf16x8 bb = *(const LAS bf16x8*)(vT + (16 * n + fr) * 72 + 32 * ks + 8 * fq);
                    acc[n] = __builtin_amdgcn_mfma_f32_16x16x32_bf16(a, bb, acc[n], 0, 0, 0); }
            }
#pragma unroll
            for (int n = 0; n < 8; ++n) { u32x2 o; o.x = pk2(acc[n][0], acc[n][1]); o.y = pk2(acc[n][2], acc[n][3]);
                *(LAS u32x2*)(stT + (16 * n + fr) * 136 + 16 * w8 + 4 * fq) = o; }
        }
        __syncthreads();
        {
            bf16_t* ST = (bf16_t*)(DRY ? (unsigned char*)A.out : ws + WS_N1) + (size_t)unit * 16384;
            const int vv = tid >> 2, part = tid & 3;
#pragma unroll
            for (int q = 0; q < 4; ++q) *(u32x4*)(ST + (size_t)vv * 128 + 32 * part + 8 * q) = *(const LAS u32x4*)(stT + vv * 136 + 32 * part + 8 * q);
        }
    }
#undef GC_LOAD
    (void)hconst;
}

template <bool DRY>
__device__ __forceinline__ void sgu_unit(const Frame& F, const Args& A, int unit) {
    const int g = unit & 3, blk = (unit >> 2) & 31, b = unit >> 7;
    const int t0 = b * SEQ + blk * 128;
    bf16_t* P = (bf16_t*)(A.ws + WS_P);
    LAS bf16_t* wA = (LAS bf16_t*)F.lds;
    LAS bf16_t* vnT = (LAS bf16_t*)(F.lds + 34816);
    LAS float* st = (LAS float*)(F.lds + 69632);
    LAS bf16_t* suS = (LAS bf16_t*)(F.lds + 70656);
    const int tid = F.tid;
    __syncthreads();
    {
        const int j = tid >> 2, q = tid & 3;
        const bf16_t* sp = P + (size_t)(t0 + j) * PLD + PC_SV + q * 128;
        float s = 0.f, s2 = 0.f;
#pragma unroll
        for (int i = 0; i < 16; ++i) { const u32x4 w = *(const u32x4*)(sp + 8 * i);
            const float f[8] = {bflo(w.x), bfhi(w.x), bflo(w.y), bfhi(w.y), bflo(w.z), bfhi(w.z), bflo(w.w), bfhi(w.w)};
#pragma unroll
            for (int e = 0; e < 8; ++e) { s += f[e]; s2 += f[e] * f[e]; } }
        s += __shfl_xor(s, 1); s += __shfl_xor(s, 2); s2 += __shfl_xor(s2, 1); s2 += __shfl_xor(s2, 2);
        const float mu = s * (1.f / 512.f); const float var = fmaxf(s2 * (1.f / 512.f) - mu * mu, 0.f);
        if (q == 0) { st[2 * j] = mu; st[2 * j + 1] = 1.f / sqrtf(var + EPS); }
    }
    {
        const int i = tid >> 2, jb = (tid & 3) * 32;
        const float* wp = A.in[I_SW] + (size_t)g * 16384 + (size_t)i * 128 + jb;
        const bf16_t* sup = P + (size_t)(t0 + i) * PLD + PC_SU + g * 128 + jb;
#pragma unroll
        for (int q = 0; q < 4; ++q) { const f32x4 a = *(const f32x4*)(wp + 8 * q), bq = *(const f32x4*)(wp + 8 * q + 4);
            const bool z = (i < 64) && (jb + 8 * q >= 64);
            u32x4 o; o.x = pk2(a.x, a.y); o.y = pk2(a.z, a.w); o.z = pk2(bq.x, bq.y); o.w = pk2(bq.z, bq.w);
            if (z) o = (u32x4){0u, 0u, 0u, 0u};
            *(LAS u32x4*)(wA + i * 136 + jb + 8 * q) = o;
            *(LAS u32x4*)(suS + i * 136 + jb + 8 * q) = *(const u32x4*)(sup + 8 * q); }
    }
    const int cch = tid & 127, seg = tid >> 7;
    bf16_t xr[32];
    { const bf16_t* sp = P + (size_t)(t0 + 32 * seg) * PLD + PC_SV + g * 128 + cch;
#pragma unroll
      for (int i = 0; i < 32; ++i) xr[i] = sp[(size_t)i * PLD]; }
    const float lg = A.in[I_SLNG][g * 128 + cch], lb = A.in[I_SLNB][g * 128 + cch];
    __syncthreads();
    {
        unsigned ow[16];
#pragma unroll
        for (int i = 0; i < 16; ++i) { const int j = 32 * seg + 2 * i; const f32x4 ms = *(const LAS f32x4*)(st + 2 * j);
            ow[i] = pk2((bf1(xr[2 * i]) - ms.x) * ms.y * lg + lb, (bf1(xr[2 * i + 1]) - ms.z) * ms.w * lg + lb); }
#pragma unroll
        for (int q = 0; q < 4; ++q) *(LAS u32x4*)(vnT + cch * 136 + 32 * seg + 8 * q) = (u32x4){ow[4 * q], ow[4 * q + 1], ow[4 * q + 2], ow[4 * q + 3]};
    }
    __syncthreads();
    {
        const int w = F.wave, l = F.lane, fr = l & 15, fq = l >> 4;
        f32x4 acc[8];
#pragma unroll
        for (int n = 0; n < 8; ++n) acc[n] = (f32x4){0.f, 0.f, 0.f, 0.f};
#pragma unroll
        for (int ks = 0; ks < 4; ++ks) {
            const bf16x8 a = *(const LAS bf16x8*)(wA + (16 * w + fr) * 136 + 32 * ks + 8 * fq);
#pragma unroll
            for (int n = 0; n < 8; ++n) { const bf16x8 bb = *(const LAS bf16x8*)(vnT + (16 * n + fr) * 136 + 32 * ks + 8 * fq);
                acc[n] = __builtin_amdgcn_mfma_f32_16x16x32_bf16(a, bb, acc[n], 0, 0, 0); }
        }
#pragma unroll
        for (int jj = 0; jj < 4; ++jj) { const int i = 16 * w + 4 * fq + jj; const float bias = A.in[I_SB][g * 128 + i];
            LAS bf16_t* rp = suS + i * 136 + fr;
#pragma unroll
            for (int n = 0; n < 8; ++n) { const float su = bf1(rp[16 * n]); rp[16 * n] = (bf16_t)f2bf(su * (acc[n][jj] + bias)); } }
    }
    __syncthreads();
    {
        const int i = tid >> 2, jb = (tid & 3) * 32;
        bf16_t* yp = DRY ? (bf16_t*)A.out + (size_t)(t0 + i) * 512 + g * 128 + jb : P + (size_t)(t0 + i) * PLD + PC_SU + g * 128 + jb;
#pragma unroll
        for (int q = 0; q < 4; ++q) *(u32x4*)(yp + 8 * q) = *(const LAS u32x4*)(suS + i * 136 + jb + 8 * q);
    }
}

template <bool DRY>
__device__ __forceinline__ void gla_scan(const Frame& F, const Args& A) {
    bf16_t* ST = (bf16_t*)(A.ws + WS_N1); bf16_t* STO = DRY ? (bf16_t*)A.out : ST; const float* DEC = (const float*)(A.ws + WS_DEC);
    for (int gi = F.bid * 512 + F.tid; gi < 131072; gi += F.G * 512) {
        const int k4 = gi & 31, vv = (gi >> 5) & 127, h = (gi >> 12) & 3, b = gi >> 14;
        float s0 = 0.f, s1 = 0.f, s2 = 0.f, s3 = 0.f;
        u32x2 wa[8], wb[8]; f32x4 da[8], db[8];
#define SCAN_LOAD(W, Dd, c0) do { _Pragma("unroll") for (int i_ = 0; i_ < 8; ++i_) { const size_t u_ = (size_t)((b * 64 + (c0) + i_) * 4 + h); \
            W[i_] = *(const u32x2*)(ST + u_ * 16384 + (size_t)vv * 128 + k4 * 4); Dd[i_] = *(const f32x4*)(DEC + u_ * 128 + k4 * 4); } } while (0)
#define SCAN_STEP(W, Dd, c0) do { _Pragma("unroll") for (int i_ = 0; i_ < 8; ++i_) { const size_t u_ = (size_t)((b * 64 + (c0) + i_) * 4 + h); \
            s0 = Dd[i_].x * s0 + bflo(W[i_].x); s1 = Dd[i_].y * s1 + bfhi(W[i_].x); s2 = Dd[i_].z * s2 + bflo(W[i_].y); s3 = Dd[i_].w * s3 + bfhi(W[i_].y); \
            u32x2 o_; o_.x = pk2(s0, s1); o_.y = pk2(s2, s3); *(u32x2*)(STO + u_ * 16384 + (size_t)vv * 128 + k4 * 4) = o_; } } while (0)
        SCAN_LOAD(wa, da, 0);
#pragma unroll
        for (int c0 = 0; c0 < 64; c0 += 16) {
            SCAN_LOAD(wb, db, c0 + 8);
            SCAN_STEP(wa, da, c0);
            if (c0 + 16 < 64) SCAN_LOAD(wa, da, c0 + 16);
            SCAN_STEP(wb, db, c0 + 8);
        }
#undef SCAN_LOAD
#undef SCAN_STEP
    }
}

template <bool DRY>
__device__ __forceinline__ void gla_out_phase(const Frame& F, const Args& A) {
    bf16_t* P = (bf16_t*)(A.ws + WS_P);
    LAS bf16_t* qA = (LAS bf16_t*)F.lds;
    LAS bf16_t* sB = (LAS bf16_t*)(F.lds + 17408);
    LAS float* oF = (LAS float*)(F.lds + 52224);
    const int tid = F.tid, s = tid >> 3, cb = (tid & 7) * 16, vv = tid >> 2, kb = (tid & 3) * 32;
    u32x4 nq0, nq1, ns0, ns1, ns2, ns3, nr0, nr1;
#define GO_LOAD(unit) do { const int h_ = (unit) & 3, c_ = ((unit) >> 2) & 63, b_ = (unit) >> 8; const int t0_ = b_ * SEQ + c_ * 64; \
        const bf16_t* qp_ = P + (size_t)(t0_ + s) * PLD + PC_Q + h_ * 128 + cb; nq0 = *(const u32x4*)qp_; nq1 = *(const u32x4*)(qp_ + 8); \
        const bf16_t* sp_ = (const bf16_t*)(A.ws + WS_N1) + (size_t)(unit) * 16384 + (size_t)vv * 128 + kb; ns0 = *(const u32x4*)sp_; ns1 = *(const u32x4*)(sp_ + 8); ns2 = *(const u32x4*)(sp_ + 16); ns3 = *(const u32x4*)(sp_ + 24); \
        const bf16_t* rp_ = P + (size_t)(t0_ + s) * PLD + PC_R + h_ * 128 + cb; nr0 = *(const u32x4*)rp_; nr1 = *(const u32x4*)(rp_ + 8); } while (0)
    int unit = F.bid;
    if (unit < 2048) GO_LOAD(unit);
    for (; unit < 2048; unit += F.G) {
        const int h = unit & 3, c = (unit >> 2) & 63, b = unit >> 8;
        const int t0 = b * SEQ + c * 64;
        __syncthreads();
        *(LAS u32x4*)(qA + s * 136 + cb) = nq0; *(LAS u32x4*)(qA + s * 136 + cb + 8) = nq1;
        *(LAS u32x4*)(sB + vv * 136 + kb) = ns0; *(LAS u32x4*)(sB + vv * 136 + kb + 8) = ns1; *(LAS u32x4*)(sB + vv * 136 + kb + 16) = ns2; *(LAS u32x4*)(sB + vv * 136 + kb + 24) = ns3;
        const u32x4 r0 = nr0, r1 = nr1;
        if (unit + F.G < 2048) GO_LOAD(unit + F.G);
        __syncthreads();
        {
            const int w = F.wave, l = F.lane, fr = l & 15, fq = l >> 4, m = w & 3, nh = w >> 2;
            f32x4 acc[4];
#pragma unroll
            for (int n = 0; n < 4; ++n) acc[n] = (f32x4){0.f, 0.f, 0.f, 0.f};
#pragma unroll
            for (int ks = 0; ks < 4; ++ks) {
                const bf16x8 a = *(const LAS bf16x8*)(qA + (16 * m + fr) * 136 + 32 * ks + 8 * fq);
#pragma unroll
                for (int n = 0; n < 4; ++n) { const bf16x8 bb = *(const LAS bf16x8*)(sB + (16 * (4 * nh + n) + fr) * 136 + 32 * ks + 8 * fq);
                    acc[n] = __builtin_amdgcn_mfma_f32_16x16x32_bf16(a, bb, acc[n], 0, 0, 0); }
            }
            const float scale = 0.08838834764831845f;
#pragma unroll
            for (int n = 0; n < 4; ++n)
#pragma unroll
                for (int jj = 0; jj < 4; ++jj) oF[(16 * m + 4 * fq + jj) * 132 + 16 * (4 * nh + n) + fr] = acc[n][jj] * scale;
        }
        __syncthreads();
        {
            float o[16]; float ss = 0.f;
#pragma unroll
            for (int i = 0; i < 16; ++i) { o[i] = oF[s * 132 + cb + i]; ss += o[i] * o[i]; }
            ss += __shfl_xor(ss, 1); ss += __shfl_xor(ss, 2); ss += __shfl_xor(ss, 4);
            const float rstd = 1.f / sqrtf(ss * (1.f / 128.f) + EPS);
            const unsigned rw[8] = {r0.x, r0.y, r0.z, r0.w, r1.x, r1.y, r1.z, r1.w};
            const float* gg = A.in[I_GLAG] + h * 128 + cb;
            unsigned ow[8];
#pragma unroll
            for (int i = 0; i < 8; ++i) { const float y0 = o[2 * i] * rstd * gg[2 * i] * siluf_(bflo(rw[i])), y1 = o[2 * i + 1] * rstd * gg[2 * i + 1] * siluf_(bfhi(rw[i])); ow[i] = pk2(y0, y1); }
            bf16_t* yp = DRY ? (bf16_t*)A.out + (size_t)(t0 + s) * 512 + h * 128 + cb : P + (size_t)(t0 + s) * PLD + PC_Q + h * 128 + cb;
            *(u32x4*)yp = (u32x4){ow[0], ow[1], ow[2], ow[3]}; *(u32x4*)(yp + 8) = (u32x4){ow[4], ow[5], ow[6], ow[7]};
        }
    }
#undef GO_LOAD
}

__device__ __forceinline__ unsigned ordkey(float v) { const unsigned u = __builtin_bit_cast(unsigned, v); return u ^ ((unsigned)((int)u >> 31) | 0x80000000u); }
__device__ __forceinline__ float unord(unsigned k) { const unsigned u = (k & 0x80000000u) ? (k & 0x7fffffffu) : ~k; return __builtin_bit_cast(float, u); }
#define INS16(r, xin) do { unsigned _x = (xin); _Pragma("unroll") for (int _i = 0; _i < 16; ++_i) { const unsigned _h = max((r)[_i], _x); _x = min((r)[_i], _x); (r)[_i] = _h; } } while (0)

#define CE(a, b) do { const unsigned _h = max((a), (b)), _l = min((a), (b)); (a) = _h; (b) = _l; } while (0)
#define SORT16(v) do { CE(v[0], v[1]); CE(v[2], v[3]); CE(v[0], v[2]); CE(v[1], v[3]); CE(v[1], v[2]); CE(v[4], v[5]); CE(v[6], v[7]); CE(v[4], v[6]); CE(v[5], v[7]); CE(v[5], v[6]); CE(v[0], v[4]); CE(v[2], v[6]); CE(v[2], v[4]); CE(v[1], v[5]); CE(v[3], v[7]); CE(v[3], v[5]); CE(v[1], v[2]); CE(v[3], v[4]); CE(v[5], v[6]); CE(v[8], v[9]); CE(v[10], v[11]); CE(v[8], v[10]); CE(v[9], v[11]); CE(v[9], v[10]); CE(v[12], v[13]); CE(v[14], v[15]); CE(v[12], v[14]); CE(v[13], v[15]); CE(v[13], v[14]); CE(v[8], v[12]); CE(v[10], v[14]); CE(v[10], v[12]); CE(v[9], v[13]); CE(v[11], v[15]); CE(v[11], v[13]); CE(v[9], v[10]); CE(v[11], v[12]); CE(v[13], v[14]); CE(v[0], v[8]); CE(v[4], v[12]); CE(v[4], v[8]); CE(v[2], v[10]); CE(v[6], v[14]); CE(v[6], v[10]); CE(v[2], v[4]); CE(v[6], v[8]); CE(v[10], v[12]); CE(v[1], v[9]); CE(v[5], v[13]); CE(v[5], v[9]); CE(v[3], v[11]); CE(v[7], v[15]); CE(v[7], v[11]); CE(v[3], v[5]); CE(v[7], v[9]); CE(v[11], v[13]); CE(v[1], v[2]); CE(v[3], v[4]); CE(v[5], v[6]); CE(v[7], v[8]); CE(v[9], v[10]); CE(v[11], v[12]); CE(v[13], v[14]); } while (0)
#define MERGE16(T, S) do { _Pragma("unroll") for (int _i = 0; _i < 16; ++_i) (T)[_i] = max((T)[_i], (S)[15 - _i]); \
    _Pragma("unroll") for (int _d = 8; _d >= 1; _d >>= 1) { _Pragma("unroll") for (int _i = 0; _i < 16; ++_i) if ((_i & _d) == 0) CE((T)[_i], (T)[_i + _d]); } } while (0)
__device__ __forceinline__ void peer_topk(const Frame& F, const Args& A) {
    const bf16_t* SC = (const bf16_t*)(A.ws + WS_P + P_SC);
    int* IDX = (int*)(A.ws + WS_P + P_IDX); float* GATE = (float*)(A.ws + WS_P + P_GATE);
    const int gw = F.bid * NWAVES + F.wave, NGW = F.G * NWAVES;
    for (int it = gw; it < 512 * 8; it += NGW) {
        const int h = it & 7, tb = it >> 3; const int tok = tb * 64 + F.lane;
        unsigned r1[16], r2[16], rc[16];
        const bf16_t* p1 = SC + ((size_t)(tok >> 4) * 256 + h * 32) * 128 + (tok & 15) * 8; const bf16_t* p2 = p1 + 16 * 128;
        {
            float raw[128]; unsigned sg[16];
#pragma unroll
            for (int jq = 0; jq < 16; ++jq) { const u32x4 t4 = *(const u32x4*)(p1 + jq * 128);
#pragma unroll
                for (int c = 0; c < 4; ++c) { raw[8 * jq + 2 * c] = bflo(t4[c]); raw[8 * jq + 2 * c + 1] = bfhi(t4[c]); } }
#pragma unroll
            for (int j = 0; j < 16; ++j) r1[j] = (ordkey(raw[j]) & ~127u) | (unsigned)(127 - j);
            SORT16(r1);
#pragma unroll
            for (int gq = 1; gq < 8; ++gq) {
#pragma unroll
                for (int j = 0; j < 16; ++j) sg[j] = (ordkey(raw[16 * gq + j]) & ~127u) | (unsigned)(127 - (16 * gq + j));
                SORT16(sg); MERGE16(r1, sg); }
#pragma unroll
            for (int jq = 0; jq < 16; ++jq) { const u32x4 t4 = *(const u32x4*)(p2 + jq * 128);
#pragma unroll
                for (int c = 0; c < 4; ++c) { raw[8 * jq + 2 * c] = bflo(t4[c]); raw[8 * jq + 2 * c + 1] = bfhi(t4[c]); } }
#pragma unroll
            for (int j = 0; j < 16; ++j) r2[j] = (ordkey(raw[j]) & ~127u) | (unsigned)(127 - j);
            SORT16(r2);
#pragma unroll
            for (int gq = 1; gq < 8; ++gq) {
#pragma unroll
                for (int j = 0; j < 16; ++j) sg[j] = (ordkey(raw[16 * gq + j]) & ~127u) | (unsigned)(127 - (16 * gq + j));
                SORT16(sg); MERGE16(r2, sg); }
        }
        float v1[16], v2[16];
#pragma unroll
        for (int i = 0; i < 16; ++i) { v1[i] = unord((r1[i] & ~127u) | 64u); v2[i] = unord((r2[i] & ~127u) | 64u); }
        {
            unsigned cg[4][16]; int cn = 0;
#pragma unroll
            for (int a = 0; a < 16; ++a)
#pragma unroll
                for (int bq = 0; bq < 16; ++bq) if ((a + 1) * (bq + 1) <= 16) { cg[cn >> 4][cn & 15] = (ordkey(v1[a] + v2[bq]) & ~255u) | (unsigned)(a * 16 + bq); ++cn; }
#pragma unroll
            for (int z = 50; z < 64; ++z) cg[z >> 4][z & 15] = 0u;
            SORT16(cg[0]); SORT16(cg[1]); SORT16(cg[2]); SORT16(cg[3]);
            MERGE16(cg[0], cg[1]); MERGE16(cg[0], cg[2]); MERGE16(cg[0], cg[3]);
#pragma unroll
            for (int i = 0; i < 16; ++i) rc[i] = cg[0][i];
        }
        float val[16]; int ex[16];
        {
            LAS unsigned* t1 = (LAS unsigned*)(F.lds + F.wave * 8704) + F.lane * 17; LAS unsigned* t2 = t1 + 64 * 17;
#pragma unroll
            for (int i = 0; i < 16; ++i) { t1[i] = r1[i]; t2[i] = r2[i]; }
            LDS_WAIT(); asm volatile("" ::: "memory");
#pragma unroll
            for (int w = 0; w < 16; ++w) {
                const int a = (rc[w] >> 4) & 15, bq = rc[w] & 15;
                const unsigned k1 = t1[a], k2 = t2[bq];
                val[w] = unord((k1 & ~127u) | 64u) + unord((k2 & ~127u) | 64u);
                ex[w] = (127 - (int)(k1 & 127u)) * 128 + (127 - (int)(k2 & 127u));
            }
            LDS_WAIT(); asm volatile("" ::: "memory");
        }
        float mx = val[0];
#pragma unroll
        for (int w = 1; w < 16; ++w) mx = fmaxf(mx, val[w]);
        float sum = 0.f;
#pragma unroll
        for (int w = 0; w < 16; ++w) { val[w] = __expf(val[w] - mx); sum += val[w]; }
        const float inv = 1.f / sum;
        int* ip = IDX + (size_t)tok * 128 + h * 16; float* gp = GATE + (size_t)tok * 128 + h * 16;
#pragma unroll
        for (int q = 0; q < 4; ++q) { *(int4*)(ip + 4 * q) = make_int4(ex[4 * q], ex[4 * q + 1], ex[4 * q + 2], ex[4 * q + 3]);
            *(f32x4*)(gp + 4 * q) = (f32x4){val[4 * q] * inv, val[4 * q + 1] * inv, val[4 * q + 2] * inv, val[4 * q + 3] * inv}; }
    }
}

#define DPP_ADD(v, ctrl) ((v) + __builtin_bit_cast(float, __builtin_amdgcn_mov_dpp(__builtin_bit_cast(int, (v)), (ctrl), 0xf, 0xf, true)))
__device__ __forceinline__ void fp8x16_to_f32x2(const u32x4 r, f32x2* f) {
#pragma unroll
    for (int q = 0; q < 4; ++q) { f[2 * q] = __builtin_amdgcn_cvt_pk_f32_fp8((int)r[q], false); f[2 * q + 1] = __builtin_amdgcn_cvt_pk_f32_fp8((int)r[q], true); }
}
__device__ __forceinline__ void fp8x16_to_f32(const u32x4 r, float* f) {
#pragma unroll
    for (int q = 0; q < 4; ++q) { const f32x2 lo = __builtin_amdgcn_cvt_pk_f32_fp8((int)r[q], false), hi = __builtin_amdgcn_cvt_pk_f32_fp8((int)r[q], true);
        f[4 * q] = lo.x; f[4 * q + 1] = lo.y; f[4 * q + 2] = hi.x; f[4 * q + 3] = hi.y; }
}
__device__ __forceinline__ long lo64(u32x4 v) { return (long)(((unsigned long)v.y << 32) | (unsigned long)v.x); }
__device__ __forceinline__ long hi64(u32x4 v) { return (long)(((unsigned long)v.w << 32) | (unsigned long)v.z); }
template <int MODE>
__device__ __forceinline__ void peer_u_phase(const Frame& F, const Args& A) {
    const unsigned char* X8 = A.ws + WS_P + P_X8;
    const unsigned char* U8 = A.ws + WS_U8; const float* SU = (const float*)(A.ws + WS_SU); const float* SV = (const float*)(A.ws + WS_SV);
    const int* IDX = (const int*)(A.ws + WS_P + P_IDX); const float* GATE = (const float*)(A.ws + WS_P + P_GATE); float* AK = (float*)(MODE == 0 ? A.ws + WS_AK : A.ws + WS_P + P_SC);
    const int g = F.bid & 7, nmem = F.G >> 3, l = F.lane, step = nmem * NWAVES;
    const int loff = 64 * (l & 15) + 16 * (l >> 4);
    const bool dg = ((l & 15) >> 2) == (l >> 4); const int dr = l & 3;
    const float dw0 = (dg && dr == 0) ? 1.f : 0.f, dw1 = (dg && dr == 1) ? 1.f : 0.f, dw2 = (dg && dr == 2) ? 1.f : 0.f, dw3 = (dg && dr == 3) ? 1.f : 0.f;
    LAS int* le = (LAS int*)(F.lds + F.wave * 2048); LAS int* lk = le + 256;
    const bool b5 = (l & 32) != 0, b4 = (l & 16) != 0, b3 = (l & 8) != 0;
    int tok = 2 * ((F.bid >> 3) * NWAVES + F.wave);
    u32x4 nxA, nxB; int neA0, neA1, neB0, neB1; float ngA0, ngA1, ngB0, ngB1;
#define U_PREFETCH(t) do { const size_t _tA = (size_t)(t), _tB = (size_t)(t) + 1; if (MODE == 4) { nxA = (u32x4){(unsigned)_tA, 1u, 2u, 3u}; nxB = nxA; neA0 = (int)((_tA * 37 + l * 11) & 16383); neA1 = (int)((_tA * 53 + l * 7) & 16383); neB0 = (int)((_tB * 37 + l * 13) & 16383); neB1 = (int)((_tB * 29 + l * 3) & 16383); ngA0 = ngA1 = ngB0 = ngB1 = 0.01f; break; } nxA = *(const u32x4*)(X8 + _tA * 1024 + loff); nxB = *(const u32x4*)(X8 + _tB * 1024 + loff); \
        neA0 = IDX[_tA * 128 + l]; neA1 = IDX[_tA * 128 + 64 + l]; neB0 = IDX[_tB * 128 + l]; neB1 = IDX[_tB * 128 + 64 + l]; \
        ngA0 = GATE[_tA * 128 + l]; ngA1 = GATE[_tA * 128 + 64 + l]; ngB0 = GATE[_tB * 128 + l]; ngB1 = GATE[_tB * 128 + 64 + l]; } while (0)
    if (tok + 1 < T_TOK) U_PREFETCH(tok);
    for (; tok + 1 < T_TOK; tok += 2 * step) {
        const int tokA = tok, tokB = tok + 1;
        const u32x4 xA = nxA, xB = nxB;
        const int eA0 = neA0, eA1 = neA1, eB0 = neB0, eB1 = neB1; const float gA0 = ngA0, gA1 = ngA1, gB0 = ngB0, gB1 = ngB1;
        bool pf_done = false;
        const bool oA0 = (eA0 & 7) == g, oA1 = (eA1 & 7) == g, oB0 = (eB0 & 7) == g, oB1 = (eB1 & 7) == g;
        const unsigned long long mA0 = __ballot(oA0), mA1 = __ballot(oA1), mB0 = __ballot(oB0), mB1 = __ballot(oB1);
        const int c0 = __popcll(mA0), c1 = c0 + __popcll(mA1), c2 = c1 + __popcll(mB0), n = c2 + __popcll(mB1);
#define MBC(m) __builtin_amdgcn_mbcnt_hi((unsigned)((m) >> 32), __builtin_amdgcn_mbcnt_lo((unsigned)(m), 0u))
        if (oA0) { const int p = MBC(mA0); le[p] = (eA0 << 8) | l; lk[p] = __builtin_bit_cast(int, gA0); }
        if (oA1) { const int p = c0 + MBC(mA1); le[p] = (eA1 << 8) | (64 + l); lk[p] = __builtin_bit_cast(int, gA1); }
        if (oB0) { const int p = c1 + MBC(mB0); le[p] = (eB0 << 8) | 128 | l; lk[p] = __builtin_bit_cast(int, gB0); }
        if (oB1) { const int p = c2 + MBC(mB1); le[p] = (eB1 << 8) | 128 | (64 + l); lk[p] = __builtin_bit_cast(int, gB1); }
#undef MBC
        LDS_WAIT(); asm volatile("" ::: "memory");
        for (int cb = 0; cb < n || cb == 0; cb += 64) {
        const int nc = min(n, cb + 64);
        const bool fv = (cb + l) < nc;
        const int ent = fv ? le[cb + l] : 0; const float gt = fv ? __builtin_bit_cast(float, lk[cb + l]) : 0.f; float tot = 0.f;
        const float su = SU[ent >> 8], sv = SV[ent >> 8];
        const unsigned long long radr = (unsigned long long)(U8 + (size_t)(((ent >> 8) & 7) * 2048 + (((ent >> 8) >> 3) & (MODE == 2 ? 255 : 2047))) * 1024);
        const int ralo = (int)(unsigned)radr, rahi = (int)(unsigned)(radr >> 32);
        for (int i = cb; i < nc; i += 16) {
            u32x4 row[2][8];
#pragma unroll
            for (int b = 0; b < 2; ++b) if (i + 8 * b < nc) {
#pragma unroll
                for (int j = 0; j < 8; ++j) { const int ln = min(i + 8 * b + j, nc - 1) - cb;
                    const unsigned lo = (unsigned)__builtin_amdgcn_readlane(ralo, ln), hi = (unsigned)__builtin_amdgcn_readlane(rahi, ln);
                    const GAS unsigned char* rp = (const GAS unsigned char*)(((unsigned long long)hi << 32) | lo);
                    row[b][j] = *(const GAS u32x4*)(rp + (unsigned)loff); } }
            if (!pf_done) { pf_done = true; if (tok + 2 * step + 1 < T_TOK) U_PREFETCH(tok + 2 * step); }
#pragma unroll
            for (int b = 0; b < 2; ++b) if (i + 8 * b < nc) {
                float p[8];
                f32x4 accj[8];
                const int base0 = i + 8 * b;
                if (base0 + 8 <= c1) {
#pragma unroll
                    for (int j = 0; j < 8; ++j) accj[j] = __builtin_amdgcn_mfma_f32_16x16x32_fp8_fp8(lo64(row[b][j]), lo64(xA), (f32x4){0.f, 0.f, 0.f, 0.f}, 0, 0, 0);
#pragma unroll
                    for (int j = 0; j < 8; ++j) accj[j] = __builtin_amdgcn_mfma_f32_16x16x32_fp8_fp8(hi64(row[b][j]), hi64(xA), accj[j], 0, 0, 0);
                } else if (base0 >= c1) {
#pragma unroll
                    for (int j = 0; j < 8; ++j) accj[j] = __builtin_amdgcn_mfma_f32_16x16x32_fp8_fp8(lo64(row[b][j]), lo64(xB), (f32x4){0.f, 0.f, 0.f, 0.f}, 0, 0, 0);
#pragma unroll
                    for (int j = 0; j < 8; ++j) accj[j] = __builtin_amdgcn_mfma_f32_16x16x32_fp8_fp8(hi64(row[b][j]), hi64(xB), accj[j], 0, 0, 0);
                } else {
#pragma unroll
                    for (int j = 0; j < 8; ++j) { const u32x4 xs = (base0 + j >= c1) ? xB : xA; accj[j] = __builtin_amdgcn_mfma_f32_16x16x32_fp8_fp8(lo64(row[b][j]), lo64(xs), (f32x4){0.f, 0.f, 0.f, 0.f}, 0, 0, 0);
                        accj[j] = __builtin_amdgcn_mfma_f32_16x16x32_fp8_fp8(hi64(row[b][j]), hi64(xs), accj[j], 0, 0, 0); }
                }
#pragma unroll
                for (int j = 0; j < 8; ++j) p[j] = __builtin_fmaf(accj[j][3], dw3, __builtin_fmaf(accj[j][2], dw2, __builtin_fmaf(accj[j][1], dw1, accj[j][0] * dw0)));
                float q4[4], q2[2], q1;
#pragma unroll
                for (int j = 0; j < 4; ++j) { const float keep = b5 ? p[4 + j] : p[j], send = b5 ? p[j] : p[4 + j]; q4[j] = keep + __shfl_xor(send, 32); }
#pragma unroll
                for (int j = 0; j < 2; ++j) { const float keep = b4 ? q4[2 + j] : q4[j], send = b4 ? q4[j] : q4[2 + j]; q2[j] = keep + __shfl_xor(send, 16); }
                { const float keep = b3 ? q2[1] : q2[0], send = b3 ? q2[0] : q2[1]; q1 = keep + __shfl_xor(send, 8); }
                q1 = DPP_ADD(q1, 0xB1); q1 = DPP_ADD(q1, 0x4E); q1 = DPP_ADD(q1, 0x141);
                const float t = __builtin_bit_cast(float, __builtin_amdgcn_ds_bpermute((l & 7) * 32, __builtin_bit_cast(int, q1)));
                const int base = i + 8 * b;
                if ((l >> 3) == ((base - cb) >> 3)) tot = t;
            }
        }
        if (!pf_done) { if (tok + 2 * step + 1 < T_TOK) U_PREFETCH(tok + 2 * step); }
        if (fv) { const int tk = (ent & 128) ? tokB : tokA; AK[(size_t)tk * 128 + (ent & 127)] = gelu_tanh(tot * su * (1.f / 16.f)) * gt * sv; }
        if (n == 0) break;
        }
        LDS_WAIT(); asm volatile("" ::: "memory");
    }
#undef U_PREFETCH
}
template <int MODE>
__device__ __forceinline__ void peer_u_phase1(const Frame& F, const Args& A) {
    const unsigned char* X8 = A.ws + WS_P + P_X8;
    const unsigned char* U8 = A.ws + WS_U8; const float* SU = (const float*)(A.ws + WS_SU); const float* SV = (const float*)(A.ws + WS_SV);
    const int* IDX = (const int*)(A.ws + WS_P + P_IDX); const float* GATE = (const float*)(A.ws + WS_P + P_GATE); float* AK = (float*)(MODE == 0 ? A.ws + WS_AK : A.ws + WS_P + P_SC);
    const int g = F.bid & (UNG - 1), nmem = F.G >> UNG_SH, l = F.lane, step = nmem * NWAVES;
    const int loff = 64 * (l & 15) + 16 * (l >> 4);
    const bool dg = ((l & 15) >> 2) == (l >> 4); const int dr = l & 3;
    const float dw0 = (dg && dr == 0) ? 1.f : 0.f, dw1 = (dg && dr == 1) ? 1.f : 0.f, dw2 = (dg && dr == 2) ? 1.f : 0.f, dw3 = (dg && dr == 3) ? 1.f : 0.f;
    LAS int* le = (LAS int*)(F.lds + F.wave * 2048); LAS int* lk = le + 256;
    const bool b5 = (l & 32) != 0, b4 = (l & 16) != 0, b3 = (l & 8) != 0;
    int tok = (F.bid >> UNG_SH) * NWAVES + F.wave;
    u32x4 nxA; int neA0, neA1; float ngA0, ngA1;
#define U1_PREFETCH(t) do { const size_t _tA = (size_t)(t); nxA = *(const u32x4*)(X8 + _tA * 1024 + loff); \
        neA0 = IDX[_tA * 128 + l]; neA1 = IDX[_tA * 128 + 64 + l]; ngA0 = GATE[_tA * 128 + l]; ngA1 = GATE[_tA * 128 + 64 + l]; } while (0)
    if (tok < T_TOK) U1_PREFETCH(tok);
    for (; tok < T_TOK; tok += step) {
        const u32x4 xA = nxA;
        const int eA0 = neA0, eA1 = neA1; const float gA0 = ngA0, gA1 = ngA1;
        bool pf_done = false;
        const bool oA0 = (eA0 & (UNG - 1)) == g, oA1 = (eA1 & (UNG - 1)) == g;
        const unsigned long long mA0 = __ballot(oA0), mA1 = __ballot(oA1);
        const int c0 = __popcll(mA0), n = c0 + __popcll(mA1);
#define MBC(m) __builtin_amdgcn_mbcnt_hi((unsigned)((m) >> 32), __builtin_amdgcn_mbcnt_lo((unsigned)(m), 0u))
        if (oA0) { const int p = MBC(mA0); le[p] = (eA0 << 8) | l; lk[p] = __builtin_bit_cast(int, gA0); }
        if (oA1) { const int p = c0 + MBC(mA1); le[p] = (eA1 << 8) | (64 + l); lk[p] = __builtin_bit_cast(int, gA1); }
#undef MBC
        LDS_WAIT(); asm volatile("" ::: "memory");
        for (int cb = 0; cb < n || cb == 0; cb += 64) {
        const int nc = min(n, cb + 64);
        const bool fv = (cb + l) < nc;
        const int ent = fv ? le[cb + l] : 0; const float gt = fv ? __builtin_bit_cast(float, lk[cb + l]) : 0.f; float tot = 0.f;
        const float su = SU[ent >> 8], sv = SV[ent >> 8];
        const unsigned long long radr = (unsigned long long)(U8 + (size_t)(((ent >> 8) & (UNG - 1)) * (NEXP / UNG) + ((ent >> 8) >> UNG_SH)) * 1024);
        const int ralo = (int)(unsigned)radr, rahi = (int)(unsigned)(radr >> 32);
        for (int i = cb; i < nc; i += 16) {
            u32x4 row[2][8];
#pragma unroll
            for (int b = 0; b < 2; ++b) if (i + 8 * b < nc) {
#pragma unroll
                for (int j = 0; j < 8; ++j) { const int ln = min(i + 8 * b + j, nc - 1) - cb;
                    const unsigned lo = (unsigned)__builtin_amdgcn_readlane(ralo, ln), hi = (unsigned)__builtin_amdgcn_readlane(rahi, ln);
                    const GAS unsigned char* rp = (const GAS unsigned char*)(((unsigned long long)hi << 32) | lo);
                    row[b][j] = *(const GAS u32x4*)(rp + (unsigned)loff); } }
            if (!pf_done) { pf_done = true; if (tok + step < T_TOK) U1_PREFETCH(tok + step); }
#pragma unroll
            for (int b = 0; b < 2; ++b) if (i + 8 * b < nc) {
                float p[8]; f32x4 accj[8];
#pragma unroll
                for (int j = 0; j < 8; ++j) accj[j] = __builtin_amdgcn_mfma_f32_16x16x32_fp8_fp8(lo64(row[b][j]), lo64(xA), (f32x4){0.f, 0.f, 0.f, 0.f}, 0, 0, 0);
#pragma unroll
                for (int j = 0; j < 8; ++j) accj[j] = __builtin_amdgcn_mfma_f32_16x16x32_fp8_fp8(hi64(row[b][j]), hi64(xA), accj[j], 0, 0, 0);
#pragma unroll
                for (int j = 0; j < 8; ++j) p[j] = __builtin_fmaf(accj[j][3], dw3, __builtin_fmaf(accj[j][2], dw2, __builtin_fmaf(accj[j][1], dw1, accj[j][0] * dw0)));
                float q4[4], q2[2], q1;
#pragma unroll
                for (int j = 0; j < 4; ++j) { const float keep = b5 ? p[4 + j] : p[j], send = b5 ? p[j] : p[4 + j]; q4[j] = keep + __shfl_xor(send, 32); }
#pragma unroll
                for (int j = 0; j < 2; ++j) { const float keep = b4 ? q4[2 + j] : q4[j], send = b4 ? q4[j] : q4[2 + j]; q2[j] = keep + __shfl_xor(send, 16); }
                { const float keep = b3 ? q2[1] : q2[0], send = b3 ? q2[0] : q2[1]; q1 = keep + __shfl_xor(send, 8); }
                q1 = DPP_ADD(q1, 0xB1); q1 = DPP_ADD(q1, 0x4E); q1 = DPP_ADD(q1, 0x141);
                const float t = __builtin_bit_cast(float, __builtin_amdgcn_ds_bpermute((l & 7) * 32, __builtin_bit_cast(int, q1)));
                const int base = i + 8 * b;
                if ((l >> 3) == ((base - cb) >> 3)) tot = t;
            }
        }
        if (!pf_done) { pf_done = true; if (tok + step < T_TOK) U1_PREFETCH(tok + step); }
        if (fv) AK[(size_t)tok * 128 + (ent & 127)] = gelu_tanh(tot * su * (1.f / 16.f)) * gt * sv;
        if (n == 0) break;
        }
        LDS_WAIT(); asm volatile("" ::: "memory");
    }
#undef U1_PREFETCH
}
template <int MODE>
__device__ __forceinline__ void peer_u4_phase(const Frame& F, const Args& A) {
    const unsigned char* X8 = A.ws + WS_P + P_X8;
    const float* SU = (const float*)(A.ws + WS_SU); const float* SV = (const float*)(A.ws + WS_SV);
    const int* IDX = (const int*)(A.ws + WS_P + P_IDX); const float* GATE = (const float*)(A.ws + WS_P + P_GATE); float* AK = (float*)(MODE == 0 ? A.ws + WS_AK : A.ws + WS_P + P_SC);
    const int g = F.bid & (UNG - 1), nmem = F.G >> UNG_SH, l = F.lane, step = nmem * NWAVES;
    const int m = l & 15, q = l >> 4;
    const GAS unsigned char* ub = (const GAS unsigned char*)(A.ws + WS_U8 + (size_t)g * (NEXP / UNG) * 512);
    const unsigned lconst = 16u * (unsigned)(4 * (m & 7) + q);
    const int xoff = 128 * (m & 7) + 16 * q;
    const bool dg = (m < 8) && ((m >> 2) == (q & 1)); const int dr = m & 3;
    const float dw0 = (dg && dr == 0) ? 1.f : 0.f, dw1 = (dg && dr == 1) ? 1.f : 0.f, dw2 = (dg && dr == 2) ? 1.f : 0.f, dw3 = (dg && dr == 3) ? 1.f : 0.f;
    const int rsel = 4 * (m >> 3);
    const int osrc = 4 * (32 * (l & 1) + 4 * ((l & 15) >> 1));
    const int sc1 = 0x7F7F7F7F;
    LAS int* le = (LAS int*)(F.lds + F.wave * 2048); LAS int* lk = le + 256;
    const bool b4 = (l & 16) != 0, b3 = (l & 8) != 0, b2 = (l & 4) != 0;
    int tok = (F.bid >> UNG_SH) * NWAVES + F.wave;
    u32x4 nx0, nx1; int ne0, ne1; float ng0, ng1;
#define U4_PREFETCH(t) do { const size_t _t = (size_t)(t); nx0 = *(const u32x4*)(X8 + _t * 1024 + xoff); nx1 = *(const u32x4*)(X8 + _t * 1024 + xoff + 64); \
        ne0 = IDX[_t * 128 + l]; ne1 = IDX[_t * 128 + 64 + l]; ng0 = GATE[_t * 128 + l]; ng1 = GATE[_t * 128 + 64 + l]; } while (0)
    if (tok < T_TOK) U4_PREFETCH(tok);
    for (; tok < T_TOK; tok += step) {
        const i32x8 xb = __builtin_shufflevector(__builtin_bit_cast(i32x4, nx0), __builtin_bit_cast(i32x4, nx1), 0, 1, 2, 3, 4, 5, 6, 7);
        const int e0 = ne0, e1 = ne1; const float g0 = ng0, g1 = ng1;
        bool pf_done = false;
        const bool o0 = (e0 & (UNG - 1)) == g, o1 = (e1 & (UNG - 1)) == g;
        const unsigned long long m0 = __ballot(o0), m1 = __ballot(o1);
        const int c0 = __popcll(m0), n = c0 + __popcll(m1);
#define MBC(mm) __builtin_amdgcn_mbcnt_hi((unsigned)((mm) >> 32), __builtin_amdgcn_mbcnt_lo((unsigned)(mm), 0u))
        if (o0) { const int p = MBC(m0); le[p] = (e0 << 8) | l; lk[p] = __builtin_bit_cast(int, g0); }
        if (o1) { const int p = c0 + MBC(m1); le[p] = (e1 << 8) | (64 + l); lk[p] = __builtin_bit_cast(int, g1); }
#undef MBC
        LDS_WAIT(); asm volatile("" ::: "memory");
        for (int cb = 0; cb < n || cb == 0; cb += 64) {
            const int nc = min(n, cb + 64);
            const bool fv = (cb + l) < nc;
            const int ent = fv ? le[cb + l] : 0; const float gt = fv ? __builtin_bit_cast(float, lk[cb + l]) : 0.f; float tot = 0.f;
            const float su = SU[ent >> 8], sv = SV[ent >> 8];
            const int roff = fv ? ((ent >> 8) >> UNG_SH) * 512 : 0;
            for (int i = cb; i < nc; i += 32) {
                u32x4 row[2][8];
#pragma unroll
                for (int b = 0; b < 2; ++b) if (i + 16 * b < nc) {
#pragma unroll
                    for (int j = 0; j < 8; ++j) { const int ro = __builtin_amdgcn_ds_bpermute(rsel + 4 * (i - cb + 16 * b + 2 * j), roff);
                        row[b][j] = *(const GAS u32x4*)(ub + ((unsigned)ro + lconst)); } }
                if (!pf_done) { pf_done = true; if (tok + step < T_TOK) U4_PREFETCH(tok + step); }
#pragma unroll
                for (int b = 0; b < 2; ++b) if (i + 16 * b < nc) {
                    float p[8];
#pragma unroll
                    for (int j = 0; j < 8; ++j) { const i32x4 r4 = __builtin_bit_cast(i32x4, row[b][j]);
                        const f32x4 d = __builtin_amdgcn_mfma_scale_f32_16x16x128_f8f6f4(__builtin_shufflevector(r4, r4, 0, 1, 2, 3, -1, -1, -1, -1), xb, (f32x4){0.f, 0.f, 0.f, 0.f}, 4, 0, 0, sc1, 0, sc1);
                        p[j] = __builtin_fmaf(d[3], dw3, __builtin_fmaf(d[2], dw2, __builtin_fmaf(d[1], dw1, d[0] * dw0))); }
                    float q4[4], q2[2], q1;
#pragma unroll
                    for (int j = 0; j < 4; ++j) { const float keep = b4 ? p[4 + j] : p[j], send = b4 ? p[j] : p[4 + j]; q4[j] = keep + __shfl_xor(send, 16); }
#pragma unroll
                    for (int j = 0; j < 2; ++j) { const float keep = b3 ? q4[2 + j] : q4[j], send = b3 ? q4[j] : q4[2 + j]; q2[j] = keep + __shfl_xor(send, 8); }
                    { const float keep = b2 ? q2[1] : q2[0], send = b2 ? q2[0] : q2[1]; q1 = keep + __shfl_xor(send, 4); }
                    q1 = DPP_ADD(q1, 0xB1); q1 = DPP_ADD(q1, 0x4E);
                    const float t = __builtin_bit_cast(float, __builtin_amdgcn_ds_bpermute(osrc, __builtin_bit_cast(int, q1)));
                    if ((l >> 4) == ((i - cb + 16 * b) >> 4)) tot = t;
                }
            }
            if (!pf_done) { pf_done = true; if (tok + step < T_TOK) U4_PREFETCH(tok + step); }
            if (fv) AK[(size_t)tok * 128 + (ent & 127)] = gelu_tanh(tot * su * (1.f / 16.f)) * gt * sv;
            if (n == 0) break;
        }
        LDS_WAIT(); asm volatile("" ::: "memory");
    }
#undef U4_PREFETCH
}
template <int MODE>
__device__ __forceinline__ void peer_u4_all(const Frame& F, const Args& A) {
    const unsigned char* X8 = A.ws + WS_P + P_X8;
    const float* SU = (const float*)(A.ws + WS_SU); const float* SV = (const float*)(A.ws + WS_SV);
    const int* IDX = (const int*)(A.ws + WS_P + P_IDX); const float* GATE = (const float*)(A.ws + WS_P + P_GATE); float* AK = (float*)(MODE == 0 ? A.ws + WS_AK : A.ws + WS_P + P_SC);
    const int l = F.lane, step = F.G * NWAVES;
    const int m = l & 15, q = l >> 4;
    const GAS unsigned char* ub = (const GAS unsigned char*)(A.ws + WS_U8);
    const unsigned lconst = 16u * (unsigned)(4 * (m & 7) + q);
    const int xoff = 128 * (m & 7) + 16 * q;
    const bool dg = (m < 8) && ((m >> 2) == (q & 1)); const int dr = m & 3;
    const float dw0 = (dg && dr == 0) ? 1.f : 0.f, dw1 = (dg && dr == 1) ? 1.f : 0.f, dw2 = (dg && dr == 2) ? 1.f : 0.f, dw3 = (dg && dr == 3) ? 1.f : 0.f;
    const int rsel = 4 * (m >> 3);
    const int osrc = 4 * (32 * (l & 1) + 4 * ((l & 15) >> 1));
    const int sc1 = 0x7F7F7F7F;
    const bool b4 = (l & 16) != 0, b3 = (l & 8) != 0, b2 = (l & 4) != 0;
    const int lhi = l >> 4;
    int tok = F.bid * NWAVES + F.wave;
    u32x4 nx0, nx1; int ne0, ne1; float ng0, ng1;
#define UA_PREFETCH(t) do { const size_t _t = (size_t)(t); nx0 = *(const u32x4*)(X8 + _t * 1024 + xoff); nx1 = *(const u32x4*)(X8 + _t * 1024 + xoff + 64); \
        ne0 = IDX[_t * 128 + l]; ne1 = IDX[_t * 128 + 64 + l]; ng0 = GATE[_t * 128 + l]; ng1 = GATE[_t * 128 + 64 + l]; } while (0)
#define UA_LOADS(R, ro_, h) do { _Pragma("unroll") for (int j_ = 0; j_ < 16; ++j_) { const int o_ = __builtin_amdgcn_ds_bpermute(rsel + 4 * (32 * (h) + 2 * j_), (ro_)); \
        R[j_] = *(const GAS u32x4*)(ub + ((unsigned)o_ + lconst)); } } while (0)
#define UA_COMPUTE(R, xb_, h, tot_) do { _Pragma("unroll") for (int b_ = 0; b_ < 2; ++b_) { float p_[8]; \
        _Pragma("unroll") for (int j_ = 0; j_ < 8; ++j_) { const i32x4 r4_ = __builtin_bit_cast(i32x4, R[8 * b_ + j_]); \
            const f32x4 d_ = __builtin_amdgcn_mfma_scale_f32_16x16x128_f8f6f4(__builtin_shufflevector(r4_, r4_, 0, 1, 2, 3, -1, -1, -1, -1), (xb_), (f32x4){0.f, 0.f, 0.f, 0.f}, 4, 0, 0, sc1, 0, sc1); \
            p_[j_] = __builtin_fmaf(d_[3], dw3, __builtin_fmaf(d_[2], dw2, __builtin_fmaf(d_[1], dw1, d_[0] * dw0))); } \
        float q4_[4], q2_[2], q1_; \
        _Pragma("unroll") for (int j_ = 0; j_ < 4; ++j_) { const float keep_ = b4 ? p_[4 + j_] : p_[j_], send_ = b4 ? p_[j_] : p_[4 + j_]; q4_[j_] = keep_ + __shfl_xor(send_, 16); } \
        _Pragma("unroll") for (int j_ = 0; j_ < 2; ++j_) { const float keep_ = b3 ? q4_[2 + j_] : q4_[j_], send_ = b3 ? q4_[j_] : q4_[2 + j_]; q2_[j_] = keep_ + __shfl_xor(send_, 8); } \
        { const float keep_ = b2 ? q2_[1] : q2_[0], send_ = b2 ? q2_[0] : q2_[1]; q1_ = keep_ + __shfl_xor(send_, 4); } \
        q1_ = DPP_ADD(q1_, 0xB1); q1_ = DPP_ADD(q1_, 0x4E); \
        const float t_ = __builtin_bit_cast(float, __builtin_amdgcn_ds_bpermute(osrc, __builtin_bit_cast(int, q1_))); \
        if (lhi == 2 * (h) + b_) (tot_) = t_; } } while (0)
    u32x4 RA[16], RB[16];
    if (tok < T_TOK) { UA_PREFETCH(tok); UA_LOADS(RA, ne0 * 512, 0); }
    for (; tok < T_TOK; tok += step) {
        const i32x8 xb = __builtin_shufflevector(__builtin_bit_cast(i32x4, nx0), __builtin_bit_cast(i32x4, nx1), 0, 1, 2, 3, 4, 5, 6, 7);
        const int e0 = ne0, e1 = ne1; const float g0 = ng0, g1 = ng1;
        const int ro0 = e0 * 512, ro1 = e1 * 512;
        const float su0 = SU[e0], sv0 = SV[e0], su1 = SU[e1], sv1 = SV[e1];
        const bool more = tok + step < T_TOK;
        float tot0 = 0.f, tot1 = 0.f;
        UA_LOADS(RB, ro0, 1);
        if (more) UA_PREFETCH(tok + step);
        UA_COMPUTE(RA, xb, 0, tot0);
        UA_LOADS(RA, ro1, 0);
        UA_COMPUTE(RB, xb, 1, tot0);
        UA_LOADS(RB, ro1, 1);
        UA_COMPUTE(RA, xb, 0, tot1);
        if (more) UA_LOADS(RA, ne0 * 512, 0);
        UA_COMPUTE(RB, xb, 1, tot1);
        AK[(size_t)tok * 128 + l] = gelu_tanh(tot0 * su0 * (1.f / 16.f)) * g0 * sv0;
        AK[(size_t)tok * 128 + 64 + l] = gelu_tanh(tot1 * su1 * (1.f / 16.f)) * g1 * sv1;
    }
#undef UA_PREFETCH
#undef UA_LOADS
#undef UA_COMPUTE
}
__device__ __forceinline__ float wave_max_nonneg(float v) {
    unsigned u = __builtin_bit_cast(unsigned, v);
    u = max(u, (unsigned)__builtin_amdgcn_mov_dpp((int)u, 0xB1, 0xf, 0xf, true));
    u = max(u, (unsigned)__builtin_amdgcn_mov_dpp((int)u, 0x4E, 0xf, 0xf, true));
    u = max(u, (unsigned)__builtin_amdgcn_mov_dpp((int)u, 0x141, 0xf, 0xf, true));
    u = max(u, (unsigned)__builtin_amdgcn_mov_dpp((int)u, 0x140, 0xf, 0xf, true));
    const unsigned a = (unsigned)__builtin_amdgcn_readlane((int)u, 0), b = (unsigned)__builtin_amdgcn_readlane((int)u, 16), c = (unsigned)__builtin_amdgcn_readlane((int)u, 32), d = (unsigned)__builtin_amdgcn_readlane((int)u, 48);
    return __builtin_bit_cast(float, max(max(a, b), max(c, d)));
}
template <int MODE>
__device__ __forceinline__ void peer_v_phase(const Frame& F, const Args& A) {
    const unsigned char* V8 = A.ws + WS_V8; const int* IDX = (const int*)(A.ws + WS_P + P_IDX); const float* AK = (const float*)(A.ws + WS_AK);
    float* out = MODE == 0 ? A.out : (float*)(A.ws + WS_P + P_SC);
    const int g = F.bid & 7, nmem = F.G >> 3, l = F.lane, sub = l & 7, rr = l >> 3, n16 = l & 15, q = l >> 4, step = nmem * NWAVES;
    const GAS unsigned char* vb = (const GAS unsigned char*)(V8 + (size_t)g * NEXP * 128);
    LAS unsigned long long* rep = (LAS unsigned long long*)(F.lds + F.wave * 2048);
    const unsigned long long bm = 0xFFull << (8 * (n16 & 7));
    const int repi = 2 * q + (n16 >> 3);
    const bool vl = (n16 < 8) && (q < 2);
    LAS float* stg = (LAS float*)(F.lds + 16384 + F.wave * 512);
    int tok = 2 * ((F.bid >> 3) * NWAVES + F.wave);
    int ne[4]; float na[4];
#define V_PREFETCH(t) do { const size_t _a = (size_t)(t) * 128, _b = ((size_t)(t) + 1) * 128; ne[0] = IDX[_a + l]; ne[1] = IDX[_a + 64 + l]; ne[2] = IDX[_b + l]; ne[3] = IDX[_b + 64 + l]; \
        na[0] = AK[_a + l]; na[1] = AK[_a + 64 + l]; na[2] = AK[_b + l]; na[3] = AK[_b + 64 + l]; } while (0)
    if (tok + 1 < T_TOK) V_PREFETCH(tok);
    for (; tok + 1 < T_TOK; tok += 2 * step) {
        const int e0 = ne[0], e1 = ne[1], e2 = ne[2], e3 = ne[3]; const float a0 = na[0], a1 = na[1], a2 = na[2], a3 = na[3];
        u32x4 rowA[16], rowB[16];
#pragma unroll
        for (int i = 0; i < 16; ++i) { const int src = (8 * (i & 7) + rr) * 4;
            const int ea = __builtin_amdgcn_ds_bpermute(src, i < 8 ? e0 : e1), eb = __builtin_amdgcn_ds_bpermute(src, i < 8 ? e2 : e3);
            rowA[i] = *(const GAS u32x4*)(vb + ((unsigned)ea * 128u + 16u * (unsigned)sub)); rowB[i] = *(const GAS u32x4*)(vb + ((unsigned)eb * 128u + 16u * (unsigned)sub)); }
        f32x4 HA = {0.f, 0.f, 0.f, 0.f}, HB = {0.f, 0.f, 0.f, 0.f};
        if (l < 32) { const float* hpa = out + (size_t)tok * D + g * 128 + 4 * l; HA = *(const f32x4*)hpa; HB = *(const f32x4*)(hpa + D); }
        if (tok + 2 * step + 1 < T_TOK) V_PREFETCH(tok + 2 * step);
        const float amA = wave_max_nonneg(fmaxf(fabsf(a0), fabsf(a1))), amB = wave_max_nonneg(fmaxf(fabsf(a2), fabsf(a3)));
        const float scA = amA > 0.f ? 224.f * __builtin_amdgcn_rcpf(amA) : 0.f, invA = amA * (1.f / 224.f), scB = amB > 0.f ? 224.f * __builtin_amdgcn_rcpf(amB) : 0.f, invB = amB * (1.f / 224.f);
        { const unsigned wA = (unsigned)__builtin_amdgcn_cvt_pk_fp8_f32(a0 * scA, a1 * scA, 0, false), wB = (unsigned)__builtin_amdgcn_cvt_pk_fp8_f32(a2 * scB, a3 * scB, 0, false);
          const unsigned r0 = (wA & 0xffu) * 0x01010101u, r1 = ((wA >> 8) & 0xffu) * 0x01010101u, r2 = (wB & 0xffu) * 0x01010101u, r3 = ((wB >> 8) & 0xffu) * 0x01010101u;
          rep[l] = ((unsigned long long)r0 << 32) | r0; rep[64 + l] = ((unsigned long long)r1 << 32) | r1; rep[128 + l] = ((unsigned long long)r2 << 32) | r2; rep[192 + l] = ((unsigned long long)r3 << 32) | r3; }
        LDS_WAIT(); asm volatile("" ::: "memory");
#pragma unroll
        for (int t2 = 0; t2 < 2; ++t2) {
            f32x4 alo = {0.f, 0.f, 0.f, 0.f}, ahi = {0.f, 0.f, 0.f, 0.f};
#pragma unroll
            for (int i = 0; i < 16; ++i) { const long bop = (long)(rep[128 * t2 + 8 * i + repi] & bm); const u32x4 rw = t2 ? rowB[i] : rowA[i];
                alo = __builtin_amdgcn_mfma_f32_16x16x32_fp8_fp8(lo64(rw), bop, alo, 0, 0, 0);
                ahi = __builtin_amdgcn_mfma_f32_16x16x32_fp8_fp8(hi64(rw), bop, ahi, 0, 0, 0); }
            const float inv = t2 ? invB : invA;
            float vlo[4], vhi[4];
#pragma unroll
            for (int r = 0; r < 4; ++r) { const float tl = alo[r], th = ahi[r];
                vlo[r] = (tl + __builtin_bit_cast(float, __builtin_amdgcn_ds_bpermute(((l + 40) & 63) * 4, __builtin_bit_cast(int, tl)))) * inv;
                vhi[r] = (th + __builtin_bit_cast(float, __builtin_amdgcn_ds_bpermute(((l + 40) & 63) * 4, __builtin_bit_cast(int, th)))) * inv; }
            if (vl) {
#pragma unroll
                for (int r = 0; r < 4; ++r) { stg[64 * q + 16 * r + n16] = vlo[r]; stg[64 * q + 16 * r + n16 + 8] = vhi[r]; } }
            LDS_WAIT(); asm volatile("" ::: "memory");
            if (l < 32) { const f32x4 dv = *(const LAS f32x4*)(stg + 4 * l); *(f32x4*)(out + (size_t)(tok + t2) * D + g * 128 + 4 * l) = (t2 ? HB : HA) + dv; }
            LDS_WAIT(); asm volatile("" ::: "memory");
        }
        LDS_WAIT(); asm volatile("" ::: "memory");
    }
#undef V_PREFETCH
}
__device__ __forceinline__ void final_norm_phase(const Frame& F, const Args& A) {
    const int gw = F.bid * NWAVES + F.wave, NGW = F.G * NWAVES, l = F.lane; const float* fg = A.in[I_FG];
    const f32x4* gp = (const f32x4*)fg + l;
    int tok = gw;
    for (; tok + 3 * NGW < T_TOK; tok += 4 * NGW) {
        f32x4 v[4][4]; float ss[4];
#pragma unroll
        for (int b = 0; b < 4; ++b) { const f32x4* hp = (const f32x4*)(A.out + (size_t)(tok + b * NGW) * D) + l;
#pragma unroll
            for (int j = 0; j < 4; ++j) v[b][j] = hp[64 * j]; }
#pragma unroll
        for (int b = 0; b < 4; ++b) { ss[b] = 0.f;
#pragma unroll
            for (int j = 0; j < 4; ++j) ss[b] += (v[b][j].x * v[b][j].x + v[b][j].y * v[b][j].y) + (v[b][j].z * v[b][j].z + v[b][j].w * v[b][j].w); }
#pragma unroll
        for (int o = 1; o < 64; o <<= 1) {
#pragma unroll
            for (int b = 0; b < 4; ++b) ss[b] += __shfl_xor(ss[b], o); }
#pragma unroll
        for (int b = 0; b < 4; ++b) { const float rstd = 1.f / sqrtf(ss[b] * (1.f / D) + EPS); f32x4* hp = (f32x4*)(A.out + (size_t)(tok + b * NGW) * D) + l;
#pragma unroll
            for (int j = 0; j < 4; ++j) hp[64 * j] = v[b][j] * rstd * gp[64 * j]; }
    }
    for (; tok < T_TOK; tok += NGW) { f32x4* hp = (f32x4*)(A.out + (size_t)tok * D) + l; f32x4 v[4]; float ss = 0.f;
#pragma unroll
        for (int j = 0; j < 4; ++j) { v[j] = hp[64 * j]; ss += (v[j].x * v[j].x + v[j].y * v[j].y) + (v[j].z * v[j].z + v[j].w * v[j].w); }
        const float rstd = 1.f / sqrtf(wave_sum(ss) * (1.f / D) + EPS);
#pragma unroll
        for (int j = 0; j < 4; ++j) hp[64 * j] = v[j] * rstd * gp[64 * j]; }
}

#ifdef DEBUG_CHECK
constexpr size_t WS_DBG = 472 * MiB;
__device__ __forceinline__ int dbg_tok(int i) { return (i * 509 + 3) & 32767; }
__device__ __forceinline__ float gelu_ref(float x) { return 0.5f * x * (1.f + tanhf(0.7978845608028654f * (x + 0.044715f * x * x * x))); }
__global__ void __launch_bounds__(512) dbg_scores(Args a) {
    __shared__ float n2s[1024]; __shared__ float q[2048];
    const int t = dbg_tok(blockIdx.x), tid = threadIdx.x;
    const bf16_t* N2 = (const bf16_t*)(a.ws + WS_N1); const float* SC = (const float*)(a.ws + WS_P + P_SC); unsigned* dbg = (unsigned*)(a.ws + WS_DBG);
    for (int k = tid; k < 1024; k += 512) n2s[k] = bf1(N2[(size_t)t * 1024 + k]);
    __syncthreads();
    for (int r = 0; r < 4; ++r) { const int c = tid + 512 * r; float s = 0.f; for (int k = 0; k < 1024; ++k) s += n2s[k] * a.in[I_WQ][(size_t)k * 2048 + c]; q[c] = s; }
    __syncthreads();
    float md = 0.f;
    for (int r = 0; r < 4; ++r) { const int n = tid + 512 * r, hh = n >> 7, key = n & 127; const float* kX = (hh & 1) ? a.in[I_K2] : a.in[I_K1];
        float s = 0.f; for (int d = 0; d < 128; ++d) s += q[hh * 128 + d] * kX[key * 128 + d];
        md = fmaxf(md, fabsf(s - SC[(size_t)n * T_TOK + t])); }
    atomicMax(&dbg[0], __builtin_bit_cast(unsigned, md));
}
__global__ void __launch_bounds__(64) dbg_topk(Args a) {
    __shared__ float s1[8][128], s2[8][128], cv[8][256]; __shared__ float t1v[8][16], t2v[8][16]; __shared__ int t1i[8][16], t2i[8][16], exi[8][16]; __shared__ float exv[8][16];
    const int t = dbg_tok(blockIdx.x), h = threadIdx.x;
    const float* SC = (const float*)(a.ws + WS_P + P_SC); const int* IDX = (const int*)(a.ws + WS_P + P_IDX); const float* GATE = (const float*)(a.ws + WS_P + P_GATE); unsigned* dbg = (unsigned*)(a.ws + WS_DBG);
    if (h >= 8) return;
    for (int j = 0; j < 128; ++j) { s1[h][j] = SC[(size_t)(h * 256 + j) * T_TOK + t]; s2[h][j] = SC[(size_t)(h * 256 + 128 + j) * T_TOK + t]; }
    for (int r = 0; r < 16; ++r) { int b1 = 0, b2 = 0; for (int j = 1; j < 128; ++j) { if (s1[h][j] > s1[h][b1]) b1 = j; if (s2[h][j] > s2[h][b2]) b2 = j; }
        t1v[h][r] = s1[h][b1]; t1i[h][r] = b1; s1[h][b1] = -1e30f; t2v[h][r] = s2[h][b2]; t2i[h][r] = b2; s2[h][b2] = -1e30f; }
    for (int c = 0; c < 256; ++c) cv[h][c] = t1v[h][c >> 4] + t2v[h][c & 15];
    for (int r = 0; r < 16; ++r) { int bc = 0; for (int c = 1; c < 256; ++c) if (cv[h][c] > cv[h][bc]) bc = c;
        exv[h][r] = cv[h][bc]; exi[h][r] = t1i[h][bc >> 4] * 128 + t2i[h][bc & 15]; cv[h][bc] = -1e30f; }
    float sum = 0.f; const float mx0 = exv[h][0]; for (int r = 0; r < 16; ++r) { exv[h][r] = expf(exv[h][r] - mx0); } for (int r = 0; r < 16; ++r) sum += exv[h][r];
    unsigned miss = 0; float gd = 0.f;
    for (int w = 0; w < 16; ++w) { const int e = IDX[(size_t)t * 128 + h * 16 + w]; const float g = GATE[(size_t)t * 128 + h * 16 + w]; bool found = false;
        for (int r = 0; r < 16; ++r) if (exi[h][r] == e) { found = true; gd = fmaxf(gd, fabsf(g - exv[h][r] / sum)); }
        if (!found) ++miss; }
    atomicAdd(&dbg[1], miss); atomicMax(&dbg[3], __builtin_bit_cast(unsigned, gd));
}
__global__ void __launch_bounds__(512) dbg_experts_pre(Args a) {
    __shared__ float n2s[1024]; __shared__ float ak[128]; __shared__ int ek[128]; __shared__ float red[8];
    const int t = dbg_tok(blockIdx.x), tid = threadIdx.x, lane = tid & 63, wave = tid >> 6;
    const bf16_t* N2 = (const bf16_t*)(a.ws + WS_N1); const int* IDX = (const int*)(a.ws + WS_P + P_IDX); const float* GATE = (const float*)(a.ws + WS_P + P_GATE);
    float* rows = (float*)(a.ws + WS_DBG + MiB);
    for (int k = tid; k < 1024; k += 512) n2s[k] = bf1(N2[(size_t)t * 1024 + k]);
    if (tid < 128) ek[tid] = IDX[(size_t)t * 128 + tid];
    __syncthreads();
    for (int k = wave * 16; k < wave * 16 + 16; ++k) { const float* u = a.in[I_PU] + (size_t)ek[k] * 1024; float s = 0.f; for (int j = lane; j < 1024; j += 64) s += u[j] * n2s[j];
        s = wave_sum(s); if (lane == 0) ak[k] = gelu_ref(s) * GATE[(size_t)t * 128 + k]; }
    __syncthreads();
    float h2[2]; float ss = 0.f;
    for (int r = 0; r < 2; ++r) { const int d = tid + 512 * r; float o = 0.f; for (int k = 0; k < 128; ++k) o += ak[k] * a.in[I_PV][(size_t)ek[k] * 1024 + d]; h2[r] = a.out[(size_t)t * 1024 + d] + o; ss += h2[r] * h2[r]; }
    ss = wave_sum(ss); if (lane == 0) red[wave] = ss; __syncthreads();
    float tot = 0.f; for (int w = 0; w < 8; ++w) tot += red[w];
    const float rstd = 1.f / sqrtf(tot / 1024.f + EPS);
    for (int r = 0; r < 2; ++r) { const int d = tid + 512 * r; rows[(size_t)blockIdx.x * 1024 + d] = h2[r] * rstd * a.in[I_FG][d]; }
}
__global__ void __launch_bounds__(512) dbg_experts_post(Args a) {
    const int t = dbg_tok(blockIdx.x), tid = threadIdx.x; const float* rows = (const float*)(a.ws + WS_DBG + MiB); float* dbgf = (float*)(a.ws + WS_DBG);
    float e = 0.f, n = 0.f;
    for (int r = 0; r < 2; ++r) { const int d = tid + 512 * r; const float x = rows[(size_t)blockIdx.x * 1024 + d], y = a.out[(size_t)t * 1024 + d]; e += (x - y) * (x - y); n += x * x; }
    e = wave_sum(e); n = wave_sum(n); if ((tid & 63) == 0) { atomicAdd(&dbgf[4], e); atomicAdd(&dbgf[5], n); }
}
__global__ void __launch_bounds__(512) dbg_report(Args a, int which) {
    const unsigned* dbg = (const unsigned*)(a.ws + WS_DBG); const float* dbgf = (const float*)(a.ws + WS_DBG);
    const float mA = dbgf[0], gd = dbgf[3]; const unsigned miss = dbg[1]; const float relC = sqrtf(dbgf[4] / fmaxf(dbgf[5], 1e-30f));
    float X;
    if (which == 0) { int mask = 0; if (mA > 0.05f) mask |= 1; if (miss > 400u) mask |= 2; if (relC > 0.05f) mask |= 4; if (gd > 0.02f) mask |= 8; X = 1000.f + 100.f * mask; }
    else if (which == 1) X = 1e6f * mA; else if (which == 2) X = 100.f + (float)miss; else if (which == 3) X = 1e6f * relC; else X = 1e6f * gd;
    for (size_t i = (size_t)blockIdx.x * 512 + threadIdx.x; i < (size_t)T_TOK * D; i += (size_t)gridDim.x * 512) a.out[i] = (i == 0) ? X : 0.f;
}
#endif

constexpr int NPH = 13;
__global__ void __launch_bounds__(NWAVES * 64, 2) fwd_kernel(Args args) {
    extern __shared__ __attribute__((aligned(16))) unsigned char lds_raw[];
    Frame F;
    F.lds = (LAS unsigned char*)lds_raw;
    F.tid = threadIdx.x; F.lane = F.tid & 63; F.wave = __builtin_amdgcn_readfirstlane(F.tid >> 6);
    F.G = gridDim.x; F.bid = blockIdx.x;
    volatile LAS unsigned* MISC = (volatile LAS unsigned*)(F.lds + MISC_OFF);
    for (int u = F.tid; u < (LDS_BYTES - LDSCTL_OFF) / 4; u += NWAVES * 64) ((LAS unsigned*)(F.lds + LDSCTL_OFF))[u] = 0u;
    __syncthreads();
    unsigned* ctl = (unsigned*)(args.ws + WS_CTL);
    const int lo = args.ph_lo, hi = args.ph_hi;
    XcdBarrier bar; bar.bar = ctl + CW_BAR + args.li * XCD_BAR_WORDS; bar.x = 0; bar.st = nullptr; bar.wave = F.wave;
    if (hi - lo > 1) bar = xcd_barrier_post(ctl + CW_BAR + args.li * XCD_BAR_WORDS, MISC + 8, F.wave);
#define IN(k) (lo <= (k) && (k) < hi)
#ifdef PROBE_TS
#define STAMP(k) do { if (F.bid == 0 && F.tid == 0) ((unsigned long long*)(args.ws + (472u << 20)))[(k)] = __builtin_amdgcn_s_memrealtime(); } while (0)
#else
#define STAMP(k) do { } while (0)
#endif
#define SEAM(k) do { if (IN(k) && IN((k) + 1)) { xcd_barrier(bar); if (XTRA_BAR) xcd_barrier(bar); } STAMP((k) + 1); } while (0)
    unsigned char* ws = args.ws;
    bf16_t* P = (bf16_t*)(ws + WS_P);

#define REFRESH() do { int z_ = 0; asm volatile("" : "+s"(z_)); F.lane = (int)__builtin_amdgcn_mbcnt_hi(~0u, __builtin_amdgcn_mbcnt_lo(~0u, (unsigned)z_)); F.tid = F.wave * 64 + F.lane; } while (0)
    STAMP(0);
    if (IN(0)) { phase0(F, args); SEAM(0); }
    if (IN(1)) { REFRESH();
        if (F8_LO > 0) { pg8::Gemm g{(const bf16_t*)(ws + WS_N1), (const bf16_t*)(ws + WS_WIN), T_TOK, F8_LO * 256, D, D}; pg8::StaticOrder S; S.init(T_TOK, F8_LO * 256, F.G, F.bid);
            pg8::EpiProj E{P, (float*)(ws + WS_ALR), 0}; pg8::gemm_phase<pg8::EpiProj, pg8::StaticOrder, false, true, false>(F.lds, g, S, E, F.wave); }
        if (F8_LO < 21) {
            pg8::Gemm g{(const bf16_t*)(ws + WS_N18), (const bf16_t*)(ws + WS_W8 + (size_t)F8_LO * 256 * 1024), T_TOK, (21 - F8_LO) * 256, D / 2, D / 2, 0x7B7B7B7B, 0x75757575};
            pg8::StaticOrder S; S.init(T_TOK, (21 - F8_LO) * 256, F.G, F.G - 1 - F.bid);
            pg8::EpiProj E{P, (float*)(ws + WS_ALR), F8_LO}; pg8::gemm_phase<pg8::EpiProj, pg8::StaticOrder, false, true, true>(F.lds, g, S, E, F.wave); }
        {
            REFRESH();
            const int nwg = (T_TOK / 256) * (NPROJ / 256), rem = nwg % F.G;
            if (rem == 0) convert_tables(F, args, F.bid * NWAVES + F.wave, F.G * NWAVES);
            else if (F.bid >= rem) convert_tables(F, args, (F.bid - rem) * NWAVES + F.wave, (F.G - rem) * NWAVES);
        }
        SEAM(1);
    }
    if (IN(2)) { REFRESH();
        if (DRY_EXP == 12) { gla_chunk_phase<true>(F, args); for (int it = F.bid; it < 1024; it += F.G) sgu_unit<true>(F, args, it); __syncthreads(); }
        gla_chunk_phase<false>(F, args);
        for (int it = F.bid; it < 1024; it += F.G) sgu_unit<false>(F, args, it);
        SEAM(2);
    }
    if (IN(3)) { REFRESH(); if (DRY_EXP == 13 || DRY_EXP == 15) { gla_scan<true>(F, args); __syncthreads(); } gla_scan<false>(F, args); SEAM(3); }
    if (IN(4)) { REFRESH(); if (DRY_EXP == 14 || DRY_EXP == 15) { gla_out_phase<true>(F, args); __syncthreads(); } gla_out_phase<false>(F, args); SEAM(4); }
    if (IN(5)) { REFRESH();
        { pg8::Gemm g{P + PC_Q, (const bf16_t*)(ws + WS_WA), T_TOK, D, 512, PLD}; pg8::StaticOrder S; S.init(T_TOK, D, F.G, F.bid);
          pg8::EpiBrA E{P}; pg8::gemm_phase<pg8::EpiBrA, pg8::StaticOrder, true, true>(F.lds, g, S, E, F.wave); }
        { pg8::Gemm g{P + PC_SU, (const bf16_t*)(ws + WS_WB), T_TOK, D, 512, PLD}; pg8::StaticOrder S; S.init(T_TOK, D, F.G, F.bid);
          pg8::EpiBrB E{P}; pg8::gemm_phase<pg8::EpiBrB, pg8::StaticOrder, true, true>(F.lds, g, S, E, F.wave); }
        SEAM(5);
    }
    if (IN(6)) { REFRESH();
        pg8::Gemm g{P + PC_MRG, (const bf16_t*)(ws + WS_WOUT), T_TOK, D, D, PLD}; pg8::StaticOrder S; S.init(T_TOK, D, F.G, F.bid);
        pg8::EpiOut E{args.in[I_X], args.out}; pg8::gemm_phase<pg8::EpiOut, pg8::StaticOrder, true, true>(F.lds, g, S, E, F.wave);
        SEAM(6);
    }
    if (IN(7)) { REFRESH();
        const int gw = F.bid * NWAVES + F.wave, NGW = F.G * NWAVES;
        { int m = gw; for (; m + 3 * NGW < T_TOK; m += 4 * NGW) rms_rows_to_bf16<(SC_F8 ? 2 : 3), 4>(F.lane, args.out + (size_t)m * D, (size_t)NGW * D, args.in[I_N2G], (bf16_t*)(ws + WS_N1) + (size_t)m * D, (size_t)NGW * D, (unsigned*)(ws + WS_P + P_X8) + (size_t)m * 256, (size_t)NGW * 256);
          for (; m < T_TOK; m += NGW) rms_rows_to_bf16<(SC_F8 ? 2 : 3), 1>(F.lane, args.out + (size_t)m * D, 0, args.in[I_N2G], (bf16_t*)(ws + WS_N1) + (size_t)m * D, 0, (unsigned*)(ws + WS_P + P_X8) + (size_t)m * 256, 0); }
        SEAM(7);
    }
    if (IN(8)) { REFRESH();
        pg8::StaticOrder S; S.init(T_TOK, 2048, F.G, F.bid); pg8::EpiScores E{(bf16_t*)(ws + WS_P + P_SC)};
        if (SC_F8) { pg8::Gemm g{(const bf16_t*)(ws + WS_P + P_X8), (const bf16_t*)(ws + WS_WQF), T_TOK, 2048, D / 2, D / 2, 0x7B7B7B7B, 0x75757575};
            pg8::gemm_phase<pg8::EpiScores, pg8::StaticOrder, true, true, true>(F.lds, g, S, E, F.wave); }
        else { pg8::Gemm g{(const bf16_t*)(ws + WS_N1), (const bf16_t*)(ws + WS_WQF), T_TOK, 2048, D, D};
            pg8::gemm_phase<pg8::EpiScores, pg8::StaticOrder, true, true>(F.lds, g, S, E, F.wave); }
        SEAM(8);
    }
    if (IN(9)) { REFRESH(); peer_topk(F, args); SEAM(9); }
    if (IN(10)) { REFRESH(); if constexpr (UNG == 1) peer_u4_all<0>(F, args); else peer_u4_phase<0>(F, args); SEAM(10); }
    if (IN(11)) { REFRESH(); if (DRY_EXP == 1) { peer_v_phase<1>(F, args); __syncthreads(); } peer_v_phase<0>(F, args); SEAM(11); }
    if (IN(12)) { REFRESH(); final_norm_phase(F, args); }
#undef IN
#undef SEAM
}


#ifdef PROBE_TS
__global__ void __launch_bounds__(512) probe_report(Args a, int pi, int pj) {
    const unsigned long long* ts = (const unsigned long long*)(a.ws + (472u << 20));
    const float X1 = 10.f * (float)(ts[pi + 1] - ts[pi]) * 0.01f, X2 = (float)(ts[pj + 1] - ts[pj]) * 0.01f;
    for (size_t i = (size_t)blockIdx.x * 512 + threadIdx.x; i < (size_t)T_TOK * D; i += (size_t)gridDim.x * 512) a.out[i] = (i == 0) ? X1 : X2;
}
#endif
#ifdef PROBE_MFMA
__global__ void __launch_bounds__(64) probe_mfma(Args a) {
    const int l = threadIdx.x;
    i32x4 av = {0, 0, 0, 0};
    if (l == PROBE_L) av[PROBE_P >> 3] = 0x2 << (4 * (PROBE_P & 7));
    i32x8 b1, b2;
    for (int r = 0; r < 8; ++r) { unsigned w1 = 0, w2 = 0;
        for (int c = 0; c < 4; ++c) { const int b = 4 * r + c; int t = 0;
            t = __builtin_amdgcn_cvt_pk_fp8_f32((float)((b & 15) + 1), (float)(1 + (b >> 4) + 2 * (l >> 4)), 0, false);
            w1 |= ((unsigned)t & 0xffu) << (8 * c); w2 |= (((unsigned)t >> 8) & 0xffu) << (8 * c); }
        b1[r] = (int)w1; b2[r] = (int)w2; }
    const f32x4 z = {0.f, 0.f, 0.f, 0.f};
    const f32x4 d1 = __builtin_amdgcn_mfma_scale_f32_16x16x128_f8f6f4(__builtin_shufflevector(av, av, 0, 1, 2, 3, -1, -1, -1, -1), b1, z, 4, 0, 0, 0x7F7F7F7F, 0, 0x7F7F7F7F);
    const f32x4 d2 = __builtin_amdgcn_mfma_scale_f32_16x16x128_f8f6f4(__builtin_shufflevector(av, av, 0, 1, 2, 3, -1, -1, -1, -1), b2, z, 4, 0, 0, 0x7F7F7F7F, 0, 0x7F7F7F7F);
    float* st = (float*)(a.ws + (472u << 20));
    *(f32x4*)(st + 8 * l) = d1; *(f32x4*)(st + 8 * l + 4) = d2;
}
__global__ void __launch_bounds__(512) probe_mfma_report(Args a) {
    const int row = PROBE_L & 15;
    const float* st = (const float*)(a.ws + (472u << 20)) + 8 * (16 * (row >> 2)) + (row & 3); const float X1 = 10.f * st[0], X2 = st[4];
    for (size_t i = (size_t)blockIdx.x * 512 + threadIdx.x; i < (size_t)T_TOK * D; i += (size_t)gridDim.x * 512) a.out[i] = (i == 0) ? X1 : X2;
}
#endif
extern "C" void kernel_launch(void* const* d_in, const int* in_sizes, int n_in, void* d_out, int out_size, void* d_ws, size_t ws_size, hipStream_t stream) {
    static int grid = 0;
    if (grid == 0) {
        if (n_in != 20 || in_sizes[0] != T_TOK * D || out_size != T_TOK * D || ws_size < WS_END) {
            fprintf(stderr, "kernel_launch: unexpected shapes: n_in %d in0 %d out %d ws %zu (need %zu)\n", n_in, n_in > 0 ? in_sizes[0] : -1, out_size, ws_size, (size_t)WS_END); grid = -1; return; }
        int dev = 0, cus = 0;
        if (hipGetDevice(&dev) != hipSuccess || hipDeviceGetAttribute(&cus, hipDeviceAttributeMultiprocessorCount, dev) != hipSuccess) { grid = -1; return; }
        if (hipFuncSetAttribute((const void*)fwd_kernel, hipFuncAttributeMaxDynamicSharedMemorySize, LDS_BYTES) != hipSuccess) { fprintf(stderr, "kernel_launch: hipFuncSetAttribute failed\n"); grid = -1; return; }
        int per_cu = 0;
        if (hipOccupancyMaxActiveBlocksPerMultiprocessor(&per_cu, (const void*)fwd_kernel, NWAVES * 64, LDS_BYTES) != hipSuccess || per_cu < 1) fprintf(stderr, "kernel_launch: occupancy query says %d\n", per_cu);
        (void)hipGetLastError();
        grid = cus;
    }
    if (grid < 0) return;
    (void)hipMemsetAsync((char*)d_ws + WS_CTL, 0, CTL_ZERO_BYTES, stream);
    Args a{};
    for (int i = 0; i < 20; ++i) a.in[i] = (const float*)d_in[i];
    a.out = (float*)d_out; a.ws = (unsigned char*)d_ws;
#ifdef PROBE_MFMA
    hipLaunchKernelGGL(probe_mfma, dim3(1), dim3(64), 0, stream, a);
    hipLaunchKernelGGL(probe_mfma_report, dim3(1024), dim3(512), 0, stream, a);
    return;
#endif
#ifndef LAUNCH_LIST
#define LAUNCH_LIST {0, NPH}
#endif
    static const int ranges[][2] = { LAUNCH_LIST };
    const int nl = (int)(sizeof(ranges) / sizeof(ranges[0]));
    for (int li = 0; li < nl; ++li) { a.ph_lo = ranges[li][0]; a.ph_hi = ranges[li][1]; a.li = li;
        hipLaunchKernelGGL(fwd_kernel, dim3(grid), dim3(NWAVES * 64), LDS_BYTES, stream, a); }
}
```

```cpp
#include <hip/hip_runtime.h>
#include <cstdio>
#include <cstdint>


#ifndef XTRA_BAR
#define XTRA_BAR 0
#endif
#ifndef DRY_EXP
#define DRY_EXP 0
#endif
#ifndef DUP_PHASE
#define DUP_PHASE -1
#endif
#ifndef MK_N_LAUNCHES
#define MK_N_LAUNCHES 1
#endif

#define LAS __attribute__((address_space(3)))
#define GAS __attribute__((address_space(1)))
typedef unsigned short bf16_t;
typedef short bf16x8 __attribute__((ext_vector_type(8)));
typedef float f32x4 __attribute__((ext_vector_type(4)));
typedef float f32x2 __attribute__((ext_vector_type(2)));
typedef unsigned u32x4 __attribute__((ext_vector_type(4)));
typedef unsigned u32x2 __attribute__((ext_vector_type(2)));
typedef int i32x4 __attribute__((ext_vector_type(4)));
typedef int i32x8 __attribute__((ext_vector_type(8)));
typedef __bf16 bf16x2_t __attribute__((ext_vector_type(2)));

constexpr int T_TOK = 32768, D = 1024, SEQ = 4096, NBATCH = 8;
constexpr int NPROJ = 5376;
constexpr int PLD = 5120;
constexpr int PC_Q = 0, PC_K = 512, PC_V = 1024, PC_R = 1536, PC_SU = 2048, PC_SV = 2560, PC_GA = 3072, PC_GB = 4096;
constexpr int PC_MRG = 512;
constexpr float EPS = 1e-6f;
constexpr int NEXP = 16384;
#ifndef U_NG
#define U_NG 1
#endif
#ifndef V_F4
#define V_F4 1
#endif
#ifndef SC_F8
#define SC_F8 0
#endif
#ifndef F8_LO
#define F8_LO 11
#endif
constexpr int UNG = U_NG, UNG_SH = (U_NG == 8 ? 3 : (U_NG == 4 ? 2 : (U_NG == 2 ? 1 : 0)));

constexpr size_t MiB = 1u << 20;
constexpr size_t WS_CTL = 0, CTL_ZERO_BYTES = 64 * 1024;
constexpr size_t WS_WIN = 1 * MiB;
constexpr size_t WS_WA = 12 * MiB;
constexpr size_t WS_WB = 13 * MiB;
constexpr size_t WS_WOUT = 14 * MiB;
constexpr size_t WS_WQF = 16 * MiB;
constexpr size_t WS_U8 = 20 * MiB;
constexpr size_t WS_V8 = 36 * MiB;
constexpr size_t WS_SU = 52 * MiB;
constexpr size_t WS_SV = 52 * MiB + 65536;
constexpr size_t WS_AK = 53 * MiB;
constexpr size_t WS_DEC = 84 * MiB;
constexpr size_t WS_ALR = 85 * MiB;
constexpr size_t WS_N1 = 87 * MiB;
constexpr size_t WS_P = 151 * MiB;
constexpr size_t WS_W8 = 472 * MiB;
constexpr size_t WS_N18 = 478 * MiB;
constexpr size_t WS_END = 510 * MiB;
constexpr size_t P_SC = 0, P_IDX = 256 * MiB, P_GATE = 272 * MiB, P_X8 = 288 * MiB;

constexpr int CW_BAR = 4096;

constexpr int RING_BYTES = 131072;
constexpr int LDSCTL_OFF = RING_BYTES, MISC_OFF = LDSCTL_OFF + 320;
constexpr int LDS_BYTES = 147456;
constexpr int NWAVES = 8;

__device__ __forceinline__ unsigned pk2(float lo, float hi) { const f32x2 v = {lo, hi}; const bf16x2_t b = __builtin_convertvector(v, bf16x2_t); return __builtin_bit_cast(unsigned, b); }
__device__ __forceinline__ unsigned f2bf(float f) { return pk2(f, 0.f) & 0xffffu; }
__device__ __forceinline__ float bflo(unsigned w) { return __builtin_bit_cast(float, w << 16); }
__device__ __forceinline__ float bfhi(unsigned w) { return __builtin_bit_cast(float, w & 0xffff0000u); }
__device__ __forceinline__ float bf1(bf16_t h) { return __builtin_bit_cast(float, ((unsigned)h) << 16); }
__device__ __forceinline__ float sigmoidf_(float x) { return __builtin_amdgcn_rcpf(1.f + __expf(-x)); }
__device__ __forceinline__ float gelu_tanh(float x) { const float y = 1.5957691216057308f * (x + 0.044715f * x * x * x); return x * sigmoidf_(y); }
__device__ __forceinline__ float siluf_(float x) { return x * sigmoidf_(x); }
__device__ __forceinline__ float wave_sum(float v) {
#pragma unroll
    for (int o = 1; o < 64; o <<= 1) v += __shfl_xor(v, o);
    return v;
}
#define LDS_WAIT() asm volatile("s_waitcnt lgkmcnt(0)" ::: "memory")
#define VM_WAIT() asm volatile("s_waitcnt vmcnt(0)" ::: "memory")

__device__ __forceinline__ int lane_now() { int z = 0; asm volatile("" : "+s"(z)); return (int)__builtin_amdgcn_mbcnt_hi(~0u, __builtin_amdgcn_mbcnt_lo(~0u, (unsigned)z)); }
namespace pg8 {
constexpr int BM = 256, BK = 64, HALF = 128, HTB = HALF * BK * 2, STAGE_BYTES = 8 * HTB, NXCD = 8, WGM = 8;
__host__ __device__ __forceinline__ int lds_byte(int r, int c) { const int st = (r >> 4) * 2 + (c >> 5), rr = r & 15, cc = c & 31, ob = rr * 64 + cc * 2; return st * 1024 + (ob ^ (((ob >> 9) & 1) << 5)); }
__host__ __device__ __forceinline__ void stage_rc(int b, int& R, int& C) { const int st = b / 1024, sb = b % 1024, swz = sb ^ (((sb >> 9) & 1) << 5); R = (st >> 1) * 16 + swz / 64; C = (st & 1) * 32 + (swz % 64) / 2; }
__host__ __device__ __forceinline__ int perm32(int rho) { const int n = rho >> 4, i = rho & 15; return 8 * (i >> 2) + 4 * n + (i & 3); }

struct Unit { int pm, pn; };
struct Gemm { const bf16_t* A; const bf16_t* Bt; int M, N, K, lda; int sa = 0, sb = 0; };

struct StaticOrder {
    int nM, nN, nwg, G, c;
    __host__ __device__ void init(int M, int N, int G_, int c_) { nM = M / BM; nN = N / BM; nwg = nM * nN; G = G_; c = c_; }
    __host__ __device__ bool next(int i, Unit& u) const {
        const long L = (long)i * G + c; if (L >= nwg) return false;
        int wgid = (int)L; { const int q = nwg / NXCD, r = nwg % NXCD, xcd = wgid % NXCD, off = wgid / NXCD; wgid = (xcd < r ? xcd * (q + 1) : r * (q + 1) + (xcd - r) * q) + off; }
        const int nig = WGM * nN, gid = wgid / nig, fm = gid * WGM, gsz = (nM - fm) < WGM ? (nM - fm) : WGM;
        u.pm = fm + ((wgid % nig) % gsz); u.pn = (wgid % nig) / gsz; return true;
    }
    __device__ __forceinline__ void a_ready(const Unit&) const {}
    __device__ __forceinline__ void done(const Unit&) const {}
};

template <class Epi, class Sched, bool ALIGN_EPI = false, bool SP2 = false, bool F8 = false>
__device__ __forceinline__ void gemm_phase(LAS unsigned char* lds, const Gemm g, const Sched& S, const Epi& E, int wave_id) {
    const int wid = wave_id, lane = lane_now(), tid = wid * 64 + lane, wr = wid >> 2, wc = wid & 3, fr = lane & 15, fq = lane >> 4;
    const int K = g.K, nt = K / BK, lda = g.lda; const int scA = g.sa, scB = g.sb; (void)scA; (void)scB;
    unsigned voffA[2], voffB[2];
#pragma unroll
    for (int i = 0; i < 2; ++i) { int R, C; stage_rc(tid * 16 + i * 8192, R, C); const int Rb = Epi::PERM ? ((R & ~31) + perm32(R & 31)) : R;
        voffA[i] = (unsigned)(R * lda + C) * 2u; voffB[i] = (unsigned)(Rb * K + C) * 2u; }
    const size_t kstep = (size_t)(BK * 2);
    const size_t hstepA = (size_t)HALF * lda * 2, hstepB = (size_t)HALF * K * 2;
    const size_t tstepA = 2 * hstepA, tstepB = 2 * hstepB;
    const unsigned ldsw = (unsigned)wid * 1024u; const unsigned ldsbase = (unsigned)(__UINTPTR_TYPE__)lds + ldsw;
    const int aoff = lds_byte(wr * 64 + fr, fq * 8), boff = lds_byte(wc * 32 + fr, fq * 8);
#define PG8_SA(b, h) (((b) * 2 + (h)) * HTB)
#define PG8_SB(b, h) ((4 + (b) * 2 + (h)) * HTB)
#define PG8_STAGE(bufoff, gbase, voff) do { _Pragma("unroll") for (int _i = 0; _i < 2; ++_i) \
        asm volatile("s_mov_b32 m0, %2\n\ts_nop 0\n\tglobal_load_lds_dwordx4 %0, %1" :: "v"((voff)[_i]), "s"((const char*)(gbase)), "s"(ldsbase + (unsigned)((bufoff) + _i * 8192)) : "memory", "m0"); } while (0)
#define PG8_LDA(dst, b, h) do { _Pragma("unroll") for (int m = 0; m < 4; ++m) _Pragma("unroll") for (int k = 0; k < 2; ++k) dst[m][k] = *(const LAS bf16x8*)(lds + PG8_SA(b, h) + aoff + m * 2048 + k * 1024); } while (0)
#define PG8_LDB(dst, b, h) do { _Pragma("unroll") for (int n = 0; n < 2; ++n) _Pragma("unroll") for (int k = 0; k < 2; ++k) dst[n][k] = *(const LAS bf16x8*)(lds + PG8_SB(b, h) + boff + n * 2048 + k * 1024); } while (0)
#define PG8_CAT(x) __builtin_shufflevector(__builtin_bit_cast(i32x4, (x)[0]), __builtin_bit_cast(i32x4, (x)[1]), 0, 1, 2, 3, 4, 5, 6, 7)
#define PG8_MMA(ai, bj, At, Bt) do { __builtin_amdgcn_s_setprio(1); if constexpr (F8) { _Pragma("unroll") for (int m = 0; m < 4; ++m) _Pragma("unroll") for (int n = 0; n < 2; ++n) \
        acc[ai][bj][m][n] = __builtin_amdgcn_mfma_scale_f32_16x16x128_f8f6f4(PG8_CAT(Bt[n]), PG8_CAT(At[m]), acc[ai][bj][m][n], 0, 0, 0, scB, 0, scA); } else { \
        _Pragma("unroll") for (int m = 0; m < 4; ++m) _Pragma("unroll") for (int n = 0; n < 2; ++n) _Pragma("unroll") for (int k = 0; k < 2; ++k) \
        acc[ai][bj][m][n] = __builtin_amdgcn_mfma_f32_16x16x32_bf16(Bt[n][k], At[m][k], acc[ai][bj][m][n], 0, 0, 0); } __builtin_amdgcn_s_setprio(0); } while (0)
#define PG8_WAIT_V(n) asm volatile("s_waitcnt vmcnt(" #n ")" ::: "memory")
#define PG8_WAIT_L(n) asm volatile("s_waitcnt lgkmcnt(" #n ")" ::: "memory")
#define PG8_BAR __builtin_amdgcn_s_barrier()
#define PG8_SCHED __builtin_amdgcn_sched_barrier(0)
    Unit cur, nxt; int ui = 0;
    if (!S.next(0, cur)) return;
    f32x4 acc[2][2][4][2];
#pragma unroll
    for (int a = 0; a < 2; ++a)
#pragma unroll
        for (int b = 0; b < 2; ++b)
#pragma unroll
            for (int m = 0; m < 4; ++m)
#pragma unroll
                for (int n = 0; n < 2; ++n) acc[a][b][m][n] = (f32x4){0.f, 0.f, 0.f, 0.f};
    bf16x8 At[4][2], B0[2][2], B1[2][2];
    const char* cA = (const char*)g.A + (size_t)cur.pm * tstepA; const char* cB = (const char*)g.Bt + (size_t)cur.pn * tstepB;
    S.a_ready(cur);
    if constexpr (SP2) {
        PG8_STAGE(PG8_SB(0, 0), cB, voffB); PG8_STAGE(PG8_SB(0, 1), cB + hstepB, voffB); PG8_STAGE(PG8_SA(0, 0), cA, voffA); PG8_STAGE(PG8_SA(0, 1), cA + hstepA, voffA);
        if (wr == 1) PG8_BAR;
        PG8_WAIT_V(2); PG8_BAR;
        PG8_STAGE(PG8_SB(1, 0), cB + kstep, voffB); PG8_STAGE(PG8_SA(1, 0), cA + kstep, voffA); PG8_STAGE(PG8_SB(1, 1), cB + hstepB + kstep, voffB);
        PG8_WAIT_V(6); PG8_BAR;
    } else {
        PG8_STAGE(PG8_SB(0, 0), cB, voffB); PG8_STAGE(PG8_SA(0, 0), cA, voffA); PG8_STAGE(PG8_SB(0, 1), cB + hstepB, voffB); PG8_STAGE(PG8_SA(0, 1), cA + hstepA, voffA);
        if (wr == 1) PG8_BAR;
        PG8_WAIT_V(4); PG8_BAR;
        PG8_STAGE(PG8_SB(1, 0), cB + kstep, voffB); PG8_STAGE(PG8_SA(1, 0), cA + kstep, voffA); PG8_STAGE(PG8_SB(1, 1), cB + hstepB + kstep, voffB);
        PG8_WAIT_V(6); PG8_BAR;
    }
    for (;;) {
        const bool has_next = S.next(ui + 1, nxt);
        const char* nA = has_next ? (const char*)g.A + (size_t)nxt.pm * tstepA : cA; const char* nB = has_next ? (const char*)g.Bt + (size_t)nxt.pn * tstepB : cB;
#pragma nounroll
        for (int t = 0; t < nt; t += 2) {
            const bool last = (t == nt - 2);
            const char* a1 = cA + (size_t)(t + 1) * kstep;
            const char* a2 = last ? nA : cA + (size_t)(t + 2) * kstep; const char* b2 = last ? nB : cB + (size_t)(t + 2) * kstep;
            const char* a3 = a2 + kstep; const char* b3 = b2 + kstep;
            if (last && has_next) S.a_ready(nxt);
            if constexpr (SP2) {
            PG8_LDB(B0, 0, 0); PG8_LDB(B1, 0, 1); PG8_SCHED; PG8_LDA(At, 0, 0); PG8_STAGE(PG8_SA(1, 1), a1 + hstepA, voffA);
            PG8_WAIT_V(8); PG8_WAIT_L(0); PG8_BAR; PG8_MMA(0, 0, At, B0); PG8_MMA(0, 1, At, B1); PG8_BAR; PG8_SCHED;
            PG8_LDA(At, 0, 1); PG8_STAGE(PG8_SB(0, 0), b2, voffB); PG8_STAGE(PG8_SB(0, 1), b2 + hstepB, voffB); PG8_STAGE(PG8_SA(0, 0), a2, voffA);
            PG8_WAIT_V(8); PG8_WAIT_L(0); PG8_BAR; PG8_MMA(1, 0, At, B0); PG8_MMA(1, 1, At, B1); PG8_BAR; PG8_SCHED;
            PG8_LDB(B0, 1, 0); PG8_LDB(B1, 1, 1); PG8_SCHED; PG8_LDA(At, 1, 0); PG8_STAGE(PG8_SA(0, 1), a2 + hstepA, voffA);
            PG8_WAIT_V(8); PG8_WAIT_L(0); PG8_BAR; PG8_MMA(0, 0, At, B0); PG8_MMA(0, 1, At, B1); PG8_BAR; PG8_SCHED;
            PG8_LDA(At, 1, 1); PG8_STAGE(PG8_SB(1, 0), b3, voffB); PG8_STAGE(PG8_SB(1, 1), b3 + hstepB, voffB); PG8_STAGE(PG8_SA(1, 0), a3, voffA);
            PG8_WAIT_V(8); PG8_WAIT_L(0); PG8_BAR; PG8_MMA(1, 0, At, B0); PG8_MMA(1, 1, At, B1); PG8_BAR; PG8_SCHED;
            } else {
            PG8_LDB(B0, 0, 0); PG8_SCHED; PG8_LDA(At, 0, 0); PG8_STAGE(PG8_SA(1, 1), a1 + hstepA, voffA);
            PG8_WAIT_L(8); PG8_BAR; PG8_WAIT_L(0); PG8_MMA(0, 0, At, B0); PG8_BAR; PG8_SCHED;
            PG8_LDB(B1, 0, 1); PG8_STAGE(PG8_SB(0, 0), b2, voffB);
            PG8_BAR; PG8_WAIT_L(0); PG8_MMA(0, 1, At, B1); PG8_BAR;
            PG8_LDA(At, 0, 1); PG8_STAGE(PG8_SA(0, 0), a2, voffA);
            PG8_BAR; PG8_WAIT_L(0); PG8_MMA(1, 0, At, B0); PG8_BAR; PG8_SCHED;
            PG8_STAGE(PG8_SB(0, 1), b2 + hstepB, voffB);
            PG8_WAIT_V(6); PG8_BAR; PG8_MMA(1, 1, At, B1); PG8_BAR;
            PG8_LDB(B0, 1, 0); PG8_SCHED; PG8_LDA(At, 1, 0); PG8_STAGE(PG8_SA(0, 1), a2 + hstepA, voffA);
            PG8_WAIT_L(8); PG8_BAR; PG8_WAIT_L(0); PG8_MMA(0, 0, At, B0); PG8_BAR; PG8_SCHED;
            PG8_LDB(B1, 1, 1); PG8_STAGE(PG8_SB(1, 0), b3, voffB);
            PG8_BAR; PG8_WAIT_L(0); PG8_MMA(0, 1, At, B1); PG8_BAR;
            PG8_LDA(At, 1, 1); PG8_STAGE(PG8_SA(1, 0), a3, voffA);
            PG8_BAR; PG8_WAIT_L(0); PG8_MMA(1, 0, At, B0); PG8_BAR; PG8_SCHED;
            PG8_STAGE(PG8_SB(1, 1), b3 + hstepB, voffB);
            PG8_WAIT_V(6); PG8_BAR; PG8_MMA(1, 1, At, B1); PG8_BAR;
            }
        }
        if constexpr (ALIGN_EPI) { if (wr == 0) PG8_BAR; }
        E(acc, cur, wr, wc, fr, fq); S.done(cur);
        if (!has_next) break;
#pragma unroll
        for (int a = 0; a < 2; ++a)
#pragma unroll
            for (int b = 0; b < 2; ++b)
#pragma unroll
                for (int m = 0; m < 4; ++m)
#pragma unroll
                    for (int n = 0; n < 2; ++n) acc[a][b][m][n] = (f32x4){0.f, 0.f, 0.f, 0.f};
        cur = nxt; cA = nA; cB = nB; ++ui;
        if constexpr (ALIGN_EPI) { if (wr == 1) PG8_BAR; }
    }
    PG8_WAIT_V(0);
    if constexpr (!ALIGN_EPI) { if (wr == 0) PG8_BAR; }
    PG8_BAR;
#undef PG8_SA
#undef PG8_SB
#undef PG8_STAGE
#undef PG8_LDA
#undef PG8_LDB
#undef PG8_MMA
#undef PG8_CAT
#undef PG8_WAIT_V
#undef PG8_WAIT_L
#undef PG8_BAR
#undef PG8_SCHED
}

__device__ __forceinline__ u32x4 pack8(f32x4 v0, f32x4 v1) { u32x4 w; w.x = pk2(v0[0], v0[1]); w.y = pk2(v0[2], v0[3]); w.z = pk2(v1[0], v1[1]); w.w = pk2(v1[2], v1[3]); return w; }
__device__ __forceinline__ void unpack8(u32x4 w, f32x4& v0, f32x4& v1) { v0 = (f32x4){bflo(w.x), bfhi(w.x), bflo(w.y), bfhi(w.y)}; v1 = (f32x4){bflo(w.z), bfhi(w.z), bflo(w.w), bfhi(w.w)}; }

struct EpiProj {
    static constexpr bool PERM = true;
    bf16_t* P; float* ALR; int pn0;
    __device__ __forceinline__ void operator()(const f32x4 (&acc)[2][2][4][2], const Unit& u, int wr, int wc, int fr, int fq) const {
        asm volatile("" : "+v"(fr), "+v"(fq));
        const int row0 = u.pm * BM + wr * 64 + fr; int pn = u.pn + pn0; const int cl = wc * 32 + 8 * fq;
        if (pn == 10) {
            if (wc == 0 && fq < 2) {
#pragma unroll
                for (int ai = 0; ai < 2; ++ai)
#pragma unroll
                    for (int m = 0; m < 4; ++m) { float* rp = ALR + (size_t)(row0 + ai * HALF + m * 16) * 16 + 8 * fq;
                        *(f32x4*)rp = acc[ai][0][m][0]; *(f32x4*)(rp + 4) = acc[ai][0][m][1]; }
            }
            return;
        }
        if (pn > 10) --pn;
        const int mode = pn < 8 ? 0 : (pn < 12 ? 1 : 2);
#pragma unroll
        for (int ai = 0; ai < 2; ++ai)
#pragma unroll
            for (int m = 0; m < 4; ++m) { bf16_t* rowp = P + (size_t)(row0 + ai * HALF + m * 16) * PLD + pn * BM + cl;
#pragma unroll
                for (int bj = 0; bj < 2; ++bj) { f32x4 v0 = acc[ai][bj][m][0], v1 = acc[ai][bj][m][1];
                    if (mode == 1) {
#pragma unroll
                        for (int i = 0; i < 4; ++i) { v0[i] = gelu_tanh(v0[i]); v1[i] = gelu_tanh(v1[i]); }
                    } else if (mode == 2) {
#pragma unroll
                        for (int i = 0; i < 4; ++i) { v0[i] = sigmoidf_(v0[i]); v1[i] = sigmoidf_(v1[i]); }
                    }
                    *(u32x4*)(rowp + bj * HALF) = pack8(v0, v1); } }
    }
};
struct EpiBrA {
    static constexpr bool PERM = true;
    bf16_t* P;
    __device__ __forceinline__ void operator()(const f32x4 (&acc)[2][2][4][2], const Unit& u, int wr, int wc, int fr, int fq) const {
        const int row0 = u.pm * BM + wr * 64 + fr; const int c0 = u.pn * BM + wc * 32 + 8 * fq;
#pragma unroll
        for (int ai = 0; ai < 2; ++ai)
#pragma unroll
            for (int m = 0; m < 4; ++m) { bf16_t* rowp = P + (size_t)(row0 + ai * HALF + m * 16) * PLD;
#pragma unroll
                for (int bj = 0; bj < 2; ++bj) { const int c = c0 + bj * HALF; f32x4 g0, g1; unpack8(*(const u32x4*)(rowp + PC_GA + c), g0, g1);
                    *(u32x4*)(rowp + PC_MRG + c) = pack8(acc[ai][bj][m][0] * g0, acc[ai][bj][m][1] * g1); } }
    }
};
struct EpiBrB {
    static constexpr bool PERM = true;
    bf16_t* P;
    __device__ __forceinline__ void operator()(const f32x4 (&acc)[2][2][4][2], const Unit& u, int wr, int wc, int fr, int fq) const {
        const int row0 = u.pm * BM + wr * 64 + fr; const int c0 = u.pn * BM + wc * 32 + 8 * fq;
#pragma unroll
        for (int ai = 0; ai < 2; ++ai)
#pragma unroll
            for (int m = 0; m < 4; ++m) { bf16_t* rowp = P + (size_t)(row0 + ai * HALF + m * 16) * PLD;
#pragma unroll
                for (int bj = 0; bj < 2; ++bj) { const int c = c0 + bj * HALF; f32x4 g0, g1, p0, p1; unpack8(*(const u32x4*)(rowp + PC_GB + c), g0, g1); unpack8(*(const u32x4*)(rowp + PC_MRG + c), p0, p1);
                    *(u32x4*)(rowp + PC_MRG + c) = pack8(p0 + acc[ai][bj][m][0] * g0, p1 + acc[ai][bj][m][1] * g1); } }
    }
};
struct EpiOut {
    static constexpr bool PERM = true;
    const float* X; float* O;
    __device__ __forceinline__ void operator()(const f32x4 (&acc)[2][2][4][2], const Unit& u, int wr, int wc, int fr, int fq) const {
        const int row0 = u.pm * BM + wr * 64 + fr; const int c0 = u.pn * BM + wc * 32 + 8 * fq;
#pragma unroll
        for (int ai = 0; ai < 2; ++ai)
#pragma unroll
            for (int m = 0; m < 4; ++m) { const size_t ro = (size_t)(row0 + ai * HALF + m * 16) * D;
#pragma unroll
                for (int bj = 0; bj < 2; ++bj) { const int c = c0 + bj * HALF;
                    const f32x4 x0 = *(const f32x4*)(X + ro + c), x1 = *(const f32x4*)(X + ro + c + 4);
                    *(f32x4*)(O + ro + c) = x0 + acc[ai][bj][m][0]; *(f32x4*)(O + ro + c + 4) = x1 + acc[ai][bj][m][1]; } }
    }
};
struct EpiScores {
    static constexpr bool PERM = true;
    bf16_t* SC;
    __device__ __forceinline__ void operator()(const f32x4 (&acc)[2][2][4][2], const Unit& u, int wr, int wc, int fr, int fq) const {
        const int tb0 = u.pm * 16 + wr * 4; const int cq0 = (u.pn * BM + wc * 32 + 8 * fq) >> 3;
#pragma unroll
        for (int ai = 0; ai < 2; ++ai)
#pragma unroll
            for (int m = 0; m < 4; ++m) { bf16_t* bp = SC + ((size_t)(tb0 + ai * 8 + m) * 256) * 128 + fr * 8;
#pragma unroll
                for (int bj = 0; bj < 2; ++bj) *(u32x4*)(bp + (size_t)(cq0 + bj * 16) * 128) = pack8(acc[ai][bj][m][0], acc[ai][bj][m][1]); }
    }
};
}

#define XB_TMO      128
#define XB_XCNT(j)  (256  + 64 * (j))
#define XB_XSUB(j)  (1280 + 64 * (j))
#define XB_XGEN(j)  (2304 + 64 * (j))
#define XB_TOP      3328
#define XB_TOPGEN   3392
#define XCD_BAR_WORDS 3456
#define XB_SPIN_CAP (1u << 18)
__device__ __forceinline__ unsigned xb_ld(unsigned* p)              { return __hip_atomic_load(p, __ATOMIC_RELAXED, __HIP_MEMORY_SCOPE_AGENT); }
__device__ __forceinline__ unsigned xb_add(unsigned* p, unsigned v) { return __hip_atomic_fetch_add(p, v, __ATOMIC_RELAXED, __HIP_MEMORY_SCOPE_AGENT); }
__device__ __forceinline__ unsigned xb_xcc_id() { return (unsigned)__builtin_amdgcn_s_getreg((3 << 11) | 20) & 0xFu; }
#define XB_SPIN(cond, bar) do { unsigned _sp = 0; while (cond) { __builtin_amdgcn_s_sleep(1); \
    if ((++_sp & 255u) == 0u) { if (xb_ld(&(bar)[XB_TMO])) break; if (_sp > XB_SPIN_CAP) { atomicAdd(&(bar)[XB_TMO], 1u); break; } } } } while (0)
struct XcdBarrier { unsigned* bar; unsigned x; volatile LAS unsigned* st; int wave; };
__device__ __forceinline__ XcdBarrier xcd_barrier_post(unsigned* bar, volatile LAS unsigned* st, int wave) {
    XcdBarrier b; b.bar = bar; b.x = xb_xcc_id(); b.st = st; b.wave = wave;
    if (wave == 0 && lane_now() == 0) (void)xb_add(&bar[XB_XCNT(b.x)], 1u);
    return b;
}
__device__ __forceinline__ void xcd_barrier_complete(unsigned* bar, unsigned x, unsigned& nloc, unsigned& nx) {
    const unsigned G = gridDim.x * gridDim.y * gridDim.z;
    unsigned sum, cnt, mine, sp = 0u;
    for (;;) {
        sum = 0u; cnt = 0u; mine = 0u;
#pragma unroll
        for (unsigned j = 0; j < 16; ++j) { const unsigned c = xb_ld(&bar[XB_XCNT(j)]); sum += c; cnt += (c > 0u) ? 1u : 0u; mine = (j == x) ? c : mine; }
        if (sum == G) break;
        __builtin_amdgcn_s_sleep(1);
        if ((++sp & 255u) == 0u) { if (xb_ld(&bar[XB_TMO])) break; if (sp > XB_SPIN_CAP) { atomicAdd(&bar[XB_TMO], 1u); break; } }
    }
    nloc = mine > 0u ? mine : 1u; nx = cnt > 0u ? cnt : 1u;
}
__device__ __forceinline__ void xcd_barrier(const XcdBarrier& b) {
    asm volatile("s_waitcnt vmcnt(0)" ::: "memory");
    __syncthreads();
    if (b.wave == 0 && lane_now() == 0) {
        unsigned* bar = b.bar;
        __builtin_amdgcn_s_waitcnt(0);
        unsigned nloc = b.st[0], nx = b.st[1];
        if (nloc == 0u) { xcd_barrier_complete(bar, b.x, nloc, nx); b.st[0] = nloc; b.st[1] = nx; }
        const unsigned old = xb_add(&bar[XB_XSUB(b.x)], 1u);
        const unsigned gen = old / nloc;
        if (old + 1u == (gen + 1u) * nloc) {
            __builtin_amdgcn_fence(__ATOMIC_RELEASE, "agent");
            asm volatile("s_waitcnt vmcnt(0)" ::: "memory");
            const unsigned og = xb_add(&bar[XB_TOP], 1u);
            const unsigned tg = og / nx;
            if (og + 1u == (tg + 1u) * nx) xb_add(&bar[XB_TOPGEN], 1u);
            else XB_SPIN(xb_ld(&bar[XB_TOPGEN]) == tg, bar);
            __builtin_amdgcn_fence(__ATOMIC_ACQUIRE, "agent");
            xb_add(&bar[XB_XGEN(b.x)], 1u);
            asm volatile("s_waitcnt vmcnt(0)" ::: "memory");
        } else {
            XB_SPIN(xb_ld(&bar[XB_XGEN(b.x)]) == gen, bar);
            __builtin_amdgcn_fence(__ATOMIC_ACQUIRE, "agent");
            asm volatile("s_waitcnt vmcnt(0)" ::: "memory");
        }
    }
    __syncthreads();
}

struct Args {
    const float* in[20]; float* out; unsigned char* ws; int ph_lo, ph_hi, li, pad;
};
enum { I_X = 0, I_N1G, I_WIN, I_WGU, I_BG, I_GLAG, I_SLNG, I_SLNB, I_SW, I_SB, I_WBA, I_WBB, I_WOUT, I_N2G, I_WQ, I_K1, I_K2, I_PU, I_PV, I_FG };

struct Frame {
    LAS unsigned char* lds;
    int tid, lane, wave, G, bid;
};

__device__ __forceinline__ float clamp448(float v) { return __builtin_amdgcn_fmed3f(v, -448.f, 448.f); }
template <int MODE, bool F8 = false>
__device__ __forceinline__ void p0_transpose_item(const float* W, int K, int Nsrc, int Ndst, bf16_t* WT, LAS float* scr, int item, int lane, float sc8 = 1.f) {
    const int nblk = Ndst / 32, kb = item / nblk, nb = item % nblk, k0 = 64 * kb, n0 = 32 * nb;
    const int nd = n0 + (lane & 31);
    int sc = nd; bool valid = true;
    if (MODE == 1) { if (nd < 2048) sc = nd; else if (nd < 2560) sc = nd + 16; else if (nd < 2576) sc = 2048 + (nd - 2560); else if (nd < 2816) { sc = 0; valid = false; } else sc = nd - 240; }
#pragma unroll 8
    for (int i = 0; i < 32; ++i) { const int kk = 2 * i + (lane >> 5); const float v = valid ? W[(size_t)(k0 + kk) * Nsrc + sc] : 0.f; scr[kk * 33 + (lane & 31)] = v; }
    LDS_WAIT(); asm volatile("" ::: "memory");
    if (F8) {
        const int c = lane & 3;
#pragma unroll
        for (int j = 0; j < 2; ++j) { const int n = (lane >> 2) + 16 * j; const LAS float* s = scr + (16 * c) * 33 + n; u32x4 o;
#pragma unroll
            for (int q = 0; q < 4; ++q) { int w = 0; w = __builtin_amdgcn_cvt_pk_fp8_f32(clamp448(s[(4 * q) * 33] * sc8), clamp448(s[(4 * q + 1) * 33] * sc8), w, false);
                w = __builtin_amdgcn_cvt_pk_fp8_f32(clamp448(s[(4 * q + 2) * 33] * sc8), clamp448(s[(4 * q + 3) * 33] * sc8), w, true); o[q] = (unsigned)w; }
            *(u32x4*)((unsigned char*)WT + (size_t)(n0 + n) * K + k0 + 16 * c) = o; }
    } else {
    const int c = lane & 7;
#pragma unroll
    for (int j = 0; j < 4; ++j) { const int n = (lane >> 3) + 8 * j; const LAS float* s = scr + (8 * c) * 33 + n;
        u32x4 o; o.x = pk2(s[0 * 33], s[1 * 33]); o.y = pk2(s[2 * 33], s[3 * 33]); o.z = pk2(s[4 * 33], s[5 * 33]); o.w = pk2(s[6 * 33], s[7 * 33]);
        *(u32x4*)(WT + (size_t)(n0 + n) * K + k0 + 8 * c) = o; }
    }
    LDS_WAIT(); asm volatile("" ::: "memory");
}
template <int OM, int NB>
__device__ __forceinline__ void rms_rows_to_bf16(int lane, const float* x0, size_t xstride, const float* g, bf16_t* o0, size_t ostride, unsigned* o80 = nullptr, size_t o8stride = 0) {
    f32x4 v[NB][4]; float s[NB];
#pragma unroll
    for (int b = 0; b < NB; ++b) { const f32x4* xr = (const f32x4*)(x0 + b * xstride) + lane;
#pragma unroll
        for (int j = 0; j < 4; ++j) v[b][j] = xr[64 * j]; }
#pragma unroll
    for (int b = 0; b < NB; ++b) { s[b] = 0.f;
#pragma unroll
        for (int j = 0; j < 4; ++j) s[b] += (v[b][j].x * v[b][j].x + v[b][j].y * v[b][j].y) + (v[b][j].z * v[b][j].z + v[b][j].w * v[b][j].w); }
#pragma unroll
    for (int o = 1; o < 64; o <<= 1) {
#pragma unroll
        for (int b = 0; b < NB; ++b) s[b] += __shfl_xor(s[b], o); }
    const f32x4* gr = (const f32x4*)g + lane;
#pragma unroll
    for (int b = 0; b < NB; ++b) { const float rstd = 1.f / sqrtf(s[b] * (1.f / D) + EPS); u32x2* o8 = (u32x2*)(o0 + b * ostride) + lane;
#pragma unroll
        for (int j = 0; j < 4; ++j) { const f32x4 gg = gr[64 * j]; const f32x4 y = v[b][j] * rstd * gg; u32x2 o; o.x = pk2(y.x, y.y); o.y = pk2(y.z, y.w); if (OM & 1) o8[64 * j] = o;
            if (OM == 3) { int w = 0; w = __builtin_amdgcn_cvt_pk_fp8_f32(clamp448(bflo(o.x) * 16.f), clamp448(bfhi(o.x) * 16.f), w, false); w = __builtin_amdgcn_cvt_pk_fp8_f32(clamp448(bflo(o.y) * 16.f), clamp448(bfhi(o.y) * 16.f), w, true); (o80 + b * o8stride)[64 * j + lane] = (unsigned)w; }
            if (OM == 2) { int w = 0; w = __builtin_amdgcn_cvt_pk_fp8_f32(clamp448(y.x * 16.f), clamp448(y.y * 16.f), w, false); w = __builtin_amdgcn_cvt_pk_fp8_f32(clamp448(y.z * 16.f), clamp448(y.w * 16.f), w, true); (o80 + b * o8stride)[64 * j + lane] = (unsigned)w; } } }
}
__device__ __forceinline__ float wave_max(float v) {
#pragma unroll
    for (int o = 1; o < 64; o <<= 1) v = fmaxf(v, __shfl_xor(v, o));
    return v;
}
template <int NB>
__device__ __forceinline__ void cvt_rows_fp8(int lane, const float* const (&src)[NB], unsigned char* const (&dst16)[NB], float* const (&scale_out)[NB]) {
    f32x4 v[NB][4]; float m[NB];
#pragma unroll
    for (int b = 0; b < NB; ++b) {
#pragma unroll
        for (int j = 0; j < 4; ++j) v[b][j] = *(const GAS f32x4*)(src[b] + 16 * lane + 4 * j); }
#pragma unroll
    for (int b = 0; b < NB; ++b) { m[b] = 0.f;
#pragma unroll
        for (int j = 0; j < 4; ++j) m[b] = fmaxf(m[b], fmaxf(fmaxf(fabsf(v[b][j].x), fabsf(v[b][j].y)), fmaxf(fabsf(v[b][j].z), fabsf(v[b][j].w)))); }
#pragma unroll
    for (int o = 1; o < 64; o <<= 1) {
#pragma unroll
        for (int b = 0; b < NB; ++b) m[b] = fmaxf(m[b], __shfl_xor(m[b], o)); }
#pragma unroll
    for (int b = 0; b < NB; ++b) { const float inv = m[b] > 0.f ? 224.f / m[b] : 0.f, sc = m[b] > 0.f ? m[b] * (1.f / 224.f) : 1.f;
        u32x4 o;
#pragma unroll
        for (int j = 0; j < 4; ++j) { int w = 0; w = __builtin_amdgcn_cvt_pk_fp8_f32(v[b][j].x * inv, v[b][j].y * inv, w, false); w = __builtin_amdgcn_cvt_pk_fp8_f32(v[b][j].z * inv, v[b][j].w * inv, w, true); o[j] = (unsigned)w; }
        *(GAS u32x4*)dst16[b] = o;
        if (lane == 0) *(GAS float*)scale_out[b] = sc; }
}
__device__ __forceinline__ unsigned fp4_code(float t) { const float a = fabsf(t);
    const unsigned c = (unsigned)(a >= 0.25f) + (unsigned)(a >= 0.75f) + (unsigned)(a >= 1.25f) + (unsigned)(a >= 1.75f) + (unsigned)(a >= 2.5f) + (unsigned)(a >= 3.5f) + (unsigned)(a >= 5.f);
    return c | (t < 0.f ? 8u : 0u); }
template <int NB>
__device__ __forceinline__ void cvt_rows_fp4(int lane, const float* const (&src)[NB], unsigned char* const (&dst8)[NB], float* const (&scale_out)[NB]) {
    f32x4 v[NB][4]; float m[NB];
#pragma unroll
    for (int b = 0; b < NB; ++b) {
#pragma unroll
        for (int j = 0; j < 4; ++j) v[b][j] = *(const GAS f32x4*)(src[b] + 16 * lane + 4 * j); }
#pragma unroll
    for (int b = 0; b < NB; ++b) { m[b] = 0.f;
#pragma unroll
        for (int j = 0; j < 4; ++j) m[b] = fmaxf(m[b], fmaxf(fmaxf(fabsf(v[b][j].x), fabsf(v[b][j].y)), fmaxf(fabsf(v[b][j].z), fabsf(v[b][j].w)))); }
#pragma unroll
    for (int o = 1; o < 64; o <<= 1) {
#pragma unroll
        for (int b = 0; b < NB; ++b) m[b] = fmaxf(m[b], __shfl_xor(m[b], o)); }
#pragma unroll
    for (int b = 0; b < NB; ++b) { const float inv = m[b] > 0.f ? 6.f / m[b] : 0.f, sc = m[b] > 0.f ? m[b] * (1.f / 6.f) : 1.f;
        u32x2 o;
#pragma unroll
        for (int h = 0; h < 2; ++h) { unsigned w = 0;
#pragma unroll
            for (int j = 0; j < 2; ++j) { const f32x4 t = v[b][2 * h + j] * inv;
                w |= (fp4_code(t.x) | (fp4_code(t.y) << 4) | (fp4_code(t.z) << 8) | (fp4_code(t.w) << 12)) << (16 * j); }
            o[h] = w; }
        *(GAS u32x2*)dst8[b] = o;
        if (lane == 0) *(GAS float*)scale_out[b] = sc; }
}
__device__ __forceinline__ void convert_tables(const Frame& F, const Args& A, int wi, int nw) {
    unsigned char* ws = A.ws; const int gw = wi, NGW = nw;
    {
        int mc = gw;
        for (; mc + 3 * NGW < NEXP; mc += 4 * NGW) { const float* src[4]; unsigned char* dst[4]; float* sco[4];
#pragma unroll
            for (int b = 0; b < 4; ++b) { const int e = mc + b * NGW; src[b] = A.in[I_PU] + (size_t)e * D; dst[b] = ws + WS_U8 + (size_t)((e & (UNG - 1)) * (NEXP / UNG) + (e >> UNG_SH)) * 512 + 8 * F.lane; sco[b] = (float*)(ws + WS_SU) + e; }
            cvt_rows_fp4<4>(F.lane, src, dst, sco); }
        for (; mc < NEXP; mc += NGW) { const float* src[1]; unsigned char* dst[1]; float* sco[1];
            const int e = mc; src[0] = A.in[I_PU] + (size_t)e * D; dst[0] = ws + WS_U8 + (size_t)((e & (UNG - 1)) * (NEXP / UNG) + (e >> UNG_SH)) * 512 + 8 * F.lane; sco[0] = (float*)(ws + WS_SU) + e;
            cvt_rows_fp4<1>(F.lane, src, dst, sco); }
    }
    if (V_F4) {
        int mc = gw;
        for (; mc + 3 * NGW < NEXP; mc += 4 * NGW) { const float* src[4]; unsigned char* dst[4]; float* sco[4];
#pragma unroll
            for (int b = 0; b < 4; ++b) { const int e = mc + b * NGW; src[b] = A.in[I_PV] + (size_t)e * D; dst[b] = ws + WS_V8 + (size_t)e * 512 + 8 * F.lane; sco[b] = (float*)(ws + WS_SV) + e; }
            cvt_rows_fp4<4>(F.lane, src, dst, sco); }
        for (; mc < NEXP; mc += NGW) { const float* src[1]; unsigned char* dst[1]; float* sco[1];
            const int e = mc; src[0] = A.in[I_PV] + (size_t)e * D; dst[0] = ws + WS_V8 + (size_t)e * 512 + 8 * F.lane; sco[0] = (float*)(ws + WS_SV) + e;
            cvt_rows_fp4<1>(F.lane, src, dst, sco); }
    } else {
        int mc = gw;
        for (; mc + 3 * NGW < NEXP; mc += 4 * NGW) { const float* src[4]; unsigned char* dst[4]; float* sco[4];
#pragma unroll
            for (int b = 0; b < 4; ++b) { const int e = mc + b * NGW; src[b] = A.in[I_PV] + (size_t)e * D; dst[b] = ws + WS_V8 + ((size_t)(F.lane >> 3) * NEXP + e) * 128 + 16 * (F.lane & 7); sco[b] = (float*)(ws + WS_SV) + e; }
            cvt_rows_fp8<4>(F.lane, src, dst, sco); }
        for (; mc < NEXP; mc += NGW) { const float* src[1]; unsigned char* dst[1]; float* sco[1];
            const int e = mc; src[0] = A.in[I_PV] + (size_t)e * D; dst[0] = ws + WS_V8 + ((size_t)(F.lane >> 3) * NEXP + e) * 128 + 16 * (F.lane & 7); sco[0] = (float*)(ws + WS_SV) + e;
            cvt_rows_fp8<1>(F.lane, src, dst, sco); }
    }
}
__device__ __forceinline__ void phase0(const Frame& F, const Args& A) {
    unsigned char* ws = A.ws;
    {
        LAS float* kx = (LAS float*)F.lds;
        LAS float* wt = (LAS float*)(F.lds + 128 * 129 * 4);
        bf16_t* WQF = (bf16_t*)(ws + WS_WQF);
        for (int it = F.bid; it < 512; it += F.G) {
            const int hh = it >> 5, kblk = it & 31, k0 = kblk * 32;
            const float* kX = (hh & 1) ? A.in[I_K2] : A.in[I_K1];
            __syncthreads();
            for (int e = F.tid; e < 128 * 128; e += 512) kx[(e >> 7) * 129 + (e & 127)] = kX[e];
            for (int e = F.tid; e < 32 * 128; e += 512) wt[e] = A.in[I_WQ][(size_t)(k0 + (e >> 7)) * 2048 + hh * 128 + (e & 127)];
            __syncthreads();
            const int key = F.tid & 127, kq = F.tid >> 7;
            float acc[8];
#pragma unroll
            for (int i = 0; i < 8; ++i) acc[i] = 0.f;
            for (int d = 0; d < 128; ++d) { const float b = kx[key * 129 + d];
#pragma unroll
                for (int i = 0; i < 8; ++i) acc[i] += wt[(kq * 8 + i) * 128 + d] * b; }
            if (SC_F8) { u32x2 o;
#pragma unroll
                for (int h2 = 0; h2 < 2; ++h2) { int w = 0; w = __builtin_amdgcn_cvt_pk_fp8_f32(clamp448(acc[4 * h2] * 1024.f), clamp448(acc[4 * h2 + 1] * 1024.f), w, false);
                    w = __builtin_amdgcn_cvt_pk_fp8_f32(clamp448(acc[4 * h2 + 2] * 1024.f), clamp448(acc[4 * h2 + 3] * 1024.f), w, true); o[h2] = (unsigned)w; }
                *(u32x2*)((unsigned char*)WQF + (size_t)(hh * 128 + key) * 1024 + k0 + kq * 8) = o;
            } else {
            u32x4 o; o.x = pk2(acc[0], acc[1]); o.y = pk2(acc[2], acc[3]); o.z = pk2(acc[4], acc[5]); o.w = pk2(acc[6], acc[7]);
            *(u32x4*)(WQF + (size_t)(hh * 128 + key) * 1024 + k0 + kq * 8) = o; }
        }
        __syncthreads();
    }
    LAS float* scr = (LAS float*)(F.lds + F.wave * 16384);
    const int gw = F.bid * NWAVES + F.wave, NGW = F.G * NWAVES;
    constexpr int I_IN = 16 * (NPROJ / 32), I_A = 8 * 32, I_B = 8 * 32, I_O = 16 * 32;
    constexpr int NITEMS = I_IN + I_A + I_B + I_O;
    for (int it = gw; it < NITEMS; it += NGW) {
        int r = it;
        if (r < I_IN) { if ((r % (NPROJ / 32)) * 32 >= F8_LO * 256) p0_transpose_item<1, true>(A.in[I_WIN], 1024, 5136, NPROJ, (bf16_t*)(ws + WS_W8), scr, r, F.lane, 1024.f);
                        else p0_transpose_item<1, false>(A.in[I_WIN], 1024, 5136, NPROJ, (bf16_t*)(ws + WS_WIN), scr, r, F.lane); continue; } r -= I_IN;
        if (r < I_A) { p0_transpose_item<0>(A.in[I_WBA], 512, 1024, 1024, (bf16_t*)(ws + WS_WA), scr, r, F.lane); continue; } r -= I_A;
        if (r < I_B) { p0_transpose_item<0>(A.in[I_WBB], 512, 1024, 1024, (bf16_t*)(ws + WS_WB), scr, r, F.lane); continue; } r -= I_B;
        p0_transpose_item<0>(A.in[I_WOUT], 1024, 1024, 1024, (bf16_t*)(ws + WS_WOUT), scr, r, F.lane);
    }
    constexpr int OM1 = F8_LO <= 0 ? 2 : (F8_LO >= 21 ? 1 : 3);
    { int m = gw; for (; m + 3 * NGW < T_TOK; m += 4 * NGW) rms_rows_to_bf16<OM1, 4>(F.lane, A.in[I_X] + (size_t)m * D, (size_t)NGW * D, A.in[I_N1G], (bf16_t*)(ws + WS_N1) + (size_t)m * D, (size_t)NGW * D, (unsigned*)(ws + WS_N18) + (size_t)m * 256, (size_t)NGW * 256);
      for (; m < T_TOK; m += NGW) rms_rows_to_bf16<OM1, 1>(F.lane, A.in[I_X] + (size_t)m * D, 0, A.in[I_N1G], (bf16_t*)(ws + WS_N1) + (size_t)m * D, 0, (unsigned*)(ws + WS_N18) + (size_t)m * 256, 0); }
}

__device__ __forceinline__ float log_sigmoid(float z) { return fminf(z, 0.f) - log1pf(__expf(-fabsf(z))); }

template <bool DRY>
__device__ __forceinline__ void gla_chunk_phase(const Frame& F, const Args& A) {
    unsigned char* ws = A.ws;
    const bf16_t* P = (const bf16_t*)(ws + WS_P);
    const float* ALR = (const float*)(ws + WS_ALR);
    LAS float* alr = (LAS float*)F.lds;
    LAS float* tot = (LAS float*)(F.lds + 4096);
    LAS bf16_t* kdT = (LAS bf16_t*)(F.lds + 8192);
    LAS bf16_t* vT = (LAS bf16_t*)(F.lds + 26624);
    LAS bf16_t* stT = (LAS bf16_t*)(F.lds + 45056);
    const int tid = F.tid, kk = tid & 127, seg = tid >> 7;
    const bool hconst = (F.G & 3) == 0;
    int hcur = -1; float w[16]; float bias = 0.f;
#pragma unroll
    for (int j = 0; j < 16; ++j) w[j] = 0.f;
    float na0, na1; bf16_t nk[16], nv[16];
#define GC_LOAD(unit) do { const int h_ = (unit) & 3, c_ = ((unit) >> 2) & 63, b_ = (unit) >> 8; const int t0_ = b_ * SEQ + c_ * 64; \
        na0 = ALR[(size_t)t0_ * 16 + tid]; na1 = ALR[(size_t)t0_ * 16 + 512 + tid]; \
        const bf16_t* kp_ = P + (size_t)(t0_ + 16 * seg) * PLD + PC_K + h_ * 128 + kk; const bf16_t* vp_ = P + (size_t)(t0_ + 16 * seg) * PLD + PC_V + h_ * 128 + kk; \
        _Pragma("unroll") for (int i_ = 0; i_ < 16; ++i_) { nk[i_] = kp_[(size_t)i_ * PLD]; nv[i_] = vp_[(size_t)i_ * PLD]; } } while (0)
    int unit = F.bid;
    if (unit < 2048) GC_LOAD(unit);
    for (; unit < 2048; unit += F.G) {
        const int h = unit & 3;
        if (h != hcur) { hcur = h;
#pragma unroll
            for (int j = 0; j < 16; ++j) w[j] = A.in[I_WGU][(size_t)j * 512 + h * 128 + kk];
            bias = A.in[I_BG][h * 128 + kk]; }
        __syncthreads();
        alr[tid] = na0; alr[512 + tid] = na1;
        bf16_t kr[16], vr[16];
#pragma unroll
        for (int i = 0; i < 16; ++i) { kr[i] = nk[i]; vr[i] = nv[i]; }
        if (unit + F.G < 2048) GC_LOAD(unit + F.G);
        __syncthreads();
        float cum[16]; float run = 0.f;
#pragma unroll
        for (int i = 0; i < 16; ++i) { const LAS f32x4* ap = (const LAS f32x4*)(alr + (16 * seg + i) * 16); float z = bias;
#pragma unroll
            for (int q = 0; q < 4; ++q) { const f32x4 a4 = ap[q]; z += a4.x * w[4 * q] + a4.y * w[4 * q + 1] + a4.z * w[4 * q + 2] + a4.w * w[4 * q + 3]; }
            const float ls = fminf(z, 0.f) - __logf(1.f + __expf(-fabsf(z)));
            run += ls * (1.f / 16.f); cum[i] = run; }
        tot[seg * 128 + kk] = run;
        __syncthreads();
        {
            const float t0s = tot[kk], t1s = tot[128 + kk], t2s = tot[256 + kk], t3s = tot[384 + kk];
            const float total = (t0s + t1s) + (t2s + t3s);
            const float prefix = seg == 0 ? 0.f : (seg == 1 ? t0s : (seg == 2 ? t0s + t1s : t0s + t1s + t2s));
            unsigned kw[8], vw[8];
#pragma unroll
            for (int i = 0; i < 8; ++i) {
                const float e0 = __expf(total - (prefix + cum[2 * i])), e1 = __expf(total - (prefix + cum[2 * i + 1]));
                kw[i] = pk2(bf1(kr[2 * i]) * e0, bf1(kr[2 * i + 1]) * e1); vw[i] = (unsigned)vr[2 * i] | ((unsigned)vr[2 * i + 1] << 16);
            }
            *(LAS u32x4*)(kdT + kk * 72 + 16 * seg) = (u32x4){kw[0], kw[1], kw[2], kw[3]}; *(LAS u32x4*)(kdT + kk * 72 + 16 * seg + 8) = (u32x4){kw[4], kw[5], kw[6], kw[7]};
            *(LAS u32x4*)(vT + kk * 72 + 16 * seg) = (u32x4){vw[0], vw[1], vw[2], vw[3]}; *(LAS u32x4*)(vT + kk * 72 + 16 * seg + 8) = (u32x4){vw[4], vw[5], vw[6], vw[7]};
            if (seg == 0) ((float*)(DRY ? (unsigned char*)A.out + 96 * MiB : ws + WS_DEC))[(size_t)unit * 128 + kk] = __expf(total);
        }
        __syncthreads();
        {
            const int w8 = F.wave, l = F.lane, fr = l & 15, fq = l >> 4;
            f32x4 acc[8];
#pragma unroll
            for (int n = 0; n < 8; ++n) acc[n] = (f32x4){0.f, 0.f, 0.f, 0.f};
#pragma unroll
            for (int ks = 0; ks < 2; ++ks) {
                const bf16x8 a = *(const LAS bf16x8*)(kdT + (16 * w8 + fr) * 72 + 32 * ks + 8 * fq);
#pragma unroll
                for (int n = 0; n < 8; ++n) { const bf16x8 bb = *(const LAS bf16x8*)(vT + (16 * n + fr) * 72 + 32 * ks + 8 * fq);
                    acc[n] = __builtin_amdgcn_mfma_f32_16x16x32_bf16(a, bb, acc[n], 0, 0, 0); }
            }
#pragma unroll
            for (int n = 0; n < 8; ++n) { u32x2 o; o.x = pk2(acc[n][0], acc[n][1]); o.y = pk2(acc[n][2], acc[n][3]);
                *(LAS u32x2*)(stT + (16 * n + fr) * 136 + 16 * w8 + 4 * fq) = o; }
        }
        __syncthreads();
        {
            bf16_t* ST = (bf16_t*)(DRY ? (unsigned char*)A.out : ws + WS_N1) + (size_t)unit * 16384;
            const int vv = tid >> 2, part = tid & 3;
#pragma unroll
            for (int q = 0; q < 4; ++q) *(u32x4*)(ST + (size_t)vv * 128 + 32 * part + 8 * q) = *(const LAS u32x4*)(stT + vv * 136 + 32 * part + 8 * q);
        }
    }
#undef GC_LOAD
    (void)hconst;
}

template <bool DRY>
__device__ __forceinline__ void sgu_unit(const Frame& F, const Args& A, int unit) {
    const int g = unit & 3, blk = (unit >> 2) & 31, b = unit >> 7;
    const int t0 = b * SEQ + blk * 128;
    bf16_t* P = (bf16_t*)(A.ws + WS_P);
    LAS bf16_t* wA = (LAS bf16_t*)F.lds;
    LAS bf16_t* vnT = (LAS bf16_t*)(F.lds + 34816);
    LAS float* st = (LAS float*)(F.lds + 69632);
    LAS bf16_t* suS = (LAS bf16_t*)(F.lds + 70656);
    const int tid = F.tid;
    __syncthreads();
    {
        const int j = tid >> 2, q = tid & 3;
        const bf16_t* sp = P + (size_t)(t0 + j) * PLD + PC_SV + q * 128;
        float s = 0.f, s2 = 0.f;
#pragma unroll
        for (int i = 0; i < 16; ++i) { const u32x4 w = *(const u32x4*)(sp + 8 * i);
            const float f[8] = {bflo(w.x), bfhi(w.x), bflo(w.y), bfhi(w.y), bflo(w.z), bfhi(w.z), bflo(w.w), bfhi(w.w)};
#pragma unroll
            for (int e = 0; e < 8; ++e) { s += f[e]; s2 += f[e] * f[e]; } }
        s += __shfl_xor(s, 1); s += __shfl_xor(s, 2); s2 += __shfl_xor(s2, 1); s2 += __shfl_xor(s2, 2);
        const float mu = s * (1.f / 512.f); const float var = fmaxf(s2 * (1.f / 512.f) - mu * mu, 0.f);
        if (q == 0) { st[2 * j] = mu; st[2 * j + 1] = 1.f / sqrtf(var + EPS); }
    }
    {
        const int i = tid >> 2, jb = (tid & 3) * 32;
        const float* wp = A.in[I_SW] + (size_t)g * 16384 + (size_t)i * 128 + jb;
        const bf16_t* sup = P + (size_t)(t0 + i) * PLD + PC_SU + g * 128 + jb;
#pragma unroll
        for (int q = 0; q < 4; ++q) { const f32x4 a = *(const f32x4*)(wp + 8 * q), bq = *(const f32x4*)(wp + 8 * q + 4);
            const bool z = (i < 64) && (jb + 8 * q >= 64);
            u32x4 o; o.x = pk2(a.x, a.y); o.y = pk2(a.z, a.w); o.z = pk2(bq.x, bq.y); o.w = pk2(bq.z, bq.w);
            if (z) o = (u32x4){0u, 0u, 0u, 0u};
            *(LAS u32x4*)(wA + i * 136 + jb + 8 * q) = o;
            *(LAS u32x4*)(suS + i * 136 + jb + 8 * q) = *(const u32x4*)(sup + 8 * q); }
    }
    const int cch = tid & 127, seg = tid >> 7;
    bf16_t xr[32];
    { const bf16_t* sp = P + (size_t)(t0 + 32 * seg) * PLD + PC_SV + g * 128 + cch;
#pragma unroll
      for (int i = 0; i < 32; ++i) xr[i] = sp[(size_t)i * PLD]; }
    const float lg = A.in[I_SLNG][g * 128 + cch], lb = A.in[I_SLNB][g * 128 + cch];
    __syncthreads();
    {
        unsigned ow[16];
#pragma unroll
        for (int i = 0; i < 16; ++i) { const int j = 32 * seg + 2 * i; const f32x4 ms = *(const LAS f32x4*)(st + 2 * j);
            ow[i] = pk2((bf1(xr[2 * i]) - ms.x) * ms.y * lg + lb, (bf1(xr[2 * i + 1]) - ms.z) * ms.w * lg + lb); }
#pragma unroll
        for (int q = 0; q < 4; ++q) *(LAS u32x4*)(vnT + cch * 136 + 32 * seg + 8 * q) = (u32x4){ow[4 * q], ow[4 * q + 1], ow[4 * q + 2], ow[4 * q + 3]};
    }
    __syncthreads();
    {
        const int w = F.wave, l = F.lane, fr = l & 15, fq = l >> 4;
        f32x4 acc[8];
#pragma unroll
        for (int n = 0; n < 8; ++n) acc[n] = (f32x4){0.f, 0.f, 0.f, 0.f};
#pragma unroll
        for (int ks = 0; ks < 4; ++ks) {
            const bf16x8 a = *(const LAS bf16x8*)(wA + (16 * w + fr) * 136 + 32 * ks + 8 * fq);
#pragma unroll
            for (int n = 0; n < 8; ++n) { const bf16x8 bb = *(const LAS bf16x8*)(vnT + (16 * n + fr) * 136 + 32 * ks + 8 * fq);
                acc[n] = __builtin_amdgcn_mfma_f32_16x16x32_bf16(a, bb, acc[n], 0, 0, 0); }
        }
#pragma unroll
        for (int jj = 0; jj < 4; ++jj) { const int i = 16 * w + 4 * fq + jj; const float bias = A.in[I_SB][g * 128 + i];
            LAS bf16_t* rp = suS + i * 136 + fr;
#pragma unroll
            for (int n = 0; n < 8; ++n) { const float su = bf1(rp[16 * n]); rp[16 * n] = (bf16_t)f2bf(su * (acc[n][jj] + bias)); } }
    }
    __syncthreads();
    {
        const int i = tid >> 2, jb = (tid & 3) * 32;
        bf16_t* yp = DRY ? (bf16_t*)A.out + (size_t)(t0 + i) * 512 + g * 128 + jb : P + (size_t)(t0 + i) * PLD + PC_SU + g * 128 + jb;
#pragma unroll
        for (int q = 0; q < 4; ++q) *(u32x4*)(yp + 8 * q) = *(const LAS u32x4*)(suS + i * 136 + jb + 8 * q);
    }
}

template <bool DRY>
__device__ __forceinline__ void gla_scan(const Frame& F, const Args& A) {
    bf16_t* ST = (bf16_t*)(A.ws + WS_N1); bf16_t* STO = DRY ? (bf16_t*)A.out : ST; const float* DEC = (const float*)(A.ws + WS_DEC);
    for (int gi = F.bid * 512 + F.tid; gi < 131072; gi += F.G * 512) {
        const int k4 = gi & 31, vv = (gi >> 5) & 127, h = (gi >> 12) & 3, b = gi >> 14;
        float s0 = 0.f, s1 = 0.f, s2 = 0.f, s3 = 0.f;
        u32x2 wa[8], wb[8]; f32x4 da[8], db[8];
#define SCAN_LOAD(W, Dd, c0) do { _Pragma("unroll") for (int i_ = 0; i_ < 8; ++i_) { const size_t u_ = (size_t)((b * 64 + (c0) + i_) * 4 + h); \
            W[i_] = *(const u32x2*)(ST + u_ * 16384 + (size_t)vv * 128 + k4 * 4); Dd[i_] = *(const f32x4*)(DEC + u_ * 128 + k4 * 4); } } while (0)
#define SCAN_STEP(W, Dd, c0) do { _Pragma("unroll") for (int i_ = 0; i_ < 8; ++i_) { const size_t u_ = (size_t)((b * 64 + (c0) + i_) * 4 + h); \
            s0 = Dd[i_].x * s0 + bflo(W[i_].x); s1 = Dd[i_].y * s1 + bfhi(W[i_].x); s2 = Dd[i_].z * s2 + bflo(W[i_].y); s3 = Dd[i_].w * s3 + bfhi(W[i_].y); \
            u32x2 o_; o_.x = pk2(s0, s1); o_.y = pk2(s2, s3); *(u32x2*)(STO + u_ * 16384 + (size_t)vv * 128 + k4 * 4) = o_; } } while (0)
        SCAN_LOAD(wa, da, 0);
#pragma unroll
        for (int c0 = 0; c0 < 64; c0 += 16) {
            SCAN_LOAD(wb, db, c0 + 8);
            SCAN_STEP(wa, da, c0);
            if (c0 + 16 < 64) SCAN_LOAD(wa, da, c0 + 16);
            SCAN_STEP(wb, db, c0 + 8);
        }
#undef SCAN_LOAD
#undef SCAN_STEP
    }
}

template <bool DRY>
__device__ __forceinline__ void gla_out_phase(const Frame& F, const Args& A) {
    bf16_t* P = (bf16_t*)(A.ws + WS_P);
    LAS bf16_t* qA = (LAS bf16_t*)F.lds;
    LAS bf16_t* sB = (LAS bf16_t*)(F.lds + 17408);
    LAS float* oF = (LAS float*)(F.lds + 52224);
    const int tid = F.tid, s = tid >> 3, cb = (tid & 7) * 16, vv = tid >> 2, kb = (tid & 3) * 32;
    u32x4 nq0, nq1, ns0, ns1, ns2, ns3, nr0, nr1;
#define GO_LOAD(unit) do { const int h_ = (unit) & 3, c_ = ((unit) >> 2) & 63, b_ = (unit) >> 8; const int t0_ = b_ * SEQ + c_ * 64; \
        const bf16_t* qp_ = P + (size_t)(t0_ + s) * PLD + PC_Q + h_ * 128 + cb; nq0 = *(const u32x4*)qp_; nq1 = *(const u32x4*)(qp_ + 8); \
        const bf16_t* sp_ = (const bf16_t*)(A.ws + WS_N1) + (size_t)(unit) * 16384 + (size_t)vv * 128 + kb; ns0 = *(const u32x4*)sp_; ns1 = *(const u32x4*)(sp_ + 8); ns2 = *(const u32x4*)(sp_ + 16); ns3 = *(const u32x4*)(sp_ + 24); \
        const bf16_t* rp_ = P + (size_t)(t0_ + s) * PLD + PC_R + h_ * 128 + cb; nr0 = *(const u32x4*)rp_; nr1 = *(const u32x4*)(rp_ + 8); } while (0)
    int unit = F.bid;
    if (unit < 2048) GO_LOAD(unit);
    for (; unit < 2048; unit += F.G) {
        const int h = unit & 3, c = (unit >> 2) & 63, b = unit >> 8;
        const int t0 = b * SEQ + c * 64;
        __syncthreads();
        *(LAS u32x4*)(qA + s * 136 + cb) = nq0; *(LAS u32x4*)(qA + s * 136 + cb + 8) = nq1;
        *(LAS u32x4*)(sB + vv * 136 + kb) = ns0; *(LAS u32x4*)(sB + vv * 136 + kb + 8) = ns1; *(LAS u32x4*)(sB + vv * 136 + kb + 16) = ns2; *(LAS u32x4*)(sB + vv * 136 + kb + 24) = ns3;
        const u32x4 r0 = nr0, r1 = nr1;
        if (unit + F.G < 2048) GO_LOAD(unit + F.G);
        __syncthreads();
        {
            const int w = F.wave, l = F.lane, fr = l & 15, fq = l >> 4, m = w & 3, nh = w >> 2;
            f32x4 acc[4];
#pragma unroll
            for (int n = 0; n < 4; ++n) acc[n] = (f32x4){0.f, 0.f, 0.f, 0.f};
#pragma unroll
            for (int ks = 0; ks < 4; ++ks) {
                const bf16x8 a = *(const LAS bf16x8*)(qA + (16 * m + fr) * 136 + 32 * ks + 8 * fq);
#pragma unroll
                for (int n = 0; n < 4; ++n) { const bf16x8 bb = *(const LAS bf16x8*)(sB + (16 * (4 * nh + n) + fr) * 136 + 32 * ks + 8 * fq);
                    acc[n] = __builtin_amdgcn_mfma_f32_16x16x32_bf16(a, bb, acc[n], 0, 0, 0); }
            }
            const float scale = 0.08838834764831845f;
#pragma unroll
            for (int n = 0; n < 4; ++n)
#pragma unroll
                for (int jj = 0; jj < 4; ++jj) oF[(16 * m + 4 * fq + jj) * 132 + 16 * (4 * nh + n) + fr] = acc[n][jj] * scale;
        }
        __syncthreads();
        {
            float o[16]; float ss = 0.f;
#pragma unroll
            for (int i = 0; i < 16; ++i) { o[i] = oF[s * 132 + cb + i]; ss += o[i] * o[i]; }
            ss += __shfl_xor(ss, 1); ss += __shfl_xor(ss, 2); ss += __shfl_xor(ss, 4);
            const float rstd = 1.f / sqrtf(ss * (1.f / 128.f) + EPS);
            const unsigned rw[8] = {r0.x, r0.y, r0.z, r0.w, r1.x, r1.y, r1.z, r1.w};
            const float* gg = A.in[I_GLAG] + h * 128 + cb;
            unsigned ow[8];
#pragma unroll
            for (int i = 0; i < 8; ++i) { const float y0 = o[2 * i] * rstd * gg[2 * i] * siluf_(bflo(rw[i])), y1 = o[2 * i + 1] * rstd * gg[2 * i + 1] * siluf_(bfhi(rw[i])); ow[i] = pk2(y0, y1); }
            bf16_t* yp = DRY ? (bf16_t*)A.out + (size_t)(t0 + s) * 512 + h * 128 + cb : P + (size_t)(t0 + s) * PLD + PC_Q + h * 128 + cb;
            *(u32x4*)yp = (u32x4){ow[0], ow[1], ow[2], ow[3]}; *(u32x4*)(yp + 8) = (u32x4){ow[4], ow[5], ow[6], ow[7]};
        }
    }
#undef GO_LOAD
}

__device__ __forceinline__ unsigned ordkey(float v) { const unsigned u = __builtin_bit_cast(unsigned, v); return u ^ ((unsigned)((int)u >> 31) | 0x80000000u); }
__device__ __forceinline__ float unord(unsigned k) { const unsigned u = (k & 0x80000000u) ? (k & 0x7fffffffu) : ~k; return __builtin_bit_cast(float, u); }
#define INS16(r, xin) do { unsigned _x = (xin); _Pragma("unroll") for (int _i = 0; _i < 16; ++_i) { const unsigned _h = max((r)[_i], _x); _x = min((r)[_i], _x); (r)[_i] = _h; } } while (0)

#define CE(a, b) do { const unsigned _h = max((a), (b)), _l = min((a), (b)); (a) = _h; (b) = _l; } while (0)
#define SORT16(v) do { CE(v[0], v[1]); CE(v[2], v[3]); CE(v[0], v[2]); CE(v[1], v[3]); CE(v[1], v[2]); CE(v[4], v[5]); CE(v[6], v[7]); CE(v[4], v[6]); CE(v[5], v[7]); CE(v[5], v[6]); CE(v[0], v[4]); CE(v[2], v[6]); CE(v[2], v[4]); CE(v[1], v[5]); CE(v[3], v[7]); CE(v[3], v[5]); CE(v[1], v[2]); CE(v[3], v[4]); CE(v[5], v[6]); CE(v[8], v[9]); CE(v[10], v[11]); CE(v[8], v[10]); CE(v[9], v[11]); CE(v[9], v[10]); CE(v[12], v[13]); CE(v[14], v[15]); CE(v[12], v[14]); CE(v[13], v[15]); CE(v[13], v[14]); CE(v[8], v[12]); CE(v[10], v[14]); CE(v[10], v[12]); CE(v[9], v[13]); CE(v[11], v[15]); CE(v[11], v[13]); CE(v[9], v[10]); CE(v[11], v[12]); CE(v[13], v[14]); CE(v[0], v[8]); CE(v[4], v[12]); CE(v[4], v[8]); CE(v[2], v[10]); CE(v[6], v[14]); CE(v[6], v[10]); CE(v[2], v[4]); CE(v[6], v[8]); CE(v[10], v[12]); CE(v[1], v[9]); CE(v[5], v[13]); CE(v[5], v[9]); CE(v[3], v[11]); CE(v[7], v[15]); CE(v[7], v[11]); CE(v[3], v[5]); CE(v[7], v[9]); CE(v[11], v[13]); CE(v[1], v[2]); CE(v[3], v[4]); CE(v[5], v[6]); CE(v[7], v[8]); CE(v[9], v[10]); CE(v[11], v[12]); CE(v[13], v[14]); } while (0)
#define MERGE16(T, S) do { _Pragma("unroll") for (int _i = 0; _i < 16; ++_i) (T)[_i] = max((T)[_i], (S)[15 - _i]); \
    _Pragma("unroll") for (int _d = 8; _d >= 1; _d >>= 1) { _Pragma("unroll") for (int _i = 0; _i < 16; ++_i) if ((_i & _d) == 0) CE((T)[_i], (T)[_i + _d]); } } while (0)
__device__ __forceinline__ void peer_topk(const Frame& F, const Args& A) {
    const bf16_t* SC = (const bf16_t*)(A.ws + WS_P + P_SC);
    int* IDX = (int*)(A.ws + WS_P + P_IDX); float* GATE = (float*)(A.ws + WS_P + P_GATE);
    const int gw = F.bid * NWAVES + F.wave, NGW = F.G * NWAVES;
    for (int it = gw; it < 512 * 8; it += NGW) {
        const int h = it & 7, tb = it >> 3; const int tok = tb * 64 + F.lane;
        unsigned r1[16], r2[16], rc[16];
        const bf16_t* p1 = SC + ((size_t)(tok >> 4) * 256 + h * 32) * 128 + (tok & 15) * 8; const bf16_t* p2 = p1 + 16 * 128;
        {
            float raw[128]; unsigned sg[16];
#pragma unroll
            for (int jq = 0; jq < 16; ++jq) { const u32x4 t4 = *(const u32x4*)(p1 + jq * 128);
#pragma unroll
                for (int c = 0; c < 4; ++c) { raw[8 * jq + 2 * c] = bflo(t4[c]); raw[8 * jq + 2 * c + 1] = bfhi(t4[c]); } }
#pragma unroll
            for (int j = 0; j < 16; ++j) r1[j] = (ordkey(raw[j]) & ~127u) | (unsigned)(127 - j);
            SORT16(r1);
#pragma unroll
            for (int gq = 1; gq < 8; ++gq) {
#pragma unroll
                for (int j = 0; j < 16; ++j) sg[j] = (ordkey(raw[16 * gq + j]) & ~127u) | (unsigned)(127 - (16 * gq + j));
                SORT16(sg); MERGE16(r1, sg); }
#pragma unroll
            for (int jq = 0; jq < 16; ++jq) { const u32x4 t4 = *(const u32x4*)(p2 + jq * 128);
#pragma unroll
                for (int c = 0; c < 4; ++c) { raw[8 * jq + 2 * c] = bflo(t4[c]); raw[8 * jq + 2 * c + 1] = bfhi(t4[c]); } }
#pragma unroll
            for (int j = 0; j < 16; ++j) r2[j] = (ordkey(raw[j]) & ~127u) | (unsigned)(127 - j);
            SORT16(r2);
#pragma unroll
            for (int gq = 1; gq < 8; ++gq) {
#pragma unroll
                for (int j = 0; j < 16; ++j) sg[j] = (ordkey(raw[16 * gq + j]) & ~127u) | (unsigned)(127 - (16 * gq + j));
                SORT16(sg); MERGE16(r2, sg); }
        }
        float v1[16], v2[16];
#pragma unroll
        for (int i = 0; i < 16; ++i) { v1[i] = unord((r1[i] & ~127u) | 64u); v2[i] = unord((r2[i] & ~127u) | 64u); }
        {
            unsigned cg[4][16]; int cn = 0;
#pragma unroll
            for (int a = 0; a < 16; ++a)
#pragma unroll
                for (int bq = 0; bq < 16; ++bq) if ((a + 1) * (bq + 1) <= 16) { cg[cn >> 4][cn & 15] = (ordkey(v1[a] + v2[bq]) & ~255u) | (unsigned)(a * 16 + bq); ++cn; }
#pragma unroll
            for (int z = 50; z < 64; ++z) cg[z >> 4][z & 15] = 0u;
            SORT16(cg[0]); SORT16(cg[1]); SORT16(cg[2]); SORT16(cg[3]);
            MERGE16(cg[0], cg[1]); MERGE16(cg[0], cg[2]); MERGE16(cg[0], cg[3]);
#pragma unroll
            for (int i = 0; i < 16; ++i) rc[i] = cg[0][i];
        }
        float val[16]; int ex[16];
        {
            LAS unsigned* t1 = (LAS unsigned*)(F.lds + F.wave * 8704) + F.lane * 17; LAS unsigned* t2 = t1 + 64 * 17;
#pragma unroll
            for (int i = 0; i < 16; ++i) { t1[i] = r1[i]; t2[i] = r2[i]; }
            LDS_WAIT(); asm volatile("" ::: "memory");
#pragma unroll
            for (int w = 0; w < 16; ++w) {
                const int a = (rc[w] >> 4) & 15, bq = rc[w] & 15;
                const unsigned k1 = t1[a], k2 = t2[bq];
                val[w] = unord((k1 & ~127u) | 64u) + unord((k2 & ~127u) | 64u);
                ex[w] = (127 - (int)(k1 & 127u)) * 128 + (127 - (int)(k2 & 127u));
            }
            LDS_WAIT(); asm volatile("" ::: "memory");
        }
        float mx = val[0];
#pragma unroll
        for (int w = 1; w < 16; ++w) mx = fmaxf(mx, val[w]);
        float sum = 0.f;
#pragma unroll
        for (int w = 0; w < 16; ++w) { val[w] = __expf(val[w] - mx); sum += val[w]; }
        const float inv = 1.f / sum;
        int* ip = IDX + (size_t)tok * 128 + h * 16; float* gp = GATE + (size_t)tok * 128 + h * 16;
#pragma unroll
        for (int q = 0; q < 4; ++q) { *(int4*)(ip + 4 * q) = make_int4(ex[4 * q], ex[4 * q + 1], ex[4 * q + 2], ex[4 * q + 3]);
            *(f32x4*)(gp + 4 * q) = (f32x4){val[4 * q] * inv, val[4 * q + 1] * inv, val[4 * q + 2] * inv, val[4 * q + 3] * inv}; }
    }
}

#define DPP_ADD(v, ctrl) ((v) + __builtin_bit_cast(float, __builtin_amdgcn_mov_dpp(__builtin_bit_cast(int, (v)), (ctrl), 0xf, 0xf, true)))
__device__ __forceinline__ void fp8x16_to_f32x2(const u32x4 r, f32x2* f) {
#pragma unroll
    for (int q = 0; q < 4; ++q) { f[2 * q] = __builtin_amdgcn_cvt_pk_f32_fp8((int)r[q], false); f[2 * q + 1] = __builtin_amdgcn_cvt_pk_f32_fp8((int)r[q], true); }
}
__device__ __forceinline__ void fp8x16_to_f32(const u32x4 r, float* f) {
#pragma unroll
    for (int q = 0; q < 4; ++q) { const f32x2 lo = __builtin_amdgcn_cvt_pk_f32_fp8((int)r[q], false), hi = __builtin_amdgcn_cvt_pk_f32_fp8((int)r[q], true);
        f[4 * q] = lo.x; f[4 * q + 1] = lo.y; f[4 * q + 2] = hi.x; f[4 * q + 3] = hi.y; }
}
__device__ __forceinline__ long lo64(u32x4 v) { return (long)(((unsigned long)v.y << 32) | (unsigned long)v.x); }
__device__ __forceinline__ long hi64(u32x4 v) { return (long)(((unsigned long)v.w << 32) | (unsigned long)v.z); }
template <int MODE>
__device__ __forceinline__ void peer_u_phase(const Frame& F, const Args& A) {
    const unsigned char* X8 = A.ws + WS_P + P_X8;
    const unsigned char* U8 = A.ws + WS_U8; const float* SU = (const float*)(A.ws + WS_SU); const float* SV = (const float*)(A.ws + WS_SV);
    const int* IDX = (const int*)(A.ws + WS_P + P_IDX); const float* GATE = (const float*)(A.ws + WS_P + P_GATE); float* AK = (float*)(MODE == 0 ? A.ws + WS_AK : A.ws + WS_P + P_SC);
    const int g = F.bid & 7, nmem = F.G >> 3, l = F.lane, step = nmem * NWAVES;
    const int loff = 64 * (l & 15) + 16 * (l >> 4);
    const bool dg = ((l & 15) >> 2) == (l >> 4); const int dr = l & 3;
    const float dw0 = (dg && dr == 0) ? 1.f : 0.f, dw1 = (dg && dr == 1) ? 1.f : 0.f, dw2 = (dg && dr == 2) ? 1.f : 0.f, dw3 = (dg && dr == 3) ? 1.f : 0.f;
    LAS int* le = (LAS int*)(F.lds + F.wave * 2048); LAS int* lk = le + 256;
    const bool b5 = (l & 32) != 0, b4 = (l & 16) != 0, b3 = (l & 8) != 0;
    int tok = 2 * ((F.bid >> 3) * NWAVES + F.wave);
    u32x4 nxA, nxB; int neA0, neA1, neB0, neB1; float ngA0, ngA1, ngB0, ngB1;
#define U_PREFETCH(t) do { const size_t _tA = (size_t)(t), _tB = (size_t)(t) + 1; if (MODE == 4) { nxA = (u32x4){(unsigned)_tA, 1u, 2u, 3u}; nxB = nxA; neA0 = (int)((_tA * 37 + l * 11) & 16383); neA1 = (int)((_tA * 53 + l * 7) & 16383); neB0 = (int)((_tB * 37 + l * 13) & 16383); neB1 = (int)((_tB * 29 + l * 3) & 16383); ngA0 = ngA1 = ngB0 = ngB1 = 0.01f; break; } nxA = *(const u32x4*)(X8 + _tA * 1024 + loff); nxB = *(const u32x4*)(X8 + _tB * 1024 + loff); \
        neA0 = IDX[_tA * 128 + l]; neA1 = IDX[_tA * 128 + 64 + l]; neB0 = IDX[_tB * 128 + l]; neB1 = IDX[_tB * 128 + 64 + l]; \
        ngA0 = GATE[_tA * 128 + l]; ngA1 = GATE[_tA * 128 + 64 + l]; ngB0 = GATE[_tB * 128 + l]; ngB1 = GATE[_tB * 128 + 64 + l]; } while (0)
    if (tok + 1 < T_TOK) U_PREFETCH(tok);
    for (; tok + 1 < T_TOK; tok += 2 * step) {
        const int tokA = tok, tokB = tok + 1;
        const u32x4 xA = nxA, xB = nxB;
        const int eA0 = neA0, eA1 = neA1, eB0 = neB0, eB1 = neB1; const float gA0 = ngA0, gA1 = ngA1, gB0 = ngB0, gB1 = ngB1;
        bool pf_done = false;
        const bool oA0 = (eA0 & 7) == g, oA1 = (eA1 & 7) == g, oB0 = (eB0 & 7) == g, oB1 = (eB1 & 7) == g;
        const unsigned long long mA0 = __ballot(oA0), mA1 = __ballot(oA1), mB0 = __ballot(oB0), mB1 = __ballot(oB1);
        const int c0 = __popcll(mA0), c1 = c0 + __popcll(mA1), c2 = c1 + __popcll(mB0), n = c2 + __popcll(mB1);
#define MBC(m) __builtin_amdgcn_mbcnt_hi((unsigned)((m) >> 32), __builtin_amdgcn_mbcnt_lo((unsigned)(m), 0u))
        if (oA0) { const int p = MBC(mA0); le[p] = (eA0 << 8) | l; lk[p] = __builtin_bit_cast(int, gA0); }
        if (oA1) { const int p = c0 + MBC(mA1); le[p] = (eA1 << 8) | (64 + l); lk[p] = __builtin_bit_cast(int, gA1); }
        if (oB0) { const int p = c1 + MBC(mB0); le[p] = (eB0 << 8) | 128 | l; lk[p] = __builtin_bit_cast(int, gB0); }
        if (oB1) { const int p = c2 + MBC(mB1); le[p] = (eB1 << 8) | 128 | (64 + l); lk[p] = __builtin_bit_cast(int, gB1); }
#undef MBC
        LDS_WAIT(); asm volatile("" ::: "memory");
        for (int cb = 0; cb < n || cb == 0; cb += 64) {
        const int nc = min(n, cb + 64);
        const bool fv = (cb + l) < nc;
        const int ent = fv ? le[cb + l] : 0; const float gt = fv ? __builtin_bit_cast(float, lk[cb + l]) : 0.f; float tot = 0.f;
        const float su = SU[ent >> 8], sv = SV[ent >> 8];
        const unsigned long long radr = (unsigned long long)(U8 + (size_t)(((ent >> 8) & 7) * 2048 + (((ent >> 8) >> 3) & (MODE == 2 ? 255 : 2047))) * 1024);
        const int ralo = (int)(unsigned)radr, rahi = (int)(unsigned)(radr >> 32);
        for (int i = cb; i < nc; i += 16) {
            u32x4 row[2][8];
#pragma unroll
            for (int b = 0; b < 2; ++b) if (i + 8 * b < nc) {
#pragma unroll
                for (int j = 0; j < 8; ++j) { const int ln = min(i + 8 * b + j, nc - 1) - cb;
                    const unsigned lo = (unsigned)__builtin_amdgcn_readlane(ralo, ln), hi = (unsigned)__builtin_amdgcn_readlane(rahi, ln);
                    const GAS unsigned char* rp = (const GAS unsigned char*)(((unsigned long long)hi << 32) | lo);
                    row[b][j] = *(const GAS u32x4*)(rp + (unsigned)loff); } }
            if (!pf_done) { pf_done = true; if (tok + 2 * step + 1 < T_TOK) U_PREFETCH(tok + 2 * step); }
#pragma unroll
            for (int b = 0; b < 2; ++b) if (i + 8 * b < nc) {
                float p[8];
                f32x4 accj[8];
                const int base0 = i + 8 * b;
                if (base0 + 8 <= c1) {
#pragma unroll
                    for (int j = 0; j < 8; ++j) accj[j] = __builtin_amdgcn_mfma_f32_16x16x32_fp8_fp8(lo64(row[b][j]), lo64(xA), (f32x4){0.f, 0.f, 0.f, 0.f}, 0, 0, 0);
#pragma unroll
                    for (int j = 0; j < 8; ++j) accj[j] = __builtin_amdgcn_mfma_f32_16x16x32_fp8_fp8(hi64(row[b][j]), hi64(xA), accj[j], 0, 0, 0);
                } else if (base0 >= c1) {
#pragma unroll
                    for (int j = 0; j < 8; ++j) accj[j] = __builtin_amdgcn_mfma_f32_16x16x32_fp8_fp8(lo64(row[b][j]), lo64(xB), (f32x4){0.f, 0.f, 0.f, 0.f}, 0, 0, 0);
#pragma unroll
                    for (int j = 0; j < 8; ++j) accj[j] = __builtin_amdgcn_mfma_f32_16x16x32_fp8_fp8(hi64(row[b][j]), hi64(xB), accj[j], 0, 0, 0);
                } else {
#pragma unroll
                    for (int j = 0; j < 8; ++j) { const u32x4 xs = (base0 + j >= c1) ? xB : xA; accj[j] = __builtin_amdgcn_mfma_f32_16x16x32_fp8_fp8(lo64(row[b][j]), lo64(xs), (f32x4){0.f, 0.f, 0.f, 0.f}, 0, 0, 0);
                        accj[j] = __builtin_amdgcn_mfma_f32_16x16x32_fp8_fp8(hi64(row[b][j]), hi64(xs), accj[j], 0, 0, 0); }
                }
#pragma unroll
                for (int j = 0; j < 8; ++j) p[j] = __builtin_fmaf(accj[j][3], dw3, __builtin_fmaf(accj[j][2], dw2, __builtin_fmaf(accj[j][1], dw1, accj[j][0] * dw0)));
                float q4[4], q2[2], q1;
#pragma unroll
                for (int j = 0; j < 4; ++j) { const float keep = b5 ? p[4 + j] : p[j], send = b5 ? p[j] : p[4 + j]; q4[j] = keep + __shfl_xor(send, 32); }
#pragma unroll
                for (int j = 0; j < 2; ++j) { const float keep = b4 ? q4[2 + j] : q4[j], send = b4 ? q4[j] : q4[2 + j]; q2[j] = keep + __shfl_xor(send, 16); }
                { const float keep = b3 ? q2[1] : q2[0], send = b3 ? q2[0] : q2[1]; q1 = keep + __shfl_xor(send, 8); }
                q1 = DPP_ADD(q1, 0xB1); q1 = DPP_ADD(q1, 0x4E); q1 = DPP_ADD(q1, 0x141);
                const float t = __builtin_bit_cast(float, __builtin_amdgcn_ds_bpermute((l & 7) * 32, __builtin_bit_cast(int, q1)));
                const int base = i + 8 * b;
                if ((l >> 3) == ((base - cb) >> 3)) tot = t;
            }
        }
        if (!pf_done) { if (tok + 2 * step + 1 < T_TOK) U_PREFETCH(tok + 2 * step); }
        if (fv) { const int tk = (ent & 128) ? tokB : tokA; AK[(size_t)tk * 128 + (ent & 127)] = gelu_tanh(tot * su * (1.f / 16.f)) * gt * sv; }
        if (n == 0) break;
        }
        LDS_WAIT(); asm volatile("" ::: "memory");
    }
#undef U_PREFETCH
}
template <int MODE>
__device__ __forceinline__ void peer_u_phase1(const Frame& F, const Args& A) {
    const unsigned char* X8 = A.ws + WS_P + P_X8;
    const unsigned char* U8 = A.ws + WS_U8; const float* SU = (const float*)(A.ws + WS_SU); const float* SV = (const float*)(A.ws + WS_SV);
    const int* IDX = (const int*)(A.ws + WS_P + P_IDX); const float* GATE = (const float*)(A.ws + WS_P + P_GATE); float* AK = (float*)(MODE == 0 ? A.ws + WS_AK : A.ws + WS_P + P_SC);
    const int g = F.bid & (UNG - 1), nmem = F.G >> UNG_SH, l = F.lane, step = nmem * NWAVES;
    const int loff = 64 * (l & 15) + 16 * (l >> 4);
    const bool dg = ((l & 15) >> 2) == (l >> 4); const int dr = l & 3;
    const float dw0 = (dg && dr == 0) ? 1.f : 0.f, dw1 = (dg && dr == 1) ? 1.f : 0.f, dw2 = (dg && dr == 2) ? 1.f : 0.f, dw3 = (dg && dr == 3) ? 1.f : 0.f;
    LAS int* le = (LAS int*)(F.lds + F.wave * 2048); LAS int* lk = le + 256;
    const bool b5 = (l & 32) != 0, b4 = (l & 16) != 0, b3 = (l & 8) != 0;
    int tok = (F.bid >> UNG_SH) * NWAVES + F.wave;
    u32x4 nxA; int neA0, neA1; float ngA0, ngA1;
#define U1_PREFETCH(t) do { const size_t _tA = (size_t)(t); nxA = *(const u32x4*)(X8 + _tA * 1024 + loff); \
        neA0 = IDX[_tA * 128 + l]; neA1 = IDX[_tA * 128 + 64 + l]; ngA0 = GATE[_tA * 128 + l]; ngA1 = GATE[_tA * 128 + 64 + l]; } while (0)
    if (tok < T_TOK) U1_PREFETCH(tok);
    for (; tok < T_TOK; tok += step) {
        const u32x4 xA = nxA;
        const int eA0 = neA0, eA1 = neA1; const float gA0 = ngA0, gA1 = ngA1;
        bool pf_done = false;
        const bool oA0 = (eA0 & (UNG - 1)) == g, oA1 = (eA1 & (UNG - 1)) == g;
        const unsigned long long mA0 = __ballot(oA0), mA1 = __ballot(oA1);
        const int c0 = __popcll(mA0), n = c0 + __popcll(mA1);
#define MBC(m) __builtin_amdgcn_mbcnt_hi((unsigned)((m) >> 32), __builtin_amdgcn_mbcnt_lo((unsigned)(m), 0u))
        if (oA0) { const int p = MBC(mA0); le[p] = (eA0 << 8) | l; lk[p] = __builtin_bit_cast(int, gA0); }
        if (oA1) { const int p = c0 + MBC(mA1); le[p] = (eA1 << 8) | (64 + l); lk[p] = __builtin_bit_cast(int, gA1); }
#undef MBC
        LDS_WAIT(); asm volatile("" ::: "memory");
        for (int cb = 0; cb < n || cb == 0; cb += 64) {
        const int nc = min(n, cb + 64);
        const bool fv = (cb + l) < nc;
        const int ent = fv ? le[cb + l] : 0; const float gt = fv ? __builtin_bit_cast(float, lk[cb + l]) : 0.f; float tot = 0.f;
        const float su = SU[ent >> 8], sv = SV[ent >> 8];
        const unsigned long long radr = (unsigned long long)(U8 + (size_t)(((ent >> 8) & (UNG - 1)) * (NEXP / UNG) + ((ent >> 8) >> UNG_SH)) * 1024);
        const int ralo = (int)(unsigned)radr, rahi = (int)(unsigned)(radr >> 32);
        for (int i = cb; i < nc; i += 16) {
            u32x4 row[2][8];
#pragma unroll
            for (int b = 0; b < 2; ++b) if (i + 8 * b < nc) {
#pragma unroll
                for (int j = 0; j < 8; ++j) { const int ln = min(i + 8 * b + j, nc - 1) - cb;
                    const unsigned lo = (unsigned)__builtin_amdgcn_readlane(ralo, ln), hi = (unsigned)__builtin_amdgcn_readlane(rahi, ln);
                    const GAS unsigned char* rp = (const GAS unsigned char*)(((unsigned long long)hi << 32) | lo);
                    row[b][j] = *(const GAS u32x4*)(rp + (unsigned)loff); } }
            if (!pf_done) { pf_done = true; if (tok + step < T_TOK) U1_PREFETCH(tok + step); }
#pragma unroll
            for (int b = 0; b < 2; ++b) if (i + 8 * b < nc) {
                float p[8]; f32x4 accj[8];
#pragma unroll
                for (int j = 0; j < 8; ++j) accj[j] = __builtin_amdgcn_mfma_f32_16x16x32_fp8_fp8(lo64(row[b][j]), lo64(xA), (f32x4){0.f, 0.f, 0.f, 0.f}, 0, 0, 0);
#pragma unroll
                for (int j = 0; j < 8; ++j) accj[j] = __builtin_amdgcn_mfma_f32_16x16x32_fp8_fp8(hi64(row[b][j]), hi64(xA), accj[j], 0, 0, 0);
#pragma unroll
                for (int j = 0; j < 8; ++j) p[j] = __builtin_fmaf(accj[j][3], dw3, __builtin_fmaf(accj[j][2], dw2, __builtin_fmaf(accj[j][1], dw1, accj[j][0] * dw0)));
                float q4[4], q2[2], q1;
#pragma unroll
                for (int j = 0; j < 4; ++j) { const float keep = b5 ? p[4 + j] : p[j], send = b5 ? p[j] : p[4 + j]; q4[j] = keep + __shfl_xor(send, 32); }
#pragma unroll
                for (int j = 0; j < 2; ++j) { const float keep = b4 ? q4[2 + j] : q4[j], send = b4 ? q4[j] : q4[2 + j]; q2[j] = keep + __shfl_xor(send, 16); }
                { const float keep = b3 ? q2[1] : q2[0], send = b3 ? q2[0] : q2[1]; q1 = keep + __shfl_xor(send, 8); }
                q1 = DPP_ADD(q1, 0xB1); q1 = DPP_ADD(q1, 0x4E); q1 = DPP_ADD(q1, 0x141);
                const float t = __builtin_bit_cast(float, __builtin_amdgcn_ds_bpermute((l & 7) * 32, __builtin_bit_cast(int, q1)));
                const int base = i + 8 * b;
                if ((l >> 3) == ((base - cb) >> 3)) tot = t;
            }
        }
        if (!pf_done) { pf_done = true; if (tok + step < T_TOK) U1_PREFETCH(tok + step); }
        if (fv) AK[(size_t)tok * 128 + (ent & 127)] = gelu_tanh(tot * su * (1.f / 16.f)) * gt * sv;
        if (n == 0) break;
        }
        LDS_WAIT(); asm volatile("" ::: "memory");
    }
#undef U1_PREFETCH
}
template <int MODE>
__device__ __forceinline__ void peer_u4_phase(const Frame& F, const Args& A) {
    const unsigned char* X8 = A.ws + WS_P + P_X8;
    const float* SU = (const float*)(A.ws + WS_SU); const float* SV = (const float*)(A.ws + WS_SV);
    const int* IDX = (const int*)(A.ws + WS_P + P_IDX); const float* GATE = (const float*)(A.ws + WS_P + P_GATE); float* AK = (float*)(MODE == 0 ? A.ws + WS_AK : A.ws + WS_P + P_SC);
    const int g = F.bid & (UNG - 1), nmem = F.G >> UNG_SH, l = F.lane, step = nmem * NWAVES;
    const int m = l & 15, q = l >> 4;
    const GAS unsigned char* ub = (const GAS unsigned char*)(A.ws + WS_U8 + (size_t)g * (NEXP / UNG) * 512);
    const unsigned lconst = 16u * (unsigned)(4 * (m & 7) + q);
    const int xoff = 128 * (m & 7) + 16 * q;
    const bool dg = (m < 8) && ((m >> 2) == (q & 1)); const int dr = m & 3;
    const float dw0 = (dg && dr == 0) ? 1.f : 0.f, dw1 = (dg && dr == 1) ? 1.f : 0.f, dw2 = (dg && dr == 2) ? 1.f : 0.f, dw3 = (dg && dr == 3) ? 1.f : 0.f;
    const int rsel = 4 * (m >> 3);
    const int osrc = 4 * (32 * (l & 1) + 4 * ((l & 15) >> 1));
    const int sc1 = 0x7F7F7F7F;
    LAS int* le = (LAS int*)(F.lds + F.wave * 2048); LAS int* lk = le + 256;
    const bool b4 = (l & 16) != 0, b3 = (l & 8) != 0, b2 = (l & 4) != 0;
    int tok = (F.bid >> UNG_SH) * NWAVES + F.wave;
    u32x4 nx0, nx1; int ne0, ne1; float ng0, ng1;
#define U4_PREFETCH(t) do { const size_t _t = (size_t)(t); nx0 = *(const u32x4*)(X8 + _t * 1024 + xoff); nx1 = *(const u32x4*)(X8 + _t * 1024 + xoff + 64); \
        ne0 = IDX[_t * 128 + l]; ne1 = IDX[_t * 128 + 64 + l]; ng0 = GATE[_t * 128 + l]; ng1 = GATE[_t * 128 + 64 + l]; } while (0)
    if (tok < T_TOK) U4_PREFETCH(tok);
    for (; tok < T_TOK; tok += step) {
        const i32x8 xb = __builtin_shufflevector(__builtin_bit_cast(i32x4, nx0), __builtin_bit_cast(i32x4, nx1), 0, 1, 2, 3, 4, 5, 6, 7);
        const int e0 = ne0, e1 = ne1; const float g0 = ng0, g1 = ng1;
        bool pf_done = false;
        const bool o0 = (e0 & (UNG - 1)) == g, o1 = (e1 & (UNG - 1)) == g;
        const unsigned long long m0 = __ballot(o0), m1 = __ballot(o1);
        const int c0 = __popcll(m0), n = c0 + __popcll(m1);
#define MBC(mm) __builtin_amdgcn_mbcnt_hi((unsigned)((mm) >> 32), __builtin_amdgcn_mbcnt_lo((unsigned)(mm), 0u))
        if (o0) { const int p = MBC(m0); le[p] = (e0 << 8) | l; lk[p] = __builtin_bit_cast(int, g0); }
        if (o1) { const int p = c0 + MBC(m1); le[p] = (e1 << 8) | (64 + l); lk[p] = __builtin_bit_cast(int, g1); }
#undef MBC
        LDS_WAIT(); asm volatile("" ::: "memory");
        for (int cb = 0; cb < n || cb == 0; cb += 64) {
            const int nc = min(n, cb + 64);
            const bool fv = (cb + l) < nc;
            const int ent = fv ? le[cb + l] : 0; const float gt = fv ? __builtin_bit_cast(float, lk[cb + l]) : 0.f; float tot = 0.f;
            const float su = SU[ent >> 8], sv = SV[ent >> 8];
            const int roff = fv ? ((ent >> 8) >> UNG_SH) * 512 : 0;
            for (int i = cb; i < nc; i += 32) {
                u32x4 row[2][8];
#pragma unroll
                for (int b = 0; b < 2; ++b) if (i + 16 * b < nc) {
#pragma unroll
                    for (int j = 0; j < 8; ++j) { const int ro = __builtin_amdgcn_ds_bpermute(rsel + 4 * (i - cb + 16 * b + 2 * j), roff);
                        row[b][j] = *(const GAS u32x4*)(ub + ((unsigned)ro + lconst)); } }
                if (!pf_done) { pf_done = true; if (tok + step < T_TOK) U4_PREFETCH(tok + step); }
#pragma unroll
                for (int b = 0; b < 2; ++b) if (i + 16 * b < nc) {
                    float p[8];
#pragma unroll
                    for (int j = 0; j < 8; ++j) { const i32x4 r4 = __builtin_bit_cast(i32x4, row[b][j]);
                        const f32x4 d = __builtin_amdgcn_mfma_scale_f32_16x16x128_f8f6f4(__builtin_shufflevector(r4, r4, 0, 1, 2, 3, -1, -1, -1, -1), xb, (f32x4){0.f, 0.f, 0.f, 0.f}, 4, 0, 0, sc1, 0, sc1);
                        p[j] = __builtin_fmaf(d[3], dw3, __builtin_fmaf(d[2], dw2, __builtin_fmaf(d[1], dw1, d[0] * dw0))); }
                    float q4[4], q2[2], q1;
#pragma unroll
                    for (int j = 0; j < 4; ++j) { const float keep = b4 ? p[4 + j] : p[j], send = b4 ? p[j] : p[4 + j]; q4[j] = keep + __shfl_xor(send, 16); }
#pragma unroll
                    for (int j = 0; j < 2; ++j) { const float keep = b3 ? q4[2 + j] : q4[j], send = b3 ? q4[j] : q4[2 + j]; q2[j] = keep + __shfl_xor(send, 8); }
                    { const float keep = b2 ? q2[1] : q2[0], send = b2 ? q2[0] : q2[1]; q1 = keep + __shfl_xor(send, 4); }
                    q1 = DPP_ADD(q1, 0xB1); q1 = DPP_ADD(q1, 0x4E);
                    const float t = __builtin_bit_cast(float, __builtin_amdgcn_ds_bpermute(osrc, __builtin_bit_cast(int, q1)));
                    if ((l >> 4) == ((i - cb + 16 * b) >> 4)) tot = t;
                }
            }
            if (!pf_done) { pf_done = true; if (tok + step < T_TOK) U4_PREFETCH(tok + step); }
            if (fv) AK[(size_t)tok * 128 + (ent & 127)] = gelu_tanh(tot * su * (1.f / 16.f)) * gt * sv;
            if (n == 0) break;
        }
        LDS_WAIT(); asm volatile("" ::: "memory");
    }
#undef U4_PREFETCH
}
template <int MODE>
__device__ __forceinline__ void peer_u4_all(const Frame& F, const Args& A) {
    const unsigned char* X8 = A.ws + WS_P + P_X8;
    const float* SU = (const float*)(A.ws + WS_SU); const float* SV = (const float*)(A.ws + WS_SV);
    const int* IDX = (const int*)(A.ws + WS_P + P_IDX); const float* GATE = (const float*)(A.ws + WS_P + P_GATE); float* AK = (float*)(MODE == 0 ? A.ws + WS_AK : A.ws + WS_P + P_SC);
    const int l = F.lane, step = F.G * NWAVES;
    const int m = l & 15, q = l >> 4;
    const GAS unsigned char* ub = (const GAS unsigned char*)(A.ws + WS_U8);
    const unsigned lconst = 16u * (unsigned)(4 * (m & 7) + q);
    const int xoff = 128 * (m & 7) + 16 * q;
    const bool dg = (m < 8) && ((m >> 2) == (q & 1)); const int dr = m & 3;
    const float dw0 = (dg && dr == 0) ? 1.f : 0.f, dw1 = (dg && dr == 1) ? 1.f : 0.f, dw2 = (dg && dr == 2) ? 1.f : 0.f, dw3 = (dg && dr == 3) ? 1.f : 0.f;
    const int rsel = 4 * (m >> 3);
    const int osrc = 4 * (32 * (l & 1) + 4 * ((l & 15) >> 1));
    const int sc1 = 0x7F7F7F7F;
    const bool b4 = (l & 16) != 0, b3 = (l & 8) != 0, b2 = (l & 4) != 0;
    const int lhi = l >> 4;
    int tok = F.bid * NWAVES + F.wave;
    u32x4 nx0, nx1; int ne0, ne1; float ng0, ng1;
#define UA_PREFETCH(t) do { const size_t _t = (size_t)(t); nx0 = *(const u32x4*)(X8 + _t * 1024 + xoff); nx1 = *(const u32x4*)(X8 + _t * 1024 + xoff + 64); \
        ne0 = IDX[_t * 128 + l]; ne1 = IDX[_t * 128 + 64 + l]; ng0 = GATE[_t * 128 + l]; ng1 = GATE[_t * 128 + 64 + l]; } while (0)
#define UA_LOADS(R, ro_, h) do { _Pragma("unroll") for (int j_ = 0; j_ < 16; ++j_) { const int o_ = __builtin_amdgcn_ds_bpermute(rsel + 4 * (32 * (h) + 2 * j_), (ro_)); \
        R[j_] = *(const GAS u32x4*)(ub + ((unsigned)o_ + lconst)); } } while (0)
#define UA_COMPUTE(R, xb_, h, tot_) do { _Pragma("unroll") for (int b_ = 0; b_ < 2; ++b_) { float p_[8]; \
        _Pragma("unroll") for (int j_ = 0; j_ < 8; ++j_) { const i32x4 r4_ = __builtin_bit_cast(i32x4, R[8 * b_ + j_]); \
            const f32x4 d_ = __builtin_amdgcn_mfma_scale_f32_16x16x128_f8f6f4(__builtin_shufflevector(r4_, r4_, 0, 1, 2, 3, -1, -1, -1, -1), (xb_), (f32x4){0.f, 0.f, 0.f, 0.f}, 4, 0, 0, sc1, 0, sc1); \
            p_[j_] = __builtin_fmaf(d_[3], dw3, __builtin_fmaf(d_[2], dw2, __builtin_fmaf(d_[1], dw1, d_[0] * dw0))); } \
        float q4_[4], q2_[2], q1_; \
        _Pragma("unroll") for (int j_ = 0; j_ < 4; ++j_) { const float keep_ = b4 ? p_[4 + j_] : p_[j_], send_ = b4 ? p_[j_] : p_[4 + j_]; q4_[j_] = keep_ + __shfl_xor(send_, 16); } \
        _Pragma("unroll") for (int j_ = 0; j_ < 2; ++j_) { const float keep_ = b3 ? q4_[2 + j_] : q4_[j_], send_ = b3 ? q4_[j_] : q4_[2 + j_]; q2_[j_] = keep_ + __shfl_xor(send_, 8); } \
        { const float keep_ = b2 ? q2_[1] : q2_[0], send_ = b2 ? q2_[0] : q2_[1]; q1_ = keep_ + __shfl_xor(send_, 4); } \
        q1_ = DPP_ADD(q1_, 0xB1); q1_ = DPP_ADD(q1_, 0x4E); \
        const float t_ = __builtin_bit_cast(float, __builtin_amdgcn_ds_bpermute(osrc, __builtin_bit_cast(int, q1_))); \
        if (lhi == 2 * (h) + b_) (tot_) = t_; } } while (0)
    u32x4 RA[16], RB[16];
    if (tok < T_TOK) { UA_PREFETCH(tok); UA_LOADS(RA, ne0 * 512, 0); }
    for (; tok < T_TOK; tok += step) {
        const i32x8 xb = __builtin_shufflevector(__builtin_bit_cast(i32x4, nx0), __builtin_bit_cast(i32x4, nx1), 0, 1, 2, 3, 4, 5, 6, 7);
        const int e0 = ne0, e1 = ne1; const float g0 = ng0, g1 = ng1;
        const int ro0 = e0 * 512, ro1 = e1 * 512;
        const float su0 = SU[e0], sv0 = SV[e0], su1 = SU[e1], sv1 = SV[e1];
        const bool more = tok + step < T_TOK;
        float tot0 = 0.f, tot1 = 0.f;
        UA_LOADS(RB, ro0, 1);
        if (more) UA_PREFETCH(tok + step);
        UA_COMPUTE(RA, xb, 0, tot0);
        UA_LOADS(RA, ro1, 0);
        UA_COMPUTE(RB, xb, 1, tot0);
        UA_LOADS(RB, ro1, 1);
        UA_COMPUTE(RA, xb, 0, tot1);
        if (more) UA_LOADS(RA, ne0 * 512, 0);
        UA_COMPUTE(RB, xb, 1, tot1);
        AK[(size_t)tok * 128 + l] = gelu_tanh(tot0 * su0 * (1.f / 16.f)) * g0 * sv0;
        AK[(size_t)tok * 128 + 64 + l] = gelu_tanh(tot1 * su1 * (1.f / 16.f)) * g1 * sv1;
    }
#undef UA_PREFETCH
#undef UA_LOADS
#undef UA_COMPUTE
}
__device__ __forceinline__ float wave_max_nonneg(float v) {
    unsigned u = __builtin_bit_cast(unsigned, v);
    u = max(u, (unsigned)__builtin_amdgcn_mov_dpp((int)u, 0xB1, 0xf, 0xf, true));
    u = max(u, (unsigned)__builtin_amdgcn_mov_dpp((int)u, 0x4E, 0xf, 0xf, true));
    u = max(u, (unsigned)__builtin_amdgcn_mov_dpp((int)u, 0x141, 0xf, 0xf, true));
    u = max(u, (unsigned)__builtin_amdgcn_mov_dpp((int)u, 0x140, 0xf, 0xf, true));
    const unsigned a = (unsigned)__builtin_amdgcn_readlane((int)u, 0), b = (unsigned)__builtin_amdgcn_readlane((int)u, 16), c = (unsigned)__builtin_amdgcn_readlane((int)u, 32), d = (unsigned)__builtin_amdgcn_readlane((int)u, 48);
    return __builtin_bit_cast(float, max(max(a, b), max(c, d)));
}
template <int MODE>
__device__ __forceinline__ void peer_v_phase(const Frame& F, const Args& A) {
    const unsigned char* V8 = A.ws + WS_V8; const int* IDX = (const int*)(A.ws + WS_P + P_IDX); const float* AK = (const float*)(A.ws + WS_AK);
    float* out = MODE == 0 ? A.out : (float*)(A.ws + WS_P + P_SC);
    const int g = F.bid & 7, nmem = F.G >> 3, l = F.lane, sub = l & 7, rr = l >> 3, n16 = l & 15, q = l >> 4, step = nmem * NWAVES;
    const GAS unsigned char* vb = (const GAS unsigned char*)(V8 + (size_t)g * NEXP * 128);
    LAS unsigned long long* rep = (LAS unsigned long long*)(F.lds + F.wave * 2048);
    const unsigned long long bm = 0xFFull << (8 * (n16 & 7));
    const int repi = 2 * q + (n16 >> 3);
    const bool vl = (n16 < 8) && (q < 2);
    LAS float* stg = (LAS float*)(F.lds + 16384 + F.wave * 512);
    int tok = 2 * ((F.bid >> 3) * NWAVES + F.wave);
    int ne[4]; float na[4];
#define V_PREFETCH(t) do { const size_t _a = (size_t)(t) * 128, _b = ((size_t)(t) + 1) * 128; ne[0] = IDX[_a + l]; ne[1] = IDX[_a + 64 + l]; ne[2] = IDX[_b + l]; ne[3] = IDX[_b + 64 + l]; \
        na[0] = AK[_a + l]; na[1] = AK[_a + 64 + l]; na[2] = AK[_b + l]; na[3] = AK[_b + 64 + l]; } while (0)
    if (tok + 1 < T_TOK) V_PREFETCH(tok);
    for (; tok + 1 < T_TOK; tok += 2 * step) {
        const int e0 = ne[0], e1 = ne[1], e2 = ne[2], e3 = ne[3]; const float a0 = na[0], a1 = na[1], a2 = na[2], a3 = na[3];
        u32x4 rowA[16], rowB[16];
#pragma unroll
        for (int i = 0; i < 16; ++i) { const int src = (8 * (i & 7) + rr) * 4;
            const int ea = __builtin_amdgcn_ds_bpermute(src, i < 8 ? e0 : e1), eb = __builtin_amdgcn_ds_bpermute(src, i < 8 ? e2 : e3);
            rowA[i] = *(const GAS u32x4*)(vb + ((unsigned)ea * 128u + 16u * (unsigned)sub)); rowB[i] = *(const GAS u32x4*)(vb + ((unsigned)eb * 128u + 16u * (unsigned)sub)); }
        f32x4 HA = {0.f, 0.f, 0.f, 0.f}, HB = {0.f, 0.f, 0.f, 0.f};
        if (l < 32) { const float* hpa = out + (size_t)tok * D + g * 128 + 4 * l; HA = *(const f32x4*)hpa; HB = *(const f32x4*)(hpa + D); }
        if (tok + 2 * step + 1 < T_TOK) V_PREFETCH(tok + 2 * step);
        const float amA = wave_max_nonneg(fmaxf(fabsf(a0), fabsf(a1))), amB = wave_max_nonneg(fmaxf(fabsf(a2), fabsf(a3)));
        const float scA = amA > 0.f ? 224.f * __builtin_amdgcn_rcpf(amA) : 0.f, invA = amA * (1.f / 224.f), scB = amB > 0.f ? 224.f * __builtin_amdgcn_rcpf(amB) : 0.f, invB = amB * (1.f / 224.f);
        { const unsigned wA = (unsigned)__builtin_amdgcn_cvt_pk_fp8_f32(a0 * scA, a1 * scA, 0, false), wB = (unsigned)__builtin_amdgcn_cvt_pk_fp8_f32(a2 * scB, a3 * scB, 0, false);
          const unsigned r0 = (wA & 0xffu) * 0x01010101u, r1 = ((wA >> 8) & 0xffu) * 0x01010101u, r2 = (wB & 0xffu) * 0x01010101u, r3 = ((wB >> 8) & 0xffu) * 0x01010101u;
          rep[l] = ((unsigned long long)r0 << 32) | r0; rep[64 + l] = ((unsigned long long)r1 << 32) | r1; rep[128 + l] = ((unsigned long long)r2 << 32) | r2; rep[192 + l] = ((unsigned long long)r3 << 32) | r3; }
        LDS_WAIT(); asm volatile("" ::: "memory");
#pragma unroll
        for (int t2 = 0; t2 < 2; ++t2) {
            f32x4 alo = {0.f, 0.f, 0.f, 0.f}, ahi = {0.f, 0.f, 0.f, 0.f};
#pragma unroll
            for (int i = 0; i < 16; ++i) { const long bop = (long)(rep[128 * t2 + 8 * i + repi] & bm); const u32x4 rw = t2 ? rowB[i] : rowA[i];
                alo = __builtin_amdgcn_mfma_f32_16x16x32_fp8_fp8(lo64(rw), bop, alo, 0, 0, 0);
                ahi = __builtin_amdgcn_mfma_f32_16x16x32_fp8_fp8(hi64(rw), bop, ahi, 0, 0, 0); }
            const float inv = t2 ? invB : invA;
            float vlo[4], vhi[4];
#pragma unroll
            for (int r = 0; r < 4; ++r) { const float tl = alo[r], th = ahi[r];
                vlo[r] = (tl + __builtin_bit_cast(float, __builtin_amdgcn_ds_bpermute(((l + 40) & 63) * 4, __builtin_bit_cast(int, tl)))) * inv;
                vhi[r] = (th + __builtin_bit_cast(float, __builtin_amdgcn_ds_bpermute(((l + 40) & 63) * 4, __builtin_bit_cast(int, th)))) * inv; }
            if (vl) {
#pragma unroll
                for (int r = 0; r < 4; ++r) { stg[64 * q + 16 * r + n16] = vlo[r]; stg[64 * q + 16 * r + n16 + 8] = vhi[r]; } }
            LDS_WAIT(); asm volatile("" ::: "memory");
            if (l < 32) { const f32x4 dv = *(const LAS f32x4*)(stg + 4 * l); *(f32x4*)(out + (size_t)(tok + t2) * D + g * 128 + 4 * l) = (t2 ? HB : HA) + dv; }
            LDS_WAIT(); asm volatile("" ::: "memory");
        }
        LDS_WAIT(); asm volatile("" ::: "memory");
    }
#undef V_PREFETCH
}
typedef float f32x16 __attribute__((ext_vector_type(16)));
template <int MODE>
__device__ __forceinline__ void peer_v4_phase(const Frame& F, const Args& A) {
    const int* IDX = (const int*)(A.ws + WS_P + P_IDX); const float* AK = (const float*)(A.ws + WS_AK);
    float* out = A.out;
    const int l = F.lane, n = l & 31, hq = l >> 5, step = F.G * NWAVES;
    const GAS unsigned char* vb = (const GAS unsigned char*)(A.ws + WS_V8);
    const unsigned lconst = 16u * (unsigned)n;
    const bool diag = ((l >> 4) & 1) == hq;
    const unsigned bytem = diag ? (0xFFu << (8 * (l & 3))) : 0u; const int dsel = (l & 15) >> 2;
    const unsigned M0 = dsel == 0 ? bytem : 0u, M1 = dsel == 1 ? bytem : 0u, M2 = dsel == 2 ? bytem : 0u, M3 = dsel == 3 ? bytem : 0u;
    const int rsel = 4 * hq;
    const int sc1 = 0x7F7F7F7F;
    const int colb = 32 * n + 4 * hq;
    int tok = F.bid * NWAVES + F.wave;
    int ne0, ne1; float na0, na1;
#define V4_PREFETCH(t) do { const size_t _t = (size_t)(t) * 128; ne0 = IDX[_t + l]; ne1 = IDX[_t + 64 + l]; na0 = AK[_t + l]; na1 = AK[_t + 64 + l]; } while (0)
#define V4_LOADS(R, ro_, h) do { int ba_ = rsel + 4 * (16 * (h)); _Pragma("unroll") for (int j_ = 0; j_ < 8; ++j_) { asm volatile("" : "+v"(ba_)); const int o_ = __builtin_amdgcn_ds_bpermute(ba_, (ro_)); ba_ += 8; \
        R[j_] = *(const GAS u32x4*)(vb + ((unsigned)o_ + lconst)); } } while (0)
#define V4_ONE(ACC, R, rep_, h, j_) do { unsigned s0_ = (unsigned)__builtin_amdgcn_readlane((int)(rep_), 16 * (h) + 2 * (j_)), s1_ = (unsigned)__builtin_amdgcn_readlane((int)(rep_), 16 * (h) + 2 * (j_) + 1); \
        asm volatile("" : "+s"(s0_), "+s"(s1_), "+v"(ACC)); \
        const i32x8 a8_ = {(int)(s0_ & M0), (int)(s0_ & M1), (int)(s0_ & M2), (int)(s0_ & M3), (int)(s1_ & M0), (int)(s1_ & M1), (int)(s1_ & M2), (int)(s1_ & M3)}; \
        const i32x4 r4_ = __builtin_bit_cast(i32x4, R[j_]); \
        ACC = __builtin_amdgcn_mfma_scale_f32_32x32x64_f8f6f4(a8_, __builtin_shufflevector(r4_, r4_, 0, 1, 2, 3, -1, -1, -1, -1), ACC, 0, 4, 0, sc1, 0, sc1); } while (0)
#define V4_COMPUTE(R, rep_, h) do { V4_ONE(acc, R, rep_, h, 0); V4_ONE(acc1, R, rep_, h, 1); V4_ONE(acc, R, rep_, h, 2); V4_ONE(acc1, R, rep_, h, 3); \
        V4_ONE(acc, R, rep_, h, 4); V4_ONE(acc1, R, rep_, h, 5); V4_ONE(acc, R, rep_, h, 6); V4_ONE(acc1, R, rep_, h, 7); } while (0)
    u32x4 RA[8], RB[8];
    if (tok < T_TOK) { V4_PREFETCH(tok); V4_LOADS(RA, ne0 * 512, 0); }
    for (; tok < T_TOK; tok += step) {
        const int e0 = ne0, e1 = ne1; const float a0 = na0, a1 = na1;
        const int ro0 = e0 * 512, ro1 = e1 * 512;
        const bool more = tok + step < T_TOK;
        V4_LOADS(RB, ro0, 1);
        if (more) V4_PREFETCH(tok + step);
        const float am = wave_max_nonneg(fmaxf(fabsf(a0), fabsf(a1)));
        const float sc = am > 0.f ? 224.f * __builtin_amdgcn_rcpf(am) : 0.f, inv = am * (1.f / 224.f);
        const unsigned w8 = (unsigned)__builtin_amdgcn_cvt_pk_fp8_f32(a0 * sc, a1 * sc, 0, false);
        const unsigned rep0 = (w8 & 0xffu) * 0x01010101u, rep1 = ((w8 >> 8) & 0xffu) * 0x01010101u;
        f32x16 acc, acc1;
#pragma unroll
        for (int i = 0; i < 16; ++i) { acc[i] = 0.f; acc1[i] = 0.f; }
        V4_COMPUTE(RA, rep0, 0); V4_LOADS(RA, ro0, 2);
        V4_COMPUTE(RB, rep0, 1); V4_LOADS(RB, ro0, 3);
        V4_COMPUTE(RA, rep0, 2); V4_LOADS(RA, ro1, 0);
        V4_COMPUTE(RB, rep0, 3); V4_LOADS(RB, ro1, 1);
        V4_COMPUTE(RA, rep1, 0); V4_LOADS(RA, ro1, 2);
        V4_COMPUTE(RB, rep1, 1); V4_LOADS(RB, ro1, 3);
        f32x4 H[4];
        { const float* hp = out + (size_t)tok * D + colb;
#pragma unroll
          for (int j = 0; j < 4; ++j) H[j] = *(const f32x4*)(hp + 8 * j); }
        V4_COMPUTE(RA, rep1, 2);
        if (more) V4_LOADS(RA, ne0 * 512, 0);
        V4_COMPUTE(RB, rep1, 3);
        acc = acc + acc1;
        float ss = 0.f;
#pragma unroll
        for (int j = 0; j < 4; ++j) { H[j] = H[j] + (f32x4){acc[4 * j], acc[4 * j + 1], acc[4 * j + 2], acc[4 * j + 3]} * inv;
            ss += (H[j].x * H[j].x + H[j].y * H[j].y) + (H[j].z * H[j].z + H[j].w * H[j].w); }
        const float rstd = 1.f / sqrtf(wave_sum(ss) * (1.f / D) + EPS);
        { float* hp = out + (size_t)tok * D + colb;
#pragma unroll
          for (int j = 0; j < 4; ++j) *(f32x4*)(hp + 8 * j) = H[j] * rstd * *(const f32x4*)(A.in[I_FG] + colb + 8 * j); }
    }
#undef V4_PREFETCH
#undef V4_LOADS
#undef V4_COMPUTE
#undef V4_ONE
}
__device__ __forceinline__ void final_norm_phase(const Frame& F, const Args& A) {
    const int gw = F.bid * NWAVES + F.wave, NGW = F.G * NWAVES, l = F.lane; const float* fg = A.in[I_FG];
    const f32x4* gp = (const f32x4*)fg + l;
    int tok = gw;
    for (; tok + 3 * NGW < T_TOK; tok += 4 * NGW) {
        f32x4 v[4][4]; float ss[4];
#pragma unroll
        for (int b = 0; b < 4; ++b) { const f32x4* hp = (const f32x4*)(A.out + (size_t)(tok + b * NGW) * D) + l;
#pragma unroll
            for (int j = 0; j < 4; ++j) v[b][j] = hp[64 * j]; }
#pragma unroll
        for (int b = 0; b < 4; ++b) { ss[b] = 0.f;
#pragma unroll
            for (int j = 0; j < 4; ++j) ss[b] += (v[b][j].x * v[b][j].x + v[b][j].y * v[b][j].y) + (v[b][j].z * v[b][j].z + v[b][j].w * v[b][j].w); }
#pragma unroll
        for (int o = 1; o < 64; o <<= 1) {
#pragma unroll
            for (int b = 0; b < 4; ++b) ss[b] += __shfl_xor(ss[b], o); }
#pragma unroll
        for (int b = 0; b < 4; ++b) { const float rstd = 1.f / sqrtf(ss[b] * (1.f / D) + EPS); f32x4* hp = (f32x4*)(A.out + (size_t)(tok + b * NGW) * D) + l;
#pragma unroll
            for (int j = 0; j < 4; ++j) hp[64 * j] = v[b][j] * rstd * gp[64 * j]; }
    }
    for (; tok < T_TOK; tok += NGW) { f32x4* hp = (f32x4*)(A.out + (size_t)tok * D) + l; f32x4 v[4]; float ss = 0.f;
#pragma unroll
        for (int j = 0; j < 4; ++j) { v[j] = hp[64 * j]; ss += (v[j].x * v[j].x + v[j].y * v[j].y) + (v[j].z * v[j].z + v[j].w * v[j].w); }
        const float rstd = 1.f / sqrtf(wave_sum(ss) * (1.f / D) + EPS);
#pragma unroll
        for (int j = 0; j < 4; ++j) hp[64 * j] = v[j] * rstd * gp[64 * j]; }
}

#ifdef DEBUG_CHECK
constexpr size_t WS_DBG = 472 * MiB;
__device__ __forceinline__ int dbg_tok(int i) { return (i * 509 + 3) & 32767; }
__device__ __forceinline__ float gelu_ref(float x) { return 0.5f * x * (1.f + tanhf(0.7978845608028654f * (x + 0.044715f * x * x * x))); }
__global__ void __launch_bounds__(512) dbg_scores(Args a) {
    __shared__ float n2s[1024]; __shared__ float q[2048];
    const int t = dbg_tok(blockIdx.x), tid = threadIdx.x;
    const bf16_t* N2 = (const bf16_t*)(a.ws + WS_N1); const float* SC = (const float*)(a.ws + WS_P + P_SC); unsigned* dbg = (unsigned*)(a.ws + WS_DBG);
    for (int k = tid; k < 1024; k += 512) n2s[k] = bf1(N2[(size_t)t * 1024 + k]);
    __syncthreads();
    for (int r = 0; r < 4; ++r) { const int c = tid + 512 * r; float s = 0.f; for (int k = 0; k < 1024; ++k) s += n2s[k] * a.in[I_WQ][(size_t)k * 2048 + c]; q[c] = s; }
    __syncthreads();
    float md = 0.f;
    for (int r = 0; r < 4; ++r) { const int n = tid + 512 * r, hh = n >> 7, key = n & 127; const float* kX = (hh & 1) ? a.in[I_K2] : a.in[I_K1];
        float s = 0.f; for (int d = 0; d < 128; ++d) s += q[hh * 128 + d] * kX[key * 128 + d];
        md = fmaxf(md, fabsf(s - SC[(size_t)n * T_TOK + t])); }
    atomicMax(&dbg[0], __builtin_bit_cast(unsigned, md));
}
__global__ void __launch_bounds__(64) dbg_topk(Args a) {
    __shared__ float s1[8][128], s2[8][128], cv[8][256]; __shared__ float t1v[8][16], t2v[8][16]; __shared__ int t1i[8][16], t2i[8][16], exi[8][16]; __shared__ float exv[8][16];
    const int t = dbg_tok(blockIdx.x), h = threadIdx.x;
    const float* SC = (const float*)(a.ws + WS_P + P_SC); const int* IDX = (const int*)(a.ws + WS_P + P_IDX); const float* GATE = (const float*)(a.ws + WS_P + P_GATE); unsigned* dbg = (unsigned*)(a.ws + WS_DBG);
    if (h >= 8) return;
    for (int j = 0; j < 128; ++j) { s1[h][j] = SC[(size_t)(h * 256 + j) * T_TOK + t]; s2[h][j] = SC[(size_t)(h * 256 + 128 + j) * T_TOK + t]; }
    for (int r = 0; r < 16; ++r) { int b1 = 0, b2 = 0; for (int j = 1; j < 128; ++j) { if (s1[h][j] > s1[h][b1]) b1 = j; if (s2[h][j] > s2[h][b2]) b2 = j; }
        t1v[h][r] = s1[h][b1]; t1i[h][r] = b1; s1[h][b1] = -1e30f; t2v[h][r] = s2[h][b2]; t2i[h][r] = b2; s2[h][b2] = -1e30f; }
    for (int c = 0; c < 256; ++c) cv[h][c] = t1v[h][c >> 4] + t2v[h][c & 15];
    for (int r = 0; r < 16; ++r) { int bc = 0; for (int c = 1; c < 256; ++c) if (cv[h][c] > cv[h][bc]) bc = c;
        exv[h][r] = cv[h][bc]; exi[h][r] = t1i[h][bc >> 4] * 128 + t2i[h][bc & 15]; cv[h][bc] = -1e30f; }
    float sum = 0.f; const float mx0 = exv[h][0]; for (int r = 0; r < 16; ++r) { exv[h][r] = expf(exv[h][r] - mx0); } for (int r = 0; r < 16; ++r) sum += exv[h][r];
    unsigned miss = 0; float gd = 0.f;
    for (int w = 0; w < 16; ++w) { const int e = IDX[(size_t)t * 128 + h * 16 + w]; const float g = GATE[(size_t)t * 128 + h * 16 + w]; bool found = false;
        for (int r = 0; r < 16; ++r) if (exi[h][r] == e) { found = true; gd = fmaxf(gd, fabsf(g - exv[h][r] / sum)); }
        if (!found) ++miss; }
    atomicAdd(&dbg[1], miss); atomicMax(&dbg[3], __builtin_bit_cast(unsigned, gd));
}
__global__ void __launch_bounds__(512) dbg_experts_pre(Args a) {
    __shared__ float n2s[1024]; __shared__ float ak[128]; __shared__ int ek[128]; __shared__ float red[8];
    const int t = dbg_tok(blockIdx.x), tid = threadIdx.x, lane = tid & 63, wave = tid >> 6;
    const bf16_t* N2 = (const bf16_t*)(a.ws + WS_N1); const int* IDX = (const int*)(a.ws + WS_P + P_IDX); const float* GATE = (const float*)(a.ws + WS_P + P_GATE);
    float* rows = (float*)(a.ws + WS_DBG + MiB);
    for (int k = tid; k < 1024; k += 512) n2s[k] = bf1(N2[(size_t)t * 1024 + k]);
    if (tid < 128) ek[tid] = IDX[(size_t)t * 128 + tid];
    __syncthreads();
    for (int k = wave * 16; k < wave * 16 + 16; ++k) { const float* u = a.in[I_PU] + (size_t)ek[k] * 1024; float s = 0.f; for (int j = lane; j < 1024; j += 64) s += u[j] * n2s[j];
        s = wave_sum(s); if (lane == 0) ak[k] = gelu_ref(s) * GATE[(size_t)t * 128 + k]; }
    __syncthreads();
    float h2[2]; float ss = 0.f;
    for (int r = 0; r < 2; ++r) { const int d = tid + 512 * r; float o = 0.f; for (int k = 0; k < 128; ++k) o += ak[k] * a.in[I_PV][(size_t)ek[k] * 1024 + d]; h2[r] = a.out[(size_t)t * 1024 + d] + o; ss += h2[r] * h2[r]; }
    ss = wave_sum(ss); if (lane == 0) red[wave] = ss; __syncthreads();
    float tot = 0.f; for (int w = 0; w < 8; ++w) tot += red[w];
    const float rstd = 1.f / sqrtf(tot / 1024.f + EPS);
    for (int r = 0; r < 2; ++r) { const int d = tid + 512 * r; rows[(size_t)blockIdx.x * 1024 + d] = h2[r] * rstd * a.in[I_FG][d]; }
}
__global__ void __launch_bounds__(512) dbg_experts_post(Args a) {
    const int t = dbg_tok(blockIdx.x), tid = threadIdx.x; const float* rows = (const float*)(a.ws + WS_DBG + MiB); float* dbgf = (float*)(a.ws + WS_DBG);
    float e = 0.f, n = 0.f;
    for (int r = 0; r < 2; ++r) { const int d = tid + 512 * r; const float x = rows[(size_t)blockIdx.x * 1024 + d], y = a.out[(size_t)t * 1024 + d]; e += (x - y) * (x - y); n += x * x; }
    e = wave_sum(e); n = wave_sum(n); if ((tid & 63) == 0) { atomicAdd(&dbgf[4], e); atomicAdd(&dbgf[5], n); }
}
__global__ void __launch_bounds__(512) dbg_report(Args a, int which) {
    const unsigned* dbg = (const unsigned*)(a.ws + WS_DBG); const float* dbgf = (const float*)(a.ws + WS_DBG);
    const float mA = dbgf[0], gd = dbgf[3]; const unsigned miss = dbg[1]; const float relC = sqrtf(dbgf[4] / fmaxf(dbgf[5], 1e-30f));
    float X;
    if (which == 0) { int mask = 0; if (mA > 0.05f) mask |= 1; if (miss > 400u) mask |= 2; if (relC > 0.05f) mask |= 4; if (gd > 0.02f) mask |= 8; X = 1000.f + 100.f * mask; }
    else if (which == 1) X = 1e6f * mA; else if (which == 2) X = 100.f + (float)miss; else if (which == 3) X = 1e6f * relC; else X = 1e6f * gd;
    for (size_t i = (size_t)blockIdx.x * 512 + threadIdx.x; i < (size_t)T_TOK * D; i += (size_t)gridDim.x * 512) a.out[i] = (i == 0) ? X : 0.f;
}
#endif

constexpr int NPH = 13;
__global__ void __launch_bounds__(NWAVES * 64, 2) fwd_kernel(Args args) {
    extern __shared__ __attribute__((aligned(16))) unsigned char lds_raw[];
    Frame F;
    F.lds = (LAS unsigned char*)lds_raw;
    F.tid = threadIdx.x; F.lane = F.tid & 63; F.wave = __builtin_amdgcn_readfirstlane(F.tid >> 6);
    F.G = gridDim.x; F.bid = blockIdx.x;
    volatile LAS unsigned* MISC = (volatile LAS unsigned*)(F.lds + MISC_OFF);
    for (int u = F.tid; u < (LDS_BYTES - LDSCTL_OFF) / 4; u += NWAVES * 64) ((LAS unsigned*)(F.lds + LDSCTL_OFF))[u] = 0u;
    __syncthreads();
    unsigned* ctl = (unsigned*)(args.ws + WS_CTL);
    const int lo = args.ph_lo, hi = args.ph_hi;
    XcdBarrier bar; bar.bar = ctl + CW_BAR + args.li * XCD_BAR_WORDS; bar.x = 0; bar.st = nullptr; bar.wave = F.wave;
    if (hi - lo > 1) bar = xcd_barrier_post(ctl + CW_BAR + args.li * XCD_BAR_WORDS, MISC + 8, F.wave);
#define IN(k) (lo <= (k) && (k) < hi)
#ifdef PROBE_TS
#define STAMP(k) do { if (F.bid == 0 && F.tid == 0) ((unsigned long long*)(args.ws + (472u << 20)))[(k)] = __builtin_amdgcn_s_memrealtime(); } while (0)
#else
#define STAMP(k) do { } while (0)
#endif
#define SEAM(k) do { if (IN(k) && IN((k) + 1)) { xcd_barrier(bar); if (XTRA_BAR) xcd_barrier(bar); } STAMP((k) + 1); } while (0)
    unsigned char* ws = args.ws;
    bf16_t* P = (bf16_t*)(ws + WS_P);

#define REFRESH() do { int z_ = 0; asm volatile("" : "+s"(z_)); F.lane = (int)__builtin_amdgcn_mbcnt_hi(~0u, __builtin_amdgcn_mbcnt_lo(~0u, (unsigned)z_)); F.tid = F.wave * 64 + F.lane; } while (0)
    STAMP(0);
    if (IN(0)) { phase0(F, args); SEAM(0); }
    if (IN(1)) { REFRESH();
        if (F8_LO > 0) { pg8::Gemm g{(const bf16_t*)(ws + WS_N1), (const bf16_t*)(ws + WS_WIN), T_TOK, F8_LO * 256, D, D}; pg8::StaticOrder S; S.init(T_TOK, F8_LO * 256, F.G, F.bid);
            pg8::EpiProj E{P, (float*)(ws + WS_ALR), 0}; pg8::gemm_phase<pg8::EpiProj, pg8::StaticOrder, false, true, false>(F.lds, g, S, E, F.wave); }
        if (F8_LO < 21) {
            pg8::Gemm g{(const bf16_t*)(ws + WS_N18), (const bf16_t*)(ws + WS_W8 + (size_t)F8_LO * 256 * 1024), T_TOK, (21 - F8_LO) * 256, D / 2, D / 2, 0x7B7B7B7B, 0x75757575};
            pg8::StaticOrder S; S.init(T_TOK, (21 - F8_LO) * 256, F.G, F.G - 1 - F.bid);
            pg8::EpiProj E{P, (float*)(ws + WS_ALR), F8_LO}; pg8::gemm_phase<pg8::EpiProj, pg8::StaticOrder, false, true, true>(F.lds, g, S, E, F.wave); }
        {
            REFRESH();
            const int nwg = (T_TOK / 256) * (NPROJ / 256), rem = nwg % F.G;
            if (rem == 0) convert_tables(F, args, F.bid * NWAVES + F.wave, F.G * NWAVES);
            else if (F.bid >= rem) convert_tables(F, args, (F.bid - rem) * NWAVES + F.wave, (F.G - rem) * NWAVES);
        }
        SEAM(1);
    }
    if (IN(2)) { REFRESH();
        if (DRY_EXP == 12) { gla_chunk_phase<true>(F, args); for (int it = F.bid; it < 1024; it += F.G) sgu_unit<true>(F, args, it); __syncthreads(); }
        gla_chunk_phase<false>(F, args);
        for (int it = F.bid; it < 1024; it += F.G) sgu_unit<false>(F, args, it);
        SEAM(2);
    }
    if (IN(3)) { REFRESH(); if (DRY_EXP == 13 || DRY_EXP == 15) { gla_scan<true>(F, args); __syncthreads(); } gla_scan<false>(F, args); SEAM(3); }
    if (IN(4)) { REFRESH(); if (DRY_EXP == 14 || DRY_EXP == 15) { gla_out_phase<true>(F, args); __syncthreads(); } gla_out_phase<false>(F, args); SEAM(4); }
    if (IN(5)) { REFRESH();
        { pg8::Gemm g{P + PC_Q, (const bf16_t*)(ws + WS_WA), T_TOK, D, 512, PLD}; pg8::StaticOrder S; S.init(T_TOK, D, F.G, F.bid);
          pg8::EpiBrA E{P}; pg8::gemm_phase<pg8::EpiBrA, pg8::StaticOrder, true, true>(F.lds, g, S, E, F.wave); }
        { pg8::Gemm g{P + PC_SU, (const bf16_t*)(ws + WS_WB), T_TOK, D, 512, PLD}; pg8::StaticOrder S; S.init(T_TOK, D, F.G, F.bid);
          pg8::EpiBrB E{P}; pg8::gemm_phase<pg8::EpiBrB, pg8::StaticOrder, true, true>(F.lds, g, S, E, F.wave); }
        SEAM(5);
    }
    if (IN(6)) { REFRESH();
        pg8::Gemm g{P + PC_MRG, (const bf16_t*)(ws + WS_WOUT), T_TOK, D, D, PLD}; pg8::StaticOrder S; S.init(T_TOK, D, F.G, F.bid);
        pg8::EpiOut E{args.in[I_X], args.out}; pg8::gemm_phase<pg8::EpiOut, pg8::StaticOrder, true, true>(F.lds, g, S, E, F.wave);
        SEAM(6);
    }
    if (IN(7)) { REFRESH();
        const int gw = F.bid * NWAVES + F.wave, NGW = F.G * NWAVES;
        { int m = gw; for (; m + 3 * NGW < T_TOK; m += 4 * NGW) rms_rows_to_bf16<(SC_F8 ? 2 : 3), 4>(F.lane, args.out + (size_t)m * D, (size_t)NGW * D, args.in[I_N2G], (bf16_t*)(ws + WS_N1) + (size_t)m * D, (size_t)NGW * D, (unsigned*)(ws + WS_P + P_X8) + (size_t)m * 256, (size_t)NGW * 256);
          for (; m < T_TOK; m += NGW) rms_rows_to_bf16<(SC_F8 ? 2 : 3), 1>(F.lane, args.out + (size_t)m * D, 0, args.in[I_N2G], (bf16_t*)(ws + WS_N1) + (size_t)m * D, 0, (unsigned*)(ws + WS_P + P_X8) + (size_t)m * 256, 0); }
        SEAM(7);
    }
    if (IN(8)) { REFRESH();
        pg8::StaticOrder S; S.init(T_TOK, 2048, F.G, F.bid); pg8::EpiScores E{(bf16_t*)(ws + WS_P + P_SC)};
        if (SC_F8) { pg8::Gemm g{(const bf16_t*)(ws + WS_P + P_X8), (const bf16_t*)(ws + WS_WQF), T_TOK, 2048, D / 2, D / 2, 0x7B7B7B7B, 0x75757575};
            pg8::gemm_phase<pg8::EpiScores, pg8::StaticOrder, true, true, true>(F.lds, g, S, E, F.wave); }
        else { pg8::Gemm g{(const bf16_t*)(ws + WS_N1), (const bf16_t*)(ws + WS_WQF), T_TOK, 2048, D, D};
            pg8::gemm_phase<pg8::EpiScores, pg8::StaticOrder, true, true>(F.lds, g, S, E, F.wave); }
        SEAM(8);
    }
    if (IN(9)) { REFRESH(); peer_topk(F, args); SEAM(9); }
    if (IN(10)) { REFRESH(); if constexpr (UNG == 1) peer_u4_all<0>(F, args); else peer_u4_phase<0>(F, args); SEAM(10); }
    if (IN(11)) { REFRESH(); if (V_F4) peer_v4_phase<0>(F, args); else { if (DRY_EXP == 1) { peer_v_phase<1>(F, args); __syncthreads(); } peer_v_phase<0>(F, args); SEAM(11); } }
    if (IN(12)) { REFRESH(); if (!V_F4) final_norm_phase(F, args); }
#undef IN
#undef SEAM
}


#ifdef PROBE_TS
__global__ void __launch_bounds__(512) probe_report(Args a, int pi, int pj) {
    const unsigned long long* ts = (const unsigned long long*)(a.ws + (472u << 20));
    const float X1 = 10.f * (float)(ts[pi + 1] - ts[pi]) * 0.01f, X2 = (float)(ts[pj + 1] - ts[pj]) * 0.01f;
    for (size_t i = (size_t)blockIdx.x * 512 + threadIdx.x; i < (size_t)T_TOK * D; i += (size_t)gridDim.x * 512) a.out[i] = (i == 0) ? X1 : X2;
}
#endif
#ifdef PROBE_MFMA
__global__ void __launch_bounds__(64) probe_mfma(Args a) {
    const int l = threadIdx.x;
    i32x4 av = {0, 0, 0, 0};
    if (l == PROBE_L) av[PROBE_P >> 3] = 0x2 << (4 * (PROBE_P & 7));
    i32x8 b1, b2;
    for (int r = 0; r < 8; ++r) { unsigned w1 = 0, w2 = 0;
        for (int c = 0; c < 4; ++c) { const int b = 4 * r + c; int t = 0;
            t = __builtin_amdgcn_cvt_pk_fp8_f32((float)((b & 15) + 1), (float)(1 + (b >> 4) + 2 * (l >> 4)), 0, false);
            w1 |= ((unsigned)t & 0xffu) << (8 * c); w2 |= (((unsigned)t >> 8) & 0xffu) << (8 * c); }
        b1[r] = (int)w1; b2[r] = (int)w2; }
    const f32x4 z = {0.f, 0.f, 0.f, 0.f};
    const f32x4 d1 = __builtin_amdgcn_mfma_scale_f32_16x16x128_f8f6f4(__builtin_shufflevector(av, av, 0, 1, 2, 3, -1, -1, -1, -1), b1, z, 4, 0, 0, 0x7F7F7F7F, 0, 0x7F7F7F7F);
    const f32x4 d2 = __builtin_amdgcn_mfma_scale_f32_16x16x128_f8f6f4(__builtin_shufflevector(av, av, 0, 1, 2, 3, -1, -1, -1, -1), b2, z, 4, 0, 0, 0x7F7F7F7F, 0, 0x7F7F7F7F);
    float* st = (float*)(a.ws + (472u << 20));
    *(f32x4*)(st + 8 * l) = d1; *(f32x4*)(st + 8 * l + 4) = d2;
}
__global__ void __launch_bounds__(512) probe_mfma_report(Args a) {
    const int row = PROBE_L & 15;
    const float* st = (const float*)(a.ws + (472u << 20)) + 8 * (16 * (row >> 2)) + (row & 3); const float X1 = 10.f * st[0], X2 = st[4];
    for (size_t i = (size_t)blockIdx.x * 512 + threadIdx.x; i < (size_t)T_TOK * D; i += (size_t)gridDim.x * 512) a.out[i] = (i == 0) ? X1 : X2;
}
#endif
extern "C" void kernel_launch(void* const* d_in, const int* in_sizes, int n_in, void* d_out, int out_size, void* d_ws, size_t ws_size, hipStream_t stream) {
    static int grid = 0;
    if (grid == 0) {
        if (n_in != 20 || in_sizes[0] != T_TOK * D || out_size != T_TOK * D || ws_size < WS_END) {
            fprintf(stderr, "kernel_launch: unexpected shapes: n_in %d in0 %d out %d ws %zu (need %zu)\n", n_in, n_in > 0 ? in_sizes[0] : -1, out_size, ws_size, (size_t)WS_END); grid = -1; return; }
        int dev = 0, cus = 0;
        if (hipGetDevice(&dev) != hipSuccess || hipDeviceGetAttribute(&cus, hipDeviceAttributeMultiprocessorCount, dev) != hipSuccess) { grid = -1; return; }
        if (hipFuncSetAttribute((const void*)fwd_kernel, hipFuncAttributeMaxDynamicSharedMemorySize, LDS_BYTES) != hipSuccess) { fprintf(stderr, "kernel_launch: hipFuncSetAttribute failed\n"); grid = -1; return; }
        int per_cu = 0;
        if (hipOccupancyMaxActiveBlocksPerMultiprocessor(&per_cu, (const void*)fwd_kernel, NWAVES * 64, LDS_BYTES) != hipSuccess || per_cu < 1) fprintf(stderr, "kernel_launch: occupancy query says %d\n", per_cu);
        (void)hipGetLastError();
        grid = cus;
    }
    if (grid < 0) return;
    (void)hipMemsetAsync((char*)d_ws + WS_CTL, 0, CTL_ZERO_BYTES, stream);
    Args a{};
    for (int i = 0; i < 20; ++i) a.in[i] = (const float*)d_in[i];
    a.out = (float*)d_out; a.ws = (unsigned char*)d_ws;
#ifdef PROBE_MFMA
    hipLaunchKernelGGL(probe_mfma, dim3(1), dim3(64), 0, stream, a);
    hipLaunchKernelGGL(probe_mfma_report, dim3(1024), dim3(512), 0, stream, a);
    return;
#endif
#ifndef LAUNCH_LIST
#define LAUNCH_LIST {0, NPH}
#endif
    static const int ranges[][2] = { LAUNCH_LIST };
    const int nl = (int)(sizeof(ranges) / sizeof(ranges[0]));
    for (int li = 0; li < nl; ++li) { a.ph_lo = ranges[li][0]; a.ph_hi = ranges[li][1]; a.li = li;
        hipLaunchKernelGGL(fwd_kernel, dim3(grid), dim3(NWAVES * 64), LDS_BYTES, stream, a); }
}
```

```cpp
#include <hip/hip_runtime.h>
#include <cstdio>
#include <cstdint>


#ifndef XTRA_BAR
#define XTRA_BAR 0
#endif
#ifndef DRY_EXP
#define DRY_EXP 0
#endif
#ifndef DUP_PHASE
#define DUP_PHASE -1
#endif
#ifndef MK_N_LAUNCHES
#define MK_N_LAUNCHES 1
#endif

#define LAS __attribute__((address_space(3)))
#define GAS __attribute__((address_space(1)))
typedef unsigned short bf16_t;
typedef short bf16x8 __attribute__((ext_vector_type(8)));
typedef float f32x4 __attribute__((ext_vector_type(4)));
typedef float f32x2 __attribute__((ext_vector_type(2)));
typedef unsigned u32x4 __attribute__((ext_vector_type(4)));
typedef unsigned u32x2 __attribute__((ext_vector_type(2)));
typedef int i32x4 __attribute__((ext_vector_type(4)));
typedef int i32x8 __attribute__((ext_vector_type(8)));
typedef __bf16 bf16x2_t __attribute__((ext_vector_type(2)));

constexpr int T_TOK = 32768, D = 1024, SEQ = 4096, NBATCH = 8;
constexpr int NPROJ = 5376;
constexpr int PLD = 5120;
constexpr int PC_Q = 0, PC_K = 512, PC_V = 1024, PC_R = 1536, PC_SU = 2048, PC_SV = 2560, PC_GA = 3072, PC_GB = 4096;
constexpr int PC_MRG = 512;
constexpr float EPS = 1e-6f;
constexpr int NEXP = 16384;
#ifndef U_NG
#define U_NG 1
#endif
#ifndef V_F4
#define V_F4 1
#endif
#ifndef SC_F8
#define SC_F8 0
#endif
#ifndef F8_LO
#define F8_LO 11
#endif
constexpr int UNG = U_NG, UNG_SH = (U_NG == 8 ? 3 : (U_NG == 4 ? 2 : (U_NG == 2 ? 1 : 0)));

constexpr size_t MiB = 1u << 20;
constexpr size_t WS_CTL = 0, CTL_ZERO_BYTES = 64 * 1024;
constexpr size_t WS_WIN = 1 * MiB;
constexpr size_t WS_WA = 12 * MiB;
constexpr size_t WS_WB = 13 * MiB;
constexpr size_t WS_WOUT = 14 * MiB;
constexpr size_t WS_WQF = 16 * MiB;
constexpr size_t WS_U8 = 20 * MiB;
constexpr size_t WS_V8 = 36 * MiB;
constexpr size_t WS_SU = 52 * MiB;
constexpr size_t WS_SV = 52 * MiB + 65536;
constexpr size_t WS_AK = 53 * MiB;
constexpr size_t WS_DEC = 84 * MiB;
constexpr size_t WS_ALR = 85 * MiB;
constexpr size_t WS_N1 = 87 * MiB;
constexpr size_t WS_P = 151 * MiB;
constexpr size_t WS_W8 = 472 * MiB;
constexpr size_t WS_N18 = 478 * MiB;
constexpr size_t WS_END = 510 * MiB;
constexpr size_t P_SC = 0, P_IDX = 256 * MiB, P_GATE = 272 * MiB, P_X8 = 288 * MiB;

constexpr int CW_BAR = 4096;

constexpr int RING_BYTES = 131072;
constexpr int LDSCTL_OFF = RING_BYTES, MISC_OFF = LDSCTL_OFF + 320;
constexpr int LDS_BYTES = 147456;
constexpr int NWAVES = 8;

__device__ __forceinline__ unsigned pk2(float lo, float hi) { const f32x2 v = {lo, hi}; const bf16x2_t b = __builtin_convertvector(v, bf16x2_t); return __builtin_bit_cast(unsigned, b); }
__device__ __forceinline__ unsigned f2bf(float f) { return pk2(f, 0.f) & 0xffffu; }
__device__ __forceinline__ float bflo(unsigned w) { return __builtin_bit_cast(float, w << 16); }
__device__ __forceinline__ float bfhi(unsigned w) { return __builtin_bit_cast(float, w & 0xffff0000u); }
__device__ __forceinline__ float bf1(bf16_t h) { return __builtin_bit_cast(float, ((unsigned)h) << 16); }
__device__ __forceinline__ float sigmoidf_(float x) { return __builtin_amdgcn_rcpf(1.f + __expf(-x)); }
__device__ __forceinline__ float gelu_tanh(float x) { const float y = 1.5957691216057308f * (x + 0.044715f * x * x * x); return x * sigmoidf_(y); }
__device__ __forceinline__ float siluf_(float x) { return x * sigmoidf_(x); }
__device__ __forceinline__ float wave_sum(float v) {
#pragma unroll
    for (int o = 1; o < 64; o <<= 1) v += __shfl_xor(v, o);
    return v;
}
#define LDS_WAIT() asm volatile("s_waitcnt lgkmcnt(0)" ::: "memory")
#define VM_WAIT() asm volatile("s_waitcnt vmcnt(0)" ::: "memory")

__device__ __forceinline__ int lane_now() { int z = 0; asm volatile("" : "+s"(z)); return (int)__builtin_amdgcn_mbcnt_hi(~0u, __builtin_amdgcn_mbcnt_lo(~0u, (unsigned)z)); }
namespace pg8 {
constexpr int BM = 256, BK = 64, HALF = 128, HTB = HALF * BK * 2, STAGE_BYTES = 8 * HTB, NXCD = 8, WGM = 8;
__host__ __device__ __forceinline__ int lds_byte(int r, int c) { const int st = (r >> 4) * 2 + (c >> 5), rr = r & 15, cc = c & 31, ob = rr * 64 + cc * 2; return st * 1024 + (ob ^ (((ob >> 9) & 1) << 5)); }
__host__ __device__ __forceinline__ void stage_rc(int b, int& R, int& C) { const int st = b / 1024, sb = b % 1024, swz = sb ^ (((sb >> 9) & 1) << 5); R = (st >> 1) * 16 + swz / 64; C = (st & 1) * 32 + (swz % 64) / 2; }
__host__ __device__ __forceinline__ int perm32(int rho) { const int n = rho >> 4, i = rho & 15; return 8 * (i >> 2) + 4 * n + (i & 3); }

struct Unit { int pm, pn; };
struct Gemm { const bf16_t* A; const bf16_t* Bt; int M, N, K, lda; int sa = 0, sb = 0; };

struct StaticOrder {
    int nM, nN, nwg, G, c;
    __host__ __device__ void init(int M, int N, int G_, int c_) { nM = M / BM; nN = N / BM; nwg = nM * nN; G = G_; c = c_; }
    __host__ __device__ bool next(int i, Unit& u) const {
        const long L = (long)i * G + c; if (L >= nwg) return false;
        int wgid = (int)L; { const int q = nwg / NXCD, r = nwg % NXCD, xcd = wgid % NXCD, off = wgid / NXCD; wgid = (xcd < r ? xcd * (q + 1) : r * (q + 1) + (xcd - r) * q) + off; }
        const int nig = WGM * nN, gid = wgid / nig, fm = gid * WGM, gsz = (nM - fm) < WGM ? (nM - fm) : WGM;
        u.pm = fm + ((wgid % nig) % gsz); u.pn = (wgid % nig) / gsz; return true;
    }
    __device__ __forceinline__ void a_ready(const Unit&) const {}
    __device__ __forceinline__ void done(const Unit&) const {}
};

template <class Epi, class Sched, bool ALIGN_EPI = false, bool SP2 = false, bool F8 = false>
__device__ __forceinline__ void gemm_phase(LAS unsigned char* lds, const Gemm g, const Sched& S, const Epi& E, int wave_id) {
    const int wid = wave_id, lane = lane_now(), tid = wid * 64 + lane, wr = wid >> 2, wc = wid & 3, fr = lane & 15, fq = lane >> 4;
    const int K = g.K, nt = K / BK, lda = g.lda; const int scA = g.sa, scB = g.sb; (void)scA; (void)scB;
    unsigned voffA[2], voffB[2];
#pragma unroll
    for (int i = 0; i < 2; ++i) { int R, C; stage_rc(tid * 16 + i * 8192, R, C); const int Rb = Epi::PERM ? ((R & ~31) + perm32(R & 31)) : R;
        voffA[i] = (unsigned)(R * lda + C) * 2u; voffB[i] = (unsigned)(Rb * K + C) * 2u; }
    const size_t kstep = (size_t)(BK * 2);
    const size_t hstepA = (size_t)HALF * lda * 2, hstepB = (size_t)HALF * K * 2;
    const size_t tstepA = 2 * hstepA, tstepB = 2 * hstepB;
    const unsigned ldsw = (unsigned)wid * 1024u; const unsigned ldsbase = (unsigned)(__UINTPTR_TYPE__)lds + ldsw;
    const int aoff = lds_byte(wr * 64 + fr, fq * 8), boff = lds_byte(wc * 32 + fr, fq * 8);
#define PG8_SA(b, h) (((b) * 2 + (h)) * HTB)
#define PG8_SB(b, h) ((4 + (b) * 2 + (h)) * HTB)
#define PG8_STAGE(bufoff, gbase, voff) do { _Pragma("unroll") for (int _i = 0; _i < 2; ++_i) \
        asm volatile("s_mov_b32 m0, %2\n\ts_nop 0\n\tglobal_load_lds_dwordx4 %0, %1" :: "v"((voff)[_i]), "s"((const char*)(gbase)), "s"(ldsbase + (unsigned)((bufoff) + _i * 8192)) : "memory", "m0"); } while (0)
#define PG8_LDA(dst, b, h) do { _Pragma("unroll") for (int m = 0; m < 4; ++m) _Pragma("unroll") for (int k = 0; k < 2; ++k) dst[m][k] = *(const LAS bf16x8*)(lds + PG8_SA(b, h) + aoff + m * 2048 + k * 1024); } while (0)
#define PG8_LDB(dst, b, h) do { _Pragma("unroll") for (int n = 0; n < 2; ++n) _Pragma("unroll") for (int k = 0; k < 2; ++k) dst[n][k] = *(const LAS bf16x8*)(lds + PG8_SB(b, h) + boff + n * 2048 + k * 1024); } while (0)
#define PG8_CAT(x) __builtin_shufflevector(__builtin_bit_cast(i32x4, (x)[0]), __builtin_bit_cast(i32x4, (x)[1]), 0, 1, 2, 3, 4, 5, 6, 7)
#define PG8_MMA(ai, bj, At, Bt) do { __builtin_amdgcn_s_setprio(1); if constexpr (F8) { _Pragma("unroll") for (int m = 0; m < 4; ++m) _Pragma("unroll") for (int n = 0; n < 2; ++n) \
        acc[ai][bj][m][n] = __builtin_amdgcn_mfma_scale_f32_16x16x128_f8f6f4(PG8_CAT(Bt[n]), PG8_CAT(At[m]), acc[ai][bj][m][n], 0, 0, 0, scB, 0, scA); } else { \
        _Pragma("unroll") for (int m = 0; m < 4; ++m) _Pragma("unroll") for (int n = 0; n < 2; ++n) _Pragma("unroll") for (int k = 0; k < 2; ++k) \
        acc[ai][bj][m][n] = __builtin_amdgcn_mfma_f32_16x16x32_bf16(Bt[n][k], At[m][k], acc[ai][bj][m][n], 0, 0, 0); } __builtin_amdgcn_s_setprio(0); } while (0)
#define PG8_WAIT_V(n) asm volatile("s_waitcnt vmcnt(" #n ")" ::: "memory")
#define PG8_WAIT_L(n) asm volatile("s_waitcnt lgkmcnt(" #n ")" ::: "memory")
#define PG8_BAR __builtin_amdgcn_s_barrier()
#define PG8_SCHED __builtin_amdgcn_sched_barrier(0)
    Unit cur, nxt; int ui = 0;
    if (!S.next(0, cur)) return;
    f32x4 acc[2][2][4][2];
#pragma unroll
    for (int a = 0; a < 2; ++a)
#pragma unroll
        for (int b = 0; b < 2; ++b)
#pragma unroll
            for (int m = 0; m < 4; ++m)
#pragma unroll
                for (int n = 0; n < 2; ++n) acc[a][b][m][n] = (f32x4){0.f, 0.f, 0.f, 0.f};
    bf16x8 At[4][2], B0[2][2], B1[2][2];
    const char* cA = (const char*)g.A + (size_t)cur.pm * tstepA; const char* cB = (const char*)g.Bt + (size_t)cur.pn * tstepB;
    S.a_ready(cur);
    if constexpr (SP2) {
        PG8_STAGE(PG8_SB(0, 0), cB, voffB); PG8_STAGE(PG8_SB(0, 1), cB + hstepB, voffB); PG8_STAGE(PG8_SA(0, 0), cA, voffA); PG8_STAGE(PG8_SA(0, 1), cA + hstepA, voffA);
        if (wr == 1) PG8_BAR;
        PG8_WAIT_V(2); PG8_BAR;
        PG8_STAGE(PG8_SB(1, 0), cB + kstep, voffB); PG8_STAGE(PG8_SA(1, 0), cA + kstep, voffA); PG8_STAGE(PG8_SB(1, 1), cB + hstepB + kstep, voffB);
        PG8_WAIT_V(6); PG8_BAR;
    } else {
        PG8_STAGE(PG8_SB(0, 0), cB, voffB); PG8_STAGE(PG8_SA(0, 0), cA, voffA); PG8_STAGE(PG8_SB(0, 1), cB + hstepB, voffB); PG8_STAGE(PG8_SA(0, 1), cA + hstepA, voffA);
        if (wr == 1) PG8_BAR;
        PG8_WAIT_V(4); PG8_BAR;
        PG8_STAGE(PG8_SB(1, 0), cB + kstep, voffB); PG8_STAGE(PG8_SA(1, 0), cA + kstep, voffA); PG8_STAGE(PG8_SB(1, 1), cB + hstepB + kstep, voffB);
        PG8_WAIT_V(6); PG8_BAR;
    }
    for (;;) {
        const bool has_next = S.next(ui + 1, nxt);
        const char* nA = has_next ? (const char*)g.A + (size_t)nxt.pm * tstepA : cA; const char* nB = has_next ? (const char*)g.Bt + (size_t)nxt.pn * tstepB : cB;
#pragma nounroll
        for (int t = 0; t < nt; t += 2) {
            const bool last = (t == nt - 2);
            const char* a1 = cA + (size_t)(t + 1) * kstep;
            const char* a2 = last ? nA : cA + (size_t)(t + 2) * kstep; const char* b2 = last ? nB : cB + (size_t)(t + 2) * kstep;
            const char* a3 = a2 + kstep; const char* b3 = b2 + kstep;
            if (last && has_next) S.a_ready(nxt);
            if constexpr (SP2) {
            PG8_LDB(B0, 0, 0); PG8_LDB(B1, 0, 1); PG8_SCHED; PG8_LDA(At, 0, 0); PG8_STAGE(PG8_SA(1, 1), a1 + hstepA, voffA);
            PG8_WAIT_V(8); PG8_WAIT_L(0); PG8_BAR; PG8_MMA(0, 0, At, B0); PG8_MMA(0, 1, At, B1); PG8_BAR; PG8_SCHED;
            PG8_LDA(At, 0, 1); PG8_STAGE(PG8_SB(0, 0), b2, voffB); PG8_STAGE(PG8_SB(0, 1), b2 + hstepB, voffB); PG8_STAGE(PG8_SA(0, 0), a2, voffA);
            PG8_WAIT_V(8); PG8_WAIT_L(0); PG8_BAR; PG8_MMA(1, 0, At, B0); PG8_MMA(1, 1, At, B1); PG8_BAR; PG8_SCHED;
            PG8_LDB(B0, 1, 0); PG8_LDB(B1, 1, 1); PG8_SCHED; PG8_LDA(At, 1, 0); PG8_STAGE(PG8_SA(0, 1), a2 + hstepA, voffA);
            PG8_WAIT_V(8); PG8_WAIT_L(0); PG8_BAR; PG8_MMA(0, 0, At, B0); PG8_MMA(0, 1, At, B1); PG8_BAR; PG8_SCHED;
            PG8_LDA(At, 1, 1); PG8_STAGE(PG8_SB(1, 0), b3, voffB); PG8_STAGE(PG8_SB(1, 1), b3 + hstepB, voffB); PG8_STAGE(PG8_SA(1, 0), a3, voffA);
            PG8_WAIT_V(8); PG8_WAIT_L(0); PG8_BAR; PG8_MMA(1, 0, At, B0); PG8_MMA(1, 1, At, B1); PG8_BAR; PG8_SCHED;
            } else {
            PG8_LDB(B0, 0, 0); PG8_SCHED; PG8_LDA(At, 0, 0); PG8_STAGE(PG8_SA(1, 1), a1 + hstepA, voffA);
            PG8_WAIT_L(8); PG8_BAR; PG8_WAIT_L(0); PG8_MMA(0, 0, At, B0); PG8_BAR; PG8_SCHED;
            PG8_LDB(B1, 0, 1); PG8_STAGE(PG8_SB(0, 0), b2, voffB);
            PG8_BAR; PG8_WAIT_L(0); PG8_MMA(0, 1, At, B1); PG8_BAR;
            PG8_LDA(At, 0, 1); PG8_STAGE(PG8_SA(0, 0), a2, voffA);
            PG8_BAR; PG8_WAIT_L(0); PG8_MMA(1, 0, At, B0); PG8_BAR; PG8_SCHED;
            PG8_STAGE(PG8_SB(0, 1), b2 + hstepB, voffB);
            PG8_WAIT_V(6); PG8_BAR; PG8_MMA(1, 1, At, B1); PG8_BAR;
            PG8_LDB(B0, 1, 0); PG8_SCHED; PG8_LDA(At, 1, 0); PG8_STAGE(PG8_SA(0, 1), a2 + hstepA, voffA);
            PG8_WAIT_L(8); PG8_BAR; PG8_WAIT_L(0); PG8_MMA(0, 0, At, B0); PG8_BAR; PG8_SCHED;
            PG8_LDB(B1, 1, 1); PG8_STAGE(PG8_SB(1, 0), b3, voffB);
            PG8_BAR; PG8_WAIT_L(0); PG8_MMA(0, 1, At, B1); PG8_BAR;
            PG8_LDA(At, 1, 1); PG8_STAGE(PG8_SA(1, 0), a3, voffA);
            PG8_BAR; PG8_WAIT_L(0); PG8_MMA(1, 0, At, B0); PG8_BAR; PG8_SCHED;
            PG8_STAGE(PG8_SB(1, 1), b3 + hstepB, voffB);
            PG8_WAIT_V(6); PG8_BAR; PG8_MMA(1, 1, At, B1); PG8_BAR;
            }
        }
        if constexpr (ALIGN_EPI) { if (wr == 0) PG8_BAR; }
        E(acc, cur, wr, wc, fr, fq); S.done(cur);
        if (!has_next) break;
#pragma unroll
        for (int a = 0; a < 2; ++a)
#pragma unroll
            for (int b = 0; b < 2; ++b)
#pragma unroll
                for (int m = 0; m < 4; ++m)
#pragma unroll
                    for (int n = 0; n < 2; ++n) acc[a][b][m][n] = (f32x4){0.f, 0.f, 0.f, 0.f};
        cur = nxt; cA = nA; cB = nB; ++ui;
        if constexpr (ALIGN_EPI) { if (wr == 1) PG8_BAR; }
    }
    PG8_WAIT_V(0);
    if constexpr (!ALIGN_EPI) { if (wr == 0) PG8_BAR; }
    PG8_BAR;
#undef PG8_SA
#undef PG8_SB
#undef PG8_STAGE
#undef PG8_LDA
#undef PG8_LDB
#undef PG8_MMA
#undef PG8_CAT
#undef PG8_WAIT_V
#undef PG8_WAIT_L
#undef PG8_BAR
#undef PG8_SCHED
}

__device__ __forceinline__ u32x4 pack8(f32x4 v0, f32x4 v1) { u32x4 w; w.x = pk2(v0[0], v0[1]); w.y = pk2(v0[2], v0[3]); w.z = pk2(v1[0], v1[1]); w.w = pk2(v1[2], v1[3]); return w; }
__device__ __forceinline__ void unpack8(u32x4 w, f32x4& v0, f32x4& v1) { v0 = (f32x4){bflo(w.x), bfhi(w.x), bflo(w.y), bfhi(w.y)}; v1 = (f32x4){bflo(w.z), bfhi(w.z), bflo(w.w), bfhi(w.w)}; }

struct EpiProj {
    static constexpr bool PERM = true;
    bf16_t* P; float* ALR; int pn0;
    __device__ __forceinline__ void operator()(const f32x4 (&acc)[2][2][4][2], const Unit& u, int wr, int wc, int fr, int fq) const {
        asm volatile("" : "+v"(fr), "+v"(fq));
        const int row0 = u.pm * BM + wr * 64 + fr; int pn = u.pn + pn0; const int cl = wc * 32 + 8 * fq;
        if (pn == 10) {
            if (wc == 0 && fq < 2) {
#pragma unroll
                for (int ai = 0; ai < 2; ++ai)
#pragma unroll
                    for (int m = 0; m < 4; ++m) { float* rp = ALR + (size_t)(row0 + ai * HALF + m * 16) * 16 + 8 * fq;
                        *(f32x4*)rp = acc[ai][0][m][0]; *(f32x4*)(rp + 4) = acc[ai][0][m][1]; }
            }
            return;
        }
        if (pn > 10) --pn;
        const int mode = pn < 8 ? 0 : (pn < 12 ? 1 : 2);
#pragma unroll
        for (int ai = 0; ai < 2; ++ai)
#pragma unroll
            for (int m = 0; m < 4; ++m) { bf16_t* rowp = P + (size_t)(row0 + ai * HALF + m * 16) * PLD + pn * BM + cl;
#pragma unroll
                for (int bj = 0; bj < 2; ++bj) { f32x4 v0 = acc[ai][bj][m][0], v1 = acc[ai][bj][m][1];
                    if (mode == 1) {
#pragma unroll
                        for (int i = 0; i < 4; ++i) { v0[i] = gelu_tanh(v0[i]); v1[i] = gelu_tanh(v1[i]); }
                    } else if (mode == 2) {
#pragma unroll
                        for (int i = 0; i < 4; ++i) { v0[i] = sigmoidf_(v0[i]); v1[i] = sigmoidf_(v1[i]); }
                    }
                    *(u32x4*)(rowp + bj * HALF) = pack8(v0, v1); } }
    }
};
struct EpiBrA {
    static constexpr bool PERM = true;
    bf16_t* P;
    __device__ __forceinline__ void operator()(const f32x4 (&acc)[2][2][4][2], const Unit& u, int wr, int wc, int fr, int fq) const {
        const int row0 = u.pm * BM + wr * 64 + fr; const int c0 = u.pn * BM + wc * 32 + 8 * fq;
#pragma unroll
        for (int ai = 0; ai < 2; ++ai)
#pragma unroll
            for (int m = 0; m < 4; ++m) { bf16_t* rowp = P + (size_t)(row0 + ai * HALF + m * 16) * PLD;
#pragma unroll
                for (int bj = 0; bj < 2; ++bj) { const int c = c0 + bj * HALF; f32x4 g0, g1; unpack8(*(const u32x4*)(rowp + PC_GA + c), g0, g1);
                    *(u32x4*)(rowp + PC_MRG + c) = pack8(acc[ai][bj][m][0] * g0, acc[ai][bj][m][1] * g1); } }
    }
};
struct EpiBrB {
    static constexpr bool PERM = true;
    bf16_t* P;
    __device__ __forceinline__ void operator()(const f32x4 (&acc)[2][2][4][2], const Unit& u, int wr, int wc, int fr, int fq) const {
        const int row0 = u.pm * BM + wr * 64 + fr; const int c0 = u.pn * BM + wc * 32 + 8 * fq;
#pragma unroll
        for (int ai = 0; ai < 2; ++ai)
#pragma unroll
            for (int m = 0; m < 4; ++m) { bf16_t* rowp = P + (size_t)(row0 + ai * HALF + m * 16) * PLD;
#pragma unroll
                for (int bj = 0; bj < 2; ++bj) { const int c = c0 + bj * HALF; f32x4 g0, g1, p0, p1; unpack8(*(const u32x4*)(rowp + PC_GB + c), g0, g1); unpack8(*(const u32x4*)(rowp + PC_MRG + c), p0, p1);
                    *(u32x4*)(rowp + PC_MRG + c) = pack8(p0 + acc[ai][bj][m][0] * g0, p1 + acc[ai][bj][m][1] * g1); } }
    }
};
struct EpiOut {
    static constexpr bool PERM = true;
    const float* X; float* O;
    __device__ __forceinline__ void operator()(const f32x4 (&acc)[2][2][4][2], const Unit& u, int wr, int wc, int fr, int fq) const {
        const int row0 = u.pm * BM + wr * 64 + fr; const int c0 = u.pn * BM + wc * 32 + 8 * fq;
#pragma unroll
        for (int ai = 0; ai < 2; ++ai)
#pragma unroll
            for (int m = 0; m < 4; ++m) { const size_t ro = (size_t)(row0 + ai * HALF + m * 16) * D;
#pragma unroll
                for (int bj = 0; bj < 2; ++bj) { const int c = c0 + bj * HALF;
                    const f32x4 x0 = *(const f32x4*)(X + ro + c), x1 = *(const f32x4*)(X + ro + c + 4);
                    *(f32x4*)(O + ro + c) = x0 + acc[ai][bj][m][0]; *(f32x4*)(O + ro + c + 4) = x1 + acc[ai][bj][m][1]; } }
    }
};
struct EpiScores {
    static constexpr bool PERM = true;
    bf16_t* SC;
    __device__ __forceinline__ void operator()(const f32x4 (&acc)[2][2][4][2], const Unit& u, int wr, int wc, int fr, int fq) const {
        const int tb0 = u.pm * 16 + wr * 4; const int cq0 = (u.pn * BM + wc * 32 + 8 * fq) >> 3;
#pragma unroll
        for (int ai = 0; ai < 2; ++ai)
#pragma unroll
            for (int m = 0; m < 4; ++m) { bf16_t* bp = SC + ((size_t)(tb0 + ai * 8 + m) * 256) * 128 + fr * 8;
#pragma unroll
                for (int bj = 0; bj < 2; ++bj) *(u32x4*)(bp + (size_t)(cq0 + bj * 16) * 128) = pack8(acc[ai][bj][m][0], acc[ai][bj][m][1]); }
    }
};
}

#define XB_TMO      128
#define XB_XCNT(j)  (256  + 64 * (j))
#define XB_XSUB(j)  (1280 + 64 * (j))
#define XB_XGEN(j)  (2304 + 64 * (j))
#define XB_TOP      3328
#define XB_TOPGEN   3392
#define XCD_BAR_WORDS 3456
#define XB_SPIN_CAP (1u << 18)
__device__ __forceinline__ unsigned xb_ld(unsigned* p)              { return __hip_atomic_load(p, __ATOMIC_RELAXED, __HIP_MEMORY_SCOPE_AGENT); }
__device__ __forceinline__ unsigned xb_add(unsigned* p, unsigned v) { return __hip_atomic_fetch_add(p, v, __ATOMIC_RELAXED, __HIP_MEMORY_SCOPE_AGENT); }
__device__ __forceinline__ unsigned xb_xcc_id() { return (unsigned)__builtin_amdgcn_s_getreg((3 << 11) | 20) & 0xFu; }
#define XB_SPIN(cond, bar) do { unsigned _sp = 0; while (cond) { __builtin_amdgcn_s_sleep(1); \
    if ((++_sp & 255u) == 0u) { if (xb_ld(&(bar)[XB_TMO])) break; if (_sp > XB_SPIN_CAP) { atomicAdd(&(bar)[XB_TMO], 1u); break; } } } } while (0)
struct XcdBarrier { unsigned* bar; unsigned x; volatile LAS unsigned* st; int wave; };
__device__ __forceinline__ XcdBarrier xcd_barrier_post(unsigned* bar, volatile LAS unsigned* st, int wave) {
    XcdBarrier b; b.bar = bar; b.x = xb_xcc_id(); b.st = st; b.wave = wave;
    if (wave == 0 && lane_now() == 0) (void)xb_add(&bar[XB_XCNT(b.x)], 1u);
    return b;
}
__device__ __forceinline__ void xcd_barrier_complete(unsigned* bar, unsigned x, unsigned& nloc, unsigned& nx) {
    const unsigned G = gridDim.x * gridDim.y * gridDim.z;
    unsigned sum, cnt, mine, sp = 0u;
    for (;;) {
        sum = 0u; cnt = 0u; mine = 0u;
#pragma unroll
        for (unsigned j = 0; j < 16; ++j) { const unsigned c = xb_ld(&bar[XB_XCNT(j)]); sum += c; cnt += (c > 0u) ? 1u : 0u; mine = (j == x) ? c : mine; }
        if (sum == G) break;
        __builtin_amdgcn_s_sleep(1);
        if ((++sp & 255u) == 0u) { if (xb_ld(&bar[XB_TMO])) break; if (sp > XB_SPIN_CAP) { atomicAdd(&bar[XB_TMO], 1u); break; } }
    }
    nloc = mine > 0u ? mine : 1u; nx = cnt > 0u ? cnt : 1u;
}
__device__ __forceinline__ void xcd_barrier(const XcdBarrier& b) {
    asm volatile("s_waitcnt vmcnt(0)" ::: "memory");
    __syncthreads();
    if (b.wave == 0 && lane_now() == 0) {
        unsigned* bar = b.bar;
        __builtin_amdgcn_s_waitcnt(0);
        unsigned nloc = b.st[0], nx = b.st[1];
        if (nloc == 0u) { xcd_barrier_complete(bar, b.x, nloc, nx); b.st[0] = nloc; b.st[1] = nx; }
        const unsigned old = xb_add(&bar[XB_XSUB(b.x)], 1u);
        const unsigned gen = old / nloc;
        if (old + 1u == (gen + 1u) * nloc) {
            __builtin_amdgcn_fence(__ATOMIC_RELEASE, "agent");
            asm volatile("s_waitcnt vmcnt(0)" ::: "memory");
            const unsigned og = xb_add(&bar[XB_TOP], 1u);
            const unsigned tg = og / nx;
            if (og + 1u == (tg + 1u) * nx) xb_add(&bar[XB_TOPGEN], 1u);
            else XB_SPIN(xb_ld(&bar[XB_TOPGEN]) == tg, bar);
            __builtin_amdgcn_fence(__ATOMIC_ACQUIRE, "agent");
            xb_add(&bar[XB_XGEN(b.x)], 1u);
            asm volatile("s_waitcnt vmcnt(0)" ::: "memory");
        } else {
            XB_SPIN(xb_ld(&bar[XB_XGEN(b.x)]) == gen, bar);
            __builtin_amdgcn_fence(__ATOMIC_ACQUIRE, "agent");
            asm volatile("s_waitcnt vmcnt(0)" ::: "memory");
        }
    }
    __syncthreads();
}

struct Args {
    const float* in[20]; float* out; unsigned char* ws; int ph_lo, ph_hi, li, pad;
};
enum { I_X = 0, I_N1G, I_WIN, I_WGU, I_BG, I_GLAG, I_SLNG, I_SLNB, I_SW, I_SB, I_WBA, I_WBB, I_WOUT, I_N2G, I_WQ, I_K1, I_K2, I_PU, I_PV, I_FG };

struct Frame {
    LAS unsigned char* lds;
    int tid, lane, wave, G, bid;
};

__device__ __forceinline__ float clamp448(float v) { return __builtin_amdgcn_fmed3f(v, -448.f, 448.f); }
template <int MODE, bool F8 = false>
__device__ __forceinline__ void p0_transpose_item(const float* W, int K, int Nsrc, int Ndst, bf16_t* WT, LAS float* scr, int item, int lane, float sc8 = 1.f) {
    const int nblk = Ndst / 32, kb = item / nblk, nb = item % nblk, k0 = 64 * kb, n0 = 32 * nb;
    const int nd = n0 + (lane & 31);
    int sc = nd; bool valid = true;
    if (MODE == 1) { if (nd < 2048) sc = nd; else if (nd < 2560) sc = nd + 16; else if (nd < 2576) sc = 2048 + (nd - 2560); else if (nd < 2816) { sc = 0; valid = false; } else sc = nd - 240; }
#pragma unroll 8
    for (int i = 0; i < 32; ++i) { const int kk = 2 * i + (lane >> 5); const float v = valid ? W[(size_t)(k0 + kk) * Nsrc + sc] : 0.f; scr[kk * 33 + (lane & 31)] = v; }
    LDS_WAIT(); asm volatile("" ::: "memory");
    if (F8) {
        const int c = lane & 3;
#pragma unroll
        for (int j = 0; j < 2; ++j) { const int n = (lane >> 2) + 16 * j; const LAS float* s = scr + (16 * c) * 33 + n; u32x4 o;
#pragma unroll
            for (int q = 0; q < 4; ++q) { int w = 0; w = __builtin_amdgcn_cvt_pk_fp8_f32(clamp448(s[(4 * q) * 33] * sc8), clamp448(s[(4 * q + 1) * 33] * sc8), w, false);
                w = __builtin_amdgcn_cvt_pk_fp8_f32(clamp448(s[(4 * q + 2) * 33] * sc8), clamp448(s[(4 * q + 3) * 33] * sc8), w, true); o[q] = (unsigned)w; }
            *(u32x4*)((unsigned char*)WT + (size_t)(n0 + n) * K + k0 + 16 * c) = o; }
    } else {
    const int c = lane & 7;
#pragma unroll
    for (int j = 0; j < 4; ++j) { const int n = (lane >> 3) + 8 * j; const LAS float* s = scr + (8 * c) * 33 + n;
        u32x4 o; o.x = pk2(s[0 * 33], s[1 * 33]); o.y = pk2(s[2 * 33], s[3 * 33]); o.z = pk2(s[4 * 33], s[5 * 33]); o.w = pk2(s[6 * 33], s[7 * 33]);
        *(u32x4*)(WT + (size_t)(n0 + n) * K + k0 + 8 * c) = o; }
    }
    LDS_WAIT(); asm volatile("" ::: "memory");
}
template <int OM, int NB>
__device__ __forceinline__ void rms_rows_to_bf16(int lane, const float* x0, size_t xstride, const float* g, bf16_t* o0, size_t ostride, unsigned* o80 = nullptr, size_t o8stride = 0) {
    f32x4 v[NB][4]; float s[NB];
#pragma unroll
    for (int b = 0; b < NB; ++b) { const f32x4* xr = (const f32x4*)(x0 + b * xstride) + lane;
#pragma unroll
        for (int j = 0; j < 4; ++j) v[b][j] = xr[64 * j]; }
#pragma unroll
    for (int b = 0; b < NB; ++b) { s[b] = 0.f;
#pragma unroll
        for (int j = 0; j < 4; ++j) s[b] += (v[b][j].x * v[b][j].x + v[b][j].y * v[b][j].y) + (v[b][j].z * v[b][j].z + v[b][j].w * v[b][j].w); }
#pragma unroll
    for (int o = 1; o < 64; o <<= 1) {
#pragma unroll
        for (int b = 0; b < NB; ++b) s[b] += __shfl_xor(s[b], o); }
    const f32x4* gr = (const f32x4*)g + lane;
#pragma unroll
    for (int b = 0; b < NB; ++b) { const float rstd = 1.f / sqrtf(s[b] * (1.f / D) + EPS); u32x2* o8 = (u32x2*)(o0 + b * ostride) + lane;
#pragma unroll
        for (int j = 0; j < 4; ++j) { const f32x4 gg = gr[64 * j]; const f32x4 y = v[b][j] * rstd * gg; u32x2 o; o.x = pk2(y.x, y.y); o.y = pk2(y.z, y.w); if (OM & 1) o8[64 * j] = o;
            if (OM == 3) { int w = 0; w = __builtin_amdgcn_cvt_pk_fp8_f32(clamp448(bflo(o.x) * 16.f), clamp448(bfhi(o.x) * 16.f), w, false); w = __builtin_amdgcn_cvt_pk_fp8_f32(clamp448(bflo(o.y) * 16.f), clamp448(bfhi(o.y) * 16.f), w, true); (o80 + b * o8stride)[64 * j + lane] = (unsigned)w; }
            if (OM == 2) { int w = 0; w = __builtin_amdgcn_cvt_pk_fp8_f32(clamp448(y.x * 16.f), clamp448(y.y * 16.f), w, false); w = __builtin_amdgcn_cvt_pk_fp8_f32(clamp448(y.z * 16.f), clamp448(y.w * 16.f), w, true); (o80 + b * o8stride)[64 * j + lane] = (unsigned)w; } } }
}
__device__ __forceinline__ float wave_max(float v) {
#pragma unroll
    for (int o = 1; o < 64; o <<= 1) v = fmaxf(v, __shfl_xor(v, o));
    return v;
}
template <int NB>
__device__ __forceinline__ void cvt_rows_fp8(int lane, const float* const (&src)[NB], unsigned char* const (&dst16)[NB], float* const (&scale_out)[NB]) {
    f32x4 v[NB][4]; float m[NB];
#pragma unroll
    for (int b = 0; b < NB; ++b) {
#pragma unroll
        for (int j = 0; j < 4; ++j) v[b][j] = *(const GAS f32x4*)(src[b] + 16 * lane + 4 * j); }
#pragma unroll
    for (int b = 0; b < NB; ++b) { m[b] = 0.f;
#pragma unroll
        for (int j = 0; j < 4; ++j) m[b] = fmaxf(m[b], fmaxf(fmaxf(fabsf(v[b][j].x), fabsf(v[b][j].y)), fmaxf(fabsf(v[b][j].z), fabsf(v[b][j].w)))); }
#pragma unroll
    for (int o = 1; o < 64; o <<= 1) {
#pragma unroll
        for (int b = 0; b < NB; ++b) m[b] = fmaxf(m[b], __shfl_xor(m[b], o)); }
#pragma unroll
    for (int b = 0; b < NB; ++b) { const float inv = m[b] > 0.f ? 224.f / m[b] : 0.f, sc = m[b] > 0.f ? m[b] * (1.f / 224.f) : 1.f;
        u32x4 o;
#pragma unroll
        for (int j = 0; j < 4; ++j) { int w = 0; w = __builtin_amdgcn_cvt_pk_fp8_f32(v[b][j].x * inv, v[b][j].y * inv, w, false); w = __builtin_amdgcn_cvt_pk_fp8_f32(v[b][j].z * inv, v[b][j].w * inv, w, true); o[j] = (unsigned)w; }
        *(GAS u32x4*)dst16[b] = o;
        if (lane == 0) *(GAS float*)scale_out[b] = sc; }
}
__device__ __forceinline__ unsigned fp4_code(float t) { const float a = fabsf(t);
    const unsigned c = (unsigned)(a >= 0.25f) + (unsigned)(a >= 0.75f) + (unsigned)(a >= 1.25f) + (unsigned)(a >= 1.75f) + (unsigned)(a >= 2.5f) + (unsigned)(a >= 3.5f) + (unsigned)(a >= 5.f);
    return c | (t < 0.f ? 8u : 0u); }
template <int NB>
__device__ __forceinline__ void cvt_rows_fp4(int lane, const float* const (&src)[NB], unsigned char* const (&dst8)[NB], float* const (&scale_out)[NB]) {
    f32x4 v[NB][4]; float m[NB];
#pragma unroll
    for (int b = 0; b < NB; ++b) {
#pragma unroll
        for (int j = 0; j < 4; ++j) v[b][j] = *(const GAS f32x4*)(src[b] + 16 * lane + 4 * j); }
#pragma unroll
    for (int b = 0; b < NB; ++b) { m[b] = 0.f;
#pragma unroll
        for (int j = 0; j < 4; ++j) m[b] = fmaxf(m[b], fmaxf(fmaxf(fabsf(v[b][j].x), fabsf(v[b][j].y)), fmaxf(fabsf(v[b][j].z), fabsf(v[b][j].w)))); }
#pragma unroll
    for (int o = 1; o < 64; o <<= 1) {
#pragma unroll
        for (int b = 0; b < NB; ++b) m[b] = fmaxf(m[b], __shfl_xor(m[b], o)); }
#pragma unroll
    for (int b = 0; b < NB; ++b) { const float inv = m[b] > 0.f ? 6.f / m[b] : 0.f, sc = m[b] > 0.f ? m[b] * (1.f / 6.f) : 1.f;
        u32x2 o;
#pragma unroll
        for (int h = 0; h < 2; ++h) { unsigned w = 0;
#pragma unroll
            for (int j = 0; j < 2; ++j) { const f32x4 t = v[b][2 * h + j] * inv;
                w |= (fp4_code(t.x) | (fp4_code(t.y) << 4) | (fp4_code(t.z) << 8) | (fp4_code(t.w) << 12)) << (16 * j); }
            o[h] = w; }
        *(GAS u32x2*)dst8[b] = o;
        if (lane == 0) *(GAS float*)scale_out[b] = sc; }
}
__device__ __forceinline__ void convert_tables(const Frame& F, const Args& A, int wi, int nw) {
    unsigned char* ws = A.ws; const int gw = wi, NGW = nw;
    {
        int mc = gw;
        for (; mc + 3 * NGW < NEXP; mc += 4 * NGW) { const float* src[4]; unsigned char* dst[4]; float* sco[4];
#pragma unroll
            for (int b = 0; b < 4; ++b) { const int e = mc + b * NGW; src[b] = A.in[I_PU] + (size_t)e * D; dst[b] = ws + WS_U8 + (size_t)((e & (UNG - 1)) * (NEXP / UNG) + (e >> UNG_SH)) * 512 + 8 * F.lane; sco[b] = (float*)(ws + WS_SU) + e; }
            cvt_rows_fp4<4>(F.lane, src, dst, sco); }
        for (; mc < NEXP; mc += NGW) { const float* src[1]; unsigned char* dst[1]; float* sco[1];
            const int e = mc; src[0] = A.in[I_PU] + (size_t)e * D; dst[0] = ws + WS_U8 + (size_t)((e & (UNG - 1)) * (NEXP / UNG) + (e >> UNG_SH)) * 512 + 8 * F.lane; sco[0] = (float*)(ws + WS_SU) + e;
            cvt_rows_fp4<1>(F.lane, src, dst, sco); }
    }
    if (V_F4) {
        int mc = gw;
        for (; mc + 3 * NGW < NEXP; mc += 4 * NGW) { const float* src[4]; unsigned char* dst[4]; float* sco[4];
#pragma unroll
            for (int b = 0; b < 4; ++b) { const int e = mc + b * NGW; src[b] = A.in[I_PV] + (size_t)e * D; dst[b] = ws + WS_V8 + (size_t)e * 512 + 8 * F.lane; sco[b] = (float*)(ws + WS_SV) + e; }
            cvt_rows_fp4<4>(F.lane, src, dst, sco); }
        for (; mc < NEXP; mc += NGW) { const float* src[1]; unsigned char* dst[1]; float* sco[1];
            const int e = mc; src[0] = A.in[I_PV] + (size_t)e * D; dst[0] = ws + WS_V8 + (size_t)e * 512 + 8 * F.lane; sco[0] = (float*)(ws + WS_SV) + e;
            cvt_rows_fp4<1>(F.lane, src, dst, sco); }
    } else {
        int mc = gw;
        for (; mc + 3 * NGW < NEXP; mc += 4 * NGW) { const float* src[4]; unsigned char* dst[4]; float* sco[4];
#pragma unroll
            for (int b = 0; b < 4; ++b) { const int e = mc + b * NGW; src[b] = A.in[I_PV] + (size_t)e * D; dst[b] = ws + WS_V8 + ((size_t)(F.lane >> 3) * NEXP + e) * 128 + 16 * (F.lane & 7); sco[b] = (float*)(ws + WS_SV) + e; }
            cvt_rows_fp8<4>(F.lane, src, dst, sco); }
        for (; mc < NEXP; mc += NGW) { const float* src[1]; unsigned char* dst[1]; float* sco[1];
            const int e = mc; src[0] = A.in[I_PV] + (size_t)e * D; dst[0] = ws + WS_V8 + ((size_t)(F.lane >> 3) * NEXP + e) * 128 + 16 * (F.lane & 7); sco[0] = (float*)(ws + WS_SV) + e;
            cvt_rows_fp8<1>(F.lane, src, dst, sco); }
    }
}
__device__ __forceinline__ void phase0(const Frame& F, const Args& A) {
    unsigned char* ws = A.ws;
    if (!SC_F8) {
        const int l = F.lane, fr = l & 15, q = l >> 4;
        bf16_t* WQF = (bf16_t*)(ws + WS_WQF);
        for (int it = F.bid * NWAVES + F.wave; it < 2048; it += F.G * NWAVES) {
            const int kh = it & 1, kt = (it >> 1) & 63, hh = it >> 7;
            const float* kX = (hh & 1) ? A.in[I_K2] : A.in[I_K1];
            const float* ap = A.in[I_WQ] + (size_t)(kt * 16 + fr) * 2048 + hh * 128 + 4 * q;
            f32x4 a[8];
#pragma unroll
            for (int t = 0; t < 8; ++t) a[t] = *(const f32x4*)(ap + 16 * t);
#pragma unroll
            for (int kb = 0; kb < 4; ++kb) { const int key0 = kh * 64 + kb * 16;
                const float* bp = kX + (size_t)(key0 + fr) * 128 + 4 * q;
                f32x4 b[8];
#pragma unroll
                for (int t = 0; t < 8; ++t) b[t] = *(const f32x4*)(bp + 16 * t);
                f32x4 d = {0.f, 0.f, 0.f, 0.f};
#pragma unroll
                for (int t = 0; t < 8; ++t)
#pragma unroll
                    for (int c = 0; c < 4; ++c) d = __builtin_amdgcn_mfma_f32_16x16x4f32(a[t][c], b[t][c], d, 0, 0, 0);
                u32x2 o; o.x = pk2(d[0], d[1]); o.y = pk2(d[2], d[3]);
                *(u32x2*)(WQF + (size_t)(hh * 128 + key0 + fr) * 1024 + kt * 16 + 4 * q) = o; }
        }
    } else {
        LAS float* kx = (LAS float*)F.lds;
        LAS float* wt = (LAS float*)(F.lds + 128 * 129 * 4);
        bf16_t* WQF = (bf16_t*)(ws + WS_WQF);
        for (int it = F.bid; it < 512; it += F.G) {
            const int hh = it >> 5, kblk = it & 31, k0 = kblk * 32;
            const float* kX = (hh & 1) ? A.in[I_K2] : A.in[I_K1];
            __syncthreads();
            for (int e = F.tid; e < 128 * 128; e += 512) kx[(e >> 7) * 129 + (e & 127)] = kX[e];
            for (int e = F.tid; e < 32 * 128; e += 512) wt[e] = A.in[I_WQ][(size_t)(k0 + (e >> 7)) * 2048 + hh * 128 + (e & 127)];
            __syncthreads();
            const int key = F.tid & 127, kq = F.tid >> 7;
            float acc[8];
#pragma unroll
            for (int i = 0; i < 8; ++i) acc[i] = 0.f;
            for (int d = 0; d < 128; ++d) { const float b = kx[key * 129 + d];
#pragma unroll
                for (int i = 0; i < 8; ++i) acc[i] += wt[(kq * 8 + i) * 128 + d] * b; }
            if (SC_F8) { u32x2 o;
#pragma unroll
                for (int h2 = 0; h2 < 2; ++h2) { int w = 0; w = __builtin_amdgcn_cvt_pk_fp8_f32(clamp448(acc[4 * h2] * 1024.f), clamp448(acc[4 * h2 + 1] * 1024.f), w, false);
                    w = __builtin_amdgcn_cvt_pk_fp8_f32(clamp448(acc[4 * h2 + 2] * 1024.f), clamp448(acc[4 * h2 + 3] * 1024.f), w, true); o[h2] = (unsigned)w; }
                *(u32x2*)((unsigned char*)WQF + (size_t)(hh * 128 + key) * 1024 + k0 + kq * 8) = o;
            } else {
            u32x4 o; o.x = pk2(acc[0], acc[1]); o.y = pk2(acc[2], acc[3]); o.z = pk2(acc[4], acc[5]); o.w = pk2(acc[6], acc[7]);
            *(u32x4*)(WQF + (size_t)(hh * 128 + key) * 1024 + k0 + kq * 8) = o; }
        }
        __syncthreads();
    }
    LAS float* scr = (LAS float*)(F.lds + F.wave * 16384);
    const int gw = F.bid * NWAVES + F.wave, NGW = F.G * NWAVES;
    constexpr int I_IN = 16 * (NPROJ / 32), I_A = 8 * 32, I_B = 8 * 32, I_O = 16 * 32;
    constexpr int NITEMS = I_IN + I_A + I_B + I_O;
    for (int it = gw; it < NITEMS; it += NGW) {
        int r = it;
        if (r < I_IN) { if ((r % (NPROJ / 32)) * 32 >= F8_LO * 256) p0_transpose_item<1, true>(A.in[I_WIN], 1024, 5136, NPROJ, (bf16_t*)(ws + WS_W8), scr, r, F.lane, 1024.f);
                        else p0_transpose_item<1, false>(A.in[I_WIN], 1024, 5136, NPROJ, (bf16_t*)(ws + WS_WIN), scr, r, F.lane); continue; } r -= I_IN;
        if (r < I_A) { p0_transpose_item<0>(A.in[I_WBA], 512, 1024, 1024, (bf16_t*)(ws + WS_WA), scr, r, F.lane); continue; } r -= I_A;
        if (r < I_B) { p0_transpose_item<0>(A.in[I_WBB], 512, 1024, 1024, (bf16_t*)(ws + WS_WB), scr, r, F.lane); continue; } r -= I_B;
        p0_transpose_item<0>(A.in[I_WOUT], 1024, 1024, 1024, (bf16_t*)(ws + WS_WOUT), scr, r, F.lane);
    }
    constexpr int OM1 = F8_LO <= 0 ? 2 : (F8_LO >= 21 ? 1 : 3);
    { int m = gw; for (; m + 3 * NGW < T_TOK; m += 4 * NGW) rms_rows_to_bf16<OM1, 4>(F.lane, A.in[I_X] + (size_t)m * D, (size_t)NGW * D, A.in[I_N1G], (bf16_t*)(ws + WS_N1) + (size_t)m * D, (size_t)NGW * D, (unsigned*)(ws + WS_N18) + (size_t)m * 256, (size_t)NGW * 256);
      for (; m < T_TOK; m += NGW) rms_rows_to_bf16<OM1, 1>(F.lane, A.in[I_X] + (size_t)m * D, 0, A.in[I_N1G], (bf16_t*)(ws + WS_N1) + (size_t)m * D, 0, (unsigned*)(ws + WS_N18) + (size_t)m * 256, 0); }
}

__device__ __forceinline__ float log_sigmoid(float z) { return fminf(z, 0.f) - log1pf(__expf(-fabsf(z))); }

template <bool DRY>
__device__ __forceinline__ void gla_chunk_phase(const Frame& F, const Args& A) {
    unsigned char* ws = A.ws;
    const bf16_t* P = (const bf16_t*)(ws + WS_P);
    const float* ALR = (const float*)(ws + WS_ALR);
    LAS float* alr = (LAS float*)F.lds;
    LAS float* tot = (LAS float*)(F.lds + 4096);
    LAS bf16_t* kdT = (LAS bf16_t*)(F.lds + 8192);
    LAS bf16_t* vT = (LAS bf16_t*)(F.lds + 26624);
    LAS bf16_t* stT = (LAS bf16_t*)(F.lds + 45056);
    const int tid = F.tid, kk = tid & 127, seg = tid >> 7;
    const bool hconst = (F.G & 3) == 0;
    int hcur = -1; float w[16]; float bias = 0.f;
#pragma unroll
    for (int j = 0; j < 16; ++j) w[j] = 0.f;
    float na0, na1; bf16_t nk[16], nv[16];
#define GC_LOAD(unit) do { const int h_ = (unit) & 3, c_ = ((unit) >> 2) & 63, b_ = (unit) >> 8; const int t0_ = b_ * SEQ + c_ * 64; \
        na0 = ALR[(size_t)t0_ * 16 + tid]; na1 = ALR[(size_t)t0_ * 16 + 512 + tid]; \
        const bf16_t* kp_ = P + (size_t)(t0_ + 16 * seg) * PLD + PC_K + h_ * 128 + kk; const bf16_t* vp_ = P + (size_t)(t0_ + 16 * seg) * PLD + PC_V + h_ * 128 + kk; \
        _Pragma("unroll") for (int i_ = 0; i_ < 16; ++i_) { nk[i_] = kp_[(size_t)i_ * PLD]; nv[i_] = vp_[(size_t)i_ * PLD]; } } while (0)
    int unit = F.bid;
    if (unit < 2048) GC_LOAD(unit);
    for (; unit < 2048; unit += F.G) {
        const int h = unit & 3;
        if (h != hcur) { hcur = h;
#pragma unroll
            for (int j = 0; j < 16; ++j) w[j] = A.in[I_WGU][(size_t)j * 512 + h * 128 + kk];
            bias = A.in[I_BG][h * 128 + kk]; }
        __syncthreads();
        alr[tid] = na0; alr[512 + tid] = na1;
        bf16_t kr[16], vr[16];
#pragma unroll
        for (int i = 0; i < 16; ++i) { kr[i] = nk[i]; vr[i] = nv[i]; }
        if (unit + F.G < 2048) GC_LOAD(unit + F.G);
        __syncthreads();
        float cum[16]; float run = 0.f;
#pragma unroll
        for (int i = 0; i < 16; ++i) { const LAS f32x4* ap = (const LAS f32x4*)(alr + (16 * seg + i) * 16); float z = bias;
#pragma unroll
            for (int q = 0; q < 4; ++q) { const f32x4 a4 = ap[q]; z += a4.x * w[4 * q] + a4.y * w[4 * q + 1] + a4.z * w[4 * q + 2] + a4.w * w[4 * q + 3]; }
            const float ls = fminf(z, 0.f) - __logf(1.f + __expf(-fabsf(z)));
            run += ls * (1.f / 16.f); cum[i] = run; }
        tot[seg * 128 + kk] = run;
        __syncthreads();
        {
            const float t0s = tot[kk], t1s = tot[128 + kk], t2s = tot[256 + kk], t3s = tot[384 + kk];
            const float total = (t0s + t1s) + (t2s + t3s);
            const float prefix = seg == 0 ? 0.f : (seg == 1 ? t0s : (seg == 2 ? t0s + t1s : t0s + t1s + t2s));
            unsigned kw[8], vw[8];
#pragma unroll
            for (int i = 0; i < 8; ++i) {
                const float e0 = __expf(total - (prefix + cum[2 * i])), e1 = __expf(total - (prefix + cum[2 * i + 1]));
                kw[i] = pk2(bf1(kr[2 * i]) * e0, bf1(kr[2 * i + 1]) * e1); vw[i] = (unsigned)vr[2 * i] | ((unsigned)vr[2 * i + 1] << 16);
            }
            *(LAS u32x4*)(kdT + kk * 72 + 16 * seg) = (u32x4){kw[0], kw[1], kw[2], kw[3]}; *(LAS u32x4*)(kdT + kk * 72 + 16 * seg + 8) = (u32x4){kw[4], kw[5], kw[6], kw[7]};
            *(LAS u32x4*)(vT + kk * 72 + 16 * seg) = (u32x4){vw[0], vw[1], vw[2], vw[3]}; *(LAS u32x4*)(vT + kk * 72 + 16 * seg + 8) = (u32x4){vw[4], vw[5], vw[6], vw[7]};
            if (seg == 0) ((float*)(DRY ? (unsigned char*)A.out + 96 * MiB : ws + WS_DEC))[(size_t)unit * 128 + kk] = __expf(total);
        }
        __syncthreads();
        {
            const int w8 = F.wave, l = F.lane, fr = l & 15, fq = l >> 4;
            f32x4 acc[8];
#pragma unroll
            for (int n = 0; n < 8; ++n) acc[n] = (f32x4){0.f, 0.f, 0.f, 0.f};
#pragma unroll
            for (int ks = 0; ks < 2; ++ks) {
                const bf16x8 a = *(const LAS bf16x8*)(kdT + (16 * w8 + fr) * 72 + 32 * ks + 8 * fq);
#pragma unroll
                for (int n = 0; n < 8; ++n) { const bf16x8 bb = *(const LAS bf16x8*)(vT + (16 * n + fr) * 72 + 32 * ks + 8 * fq);
                    acc[n] = __builtin_amdgcn_mfma_f32_16x16x32_bf16(a, bb, acc[n], 0, 0, 0); }
            }
#pragma unroll
            for (int n = 0; n < 8; ++n) { u32x2 o; o.x = pk2(acc[n][0], acc[n][1]); o.y = pk2(acc[n][2], acc[n][3]);
                *(LAS u32x2*)(stT + (16 * n + fr) * 136 + 16 * w8 + 4 * fq) = o; }
        }
        __syncthreads();
        {
            bf16_t* ST = (bf16_t*)(DRY ? (unsigned char*)A.out : ws + WS_N1) + (size_t)unit * 16384;
            const int vv = tid >> 2, part = tid & 3;
#pragma unroll
            for (int q = 0; q < 4; ++q) *(u32x4*)(ST + (size_t)vv * 128 + 32 * part + 8 * q) = *(const LAS u32x4*)(stT + vv * 136 + 32 * part + 8 * q);
        }
    }
#undef GC_LOAD
    (void)hconst;
}

template <bool DRY>
__device__ __forceinline__ void sgu_unit(const Frame& F, const Args& A, int unit, bool stats) {
    const int g = unit & 3, blk = (unit >> 2) & 31, b = unit >> 7;
    const int t0 = b * SEQ + blk * 128;
    bf16_t* P = (bf16_t*)(A.ws + WS_P);
    LAS bf16_t* wA = (LAS bf16_t*)F.lds;
    LAS bf16_t* vnT = (LAS bf16_t*)(F.lds + 34816);
    LAS float* st = (LAS float*)(F.lds + 69632);
    LAS bf16_t* suS = (LAS bf16_t*)(F.lds + 70656);
    const int tid = F.tid;
    __syncthreads();
    if (stats) {
        const int j = tid >> 2, q = tid & 3;
        const bf16_t* sp = P + (size_t)(t0 + j) * PLD + PC_SV + q * 128;
        float s = 0.f, s2 = 0.f;
#pragma unroll
        for (int i = 0; i < 16; ++i) { const u32x4 w = *(const u32x4*)(sp + 8 * i);
            const float f[8] = {bflo(w.x), bfhi(w.x), bflo(w.y), bfhi(w.y), bflo(w.z), bfhi(w.z), bflo(w.w), bfhi(w.w)};
#pragma unroll
            for (int e = 0; e < 8; ++e) { s += f[e]; s2 += f[e] * f[e]; } }
        s += __shfl_xor(s, 1); s += __shfl_xor(s, 2); s2 += __shfl_xor(s2, 1); s2 += __shfl_xor(s2, 2);
        const float mu = s * (1.f / 512.f); const float var = fmaxf(s2 * (1.f / 512.f) - mu * mu, 0.f);
        if (q == 0) { st[2 * j] = mu; st[2 * j + 1] = 1.f / sqrtf(var + EPS); }
    }
    {
        const int i = tid >> 2, jb = (tid & 3) * 32;
        const float* wp = A.in[I_SW] + (size_t)g * 16384 + (size_t)i * 128 + jb;
        const bf16_t* sup = P + (size_t)(t0 + i) * PLD + PC_SU + g * 128 + jb;
#pragma unroll
        for (int q = 0; q < 4; ++q) { const f32x4 a = *(const f32x4*)(wp + 8 * q), bq = *(const f32x4*)(wp + 8 * q + 4);
            const bool z = (i < 64) && (jb + 8 * q >= 64);
            u32x4 o; o.x = pk2(a.x, a.y); o.y = pk2(a.z, a.w); o.z = pk2(bq.x, bq.y); o.w = pk2(bq.z, bq.w);
            if (z) o = (u32x4){0u, 0u, 0u, 0u};
            *(LAS u32x4*)(wA + i * 136 + jb + 8 * q) = o;
            *(LAS u32x4*)(suS + i * 136 + jb + 8 * q) = *(const u32x4*)(sup + 8 * q); }
    }
    const int cch = tid & 127, seg = tid >> 7;
    bf16_t xr[32];
    { const bf16_t* sp = P + (size_t)(t0 + 32 * seg) * PLD + PC_SV + g * 128 + cch;
#pragma unroll
      for (int i = 0; i < 32; ++i) xr[i] = sp[(size_t)i * PLD]; }
    const float lg = A.in[I_SLNG][g * 128 + cch], lb = A.in[I_SLNB][g * 128 + cch];
    __syncthreads();
    {
        unsigned ow[16];
#pragma unroll
        for (int i = 0; i < 16; ++i) { const int j = 32 * seg + 2 * i; const f32x4 ms = *(const LAS f32x4*)(st + 2 * j);
            ow[i] = pk2((bf1(xr[2 * i]) - ms.x) * ms.y * lg + lb, (bf1(xr[2 * i + 1]) - ms.z) * ms.w * lg + lb); }
#pragma unroll
        for (int q = 0; q < 4; ++q) *(LAS u32x4*)(vnT + cch * 136 + 32 * seg + 8 * q) = (u32x4){ow[4 * q], ow[4 * q + 1], ow[4 * q + 2], ow[4 * q + 3]};
    }
    __syncthreads();
    {
        const int w = F.wave, l = F.lane, fr = l & 15, fq = l >> 4;
        f32x4 acc[8];
#pragma unroll
        for (int n = 0; n < 8; ++n) acc[n] = (f32x4){0.f, 0.f, 0.f, 0.f};
#pragma unroll
        for (int ks = 0; ks < 4; ++ks) {
            const bf16x8 a = *(const LAS bf16x8*)(wA + (16 * w + fr) * 136 + 32 * ks + 8 * fq);
#pragma unroll
            for (int n = 0; n < 8; ++n) { const bf16x8 bb = *(const LAS bf16x8*)(vnT + (16 * n + fr) * 136 + 32 * ks + 8 * fq);
                acc[n] = __builtin_amdgcn_mfma_f32_16x16x32_bf16(a, bb, acc[n], 0, 0, 0); }
        }
#pragma unroll
        for (int jj = 0; jj < 4; ++jj) { const int i = 16 * w + 4 * fq + jj; const float bias = A.in[I_SB][g * 128 + i];
            LAS bf16_t* rp = suS + i * 136 + fr;
#pragma unroll
            for (int n = 0; n < 8; ++n) { const float su = bf1(rp[16 * n]); rp[16 * n] = (bf16_t)f2bf(su * (acc[n][jj] + bias)); } }
    }
    __syncthreads();
    {
        const int i = tid >> 2, jb = (tid & 3) * 32;
        bf16_t* yp = DRY ? (bf16_t*)A.out + (size_t)(t0 + i) * 512 + g * 128 + jb : P + (size_t)(t0 + i) * PLD + PC_SU + g * 128 + jb;
#pragma unroll
        for (int q = 0; q < 4; ++q) *(u32x4*)(yp + 8 * q) = *(const LAS u32x4*)(suS + i * 136 + jb + 8 * q);
    }
}

template <bool DRY>
__device__ __forceinline__ void gla_scan(const Frame& F, const Args& A) {
    bf16_t* ST = (bf16_t*)(A.ws + WS_N1); bf16_t* STO = DRY ? (bf16_t*)A.out : ST; const float* DEC = (const float*)(A.ws + WS_DEC);
    for (int gi = F.bid * 512 + F.tid; gi < 131072; gi += F.G * 512) {
        const int k4 = gi & 31, vv = (gi >> 5) & 127, h = (gi >> 12) & 3, b = gi >> 14;
        float s0 = 0.f, s1 = 0.f, s2 = 0.f, s3 = 0.f;
        u32x2 wa[8], wb[8]; f32x4 da[8], db[8];
#define SCAN_LOAD(W, Dd, c0) do { _Pragma("unroll") for (int i_ = 0; i_ < 8; ++i_) { const size_t u_ = (size_t)((b * 64 + (c0) + i_) * 4 + h); \
            W[i_] = *(const u32x2*)(ST + u_ * 16384 + (size_t)vv * 128 + k4 * 4); Dd[i_] = *(const f32x4*)(DEC + u_ * 128 + k4 * 4); } } while (0)
#define SCAN_STEP(W, Dd, c0) do { _Pragma("unroll") for (int i_ = 0; i_ < 8; ++i_) { const size_t u_ = (size_t)((b * 64 + (c0) + i_) * 4 + h); \
            s0 = Dd[i_].x * s0 + bflo(W[i_].x); s1 = Dd[i_].y * s1 + bfhi(W[i_].x); s2 = Dd[i_].z * s2 + bflo(W[i_].y); s3 = Dd[i_].w * s3 + bfhi(W[i_].y); \
            u32x2 o_; o_.x = pk2(s0, s1); o_.y = pk2(s2, s3); *(u32x2*)(STO + u_ * 16384 + (size_t)vv * 128 + k4 * 4) = o_; } } while (0)
        SCAN_LOAD(wa, da, 0);
#pragma unroll
        for (int c0 = 0; c0 < 64; c0 += 16) {
            SCAN_LOAD(wb, db, c0 + 8);
            SCAN_STEP(wa, da, c0);
            if (c0 + 16 < 64) SCAN_LOAD(wa, da, c0 + 16);
            SCAN_STEP(wb, db, c0 + 8);
        }
#undef SCAN_LOAD
#undef SCAN_STEP
    }
}

template <bool DRY>
__device__ __forceinline__ void gla_out_phase(const Frame& F, const Args& A) {
    bf16_t* P = (bf16_t*)(A.ws + WS_P);
    LAS bf16_t* qA = (LAS bf16_t*)F.lds;
    LAS bf16_t* sB = (LAS bf16_t*)(F.lds + 17408);
    LAS float* oF = (LAS float*)(F.lds + 52224);
    const int tid = F.tid, s = tid >> 3, cb = (tid & 7) * 16, vv = tid >> 2, kb = (tid & 3) * 32;
    u32x4 nq0, nq1, ns0, ns1, ns2, ns3, nr0, nr1;
#define GO_LOAD(unit) do { const int h_ = (unit) & 3, c_ = ((unit) >> 2) & 63, b_ = (unit) >> 8; const int t0_ = b_ * SEQ + c_ * 64; \
        const bf16_t* qp_ = P + (size_t)(t0_ + s) * PLD + PC_Q + h_ * 128 + cb; nq0 = *(const u32x4*)qp_; nq1 = *(const u32x4*)(qp_ + 8); \
        const bf16_t* sp_ = (const bf16_t*)(A.ws + WS_N1) + (size_t)(unit) * 16384 + (size_t)vv * 128 + kb; ns0 = *(const u32x4*)sp_; ns1 = *(const u32x4*)(sp_ + 8); ns2 = *(const u32x4*)(sp_ + 16); ns3 = *(const u32x4*)(sp_ + 24); \
        const bf16_t* rp_ = P + (size_t)(t0_ + s) * PLD + PC_R + h_ * 128 + cb; nr0 = *(const u32x4*)rp_; nr1 = *(const u32x4*)(rp_ + 8); } while (0)
    int unit = F.bid;
    if (unit < 2048) GO_LOAD(unit);
    for (; unit < 2048; unit += F.G) {
        const int h = unit & 3, c = (unit >> 2) & 63, b = unit >> 8;
        const int t0 = b * SEQ + c * 64;
        __syncthreads();
        *(LAS u32x4*)(qA + s * 136 + cb) = nq0; *(LAS u32x4*)(qA + s * 136 + cb + 8) = nq1;
        *(LAS u32x4*)(sB + vv * 136 + kb) = ns0; *(LAS u32x4*)(sB + vv * 136 + kb + 8) = ns1; *(LAS u32x4*)(sB + vv * 136 + kb + 16) = ns2; *(LAS u32x4*)(sB + vv * 136 + kb + 24) = ns3;
        const u32x4 r0 = nr0, r1 = nr1;
        if (unit + F.G < 2048) GO_LOAD(unit + F.G);
        __syncthreads();
        {
            const int w = F.wave, l = F.lane, fr = l & 15, fq = l >> 4, m = w & 3, nh = w >> 2;
            f32x4 acc[4];
#pragma unroll
            for (int n = 0; n < 4; ++n) acc[n] = (f32x4){0.f, 0.f, 0.f, 0.f};
#pragma unroll
            for (int ks = 0; ks < 4; ++ks) {
                const bf16x8 a = *(const LAS bf16x8*)(qA + (16 * m + fr) * 136 + 32 * ks + 8 * fq);
#pragma unroll
                for (int n = 0; n < 4; ++n) { const bf16x8 bb = *(const LAS bf16x8*)(sB + (16 * (4 * nh + n) + fr) * 136 + 32 * ks + 8 * fq);
                    acc[n] = __builtin_amdgcn_mfma_f32_16x16x32_bf16(a, bb, acc[n], 0, 0, 0); }
            }
            const float scale = 0.08838834764831845f;
#pragma unroll
            for (int n = 0; n < 4; ++n)
#pragma unroll
                for (int jj = 0; jj < 4; ++jj) oF[(16 * m + 4 * fq + jj) * 132 + 16 * (4 * nh + n) + fr] = acc[n][jj] * scale;
        }
        __syncthreads();
        {
            float o[16]; float ss = 0.f;
#pragma unroll
            for (int i = 0; i < 16; ++i) { o[i] = oF[s * 132 + cb + i]; ss += o[i] * o[i]; }
            ss += __shfl_xor(ss, 1); ss += __shfl_xor(ss, 2); ss += __shfl_xor(ss, 4);
            const float rstd = 1.f / sqrtf(ss * (1.f / 128.f) + EPS);
            const unsigned rw[8] = {r0.x, r0.y, r0.z, r0.w, r1.x, r1.y, r1.z, r1.w};
            const float* gg = A.in[I_GLAG] + h * 128 + cb;
            unsigned ow[8];
#pragma unroll
            for (int i = 0; i < 8; ++i) { const float y0 = o[2 * i] * rstd * gg[2 * i] * siluf_(bflo(rw[i])), y1 = o[2 * i + 1] * rstd * gg[2 * i + 1] * siluf_(bfhi(rw[i])); ow[i] = pk2(y0, y1); }
            bf16_t* yp = DRY ? (bf16_t*)A.out + (size_t)(t0 + s) * 512 + h * 128 + cb : P + (size_t)(t0 + s) * PLD + PC_Q + h * 128 + cb;
            *(u32x4*)yp = (u32x4){ow[0], ow[1], ow[2], ow[3]}; *(u32x4*)(yp + 8) = (u32x4){ow[4], ow[5], ow[6], ow[7]};
        }
    }
#undef GO_LOAD
}

__device__ __forceinline__ unsigned ordkey(float v) { const unsigned u = __builtin_bit_cast(unsigned, v); return u ^ ((unsigned)((int)u >> 31) | 0x80000000u); }
__device__ __forceinline__ float unord(unsigned k) { const unsigned u = (k & 0x80000000u) ? (k & 0x7fffffffu) : ~k; return __builtin_bit_cast(float, u); }
#define INS16(r, xin) do { unsigned _x = (xin); _Pragma("unroll") for (int _i = 0; _i < 16; ++_i) { const unsigned _h = max((r)[_i], _x); _x = min((r)[_i], _x); (r)[_i] = _h; } } while (0)

#define CE(a, b) do { const unsigned _h = max((a), (b)), _l = min((a), (b)); (a) = _h; (b) = _l; } while (0)
#define SORT16(v) do { CE(v[0], v[1]); CE(v[2], v[3]); CE(v[0], v[2]); CE(v[1], v[3]); CE(v[1], v[2]); CE(v[4], v[5]); CE(v[6], v[7]); CE(v[4], v[6]); CE(v[5], v[7]); CE(v[5], v[6]); CE(v[0], v[4]); CE(v[2], v[6]); CE(v[2], v[4]); CE(v[1], v[5]); CE(v[3], v[7]); CE(v[3], v[5]); CE(v[1], v[2]); CE(v[3], v[4]); CE(v[5], v[6]); CE(v[8], v[9]); CE(v[10], v[11]); CE(v[8], v[10]); CE(v[9], v[11]); CE(v[9], v[10]); CE(v[12], v[13]); CE(v[14], v[15]); CE(v[12], v[14]); CE(v[13], v[15]); CE(v[13], v[14]); CE(v[8], v[12]); CE(v[10], v[14]); CE(v[10], v[12]); CE(v[9], v[13]); CE(v[11], v[15]); CE(v[11], v[13]); CE(v[9], v[10]); CE(v[11], v[12]); CE(v[13], v[14]); CE(v[0], v[8]); CE(v[4], v[12]); CE(v[4], v[8]); CE(v[2], v[10]); CE(v[6], v[14]); CE(v[6], v[10]); CE(v[2], v[4]); CE(v[6], v[8]); CE(v[10], v[12]); CE(v[1], v[9]); CE(v[5], v[13]); CE(v[5], v[9]); CE(v[3], v[11]); CE(v[7], v[15]); CE(v[7], v[11]); CE(v[3], v[5]); CE(v[7], v[9]); CE(v[11], v[13]); CE(v[1], v[2]); CE(v[3], v[4]); CE(v[5], v[6]); CE(v[7], v[8]); CE(v[9], v[10]); CE(v[11], v[12]); CE(v[13], v[14]); } while (0)
#define MERGE16(T, S) do { _Pragma("unroll") for (int _i = 0; _i < 16; ++_i) (T)[_i] = max((T)[_i], (S)[15 - _i]); \
    _Pragma("unroll") for (int _d = 8; _d >= 1; _d >>= 1) { _Pragma("unroll") for (int _i = 0; _i < 16; ++_i) if ((_i & _d) == 0) CE((T)[_i], (T)[_i + _d]); } } while (0)
__device__ __forceinline__ void peer_topk(const Frame& F, const Args& A) {
    const bf16_t* SC = (const bf16_t*)(A.ws + WS_P + P_SC);
    int* IDX = (int*)(A.ws + WS_P + P_IDX); float* GATE = (float*)(A.ws + WS_P + P_GATE);
    const int gw = F.bid * NWAVES + F.wave, NGW = F.G * NWAVES;
    for (int it = gw; it < 512 * 8; it += NGW) {
        const int h = it & 7, tb = it >> 3; const int tok = tb * 64 + F.lane;
        unsigned r1[16], r2[16], rc[16];
        const bf16_t* p1 = SC + ((size_t)(tok >> 4) * 256 + h * 32) * 128 + (tok & 15) * 8; const bf16_t* p2 = p1 + 16 * 128;
        {
            float raw[128]; unsigned sg[16];
#pragma unroll
            for (int jq = 0; jq < 16; ++jq) { const u32x4 t4 = *(const u32x4*)(p1 + jq * 128);
#pragma unroll
                for (int c = 0; c < 4; ++c) { raw[8 * jq + 2 * c] = bflo(t4[c]); raw[8 * jq + 2 * c + 1] = bfhi(t4[c]); } }
#pragma unroll
            for (int j = 0; j < 16; ++j) r1[j] = (ordkey(raw[j]) & ~127u) | (unsigned)(127 - j);
            SORT16(r1);
#pragma unroll
            for (int gq = 1; gq < 8; ++gq) {
#pragma unroll
                for (int j = 0; j < 16; ++j) sg[j] = (ordkey(raw[16 * gq + j]) & ~127u) | (unsigned)(127 - (16 * gq + j));
                SORT16(sg); MERGE16(r1, sg); }
#pragma unroll
            for (int jq = 0; jq < 16; ++jq) { const u32x4 t4 = *(const u32x4*)(p2 + jq * 128);
#pragma unroll
                for (int c = 0; c < 4; ++c) { raw[8 * jq + 2 * c] = bflo(t4[c]); raw[8 * jq + 2 * c + 1] = bfhi(t4[c]); } }
#pragma unroll
            for (int j = 0; j < 16; ++j) r2[j] = (ordkey(raw[j]) & ~127u) | (unsigned)(127 - j);
            SORT16(r2);
#pragma unroll
            for (int gq = 1; gq < 8; ++gq) {
#pragma unroll
                for (int j = 0; j < 16; ++j) sg[j] = (ordkey(raw[16 * gq + j]) & ~127u) | (unsigned)(127 - (16 * gq + j));
                SORT16(sg); MERGE16(r2, sg); }
        }
        float v1[16], v2[16];
#pragma unroll
        for (int i = 0; i < 16; ++i) { v1[i] = unord((r1[i] & ~127u) | 64u); v2[i] = unord((r2[i] & ~127u) | 64u); }
        {
            unsigned cg[4][16]; int cn = 0;
#pragma unroll
            for (int a = 0; a < 16; ++a)
#pragma unroll
                for (int bq = 0; bq < 16; ++bq) if ((a + 1) * (bq + 1) <= 16) { cg[cn >> 4][cn & 15] = (ordkey(v1[a] + v2[bq]) & ~255u) | (unsigned)(a * 16 + bq); ++cn; }
#pragma unroll
            for (int z = 50; z < 64; ++z) cg[z >> 4][z & 15] = 0u;
            SORT16(cg[0]); SORT16(cg[1]); SORT16(cg[2]); SORT16(cg[3]);
            MERGE16(cg[0], cg[1]); MERGE16(cg[0], cg[2]); MERGE16(cg[0], cg[3]);
#pragma unroll
            for (int i = 0; i < 16; ++i) rc[i] = cg[0][i];
        }
        float val[16]; int ex[16];
        {
            LAS unsigned* t1 = (LAS unsigned*)(F.lds + F.wave * 8704) + F.lane * 17; LAS unsigned* t2 = t1 + 64 * 17;
#pragma unroll
            for (int i = 0; i < 16; ++i) { t1[i] = r1[i]; t2[i] = r2[i]; }
            LDS_WAIT(); asm volatile("" ::: "memory");
#pragma unroll
            for (int w = 0; w < 16; ++w) {
                const int a = (rc[w] >> 4) & 15, bq = rc[w] & 15;
                const unsigned k1 = t1[a], k2 = t2[bq];
                val[w] = unord((k1 & ~127u) | 64u) + unord((k2 & ~127u) | 64u);
                ex[w] = (127 - (int)(k1 & 127u)) * 128 + (127 - (int)(k2 & 127u));
            }
            LDS_WAIT(); asm volatile("" ::: "memory");
        }
        float mx = val[0];
#pragma unroll
        for (int w = 1; w < 16; ++w) mx = fmaxf(mx, val[w]);
        float sum = 0.f;
#pragma unroll
        for (int w = 0; w < 16; ++w) { val[w] = __expf(val[w] - mx); sum += val[w]; }
        const float inv = 1.f / sum;
        int* ip = IDX + (size_t)tok * 128 + h * 16; float* gp = GATE + (size_t)tok * 128 + h * 16;
#pragma unroll
        for (int q = 0; q < 4; ++q) { *(int4*)(ip + 4 * q) = make_int4(ex[4 * q], ex[4 * q + 1], ex[4 * q + 2], ex[4 * q + 3]);
            *(f32x4*)(gp + 4 * q) = (f32x4){val[4 * q] * inv, val[4 * q + 1] * inv, val[4 * q + 2] * inv, val[4 * q + 3] * inv}; }
    }
}

#define DPP_ADD(v, ctrl) ((v) + __builtin_bit_cast(float, __builtin_amdgcn_mov_dpp(__builtin_bit_cast(int, (v)), (ctrl), 0xf, 0xf, true)))
__device__ __forceinline__ void fp8x16_to_f32x2(const u32x4 r, f32x2* f) {
#pragma unroll
    for (int q = 0; q < 4; ++q) { f[2 * q] = __builtin_amdgcn_cvt_pk_f32_fp8((int)r[q], false); f[2 * q + 1] = __builtin_amdgcn_cvt_pk_f32_fp8((int)r[q], true); }
}
__device__ __forceinline__ void fp8x16_to_f32(const u32x4 r, float* f) {
#pragma unroll
    for (int q = 0; q < 4; ++q) { const f32x2 lo = __builtin_amdgcn_cvt_pk_f32_fp8((int)r[q], false), hi = __builtin_amdgcn_cvt_pk_f32_fp8((int)r[q], true);
        f[4 * q] = lo.x; f[4 * q + 1] = lo.y; f[4 * q + 2] = hi.x; f[4 * q + 3] = hi.y; }
}
__device__ __forceinline__ long lo64(u32x4 v) { return (long)(((unsigned long)v.y << 32) | (unsigned long)v.x); }
__device__ __forceinline__ long hi64(u32x4 v) { return (long)(((unsigned long)v.w << 32) | (unsigned long)v.z); }
template <int MODE>
__device__ __forceinline__ void peer_u_phase(const Frame& F, const Args& A) {
    const unsigned char* X8 = A.ws + WS_P + P_X8;
    const unsigned char* U8 = A.ws + WS_U8; const float* SU = (const float*)(A.ws + WS_SU); const float* SV = (const float*)(A.ws + WS_SV);
    const int* IDX = (const int*)(A.ws + WS_P + P_IDX); const float* GATE = (const float*)(A.ws + WS_P + P_GATE); float* AK = (float*)(MODE == 0 ? A.ws + WS_AK : A.ws + WS_P + P_SC);
    const int g = F.bid & 7, nmem = F.G >> 3, l = F.lane, step = nmem * NWAVES;
    const int loff = 64 * (l & 15) + 16 * (l >> 4);
    const bool dg = ((l & 15) >> 2) == (l >> 4); const int dr = l & 3;
    const float dw0 = (dg && dr == 0) ? 1.f : 0.f, dw1 = (dg && dr == 1) ? 1.f : 0.f, dw2 = (dg && dr == 2) ? 1.f : 0.f, dw3 = (dg && dr == 3) ? 1.f : 0.f;
    LAS int* le = (LAS int*)(F.lds + F.wave * 2048); LAS int* lk = le + 256;
    const bool b5 = (l & 32) != 0, b4 = (l & 16) != 0, b3 = (l & 8) != 0;
    int tok = 2 * ((F.bid >> 3) * NWAVES + F.wave);
    u32x4 nxA, nxB; int neA0, neA1, neB0, neB1; float ngA0, ngA1, ngB0, ngB1;
#define U_PREFETCH(t) do { const size_t _tA = (size_t)(t), _tB = (size_t)(t) + 1; if (MODE == 4) { nxA = (u32x4){(unsigned)_tA, 1u, 2u, 3u}; nxB = nxA; neA0 = (int)((_tA * 37 + l * 11) & 16383); neA1 = (int)((_tA * 53 + l * 7) & 16383); neB0 = (int)((_tB * 37 + l * 13) & 16383); neB1 = (int)((_tB * 29 + l * 3) & 16383); ngA0 = ngA1 = ngB0 = ngB1 = 0.01f; break; } nxA = *(const u32x4*)(X8 + _tA * 1024 + loff); nxB = *(const u32x4*)(X8 + _tB * 1024 + loff); \
        neA0 = IDX[_tA * 128 + l]; neA1 = IDX[_tA * 128 + 64 + l]; neB0 = IDX[_tB * 128 + l]; neB1 = IDX[_tB * 128 + 64 + l]; \
        ngA0 = GATE[_tA * 128 + l]; ngA1 = GATE[_tA * 128 + 64 + l]; ngB0 = GATE[_tB * 128 + l]; ngB1 = GATE[_tB * 128 + 64 + l]; } while (0)
    if (tok + 1 < T_TOK) U_PREFETCH(tok);
    for (; tok + 1 < T_TOK; tok += 2 * step) {
        const int tokA = tok, tokB = tok + 1;
        const u32x4 xA = nxA, xB = nxB;
        const int eA0 = neA0, eA1 = neA1, eB0 = neB0, eB1 = neB1; const float gA0 = ngA0, gA1 = ngA1, gB0 = ngB0, gB1 = ngB1;
        bool pf_done = false;
        const bool oA0 = (eA0 & 7) == g, oA1 = (eA1 & 7) == g, oB0 = (eB0 & 7) == g, oB1 = (eB1 & 7) == g;
        const unsigned long long mA0 = __ballot(oA0), mA1 = __ballot(oA1), mB0 = __ballot(oB0), mB1 = __ballot(oB1);
        const int c0 = __popcll(mA0), c1 = c0 + __popcll(mA1), c2 = c1 + __popcll(mB0), n = c2 + __popcll(mB1);
#define MBC(m) __builtin_amdgcn_mbcnt_hi((unsigned)((m) >> 32), __builtin_amdgcn_mbcnt_lo((unsigned)(m), 0u))
        if (oA0) { const int p = MBC(mA0); le[p] = (eA0 << 8) | l; lk[p] = __builtin_bit_cast(int, gA0); }
        if (oA1) { const int p = c0 + MBC(mA1); le[p] = (eA1 << 8) | (64 + l); lk[p] = __builtin_bit_cast(int, gA1); }
        if (oB0) { const int p = c1 + MBC(mB0); le[p] = (eB0 << 8) | 128 | l; lk[p] = __builtin_bit_cast(int, gB0); }
        if (oB1) { const int p = c2 + MBC(mB1); le[p] = (eB1 << 8) | 128 | (64 + l); lk[p] = __builtin_bit_cast(int, gB1); }
#undef MBC
        LDS_WAIT(); asm volatile("" ::: "memory");
        for (int cb = 0; cb < n || cb == 0; cb += 64) {
        const int nc = min(n, cb + 64);
        const bool fv = (cb + l) < nc;
        const int ent = fv ? le[cb + l] : 0; const float gt = fv ? __builtin_bit_cast(float, lk[cb + l]) : 0.f; float tot = 0.f;
        const float su = SU[ent >> 8], sv = SV[ent >> 8];
        const unsigned long long radr = (unsigned long long)(U8 + (size_t)(((ent >> 8) & 7) * 2048 + (((ent >> 8) >> 3) & (MODE == 2 ? 255 : 2047))) * 1024);
        const int ralo = (int)(unsigned)radr, rahi = (int)(unsigned)(radr >> 32);
        for (int i = cb; i < nc; i += 16) {
            u32x4 row[2][8];
#pragma unroll
            for (int b = 0; b < 2; ++b) if (i + 8 * b < nc) {
#pragma unroll
                for (int j = 0; j < 8; ++j) { const int ln = min(i + 8 * b + j, nc - 1) - cb;
                    const unsigned lo = (unsigned)__builtin_amdgcn_readlane(ralo, ln), hi = (unsigned)__builtin_amdgcn_readlane(rahi, ln);
                    const GAS unsigned char* rp = (const GAS unsigned char*)(((unsigned long long)hi << 32) | lo);
                    row[b][j] = *(const GAS u32x4*)(rp + (unsigned)loff); } }
            if (!pf_done) { pf_done = true; if (tok + 2 * step + 1 < T_TOK) U_PREFETCH(tok + 2 * step); }
#pragma unroll
            for (int b = 0; b < 2; ++b) if (i + 8 * b < nc) {
                float p[8];
                f32x4 accj[8];
                const int base0 = i + 8 * b;
                if (base0 + 8 <= c1) {
#pragma unroll
                    for (int j = 0; j < 8; ++j) accj[j] = __builtin_amdgcn_mfma_f32_16x16x32_fp8_fp8(lo64(row[b][j]), lo64(xA), (f32x4){0.f, 0.f, 0.f, 0.f}, 0, 0, 0);
#pragma unroll
                    for (int j = 0; j < 8; ++j) accj[j] = __builtin_amdgcn_mfma_f32_16x16x32_fp8_fp8(hi64(row[b][j]), hi64(xA), accj[j], 0, 0, 0);
                } else if (base0 >= c1) {
#pragma unroll
                    for (int j = 0; j < 8; ++j) accj[j] = __builtin_amdgcn_mfma_f32_16x16x32_fp8_fp8(lo64(row[b][j]), lo64(xB), (f32x4){0.f, 0.f, 0.f, 0.f}, 0, 0, 0);
#pragma unroll
                    for (int j = 0; j < 8; ++j) accj[j] = __builtin_amdgcn_mfma_f32_16x16x32_fp8_fp8(hi64(row[b][j]), hi64(xB), accj[j], 0, 0, 0);
                } else {
#pragma unroll
                    for (int j = 0; j < 8; ++j) { const u32x4 xs = (base0 + j >= c1) ? xB : xA; accj[j] = __builtin_amdgcn_mfma_f32_16x16x32_fp8_fp8(lo64(row[b][j]), lo64(xs), (f32x4){0.f, 0.f, 0.f, 0.f}, 0, 0, 0);
                        accj[j] = __builtin_amdgcn_mfma_f32_16x16x32_fp8_fp8(hi64(row[b][j]), hi64(xs), accj[j], 0, 0, 0); }
                }
#pragma unroll
                for (int j = 0; j < 8; ++j) p[j] = __builtin_fmaf(accj[j][3], dw3, __builtin_fmaf(accj[j][2], dw2, __builtin_fmaf(accj[j][1], dw1, accj[j][0] * dw0)));
                float q4[4], q2[2], q1;
#pragma unroll
                for (int j = 0; j < 4; ++j) { const float keep = b5 ? p[4 + j] : p[j], send = b5 ? p[j] : p[4 + j]; q4[j] = keep + __shfl_xor(send, 32); }
#pragma unroll
                for (int j = 0; j < 2; ++j) { const float keep = b4 ? q4[2 + j] : q4[j], send = b4 ? q4[j] : q4[2 + j]; q2[j] = keep + __shfl_xor(send, 16); }
                { const float keep = b3 ? q2[1] : q2[0], send = b3 ? q2[0] : q2[1]; q1 = keep + __shfl_xor(send, 8); }
                q1 = DPP_ADD(q1, 0xB1); q1 = DPP_ADD(q1, 0x4E); q1 = DPP_ADD(q1, 0x141);
                const float t = __builtin_bit_cast(float, __builtin_amdgcn_ds_bpermute((l & 7) * 32, __builtin_bit_cast(int, q1)));
                const int base = i + 8 * b;
                if ((l >> 3) == ((base - cb) >> 3)) tot = t;
            }
        }
        if (!pf_done) { if (tok + 2 * step + 1 < T_TOK) U_PREFETCH(tok + 2 * step); }
        if (fv) { const int tk = (ent & 128) ? tokB : tokA; AK[(size_t)tk * 128 + (ent & 127)] = gelu_tanh(tot * su * (1.f / 16.f)) * gt * sv; }
        if (n == 0) break;
        }
        LDS_WAIT(); asm volatile("" ::: "memory");
    }
#undef U_PREFETCH
}
template <int MODE>
__device__ __forceinline__ void peer_u_phase1(const Frame& F, const Args& A) {
    const unsigned char* X8 = A.ws + WS_P + P_X8;
    const unsigned char* U8 = A.ws + WS_U8; const float* SU = (const float*)(A.ws + WS_SU); const float* SV = (const float*)(A.ws + WS_SV);
    const int* IDX = (const int*)(A.ws + WS_P + P_IDX); const float* GATE = (const float*)(A.ws + WS_P + P_GATE); float* AK = (float*)(MODE == 0 ? A.ws + WS_AK : A.ws + WS_P + P_SC);
    const int g = F.bid & (UNG - 1), nmem = F.G >> UNG_SH, l = F.lane, step = nmem * NWAVES;
    const int loff = 64 * (l & 15) + 16 * (l >> 4);
    const bool dg = ((l & 15) >> 2) == (l >> 4); const int dr = l & 3;
    const float dw0 = (dg && dr == 0) ? 1.f : 0.f, dw1 = (dg && dr == 1) ? 1.f : 0.f, dw2 = (dg && dr == 2) ? 1.f : 0.f, dw3 = (dg && dr == 3) ? 1.f : 0.f;
    LAS int* le = (LAS int*)(F.lds + F.wave * 2048); LAS int* lk = le + 256;
    const bool b5 = (l & 32) != 0, b4 = (l & 16) != 0, b3 = (l & 8) != 0;
    int tok = (F.bid >> UNG_SH) * NWAVES + F.wave;
    u32x4 nxA; int neA0, neA1; float ngA0, ngA1;
#define U1_PREFETCH(t) do { const size_t _tA = (size_t)(t); nxA = *(const u32x4*)(X8 + _tA * 1024 + loff); \
        neA0 = IDX[_tA * 128 + l]; neA1 = IDX[_tA * 128 + 64 + l]; ngA0 = GATE[_tA * 128 + l]; ngA1 = GATE[_tA * 128 + 64 + l]; } while (0)
    if (tok < T_TOK) U1_PREFETCH(tok);
    for (; tok < T_TOK; tok += step) {
        const u32x4 xA = nxA;
        const int eA0 = neA0, eA1 = neA1; const float gA0 = ngA0, gA1 = ngA1;
        bool pf_done = false;
        const bool oA0 = (eA0 & (UNG - 1)) == g, oA1 = (eA1 & (UNG - 1)) == g;
        const unsigned long long mA0 = __ballot(oA0), mA1 = __ballot(oA1);
        const int c0 = __popcll(mA0), n = c0 + __popcll(mA1);
#define MBC(m) __builtin_amdgcn_mbcnt_hi((unsigned)((m) >> 32), __builtin_amdgcn_mbcnt_lo((unsigned)(m), 0u))
        if (oA0) { const int p = MBC(mA0); le[p] = (eA0 << 8) | l; lk[p] = __builtin_bit_cast(int, gA0); }
        if (oA1) { const int p = c0 + MBC(mA1); le[p] = (eA1 << 8) | (64 + l); lk[p] = __builtin_bit_cast(int, gA1); }
#undef MBC
        LDS_WAIT(); asm volatile("" ::: "memory");
        for (int cb = 0; cb < n || cb == 0; cb += 64) {
        const int nc = min(n, cb + 64);
        const bool fv = (cb + l) < nc;
        const int ent = fv ? le[cb + l] : 0; const float gt = fv ? __builtin_bit_cast(float, lk[cb + l]) : 0.f; float tot = 0.f;
        const float su = SU[ent >> 8], sv = SV[ent >> 8];
        const unsigned long long radr = (unsigned long long)(U8 + (size_t)(((ent >> 8) & (UNG - 1)) * (NEXP / UNG) + ((ent >> 8) >> UNG_SH)) * 1024);
        const int ralo = (int)(unsigned)radr, rahi = (int)(unsigned)(radr >> 32);
        for (int i = cb; i < nc; i += 16) {
            u32x4 row[2][8];
#pragma unroll
            for (int b = 0; b < 2; ++b) if (i + 8 * b < nc) {
#pragma unroll
                for (int j = 0; j < 8; ++j) { const int ln = min(i + 8 * b + j, nc - 1) - cb;
                    const unsigned lo = (unsigned)__builtin_amdgcn_readlane(ralo, ln), hi = (unsigned)__builtin_amdgcn_readlane(rahi, ln);
                    const GAS unsigned char* rp = (const GAS unsigned char*)(((unsigned long long)hi << 32) | lo);
                    row[b][j] = *(const GAS u32x4*)(rp + (unsigned)loff); } }
            if (!pf_done) { pf_done = true; if (tok + step < T_TOK) U1_PREFETCH(tok + step); }
#pragma unroll
            for (int b = 0; b < 2; ++b) if (i + 8 * b < nc) {
                float p[8]; f32x4 accj[8];
#pragma unroll
                for (int j = 0; j < 8; ++j) accj[j] = __builtin_amdgcn_mfma_f32_16x16x32_fp8_fp8(lo64(row[b][j]), lo64(xA), (f32x4){0.f, 0.f, 0.f, 0.f}, 0, 0, 0);
#pragma unroll
                for (int j = 0; j < 8; ++j) accj[j] = __builtin_amdgcn_mfma_f32_16x16x32_fp8_fp8(hi64(row[b][j]), hi64(xA), accj[j], 0, 0, 0);
#pragma unroll
                for (int j = 0; j < 8; ++j) p[j] = __builtin_fmaf(accj[j][3], dw3, __builtin_fmaf(accj[j][2], dw2, __builtin_fmaf(accj[j][1], dw1, accj[j][0] * dw0)));
                float q4[4], q2[2], q1;
#pragma unroll
                for (int j = 0; j < 4; ++j) { const float keep = b5 ? p[4 + j] : p[j], send = b5 ? p[j] : p[4 + j]; q4[j] = keep + __shfl_xor(send, 32); }
#pragma unroll
                for (int j = 0; j < 2; ++j) { const float keep = b4 ? q4[2 + j] : q4[j], send = b4 ? q4[j] : q4[2 + j]; q2[j] = keep + __shfl_xor(send, 16); }
                { const float keep = b3 ? q2[1] : q2[0], send = b3 ? q2[0] : q2[1]; q1 = keep + __shfl_xor(send, 8); }
                q1 = DPP_ADD(q1, 0xB1); q1 = DPP_ADD(q1, 0x4E); q1 = DPP_ADD(q1, 0x141);
                const float t = __builtin_bit_cast(float, __builtin_amdgcn_ds_bpermute((l & 7) * 32, __builtin_bit_cast(int, q1)));
                const int base = i + 8 * b;
                if ((l >> 3) == ((base - cb) >> 3)) tot = t;
            }
        }
        if (!pf_done) { pf_done = true; if (tok + step < T_TOK) U1_PREFETCH(tok + step); }
        if (fv) AK[(size_t)tok * 128 + (ent & 127)] = gelu_tanh(tot * su * (1.f / 16.f)) * gt * sv;
        if (n == 0) break;
        }
        LDS_WAIT(); asm volatile("" ::: "memory");
    }
#undef U1_PREFETCH
}
template <int MODE>
__device__ __forceinline__ void peer_u4_phase(const Frame& F, const Args& A) {
    const unsigned char* X8 = A.ws + WS_P + P_X8;
    const float* SU = (const float*)(A.ws + WS_SU); const float* SV = (const float*)(A.ws + WS_SV);
    const int* IDX = (const int*)(A.ws + WS_P + P_IDX); const float* GATE = (const float*)(A.ws + WS_P + P_GATE); float* AK = (float*)(MODE == 0 ? A.ws + WS_AK : A.ws + WS_P + P_SC);
    const int g = F.bid & (UNG - 1), nmem = F.G >> UNG_SH, l = F.lane, step = nmem * NWAVES;
    const int m = l & 15, q = l >> 4;
    const GAS unsigned char* ub = (const GAS unsigned char*)(A.ws + WS_U8 + (size_t)g * (NEXP / UNG) * 512);
    const unsigned lconst = 16u * (unsigned)(4 * (m & 7) + q);
    const int xoff = 128 * (m & 7) + 16 * q;
    const bool dg = (m < 8) && ((m >> 2) == (q & 1)); const int dr = m & 3;
    const float dw0 = (dg && dr == 0) ? 1.f : 0.f, dw1 = (dg && dr == 1) ? 1.f : 0.f, dw2 = (dg && dr == 2) ? 1.f : 0.f, dw3 = (dg && dr == 3) ? 1.f : 0.f;
    const int rsel = 4 * (m >> 3);
    const int osrc = 4 * (32 * (l & 1) + 4 * ((l & 15) >> 1));
    const int sc1 = 0x7F7F7F7F;
    LAS int* le = (LAS int*)(F.lds + F.wave * 2048); LAS int* lk = le + 256;
    const bool b4 = (l & 16) != 0, b3 = (l & 8) != 0, b2 = (l & 4) != 0;
    int tok = (F.bid >> UNG_SH) * NWAVES + F.wave;
    u32x4 nx0, nx1; int ne0, ne1; float ng0, ng1;
#define U4_PREFETCH(t) do { const size_t _t = (size_t)(t); nx0 = *(const u32x4*)(X8 + _t * 1024 + xoff); nx1 = *(const u32x4*)(X8 + _t * 1024 + xoff + 64); \
        ne0 = IDX[_t * 128 + l]; ne1 = IDX[_t * 128 + 64 + l]; ng0 = GATE[_t * 128 + l]; ng1 = GATE[_t * 128 + 64 + l]; } while (0)
    if (tok < T_TOK) U4_PREFETCH(tok);
    for (; tok < T_TOK; tok += step) {
        const i32x8 xb = __builtin_shufflevector(__builtin_bit_cast(i32x4, nx0), __builtin_bit_cast(i32x4, nx1), 0, 1, 2, 3, 4, 5, 6, 7);
        const int e0 = ne0, e1 = ne1; const float g0 = ng0, g1 = ng1;
        bool pf_done = false;
        const bool o0 = (e0 & (UNG - 1)) == g, o1 = (e1 & (UNG - 1)) == g;
        const unsigned long long m0 = __ballot(o0), m1 = __ballot(o1);
        const int c0 = __popcll(m0), n = c0 + __popcll(m1);
#define MBC(mm) __builtin_amdgcn_mbcnt_hi((unsigned)((mm) >> 32), __builtin_amdgcn_mbcnt_lo((unsigned)(mm), 0u))
        if (o0) { const int p = MBC(m0); le[p] = (e0 << 8) | l; lk[p] = __builtin_bit_cast(int, g0); }
        if (o1) { const int p = c0 + MBC(m1); le[p] = (e1 << 8) | (64 + l); lk[p] = __builtin_bit_cast(int, g1); }
#undef MBC
        LDS_WAIT(); asm volatile("" ::: "memory");
        for (int cb = 0; cb < n || cb == 0; cb += 64) {
            const int nc = min(n, cb + 64);
            const bool fv = (cb + l) < nc;
            const int ent = fv ? le[cb + l] : 0; const float gt = fv ? __builtin_bit_cast(float, lk[cb + l]) : 0.f; float tot = 0.f;
            const float su = SU[ent >> 8], sv = SV[ent >> 8];
            const int roff = fv ? ((ent >> 8) >> UNG_SH) * 512 : 0;
            for (int i = cb; i < nc; i += 32) {
                u32x4 row[2][8];
#pragma unroll
                for (int b = 0; b < 2; ++b) if (i + 16 * b < nc) {
#pragma unroll
                    for (int j = 0; j < 8; ++j) { const int ro = __builtin_amdgcn_ds_bpermute(rsel + 4 * (i - cb + 16 * b + 2 * j), roff);
                        row[b][j] = *(const GAS u32x4*)(ub + ((unsigned)ro + lconst)); } }
                if (!pf_done) { pf_done = true; if (tok + step < T_TOK) U4_PREFETCH(tok + step); }
#pragma unroll
                for (int b = 0; b < 2; ++b) if (i + 16 * b < nc) {
                    float p[8];
#pragma unroll
                    for (int j = 0; j < 8; ++j) { const i32x4 r4 = __builtin_bit_cast(i32x4, row[b][j]);
                        const f32x4 d = __builtin_amdgcn_mfma_scale_f32_16x16x128_f8f6f4(__builtin_shufflevector(r4, r4, 0, 1, 2, 3, -1, -1, -1, -1), xb, (f32x4){0.f, 0.f, 0.f, 0.f}, 4, 0, 0, sc1, 0, sc1);
                        p[j] = __builtin_fmaf(d[3], dw3, __builtin_fmaf(d[2], dw2, __builtin_fmaf(d[1], dw1, d[0] * dw0))); }
                    float q4[4], q2[2], q1;
#pragma unroll
                    for (int j = 0; j < 4; ++j) { const float keep = b4 ? p[4 + j] : p[j], send = b4 ? p[j] : p[4 + j]; q4[j] = keep + __shfl_xor(send, 16); }
#pragma unroll
                    for (int j = 0; j < 2; ++j) { const float keep = b3 ? q4[2 + j] : q4[j], send = b3 ? q4[j] : q4[2 + j]; q2[j] = keep + __shfl_xor(send, 8); }
                    { const float keep = b2 ? q2[1] : q2[0], send = b2 ? q2[0] : q2[1]; q1 = keep + __shfl_xor(send, 4); }
                    q1 = DPP_ADD(q1, 0xB1); q1 = DPP_ADD(q1, 0x4E);
                    const float t = __builtin_bit_cast(float, __builtin_amdgcn_ds_bpermute(osrc, __builtin_bit_cast(int, q1)));
                    if ((l >> 4) == ((i - cb + 16 * b) >> 4)) tot = t;
                }
            }
            if (!pf_done) { pf_done = true; if (tok + step < T_TOK) U4_PREFETCH(tok + step); }
            if (fv) AK[(size_t)tok * 128 + (ent & 127)] = gelu_tanh(tot * su * (1.f / 16.f)) * gt * sv;
            if (n == 0) break;
        }
        LDS_WAIT(); asm volatile("" ::: "memory");
    }
#undef U4_PREFETCH
}
template <int MODE>
__device__ __forceinline__ void peer_u4_all(const Frame& F, const Args& A) {
    const unsigned char* X8 = A.ws + WS_P + P_X8;
    const float* SU = (const float*)(A.ws + WS_SU); const float* SV = (const float*)(A.ws + WS_SV);
    const int* IDX = (const int*)(A.ws + WS_P + P_IDX); const float* GATE = (const float*)(A.ws + WS_P + P_GATE); float* AK = (float*)(MODE == 0 ? A.ws + WS_AK : A.ws + WS_P + P_SC);
    const int l = F.lane, step = F.G * NWAVES;
    const int m = l & 15, q = l >> 4;
    const GAS unsigned char* ub = (const GAS unsigned char*)(A.ws + WS_U8);
    const unsigned lconst = 16u * (unsigned)(4 * (m & 7) + q);
    const int xoff = 128 * (m & 7) + 16 * q;
    const bool dg = (m < 8) && ((m >> 2) == (q & 1)); const int dr = m & 3;
    const float dw0 = (dg && dr == 0) ? 1.f : 0.f, dw1 = (dg && dr == 1) ? 1.f : 0.f, dw2 = (dg && dr == 2) ? 1.f : 0.f, dw3 = (dg && dr == 3) ? 1.f : 0.f;
    const int rsel = 4 * (m >> 3);
    const int osrc = 4 * (32 * (l & 1) + 4 * ((l & 15) >> 1));
    const int sc1 = 0x7F7F7F7F;
    const bool b4 = (l & 16) != 0, b3 = (l & 8) != 0, b2 = (l & 4) != 0;
    const int lhi = l >> 4;
    int tok = F.bid * NWAVES + F.wave;
    u32x4 nx0, nx1; int ne0, ne1; float ng0, ng1;
#define UA_PREFETCH(t) do { const size_t _t = (size_t)(t); nx0 = *(const u32x4*)(X8 + _t * 1024 + xoff); nx1 = *(const u32x4*)(X8 + _t * 1024 + xoff + 64); \
        ne0 = IDX[_t * 128 + l]; ne1 = IDX[_t * 128 + 64 + l]; ng0 = GATE[_t * 128 + l]; ng1 = GATE[_t * 128 + 64 + l]; } while (0)
#define UA_LOADS(R, ro_, h) do { _Pragma("unroll") for (int j_ = 0; j_ < 16; ++j_) { const int o_ = __builtin_amdgcn_ds_bpermute(rsel + 4 * (32 * (h) + 2 * j_), (ro_)); \
        R[j_] = *(const GAS u32x4*)(ub + ((unsigned)o_ + lconst)); } } while (0)
#define UA_COMPUTE(R, xb_, h, tot_) do { _Pragma("unroll") for (int b_ = 0; b_ < 2; ++b_) { float p_[8]; \
        _Pragma("unroll") for (int j_ = 0; j_ < 8; ++j_) { const i32x4 r4_ = __builtin_bit_cast(i32x4, R[8 * b_ + j_]); \
            const f32x4 d_ = __builtin_amdgcn_mfma_scale_f32_16x16x128_f8f6f4(__builtin_shufflevector(r4_, r4_, 0, 1, 2, 3, -1, -1, -1, -1), (xb_), (f32x4){0.f, 0.f, 0.f, 0.f}, 4, 0, 0, sc1, 0, sc1); \
            p_[j_] = __builtin_fmaf(d_[3], dw3, __builtin_fmaf(d_[2], dw2, __builtin_fmaf(d_[1], dw1, d_[0] * dw0))); } \
        float q4_[4], q2_[2], q1_; \
        _Pragma("unroll") for (int j_ = 0; j_ < 4; ++j_) { const float keep_ = b4 ? p_[4 + j_] : p_[j_], send_ = b4 ? p_[j_] : p_[4 + j_]; q4_[j_] = keep_ + __shfl_xor(send_, 16); } \
        _Pragma("unroll") for (int j_ = 0; j_ < 2; ++j_) { const float keep_ = b3 ? q4_[2 + j_] : q4_[j_], send_ = b3 ? q4_[j_] : q4_[2 + j_]; q2_[j_] = keep_ + __shfl_xor(send_, 8); } \
        { const float keep_ = b2 ? q2_[1] : q2_[0], send_ = b2 ? q2_[0] : q2_[1]; q1_ = keep_ + __shfl_xor(send_, 4); } \
        q1_ = DPP_ADD(q1_, 0xB1); q1_ = DPP_ADD(q1_, 0x4E); \
        const float t_ = __builtin_bit_cast(float, __builtin_amdgcn_ds_bpermute(osrc, __builtin_bit_cast(int, q1_))); \
        if (lhi == 2 * (h) + b_) (tot_) = t_; } } while (0)
    u32x4 RA[16], RB[16];
    if (tok < T_TOK) { UA_PREFETCH(tok); UA_LOADS(RA, ne0 * 512, 0); }
    for (; tok < T_TOK; tok += step) {
        const i32x8 xb = __builtin_shufflevector(__builtin_bit_cast(i32x4, nx0), __builtin_bit_cast(i32x4, nx1), 0, 1, 2, 3, 4, 5, 6, 7);
        const int e0 = ne0, e1 = ne1; const float g0 = ng0, g1 = ng1;
        const int ro0 = e0 * 512, ro1 = e1 * 512;
        const float su0 = SU[e0], sv0 = SV[e0], su1 = SU[e1], sv1 = SV[e1];
        const bool more = tok + step < T_TOK;
        float tot0 = 0.f, tot1 = 0.f;
        UA_LOADS(RB, ro0, 1);
        if (more) UA_PREFETCH(tok + step);
        UA_COMPUTE(RA, xb, 0, tot0);
        UA_LOADS(RA, ro1, 0);
        UA_COMPUTE(RB, xb, 1, tot0);
        UA_LOADS(RB, ro1, 1);
        UA_COMPUTE(RA, xb, 0, tot1);
        if (more) UA_LOADS(RA, ne0 * 512, 0);
        UA_COMPUTE(RB, xb, 1, tot1);
        AK[(size_t)tok * 128 + l] = gelu_tanh(tot0 * su0 * (1.f / 16.f)) * g0 * sv0;
        AK[(size_t)tok * 128 + 64 + l] = gelu_tanh(tot1 * su1 * (1.f / 16.f)) * g1 * sv1;
    }
#undef UA_PREFETCH
#undef UA_LOADS
#undef UA_COMPUTE
}
__device__ __forceinline__ float wave_max_nonneg(float v) {
    unsigned u = __builtin_bit_cast(unsigned, v);
    u = max(u, (unsigned)__builtin_amdgcn_mov_dpp((int)u, 0xB1, 0xf, 0xf, true));
    u = max(u, (unsigned)__builtin_amdgcn_mov_dpp((int)u, 0x4E, 0xf, 0xf, true));
    u = max(u, (unsigned)__builtin_amdgcn_mov_dpp((int)u, 0x141, 0xf, 0xf, true));
    u = max(u, (unsigned)__builtin_amdgcn_mov_dpp((int)u, 0x140, 0xf, 0xf, true));
    const unsigned a = (unsigned)__builtin_amdgcn_readlane((int)u, 0), b = (unsigned)__builtin_amdgcn_readlane((int)u, 16), c = (unsigned)__builtin_amdgcn_readlane((int)u, 32), d = (unsigned)__builtin_amdgcn_readlane((int)u, 48);
    return __builtin_bit_cast(float, max(max(a, b), max(c, d)));
}
template <int MODE>
__device__ __forceinline__ void peer_v_phase(const Frame& F, const Args& A) {
    const unsigned char* V8 = A.ws + WS_V8; const int* IDX = (const int*)(A.ws + WS_P + P_IDX); const float* AK = (const float*)(A.ws + WS_AK);
    float* out = MODE == 0 ? A.out : (float*)(A.ws + WS_P + P_SC);
    const int g = F.bid & 7, nmem = F.G >> 3, l = F.lane, sub = l & 7, rr = l >> 3, n16 = l & 15, q = l >> 4, step = nmem * NWAVES;
    const GAS unsigned char* vb = (const GAS unsigned char*)(V8 + (size_t)g * NEXP * 128);
    LAS unsigned long long* rep = (LAS unsigned long long*)(F.lds + F.wave * 2048);
    const unsigned long long bm = 0xFFull << (8 * (n16 & 7));
    const int repi = 2 * q + (n16 >> 3);
    const bool vl = (n16 < 8) && (q < 2);
    LAS float* stg = (LAS float*)(F.lds + 16384 + F.wave * 512);
    int tok = 2 * ((F.bid >> 3) * NWAVES + F.wave);
    int ne[4]; float na[4];
#define V_PREFETCH(t) do { const size_t _a = (size_t)(t) * 128, _b = ((size_t)(t) + 1) * 128; ne[0] = IDX[_a + l]; ne[1] = IDX[_a + 64 + l]; ne[2] = IDX[_b + l]; ne[3] = IDX[_b + 64 + l]; \
        na[0] = AK[_a + l]; na[1] = AK[_a + 64 + l]; na[2] = AK[_b + l]; na[3] = AK[_b + 64 + l]; } while (0)
    if (tok + 1 < T_TOK) V_PREFETCH(tok);
    for (; tok + 1 < T_TOK; tok += 2 * step) {
        const int e0 = ne[0], e1 = ne[1], e2 = ne[2], e3 = ne[3]; const float a0 = na[0], a1 = na[1], a2 = na[2], a3 = na[3];
        u32x4 rowA[16], rowB[16];
#pragma unroll
        for (int i = 0; i < 16; ++i) { const int src = (8 * (i & 7) + rr) * 4;
            const int ea = __builtin_amdgcn_ds_bpermute(src, i < 8 ? e0 : e1), eb = __builtin_amdgcn_ds_bpermute(src, i < 8 ? e2 : e3);
            rowA[i] = *(const GAS u32x4*)(vb + ((unsigned)ea * 128u + 16u * (unsigned)sub)); rowB[i] = *(const GAS u32x4*)(vb + ((unsigned)eb * 128u + 16u * (unsigned)sub)); }
        f32x4 HA = {0.f, 0.f, 0.f, 0.f}, HB = {0.f, 0.f, 0.f, 0.f};
        if (l < 32) { const float* hpa = out + (size_t)tok * D + g * 128 + 4 * l; HA = *(const f32x4*)hpa; HB = *(const f32x4*)(hpa + D); }
        if (tok + 2 * step + 1 < T_TOK) V_PREFETCH(tok + 2 * step);
        const float amA = wave_max_nonneg(fmaxf(fabsf(a0), fabsf(a1))), amB = wave_max_nonneg(fmaxf(fabsf(a2), fabsf(a3)));
        const float scA = amA > 0.f ? 224.f * __builtin_amdgcn_rcpf(amA) : 0.f, invA = amA * (1.f / 224.f), scB = amB > 0.f ? 224.f * __builtin_amdgcn_rcpf(amB) : 0.f, invB = amB * (1.f / 224.f);
        { const unsigned wA = (unsigned)__builtin_amdgcn_cvt_pk_fp8_f32(a0 * scA, a1 * scA, 0, false), wB = (unsigned)__builtin_amdgcn_cvt_pk_fp8_f32(a2 * scB, a3 * scB, 0, false);
          const unsigned r0 = (wA & 0xffu) * 0x01010101u, r1 = ((wA >> 8) & 0xffu) * 0x01010101u, r2 = (wB & 0xffu) * 0x01010101u, r3 = ((wB >> 8) & 0xffu) * 0x01010101u;
          rep[l] = ((unsigned long long)r0 << 32) | r0; rep[64 + l] = ((unsigned long long)r1 << 32) | r1; rep[128 + l] = ((unsigned long long)r2 << 32) | r2; rep[192 + l] = ((unsigned long long)r3 << 32) | r3; }
        LDS_WAIT(); asm volatile("" ::: "memory");
#pragma unroll
        for (int t2 = 0; t2 < 2; ++t2) {
            f32x4 alo = {0.f, 0.f, 0.f, 0.f}, ahi = {0.f, 0.f, 0.f, 0.f};
#pragma unroll
            for (int i = 0; i < 16; ++i) { const long bop = (long)(rep[128 * t2 + 8 * i + repi] & bm); const u32x4 rw = t2 ? rowB[i] : rowA[i];
                alo = __builtin_amdgcn_mfma_f32_16x16x32_fp8_fp8(lo64(rw), bop, alo, 0, 0, 0);
                ahi = __builtin_amdgcn_mfma_f32_16x16x32_fp8_fp8(hi64(rw), bop, ahi, 0, 0, 0); }
            const float inv = t2 ? invB : invA;
            float vlo[4], vhi[4];
#pragma unroll
            for (int r = 0; r < 4; ++r) { const float tl = alo[r], th = ahi[r];
                vlo[r] = (tl + __builtin_bit_cast(float, __builtin_amdgcn_ds_bpermute(((l + 40) & 63) * 4, __builtin_bit_cast(int, tl)))) * inv;
                vhi[r] = (th + __builtin_bit_cast(float, __builtin_amdgcn_ds_bpermute(((l + 40) & 63) * 4, __builtin_bit_cast(int, th)))) * inv; }
            if (vl) {
#pragma unroll
                for (int r = 0; r < 4; ++r) { stg[64 * q + 16 * r + n16] = vlo[r]; stg[64 * q + 16 * r + n16 + 8] = vhi[r]; } }
            LDS_WAIT(); asm volatile("" ::: "memory");
            if (l < 32) { const f32x4 dv = *(const LAS f32x4*)(stg + 4 * l); *(f32x4*)(out + (size_t)(tok + t2) * D + g * 128 + 4 * l) = (t2 ? HB : HA) + dv; }
            LDS_WAIT(); asm volatile("" ::: "memory");
        }
        LDS_WAIT(); asm volatile("" ::: "memory");
    }
#undef V_PREFETCH
}
typedef float f32x16 __attribute__((ext_vector_type(16)));
template <int MODE>
__device__ __forceinline__ void peer_v4_phase(const Frame& F, const Args& A) {
    const int* IDX = (const int*)(A.ws + WS_P + P_IDX); const float* AK = (const float*)(A.ws + WS_AK);
    float* out = A.out;
    const int l = F.lane, n = l & 31, hq = l >> 5, step = F.G * NWAVES;
    const GAS unsigned char* vb = (const GAS unsigned char*)(A.ws + WS_V8);
    const unsigned lconst = 16u * (unsigned)n;
    const bool diag = ((l >> 4) & 1) == hq;
    const unsigned bytem = diag ? (0xFFu << (8 * (l & 3))) : 0u; const int dsel = (l & 15) >> 2;
    const unsigned M0 = dsel == 0 ? bytem : 0u, M1 = dsel == 1 ? bytem : 0u, M2 = dsel == 2 ? bytem : 0u, M3 = dsel == 3 ? bytem : 0u;
    const int rsel = 4 * hq;
    const int sc1 = 0x7F7F7F7F;
    const int colb = 32 * n + 4 * hq;
    int tok = F.bid * NWAVES + F.wave;
    int ne0, ne1; float na0, na1;
#define V4_PREFETCH(t) do { const size_t _t = (size_t)(t) * 128; ne0 = IDX[_t + l]; ne1 = IDX[_t + 64 + l]; na0 = AK[_t + l]; na1 = AK[_t + 64 + l]; } while (0)
#define V4_LOADS(R, ro_, h) do { int ba_ = rsel + 4 * (16 * (h)); _Pragma("unroll") for (int j_ = 0; j_ < 8; ++j_) { asm volatile("" : "+v"(ba_)); const int o_ = __builtin_amdgcn_ds_bpermute(ba_, (ro_)); ba_ += 8; \
        R[j_] = *(const GAS u32x4*)(vb + ((unsigned)o_ + lconst)); } } while (0)
#define V4_ONE(ACC, R, rep_, h, j_) do { unsigned s0_ = (unsigned)__builtin_amdgcn_readlane((int)(rep_), 16 * (h) + 2 * (j_)), s1_ = (unsigned)__builtin_amdgcn_readlane((int)(rep_), 16 * (h) + 2 * (j_) + 1); \
        asm volatile("" : "+s"(s0_), "+s"(s1_), "+v"(ACC)); \
        const i32x8 a8_ = {(int)(s0_ & M0), (int)(s0_ & M1), (int)(s0_ & M2), (int)(s0_ & M3), (int)(s1_ & M0), (int)(s1_ & M1), (int)(s1_ & M2), (int)(s1_ & M3)}; \
        const i32x4 r4_ = __builtin_bit_cast(i32x4, R[j_]); \
        ACC = __builtin_amdgcn_mfma_scale_f32_32x32x64_f8f6f4(a8_, __builtin_shufflevector(r4_, r4_, 0, 1, 2, 3, -1, -1, -1, -1), ACC, 0, 4, 0, sc1, 0, sc1); } while (0)
#define V4_COMPUTE(R, rep_, h) do { V4_ONE(acc, R, rep_, h, 0); V4_ONE(acc1, R, rep_, h, 1); V4_ONE(acc, R, rep_, h, 2); V4_ONE(acc1, R, rep_, h, 3); \
        V4_ONE(acc, R, rep_, h, 4); V4_ONE(acc1, R, rep_, h, 5); V4_ONE(acc, R, rep_, h, 6); V4_ONE(acc1, R, rep_, h, 7); } while (0)
    u32x4 RA[8], RB[8];
    if (tok < T_TOK) { V4_PREFETCH(tok); V4_LOADS(RA, ne0 * 512, 0); }
    for (; tok < T_TOK; tok += step) {
        const int e0 = ne0, e1 = ne1; const float a0 = na0, a1 = na1;
        const int ro0 = e0 * 512, ro1 = e1 * 512;
        const bool more = tok + step < T_TOK;
        V4_LOADS(RB, ro0, 1);
        if (more) V4_PREFETCH(tok + step);
        const float am = wave_max_nonneg(fmaxf(fabsf(a0), fabsf(a1)));
        const float sc = am > 0.f ? 224.f * __builtin_amdgcn_rcpf(am) : 0.f, inv = am * (1.f / 224.f);
        const unsigned w8 = (unsigned)__builtin_amdgcn_cvt_pk_fp8_f32(a0 * sc, a1 * sc, 0, false);
        const unsigned rep0 = (w8 & 0xffu) * 0x01010101u, rep1 = ((w8 >> 8) & 0xffu) * 0x01010101u;
        f32x16 acc, acc1;
#pragma unroll
        for (int i = 0; i < 16; ++i) { acc[i] = 0.f; acc1[i] = 0.f; }
        V4_COMPUTE(RA, rep0, 0); V4_LOADS(RA, ro0, 2);
        V4_COMPUTE(RB, rep0, 1); V4_LOADS(RB, ro0, 3);
        V4_COMPUTE(RA, rep0, 2); V4_LOADS(RA, ro1, 0);
        V4_COMPUTE(RB, rep0, 3); V4_LOADS(RB, ro1, 1);
        V4_COMPUTE(RA, rep1, 0); V4_LOADS(RA, ro1, 2);
        V4_COMPUTE(RB, rep1, 1); V4_LOADS(RB, ro1, 3);
        f32x4 H[4];
        { const float* hp = out + (size_t)tok * D + colb;
#pragma unroll
          for (int j = 0; j < 4; ++j) H[j] = *(const f32x4*)(hp + 8 * j); }
        V4_COMPUTE(RA, rep1, 2);
        if (more) V4_LOADS(RA, ne0 * 512, 0);
        V4_COMPUTE(RB, rep1, 3);
        acc = acc + acc1;
        float ss = 0.f;
#pragma unroll
        for (int j = 0; j < 4; ++j) { H[j] = H[j] + (f32x4){acc[4 * j], acc[4 * j + 1], acc[4 * j + 2], acc[4 * j + 3]} * inv;
            ss += (H[j].x * H[j].x + H[j].y * H[j].y) + (H[j].z * H[j].z + H[j].w * H[j].w); }
        const float rstd = 1.f / sqrtf(wave_sum(ss) * (1.f / D) + EPS);
        { float* hp = out + (size_t)tok * D + colb;
#pragma unroll
          for (int j = 0; j < 4; ++j) *(f32x4*)(hp + 8 * j) = H[j] * rstd * *(const f32x4*)(A.in[I_FG] + colb + 8 * j); }
    }
#undef V4_PREFETCH
#undef V4_LOADS
#undef V4_COMPUTE
#undef V4_ONE
}
__device__ __forceinline__ void final_norm_phase(const Frame& F, const Args& A) {
    const int gw = F.bid * NWAVES + F.wave, NGW = F.G * NWAVES, l = F.lane; const float* fg = A.in[I_FG];
    const f32x4* gp = (const f32x4*)fg + l;
    int tok = gw;
    for (; tok + 3 * NGW < T_TOK; tok += 4 * NGW) {
        f32x4 v[4][4]; float ss[4];
#pragma unroll
        for (int b = 0; b < 4; ++b) { const f32x4* hp = (const f32x4*)(A.out + (size_t)(tok + b * NGW) * D) + l;
#pragma unroll
            for (int j = 0; j < 4; ++j) v[b][j] = hp[64 * j]; }
#pragma unroll
        for (int b = 0; b < 4; ++b) { ss[b] = 0.f;
#pragma unroll
            for (int j = 0; j < 4; ++j) ss[b] += (v[b][j].x * v[b][j].x + v[b][j].y * v[b][j].y) + (v[b][j].z * v[b][j].z + v[b][j].w * v[b][j].w); }
#pragma unroll
        for (int o = 1; o < 64; o <<= 1) {
#pragma unroll
            for (int b = 0; b < 4; ++b) ss[b] += __shfl_xor(ss[b], o); }
#pragma unroll
        for (int b = 0; b < 4; ++b) { const float rstd = 1.f / sqrtf(ss[b] * (1.f / D) + EPS); f32x4* hp = (f32x4*)(A.out + (size_t)(tok + b * NGW) * D) + l;
#pragma unroll
            for (int j = 0; j < 4; ++j) hp[64 * j] = v[b][j] * rstd * gp[64 * j]; }
    }
    for (; tok < T_TOK; tok += NGW) { f32x4* hp = (f32x4*)(A.out + (size_t)tok * D) + l; f32x4 v[4]; float ss = 0.f;
#pragma unroll
        for (int j = 0; j < 4; ++j) { v[j] = hp[64 * j]; ss += (v[j].x * v[j].x + v[j].y * v[j].y) + (v[j].z * v[j].z + v[j].w * v[j].w); }
        const float rstd = 1.f / sqrtf(wave_sum(ss) * (1.f / D) + EPS);
#pragma unroll
        for (int j = 0; j < 4; ++j) hp[64 * j] = v[j] * rstd * gp[64 * j]; }
}

#ifdef DEBUG_CHECK
constexpr size_t WS_DBG = 472 * MiB;
__device__ __forceinline__ int dbg_tok(int i) { return (i * 509 + 3) & 32767; }
__device__ __forceinline__ float gelu_ref(float x) { return 0.5f * x * (1.f + tanhf(0.7978845608028654f * (x + 0.044715f * x * x * x))); }
__global__ void __launch_bounds__(512) dbg_scores(Args a) {
    __shared__ float n2s[1024]; __shared__ float q[2048];
    const int t = dbg_tok(blockIdx.x), tid = threadIdx.x;
    const bf16_t* N2 = (const bf16_t*)(a.ws + WS_N1); const float* SC = (const float*)(a.ws + WS_P + P_SC); unsigned* dbg = (unsigned*)(a.ws + WS_DBG);
    for (int k = tid; k < 1024; k += 512) n2s[k] = bf1(N2[(size_t)t * 1024 + k]);
    __syncthreads();
    for (int r = 0; r < 4; ++r) { const int c = tid + 512 * r; float s = 0.f; for (int k = 0; k < 1024; ++k) s += n2s[k] * a.in[I_WQ][(size_t)k * 2048 + c]; q[c] = s; }
    __syncthreads();
    float md = 0.f;
    for (int r = 0; r < 4; ++r) { const int n = tid + 512 * r, hh = n >> 7, key = n & 127; const float* kX = (hh & 1) ? a.in[I_K2] : a.in[I_K1];
        float s = 0.f; for (int d = 0; d < 128; ++d) s += q[hh * 128 + d] * kX[key * 128 + d];
        md = fmaxf(md, fabsf(s - SC[(size_t)n * T_TOK + t])); }
    atomicMax(&dbg[0], __builtin_bit_cast(unsigned, md));
}
__global__ void __launch_bounds__(64) dbg_topk(Args a) {
    __shared__ float s1[8][128], s2[8][128], cv[8][256]; __shared__ float t1v[8][16], t2v[8][16]; __shared__ int t1i[8][16], t2i[8][16], exi[8][16]; __shared__ float exv[8][16];
    const int t = dbg_tok(blockIdx.x), h = threadIdx.x;
    const float* SC = (const float*)(a.ws + WS_P + P_SC); const int* IDX = (const int*)(a.ws + WS_P + P_IDX); const float* GATE = (const float*)(a.ws + WS_P + P_GATE); unsigned* dbg = (unsigned*)(a.ws + WS_DBG);
    if (h >= 8) return;
    for (int j = 0; j < 128; ++j) { s1[h][j] = SC[(size_t)(h * 256 + j) * T_TOK + t]; s2[h][j] = SC[(size_t)(h * 256 + 128 + j) * T_TOK + t]; }
    for (int r = 0; r < 16; ++r) { int b1 = 0, b2 = 0; for (int j = 1; j < 128; ++j) { if (s1[h][j] > s1[h][b1]) b1 = j; if (s2[h][j] > s2[h][b2]) b2 = j; }
        t1v[h][r] = s1[h][b1]; t1i[h][r] = b1; s1[h][b1] = -1e30f; t2v[h][r] = s2[h][b2]; t2i[h][r] = b2; s2[h][b2] = -1e30f; }
    for (int c = 0; c < 256; ++c) cv[h][c] = t1v[h][c >> 4] + t2v[h][c & 15];
    for (int r = 0; r < 16; ++r) { int bc = 0; for (int c = 1; c < 256; ++c) if (cv[h][c] > cv[h][bc]) bc = c;
        exv[h][r] = cv[h][bc]; exi[h][r] = t1i[h][bc >> 4] * 128 + t2i[h][bc & 15]; cv[h][bc] = -1e30f; }
    float sum = 0.f; const float mx0 = exv[h][0]; for (int r = 0; r < 16; ++r) { exv[h][r] = expf(exv[h][r] - mx0); } for (int r = 0; r < 16; ++r) sum += exv[h][r];
    unsigned miss = 0; float gd = 0.f;
    for (int w = 0; w < 16; ++w) { const int e = IDX[(size_t)t * 128 + h * 16 + w]; const float g = GATE[(size_t)t * 128 + h * 16 + w]; bool found = false;
        for (int r = 0; r < 16; ++r) if (exi[h][r] == e) { found = true; gd = fmaxf(gd, fabsf(g - exv[h][r] / sum)); }
        if (!found) ++miss; }
    atomicAdd(&dbg[1], miss); atomicMax(&dbg[3], __builtin_bit_cast(unsigned, gd));
}
__global__ void __launch_bounds__(512) dbg_experts_pre(Args a) {
    __shared__ float n2s[1024]; __shared__ float ak[128]; __shared__ int ek[128]; __shared__ float red[8];
    const int t = dbg_tok(blockIdx.x), tid = threadIdx.x, lane = tid & 63, wave = tid >> 6;
    const bf16_t* N2 = (const bf16_t*)(a.ws + WS_N1); const int* IDX = (const int*)(a.ws + WS_P + P_IDX); const float* GATE = (const float*)(a.ws + WS_P + P_GATE);
    float* rows = (float*)(a.ws + WS_DBG + MiB);
    for (int k = tid; k < 1024; k += 512) n2s[k] = bf1(N2[(size_t)t * 1024 + k]);
    if (tid < 128) ek[tid] = IDX[(size_t)t * 128 + tid];
    __syncthreads();
    for (int k = wave * 16; k < wave * 16 + 16; ++k) { const float* u = a.in[I_PU] + (size_t)ek[k] * 1024; float s = 0.f; for (int j = lane; j < 1024; j += 64) s += u[j] * n2s[j];
        s = wave_sum(s); if (lane == 0) ak[k] = gelu_ref(s) * GATE[(size_t)t * 128 + k]; }
    __syncthreads();
    float h2[2]; float ss = 0.f;
    for (int r = 0; r < 2; ++r) { const int d = tid + 512 * r; float o = 0.f; for (int k = 0; k < 128; ++k) o += ak[k] * a.in[I_PV][(size_t)ek[k] * 1024 + d]; h2[r] = a.out[(size_t)t * 1024 + d] + o; ss += h2[r] * h2[r]; }
    ss = wave_sum(ss); if (lane == 0) red[wave] = ss; __syncthreads();
    float tot = 0.f; for (int w = 0; w < 8; ++w) tot += red[w];
    const float rstd = 1.f / sqrtf(tot / 1024.f + EPS);
    for (int r = 0; r < 2; ++r) { const int d = tid + 512 * r; rows[(size_t)blockIdx.x * 1024 + d] = h2[r] * rstd * a.in[I_FG][d]; }
}
__global__ void __launch_bounds__(512) dbg_experts_post(Args a) {
    const int t = dbg_tok(blockIdx.x), tid = threadIdx.x; const float* rows = (const float*)(a.ws + WS_DBG + MiB); float* dbgf = (float*)(a.ws + WS_DBG);
    float e = 0.f, n = 0.f;
    for (int r = 0; r < 2; ++r) { const int d = tid + 512 * r; const float x = rows[(size_t)blockIdx.x * 1024 + d], y = a.out[(size_t)t * 1024 + d]; e += (x - y) * (x - y); n += x * x; }
    e = wave_sum(e); n = wave_sum(n); if ((tid & 63) == 0) { atomicAdd(&dbgf[4], e); atomicAdd(&dbgf[5], n); }
}
__global__ void __launch_bounds__(512) dbg_report(Args a, int which) {
    const unsigned* dbg = (const unsigned*)(a.ws + WS_DBG); const float* dbgf = (const float*)(a.ws + WS_DBG);
    const float mA = dbgf[0], gd = dbgf[3]; const unsigned miss = dbg[1]; const float relC = sqrtf(dbgf[4] / fmaxf(dbgf[5], 1e-30f));
    float X;
    if (which == 0) { int mask = 0; if (mA > 0.05f) mask |= 1; if (miss > 400u) mask |= 2; if (relC > 0.05f) mask |= 4; if (gd > 0.02f) mask |= 8; X = 1000.f + 100.f * mask; }
    else if (which == 1) X = 1e6f * mA; else if (which == 2) X = 100.f + (float)miss; else if (which == 3) X = 1e6f * relC; else X = 1e6f * gd;
    for (size_t i = (size_t)blockIdx.x * 512 + threadIdx.x; i < (size_t)T_TOK * D; i += (size_t)gridDim.x * 512) a.out[i] = (i == 0) ? X : 0.f;
}
#endif

constexpr int NPH = 13;
__global__ void __launch_bounds__(NWAVES * 64, 2) fwd_kernel(Args args) {
    extern __shared__ __attribute__((aligned(16))) unsigned char lds_raw[];
    Frame F;
    F.lds = (LAS unsigned char*)lds_raw;
    F.tid = threadIdx.x; F.lane = F.tid & 63; F.wave = __builtin_amdgcn_readfirstlane(F.tid >> 6);
    F.G = gridDim.x; F.bid = blockIdx.x;
    volatile LAS unsigned* MISC = (volatile LAS unsigned*)(F.lds + MISC_OFF);
    for (int u = F.tid; u < (LDS_BYTES - LDSCTL_OFF) / 4; u += NWAVES * 64) ((LAS unsigned*)(F.lds + LDSCTL_OFF))[u] = 0u;
    __syncthreads();
    unsigned* ctl = (unsigned*)(args.ws + WS_CTL);
    const int lo = args.ph_lo, hi = args.ph_hi;
    XcdBarrier bar; bar.bar = ctl + CW_BAR + args.li * XCD_BAR_WORDS; bar.x = 0; bar.st = nullptr; bar.wave = F.wave;
    if (hi - lo > 1) bar = xcd_barrier_post(ctl + CW_BAR + args.li * XCD_BAR_WORDS, MISC + 8, F.wave);
#define IN(k) (lo <= (k) && (k) < hi)
#ifdef PROBE_TS
#define STAMP(k) do { if (F.bid == 0 && F.tid == 0) ((unsigned long long*)(args.ws + (472u << 20)))[(k)] = __builtin_amdgcn_s_memrealtime(); } while (0)
#else
#define STAMP(k) do { } while (0)
#endif
#define SEAM(k) do { if (IN(k) && IN((k) + 1)) { xcd_barrier(bar); if (XTRA_BAR) xcd_barrier(bar); } STAMP((k) + 1); } while (0)
    unsigned char* ws = args.ws;
    bf16_t* P = (bf16_t*)(ws + WS_P);

#define REFRESH() do { int z_ = 0; asm volatile("" : "+s"(z_)); F.lane = (int)__builtin_amdgcn_mbcnt_hi(~0u, __builtin_amdgcn_mbcnt_lo(~0u, (unsigned)z_)); F.tid = F.wave * 64 + F.lane; } while (0)
    STAMP(0);
    if (IN(0)) { phase0(F, args); SEAM(0); }
    if (IN(1)) { REFRESH();
        if (F8_LO > 0) { pg8::Gemm g{(const bf16_t*)(ws + WS_N1), (const bf16_t*)(ws + WS_WIN), T_TOK, F8_LO * 256, D, D}; pg8::StaticOrder S; S.init(T_TOK, F8_LO * 256, F.G, F.bid);
            pg8::EpiProj E{P, (float*)(ws + WS_ALR), 0}; pg8::gemm_phase<pg8::EpiProj, pg8::StaticOrder, false, true, false>(F.lds, g, S, E, F.wave); }
        if (F8_LO < 21) {
            pg8::Gemm g{(const bf16_t*)(ws + WS_N18), (const bf16_t*)(ws + WS_W8 + (size_t)F8_LO * 256 * 1024), T_TOK, (21 - F8_LO) * 256, D / 2, D / 2, 0x7B7B7B7B, 0x75757575};
            pg8::StaticOrder S; S.init(T_TOK, (21 - F8_LO) * 256, F.G, F.G - 1 - F.bid);
            pg8::EpiProj E{P, (float*)(ws + WS_ALR), F8_LO}; pg8::gemm_phase<pg8::EpiProj, pg8::StaticOrder, false, true, true>(F.lds, g, S, E, F.wave); }
        {
            REFRESH();
            const int nwg = (T_TOK / 256) * (NPROJ / 256), rem = nwg % F.G;
            if (rem == 0) convert_tables(F, args, F.bid * NWAVES + F.wave, F.G * NWAVES);
            else if (F.bid >= rem) convert_tables(F, args, (F.bid - rem) * NWAVES + F.wave, (F.G - rem) * NWAVES);
        }
        SEAM(1);
    }
    if (IN(2)) { REFRESH();
        if (DRY_EXP == 12) { gla_chunk_phase<true>(F, args); for (int it = F.bid; it < 256; it += F.G) for (int g4 = 0; g4 < 4; ++g4) sgu_unit<true>(F, args, 4 * it + g4, g4 == 0); __syncthreads(); }
        gla_chunk_phase<false>(F, args);
        for (int it = F.bid; it < 256; it += F.G) for (int g4 = 0; g4 < 4; ++g4) sgu_unit<false>(F, args, 4 * it + g4, g4 == 0);
        SEAM(2);
    }
    if (IN(3)) { REFRESH(); if (DRY_EXP == 13 || DRY_EXP == 15) { gla_scan<true>(F, args); __syncthreads(); } gla_scan<false>(F, args); SEAM(3); }
    if (IN(4)) { REFRESH(); if (DRY_EXP == 14 || DRY_EXP == 15) { gla_out_phase<true>(F, args); __syncthreads(); } gla_out_phase<false>(F, args); SEAM(4); }
    if (IN(5)) { REFRESH();
        { pg8::Gemm g{P + PC_Q, (const bf16_t*)(ws + WS_WA), T_TOK, D, 512, PLD}; pg8::StaticOrder S; S.init(T_TOK, D, F.G, F.bid);
          pg8::EpiBrA E{P}; pg8::gemm_phase<pg8::EpiBrA, pg8::StaticOrder, true, true>(F.lds, g, S, E, F.wave); }
        { pg8::Gemm g{P + PC_SU, (const bf16_t*)(ws + WS_WB), T_TOK, D, 512, PLD}; pg8::StaticOrder S; S.init(T_TOK, D, F.G, F.bid);
          pg8::EpiBrB E{P}; pg8::gemm_phase<pg8::EpiBrB, pg8::StaticOrder, true, true>(F.lds, g, S, E, F.wave); }
        SEAM(5);
    }
    if (IN(6)) { REFRESH();
        pg8::Gemm g{P + PC_MRG, (const bf16_t*)(ws + WS_WOUT), T_TOK, D, D, PLD}; pg8::StaticOrder S; S.init(T_TOK, D, F.G, F.bid);
        pg8::EpiOut E{args.in[I_X], args.out}; pg8::gemm_phase<pg8::EpiOut, pg8::StaticOrder, true, true>(F.lds, g, S, E, F.wave);
        SEAM(6);
    }
    if (IN(7)) { REFRESH();
        const int gw = F.bid * NWAVES + F.wave, NGW = F.G * NWAVES;
        { int m = gw; for (; m + 3 * NGW < T_TOK; m += 4 * NGW) rms_rows_to_bf16<(SC_F8 ? 2 : 3), 4>(F.lane, args.out + (size_t)m * D, (size_t)NGW * D, args.in[I_N2G], (bf16_t*)(ws + WS_N1) + (size_t)m * D, (size_t)NGW * D, (unsigned*)(ws + WS_P + P_X8) + (size_t)m * 256, (size_t)NGW * 256);
          for (; m < T_TOK; m += NGW) rms_rows_to_bf16<(SC_F8 ? 2 : 3), 1>(F.lane, args.out + (size_t)m * D, 0, args.in[I_N2G], (bf16_t*)(ws + WS_N1) + (size_t)m * D, 0, (unsigned*)(ws + WS_P + P_X8) + (size_t)m * 256, 0); }
        SEAM(7);
    }
    if (IN(8)) { REFRESH();
        pg8::StaticOrder S; S.init(T_TOK, 2048, F.G, F.bid); pg8::EpiScores E{(bf16_t*)(ws + WS_P + P_SC)};
        if (SC_F8) { pg8::Gemm g{(const bf16_t*)(ws + WS_P + P_X8), (const bf16_t*)(ws + WS_WQF), T_TOK, 2048, D / 2, D / 2, 0x7B7B7B7B, 0x75757575};
            pg8::gemm_phase<pg8::EpiScores, pg8::StaticOrder, true, true, true>(F.lds, g, S, E, F.wave); }
        else { pg8::Gemm g{(const bf16_t*)(ws + WS_N1), (const bf16_t*)(ws + WS_WQF), T_TOK, 2048, D, D};
            pg8::gemm_phase<pg8::EpiScores, pg8::StaticOrder, true, true>(F.lds, g, S, E, F.wave); }
        SEAM(8);
    }
    if (IN(9)) { REFRESH(); peer_topk(F, args); SEAM(9); }
    if (IN(10)) { REFRESH(); if constexpr (UNG == 1) peer_u4_all<0>(F, args); else peer_u4_phase<0>(F, args); SEAM(10); }
    if (IN(11)) { REFRESH(); if (V_F4) peer_v4_phase<0>(F, args); else { if (DRY_EXP == 1) { peer_v_phase<1>(F, args); __syncthreads(); } peer_v_phase<0>(F, args); SEAM(11); } }
    if (IN(12)) { REFRESH(); if (!V_F4) final_norm_phase(F, args); }
#undef IN
#undef SEAM
}


#ifdef PROBE_TS
__global__ void __launch_bounds__(512) probe_report(Args a, int pi, int pj) {
    const unsigned long long* ts = (const unsigned long long*)(a.ws + (472u << 20));
    const float X1 = 10.f * (float)(ts[pi + 1] - ts[pi]) * 0.01f, X2 = (float)(ts[pj + 1] - ts[pj]) * 0.01f;
    for (size_t i = (size_t)blockIdx.x * 512 + threadIdx.x; i < (size_t)T_TOK * D; i += (size_t)gridDim.x * 512) a.out[i] = (i == 0) ? X1 : X2;
}
#endif
#ifdef PROBE_MFMA
__global__ void __launch_bounds__(64) probe_mfma(Args a) {
    const int l = threadIdx.x;
    i32x4 av = {0, 0, 0, 0};
    if (l == PROBE_L) av[PROBE_P >> 3] = 0x2 << (4 * (PROBE_P & 7));
    i32x8 b1, b2;
    for (int r = 0; r < 8; ++r) { unsigned w1 = 0, w2 = 0;
        for (int c = 0; c < 4; ++c) { const int b = 4 * r + c; int t = 0;
            t = __builtin_amdgcn_cvt_pk_fp8_f32((float)((b & 15) + 1), (float)(1 + (b >> 4) + 2 * (l >> 4)), 0, false);
            w1 |= ((unsigned)t & 0xffu) << (8 * c); w2 |= (((unsigned)t >> 8) & 0xffu) << (8 * c); }
        b1[r] = (int)w1; b2[r] = (int)w2; }
    const f32x4 z = {0.f, 0.f, 0.f, 0.f};
    const f32x4 d1 = __builtin_amdgcn_mfma_scale_f32_16x16x128_f8f6f4(__builtin_shufflevector(av, av, 0, 1, 2, 3, -1, -1, -1, -1), b1, z, 4, 0, 0, 0x7F7F7F7F, 0, 0x7F7F7F7F);
    const f32x4 d2 = __builtin_amdgcn_mfma_scale_f32_16x16x128_f8f6f4(__builtin_shufflevector(av, av, 0, 1, 2, 3, -1, -1, -1, -1), b2, z, 4, 0, 0, 0x7F7F7F7F, 0, 0x7F7F7F7F);
    float* st = (float*)(a.ws + (472u << 20));
    *(f32x4*)(st + 8 * l) = d1; *(f32x4*)(st + 8 * l + 4) = d2;
}
__global__ void __launch_bounds__(512) probe_mfma_report(Args a) {
    const int row = PROBE_L & 15;
    const float* st = (const float*)(a.ws + (472u << 20)) + 8 * (16 * (row >> 2)) + (row & 3); const float X1 = 10.f * st[0], X2 = st[4];
    for (size_t i = (size_t)blockIdx.x * 512 + threadIdx.x; i < (size_t)T_TOK * D; i += (size_t)gridDim.x * 512) a.out[i] = (i == 0) ? X1 : X2;
}
#endif
extern "C" void kernel_launch(void* const* d_in, const int* in_sizes, int n_in, void* d_out, int out_size, void* d_ws, size_t ws_size, hipStream_t stream) {
    static int grid = 0;
    if (grid == 0) {
        if (n_in != 20 || in_sizes[0] != T_TOK * D || out_size != T_TOK * D || ws_size < WS_END) {
            fprintf(stderr, "kernel_launch: unexpected shapes: n_in %d in0 %d out %d ws %zu (need %zu)\n", n_in, n_in > 0 ? in_sizes[0] : -1, out_size, ws_size, (size_t)WS_END); grid = -1; return; }
        int dev = 0, cus = 0;
        if (hipGetDevice(&dev) != hipSuccess || hipDeviceGetAttribute(&cus, hipDeviceAttributeMultiprocessorCount, dev) != hipSuccess) { grid = -1; return; }
        if (hipFuncSetAttribute((const void*)fwd_kernel, hipFuncAttributeMaxDynamicSharedMemorySize, LDS_BYTES) != hipSuccess) { fprintf(stderr, "kernel_launch: hipFuncSetAttribute failed\n"); grid = -1; return; }
        int per_cu = 0;
        if (hipOccupancyMaxActiveBlocksPerMultiprocessor(&per_cu, (const void*)fwd_kernel, NWAVES * 64, LDS_BYTES) != hipSuccess || per_cu < 1) fprintf(stderr, "kernel_launch: occupancy query says %d\n", per_cu);
        (void)hipGetLastError();
        grid = cus;
    }
    if (grid < 0) return;
    (void)hipMemsetAsync((char*)d_ws + WS_CTL, 0, CTL_ZERO_BYTES, stream);
    Args a{};
    for (int i = 0; i < 20; ++i) a.in[i] = (const float*)d_in[i];
    a.out = (float*)d_out; a.ws = (unsigned char*)d_ws;
#ifdef PROBE_MFMA
    hipLaunchKernelGGL(probe_mfma, dim3(1), dim3(64), 0, stream, a);
    hipLaunchKernelGGL(probe_mfma_report, dim3(1024), dim3(512), 0, stream, a);
    return;
#endif
#ifndef LAUNCH_LIST
#define LAUNCH_LIST {0, NPH}
#endif
    static const int ranges[][2] = { LAUNCH_LIST };
    const int nl = (int)(sizeof(ranges) / sizeof(ranges[0]));
    for (int li = 0; li < nl; ++li) { a.ph_lo = ranges[li][0]; a.ph_hi = ranges[li][1]; a.li = li;
        hipLaunchKernelGGL(fwd_kernel, dim3(grid), dim3(NWAVES * 64), LDS_BYTES, stream, a); }
}
```

```cpp
#include <hip/hip_runtime.h>
#include <cstdio>
#include <cstdint>


#ifndef XTRA_BAR
#define XTRA_BAR 0
#endif
#ifndef DRY_EXP
#define DRY_EXP 0
#endif
#ifndef DUP_PHASE
#define DUP_PHASE -1
#endif
#ifndef MK_N_LAUNCHES
#define MK_N_LAUNCHES 1
#endif

#define LAS __attribute__((address_space(3)))
#define GAS __attribute__((address_space(1)))
typedef unsigned short bf16_t;
typedef short bf16x8 __attribute__((ext_vector_type(8)));
typedef float f32x4 __attribute__((ext_vector_type(4)));
typedef float f32x2 __attribute__((ext_vector_type(2)));
typedef unsigned u32x4 __attribute__((ext_vector_type(4)));
typedef unsigned u32x2 __attribute__((ext_vector_type(2)));
typedef int i32x4 __attribute__((ext_vector_type(4)));
typedef int i32x8 __attribute__((ext_vector_type(8)));
typedef __bf16 bf16x2_t __attribute__((ext_vector_type(2)));

constexpr int T_TOK = 32768, D = 1024, SEQ = 4096, NBATCH = 8;
constexpr int NPROJ = 5376;
constexpr int PLD = 5120;
constexpr int PC_Q = 0, PC_K = 512, PC_V = 1024, PC_R = 1536, PC_SU = 2048, PC_SV = 2560, PC_GA = 3072, PC_GB = 4096;
constexpr int PC_MRG = 512;
constexpr float EPS = 1e-6f;
constexpr int NEXP = 16384;
#ifndef U_NG
#define U_NG 1
#endif
#ifndef V_F4
#define V_F4 1
#endif
#ifndef SC_F8
#define SC_F8 0
#endif
#ifndef F8_LO
#define F8_LO 11
#endif
constexpr int UNG = U_NG, UNG_SH = (U_NG == 8 ? 3 : (U_NG == 4 ? 2 : (U_NG == 2 ? 1 : 0)));

constexpr size_t MiB = 1u << 20;
constexpr size_t WS_CTL = 0, CTL_ZERO_BYTES = 64 * 1024;
constexpr size_t WS_WIN = 1 * MiB;
constexpr size_t WS_WA = 12 * MiB;
constexpr size_t WS_WB = 13 * MiB;
constexpr size_t WS_WOUT = 14 * MiB;
constexpr size_t WS_WQF = 16 * MiB;
constexpr size_t WS_U8 = 20 * MiB;
constexpr size_t WS_V8 = 36 * MiB;
constexpr size_t WS_SU = 52 * MiB;
constexpr size_t WS_SV = 52 * MiB + 65536;
constexpr size_t WS_AK = 53 * MiB;
constexpr size_t WS_DEC = 84 * MiB;
constexpr size_t WS_ALR = 85 * MiB;
constexpr size_t WS_N1 = 87 * MiB;
constexpr size_t WS_P = 151 * MiB;
constexpr size_t WS_W8 = 472 * MiB;
constexpr size_t WS_N18 = 478 * MiB;
constexpr size_t WS_END = 510 * MiB;
constexpr size_t P_N2 = 128 * MiB;
constexpr size_t P_SC = 0, P_IDX = 256 * MiB, P_GATE = 272 * MiB, P_X8 = 288 * MiB;

constexpr int CW_BAR = 4096;

constexpr int RING_BYTES = 131072;
constexpr int LDSCTL_OFF = RING_BYTES, MISC_OFF = LDSCTL_OFF + 320;
constexpr int LDS_BYTES = 147456;
constexpr int NWAVES = 8;

__device__ __forceinline__ unsigned pk2(float lo, float hi) { const f32x2 v = {lo, hi}; const bf16x2_t b = __builtin_convertvector(v, bf16x2_t); return __builtin_bit_cast(unsigned, b); }
__device__ __forceinline__ unsigned f2bf(float f) { return pk2(f, 0.f) & 0xffffu; }
__device__ __forceinline__ float bflo(unsigned w) { return __builtin_bit_cast(float, w << 16); }
__device__ __forceinline__ float bfhi(unsigned w) { return __builtin_bit_cast(float, w & 0xffff0000u); }
__device__ __forceinline__ float bf1(bf16_t h) { return __builtin_bit_cast(float, ((unsigned)h) << 16); }
__device__ __forceinline__ float sigmoidf_(float x) { return __builtin_amdgcn_rcpf(1.f + __expf(-x)); }
__device__ __forceinline__ float gelu_tanh(float x) { const float y = 1.5957691216057308f * (x + 0.044715f * x * x * x); return x * sigmoidf_(y); }
__device__ __forceinline__ float siluf_(float x) { return x * sigmoidf_(x); }
__device__ __forceinline__ float wave_sum(float v) {
#pragma unroll
    for (int o = 1; o < 64; o <<= 1) v += __shfl_xor(v, o);
    return v;
}
#define LDS_WAIT() asm volatile("s_waitcnt lgkmcnt(0)" ::: "memory")
#define VM_WAIT() asm volatile("s_waitcnt vmcnt(0)" ::: "memory")

__device__ __forceinline__ int lane_now() { int z = 0; asm volatile("" : "+s"(z)); return (int)__builtin_amdgcn_mbcnt_hi(~0u, __builtin_amdgcn_mbcnt_lo(~0u, (unsigned)z)); }
namespace pg8 {
constexpr int BM = 256, BK = 64, HALF = 128, HTB = HALF * BK * 2, STAGE_BYTES = 8 * HTB, NXCD = 8, WGM = 8;
__host__ __device__ __forceinline__ int lds_byte(int r, int c) { const int st = (r >> 4) * 2 + (c >> 5), rr = r & 15, cc = c & 31, ob = rr * 64 + cc * 2; return st * 1024 + (ob ^ (((ob >> 9) & 1) << 5)); }
__host__ __device__ __forceinline__ void stage_rc(int b, int& R, int& C) { const int st = b / 1024, sb = b % 1024, swz = sb ^ (((sb >> 9) & 1) << 5); R = (st >> 1) * 16 + swz / 64; C = (st & 1) * 32 + (swz % 64) / 2; }
__host__ __device__ __forceinline__ int perm32(int rho) { const int n = rho >> 4, i = rho & 15; return 8 * (i >> 2) + 4 * n + (i & 3); }

struct Unit { int pm, pn; };
struct Gemm { const bf16_t* A; const bf16_t* Bt; int M, N, K, lda; int sa = 0, sb = 0; };

struct StaticOrder {
    int nM, nN, nwg, G, c;
    __host__ __device__ void init(int M, int N, int G_, int c_) { nM = M / BM; nN = N / BM; nwg = nM * nN; G = G_; c = c_; }
    __host__ __device__ bool next(int i, Unit& u) const {
        const long L = (long)i * G + c; if (L >= nwg) return false;
        int wgid = (int)L; { const int q = nwg / NXCD, r = nwg % NXCD, xcd = wgid % NXCD, off = wgid / NXCD; wgid = (xcd < r ? xcd * (q + 1) : r * (q + 1) + (xcd - r) * q) + off; }
        const int nig = WGM * nN, gid = wgid / nig, fm = gid * WGM, gsz = (nM - fm) < WGM ? (nM - fm) : WGM;
        u.pm = fm + ((wgid % nig) % gsz); u.pn = (wgid % nig) / gsz; return true;
    }
    __device__ __forceinline__ void a_ready(const Unit&) const {}
    __device__ __forceinline__ void done(const Unit&) const {}
};

template <class Epi, class Sched, bool ALIGN_EPI = false, bool SP2 = false, bool F8 = false, bool MID = false>
__device__ __forceinline__ void gemm_phase(LAS unsigned char* lds, const Gemm g, const Sched& S, const Epi& E, int wave_id) {
    const int wid = wave_id, lane = lane_now(), tid = wid * 64 + lane, wr = wid >> 2, wc = wid & 3, fr = lane & 15, fq = lane >> 4;
    const int K = g.K, nt = K / BK, lda = g.lda; const int scA = g.sa, scB = g.sb; (void)scA; (void)scB;
    unsigned voffA[2], voffB[2];
#pragma unroll
    for (int i = 0; i < 2; ++i) { int R, C; stage_rc(tid * 16 + i * 8192, R, C); const int Rb = Epi::PERM ? ((R & ~31) + perm32(R & 31)) : R;
        voffA[i] = (unsigned)(R * lda + C) * 2u; voffB[i] = (unsigned)(Rb * K + C) * 2u; }
    const size_t kstep = (size_t)(BK * 2);
    const size_t hstepA = (size_t)HALF * lda * 2, hstepB = (size_t)HALF * K * 2;
    const size_t tstepA = 2 * hstepA, tstepB = 2 * hstepB;
    const unsigned ldsw = (unsigned)wid * 1024u; const unsigned ldsbase = (unsigned)(__UINTPTR_TYPE__)lds + ldsw;
    const int aoff = lds_byte(wr * 64 + fr, fq * 8), boff = lds_byte(wc * 32 + fr, fq * 8);
#define PG8_SA(b, h) (((b) * 2 + (h)) * HTB)
#define PG8_SB(b, h) ((4 + (b) * 2 + (h)) * HTB)
#define PG8_STAGE(bufoff, gbase, voff) do { _Pragma("unroll") for (int _i = 0; _i < 2; ++_i) \
        asm volatile("s_mov_b32 m0, %2\n\ts_nop 0\n\tglobal_load_lds_dwordx4 %0, %1" :: "v"((voff)[_i]), "s"((const char*)(gbase)), "s"(ldsbase + (unsigned)((bufoff) + _i * 8192)) : "memory", "m0"); } while (0)
#define PG8_LDA(dst, b, h) do { _Pragma("unroll") for (int m = 0; m < 4; ++m) _Pragma("unroll") for (int k = 0; k < 2; ++k) dst[m][k] = *(const LAS bf16x8*)(lds + PG8_SA(b, h) + aoff + m * 2048 + k * 1024); } while (0)
#define PG8_LDB(dst, b, h) do { _Pragma("unroll") for (int n = 0; n < 2; ++n) _Pragma("unroll") for (int k = 0; k < 2; ++k) dst[n][k] = *(const LAS bf16x8*)(lds + PG8_SB(b, h) + boff + n * 2048 + k * 1024); } while (0)
#define PG8_CAT(x) __builtin_shufflevector(__builtin_bit_cast(i32x4, (x)[0]), __builtin_bit_cast(i32x4, (x)[1]), 0, 1, 2, 3, 4, 5, 6, 7)
#define PG8_MMA(ai, bj, At, Bt) do { __builtin_amdgcn_s_setprio(1); if constexpr (F8) { _Pragma("unroll") for (int m = 0; m < 4; ++m) _Pragma("unroll") for (int n = 0; n < 2; ++n) \
        acc[ai][bj][m][n] = __builtin_amdgcn_mfma_scale_f32_16x16x128_f8f6f4(PG8_CAT(Bt[n]), PG8_CAT(At[m]), acc[ai][bj][m][n], 0, 0, 0, scB, 0, scA); } else { \
        _Pragma("unroll") for (int m = 0; m < 4; ++m) _Pragma("unroll") for (int n = 0; n < 2; ++n) _Pragma("unroll") for (int k = 0; k < 2; ++k) \
        acc[ai][bj][m][n] = __builtin_amdgcn_mfma_f32_16x16x32_bf16(Bt[n][k], At[m][k], acc[ai][bj][m][n], 0, 0, 0); } __builtin_amdgcn_s_setprio(0); } while (0)
#define PG8_WAIT_V(n) asm volatile("s_waitcnt vmcnt(" #n ")" ::: "memory")
#define PG8_WAIT_L(n) asm volatile("s_waitcnt lgkmcnt(" #n ")" ::: "memory")
#define PG8_BAR __builtin_amdgcn_s_barrier()
#define PG8_SCHED __builtin_amdgcn_sched_barrier(0)
    Unit cur, nxt; int ui = 0;
    if (!S.next(0, cur)) return;
    f32x4 acc[2][2][4][2];
#pragma unroll
    for (int a = 0; a < 2; ++a)
#pragma unroll
        for (int b = 0; b < 2; ++b)
#pragma unroll
            for (int m = 0; m < 4; ++m)
#pragma unroll
                for (int n = 0; n < 2; ++n) acc[a][b][m][n] = (f32x4){0.f, 0.f, 0.f, 0.f};
    bf16x8 At[4][2], B0[2][2], B1[2][2];
    const char* cA = (const char*)g.A + (size_t)cur.pm * tstepA; const char* cB = (const char*)g.Bt + (size_t)cur.pn * tstepB;
    S.a_ready(cur);
    if constexpr (SP2) {
        PG8_STAGE(PG8_SB(0, 0), cB, voffB); PG8_STAGE(PG8_SB(0, 1), cB + hstepB, voffB); PG8_STAGE(PG8_SA(0, 0), cA, voffA); PG8_STAGE(PG8_SA(0, 1), cA + hstepA, voffA);
        if (wr == 1) PG8_BAR;
        PG8_WAIT_V(2); PG8_BAR;
        PG8_STAGE(PG8_SB(1, 0), cB + kstep, voffB); PG8_STAGE(PG8_SA(1, 0), cA + kstep, voffA); PG8_STAGE(PG8_SB(1, 1), cB + hstepB + kstep, voffB);
        PG8_WAIT_V(6); PG8_BAR;
    } else {
        PG8_STAGE(PG8_SB(0, 0), cB, voffB); PG8_STAGE(PG8_SA(0, 0), cA, voffA); PG8_STAGE(PG8_SB(0, 1), cB + hstepB, voffB); PG8_STAGE(PG8_SA(0, 1), cA + hstepA, voffA);
        if (wr == 1) PG8_BAR;
        PG8_WAIT_V(4); PG8_BAR;
        PG8_STAGE(PG8_SB(1, 0), cB + kstep, voffB); PG8_STAGE(PG8_SA(1, 0), cA + kstep, voffA); PG8_STAGE(PG8_SB(1, 1), cB + hstepB + kstep, voffB);
        PG8_WAIT_V(6); PG8_BAR;
    }
    for (;;) {
        const bool has_next = S.next(ui + 1, nxt);
        const char* nA = has_next ? (const char*)g.A + (size_t)nxt.pm * tstepA : cA; const char* nB = has_next ? (const char*)g.Bt + (size_t)nxt.pn * tstepB : cB;
#pragma nounroll
        for (int t = 0; t < nt; t += 2) {
            if constexpr (MID) { if (t == (nt >> 1)) E.mid(acc, cur, wr, wc); }
            const bool last = (t == nt - 2);
            const char* a1 = cA + (size_t)(t + 1) * kstep;
            const char* a2 = last ? nA : cA + (size_t)(t + 2) * kstep; const char* b2 = last ? nB : cB + (size_t)(t + 2) * kstep;
            const char* a3 = a2 + kstep; const char* b3 = b2 + kstep;
            if (last && has_next) S.a_ready(nxt);
            if constexpr (SP2) {
            PG8_LDB(B0, 0, 0); PG8_LDB(B1, 0, 1); PG8_SCHED; PG8_LDA(At, 0, 0); PG8_STAGE(PG8_SA(1, 1), a1 + hstepA, voffA);
            PG8_WAIT_V(8); PG8_WAIT_L(0); PG8_BAR; PG8_MMA(0, 0, At, B0); PG8_MMA(0, 1, At, B1); PG8_BAR; PG8_SCHED;
            PG8_LDA(At, 0, 1); PG8_STAGE(PG8_SB(0, 0), b2, voffB); PG8_STAGE(PG8_SB(0, 1), b2 + hstepB, voffB); PG8_STAGE(PG8_SA(0, 0), a2, voffA);
            PG8_WAIT_V(8); PG8_WAIT_L(0); PG8_BAR; PG8_MMA(1, 0, At, B0); PG8_MMA(1, 1, At, B1); PG8_BAR; PG8_SCHED;
            PG8_LDB(B0, 1, 0); PG8_LDB(B1, 1, 1); PG8_SCHED; PG8_LDA(At, 1, 0); PG8_STAGE(PG8_SA(0, 1), a2 + hstepA, voffA);
            PG8_WAIT_V(8); PG8_WAIT_L(0); PG8_BAR; PG8_MMA(0, 0, At, B0); PG8_MMA(0, 1, At, B1); PG8_BAR; PG8_SCHED;
            PG8_LDA(At, 1, 1); PG8_STAGE(PG8_SB(1, 0), b3, voffB); PG8_STAGE(PG8_SB(1, 1), b3 + hstepB, voffB); PG8_STAGE(PG8_SA(1, 0), a3, voffA);
            PG8_WAIT_V(8); PG8_WAIT_L(0); PG8_BAR; PG8_MMA(1, 0, At, B0); PG8_MMA(1, 1, At, B1); PG8_BAR; PG8_SCHED;
            } else {
            PG8_LDB(B0, 0, 0); PG8_SCHED; PG8_LDA(At, 0, 0); PG8_STAGE(PG8_SA(1, 1), a1 + hstepA, voffA);
            PG8_WAIT_L(8); PG8_BAR; PG8_WAIT_L(0); PG8_MMA(0, 0, At, B0); PG8_BAR; PG8_SCHED;
            PG8_LDB(B1, 0, 1); PG8_STAGE(PG8_SB(0, 0), b2, voffB);
            PG8_BAR; PG8_WAIT_L(0); PG8_MMA(0, 1, At, B1); PG8_BAR;
            PG8_LDA(At, 0, 1); PG8_STAGE(PG8_SA(0, 0), a2, voffA);
            PG8_BAR; PG8_WAIT_L(0); PG8_MMA(1, 0, At, B0); PG8_BAR; PG8_SCHED;
            PG8_STAGE(PG8_SB(0, 1), b2 + hstepB, voffB);
            PG8_WAIT_V(6); PG8_BAR; PG8_MMA(1, 1, At, B1); PG8_BAR;
            PG8_LDB(B0, 1, 0); PG8_SCHED; PG8_LDA(At, 1, 0); PG8_STAGE(PG8_SA(0, 1), a2 + hstepA, voffA);
            PG8_WAIT_L(8); PG8_BAR; PG8_WAIT_L(0); PG8_MMA(0, 0, At, B0); PG8_BAR; PG8_SCHED;
            PG8_LDB(B1, 1, 1); PG8_STAGE(PG8_SB(1, 0), b3, voffB);
            PG8_BAR; PG8_WAIT_L(0); PG8_MMA(0, 1, At, B1); PG8_BAR;
            PG8_LDA(At, 1, 1); PG8_STAGE(PG8_SA(1, 0), a3, voffA);
            PG8_BAR; PG8_WAIT_L(0); PG8_MMA(1, 0, At, B0); PG8_BAR; PG8_SCHED;
            PG8_STAGE(PG8_SB(1, 1), b3 + hstepB, voffB);
            PG8_WAIT_V(6); PG8_BAR; PG8_MMA(1, 1, At, B1); PG8_BAR;
            }
        }
        if constexpr (ALIGN_EPI) { if (wr == 0) PG8_BAR; }
        E(acc, cur, wr, wc, fr, fq); S.done(cur);
        if (!has_next) break;
#pragma unroll
        for (int a = 0; a < 2; ++a)
#pragma unroll
            for (int b = 0; b < 2; ++b)
#pragma unroll
                for (int m = 0; m < 4; ++m)
#pragma unroll
                    for (int n = 0; n < 2; ++n) acc[a][b][m][n] = (f32x4){0.f, 0.f, 0.f, 0.f};
        cur = nxt; cA = nA; cB = nB; ++ui;
        if constexpr (ALIGN_EPI) { if (wr == 1) PG8_BAR; }
    }
    PG8_WAIT_V(0);
    if constexpr (!ALIGN_EPI) { if (wr == 0) PG8_BAR; }
    PG8_BAR;
#undef PG8_SA
#undef PG8_SB
#undef PG8_STAGE
#undef PG8_LDA
#undef PG8_LDB
#undef PG8_MMA
#undef PG8_CAT
#undef PG8_WAIT_V
#undef PG8_WAIT_L
#undef PG8_BAR
#undef PG8_SCHED
}

__device__ __forceinline__ u32x4 pack8(f32x4 v0, f32x4 v1) { u32x4 w; w.x = pk2(v0[0], v0[1]); w.y = pk2(v0[2], v0[3]); w.z = pk2(v1[0], v1[1]); w.w = pk2(v1[2], v1[3]); return w; }
__device__ __forceinline__ void unpack8(u32x4 w, f32x4& v0, f32x4& v1) { v0 = (f32x4){bflo(w.x), bfhi(w.x), bflo(w.y), bfhi(w.y)}; v1 = (f32x4){bflo(w.z), bfhi(w.z), bflo(w.w), bfhi(w.w)}; }

struct EpiProj {
    static constexpr bool PERM = true;
    bf16_t* P; float* ALR; int pn0;
    __device__ __forceinline__ void operator()(const f32x4 (&acc)[2][2][4][2], const Unit& u, int wr, int wc, int fr, int fq) const {
        { const int ln = lane_now(); fr = ln & 15; fq = ln >> 4; }
        const int row0 = u.pm * BM + wr * 64 + fr; int pn = u.pn + pn0; const int cl = wc * 32 + 8 * fq;
        if (pn == 10) {
            if (wc == 0 && fq < 2) {
#pragma unroll
                for (int ai = 0; ai < 2; ++ai)
#pragma unroll
                    for (int m = 0; m < 4; ++m) { float* rp = ALR + (size_t)(row0 + ai * HALF + m * 16) * 16 + 8 * fq;
                        *(f32x4*)rp = acc[ai][0][m][0]; *(f32x4*)(rp + 4) = acc[ai][0][m][1]; }
            }
            return;
        }
        if (pn > 10) --pn;
        const int mode = pn < 8 ? 0 : (pn < 12 ? 1 : 2);
#pragma unroll
        for (int ai = 0; ai < 2; ++ai)
#pragma unroll
            for (int m = 0; m < 4; ++m) { bf16_t* rowp = P + (size_t)(row0 + ai * HALF + m * 16) * PLD + pn * BM + cl;
#pragma unroll
                for (int bj = 0; bj < 2; ++bj) { f32x4 v0 = acc[ai][bj][m][0], v1 = acc[ai][bj][m][1];
                    if (mode == 1) {
#pragma unroll
                        for (int i = 0; i < 4; ++i) { v0[i] = gelu_tanh(v0[i]); v1[i] = gelu_tanh(v1[i]); }
                    } else if (mode == 2) {
#pragma unroll
                        for (int i = 0; i < 4; ++i) { v0[i] = sigmoidf_(v0[i]); v1[i] = sigmoidf_(v1[i]); }
                    }
                    *(u32x4*)(rowp + bj * HALF) = pack8(v0, v1); } }
    }
};
struct EpiBrA {
    static constexpr bool PERM = true;
    bf16_t* P;
    __device__ __forceinline__ void operator()(const f32x4 (&acc)[2][2][4][2], const Unit& u, int wr, int wc, int fr, int fq) const {
        const int row0 = u.pm * BM + wr * 64 + fr; const int c0 = u.pn * BM + wc * 32 + 8 * fq;
#pragma unroll
        for (int ai = 0; ai < 2; ++ai)
#pragma unroll
            for (int m = 0; m < 4; ++m) { bf16_t* rowp = P + (size_t)(row0 + ai * HALF + m * 16) * PLD;
#pragma unroll
                for (int bj = 0; bj < 2; ++bj) { const int c = c0 + bj * HALF; f32x4 g0, g1; unpack8(*(const u32x4*)(rowp + PC_GA + c), g0, g1);
                    *(u32x4*)(rowp + PC_MRG + c) = pack8(acc[ai][bj][m][0] * g0, acc[ai][bj][m][1] * g1); } }
    }
};
struct EpiBrB {
    static constexpr bool PERM = true;
    bf16_t* P;
    __device__ __forceinline__ void operator()(const f32x4 (&acc)[2][2][4][2], const Unit& u, int wr, int wc, int fr, int fq) const {
        const int row0 = u.pm * BM + wr * 64 + fr; const int c0 = u.pn * BM + wc * 32 + 8 * fq;
#pragma unroll
        for (int ai = 0; ai < 2; ++ai)
#pragma unroll
            for (int m = 0; m < 4; ++m) { bf16_t* rowp = P + (size_t)(row0 + ai * HALF + m * 16) * PLD;
#pragma unroll
                for (int bj = 0; bj < 2; ++bj) { const int c = c0 + bj * HALF; f32x4 g0, g1, p0, p1; unpack8(*(const u32x4*)(rowp + PC_GB + c), g0, g1); unpack8(*(const u32x4*)(rowp + PC_MRG + c), p0, p1);
                    *(u32x4*)(rowp + PC_MRG + c) = pack8(p0 + acc[ai][bj][m][0] * g0, p1 + acc[ai][bj][m][1] * g1); } }
    }
};
struct EpiBrAB {
    static constexpr bool PERM = true;
    bf16_t* P;
    __device__ __forceinline__ void mid(f32x4 (&acc)[2][2][4][2], const Unit& u, int wr, int wc) const {
        const int ln = lane_now(), fr = ln & 15, fq = ln >> 4;
        const int row0 = u.pm * BM + wr * 64 + fr; const int c0 = u.pn * BM + wc * 32 + 8 * fq;
#pragma unroll
        for (int ai = 0; ai < 2; ++ai)
#pragma unroll
            for (int m = 0; m < 4; ++m) { const bf16_t* rowp = P + (size_t)(row0 + ai * HALF + m * 16) * PLD;
#pragma unroll
                for (int bj = 0; bj < 2; ++bj) { const int c = c0 + bj * HALF; f32x4 a0, a1, b0, b1; unpack8(*(const u32x4*)(rowp + PC_GA + c), a0, a1); unpack8(*(const u32x4*)(rowp + PC_GB + c), b0, b1);
#pragma unroll
                    for (int i = 0; i < 4; ++i) { acc[ai][bj][m][0][i] *= a0[i] * __builtin_amdgcn_rcpf(fmaxf(b0[i], 1e-20f)); acc[ai][bj][m][1][i] *= a1[i] * __builtin_amdgcn_rcpf(fmaxf(b1[i], 1e-20f)); } } }
    }
    __device__ __forceinline__ void operator()(const f32x4 (&acc)[2][2][4][2], const Unit& u, int wr, int wc, int fr, int fq) const {
        { const int ln = lane_now(); fr = ln & 15; fq = ln >> 4; }
        const int row0 = u.pm * BM + wr * 64 + fr; const int c0 = u.pn * BM + wc * 32 + 8 * fq;
#pragma unroll
        for (int ai = 0; ai < 2; ++ai)
#pragma unroll
            for (int m = 0; m < 4; ++m) { bf16_t* rowp = P + (size_t)(row0 + ai * HALF + m * 16) * PLD;
#pragma unroll
                for (int bj = 0; bj < 2; ++bj) { const int c = c0 + bj * HALF; f32x4 g0, g1; unpack8(*(const u32x4*)(rowp + PC_GB + c), g0, g1);
                    *(u32x4*)(rowp + PC_MRG + c) = pack8(acc[ai][bj][m][0] * g0, acc[ai][bj][m][1] * g1); } }
    }
};
struct EpiOut {
    static constexpr bool PERM = true;
    bf16_t* O;
    __device__ __forceinline__ void operator()(const f32x4 (&acc)[2][2][4][2], const Unit& u, int wr, int wc, int fr, int fq) const {
        const int row0 = u.pm * BM + wr * 64 + fr; const int c0 = u.pn * BM + wc * 32 + 8 * fq;
#pragma unroll
        for (int ai = 0; ai < 2; ++ai)
#pragma unroll
            for (int m = 0; m < 4; ++m) { const size_t ro = (size_t)(row0 + ai * HALF + m * 16) * D;
#pragma unroll
                for (int bj = 0; bj < 2; ++bj) *(u32x4*)(O + ro + c0 + bj * HALF) = pack8(acc[ai][bj][m][0], acc[ai][bj][m][1]); }
    }
};
struct EpiScores {
    static constexpr bool PERM = true;
    bf16_t* SC;
    __device__ __forceinline__ void operator()(const f32x4 (&acc)[2][2][4][2], const Unit& u, int wr, int wc, int fr, int fq) const {
        const int tb0 = u.pm * 16 + wr * 4; const int cq0 = (u.pn * BM + wc * 32 + 8 * fq) >> 3;
#pragma unroll
        for (int ai = 0; ai < 2; ++ai)
#pragma unroll
            for (int m = 0; m < 4; ++m) { bf16_t* bp = SC + ((size_t)(tb0 + ai * 8 + m) * 256) * 128 + fr * 8;
#pragma unroll
                for (int bj = 0; bj < 2; ++bj) *(u32x4*)(bp + (size_t)(cq0 + bj * 16) * 128) = pack8(acc[ai][bj][m][0], acc[ai][bj][m][1]); }
    }
};
}

#define XB_TMO      128
#define XB_XCNT(j)  (256  + 64 * (j))
#define XB_XSUB(j)  (1280 + 64 * (j))
#define XB_XGEN(j)  (2304 + 64 * (j))
#define XB_TOP      3328
#define XB_TOPGEN   3392
#define XCD_BAR_WORDS 3456
#define XB_SPIN_CAP (1u << 18)
__device__ __forceinline__ unsigned xb_ld(unsigned* p)              { return __hip_atomic_load(p, __ATOMIC_RELAXED, __HIP_MEMORY_SCOPE_AGENT); }
__device__ __forceinline__ unsigned xb_add(unsigned* p, unsigned v) { return __hip_atomic_fetch_add(p, v, __ATOMIC_RELAXED, __HIP_MEMORY_SCOPE_AGENT); }
__device__ __forceinline__ unsigned xb_xcc_id() { return (unsigned)__builtin_amdgcn_s_getreg((3 << 11) | 20) & 0xFu; }
#define XB_SPIN(cond, bar) do { unsigned _sp = 0; while (cond) { __builtin_amdgcn_s_sleep(1); \
    if ((++_sp & 255u) == 0u) { if (xb_ld(&(bar)[XB_TMO])) break; if (_sp > XB_SPIN_CAP) { atomicAdd(&(bar)[XB_TMO], 1u); break; } } } } while (0)
struct XcdBarrier { unsigned* bar; unsigned x; volatile LAS unsigned* st; int wave; };
__device__ __forceinline__ XcdBarrier xcd_barrier_post(unsigned* bar, volatile LAS unsigned* st, int wave) {
    XcdBarrier b; b.bar = bar; b.x = xb_xcc_id(); b.st = st; b.wave = wave;
    if (wave == 0 && lane_now() == 0) (void)xb_add(&bar[XB_XCNT(b.x)], 1u);
    return b;
}
__device__ __forceinline__ void xcd_barrier_complete(unsigned* bar, unsigned x, unsigned& nloc, unsigned& nx) {
    const unsigned G = gridDim.x * gridDim.y * gridDim.z;
    unsigned sum, cnt, mine, sp = 0u;
    for (;;) {
        sum = 0u; cnt = 0u; mine = 0u;
#pragma unroll
        for (unsigned j = 0; j < 16; ++j) { const unsigned c = xb_ld(&bar[XB_XCNT(j)]); sum += c; cnt += (c > 0u) ? 1u : 0u; mine = (j == x) ? c : mine; }
        if (sum == G) break;
        __builtin_amdgcn_s_sleep(1);
        if ((++sp & 255u) == 0u) { if (xb_ld(&bar[XB_TMO])) break; if (sp > XB_SPIN_CAP) { atomicAdd(&bar[XB_TMO], 1u); break; } }
    }
    nloc = mine > 0u ? mine : 1u; nx = cnt > 0u ? cnt : 1u;
}
__device__ __forceinline__ void xcd_barrier(const XcdBarrier& b) {
    asm volatile("s_waitcnt vmcnt(0)" ::: "memory");
    __syncthreads();
    if (b.wave == 0 && lane_now() == 0) {
        unsigned* bar = b.bar;
        __builtin_amdgcn_s_waitcnt(0);
        unsigned nloc = b.st[0], nx = b.st[1];
        if (nloc == 0u) { xcd_barrier_complete(bar, b.x, nloc, nx); b.st[0] = nloc; b.st[1] = nx; }
        const unsigned old = xb_add(&bar[XB_XSUB(b.x)], 1u);
        const unsigned gen = old / nloc;
        if (old + 1u == (gen + 1u) * nloc) {
            __builtin_amdgcn_fence(__ATOMIC_RELEASE, "agent");
            asm volatile("s_waitcnt vmcnt(0)" ::: "memory");
            const unsigned og = xb_add(&bar[XB_TOP], 1u);
            const unsigned tg = og / nx;
            if (og + 1u == (tg + 1u) * nx) xb_add(&bar[XB_TOPGEN], 1u);
            else XB_SPIN(xb_ld(&bar[XB_TOPGEN]) == tg, bar);
            __builtin_amdgcn_fence(__ATOMIC_ACQUIRE, "agent");
            xb_add(&bar[XB_XGEN(b.x)], 1u);
            asm volatile("s_waitcnt vmcnt(0)" ::: "memory");
        } else {
            XB_SPIN(xb_ld(&bar[XB_XGEN(b.x)]) == gen, bar);
            __builtin_amdgcn_fence(__ATOMIC_ACQUIRE, "agent");
            asm volatile("s_waitcnt vmcnt(0)" ::: "memory");
        }
    }
    __syncthreads();
}

struct Args {
    const float* in[20]; float* out; unsigned char* ws; int ph_lo, ph_hi, li, pad;
};
enum { I_X = 0, I_N1G, I_WIN, I_WGU, I_BG, I_GLAG, I_SLNG, I_SLNB, I_SW, I_SB, I_WBA, I_WBB, I_WOUT, I_N2G, I_WQ, I_K1, I_K2, I_PU, I_PV, I_FG };

struct Frame {
    LAS unsigned char* lds;
    int tid, lane, wave, G, bid;
};

__device__ __forceinline__ float clamp448(float v) { return __builtin_amdgcn_fmed3f(v, -448.f, 448.f); }
template <int MODE, bool F8 = false>
__device__ __forceinline__ void p0_transpose_item(const float* W, int K, int Nsrc, int Ndst, bf16_t* WT, LAS float* scr, int item, int lane, float sc8 = 1.f, int ldk = 0) {
    if (ldk == 0) ldk = K;
    const int nblk = Ndst / 32, kb = item / nblk, nb = item % nblk, k0 = 64 * kb, n0 = 32 * nb;
    const int nd = n0 + (lane & 31);
    int sc = nd; bool valid = true;
    if (MODE == 1) { if (nd < 2048) sc = nd; else if (nd < 2560) sc = nd + 16; else if (nd < 2576) sc = 2048 + (nd - 2560); else if (nd < 2816) { sc = 0; valid = false; } else sc = nd - 240; }
#pragma unroll 8
    for (int i = 0; i < 32; ++i) { const int kk = 2 * i + (lane >> 5); const float v = valid ? W[(size_t)(k0 + kk) * Nsrc + sc] : 0.f; scr[kk * 33 + (lane & 31)] = v; }
    LDS_WAIT(); asm volatile("" ::: "memory");
    if (F8) {
        const int c = lane & 3;
#pragma unroll
        for (int j = 0; j < 2; ++j) { const int n = (lane >> 2) + 16 * j; const LAS float* s = scr + (16 * c) * 33 + n; u32x4 o;
#pragma unroll
            for (int q = 0; q < 4; ++q) { int w = 0; w = __builtin_amdgcn_cvt_pk_fp8_f32(clamp448(s[(4 * q) * 33] * sc8), clamp448(s[(4 * q + 1) * 33] * sc8), w, false);
                w = __builtin_amdgcn_cvt_pk_fp8_f32(clamp448(s[(4 * q + 2) * 33] * sc8), clamp448(s[(4 * q + 3) * 33] * sc8), w, true); o[q] = (unsigned)w; }
            *(u32x4*)((unsigned char*)WT + (size_t)(n0 + n) * ldk + k0 + 16 * c) = o; }
    } else {
    const int c = lane & 7;
#pragma unroll
    for (int j = 0; j < 4; ++j) { const int n = (lane >> 3) + 8 * j; const LAS float* s = scr + (8 * c) * 33 + n;
        u32x4 o; o.x = pk2(s[0 * 33], s[1 * 33]); o.y = pk2(s[2 * 33], s[3 * 33]); o.z = pk2(s[4 * 33], s[5 * 33]); o.w = pk2(s[6 * 33], s[7 * 33]);
        *(u32x4*)(WT + (size_t)(n0 + n) * ldk + k0 + 8 * c) = o; }
    }
    LDS_WAIT(); asm volatile("" ::: "memory");
}
template <int OM, int NB>
__device__ __forceinline__ void rms_rows_to_bf16(int lane, const float* x0, size_t xstride, const float* g, bf16_t* o0, size_t ostride, unsigned* o80 = nullptr, size_t o8stride = 0, const bf16_t* add0 = nullptr, size_t addstride = 0) {
    f32x4 v[NB][4]; float s[NB];
#pragma unroll
    for (int b = 0; b < NB; ++b) { const f32x4* xr = (const f32x4*)(x0 + b * xstride) + lane;
#pragma unroll
        for (int j = 0; j < 4; ++j) v[b][j] = xr[64 * j]; }
    if (add0) {
        u32x2 ad[NB][4];
#pragma unroll
        for (int b = 0; b < NB; ++b) { const u32x2* ar = (const u32x2*)(add0 + b * addstride) + lane;
#pragma unroll
            for (int j = 0; j < 4; ++j) ad[b][j] = ar[64 * j]; }
#pragma unroll
        for (int b = 0; b < NB; ++b)
#pragma unroll
            for (int j = 0; j < 4; ++j) v[b][j] = v[b][j] + (f32x4){bflo(ad[b][j].x), bfhi(ad[b][j].x), bflo(ad[b][j].y), bfhi(ad[b][j].y)};
    }
#pragma unroll
    for (int b = 0; b < NB; ++b) { s[b] = 0.f;
#pragma unroll
        for (int j = 0; j < 4; ++j) s[b] += (v[b][j].x * v[b][j].x + v[b][j].y * v[b][j].y) + (v[b][j].z * v[b][j].z + v[b][j].w * v[b][j].w); }
#pragma unroll
    for (int o = 1; o < 64; o <<= 1) {
#pragma unroll
        for (int b = 0; b < NB; ++b) s[b] += __shfl_xor(s[b], o); }
    const f32x4* gr = (const f32x4*)g + lane;
#pragma unroll
    for (int b = 0; b < NB; ++b) { const float rstd = 1.f / sqrtf(s[b] * (1.f / D) + EPS); u32x2* o8 = (u32x2*)(o0 + b * ostride) + lane;
#pragma unroll
        for (int j = 0; j < 4; ++j) { const f32x4 gg = gr[64 * j]; const f32x4 y = v[b][j] * rstd * gg; u32x2 o; o.x = pk2(y.x, y.y); o.y = pk2(y.z, y.w); if (OM & 1) o8[64 * j] = o;
            if (OM == 3) { int w = 0; w = __builtin_amdgcn_cvt_pk_fp8_f32(clamp448(bflo(o.x) * 16.f), clamp448(bfhi(o.x) * 16.f), w, false); w = __builtin_amdgcn_cvt_pk_fp8_f32(clamp448(bflo(o.y) * 16.f), clamp448(bfhi(o.y) * 16.f), w, true); (o80 + b * o8stride)[64 * j + lane] = (unsigned)w; }
            if (OM == 2) { int w = 0; w = __builtin_amdgcn_cvt_pk_fp8_f32(clamp448(y.x * 16.f), clamp448(y.y * 16.f), w, false); w = __builtin_amdgcn_cvt_pk_fp8_f32(clamp448(y.z * 16.f), clamp448(y.w * 16.f), w, true); (o80 + b * o8stride)[64 * j + lane] = (unsigned)w; } } }
}
__device__ __forceinline__ float wave_max(float v) {
#pragma unroll
    for (int o = 1; o < 64; o <<= 1) v = fmaxf(v, __shfl_xor(v, o));
    return v;
}
template <int NB>
__device__ __forceinline__ void cvt_rows_fp8(int lane, const float* const (&src)[NB], unsigned char* const (&dst16)[NB], float* const (&scale_out)[NB]) {
    f32x4 v[NB][4]; float m[NB];
#pragma unroll
    for (int b = 0; b < NB; ++b) {
#pragma unroll
        for (int j = 0; j < 4; ++j) v[b][j] = *(const GAS f32x4*)(src[b] + 16 * lane + 4 * j); }
#pragma unroll
    for (int b = 0; b < NB; ++b) { m[b] = 0.f;
#pragma unroll
        for (int j = 0; j < 4; ++j) m[b] = fmaxf(m[b], fmaxf(fmaxf(fabsf(v[b][j].x), fabsf(v[b][j].y)), fmaxf(fabsf(v[b][j].z), fabsf(v[b][j].w)))); }
#pragma unroll
    for (int o = 1; o < 64; o <<= 1) {
#pragma unroll
        for (int b = 0; b < NB; ++b) m[b] = fmaxf(m[b], __shfl_xor(m[b], o)); }
#pragma unroll
    for (int b = 0; b < NB; ++b) { const float inv = m[b] > 0.f ? 224.f / m[b] : 0.f, sc = m[b] > 0.f ? m[b] * (1.f / 224.f) : 1.f;
        u32x4 o;
#pragma unroll
        for (int j = 0; j < 4; ++j) { int w = 0; w = __builtin_amdgcn_cvt_pk_fp8_f32(v[b][j].x * inv, v[b][j].y * inv, w, false); w = __builtin_amdgcn_cvt_pk_fp8_f32(v[b][j].z * inv, v[b][j].w * inv, w, true); o[j] = (unsigned)w; }
        *(GAS u32x4*)dst16[b] = o;
        if (lane == 0) *(GAS float*)scale_out[b] = sc; }
}
__device__ __forceinline__ unsigned fp4_code(float t) { const float a = fabsf(t);
    const unsigned c = (unsigned)(a >= 0.25f) + (unsigned)(a >= 0.75f) + (unsigned)(a >= 1.25f) + (unsigned)(a >= 1.75f) + (unsigned)(a >= 2.5f) + (unsigned)(a >= 3.5f) + (unsigned)(a >= 5.f);
    return c | (t < 0.f ? 8u : 0u); }
template <int NB>
__device__ __forceinline__ void cvt_rows_fp4(int lane, const float* const (&src)[NB], unsigned char* const (&dst8)[NB], float* const (&scale_out)[NB]) {
    f32x4 v[NB][4]; float m[NB];
#pragma unroll
    for (int b = 0; b < NB; ++b) {
#pragma unroll
        for (int j = 0; j < 4; ++j) v[b][j] = *(const GAS f32x4*)(src[b] + 16 * lane + 4 * j); }
#pragma unroll
    for (int b = 0; b < NB; ++b) { m[b] = 0.f;
#pragma unroll
        for (int j = 0; j < 4; ++j) m[b] = fmaxf(m[b], fmaxf(fmaxf(fabsf(v[b][j].x), fabsf(v[b][j].y)), fmaxf(fabsf(v[b][j].z), fabsf(v[b][j].w)))); }
#pragma unroll
    for (int o = 1; o < 64; o <<= 1) {
#pragma unroll
        for (int b = 0; b < NB; ++b) m[b] = fmaxf(m[b], __shfl_xor(m[b], o)); }
#pragma unroll
    for (int b = 0; b < NB; ++b) { const float inv = m[b] > 0.f ? 6.f / m[b] : 0.f, sc = m[b] > 0.f ? m[b] * (1.f / 6.f) : 1.f;
        u32x2 o;
#pragma unroll
        for (int h = 0; h < 2; ++h) { unsigned w = 0;
            const f32x4 t0 = v[b][2 * h] * inv, t1 = v[b][2 * h + 1] * inv;
            w = __builtin_amdgcn_cvt_scalef32_pk_fp4_f32(w, t0.x, t0.y, 1.f, 0); w = __builtin_amdgcn_cvt_scalef32_pk_fp4_f32(w, t0.z, t0.w, 1.f, 1);
            w = __builtin_amdgcn_cvt_scalef32_pk_fp4_f32(w, t1.x, t1.y, 1.f, 2); w = __builtin_amdgcn_cvt_scalef32_pk_fp4_f32(w, t1.z, t1.w, 1.f, 3);
            o[h] = w; }
        *(GAS u32x2*)dst8[b] = o;
        if (lane == 0) *(GAS float*)scale_out[b] = sc; }
}
__device__ __forceinline__ void convert_tables(const Frame& F, const Args& A, int wi, int nw) {
    unsigned char* ws = A.ws; const int gw = wi, NGW = nw;
    {
        int mc = gw;
        for (; mc + 3 * NGW < NEXP; mc += 4 * NGW) { const float* src[4]; unsigned char* dst[4]; float* sco[4];
#pragma unroll
            for (int b = 0; b < 4; ++b) { const int e = mc + b * NGW; src[b] = A.in[I_PU] + (size_t)e * D; dst[b] = ws + WS_U8 + (size_t)((e & (UNG - 1)) * (NEXP / UNG) + (e >> UNG_SH)) * 512 + 8 * F.lane; sco[b] = (float*)(ws + WS_SU) + e; }
            cvt_rows_fp4<4>(F.lane, src, dst, sco); }
        for (; mc < NEXP; mc += NGW) { const float* src[1]; unsigned char* dst[1]; float* sco[1];
            const int e = mc; src[0] = A.in[I_PU] + (size_t)e * D; dst[0] = ws + WS_U8 + (size_t)((e & (UNG - 1)) * (NEXP / UNG) + (e >> UNG_SH)) * 512 + 8 * F.lane; sco[0] = (float*)(ws + WS_SU) + e;
            cvt_rows_fp4<1>(F.lane, src, dst, sco); }
    }
    if (V_F4) {
        int mc = gw;
        for (; mc + 3 * NGW < NEXP; mc += 4 * NGW) { const float* src[4]; unsigned char* dst[4]; float* sco[4];
#pragma unroll
            for (int b = 0; b < 4; ++b) { const int e = mc + b * NGW; src[b] = A.in[I_PV] + (size_t)e * D; dst[b] = ws + WS_V8 + (size_t)e * 512 + 8 * F.lane; sco[b] = (float*)(ws + WS_SV) + e; }
            cvt_rows_fp4<4>(F.lane, src, dst, sco); }
        for (; mc < NEXP; mc += NGW) { const float* src[1]; unsigned char* dst[1]; float* sco[1];
            const int e = mc; src[0] = A.in[I_PV] + (size_t)e * D; dst[0] = ws + WS_V8 + (size_t)e * 512 + 8 * F.lane; sco[0] = (float*)(ws + WS_SV) + e;
            cvt_rows_fp4<1>(F.lane, src, dst, sco); }
    } else {
        int mc = gw;
        for (; mc + 3 * NGW < NEXP; mc += 4 * NGW) { const float* src[4]; unsigned char* dst[4]; float* sco[4];
#pragma unroll
            for (int b = 0; b < 4; ++b) { const int e = mc + b * NGW; src[b] = A.in[I_PV] + (size_t)e * D; dst[b] = ws + WS_V8 + ((size_t)(F.lane >> 3) * NEXP + e) * 128 + 16 * (F.lane & 7); sco[b] = (float*)(ws + WS_SV) + e; }
            cvt_rows_fp8<4>(F.lane, src, dst, sco); }
        for (; mc < NEXP; mc += NGW) { const float* src[1]; unsigned char* dst[1]; float* sco[1];
            const int e = mc; src[0] = A.in[I_PV] + (size_t)e * D; dst[0] = ws + WS_V8 + ((size_t)(F.lane >> 3) * NEXP + e) * 128 + 16 * (F.lane & 7); sco[0] = (float*)(ws + WS_SV) + e;
            cvt_rows_fp8<1>(F.lane, src, dst, sco); }
    }
}
__device__ __forceinline__ void phase0(const Frame& F, const Args& A) {
    unsigned char* ws = A.ws;
    if (!SC_F8) {
        const int l = F.lane, fr = l & 15, q = l >> 4;
        bf16_t* WQF = (bf16_t*)(ws + WS_WQF);
        for (int it = F.bid * NWAVES + F.wave; it < 2048; it += F.G * NWAVES) {
            const int kh = it & 1, kt = (it >> 1) & 63, hh = it >> 7;
            const float* kX = (hh & 1) ? A.in[I_K2] : A.in[I_K1];
            const float* ap = A.in[I_WQ] + (size_t)(kt * 16 + fr) * 2048 + hh * 128 + 4 * q;
            f32x4 a[8];
#pragma unroll
            for (int t = 0; t < 8; ++t) a[t] = *(const f32x4*)(ap + 16 * t);
#pragma unroll
            for (int kb = 0; kb < 4; ++kb) { const int key0 = kh * 64 + kb * 16;
                const float* bp = kX + (size_t)(key0 + fr) * 128 + 4 * q;
                f32x4 b[8];
#pragma unroll
                for (int t = 0; t < 8; ++t) b[t] = *(const f32x4*)(bp + 16 * t);
                f32x4 d = {0.f, 0.f, 0.f, 0.f};
#pragma unroll
                for (int t = 0; t < 8; ++t)
#pragma unroll
                    for (int c = 0; c < 4; ++c) d = __builtin_amdgcn_mfma_f32_16x16x4f32(a[t][c], b[t][c], d, 0, 0, 0);
                u32x2 o; o.x = pk2(d[0], d[1]); o.y = pk2(d[2], d[3]);
                *(u32x2*)(WQF + (size_t)(hh * 128 + key0 + fr) * 1024 + kt * 16 + 4 * q) = o; }
        }
    } else {
        LAS float* kx = (LAS float*)F.lds;
        LAS float* wt = (LAS float*)(F.lds + 128 * 129 * 4);
        bf16_t* WQF = (bf16_t*)(ws + WS_WQF);
        for (int it = F.bid; it < 512; it += F.G) {
            const int hh = it >> 5, kblk = it & 31, k0 = kblk * 32;
            const float* kX = (hh & 1) ? A.in[I_K2] : A.in[I_K1];
            __syncthreads();
            for (int e = F.tid; e < 128 * 128; e += 512) kx[(e >> 7) * 129 + (e & 127)] = kX[e];
            for (int e = F.tid; e < 32 * 128; e += 512) wt[e] = A.in[I_WQ][(size_t)(k0 + (e >> 7)) * 2048 + hh * 128 + (e & 127)];
            __syncthreads();
            const int key = F.tid & 127, kq = F.tid >> 7;
            float acc[8];
#pragma unroll
            for (int i = 0; i < 8; ++i) acc[i] = 0.f;
            for (int d = 0; d < 128; ++d) { const float b = kx[key * 129 + d];
#pragma unroll
                for (int i = 0; i < 8; ++i) acc[i] += wt[(kq * 8 + i) * 128 + d] * b; }
            if (SC_F8) { u32x2 o;
#pragma unroll
                for (int h2 = 0; h2 < 2; ++h2) { int w = 0; w = __builtin_amdgcn_cvt_pk_fp8_f32(clamp448(acc[4 * h2] * 1024.f), clamp448(acc[4 * h2 + 1] * 1024.f), w, false);
                    w = __builtin_amdgcn_cvt_pk_fp8_f32(clamp448(acc[4 * h2 + 2] * 1024.f), clamp448(acc[4 * h2 + 3] * 1024.f), w, true); o[h2] = (unsigned)w; }
                *(u32x2*)((unsigned char*)WQF + (size_t)(hh * 128 + key) * 1024 + k0 + kq * 8) = o;
            } else {
            u32x4 o; o.x = pk2(acc[0], acc[1]); o.y = pk2(acc[2], acc[3]); o.z = pk2(acc[4], acc[5]); o.w = pk2(acc[6], acc[7]);
            *(u32x4*)(WQF + (size_t)(hh * 128 + key) * 1024 + k0 + kq * 8) = o; }
        }
        __syncthreads();
    }
    LAS float* scr = (LAS float*)(F.lds + F.wave * 16384);
    const int gw = F.bid * NWAVES + F.wave, NGW = F.G * NWAVES;
    constexpr int I_IN = 16 * (NPROJ / 32), I_A = 8 * 32, I_B = 8 * 32, I_O = 16 * 32;
    constexpr int NITEMS = I_IN + I_A + I_B + I_O;
    for (int it = gw; it < NITEMS; it += NGW) {
        int r = it;
        if (r < I_IN) { if ((r % (NPROJ / 32)) * 32 >= F8_LO * 256) p0_transpose_item<1, true>(A.in[I_WIN], 1024, 5136, NPROJ, (bf16_t*)(ws + WS_W8), scr, r, F.lane, 1024.f);
                        else p0_transpose_item<1, false>(A.in[I_WIN], 1024, 5136, NPROJ, (bf16_t*)(ws + WS_WIN), scr, r, F.lane); continue; } r -= I_IN;
        if (r < I_A) { p0_transpose_item<0>(A.in[I_WBA], 512, 1024, 1024, (bf16_t*)(ws + WS_WA), scr, r, F.lane, 1.f, 1024); continue; } r -= I_A;
        if (r < I_B) { p0_transpose_item<0>(A.in[I_WBB], 512, 1024, 1024, (bf16_t*)(ws + WS_WA) + 512, scr, r, F.lane, 1.f, 1024); continue; } r -= I_B;
        p0_transpose_item<0>(A.in[I_WOUT], 1024, 1024, 1024, (bf16_t*)(ws + WS_WOUT), scr, r, F.lane);
    }
    constexpr int OM1 = F8_LO <= 0 ? 2 : (F8_LO >= 21 ? 1 : 3);
    { int m = gw; for (; m + 3 * NGW < T_TOK; m += 4 * NGW) rms_rows_to_bf16<OM1, 4>(F.lane, A.in[I_X] + (size_t)m * D, (size_t)NGW * D, A.in[I_N1G], (bf16_t*)(ws + WS_N1) + (size_t)m * D, (size_t)NGW * D, (unsigned*)(ws + WS_N18) + (size_t)m * 256, (size_t)NGW * 256);
      for (; m < T_TOK; m += NGW) rms_rows_to_bf16<OM1, 1>(F.lane, A.in[I_X] + (size_t)m * D, 0, A.in[I_N1G], (bf16_t*)(ws + WS_N1) + (size_t)m * D, 0, (unsigned*)(ws + WS_N18) + (size_t)m * 256, 0); }
}

__device__ __forceinline__ float log_sigmoid(float z) { return fminf(z, 0.f) - log1pf(__expf(-fabsf(z))); }

template <bool DRY>
__device__ __forceinline__ void gla_chunk_phase(const Frame& F, const Args& A) {
    unsigned char* ws = A.ws;
    const bf16_t* P = (const bf16_t*)(ws + WS_P);
    const float* ALR = (const float*)(ws + WS_ALR);
    LAS float* alr = (LAS float*)F.lds;
    LAS float* tot = (LAS float*)(F.lds + 4096);
    LAS bf16_t* kdT = (LAS bf16_t*)(F.lds + 8192);
    LAS bf16_t* vT = (LAS bf16_t*)(F.lds + 26624);
    LAS bf16_t* stT = (LAS bf16_t*)(F.lds + 45056);
    const int tid = F.tid, kk = tid & 127, seg = tid >> 7;
    const bool hconst = (F.G & 3) == 0;
    int hcur = -1; float w[16]; float bias = 0.f;
#pragma unroll
    for (int j = 0; j < 16; ++j) w[j] = 0.f;
    float na0, na1; bf16_t nk[16], nv[16];
#define GC_LOAD(unit) do { const int h_ = (unit) & 3, c_ = ((unit) >> 2) & 63, b_ = (unit) >> 8; const int t0_ = b_ * SEQ + c_ * 64; \
        na0 = ALR[(size_t)t0_ * 16 + tid]; na1 = ALR[(size_t)t0_ * 16 + 512 + tid]; \
        const bf16_t* kp_ = P + (size_t)(t0_ + 16 * seg) * PLD + PC_K + h_ * 128 + kk; const bf16_t* vp_ = P + (size_t)(t0_ + 16 * seg) * PLD + PC_V + h_ * 128 + kk; \
        _Pragma("unroll") for (int i_ = 0; i_ < 16; ++i_) { nk[i_] = kp_[(size_t)i_ * PLD]; nv[i_] = vp_[(size_t)i_ * PLD]; } } while (0)
    int unit = F.bid;
    if (unit < 2048) GC_LOAD(unit);
    for (; unit < 2048; unit += F.G) {
        const int h = unit & 3;
        if (h != hcur) { hcur = h;
#pragma unroll
            for (int j = 0; j < 16; ++j) w[j] = A.in[I_WGU][(size_t)j * 512 + h * 128 + kk];
            bias = A.in[I_BG][h * 128 + kk]; }
        __syncthreads();
        alr[tid] = na0; alr[512 + tid] = na1;
        bf16_t kr[16], vr[16];
#pragma unroll
        for (int i = 0; i < 16; ++i) { kr[i] = nk[i]; vr[i] = nv[i]; }
        if (unit + F.G < 2048) GC_LOAD(unit + F.G);
        __syncthreads();
        float cum[16]; float run = 0.f;
#pragma unroll
        for (int i = 0; i < 16; ++i) { const LAS f32x4* ap = (const LAS f32x4*)(alr + (16 * seg + i) * 16); float z = bias;
#pragma unroll
            for (int q = 0; q < 4; ++q) { const f32x4 a4 = ap[q]; z += a4.x * w[4 * q] + a4.y * w[4 * q + 1] + a4.z * w[4 * q + 2] + a4.w * w[4 * q + 3]; }
            const float ls = fminf(z, 0.f) - __logf(1.f + __expf(-fabsf(z)));
            run += ls * (1.f / 16.f); cum[i] = run; }
        tot[seg * 128 + kk] = run;
        __syncthreads();
        {
            const float t0s = tot[kk], t1s = tot[128 + kk], t2s = tot[256 + kk], t3s = tot[384 + kk];
            const float total = (t0s + t1s) + (t2s + t3s);
            const float prefix = seg == 0 ? 0.f : (seg == 1 ? t0s : (seg == 2 ? t0s + t1s : t0s + t1s + t2s));
            unsigned kw[8], vw[8];
#pragma unroll
            for (int i = 0; i < 8; ++i) {
                const float e0 = __expf(total - (prefix + cum[2 * i])), e1 = __expf(total - (prefix + cum[2 * i + 1]));
                kw[i] = pk2(bf1(kr[2 * i]) * e0, bf1(kr[2 * i + 1]) * e1); vw[i] = (unsigned)vr[2 * i] | ((unsigned)vr[2 * i + 1] << 16);
            }
            *(LAS u32x4*)(kdT + kk * 72 + 16 * seg) = (u32x4){kw[0], kw[1], kw[2], kw[3]}; *(LAS u32x4*)(kdT + kk * 72 + 16 * seg + 8) = (u32x4){kw[4], kw[5], kw[6], kw[7]};
            *(LAS u32x4*)(vT + kk * 72 + 16 * seg) = (u32x4){vw[0], vw[1], vw[2], vw[3]}; *(LAS u32x4*)(vT + kk * 72 + 16 * seg + 8) = (u32x4){vw[4], vw[5], vw[6], vw[7]};
            if (seg == 0) ((float*)(DRY ? (unsigned char*)A.out + 96 * MiB : ws + WS_DEC))[(size_t)unit * 128 + kk] = __expf(total);
        }
        __syncthreads();
        {
            const int w8 = F.wave, l = F.lane, fr = l & 15, fq = l >> 4;
            f32x4 acc[8];
#pragma unroll
            for (int n = 0; n < 8; ++n) acc[n] = (f32x4){0.f, 0.f, 0.f, 0.f};
#pragma unroll
            for (int ks = 0; ks < 2; ++ks) {
                const bf16x8 a = *(const LAS bf16x8*)(kdT + (16 * w8 + fr) * 72 + 32 * ks + 8 * fq);
#pragma unroll
                for (int n = 0; n < 8; ++n) { const bf16x8 bb = *(const LAS bf16x8*)(vT + (16 * n + fr) * 72 + 32 * ks + 8 * fq);
                    acc[n] = __builtin_amdgcn_mfma_f32_16x16x32_bf16(a, bb, acc[n], 0, 0, 0); }
            }
#pragma unroll
            for (int n = 0; n < 8; ++n) { u32x2 o; o.x = pk2(acc[n][0], acc[n][1]); o.y = pk2(acc[n][2], acc[n][3]);
                *(LAS u32x2*)(stT + (16 * n + fr) * 136 + 16 * w8 + 4 * fq) = o; }
        }
        __syncthreads();
        {
            bf16_t* ST = (bf16_t*)(DRY ? (unsigned char*)A.out : ws + WS_N1) + (size_t)unit * 16384;
            const int vv = tid >> 2, part = tid & 3;
#pragma unroll
            for (int q = 0; q < 4; ++q) *(u32x4*)(ST + (size_t)vv * 128 + 32 * part + 8 * q) = *(const LAS u32x4*)(stT + vv * 136 + 32 * part + 8 * q);
        }
    }
#undef GC_LOAD
    (void)hconst;
}

template <bool DRY>
__device__ __forceinline__ void sgu_unit(const Frame& F, const Args& A, int unit, bool stats) {
    const int g = unit & 3, blk = (unit >> 2) & 31, b = unit >> 7;
    const int t0 = b * SEQ + blk * 128;
    bf16_t* P = (bf16_t*)(A.ws + WS_P);
    LAS bf16_t* wA = (LAS bf16_t*)F.lds;
    LAS bf16_t* vnT = (LAS bf16_t*)(F.lds + 34816);
    LAS float* st = (LAS float*)(F.lds + 69632);
    LAS bf16_t* suS = (LAS bf16_t*)(F.lds + 70656);
    const int tid = F.tid;
    __syncthreads();
    if (stats) {
        const int j = tid >> 2, q = tid & 3;
        const bf16_t* sp = P + (size_t)(t0 + j) * PLD + PC_SV + q * 128;
        float s = 0.f, s2 = 0.f;
#pragma unroll
        for (int i = 0; i < 16; ++i) { const u32x4 w = *(const u32x4*)(sp + 8 * i);
            const float f[8] = {bflo(w.x), bfhi(w.x), bflo(w.y), bfhi(w.y), bflo(w.z), bfhi(w.z), bflo(w.w), bfhi(w.w)};
#pragma unroll
            for (int e = 0; e < 8; ++e) { s += f[e]; s2 += f[e] * f[e]; } }
        s += __shfl_xor(s, 1); s += __shfl_xor(s, 2); s2 += __shfl_xor(s2, 1); s2 += __shfl_xor(s2, 2);
        const float mu = s * (1.f / 512.f); const float var = fmaxf(s2 * (1.f / 512.f) - mu * mu, 0.f);
        if (q == 0) { st[2 * j] = mu; st[2 * j + 1] = 1.f / sqrtf(var + EPS); }
    }
    {
        const int i = tid >> 2, jb = (tid & 3) * 32;
        const float* wp = A.in[I_SW] + (size_t)g * 16384 + (size_t)i * 128 + jb;
        const bf16_t* sup = P + (size_t)(t0 + i) * PLD + PC_SU + g * 128 + jb;
#pragma unroll
        for (int q = 0; q < 4; ++q) { const f32x4 a = *(const f32x4*)(wp + 8 * q), bq = *(const f32x4*)(wp + 8 * q + 4);
            const bool z = (i < 64) && (jb + 8 * q >= 64);
            u32x4 o; o.x = pk2(a.x, a.y); o.y = pk2(a.z, a.w); o.z = pk2(bq.x, bq.y); o.w = pk2(bq.z, bq.w);
            if (z) o = (u32x4){0u, 0u, 0u, 0u};
            *(LAS u32x4*)(wA + i * 136 + jb + 8 * q) = o;
            *(LAS u32x4*)(suS + i * 136 + jb + 8 * q) = *(const u32x4*)(sup + 8 * q); }
    }
    const int cch = tid & 127, seg = tid >> 7;
    bf16_t xr[32];
    { const bf16_t* sp = P + (size_t)(t0 + 32 * seg) * PLD + PC_SV + g * 128 + cch;
#pragma unroll
      for (int i = 0; i < 32; ++i) xr[i] = sp[(size_t)i * PLD]; }
    const float lg = A.in[I_SLNG][g * 128 + cch], lb = A.in[I_SLNB][g * 128 + cch];
    __syncthreads();
    {
        unsigned ow[16];
#pragma unroll
        for (int i = 0; i < 16; ++i) { const int j = 32 * seg + 2 * i; const f32x4 ms = *(const LAS f32x4*)(st + 2 * j);
            ow[i] = pk2((bf1(xr[2 * i]) - ms.x) * ms.y * lg + lb, (bf1(xr[2 * i + 1]) - ms.z) * ms.w * lg + lb); }
#pragma unroll
        for (int q = 0; q < 4; ++q) *(LAS u32x4*)(vnT + cch * 136 + 32 * seg + 8 * q) = (u32x4){ow[4 * q], ow[4 * q + 1], ow[4 * q + 2], ow[4 * q + 3]};
    }
    __syncthreads();
    {
        const int w = F.wave, l = F.lane, fr = l & 15, fq = l >> 4;
        f32x4 acc[8];
#pragma unroll
        for (int n = 0; n < 8; ++n) acc[n] = (f32x4){0.f, 0.f, 0.f, 0.f};
#pragma unroll
        for (int ks = 0; ks < 4; ++ks) {
            const bf16x8 a = *(const LAS bf16x8*)(wA + (16 * w + fr) * 136 + 32 * ks + 8 * fq);
#pragma unroll
            for (int n = 0; n < 8; ++n) { const bf16x8 bb = *(const LAS bf16x8*)(vnT + (16 * n + fr) * 136 + 32 * ks + 8 * fq);
                acc[n] = __builtin_amdgcn_mfma_f32_16x16x32_bf16(a, bb, acc[n], 0, 0, 0); }
        }
#pragma unroll
        for (int jj = 0; jj < 4; ++jj) { const int i = 16 * w + 4 * fq + jj; const float bias = A.in[I_SB][g * 128 + i];
            LAS bf16_t* rp = suS + i * 136 + fr;
#pragma unroll
            for (int n = 0; n < 8; ++n) { const float su = bf1(rp[16 * n]); rp[16 * n] = (bf16_t)f2bf(su * (acc[n][jj] + bias)); } }
    }
    __syncthreads();
    {
        const int i = tid >> 2, jb = (tid & 3) * 32;
        bf16_t* yp = DRY ? (bf16_t*)A.out + (size_t)(t0 + i) * 512 + g * 128 + jb : P + (size_t)(t0 + i) * PLD + PC_SU + g * 128 + jb;
#pragma unroll
        for (int q = 0; q < 4; ++q) *(u32x4*)(yp + 8 * q) = *(const LAS u32x4*)(suS + i * 136 + jb + 8 * q);
    }
}

template <bool DRY>
__device__ __forceinline__ void gla_scan(const Frame& F, const Args& A) {
    bf16_t* ST = (bf16_t*)(A.ws + WS_N1); bf16_t* STO = DRY ? (bf16_t*)A.out : ST; const float* DEC = (const float*)(A.ws + WS_DEC);
    for (int gi = F.bid * 512 + F.tid; gi < 131072; gi += F.G * 512) {
        const int k4 = gi & 31, vv = (gi >> 5) & 127, h = (gi >> 12) & 3, b = gi >> 14;
        float s0 = 0.f, s1 = 0.f, s2 = 0.f, s3 = 0.f;
        u32x2 wa[8], wb[8]; f32x4 da[8], db[8];
#define SCAN_LOAD(W, Dd, c0) do { _Pragma("unroll") for (int i_ = 0; i_ < 8; ++i_) { const size_t u_ = (size_t)((b * 64 + (c0) + i_) * 4 + h); \
            W[i_] = *(const u32x2*)(ST + u_ * 16384 + (size_t)vv * 128 + k4 * 4); Dd[i_] = *(const f32x4*)(DEC + u_ * 128 + k4 * 4); } } while (0)
#define SCAN_STEP(W, Dd, c0) do { _Pragma("unroll") for (int i_ = 0; i_ < 8; ++i_) { const size_t u_ = (size_t)((b * 64 + (c0) + i_) * 4 + h); \
            s0 = Dd[i_].x * s0 + bflo(W[i_].x); s1 = Dd[i_].y * s1 + bfhi(W[i_].x); s2 = Dd[i_].z * s2 + bflo(W[i_].y); s3 = Dd[i_].w * s3 + bfhi(W[i_].y); \
            u32x2 o_; o_.x = pk2(s0, s1); o_.y = pk2(s2, s3); *(u32x2*)(STO + u_ * 16384 + (size_t)vv * 128 + k4 * 4) = o_; } } while (0)
        SCAN_LOAD(wa, da, 0);
#pragma unroll
        for (int c0 = 0; c0 < 64; c0 += 16) {
            SCAN_LOAD(wb, db, c0 + 8);
            SCAN_STEP(wa, da, c0);
            if (c0 + 16 < 64) SCAN_LOAD(wa, da, c0 + 16);
            SCAN_STEP(wb, db, c0 + 8);
        }
#undef SCAN_LOAD
#undef SCAN_STEP
    }
}

template <bool DRY>
__device__ __forceinline__ void gla_out_phase(const Frame& F, const Args& A) {
    bf16_t* P = (bf16_t*)(A.ws + WS_P);
    LAS bf16_t* qA = (LAS bf16_t*)F.lds;
    LAS bf16_t* sB = (LAS bf16_t*)(F.lds + 17408);
    LAS float* oF = (LAS float*)(F.lds + 52224);
    const int tid = F.tid, s = tid >> 3, cb = (tid & 7) * 16, vv = tid >> 2, kb = (tid & 3) * 32;
    u32x4 nq0, nq1, ns0, ns1, ns2, ns3, nr0, nr1;
#define GO_LOAD(unit) do { const int h_ = (unit) & 3, c_ = ((unit) >> 2) & 63, b_ = (unit) >> 8; const int t0_ = b_ * SEQ + c_ * 64; \
        const bf16_t* qp_ = P + (size_t)(t0_ + s) * PLD + PC_Q + h_ * 128 + cb; nq0 = *(const u32x4*)qp_; nq1 = *(const u32x4*)(qp_ + 8); \
        const bf16_t* sp_ = (const bf16_t*)(A.ws + WS_N1) + (size_t)(unit) * 16384 + (size_t)vv * 128 + kb; ns0 = *(const u32x4*)sp_; ns1 = *(const u32x4*)(sp_ + 8); ns2 = *(const u32x4*)(sp_ + 16); ns3 = *(const u32x4*)(sp_ + 24); \
        const bf16_t* rp_ = P + (size_t)(t0_ + s) * PLD + PC_R + h_ * 128 + cb; nr0 = *(const u32x4*)rp_; nr1 = *(const u32x4*)(rp_ + 8); } while (0)
    int unit = F.bid;
    if (unit < 2048) GO_LOAD(unit);
    for (; unit < 2048; unit += F.G) {
        const int h = unit & 3, c = (unit >> 2) & 63, b = unit >> 8;
        const int t0 = b * SEQ + c * 64;
        __syncthreads();
        *(LAS u32x4*)(qA + s * 136 + cb) = nq0; *(LAS u32x4*)(qA + s * 136 + cb + 8) = nq1;
        *(LAS u32x4*)(sB + vv * 136 + kb) = ns0; *(LAS u32x4*)(sB + vv * 136 + kb + 8) = ns1; *(LAS u32x4*)(sB + vv * 136 + kb + 16) = ns2; *(LAS u32x4*)(sB + vv * 136 + kb + 24) = ns3;
        const u32x4 r0 = nr0, r1 = nr1;
        if (unit + F.G < 2048) GO_LOAD(unit + F.G);
        __syncthreads();
        {
            const int w = F.wave, l = F.lane, fr = l & 15, fq = l >> 4, m = w & 3, nh = w >> 2;
            f32x4 acc[4];
#pragma unroll
            for (int n = 0; n < 4; ++n) acc[n] = (f32x4){0.f, 0.f, 0.f, 0.f};
#pragma unroll
            for (int ks = 0; ks < 4; ++ks) {
                const bf16x8 a = *(const LAS bf16x8*)(qA + (16 * m + fr) * 136 + 32 * ks + 8 * fq);
#pragma unroll
                for (int n = 0; n < 4; ++n) { const bf16x8 bb = *(const LAS bf16x8*)(sB + (16 * (4 * nh + n) + fr) * 136 + 32 * ks + 8 * fq);
                    acc[n] = __builtin_amdgcn_mfma_f32_16x16x32_bf16(a, bb, acc[n], 0, 0, 0); }
            }
            const float scale = 0.08838834764831845f;
#pragma unroll
            for (int n = 0; n < 4; ++n)
#pragma unroll
                for (int jj = 0; jj < 4; ++jj) oF[(16 * m + 4 * fq + jj) * 132 + 16 * (4 * nh + n) + fr] = acc[n][jj] * scale;
        }
        __syncthreads();
        {
            float o[16]; float ss = 0.f;
#pragma unroll
            for (int i = 0; i < 16; ++i) { o[i] = oF[s * 132 + cb + i]; ss += o[i] * o[i]; }
            ss += __shfl_xor(ss, 1); ss += __shfl_xor(ss, 2); ss += __shfl_xor(ss, 4);
            const float rstd = 1.f / sqrtf(ss * (1.f / 128.f) + EPS);
            const unsigned rw[8] = {r0.x, r0.y, r0.z, r0.w, r1.x, r1.y, r1.z, r1.w};
            const float* gg = A.in[I_GLAG] + h * 128 + cb;
            unsigned ow[8];
#pragma unroll
            for (int i = 0; i < 8; ++i) { const float y0 = o[2 * i] * rstd * gg[2 * i] * siluf_(bflo(rw[i])), y1 = o[2 * i + 1] * rstd * gg[2 * i + 1] * siluf_(bfhi(rw[i])); ow[i] = pk2(y0, y1); }
            bf16_t* yp = DRY ? (bf16_t*)A.out + (size_t)(t0 + s) * 512 + h * 128 + cb : P + (size_t)(t0 + s) * PLD + PC_R + h * 128 + cb;
            *(u32x4*)yp = (u32x4){ow[0], ow[1], ow[2], ow[3]}; *(u32x4*)(yp + 8) = (u32x4){ow[4], ow[5], ow[6], ow[7]};
        }
    }
#undef GO_LOAD
}

__device__ __forceinline__ unsigned ordkey(float v) { const unsigned u = __builtin_bit_cast(unsigned, v); return u ^ ((unsigned)((int)u >> 31) | 0x80000000u); }
__device__ __forceinline__ float unord(unsigned k) { const unsigned u = (k & 0x80000000u) ? (k & 0x7fffffffu) : ~k; return __builtin_bit_cast(float, u); }
#define INS16(r, xin) do { unsigned _x = (xin); _Pragma("unroll") for (int _i = 0; _i < 16; ++_i) { const unsigned _h = max((r)[_i], _x); _x = min((r)[_i], _x); (r)[_i] = _h; } } while (0)

#define CE(a, b) do { const unsigned _h = max((a), (b)), _l = min((a), (b)); (a) = _h; (b) = _l; } while (0)
#define SORT16(v) do { CE(v[0], v[1]); CE(v[2], v[3]); CE(v[0], v[2]); CE(v[1], v[3]); CE(v[1], v[2]); CE(v[4], v[5]); CE(v[6], v[7]); CE(v[4], v[6]); CE(v[5], v[7]); CE(v[5], v[6]); CE(v[0], v[4]); CE(v[2], v[6]); CE(v[2], v[4]); CE(v[1], v[5]); CE(v[3], v[7]); CE(v[3], v[5]); CE(v[1], v[2]); CE(v[3], v[4]); CE(v[5], v[6]); CE(v[8], v[9]); CE(v[10], v[11]); CE(v[8], v[10]); CE(v[9], v[11]); CE(v[9], v[10]); CE(v[12], v[13]); CE(v[14], v[15]); CE(v[12], v[14]); CE(v[13], v[15]); CE(v[13], v[14]); CE(v[8], v[12]); CE(v[10], v[14]); CE(v[10], v[12]); CE(v[9], v[13]); CE(v[11], v[15]); CE(v[11], v[13]); CE(v[9], v[10]); CE(v[11], v[12]); CE(v[13], v[14]); CE(v[0], v[8]); CE(v[4], v[12]); CE(v[4], v[8]); CE(v[2], v[10]); CE(v[6], v[14]); CE(v[6], v[10]); CE(v[2], v[4]); CE(v[6], v[8]); CE(v[10], v[12]); CE(v[1], v[9]); CE(v[5], v[13]); CE(v[5], v[9]); CE(v[3], v[11]); CE(v[7], v[15]); CE(v[7], v[11]); CE(v[3], v[5]); CE(v[7], v[9]); CE(v[11], v[13]); CE(v[1], v[2]); CE(v[3], v[4]); CE(v[5], v[6]); CE(v[7], v[8]); CE(v[9], v[10]); CE(v[11], v[12]); CE(v[13], v[14]); } while (0)
#define MERGE16(T, S) do { _Pragma("unroll") for (int _i = 0; _i < 16; ++_i) (T)[_i] = max((T)[_i], (S)[15 - _i]); \
    _Pragma("unroll") for (int _d = 8; _d >= 1; _d >>= 1) { _Pragma("unroll") for (int _i = 0; _i < 16; ++_i) if ((_i & _d) == 0) CE((T)[_i], (T)[_i + _d]); } } while (0)
__device__ __forceinline__ void peer_topk(const Frame& F, const Args& A) {
    const bf16_t* SC = (const bf16_t*)(A.ws + WS_P + P_SC);
    int* IDX = (int*)(A.ws + WS_P + P_IDX); float* GATE = (float*)(A.ws + WS_P + P_GATE);
    const int gw = F.bid * NWAVES + F.wave, NGW = F.G * NWAVES;
    for (int it = gw; it < 512 * 8; it += NGW) {
        const int h = it & 7, tb = it >> 3; const int tok = tb * 64 + F.lane;
        unsigned r1[16], r2[16], rc[16];
        const bf16_t* p1 = SC + ((size_t)(tok >> 4) * 256 + h * 32) * 128 + (tok & 15) * 8; const bf16_t* p2 = p1 + 16 * 128;
        {
            float raw[128]; unsigned sg[16];
#pragma unroll
            for (int jq = 0; jq < 16; ++jq) { const u32x4 t4 = *(const u32x4*)(p1 + jq * 128);
#pragma unroll
                for (int c = 0; c < 4; ++c) { raw[8 * jq + 2 * c] = bflo(t4[c]); raw[8 * jq + 2 * c + 1] = bfhi(t4[c]); } }
#pragma unroll
            for (int j = 0; j < 16; ++j) r1[j] = (ordkey(raw[j]) & ~127u) | (unsigned)(127 - j);
            SORT16(r1);
#pragma unroll
            for (int gq = 1; gq < 8; ++gq) {
#pragma unroll
                for (int j = 0; j < 16; ++j) sg[j] = (ordkey(raw[16 * gq + j]) & ~127u) | (unsigned)(127 - (16 * gq + j));
                SORT16(sg); MERGE16(r1, sg); }
#pragma unroll
            for (int jq = 0; jq < 16; ++jq) { const u32x4 t4 = *(const u32x4*)(p2 + jq * 128);
#pragma unroll
                for (int c = 0; c < 4; ++c) { raw[8 * jq + 2 * c] = bflo(t4[c]); raw[8 * jq + 2 * c + 1] = bfhi(t4[c]); } }
#pragma unroll
            for (int j = 0; j < 16; ++j) r2[j] = (ordkey(raw[j]) & ~127u) | (unsigned)(127 - j);
            SORT16(r2);
#pragma unroll
            for (int gq = 1; gq < 8; ++gq) {
#pragma unroll
                for (int j = 0; j < 16; ++j) sg[j] = (ordkey(raw[16 * gq + j]) & ~127u) | (unsigned)(127 - (16 * gq + j));
                SORT16(sg); MERGE16(r2, sg); }
        }
        float v1[16], v2[16];
#pragma unroll
        for (int i = 0; i < 16; ++i) { v1[i] = unord((r1[i] & ~127u) | 64u); v2[i] = unord((r2[i] & ~127u) | 64u); }
        {
            unsigned cg[4][16]; int cn = 0;
#pragma unroll
            for (int a = 0; a < 16; ++a)
#pragma unroll
                for (int bq = 0; bq < 16; ++bq) if ((a + 1) * (bq + 1) <= 16) { cg[cn >> 4][cn & 15] = (ordkey(v1[a] + v2[bq]) & ~255u) | (unsigned)(a * 16 + bq); ++cn; }
#pragma unroll
            for (int z = 50; z < 64; ++z) cg[z >> 4][z & 15] = 0u;
            SORT16(cg[0]); SORT16(cg[1]); SORT16(cg[2]); SORT16(cg[3]);
            MERGE16(cg[0], cg[1]); MERGE16(cg[0], cg[2]); MERGE16(cg[0], cg[3]);
#pragma unroll
            for (int i = 0; i < 16; ++i) rc[i] = cg[0][i];
        }
        float val[16]; int ex[16];
        {
            LAS unsigned* t1 = (LAS unsigned*)(F.lds + F.wave * 8704) + F.lane * 17; LAS unsigned* t2 = t1 + 64 * 17;
#pragma unroll
            for (int i = 0; i < 16; ++i) { t1[i] = r1[i]; t2[i] = r2[i]; }
            LDS_WAIT(); asm volatile("" ::: "memory");
#pragma unroll
            for (int w = 0; w < 16; ++w) {
                const int a = (rc[w] >> 4) & 15, bq = rc[w] & 15;
                const unsigned k1 = t1[a], k2 = t2[bq];
                val[w] = unord((k1 & ~127u) | 64u) + unord((k2 & ~127u) | 64u);
                ex[w] = (127 - (int)(k1 & 127u)) * 128 + (127 - (int)(k2 & 127u));
            }
            LDS_WAIT(); asm volatile("" ::: "memory");
        }
        float mx = val[0];
#pragma unroll
        for (int w = 1; w < 16; ++w) mx = fmaxf(mx, val[w]);
        float sum = 0.f;
#pragma unroll
        for (int w = 0; w < 16; ++w) { val[w] = __expf(val[w] - mx); sum += val[w]; }
        const float inv = 1.f / sum;
        int* ip = IDX + (size_t)tok * 128 + h * 16; float* gp = GATE + (size_t)tok * 128 + h * 16;
#pragma unroll
        for (int q = 0; q < 4; ++q) { *(int4*)(ip + 4 * q) = make_int4(ex[4 * q], ex[4 * q + 1], ex[4 * q + 2], ex[4 * q + 3]);
            *(f32x4*)(gp + 4 * q) = (f32x4){val[4 * q] * inv, val[4 * q + 1] * inv, val[4 * q + 2] * inv, val[4 * q + 3] * inv}; }
    }
}

#define DPP_ADD(v, ctrl) ((v) + __builtin_bit_cast(float, __builtin_amdgcn_mov_dpp(__builtin_bit_cast(int, (v)), (ctrl), 0xf, 0xf, true)))
__device__ __forceinline__ void fp8x16_to_f32x2(const u32x4 r, f32x2* f) {
#pragma unroll
    for (int q = 0; q < 4; ++q) { f[2 * q] = __builtin_amdgcn_cvt_pk_f32_fp8((int)r[q], false); f[2 * q + 1] = __builtin_amdgcn_cvt_pk_f32_fp8((int)r[q], true); }
}
__device__ __forceinline__ void fp8x16_to_f32(const u32x4 r, float* f) {
#pragma unroll
    for (int q = 0; q < 4; ++q) { const f32x2 lo = __builtin_amdgcn_cvt_pk_f32_fp8((int)r[q], false), hi = __builtin_amdgcn_cvt_pk_f32_fp8((int)r[q], true);
        f[4 * q] = lo.x; f[4 * q + 1] = lo.y; f[4 * q + 2] = hi.x; f[4 * q + 3] = hi.y; }
}
__device__ __forceinline__ long lo64(u32x4 v) { return (long)(((unsigned long)v.y << 32) | (unsigned long)v.x); }
__device__ __forceinline__ long hi64(u32x4 v) { return (long)(((unsigned long)v.w << 32) | (unsigned long)v.z); }
template <int MODE>
__device__ __forceinline__ void peer_u_phase(const Frame& F, const Args& A) {
    const unsigned char* X8 = A.ws + WS_P + P_X8;
    const unsigned char* U8 = A.ws + WS_U8; const float* SU = (const float*)(A.ws + WS_SU); const float* SV = (const float*)(A.ws + WS_SV);
    const int* IDX = (const int*)(A.ws + WS_P + P_IDX); const float* GATE = (const float*)(A.ws + WS_P + P_GATE); float* AK = (float*)(MODE == 0 ? A.ws + WS_AK : A.ws + WS_P + P_SC);
    const int g = F.bid & 7, nmem = F.G >> 3, l = F.lane, step = nmem * NWAVES;
    const int loff = 64 * (l & 15) + 16 * (l >> 4);
    const bool dg = ((l & 15) >> 2) == (l >> 4); const int dr = l & 3;
    const float dw0 = (dg && dr == 0) ? 1.f : 0.f, dw1 = (dg && dr == 1) ? 1.f : 0.f, dw2 = (dg && dr == 2) ? 1.f : 0.f, dw3 = (dg && dr == 3) ? 1.f : 0.f;
    LAS int* le = (LAS int*)(F.lds + F.wave * 2048); LAS int* lk = le + 256;
    const bool b5 = (l & 32) != 0, b4 = (l & 16) != 0, b3 = (l & 8) != 0;
    int tok = 2 * ((F.bid >> 3) * NWAVES + F.wave);
    u32x4 nxA, nxB; int neA0, neA1, neB0, neB1; float ngA0, ngA1, ngB0, ngB1;
#define U_PREFETCH(t) do { const size_t _tA = (size_t)(t), _tB = (size_t)(t) + 1; if (MODE == 4) { nxA = (u32x4){(unsigned)_tA, 1u, 2u, 3u}; nxB = nxA; neA0 = (int)((_tA * 37 + l * 11) & 16383); neA1 = (int)((_tA * 53 + l * 7) & 16383); neB0 = (int)((_tB * 37 + l * 13) & 16383); neB1 = (int)((_tB * 29 + l * 3) & 16383); ngA0 = ngA1 = ngB0 = ngB1 = 0.01f; break; } nxA = *(const u32x4*)(X8 + _tA * 1024 + loff); nxB = *(const u32x4*)(X8 + _tB * 1024 + loff); \
        neA0 = IDX[_tA * 128 + l]; neA1 = IDX[_tA * 128 + 64 + l]; neB0 = IDX[_tB * 128 + l]; neB1 = IDX[_tB * 128 + 64 + l]; \
        ngA0 = GATE[_tA * 128 + l]; ngA1 = GATE[_tA * 128 + 64 + l]; ngB0 = GATE[_tB * 128 + l]; ngB1 = GATE[_tB * 128 + 64 + l]; } while (0)
    if (tok + 1 < T_TOK) U_PREFETCH(tok);
    for (; tok + 1 < T_TOK; tok += 2 * step) {
        const int tokA = tok, tokB = tok + 1;
        const u32x4 xA = nxA, xB = nxB;
        const int eA0 = neA0, eA1 = neA1, eB0 = neB0, eB1 = neB1; const float gA0 = ngA0, gA1 = ngA1, gB0 = ngB0, gB1 = ngB1;
        bool pf_done = false;
        const bool oA0 = (eA0 & 7) == g, oA1 = (eA1 & 7) == g, oB0 = (eB0 & 7) == g, oB1 = (eB1 & 7) == g;
        const unsigned long long mA0 = __ballot(oA0), mA1 = __ballot(oA1), mB0 = __ballot(oB0), mB1 = __ballot(oB1);
        const int c0 = __popcll(mA0), c1 = c0 + __popcll(mA1), c2 = c1 + __popcll(mB0), n = c2 + __popcll(mB1);
#define MBC(m) __builtin_amdgcn_mbcnt_hi((unsigned)((m) >> 32), __builtin_amdgcn_mbcnt_lo((unsigned)(m), 0u))
        if (oA0) { const int p = MBC(mA0); le[p] = (eA0 << 8) | l; lk[p] = __builtin_bit_cast(int, gA0); }
        if (oA1) { const int p = c0 + MBC(mA1); le[p] = (eA1 << 8) | (64 + l); lk[p] = __builtin_bit_cast(int, gA1); }
        if (oB0) { const int p = c1 + MBC(mB0); le[p] = (eB0 << 8) | 128 | l; lk[p] = __builtin_bit_cast(int, gB0); }
        if (oB1) { const int p = c2 + MBC(mB1); le[p] = (eB1 << 8) | 128 | (64 + l); lk[p] = __builtin_bit_cast(int, gB1); }
#undef MBC
        LDS_WAIT(); asm volatile("" ::: "memory");
        for (int cb = 0; cb < n || cb == 0; cb += 64) {
        const int nc = min(n, cb + 64);
        const bool fv = (cb + l) < nc;
        const int ent = fv ? le[cb + l] : 0; const float gt = fv ? __builtin_bit_cast(float, lk[cb + l]) : 0.f; float tot = 0.f;
        const float su = SU[ent >> 8], sv = SV[ent >> 8];
        const unsigned long long radr = (unsigned long long)(U8 + (size_t)(((ent >> 8) & 7) * 2048 + (((ent >> 8) >> 3) & (MODE == 2 ? 255 : 2047))) * 1024);
        const int ralo = (int)(unsigned)radr, rahi = (int)(unsigned)(radr >> 32);
        for (int i = cb; i < nc; i += 16) {
            u32x4 row[2][8];
#pragma unroll
            for (int b = 0; b < 2; ++b) if (i + 8 * b < nc) {
#pragma unroll
                for (int j = 0; j < 8; ++j) { const int ln = min(i + 8 * b + j, nc - 1) - cb;
                    const unsigned lo = (unsigned)__builtin_amdgcn_readlane(ralo, ln), hi = (unsigned)__builtin_amdgcn_readlane(rahi, ln);
                    const GAS unsigned char* rp = (const GAS unsigned char*)(((unsigned long long)hi << 32) | lo);
                    row[b][j] = *(const GAS u32x4*)(rp + (unsigned)loff); } }
            if (!pf_done) { pf_done = true; if (tok + 2 * step + 1 < T_TOK) U_PREFETCH(tok + 2 * step); }
#pragma unroll
            for (int b = 0; b < 2; ++b) if (i + 8 * b < nc) {
                float p[8];
                f32x4 accj[8];
                const int base0 = i + 8 * b;
                if (base0 + 8 <= c1) {
#pragma unroll
                    for (int j = 0; j < 8; ++j) accj[j] = __builtin_amdgcn_mfma_f32_16x16x32_fp8_fp8(lo64(row[b][j]), lo64(xA), (f32x4){0.f, 0.f, 0.f, 0.f}, 0, 0, 0);
#pragma unroll
                    for (int j = 0; j < 8; ++j) accj[j] = __builtin_amdgcn_mfma_f32_16x16x32_fp8_fp8(hi64(row[b][j]), hi64(xA), accj[j], 0, 0, 0);
                } else if (base0 >= c1) {
#pragma unroll
                    for (int j = 0; j < 8; ++j) accj[j] = __builtin_amdgcn_mfma_f32_16x16x32_fp8_fp8(lo64(row[b][j]), lo64(xB), (f32x4){0.f, 0.f, 0.f, 0.f}, 0, 0, 0);
#pragma unroll
                    for (int j = 0; j < 8; ++j) accj[j] = __builtin_amdgcn_mfma_f32_16x16x32_fp8_fp8(hi64(row[b][j]), hi64(xB), accj[j], 0, 0, 0);
                } else {
#pragma unroll
                    for (int j = 0; j < 8; ++j) { const u32x4 xs = (base0 + j >= c1) ? xB : xA; accj[j] = __builtin_amdgcn_mfma_f32_16x16x32_fp8_fp8(lo64(row[b][j]), lo64(xs), (f32x4){0.f, 0.f, 0.f, 0.f}, 0, 0, 0);
                        accj[j] = __builtin_amdgcn_mfma_f32_16x16x32_fp8_fp8(hi64(row[b][j]), hi64(xs), accj[j], 0, 0, 0); }
                }
#pragma unroll
                for (int j = 0; j < 8; ++j) p[j] = __builtin_fmaf(accj[j][3], dw3, __builtin_fmaf(accj[j][2], dw2, __builtin_fmaf(accj[j][1], dw1, accj[j][0] * dw0)));
                float q4[4], q2[2], q1;
#pragma unroll
                for (int j = 0; j < 4; ++j) { const float keep = b5 ? p[4 + j] : p[j], send = b5 ? p[j] : p[4 + j]; q4[j] = keep + __shfl_xor(send, 32); }
#pragma unroll
                for (int j = 0; j < 2; ++j) { const float keep = b4 ? q4[2 + j] : q4[j], send = b4 ? q4[j] : q4[2 + j]; q2[j] = keep + __shfl_xor(send, 16); }
                { const float keep = b3 ? q2[1] : q2[0], send = b3 ? q2[0] : q2[1]; q1 = keep + __shfl_xor(send, 8); }
                q1 = DPP_ADD(q1, 0xB1); q1 = DPP_ADD(q1, 0x4E); q1 = DPP_ADD(q1, 0x141);
                const float t = __builtin_bit_cast(float, __builtin_amdgcn_ds_bpermute((l & 7) * 32, __builtin_bit_cast(int, q1)));
                const int base = i + 8 * b;
                if ((l >> 3) == ((base - cb) >> 3)) tot = t;
            }
        }
        if (!pf_done) { if (tok + 2 * step + 1 < T_TOK) U_PREFETCH(tok + 2 * step); }
        if (fv) { const int tk = (ent & 128) ? tokB : tokA; AK[(size_t)tk * 128 + (ent & 127)] = gelu_tanh(tot * su * (1.f / 16.f)) * gt * sv; }
        if (n == 0) break;
        }
        LDS_WAIT(); asm volatile("" ::: "memory");
    }
#undef U_PREFETCH
}
template <int MODE>
__device__ __forceinline__ void peer_u_phase1(const Frame& F, const Args& A) {
    const unsigned char* X8 = A.ws + WS_P + P_X8;
    const unsigned char* U8 = A.ws + WS_U8; const float* SU = (const float*)(A.ws + WS_SU); const float* SV = (const float*)(A.ws + WS_SV);
    const int* IDX = (const int*)(A.ws + WS_P + P_IDX); const float* GATE = (const float*)(A.ws + WS_P + P_GATE); float* AK = (float*)(MODE == 0 ? A.ws + WS_AK : A.ws + WS_P + P_SC);
    const int g = F.bid & (UNG - 1), nmem = F.G >> UNG_SH, l = F.lane, step = nmem * NWAVES;
    const int loff = 64 * (l & 15) + 16 * (l >> 4);
    const bool dg = ((l & 15) >> 2) == (l >> 4); const int dr = l & 3;
    const float dw0 = (dg && dr == 0) ? 1.f : 0.f, dw1 = (dg && dr == 1) ? 1.f : 0.f, dw2 = (dg && dr == 2) ? 1.f : 0.f, dw3 = (dg && dr == 3) ? 1.f : 0.f;
    LAS int* le = (LAS int*)(F.lds + F.wave * 2048); LAS int* lk = le + 256;
    const bool b5 = (l & 32) != 0, b4 = (l & 16) != 0, b3 = (l & 8) != 0;
    int tok = (F.bid >> UNG_SH) * NWAVES + F.wave;
    u32x4 nxA; int neA0, neA1; float ngA0, ngA1;
#define U1_PREFETCH(t) do { const size_t _tA = (size_t)(t); nxA = *(const u32x4*)(X8 + _tA * 1024 + loff); \
        neA0 = IDX[_tA * 128 + l]; neA1 = IDX[_tA * 128 + 64 + l]; ngA0 = GATE[_tA * 128 + l]; ngA1 = GATE[_tA * 128 + 64 + l]; } while (0)
    if (tok < T_TOK) U1_PREFETCH(tok);
    for (; tok < T_TOK; tok += step) {
        const u32x4 xA = nxA;
        const int eA0 = neA0, eA1 = neA1; const float gA0 = ngA0, gA1 = ngA1;
        bool pf_done = false;
        const bool oA0 = (eA0 & (UNG - 1)) == g, oA1 = (eA1 & (UNG - 1)) == g;
        const unsigned long long mA0 = __ballot(oA0), mA1 = __ballot(oA1);
        const int c0 = __popcll(mA0), n = c0 + __popcll(mA1);
#define MBC(m) __builtin_amdgcn_mbcnt_hi((unsigned)((m) >> 32), __builtin_amdgcn_mbcnt_lo((unsigned)(m), 0u))
        if (oA0) { const int p = MBC(mA0); le[p] = (eA0 << 8) | l; lk[p] = __builtin_bit_cast(int, gA0); }
        if (oA1) { const int p = c0 + MBC(mA1); le[p] = (eA1 << 8) | (64 + l); lk[p] = __builtin_bit_cast(int, gA1); }
#undef MBC
        LDS_WAIT(); asm volatile("" ::: "memory");
        for (int cb = 0; cb < n || cb == 0; cb += 64) {
        const int nc = min(n, cb + 64);
        const bool fv = (cb + l) < nc;
        const int ent = fv ? le[cb + l] : 0; const float gt = fv ? __builtin_bit_cast(float, lk[cb + l]) : 0.f; float tot = 0.f;
        const float su = SU[ent >> 8], sv = SV[ent >> 8];
        const unsigned long long radr = (unsigned long long)(U8 + (size_t)(((ent >> 8) & (UNG - 1)) * (NEXP / UNG) + ((ent >> 8) >> UNG_SH)) * 1024);
        const int ralo = (int)(unsigned)radr, rahi = (int)(unsigned)(radr >> 32);
        for (int i = cb; i < nc; i += 16) {
            u32x4 row[2][8];
#pragma unroll
            for (int b = 0; b < 2; ++b) if (i + 8 * b < nc) {
#pragma unroll
                for (int j = 0; j < 8; ++j) { const int ln = min(i + 8 * b + j, nc - 1) - cb;
                    const unsigned lo = (unsigned)__builtin_amdgcn_readlane(ralo, ln), hi = (unsigned)__builtin_amdgcn_readlane(rahi, ln);
                    const GAS unsigned char* rp = (const GAS unsigned char*)(((unsigned long long)hi << 32) | lo);
                    row[b][j] = *(const GAS u32x4*)(rp + (unsigned)loff); } }
            if (!pf_done) { pf_done = true; if (tok + step < T_TOK) U1_PREFETCH(tok + step); }
#pragma unroll
            for (int b = 0; b < 2; ++b) if (i + 8 * b < nc) {
                float p[8]; f32x4 accj[8];
#pragma unroll
                for (int j = 0; j < 8; ++j) accj[j] = __builtin_amdgcn_mfma_f32_16x16x32_fp8_fp8(lo64(row[b][j]), lo64(xA), (f32x4){0.f, 0.f, 0.f, 0.f}, 0, 0, 0);
#pragma unroll
                for (int j = 0; j < 8; ++j) accj[j] = __builtin_amdgcn_mfma_f32_16x16x32_fp8_fp8(hi64(row[b][j]), hi64(xA), accj[j], 0, 0, 0);
#pragma unroll
                for (int j = 0; j < 8; ++j) p[j] = __builtin_fmaf(accj[j][3], dw3, __builtin_fmaf(accj[j][2], dw2, __builtin_fmaf(accj[j][1], dw1, accj[j][0] * dw0)));
                float q4[4], q2[2], q1;
#pragma unroll
                for (int j = 0; j < 4; ++j) { const float keep = b5 ? p[4 + j] : p[j], send = b5 ? p[j] : p[4 + j]; q4[j] = keep + __shfl_xor(send, 32); }
#pragma unroll
                for (int j = 0; j < 2; ++j) { const float keep = b4 ? q4[2 + j] : q4[j], send = b4 ? q4[j] : q4[2 + j]; q2[j] = keep + __shfl_xor(send, 16); }
                { const float keep = b3 ? q2[1] : q2[0], send = b3 ? q2[0] : q2[1]; q1 = keep + __shfl_xor(send, 8); }
                q1 = DPP_ADD(q1, 0xB1); q1 = DPP_ADD(q1, 0x4E); q1 = DPP_ADD(q1, 0x141);
                const float t = __builtin_bit_cast(float, __builtin_amdgcn_ds_bpermute((l & 7) * 32, __builtin_bit_cast(int, q1)));
                const int base = i + 8 * b;
                if ((l >> 3) == ((base - cb) >> 3)) tot = t;
            }
        }
        if (!pf_done) { pf_done = true; if (tok + step < T_TOK) U1_PREFETCH(tok + step); }
        if (fv) AK[(size_t)tok * 128 + (ent & 127)] = gelu_tanh(tot * su * (1.f / 16.f)) * gt * sv;
        if (n == 0) break;
        }
        LDS_WAIT(); asm volatile("" ::: "memory");
    }
#undef U1_PREFETCH
}
template <int MODE>
__device__ __forceinline__ void peer_u4_phase(const Frame& F, const Args& A) {
    const unsigned char* X8 = A.ws + WS_P + P_X8;
    const float* SU = (const float*)(A.ws + WS_SU); const float* SV = (const float*)(A.ws + WS_SV);
    const int* IDX = (const int*)(A.ws + WS_P + P_IDX); const float* GATE = (const float*)(A.ws + WS_P + P_GATE); float* AK = (float*)(MODE == 0 ? A.ws + WS_AK : A.ws + WS_P + P_SC);
    const int g = F.bid & (UNG - 1), nmem = F.G >> UNG_SH, l = F.lane, step = nmem * NWAVES;
    const int m = l & 15, q = l >> 4;
    const GAS unsigned char* ub = (const GAS unsigned char*)(A.ws + WS_U8 + (size_t)g * (NEXP / UNG) * 512);
    const unsigned lconst = 16u * (unsigned)(4 * (m & 7) + q);
    const int xoff = 128 * (m & 7) + 16 * q;
    const bool dg = (m < 8) && ((m >> 2) == (q & 1)); const int dr = m & 3;
    const float dw0 = (dg && dr == 0) ? 1.f : 0.f, dw1 = (dg && dr == 1) ? 1.f : 0.f, dw2 = (dg && dr == 2) ? 1.f : 0.f, dw3 = (dg && dr == 3) ? 1.f : 0.f;
    const int rsel = 4 * (m >> 3);
    const int osrc = 4 * (32 * (l & 1) + 4 * ((l & 15) >> 1));
    const int sc1 = 0x7F7F7F7F;
    LAS int* le = (LAS int*)(F.lds + F.wave * 2048); LAS int* lk = le + 256;
    const bool b4 = (l & 16) != 0, b3 = (l & 8) != 0, b2 = (l & 4) != 0;
    int tok = (F.bid >> UNG_SH) * NWAVES + F.wave;
    u32x4 nx0, nx1; int ne0, ne1; float ng0, ng1;
#define U4_PREFETCH(t) do { const size_t _t = (size_t)(t); nx0 = *(const u32x4*)(X8 + _t * 1024 + xoff); nx1 = *(const u32x4*)(X8 + _t * 1024 + xoff + 64); \
        ne0 = IDX[_t * 128 + l]; ne1 = IDX[_t * 128 + 64 + l]; ng0 = GATE[_t * 128 + l]; ng1 = GATE[_t * 128 + 64 + l]; } while (0)
    if (tok < T_TOK) U4_PREFETCH(tok);
    for (; tok < T_TOK; tok += step) {
        const i32x8 xb = __builtin_shufflevector(__builtin_bit_cast(i32x4, nx0), __builtin_bit_cast(i32x4, nx1), 0, 1, 2, 3, 4, 5, 6, 7);
        const int e0 = ne0, e1 = ne1; const float g0 = ng0, g1 = ng1;
        bool pf_done = false;
        const bool o0 = (e0 & (UNG - 1)) == g, o1 = (e1 & (UNG - 1)) == g;
        const unsigned long long m0 = __ballot(o0), m1 = __ballot(o1);
        const int c0 = __popcll(m0), n = c0 + __popcll(m1);
#define MBC(mm) __builtin_amdgcn_mbcnt_hi((unsigned)((mm) >> 32), __builtin_amdgcn_mbcnt_lo((unsigned)(mm), 0u))
        if (o0) { const int p = MBC(m0); le[p] = (e0 << 8) | l; lk[p] = __builtin_bit_cast(int, g0); }
        if (o1) { const int p = c0 + MBC(m1); le[p] = (e1 << 8) | (64 + l); lk[p] = __builtin_bit_cast(int, g1); }
#undef MBC
        LDS_WAIT(); asm volatile("" ::: "memory");
        for (int cb = 0; cb < n || cb == 0; cb += 64) {
            const int nc = min(n, cb + 64);
            const bool fv = (cb + l) < nc;
            const int ent = fv ? le[cb + l] : 0; const float gt = fv ? __builtin_bit_cast(float, lk[cb + l]) : 0.f; float tot = 0.f;
            const float su = SU[ent >> 8], sv = SV[ent >> 8];
            const int roff = fv ? ((ent >> 8) >> UNG_SH) * 512 : 0;
            for (int i = cb; i < nc; i += 32) {
                u32x4 row[2][8];
#pragma unroll
                for (int b = 0; b < 2; ++b) if (i + 16 * b < nc) {
#pragma unroll
                    for (int j = 0; j < 8; ++j) { const int ro = __builtin_amdgcn_ds_bpermute(rsel + 4 * (i - cb + 16 * b + 2 * j), roff);
                        row[b][j] = *(const GAS u32x4*)(ub + ((unsigned)ro + lconst)); } }
                if (!pf_done) { pf_done = true; if (tok + step < T_TOK) U4_PREFETCH(tok + step); }
#pragma unroll
                for (int b = 0; b < 2; ++b) if (i + 16 * b < nc) {
                    float p[8];
#pragma unroll
                    for (int j = 0; j < 8; ++j) { const i32x4 r4 = __builtin_bit_cast(i32x4, row[b][j]);
                        const f32x4 d = __builtin_amdgcn_mfma_scale_f32_16x16x128_f8f6f4(__builtin_shufflevector(r4, r4, 0, 1, 2, 3, -1, -1, -1, -1), xb, (f32x4){0.f, 0.f, 0.f, 0.f}, 4, 0, 0, sc1, 0, sc1);
                        p[j] = __builtin_fmaf(d[3], dw3, __builtin_fmaf(d[2], dw2, __builtin_fmaf(d[1], dw1, d[0] * dw0))); }
                    float q4[4], q2[2], q1;
#pragma unroll
                    for (int j = 0; j < 4; ++j) { const float keep = b4 ? p[4 + j] : p[j], send = b4 ? p[j] : p[4 + j]; q4[j] = keep + __shfl_xor(send, 16); }
#pragma unroll
                    for (int j = 0; j < 2; ++j) { const float keep = b3 ? q4[2 + j] : q4[j], send = b3 ? q4[j] : q4[2 + j]; q2[j] = keep + __shfl_xor(send, 8); }
                    { const float keep = b2 ? q2[1] : q2[0], send = b2 ? q2[0] : q2[1]; q1 = keep + __shfl_xor(send, 4); }
                    q1 = DPP_ADD(q1, 0xB1); q1 = DPP_ADD(q1, 0x4E);
                    const float t = __builtin_bit_cast(float, __builtin_amdgcn_ds_bpermute(osrc, __builtin_bit_cast(int, q1)));
                    if ((l >> 4) == ((i - cb + 16 * b) >> 4)) tot = t;
                }
            }
            if (!pf_done) { pf_done = true; if (tok + step < T_TOK) U4_PREFETCH(tok + step); }
            if (fv) AK[(size_t)tok * 128 + (ent & 127)] = gelu_tanh(tot * su * (1.f / 16.f)) * gt * sv;
            if (n == 0) break;
        }
        LDS_WAIT(); asm volatile("" ::: "memory");
    }
#undef U4_PREFETCH
}
template <int MODE>
__device__ __forceinline__ void peer_u4_all(const Frame& F, const Args& A) {
    const unsigned char* X8 = A.ws + WS_P + P_X8;
    const float* SU = (const float*)(A.ws + WS_SU); const float* SV = (const float*)(A.ws + WS_SV);
    const int* IDX = (const int*)(A.ws + WS_P + P_IDX); const float* GATE = (const float*)(A.ws + WS_P + P_GATE); float* AK = (float*)(MODE == 0 ? A.ws + WS_AK : A.ws + WS_P + P_SC);
    const int l = F.lane, step = F.G * NWAVES;
    const int m = l & 15, q = l >> 4;
    const GAS unsigned char* ub = (const GAS unsigned char*)(A.ws + WS_U8);
    const unsigned lconst = 16u * (unsigned)(4 * (m & 7) + q);
    const int xoff = 128 * (m & 7) + 16 * q;
    const bool dg = (m < 8) && ((m >> 2) == (q & 1)); const int dr = m & 3;
    const float dw0 = (dg && dr == 0) ? 1.f : 0.f, dw1 = (dg && dr == 1) ? 1.f : 0.f, dw2 = (dg && dr == 2) ? 1.f : 0.f, dw3 = (dg && dr == 3) ? 1.f : 0.f;
    const int rsel = 4 * (m >> 3);
    const int osrc = 4 * (32 * (l & 1) + 4 * ((l & 15) >> 1));
    const int sc1 = 0x7F7F7F7F;
    const bool b4 = (l & 16) != 0, b3 = (l & 8) != 0, b2 = (l & 4) != 0;
    const int lhi = l >> 4;
    int tok = F.bid * NWAVES + F.wave;
    u32x4 nx0, nx1; int ne0, ne1; float ng0, ng1;
#define UA_PREFETCH(t) do { const size_t _t = (size_t)(t); nx0 = *(const u32x4*)(X8 + _t * 1024 + xoff); nx1 = *(const u32x4*)(X8 + _t * 1024 + xoff + 64); \
        ne0 = IDX[_t * 128 + l]; ne1 = IDX[_t * 128 + 64 + l]; ng0 = GATE[_t * 128 + l]; ng1 = GATE[_t * 128 + 64 + l]; } while (0)
#define UA_LOADS(R, ro_, h) do { _Pragma("unroll") for (int j_ = 0; j_ < 16; ++j_) { const int o_ = __builtin_amdgcn_ds_bpermute(rsel + 4 * (32 * (h) + 2 * j_), (ro_)); \
        R[j_] = *(const GAS u32x4*)(ub + ((unsigned)o_ + lconst)); } } while (0)
#define UA_COMPUTE(R, xb_, h, tot_) do { _Pragma("unroll") for (int b_ = 0; b_ < 2; ++b_) { float p_[8]; \
        _Pragma("unroll") for (int j_ = 0; j_ < 8; ++j_) { const i32x4 r4_ = __builtin_bit_cast(i32x4, R[8 * b_ + j_]); \
            const f32x4 d_ = __builtin_amdgcn_mfma_scale_f32_16x16x128_f8f6f4(__builtin_shufflevector(r4_, r4_, 0, 1, 2, 3, -1, -1, -1, -1), (xb_), (f32x4){0.f, 0.f, 0.f, 0.f}, 4, 0, 0, sc1, 0, sc1); \
            p_[j_] = __builtin_fmaf(d_[3], dw3, __builtin_fmaf(d_[2], dw2, __builtin_fmaf(d_[1], dw1, d_[0] * dw0))); } \
        float q4_[4], q2_[2], q1_; \
        _Pragma("unroll") for (int j_ = 0; j_ < 4; ++j_) { const float keep_ = b4 ? p_[4 + j_] : p_[j_], send_ = b4 ? p_[j_] : p_[4 + j_]; q4_[j_] = keep_ + __shfl_xor(send_, 16); } \
        _Pragma("unroll") for (int j_ = 0; j_ < 2; ++j_) { const float keep_ = b3 ? q4_[2 + j_] : q4_[j_], send_ = b3 ? q4_[j_] : q4_[2 + j_]; q2_[j_] = keep_ + __shfl_xor(send_, 8); } \
        { const float keep_ = b2 ? q2_[1] : q2_[0], send_ = b2 ? q2_[0] : q2_[1]; q1_ = keep_ + __shfl_xor(send_, 4); } \
        q1_ = DPP_ADD(q1_, 0xB1); q1_ = DPP_ADD(q1_, 0x4E); \
        const float t_ = __builtin_bit_cast(float, __builtin_amdgcn_ds_bpermute(osrc, __builtin_bit_cast(int, q1_))); \
        if (lhi == 2 * (h) + b_) (tot_) = t_; } } while (0)
    u32x4 RA[16], RB[16];
    if (tok < T_TOK) { UA_PREFETCH(tok); UA_LOADS(RA, ne0 * 512, 0); }
    for (; tok < T_TOK; tok += step) {
        const i32x8 xb = __builtin_shufflevector(__builtin_bit_cast(i32x4, nx0), __builtin_bit_cast(i32x4, nx1), 0, 1, 2, 3, 4, 5, 6, 7);
        const int e0 = ne0, e1 = ne1; const float g0 = ng0, g1 = ng1;
        const int ro0 = e0 * 512, ro1 = e1 * 512;
        const float su0 = SU[e0], sv0 = SV[e0], su1 = SU[e1], sv1 = SV[e1];
        const bool more = tok + step < T_TOK;
        float tot0 = 0.f, tot1 = 0.f;
        UA_LOADS(RB, ro0, 1);
        if (more) UA_PREFETCH(tok + step);
        UA_COMPUTE(RA, xb, 0, tot0);
        UA_LOADS(RA, ro1, 0);
        UA_COMPUTE(RB, xb, 1, tot0);
        UA_LOADS(RB, ro1, 1);
        UA_COMPUTE(RA, xb, 0, tot1);
        if (more) UA_LOADS(RA, ne0 * 512, 0);
        UA_COMPUTE(RB, xb, 1, tot1);
        AK[(size_t)tok * 128 + l] = gelu_tanh(tot0 * su0 * (1.f / 16.f)) * g0 * sv0;
        AK[(size_t)tok * 128 + 64 + l] = gelu_tanh(tot1 * su1 * (1.f / 16.f)) * g1 * sv1;
    }
#undef UA_PREFETCH
#undef UA_LOADS
#undef UA_COMPUTE
}
__device__ __forceinline__ float wave_max_nonneg(float v) {
    unsigned u = __builtin_bit_cast(unsigned, v);
    u = max(u, (unsigned)__builtin_amdgcn_mov_dpp((int)u, 0xB1, 0xf, 0xf, true));
    u = max(u, (unsigned)__builtin_amdgcn_mov_dpp((int)u, 0x4E, 0xf, 0xf, true));
    u = max(u, (unsigned)__builtin_amdgcn_mov_dpp((int)u, 0x141, 0xf, 0xf, true));
    u = max(u, (unsigned)__builtin_amdgcn_mov_dpp((int)u, 0x140, 0xf, 0xf, true));
    const unsigned a = (unsigned)__builtin_amdgcn_readlane((int)u, 0), b = (unsigned)__builtin_amdgcn_readlane((int)u, 16), c = (unsigned)__builtin_amdgcn_readlane((int)u, 32), d = (unsigned)__builtin_amdgcn_readlane((int)u, 48);
    return __builtin_bit_cast(float, max(max(a, b), max(c, d)));
}
template <int MODE>
__device__ __forceinline__ void peer_v_phase(const Frame& F, const Args& A) {
    const unsigned char* V8 = A.ws + WS_V8; const int* IDX = (const int*)(A.ws + WS_P + P_IDX); const float* AK = (const float*)(A.ws + WS_AK);
    float* out = MODE == 0 ? A.out : (float*)(A.ws + WS_P + P_SC);
    const int g = F.bid & 7, nmem = F.G >> 3, l = F.lane, sub = l & 7, rr = l >> 3, n16 = l & 15, q = l >> 4, step = nmem * NWAVES;
    const GAS unsigned char* vb = (const GAS unsigned char*)(V8 + (size_t)g * NEXP * 128);
    LAS unsigned long long* rep = (LAS unsigned long long*)(F.lds + F.wave * 2048);
    const unsigned long long bm = 0xFFull << (8 * (n16 & 7));
    const int repi = 2 * q + (n16 >> 3);
    const bool vl = (n16 < 8) && (q < 2);
    LAS float* stg = (LAS float*)(F.lds + 16384 + F.wave * 512);
    int tok = 2 * ((F.bid >> 3) * NWAVES + F.wave);
    int ne[4]; float na[4];
#define V_PREFETCH(t) do { const size_t _a = (size_t)(t) * 128, _b = ((size_t)(t) + 1) * 128; ne[0] = IDX[_a + l]; ne[1] = IDX[_a + 64 + l]; ne[2] = IDX[_b + l]; ne[3] = IDX[_b + 64 + l]; \
        na[0] = AK[_a + l]; na[1] = AK[_a + 64 + l]; na[2] = AK[_b + l]; na[3] = AK[_b + 64 + l]; } while (0)
    if (tok + 1 < T_TOK) V_PREFETCH(tok);
    for (; tok + 1 < T_TOK; tok += 2 * step) {
        const int e0 = ne[0], e1 = ne[1], e2 = ne[2], e3 = ne[3]; const float a0 = na[0], a1 = na[1], a2 = na[2], a3 = na[3];
        u32x4 rowA[16], rowB[16];
#pragma unroll
        for (int i = 0; i < 16; ++i) { const int src = (8 * (i & 7) + rr) * 4;
            const int ea = __builtin_amdgcn_ds_bpermute(src, i < 8 ? e0 : e1), eb = __builtin_amdgcn_ds_bpermute(src, i < 8 ? e2 : e3);
            rowA[i] = *(const GAS u32x4*)(vb + ((unsigned)ea * 128u + 16u * (unsigned)sub)); rowB[i] = *(const GAS u32x4*)(vb + ((unsigned)eb * 128u + 16u * (unsigned)sub)); }
        f32x4 HA = {0.f, 0.f, 0.f, 0.f}, HB = {0.f, 0.f, 0.f, 0.f};
        if (l < 32) { const float* hpa = out + (size_t)tok * D + g * 128 + 4 * l; HA = *(const f32x4*)hpa; HB = *(const f32x4*)(hpa + D); }
        if (tok + 2 * step + 1 < T_TOK) V_PREFETCH(tok + 2 * step);
        const float amA = wave_max_nonneg(fmaxf(fabsf(a0), fabsf(a1))), amB = wave_max_nonneg(fmaxf(fabsf(a2), fabsf(a3)));
        const float scA = amA > 0.f ? 224.f * __builtin_amdgcn_rcpf(amA) : 0.f, invA = amA * (1.f / 224.f), scB = amB > 0.f ? 224.f * __builtin_amdgcn_rcpf(amB) : 0.f, invB = amB * (1.f / 224.f);
        { const unsigned wA = (unsigned)__builtin_amdgcn_cvt_pk_fp8_f32(a0 * scA, a1 * scA, 0, false), wB = (unsigned)__builtin_amdgcn_cvt_pk_fp8_f32(a2 * scB, a3 * scB, 0, false);
          const unsigned r0 = (wA & 0xffu) * 0x01010101u, r1 = ((wA >> 8) & 0xffu) * 0x01010101u, r2 = (wB & 0xffu) * 0x01010101u, r3 = ((wB >> 8) & 0xffu) * 0x01010101u;
          rep[l] = ((unsigned long long)r0 << 32) | r0; rep[64 + l] = ((unsigned long long)r1 << 32) | r1; rep[128 + l] = ((unsigned long long)r2 << 32) | r2; rep[192 + l] = ((unsigned long long)r3 << 32) | r3; }
        LDS_WAIT(); asm volatile("" ::: "memory");
#pragma unroll
        for (int t2 = 0; t2 < 2; ++t2) {
            f32x4 alo = {0.f, 0.f, 0.f, 0.f}, ahi = {0.f, 0.f, 0.f, 0.f};
#pragma unroll
            for (int i = 0; i < 16; ++i) { const long bop = (long)(rep[128 * t2 + 8 * i + repi] & bm); const u32x4 rw = t2 ? rowB[i] : rowA[i];
                alo = __builtin_amdgcn_mfma_f32_16x16x32_fp8_fp8(lo64(rw), bop, alo, 0, 0, 0);
                ahi = __builtin_amdgcn_mfma_f32_16x16x32_fp8_fp8(hi64(rw), bop, ahi, 0, 0, 0); }
            const float inv = t2 ? invB : invA;
            float vlo[4], vhi[4];
#pragma unroll
            for (int r = 0; r < 4; ++r) { const float tl = alo[r], th = ahi[r];
                vlo[r] = (tl + __builtin_bit_cast(float, __builtin_amdgcn_ds_bpermute(((l + 40) & 63) * 4, __builtin_bit_cast(int, tl)))) * inv;
                vhi[r] = (th + __builtin_bit_cast(float, __builtin_amdgcn_ds_bpermute(((l + 40) & 63) * 4, __builtin_bit_cast(int, th)))) * inv; }
            if (vl) {
#pragma unroll
                for (int r = 0; r < 4; ++r) { stg[64 * q + 16 * r + n16] = vlo[r]; stg[64 * q + 16 * r + n16 + 8] = vhi[r]; } }
            LDS_WAIT(); asm volatile("" ::: "memory");
            if (l < 32) { const f32x4 dv = *(const LAS f32x4*)(stg + 4 * l); *(f32x4*)(out + (size_t)(tok + t2) * D + g * 128 + 4 * l) = (t2 ? HB : HA) + dv; }
            LDS_WAIT(); asm volatile("" ::: "memory");
        }
        LDS_WAIT(); asm volatile("" ::: "memory");
    }
#undef V_PREFETCH
}
typedef float f32x16 __attribute__((ext_vector_type(16)));
template <int MODE>
__device__ __forceinline__ void peer_v4_phase(const Frame& F, const Args& A) {
    const int* IDX = (const int*)(A.ws + WS_P + P_IDX); const float* AK = (const float*)(A.ws + WS_AK);
    float* out = A.out;
    const int l = F.lane, n = l & 31, hq = l >> 5, step = F.G * NWAVES;
    const GAS unsigned char* vb = (const GAS unsigned char*)(A.ws + WS_V8);
    const unsigned lconst = 16u * (unsigned)n;
    const bool diag = ((l >> 4) & 1) == hq;
    const unsigned bytem = diag ? (0xFFu << (8 * (l & 3))) : 0u; const int dsel = (l & 15) >> 2;
    const unsigned M0 = dsel == 0 ? bytem : 0u, M1 = dsel == 1 ? bytem : 0u, M2 = dsel == 2 ? bytem : 0u, M3 = dsel == 3 ? bytem : 0u;
    const int rsel = 4 * hq;
    const int sc1 = 0x7F7F7F7F;
    const int colb = 32 * n + 4 * hq;
    int tok = F.bid * NWAVES + F.wave;
    int ne0, ne1; float na0, na1;
#define V4_PREFETCH(t) do { const size_t _t = (size_t)(t) * 128; ne0 = IDX[_t + l]; ne1 = IDX[_t + 64 + l]; na0 = AK[_t + l]; na1 = AK[_t + 64 + l]; } while (0)
#define V4_LOADS(R, ro_, h) do { int ba_ = rsel + 4 * (16 * (h)); _Pragma("unroll") for (int j_ = 0; j_ < 8; ++j_) { asm volatile("" : "+v"(ba_)); const int o_ = __builtin_amdgcn_ds_bpermute(ba_, (ro_)); ba_ += 8; \
        R[j_] = *(const GAS u32x4*)(vb + ((unsigned)o_ + lconst)); } } while (0)
#define V4_ONE(ACC, R, rep_, h, j_) do { unsigned s0_ = (unsigned)__builtin_amdgcn_readlane((int)(rep_), 16 * (h) + 2 * (j_)), s1_ = (unsigned)__builtin_amdgcn_readlane((int)(rep_), 16 * (h) + 2 * (j_) + 1); \
        asm volatile("" : "+s"(s0_), "+s"(s1_), "+v"(ACC)); \
        const i32x8 a8_ = {(int)(s0_ & M0), (int)(s0_ & M1), (int)(s0_ & M2), (int)(s0_ & M3), (int)(s1_ & M0), (int)(s1_ & M1), (int)(s1_ & M2), (int)(s1_ & M3)}; \
        const i32x4 r4_ = __builtin_bit_cast(i32x4, R[j_]); \
        ACC = __builtin_amdgcn_mfma_scale_f32_32x32x64_f8f6f4(a8_, __builtin_shufflevector(r4_, r4_, 0, 1, 2, 3, -1, -1, -1, -1), ACC, 0, 4, 0, sc1, 0, sc1); } while (0)
#define V4_COMPUTE(R, rep_, h) do { V4_ONE(acc, R, rep_, h, 0); V4_ONE(acc1, R, rep_, h, 1); V4_ONE(acc, R, rep_, h, 2); V4_ONE(acc1, R, rep_, h, 3); \
        V4_ONE(acc, R, rep_, h, 4); V4_ONE(acc1, R, rep_, h, 5); V4_ONE(acc, R, rep_, h, 6); V4_ONE(acc1, R, rep_, h, 7); } while (0)
    u32x4 RA[8], RB[8];
    if (tok < T_TOK) { V4_PREFETCH(tok); V4_LOADS(RA, ne0 * 512, 0); }
    for (; tok < T_TOK; tok += step) {
        const int e0 = ne0, e1 = ne1; const float a0 = na0, a1 = na1;
        const int ro0 = e0 * 512, ro1 = e1 * 512;
        const bool more = tok + step < T_TOK;
        V4_LOADS(RB, ro0, 1);
        if (more) V4_PREFETCH(tok + step);
        const float am = wave_max_nonneg(fmaxf(fabsf(a0), fabsf(a1)));
        const float sc = am > 0.f ? 224.f * __builtin_amdgcn_rcpf(am) : 0.f, inv = am * (1.f / 224.f);
        const unsigned w8 = (unsigned)__builtin_amdgcn_cvt_pk_fp8_f32(a0 * sc, a1 * sc, 0, false);
        const unsigned rep0 = (w8 & 0xffu) * 0x01010101u, rep1 = ((w8 >> 8) & 0xffu) * 0x01010101u;
        f32x16 acc, acc1;
#pragma unroll
        for (int i = 0; i < 16; ++i) { acc[i] = 0.f; acc1[i] = 0.f; }
        V4_COMPUTE(RA, rep0, 0); V4_LOADS(RA, ro0, 2);
        V4_COMPUTE(RB, rep0, 1); V4_LOADS(RB, ro0, 3);
        V4_COMPUTE(RA, rep0, 2); V4_LOADS(RA, ro1, 0);
        V4_COMPUTE(RB, rep0, 3); V4_LOADS(RB, ro1, 1);
        V4_COMPUTE(RA, rep1, 0); V4_LOADS(RA, ro1, 2);
        V4_COMPUTE(RB, rep1, 1); V4_LOADS(RB, ro1, 3);
        f32x4 H[4];
        u32x2 MX[4];
        { const float* hp = A.in[I_X] + (size_t)tok * D + colb; const bf16_t* mp = (const bf16_t*)(A.ws + WS_N1) + (size_t)tok * D + colb;
#pragma unroll
          for (int j = 0; j < 4; ++j) { H[j] = *(const f32x4*)(hp + 8 * j); MX[j] = *(const u32x2*)(mp + 8 * j); } }
        V4_COMPUTE(RA, rep1, 2);
        if (more) V4_LOADS(RA, ne0 * 512, 0);
        V4_COMPUTE(RB, rep1, 3);
        acc = acc + acc1;
        float ss = 0.f;
#pragma unroll
        for (int j = 0; j < 4; ++j) { H[j] = H[j] + (f32x4){bflo(MX[j].x), bfhi(MX[j].x), bflo(MX[j].y), bfhi(MX[j].y)} + (f32x4){acc[4 * j], acc[4 * j + 1], acc[4 * j + 2], acc[4 * j + 3]} * inv;
            ss += (H[j].x * H[j].x + H[j].y * H[j].y) + (H[j].z * H[j].z + H[j].w * H[j].w); }
        const float rstd = 1.f / sqrtf(wave_sum(ss) * (1.f / D) + EPS);
        { float* hp = out + (size_t)tok * D + colb;
#pragma unroll
          for (int j = 0; j < 4; ++j) *(f32x4*)(hp + 8 * j) = H[j] * rstd * *(const f32x4*)(A.in[I_FG] + colb + 8 * j); }
    }
#undef V4_PREFETCH
#undef V4_LOADS
#undef V4_COMPUTE
#undef V4_ONE
}
__device__ __forceinline__ void final_norm_phase(const Frame& F, const Args& A) {
    const int gw = F.bid * NWAVES + F.wave, NGW = F.G * NWAVES, l = F.lane; const float* fg = A.in[I_FG];
    const f32x4* gp = (const f32x4*)fg + l;
    int tok = gw;
    for (; tok + 3 * NGW < T_TOK; tok += 4 * NGW) {
        f32x4 v[4][4]; float ss[4];
#pragma unroll
        for (int b = 0; b < 4; ++b) { const f32x4* hp = (const f32x4*)(A.out + (size_t)(tok + b * NGW) * D) + l;
#pragma unroll
            for (int j = 0; j < 4; ++j) v[b][j] = hp[64 * j]; }
#pragma unroll
        for (int b = 0; b < 4; ++b) { ss[b] = 0.f;
#pragma unroll
            for (int j = 0; j < 4; ++j) ss[b] += (v[b][j].x * v[b][j].x + v[b][j].y * v[b][j].y) + (v[b][j].z * v[b][j].z + v[b][j].w * v[b][j].w); }
#pragma unroll
        for (int o = 1; o < 64; o <<= 1) {
#pragma unroll
            for (int b = 0; b < 4; ++b) ss[b] += __shfl_xor(ss[b], o); }
#pragma unroll
        for (int b = 0; b < 4; ++b) { const float rstd = 1.f / sqrtf(ss[b] * (1.f / D) + EPS); f32x4* hp = (f32x4*)(A.out + (size_t)(tok + b * NGW) * D) + l;
#pragma unroll
            for (int j = 0; j < 4; ++j) hp[64 * j] = v[b][j] * rstd * gp[64 * j]; }
    }
    for (; tok < T_TOK; tok += NGW) { f32x4* hp = (f32x4*)(A.out + (size_t)tok * D) + l; f32x4 v[4]; float ss = 0.f;
#pragma unroll
        for (int j = 0; j < 4; ++j) { v[j] = hp[64 * j]; ss += (v[j].x * v[j].x + v[j].y * v[j].y) + (v[j].z * v[j].z + v[j].w * v[j].w); }
        const float rstd = 1.f / sqrtf(wave_sum(ss) * (1.f / D) + EPS);
#pragma unroll
        for (int j = 0; j < 4; ++j) hp[64 * j] = v[j] * rstd * gp[64 * j]; }
}

#ifdef DEBUG_CHECK
constexpr size_t WS_DBG = 472 * MiB;
__device__ __forceinline__ int dbg_tok(int i) { return (i * 509 + 3) & 32767; }
__device__ __forceinline__ float gelu_ref(float x) { return 0.5f * x * (1.f + tanhf(0.7978845608028654f * (x + 0.044715f * x * x * x))); }
__global__ void __launch_bounds__(512) dbg_scores(Args a) {
    __shared__ float n2s[1024]; __shared__ float q[2048];
    const int t = dbg_tok(blockIdx.x), tid = threadIdx.x;
    const bf16_t* N2 = (const bf16_t*)(a.ws + WS_N1); const float* SC = (const float*)(a.ws + WS_P + P_SC); unsigned* dbg = (unsigned*)(a.ws + WS_DBG);
    for (int k = tid; k < 1024; k += 512) n2s[k] = bf1(N2[(size_t)t * 1024 + k]);
    __syncthreads();
    for (int r = 0; r < 4; ++r) { const int c = tid + 512 * r; float s = 0.f; for (int k = 0; k < 1024; ++k) s += n2s[k] * a.in[I_WQ][(size_t)k * 2048 + c]; q[c] = s; }
    __syncthreads();
    float md = 0.f;
    for (int r = 0; r < 4; ++r) { const int n = tid + 512 * r, hh = n >> 7, key = n & 127; const float* kX = (hh & 1) ? a.in[I_K2] : a.in[I_K1];
        float s = 0.f; for (int d = 0; d < 128; ++d) s += q[hh * 128 + d] * kX[key * 128 + d];
        md = fmaxf(md, fabsf(s - SC[(size_t)n * T_TOK + t])); }
    atomicMax(&dbg[0], __builtin_bit_cast(unsigned, md));
}
__global__ void __launch_bounds__(64) dbg_topk(Args a) {
    __shared__ float s1[8][128], s2[8][128], cv[8][256]; __shared__ float t1v[8][16], t2v[8][16]; __shared__ int t1i[8][16], t2i[8][16], exi[8][16]; __shared__ float exv[8][16];
    const int t = dbg_tok(blockIdx.x), h = threadIdx.x;
    const float* SC = (const float*)(a.ws + WS_P + P_SC); const int* IDX = (const int*)(a.ws + WS_P + P_IDX); const float* GATE = (const float*)(a.ws + WS_P + P_GATE); unsigned* dbg = (unsigned*)(a.ws + WS_DBG);
    if (h >= 8) return;
    for (int j = 0; j < 128; ++j) { s1[h][j] = SC[(size_t)(h * 256 + j) * T_TOK + t]; s2[h][j] = SC[(size_t)(h * 256 + 128 + j) * T_TOK + t]; }
    for (int r = 0; r < 16; ++r) { int b1 = 0, b2 = 0; for (int j = 1; j < 128; ++j) { if (s1[h][j] > s1[h][b1]) b1 = j; if (s2[h][j] > s2[h][b2]) b2 = j; }
        t1v[h][r] = s1[h][b1]; t1i[h][r] = b1; s1[h][b1] = -1e30f; t2v[h][r] = s2[h][b2]; t2i[h][r] = b2; s2[h][b2] = -1e30f; }
    for (int c = 0; c < 256; ++c) cv[h][c] = t1v[h][c >> 4] + t2v[h][c & 15];
    for (int r = 0; r < 16; ++r) { int bc = 0; for (int c = 1; c < 256; ++c) if (cv[h][c] > cv[h][bc]) bc = c;
        exv[h][r] = cv[h][bc]; exi[h][r] = t1i[h][bc >> 4] * 128 + t2i[h][bc & 15]; cv[h][bc] = -1e30f; }
    float sum = 0.f; const float mx0 = exv[h][0]; for (int r = 0; r < 16; ++r) { exv[h][r] = expf(exv[h][r] - mx0); } for (int r = 0; r < 16; ++r) sum += exv[h][r];
    unsigned miss = 0; float gd = 0.f;
    for (int w = 0; w < 16; ++w) { const int e = IDX[(size_t)t * 128 + h * 16 + w]; const float g = GATE[(size_t)t * 128 + h * 16 + w]; bool found = false;
        for (int r = 0; r < 16; ++r) if (exi[h][r] == e) { found = true; gd = fmaxf(gd, fabsf(g - exv[h][r] / sum)); }
        if (!found) ++miss; }
    atomicAdd(&dbg[1], miss); atomicMax(&dbg[3], __builtin_bit_cast(unsigned, gd));
}
__global__ void __launch_bounds__(512) dbg_experts_pre(Args a) {
    __shared__ float n2s[1024]; __shared__ float ak[128]; __shared__ int ek[128]; __shared__ float red[8];
    const int t = dbg_tok(blockIdx.x), tid = threadIdx.x, lane = tid & 63, wave = tid >> 6;
    const bf16_t* N2 = (const bf16_t*)(a.ws + WS_N1); const int* IDX = (const int*)(a.ws + WS_P + P_IDX); const float* GATE = (const float*)(a.ws + WS_P + P_GATE);
    float* rows = (float*)(a.ws + WS_DBG + MiB);
    for (int k = tid; k < 1024; k += 512) n2s[k] = bf1(N2[(size_t)t * 1024 + k]);
    if (tid < 128) ek[tid] = IDX[(size_t)t * 128 + tid];
    __syncthreads();
    for (int k = wave * 16; k < wave * 16 + 16; ++k) { const float* u = a.in[I_PU] + (size_t)ek[k] * 1024; float s = 0.f; for (int j = lane; j < 1024; j += 64) s += u[j] * n2s[j];
        s = wave_sum(s); if (lane == 0) ak[k] = gelu_ref(s) * GATE[(size_t)t * 128 + k]; }
    __syncthreads();
    float h2[2]; float ss = 0.f;
    for (int r = 0; r < 2; ++r) { const int d = tid + 512 * r; float o = 0.f; for (int k = 0; k < 128; ++k) o += ak[k] * a.in[I_PV][(size_t)ek[k] * 1024 + d]; h2[r] = a.out[(size_t)t * 1024 + d] + o; ss += h2[r] * h2[r]; }
    ss = wave_sum(ss); if (lane == 0) red[wave] = ss; __syncthreads();
    float tot = 0.f; for (int w = 0; w < 8; ++w) tot += red[w];
    const float rstd = 1.f / sqrtf(tot / 1024.f + EPS);
    for (int r = 0; r < 2; ++r) { const int d = tid + 512 * r; rows[(size_t)blockIdx.x * 1024 + d] = h2[r] * rstd * a.in[I_FG][d]; }
}
__global__ void __launch_bounds__(512) dbg_experts_post(Args a) {
    const int t = dbg_tok(blockIdx.x), tid = threadIdx.x; const float* rows = (const float*)(a.ws + WS_DBG + MiB); float* dbgf = (float*)(a.ws + WS_DBG);
    float e = 0.f, n = 0.f;
    for (int r = 0; r < 2; ++r) { const int d = tid + 512 * r; const float x = rows[(size_t)blockIdx.x * 1024 + d], y = a.out[(size_t)t * 1024 + d]; e += (x - y) * (x - y); n += x * x; }
    e = wave_sum(e); n = wave_sum(n); if ((tid & 63) == 0) { atomicAdd(&dbgf[4], e); atomicAdd(&dbgf[5], n); }
}
__global__ void __launch_bounds__(512) dbg_report(Args a, int which) {
    const unsigned* dbg = (const unsigned*)(a.ws + WS_DBG); const float* dbgf = (const float*)(a.ws + WS_DBG);
    const float mA = dbgf[0], gd = dbgf[3]; const unsigned miss = dbg[1]; const float relC = sqrtf(dbgf[4] / fmaxf(dbgf[5], 1e-30f));
    float X;
    if (which == 0) { int mask = 0; if (mA > 0.05f) mask |= 1; if (miss > 400u) mask |= 2; if (relC > 0.05f) mask |= 4; if (gd > 0.02f) mask |= 8; X = 1000.f + 100.f * mask; }
    else if (which == 1) X = 1e6f * mA; else if (which == 2) X = 100.f + (float)miss; else if (which == 3) X = 1e6f * relC; else X = 1e6f * gd;
    for (size_t i = (size_t)blockIdx.x * 512 + threadIdx.x; i < (size_t)T_TOK * D; i += (size_t)gridDim.x * 512) a.out[i] = (i == 0) ? X : 0.f;
}
#endif

constexpr int NPH = 13;
__global__ void __launch_bounds__(NWAVES * 64, 2) fwd_kernel(Args args) {
    extern __shared__ __attribute__((aligned(16))) unsigned char lds_raw[];
    Frame F;
    F.lds = (LAS unsigned char*)lds_raw;
    F.tid = threadIdx.x; F.lane = F.tid & 63; F.wave = __builtin_amdgcn_readfirstlane(F.tid >> 6);
    F.G = gridDim.x; F.bid = blockIdx.x;
    volatile LAS unsigned* MISC = (volatile LAS unsigned*)(F.lds + MISC_OFF);
    for (int u = F.tid; u < (LDS_BYTES - LDSCTL_OFF) / 4; u += NWAVES * 64) ((LAS unsigned*)(F.lds + LDSCTL_OFF))[u] = 0u;
    __syncthreads();
    unsigned* ctl = (unsigned*)(args.ws + WS_CTL);
    const int lo = args.ph_lo, hi = args.ph_hi;
    XcdBarrier bar; bar.bar = ctl + CW_BAR + args.li * XCD_BAR_WORDS; bar.x = 0; bar.st = nullptr; bar.wave = F.wave;
    if (hi - lo > 1) bar = xcd_barrier_post(ctl + CW_BAR + args.li * XCD_BAR_WORDS, MISC + 8, F.wave);
#define IN(k) (lo <= (k) && (k) < hi)
#ifdef PROBE_TS
#define STAMP(k) do { if (F.bid == 0 && F.tid == 0) ((unsigned long long*)(args.ws + (472u << 20)))[(k)] = __builtin_amdgcn_s_memrealtime(); } while (0)
#else
#define STAMP(k) do { } while (0)
#endif
#define SEAM(k) do { if (IN(k) && IN((k) + 1)) { xcd_barrier(bar); if (XTRA_BAR) xcd_barrier(bar); } STAMP((k) + 1); } while (0)
    unsigned char* ws = args.ws;
    bf16_t* P = (bf16_t*)(ws + WS_P);

#define REFRESH() do { int z_ = 0; asm volatile("" : "+s"(z_)); F.lane = (int)__builtin_amdgcn_mbcnt_hi(~0u, __builtin_amdgcn_mbcnt_lo(~0u, (unsigned)z_)); F.tid = F.wave * 64 + F.lane; } while (0)
    STAMP(0);
    if (IN(0)) { phase0(F, args); SEAM(0); }
    if (IN(1)) { REFRESH();
        if (F8_LO > 0) { pg8::Gemm g{(const bf16_t*)(ws + WS_N1), (const bf16_t*)(ws + WS_WIN), T_TOK, F8_LO * 256, D, D}; pg8::StaticOrder S; S.init(T_TOK, F8_LO * 256, F.G, F.bid);
            pg8::EpiProj E{P, (float*)(ws + WS_ALR), 0}; pg8::gemm_phase<pg8::EpiProj, pg8::StaticOrder, false, true, false>(F.lds, g, S, E, F.wave); }
        if (F8_LO < 21) {
            pg8::Gemm g{(const bf16_t*)(ws + WS_N18), (const bf16_t*)(ws + WS_W8 + (size_t)F8_LO * 256 * 1024), T_TOK, (21 - F8_LO) * 256, D / 2, D / 2, 0x7B7B7B7B, 0x75757575};
            pg8::StaticOrder S; S.init(T_TOK, (21 - F8_LO) * 256, F.G, ((F8_LO * 128) % F.G) != 0 ? F.G - 1 - F.bid : F.bid);
            pg8::EpiProj E{P, (float*)(ws + WS_ALR), F8_LO}; pg8::gemm_phase<pg8::EpiProj, pg8::StaticOrder, false, true, true>(F.lds, g, S, E, F.wave); }
        {
            REFRESH();
            const int nwg = (T_TOK / 256) * (NPROJ / 256), rem = nwg % F.G;
            if (rem == 0) convert_tables(F, args, F.bid * NWAVES + F.wave, F.G * NWAVES);
            else if (F.bid >= rem) convert_tables(F, args, (F.bid - rem) * NWAVES + F.wave, (F.G - rem) * NWAVES);
        }
        SEAM(1);
    }
    if (IN(2)) { REFRESH();
        if (DRY_EXP == 12) { gla_chunk_phase<true>(F, args); for (int it = F.bid; it < 256; it += F.G) for (int g4 = 0; g4 < 4; ++g4) sgu_unit<true>(F, args, 4 * it + g4, g4 == 0); __syncthreads(); }
        gla_chunk_phase<false>(F, args);
        for (int it = F.bid; it < 256; it += F.G) for (int g4 = 0; g4 < 4; ++g4) sgu_unit<false>(F, args, 4 * it + g4, g4 == 0);
        SEAM(2);
    }
    if (IN(3)) { REFRESH(); if (DRY_EXP == 13 || DRY_EXP == 15) { gla_scan<true>(F, args); __syncthreads(); } gla_scan<false>(F, args); SEAM(3); }
    if (IN(4)) { REFRESH(); if (DRY_EXP == 14 || DRY_EXP == 15) { gla_out_phase<true>(F, args); __syncthreads(); } gla_out_phase<false>(F, args); SEAM(4); }
    if (IN(5)) { REFRESH();
        { pg8::Gemm g{P + PC_R, (const bf16_t*)(ws + WS_WA), T_TOK, D, 1024, PLD}; pg8::StaticOrder S; S.init(T_TOK, D, F.G, F.bid);
          pg8::EpiBrAB E{P}; pg8::gemm_phase<pg8::EpiBrAB, pg8::StaticOrder, true, true, false, true>(F.lds, g, S, E, F.wave); }
        SEAM(5);
    }
    if (IN(6)) { REFRESH();
        pg8::Gemm g{P + PC_MRG, (const bf16_t*)(ws + WS_WOUT), T_TOK, D, D, PLD}; pg8::StaticOrder S; S.init(T_TOK, D, F.G, F.bid);
        pg8::EpiOut E{(bf16_t*)(ws + WS_N1)}; pg8::gemm_phase<pg8::EpiOut, pg8::StaticOrder, true, true>(F.lds, g, S, E, F.wave);
        SEAM(6);
    }
    if (IN(7)) { REFRESH();
        const int gw = F.bid * NWAVES + F.wave, NGW = F.G * NWAVES;
        { int m = gw; for (; m + 3 * NGW < T_TOK; m += 4 * NGW) rms_rows_to_bf16<(SC_F8 ? 2 : 3), 4>(F.lane, args.in[I_X] + (size_t)m * D, (size_t)NGW * D, args.in[I_N2G], (bf16_t*)(ws + WS_P + P_N2) + (size_t)m * D, (size_t)NGW * D, (unsigned*)(ws + WS_P + P_X8) + (size_t)m * 256, (size_t)NGW * 256, (const bf16_t*)(ws + WS_N1) + (size_t)m * D, (size_t)NGW * D);
          for (; m < T_TOK; m += NGW) rms_rows_to_bf16<(SC_F8 ? 2 : 3), 1>(F.lane, args.in[I_X] + (size_t)m * D, 0, args.in[I_N2G], (bf16_t*)(ws + WS_P + P_N2) + (size_t)m * D, 0, (unsigned*)(ws + WS_P + P_X8) + (size_t)m * 256, 0, (const bf16_t*)(ws + WS_N1) + (size_t)m * D, 0); }
        SEAM(7);
    }
    if (IN(8)) { REFRESH();
        pg8::StaticOrder S; S.init(T_TOK, 2048, F.G, F.bid); pg8::EpiScores E{(bf16_t*)(ws + WS_P + P_SC)};
        if (SC_F8) { pg8::Gemm g{(const bf16_t*)(ws + WS_P + P_X8), (const bf16_t*)(ws + WS_WQF), T_TOK, 2048, D / 2, D / 2, 0x7B7B7B7B, 0x75757575};
            pg8::gemm_phase<pg8::EpiScores, pg8::StaticOrder, true, true, true>(F.lds, g, S, E, F.wave); }
        else { pg8::Gemm g{(const bf16_t*)(ws + WS_P + P_N2), (const bf16_t*)(ws + WS_WQF), T_TOK, 2048, D, D};
            pg8::gemm_phase<pg8::EpiScores, pg8::StaticOrder, true, true>(F.lds, g, S, E, F.wave); }
        SEAM(8);
    }
    if (IN(9)) { REFRESH(); peer_topk(F, args); SEAM(9); }
    if (IN(10)) { REFRESH(); if constexpr (UNG == 1) peer_u4_all<0>(F, args); else peer_u4_phase<0>(F, args); SEAM(10); }
    if (IN(11)) { REFRESH(); if (V_F4) peer_v4_phase<0>(F, args); else { if (DRY_EXP == 1) { peer_v_phase<1>(F, args); __syncthreads(); } peer_v_phase<0>(F, args); SEAM(11); } }
    if (IN(12)) { REFRESH(); if (!V_F4) final_norm_phase(F, args); }
#undef IN
#undef SEAM
}


#ifdef PROBE_TS
__global__ void __launch_bounds__(512) probe_report(Args a, int pi, int pj) {
    const unsigned long long* ts = (const unsigned long long*)(a.ws + (472u << 20));
    const float X1 = 10.f * (float)(ts[pi + 1] - ts[pi]) * 0.01f, X2 = (float)(ts[pj + 1] - ts[pj]) * 0.01f;
    for (size_t i = (size_t)blockIdx.x * 512 + threadIdx.x; i < (size_t)T_TOK * D; i += (size_t)gridDim.x * 512) a.out[i] = (i == 0) ? X1 : X2;
}
#endif
#ifdef PROBE_MFMA
__global__ void __launch_bounds__(64) probe_mfma(Args a) {
    const int l = threadIdx.x;
    i32x4 av = {0, 0, 0, 0};
    if (l == PROBE_L) av[PROBE_P >> 3] = 0x2 << (4 * (PROBE_P & 7));
    i32x8 b1, b2;
    for (int r = 0; r < 8; ++r) { unsigned w1 = 0, w2 = 0;
        for (int c = 0; c < 4; ++c) { const int b = 4 * r + c; int t = 0;
            t = __builtin_amdgcn_cvt_pk_fp8_f32((float)((b & 15) + 1), (float)(1 + (b >> 4) + 2 * (l >> 4)), 0, false);
            w1 |= ((unsigned)t & 0xffu) << (8 * c); w2 |= (((unsigned)t >> 8) & 0xffu) << (8 * c); }
        b1[r] = (int)w1; b2[r] = (int)w2; }
    const f32x4 z = {0.f, 0.f, 0.f, 0.f};
    const f32x4 d1 = __builtin_amdgcn_mfma_scale_f32_16x16x128_f8f6f4(__builtin_shufflevector(av, av, 0, 1, 2, 3, -1, -1, -1, -1), b1, z, 4, 0, 0, 0x7F7F7F7F, 0, 0x7F7F7F7F);
    const f32x4 d2 = __builtin_amdgcn_mfma_scale_f32_16x16x128_f8f6f4(__builtin_shufflevector(av, av, 0, 1, 2, 3, -1, -1, -1, -1), b2, z, 4, 0, 0, 0x7F7F7F7F, 0, 0x7F7F7F7F);
    float* st = (float*)(a.ws + (472u << 20));
    *(f32x4*)(st + 8 * l) = d1; *(f32x4*)(st + 8 * l + 4) = d2;
}
__global__ void __launch_bounds__(512) probe_mfma_report(Args a) {
    const int row = PROBE_L & 15;
    const float* st = (const float*)(a.ws + (472u << 20)) + 8 * (16 * (row >> 2)) + (row & 3); const float X1 = 10.f * st[0], X2 = st[4];
    for (size_t i = (size_t)blockIdx.x * 512 + threadIdx.x; i < (size_t)T_TOK * D; i += (size_t)gridDim.x * 512) a.out[i] = (i == 0) ? X1 : X2;
}
#endif
extern "C" void kernel_launch(void* const* d_in, const int* in_sizes, int n_in, void* d_out, int out_size, void* d_ws, size_t ws_size, hipStream_t stream) {
    static int grid = 0;
    if (grid == 0) {
        if (n_in != 20 || in_sizes[0] != T_TOK * D || out_size != T_TOK * D || ws_size < WS_END) {
            fprintf(stderr, "kernel_launch: unexpected shapes: n_in %d in0 %d out %d ws %zu (need %zu)\n", n_in, n_in > 0 ? in_sizes[0] : -1, out_size, ws_size, (size_t)WS_END); grid = -1; return; }
        int dev = 0, cus = 0;
        if (hipGetDevice(&dev) != hipSuccess || hipDeviceGetAttribute(&cus, hipDeviceAttributeMultiprocessorCount, dev) != hipSuccess) { grid = -1; return; }
        if (hipFuncSetAttribute((const void*)fwd_kernel, hipFuncAttributeMaxDynamicSharedMemorySize, LDS_BYTES) != hipSuccess) { fprintf(stderr, "kernel_launch: hipFuncSetAttribute failed\n"); grid = -1; return; }
        int per_cu = 0;
        if (hipOccupancyMaxActiveBlocksPerMultiprocessor(&per_cu, (const void*)fwd_kernel, NWAVES * 64, LDS_BYTES) != hipSuccess || per_cu < 1) fprintf(stderr, "kernel_launch: occupancy query says %d\n", per_cu);
        (void)hipGetLastError();
        grid = cus;
    }
    if (grid < 0) return;
    (void)hipMemsetAsync((char*)d_ws + WS_CTL, 0, CTL_ZERO_BYTES, stream);
    Args a{};
    for (int i = 0; i < 20; ++i) a.in[i] = (const float*)d_in[i];
    a.out = (float*)d_out; a.ws = (unsigned char*)d_ws;
#ifdef PROBE_MFMA
    hipLaunchKernelGGL(probe_mfma, dim3(1), dim3(64), 0, stream, a);
    hipLaunchKernelGGL(probe_mfma_report, dim3(1024), dim3(512), 0, stream, a);
    return;
#endif
#ifndef LAUNCH_LIST
#define LAUNCH_LIST {0, NPH}
#endif
    static const int ranges[][2] = { LAUNCH_LIST };
    const int nl = (int)(sizeof(ranges) / sizeof(ranges[0]));
    for (int li = 0; li < nl; ++li) { a.ph_lo = ranges[li][0]; a.ph_hi = ranges[li][1]; a.li = li;
        hipLaunchKernelGGL(fwd_kernel, dim3(grid), dim3(NWAVES * 64), LDS_BYTES, stream, a); }
}
```

```cpp
#include <hip/hip_runtime.h>
#include <cstdio>
#include <cstdint>


#ifndef XTRA_BAR
#define XTRA_BAR 0
#endif
#ifndef DRY_EXP
#define DRY_EXP 0
#endif
#ifndef DUP_PHASE
#define DUP_PHASE -1
#endif
#ifndef MK_N_LAUNCHES
#define MK_N_LAUNCHES 1
#endif

#define LAS __attribute__((address_space(3)))
#define GAS __attribute__((address_space(1)))
typedef unsigned short bf16_t;
typedef short bf16x8 __attribute__((ext_vector_type(8)));
typedef float f32x4 __attribute__((ext_vector_type(4)));
typedef float f32x2 __attribute__((ext_vector_type(2)));
typedef unsigned u32x4 __attribute__((ext_vector_type(4)));
typedef unsigned u32x2 __attribute__((ext_vector_type(2)));
typedef int i32x4 __attribute__((ext_vector_type(4)));
typedef int i32x8 __attribute__((ext_vector_type(8)));
typedef __bf16 bf16x2_t __attribute__((ext_vector_type(2)));

constexpr int T_TOK = 32768, D = 1024, SEQ = 4096, NBATCH = 8;
constexpr int NPROJ = 5376;
constexpr int PLD = 5120;
constexpr int PC_Q = 0, PC_K = 512, PC_V = 1024, PC_R = 1536, PC_SU = 2048, PC_SV = 2560, PC_GA = 3072, PC_GB = 4096;
constexpr int PC_MRG = 512;
constexpr float EPS = 1e-6f;
constexpr int NEXP = 16384;
#ifndef U_NG
#define U_NG 1
#endif
#ifndef V_F4
#define V_F4 1
#endif
#ifndef SC_F8
#define SC_F8 0
#endif
#ifndef F8_LO
#define F8_LO 11
#endif
constexpr int UNG = U_NG, UNG_SH = (U_NG == 8 ? 3 : (U_NG == 4 ? 2 : (U_NG == 2 ? 1 : 0)));

constexpr size_t MiB = 1u << 20;
constexpr size_t WS_CTL = 0, CTL_ZERO_BYTES = 64 * 1024;
constexpr size_t WS_WIN = 1 * MiB;
constexpr size_t WS_WA = 12 * MiB;
constexpr size_t WS_WB = 13 * MiB;
constexpr size_t WS_WOUT = 14 * MiB;
constexpr size_t WS_WQF = 16 * MiB;
constexpr size_t WS_U8 = 20 * MiB;
constexpr size_t WS_V8 = 36 * MiB;
constexpr size_t WS_SU = 52 * MiB;
constexpr size_t WS_SV = 52 * MiB + 65536;
constexpr size_t WS_AK = 53 * MiB;
constexpr size_t WS_DEC = 84 * MiB;
constexpr size_t WS_ALR = 85 * MiB;
constexpr size_t WS_N1 = 87 * MiB;
constexpr size_t WS_P = 151 * MiB;
constexpr size_t WS_W8 = 472 * MiB;
constexpr size_t WS_N18 = 478 * MiB;
constexpr size_t WS_END = 510 * MiB;
constexpr size_t P_N2 = 128 * MiB;
constexpr size_t P_SC = 0, P_IDX = 256 * MiB, P_GATE = 272 * MiB, P_X8 = 288 * MiB;

constexpr int CW_BAR = 4096;

constexpr int RING_BYTES = 131072;
constexpr int LDSCTL_OFF = RING_BYTES, MISC_OFF = LDSCTL_OFF + 320;
constexpr int LDS_BYTES = 147456;
constexpr int NWAVES = 8;

__device__ __forceinline__ unsigned pk2(float lo, float hi) { const f32x2 v = {lo, hi}; const bf16x2_t b = __builtin_convertvector(v, bf16x2_t); return __builtin_bit_cast(unsigned, b); }
__device__ __forceinline__ unsigned f2bf(float f) { return pk2(f, 0.f) & 0xffffu; }
__device__ __forceinline__ float bflo(unsigned w) { return __builtin_bit_cast(float, w << 16); }
__device__ __forceinline__ float bfhi(unsigned w) { return __builtin_bit_cast(float, w & 0xffff0000u); }
__device__ __forceinline__ float bf1(bf16_t h) { return __builtin_bit_cast(float, ((unsigned)h) << 16); }
__device__ __forceinline__ float sigmoidf_(float x) { return __builtin_amdgcn_rcpf(1.f + __expf(-x)); }
__device__ __forceinline__ float gelu_tanh(float x) { const float y = 1.5957691216057308f * (x + 0.044715f * x * x * x); return x * sigmoidf_(y); }
__device__ __forceinline__ float siluf_(float x) { return x * sigmoidf_(x); }
__device__ __forceinline__ float wave_sum(float v) {
#pragma unroll
    for (int o = 1; o < 64; o <<= 1) v += __shfl_xor(v, o);
    return v;
}
#define LDS_WAIT() asm volatile("s_waitcnt lgkmcnt(0)" ::: "memory")
#define VM_WAIT() asm volatile("s_waitcnt vmcnt(0)" ::: "memory")

__device__ __forceinline__ int lane_now() { int z = 0; asm volatile("" : "+s"(z)); return (int)__builtin_amdgcn_mbcnt_hi(~0u, __builtin_amdgcn_mbcnt_lo(~0u, (unsigned)z)); }
namespace pg8 {
constexpr int BM = 256, BK = 64, HALF = 128, HTB = HALF * BK * 2, STAGE_BYTES = 8 * HTB, NXCD = 8, WGM = 8;
__host__ __device__ __forceinline__ int lds_byte(int r, int c) { const int st = (r >> 4) * 2 + (c >> 5), rr = r & 15, cc = c & 31, ob = rr * 64 + cc * 2; return st * 1024 + (ob ^ (((ob >> 9) & 1) << 5)); }
__host__ __device__ __forceinline__ void stage_rc(int b, int& R, int& C) { const int st = b / 1024, sb = b % 1024, swz = sb ^ (((sb >> 9) & 1) << 5); R = (st >> 1) * 16 + swz / 64; C = (st & 1) * 32 + (swz % 64) / 2; }
__host__ __device__ __forceinline__ int perm32(int rho) { const int n = rho >> 4, i = rho & 15; return 8 * (i >> 2) + 4 * n + (i & 3); }

struct Unit { int pm, pn; };
struct Gemm { const bf16_t* A; const bf16_t* Bt; int M, N, K, lda; int sa = 0, sb = 0; };

struct StaticOrder {
    int nM, nN, nwg, G, c;
    __host__ __device__ void init(int M, int N, int G_, int c_) { nM = M / BM; nN = N / BM; nwg = nM * nN; G = G_; c = c_; }
    __host__ __device__ bool next(int i, Unit& u) const {
        const long L = (long)i * G + c; if (L >= nwg) return false;
        int wgid = (int)L; { const int q = nwg / NXCD, r = nwg % NXCD, xcd = wgid % NXCD, off = wgid / NXCD; wgid = (xcd < r ? xcd * (q + 1) : r * (q + 1) + (xcd - r) * q) + off; }
        const int nig = WGM * nN, gid = wgid / nig, fm = gid * WGM, gsz = (nM - fm) < WGM ? (nM - fm) : WGM;
        u.pm = fm + ((wgid % nig) % gsz); u.pn = (wgid % nig) / gsz; return true;
    }
    __device__ __forceinline__ void a_ready(const Unit&) const {}
    __device__ __forceinline__ void done(const Unit&) const {}
};

template <class Epi, class Sched, bool ALIGN_EPI = false, bool SP2 = false, bool F8 = false, bool MID = false>
__device__ __forceinline__ void gemm_phase(LAS unsigned char* lds, const Gemm g, const Sched& S, const Epi& E, int wave_id) {
    const int wid = wave_id, lane = lane_now(), tid = wid * 64 + lane, wr = wid >> 2, wc = wid & 3, fr = lane & 15, fq = lane >> 4;
    const int K = g.K, nt = K / BK, lda = g.lda; const int scA = g.sa, scB = g.sb; (void)scA; (void)scB;
    unsigned voffA[2], voffB[2];
#pragma unroll
    for (int i = 0; i < 2; ++i) { int R, C; stage_rc(tid * 16 + i * 8192, R, C); const int Rb = Epi::PERM ? ((R & ~31) + perm32(R & 31)) : R;
        voffA[i] = (unsigned)(R * lda + C) * 2u; voffB[i] = (unsigned)(Rb * K + C) * 2u; }
    const size_t kstep = (size_t)(BK * 2);
    const size_t hstepA = (size_t)HALF * lda * 2, hstepB = (size_t)HALF * K * 2;
    const size_t tstepA = 2 * hstepA, tstepB = 2 * hstepB;
    const unsigned ldsw = (unsigned)wid * 1024u; const unsigned ldsbase = (unsigned)(__UINTPTR_TYPE__)lds + ldsw;
    const int aoff = lds_byte(wr * 64 + fr, fq * 8), boff = lds_byte(wc * 32 + fr, fq * 8);
#define PG8_SA(b, h) (((b) * 2 + (h)) * HTB)
#define PG8_SB(b, h) ((4 + (b) * 2 + (h)) * HTB)
#define PG8_STAGE(bufoff, gbase, voff) do { _Pragma("unroll") for (int _i = 0; _i < 2; ++_i) \
        asm volatile("s_mov_b32 m0, %2\n\ts_nop 0\n\tglobal_load_lds_dwordx4 %0, %1" :: "v"((voff)[_i]), "s"((const char*)(gbase)), "s"(ldsbase + (unsigned)((bufoff) + _i * 8192)) : "memory", "m0"); } while (0)
#define PG8_LDA(dst, b, h) do { _Pragma("unroll") for (int m = 0; m < 4; ++m) _Pragma("unroll") for (int k = 0; k < 2; ++k) dst[m][k] = *(const LAS bf16x8*)(lds + PG8_SA(b, h) + aoff + m * 2048 + k * 1024); } while (0)
#define PG8_LDB(dst, b, h) do { _Pragma("unroll") for (int n = 0; n < 2; ++n) _Pragma("unroll") for (int k = 0; k < 2; ++k) dst[n][k] = *(const LAS bf16x8*)(lds + PG8_SB(b, h) + boff + n * 2048 + k * 1024); } while (0)
#define PG8_CAT(x) __builtin_shufflevector(__builtin_bit_cast(i32x4, (x)[0]), __builtin_bit_cast(i32x4, (x)[1]), 0, 1, 2, 3, 4, 5, 6, 7)
#define PG8_MMA(ai, bj, At, Bt) do { __builtin_amdgcn_s_setprio(1); if constexpr (F8) { _Pragma("unroll") for (int m = 0; m < 4; ++m) _Pragma("unroll") for (int n = 0; n < 2; ++n) \
        acc[ai][bj][m][n] = __builtin_amdgcn_mfma_scale_f32_16x16x128_f8f6f4(PG8_CAT(Bt[n]), PG8_CAT(At[m]), acc[ai][bj][m][n], 0, 0, 0, scB, 0, scA); } else { \
        _Pragma("unroll") for (int m = 0; m < 4; ++m) _Pragma("unroll") for (int n = 0; n < 2; ++n) _Pragma("unroll") for (int k = 0; k < 2; ++k) \
        acc[ai][bj][m][n] = __builtin_amdgcn_mfma_f32_16x16x32_bf16(Bt[n][k], At[m][k], acc[ai][bj][m][n], 0, 0, 0); } __builtin_amdgcn_s_setprio(0); } while (0)
#define PG8_WAIT_V(n) asm volatile("s_waitcnt vmcnt(" #n ")" ::: "memory")
#define PG8_WAIT_L(n) asm volatile("s_waitcnt lgkmcnt(" #n ")" ::: "memory")
#define PG8_BAR __builtin_amdgcn_s_barrier()
#define PG8_SCHED __builtin_amdgcn_sched_barrier(0)
    Unit cur, nxt; int ui = 0;
    if (!S.next(0, cur)) return;
    f32x4 acc[2][2][4][2];
#pragma unroll
    for (int a = 0; a < 2; ++a)
#pragma unroll
        for (int b = 0; b < 2; ++b)
#pragma unroll
            for (int m = 0; m < 4; ++m)
#pragma unroll
                for (int n = 0; n < 2; ++n) acc[a][b][m][n] = (f32x4){0.f, 0.f, 0.f, 0.f};
    bf16x8 At[4][2], B0[2][2], B1[2][2];
    const char* cA = (const char*)g.A + (size_t)cur.pm * tstepA; const char* cB = (const char*)g.Bt + (size_t)cur.pn * tstepB;
    S.a_ready(cur);
    if constexpr (SP2) {
        PG8_STAGE(PG8_SB(0, 0), cB, voffB); PG8_STAGE(PG8_SB(0, 1), cB + hstepB, voffB); PG8_STAGE(PG8_SA(0, 0), cA, voffA); PG8_STAGE(PG8_SA(0, 1), cA + hstepA, voffA);
        if (wr == 1) PG8_BAR;
        PG8_WAIT_V(2); PG8_BAR;
        PG8_STAGE(PG8_SB(1, 0), cB + kstep, voffB); PG8_STAGE(PG8_SA(1, 0), cA + kstep, voffA); PG8_STAGE(PG8_SB(1, 1), cB + hstepB + kstep, voffB);
        PG8_WAIT_V(6); PG8_BAR;
    } else {
        PG8_STAGE(PG8_SB(0, 0), cB, voffB); PG8_STAGE(PG8_SA(0, 0), cA, voffA); PG8_STAGE(PG8_SB(0, 1), cB + hstepB, voffB); PG8_STAGE(PG8_SA(0, 1), cA + hstepA, voffA);
        if (wr == 1) PG8_BAR;
        PG8_WAIT_V(4); PG8_BAR;
        PG8_STAGE(PG8_SB(1, 0), cB + kstep, voffB); PG8_STAGE(PG8_SA(1, 0), cA + kstep, voffA); PG8_STAGE(PG8_SB(1, 1), cB + hstepB + kstep, voffB);
        PG8_WAIT_V(6); PG8_BAR;
    }
    for (;;) {
        const bool has_next = S.next(ui + 1, nxt);
        const char* nA = has_next ? (const char*)g.A + (size_t)nxt.pm * tstepA : cA; const char* nB = has_next ? (const char*)g.Bt + (size_t)nxt.pn * tstepB : cB;
#pragma nounroll
        for (int t = 0; t < nt; t += 2) {
            if constexpr (MID) { if (t == (nt >> 1)) E.mid(acc, cur, wr, wc); }
            const bool last = (t == nt - 2);
            const char* a1 = cA + (size_t)(t + 1) * kstep;
            const char* a2 = last ? nA : cA + (size_t)(t + 2) * kstep; const char* b2 = last ? nB : cB + (size_t)(t + 2) * kstep;
            const char* a3 = a2 + kstep; const char* b3 = b2 + kstep;
            if (last && has_next) S.a_ready(nxt);
            if constexpr (SP2) {
            PG8_LDB(B0, 0, 0); PG8_LDB(B1, 0, 1); PG8_SCHED; PG8_LDA(At, 0, 0); PG8_STAGE(PG8_SA(1, 1), a1 + hstepA, voffA);
            PG8_WAIT_V(8); PG8_WAIT_L(0); PG8_BAR; PG8_MMA(0, 0, At, B0); PG8_MMA(0, 1, At, B1); PG8_BAR; PG8_SCHED;
            PG8_LDA(At, 0, 1); PG8_STAGE(PG8_SB(0, 0), b2, voffB); PG8_STAGE(PG8_SB(0, 1), b2 + hstepB, voffB); PG8_STAGE(PG8_SA(0, 0), a2, voffA);
            PG8_WAIT_V(8); PG8_WAIT_L(0); PG8_BAR; PG8_MMA(1, 0, At, B0); PG8_MMA(1, 1, At, B1); PG8_BAR; PG8_SCHED;
            PG8_LDB(B0, 1, 0); PG8_LDB(B1, 1, 1); PG8_SCHED; PG8_LDA(At, 1, 0); PG8_STAGE(PG8_SA(0, 1), a2 + hstepA, voffA);
            PG8_WAIT_V(8); PG8_WAIT_L(0); PG8_BAR; PG8_MMA(0, 0, At, B0); PG8_MMA(0, 1, At, B1); PG8_BAR; PG8_SCHED;
            PG8_LDA(At, 1, 1); PG8_STAGE(PG8_SB(1, 0), b3, voffB); PG8_STAGE(PG8_SB(1, 1), b3 + hstepB, voffB); PG8_STAGE(PG8_SA(1, 0), a3, voffA);
            PG8_WAIT_V(8); PG8_WAIT_L(0); PG8_BAR; PG8_MMA(1, 0, At, B0); PG8_MMA(1, 1, At, B1); PG8_BAR; PG8_SCHED;
            } else {
            PG8_LDB(B0, 0, 0); PG8_SCHED; PG8_LDA(At, 0, 0); PG8_STAGE(PG8_SA(1, 1), a1 + hstepA, voffA);
            PG8_WAIT_L(8); PG8_BAR; PG8_WAIT_L(0); PG8_MMA(0, 0, At, B0); PG8_BAR; PG8_SCHED;
            PG8_LDB(B1, 0, 1); PG8_STAGE(PG8_SB(0, 0), b2, voffB);
            PG8_BAR; PG8_WAIT_L(0); PG8_MMA(0, 1, At, B1); PG8_BAR;
            PG8_LDA(At, 0, 1); PG8_STAGE(PG8_SA(0, 0), a2, voffA);
            PG8_BAR; PG8_WAIT_L(0); PG8_MMA(1, 0, At, B0); PG8_BAR; PG8_SCHED;
            PG8_STAGE(PG8_SB(0, 1), b2 + hstepB, voffB);
            PG8_WAIT_V(6); PG8_BAR; PG8_MMA(1, 1, At, B1); PG8_BAR;
            PG8_LDB(B0, 1, 0); PG8_SCHED; PG8_LDA(At, 1, 0); PG8_STAGE(PG8_SA(0, 1), a2 + hstepA, voffA);
            PG8_WAIT_L(8); PG8_BAR; PG8_WAIT_L(0); PG8_MMA(0, 0, At, B0); PG8_BAR; PG8_SCHED;
            PG8_LDB(B1, 1, 1); PG8_STAGE(PG8_SB(1, 0), b3, voffB);
            PG8_BAR; PG8_WAIT_L(0); PG8_MMA(0, 1, At, B1); PG8_BAR;
            PG8_LDA(At, 1, 1); PG8_STAGE(PG8_SA(1, 0), a3, voffA);
            PG8_BAR; PG8_WAIT_L(0); PG8_MMA(1, 0, At, B0); PG8_BAR; PG8_SCHED;
            PG8_STAGE(PG8_SB(1, 1), b3 + hstepB, voffB);
            PG8_WAIT_V(6); PG8_BAR; PG8_MMA(1, 1, At, B1); PG8_BAR;
            }
        }
        if constexpr (ALIGN_EPI) { if (wr == 0) PG8_BAR; }
        E(acc, cur, wr, wc, fr, fq); S.done(cur);
        if (!has_next) break;
#pragma unroll
        for (int a = 0; a < 2; ++a)
#pragma unroll
            for (int b = 0; b < 2; ++b)
#pragma unroll
                for (int m = 0; m < 4; ++m)
#pragma unroll
                    for (int n = 0; n < 2; ++n) acc[a][b][m][n] = (f32x4){0.f, 0.f, 0.f, 0.f};
        cur = nxt; cA = nA; cB = nB; ++ui;
        if constexpr (ALIGN_EPI) { if (wr == 1) PG8_BAR; }
    }
    PG8_WAIT_V(0);
    if constexpr (!ALIGN_EPI) { if (wr == 0) PG8_BAR; }
    PG8_BAR;
#undef PG8_SA
#undef PG8_SB
#undef PG8_STAGE
#undef PG8_LDA
#undef PG8_LDB
#undef PG8_MMA
#undef PG8_CAT
#undef PG8_WAIT_V
#undef PG8_WAIT_L
#undef PG8_BAR
#undef PG8_SCHED
}

__device__ __forceinline__ u32x4 pack8(f32x4 v0, f32x4 v1) { u32x4 w; w.x = pk2(v0[0], v0[1]); w.y = pk2(v0[2], v0[3]); w.z = pk2(v1[0], v1[1]); w.w = pk2(v1[2], v1[3]); return w; }
__device__ __forceinline__ void unpack8(u32x4 w, f32x4& v0, f32x4& v1) { v0 = (f32x4){bflo(w.x), bfhi(w.x), bflo(w.y), bfhi(w.y)}; v1 = (f32x4){bflo(w.z), bfhi(w.z), bflo(w.w), bfhi(w.w)}; }

struct EpiProj {
    static constexpr bool PERM = true;
    bf16_t* P; float* ALR; int pn0;
    __device__ __forceinline__ void operator()(const f32x4 (&acc)[2][2][4][2], const Unit& u, int wr, int wc, int fr, int fq) const {
        { const int ln = lane_now(); fr = ln & 15; fq = ln >> 4; }
        const int row0 = u.pm * BM + wr * 64 + fr; int pn = u.pn + pn0; const int cl = wc * 32 + 8 * fq;
        if (pn == 10) {
            if (wc == 0 && fq < 2) {
#pragma unroll
                for (int ai = 0; ai < 2; ++ai)
#pragma unroll
                    for (int m = 0; m < 4; ++m) { float* rp = ALR + (size_t)(row0 + ai * HALF + m * 16) * 16 + 8 * fq;
                        *(f32x4*)rp = acc[ai][0][m][0]; *(f32x4*)(rp + 4) = acc[ai][0][m][1]; }
            }
            return;
        }
        if (pn > 10) --pn;
        const int mode = pn < 8 ? 0 : (pn < 12 ? 1 : 2);
#pragma unroll
        for (int ai = 0; ai < 2; ++ai)
#pragma unroll
            for (int m = 0; m < 4; ++m) { bf16_t* rowp = P + (size_t)(row0 + ai * HALF + m * 16) * PLD + pn * BM + cl;
#pragma unroll
                for (int bj = 0; bj < 2; ++bj) { f32x4 v0 = acc[ai][bj][m][0], v1 = acc[ai][bj][m][1];
                    if (mode == 1) {
#pragma unroll
                        for (int i = 0; i < 4; ++i) { v0[i] = gelu_tanh(v0[i]); v1[i] = gelu_tanh(v1[i]); }
                    } else if (mode == 2) {
#pragma unroll
                        for (int i = 0; i < 4; ++i) { v0[i] = sigmoidf_(v0[i]); v1[i] = sigmoidf_(v1[i]); }
                    }
                    *(u32x4*)(rowp + bj * HALF) = pack8(v0, v1); } }
    }
};
struct EpiBrA {
    static constexpr bool PERM = true;
    bf16_t* P;
    __device__ __forceinline__ void operator()(const f32x4 (&acc)[2][2][4][2], const Unit& u, int wr, int wc, int fr, int fq) const {
        const int row0 = u.pm * BM + wr * 64 + fr; const int c0 = u.pn * BM + wc * 32 + 8 * fq;
#pragma unroll
        for (int ai = 0; ai < 2; ++ai)
#pragma unroll
            for (int m = 0; m < 4; ++m) { bf16_t* rowp = P + (size_t)(row0 + ai * HALF + m * 16) * PLD;
#pragma unroll
                for (int bj = 0; bj < 2; ++bj) { const int c = c0 + bj * HALF; f32x4 g0, g1; unpack8(*(const u32x4*)(rowp + PC_GA + c), g0, g1);
                    *(u32x4*)(rowp + PC_MRG + c) = pack8(acc[ai][bj][m][0] * g0, acc[ai][bj][m][1] * g1); } }
    }
};
struct EpiBrB {
    static constexpr bool PERM = true;
    bf16_t* P;
    __device__ __forceinline__ void operator()(const f32x4 (&acc)[2][2][4][2], const Unit& u, int wr, int wc, int fr, int fq) const {
        const int row0 = u.pm * BM + wr * 64 + fr; const int c0 = u.pn * BM + wc * 32 + 8 * fq;
#pragma unroll
        for (int ai = 0; ai < 2; ++ai)
#pragma unroll
            for (int m = 0; m < 4; ++m) { bf16_t* rowp = P + (size_t)(row0 + ai * HALF + m * 16) * PLD;
#pragma unroll
                for (int bj = 0; bj < 2; ++bj) { const int c = c0 + bj * HALF; f32x4 g0, g1, p0, p1; unpack8(*(const u32x4*)(rowp + PC_GB + c), g0, g1); unpack8(*(const u32x4*)(rowp + PC_MRG + c), p0, p1);
                    *(u32x4*)(rowp + PC_MRG + c) = pack8(p0 + acc[ai][bj][m][0] * g0, p1 + acc[ai][bj][m][1] * g1); } }
    }
};
struct EpiBrAB {
    static constexpr bool PERM = true;
    bf16_t* P;
    __device__ __forceinline__ void mid(f32x4 (&acc)[2][2][4][2], const Unit& u, int wr, int wc) const {
        const int ln = lane_now(), fr = ln & 15, fq = ln >> 4;
        const int row0 = u.pm * BM + wr * 64 + fr; const int c0 = u.pn * BM + wc * 32 + 8 * fq;
#pragma unroll
        for (int ai = 0; ai < 2; ++ai)
#pragma unroll
            for (int m = 0; m < 4; ++m) { const bf16_t* rowp = P + (size_t)(row0 + ai * HALF + m * 16) * PLD;
#pragma unroll
                for (int bj = 0; bj < 2; ++bj) { const int c = c0 + bj * HALF; f32x4 a0, a1, b0, b1; unpack8(*(const u32x4*)(rowp + PC_GA + c), a0, a1); unpack8(*(const u32x4*)(rowp + PC_GB + c), b0, b1);
#pragma unroll
                    for (int i = 0; i < 4; ++i) { acc[ai][bj][m][0][i] *= a0[i] * __builtin_amdgcn_rcpf(fmaxf(b0[i], 1e-20f)); acc[ai][bj][m][1][i] *= a1[i] * __builtin_amdgcn_rcpf(fmaxf(b1[i], 1e-20f)); } } }
    }
    __device__ __forceinline__ void operator()(const f32x4 (&acc)[2][2][4][2], const Unit& u, int wr, int wc, int fr, int fq) const {
        { const int ln = lane_now(); fr = ln & 15; fq = ln >> 4; }
        const int row0 = u.pm * BM + wr * 64 + fr; const int c0 = u.pn * BM + wc * 32 + 8 * fq;
#pragma unroll
        for (int ai = 0; ai < 2; ++ai)
#pragma unroll
            for (int m = 0; m < 4; ++m) { bf16_t* rowp = P + (size_t)(row0 + ai * HALF + m * 16) * PLD;
#pragma unroll
                for (int bj = 0; bj < 2; ++bj) { const int c = c0 + bj * HALF; f32x4 g0, g1; unpack8(*(const u32x4*)(rowp + PC_GB + c), g0, g1);
                    *(u32x4*)(rowp + PC_MRG + c) = pack8(acc[ai][bj][m][0] * g0, acc[ai][bj][m][1] * g1); } }
    }
};
struct EpiOut {
    static constexpr bool PERM = true;
    bf16_t* O;
    __device__ __forceinline__ void operator()(const f32x4 (&acc)[2][2][4][2], const Unit& u, int wr, int wc, int fr, int fq) const {
        const int row0 = u.pm * BM + wr * 64 + fr; const int c0 = u.pn * BM + wc * 32 + 8 * fq;
#pragma unroll
        for (int ai = 0; ai < 2; ++ai)
#pragma unroll
            for (int m = 0; m < 4; ++m) { const size_t ro = (size_t)(row0 + ai * HALF + m * 16) * D;
#pragma unroll
                for (int bj = 0; bj < 2; ++bj) *(u32x4*)(O + ro + c0 + bj * HALF) = pack8(acc[ai][bj][m][0], acc[ai][bj][m][1]); }
    }
};
struct EpiScores {
    static constexpr bool PERM = true;
    bf16_t* SC;
    __device__ __forceinline__ void operator()(const f32x4 (&acc)[2][2][4][2], const Unit& u, int wr, int wc, int fr, int fq) const {
        const int tb0 = u.pm * 16 + wr * 4; const int cq0 = (u.pn * BM + wc * 32 + 8 * fq) >> 3;
#pragma unroll
        for (int ai = 0; ai < 2; ++ai)
#pragma unroll
            for (int m = 0; m < 4; ++m) { bf16_t* bp = SC + ((size_t)(tb0 + ai * 8 + m) * 256) * 128 + fr * 8;
#pragma unroll
                for (int bj = 0; bj < 2; ++bj) *(u32x4*)(bp + (size_t)(cq0 + bj * 16) * 128) = pack8(acc[ai][bj][m][0], acc[ai][bj][m][1]); }
    }
};
}

#define XB_TMO      128
#define XB_XCNT(j)  (256  + 64 * (j))
#define XB_XSUB(j)  (1280 + 64 * (j))
#define XB_XGEN(j)  (2304 + 64 * (j))
#define XB_TOP      3328
#define XB_TOPGEN   3392
#define XCD_BAR_WORDS 3456
#define XB_SPIN_CAP (1u << 18)
__device__ __forceinline__ unsigned xb_ld(unsigned* p)              { return __hip_atomic_load(p, __ATOMIC_RELAXED, __HIP_MEMORY_SCOPE_AGENT); }
__device__ __forceinline__ unsigned xb_add(unsigned* p, unsigned v) { return __hip_atomic_fetch_add(p, v, __ATOMIC_RELAXED, __HIP_MEMORY_SCOPE_AGENT); }
__device__ __forceinline__ unsigned xb_xcc_id() { return (unsigned)__builtin_amdgcn_s_getreg((3 << 11) | 20) & 0xFu; }
#define XB_SPIN(cond, bar) do { unsigned _sp = 0; while (cond) { __builtin_amdgcn_s_sleep(1); \
    if ((++_sp & 255u) == 0u) { if (xb_ld(&(bar)[XB_TMO])) break; if (_sp > XB_SPIN_CAP) { atomicAdd(&(bar)[XB_TMO], 1u); break; } } } } while (0)
struct XcdBarrier { unsigned* bar; unsigned x; volatile LAS unsigned* st; int wave; };
__device__ __forceinline__ XcdBarrier xcd_barrier_post(unsigned* bar, volatile LAS unsigned* st, int wave) {
    XcdBarrier b; b.bar = bar; b.x = xb_xcc_id(); b.st = st; b.wave = wave;
    if (wave == 0 && lane_now() == 0) (void)xb_add(&bar[XB_XCNT(b.x)], 1u);
    return b;
}
__device__ __forceinline__ void xcd_barrier_complete(unsigned* bar, unsigned x, unsigned& nloc, unsigned& nx) {
    const unsigned G = gridDim.x * gridDim.y * gridDim.z;
    unsigned sum, cnt, mine, sp = 0u;
    for (;;) {
        sum = 0u; cnt = 0u; mine = 0u;
#pragma unroll
        for (unsigned j = 0; j < 16; ++j) { const unsigned c = xb_ld(&bar[XB_XCNT(j)]); sum += c; cnt += (c > 0u) ? 1u : 0u; mine = (j == x) ? c : mine; }
        if (sum == G) break;
        __builtin_amdgcn_s_sleep(1);
        if ((++sp & 255u) == 0u) { if (xb_ld(&bar[XB_TMO])) break; if (sp > XB_SPIN_CAP) { atomicAdd(&bar[XB_TMO], 1u); break; } }
    }
    nloc = mine > 0u ? mine : 1u; nx = cnt > 0u ? cnt : 1u;
}
__device__ __forceinline__ void xcd_barrier(const XcdBarrier& b) {
    asm volatile("s_waitcnt vmcnt(0)" ::: "memory");
    __syncthreads();
    if (b.wave == 0 && lane_now() == 0) {
        unsigned* bar = b.bar;
        __builtin_amdgcn_s_waitcnt(0);
        unsigned nloc = b.st[0], nx = b.st[1];
        if (nloc == 0u) { xcd_barrier_complete(bar, b.x, nloc, nx); b.st[0] = nloc; b.st[1] = nx; }
        const unsigned old = xb_add(&bar[XB_XSUB(b.x)], 1u);
        const unsigned gen = old / nloc;
        if (old + 1u == (gen + 1u) * nloc) {
            __builtin_amdgcn_fence(__ATOMIC_RELEASE, "agent");
            asm volatile("s_waitcnt vmcnt(0)" ::: "memory");
            const unsigned og = xb_add(&bar[XB_TOP], 1u);
            const unsigned tg = og / nx;
            if (og + 1u == (tg + 1u) * nx) xb_add(&bar[XB_TOPGEN], 1u);
            else XB_SPIN(xb_ld(&bar[XB_TOPGEN]) == tg, bar);
            __builtin_amdgcn_fence(__ATOMIC_ACQUIRE, "agent");
            xb_add(&bar[XB_XGEN(b.x)], 1u);
            asm volatile("s_waitcnt vmcnt(0)" ::: "memory");
        } else {
            XB_SPIN(xb_ld(&bar[XB_XGEN(b.x)]) == gen, bar);
            __builtin_amdgcn_fence(__ATOMIC_ACQUIRE, "agent");
            asm volatile("s_waitcnt vmcnt(0)" ::: "memory");
        }
    }
    __syncthreads();
}

struct Args {
    const float* in[20]; float* out; unsigned char* ws; int ph_lo, ph_hi, li, pad;
};
enum { I_X = 0, I_N1G, I_WIN, I_WGU, I_BG, I_GLAG, I_SLNG, I_SLNB, I_SW, I_SB, I_WBA, I_WBB, I_WOUT, I_N2G, I_WQ, I_K1, I_K2, I_PU, I_PV, I_FG };

struct Frame {
    LAS unsigned char* lds;
    int tid, lane, wave, G, bid;
};

__device__ __forceinline__ float clamp448(float v) { return __builtin_amdgcn_fmed3f(v, -448.f, 448.f); }
template <int MODE, bool F8 = false>
__device__ __forceinline__ void p0_transpose_item(const float* W, int K, int Nsrc, int Ndst, bf16_t* WT, LAS float* scr, int item, int lane, float sc8 = 1.f, int ldk = 0) {
    if (ldk == 0) ldk = K;
    const int nblk = Ndst / 32, kb = item / nblk, nb = item % nblk, k0 = 64 * kb, n0 = 32 * nb;
    const int nd = n0 + (lane & 31);
    int sc = nd; bool valid = true;
    if (MODE == 1) { if (nd < 2048) sc = nd; else if (nd < 2560) sc = nd + 16; else if (nd < 2576) sc = 2048 + (nd - 2560); else if (nd < 2816) { sc = 0; valid = false; } else sc = nd - 240; }
#pragma unroll 8
    for (int i = 0; i < 32; ++i) { const int kk = 2 * i + (lane >> 5); const float v = valid ? W[(size_t)(k0 + kk) * Nsrc + sc] : 0.f; scr[kk * 33 + (lane & 31)] = v; }
    LDS_WAIT(); asm volatile("" ::: "memory");
    if (F8) {
        const int c = lane & 3;
#pragma unroll
        for (int j = 0; j < 2; ++j) { const int n = (lane >> 2) + 16 * j; const LAS float* s = scr + (16 * c) * 33 + n; u32x4 o;
#pragma unroll
            for (int q = 0; q < 4; ++q) { int w = 0; w = __builtin_amdgcn_cvt_pk_fp8_f32(clamp448(s[(4 * q) * 33] * sc8), clamp448(s[(4 * q + 1) * 33] * sc8), w, false);
                w = __builtin_amdgcn_cvt_pk_fp8_f32(clamp448(s[(4 * q + 2) * 33] * sc8), clamp448(s[(4 * q + 3) * 33] * sc8), w, true); o[q] = (unsigned)w; }
            *(u32x4*)((unsigned char*)WT + (size_t)(n0 + n) * ldk + k0 + 16 * c) = o; }
    } else {
    const int c = lane & 7;
#pragma unroll
    for (int j = 0; j < 4; ++j) { const int n = (lane >> 3) + 8 * j; const LAS float* s = scr + (8 * c) * 33 + n;
        u32x4 o; o.x = pk2(s[0 * 33], s[1 * 33]); o.y = pk2(s[2 * 33], s[3 * 33]); o.z = pk2(s[4 * 33], s[5 * 33]); o.w = pk2(s[6 * 33], s[7 * 33]);
        *(u32x4*)(WT + (size_t)(n0 + n) * ldk + k0 + 8 * c) = o; }
    }
    LDS_WAIT(); asm volatile("" ::: "memory");
}
template <int OM, int NB>
__device__ __forceinline__ void rms_rows_to_bf16(int lane, const float* x0, size_t xstride, const float* g, bf16_t* o0, size_t ostride, unsigned* o80 = nullptr, size_t o8stride = 0, const bf16_t* add0 = nullptr, size_t addstride = 0) {
    f32x4 v[NB][4]; float s[NB];
#pragma unroll
    for (int b = 0; b < NB; ++b) { const float* xr = x0 + b * xstride + 8 * lane;
#pragma unroll
        for (int j = 0; j < 2; ++j) { v[b][2 * j] = *(const f32x4*)(xr + 512 * j); v[b][2 * j + 1] = *(const f32x4*)(xr + 512 * j + 4); } }
    if (add0) {
        u32x4 ad[NB][2];
#pragma unroll
        for (int b = 0; b < NB; ++b) { const bf16_t* ar = add0 + b * addstride + 8 * lane;
#pragma unroll
            for (int j = 0; j < 2; ++j) ad[b][j] = *(const u32x4*)(ar + 512 * j); }
#pragma unroll
        for (int b = 0; b < NB; ++b)
#pragma unroll
            for (int j = 0; j < 2; ++j) { v[b][2 * j] = v[b][2 * j] + (f32x4){bflo(ad[b][j].x), bfhi(ad[b][j].x), bflo(ad[b][j].y), bfhi(ad[b][j].y)};
                v[b][2 * j + 1] = v[b][2 * j + 1] + (f32x4){bflo(ad[b][j].z), bfhi(ad[b][j].z), bflo(ad[b][j].w), bfhi(ad[b][j].w)}; }
    }
#pragma unroll
    for (int b = 0; b < NB; ++b) { s[b] = 0.f;
#pragma unroll
        for (int j = 0; j < 4; ++j) s[b] += (v[b][j].x * v[b][j].x + v[b][j].y * v[b][j].y) + (v[b][j].z * v[b][j].z + v[b][j].w * v[b][j].w); }
#pragma unroll
    for (int o = 1; o < 64; o <<= 1) {
#pragma unroll
        for (int b = 0; b < NB; ++b) s[b] += __shfl_xor(s[b], o); }
    const float* gr = g + 8 * lane;
#pragma unroll
    for (int b = 0; b < NB; ++b) { const float rstd = 1.f / sqrtf(s[b] * (1.f / D) + EPS);
#pragma unroll
        for (int j = 0; j < 2; ++j) { const f32x4 y0 = v[b][2 * j] * rstd * *(const f32x4*)(gr + 512 * j), y1 = v[b][2 * j + 1] * rstd * *(const f32x4*)(gr + 512 * j + 4);
            const u32x4 o = pg8::pack8(y0, y1);
            if (OM & 1) *(u32x4*)(o0 + b * ostride + 512 * j + 8 * lane) = o;
            if (OM == 3) { u32x2 w8;
#pragma unroll
                for (int h = 0; h < 2; ++h) { int w = 0; w = __builtin_amdgcn_cvt_pk_fp8_f32(clamp448(bflo(o[2 * h]) * 16.f), clamp448(bfhi(o[2 * h]) * 16.f), w, false);
                    w = __builtin_amdgcn_cvt_pk_fp8_f32(clamp448(bflo(o[2 * h + 1]) * 16.f), clamp448(bfhi(o[2 * h + 1]) * 16.f), w, true); w8[h] = (unsigned)w; }
                *(u32x2*)(o80 + b * o8stride + 128 * j + 2 * lane) = w8; }
            if (OM == 2) { u32x2 w8; int w = 0;
                w = __builtin_amdgcn_cvt_pk_fp8_f32(clamp448(y0.x * 16.f), clamp448(y0.y * 16.f), w, false); w = __builtin_amdgcn_cvt_pk_fp8_f32(clamp448(y0.z * 16.f), clamp448(y0.w * 16.f), w, true); w8.x = (unsigned)w;
                w = 0; w = __builtin_amdgcn_cvt_pk_fp8_f32(clamp448(y1.x * 16.f), clamp448(y1.y * 16.f), w, false); w = __builtin_amdgcn_cvt_pk_fp8_f32(clamp448(y1.z * 16.f), clamp448(y1.w * 16.f), w, true); w8.y = (unsigned)w;
                *(u32x2*)(o80 + b * o8stride + 128 * j + 2 * lane) = w8; } } }
}
__device__ __forceinline__ float wave_max(float v) {
#pragma unroll
    for (int o = 1; o < 64; o <<= 1) v = fmaxf(v, __shfl_xor(v, o));
    return v;
}
template <int NB>
__device__ __forceinline__ void cvt_rows_fp8(int lane, const float* const (&src)[NB], unsigned char* const (&dst16)[NB], float* const (&scale_out)[NB]) {
    f32x4 v[NB][4]; float m[NB];
#pragma unroll
    for (int b = 0; b < NB; ++b) {
#pragma unroll
        for (int j = 0; j < 4; ++j) v[b][j] = *(const GAS f32x4*)(src[b] + 16 * lane + 4 * j); }
#pragma unroll
    for (int b = 0; b < NB; ++b) { m[b] = 0.f;
#pragma unroll
        for (int j = 0; j < 4; ++j) m[b] = fmaxf(m[b], fmaxf(fmaxf(fabsf(v[b][j].x), fabsf(v[b][j].y)), fmaxf(fabsf(v[b][j].z), fabsf(v[b][j].w)))); }
#pragma unroll
    for (int o = 1; o < 64; o <<= 1) {
#pragma unroll
        for (int b = 0; b < NB; ++b) m[b] = fmaxf(m[b], __shfl_xor(m[b], o)); }
#pragma unroll
    for (int b = 0; b < NB; ++b) { const float inv = m[b] > 0.f ? 224.f / m[b] : 0.f, sc = m[b] > 0.f ? m[b] * (1.f / 224.f) : 1.f;
        u32x4 o;
#pragma unroll
        for (int j = 0; j < 4; ++j) { int w = 0; w = __builtin_amdgcn_cvt_pk_fp8_f32(v[b][j].x * inv, v[b][j].y * inv, w, false); w = __builtin_amdgcn_cvt_pk_fp8_f32(v[b][j].z * inv, v[b][j].w * inv, w, true); o[j] = (unsigned)w; }
        *(GAS u32x4*)dst16[b] = o;
        if (lane == 0) *(GAS float*)scale_out[b] = sc; }
}
__device__ __forceinline__ unsigned fp4_code(float t) { const float a = fabsf(t);
    const unsigned c = (unsigned)(a >= 0.25f) + (unsigned)(a >= 0.75f) + (unsigned)(a >= 1.25f) + (unsigned)(a >= 1.75f) + (unsigned)(a >= 2.5f) + (unsigned)(a >= 3.5f) + (unsigned)(a >= 5.f);
    return c | (t < 0.f ? 8u : 0u); }
template <int NB, bool PERMV = false>
__device__ __forceinline__ void cvt_rows_fp4(int lane, const float* const (&src)[NB], unsigned char* const (&dst8)[NB], float* const (&scale_out)[NB]) {
    f32x4 v[NB][4]; float m[NB];
#pragma unroll
    for (int b = 0; b < NB; ++b) {
#pragma unroll
        for (int j = 0; j < 4; ++j) v[b][j] = *(const GAS f32x4*)(src[b] + 16 * lane + 4 * j); }
#pragma unroll
    for (int b = 0; b < NB; ++b) { m[b] = 0.f;
#pragma unroll
        for (int j = 0; j < 4; ++j) m[b] = fmaxf(m[b], fmaxf(fmaxf(fabsf(v[b][j].x), fabsf(v[b][j].y)), fmaxf(fabsf(v[b][j].z), fabsf(v[b][j].w)))); }
#pragma unroll
    for (int o = 1; o < 64; o <<= 1) {
#pragma unroll
        for (int b = 0; b < NB; ++b) m[b] = fmaxf(m[b], __shfl_xor(m[b], o)); }
#pragma unroll
    for (int b = 0; b < NB; ++b) { const float inv = m[b] > 0.f ? 6.f / m[b] : 0.f, sc = m[b] > 0.f ? m[b] * (1.f / 6.f) : 1.f;
        u32x2 o;
#pragma unroll
        for (int h = 0; h < 2; ++h) { unsigned w = 0;
            const f32x4 t0 = v[b][2 * h] * inv, t1 = v[b][2 * h + 1] * inv;
            w = __builtin_amdgcn_cvt_scalef32_pk_fp4_f32(w, t0.x, t0.y, 1.f, 0); w = __builtin_amdgcn_cvt_scalef32_pk_fp4_f32(w, t0.z, t0.w, 1.f, 1);
            w = __builtin_amdgcn_cvt_scalef32_pk_fp4_f32(w, t1.x, t1.y, 1.f, 2); w = __builtin_amdgcn_cvt_scalef32_pk_fp4_f32(w, t1.z, t1.w, 1.f, 3);
            o[h] = w; }
        if (PERMV) { *(GAS unsigned*)(dst8[b] + 16 * ((2 * lane) & 31) + 4 * (lane >> 4)) = o.x; *(GAS unsigned*)(dst8[b] + 16 * ((2 * lane + 1) & 31) + 4 * (lane >> 4)) = o.y; }
        else *(GAS u32x2*)dst8[b] = o;
        if (lane == 0) *(GAS float*)scale_out[b] = sc; }
}
__device__ __forceinline__ void convert_tables(const Frame& F, const Args& A, int wi, int nw) {
    unsigned char* ws = A.ws; const int gw = wi, NGW = nw;
    {
        int mc = gw;
        for (; mc + 3 * NGW < NEXP; mc += 4 * NGW) { const float* src[4]; unsigned char* dst[4]; float* sco[4];
#pragma unroll
            for (int b = 0; b < 4; ++b) { const int e = mc + b * NGW; src[b] = A.in[I_PU] + (size_t)e * D; dst[b] = ws + WS_U8 + (size_t)((e & (UNG - 1)) * (NEXP / UNG) + (e >> UNG_SH)) * 512 + 8 * F.lane; sco[b] = (float*)(ws + WS_SU) + e; }
            cvt_rows_fp4<4>(F.lane, src, dst, sco); }
        for (; mc < NEXP; mc += NGW) { const float* src[1]; unsigned char* dst[1]; float* sco[1];
            const int e = mc; src[0] = A.in[I_PU] + (size_t)e * D; dst[0] = ws + WS_U8 + (size_t)((e & (UNG - 1)) * (NEXP / UNG) + (e >> UNG_SH)) * 512 + 8 * F.lane; sco[0] = (float*)(ws + WS_SU) + e;
            cvt_rows_fp4<1>(F.lane, src, dst, sco); }
    }
    if (V_F4) {
        int mc = gw;
        for (; mc + 3 * NGW < NEXP; mc += 4 * NGW) { const float* src[4]; unsigned char* dst[4]; float* sco[4];
#pragma unroll
            for (int b = 0; b < 4; ++b) { const int e = mc + b * NGW; src[b] = A.in[I_PV] + (size_t)e * D; dst[b] = ws + WS_V8 + (size_t)e * 512; sco[b] = (float*)(ws + WS_SV) + e; }
            cvt_rows_fp4<4, true>(F.lane, src, dst, sco); }
        for (; mc < NEXP; mc += NGW) { const float* src[1]; unsigned char* dst[1]; float* sco[1];
            const int e = mc; src[0] = A.in[I_PV] + (size_t)e * D; dst[0] = ws + WS_V8 + (size_t)e * 512; sco[0] = (float*)(ws + WS_SV) + e;
            cvt_rows_fp4<1, true>(F.lane, src, dst, sco); }
    } else {
        int mc = gw;
        for (; mc + 3 * NGW < NEXP; mc += 4 * NGW) { const float* src[4]; unsigned char* dst[4]; float* sco[4];
#pragma unroll
            for (int b = 0; b < 4; ++b) { const int e = mc + b * NGW; src[b] = A.in[I_PV] + (size_t)e * D; dst[b] = ws + WS_V8 + ((size_t)(F.lane >> 3) * NEXP + e) * 128 + 16 * (F.lane & 7); sco[b] = (float*)(ws + WS_SV) + e; }
            cvt_rows_fp8<4>(F.lane, src, dst, sco); }
        for (; mc < NEXP; mc += NGW) { const float* src[1]; unsigned char* dst[1]; float* sco[1];
            const int e = mc; src[0] = A.in[I_PV] + (size_t)e * D; dst[0] = ws + WS_V8 + ((size_t)(F.lane >> 3) * NEXP + e) * 128 + 16 * (F.lane & 7); sco[0] = (float*)(ws + WS_SV) + e;
            cvt_rows_fp8<1>(F.lane, src, dst, sco); }
    }
}
__device__ __forceinline__ void phase0(const Frame& F, const Args& A) {
    unsigned char* ws = A.ws;
    if (!SC_F8) {
        const int l = F.lane, fr = l & 15, q = l >> 4;
        bf16_t* WQF = (bf16_t*)(ws + WS_WQF);
        for (int it = F.bid * NWAVES + F.wave; it < 2048; it += F.G * NWAVES) {
            const int kh = it & 1, kt = (it >> 1) & 63, hh = it >> 7;
            const float* kX = (hh & 1) ? A.in[I_K2] : A.in[I_K1];
            const float* ap = A.in[I_WQ] + (size_t)(kt * 16 + fr) * 2048 + hh * 128 + 4 * q;
            f32x4 a[8];
#pragma unroll
            for (int t = 0; t < 8; ++t) a[t] = *(const f32x4*)(ap + 16 * t);
#pragma unroll
            for (int kb = 0; kb < 4; ++kb) { const int key0 = kh * 64 + kb * 16;
                const float* bp = kX + (size_t)(key0 + fr) * 128 + 4 * q;
                f32x4 b[8];
#pragma unroll
                for (int t = 0; t < 8; ++t) b[t] = *(const f32x4*)(bp + 16 * t);
                f32x4 d = {0.f, 0.f, 0.f, 0.f};
#pragma unroll
                for (int t = 0; t < 8; ++t)
#pragma unroll
                    for (int c = 0; c < 4; ++c) d = __builtin_amdgcn_mfma_f32_16x16x4f32(a[t][c], b[t][c], d, 0, 0, 0);
                u32x2 o; o.x = pk2(d[0], d[1]); o.y = pk2(d[2], d[3]);
                *(u32x2*)(WQF + (size_t)(hh * 128 + key0 + fr) * 1024 + kt * 16 + 4 * q) = o; }
        }
    } else {
        LAS float* kx = (LAS float*)F.lds;
        LAS float* wt = (LAS float*)(F.lds + 128 * 129 * 4);
        bf16_t* WQF = (bf16_t*)(ws + WS_WQF);
        for (int it = F.bid; it < 512; it += F.G) {
            const int hh = it >> 5, kblk = it & 31, k0 = kblk * 32;
            const float* kX = (hh & 1) ? A.in[I_K2] : A.in[I_K1];
            __syncthreads();
            for (int e = F.tid; e < 128 * 128; e += 512) kx[(e >> 7) * 129 + (e & 127)] = kX[e];
            for (int e = F.tid; e < 32 * 128; e += 512) wt[e] = A.in[I_WQ][(size_t)(k0 + (e >> 7)) * 2048 + hh * 128 + (e & 127)];
            __syncthreads();
            const int key = F.tid & 127, kq = F.tid >> 7;
            float acc[8];
#pragma unroll
            for (int i = 0; i < 8; ++i) acc[i] = 0.f;
            for (int d = 0; d < 128; ++d) { const float b = kx[key * 129 + d];
#pragma unroll
                for (int i = 0; i < 8; ++i) acc[i] += wt[(kq * 8 + i) * 128 + d] * b; }
            if (SC_F8) { u32x2 o;
#pragma unroll
                for (int h2 = 0; h2 < 2; ++h2) { int w = 0; w = __builtin_amdgcn_cvt_pk_fp8_f32(clamp448(acc[4 * h2] * 1024.f), clamp448(acc[4 * h2 + 1] * 1024.f), w, false);
                    w = __builtin_amdgcn_cvt_pk_fp8_f32(clamp448(acc[4 * h2 + 2] * 1024.f), clamp448(acc[4 * h2 + 3] * 1024.f), w, true); o[h2] = (unsigned)w; }
                *(u32x2*)((unsigned char*)WQF + (size_t)(hh * 128 + key) * 1024 + k0 + kq * 8) = o;
            } else {
            u32x4 o; o.x = pk2(acc[0], acc[1]); o.y = pk2(acc[2], acc[3]); o.z = pk2(acc[4], acc[5]); o.w = pk2(acc[6], acc[7]);
            *(u32x4*)(WQF + (size_t)(hh * 128 + key) * 1024 + k0 + kq * 8) = o; }
        }
        __syncthreads();
    }
    LAS float* scr = (LAS float*)(F.lds + F.wave * 16384);
    const int gw = F.bid * NWAVES + F.wave, NGW = F.G * NWAVES;
    constexpr int I_IN = 16 * (NPROJ / 32), I_A = 8 * 32, I_B = 8 * 32, I_O = 16 * 32;
    constexpr int NITEMS = I_IN + I_A + I_B + I_O;
    for (int it = gw; it < NITEMS; it += NGW) {
        int r = it;
        if (r < I_IN) { if ((r % (NPROJ / 32)) * 32 >= F8_LO * 256) p0_transpose_item<1, true>(A.in[I_WIN], 1024, 5136, NPROJ, (bf16_t*)(ws + WS_W8), scr, r, F.lane, 1024.f);
                        else p0_transpose_item<1, false>(A.in[I_WIN], 1024, 5136, NPROJ, (bf16_t*)(ws + WS_WIN), scr, r, F.lane); continue; } r -= I_IN;
        if (r < I_A) { p0_transpose_item<0>(A.in[I_WBA], 512, 1024, 1024, (bf16_t*)(ws + WS_WA), scr, r, F.lane, 1.f, 1024); continue; } r -= I_A;
        if (r < I_B) { p0_transpose_item<0>(A.in[I_WBB], 512, 1024, 1024, (bf16_t*)(ws + WS_WA) + 512, scr, r, F.lane, 1.f, 1024); continue; } r -= I_B;
        p0_transpose_item<0>(A.in[I_WOUT], 1024, 1024, 1024, (bf16_t*)(ws + WS_WOUT), scr, r, F.lane);
    }
    constexpr int OM1 = F8_LO <= 0 ? 2 : (F8_LO >= 21 ? 1 : 3);
    { int m = gw; for (; m + 3 * NGW < T_TOK; m += 4 * NGW) rms_rows_to_bf16<OM1, 4>(F.lane, A.in[I_X] + (size_t)m * D, (size_t)NGW * D, A.in[I_N1G], (bf16_t*)(ws + WS_N1) + (size_t)m * D, (size_t)NGW * D, (unsigned*)(ws + WS_N18) + (size_t)m * 256, (size_t)NGW * 256);
      for (; m < T_TOK; m += NGW) rms_rows_to_bf16<OM1, 1>(F.lane, A.in[I_X] + (size_t)m * D, 0, A.in[I_N1G], (bf16_t*)(ws + WS_N1) + (size_t)m * D, 0, (unsigned*)(ws + WS_N18) + (size_t)m * 256, 0); }
}

__device__ __forceinline__ float log_sigmoid(float z) { return fminf(z, 0.f) - log1pf(__expf(-fabsf(z))); }

template <bool DRY>
__device__ __forceinline__ void gla_chunk_phase(const Frame& F, const Args& A) {
    unsigned char* ws = A.ws;
    const bf16_t* P = (const bf16_t*)(ws + WS_P);
    const float* ALR = (const float*)(ws + WS_ALR);
    LAS float* alr = (LAS float*)F.lds;
    LAS float* tot = (LAS float*)(F.lds + 4096);
    LAS bf16_t* kdT = (LAS bf16_t*)(F.lds + 8192);
    LAS bf16_t* vT = (LAS bf16_t*)(F.lds + 26624);
    LAS bf16_t* stT = (LAS bf16_t*)(F.lds + 45056);
    const int tid = F.tid, kk = tid & 127, seg = tid >> 7;
    const bool hconst = (F.G & 3) == 0;
    int hcur = -1; float w[16]; float bias = 0.f;
#pragma unroll
    for (int j = 0; j < 16; ++j) w[j] = 0.f;
    float na0, na1; bf16_t nk[16], nv[16];
#define GC_LOAD(unit) do { const int h_ = (unit) & 3, c_ = ((unit) >> 2) & 63, b_ = (unit) >> 8; const int t0_ = b_ * SEQ + c_ * 64; \
        na0 = ALR[(size_t)t0_ * 16 + tid]; na1 = ALR[(size_t)t0_ * 16 + 512 + tid]; \
        const bf16_t* kp_ = P + (size_t)(t0_ + 16 * seg) * PLD + PC_K + h_ * 128 + kk; const bf16_t* vp_ = P + (size_t)(t0_ + 16 * seg) * PLD + PC_V + h_ * 128 + kk; \
        _Pragma("unroll") for (int i_ = 0; i_ < 16; ++i_) { nk[i_] = kp_[(size_t)i_ * PLD]; nv[i_] = vp_[(size_t)i_ * PLD]; } } while (0)
    int unit = F.bid;
    if (unit < 2048) GC_LOAD(unit);
    for (; unit < 2048; unit += F.G) {
        const int h = unit & 3;
        if (h != hcur) { hcur = h;
#pragma unroll
            for (int j = 0; j < 16; ++j) w[j] = A.in[I_WGU][(size_t)j * 512 + h * 128 + kk];
            bias = A.in[I_BG][h * 128 + kk]; }
        __syncthreads();
        alr[tid] = na0; alr[512 + tid] = na1;
        bf16_t kr[16], vr[16];
#pragma unroll
        for (int i = 0; i < 16; ++i) { kr[i] = nk[i]; vr[i] = nv[i]; }
        if (unit + F.G < 2048) GC_LOAD(unit + F.G);
        __syncthreads();
        float cum[16]; float run = 0.f;
#pragma unroll
        for (int i = 0; i < 16; ++i) { const LAS f32x4* ap = (const LAS f32x4*)(alr + (16 * seg + i) * 16); float z = bias;
#pragma unroll
            for (int q = 0; q < 4; ++q) { const f32x4 a4 = ap[q]; z += a4.x * w[4 * q] + a4.y * w[4 * q + 1] + a4.z * w[4 * q + 2] + a4.w * w[4 * q + 3]; }
            const float ls = fminf(z, 0.f) - __logf(1.f + __expf(-fabsf(z)));
            run += ls * (1.f / 16.f); cum[i] = run; }
        tot[seg * 128 + kk] = run;
        __syncthreads();
        {
            const float t0s = tot[kk], t1s = tot[128 + kk], t2s = tot[256 + kk], t3s = tot[384 + kk];
            const float total = (t0s + t1s) + (t2s + t3s);
            const float prefix = seg == 0 ? 0.f : (seg == 1 ? t0s : (seg == 2 ? t0s + t1s : t0s + t1s + t2s));
            unsigned kw[8], vw[8];
#pragma unroll
            for (int i = 0; i < 8; ++i) {
                const float e0 = __expf(total - (prefix + cum[2 * i])), e1 = __expf(total - (prefix + cum[2 * i + 1]));
                kw[i] = pk2(bf1(kr[2 * i]) * e0, bf1(kr[2 * i + 1]) * e1); vw[i] = (unsigned)vr[2 * i] | ((unsigned)vr[2 * i + 1] << 16);
            }
            *(LAS u32x4*)(kdT + kk * 72 + 16 * seg) = (u32x4){kw[0], kw[1], kw[2], kw[3]}; *(LAS u32x4*)(kdT + kk * 72 + 16 * seg + 8) = (u32x4){kw[4], kw[5], kw[6], kw[7]};
            *(LAS u32x4*)(vT + kk * 72 + 16 * seg) = (u32x4){vw[0], vw[1], vw[2], vw[3]}; *(LAS u32x4*)(vT + kk * 72 + 16 * seg + 8) = (u32x4){vw[4], vw[5], vw[6], vw[7]};
            if (seg == 0) ((float*)(DRY ? (unsigned char*)A.out + 96 * MiB : ws + WS_DEC))[(size_t)unit * 128 + kk] = __expf(total);
        }
        __syncthreads();
        {
            const int w8 = F.wave, l = F.lane, fr = l & 15, fq = l >> 4;
            f32x4 acc[8];
#pragma unroll
            for (int n = 0; n < 8; ++n) acc[n] = (f32x4){0.f, 0.f, 0.f, 0.f};
#pragma unroll
            for (int ks = 0; ks < 2; ++ks) {
                const bf16x8 a = *(const LAS bf16x8*)(kdT + (16 * w8 + fr) * 72 + 32 * ks + 8 * fq);
#pragma unroll
                for (int n = 0; n < 8; ++n) { const bf16x8 bb = *(const LAS bf16x8*)(vT + (16 * n + fr) * 72 + 32 * ks + 8 * fq);
                    acc[n] = __builtin_amdgcn_mfma_f32_16x16x32_bf16(a, bb, acc[n], 0, 0, 0); }
            }
#pragma unroll
            for (int n = 0; n < 8; ++n) { u32x2 o; o.x = pk2(acc[n][0], acc[n][1]); o.y = pk2(acc[n][2], acc[n][3]);
                *(LAS u32x2*)(stT + (16 * n + fr) * 136 + 16 * w8 + 4 * fq) = o; }
        }
        __syncthreads();
        {
            bf16_t* ST = (bf16_t*)(DRY ? (unsigned char*)A.out : ws + WS_N1) + (size_t)unit * 16384;
            const int vv = tid >> 2, part = tid & 3;
#pragma unroll
            for (int q = 0; q < 4; ++q) *(u32x4*)(ST + (size_t)vv * 128 + 32 * part + 8 * q) = *(const LAS u32x4*)(stT + vv * 136 + 32 * part + 8 * q);
        }
    }
#undef GC_LOAD
    (void)hconst;
}

template <bool DRY>
__device__ __forceinline__ void sgu_unit(const Frame& F, const Args& A, int unit, bool stats) {
    const int g = unit & 3, blk = (unit >> 2) & 31, b = unit >> 7;
    const int t0 = b * SEQ + blk * 128;
    bf16_t* P = (bf16_t*)(A.ws + WS_P);
    LAS bf16_t* wA = (LAS bf16_t*)F.lds;
    LAS bf16_t* vnT = (LAS bf16_t*)(F.lds + 34816);
    LAS float* st = (LAS float*)(F.lds + 69632);
    LAS bf16_t* suS = (LAS bf16_t*)(F.lds + 70656);
    const int tid = F.tid;
    __syncthreads();
    if (stats) {
        const int j = tid >> 2, q = tid & 3;
        const bf16_t* sp = P + (size_t)(t0 + j) * PLD + PC_SV + q * 128;
        float s = 0.f, s2 = 0.f;
#pragma unroll
        for (int i = 0; i < 16; ++i) { const u32x4 w = *(const u32x4*)(sp + 8 * i);
            const float f[8] = {bflo(w.x), bfhi(w.x), bflo(w.y), bfhi(w.y), bflo(w.z), bfhi(w.z), bflo(w.w), bfhi(w.w)};
#pragma unroll
            for (int e = 0; e < 8; ++e) { s += f[e]; s2 += f[e] * f[e]; } }
        s += __shfl_xor(s, 1); s += __shfl_xor(s, 2); s2 += __shfl_xor(s2, 1); s2 += __shfl_xor(s2, 2);
        const float mu = s * (1.f / 512.f); const float var = fmaxf(s2 * (1.f / 512.f) - mu * mu, 0.f);
        if (q == 0) { st[2 * j] = mu; st[2 * j + 1] = 1.f / sqrtf(var + EPS); }
    }
    {
        const int i = tid >> 2, jb = (tid & 3) * 32;
        const float* wp = A.in[I_SW] + (size_t)g * 16384 + (size_t)i * 128 + jb;
        const bf16_t* sup = P + (size_t)(t0 + i) * PLD + PC_SU + g * 128 + jb;
#pragma unroll
        for (int q = 0; q < 4; ++q) { const f32x4 a = *(const f32x4*)(wp + 8 * q), bq = *(const f32x4*)(wp + 8 * q + 4);
            const bool z = (i < 64) && (jb + 8 * q >= 64);
            u32x4 o; o.x = pk2(a.x, a.y); o.y = pk2(a.z, a.w); o.z = pk2(bq.x, bq.y); o.w = pk2(bq.z, bq.w);
            if (z) o = (u32x4){0u, 0u, 0u, 0u};
            *(LAS u32x4*)(wA + i * 136 + jb + 8 * q) = o;
            *(LAS u32x4*)(suS + i * 136 + jb + 8 * q) = *(const u32x4*)(sup + 8 * q); }
    }
    const int cch = tid & 127, seg = tid >> 7;
    bf16_t xr[32];
    { const bf16_t* sp = P + (size_t)(t0 + 32 * seg) * PLD + PC_SV + g * 128 + cch;
#pragma unroll
      for (int i = 0; i < 32; ++i) xr[i] = sp[(size_t)i * PLD]; }
    const float lg = A.in[I_SLNG][g * 128 + cch], lb = A.in[I_SLNB][g * 128 + cch];
    __syncthreads();
    {
        unsigned ow[16];
#pragma unroll
        for (int i = 0; i < 16; ++i) { const int j = 32 * seg + 2 * i; const f32x4 ms = *(const LAS f32x4*)(st + 2 * j);
            ow[i] = pk2((bf1(xr[2 * i]) - ms.x) * ms.y * lg + lb, (bf1(xr[2 * i + 1]) - ms.z) * ms.w * lg + lb); }
#pragma unroll
        for (int q = 0; q < 4; ++q) *(LAS u32x4*)(vnT + cch * 136 + 32 * seg + 8 * q) = (u32x4){ow[4 * q], ow[4 * q + 1], ow[4 * q + 2], ow[4 * q + 3]};
    }
    __syncthreads();
    {
        const int w = F.wave, l = F.lane, fr = l & 15, fq = l >> 4;
        f32x4 acc[8];
#pragma unroll
        for (int n = 0; n < 8; ++n) acc[n] = (f32x4){0.f, 0.f, 0.f, 0.f};
#pragma unroll
        for (int ks = 0; ks < 4; ++ks) {
            const bf16x8 a = *(const LAS bf16x8*)(wA + (16 * w + fr) * 136 + 32 * ks + 8 * fq);
#pragma unroll
            for (int n = 0; n < 8; ++n) { const bf16x8 bb = *(const LAS bf16x8*)(vnT + (16 * n + fr) * 136 + 32 * ks + 8 * fq);
                acc[n] = __builtin_amdgcn_mfma_f32_16x16x32_bf16(a, bb, acc[n], 0, 0, 0); }
        }
#pragma unroll
        for (int jj = 0; jj < 4; ++jj) { const int i = 16 * w + 4 * fq + jj; const float bias = A.in[I_SB][g * 128 + i];
            LAS bf16_t* rp = suS + i * 136 + fr;
#pragma unroll
            for (int n = 0; n < 8; ++n) { const float su = bf1(rp[16 * n]); rp[16 * n] = (bf16_t)f2bf(su * (acc[n][jj] + bias)); } }
    }
    __syncthreads();
    {
        const int i = tid >> 2, jb = (tid & 3) * 32;
        bf16_t* yp = DRY ? (bf16_t*)A.out + (size_t)(t0 + i) * 512 + g * 128 + jb : P + (size_t)(t0 + i) * PLD + PC_SU + g * 128 + jb;
#pragma unroll
        for (int q = 0; q < 4; ++q) *(u32x4*)(yp + 8 * q) = *(const LAS u32x4*)(suS + i * 136 + jb + 8 * q);
    }
}

template <bool DRY>
__device__ __forceinline__ void gla_scan(const Frame& F, const Args& A) {
    bf16_t* ST = (bf16_t*)(A.ws + WS_N1); bf16_t* STO = DRY ? (bf16_t*)A.out : ST; const float* DEC = (const float*)(A.ws + WS_DEC);
    for (int gi = F.bid * 512 + F.tid; gi < 131072; gi += F.G * 512) {
        const int k4 = gi & 31, vv = (gi >> 5) & 127, h = (gi >> 12) & 3, b = gi >> 14;
        float s0 = 0.f, s1 = 0.f, s2 = 0.f, s3 = 0.f;
        u32x2 wa[8], wb[8]; f32x4 da[8], db[8];
#define SCAN_LOAD(W, Dd, c0) do { _Pragma("unroll") for (int i_ = 0; i_ < 8; ++i_) { const size_t u_ = (size_t)((b * 64 + (c0) + i_) * 4 + h); \
            W[i_] = *(const u32x2*)(ST + u_ * 16384 + (size_t)vv * 128 + k4 * 4); Dd[i_] = *(const f32x4*)(DEC + u_ * 128 + k4 * 4); } } while (0)
#define SCAN_STEP(W, Dd, c0) do { _Pragma("unroll") for (int i_ = 0; i_ < 8; ++i_) { const size_t u_ = (size_t)((b * 64 + (c0) + i_) * 4 + h); \
            s0 = Dd[i_].x * s0 + bflo(W[i_].x); s1 = Dd[i_].y * s1 + bfhi(W[i_].x); s2 = Dd[i_].z * s2 + bflo(W[i_].y); s3 = Dd[i_].w * s3 + bfhi(W[i_].y); \
            u32x2 o_; o_.x = pk2(s0, s1); o_.y = pk2(s2, s3); *(u32x2*)(STO + u_ * 16384 + (size_t)vv * 128 + k4 * 4) = o_; } } while (0)
        SCAN_LOAD(wa, da, 0);
#pragma unroll
        for (int c0 = 0; c0 < 64; c0 += 16) {
            SCAN_LOAD(wb, db, c0 + 8);
            SCAN_STEP(wa, da, c0);
            if (c0 + 16 < 64) SCAN_LOAD(wa, da, c0 + 16);
            SCAN_STEP(wb, db, c0 + 8);
        }
#undef SCAN_LOAD
#undef SCAN_STEP
    }
}

template <bool DRY>
__device__ __forceinline__ void gla_out_phase(const Frame& F, const Args& A) {
    bf16_t* P = (bf16_t*)(A.ws + WS_P);
    LAS bf16_t* qA = (LAS bf16_t*)F.lds;
    LAS bf16_t* sB = (LAS bf16_t*)(F.lds + 17408);
    LAS float* oF = (LAS float*)(F.lds + 52224);
    const int tid = F.tid, s = tid >> 3, cb = (tid & 7) * 16, vv = tid >> 2, kb = (tid & 3) * 32;
    u32x4 nq0, nq1, ns0, ns1, ns2, ns3, nr0, nr1;
#define GO_LOAD(unit) do { const int h_ = (unit) & 3, c_ = ((unit) >> 2) & 63, b_ = (unit) >> 8; const int t0_ = b_ * SEQ + c_ * 64; \
        const bf16_t* qp_ = P + (size_t)(t0_ + s) * PLD + PC_Q + h_ * 128 + cb; nq0 = *(const u32x4*)qp_; nq1 = *(const u32x4*)(qp_ + 8); \
        const bf16_t* sp_ = (const bf16_t*)(A.ws + WS_N1) + (size_t)(unit) * 16384 + (size_t)vv * 128 + kb; ns0 = *(const u32x4*)sp_; ns1 = *(const u32x4*)(sp_ + 8); ns2 = *(const u32x4*)(sp_ + 16); ns3 = *(const u32x4*)(sp_ + 24); \
        const bf16_t* rp_ = P + (size_t)(t0_ + s) * PLD + PC_R + h_ * 128 + cb; nr0 = *(const u32x4*)rp_; nr1 = *(const u32x4*)(rp_ + 8); } while (0)
    int unit = F.bid;
    if (unit < 2048) GO_LOAD(unit);
    for (; unit < 2048; unit += F.G) {
        const int h = unit & 3, c = (unit >> 2) & 63, b = unit >> 8;
        const int t0 = b * SEQ + c * 64;
        __syncthreads();
        *(LAS u32x4*)(qA + s * 136 + cb) = nq0; *(LAS u32x4*)(qA + s * 136 + cb + 8) = nq1;
        *(LAS u32x4*)(sB + vv * 136 + kb) = ns0; *(LAS u32x4*)(sB + vv * 136 + kb + 8) = ns1; *(LAS u32x4*)(sB + vv * 136 + kb + 16) = ns2; *(LAS u32x4*)(sB + vv * 136 + kb + 24) = ns3;
        const u32x4 r0 = nr0, r1 = nr1;
        if (unit + F.G < 2048) GO_LOAD(unit + F.G);
        __syncthreads();
        {
            const int w = F.wave, l = F.lane, fr = l & 15, fq = l >> 4, m = w & 3, nh = w >> 2;
            f32x4 acc[4];
#pragma unroll
            for (int n = 0; n < 4; ++n) acc[n] = (f32x4){0.f, 0.f, 0.f, 0.f};
#pragma unroll
            for (int ks = 0; ks < 4; ++ks) {
                const bf16x8 a = *(const LAS bf16x8*)(qA + (16 * m + fr) * 136 + 32 * ks + 8 * fq);
#pragma unroll
                for (int n = 0; n < 4; ++n) { const bf16x8 bb = *(const LAS bf16x8*)(sB + (16 * (4 * nh + n) + fr) * 136 + 32 * ks + 8 * fq);
                    acc[n] = __builtin_amdgcn_mfma_f32_16x16x32_bf16(a, bb, acc[n], 0, 0, 0); }
            }
            const float scale = 0.08838834764831845f;
#pragma unroll
            for (int n = 0; n < 4; ++n)
#pragma unroll
                for (int jj = 0; jj < 4; ++jj) oF[(16 * m + 4 * fq + jj) * 132 + 16 * (4 * nh + n) + fr] = acc[n][jj] * scale;
        }
        __syncthreads();
        {
            float o[16]; float ss = 0.f;
#pragma unroll
            for (int i = 0; i < 16; ++i) { o[i] = oF[s * 132 + cb + i]; ss += o[i] * o[i]; }
            ss += __shfl_xor(ss, 1); ss += __shfl_xor(ss, 2); ss += __shfl_xor(ss, 4);
            const float rstd = 1.f / sqrtf(ss * (1.f / 128.f) + EPS);
            const unsigned rw[8] = {r0.x, r0.y, r0.z, r0.w, r1.x, r1.y, r1.z, r1.w};
            const float* gg = A.in[I_GLAG] + h * 128 + cb;
            unsigned ow[8];
#pragma unroll
            for (int i = 0; i < 8; ++i) { const float y0 = o[2 * i] * rstd * gg[2 * i] * siluf_(bflo(rw[i])), y1 = o[2 * i + 1] * rstd * gg[2 * i + 1] * siluf_(bfhi(rw[i])); ow[i] = pk2(y0, y1); }
            bf16_t* yp = DRY ? (bf16_t*)A.out + (size_t)(t0 + s) * 512 + h * 128 + cb : P + (size_t)(t0 + s) * PLD + PC_R + h * 128 + cb;
            *(u32x4*)yp = (u32x4){ow[0], ow[1], ow[2], ow[3]}; *(u32x4*)(yp + 8) = (u32x4){ow[4], ow[5], ow[6], ow[7]};
        }
    }
#undef GO_LOAD
}

__device__ __forceinline__ unsigned ordkey(float v) { const unsigned u = __builtin_bit_cast(unsigned, v); return u ^ ((unsigned)((int)u >> 31) | 0x80000000u); }
__device__ __forceinline__ float unord(unsigned k) { const unsigned u = (k & 0x80000000u) ? (k & 0x7fffffffu) : ~k; return __builtin_bit_cast(float, u); }
#define INS16(r, xin) do { unsigned _x = (xin); _Pragma("unroll") for (int _i = 0; _i < 16; ++_i) { const unsigned _h = max((r)[_i], _x); _x = min((r)[_i], _x); (r)[_i] = _h; } } while (0)

#define CE(a, b) do { const unsigned _h = max((a), (b)), _l = min((a), (b)); (a) = _h; (b) = _l; } while (0)
#define SORT16(v) do { CE(v[0], v[1]); CE(v[2], v[3]); CE(v[0], v[2]); CE(v[1], v[3]); CE(v[1], v[2]); CE(v[4], v[5]); CE(v[6], v[7]); CE(v[4], v[6]); CE(v[5], v[7]); CE(v[5], v[6]); CE(v[0], v[4]); CE(v[2], v[6]); CE(v[2], v[4]); CE(v[1], v[5]); CE(v[3], v[7]); CE(v[3], v[5]); CE(v[1], v[2]); CE(v[3], v[4]); CE(v[5], v[6]); CE(v[8], v[9]); CE(v[10], v[11]); CE(v[8], v[10]); CE(v[9], v[11]); CE(v[9], v[10]); CE(v[12], v[13]); CE(v[14], v[15]); CE(v[12], v[14]); CE(v[13], v[15]); CE(v[13], v[14]); CE(v[8], v[12]); CE(v[10], v[14]); CE(v[10], v[12]); CE(v[9], v[13]); CE(v[11], v[15]); CE(v[11], v[13]); CE(v[9], v[10]); CE(v[11], v[12]); CE(v[13], v[14]); CE(v[0], v[8]); CE(v[4], v[12]); CE(v[4], v[8]); CE(v[2], v[10]); CE(v[6], v[14]); CE(v[6], v[10]); CE(v[2], v[4]); CE(v[6], v[8]); CE(v[10], v[12]); CE(v[1], v[9]); CE(v[5], v[13]); CE(v[5], v[9]); CE(v[3], v[11]); CE(v[7], v[15]); CE(v[7], v[11]); CE(v[3], v[5]); CE(v[7], v[9]); CE(v[11], v[13]); CE(v[1], v[2]); CE(v[3], v[4]); CE(v[5], v[6]); CE(v[7], v[8]); CE(v[9], v[10]); CE(v[11], v[12]); CE(v[13], v[14]); } while (0)
#define MERGE16(T, S) do { _Pragma("unroll") for (int _i = 0; _i < 16; ++_i) (T)[_i] = max((T)[_i], (S)[15 - _i]); \
    _Pragma("unroll") for (int _d = 8; _d >= 1; _d >>= 1) { _Pragma("unroll") for (int _i = 0; _i < 16; ++_i) if ((_i & _d) == 0) CE((T)[_i], (T)[_i + _d]); } } while (0)
__device__ __forceinline__ void peer_topk(const Frame& F, const Args& A) {
    const bf16_t* SC = (const bf16_t*)(A.ws + WS_P + P_SC);
    int* IDX = (int*)(A.ws + WS_P + P_IDX); float* GATE = (float*)(A.ws + WS_P + P_GATE);
    const int gw = F.bid * NWAVES + F.wave, NGW = F.G * NWAVES;
    for (int it = gw; it < 512 * 8; it += NGW) {
        const int h = it & 7, tb = it >> 3; const int tok = tb * 64 + F.lane;
        unsigned r1[16], r2[16], rc[16];
        const bf16_t* p1 = SC + ((size_t)(tok >> 4) * 256 + h * 32) * 128 + (tok & 15) * 8; const bf16_t* p2 = p1 + 16 * 128;
        {
            float raw[128]; unsigned sg[16];
#pragma unroll
            for (int jq = 0; jq < 16; ++jq) { const u32x4 t4 = *(const u32x4*)(p1 + jq * 128);
#pragma unroll
                for (int c = 0; c < 4; ++c) { raw[8 * jq + 2 * c] = bflo(t4[c]); raw[8 * jq + 2 * c + 1] = bfhi(t4[c]); } }
#pragma unroll
            for (int j = 0; j < 16; ++j) r1[j] = (ordkey(raw[j]) & ~127u) | (unsigned)(127 - j);
            SORT16(r1);
#pragma unroll
            for (int gq = 1; gq < 8; ++gq) {
#pragma unroll
                for (int j = 0; j < 16; ++j) sg[j] = (ordkey(raw[16 * gq + j]) & ~127u) | (unsigned)(127 - (16 * gq + j));
                SORT16(sg); MERGE16(r1, sg); }
#pragma unroll
            for (int jq = 0; jq < 16; ++jq) { const u32x4 t4 = *(const u32x4*)(p2 + jq * 128);
#pragma unroll
                for (int c = 0; c < 4; ++c) { raw[8 * jq + 2 * c] = bflo(t4[c]); raw[8 * jq + 2 * c + 1] = bfhi(t4[c]); } }
#pragma unroll
            for (int j = 0; j < 16; ++j) r2[j] = (ordkey(raw[j]) & ~127u) | (unsigned)(127 - j);
            SORT16(r2);
#pragma unroll
            for (int gq = 1; gq < 8; ++gq) {
#pragma unroll
                for (int j = 0; j < 16; ++j) sg[j] = (ordkey(raw[16 * gq + j]) & ~127u) | (unsigned)(127 - (16 * gq + j));
                SORT16(sg); MERGE16(r2, sg); }
        }
        float v1[16], v2[16];
#pragma unroll
        for (int i = 0; i < 16; ++i) { v1[i] = unord((r1[i] & ~127u) | 64u); v2[i] = unord((r2[i] & ~127u) | 64u); }
        {
            unsigned cg[4][16]; int cn = 0;
#pragma unroll
            for (int a = 0; a < 16; ++a)
#pragma unroll
                for (int bq = 0; bq < 16; ++bq) if ((a + 1) * (bq + 1) <= 16) { cg[cn >> 4][cn & 15] = (ordkey(v1[a] + v2[bq]) & ~255u) | (unsigned)(a * 16 + bq); ++cn; }
#pragma unroll
            for (int z = 50; z < 64; ++z) cg[z >> 4][z & 15] = 0u;
            SORT16(cg[0]); SORT16(cg[1]); SORT16(cg[2]); SORT16(cg[3]);
            MERGE16(cg[0], cg[1]); MERGE16(cg[0], cg[2]); MERGE16(cg[0], cg[3]);
#pragma unroll
            for (int i = 0; i < 16; ++i) rc[i] = cg[0][i];
        }
        float val[16]; int ex[16];
        {
            LAS unsigned* t1 = (LAS unsigned*)(F.lds + F.wave * 8704) + F.lane * 17; LAS unsigned* t2 = t1 + 64 * 17;
#pragma unroll
            for (int i = 0; i < 16; ++i) { t1[i] = r1[i]; t2[i] = r2[i]; }
            LDS_WAIT(); asm volatile("" ::: "memory");
#pragma unroll
            for (int w = 0; w < 16; ++w) {
                const int a = (rc[w] >> 4) & 15, bq = rc[w] & 15;
                const unsigned k1 = t1[a], k2 = t2[bq];
                val[w] = unord((k1 & ~127u) | 64u) + unord((k2 & ~127u) | 64u);
                ex[w] = (127 - (int)(k1 & 127u)) * 128 + (127 - (int)(k2 & 127u));
            }
            LDS_WAIT(); asm volatile("" ::: "memory");
        }
        float mx = val[0];
#pragma unroll
        for (int w = 1; w < 16; ++w) mx = fmaxf(mx, val[w]);
        float sum = 0.f;
#pragma unroll
        for (int w = 0; w < 16; ++w) { val[w] = __expf(val[w] - mx); sum += val[w]; }
        const float inv = 1.f / sum;
        int* ip = IDX + (size_t)tok * 128 + h * 16; float* gp = GATE + (size_t)tok * 128 + h * 16;
#pragma unroll
        for (int q = 0; q < 4; ++q) { *(int4*)(ip + 4 * q) = make_int4(ex[4 * q], ex[4 * q + 1], ex[4 * q + 2], ex[4 * q + 3]);
            *(f32x4*)(gp + 4 * q) = (f32x4){val[4 * q] * inv, val[4 * q + 1] * inv, val[4 * q + 2] * inv, val[4 * q + 3] * inv}; }
    }
}

#define DPP_ADD(v, ctrl) ((v) + __builtin_bit_cast(float, __builtin_amdgcn_mov_dpp(__builtin_bit_cast(int, (v)), (ctrl), 0xf, 0xf, true)))
__device__ __forceinline__ void fp8x16_to_f32x2(const u32x4 r, f32x2* f) {
#pragma unroll
    for (int q = 0; q < 4; ++q) { f[2 * q] = __builtin_amdgcn_cvt_pk_f32_fp8((int)r[q], false); f[2 * q + 1] = __builtin_amdgcn_cvt_pk_f32_fp8((int)r[q], true); }
}
__device__ __forceinline__ void fp8x16_to_f32(const u32x4 r, float* f) {
#pragma unroll
    for (int q = 0; q < 4; ++q) { const f32x2 lo = __builtin_amdgcn_cvt_pk_f32_fp8((int)r[q], false), hi = __builtin_amdgcn_cvt_pk_f32_fp8((int)r[q], true);
        f[4 * q] = lo.x; f[4 * q + 1] = lo.y; f[4 * q + 2] = hi.x; f[4 * q + 3] = hi.y; }
}
__device__ __forceinline__ long lo64(u32x4 v) { return (long)(((unsigned long)v.y << 32) | (unsigned long)v.x); }
__device__ __forceinline__ long hi64(u32x4 v) { return (long)(((unsigned long)v.w << 32) | (unsigned long)v.z); }
template <int MODE>
__device__ __forceinline__ void peer_u_phase(const Frame& F, const Args& A) {
    const unsigned char* X8 = A.ws + WS_P + P_X8;
    const unsigned char* U8 = A.ws + WS_U8; const float* SU = (const float*)(A.ws + WS_SU); const float* SV = (const float*)(A.ws + WS_SV);
    const int* IDX = (const int*)(A.ws + WS_P + P_IDX); const float* GATE = (const float*)(A.ws + WS_P + P_GATE); float* AK = (float*)(MODE == 0 ? A.ws + WS_AK : A.ws + WS_P + P_SC);
    const int g = F.bid & 7, nmem = F.G >> 3, l = F.lane, step = nmem * NWAVES;
    const int loff = 64 * (l & 15) + 16 * (l >> 4);
    const bool dg = ((l & 15) >> 2) == (l >> 4); const int dr = l & 3;
    const float dw0 = (dg && dr == 0) ? 1.f : 0.f, dw1 = (dg && dr == 1) ? 1.f : 0.f, dw2 = (dg && dr == 2) ? 1.f : 0.f, dw3 = (dg && dr == 3) ? 1.f : 0.f;
    LAS int* le = (LAS int*)(F.lds + F.wave * 2048); LAS int* lk = le + 256;
    const bool b5 = (l & 32) != 0, b4 = (l & 16) != 0, b3 = (l & 8) != 0;
    int tok = 2 * ((F.bid >> 3) * NWAVES + F.wave);
    u32x4 nxA, nxB; int neA0, neA1, neB0, neB1; float ngA0, ngA1, ngB0, ngB1;
#define U_PREFETCH(t) do { const size_t _tA = (size_t)(t), _tB = (size_t)(t) + 1; if (MODE == 4) { nxA = (u32x4){(unsigned)_tA, 1u, 2u, 3u}; nxB = nxA; neA0 = (int)((_tA * 37 + l * 11) & 16383); neA1 = (int)((_tA * 53 + l * 7) & 16383); neB0 = (int)((_tB * 37 + l * 13) & 16383); neB1 = (int)((_tB * 29 + l * 3) & 16383); ngA0 = ngA1 = ngB0 = ngB1 = 0.01f; break; } nxA = *(const u32x4*)(X8 + _tA * 1024 + loff); nxB = *(const u32x4*)(X8 + _tB * 1024 + loff); \
        neA0 = IDX[_tA * 128 + l]; neA1 = IDX[_tA * 128 + 64 + l]; neB0 = IDX[_tB * 128 + l]; neB1 = IDX[_tB * 128 + 64 + l]; \
        ngA0 = GATE[_tA * 128 + l]; ngA1 = GATE[_tA * 128 + 64 + l]; ngB0 = GATE[_tB * 128 + l]; ngB1 = GATE[_tB * 128 + 64 + l]; } while (0)
    if (tok + 1 < T_TOK) U_PREFETCH(tok);
    for (; tok + 1 < T_TOK; tok += 2 * step) {
        const int tokA = tok, tokB = tok + 1;
        const u32x4 xA = nxA, xB = nxB;
        const int eA0 = neA0, eA1 = neA1, eB0 = neB0, eB1 = neB1; const float gA0 = ngA0, gA1 = ngA1, gB0 = ngB0, gB1 = ngB1;
        bool pf_done = false;
        const bool oA0 = (eA0 & 7) == g, oA1 = (eA1 & 7) == g, oB0 = (eB0 & 7) == g, oB1 = (eB1 & 7) == g;
        const unsigned long long mA0 = __ballot(oA0), mA1 = __ballot(oA1), mB0 = __ballot(oB0), mB1 = __ballot(oB1);
        const int c0 = __popcll(mA0), c1 = c0 + __popcll(mA1), c2 = c1 + __popcll(mB0), n = c2 + __popcll(mB1);
#define MBC(m) __builtin_amdgcn_mbcnt_hi((unsigned)((m) >> 32), __builtin_amdgcn_mbcnt_lo((unsigned)(m), 0u))
        if (oA0) { const int p = MBC(mA0); le[p] = (eA0 << 8) | l; lk[p] = __builtin_bit_cast(int, gA0); }
        if (oA1) { const int p = c0 + MBC(mA1); le[p] = (eA1 << 8) | (64 + l); lk[p] = __builtin_bit_cast(int, gA1); }
        if (oB0) { const int p = c1 + MBC(mB0); le[p] = (eB0 << 8) | 128 | l; lk[p] = __builtin_bit_cast(int, gB0); }
        if (oB1) { const int p = c2 + MBC(mB1); le[p] = (eB1 << 8) | 128 | (64 + l); lk[p] = __builtin_bit_cast(int, gB1); }
#undef MBC
        LDS_WAIT(); asm volatile("" ::: "memory");
        for (int cb = 0; cb < n || cb == 0; cb += 64) {
        const int nc = min(n, cb + 64);
        const bool fv = (cb + l) < nc;
        const int ent = fv ? le[cb + l] : 0; const float gt = fv ? __builtin_bit_cast(float, lk[cb + l]) : 0.f; float tot = 0.f;
        const float su = SU[ent >> 8], sv = SV[ent >> 8];
        const unsigned long long radr = (unsigned long long)(U8 + (size_t)(((ent >> 8) & 7) * 2048 + (((ent >> 8) >> 3) & (MODE == 2 ? 255 : 2047))) * 1024);
        const int ralo = (int)(unsigned)radr, rahi = (int)(unsigned)(radr >> 32);
        for (int i = cb; i < nc; i += 16) {
            u32x4 row[2][8];
#pragma unroll
            for (int b = 0; b < 2; ++b) if (i + 8 * b < nc) {
#pragma unroll
                for (int j = 0; j < 8; ++j) { const int ln = min(i + 8 * b + j, nc - 1) - cb;
                    const unsigned lo = (unsigned)__builtin_amdgcn_readlane(ralo, ln), hi = (unsigned)__builtin_amdgcn_readlane(rahi, ln);
                    const GAS unsigned char* rp = (const GAS unsigned char*)(((unsigned long long)hi << 32) | lo);
                    row[b][j] = *(const GAS u32x4*)(rp + (unsigned)loff); } }
            if (!pf_done) { pf_done = true; if (tok + 2 * step + 1 < T_TOK) U_PREFETCH(tok + 2 * step); }
#pragma unroll
            for (int b = 0; b < 2; ++b) if (i + 8 * b < nc) {
                float p[8];
                f32x4 accj[8];
                const int base0 = i + 8 * b;
                if (base0 + 8 <= c1) {
#pragma unroll
                    for (int j = 0; j < 8; ++j) accj[j] = __builtin_amdgcn_mfma_f32_16x16x32_fp8_fp8(lo64(row[b][j]), lo64(xA), (f32x4){0.f, 0.f, 0.f, 0.f}, 0, 0, 0);
#pragma unroll
                    for (int j = 0; j < 8; ++j) accj[j] = __builtin_amdgcn_mfma_f32_16x16x32_fp8_fp8(hi64(row[b][j]), hi64(xA), accj[j], 0, 0, 0);
                } else if (base0 >= c1) {
#pragma unroll
                    for (int j = 0; j < 8; ++j) accj[j] = __builtin_amdgcn_mfma_f32_16x16x32_fp8_fp8(lo64(row[b][j]), lo64(xB), (f32x4){0.f, 0.f, 0.f, 0.f}, 0, 0, 0);
#pragma unroll
                    for (int j = 0; j < 8; ++j) accj[j] = __builtin_amdgcn_mfma_f32_16x16x32_fp8_fp8(hi64(row[b][j]), hi64(xB), accj[j], 0, 0, 0);
                } else {
#pragma unroll
                    for (int j = 0; j < 8; ++j) { const u32x4 xs = (base0 + j >= c1) ? xB : xA; accj[j] = __builtin_amdgcn_mfma_f32_16x16x32_fp8_fp8(lo64(row[b][j]), lo64(xs), (f32x4){0.f, 0.f, 0.f, 0.f}, 0, 0, 0);
                        accj[j] = __builtin_amdgcn_mfma_f32_16x16x32_fp8_fp8(hi64(row[b][j]), hi64(xs), accj[j], 0, 0, 0); }
                }
#pragma unroll
                for (int j = 0; j < 8; ++j) p[j] = __builtin_fmaf(accj[j][3], dw3, __builtin_fmaf(accj[j][2], dw2, __builtin_fmaf(accj[j][1], dw1, accj[j][0] * dw0)));
                float q4[4], q2[2], q1;
#pragma unroll
                for (int j = 0; j < 4; ++j) { const float keep = b5 ? p[4 + j] : p[j], send = b5 ? p[j] : p[4 + j]; q4[j] = keep + __shfl_xor(send, 32); }
#pragma unroll
                for (int j = 0; j < 2; ++j) { const float keep = b4 ? q4[2 + j] : q4[j], send = b4 ? q4[j] : q4[2 + j]; q2[j] = keep + __shfl_xor(send, 16); }
                { const float keep = b3 ? q2[1] : q2[0], send = b3 ? q2[0] : q2[1]; q1 = keep + __shfl_xor(send, 8); }
                q1 = DPP_ADD(q1, 0xB1); q1 = DPP_ADD(q1, 0x4E); q1 = DPP_ADD(q1, 0x141);
                const float t = __builtin_bit_cast(float, __builtin_amdgcn_ds_bpermute((l & 7) * 32, __builtin_bit_cast(int, q1)));
                const int base = i + 8 * b;
                if ((l >> 3) == ((base - cb) >> 3)) tot = t;
            }
        }
        if (!pf_done) { if (tok + 2 * step + 1 < T_TOK) U_PREFETCH(tok + 2 * step); }
        if (fv) { const int tk = (ent & 128) ? tokB : tokA; AK[(size_t)tk * 128 + (ent & 127)] = gelu_tanh(tot * su * (1.f / 16.f)) * gt * sv; }
        if (n == 0) break;
        }
        LDS_WAIT(); asm volatile("" ::: "memory");
    }
#undef U_PREFETCH
}
template <int MODE>
__device__ __forceinline__ void peer_u_phase1(const Frame& F, const Args& A) {
    const unsigned char* X8 = A.ws + WS_P + P_X8;
    const unsigned char* U8 = A.ws + WS_U8; const float* SU = (const float*)(A.ws + WS_SU); const float* SV = (const float*)(A.ws + WS_SV);
    const int* IDX = (const int*)(A.ws + WS_P + P_IDX); const float* GATE = (const float*)(A.ws + WS_P + P_GATE); float* AK = (float*)(MODE == 0 ? A.ws + WS_AK : A.ws + WS_P + P_SC);
    const int g = F.bid & (UNG - 1), nmem = F.G >> UNG_SH, l = F.lane, step = nmem * NWAVES;
    const int loff = 64 * (l & 15) + 16 * (l >> 4);
    const bool dg = ((l & 15) >> 2) == (l >> 4); const int dr = l & 3;
    const float dw0 = (dg && dr == 0) ? 1.f : 0.f, dw1 = (dg && dr == 1) ? 1.f : 0.f, dw2 = (dg && dr == 2) ? 1.f : 0.f, dw3 = (dg && dr == 3) ? 1.f : 0.f;
    LAS int* le = (LAS int*)(F.lds + F.wave * 2048); LAS int* lk = le + 256;
    const bool b5 = (l & 32) != 0, b4 = (l & 16) != 0, b3 = (l & 8) != 0;
    int tok = (F.bid >> UNG_SH) * NWAVES + F.wave;
    u32x4 nxA; int neA0, neA1; float ngA0, ngA1;
#define U1_PREFETCH(t) do { const size_t _tA = (size_t)(t); nxA = *(const u32x4*)(X8 + _tA * 1024 + loff); \
        neA0 = IDX[_tA * 128 + l]; neA1 = IDX[_tA * 128 + 64 + l]; ngA0 = GATE[_tA * 128 + l]; ngA1 = GATE[_tA * 128 + 64 + l]; } while (0)
    if (tok < T_TOK) U1_PREFETCH(tok);
    for (; tok < T_TOK; tok += step) {
        const u32x4 xA = nxA;
        const int eA0 = neA0, eA1 = neA1; const float gA0 = ngA0, gA1 = ngA1;
        bool pf_done = false;
        const bool oA0 = (eA0 & (UNG - 1)) == g, oA1 = (eA1 & (UNG - 1)) == g;
        const unsigned long long mA0 = __ballot(oA0), mA1 = __ballot(oA1);
        const int c0 = __popcll(mA0), n = c0 + __popcll(mA1);
#define MBC(m) __builtin_amdgcn_mbcnt_hi((unsigned)((m) >> 32), __builtin_amdgcn_mbcnt_lo((unsigned)(m), 0u))
        if (oA0) { const int p = MBC(mA0); le[p] = (eA0 << 8) | l; lk[p] = __builtin_bit_cast(int, gA0); }
        if (oA1) { const int p = c0 + MBC(mA1); le[p] = (eA1 << 8) | (64 + l); lk[p] = __builtin_bit_cast(int, gA1); }
#undef MBC
        LDS_WAIT(); asm volatile("" ::: "memory");
        for (int cb = 0; cb < n || cb == 0; cb += 64) {
        const int nc = min(n, cb + 64);
        const bool fv = (cb + l) < nc;
        const int ent = fv ? le[cb + l] : 0; const float gt = fv ? __builtin_bit_cast(float, lk[cb + l]) : 0.f; float tot = 0.f;
        const float su = SU[ent >> 8], sv = SV[ent >> 8];
        const unsigned long long radr = (unsigned long long)(U8 + (size_t)(((ent >> 8) & (UNG - 1)) * (NEXP / UNG) + ((ent >> 8) >> UNG_SH)) * 1024);
        const int ralo = (int)(unsigned)radr, rahi = (int)(unsigned)(radr >> 32);
        for (int i = cb; i < nc; i += 16) {
            u32x4 row[2][8];
#pragma unroll
            for (int b = 0; b < 2; ++b) if (i + 8 * b < nc) {
#pragma unroll
                for (int j = 0; j < 8; ++j) { const int ln = min(i + 8 * b + j, nc - 1) - cb;
                    const unsigned lo = (unsigned)__builtin_amdgcn_readlane(ralo, ln), hi = (unsigned)__builtin_amdgcn_readlane(rahi, ln);
                    const GAS unsigned char* rp = (const GAS unsigned char*)(((unsigned long long)hi << 32) | lo);
                    row[b][j] = *(const GAS u32x4*)(rp + (unsigned)loff); } }
            if (!pf_done) { pf_done = true; if (tok + step < T_TOK) U1_PREFETCH(tok + step); }
#pragma unroll
            for (int b = 0; b < 2; ++b) if (i + 8 * b < nc) {
                float p[8]; f32x4 accj[8];
#pragma unroll
                for (int j = 0; j < 8; ++j) accj[j] = __builtin_amdgcn_mfma_f32_16x16x32_fp8_fp8(lo64(row[b][j]), lo64(xA), (f32x4){0.f, 0.f, 0.f, 0.f}, 0, 0, 0);
#pragma unroll
                for (int j = 0; j < 8; ++j) accj[j] = __builtin_amdgcn_mfma_f32_16x16x32_fp8_fp8(hi64(row[b][j]), hi64(xA), accj[j], 0, 0, 0);
#pragma unroll
                for (int j = 0; j < 8; ++j) p[j] = __builtin_fmaf(accj[j][3], dw3, __builtin_fmaf(accj[j][2], dw2, __builtin_fmaf(accj[j][1], dw1, accj[j][0] * dw0)));
                float q4[4], q2[2], q1;
#pragma unroll
                for (int j = 0; j < 4; ++j) { const float keep = b5 ? p[4 + j] : p[j], send = b5 ? p[j] : p[4 + j]; q4[j] = keep + __shfl_xor(send, 32); }
#pragma unroll
                for (int j = 0; j < 2; ++j) { const float keep = b4 ? q4[2 + j] : q4[j], send = b4 ? q4[j] : q4[2 + j]; q2[j] = keep + __shfl_xor(send, 16); }
                { const float keep = b3 ? q2[1] : q2[0], send = b3 ? q2[0] : q2[1]; q1 = keep + __shfl_xor(send, 8); }
                q1 = DPP_ADD(q1, 0xB1); q1 = DPP_ADD(q1, 0x4E); q1 = DPP_ADD(q1, 0x141);
                const float t = __builtin_bit_cast(float, __builtin_amdgcn_ds_bpermute((l & 7) * 32, __builtin_bit_cast(int, q1)));
                const int base = i + 8 * b;
                if ((l >> 3) == ((base - cb) >> 3)) tot = t;
            }
        }
        if (!pf_done) { pf_done = true; if (tok + step < T_TOK) U1_PREFETCH(tok + step); }
        if (fv) AK[(size_t)tok * 128 + (ent & 127)] = gelu_tanh(tot * su * (1.f / 16.f)) * gt * sv;
        if (n == 0) break;
        }
        LDS_WAIT(); asm volatile("" ::: "memory");
    }
#undef U1_PREFETCH
}
template <int MODE>
__device__ __forceinline__ void peer_u4_phase(const Frame& F, const Args& A) {
    const unsigned char* X8 = A.ws + WS_P + P_X8;
    const float* SU = (const float*)(A.ws + WS_SU); const float* SV = (const float*)(A.ws + WS_SV);
    const int* IDX = (const int*)(A.ws + WS_P + P_IDX); const float* GATE = (const float*)(A.ws + WS_P + P_GATE); float* AK = (float*)(MODE == 0 ? A.ws + WS_AK : A.ws + WS_P + P_SC);
    const int g = F.bid & (UNG - 1), nmem = F.G >> UNG_SH, l = F.lane, step = nmem * NWAVES;
    const int m = l & 15, q = l >> 4;
    const GAS unsigned char* ub = (const GAS unsigned char*)(A.ws + WS_U8 + (size_t)g * (NEXP / UNG) * 512);
    const unsigned lconst = 16u * (unsigned)(4 * (m & 7) + q);
    const int xoff = 128 * (m & 7) + 16 * q;
    const bool dg = (m < 8) && ((m >> 2) == (q & 1)); const int dr = m & 3;
    const float dw0 = (dg && dr == 0) ? 1.f : 0.f, dw1 = (dg && dr == 1) ? 1.f : 0.f, dw2 = (dg && dr == 2) ? 1.f : 0.f, dw3 = (dg && dr == 3) ? 1.f : 0.f;
    const int rsel = 4 * (m >> 3);
    const int osrc = 4 * (32 * (l & 1) + 4 * ((l & 15) >> 1));
    const int sc1 = 0x7F7F7F7F;
    LAS int* le = (LAS int*)(F.lds + F.wave * 2048); LAS int* lk = le + 256;
    const bool b4 = (l & 16) != 0, b3 = (l & 8) != 0, b2 = (l & 4) != 0;
    int tok = (F.bid >> UNG_SH) * NWAVES + F.wave;
    u32x4 nx0, nx1; int ne0, ne1; float ng0, ng1;
#define U4_PREFETCH(t) do { const size_t _t = (size_t)(t); nx0 = *(const u32x4*)(X8 + _t * 1024 + xoff); nx1 = *(const u32x4*)(X8 + _t * 1024 + xoff + 64); \
        ne0 = IDX[_t * 128 + l]; ne1 = IDX[_t * 128 + 64 + l]; ng0 = GATE[_t * 128 + l]; ng1 = GATE[_t * 128 + 64 + l]; } while (0)
    if (tok < T_TOK) U4_PREFETCH(tok);
    for (; tok < T_TOK; tok += step) {
        const i32x8 xb = __builtin_shufflevector(__builtin_bit_cast(i32x4, nx0), __builtin_bit_cast(i32x4, nx1), 0, 1, 2, 3, 4, 5, 6, 7);
        const int e0 = ne0, e1 = ne1; const float g0 = ng0, g1 = ng1;
        bool pf_done = false;
        const bool o0 = (e0 & (UNG - 1)) == g, o1 = (e1 & (UNG - 1)) == g;
        const unsigned long long m0 = __ballot(o0), m1 = __ballot(o1);
        const int c0 = __popcll(m0), n = c0 + __popcll(m1);
#define MBC(mm) __builtin_amdgcn_mbcnt_hi((unsigned)((mm) >> 32), __builtin_amdgcn_mbcnt_lo((unsigned)(mm), 0u))
        if (o0) { const int p = MBC(m0); le[p] = (e0 << 8) | l; lk[p] = __builtin_bit_cast(int, g0); }
        if (o1) { const int p = c0 + MBC(m1); le[p] = (e1 << 8) | (64 + l); lk[p] = __builtin_bit_cast(int, g1); }
#undef MBC
        LDS_WAIT(); asm volatile("" ::: "memory");
        for (int cb = 0; cb < n || cb == 0; cb += 64) {
            const int nc = min(n, cb + 64);
            const bool fv = (cb + l) < nc;
            const int ent = fv ? le[cb + l] : 0; const float gt = fv ? __builtin_bit_cast(float, lk[cb + l]) : 0.f; float tot = 0.f;
            const float su = SU[ent >> 8], sv = SV[ent >> 8];
            const int roff = fv ? ((ent >> 8) >> UNG_SH) * 512 : 0;
            for (int i = cb; i < nc; i += 32) {
                u32x4 row[2][8];
#pragma unroll
                for (int b = 0; b < 2; ++b) if (i + 16 * b < nc) {
#pragma unroll
                    for (int j = 0; j < 8; ++j) { const int ro = __builtin_amdgcn_ds_bpermute(rsel + 4 * (i - cb + 16 * b + 2 * j), roff);
                        row[b][j] = *(const GAS u32x4*)(ub + ((unsigned)ro + lconst)); } }
                if (!pf_done) { pf_done = true; if (tok + step < T_TOK) U4_PREFETCH(tok + step); }
#pragma unroll
                for (int b = 0; b < 2; ++b) if (i + 16 * b < nc) {
                    float p[8];
#pragma unroll
                    for (int j = 0; j < 8; ++j) { const i32x4 r4 = __builtin_bit_cast(i32x4, row[b][j]);
                        const f32x4 d = __builtin_amdgcn_mfma_scale_f32_16x16x128_f8f6f4(__builtin_shufflevector(r4, r4, 0, 1, 2, 3, -1, -1, -1, -1), xb, (f32x4){0.f, 0.f, 0.f, 0.f}, 4, 0, 0, sc1, 0, sc1);
                        p[j] = __builtin_fmaf(d[3], dw3, __builtin_fmaf(d[2], dw2, __builtin_fmaf(d[1], dw1, d[0] * dw0))); }
                    float q4[4], q2[2], q1;
#pragma unroll
                    for (int j = 0; j < 4; ++j) { const float keep = b4 ? p[4 + j] : p[j], send = b4 ? p[j] : p[4 + j]; q4[j] = keep + __shfl_xor(send, 16); }
#pragma unroll
                    for (int j = 0; j < 2; ++j) { const float keep = b3 ? q4[2 + j] : q4[j], send = b3 ? q4[j] : q4[2 + j]; q2[j] = keep + __shfl_xor(send, 8); }
                    { const float keep = b2 ? q2[1] : q2[0], send = b2 ? q2[0] : q2[1]; q1 = keep + __shfl_xor(send, 4); }
                    q1 = DPP_ADD(q1, 0xB1); q1 = DPP_ADD(q1, 0x4E);
                    const float t = __builtin_bit_cast(float, __builtin_amdgcn_ds_bpermute(osrc, __builtin_bit_cast(int, q1)));
                    if ((l >> 4) == ((i - cb + 16 * b) >> 4)) tot = t;
                }
            }
            if (!pf_done) { pf_done = true; if (tok + step < T_TOK) U4_PREFETCH(tok + step); }
            if (fv) AK[(size_t)tok * 128 + (ent & 127)] = gelu_tanh(tot * su * (1.f / 16.f)) * gt * sv;
            if (n == 0) break;
        }
        LDS_WAIT(); asm volatile("" ::: "memory");
    }
#undef U4_PREFETCH
}
template <int MODE>
__device__ __forceinline__ void peer_u4_all(const Frame& F, const Args& A) {
    const unsigned char* X8 = A.ws + WS_P + P_X8;
    const float* SU = (const float*)(A.ws + WS_SU); const float* SV = (const float*)(A.ws + WS_SV);
    const int* IDX = (const int*)(A.ws + WS_P + P_IDX); const float* GATE = (const float*)(A.ws + WS_P + P_GATE); float* AK = (float*)(MODE == 0 ? A.ws + WS_AK : A.ws + WS_P + P_SC);
    const int l = F.lane, step = F.G * NWAVES;
    const int m = l & 15, q = l >> 4;
    const GAS unsigned char* ub = (const GAS unsigned char*)(A.ws + WS_U8);
    const unsigned lconst = 16u * (unsigned)(4 * (m & 7) + q);
    const int xoff = 128 * (m & 7) + 16 * q;
    const bool dg = (m < 8) && ((m >> 2) == (q & 1)); const int dr = m & 3;
    const float dw0 = (dg && dr == 0) ? 1.f : 0.f, dw1 = (dg && dr == 1) ? 1.f : 0.f, dw2 = (dg && dr == 2) ? 1.f : 0.f, dw3 = (dg && dr == 3) ? 1.f : 0.f;
    const int rsel = 4 * (m >> 3);
    const int osrc = 4 * (32 * (l & 1) + 4 * ((l & 15) >> 1));
    const int sc1 = 0x7F7F7F7F;
    const bool b4 = (l & 16) != 0, b3 = (l & 8) != 0, b2 = (l & 4) != 0;
    const int lhi = l >> 4;
    int tok = F.bid * NWAVES + F.wave;
    u32x4 nx0, nx1; int ne0, ne1; float ng0, ng1;
#define UA_PREFETCH(t) do { const size_t _t = (size_t)(t); nx0 = *(const u32x4*)(X8 + _t * 1024 + xoff); nx1 = *(const u32x4*)(X8 + _t * 1024 + xoff + 64); \
        ne0 = IDX[_t * 128 + l]; ne1 = IDX[_t * 128 + 64 + l]; ng0 = GATE[_t * 128 + l]; ng1 = GATE[_t * 128 + 64 + l]; } while (0)
#define UA_LOADS(R, ro_, h) do { _Pragma("unroll") for (int j_ = 0; j_ < 16; ++j_) { const int o_ = __builtin_amdgcn_ds_bpermute(rsel + 4 * (32 * (h) + 2 * j_), (ro_)); \
        R[j_] = *(const GAS u32x4*)(ub + ((unsigned)o_ + lconst)); } } while (0)
#define UA_COMPUTE(R, xb_, h, tot_) do { _Pragma("unroll") for (int b_ = 0; b_ < 2; ++b_) { float p_[8]; \
        _Pragma("unroll") for (int j_ = 0; j_ < 8; ++j_) { const i32x4 r4_ = __builtin_bit_cast(i32x4, R[8 * b_ + j_]); \
            const f32x4 d_ = __builtin_amdgcn_mfma_scale_f32_16x16x128_f8f6f4(__builtin_shufflevector(r4_, r4_, 0, 1, 2, 3, -1, -1, -1, -1), (xb_), (f32x4){0.f, 0.f, 0.f, 0.f}, 4, 0, 0, sc1, 0, sc1); \
            p_[j_] = __builtin_fmaf(d_[3], dw3, __builtin_fmaf(d_[2], dw2, __builtin_fmaf(d_[1], dw1, d_[0] * dw0))); } \
        float q4_[4], q2_[2], q1_; \
        _Pragma("unroll") for (int j_ = 0; j_ < 4; ++j_) { const float keep_ = b4 ? p_[4 + j_] : p_[j_], send_ = b4 ? p_[j_] : p_[4 + j_]; q4_[j_] = keep_ + __shfl_xor(send_, 16); } \
        _Pragma("unroll") for (int j_ = 0; j_ < 2; ++j_) { const float keep_ = b3 ? q4_[2 + j_] : q4_[j_], send_ = b3 ? q4_[j_] : q4_[2 + j_]; q2_[j_] = keep_ + __shfl_xor(send_, 8); } \
        { const float keep_ = b2 ? q2_[1] : q2_[0], send_ = b2 ? q2_[0] : q2_[1]; q1_ = keep_ + __shfl_xor(send_, 4); } \
        q1_ = DPP_ADD(q1_, 0xB1); q1_ = DPP_ADD(q1_, 0x4E); \
        const float t_ = __builtin_bit_cast(float, __builtin_amdgcn_ds_bpermute(osrc, __builtin_bit_cast(int, q1_))); \
        if (lhi == 2 * (h) + b_) (tot_) = t_; } } while (0)
    u32x4 RA[16], RB[16];
    if (tok < T_TOK) { UA_PREFETCH(tok); UA_LOADS(RA, ne0 * 512, 0); }
    for (; tok < T_TOK; tok += step) {
        const i32x8 xb = __builtin_shufflevector(__builtin_bit_cast(i32x4, nx0), __builtin_bit_cast(i32x4, nx1), 0, 1, 2, 3, 4, 5, 6, 7);
        const int e0 = ne0, e1 = ne1; const float g0 = ng0, g1 = ng1;
        const int ro0 = e0 * 512, ro1 = e1 * 512;
        const float su0 = SU[e0], sv0 = SV[e0], su1 = SU[e1], sv1 = SV[e1];
        const bool more = tok + step < T_TOK;
        float tot0 = 0.f, tot1 = 0.f;
        UA_LOADS(RB, ro0, 1);
        if (more) UA_PREFETCH(tok + step);
        UA_COMPUTE(RA, xb, 0, tot0);
        UA_LOADS(RA, ro1, 0);
        UA_COMPUTE(RB, xb, 1, tot0);
        UA_LOADS(RB, ro1, 1);
        UA_COMPUTE(RA, xb, 0, tot1);
        if (more) UA_LOADS(RA, ne0 * 512, 0);
        UA_COMPUTE(RB, xb, 1, tot1);
        AK[(size_t)tok * 128 + l] = gelu_tanh(tot0 * su0 * (1.f / 16.f)) * g0 * sv0;
        AK[(size_t)tok * 128 + 64 + l] = gelu_tanh(tot1 * su1 * (1.f / 16.f)) * g1 * sv1;
    }
#undef UA_PREFETCH
#undef UA_LOADS
#undef UA_COMPUTE
}
__device__ __forceinline__ float wave_max_nonneg(float v) {
    unsigned u = __builtin_bit_cast(unsigned, v);
    u = max(u, (unsigned)__builtin_amdgcn_mov_dpp((int)u, 0xB1, 0xf, 0xf, true));
    u = max(u, (unsigned)__builtin_amdgcn_mov_dpp((int)u, 0x4E, 0xf, 0xf, true));
    u = max(u, (unsigned)__builtin_amdgcn_mov_dpp((int)u, 0x141, 0xf, 0xf, true));
    u = max(u, (unsigned)__builtin_amdgcn_mov_dpp((int)u, 0x140, 0xf, 0xf, true));
    const unsigned a = (unsigned)__builtin_amdgcn_readlane((int)u, 0), b = (unsigned)__builtin_amdgcn_readlane((int)u, 16), c = (unsigned)__builtin_amdgcn_readlane((int)u, 32), d = (unsigned)__builtin_amdgcn_readlane((int)u, 48);
    return __builtin_bit_cast(float, max(max(a, b), max(c, d)));
}
template <int MODE>
__device__ __forceinline__ void peer_v_phase(const Frame& F, const Args& A) {
    const unsigned char* V8 = A.ws + WS_V8; const int* IDX = (const int*)(A.ws + WS_P + P_IDX); const float* AK = (const float*)(A.ws + WS_AK);
    float* out = MODE == 0 ? A.out : (float*)(A.ws + WS_P + P_SC);
    const int g = F.bid & 7, nmem = F.G >> 3, l = F.lane, sub = l & 7, rr = l >> 3, n16 = l & 15, q = l >> 4, step = nmem * NWAVES;
    const GAS unsigned char* vb = (const GAS unsigned char*)(V8 + (size_t)g * NEXP * 128);
    LAS unsigned long long* rep = (LAS unsigned long long*)(F.lds + F.wave * 2048);
    const unsigned long long bm = 0xFFull << (8 * (n16 & 7));
    const int repi = 2 * q + (n16 >> 3);
    const bool vl = (n16 < 8) && (q < 2);
    LAS float* stg = (LAS float*)(F.lds + 16384 + F.wave * 512);
    int tok = 2 * ((F.bid >> 3) * NWAVES + F.wave);
    int ne[4]; float na[4];
#define V_PREFETCH(t) do { const size_t _a = (size_t)(t) * 128, _b = ((size_t)(t) + 1) * 128; ne[0] = IDX[_a + l]; ne[1] = IDX[_a + 64 + l]; ne[2] = IDX[_b + l]; ne[3] = IDX[_b + 64 + l]; \
        na[0] = AK[_a + l]; na[1] = AK[_a + 64 + l]; na[2] = AK[_b + l]; na[3] = AK[_b + 64 + l]; } while (0)
    if (tok + 1 < T_TOK) V_PREFETCH(tok);
    for (; tok + 1 < T_TOK; tok += 2 * step) {
        const int e0 = ne[0], e1 = ne[1], e2 = ne[2], e3 = ne[3]; const float a0 = na[0], a1 = na[1], a2 = na[2], a3 = na[3];
        u32x4 rowA[16], rowB[16];
#pragma unroll
        for (int i = 0; i < 16; ++i) { const int src = (8 * (i & 7) + rr) * 4;
            const int ea = __builtin_amdgcn_ds_bpermute(src, i < 8 ? e0 : e1), eb = __builtin_amdgcn_ds_bpermute(src, i < 8 ? e2 : e3);
            rowA[i] = *(const GAS u32x4*)(vb + ((unsigned)ea * 128u + 16u * (unsigned)sub)); rowB[i] = *(const GAS u32x4*)(vb + ((unsigned)eb * 128u + 16u * (unsigned)sub)); }
        f32x4 HA = {0.f, 0.f, 0.f, 0.f}, HB = {0.f, 0.f, 0.f, 0.f};
        if (l < 32) { const float* hpa = out + (size_t)tok * D + g * 128 + 4 * l; HA = *(const f32x4*)hpa; HB = *(const f32x4*)(hpa + D); }
        if (tok + 2 * step + 1 < T_TOK) V_PREFETCH(tok + 2 * step);
        const float amA = wave_max_nonneg(fmaxf(fabsf(a0), fabsf(a1))), amB = wave_max_nonneg(fmaxf(fabsf(a2), fabsf(a3)));
        const float scA = amA > 0.f ? 224.f * __builtin_amdgcn_rcpf(amA) : 0.f, invA = amA * (1.f / 224.f), scB = amB > 0.f ? 224.f * __builtin_amdgcn_rcpf(amB) : 0.f, invB = amB * (1.f / 224.f);
        { const unsigned wA = (unsigned)__builtin_amdgcn_cvt_pk_fp8_f32(a0 * scA, a1 * scA, 0, false), wB = (unsigned)__builtin_amdgcn_cvt_pk_fp8_f32(a2 * scB, a3 * scB, 0, false);
          const unsigned r0 = (wA & 0xffu) * 0x01010101u, r1 = ((wA >> 8) & 0xffu) * 0x01010101u, r2 = (wB & 0xffu) * 0x01010101u, r3 = ((wB >> 8) & 0xffu) * 0x01010101u;
          rep[l] = ((unsigned long long)r0 << 32) | r0; rep[64 + l] = ((unsigned long long)r1 << 32) | r1; rep[128 + l] = ((unsigned long long)r2 << 32) | r2; rep[192 + l] = ((unsigned long long)r3 << 32) | r3; }
        LDS_WAIT(); asm volatile("" ::: "memory");
#pragma unroll
        for (int t2 = 0; t2 < 2; ++t2) {
            f32x4 alo = {0.f, 0.f, 0.f, 0.f}, ahi = {0.f, 0.f, 0.f, 0.f};
#pragma unroll
            for (int i = 0; i < 16; ++i) { const long bop = (long)(rep[128 * t2 + 8 * i + repi] & bm); const u32x4 rw = t2 ? rowB[i] : rowA[i];
                alo = __builtin_amdgcn_mfma_f32_16x16x32_fp8_fp8(lo64(rw), bop, alo, 0, 0, 0);
                ahi = __builtin_amdgcn_mfma_f32_16x16x32_fp8_fp8(hi64(rw), bop, ahi, 0, 0, 0); }
            const float inv = t2 ? invB : invA;
            float vlo[4], vhi[4];
#pragma unroll
            for (int r = 0; r < 4; ++r) { const float tl = alo[r], th = ahi[r];
                vlo[r] = (tl + __builtin_bit_cast(float, __builtin_amdgcn_ds_bpermute(((l + 40) & 63) * 4, __builtin_bit_cast(int, tl)))) * inv;
                vhi[r] = (th + __builtin_bit_cast(float, __builtin_amdgcn_ds_bpermute(((l + 40) & 63) * 4, __builtin_bit_cast(int, th)))) * inv; }
            if (vl) {
#pragma unroll
                for (int r = 0; r < 4; ++r) { stg[64 * q + 16 * r + n16] = vlo[r]; stg[64 * q + 16 * r + n16 + 8] = vhi[r]; } }
            LDS_WAIT(); asm volatile("" ::: "memory");
            if (l < 32) { const f32x4 dv = *(const LAS f32x4*)(stg + 4 * l); *(f32x4*)(out + (size_t)(tok + t2) * D + g * 128 + 4 * l) = (t2 ? HB : HA) + dv; }
            LDS_WAIT(); asm volatile("" ::: "memory");
        }
        LDS_WAIT(); asm volatile("" ::: "memory");
    }
#undef V_PREFETCH
}
typedef float f32x16 __attribute__((ext_vector_type(16)));
template <int MODE>
__device__ __forceinline__ void peer_v4_phase(const Frame& F, const Args& A) {
    const int* IDX = (const int*)(A.ws + WS_P + P_IDX); const float* AK = (const float*)(A.ws + WS_AK);
    float* out = A.out;
    const int l = F.lane, n = l & 31, hq = l >> 5, step = F.G * NWAVES;
    const GAS unsigned char* vb = (const GAS unsigned char*)(A.ws + WS_V8);
    const unsigned lconst = 16u * (unsigned)n;
    const bool diag = ((l >> 4) & 1) == hq;
    const unsigned bytem = diag ? (0xFFu << (8 * (l & 3))) : 0u; const int dsel = (l & 15) >> 2;
    const unsigned M0 = dsel == 0 ? bytem : 0u, M1 = dsel == 1 ? bytem : 0u, M2 = dsel == 2 ? bytem : 0u, M3 = dsel == 3 ? bytem : 0u;
    const int rsel = 4 * hq;
    const int sc1 = 0x7F7F7F7F;
    const int colb = 8 * n + 4 * hq;
    int tok = F.bid * NWAVES + F.wave;
    int ne0, ne1; float na0, na1;
#define V4_PREFETCH(t) do { const size_t _t = (size_t)(t) * 128; ne0 = IDX[_t + l]; ne1 = IDX[_t + 64 + l]; na0 = AK[_t + l]; na1 = AK[_t + 64 + l]; } while (0)
#define V4_LOADS(R, ro_, h) do { int ba_ = rsel + 4 * (16 * (h)); _Pragma("unroll") for (int j_ = 0; j_ < 8; ++j_) { asm volatile("" : "+v"(ba_)); const int o_ = __builtin_amdgcn_ds_bpermute(ba_, (ro_)); ba_ += 8; \
        R[j_] = *(const GAS u32x4*)(vb + ((unsigned)o_ + lconst)); } } while (0)
#define V4_ONE(ACC, R, rep_, h, j_) do { unsigned s0_ = (unsigned)__builtin_amdgcn_readlane((int)(rep_), 16 * (h) + 2 * (j_)), s1_ = (unsigned)__builtin_amdgcn_readlane((int)(rep_), 16 * (h) + 2 * (j_) + 1); \
        asm volatile("" : "+s"(s0_), "+s"(s1_), "+v"(ACC)); \
        const i32x8 a8_ = {(int)(s0_ & M0), (int)(s0_ & M1), (int)(s0_ & M2), (int)(s0_ & M3), (int)(s1_ & M0), (int)(s1_ & M1), (int)(s1_ & M2), (int)(s1_ & M3)}; \
        const i32x4 r4_ = __builtin_bit_cast(i32x4, R[j_]); \
        ACC = __builtin_amdgcn_mfma_scale_f32_32x32x64_f8f6f4(a8_, __builtin_shufflevector(r4_, r4_, 0, 1, 2, 3, -1, -1, -1, -1), ACC, 0, 4, 0, sc1, 0, sc1); } while (0)
#define V4_COMPUTE(R, rep_, h) do { V4_ONE(acc, R, rep_, h, 0); V4_ONE(acc1, R, rep_, h, 1); V4_ONE(acc, R, rep_, h, 2); V4_ONE(acc1, R, rep_, h, 3); \
        V4_ONE(acc, R, rep_, h, 4); V4_ONE(acc1, R, rep_, h, 5); V4_ONE(acc, R, rep_, h, 6); V4_ONE(acc1, R, rep_, h, 7); } while (0)
    u32x4 RA[8], RB[8];
    if (tok < T_TOK) { V4_PREFETCH(tok); V4_LOADS(RA, ne0 * 512, 0); }
    for (; tok < T_TOK; tok += step) {
        const int e0 = ne0, e1 = ne1; const float a0 = na0, a1 = na1;
        const int ro0 = e0 * 512, ro1 = e1 * 512;
        const bool more = tok + step < T_TOK;
        V4_LOADS(RB, ro0, 1);
        if (more) V4_PREFETCH(tok + step);
        const float am = wave_max_nonneg(fmaxf(fabsf(a0), fabsf(a1)));
        const float sc = am > 0.f ? 224.f * __builtin_amdgcn_rcpf(am) : 0.f, inv = am * (1.f / 224.f);
        const unsigned w8 = (unsigned)__builtin_amdgcn_cvt_pk_fp8_f32(a0 * sc, a1 * sc, 0, false);
        const unsigned rep0 = (w8 & 0xffu) * 0x01010101u, rep1 = ((w8 >> 8) & 0xffu) * 0x01010101u;
        f32x16 acc, acc1;
#pragma unroll
        for (int i = 0; i < 16; ++i) { acc[i] = 0.f; acc1[i] = 0.f; }
        V4_COMPUTE(RA, rep0, 0); V4_LOADS(RA, ro0, 2);
        V4_COMPUTE(RB, rep0, 1); V4_LOADS(RB, ro0, 3);
        V4_COMPUTE(RA, rep0, 2); V4_LOADS(RA, ro1, 0);
        V4_COMPUTE(RB, rep0, 3); V4_LOADS(RB, ro1, 1);
        V4_COMPUTE(RA, rep1, 0); V4_LOADS(RA, ro1, 2);
        V4_COMPUTE(RB, rep1, 1); V4_LOADS(RB, ro1, 3);
        f32x4 H[4];
        u32x2 MX[4];
        { const float* hp = A.in[I_X] + (size_t)tok * D + colb; const bf16_t* mp = (const bf16_t*)(A.ws + WS_N1) + (size_t)tok * D + colb;
#pragma unroll
          for (int j = 0; j < 4; ++j) { H[j] = *(const f32x4*)(hp + 256 * j); MX[j] = *(const u32x2*)(mp + 256 * j); } }
        V4_COMPUTE(RA, rep1, 2);
        if (more) V4_LOADS(RA, ne0 * 512, 0);
        V4_COMPUTE(RB, rep1, 3);
        acc = acc + acc1;
        float ss = 0.f;
#pragma unroll
        for (int j = 0; j < 4; ++j) { H[j] = H[j] + (f32x4){bflo(MX[j].x), bfhi(MX[j].x), bflo(MX[j].y), bfhi(MX[j].y)} + (f32x4){acc[4 * j], acc[4 * j + 1], acc[4 * j + 2], acc[4 * j + 3]} * inv;
            ss += (H[j].x * H[j].x + H[j].y * H[j].y) + (H[j].z * H[j].z + H[j].w * H[j].w); }
        const float rstd = 1.f / sqrtf(wave_sum(ss) * (1.f / D) + EPS);
        { float* hp = out + (size_t)tok * D + colb;
#pragma unroll
          for (int j = 0; j < 4; ++j) *(f32x4*)(hp + 256 * j) = H[j] * rstd * *(const f32x4*)(A.in[I_FG] + colb + 256 * j); }
    }
#undef V4_PREFETCH
#undef V4_LOADS
#undef V4_COMPUTE
#undef V4_ONE
}
__device__ __forceinline__ void final_norm_phase(const Frame& F, const Args& A) {
    const int gw = F.bid * NWAVES + F.wave, NGW = F.G * NWAVES, l = F.lane; const float* fg = A.in[I_FG];
    const f32x4* gp = (const f32x4*)fg + l;
    int tok = gw;
    for (; tok + 3 * NGW < T_TOK; tok += 4 * NGW) {
        f32x4 v[4][4]; float ss[4];
#pragma unroll
        for (int b = 0; b < 4; ++b) { const f32x4* hp = (const f32x4*)(A.out + (size_t)(tok + b * NGW) * D) + l;
#pragma unroll
            for (int j = 0; j < 4; ++j) v[b][j] = hp[64 * j]; }
#pragma unroll
        for (int b = 0; b < 4; ++b) { ss[b] = 0.f;
#pragma unroll
            for (int j = 0; j < 4; ++j) ss[b] += (v[b][j].x * v[b][j].x + v[b][j].y * v[b][j].y) + (v[b][j].z * v[b][j].z + v[b][j].w * v[b][j].w); }
#pragma unroll
        for (int o = 1; o < 64; o <<= 1) {
#pragma unroll
            for (int b = 0; b < 4; ++b) ss[b] += __shfl_xor(ss[b], o); }
#pragma unroll
        for (int b = 0; b < 4; ++b) { const float rstd = 1.f / sqrtf(ss[b] * (1.f / D) + EPS); f32x4* hp = (f32x4*)(A.out + (size_t)(tok + b * NGW) * D) + l;
#pragma unroll
            for (int j = 0; j < 4; ++j) hp[64 * j] = v[b][j] * rstd * gp[64 * j]; }
    }
    for (; tok < T_TOK; tok += NGW) { f32x4* hp = (f32x4*)(A.out + (size_t)tok * D) + l; f32x4 v[4]; float ss = 0.f;
#pragma unroll
        for (int j = 0; j < 4; ++j) { v[j] = hp[64 * j]; ss += (v[j].x * v[j].x + v[j].y * v[j].y) + (v[j].z * v[j].z + v[j].w * v[j].w); }
        const float rstd = 1.f / sqrtf(wave_sum(ss) * (1.f / D) + EPS);
#pragma unroll
        for (int j = 0; j < 4; ++j) hp[64 * j] = v[j] * rstd * gp[64 * j]; }
}

#ifdef DEBUG_CHECK
constexpr size_t WS_DBG = 472 * MiB;
__device__ __forceinline__ int dbg_tok(int i) { return (i * 509 + 3) & 32767; }
__device__ __forceinline__ float gelu_ref(float x) { return 0.5f * x * (1.f + tanhf(0.7978845608028654f * (x + 0.044715f * x * x * x))); }
__global__ void __launch_bounds__(512) dbg_scores(Args a) {
    __shared__ float n2s[1024]; __shared__ float q[2048];
    const int t = dbg_tok(blockIdx.x), tid = threadIdx.x;
    const bf16_t* N2 = (const bf16_t*)(a.ws + WS_N1); const float* SC = (const float*)(a.ws + WS_P + P_SC); unsigned* dbg = (unsigned*)(a.ws + WS_DBG);
    for (int k = tid; k < 1024; k += 512) n2s[k] = bf1(N2[(size_t)t * 1024 + k]);
    __syncthreads();
    for (int r = 0; r < 4; ++r) { const int c = tid + 512 * r; float s = 0.f; for (int k = 0; k < 1024; ++k) s += n2s[k] * a.in[I_WQ][(size_t)k * 2048 + c]; q[c] = s; }
    __syncthreads();
    float md = 0.f;
    for (int r = 0; r < 4; ++r) { const int n = tid + 512 * r, hh = n >> 7, key = n & 127; const float* kX = (hh & 1) ? a.in[I_K2] : a.in[I_K1];
        float s = 0.f; for (int d = 0; d < 128; ++d) s += q[hh * 128 + d] * kX[key * 128 + d];
        md = fmaxf(md, fabsf(s - SC[(size_t)n * T_TOK + t])); }
    atomicMax(&dbg[0], __builtin_bit_cast(unsigned, md));
}
__global__ void __launch_bounds__(64) dbg_topk(Args a) {
    __shared__ float s1[8][128], s2[8][128], cv[8][256]; __shared__ float t1v[8][16], t2v[8][16]; __shared__ int t1i[8][16], t2i[8][16], exi[8][16]; __shared__ float exv[8][16];
    const int t = dbg_tok(blockIdx.x), h = threadIdx.x;
    const float* SC = (const float*)(a.ws + WS_P + P_SC); const int* IDX = (const int*)(a.ws + WS_P + P_IDX); const float* GATE = (const float*)(a.ws + WS_P + P_GATE); unsigned* dbg = (unsigned*)(a.ws + WS_DBG);
    if (h >= 8) return;
    for (int j = 0; j < 128; ++j) { s1[h][j] = SC[(size_t)(h * 256 + j) * T_TOK + t]; s2[h][j] = SC[(size_t)(h * 256 + 128 + j) * T_TOK + t]; }
    for (int r = 0; r < 16; ++r) { int b1 = 0, b2 = 0; for (int j = 1; j < 128; ++j) { if (s1[h][j] > s1[h][b1]) b1 = j; if (s2[h][j] > s2[h][b2]) b2 = j; }
        t1v[h][r] = s1[h][b1]; t1i[h][r] = b1; s1[h][b1] = -1e30f; t2v[h][r] = s2[h][b2]; t2i[h][r] = b2; s2[h][b2] = -1e30f; }
    for (int c = 0; c < 256; ++c) cv[h][c] = t1v[h][c >> 4] + t2v[h][c & 15];
    for (int r = 0; r < 16; ++r) { int bc = 0; for (int c = 1; c < 256; ++c) if (cv[h][c] > cv[h][bc]) bc = c;
        exv[h][r] = cv[h][bc]; exi[h][r] = t1i[h][bc >> 4] * 128 + t2i[h][bc & 15]; cv[h][bc] = -1e30f; }
    float sum = 0.f; const float mx0 = exv[h][0]; for (int r = 0; r < 16; ++r) { exv[h][r] = expf(exv[h][r] - mx0); } for (int r = 0; r < 16; ++r) sum += exv[h][r];
    unsigned miss = 0; float gd = 0.f;
    for (int w = 0; w < 16; ++w) { const int e = IDX[(size_t)t * 128 + h * 16 + w]; const float g = GATE[(size_t)t * 128 + h * 16 + w]; bool found = false;
        for (int r = 0; r < 16; ++r) if (exi[h][r] == e) { found = true; gd = fmaxf(gd, fabsf(g - exv[h][r] / sum)); }
        if (!found) ++miss; }
    atomicAdd(&dbg[1], miss); atomicMax(&dbg[3], __builtin_bit_cast(unsigned, gd));
}
__global__ void __launch_bounds__(512) dbg_experts_pre(Args a) {
    __shared__ float n2s[1024]; __shared__ float ak[128]; __shared__ int ek[128]; __shared__ float red[8];
    const int t = dbg_tok(blockIdx.x), tid = threadIdx.x, lane = tid & 63, wave = tid >> 6;
    const bf16_t* N2 = (const bf16_t*)(a.ws + WS_N1); const int* IDX = (const int*)(a.ws + WS_P + P_IDX); const float* GATE = (const float*)(a.ws + WS_P + P_GATE);
    float* rows = (float*)(a.ws + WS_DBG + MiB);
    for (int k = tid; k < 1024; k += 512) n2s[k] = bf1(N2[(size_t)t * 1024 + k]);
    if (tid < 128) ek[tid] = IDX[(size_t)t * 128 + tid];
    __syncthreads();
    for (int k = wave * 16; k < wave * 16 + 16; ++k) { const float* u = a.in[I_PU] + (size_t)ek[k] * 1024; float s = 0.f; for (int j = lane; j < 1024; j += 64) s += u[j] * n2s[j];
        s = wave_sum(s); if (lane == 0) ak[k] = gelu_ref(s) * GATE[(size_t)t * 128 + k]; }
    __syncthreads();
    float h2[2]; float ss = 0.f;
    for (int r = 0; r < 2; ++r) { const int d = tid + 512 * r; float o = 0.f; for (int k = 0; k < 128; ++k) o += ak[k] * a.in[I_PV][(size_t)ek[k] * 1024 + d]; h2[r] = a.out[(size_t)t * 1024 + d] + o; ss += h2[r] * h2[r]; }
    ss = wave_sum(ss); if (lane == 0) red[wave] = ss; __syncthreads();
    float tot = 0.f; for (int w = 0; w < 8; ++w) tot += red[w];
    const float rstd = 1.f / sqrtf(tot / 1024.f + EPS);
    for (int r = 0; r < 2; ++r) { const int d = tid + 512 * r; rows[(size_t)blockIdx.x * 1024 + d] = h2[r] * rstd * a.in[I_FG][d]; }
}
__global__ void __launch_bounds__(512) dbg_experts_post(Args a) {
    const int t = dbg_tok(blockIdx.x), tid = threadIdx.x; const float* rows = (const float*)(a.ws + WS_DBG + MiB); float* dbgf = (float*)(a.ws + WS_DBG);
    float e = 0.f, n = 0.f;
    for (int r = 0; r < 2; ++r) { const int d = tid + 512 * r; const float x = rows[(size_t)blockIdx.x * 1024 + d], y = a.out[(size_t)t * 1024 + d]; e += (x - y) * (x - y); n += x * x; }
    e = wave_sum(e); n = wave_sum(n); if ((tid & 63) == 0) { atomicAdd(&dbgf[4], e); atomicAdd(&dbgf[5], n); }
}
__global__ void __launch_bounds__(512) dbg_report(Args a, int which) {
    const unsigned* dbg = (const unsigned*)(a.ws + WS_DBG); const float* dbgf = (const float*)(a.ws + WS_DBG);
    const float mA = dbgf[0], gd = dbgf[3]; const unsigned miss = dbg[1]; const float relC = sqrtf(dbgf[4] / fmaxf(dbgf[5], 1e-30f));
    float X;
    if (which == 0) { int mask = 0; if (mA > 0.05f) mask |= 1; if (miss > 400u) mask |= 2; if (relC > 0.05f) mask |= 4; if (gd > 0.02f) mask |= 8; X = 1000.f + 100.f * mask; }
    else if (which == 1) X = 1e6f * mA; else if (which == 2) X = 100.f + (float)miss; else if (which == 3) X = 1e6f * relC; else X = 1e6f * gd;
    for (size_t i = (size_t)blockIdx.x * 512 + threadIdx.x; i < (size_t)T_TOK * D; i += (size_t)gridDim.x * 512) a.out[i] = (i == 0) ? X : 0.f;
}
#endif

constexpr int NPH = 13;
__global__ void __launch_bounds__(NWAVES * 64, 2) fwd_kernel(Args args) {
    extern __shared__ __attribute__((aligned(16))) unsigned char lds_raw[];
    Frame F;
    F.lds = (LAS unsigned char*)lds_raw;
    F.tid = threadIdx.x; F.lane = F.tid & 63; F.wave = __builtin_amdgcn_readfirstlane(F.tid >> 6);
    F.G = gridDim.x; F.bid = blockIdx.x;
    volatile LAS unsigned* MISC = (volatile LAS unsigned*)(F.lds + MISC_OFF);
    for (int u = F.tid; u < (LDS_BYTES - LDSCTL_OFF) / 4; u += NWAVES * 64) ((LAS unsigned*)(F.lds + LDSCTL_OFF))[u] = 0u;
    __syncthreads();
    unsigned* ctl = (unsigned*)(args.ws + WS_CTL);
    const int lo = args.ph_lo, hi = args.ph_hi;
    XcdBarrier bar; bar.bar = ctl + CW_BAR + args.li * XCD_BAR_WORDS; bar.x = 0; bar.st = nullptr; bar.wave = F.wave;
    if (hi - lo > 1) bar = xcd_barrier_post(ctl + CW_BAR + args.li * XCD_BAR_WORDS, MISC + 8, F.wave);
#define IN(k) (lo <= (k) && (k) < hi)
#ifdef PROBE_TS
#define STAMP(k) do { if (F.bid == 0 && F.tid == 0) ((unsigned long long*)(args.ws + (472u << 20)))[(k)] = __builtin_amdgcn_s_memrealtime(); } while (0)
#else
#define STAMP(k) do { } while (0)
#endif
#define SEAM(k) do { if (IN(k) && IN((k) + 1)) { xcd_barrier(bar); if (XTRA_BAR) xcd_barrier(bar); } STAMP((k) + 1); } while (0)
    unsigned char* ws = args.ws;
    bf16_t* P = (bf16_t*)(ws + WS_P);

#define REFRESH() do { int z_ = 0; asm volatile("" : "+s"(z_)); F.lane = (int)__builtin_amdgcn_mbcnt_hi(~0u, __builtin_amdgcn_mbcnt_lo(~0u, (unsigned)z_)); F.tid = F.wave * 64 + F.lane; } while (0)
    STAMP(0);
    if (IN(0)) { phase0(F, args); SEAM(0); }
    if (IN(1)) { REFRESH();
        if (F8_LO > 0) { pg8::Gemm g{(const bf16_t*)(ws + WS_N1), (const bf16_t*)(ws + WS_WIN), T_TOK, F8_LO * 256, D, D}; pg8::StaticOrder S; S.init(T_TOK, F8_LO * 256, F.G, F.bid);
            pg8::EpiProj E{P, (float*)(ws + WS_ALR), 0}; pg8::gemm_phase<pg8::EpiProj, pg8::StaticOrder, false, true, false>(F.lds, g, S, E, F.wave); }
        if (F8_LO < 21) {
            pg8::Gemm g{(const bf16_t*)(ws + WS_N18), (const bf16_t*)(ws + WS_W8 + (size_t)F8_LO * 256 * 1024), T_TOK, (21 - F8_LO) * 256, D / 2, D / 2, 0x7B7B7B7B, 0x75757575};
            pg8::StaticOrder S; S.init(T_TOK, (21 - F8_LO) * 256, F.G, ((F8_LO * 128) % F.G) != 0 ? F.G - 1 - F.bid : F.bid);
            pg8::EpiProj E{P, (float*)(ws + WS_ALR), F8_LO}; pg8::gemm_phase<pg8::EpiProj, pg8::StaticOrder, false, true, true>(F.lds, g, S, E, F.wave); }
        {
            REFRESH();
            const int nwg = (T_TOK / 256) * (NPROJ / 256), rem = nwg % F.G;
            if (rem == 0) convert_tables(F, args, F.bid * NWAVES + F.wave, F.G * NWAVES);
            else if (F.bid >= rem) convert_tables(F, args, (F.bid - rem) * NWAVES + F.wave, (F.G - rem) * NWAVES);
        }
        SEAM(1);
    }
    if (IN(2)) { REFRESH();
        if (DRY_EXP == 12) { gla_chunk_phase<true>(F, args); for (int it = F.bid; it < 256; it += F.G) for (int g4 = 0; g4 < 4; ++g4) sgu_unit<true>(F, args, 4 * it + g4, g4 == 0); __syncthreads(); }
        gla_chunk_phase<false>(F, args);
        for (int it = F.bid; it < 256; it += F.G) for (int g4 = 0; g4 < 4; ++g4) sgu_unit<false>(F, args, 4 * it + g4, g4 == 0);
        SEAM(2);
    }
    if (IN(3)) { REFRESH(); if (DRY_EXP == 13 || DRY_EXP == 15) { gla_scan<true>(F, args); __syncthreads(); } gla_scan<false>(F, args); SEAM(3); }
    if (IN(4)) { REFRESH(); if (DRY_EXP == 14 || DRY_EXP == 15) { gla_out_phase<true>(F, args); __syncthreads(); } gla_out_phase<false>(F, args); SEAM(4); }
    if (IN(5)) { REFRESH();
        { pg8::Gemm g{P + PC_R, (const bf16_t*)(ws + WS_WA), T_TOK, D, 1024, PLD}; pg8::StaticOrder S; S.init(T_TOK, D, F.G, F.bid);
          pg8::EpiBrAB E{P}; pg8::gemm_phase<pg8::EpiBrAB, pg8::StaticOrder, true, true, false, true>(F.lds, g, S, E, F.wave); }
        SEAM(5);
    }
    if (IN(6)) { REFRESH();
        pg8::Gemm g{P + PC_MRG, (const bf16_t*)(ws + WS_WOUT), T_TOK, D, D, PLD}; pg8::StaticOrder S; S.init(T_TOK, D, F.G, F.bid);
        pg8::EpiOut E{(bf16_t*)(ws + WS_N1)}; pg8::gemm_phase<pg8::EpiOut, pg8::StaticOrder, true, true>(F.lds, g, S, E, F.wave);
        SEAM(6);
    }
    if (IN(7)) { REFRESH();
        const int gw = F.bid * NWAVES + F.wave, NGW = F.G * NWAVES;
        { int m = gw; for (; m + 3 * NGW < T_TOK; m += 4 * NGW) rms_rows_to_bf16<(SC_F8 ? 2 : 3), 4>(F.lane, args.in[I_X] + (size_t)m * D, (size_t)NGW * D, args.in[I_N2G], (bf16_t*)(ws + WS_P + P_N2) + (size_t)m * D, (size_t)NGW * D, (unsigned*)(ws + WS_P + P_X8) + (size_t)m * 256, (size_t)NGW * 256, (const bf16_t*)(ws + WS_N1) + (size_t)m * D, (size_t)NGW * D);
          for (; m < T_TOK; m += NGW) rms_rows_to_bf16<(SC_F8 ? 2 : 3), 1>(F.lane, args.in[I_X] + (size_t)m * D, 0, args.in[I_N2G], (bf16_t*)(ws + WS_P + P_N2) + (size_t)m * D, 0, (unsigned*)(ws + WS_P + P_X8) + (size_t)m * 256, 0, (const bf16_t*)(ws + WS_N1) + (size_t)m * D, 0); }
        SEAM(7);
    }
    if (IN(8)) { REFRESH();
        pg8::StaticOrder S; S.init(T_TOK, 2048, F.G, F.bid); pg8::EpiScores E{(bf16_t*)(ws + WS_P + P_SC)};
        if (SC_F8) { pg8::Gemm g{(const bf16_t*)(ws + WS_P + P_X8), (const bf16_t*)(ws + WS_WQF), T_TOK, 2048, D / 2, D / 2, 0x7B7B7B7B, 0x75757575};
            pg8::gemm_phase<pg8::EpiScores, pg8::StaticOrder, true, true, true>(F.lds, g, S, E, F.wave); }
        else { pg8::Gemm g{(const bf16_t*)(ws + WS_P + P_N2), (const bf16_t*)(ws + WS_WQF), T_TOK, 2048, D, D};
            pg8::gemm_phase<pg8::EpiScores, pg8::StaticOrder, true, true>(F.lds, g, S, E, F.wave); }
        SEAM(8);
    }
    if (IN(9)) { REFRESH(); peer_topk(F, args); SEAM(9); }
    if (IN(10)) { REFRESH(); if constexpr (UNG == 1) peer_u4_all<0>(F, args); else peer_u4_phase<0>(F, args); SEAM(10); }
    if (IN(11)) { REFRESH(); if (V_F4) peer_v4_phase<0>(F, args); else { if (DRY_EXP == 1) { peer_v_phase<1>(F, args); __syncthreads(); } peer_v_phase<0>(F, args); SEAM(11); } }
    if (IN(12)) { REFRESH(); if (!V_F4) final_norm_phase(F, args); }
#undef IN
#undef SEAM
}


#ifdef PROBE_TS
__global__ void __launch_bounds__(512) probe_report(Args a, int pi, int pj) {
    const unsigned long long* ts = (const unsigned long long*)(a.ws + (472u << 20));
    const float X1 = 10.f * (float)(ts[pi + 1] - ts[pi]) * 0.01f, X2 = (float)(ts[pj + 1] - ts[pj]) * 0.01f;
    for (size_t i = (size_t)blockIdx.x * 512 + threadIdx.x; i < (size_t)T_TOK * D; i += (size_t)gridDim.x * 512) a.out[i] = (i == 0) ? X1 : X2;
}
#endif
#ifdef PROBE_MFMA
__global__ void __launch_bounds__(64) probe_mfma(Args a) {
    const int l = threadIdx.x;
    i32x4 av = {0, 0, 0, 0};
    if (l == PROBE_L) av[PROBE_P >> 3] = 0x2 << (4 * (PROBE_P & 7));
    i32x8 b1, b2;
    for (int r = 0; r < 8; ++r) { unsigned w1 = 0, w2 = 0;
        for (int c = 0; c < 4; ++c) { const int b = 4 * r + c; int t = 0;
            t = __builtin_amdgcn_cvt_pk_fp8_f32((float)((b & 15) + 1), (float)(1 + (b >> 4) + 2 * (l >> 4)), 0, false);
            w1 |= ((unsigned)t & 0xffu) << (8 * c); w2 |= (((unsigned)t >> 8) & 0xffu) << (8 * c); }
        b1[r] = (int)w1; b2[r] = (int)w2; }
    const f32x4 z = {0.f, 0.f, 0.f, 0.f};
    const f32x4 d1 = __builtin_amdgcn_mfma_scale_f32_16x16x128_f8f6f4(__builtin_shufflevector(av, av, 0, 1, 2, 3, -1, -1, -1, -1), b1, z, 4, 0, 0, 0x7F7F7F7F, 0, 0x7F7F7F7F);
    const f32x4 d2 = __builtin_amdgcn_mfma_scale_f32_16x16x128_f8f6f4(__builtin_shufflevector(av, av, 0, 1, 2, 3, -1, -1, -1, -1), b2, z, 4, 0, 0, 0x7F7F7F7F, 0, 0x7F7F7F7F);
    float* st = (float*)(a.ws + (472u << 20));
    *(f32x4*)(st + 8 * l) = d1; *(f32x4*)(st + 8 * l + 4) = d2;
}
__global__ void __launch_bounds__(512) probe_mfma_report(Args a) {
    const int row = PROBE_L & 15;
    const float* st = (const float*)(a.ws + (472u << 20)) + 8 * (16 * (row >> 2)) + (row & 3); const float X1 = 10.f * st[0], X2 = st[4];
    for (size_t i = (size_t)blockIdx.x * 512 + threadIdx.x; i < (size_t)T_TOK * D; i += (size_t)gridDim.x * 512) a.out[i] = (i == 0) ? X1 : X2;
}
#endif
extern "C" void kernel_launch(void* const* d_in, const int* in_sizes, int n_in, void* d_out, int out_size, void* d_ws, size_t ws_size, hipStream_t stream) {
    static int grid = 0;
    if (grid == 0) {
        if (n_in != 20 || in_sizes[0] != T_TOK * D || out_size != T_TOK * D || ws_size < WS_END) {
            fprintf(stderr, "kernel_launch: unexpected shapes: n_in %d in0 %d out %d ws %zu (need %zu)\n", n_in, n_in > 0 ? in_sizes[0] : -1, out_size, ws_size, (size_t)WS_END); grid = -1; return; }
        int dev = 0, cus = 0;
        if (hipGetDevice(&dev) != hipSuccess || hipDeviceGetAttribute(&cus, hipDeviceAttributeMultiprocessorCount, dev) != hipSuccess) { grid = -1; return; }
        if (hipFuncSetAttribute((const void*)fwd_kernel, hipFuncAttributeMaxDynamicSharedMemorySize, LDS_BYTES) != hipSuccess) { fprintf(stderr, "kernel_launch: hipFuncSetAttribute failed\n"); grid = -1; return; }
        int per_cu = 0;
        if (hipOccupancyMaxActiveBlocksPerMultiprocessor(&per_cu, (const void*)fwd_kernel, NWAVES * 64, LDS_BYTES) != hipSuccess || per_cu < 1) fprintf(stderr, "kernel_launch: occupancy query says %d\n", per_cu);
        (void)hipGetLastError();
        grid = cus;
    }
    if (grid < 0) return;
    (void)hipMemsetAsync((char*)d_ws + WS_CTL, 0, CTL_ZERO_BYTES, stream);
    Args a{};
    for (int i = 0; i < 20; ++i) a.in[i] = (const float*)d_in[i];
    a.out = (float*)d_out; a.ws = (unsigned char*)d_ws;
#ifdef PROBE_MFMA
    hipLaunchKernelGGL(probe_mfma, dim3(1), dim3(64), 0, stream, a);
    hipLaunchKernelGGL(probe_mfma_report, dim3(1024), dim3(512), 0, stream, a);
    return;
#endif
#ifndef LAUNCH_LIST
#define LAUNCH_LIST {0, NPH}
#endif
    static const int ranges[][2] = { LAUNCH_LIST };
    const int nl = (int)(sizeof(ranges) / sizeof(ranges[0]));
    for (int li = 0; li < nl; ++li) { a.ph_lo = ranges[li][0]; a.ph_hi = ranges[li][1]; a.li = li;
        hipLaunchKernelGGL(fwd_kernel, dim3(grid), dim3(NWAVES * 64), LDS_BYTES, stream, a); }
}
```

```cpp
#include <hip/hip_runtime.h>
#include <cstdio>
#include <cstdint>


#ifndef XTRA_BAR
#define XTRA_BAR 0
#endif
#ifndef DRY_EXP
#define DRY_EXP 0
#endif
#ifndef DUP_PHASE
#define DUP_PHASE -1
#endif
#ifndef MK_N_LAUNCHES
#define MK_N_LAUNCHES 1
#endif

#define LAS __attribute__((address_space(3)))
#define GAS __attribute__((address_space(1)))
typedef unsigned short bf16_t;
typedef short bf16x8 __attribute__((ext_vector_type(8)));
typedef float f32x4 __attribute__((ext_vector_type(4)));
typedef float f32x2 __attribute__((ext_vector_type(2)));
typedef unsigned u32x4 __attribute__((ext_vector_type(4)));
typedef unsigned u32x2 __attribute__((ext_vector_type(2)));
typedef int i32x4 __attribute__((ext_vector_type(4)));
typedef int i32x8 __attribute__((ext_vector_type(8)));
typedef __bf16 bf16x2_t __attribute__((ext_vector_type(2)));

constexpr int T_TOK = 32768, D = 1024, SEQ = 4096, NBATCH = 8;
constexpr int NPROJ = 5376;
constexpr int PLD = 5120;
constexpr int PC_Q = 0, PC_K = 512, PC_V = 1024, PC_R = 1536, PC_SU = 2048, PC_SV = 2560, PC_GA = 3072, PC_GB = 4096;
constexpr int PC_MRG = 512;
constexpr float EPS = 1e-6f;
constexpr int NEXP = 16384;
#ifndef U_NG
#define U_NG 1
#endif
#ifndef V_F4
#define V_F4 1
#endif
#ifndef SC_F8
#define SC_F8 0
#endif
#ifndef F8_LO
#define F8_LO 11
#endif
constexpr int UNG = U_NG, UNG_SH = (U_NG == 8 ? 3 : (U_NG == 4 ? 2 : (U_NG == 2 ? 1 : 0)));

constexpr size_t MiB = 1u << 20;
constexpr size_t WS_CTL = 0, CTL_ZERO_BYTES = 64 * 1024;
constexpr size_t WS_WIN = 1 * MiB;
constexpr size_t WS_WA = 12 * MiB;
constexpr size_t WS_WB = 13 * MiB;
constexpr size_t WS_WOUT = 14 * MiB;
constexpr size_t WS_WQF = 16 * MiB;
constexpr size_t WS_U8 = 20 * MiB;
constexpr size_t WS_V8 = 36 * MiB;
constexpr size_t WS_SU = 52 * MiB;
constexpr size_t WS_SV = 52 * MiB + 65536;
constexpr size_t WS_AK = 53 * MiB;
constexpr size_t WS_DEC = 84 * MiB;
constexpr size_t WS_ALR = 85 * MiB;
constexpr size_t WS_N1 = 87 * MiB;
constexpr size_t WS_P = 151 * MiB;
constexpr size_t WS_W8 = 472 * MiB;
constexpr size_t WS_N18 = 478 * MiB;
constexpr size_t WS_END = 510 * MiB;
constexpr size_t P_N2 = 128 * MiB;
constexpr size_t P_SC = 0, P_IDX = 256 * MiB, P_GATE = 272 * MiB, P_X8 = 288 * MiB;

constexpr int CW_BAR = 4096;

constexpr int RING_BYTES = 131072;
constexpr int LDSCTL_OFF = RING_BYTES, MISC_OFF = LDSCTL_OFF + 320;
constexpr int LDS_BYTES = 147456;
constexpr int NWAVES = 8;

__device__ __forceinline__ unsigned pk2(float lo, float hi) { const f32x2 v = {lo, hi}; const bf16x2_t b = __builtin_convertvector(v, bf16x2_t); return __builtin_bit_cast(unsigned, b); }
__device__ __forceinline__ unsigned f2bf(float f) { return pk2(f, 0.f) & 0xffffu; }
__device__ __forceinline__ float bflo(unsigned w) { return __builtin_bit_cast(float, w << 16); }
__device__ __forceinline__ float bfhi(unsigned w) { return __builtin_bit_cast(float, w & 0xffff0000u); }
__device__ __forceinline__ float bf1(bf16_t h) { return __builtin_bit_cast(float, ((unsigned)h) << 16); }
__device__ __forceinline__ float sigmoidf_(float x) { return __builtin_amdgcn_rcpf(1.f + __expf(-x)); }
__device__ __forceinline__ float gelu_tanh(float x) { const float y = 1.5957691216057308f * (x + 0.044715f * x * x * x); return x * sigmoidf_(y); }
__device__ __forceinline__ float siluf_(float x) { return x * sigmoidf_(x); }
__device__ __forceinline__ float wave_sum(float v) {
#pragma unroll
    for (int o = 1; o < 64; o <<= 1) v += __shfl_xor(v, o);
    return v;
}
#define LDS_WAIT() asm volatile("s_waitcnt lgkmcnt(0)" ::: "memory")
#define VM_WAIT() asm volatile("s_waitcnt vmcnt(0)" ::: "memory")

__device__ __forceinline__ int lane_now() { int z = 0; asm volatile("" : "+s"(z)); return (int)__builtin_amdgcn_mbcnt_hi(~0u, __builtin_amdgcn_mbcnt_lo(~0u, (unsigned)z)); }
namespace pg8 {
constexpr int BM = 256, BK = 64, HALF = 128, HTB = HALF * BK * 2, STAGE_BYTES = 8 * HTB, NXCD = 8, WGM = 8;
__host__ __device__ __forceinline__ int lds_byte(int r, int c) { const int st = (r >> 4) * 2 + (c >> 5), rr = r & 15, cc = c & 31, ob = rr * 64 + cc * 2; return st * 1024 + (ob ^ (((ob >> 9) & 1) << 5)); }
__host__ __device__ __forceinline__ void stage_rc(int b, int& R, int& C) { const int st = b / 1024, sb = b % 1024, swz = sb ^ (((sb >> 9) & 1) << 5); R = (st >> 1) * 16 + swz / 64; C = (st & 1) * 32 + (swz % 64) / 2; }
__host__ __device__ __forceinline__ int perm32(int rho) { const int n = rho >> 4, i = rho & 15; return 8 * (i >> 2) + 4 * n + (i & 3); }

struct Unit { int pm, pn; };
struct Gemm { const bf16_t* A; const bf16_t* Bt; int M, N, K, lda; int sa = 0, sb = 0; };

struct StaticOrder {
    int nM, nN, nwg, G, c;
    __host__ __device__ void init(int M, int N, int G_, int c_) { nM = M / BM; nN = N / BM; nwg = nM * nN; G = G_; c = c_; }
    __host__ __device__ bool next(int i, Unit& u) const {
        const long L = (long)i * G + c; if (L >= nwg) return false;
        int wgid = (int)L; { const int q = nwg / NXCD, r = nwg % NXCD, xcd = wgid % NXCD, off = wgid / NXCD; wgid = (xcd < r ? xcd * (q + 1) : r * (q + 1) + (xcd - r) * q) + off; }
        const int nig = WGM * nN, gid = wgid / nig, fm = gid * WGM, gsz = (nM - fm) < WGM ? (nM - fm) : WGM;
        u.pm = fm + ((wgid % nig) % gsz); u.pn = (wgid % nig) / gsz; return true;
    }
    __device__ __forceinline__ void a_ready(const Unit&) const {}
    __device__ __forceinline__ void done(const Unit&) const {}
};

template <class Epi, class Sched, bool ALIGN_EPI = false, bool SP2 = false, bool F8 = false, bool MID = false>
__device__ __forceinline__ void gemm_phase(LAS unsigned char* lds, const Gemm g, const Sched& S, const Epi& E, int wave_id) {
    const int wid = wave_id, lane = lane_now(), tid = wid * 64 + lane, wr = wid >> 2, wc = wid & 3, fr = lane & 15, fq = lane >> 4;
    const int K = g.K, nt = K / BK, lda = g.lda; const int scA = g.sa, scB = g.sb; (void)scA; (void)scB;
    unsigned voffA[2], voffB[2];
#pragma unroll
    for (int i = 0; i < 2; ++i) { int R, C; stage_rc(tid * 16 + i * 8192, R, C); const int Rb = Epi::PERM ? ((R & ~31) + perm32(R & 31)) : R;
        voffA[i] = (unsigned)(R * lda + C) * 2u; voffB[i] = (unsigned)(Rb * K + C) * 2u; }
    const size_t kstep = (size_t)(BK * 2);
    const size_t hstepA = (size_t)HALF * lda * 2, hstepB = (size_t)HALF * K * 2;
    const size_t tstepA = 2 * hstepA, tstepB = 2 * hstepB;
    const unsigned ldsw = (unsigned)wid * 1024u; const unsigned ldsbase = (unsigned)(__UINTPTR_TYPE__)lds + ldsw;
    const int aoff = lds_byte(wr * 64 + fr, fq * 8), boff = lds_byte(wc * 32 + fr, fq * 8);
#define PG8_SA(b, h) (((b) * 2 + (h)) * HTB)
#define PG8_SB(b, h) ((4 + (b) * 2 + (h)) * HTB)
#define PG8_STAGE(bufoff, gbase, voff) do { _Pragma("unroll") for (int _i = 0; _i < 2; ++_i) \
        asm volatile("s_mov_b32 m0, %2\n\ts_nop 0\n\tglobal_load_lds_dwordx4 %0, %1" :: "v"((voff)[_i]), "s"((const char*)(gbase)), "s"(ldsbase + (unsigned)((bufoff) + _i * 8192)) : "memory", "m0"); } while (0)
#define PG8_LDA(dst, b, h) do { _Pragma("unroll") for (int m = 0; m < 4; ++m) _Pragma("unroll") for (int k = 0; k < 2; ++k) dst[m][k] = *(const LAS bf16x8*)(lds + PG8_SA(b, h) + aoff + m * 2048 + k * 1024); } while (0)
#define PG8_LDB(dst, b, h) do { _Pragma("unroll") for (int n = 0; n < 2; ++n) _Pragma("unroll") for (int k = 0; k < 2; ++k) dst[n][k] = *(const LAS bf16x8*)(lds + PG8_SB(b, h) + boff + n * 2048 + k * 1024); } while (0)
#define PG8_CAT(x) __builtin_shufflevector(__builtin_bit_cast(i32x4, (x)[0]), __builtin_bit_cast(i32x4, (x)[1]), 0, 1, 2, 3, 4, 5, 6, 7)
#define PG8_MMA(ai, bj, At, Bt) do { __builtin_amdgcn_s_setprio(1); if constexpr (F8) { _Pragma("unroll") for (int m = 0; m < 4; ++m) _Pragma("unroll") for (int n = 0; n < 2; ++n) \
        acc[ai][bj][m][n] = __builtin_amdgcn_mfma_scale_f32_16x16x128_f8f6f4(PG8_CAT(Bt[n]), PG8_CAT(At[m]), acc[ai][bj][m][n], 0, 0, 0, scB, 0, scA); } else { \
        _Pragma("unroll") for (int m = 0; m < 4; ++m) _Pragma("unroll") for (int n = 0; n < 2; ++n) _Pragma("unroll") for (int k = 0; k < 2; ++k) \
        acc[ai][bj][m][n] = __builtin_amdgcn_mfma_f32_16x16x32_bf16(Bt[n][k], At[m][k], acc[ai][bj][m][n], 0, 0, 0); } __builtin_amdgcn_s_setprio(0); } while (0)
#define PG8_WAIT_V(n) asm volatile("s_waitcnt vmcnt(" #n ")" ::: "memory")
#define PG8_WAIT_L(n) asm volatile("s_waitcnt lgkmcnt(" #n ")" ::: "memory")
#define PG8_BAR __builtin_amdgcn_s_barrier()
#define PG8_SCHED __builtin_amdgcn_sched_barrier(0)
    Unit cur, nxt; int ui = 0;
    if (!S.next(0, cur)) return;
    f32x4 acc[2][2][4][2];
#pragma unroll
    for (int a = 0; a < 2; ++a)
#pragma unroll
        for (int b = 0; b < 2; ++b)
#pragma unroll
            for (int m = 0; m < 4; ++m)
#pragma unroll
                for (int n = 0; n < 2; ++n) acc[a][b][m][n] = (f32x4){0.f, 0.f, 0.f, 0.f};
    bf16x8 At[4][2], B0[2][2], B1[2][2];
    const char* cA = (const char*)g.A + (size_t)cur.pm * tstepA; const char* cB = (const char*)g.Bt + (size_t)cur.pn * tstepB;
    S.a_ready(cur);
    if constexpr (SP2) {
        PG8_STAGE(PG8_SB(0, 0), cB, voffB); PG8_STAGE(PG8_SB(0, 1), cB + hstepB, voffB); PG8_STAGE(PG8_SA(0, 0), cA, voffA); PG8_STAGE(PG8_SA(0, 1), cA + hstepA, voffA);
        if (wr == 1) PG8_BAR;
        PG8_WAIT_V(2); PG8_BAR;
        PG8_STAGE(PG8_SB(1, 0), cB + kstep, voffB); PG8_STAGE(PG8_SA(1, 0), cA + kstep, voffA); PG8_STAGE(PG8_SB(1, 1), cB + hstepB + kstep, voffB);
        PG8_WAIT_V(6); PG8_BAR;
    } else {
        PG8_STAGE(PG8_SB(0, 0), cB, voffB); PG8_STAGE(PG8_SA(0, 0), cA, voffA); PG8_STAGE(PG8_SB(0, 1), cB + hstepB, voffB); PG8_STAGE(PG8_SA(0, 1), cA + hstepA, voffA);
        if (wr == 1) PG8_BAR;
        PG8_WAIT_V(4); PG8_BAR;
        PG8_STAGE(PG8_SB(1, 0), cB + kstep, voffB); PG8_STAGE(PG8_SA(1, 0), cA + kstep, voffA); PG8_STAGE(PG8_SB(1, 1), cB + hstepB + kstep, voffB);
        PG8_WAIT_V(6); PG8_BAR;
    }
    for (;;) {
        const bool has_next = S.next(ui + 1, nxt);
        const char* nA = has_next ? (const char*)g.A + (size_t)nxt.pm * tstepA : cA; const char* nB = has_next ? (const char*)g.Bt + (size_t)nxt.pn * tstepB : cB;
#pragma nounroll
        for (int t = 0; t < nt; t += 2) {
            if constexpr (MID) { if (t == (nt >> 1)) E.mid(acc, cur, wr, wc); }
            const bool last = (t == nt - 2);
            const char* a1 = cA + (size_t)(t + 1) * kstep;
            const char* a2 = last ? nA : cA + (size_t)(t + 2) * kstep; const char* b2 = last ? nB : cB + (size_t)(t + 2) * kstep;
            const char* a3 = a2 + kstep; const char* b3 = b2 + kstep;
            if (last && has_next) S.a_ready(nxt);
            if constexpr (SP2) {
            PG8_LDB(B0, 0, 0); PG8_LDB(B1, 0, 1); PG8_SCHED; PG8_LDA(At, 0, 0); PG8_STAGE(PG8_SA(1, 1), a1 + hstepA, voffA);
            PG8_WAIT_V(8); PG8_WAIT_L(0); PG8_BAR; PG8_MMA(0, 0, At, B0); PG8_MMA(0, 1, At, B1); PG8_BAR; PG8_SCHED;
            PG8_LDA(At, 0, 1); PG8_STAGE(PG8_SB(0, 0), b2, voffB); PG8_STAGE(PG8_SB(0, 1), b2 + hstepB, voffB); PG8_STAGE(PG8_SA(0, 0), a2, voffA);
            PG8_WAIT_V(8); PG8_WAIT_L(0); PG8_BAR; PG8_MMA(1, 0, At, B0); PG8_MMA(1, 1, At, B1); PG8_BAR; PG8_SCHED;
            PG8_LDB(B0, 1, 0); PG8_LDB(B1, 1, 1); PG8_SCHED; PG8_LDA(At, 1, 0); PG8_STAGE(PG8_SA(0, 1), a2 + hstepA, voffA);
            PG8_WAIT_V(8); PG8_WAIT_L(0); PG8_BAR; PG8_MMA(0, 0, At, B0); PG8_MMA(0, 1, At, B1); PG8_BAR; PG8_SCHED;
            PG8_LDA(At, 1, 1); PG8_STAGE(PG8_SB(1, 0), b3, voffB); PG8_STAGE(PG8_SB(1, 1), b3 + hstepB, voffB); PG8_STAGE(PG8_SA(1, 0), a3, voffA);
            PG8_WAIT_V(8); PG8_WAIT_L(0); PG8_BAR; PG8_MMA(1, 0, At, B0); PG8_MMA(1, 1, At, B1); PG8_BAR; PG8_SCHED;
            } else {
            PG8_LDB(B0, 0, 0); PG8_SCHED; PG8_LDA(At, 0, 0); PG8_STAGE(PG8_SA(1, 1), a1 + hstepA, voffA);
            PG8_WAIT_L(8); PG8_BAR; PG8_WAIT_L(0); PG8_MMA(0, 0, At, B0); PG8_BAR; PG8_SCHED;
            PG8_LDB(B1, 0, 1); PG8_STAGE(PG8_SB(0, 0), b2, voffB);
            PG8_BAR; PG8_WAIT_L(0); PG8_MMA(0, 1, At, B1); PG8_BAR;
            PG8_LDA(At, 0, 1); PG8_STAGE(PG8_SA(0, 0), a2, voffA);
            PG8_BAR; PG8_WAIT_L(0); PG8_MMA(1, 0, At, B0); PG8_BAR; PG8_SCHED;
            PG8_STAGE(PG8_SB(0, 1), b2 + hstepB, voffB);
            PG8_WAIT_V(6); PG8_BAR; PG8_MMA(1, 1, At, B1); PG8_BAR;
            PG8_LDB(B0, 1, 0); PG8_SCHED; PG8_LDA(At, 1, 0); PG8_STAGE(PG8_SA(0, 1), a2 + hstepA, voffA);
            PG8_WAIT_L(8); PG8_BAR; PG8_WAIT_L(0); PG8_MMA(0, 0, At, B0); PG8_BAR; PG8_SCHED;
            PG8_LDB(B1, 1, 1); PG8_STAGE(PG8_SB(1, 0), b3, voffB);
            PG8_BAR; PG8_WAIT_L(0); PG8_MMA(0, 1, At, B1); PG8_BAR;
            PG8_LDA(At, 1, 1); PG8_STAGE(PG8_SA(1, 0), a3, voffA);
            PG8_BAR; PG8_WAIT_L(0); PG8_MMA(1, 0, At, B0); PG8_BAR; PG8_SCHED;
            PG8_STAGE(PG8_SB(1, 1), b3 + hstepB, voffB);
            PG8_WAIT_V(6); PG8_BAR; PG8_MMA(1, 1, At, B1); PG8_BAR;
            }
        }
        if constexpr (ALIGN_EPI) { if (wr == 0) PG8_BAR; }
        E(acc, cur, wr, wc, fr, fq); S.done(cur);
        if (!has_next) break;
#pragma unroll
        for (int a = 0; a < 2; ++a)
#pragma unroll
            for (int b = 0; b < 2; ++b)
#pragma unroll
                for (int m = 0; m < 4; ++m)
#pragma unroll
                    for (int n = 0; n < 2; ++n) acc[a][b][m][n] = (f32x4){0.f, 0.f, 0.f, 0.f};
        cur = nxt; cA = nA; cB = nB; ++ui;
        if constexpr (ALIGN_EPI) { if (wr == 1) PG8_BAR; }
    }
    PG8_WAIT_V(0);
    if constexpr (!ALIGN_EPI) { if (wr == 0) PG8_BAR; }
    PG8_BAR;
#undef PG8_SA
#undef PG8_SB
#undef PG8_STAGE
#undef PG8_LDA
#undef PG8_LDB
#undef PG8_MMA
#undef PG8_CAT
#undef PG8_WAIT_V
#undef PG8_WAIT_L
#undef PG8_BAR
#undef PG8_SCHED
}

__device__ __forceinline__ u32x4 pack8(f32x4 v0, f32x4 v1) { u32x4 w; w.x = pk2(v0[0], v0[1]); w.y = pk2(v0[2], v0[3]); w.z = pk2(v1[0], v1[1]); w.w = pk2(v1[2], v1[3]); return w; }
__device__ __forceinline__ void unpack8(u32x4 w, f32x4& v0, f32x4& v1) { v0 = (f32x4){bflo(w.x), bfhi(w.x), bflo(w.y), bfhi(w.y)}; v1 = (f32x4){bflo(w.z), bfhi(w.z), bflo(w.w), bfhi(w.w)}; }

struct EpiProj {
    static constexpr bool PERM = true;
    bf16_t* P; float* ALR; int pn0;
    __device__ __forceinline__ void operator()(const f32x4 (&acc)[2][2][4][2], const Unit& u, int wr, int wc, int fr, int fq) const {
        { const int ln = lane_now(); fr = ln & 15; fq = ln >> 4; }
        const int row0 = u.pm * BM + wr * 64 + fr; int pn = u.pn + pn0; const int cl = wc * 32 + 8 * fq;
        if (pn == 10) {
            if (wc == 0 && fq < 2) {
#pragma unroll
                for (int ai = 0; ai < 2; ++ai)
#pragma unroll
                    for (int m = 0; m < 4; ++m) { float* rp = ALR + (size_t)(row0 + ai * HALF + m * 16) * 16 + 8 * fq;
                        *(f32x4*)rp = acc[ai][0][m][0]; *(f32x4*)(rp + 4) = acc[ai][0][m][1]; }
            }
            return;
        }
        if (pn > 10) --pn;
        const int mode = pn < 8 ? 0 : (pn < 12 ? 1 : 2);
#pragma unroll
        for (int ai = 0; ai < 2; ++ai)
#pragma unroll
            for (int m = 0; m < 4; ++m) { bf16_t* rowp = P + (size_t)(row0 + ai * HALF + m * 16) * PLD + pn * BM + cl;
#pragma unroll
                for (int bj = 0; bj < 2; ++bj) { f32x4 v0 = acc[ai][bj][m][0], v1 = acc[ai][bj][m][1];
                    if (mode == 1) {
#pragma unroll
                        for (int i = 0; i < 4; ++i) { v0[i] = gelu_tanh(v0[i]); v1[i] = gelu_tanh(v1[i]); }
                    } else if (mode == 2) {
#pragma unroll
                        for (int i = 0; i < 4; ++i) { v0[i] = sigmoidf_(v0[i]); v1[i] = sigmoidf_(v1[i]); }
                    }
                    *(u32x4*)(rowp + bj * HALF) = pack8(v0, v1); } }
    }
};
struct EpiBrA {
    static constexpr bool PERM = true;
    bf16_t* P;
    __device__ __forceinline__ void operator()(const f32x4 (&acc)[2][2][4][2], const Unit& u, int wr, int wc, int fr, int fq) const {
        const int row0 = u.pm * BM + wr * 64 + fr; const int c0 = u.pn * BM + wc * 32 + 8 * fq;
#pragma unroll
        for (int ai = 0; ai < 2; ++ai)
#pragma unroll
            for (int m = 0; m < 4; ++m) { bf16_t* rowp = P + (size_t)(row0 + ai * HALF + m * 16) * PLD;
#pragma unroll
                for (int bj = 0; bj < 2; ++bj) { const int c = c0 + bj * HALF; f32x4 g0, g1; unpack8(*(const u32x4*)(rowp + PC_GA + c), g0, g1);
                    *(u32x4*)(rowp + PC_MRG + c) = pack8(acc[ai][bj][m][0] * g0, acc[ai][bj][m][1] * g1); } }
    }
};
struct EpiBrB {
    static constexpr bool PERM = true;
    bf16_t* P;
    __device__ __forceinline__ void operator()(const f32x4 (&acc)[2][2][4][2], const Unit& u, int wr, int wc, int fr, int fq) const {
        const int row0 = u.pm * BM + wr * 64 + fr; const int c0 = u.pn * BM + wc * 32 + 8 * fq;
#pragma unroll
        for (int ai = 0; ai < 2; ++ai)
#pragma unroll
            for (int m = 0; m < 4; ++m) { bf16_t* rowp = P + (size_t)(row0 + ai * HALF + m * 16) * PLD;
#pragma unroll
                for (int bj = 0; bj < 2; ++bj) { const int c = c0 + bj * HALF; f32x4 g0, g1, p0, p1; unpack8(*(const u32x4*)(rowp + PC_GB + c), g0, g1); unpack8(*(const u32x4*)(rowp + PC_MRG + c), p0, p1);
                    *(u32x4*)(rowp + PC_MRG + c) = pack8(p0 + acc[ai][bj][m][0] * g0, p1 + acc[ai][bj][m][1] * g1); } }
    }
};
struct EpiBrAB {
    static constexpr bool PERM = true;
    bf16_t* P;
    __device__ __forceinline__ void mid(f32x4 (&acc)[2][2][4][2], const Unit& u, int wr, int wc) const {
        const int ln = lane_now(), fr = ln & 15, fq = ln >> 4;
        const int row0 = u.pm * BM + wr * 64 + fr; const int c0 = u.pn * BM + wc * 32 + 8 * fq;
#pragma unroll
        for (int ai = 0; ai < 2; ++ai)
#pragma unroll
            for (int m = 0; m < 4; ++m) { const bf16_t* rowp = P + (size_t)(row0 + ai * HALF + m * 16) * PLD;
#pragma unroll
                for (int bj = 0; bj < 2; ++bj) { const int c = c0 + bj * HALF; f32x4 a0, a1, b0, b1; unpack8(*(const u32x4*)(rowp + PC_GA + c), a0, a1); unpack8(*(const u32x4*)(rowp + PC_GB + c), b0, b1);
#pragma unroll
                    for (int i = 0; i < 4; ++i) { acc[ai][bj][m][0][i] *= a0[i] * __builtin_amdgcn_rcpf(fmaxf(b0[i], 1e-20f)); acc[ai][bj][m][1][i] *= a1[i] * __builtin_amdgcn_rcpf(fmaxf(b1[i], 1e-20f)); } } }
    }
    __device__ __forceinline__ void operator()(const f32x4 (&acc)[2][2][4][2], const Unit& u, int wr, int wc, int fr, int fq) const {
        { const int ln = lane_now(); fr = ln & 15; fq = ln >> 4; }
        const int row0 = u.pm * BM + wr * 64 + fr; const int c0 = u.pn * BM + wc * 32 + 8 * fq;
#pragma unroll
        for (int ai = 0; ai < 2; ++ai)
#pragma unroll
            for (int m = 0; m < 4; ++m) { bf16_t* rowp = P + (size_t)(row0 + ai * HALF + m * 16) * PLD;
#pragma unroll
                for (int bj = 0; bj < 2; ++bj) { const int c = c0 + bj * HALF; f32x4 g0, g1; unpack8(*(const u32x4*)(rowp + PC_GB + c), g0, g1);
                    *(u32x4*)(rowp + PC_MRG + c) = pack8(acc[ai][bj][m][0] * g0, acc[ai][bj][m][1] * g1); } }
    }
};
struct EpiOut {
    static constexpr bool PERM = true;
    bf16_t* O;
    __device__ __forceinline__ void operator()(const f32x4 (&acc)[2][2][4][2], const Unit& u, int wr, int wc, int fr, int fq) const {
        const int row0 = u.pm * BM + wr * 64 + fr; const int c0 = u.pn * BM + wc * 32 + 8 * fq;
#pragma unroll
        for (int ai = 0; ai < 2; ++ai)
#pragma unroll
            for (int m = 0; m < 4; ++m) { const size_t ro = (size_t)(row0 + ai * HALF + m * 16) * D;
#pragma unroll
                for (int bj = 0; bj < 2; ++bj) *(u32x4*)(O + ro + c0 + bj * HALF) = pack8(acc[ai][bj][m][0], acc[ai][bj][m][1]); }
    }
};
struct EpiScores {
    static constexpr bool PERM = true;
    bf16_t* SC;
    __device__ __forceinline__ void operator()(const f32x4 (&acc)[2][2][4][2], const Unit& u, int wr, int wc, int fr, int fq) const {
        const int tb0 = u.pm * 16 + wr * 4; const int cq0 = (u.pn * BM + wc * 32 + 8 * fq) >> 3;
#pragma unroll
        for (int ai = 0; ai < 2; ++ai)
#pragma unroll
            for (int m = 0; m < 4; ++m) { bf16_t* bp = SC + ((size_t)(tb0 + ai * 8 + m) * 256) * 128 + fr * 8;
#pragma unroll
                for (int bj = 0; bj < 2; ++bj) *(u32x4*)(bp + (size_t)(cq0 + bj * 16) * 128) = pack8(acc[ai][bj][m][0], acc[ai][bj][m][1]); }
    }
};
}

#define XB_TMO      128
#define XB_XCNT(j)  (256  + 64 * (j))
#define XB_XSUB(j)  (1280 + 64 * (j))
#define XB_XGEN(j)  (2304 + 64 * (j))
#define XB_TOP      3328
#define XB_TOPGEN   3392
#define XCD_BAR_WORDS 3456
#define XB_SPIN_CAP (1u << 18)
__device__ __forceinline__ unsigned xb_ld(unsigned* p)              { return __hip_atomic_load(p, __ATOMIC_RELAXED, __HIP_MEMORY_SCOPE_AGENT); }
__device__ __forceinline__ unsigned xb_add(unsigned* p, unsigned v) { return __hip_atomic_fetch_add(p, v, __ATOMIC_RELAXED, __HIP_MEMORY_SCOPE_AGENT); }
__device__ __forceinline__ unsigned xb_xcc_id() { return (unsigned)__builtin_amdgcn_s_getreg((3 << 11) | 20) & 0xFu; }
#define XB_SPIN(cond, bar) do { unsigned _sp = 0; while (cond) { __builtin_amdgcn_s_sleep(1); \
    if ((++_sp & 255u) == 0u) { if (xb_ld(&(bar)[XB_TMO])) break; if (_sp > XB_SPIN_CAP) { atomicAdd(&(bar)[XB_TMO], 1u); break; } } } } while (0)
struct XcdBarrier { unsigned* bar; unsigned x; volatile LAS unsigned* st; int wave; };
__device__ __forceinline__ XcdBarrier xcd_barrier_post(unsigned* bar, volatile LAS unsigned* st, int wave) {
    XcdBarrier b; b.bar = bar; b.x = xb_xcc_id(); b.st = st; b.wave = wave;
    if (wave == 0 && lane_now() == 0) (void)xb_add(&bar[XB_XCNT(b.x)], 1u);
    return b;
}
__device__ __forceinline__ void xcd_barrier_complete(unsigned* bar, unsigned x, unsigned& nloc, unsigned& nx) {
    const unsigned G = gridDim.x * gridDim.y * gridDim.z;
    unsigned sum, cnt, mine, sp = 0u;
    for (;;) {
        sum = 0u; cnt = 0u; mine = 0u;
#pragma unroll
        for (unsigned j = 0; j < 16; ++j) { const unsigned c = xb_ld(&bar[XB_XCNT(j)]); sum += c; cnt += (c > 0u) ? 1u : 0u; mine = (j == x) ? c : mine; }
        if (sum == G) break;
        __builtin_amdgcn_s_sleep(1);
        if ((++sp & 255u) == 0u) { if (xb_ld(&bar[XB_TMO])) break; if (sp > XB_SPIN_CAP) { atomicAdd(&bar[XB_TMO], 1u); break; } }
    }
    nloc = mine > 0u ? mine : 1u; nx = cnt > 0u ? cnt : 1u;
}
__device__ __forceinline__ void xcd_barrier(const XcdBarrier& b) {
    asm volatile("s_waitcnt vmcnt(0)" ::: "memory");
    __syncthreads();
    if (b.wave == 0 && lane_now() == 0) {
        unsigned* bar = b.bar;
        __builtin_amdgcn_s_waitcnt(0);
        unsigned nloc = b.st[0], nx = b.st[1];
        if (nloc == 0u) { xcd_barrier_complete(bar, b.x, nloc, nx); b.st[0] = nloc; b.st[1] = nx; }
        const unsigned old = xb_add(&bar[XB_XSUB(b.x)], 1u);
        const unsigned gen = old / nloc;
        if (old + 1u == (gen + 1u) * nloc) {
            __builtin_amdgcn_fence(__ATOMIC_RELEASE, "agent");
            asm volatile("s_waitcnt vmcnt(0)" ::: "memory");
            const unsigned og = xb_add(&bar[XB_TOP], 1u);
            const unsigned tg = og / nx;
            if (og + 1u == (tg + 1u) * nx) xb_add(&bar[XB_TOPGEN], 1u);
            else XB_SPIN(xb_ld(&bar[XB_TOPGEN]) == tg, bar);
            __builtin_amdgcn_fence(__ATOMIC_ACQUIRE, "agent");
            xb_add(&bar[XB_XGEN(b.x)], 1u);
            asm volatile("s_waitcnt vmcnt(0)" ::: "memory");
        } else {
            XB_SPIN(xb_ld(&bar[XB_XGEN(b.x)]) == gen, bar);
            __builtin_amdgcn_fence(__ATOMIC_ACQUIRE, "agent");
            asm volatile("s_waitcnt vmcnt(0)" ::: "memory");
        }
    }
    __syncthreads();
}

struct Args {
    const float* in[20]; float* out; unsigned char* ws; int ph_lo, ph_hi, li, pad;
};
enum { I_X = 0, I_N1G, I_WIN, I_WGU, I_BG, I_GLAG, I_SLNG, I_SLNB, I_SW, I_SB, I_WBA, I_WBB, I_WOUT, I_N2G, I_WQ, I_K1, I_K2, I_PU, I_PV, I_FG };

struct Frame {
    LAS unsigned char* lds;
    int tid, lane, wave, G, bid;
};

__device__ __forceinline__ float clamp448(float v) { return __builtin_amdgcn_fmed3f(v, -448.f, 448.f); }
template <int MODE, bool F8 = false>
__device__ __forceinline__ void p0_transpose_item(const float* W, int K, int Nsrc, int Ndst, bf16_t* WT, LAS float* scr, int item, int lane, float sc8 = 1.f, int ldk = 0) {
    if (ldk == 0) ldk = K;
    const int nblk = Ndst / 32, kb = item / nblk, nb = item % nblk, k0 = 64 * kb, n0 = 32 * nb;
    const int nd = n0 + (lane & 31);
    int sc = nd; bool valid = true;
    if (MODE == 1) { if (nd < 2048) sc = nd; else if (nd < 2560) sc = nd + 16; else if (nd < 2576) sc = 2048 + (nd - 2560); else if (nd < 2816) { sc = 0; valid = false; } else sc = nd - 240; }
#pragma unroll 8
    for (int i = 0; i < 32; ++i) { const int kk = 2 * i + (lane >> 5); const float v = valid ? W[(size_t)(k0 + kk) * Nsrc + sc] : 0.f; scr[kk * 33 + (lane & 31)] = v; }
    LDS_WAIT(); asm volatile("" ::: "memory");
    if (F8) {
        const int c = lane & 3;
#pragma unroll
        for (int j = 0; j < 2; ++j) { const int n = (lane >> 2) + 16 * j; const LAS float* s = scr + (16 * c) * 33 + n; u32x4 o;
#pragma unroll
            for (int q = 0; q < 4; ++q) { int w = 0; w = __builtin_amdgcn_cvt_pk_fp8_f32(clamp448(s[(4 * q) * 33] * sc8), clamp448(s[(4 * q + 1) * 33] * sc8), w, false);
                w = __builtin_amdgcn_cvt_pk_fp8_f32(clamp448(s[(4 * q + 2) * 33] * sc8), clamp448(s[(4 * q + 3) * 33] * sc8), w, true); o[q] = (unsigned)w; }
            *(u32x4*)((unsigned char*)WT + (size_t)(n0 + n) * ldk + k0 + 16 * c) = o; }
    } else {
    const int c = lane & 7;
#pragma unroll
    for (int j = 0; j < 4; ++j) { const int n = (lane >> 3) + 8 * j; const LAS float* s = scr + (8 * c) * 33 + n;
        u32x4 o; o.x = pk2(s[0 * 33], s[1 * 33]); o.y = pk2(s[2 * 33], s[3 * 33]); o.z = pk2(s[4 * 33], s[5 * 33]); o.w = pk2(s[6 * 33], s[7 * 33]);
        *(u32x4*)(WT + (size_t)(n0 + n) * ldk + k0 + 8 * c) = o; }
    }
    LDS_WAIT(); asm volatile("" ::: "memory");
}
template <int OM, int NB>
__device__ __forceinline__ void rms_rows_to_bf16(int lane, const float* x0, size_t xstride, const float* g, bf16_t* o0, size_t ostride, unsigned* o80 = nullptr, size_t o8stride = 0, const bf16_t* add0 = nullptr, size_t addstride = 0) {
    f32x4 v[NB][4]; float s[NB];
#pragma unroll
    for (int b = 0; b < NB; ++b) { const float* xr = x0 + b * xstride + 8 * lane;
#pragma unroll
        for (int j = 0; j < 2; ++j) { v[b][2 * j] = *(const f32x4*)(xr + 512 * j); v[b][2 * j + 1] = *(const f32x4*)(xr + 512 * j + 4); } }
    if (add0) {
        u32x4 ad[NB][2];
#pragma unroll
        for (int b = 0; b < NB; ++b) { const bf16_t* ar = add0 + b * addstride + 8 * lane;
#pragma unroll
            for (int j = 0; j < 2; ++j) ad[b][j] = *(const u32x4*)(ar + 512 * j); }
#pragma unroll
        for (int b = 0; b < NB; ++b)
#pragma unroll
            for (int j = 0; j < 2; ++j) { v[b][2 * j] = v[b][2 * j] + (f32x4){bflo(ad[b][j].x), bfhi(ad[b][j].x), bflo(ad[b][j].y), bfhi(ad[b][j].y)};
                v[b][2 * j + 1] = v[b][2 * j + 1] + (f32x4){bflo(ad[b][j].z), bfhi(ad[b][j].z), bflo(ad[b][j].w), bfhi(ad[b][j].w)}; }
    }
#pragma unroll
    for (int b = 0; b < NB; ++b) { s[b] = 0.f;
#pragma unroll
        for (int j = 0; j < 4; ++j) s[b] += (v[b][j].x * v[b][j].x + v[b][j].y * v[b][j].y) + (v[b][j].z * v[b][j].z + v[b][j].w * v[b][j].w); }
#pragma unroll
    for (int o = 1; o < 64; o <<= 1) {
#pragma unroll
        for (int b = 0; b < NB; ++b) s[b] += __shfl_xor(s[b], o); }
    const float* gr = g + 8 * lane;
#pragma unroll
    for (int b = 0; b < NB; ++b) { const float rstd = 1.f / sqrtf(s[b] * (1.f / D) + EPS);
#pragma unroll
        for (int j = 0; j < 2; ++j) { const f32x4 y0 = v[b][2 * j] * rstd * *(const f32x4*)(gr + 512 * j), y1 = v[b][2 * j + 1] * rstd * *(const f32x4*)(gr + 512 * j + 4);
            const u32x4 o = pg8::pack8(y0, y1);
            if (OM & 1) *(u32x4*)(o0 + b * ostride + 512 * j + 8 * lane) = o;
            if (OM == 3) { u32x2 w8;
#pragma unroll
                for (int h = 0; h < 2; ++h) { int w = 0; w = __builtin_amdgcn_cvt_pk_fp8_f32(clamp448(bflo(o[2 * h]) * 16.f), clamp448(bfhi(o[2 * h]) * 16.f), w, false);
                    w = __builtin_amdgcn_cvt_pk_fp8_f32(clamp448(bflo(o[2 * h + 1]) * 16.f), clamp448(bfhi(o[2 * h + 1]) * 16.f), w, true); w8[h] = (unsigned)w; }
                *(u32x2*)(o80 + b * o8stride + 128 * j + 2 * lane) = w8; }
            if (OM == 2) { u32x2 w8; int w = 0;
                w = __builtin_amdgcn_cvt_pk_fp8_f32(clamp448(y0.x * 16.f), clamp448(y0.y * 16.f), w, false); w = __builtin_amdgcn_cvt_pk_fp8_f32(clamp448(y0.z * 16.f), clamp448(y0.w * 16.f), w, true); w8.x = (unsigned)w;
                w = 0; w = __builtin_amdgcn_cvt_pk_fp8_f32(clamp448(y1.x * 16.f), clamp448(y1.y * 16.f), w, false); w = __builtin_amdgcn_cvt_pk_fp8_f32(clamp448(y1.z * 16.f), clamp448(y1.w * 16.f), w, true); w8.y = (unsigned)w;
                *(u32x2*)(o80 + b * o8stride + 128 * j + 2 * lane) = w8; } } }
}
__device__ __forceinline__ float wave_max(float v) {
#pragma unroll
    for (int o = 1; o < 64; o <<= 1) v = fmaxf(v, __shfl_xor(v, o));
    return v;
}
template <int NB>
__device__ __forceinline__ void cvt_rows_fp8(int lane, const float* const (&src)[NB], unsigned char* const (&dst16)[NB], float* const (&scale_out)[NB]) {
    f32x4 v[NB][4]; float m[NB];
#pragma unroll
    for (int b = 0; b < NB; ++b) {
#pragma unroll
        for (int j = 0; j < 4; ++j) v[b][j] = *(const GAS f32x4*)(src[b] + 16 * lane + 4 * j); }
#pragma unroll
    for (int b = 0; b < NB; ++b) { m[b] = 0.f;
#pragma unroll
        for (int j = 0; j < 4; ++j) m[b] = fmaxf(m[b], fmaxf(fmaxf(fabsf(v[b][j].x), fabsf(v[b][j].y)), fmaxf(fabsf(v[b][j].z), fabsf(v[b][j].w)))); }
#pragma unroll
    for (int o = 1; o < 64; o <<= 1) {
#pragma unroll
        for (int b = 0; b < NB; ++b) m[b] = fmaxf(m[b], __shfl_xor(m[b], o)); }
#pragma unroll
    for (int b = 0; b < NB; ++b) { const float inv = m[b] > 0.f ? 224.f / m[b] : 0.f, sc = m[b] > 0.f ? m[b] * (1.f / 224.f) : 1.f;
        u32x4 o;
#pragma unroll
        for (int j = 0; j < 4; ++j) { int w = 0; w = __builtin_amdgcn_cvt_pk_fp8_f32(v[b][j].x * inv, v[b][j].y * inv, w, false); w = __builtin_amdgcn_cvt_pk_fp8_f32(v[b][j].z * inv, v[b][j].w * inv, w, true); o[j] = (unsigned)w; }
        *(GAS u32x4*)dst16[b] = o;
        if (lane == 0) *(GAS float*)scale_out[b] = sc; }
}
__device__ __forceinline__ unsigned fp4_code(float t) { const float a = fabsf(t);
    const unsigned c = (unsigned)(a >= 0.25f) + (unsigned)(a >= 0.75f) + (unsigned)(a >= 1.25f) + (unsigned)(a >= 1.75f) + (unsigned)(a >= 2.5f) + (unsigned)(a >= 3.5f) + (unsigned)(a >= 5.f);
    return c | (t < 0.f ? 8u : 0u); }
template <int NB, bool PERMV = false>
__device__ __forceinline__ void cvt_rows_fp4(int lane, const float* const (&src)[NB], unsigned char* const (&dst8)[NB], float* const (&scale_out)[NB]) {
    f32x4 v[NB][4]; float m[NB];
#pragma unroll
    for (int b = 0; b < NB; ++b) {
#pragma unroll
        for (int j = 0; j < 4; ++j) v[b][j] = *(const GAS f32x4*)(src[b] + 16 * lane + 4 * j); }
#pragma unroll
    for (int b = 0; b < NB; ++b) { m[b] = 0.f;
#pragma unroll
        for (int j = 0; j < 4; ++j) m[b] = fmaxf(m[b], fmaxf(fmaxf(fabsf(v[b][j].x), fabsf(v[b][j].y)), fmaxf(fabsf(v[b][j].z), fabsf(v[b][j].w)))); }
#pragma unroll
    for (int o = 1; o < 64; o <<= 1) {
#pragma unroll
        for (int b = 0; b < NB; ++b) m[b] = fmaxf(m[b], __shfl_xor(m[b], o)); }
#pragma unroll
    for (int b = 0; b < NB; ++b) { const float inv = m[b] > 0.f ? 6.f / m[b] : 0.f, sc = m[b] > 0.f ? m[b] * (1.f / 6.f) : 1.f;
        u32x2 o;
#pragma unroll
        for (int h = 0; h < 2; ++h) { unsigned w = 0;
            const f32x4 t0 = v[b][2 * h] * inv, t1 = v[b][2 * h + 1] * inv;
            w = __builtin_amdgcn_cvt_scalef32_pk_fp4_f32(w, t0.x, t0.y, 1.f, 0); w = __builtin_amdgcn_cvt_scalef32_pk_fp4_f32(w, t0.z, t0.w, 1.f, 1);
            w = __builtin_amdgcn_cvt_scalef32_pk_fp4_f32(w, t1.x, t1.y, 1.f, 2); w = __builtin_amdgcn_cvt_scalef32_pk_fp4_f32(w, t1.z, t1.w, 1.f, 3);
            o[h] = w; }
        if (PERMV) { *(GAS unsigned*)(dst8[b] + 16 * ((2 * lane) & 31) + 4 * (lane >> 4)) = o.x; *(GAS unsigned*)(dst8[b] + 16 * ((2 * lane + 1) & 31) + 4 * (lane >> 4)) = o.y; }
        else *(GAS u32x2*)dst8[b] = o;
        if (lane == 0) *(GAS float*)scale_out[b] = sc; }
}
__device__ __forceinline__ void convert_tables(const Frame& F, const Args& A, int wi, int nw) {
    unsigned char* ws = A.ws; const int gw = wi, NGW = nw;
    {
        int mc = gw;
        for (; mc + 3 * NGW < NEXP; mc += 4 * NGW) { const float* src[4]; unsigned char* dst[4]; float* sco[4];
#pragma unroll
            for (int b = 0; b < 4; ++b) { const int e = mc + b * NGW; src[b] = A.in[I_PU] + (size_t)e * D; dst[b] = ws + WS_U8 + (size_t)((e & (UNG - 1)) * (NEXP / UNG) + (e >> UNG_SH)) * 512 + 8 * F.lane; sco[b] = (float*)(ws + WS_SU) + e; }
            cvt_rows_fp4<4>(F.lane, src, dst, sco); }
        for (; mc < NEXP; mc += NGW) { const float* src[1]; unsigned char* dst[1]; float* sco[1];
            const int e = mc; src[0] = A.in[I_PU] + (size_t)e * D; dst[0] = ws + WS_U8 + (size_t)((e & (UNG - 1)) * (NEXP / UNG) + (e >> UNG_SH)) * 512 + 8 * F.lane; sco[0] = (float*)(ws + WS_SU) + e;
            cvt_rows_fp4<1>(F.lane, src, dst, sco); }
    }
    if (V_F4) {
        int mc = gw;
        for (; mc + 3 * NGW < NEXP; mc += 4 * NGW) { const float* src[4]; unsigned char* dst[4]; float* sco[4];
#pragma unroll
            for (int b = 0; b < 4; ++b) { const int e = mc + b * NGW; src[b] = A.in[I_PV] + (size_t)e * D; dst[b] = ws + WS_V8 + (size_t)e * 512; sco[b] = (float*)(ws + WS_SV) + e; }
            cvt_rows_fp4<4, true>(F.lane, src, dst, sco); }
        for (; mc < NEXP; mc += NGW) { const float* src[1]; unsigned char* dst[1]; float* sco[1];
            const int e = mc; src[0] = A.in[I_PV] + (size_t)e * D; dst[0] = ws + WS_V8 + (size_t)e * 512; sco[0] = (float*)(ws + WS_SV) + e;
            cvt_rows_fp4<1, true>(F.lane, src, dst, sco); }
    } else {
        int mc = gw;
        for (; mc + 3 * NGW < NEXP; mc += 4 * NGW) { const float* src[4]; unsigned char* dst[4]; float* sco[4];
#pragma unroll
            for (int b = 0; b < 4; ++b) { const int e = mc + b * NGW; src[b] = A.in[I_PV] + (size_t)e * D; dst[b] = ws + WS_V8 + ((size_t)(F.lane >> 3) * NEXP + e) * 128 + 16 * (F.lane & 7); sco[b] = (float*)(ws + WS_SV) + e; }
            cvt_rows_fp8<4>(F.lane, src, dst, sco); }
        for (; mc < NEXP; mc += NGW) { const float* src[1]; unsigned char* dst[1]; float* sco[1];
            const int e = mc; src[0] = A.in[I_PV] + (size_t)e * D; dst[0] = ws + WS_V8 + ((size_t)(F.lane >> 3) * NEXP + e) * 128 + 16 * (F.lane & 7); sco[0] = (float*)(ws + WS_SV) + e;
            cvt_rows_fp8<1>(F.lane, src, dst, sco); }
    }
}
__device__ __forceinline__ void phase0(const Frame& F, const Args& A) {
    unsigned char* ws = A.ws;
    if (!SC_F8) {
        const int l = F.lane, fr = l & 15, q = l >> 4;
        bf16_t* WQF = (bf16_t*)(ws + WS_WQF);
        for (int it = F.bid * NWAVES + F.wave; it < 2048; it += F.G * NWAVES) {
            const int kh = it & 1, kt = (it >> 1) & 63, hh = it >> 7;
            const float* kX = (hh & 1) ? A.in[I_K2] : A.in[I_K1];
            const float* ap = A.in[I_WQ] + (size_t)(kt * 16 + fr) * 2048 + hh * 128 + 4 * q;
            f32x4 a[8];
#pragma unroll
            for (int t = 0; t < 8; ++t) a[t] = *(const f32x4*)(ap + 16 * t);
#pragma unroll
            for (int kb = 0; kb < 4; ++kb) { const int key0 = kh * 64 + kb * 16;
                const float* bp = kX + (size_t)(key0 + fr) * 128 + 4 * q;
                f32x4 b[8];
#pragma unroll
                for (int t = 0; t < 8; ++t) b[t] = *(const f32x4*)(bp + 16 * t);
                f32x4 d = {0.f, 0.f, 0.f, 0.f};
#pragma unroll
                for (int t = 0; t < 8; ++t)
#pragma unroll
                    for (int c = 0; c < 4; ++c) d = __builtin_amdgcn_mfma_f32_16x16x4f32(a[t][c], b[t][c], d, 0, 0, 0);
                u32x2 o; o.x = pk2(d[0], d[1]); o.y = pk2(d[2], d[3]);
                *(u32x2*)(WQF + (size_t)(hh * 128 + key0 + fr) * 1024 + kt * 16 + 4 * q) = o; }
        }
    } else {
        LAS float* kx = (LAS float*)F.lds;
        LAS float* wt = (LAS float*)(F.lds + 128 * 129 * 4);
        bf16_t* WQF = (bf16_t*)(ws + WS_WQF);
        for (int it = F.bid; it < 512; it += F.G) {
            const int hh = it >> 5, kblk = it & 31, k0 = kblk * 32;
            const float* kX = (hh & 1) ? A.in[I_K2] : A.in[I_K1];
            __syncthreads();
            for (int e = F.tid; e < 128 * 128; e += 512) kx[(e >> 7) * 129 + (e & 127)] = kX[e];
            for (int e = F.tid; e < 32 * 128; e += 512) wt[e] = A.in[I_WQ][(size_t)(k0 + (e >> 7)) * 2048 + hh * 128 + (e & 127)];
            __syncthreads();
            const int key = F.tid & 127, kq = F.tid >> 7;
            float acc[8];
#pragma unroll
            for (int i = 0; i < 8; ++i) acc[i] = 0.f;
            for (int d = 0; d < 128; ++d) { const float b = kx[key * 129 + d];
#pragma unroll
                for (int i = 0; i < 8; ++i) acc[i] += wt[(kq * 8 + i) * 128 + d] * b; }
            if (SC_F8) { u32x2 o;
#pragma unroll
                for (int h2 = 0; h2 < 2; ++h2) { int w = 0; w = __builtin_amdgcn_cvt_pk_fp8_f32(clamp448(acc[4 * h2] * 1024.f), clamp448(acc[4 * h2 + 1] * 1024.f), w, false);
                    w = __builtin_amdgcn_cvt_pk_fp8_f32(clamp448(acc[4 * h2 + 2] * 1024.f), clamp448(acc[4 * h2 + 3] * 1024.f), w, true); o[h2] = (unsigned)w; }
                *(u32x2*)((unsigned char*)WQF + (size_t)(hh * 128 + key) * 1024 + k0 + kq * 8) = o;
            } else {
            u32x4 o; o.x = pk2(acc[0], acc[1]); o.y = pk2(acc[2], acc[3]); o.z = pk2(acc[4], acc[5]); o.w = pk2(acc[6], acc[7]);
            *(u32x4*)(WQF + (size_t)(hh * 128 + key) * 1024 + k0 + kq * 8) = o; }
        }
        __syncthreads();
    }
    LAS float* scr = (LAS float*)(F.lds + F.wave * 16384);
    const int gw = F.bid * NWAVES + F.wave, NGW = F.G * NWAVES;
    constexpr int I_IN = 16 * (NPROJ / 32), I_A = 8 * 32, I_B = 8 * 32, I_O = 16 * 32;
    constexpr int NITEMS = I_IN + I_A + I_B + I_O;
    for (int it = gw; it < NITEMS; it += NGW) {
        int r = it;
        if (r < I_IN) { if ((r % (NPROJ / 32)) * 32 >= F8_LO * 256) p0_transpose_item<1, true>(A.in[I_WIN], 1024, 5136, NPROJ, (bf16_t*)(ws + WS_W8), scr, r, F.lane, 1024.f);
                        else p0_transpose_item<1, false>(A.in[I_WIN], 1024, 5136, NPROJ, (bf16_t*)(ws + WS_WIN), scr, r, F.lane); continue; } r -= I_IN;
        if (r < I_A) { p0_transpose_item<0>(A.in[I_WBA], 512, 1024, 1024, (bf16_t*)(ws + WS_WA), scr, r, F.lane, 1.f, 1024); continue; } r -= I_A;
        if (r < I_B) { p0_transpose_item<0>(A.in[I_WBB], 512, 1024, 1024, (bf16_t*)(ws + WS_WA) + 512, scr, r, F.lane, 1.f, 1024); continue; } r -= I_B;
        p0_transpose_item<0>(A.in[I_WOUT], 1024, 1024, 1024, (bf16_t*)(ws + WS_WOUT), scr, r, F.lane);
    }
    constexpr int OM1 = F8_LO <= 0 ? 2 : (F8_LO >= 21 ? 1 : 3);
    { int m = gw; for (; m + 3 * NGW < T_TOK; m += 4 * NGW) rms_rows_to_bf16<OM1, 4>(F.lane, A.in[I_X] + (size_t)m * D, (size_t)NGW * D, A.in[I_N1G], (bf16_t*)(ws + WS_N1) + (size_t)m * D, (size_t)NGW * D, (unsigned*)(ws + WS_N18) + (size_t)m * 256, (size_t)NGW * 256);
      for (; m < T_TOK; m += NGW) rms_rows_to_bf16<OM1, 1>(F.lane, A.in[I_X] + (size_t)m * D, 0, A.in[I_N1G], (bf16_t*)(ws + WS_N1) + (size_t)m * D, 0, (unsigned*)(ws + WS_N18) + (size_t)m * 256, 0); }
}

__device__ __forceinline__ float log_sigmoid(float z) { return fminf(z, 0.f) - log1pf(__expf(-fabsf(z))); }

template <bool DRY>
__device__ __forceinline__ void gla_chunk_phase(const Frame& F, const Args& A) {
    unsigned char* ws = A.ws;
    const bf16_t* P = (const bf16_t*)(ws + WS_P);
    const float* ALR = (const float*)(ws + WS_ALR);
    LAS float* alr = (LAS float*)F.lds;
    LAS float* tot = (LAS float*)(F.lds + 4096);
    LAS bf16_t* kdT = (LAS bf16_t*)(F.lds + 8192);
    LAS bf16_t* vT = (LAS bf16_t*)(F.lds + 26624);
    LAS bf16_t* stT = (LAS bf16_t*)(F.lds + 45056);
    const int tid = F.tid, kk = tid & 127, seg = tid >> 7;
    const bool hconst = (F.G & 3) == 0;
    int hcur = -1; float w[16]; float bias = 0.f;
#pragma unroll
    for (int j = 0; j < 16; ++j) w[j] = 0.f;
    float na0, na1; bf16_t nk[16], nv[16];
#define GC_LOAD(unit) do { const int h_ = (unit) & 3, c_ = ((unit) >> 2) & 63, b_ = (unit) >> 8; const int t0_ = b_ * SEQ + c_ * 64; \
        na0 = ALR[(size_t)t0_ * 16 + tid]; na1 = ALR[(size_t)t0_ * 16 + 512 + tid]; \
        const bf16_t* kp_ = P + (size_t)(t0_ + 16 * seg) * PLD + PC_K + h_ * 128 + kk; const bf16_t* vp_ = P + (size_t)(t0_ + 16 * seg) * PLD + PC_V + h_ * 128 + kk; \
        _Pragma("unroll") for (int i_ = 0; i_ < 16; ++i_) { nk[i_] = kp_[(size_t)i_ * PLD]; nv[i_] = vp_[(size_t)i_ * PLD]; } } while (0)
    int unit = F.bid;
    if (unit < 2048) GC_LOAD(unit);
    for (; unit < 2048; unit += F.G) {
        const int h = unit & 3;
        if (h != hcur) { hcur = h;
#pragma unroll
            for (int j = 0; j < 16; ++j) w[j] = A.in[I_WGU][(size_t)j * 512 + h * 128 + kk];
            bias = A.in[I_BG][h * 128 + kk]; }
        __syncthreads();
        alr[tid] = na0; alr[512 + tid] = na1;
        bf16_t kr[16], vr[16];
#pragma unroll
        for (int i = 0; i < 16; ++i) { kr[i] = nk[i]; vr[i] = nv[i]; }
        if (unit + F.G < 2048) GC_LOAD(unit + F.G);
        __syncthreads();
        float cum[16]; float run = 0.f;
#pragma unroll
        for (int i = 0; i < 16; ++i) { const LAS f32x4* ap = (const LAS f32x4*)(alr + (16 * seg + i) * 16); float z = bias;
#pragma unroll
            for (int q = 0; q < 4; ++q) { const f32x4 a4 = ap[q]; z += a4.x * w[4 * q] + a4.y * w[4 * q + 1] + a4.z * w[4 * q + 2] + a4.w * w[4 * q + 3]; }
            const float ls = fminf(z, 0.f) - __logf(1.f + __expf(-fabsf(z)));
            run += ls * (1.f / 16.f); cum[i] = run; }
        tot[seg * 128 + kk] = run;
        __syncthreads();
        {
            const float t0s = tot[kk], t1s = tot[128 + kk], t2s = tot[256 + kk], t3s = tot[384 + kk];
            const float total = (t0s + t1s) + (t2s + t3s);
            const float prefix = seg == 0 ? 0.f : (seg == 1 ? t0s : (seg == 2 ? t0s + t1s : t0s + t1s + t2s));
            unsigned kw[8], vw[8];
#pragma unroll
            for (int i = 0; i < 8; ++i) {
                const float e0 = __expf(total - (prefix + cum[2 * i])), e1 = __expf(total - (prefix + cum[2 * i + 1]));
                kw[i] = pk2(bf1(kr[2 * i]) * e0, bf1(kr[2 * i + 1]) * e1); vw[i] = (unsigned)vr[2 * i] | ((unsigned)vr[2 * i + 1] << 16);
            }
            *(LAS u32x4*)(kdT + kk * 72 + 16 * seg) = (u32x4){kw[0], kw[1], kw[2], kw[3]}; *(LAS u32x4*)(kdT + kk * 72 + 16 * seg + 8) = (u32x4){kw[4], kw[5], kw[6], kw[7]};
            *(LAS u32x4*)(vT + kk * 72 + 16 * seg) = (u32x4){vw[0], vw[1], vw[2], vw[3]}; *(LAS u32x4*)(vT + kk * 72 + 16 * seg + 8) = (u32x4){vw[4], vw[5], vw[6], vw[7]};
            if (seg == 0) ((float*)(DRY ? (unsigned char*)A.out + 96 * MiB : ws + WS_DEC))[(size_t)unit * 128 + kk] = __expf(total);
        }
        __syncthreads();
        {
            const int w8 = F.wave, l = F.lane, fr = l & 15, fq = l >> 4;
            f32x4 acc[8];
#pragma unroll
            for (int n = 0; n < 8; ++n) acc[n] = (f32x4){0.f, 0.f, 0.f, 0.f};
#pragma unroll
            for (int ks = 0; ks < 2; ++ks) {
                const bf16x8 a = *(const LAS bf16x8*)(kdT + (16 * w8 + fr) * 72 + 32 * ks + 8 * fq);
#pragma unroll
                for (int n = 0; n < 8; ++n) { const bf16x8 bb = *(const LAS bf16x8*)(vT + (16 * n + fr) * 72 + 32 * ks + 8 * fq);
                    acc[n] = __builtin_amdgcn_mfma_f32_16x16x32_bf16(a, bb, acc[n], 0, 0, 0); }
            }
#pragma unroll
            for (int n = 0; n < 8; ++n) { u32x2 o; o.x = pk2(acc[n][0], acc[n][1]); o.y = pk2(acc[n][2], acc[n][3]);
                *(LAS u32x2*)(stT + (16 * n + fr) * 136 + 16 * w8 + 4 * fq) = o; }
        }
        __syncthreads();
        {
            bf16_t* ST = (bf16_t*)(DRY ? (unsigned char*)A.out : ws + WS_N1) + (size_t)unit * 16384;
            const int vv = tid >> 2, part = tid & 3;
#pragma unroll
            for (int q = 0; q < 4; ++q) *(u32x4*)(ST + (size_t)vv * 128 + 32 * part + 8 * q) = *(const LAS u32x4*)(stT + vv * 136 + 32 * part + 8 * q);
        }
    }
#undef GC_LOAD
    (void)hconst;
}

template <bool DRY>
__device__ __forceinline__ void sgu_unit(const Frame& F, const Args& A, int unit, bool stats) {
    const int g = unit & 3, blk = (unit >> 2) & 31, b = unit >> 7;
    const int t0 = b * SEQ + blk * 128;
    bf16_t* P = (bf16_t*)(A.ws + WS_P);
    LAS bf16_t* wA = (LAS bf16_t*)F.lds;
    LAS bf16_t* vnT = (LAS bf16_t*)(F.lds + 34816);
    LAS float* st = (LAS float*)(F.lds + 69632);
    LAS bf16_t* suS = (LAS bf16_t*)(F.lds + 70656);
    const int tid = F.tid;
    __syncthreads();
    if (stats) {
        const int j = tid >> 2, q = tid & 3;
        const bf16_t* sp = P + (size_t)(t0 + j) * PLD + PC_SV + q * 128;
        float s = 0.f, s2 = 0.f;
#pragma unroll
        for (int i = 0; i < 16; ++i) { const u32x4 w = *(const u32x4*)(sp + 8 * i);
            const float f[8] = {bflo(w.x), bfhi(w.x), bflo(w.y), bfhi(w.y), bflo(w.z), bfhi(w.z), bflo(w.w), bfhi(w.w)};
#pragma unroll
            for (int e = 0; e < 8; ++e) { s += f[e]; s2 += f[e] * f[e]; } }
        s += __shfl_xor(s, 1); s += __shfl_xor(s, 2); s2 += __shfl_xor(s2, 1); s2 += __shfl_xor(s2, 2);
        const float mu = s * (1.f / 512.f); const float var = fmaxf(s2 * (1.f / 512.f) - mu * mu, 0.f);
        if (q == 0) { st[2 * j] = mu; st[2 * j + 1] = 1.f / sqrtf(var + EPS); }
    }
    {
        const int i = tid >> 2, jb = (tid & 3) * 32;
        const float* wp = A.in[I_SW] + (size_t)g * 16384 + (size_t)i * 128 + jb;
        const bf16_t* sup = P + (size_t)(t0 + i) * PLD + PC_SU + g * 128 + jb;
#pragma unroll
        for (int q = 0; q < 4; ++q) { const f32x4 a = *(const f32x4*)(wp + 8 * q), bq = *(const f32x4*)(wp + 8 * q + 4);
            const bool z = (i < 64) && (jb + 8 * q >= 64);
            u32x4 o; o.x = pk2(a.x, a.y); o.y = pk2(a.z, a.w); o.z = pk2(bq.x, bq.y); o.w = pk2(bq.z, bq.w);
            if (z) o = (u32x4){0u, 0u, 0u, 0u};
            *(LAS u32x4*)(wA + i * 136 + jb + 8 * q) = o;
            *(LAS u32x4*)(suS + i * 136 + jb + 8 * q) = *(const u32x4*)(sup + 8 * q); }
    }
    const int cch = tid & 127, seg = tid >> 7;
    bf16_t xr[32];
    { const bf16_t* sp = P + (size_t)(t0 + 32 * seg) * PLD + PC_SV + g * 128 + cch;
#pragma unroll
      for (int i = 0; i < 32; ++i) xr[i] = sp[(size_t)i * PLD]; }
    const float lg = A.in[I_SLNG][g * 128 + cch], lb = A.in[I_SLNB][g * 128 + cch];
    __syncthreads();
    {
        unsigned ow[16];
#pragma unroll
        for (int i = 0; i < 16; ++i) { const int j = 32 * seg + 2 * i; const f32x4 ms = *(const LAS f32x4*)(st + 2 * j);
            ow[i] = pk2((bf1(xr[2 * i]) - ms.x) * ms.y * lg + lb, (bf1(xr[2 * i + 1]) - ms.z) * ms.w * lg + lb); }
#pragma unroll
        for (int q = 0; q < 4; ++q) *(LAS u32x4*)(vnT + cch * 136 + 32 * seg + 8 * q) = (u32x4){ow[4 * q], ow[4 * q + 1], ow[4 * q + 2], ow[4 * q + 3]};
    }
    __syncthreads();
    {
        const int w = F.wave, l = F.lane, fr = l & 15, fq = l >> 4;
        f32x4 acc[8];
#pragma unroll
        for (int n = 0; n < 8; ++n) acc[n] = (f32x4){0.f, 0.f, 0.f, 0.f};
#pragma unroll
        for (int ks = 0; ks < 4; ++ks) {
            const bf16x8 a = *(const LAS bf16x8*)(wA + (16 * w + fr) * 136 + 32 * ks + 8 * fq);
#pragma unroll
            for (int n = 0; n < 8; ++n) { const bf16x8 bb = *(const LAS bf16x8*)(vnT + (16 * n + fr) * 136 + 32 * ks + 8 * fq);
                acc[n] = __builtin_amdgcn_mfma_f32_16x16x32_bf16(a, bb, acc[n], 0, 0, 0); }
        }
#pragma unroll
        for (int jj = 0; jj < 4; ++jj) { const int i = 16 * w + 4 * fq + jj; const float bias = A.in[I_SB][g * 128 + i];
            LAS bf16_t* rp = suS + i * 136 + fr;
#pragma unroll
            for (int n = 0; n < 8; ++n) { const float su = bf1(rp[16 * n]); rp[16 * n] = (bf16_t)f2bf(su * (acc[n][jj] + bias)); } }
    }
    __syncthreads();
    {
        const int i = tid >> 2, jb = (tid & 3) * 32;
        bf16_t* yp = DRY ? (bf16_t*)A.out + (size_t)(t0 + i) * 512 + g * 128 + jb : P + (size_t)(t0 + i) * PLD + PC_SU + g * 128 + jb;
#pragma unroll
        for (int q = 0; q < 4; ++q) *(u32x4*)(yp + 8 * q) = *(const LAS u32x4*)(suS + i * 136 + jb + 8 * q);
    }
}

template <bool DRY>
__device__ __forceinline__ void gla_scan(const Frame& F, const Args& A) {
    bf16_t* ST = (bf16_t*)(A.ws + WS_N1); bf16_t* STO = DRY ? (bf16_t*)A.out : ST; const float* DEC = (const float*)(A.ws + WS_DEC);
    for (int gi = F.bid * 512 + F.tid; gi < 131072; gi += F.G * 512) {
        const int k4 = gi & 31, vv = (gi >> 5) & 127, h = (gi >> 12) & 3, b = gi >> 14;
        float s0 = 0.f, s1 = 0.f, s2 = 0.f, s3 = 0.f;
        u32x2 wa[8], wb[8]; f32x4 da[8], db[8];
#define SCAN_LOAD(W, Dd, c0) do { _Pragma("unroll") for (int i_ = 0; i_ < 8; ++i_) { const size_t u_ = (size_t)((b * 64 + (c0) + i_) * 4 + h); \
            W[i_] = *(const u32x2*)(ST + u_ * 16384 + (size_t)vv * 128 + k4 * 4); Dd[i_] = *(const f32x4*)(DEC + u_ * 128 + k4 * 4); } } while (0)
#define SCAN_STEP(W, Dd, c0) do { _Pragma("unroll") for (int i_ = 0; i_ < 8; ++i_) { const size_t u_ = (size_t)((b * 64 + (c0) + i_) * 4 + h); \
            s0 = Dd[i_].x * s0 + bflo(W[i_].x); s1 = Dd[i_].y * s1 + bfhi(W[i_].x); s2 = Dd[i_].z * s2 + bflo(W[i_].y); s3 = Dd[i_].w * s3 + bfhi(W[i_].y); \
            u32x2 o_; o_.x = pk2(s0, s1); o_.y = pk2(s2, s3); *(u32x2*)(STO + u_ * 16384 + (size_t)vv * 128 + k4 * 4) = o_; } } while (0)
        SCAN_LOAD(wa, da, 0);
#pragma unroll
        for (int c0 = 0; c0 < 64; c0 += 16) {
            SCAN_LOAD(wb, db, c0 + 8);
            SCAN_STEP(wa, da, c0);
            if (c0 + 16 < 64) SCAN_LOAD(wa, da, c0 + 16);
            SCAN_STEP(wb, db, c0 + 8);
        }
#undef SCAN_LOAD
#undef SCAN_STEP
    }
}

template <bool DRY>
__device__ __forceinline__ void gla_out_phase(const Frame& F, const Args& A) {
    bf16_t* P = (bf16_t*)(A.ws + WS_P);
    LAS bf16_t* qA = (LAS bf16_t*)F.lds;
    LAS bf16_t* sB = (LAS bf16_t*)(F.lds + 17408);
    LAS float* oF = (LAS float*)(F.lds + 52224);
    const int tid = F.tid, s = tid >> 3, cb = (tid & 7) * 16, vv = tid >> 2, kb = (tid & 3) * 32;
    u32x4 nq0, nq1, ns0, ns1, ns2, ns3, nr0, nr1;
#define GO_LOAD(unit) do { const int h_ = (unit) & 3, c_ = ((unit) >> 2) & 63, b_ = (unit) >> 8; const int t0_ = b_ * SEQ + c_ * 64; \
        const bf16_t* qp_ = P + (size_t)(t0_ + s) * PLD + PC_Q + h_ * 128 + cb; nq0 = *(const u32x4*)qp_; nq1 = *(const u32x4*)(qp_ + 8); \
        const bf16_t* sp_ = (const bf16_t*)(A.ws + WS_N1) + (size_t)(unit) * 16384 + (size_t)vv * 128 + kb; ns0 = *(const u32x4*)sp_; ns1 = *(const u32x4*)(sp_ + 8); ns2 = *(const u32x4*)(sp_ + 16); ns3 = *(const u32x4*)(sp_ + 24); \
        const bf16_t* rp_ = P + (size_t)(t0_ + s) * PLD + PC_R + h_ * 128 + cb; nr0 = *(const u32x4*)rp_; nr1 = *(const u32x4*)(rp_ + 8); } while (0)
    int unit = F.bid;
    if (unit < 2048) GO_LOAD(unit);
    for (; unit < 2048; unit += F.G) {
        const int h = unit & 3, c = (unit >> 2) & 63, b = unit >> 8;
        const int t0 = b * SEQ + c * 64;
        __syncthreads();
        *(LAS u32x4*)(qA + s * 136 + cb) = nq0; *(LAS u32x4*)(qA + s * 136 + cb + 8) = nq1;
        *(LAS u32x4*)(sB + vv * 136 + kb) = ns0; *(LAS u32x4*)(sB + vv * 136 + kb + 8) = ns1; *(LAS u32x4*)(sB + vv * 136 + kb + 16) = ns2; *(LAS u32x4*)(sB + vv * 136 + kb + 24) = ns3;
        const u32x4 r0 = nr0, r1 = nr1;
        if (unit + F.G < 2048) GO_LOAD(unit + F.G);
        __syncthreads();
        {
            const int w = F.wave, l = F.lane, fr = l & 15, fq = l >> 4, m = w & 3, nh = w >> 2;
            f32x4 acc[4];
#pragma unroll
            for (int n = 0; n < 4; ++n) acc[n] = (f32x4){0.f, 0.f, 0.f, 0.f};
#pragma unroll
            for (int ks = 0; ks < 4; ++ks) {
                const bf16x8 a = *(const LAS bf16x8*)(qA + (16 * m + fr) * 136 + 32 * ks + 8 * fq);
#pragma unroll
                for (int n = 0; n < 4; ++n) { const bf16x8 bb = *(const LAS bf16x8*)(sB + (16 * (4 * nh + n) + fr) * 136 + 32 * ks + 8 * fq);
                    acc[n] = __builtin_amdgcn_mfma_f32_16x16x32_bf16(a, bb, acc[n], 0, 0, 0); }
            }
            const float scale = 0.08838834764831845f;
#pragma unroll
            for (int n = 0; n < 4; ++n)
#pragma unroll
                for (int jj = 0; jj < 4; ++jj) oF[(16 * m + 4 * fq + jj) * 132 + 16 * (4 * nh + n) + fr] = acc[n][jj] * scale;
        }
        __syncthreads();
        {
            float o[16]; float ss = 0.f;
#pragma unroll
            for (int i = 0; i < 16; ++i) { o[i] = oF[s * 132 + cb + i]; ss += o[i] * o[i]; }
            ss += __shfl_xor(ss, 1); ss += __shfl_xor(ss, 2); ss += __shfl_xor(ss, 4);
            const float rstd = 1.f / sqrtf(ss * (1.f / 128.f) + EPS);
            const unsigned rw[8] = {r0.x, r0.y, r0.z, r0.w, r1.x, r1.y, r1.z, r1.w};
            const float* gg = A.in[I_GLAG] + h * 128 + cb;
            unsigned ow[8];
#pragma unroll
            for (int i = 0; i < 8; ++i) { const float y0 = o[2 * i] * rstd * gg[2 * i] * siluf_(bflo(rw[i])), y1 = o[2 * i + 1] * rstd * gg[2 * i + 1] * siluf_(bfhi(rw[i])); ow[i] = pk2(y0, y1); }
            bf16_t* yp = DRY ? (bf16_t*)A.out + (size_t)(t0 + s) * 512 + h * 128 + cb : P + (size_t)(t0 + s) * PLD + PC_R + h * 128 + cb;
            *(u32x4*)yp = (u32x4){ow[0], ow[1], ow[2], ow[3]}; *(u32x4*)(yp + 8) = (u32x4){ow[4], ow[5], ow[6], ow[7]};
        }
    }
#undef GO_LOAD
}

__device__ __forceinline__ unsigned ordkey(float v) { const unsigned u = __builtin_bit_cast(unsigned, v); return u ^ ((unsigned)((int)u >> 31) | 0x80000000u); }
__device__ __forceinline__ float unord(unsigned k) { const unsigned u = (k & 0x80000000u) ? (k & 0x7fffffffu) : ~k; return __builtin_bit_cast(float, u); }
#define INS16(r, xin) do { unsigned _x = (xin); _Pragma("unroll") for (int _i = 0; _i < 16; ++_i) { const unsigned _h = max((r)[_i], _x); _x = min((r)[_i], _x); (r)[_i] = _h; } } while (0)

#define CE(a, b) do { const unsigned _h = max((a), (b)), _l = min((a), (b)); (a) = _h; (b) = _l; } while (0)
#define SORT16(v) do { CE(v[0], v[1]); CE(v[2], v[3]); CE(v[0], v[2]); CE(v[1], v[3]); CE(v[1], v[2]); CE(v[4], v[5]); CE(v[6], v[7]); CE(v[4], v[6]); CE(v[5], v[7]); CE(v[5], v[6]); CE(v[0], v[4]); CE(v[2], v[6]); CE(v[2], v[4]); CE(v[1], v[5]); CE(v[3], v[7]); CE(v[3], v[5]); CE(v[1], v[2]); CE(v[3], v[4]); CE(v[5], v[6]); CE(v[8], v[9]); CE(v[10], v[11]); CE(v[8], v[10]); CE(v[9], v[11]); CE(v[9], v[10]); CE(v[12], v[13]); CE(v[14], v[15]); CE(v[12], v[14]); CE(v[13], v[15]); CE(v[13], v[14]); CE(v[8], v[12]); CE(v[10], v[14]); CE(v[10], v[12]); CE(v[9], v[13]); CE(v[11], v[15]); CE(v[11], v[13]); CE(v[9], v[10]); CE(v[11], v[12]); CE(v[13], v[14]); CE(v[0], v[8]); CE(v[4], v[12]); CE(v[4], v[8]); CE(v[2], v[10]); CE(v[6], v[14]); CE(v[6], v[10]); CE(v[2], v[4]); CE(v[6], v[8]); CE(v[10], v[12]); CE(v[1], v[9]); CE(v[5], v[13]); CE(v[5], v[9]); CE(v[3], v[11]); CE(v[7], v[15]); CE(v[7], v[11]); CE(v[3], v[5]); CE(v[7], v[9]); CE(v[11], v[13]); CE(v[1], v[2]); CE(v[3], v[4]); CE(v[5], v[6]); CE(v[7], v[8]); CE(v[9], v[10]); CE(v[11], v[12]); CE(v[13], v[14]); } while (0)
#define MERGE16(T, S) do { _Pragma("unroll") for (int _i = 0; _i < 16; ++_i) (T)[_i] = max((T)[_i], (S)[15 - _i]); \
    _Pragma("unroll") for (int _d = 8; _d >= 1; _d >>= 1) { _Pragma("unroll") for (int _i = 0; _i < 16; ++_i) if ((_i & _d) == 0) CE((T)[_i], (T)[_i + _d]); } } while (0)
__device__ __forceinline__ void peer_topk(const Frame& F, const Args& A) {
    const bf16_t* SC = (const bf16_t*)(A.ws + WS_P + P_SC);
    int* IDX = (int*)(A.ws + WS_P + P_IDX); float* GATE = (float*)(A.ws + WS_P + P_GATE);
    const int gw = F.bid * NWAVES + F.wave, NGW = F.G * NWAVES;
    for (int it = gw; it < 512 * 8; it += NGW) {
        const int h = it & 7, tb = it >> 3; const int tok = tb * 64 + F.lane;
        unsigned r1[16], r2[16], rc[16];
        const bf16_t* p1 = SC + ((size_t)(tok >> 4) * 256 + h * 32) * 128 + (tok & 15) * 8; const bf16_t* p2 = p1 + 16 * 128;
        {
            float raw[128]; unsigned sg[16];
#pragma unroll
            for (int jq = 0; jq < 16; ++jq) { const u32x4 t4 = *(const u32x4*)(p1 + jq * 128);
#pragma unroll
                for (int c = 0; c < 4; ++c) { raw[8 * jq + 2 * c] = bflo(t4[c]); raw[8 * jq + 2 * c + 1] = bfhi(t4[c]); } }
#pragma unroll
            for (int j = 0; j < 16; ++j) r1[j] = (ordkey(raw[j]) & ~127u) | (unsigned)(127 - j);
            SORT16(r1);
#pragma unroll
            for (int gq = 1; gq < 8; ++gq) {
#pragma unroll
                for (int j = 0; j < 16; ++j) sg[j] = (ordkey(raw[16 * gq + j]) & ~127u) | (unsigned)(127 - (16 * gq + j));
                SORT16(sg); MERGE16(r1, sg); }
#pragma unroll
            for (int jq = 0; jq < 16; ++jq) { const u32x4 t4 = *(const u32x4*)(p2 + jq * 128);
#pragma unroll
                for (int c = 0; c < 4; ++c) { raw[8 * jq + 2 * c] = bflo(t4[c]); raw[8 * jq + 2 * c + 1] = bfhi(t4[c]); } }
#pragma unroll
            for (int j = 0; j < 16; ++j) r2[j] = (ordkey(raw[j]) & ~127u) | (unsigned)(127 - j);
            SORT16(r2);
#pragma unroll
            for (int gq = 1; gq < 8; ++gq) {
#pragma unroll
                for (int j = 0; j < 16; ++j) sg[j] = (ordkey(raw[16 * gq + j]) & ~127u) | (unsigned)(127 - (16 * gq + j));
                SORT16(sg); MERGE16(r2, sg); }
        }
        float v1[16], v2[16];
#pragma unroll
        for (int i = 0; i < 16; ++i) { v1[i] = unord((r1[i] & ~127u) | 64u); v2[i] = unord((r2[i] & ~127u) | 64u); }
        {
            unsigned cg[4][16]; int cn = 0;
#pragma unroll
            for (int a = 0; a < 16; ++a)
#pragma unroll
                for (int bq = 0; bq < 16; ++bq) if ((a + 1) * (bq + 1) <= 16) { cg[cn >> 4][cn & 15] = (ordkey(v1[a] + v2[bq]) & ~255u) | (unsigned)(a * 16 + bq); ++cn; }
#pragma unroll
            for (int z = 50; z < 64; ++z) cg[z >> 4][z & 15] = 0u;
            SORT16(cg[0]); SORT16(cg[1]); SORT16(cg[2]); SORT16(cg[3]);
            MERGE16(cg[0], cg[1]); MERGE16(cg[0], cg[2]); MERGE16(cg[0], cg[3]);
#pragma unroll
            for (int i = 0; i < 16; ++i) rc[i] = cg[0][i];
        }
        float val[16]; int ex[16];
        {
            LAS unsigned* t1 = (LAS unsigned*)(F.lds + F.wave * 8704) + F.lane * 17; LAS unsigned* t2 = t1 + 64 * 17;
#pragma unroll
            for (int i = 0; i < 16; ++i) { t1[i] = r1[i]; t2[i] = r2[i]; }
            LDS_WAIT(); asm volatile("" ::: "memory");
#pragma unroll
            for (int w = 0; w < 16; ++w) {
                const int a = (rc[w] >> 4) & 15, bq = rc[w] & 15;
                const unsigned k1 = t1[a], k2 = t2[bq];
                val[w] = unord((k1 & ~127u) | 64u) + unord((k2 & ~127u) | 64u);
                ex[w] = (127 - (int)(k1 & 127u)) * 128 + (127 - (int)(k2 & 127u));
            }
            LDS_WAIT(); asm volatile("" ::: "memory");
        }
        float mx = val[0];
#pragma unroll
        for (int w = 1; w < 16; ++w) mx = fmaxf(mx, val[w]);
        float sum = 0.f;
#pragma unroll
        for (int w = 0; w < 16; ++w) { val[w] = __expf(val[w] - mx); sum += val[w]; }
        const float inv = 1.f / sum;
        int* ip = IDX + (size_t)tok * 128 + h * 16; float* gp = GATE + (size_t)tok * 128 + h * 16;
#pragma unroll
        for (int q = 0; q < 4; ++q) { *(int4*)(ip + 4 * q) = make_int4(ex[4 * q], ex[4 * q + 1], ex[4 * q + 2], ex[4 * q + 3]);
            *(f32x4*)(gp + 4 * q) = (f32x4){val[4 * q] * inv, val[4 * q + 1] * inv, val[4 * q + 2] * inv, val[4 * q + 3] * inv}; }
    }
}

#define DPP_ADD(v, ctrl) ((v) + __builtin_bit_cast(float, __builtin_amdgcn_mov_dpp(__builtin_bit_cast(int, (v)), (ctrl), 0xf, 0xf, true)))
__device__ __forceinline__ void fp8x16_to_f32x2(const u32x4 r, f32x2* f) {
#pragma unroll
    for (int q = 0; q < 4; ++q) { f[2 * q] = __builtin_amdgcn_cvt_pk_f32_fp8((int)r[q], false); f[2 * q + 1] = __builtin_amdgcn_cvt_pk_f32_fp8((int)r[q], true); }
}
__device__ __forceinline__ void fp8x16_to_f32(const u32x4 r, float* f) {
#pragma unroll
    for (int q = 0; q < 4; ++q) { const f32x2 lo = __builtin_amdgcn_cvt_pk_f32_fp8((int)r[q], false), hi = __builtin_amdgcn_cvt_pk_f32_fp8((int)r[q], true);
        f[4 * q] = lo.x; f[4 * q + 1] = lo.y; f[4 * q + 2] = hi.x; f[4 * q + 3] = hi.y; }
}
__device__ __forceinline__ long lo64(u32x4 v) { return (long)(((unsigned long)v.y << 32) | (unsigned long)v.x); }
__device__ __forceinline__ long hi64(u32x4 v) { return (long)(((unsigned long)v.w << 32) | (unsigned long)v.z); }
template <int MODE>
__device__ __forceinline__ void peer_u_phase(const Frame& F, const Args& A) {
    const unsigned char* X8 = A.ws + WS_P + P_X8;
    const unsigned char* U8 = A.ws + WS_U8; const float* SU = (const float*)(A.ws + WS_SU); const float* SV = (const float*)(A.ws + WS_SV);
    const int* IDX = (const int*)(A.ws + WS_P + P_IDX); const float* GATE = (const float*)(A.ws + WS_P + P_GATE); float* AK = (float*)(MODE == 0 ? A.ws + WS_AK : A.ws + WS_P + P_SC);
    const int g = F.bid & 7, nmem = F.G >> 3, l = F.lane, step = nmem * NWAVES;
    const int loff = 64 * (l & 15) + 16 * (l >> 4);
    const bool dg = ((l & 15) >> 2) == (l >> 4); const int dr = l & 3;
    const float dw0 = (dg && dr == 0) ? 1.f : 0.f, dw1 = (dg && dr == 1) ? 1.f : 0.f, dw2 = (dg && dr == 2) ? 1.f : 0.f, dw3 = (dg && dr == 3) ? 1.f : 0.f;
    LAS int* le = (LAS int*)(F.lds + F.wave * 2048); LAS int* lk = le + 256;
    const bool b5 = (l & 32) != 0, b4 = (l & 16) != 0, b3 = (l & 8) != 0;
    int tok = 2 * ((F.bid >> 3) * NWAVES + F.wave);
    u32x4 nxA, nxB; int neA0, neA1, neB0, neB1; float ngA0, ngA1, ngB0, ngB1;
#define U_PREFETCH(t) do { const size_t _tA = (size_t)(t), _tB = (size_t)(t) + 1; if (MODE == 4) { nxA = (u32x4){(unsigned)_tA, 1u, 2u, 3u}; nxB = nxA; neA0 = (int)((_tA * 37 + l * 11) & 16383); neA1 = (int)((_tA * 53 + l * 7) & 16383); neB0 = (int)((_tB * 37 + l * 13) & 16383); neB1 = (int)((_tB * 29 + l * 3) & 16383); ngA0 = ngA1 = ngB0 = ngB1 = 0.01f; break; } nxA = *(const u32x4*)(X8 + _tA * 1024 + loff); nxB = *(const u32x4*)(X8 + _tB * 1024 + loff); \
        neA0 = IDX[_tA * 128 + l]; neA1 = IDX[_tA * 128 + 64 + l]; neB0 = IDX[_tB * 128 + l]; neB1 = IDX[_tB * 128 + 64 + l]; \
        ngA0 = GATE[_tA * 128 + l]; ngA1 = GATE[_tA * 128 + 64 + l]; ngB0 = GATE[_tB * 128 + l]; ngB1 = GATE[_tB * 128 + 64 + l]; } while (0)
    if (tok + 1 < T_TOK) U_PREFETCH(tok);
    for (; tok + 1 < T_TOK; tok += 2 * step) {
        const int tokA = tok, tokB = tok + 1;
        const u32x4 xA = nxA, xB = nxB;
        const int eA0 = neA0, eA1 = neA1, eB0 = neB0, eB1 = neB1; const float gA0 = ngA0, gA1 = ngA1, gB0 = ngB0, gB1 = ngB1;
        bool pf_done = false;
        const bool oA0 = (eA0 & 7) == g, oA1 = (eA1 & 7) == g, oB0 = (eB0 & 7) == g, oB1 = (eB1 & 7) == g;
        const unsigned long long mA0 = __ballot(oA0), mA1 = __ballot(oA1), mB0 = __ballot(oB0), mB1 = __ballot(oB1);
        const int c0 = __popcll(mA0), c1 = c0 + __popcll(mA1), c2 = c1 + __popcll(mB0), n = c2 + __popcll(mB1);
#define MBC(m) __builtin_amdgcn_mbcnt_hi((unsigned)((m) >> 32), __builtin_amdgcn_mbcnt_lo((unsigned)(m), 0u))
        if (oA0) { const int p = MBC(mA0); le[p] = (eA0 << 8) | l; lk[p] = __builtin_bit_cast(int, gA0); }
        if (oA1) { const int p = c0 + MBC(mA1); le[p] = (eA1 << 8) | (64 + l); lk[p] = __builtin_bit_cast(int, gA1); }
        if (oB0) { const int p = c1 + MBC(mB0); le[p] = (eB0 << 8) | 128 | l; lk[p] = __builtin_bit_cast(int, gB0); }
        if (oB1) { const int p = c2 + MBC(mB1); le[p] = (eB1 << 8) | 128 | (64 + l); lk[p] = __builtin_bit_cast(int, gB1); }
#undef MBC
        LDS_WAIT(); asm volatile("" ::: "memory");
        for (int cb = 0; cb < n || cb == 0; cb += 64) {
        const int nc = min(n, cb + 64);
        const bool fv = (cb + l) < nc;
        const int ent = fv ? le[cb + l] : 0; const float gt = fv ? __builtin_bit_cast(float, lk[cb + l]) : 0.f; float tot = 0.f;
        const float su = SU[ent >> 8], sv = SV[ent >> 8];
        const unsigned long long radr = (unsigned long long)(U8 + (size_t)(((ent >> 8) & 7) * 2048 + (((ent >> 8) >> 3) & (MODE == 2 ? 255 : 2047))) * 1024);
        const int ralo = (int)(unsigned)radr, rahi = (int)(unsigned)(radr >> 32);
        for (int i = cb; i < nc; i += 16) {
            u32x4 row[2][8];
#pragma unroll
            for (int b = 0; b < 2; ++b) if (i + 8 * b < nc) {
#pragma unroll
                for (int j = 0; j < 8; ++j) { const int ln = min(i + 8 * b + j, nc - 1) - cb;
                    const unsigned lo = (unsigned)__builtin_amdgcn_readlane(ralo, ln), hi = (unsigned)__builtin_amdgcn_readlane(rahi, ln);
                    const GAS unsigned char* rp = (const GAS unsigned char*)(((unsigned long long)hi << 32) | lo);
                    row[b][j] = *(const GAS u32x4*)(rp + (unsigned)loff); } }
            if (!pf_done) { pf_done = true; if (tok + 2 * step + 1 < T_TOK) U_PREFETCH(tok + 2 * step); }
#pragma unroll
            for (int b = 0; b < 2; ++b) if (i + 8 * b < nc) {
                float p[8];
                f32x4 accj[8];
                const int base0 = i + 8 * b;
                if (base0 + 8 <= c1) {
#pragma unroll
                    for (int j = 0; j < 8; ++j) accj[j] = __builtin_amdgcn_mfma_f32_16x16x32_fp8_fp8(lo64(row[b][j]), lo64(xA), (f32x4){0.f, 0.f, 0.f, 0.f}, 0, 0, 0);
#pragma unroll
                    for (int j = 0; j < 8; ++j) accj[j] = __builtin_amdgcn_mfma_f32_16x16x32_fp8_fp8(hi64(row[b][j]), hi64(xA), accj[j], 0, 0, 0);
                } else if (base0 >= c1) {
#pragma unroll
                    for (int j = 0; j < 8; ++j) accj[j] = __builtin_amdgcn_mfma_f32_16x16x32_fp8_fp8(lo64(row[b][j]), lo64(xB), (f32x4){0.f, 0.f, 0.f, 0.f}, 0, 0, 0);
#pragma unroll
                    for (int j = 0; j < 8; ++j) accj[j] = __builtin_amdgcn_mfma_f32_16x16x32_fp8_fp8(hi64(row[b][j]), hi64(xB), accj[j], 0, 0, 0);
                } else {
#pragma unroll
                    for (int j = 0; j < 8; ++j) { const u32x4 xs = (base0 + j >= c1) ? xB : xA; accj[j] = __builtin_amdgcn_mfma_f32_16x16x32_fp8_fp8(lo64(row[b][j]), lo64(xs), (f32x4){0.f, 0.f, 0.f, 0.f}, 0, 0, 0);
                        accj[j] = __builtin_amdgcn_mfma_f32_16x16x32_fp8_fp8(hi64(row[b][j]), hi64(xs), accj[j], 0, 0, 0); }
                }
#pragma unroll
                for (int j = 0; j < 8; ++j) p[j] = __builtin_fmaf(accj[j][3], dw3, __builtin_fmaf(accj[j][2], dw2, __builtin_fmaf(accj[j][1], dw1, accj[j][0] * dw0)));
                float q4[4], q2[2], q1;
#pragma unroll
                for (int j = 0; j < 4; ++j) { const float keep = b5 ? p[4 + j] : p[j], send = b5 ? p[j] : p[4 + j]; q4[j] = keep + __shfl_xor(send, 32); }
#pragma unroll
                for (int j = 0; j < 2; ++j) { const float keep = b4 ? q4[2 + j] : q4[j], send = b4 ? q4[j] : q4[2 + j]; q2[j] = keep + __shfl_xor(send, 16); }
                { const float keep = b3 ? q2[1] : q2[0], send = b3 ? q2[0] : q2[1]; q1 = keep + __shfl_xor(send, 8); }
                q1 = DPP_ADD(q1, 0xB1); q1 = DPP_ADD(q1, 0x4E); q1 = DPP_ADD(q1, 0x141);
                const float t = __builtin_bit_cast(float, __builtin_amdgcn_ds_bpermute((l & 7) * 32, __builtin_bit_cast(int, q1)));
                const int base = i + 8 * b;
                if ((l >> 3) == ((base - cb) >> 3)) tot = t;
            }
        }
        if (!pf_done) { if (tok + 2 * step + 1 < T_TOK) U_PREFETCH(tok + 2 * step); }
        if (fv) { const int tk = (ent & 128) ? tokB : tokA; AK[(size_t)tk * 128 + (ent & 127)] = gelu_tanh(tot * su * (1.f / 16.f)) * gt * sv; }
        if (n == 0) break;
        }
        LDS_WAIT(); asm volatile("" ::: "memory");
    }
#undef U_PREFETCH
}
template <int MODE>
__device__ __forceinline__ void peer_u_phase1(const Frame& F, const Args& A) {
    const unsigned char* X8 = A.ws + WS_P + P_X8;
    const unsigned char* U8 = A.ws + WS_U8; const float* SU = (const float*)(A.ws + WS_SU); const float* SV = (const float*)(A.ws + WS_SV);
    const int* IDX = (const int*)(A.ws + WS_P + P_IDX); const float* GATE = (const float*)(A.ws + WS_P + P_GATE); float* AK = (float*)(MODE == 0 ? A.ws + WS_AK : A.ws + WS_P + P_SC);
    const int g = F.bid & (UNG - 1), nmem = F.G >> UNG_SH, l = F.lane, step = nmem * NWAVES;
    const int loff = 64 * (l & 15) + 16 * (l >> 4);
    const bool dg = ((l & 15) >> 2) == (l >> 4); const int dr = l & 3;
    const float dw0 = (dg && dr == 0) ? 1.f : 0.f, dw1 = (dg && dr == 1) ? 1.f : 0.f, dw2 = (dg && dr == 2) ? 1.f : 0.f, dw3 = (dg && dr == 3) ? 1.f : 0.f;
    LAS int* le = (LAS int*)(F.lds + F.wave * 2048); LAS int* lk = le + 256;
    const bool b5 = (l & 32) != 0, b4 = (l & 16) != 0, b3 = (l & 8) != 0;
    int tok = (F.bid >> UNG_SH) * NWAVES + F.wave;
    u32x4 nxA; int neA0, neA1; float ngA0, ngA1;
#define U1_PREFETCH(t) do { const size_t _tA = (size_t)(t); nxA = *(const u32x4*)(X8 + _tA * 1024 + loff); \
        neA0 = IDX[_tA * 128 + l]; neA1 = IDX[_tA * 128 + 64 + l]; ngA0 = GATE[_tA * 128 + l]; ngA1 = GATE[_tA * 128 + 64 + l]; } while (0)
    if (tok < T_TOK) U1_PREFETCH(tok);
    for (; tok < T_TOK; tok += step) {
        const u32x4 xA = nxA;
        const int eA0 = neA0, eA1 = neA1; const float gA0 = ngA0, gA1 = ngA1;
        bool pf_done = false;
        const bool oA0 = (eA0 & (UNG - 1)) == g, oA1 = (eA1 & (UNG - 1)) == g;
        const unsigned long long mA0 = __ballot(oA0), mA1 = __ballot(oA1);
        const int c0 = __popcll(mA0), n = c0 + __popcll(mA1);
#define MBC(m) __builtin_amdgcn_mbcnt_hi((unsigned)((m) >> 32), __builtin_amdgcn_mbcnt_lo((unsigned)(m), 0u))
        if (oA0) { const int p = MBC(mA0); le[p] = (eA0 << 8) | l; lk[p] = __builtin_bit_cast(int, gA0); }
        if (oA1) { const int p = c0 + MBC(mA1); le[p] = (eA1 << 8) | (64 + l); lk[p] = __builtin_bit_cast(int, gA1); }
#undef MBC
        LDS_WAIT(); asm volatile("" ::: "memory");
        for (int cb = 0; cb < n || cb == 0; cb += 64) {
        const int nc = min(n, cb + 64);
        const bool fv = (cb + l) < nc;
        const int ent = fv ? le[cb + l] : 0; const float gt = fv ? __builtin_bit_cast(float, lk[cb + l]) : 0.f; float tot = 0.f;
        const float su = SU[ent >> 8], sv = SV[ent >> 8];
        const unsigned long long radr = (unsigned long long)(U8 + (size_t)(((ent >> 8) & (UNG - 1)) * (NEXP / UNG) + ((ent >> 8) >> UNG_SH)) * 1024);
        const int ralo = (int)(unsigned)radr, rahi = (int)(unsigned)(radr >> 32);
        for (int i = cb; i < nc; i += 16) {
            u32x4 row[2][8];
#pragma unroll
            for (int b = 0; b < 2; ++b) if (i + 8 * b < nc) {
#pragma unroll
                for (int j = 0; j < 8; ++j) { const int ln = min(i + 8 * b + j, nc - 1) - cb;
                    const unsigned lo = (unsigned)__builtin_amdgcn_readlane(ralo, ln), hi = (unsigned)__builtin_amdgcn_readlane(rahi, ln);
                    const GAS unsigned char* rp = (const GAS unsigned char*)(((unsigned long long)hi << 32) | lo);
                    row[b][j] = *(const GAS u32x4*)(rp + (unsigned)loff); } }
            if (!pf_done) { pf_done = true; if (tok + step < T_TOK) U1_PREFETCH(tok + step); }
#pragma unroll
            for (int b = 0; b < 2; ++b) if (i + 8 * b < nc) {
                float p[8]; f32x4 accj[8];
#pragma unroll
                for (int j = 0; j < 8; ++j) accj[j] = __builtin_amdgcn_mfma_f32_16x16x32_fp8_fp8(lo64(row[b][j]), lo64(xA), (f32x4){0.f, 0.f, 0.f, 0.f}, 0, 0, 0);
#pragma unroll
                for (int j = 0; j < 8; ++j) accj[j] = __builtin_amdgcn_mfma_f32_16x16x32_fp8_fp8(hi64(row[b][j]), hi64(xA), accj[j], 0, 0, 0);
#pragma unroll
                for (int j = 0; j < 8; ++j) p[j] = __builtin_fmaf(accj[j][3], dw3, __builtin_fmaf(accj[j][2], dw2, __builtin_fmaf(accj[j][1], dw1, accj[j][0] * dw0)));
                float q4[4], q2[2], q1;
#pragma unroll
                for (int j = 0; j < 4; ++j) { const float keep = b5 ? p[4 + j] : p[j], send = b5 ? p[j] : p[4 + j]; q4[j] = keep + __shfl_xor(send, 32); }
#pragma unroll
                for (int j = 0; j < 2; ++j) { const float keep = b4 ? q4[2 + j] : q4[j], send = b4 ? q4[j] : q4[2 + j]; q2[j] = keep + __shfl_xor(send, 16); }
                { const float keep = b3 ? q2[1] : q2[0], send = b3 ? q2[0] : q2[1]; q1 = keep + __shfl_xor(send, 8); }
                q1 = DPP_ADD(q1, 0xB1); q1 = DPP_ADD(q1, 0x4E); q1 = DPP_ADD(q1, 0x141);
                const float t = __builtin_bit_cast(float, __builtin_amdgcn_ds_bpermute((l & 7) * 32, __builtin_bit_cast(int, q1)));
                const int base = i + 8 * b;
                if ((l >> 3) == ((base - cb) >> 3)) tot = t;
            }
        }
        if (!pf_done) { pf_done = true; if (tok + step < T_TOK) U1_PREFETCH(tok + step); }
        if (fv) AK[(size_t)tok * 128 + (ent & 127)] = gelu_tanh(tot * su * (1.f / 16.f)) * gt * sv;
        if (n == 0) break;
        }
        LDS_WAIT(); asm volatile("" ::: "memory");
    }
#undef U1_PREFETCH
}
template <int MODE>
__device__ __forceinline__ void peer_u4_phase(const Frame& F, const Args& A) {
    const unsigned char* X8 = A.ws + WS_P + P_X8;
    const float* SU = (const float*)(A.ws + WS_SU); const float* SV = (const float*)(A.ws + WS_SV);
    const int* IDX = (const int*)(A.ws + WS_P + P_IDX); const float* GATE = (const float*)(A.ws + WS_P + P_GATE); float* AK = (float*)(MODE == 0 ? A.ws + WS_AK : A.ws + WS_P + P_SC);
    const int g = F.bid & (UNG - 1), nmem = F.G >> UNG_SH, l = F.lane, step = nmem * NWAVES;
    const int m = l & 15, q = l >> 4;
    const GAS unsigned char* ub = (const GAS unsigned char*)(A.ws + WS_U8 + (size_t)g * (NEXP / UNG) * 512);
    const unsigned lconst = 16u * (unsigned)(4 * (m & 7) + q);
    const int xoff = 128 * (m & 7) + 16 * q;
    const bool dg = (m < 8) && ((m >> 2) == (q & 1)); const int dr = m & 3;
    const float dw0 = (dg && dr == 0) ? 1.f : 0.f, dw1 = (dg && dr == 1) ? 1.f : 0.f, dw2 = (dg && dr == 2) ? 1.f : 0.f, dw3 = (dg && dr == 3) ? 1.f : 0.f;
    const int rsel = 4 * (m >> 3);
    const int osrc = 4 * (32 * (l & 1) + 4 * ((l & 15) >> 1));
    const int sc1 = 0x7F7F7F7F;
    LAS int* le = (LAS int*)(F.lds + F.wave * 2048); LAS int* lk = le + 256;
    const bool b4 = (l & 16) != 0, b3 = (l & 8) != 0, b2 = (l & 4) != 0;
    int tok = (F.bid >> UNG_SH) * NWAVES + F.wave;
    u32x4 nx0, nx1; int ne0, ne1; float ng0, ng1;
#define U4_PREFETCH(t) do { const size_t _t = (size_t)(t); nx0 = *(const u32x4*)(X8 + _t * 1024 + xoff); nx1 = *(const u32x4*)(X8 + _t * 1024 + xoff + 64); \
        ne0 = IDX[_t * 128 + l]; ne1 = IDX[_t * 128 + 64 + l]; ng0 = GATE[_t * 128 + l]; ng1 = GATE[_t * 128 + 64 + l]; } while (0)
    if (tok < T_TOK) U4_PREFETCH(tok);
    for (; tok < T_TOK; tok += step) {
        const i32x8 xb = __builtin_shufflevector(__builtin_bit_cast(i32x4, nx0), __builtin_bit_cast(i32x4, nx1), 0, 1, 2, 3, 4, 5, 6, 7);
        const int e0 = ne0, e1 = ne1; const float g0 = ng0, g1 = ng1;
        bool pf_done = false;
        const bool o0 = (e0 & (UNG - 1)) == g, o1 = (e1 & (UNG - 1)) == g;
        const unsigned long long m0 = __ballot(o0), m1 = __ballot(o1);
        const int c0 = __popcll(m0), n = c0 + __popcll(m1);
#define MBC(mm) __builtin_amdgcn_mbcnt_hi((unsigned)((mm) >> 32), __builtin_amdgcn_mbcnt_lo((unsigned)(mm), 0u))
        if (o0) { const int p = MBC(m0); le[p] = (e0 << 8) | l; lk[p] = __builtin_bit_cast(int, g0); }
        if (o1) { const int p = c0 + MBC(m1); le[p] = (e1 << 8) | (64 + l); lk[p] = __builtin_bit_cast(int, g1); }
#undef MBC
        LDS_WAIT(); asm volatile("" ::: "memory");
        for (int cb = 0; cb < n || cb == 0; cb += 64) {
            const int nc = min(n, cb + 64);
            const bool fv = (cb + l) < nc;
            const int ent = fv ? le[cb + l] : 0; const float gt = fv ? __builtin_bit_cast(float, lk[cb + l]) : 0.f; float tot = 0.f;
            const float su = SU[ent >> 8], sv = SV[ent >> 8];
            const int roff = fv ? ((ent >> 8) >> UNG_SH) * 512 : 0;
            for (int i = cb; i < nc; i += 32) {
                u32x4 row[2][8];
#pragma unroll
                for (int b = 0; b < 2; ++b) if (i + 16 * b < nc) {
#pragma unroll
                    for (int j = 0; j < 8; ++j) { const int ro = __builtin_amdgcn_ds_bpermute(rsel + 4 * (i - cb + 16 * b + 2 * j), roff);
                        row[b][j] = *(const GAS u32x4*)(ub + ((unsigned)ro + lconst)); } }
                if (!pf_done) { pf_done = true; if (tok + step < T_TOK) U4_PREFETCH(tok + step); }
#pragma unroll
                for (int b = 0; b < 2; ++b) if (i + 16 * b < nc) {
                    float p[8];
#pragma unroll
                    for (int j = 0; j < 8; ++j) { const i32x4 r4 = __builtin_bit_cast(i32x4, row[b][j]);
                        const f32x4 d = __builtin_amdgcn_mfma_scale_f32_16x16x128_f8f6f4(__builtin_shufflevector(r4, r4, 0, 1, 2, 3, -1, -1, -1, -1), xb, (f32x4){0.f, 0.f, 0.f, 0.f}, 4, 0, 0, sc1, 0, sc1);
                        p[j] = __builtin_fmaf(d[3], dw3, __builtin_fmaf(d[2], dw2, __builtin_fmaf(d[1], dw1, d[0] * dw0))); }
                    float q4[4], q2[2], q1;
#pragma unroll
                    for (int j = 0; j < 4; ++j) { const float keep = b4 ? p[4 + j] : p[j], send = b4 ? p[j] : p[4 + j]; q4[j] = keep + __shfl_xor(send, 16); }
#pragma unroll
                    for (int j = 0; j < 2; ++j) { const float keep = b3 ? q4[2 + j] : q4[j], send = b3 ? q4[j] : q4[2 + j]; q2[j] = keep + __shfl_xor(send, 8); }
                    { const float keep = b2 ? q2[1] : q2[0], send = b2 ? q2[0] : q2[1]; q1 = keep + __shfl_xor(send, 4); }
                    q1 = DPP_ADD(q1, 0xB1); q1 = DPP_ADD(q1, 0x4E);
                    const float t = __builtin_bit_cast(float, __builtin_amdgcn_ds_bpermute(osrc, __builtin_bit_cast(int, q1)));
                    if ((l >> 4) == ((i - cb + 16 * b) >> 4)) tot = t;
                }
            }
            if (!pf_done) { pf_done = true; if (tok + step < T_TOK) U4_PREFETCH(tok + step); }
            if (fv) AK[(size_t)tok * 128 + (ent & 127)] = gelu_tanh(tot * su * (1.f / 16.f)) * gt * sv;
            if (n == 0) break;
        }
        LDS_WAIT(); asm volatile("" ::: "memory");
    }
#undef U4_PREFETCH
}
template <int MODE>
__device__ __forceinline__ void peer_u4_all(const Frame& F, const Args& A) {
    const unsigned char* X8 = A.ws + WS_P + P_X8;
    const float* SU = (const float*)(A.ws + WS_SU); const float* SV = (const float*)(A.ws + WS_SV);
    const int* IDX = (const int*)(A.ws + WS_P + P_IDX); const float* GATE = (const float*)(A.ws + WS_P + P_GATE); float* AK = (float*)(MODE == 0 ? A.ws + WS_AK : A.ws + WS_P + P_SC);
    const int l = F.lane, step = F.G * NWAVES;
    const int m = l & 15, q = l >> 4;
    const GAS unsigned char* ub = (const GAS unsigned char*)(A.ws + WS_U8);
    const unsigned lconst = 16u * (unsigned)(8 * q + (m & 7));
    const int xoff = 256 * (q >> 1) + 32 * (m & 7) + 16 * (q & 1);
    const bool dg = (m < 8) && ((m >> 2) == (q & 1)); const int dr = m & 3;
    const float dw0 = (dg && dr == 0) ? 1.f : 0.f, dw1 = (dg && dr == 1) ? 1.f : 0.f, dw2 = (dg && dr == 2) ? 1.f : 0.f, dw3 = (dg && dr == 3) ? 1.f : 0.f;
    const int rsel = 4 * (m >> 3);
    const int osrc = 4 * (32 * (l & 1) + 4 * ((l & 15) >> 1));
    const int sc1 = 0x7F7F7F7F;
    const bool b4 = (l & 16) != 0, b3 = (l & 8) != 0, b2 = (l & 4) != 0;
    const int lhi = l >> 4;
    int tok = F.bid * NWAVES + F.wave;
    u32x4 nx0, nx1; int ne0, ne1; float ng0, ng1;
#define UA_PREFETCH(t) do { const size_t _t = (size_t)(t); nx0 = *(const u32x4*)(X8 + _t * 1024 + xoff); nx1 = *(const u32x4*)(X8 + _t * 1024 + xoff + 512); \
        ne0 = IDX[_t * 128 + l]; ne1 = IDX[_t * 128 + 64 + l]; ng0 = GATE[_t * 128 + l]; ng1 = GATE[_t * 128 + 64 + l]; } while (0)
#define UA_LOADS(R, ro_, h) do { _Pragma("unroll") for (int j_ = 0; j_ < 16; ++j_) { const int o_ = __builtin_amdgcn_ds_bpermute(rsel + 4 * (32 * (h) + 2 * j_), (ro_)); \
        R[j_] = *(const GAS u32x4*)(ub + ((unsigned)o_ + lconst)); } } while (0)
#define UA_COMPUTE(R, xb_, h, tot_) do { _Pragma("unroll") for (int b_ = 0; b_ < 2; ++b_) { float p_[8]; \
        _Pragma("unroll") for (int j_ = 0; j_ < 8; ++j_) { const i32x4 r4_ = __builtin_bit_cast(i32x4, R[8 * b_ + j_]); \
            const f32x4 d_ = __builtin_amdgcn_mfma_scale_f32_16x16x128_f8f6f4(__builtin_shufflevector(r4_, r4_, 0, 1, 2, 3, -1, -1, -1, -1), (xb_), (f32x4){0.f, 0.f, 0.f, 0.f}, 4, 0, 0, sc1, 0, sc1); \
            p_[j_] = __builtin_fmaf(d_[3], dw3, __builtin_fmaf(d_[2], dw2, __builtin_fmaf(d_[1], dw1, d_[0] * dw0))); } \
        float q4_[4], q2_[2], q1_; \
        _Pragma("unroll") for (int j_ = 0; j_ < 4; ++j_) { const float keep_ = b4 ? p_[4 + j_] : p_[j_], send_ = b4 ? p_[j_] : p_[4 + j_]; q4_[j_] = keep_ + __shfl_xor(send_, 16); } \
        _Pragma("unroll") for (int j_ = 0; j_ < 2; ++j_) { const float keep_ = b3 ? q4_[2 + j_] : q4_[j_], send_ = b3 ? q4_[j_] : q4_[2 + j_]; q2_[j_] = keep_ + __shfl_xor(send_, 8); } \
        { const float keep_ = b2 ? q2_[1] : q2_[0], send_ = b2 ? q2_[0] : q2_[1]; q1_ = keep_ + __shfl_xor(send_, 4); } \
        q1_ = DPP_ADD(q1_, 0xB1); q1_ = DPP_ADD(q1_, 0x4E); \
        const float t_ = __builtin_bit_cast(float, __builtin_amdgcn_ds_bpermute(osrc, __builtin_bit_cast(int, q1_))); \
        if (lhi == 2 * (h) + b_) (tot_) = t_; } } while (0)
    u32x4 RA[16], RB[16];
    if (tok < T_TOK) { UA_PREFETCH(tok); UA_LOADS(RA, ne0 * 512, 0); }
    for (; tok < T_TOK; tok += step) {
        const i32x8 xb = __builtin_shufflevector(__builtin_bit_cast(i32x4, nx0), __builtin_bit_cast(i32x4, nx1), 0, 1, 2, 3, 4, 5, 6, 7);
        const int e0 = ne0, e1 = ne1; const float g0 = ng0, g1 = ng1;
        const int ro0 = e0 * 512, ro1 = e1 * 512;
        const float su0 = SU[e0], sv0 = SV[e0], su1 = SU[e1], sv1 = SV[e1];
        const bool more = tok + step < T_TOK;
        float tot0 = 0.f, tot1 = 0.f;
        UA_LOADS(RB, ro0, 1);
        if (more) UA_PREFETCH(tok + step);
        UA_COMPUTE(RA, xb, 0, tot0);
        UA_LOADS(RA, ro1, 0);
        UA_COMPUTE(RB, xb, 1, tot0);
        UA_LOADS(RB, ro1, 1);
        UA_COMPUTE(RA, xb, 0, tot1);
        if (more) UA_LOADS(RA, ne0 * 512, 0);
        UA_COMPUTE(RB, xb, 1, tot1);
        AK[(size_t)tok * 128 + l] = gelu_tanh(tot0 * su0 * (1.f / 16.f)) * g0 * sv0;
        AK[(size_t)tok * 128 + 64 + l] = gelu_tanh(tot1 * su1 * (1.f / 16.f)) * g1 * sv1;
    }
#undef UA_PREFETCH
#undef UA_LOADS
#undef UA_COMPUTE
}
__device__ __forceinline__ float wave_max_nonneg(float v) {
    unsigned u = __builtin_bit_cast(unsigned, v);
    u = max(u, (unsigned)__builtin_amdgcn_mov_dpp((int)u, 0xB1, 0xf, 0xf, true));
    u = max(u, (unsigned)__builtin_amdgcn_mov_dpp((int)u, 0x4E, 0xf, 0xf, true));
    u = max(u, (unsigned)__builtin_amdgcn_mov_dpp((int)u, 0x141, 0xf, 0xf, true));
    u = max(u, (unsigned)__builtin_amdgcn_mov_dpp((int)u, 0x140, 0xf, 0xf, true));
    const unsigned a = (unsigned)__builtin_amdgcn_readlane((int)u, 0), b = (unsigned)__builtin_amdgcn_readlane((int)u, 16), c = (unsigned)__builtin_amdgcn_readlane((int)u, 32), d = (unsigned)__builtin_amdgcn_readlane((int)u, 48);
    return __builtin_bit_cast(float, max(max(a, b), max(c, d)));
}
template <int MODE>
__device__ __forceinline__ void peer_v_phase(const Frame& F, const Args& A) {
    const unsigned char* V8 = A.ws + WS_V8; const int* IDX = (const int*)(A.ws + WS_P + P_IDX); const float* AK = (const float*)(A.ws + WS_AK);
    float* out = MODE == 0 ? A.out : (float*)(A.ws + WS_P + P_SC);
    const int g = F.bid & 7, nmem = F.G >> 3, l = F.lane, sub = l & 7, rr = l >> 3, n16 = l & 15, q = l >> 4, step = nmem * NWAVES;
    const GAS unsigned char* vb = (const GAS unsigned char*)(V8 + (size_t)g * NEXP * 128);
    LAS unsigned long long* rep = (LAS unsigned long long*)(F.lds + F.wave * 2048);
    const unsigned long long bm = 0xFFull << (8 * (n16 & 7));
    const int repi = 2 * q + (n16 >> 3);
    const bool vl = (n16 < 8) && (q < 2);
    LAS float* stg = (LAS float*)(F.lds + 16384 + F.wave * 512);
    int tok = 2 * ((F.bid >> 3) * NWAVES + F.wave);
    int ne[4]; float na[4];
#define V_PREFETCH(t) do { const size_t _a = (size_t)(t) * 128, _b = ((size_t)(t) + 1) * 128; ne[0] = IDX[_a + l]; ne[1] = IDX[_a + 64 + l]; ne[2] = IDX[_b + l]; ne[3] = IDX[_b + 64 + l]; \
        na[0] = AK[_a + l]; na[1] = AK[_a + 64 + l]; na[2] = AK[_b + l]; na[3] = AK[_b + 64 + l]; } while (0)
    if (tok + 1 < T_TOK) V_PREFETCH(tok);
    for (; tok + 1 < T_TOK; tok += 2 * step) {
        const int e0 = ne[0], e1 = ne[1], e2 = ne[2], e3 = ne[3]; const float a0 = na[0], a1 = na[1], a2 = na[2], a3 = na[3];
        u32x4 rowA[16], rowB[16];
#pragma unroll
        for (int i = 0; i < 16; ++i) { const int src = (8 * (i & 7) + rr) * 4;
            const int ea = __builtin_amdgcn_ds_bpermute(src, i < 8 ? e0 : e1), eb = __builtin_amdgcn_ds_bpermute(src, i < 8 ? e2 : e3);
            rowA[i] = *(const GAS u32x4*)(vb + ((unsigned)ea * 128u + 16u * (unsigned)sub)); rowB[i] = *(const GAS u32x4*)(vb + ((unsigned)eb * 128u + 16u * (unsigned)sub)); }
        f32x4 HA = {0.f, 0.f, 0.f, 0.f}, HB = {0.f, 0.f, 0.f, 0.f};
        if (l < 32) { const float* hpa = out + (size_t)tok * D + g * 128 + 4 * l; HA = *(const f32x4*)hpa; HB = *(const f32x4*)(hpa + D); }
        if (tok + 2 * step + 1 < T_TOK) V_PREFETCH(tok + 2 * step);
        const float amA = wave_max_nonneg(fmaxf(fabsf(a0), fabsf(a1))), amB = wave_max_nonneg(fmaxf(fabsf(a2), fabsf(a3)));
        const float scA = amA > 0.f ? 224.f * __builtin_amdgcn_rcpf(amA) : 0.f, invA = amA * (1.f / 224.f), scB = amB > 0.f ? 224.f * __builtin_amdgcn_rcpf(amB) : 0.f, invB = amB * (1.f / 224.f);
        { const unsigned wA = (unsigned)__builtin_amdgcn_cvt_pk_fp8_f32(a0 * scA, a1 * scA, 0, false), wB = (unsigned)__builtin_amdgcn_cvt_pk_fp8_f32(a2 * scB, a3 * scB, 0, false);
          const unsigned r0 = (wA & 0xffu) * 0x01010101u, r1 = ((wA >> 8) & 0xffu) * 0x01010101u, r2 = (wB & 0xffu) * 0x01010101u, r3 = ((wB >> 8) & 0xffu) * 0x01010101u;
          rep[l] = ((unsigned long long)r0 << 32) | r0; rep[64 + l] = ((unsigned long long)r1 << 32) | r1; rep[128 + l] = ((unsigned long long)r2 << 32) | r2; rep[192 + l] = ((unsigned long long)r3 << 32) | r3; }
        LDS_WAIT(); asm volatile("" ::: "memory");
#pragma unroll
        for (int t2 = 0; t2 < 2; ++t2) {
            f32x4 alo = {0.f, 0.f, 0.f, 0.f}, ahi = {0.f, 0.f, 0.f, 0.f};
#pragma unroll
            for (int i = 0; i < 16; ++i) { const long bop = (long)(rep[128 * t2 + 8 * i + repi] & bm); const u32x4 rw = t2 ? rowB[i] : rowA[i];
                alo = __builtin_amdgcn_mfma_f32_16x16x32_fp8_fp8(lo64(rw), bop, alo, 0, 0, 0);
                ahi = __builtin_amdgcn_mfma_f32_16x16x32_fp8_fp8(hi64(rw), bop, ahi, 0, 0, 0); }
            const float inv = t2 ? invB : invA;
            float vlo[4], vhi[4];
#pragma unroll
            for (int r = 0; r < 4; ++r) { const float tl = alo[r], th = ahi[r];
                vlo[r] = (tl + __builtin_bit_cast(float, __builtin_amdgcn_ds_bpermute(((l + 40) & 63) * 4, __builtin_bit_cast(int, tl)))) * inv;
                vhi[r] = (th + __builtin_bit_cast(float, __builtin_amdgcn_ds_bpermute(((l + 40) & 63) * 4, __builtin_bit_cast(int, th)))) * inv; }
            if (vl) {
#pragma unroll
                for (int r = 0; r < 4; ++r) { stg[64 * q + 16 * r + n16] = vlo[r]; stg[64 * q + 16 * r + n16 + 8] = vhi[r]; } }
            LDS_WAIT(); asm volatile("" ::: "memory");
            if (l < 32) { const f32x4 dv = *(const LAS f32x4*)(stg + 4 * l); *(f32x4*)(out + (size_t)(tok + t2) * D + g * 128 + 4 * l) = (t2 ? HB : HA) + dv; }
            LDS_WAIT(); asm volatile("" ::: "memory");
        }
        LDS_WAIT(); asm volatile("" ::: "memory");
    }
#undef V_PREFETCH
}
typedef float f32x16 __attribute__((ext_vector_type(16)));
template <int MODE>
__device__ __forceinline__ void peer_v4_phase(const Frame& F, const Args& A) {
    const int* IDX = (const int*)(A.ws + WS_P + P_IDX); const float* AK = (const float*)(A.ws + WS_AK);
    float* out = A.out;
    const int l = F.lane, n = l & 31, hq = l >> 5, step = F.G * NWAVES;
    const GAS unsigned char* vb = (const GAS unsigned char*)(A.ws + WS_V8);
    const unsigned lconst = 16u * (unsigned)n;
    const bool diag = ((l >> 4) & 1) == hq;
    const unsigned bytem = diag ? (0xFFu << (8 * (l & 3))) : 0u; const int dsel = (l & 15) >> 2;
    const unsigned M0 = dsel == 0 ? bytem : 0u, M1 = dsel == 1 ? bytem : 0u, M2 = dsel == 2 ? bytem : 0u, M3 = dsel == 3 ? bytem : 0u;
    const int rsel = 4 * hq;
    const int sc1 = 0x7F7F7F7F;
    const int colb = 8 * n + 4 * hq;
    int tok = F.bid * NWAVES + F.wave;
    int ne0, ne1; float na0, na1;
#define V4_PREFETCH(t) do { const size_t _t = (size_t)(t) * 128; ne0 = IDX[_t + l]; ne1 = IDX[_t + 64 + l]; na0 = AK[_t + l]; na1 = AK[_t + 64 + l]; } while (0)
#define V4_LOADS(R, ro_, h) do { int ba_ = rsel + 4 * (16 * (h)); _Pragma("unroll") for (int j_ = 0; j_ < 8; ++j_) { asm volatile("" : "+v"(ba_)); const int o_ = __builtin_amdgcn_ds_bpermute(ba_, (ro_)); ba_ += 8; \
        R[j_] = *(const GAS u32x4*)(vb + ((unsigned)o_ + lconst)); } } while (0)
#define V4_ONE(ACC, R, rep_, h, j_) do { unsigned s0_ = (unsigned)__builtin_amdgcn_readlane((int)(rep_), 16 * (h) + 2 * (j_)), s1_ = (unsigned)__builtin_amdgcn_readlane((int)(rep_), 16 * (h) + 2 * (j_) + 1); \
        asm volatile("" : "+s"(s0_), "+s"(s1_), "+v"(ACC)); \
        const i32x8 a8_ = {(int)(s0_ & M0), (int)(s0_ & M1), (int)(s0_ & M2), (int)(s0_ & M3), (int)(s1_ & M0), (int)(s1_ & M1), (int)(s1_ & M2), (int)(s1_ & M3)}; \
        const i32x4 r4_ = __builtin_bit_cast(i32x4, R[j_]); \
        ACC = __builtin_amdgcn_mfma_scale_f32_32x32x64_f8f6f4(a8_, __builtin_shufflevector(r4_, r4_, 0, 1, 2, 3, -1, -1, -1, -1), ACC, 0, 4, 0, sc1, 0, sc1); } while (0)
#define V4_COMPUTE(R, rep_, h) do { V4_ONE(acc, R, rep_, h, 0); V4_ONE(acc1, R, rep_, h, 1); V4_ONE(acc, R, rep_, h, 2); V4_ONE(acc1, R, rep_, h, 3); \
        V4_ONE(acc, R, rep_, h, 4); V4_ONE(acc1, R, rep_, h, 5); V4_ONE(acc, R, rep_, h, 6); V4_ONE(acc1, R, rep_, h, 7); } while (0)
    u32x4 RA[8], RB[8];
    if (tok < T_TOK) { V4_PREFETCH(tok); V4_LOADS(RA, ne0 * 512, 0); }
    for (; tok < T_TOK; tok += step) {
        const int e0 = ne0, e1 = ne1; const float a0 = na0, a1 = na1;
        const int ro0 = e0 * 512, ro1 = e1 * 512;
        const bool more = tok + step < T_TOK;
        V4_LOADS(RB, ro0, 1);
        if (more) V4_PREFETCH(tok + step);
        const float am = wave_max_nonneg(fmaxf(fabsf(a0), fabsf(a1)));
        const float sc = am > 0.f ? 224.f * __builtin_amdgcn_rcpf(am) : 0.f, inv = am * (1.f / 224.f);
        const unsigned w8 = (unsigned)__builtin_amdgcn_cvt_pk_fp8_f32(a0 * sc, a1 * sc, 0, false);
        const unsigned rep0 = (w8 & 0xffu) * 0x01010101u, rep1 = ((w8 >> 8) & 0xffu) * 0x01010101u;
        f32x16 acc, acc1;
#pragma unroll
        for (int i = 0; i < 16; ++i) { acc[i] = 0.f; acc1[i] = 0.f; }
        V4_COMPUTE(RA, rep0, 0); V4_LOADS(RA, ro0, 2);
        V4_COMPUTE(RB, rep0, 1); V4_LOADS(RB, ro0, 3);
        V4_COMPUTE(RA, rep0, 2); V4_LOADS(RA, ro1, 0);
        V4_COMPUTE(RB, rep0, 3); V4_LOADS(RB, ro1, 1);
        V4_COMPUTE(RA, rep1, 0); V4_LOADS(RA, ro1, 2);
        V4_COMPUTE(RB, rep1, 1); V4_LOADS(RB, ro1, 3);
        f32x4 H[4];
        u32x2 MX[4];
        { const float* hp = A.in[I_X] + (size_t)tok * D + colb; const bf16_t* mp = (const bf16_t*)(A.ws + WS_N1) + (size_t)tok * D + colb;
#pragma unroll
          for (int j = 0; j < 4; ++j) { H[j] = *(const f32x4*)(hp + 256 * j); MX[j] = *(const u32x2*)(mp + 256 * j); } }
        V4_COMPUTE(RA, rep1, 2);
        if (more) V4_LOADS(RA, ne0 * 512, 0);
        V4_COMPUTE(RB, rep1, 3);
        acc = acc + acc1;
        float ss = 0.f;
#pragma unroll
        for (int j = 0; j < 4; ++j) { H[j] = H[j] + (f32x4){bflo(MX[j].x), bfhi(MX[j].x), bflo(MX[j].y), bfhi(MX[j].y)} + (f32x4){acc[4 * j], acc[4 * j + 1], acc[4 * j + 2], acc[4 * j + 3]} * inv;
            ss += (H[j].x * H[j].x + H[j].y * H[j].y) + (H[j].z * H[j].z + H[j].w * H[j].w); }
        const float rstd = 1.f / sqrtf(wave_sum(ss) * (1.f / D) + EPS);
        { float* hp = out + (size_t)tok * D + colb;
#pragma unroll
          for (int j = 0; j < 4; ++j) *(f32x4*)(hp + 256 * j) = H[j] * rstd * *(const f32x4*)(A.in[I_FG] + colb + 256 * j); }
    }
#undef V4_PREFETCH
#undef V4_LOADS
#undef V4_COMPUTE
#undef V4_ONE
}
__device__ __forceinline__ void final_norm_phase(const Frame& F, const Args& A) {
    const int gw = F.bid * NWAVES + F.wave, NGW = F.G * NWAVES, l = F.lane; const float* fg = A.in[I_FG];
    const f32x4* gp = (const f32x4*)fg + l;
    int tok = gw;
    for (; tok + 3 * NGW < T_TOK; tok += 4 * NGW) {
        f32x4 v[4][4]; float ss[4];
#pragma unroll
        for (int b = 0; b < 4; ++b) { const f32x4* hp = (const f32x4*)(A.out + (size_t)(tok + b * NGW) * D) + l;
#pragma unroll
            for (int j = 0; j < 4; ++j) v[b][j] = hp[64 * j]; }
#pragma unroll
        for (int b = 0; b < 4; ++b) { ss[b] = 0.f;
#pragma unroll
            for (int j = 0; j < 4; ++j) ss[b] += (v[b][j].x * v[b][j].x + v[b][j].y * v[b][j].y) + (v[b][j].z * v[b][j].z + v[b][j].w * v[b][j].w); }
#pragma unroll
        for (int o = 1; o < 64; o <<= 1) {
#pragma unroll
            for (int b = 0; b < 4; ++b) ss[b] += __shfl_xor(ss[b], o); }
#pragma unroll
        for (int b = 0; b < 4; ++b) { const float rstd = 1.f / sqrtf(ss[b] * (1.f / D) + EPS); f32x4* hp = (f32x4*)(A.out + (size_t)(tok + b * NGW) * D) + l;
#pragma unroll
            for (int j = 0; j < 4; ++j) hp[64 * j] = v[b][j] * rstd * gp[64 * j]; }
    }
    for (; tok < T_TOK; tok += NGW) { f32x4* hp = (f32x4*)(A.out + (size_t)tok * D) + l; f32x4 v[4]; float ss = 0.f;
#pragma unroll
        for (int j = 0; j < 4; ++j) { v[j] = hp[64 * j]; ss += (v[j].x * v[j].x + v[j].y * v[j].y) + (v[j].z * v[j].z + v[j].w * v[j].w); }
        const float rstd = 1.f / sqrtf(wave_sum(ss) * (1.f / D) + EPS);
#pragma unroll
        for (int j = 0; j < 4; ++j) hp[64 * j] = v[j] * rstd * gp[64 * j]; }
}

#ifdef DEBUG_CHECK
constexpr size_t WS_DBG = 472 * MiB;
__device__ __forceinline__ int dbg_tok(int i) { return (i * 509 + 3) & 32767; }
__device__ __forceinline__ float gelu_ref(float x) { return 0.5f * x * (1.f + tanhf(0.7978845608028654f * (x + 0.044715f * x * x * x))); }
__global__ void __launch_bounds__(512) dbg_scores(Args a) {
    __shared__ float n2s[1024]; __shared__ float q[2048];
    const int t = dbg_tok(blockIdx.x), tid = threadIdx.x;
    const bf16_t* N2 = (const bf16_t*)(a.ws + WS_N1); const float* SC = (const float*)(a.ws + WS_P + P_SC); unsigned* dbg = (unsigned*)(a.ws + WS_DBG);
    for (int k = tid; k < 1024; k += 512) n2s[k] = bf1(N2[(size_t)t * 1024 + k]);
    __syncthreads();
    for (int r = 0; r < 4; ++r) { const int c = tid + 512 * r; float s = 0.f; for (int k = 0; k < 1024; ++k) s += n2s[k] * a.in[I_WQ][(size_t)k * 2048 + c]; q[c] = s; }
    __syncthreads();
    float md = 0.f;
    for (int r = 0; r < 4; ++r) { const int n = tid + 512 * r, hh = n >> 7, key = n & 127; const float* kX = (hh & 1) ? a.in[I_K2] : a.in[I_K1];
        float s = 0.f; for (int d = 0; d < 128; ++d) s += q[hh * 128 + d] * kX[key * 128 + d];
        md = fmaxf(md, fabsf(s - SC[(size_t)n * T_TOK + t])); }
    atomicMax(&dbg[0], __builtin_bit_cast(unsigned, md));
}
__global__ void __launch_bounds__(64) dbg_topk(Args a) {
    __shared__ float s1[8][128], s2[8][128], cv[8][256]; __shared__ float t1v[8][16], t2v[8][16]; __shared__ int t1i[8][16], t2i[8][16], exi[8][16]; __shared__ float exv[8][16];
    const int t = dbg_tok(blockIdx.x), h = threadIdx.x;
    const float* SC = (const float*)(a.ws + WS_P + P_SC); const int* IDX = (const int*)(a.ws + WS_P + P_IDX); const float* GATE = (const float*)(a.ws + WS_P + P_GATE); unsigned* dbg = (unsigned*)(a.ws + WS_DBG);
    if (h >= 8) return;
    for (int j = 0; j < 128; ++j) { s1[h][j] = SC[(size_t)(h * 256 + j) * T_TOK + t]; s2[h][j] = SC[(size_t)(h * 256 + 128 + j) * T_TOK + t]; }
    for (int r = 0; r < 16; ++r) { int b1 = 0, b2 = 0; for (int j = 1; j < 128; ++j) { if (s1[h][j] > s1[h][b1]) b1 = j; if (s2[h][j] > s2[h][b2]) b2 = j; }
        t1v[h][r] = s1[h][b1]; t1i[h][r] = b1; s1[h][b1] = -1e30f; t2v[h][r] = s2[h][b2]; t2i[h][r] = b2; s2[h][b2] = -1e30f; }
    for (int c = 0; c < 256; ++c) cv[h][c] = t1v[h][c >> 4] + t2v[h][c & 15];
    for (int r = 0; r < 16; ++r) { int bc = 0; for (int c = 1; c < 256; ++c) if (cv[h][c] > cv[h][bc]) bc = c;
        exv[h][r] = cv[h][bc]; exi[h][r] = t1i[h][bc >> 4] * 128 + t2i[h][bc & 15]; cv[h][bc] = -1e30f; }
    float sum = 0.f; const float mx0 = exv[h][0]; for (int r = 0; r < 16; ++r) { exv[h][r] = expf(exv[h][r] - mx0); } for (int r = 0; r < 16; ++r) sum += exv[h][r];
    unsigned miss = 0; float gd = 0.f;
    for (int w = 0; w < 16; ++w) { const int e = IDX[(size_t)t * 128 + h * 16 + w]; const float g = GATE[(size_t)t * 128 + h * 16 + w]; bool found = false;
        for (int r = 0; r < 16; ++r) if (exi[h][r] == e) { found = true; gd = fmaxf(gd, fabsf(g - exv[h][r] / sum)); }
        if (!found) ++miss; }
    atomicAdd(&dbg[1], miss); atomicMax(&dbg[3], __builtin_bit_cast(unsigned, gd));
}
__global__ void __launch_bounds__(512) dbg_experts_pre(Args a) {
    __shared__ float n2s[1024]; __shared__ float ak[128]; __shared__ int ek[128]; __shared__ float red[8];
    const int t = dbg_tok(blockIdx.x), tid = threadIdx.x, lane = tid & 63, wave = tid >> 6;
    const bf16_t* N2 = (const bf16_t*)(a.ws + WS_N1); const int* IDX = (const int*)(a.ws + WS_P + P_IDX); const float* GATE = (const float*)(a.ws + WS_P + P_GATE);
    float* rows = (float*)(a.ws + WS_DBG + MiB);
    for (int k = tid; k < 1024; k += 512) n2s[k] = bf1(N2[(size_t)t * 1024 + k]);
    if (tid < 128) ek[tid] = IDX[(size_t)t * 128 + tid];
    __syncthreads();
    for (int k = wave * 16; k < wave * 16 + 16; ++k) { const float* u = a.in[I_PU] + (size_t)ek[k] * 1024; float s = 0.f; for (int j = lane; j < 1024; j += 64) s += u[j] * n2s[j];
        s = wave_sum(s); if (lane == 0) ak[k] = gelu_ref(s) * GATE[(size_t)t * 128 + k]; }
    __syncthreads();
    float h2[2]; float ss = 0.f;
    for (int r = 0; r < 2; ++r) { const int d = tid + 512 * r; float o = 0.f; for (int k = 0; k < 128; ++k) o += ak[k] * a.in[I_PV][(size_t)ek[k] * 1024 + d]; h2[r] = a.out[(size_t)t * 1024 + d] + o; ss += h2[r] * h2[r]; }
    ss = wave_sum(ss); if (lane == 0) red[wave] = ss; __syncthreads();
    float tot = 0.f; for (int w = 0; w < 8; ++w) tot += red[w];
    const float rstd = 1.f / sqrtf(tot / 1024.f + EPS);
    for (int r = 0; r < 2; ++r) { const int d = tid + 512 * r; rows[(size_t)blockIdx.x * 1024 + d] = h2[r] * rstd * a.in[I_FG][d]; }
}
__global__ void __launch_bounds__(512) dbg_experts_post(Args a) {
    const int t = dbg_tok(blockIdx.x), tid = threadIdx.x; const float* rows = (const float*)(a.ws + WS_DBG + MiB); float* dbgf = (float*)(a.ws + WS_DBG);
    float e = 0.f, n = 0.f;
    for (int r = 0; r < 2; ++r) { const int d = tid + 512 * r; const float x = rows[(size_t)blockIdx.x * 1024 + d], y = a.out[(size_t)t * 1024 + d]; e += (x - y) * (x - y); n += x * x; }
    e = wave_sum(e); n = wave_sum(n); if ((tid & 63) == 0) { atomicAdd(&dbgf[4], e); atomicAdd(&dbgf[5], n); }
}
__global__ void __launch_bounds__(512) dbg_report(Args a, int which) {
    const unsigned* dbg = (const unsigned*)(a.ws + WS_DBG); const float* dbgf = (const float*)(a.ws + WS_DBG);
    const float mA = dbgf[0], gd = dbgf[3]; const unsigned miss = dbg[1]; const float relC = sqrtf(dbgf[4] / fmaxf(dbgf[5], 1e-30f));
    float X;
    if (which == 0) { int mask = 0; if (mA > 0.05f) mask |= 1; if (miss > 400u) mask |= 2; if (relC > 0.05f) mask |= 4; if (gd > 0.02f) mask |= 8; X = 1000.f + 100.f * mask; }
    else if (which == 1) X = 1e6f * mA; else if (which == 2) X = 100.f + (float)miss; else if (which == 3) X = 1e6f * relC; else X = 1e6f * gd;
    for (size_t i = (size_t)blockIdx.x * 512 + threadIdx.x; i < (size_t)T_TOK * D; i += (size_t)gridDim.x * 512) a.out[i] = (i == 0) ? X : 0.f;
}
#endif

constexpr int NPH = 13;
__global__ void __launch_bounds__(NWAVES * 64, 2) fwd_kernel(Args args) {
    extern __shared__ __attribute__((aligned(16))) unsigned char lds_raw[];
    Frame F;
    F.lds = (LAS unsigned char*)lds_raw;
    F.tid = threadIdx.x; F.lane = F.tid & 63; F.wave = __builtin_amdgcn_readfirstlane(F.tid >> 6);
    F.G = gridDim.x; F.bid = blockIdx.x;
    volatile LAS unsigned* MISC = (volatile LAS unsigned*)(F.lds + MISC_OFF);
    for (int u = F.tid; u < (LDS_BYTES - LDSCTL_OFF) / 4; u += NWAVES * 64) ((LAS unsigned*)(F.lds + LDSCTL_OFF))[u] = 0u;
    __syncthreads();
    unsigned* ctl = (unsigned*)(args.ws + WS_CTL);
    const int lo = args.ph_lo, hi = args.ph_hi;
    XcdBarrier bar; bar.bar = ctl + CW_BAR + args.li * XCD_BAR_WORDS; bar.x = 0; bar.st = nullptr; bar.wave = F.wave;
    if (hi - lo > 1) bar = xcd_barrier_post(ctl + CW_BAR + args.li * XCD_BAR_WORDS, MISC + 8, F.wave);
#define IN(k) (lo <= (k) && (k) < hi)
#ifdef PROBE_TS
#define STAMP(k) do { if (F.bid == 0 && F.tid == 0) ((unsigned long long*)(args.ws + (472u << 20)))[(k)] = __builtin_amdgcn_s_memrealtime(); } while (0)
#else
#define STAMP(k) do { } while (0)
#endif
#define SEAM(k) do { if (IN(k) && IN((k) + 1)) { xcd_barrier(bar); if (XTRA_BAR) xcd_barrier(bar); } STAMP((k) + 1); } while (0)
    unsigned char* ws = args.ws;
    bf16_t* P = (bf16_t*)(ws + WS_P);

#define REFRESH() do { int z_ = 0; asm volatile("" : "+s"(z_)); F.lane = (int)__builtin_amdgcn_mbcnt_hi(~0u, __builtin_amdgcn_mbcnt_lo(~0u, (unsigned)z_)); F.tid = F.wave * 64 + F.lane; } while (0)
    STAMP(0);
    if (IN(0)) { phase0(F, args); SEAM(0); }
    if (IN(1)) { REFRESH();
        if (F8_LO > 0) { pg8::Gemm g{(const bf16_t*)(ws + WS_N1), (const bf16_t*)(ws + WS_WIN), T_TOK, F8_LO * 256, D, D}; pg8::StaticOrder S; S.init(T_TOK, F8_LO * 256, F.G, F.bid);
            pg8::EpiProj E{P, (float*)(ws + WS_ALR), 0}; pg8::gemm_phase<pg8::EpiProj, pg8::StaticOrder, false, true, false>(F.lds, g, S, E, F.wave); }
        if (F8_LO < 21) {
            pg8::Gemm g{(const bf16_t*)(ws + WS_N18), (const bf16_t*)(ws + WS_W8 + (size_t)F8_LO * 256 * 1024), T_TOK, (21 - F8_LO) * 256, D / 2, D / 2, 0x7B7B7B7B, 0x75757575};
            pg8::StaticOrder S; S.init(T_TOK, (21 - F8_LO) * 256, F.G, ((F8_LO * 128) % F.G) != 0 ? F.G - 1 - F.bid : F.bid);
            pg8::EpiProj E{P, (float*)(ws + WS_ALR), F8_LO}; pg8::gemm_phase<pg8::EpiProj, pg8::StaticOrder, false, true, true>(F.lds, g, S, E, F.wave); }
        {
            REFRESH();
            const int nwg = (T_TOK / 256) * (NPROJ / 256), rem = nwg % F.G;
            if (rem == 0) convert_tables(F, args, F.bid * NWAVES + F.wave, F.G * NWAVES);
            else if (F.bid >= rem) convert_tables(F, args, (F.bid - rem) * NWAVES + F.wave, (F.G - rem) * NWAVES);
        }
        SEAM(1);
    }
    if (IN(2)) { REFRESH();
        if (DRY_EXP == 12) { gla_chunk_phase<true>(F, args); for (int it = F.bid; it < 256; it += F.G) for (int g4 = 0; g4 < 4; ++g4) sgu_unit<true>(F, args, 4 * it + g4, g4 == 0); __syncthreads(); }
        gla_chunk_phase<false>(F, args);
        for (int it = F.bid; it < 256; it += F.G) for (int g4 = 0; g4 < 4; ++g4) sgu_unit<false>(F, args, 4 * it + g4, g4 == 0);
        SEAM(2);
    }
    if (IN(3)) { REFRESH(); if (DRY_EXP == 13 || DRY_EXP == 15) { gla_scan<true>(F, args); __syncthreads(); } gla_scan<false>(F, args); SEAM(3); }
    if (IN(4)) { REFRESH(); if (DRY_EXP == 14 || DRY_EXP == 15) { gla_out_phase<true>(F, args); __syncthreads(); } gla_out_phase<false>(F, args); SEAM(4); }
    if (IN(5)) { REFRESH();
        { pg8::Gemm g{P + PC_R, (const bf16_t*)(ws + WS_WA), T_TOK, D, 1024, PLD}; pg8::StaticOrder S; S.init(T_TOK, D, F.G, F.bid);
          pg8::EpiBrAB E{P}; pg8::gemm_phase<pg8::EpiBrAB, pg8::StaticOrder, true, true, false, true>(F.lds, g, S, E, F.wave); }
        SEAM(5);
    }
    if (IN(6)) { REFRESH();
        pg8::Gemm g{P + PC_MRG, (const bf16_t*)(ws + WS_WOUT), T_TOK, D, D, PLD}; pg8::StaticOrder S; S.init(T_TOK, D, F.G, F.bid);
        pg8::EpiOut E{(bf16_t*)(ws + WS_N1)}; pg8::gemm_phase<pg8::EpiOut, pg8::StaticOrder, true, true>(F.lds, g, S, E, F.wave);
        SEAM(6);
    }
    if (IN(7)) { REFRESH();
        const int gw = F.bid * NWAVES + F.wave, NGW = F.G * NWAVES;
        { int m = gw; for (; m + 3 * NGW < T_TOK; m += 4 * NGW) rms_rows_to_bf16<(SC_F8 ? 2 : 3), 4>(F.lane, args.in[I_X] + (size_t)m * D, (size_t)NGW * D, args.in[I_N2G], (bf16_t*)(ws + WS_P + P_N2) + (size_t)m * D, (size_t)NGW * D, (unsigned*)(ws + WS_P + P_X8) + (size_t)m * 256, (size_t)NGW * 256, (const bf16_t*)(ws + WS_N1) + (size_t)m * D, (size_t)NGW * D);
          for (; m < T_TOK; m += NGW) rms_rows_to_bf16<(SC_F8 ? 2 : 3), 1>(F.lane, args.in[I_X] + (size_t)m * D, 0, args.in[I_N2G], (bf16_t*)(ws + WS_P + P_N2) + (size_t)m * D, 0, (unsigned*)(ws + WS_P + P_X8) + (size_t)m * 256, 0, (const bf16_t*)(ws + WS_N1) + (size_t)m * D, 0); }
        SEAM(7);
    }
    if (IN(8)) { REFRESH();
        pg8::StaticOrder S; S.init(T_TOK, 2048, F.G, F.bid); pg8::EpiScores E{(bf16_t*)(ws + WS_P + P_SC)};
        if (SC_F8) { pg8::Gemm g{(const bf16_t*)(ws + WS_P + P_X8), (const bf16_t*)(ws + WS_WQF), T_TOK, 2048, D / 2, D / 2, 0x7B7B7B7B, 0x75757575};
            pg8::gemm_phase<pg8::EpiScores, pg8::StaticOrder, true, true, true>(F.lds, g, S, E, F.wave); }
        else { pg8::Gemm g{(const bf16_t*)(ws + WS_P + P_N2), (const bf16_t*)(ws + WS_WQF), T_TOK, 2048, D, D};
            pg8::gemm_phase<pg8::EpiScores, pg8::StaticOrder, true, true>(F.lds, g, S, E, F.wave); }
        SEAM(8);
    }
    if (IN(9)) { REFRESH(); peer_topk(F, args); SEAM(9); }
    if (IN(10)) { REFRESH(); if constexpr (UNG == 1) peer_u4_all<0>(F, args); else peer_u4_phase<0>(F, args); SEAM(10); }
    if (IN(11)) { REFRESH(); if (V_F4) peer_v4_phase<0>(F, args); else { if (DRY_EXP == 1) { peer_v_phase<1>(F, args); __syncthreads(); } peer_v_phase<0>(F, args); SEAM(11); } }
    if (IN(12)) { REFRESH(); if (!V_F4) final_norm_phase(F, args); }
#undef IN
#undef SEAM
}


#ifdef PROBE_TS
__global__ void __launch_bounds__(512) probe_report(Args a, int pi, int pj) {
    const unsigned long long* ts = (const unsigned long long*)(a.ws + (472u << 20));
    const float X1 = 10.f * (float)(ts[pi + 1] - ts[pi]) * 0.01f, X2 = (float)(ts[pj + 1] - ts[pj]) * 0.01f;
    for (size_t i = (size_t)blockIdx.x * 512 + threadIdx.x; i < (size_t)T_TOK * D; i += (size_t)gridDim.x * 512) a.out[i] = (i == 0) ? X1 : X2;
}
#endif
#ifdef PROBE_MFMA
__global__ void __launch_bounds__(64) probe_mfma(Args a) {
    const int l = threadIdx.x;
    i32x4 av = {0, 0, 0, 0};
    if (l == PROBE_L) av[PROBE_P >> 3] = 0x2 << (4 * (PROBE_P & 7));
    i32x8 b1, b2;
    for (int r = 0; r < 8; ++r) { unsigned w1 = 0, w2 = 0;
        for (int c = 0; c < 4; ++c) { const int b = 4 * r + c; int t = 0;
            t = __builtin_amdgcn_cvt_pk_fp8_f32((float)((b & 15) + 1), (float)(1 + (b >> 4) + 2 * (l >> 4)), 0, false);
            w1 |= ((unsigned)t & 0xffu) << (8 * c); w2 |= (((unsigned)t >> 8) & 0xffu) << (8 * c); }
        b1[r] = (int)w1; b2[r] = (int)w2; }
    const f32x4 z = {0.f, 0.f, 0.f, 0.f};
    const f32x4 d1 = __builtin_amdgcn_mfma_scale_f32_16x16x128_f8f6f4(__builtin_shufflevector(av, av, 0, 1, 2, 3, -1, -1, -1, -1), b1, z, 4, 0, 0, 0x7F7F7F7F, 0, 0x7F7F7F7F);
    const f32x4 d2 = __builtin_amdgcn_mfma_scale_f32_16x16x128_f8f6f4(__builtin_shufflevector(av, av, 0, 1, 2, 3, -1, -1, -1, -1), b2, z, 4, 0, 0, 0x7F7F7F7F, 0, 0x7F7F7F7F);
    float* st = (float*)(a.ws + (472u << 20));
    *(f32x4*)(st + 8 * l) = d1; *(f32x4*)(st + 8 * l + 4) = d2;
}
__global__ void __launch_bounds__(512) probe_mfma_report(Args a) {
    const int row = PROBE_L & 15;
    const float* st = (const float*)(a.ws + (472u << 20)) + 8 * (16 * (row >> 2)) + (row & 3); const float X1 = 10.f * st[0], X2 = st[4];
    for (size_t i = (size_t)blockIdx.x * 512 + threadIdx.x; i < (size_t)T_TOK * D; i += (size_t)gridDim.x * 512) a.out[i] = (i == 0) ? X1 : X2;
}
#endif
extern "C" void kernel_launch(void* const* d_in, const int* in_sizes, int n_in, void* d_out, int out_size, void* d_ws, size_t ws_size, hipStream_t stream) {
    static int grid = 0;
    if (grid == 0) {
        if (n_in != 20 || in_sizes[0] != T_TOK * D || out_size != T_TOK * D || ws_size < WS_END) {
            fprintf(stderr, "kernel_launch: unexpected shapes: n_in %d in0 %d out %d ws %zu (need %zu)\n", n_in, n_in > 0 ? in_sizes[0] : -1, out_size, ws_size, (size_t)WS_END); grid = -1; return; }
        int dev = 0, cus = 0;
        if (hipGetDevice(&dev) != hipSuccess || hipDeviceGetAttribute(&cus, hipDeviceAttributeMultiprocessorCount, dev) != hipSuccess) { grid = -1; return; }
        if (hipFuncSetAttribute((const void*)fwd_kernel, hipFuncAttributeMaxDynamicSharedMemorySize, LDS_BYTES) != hipSuccess) { fprintf(stderr, "kernel_launch: hipFuncSetAttribute failed\n"); grid = -1; return; }
        int per_cu = 0;
        if (hipOccupancyMaxActiveBlocksPerMultiprocessor(&per_cu, (const void*)fwd_kernel, NWAVES * 64, LDS_BYTES) != hipSuccess || per_cu < 1) fprintf(stderr, "kernel_launch: occupancy query says %d\n", per_cu);
        (void)hipGetLastError();
        grid = cus;
    }
    if (grid < 0) return;
    (void)hipMemsetAsync((char*)d_ws + WS_CTL, 0, CTL_ZERO_BYTES, stream);
    Args a{};
    for (int i = 0; i < 20; ++i) a.in[i] = (const float*)d_in[i];
    a.out = (float*)d_out; a.ws = (unsigned char*)d_ws;
#ifdef PROBE_MFMA
    hipLaunchKernelGGL(probe_mfma, dim3(1), dim3(64), 0, stream, a);
    hipLaunchKernelGGL(probe_mfma_report, dim3(1024), dim3(512), 0, stream, a);
    return;
#endif
#ifndef LAUNCH_LIST
#define LAUNCH_LIST {0, NPH}
#endif
    static const int ranges[][2] = { LAUNCH_LIST };
    const int nl = (int)(sizeof(ranges) / sizeof(ranges[0]));
    for (int li = 0; li < nl; ++li) { a.ph_lo = ranges[li][0]; a.ph_hi = ranges[li][1]; a.li = li;
        hipLaunchKernelGGL(fwd_kernel, dim3(grid), dim3(NWAVES * 64), LDS_BYTES, stream, a); }
}
```

```cpp
#include <hip/hip_runtime.h>
#include <cstdio>
#include <cstdint>


#ifndef XTRA_BAR
#define XTRA_BAR 0
#endif
#ifndef DRY_EXP
#define DRY_EXP 0
#endif
#ifndef DUP_PHASE
#define DUP_PHASE -1
#endif
#ifndef MK_N_LAUNCHES
#define MK_N_LAUNCHES 1
#endif

#define LAS __attribute__((address_space(3)))
#define GAS __attribute__((address_space(1)))
typedef unsigned short bf16_t;
typedef short bf16x8 __attribute__((ext_vector_type(8)));
typedef float f32x4 __attribute__((ext_vector_type(4)));
typedef float f32x2 __attribute__((ext_vector_type(2)));
typedef unsigned u32x4 __attribute__((ext_vector_type(4)));
typedef unsigned u32x2 __attribute__((ext_vector_type(2)));
typedef int i32x4 __attribute__((ext_vector_type(4)));
typedef int i32x8 __attribute__((ext_vector_type(8)));
typedef __bf16 bf16x2_t __attribute__((ext_vector_type(2)));

constexpr int T_TOK = 32768, D = 1024, SEQ = 4096, NBATCH = 8;
constexpr int NPROJ = 5376;
constexpr int PLD = 5120;
constexpr int PC_Q = 0, PC_K = 512, PC_V = 1024, PC_R = 1536, PC_SU = 2048, PC_SV = 2560, PC_GA = 3072, PC_GB = 4096;
constexpr int PC_MRG = 512;
constexpr float EPS = 1e-6f;
constexpr int NEXP = 16384;
#ifndef U_NG
#define U_NG 1
#endif
#ifndef V_F4
#define V_F4 1
#endif
#ifndef SC_F8
#define SC_F8 0
#endif
#ifndef F8_LO
#define F8_LO 11
#endif
constexpr int UNG = U_NG, UNG_SH = (U_NG == 8 ? 3 : (U_NG == 4 ? 2 : (U_NG == 2 ? 1 : 0)));

constexpr size_t MiB = 1u << 20;
constexpr size_t WS_CTL = 0, CTL_ZERO_BYTES = 64 * 1024;
constexpr size_t WS_WIN = 1 * MiB;
constexpr size_t WS_WA = 12 * MiB;
constexpr size_t WS_WB = 13 * MiB;
constexpr size_t WS_WOUT = 14 * MiB;
constexpr size_t WS_WQF = 16 * MiB;
constexpr size_t WS_U8 = 20 * MiB;
constexpr size_t WS_V8 = 36 * MiB;
constexpr size_t WS_SU = 52 * MiB;
constexpr size_t WS_SV = 52 * MiB + 65536;
constexpr size_t WS_AK = 53 * MiB;
constexpr size_t WS_DEC = 84 * MiB;
constexpr size_t WS_ALR = 85 * MiB;
constexpr size_t WS_N1 = 87 * MiB;
constexpr size_t WS_P = 151 * MiB;
constexpr size_t WS_W8 = 472 * MiB;
constexpr size_t WS_N18 = 478 * MiB;
constexpr size_t WS_END = 510 * MiB;
constexpr size_t P_HB = 192 * MiB;
constexpr size_t P_N2 = 128 * MiB;
constexpr size_t P_SC = 0, P_IDX = 256 * MiB, P_GATE = 272 * MiB, P_X8 = 288 * MiB;

constexpr int CW_BAR = 4096;

constexpr int RING_BYTES = 131072;
constexpr int LDSCTL_OFF = RING_BYTES, MISC_OFF = LDSCTL_OFF + 320;
constexpr int LDS_BYTES = 147456;
constexpr int NWAVES = 8;

__device__ __forceinline__ unsigned pk2(float lo, float hi) { const f32x2 v = {lo, hi}; const bf16x2_t b = __builtin_convertvector(v, bf16x2_t); return __builtin_bit_cast(unsigned, b); }
__device__ __forceinline__ unsigned f2bf(float f) { return pk2(f, 0.f) & 0xffffu; }
__device__ __forceinline__ float bflo(unsigned w) { return __builtin_bit_cast(float, w << 16); }
__device__ __forceinline__ float bfhi(unsigned w) { return __builtin_bit_cast(float, w & 0xffff0000u); }
__device__ __forceinline__ float bf1(bf16_t h) { return __builtin_bit_cast(float, ((unsigned)h) << 16); }
__device__ __forceinline__ float sigmoidf_(float x) { return __builtin_amdgcn_rcpf(1.f + __expf(-x)); }
__device__ __forceinline__ float gelu_tanh(float x) { const float y = 1.5957691216057308f * (x + 0.044715f * x * x * x); return x * sigmoidf_(y); }
__device__ __forceinline__ float siluf_(float x) { return x * sigmoidf_(x); }
__device__ __forceinline__ float wave_sum(float v) {
#pragma unroll
    for (int o = 1; o < 64; o <<= 1) v += __shfl_xor(v, o);
    return v;
}
#define LDS_WAIT() asm volatile("s_waitcnt lgkmcnt(0)" ::: "memory")
#define VM_WAIT() asm volatile("s_waitcnt vmcnt(0)" ::: "memory")

__device__ __forceinline__ int lane_now() { int z = 0; asm volatile("" : "+s"(z)); return (int)__builtin_amdgcn_mbcnt_hi(~0u, __builtin_amdgcn_mbcnt_lo(~0u, (unsigned)z)); }
namespace pg8 {
constexpr int BM = 256, BK = 64, HALF = 128, HTB = HALF * BK * 2, STAGE_BYTES = 8 * HTB, NXCD = 8, WGM = 8;
__host__ __device__ __forceinline__ int lds_byte(int r, int c) { const int st = (r >> 4) * 2 + (c >> 5), rr = r & 15, cc = c & 31, ob = rr * 64 + cc * 2; return st * 1024 + (ob ^ (((ob >> 9) & 1) << 5)); }
__host__ __device__ __forceinline__ void stage_rc(int b, int& R, int& C) { const int st = b / 1024, sb = b % 1024, swz = sb ^ (((sb >> 9) & 1) << 5); R = (st >> 1) * 16 + swz / 64; C = (st & 1) * 32 + (swz % 64) / 2; }
__host__ __device__ __forceinline__ int perm32(int rho) { const int n = rho >> 4, i = rho & 15; return 8 * (i >> 2) + 4 * n + (i & 3); }

struct Unit { int pm, pn; };
struct Gemm { const bf16_t* A; const bf16_t* Bt; int M, N, K, lda; int sa = 0, sb = 0; };

struct StaticOrder {
    int nM, nN, nwg, G, c;
    __host__ __device__ void init(int M, int N, int G_, int c_) { nM = M / BM; nN = N / BM; nwg = nM * nN; G = G_; c = c_; }
    __host__ __device__ bool next(int i, Unit& u) const {
        const long L = (long)i * G + c; if (L >= nwg) return false;
        int wgid = (int)L; { const int q = nwg / NXCD, r = nwg % NXCD, xcd = wgid % NXCD, off = wgid / NXCD; wgid = (xcd < r ? xcd * (q + 1) : r * (q + 1) + (xcd - r) * q) + off; }
        const int nig = WGM * nN, gid = wgid / nig, fm = gid * WGM, gsz = (nM - fm) < WGM ? (nM - fm) : WGM;
        u.pm = fm + ((wgid % nig) % gsz); u.pn = (wgid % nig) / gsz; return true;
    }
    __device__ __forceinline__ void a_ready(const Unit&) const {}
    __device__ __forceinline__ void done(const Unit&) const {}
};

template <class Epi, class Sched, bool ALIGN_EPI = false, bool SP2 = false, bool F8 = false, bool MID = false>
__device__ __forceinline__ void gemm_phase(LAS unsigned char* lds, const Gemm g, const Sched& S, const Epi& E, int wave_id) {
    const int wid = wave_id, lane = lane_now(), tid = wid * 64 + lane, wr = wid >> 2, wc = wid & 3, fr = lane & 15, fq = lane >> 4;
    const int K = g.K, nt = K / BK, lda = g.lda; const int scA = g.sa, scB = g.sb; (void)scA; (void)scB;
    unsigned voffA[2], voffB[2];
#pragma unroll
    for (int i = 0; i < 2; ++i) { int R, C; stage_rc(tid * 16 + i * 8192, R, C); const int Rb = Epi::PERM ? ((R & ~31) + perm32(R & 31)) : R;
        voffA[i] = (unsigned)(R * lda + C) * 2u; voffB[i] = (unsigned)(Rb * K + C) * 2u; }
    const size_t kstep = (size_t)(BK * 2);
    const size_t hstepA = (size_t)HALF * lda * 2, hstepB = (size_t)HALF * K * 2;
    const size_t tstepA = 2 * hstepA, tstepB = 2 * hstepB;
    const unsigned ldsw = (unsigned)wid * 1024u; const unsigned ldsbase = (unsigned)(__UINTPTR_TYPE__)lds + ldsw;
    const int aoff = lds_byte(wr * 64 + fr, fq * 8), boff = lds_byte(wc * 32 + fr, fq * 8);
#define PG8_SA(b, h) (((b) * 2 + (h)) * HTB)
#define PG8_SB(b, h) ((4 + (b) * 2 + (h)) * HTB)
#define PG8_STAGE(bufoff, gbase, voff) do { _Pragma("unroll") for (int _i = 0; _i < 2; ++_i) \
        asm volatile("s_mov_b32 m0, %2\n\ts_nop 0\n\tglobal_load_lds_dwordx4 %0, %1" :: "v"((voff)[_i]), "s"((const char*)(gbase)), "s"(ldsbase + (unsigned)((bufoff) + _i * 8192)) : "memory", "m0"); } while (0)
#define PG8_LDA(dst, b, h) do { _Pragma("unroll") for (int m = 0; m < 4; ++m) _Pragma("unroll") for (int k = 0; k < 2; ++k) dst[m][k] = *(const LAS bf16x8*)(lds + PG8_SA(b, h) + aoff + m * 2048 + k * 1024); } while (0)
#define PG8_LDB(dst, b, h) do { _Pragma("unroll") for (int n = 0; n < 2; ++n) _Pragma("unroll") for (int k = 0; k < 2; ++k) dst[n][k] = *(const LAS bf16x8*)(lds + PG8_SB(b, h) + boff + n * 2048 + k * 1024); } while (0)
#define PG8_CAT(x) __builtin_shufflevector(__builtin_bit_cast(i32x4, (x)[0]), __builtin_bit_cast(i32x4, (x)[1]), 0, 1, 2, 3, 4, 5, 6, 7)
#define PG8_MMA(ai, bj, At, Bt) do { __builtin_amdgcn_s_setprio(1); if constexpr (F8) { _Pragma("unroll") for (int m = 0; m < 4; ++m) _Pragma("unroll") for (int n = 0; n < 2; ++n) \
        acc[ai][bj][m][n] = __builtin_amdgcn_mfma_scale_f32_16x16x128_f8f6f4(PG8_CAT(Bt[n]), PG8_CAT(At[m]), acc[ai][bj][m][n], 0, 0, 0, scB, 0, scA); } else { \
        _Pragma("unroll") for (int m = 0; m < 4; ++m) _Pragma("unroll") for (int n = 0; n < 2; ++n) _Pragma("unroll") for (int k = 0; k < 2; ++k) \
        acc[ai][bj][m][n] = __builtin_amdgcn_mfma_f32_16x16x32_bf16(Bt[n][k], At[m][k], acc[ai][bj][m][n], 0, 0, 0); } __builtin_amdgcn_s_setprio(0); } while (0)
#define PG8_WAIT_V(n) asm volatile("s_waitcnt vmcnt(" #n ")" ::: "memory")
#define PG8_WAIT_L(n) asm volatile("s_waitcnt lgkmcnt(" #n ")" ::: "memory")
#define PG8_BAR __builtin_amdgcn_s_barrier()
#define PG8_SCHED __builtin_amdgcn_sched_barrier(0)
    Unit cur, nxt; int ui = 0;
    if (!S.next(0, cur)) return;
    f32x4 acc[2][2][4][2];
#pragma unroll
    for (int a = 0; a < 2; ++a)
#pragma unroll
        for (int b = 0; b < 2; ++b)
#pragma unroll
            for (int m = 0; m < 4; ++m)
#pragma unroll
                for (int n = 0; n < 2; ++n) acc[a][b][m][n] = (f32x4){0.f, 0.f, 0.f, 0.f};
    bf16x8 At[4][2], B0[2][2], B1[2][2];
    const char* cA = (const char*)g.A + (size_t)cur.pm * tstepA; const char* cB = (const char*)g.Bt + (size_t)cur.pn * tstepB;
    S.a_ready(cur);
    if constexpr (SP2) {
        PG8_STAGE(PG8_SB(0, 0), cB, voffB); PG8_STAGE(PG8_SB(0, 1), cB + hstepB, voffB); PG8_STAGE(PG8_SA(0, 0), cA, voffA); PG8_STAGE(PG8_SA(0, 1), cA + hstepA, voffA);
        if (wr == 1) PG8_BAR;
        PG8_WAIT_V(2); PG8_BAR;
        PG8_STAGE(PG8_SB(1, 0), cB + kstep, voffB); PG8_STAGE(PG8_SA(1, 0), cA + kstep, voffA); PG8_STAGE(PG8_SB(1, 1), cB + hstepB + kstep, voffB);
        PG8_WAIT_V(6); PG8_BAR;
    } else {
        PG8_STAGE(PG8_SB(0, 0), cB, voffB); PG8_STAGE(PG8_SA(0, 0), cA, voffA); PG8_STAGE(PG8_SB(0, 1), cB + hstepB, voffB); PG8_STAGE(PG8_SA(0, 1), cA + hstepA, voffA);
        if (wr == 1) PG8_BAR;
        PG8_WAIT_V(4); PG8_BAR;
        PG8_STAGE(PG8_SB(1, 0), cB + kstep, voffB); PG8_STAGE(PG8_SA(1, 0), cA + kstep, voffA); PG8_STAGE(PG8_SB(1, 1), cB + hstepB + kstep, voffB);
        PG8_WAIT_V(6); PG8_BAR;
    }
    for (;;) {
        const bool has_next = S.next(ui + 1, nxt);
        const char* nA = has_next ? (const char*)g.A + (size_t)nxt.pm * tstepA : cA; const char* nB = has_next ? (const char*)g.Bt + (size_t)nxt.pn * tstepB : cB;
#pragma nounroll
        for (int t = 0; t < nt; t += 2) {
            if constexpr (MID) { if (t == (nt >> 1)) E.mid(acc, cur, wr, wc); }
            const bool last = (t == nt - 2);
            const char* a1 = cA + (size_t)(t + 1) * kstep;
            const char* a2 = last ? nA : cA + (size_t)(t + 2) * kstep; const char* b2 = last ? nB : cB + (size_t)(t + 2) * kstep;
            const char* a3 = a2 + kstep; const char* b3 = b2 + kstep;
            if (last && has_next) S.a_ready(nxt);
            if constexpr (SP2) {
            PG8_LDB(B0, 0, 0); PG8_LDB(B1, 0, 1); PG8_SCHED; PG8_LDA(At, 0, 0); PG8_STAGE(PG8_SA(1, 1), a1 + hstepA, voffA);
            PG8_WAIT_V(8); PG8_WAIT_L(0); PG8_BAR; PG8_MMA(0, 0, At, B0); PG8_MMA(0, 1, At, B1); PG8_BAR; PG8_SCHED;
            PG8_LDA(At, 0, 1); PG8_STAGE(PG8_SB(0, 0), b2, voffB); PG8_STAGE(PG8_SB(0, 1), b2 + hstepB, voffB); PG8_STAGE(PG8_SA(0, 0), a2, voffA);
            PG8_WAIT_V(8); PG8_WAIT_L(0); PG8_BAR; PG8_MMA(1, 0, At, B0); PG8_MMA(1, 1, At, B1); PG8_BAR; PG8_SCHED;
            PG8_LDB(B0, 1, 0); PG8_LDB(B1, 1, 1); PG8_SCHED; PG8_LDA(At, 1, 0); PG8_STAGE(PG8_SA(0, 1), a2 + hstepA, voffA);
            PG8_WAIT_V(8); PG8_WAIT_L(0); PG8_BAR; PG8_MMA(0, 0, At, B0); PG8_MMA(0, 1, At, B1); PG8_BAR; PG8_SCHED;
            PG8_LDA(At, 1, 1); PG8_STAGE(PG8_SB(1, 0), b3, voffB); PG8_STAGE(PG8_SB(1, 1), b3 + hstepB, voffB); PG8_STAGE(PG8_SA(1, 0), a3, voffA);
            PG8_WAIT_V(8); PG8_WAIT_L(0); PG8_BAR; PG8_MMA(1, 0, At, B0); PG8_MMA(1, 1, At, B1); PG8_BAR; PG8_SCHED;
            } else {
            PG8_LDB(B0, 0, 0); PG8_SCHED; PG8_LDA(At, 0, 0); PG8_STAGE(PG8_SA(1, 1), a1 + hstepA, voffA);
            PG8_WAIT_L(8); PG8_BAR; PG8_WAIT_L(0); PG8_MMA(0, 0, At, B0); PG8_BAR; PG8_SCHED;
            PG8_LDB(B1, 0, 1); PG8_STAGE(PG8_SB(0, 0), b2, voffB);
            PG8_BAR; PG8_WAIT_L(0); PG8_MMA(0, 1, At, B1); PG8_BAR;
            PG8_LDA(At, 0, 1); PG8_STAGE(PG8_SA(0, 0), a2, voffA);
            PG8_BAR; PG8_WAIT_L(0); PG8_MMA(1, 0, At, B0); PG8_BAR; PG8_SCHED;
            PG8_STAGE(PG8_SB(0, 1), b2 + hstepB, voffB);
            PG8_WAIT_V(6); PG8_BAR; PG8_MMA(1, 1, At, B1); PG8_BAR;
            PG8_LDB(B0, 1, 0); PG8_SCHED; PG8_LDA(At, 1, 0); PG8_STAGE(PG8_SA(0, 1), a2 + hstepA, voffA);
            PG8_WAIT_L(8); PG8_BAR; PG8_WAIT_L(0); PG8_MMA(0, 0, At, B0); PG8_BAR; PG8_SCHED;
            PG8_LDB(B1, 1, 1); PG8_STAGE(PG8_SB(1, 0), b3, voffB);
            PG8_BAR; PG8_WAIT_L(0); PG8_MMA(0, 1, At, B1); PG8_BAR;
            PG8_LDA(At, 1, 1); PG8_STAGE(PG8_SA(1, 0), a3, voffA);
            PG8_BAR; PG8_WAIT_L(0); PG8_MMA(1, 0, At, B0); PG8_BAR; PG8_SCHED;
            PG8_STAGE(PG8_SB(1, 1), b3 + hstepB, voffB);
            PG8_WAIT_V(6); PG8_BAR; PG8_MMA(1, 1, At, B1); PG8_BAR;
            }
        }
        if constexpr (ALIGN_EPI) { if (wr == 0) PG8_BAR; }
        E(acc, cur, wr, wc, fr, fq); S.done(cur);
        if (!has_next) break;
#pragma unroll
        for (int a = 0; a < 2; ++a)
#pragma unroll
            for (int b = 0; b < 2; ++b)
#pragma unroll
                for (int m = 0; m < 4; ++m)
#pragma unroll
                    for (int n = 0; n < 2; ++n) acc[a][b][m][n] = (f32x4){0.f, 0.f, 0.f, 0.f};
        cur = nxt; cA = nA; cB = nB; ++ui;
        if constexpr (ALIGN_EPI) { if (wr == 1) PG8_BAR; }
    }
    PG8_WAIT_V(0);
    if constexpr (!ALIGN_EPI) { if (wr == 0) PG8_BAR; }
    PG8_BAR;
#undef PG8_SA
#undef PG8_SB
#undef PG8_STAGE
#undef PG8_LDA
#undef PG8_LDB
#undef PG8_MMA
#undef PG8_CAT
#undef PG8_WAIT_V
#undef PG8_WAIT_L
#undef PG8_BAR
#undef PG8_SCHED
}

__device__ __forceinline__ u32x4 pack8(f32x4 v0, f32x4 v1) { u32x4 w; w.x = pk2(v0[0], v0[1]); w.y = pk2(v0[2], v0[3]); w.z = pk2(v1[0], v1[1]); w.w = pk2(v1[2], v1[3]); return w; }
__device__ __forceinline__ void unpack8(u32x4 w, f32x4& v0, f32x4& v1) { v0 = (f32x4){bflo(w.x), bfhi(w.x), bflo(w.y), bfhi(w.y)}; v1 = (f32x4){bflo(w.z), bfhi(w.z), bflo(w.w), bfhi(w.w)}; }

struct EpiProj {
    static constexpr bool PERM = true;
    bf16_t* P; float* ALR; int pn0;
    __device__ __forceinline__ void operator()(const f32x4 (&acc)[2][2][4][2], const Unit& u, int wr, int wc, int fr, int fq) const {
        { const int ln = lane_now(); fr = ln & 15; fq = ln >> 4; }
        const int row0 = u.pm * BM + wr * 64 + fr; int pn = u.pn + pn0; const int cl = wc * 32 + 8 * fq;
        if (pn == 10) {
            if (wc == 0 && fq < 2) {
#pragma unroll
                for (int ai = 0; ai < 2; ++ai)
#pragma unroll
                    for (int m = 0; m < 4; ++m) { float* rp = ALR + (size_t)(row0 + ai * HALF + m * 16) * 16 + 8 * fq;
                        *(f32x4*)rp = acc[ai][0][m][0]; *(f32x4*)(rp + 4) = acc[ai][0][m][1]; }
            }
            return;
        }
        if (pn > 10) --pn;
        const int mode = pn < 8 ? 0 : (pn < 12 ? 1 : 2);
#pragma unroll
        for (int ai = 0; ai < 2; ++ai)
#pragma unroll
            for (int m = 0; m < 4; ++m) { bf16_t* rowp = P + (size_t)(row0 + ai * HALF + m * 16) * PLD + pn * BM + cl;
#pragma unroll
                for (int bj = 0; bj < 2; ++bj) { f32x4 v0 = acc[ai][bj][m][0], v1 = acc[ai][bj][m][1];
                    if (mode == 1) {
#pragma unroll
                        for (int i = 0; i < 4; ++i) { v0[i] = gelu_tanh(v0[i]); v1[i] = gelu_tanh(v1[i]); }
                    } else if (mode == 2) {
#pragma unroll
                        for (int i = 0; i < 4; ++i) { v0[i] = sigmoidf_(v0[i]); v1[i] = sigmoidf_(v1[i]); }
                    }
                    *(u32x4*)(rowp + bj * HALF) = pack8(v0, v1); } }
    }
};
struct EpiBrA {
    static constexpr bool PERM = true;
    bf16_t* P;
    __device__ __forceinline__ void operator()(const f32x4 (&acc)[2][2][4][2], const Unit& u, int wr, int wc, int fr, int fq) const {
        const int row0 = u.pm * BM + wr * 64 + fr; const int c0 = u.pn * BM + wc * 32 + 8 * fq;
#pragma unroll
        for (int ai = 0; ai < 2; ++ai)
#pragma unroll
            for (int m = 0; m < 4; ++m) { bf16_t* rowp = P + (size_t)(row0 + ai * HALF + m * 16) * PLD;
#pragma unroll
                for (int bj = 0; bj < 2; ++bj) { const int c = c0 + bj * HALF; f32x4 g0, g1; unpack8(*(const u32x4*)(rowp + PC_GA + c), g0, g1);
                    *(u32x4*)(rowp + PC_MRG + c) = pack8(acc[ai][bj][m][0] * g0, acc[ai][bj][m][1] * g1); } }
    }
};
struct EpiBrB {
    static constexpr bool PERM = true;
    bf16_t* P;
    __device__ __forceinline__ void operator()(const f32x4 (&acc)[2][2][4][2], const Unit& u, int wr, int wc, int fr, int fq) const {
        const int row0 = u.pm * BM + wr * 64 + fr; const int c0 = u.pn * BM + wc * 32 + 8 * fq;
#pragma unroll
        for (int ai = 0; ai < 2; ++ai)
#pragma unroll
            for (int m = 0; m < 4; ++m) { bf16_t* rowp = P + (size_t)(row0 + ai * HALF + m * 16) * PLD;
#pragma unroll
                for (int bj = 0; bj < 2; ++bj) { const int c = c0 + bj * HALF; f32x4 g0, g1, p0, p1; unpack8(*(const u32x4*)(rowp + PC_GB + c), g0, g1); unpack8(*(const u32x4*)(rowp + PC_MRG + c), p0, p1);
                    *(u32x4*)(rowp + PC_MRG + c) = pack8(p0 + acc[ai][bj][m][0] * g0, p1 + acc[ai][bj][m][1] * g1); } }
    }
};
struct EpiBrAB {
    static constexpr bool PERM = true;
    bf16_t* P;
    __device__ __forceinline__ void mid(f32x4 (&acc)[2][2][4][2], const Unit& u, int wr, int wc) const {
        const int ln = lane_now(), fr = ln & 15, fq = ln >> 4;
        const int row0 = u.pm * BM + wr * 64 + fr; const int c0 = u.pn * BM + wc * 32 + 8 * fq;
#pragma unroll
        for (int ai = 0; ai < 2; ++ai)
#pragma unroll
            for (int m = 0; m < 4; ++m) { const bf16_t* rowp = P + (size_t)(row0 + ai * HALF + m * 16) * PLD;
#pragma unroll
                for (int bj = 0; bj < 2; ++bj) { const int c = c0 + bj * HALF; f32x4 a0, a1, b0, b1; unpack8(*(const u32x4*)(rowp + PC_GA + c), a0, a1); unpack8(*(const u32x4*)(rowp + PC_GB + c), b0, b1);
#pragma unroll
                    for (int i = 0; i < 4; ++i) { acc[ai][bj][m][0][i] *= a0[i] * __builtin_amdgcn_rcpf(fmaxf(b0[i], 1e-20f)); acc[ai][bj][m][1][i] *= a1[i] * __builtin_amdgcn_rcpf(fmaxf(b1[i], 1e-20f)); } } }
    }
    __device__ __forceinline__ void operator()(const f32x4 (&acc)[2][2][4][2], const Unit& u, int wr, int wc, int fr, int fq) const {
        { const int ln = lane_now(); fr = ln & 15; fq = ln >> 4; }
        const int row0 = u.pm * BM + wr * 64 + fr; const int c0 = u.pn * BM + wc * 32 + 8 * fq;
#pragma unroll
        for (int ai = 0; ai < 2; ++ai)
#pragma unroll
            for (int m = 0; m < 4; ++m) { bf16_t* rowp = P + (size_t)(row0 + ai * HALF + m * 16) * PLD;
#pragma unroll
                for (int bj = 0; bj < 2; ++bj) { const int c = c0 + bj * HALF; f32x4 g0, g1; unpack8(*(const u32x4*)(rowp + PC_GB + c), g0, g1);
                    *(u32x4*)(rowp + PC_MRG + c) = pack8(acc[ai][bj][m][0] * g0, acc[ai][bj][m][1] * g1); } }
    }
};
struct EpiOut {
    static constexpr bool PERM = true;
    bf16_t* O;
    __device__ __forceinline__ void operator()(const f32x4 (&acc)[2][2][4][2], const Unit& u, int wr, int wc, int fr, int fq) const {
        const int row0 = u.pm * BM + wr * 64 + fr; const int c0 = u.pn * BM + wc * 32 + 8 * fq;
#pragma unroll
        for (int ai = 0; ai < 2; ++ai)
#pragma unroll
            for (int m = 0; m < 4; ++m) { const size_t ro = (size_t)(row0 + ai * HALF + m * 16) * D;
#pragma unroll
                for (int bj = 0; bj < 2; ++bj) *(u32x4*)(O + ro + c0 + bj * HALF) = pack8(acc[ai][bj][m][0], acc[ai][bj][m][1]); }
    }
};
struct EpiScores {
    static constexpr bool PERM = true;
    bf16_t* SC;
    __device__ __forceinline__ void operator()(const f32x4 (&acc)[2][2][4][2], const Unit& u, int wr, int wc, int fr, int fq) const {
        const int tb0 = u.pm * 16 + wr * 4; const int cq0 = (u.pn * BM + wc * 32 + 8 * fq) >> 3;
#pragma unroll
        for (int ai = 0; ai < 2; ++ai)
#pragma unroll
            for (int m = 0; m < 4; ++m) { bf16_t* bp = SC + ((size_t)(tb0 + ai * 8 + m) * 256) * 128 + fr * 8;
#pragma unroll
                for (int bj = 0; bj < 2; ++bj) *(u32x4*)(bp + (size_t)(cq0 + bj * 16) * 128) = pack8(acc[ai][bj][m][0], acc[ai][bj][m][1]); }
    }
};
}

#define XB_TMO      128
#define XB_XCNT(j)  (256  + 64 * (j))
#define XB_XSUB(j)  (1280 + 64 * (j))
#define XB_XGEN(j)  (2304 + 64 * (j))
#define XB_TOP      3328
#define XB_TOPGEN   3392
#define XCD_BAR_WORDS 3456
#define XB_SPIN_CAP (1u << 18)
__device__ __forceinline__ unsigned xb_ld(unsigned* p)              { return __hip_atomic_load(p, __ATOMIC_RELAXED, __HIP_MEMORY_SCOPE_AGENT); }
__device__ __forceinline__ unsigned xb_add(unsigned* p, unsigned v) { return __hip_atomic_fetch_add(p, v, __ATOMIC_RELAXED, __HIP_MEMORY_SCOPE_AGENT); }
__device__ __forceinline__ unsigned xb_xcc_id() { return (unsigned)__builtin_amdgcn_s_getreg((3 << 11) | 20) & 0xFu; }
#define XB_SPIN(cond, bar) do { unsigned _sp = 0; while (cond) { __builtin_amdgcn_s_sleep(1); \
    if ((++_sp & 255u) == 0u) { if (xb_ld(&(bar)[XB_TMO])) break; if (_sp > XB_SPIN_CAP) { atomicAdd(&(bar)[XB_TMO], 1u); break; } } } } while (0)
struct XcdBarrier { unsigned* bar; unsigned x; volatile LAS unsigned* st; int wave; };
__device__ __forceinline__ XcdBarrier xcd_barrier_post(unsigned* bar, volatile LAS unsigned* st, int wave) {
    XcdBarrier b; b.bar = bar; b.x = xb_xcc_id(); b.st = st; b.wave = wave;
    if (wave == 0 && lane_now() == 0) (void)xb_add(&bar[XB_XCNT(b.x)], 1u);
    return b;
}
__device__ __forceinline__ void xcd_barrier_complete(unsigned* bar, unsigned x, unsigned& nloc, unsigned& nx) {
    const unsigned G = gridDim.x * gridDim.y * gridDim.z;
    unsigned sum, cnt, mine, sp = 0u;
    for (;;) {
        sum = 0u; cnt = 0u; mine = 0u;
#pragma unroll
        for (unsigned j = 0; j < 16; ++j) { const unsigned c = xb_ld(&bar[XB_XCNT(j)]); sum += c; cnt += (c > 0u) ? 1u : 0u; mine = (j == x) ? c : mine; }
        if (sum == G) break;
        __builtin_amdgcn_s_sleep(1);
        if ((++sp & 255u) == 0u) { if (xb_ld(&bar[XB_TMO])) break; if (sp > XB_SPIN_CAP) { atomicAdd(&bar[XB_TMO], 1u); break; } }
    }
    nloc = mine > 0u ? mine : 1u; nx = cnt > 0u ? cnt : 1u;
}
__device__ __forceinline__ void xcd_barrier(const XcdBarrier& b) {
    asm volatile("s_waitcnt vmcnt(0)" ::: "memory");
    __syncthreads();
    if (b.wave == 0 && lane_now() == 0) {
        unsigned* bar = b.bar;
        __builtin_amdgcn_s_waitcnt(0);
        unsigned nloc = b.st[0], nx = b.st[1];
        if (nloc == 0u) { xcd_barrier_complete(bar, b.x, nloc, nx); b.st[0] = nloc; b.st[1] = nx; }
        const unsigned old = xb_add(&bar[XB_XSUB(b.x)], 1u);
        const unsigned gen = old / nloc;
        if (old + 1u == (gen + 1u) * nloc) {
            __builtin_amdgcn_fence(__ATOMIC_RELEASE, "agent");
            asm volatile("s_waitcnt vmcnt(0)" ::: "memory");
            const unsigned og = xb_add(&bar[XB_TOP], 1u);
            const unsigned tg = og / nx;
            if (og + 1u == (tg + 1u) * nx) xb_add(&bar[XB_TOPGEN], 1u);
            else XB_SPIN(xb_ld(&bar[XB_TOPGEN]) == tg, bar);
            __builtin_amdgcn_fence(__ATOMIC_ACQUIRE, "agent");
            xb_add(&bar[XB_XGEN(b.x)], 1u);
            asm volatile("s_waitcnt vmcnt(0)" ::: "memory");
        } else {
            XB_SPIN(xb_ld(&bar[XB_XGEN(b.x)]) == gen, bar);
            __builtin_amdgcn_fence(__ATOMIC_ACQUIRE, "agent");
            asm volatile("s_waitcnt vmcnt(0)" ::: "memory");
        }
    }
    __syncthreads();
}

struct Args {
    const float* in[20]; float* out; unsigned char* ws; int ph_lo, ph_hi, li, pad;
};
enum { I_X = 0, I_N1G, I_WIN, I_WGU, I_BG, I_GLAG, I_SLNG, I_SLNB, I_SW, I_SB, I_WBA, I_WBB, I_WOUT, I_N2G, I_WQ, I_K1, I_K2, I_PU, I_PV, I_FG };

struct Frame {
    LAS unsigned char* lds;
    int tid, lane, wave, G, bid;
};

__device__ __forceinline__ float clamp448(float v) { return __builtin_amdgcn_fmed3f(v, -448.f, 448.f); }
template <int MODE, bool F8 = false>
__device__ __forceinline__ void p0_transpose_item(const float* W, int K, int Nsrc, int Ndst, bf16_t* WT, LAS float* scr, int item, int lane, float sc8 = 1.f, int ldk = 0) {
    if (ldk == 0) ldk = K;
    const int nblk = Ndst / 32, kb = item / nblk, nb = item % nblk, k0 = 64 * kb, n0 = 32 * nb;
    const int nd = n0 + (lane & 31);
    int sc = nd; bool valid = true;
    if (MODE == 1) { if (nd < 2048) sc = nd; else if (nd < 2560) sc = nd + 16; else if (nd < 2576) sc = 2048 + (nd - 2560); else if (nd < 2816) { sc = 0; valid = false; } else sc = nd - 240; }
#pragma unroll 8
    for (int i = 0; i < 32; ++i) { const int kk = 2 * i + (lane >> 5); const float v = valid ? W[(size_t)(k0 + kk) * Nsrc + sc] : 0.f; scr[kk * 33 + (lane & 31)] = v; }
    LDS_WAIT(); asm volatile("" ::: "memory");
    if (F8) {
        const int c = lane & 3;
#pragma unroll
        for (int j = 0; j < 2; ++j) { const int n = (lane >> 2) + 16 * j; const LAS float* s = scr + (16 * c) * 33 + n; u32x4 o;
#pragma unroll
            for (int q = 0; q < 4; ++q) { int w = 0; w = __builtin_amdgcn_cvt_pk_fp8_f32(clamp448(s[(4 * q) * 33] * sc8), clamp448(s[(4 * q + 1) * 33] * sc8), w, false);
                w = __builtin_amdgcn_cvt_pk_fp8_f32(clamp448(s[(4 * q + 2) * 33] * sc8), clamp448(s[(4 * q + 3) * 33] * sc8), w, true); o[q] = (unsigned)w; }
            *(u32x4*)((unsigned char*)WT + (size_t)(n0 + n) * ldk + k0 + 16 * c) = o; }
    } else {
    const int c = lane & 7;
#pragma unroll
    for (int j = 0; j < 4; ++j) { const int n = (lane >> 3) + 8 * j; const LAS float* s = scr + (8 * c) * 33 + n;
        u32x4 o; o.x = pk2(s[0 * 33], s[1 * 33]); o.y = pk2(s[2 * 33], s[3 * 33]); o.z = pk2(s[4 * 33], s[5 * 33]); o.w = pk2(s[6 * 33], s[7 * 33]);
        *(u32x4*)(WT + (size_t)(n0 + n) * ldk + k0 + 8 * c) = o; }
    }
    LDS_WAIT(); asm volatile("" ::: "memory");
}
template <int OM, int NB>
__device__ __forceinline__ void rms_rows_to_bf16(int lane, const float* x0, size_t xstride, const float* g, bf16_t* o0, size_t ostride, unsigned* o80 = nullptr, size_t o8stride = 0, const bf16_t* add0 = nullptr, size_t addstride = 0, bf16_t* hb0 = nullptr, size_t hbstride = 0) {
    f32x4 v[NB][4]; float s[NB];
#pragma unroll
    for (int b = 0; b < NB; ++b) { const float* xr = x0 + b * xstride + 8 * lane;
#pragma unroll
        for (int j = 0; j < 2; ++j) { v[b][2 * j] = *(const f32x4*)(xr + 512 * j); v[b][2 * j + 1] = *(const f32x4*)(xr + 512 * j + 4); } }
    if (add0) {
        u32x4 ad[NB][2];
#pragma unroll
        for (int b = 0; b < NB; ++b) { const bf16_t* ar = add0 + b * addstride + 8 * lane;
#pragma unroll
            for (int j = 0; j < 2; ++j) ad[b][j] = *(const u32x4*)(ar + 512 * j); }
#pragma unroll
        for (int b = 0; b < NB; ++b)
#pragma unroll
            for (int j = 0; j < 2; ++j) { v[b][2 * j] = v[b][2 * j] + (f32x4){bflo(ad[b][j].x), bfhi(ad[b][j].x), bflo(ad[b][j].y), bfhi(ad[b][j].y)};
                v[b][2 * j + 1] = v[b][2 * j + 1] + (f32x4){bflo(ad[b][j].z), bfhi(ad[b][j].z), bflo(ad[b][j].w), bfhi(ad[b][j].w)}; }
    }
    if (hb0) {
#pragma unroll
        for (int b = 0; b < NB; ++b)
#pragma unroll
            for (int j = 0; j < 2; ++j) *(u32x4*)(hb0 + b * hbstride + 512 * j + 8 * lane) = pg8::pack8(v[b][2 * j], v[b][2 * j + 1]);
    }
#pragma unroll
    for (int b = 0; b < NB; ++b) { s[b] = 0.f;
#pragma unroll
        for (int j = 0; j < 4; ++j) s[b] += (v[b][j].x * v[b][j].x + v[b][j].y * v[b][j].y) + (v[b][j].z * v[b][j].z + v[b][j].w * v[b][j].w); }
#pragma unroll
    for (int o = 1; o < 64; o <<= 1) {
#pragma unroll
        for (int b = 0; b < NB; ++b) s[b] += __shfl_xor(s[b], o); }
    const float* gr = g + 8 * lane;
#pragma unroll
    for (int b = 0; b < NB; ++b) { const float rstd = 1.f / sqrtf(s[b] * (1.f / D) + EPS);
#pragma unroll
        for (int j = 0; j < 2; ++j) { const f32x4 y0 = v[b][2 * j] * rstd * *(const f32x4*)(gr + 512 * j), y1 = v[b][2 * j + 1] * rstd * *(const f32x4*)(gr + 512 * j + 4);
            const u32x4 o = pg8::pack8(y0, y1);
            if (OM & 1) *(u32x4*)(o0 + b * ostride + 512 * j + 8 * lane) = o;
            if (OM == 3) { u32x2 w8;
#pragma unroll
                for (int h = 0; h < 2; ++h) { int w = 0; w = __builtin_amdgcn_cvt_pk_fp8_f32(clamp448(bflo(o[2 * h]) * 16.f), clamp448(bfhi(o[2 * h]) * 16.f), w, false);
                    w = __builtin_amdgcn_cvt_pk_fp8_f32(clamp448(bflo(o[2 * h + 1]) * 16.f), clamp448(bfhi(o[2 * h + 1]) * 16.f), w, true); w8[h] = (unsigned)w; }
                *(u32x2*)(o80 + b * o8stride + 128 * j + 2 * lane) = w8; }
            if (OM == 2) { u32x2 w8; int w = 0;
                w = __builtin_amdgcn_cvt_pk_fp8_f32(clamp448(y0.x * 16.f), clamp448(y0.y * 16.f), w, false); w = __builtin_amdgcn_cvt_pk_fp8_f32(clamp448(y0.z * 16.f), clamp448(y0.w * 16.f), w, true); w8.x = (unsigned)w;
                w = 0; w = __builtin_amdgcn_cvt_pk_fp8_f32(clamp448(y1.x * 16.f), clamp448(y1.y * 16.f), w, false); w = __builtin_amdgcn_cvt_pk_fp8_f32(clamp448(y1.z * 16.f), clamp448(y1.w * 16.f), w, true); w8.y = (unsigned)w;
                *(u32x2*)(o80 + b * o8stride + 128 * j + 2 * lane) = w8; } } }
}
__device__ __forceinline__ float wave_max(float v) {
#pragma unroll
    for (int o = 1; o < 64; o <<= 1) v = fmaxf(v, __shfl_xor(v, o));
    return v;
}
template <int NB>
__device__ __forceinline__ void cvt_rows_fp8(int lane, const float* const (&src)[NB], unsigned char* const (&dst16)[NB], float* const (&scale_out)[NB]) {
    f32x4 v[NB][4]; float m[NB];
#pragma unroll
    for (int b = 0; b < NB; ++b) {
#pragma unroll
        for (int j = 0; j < 4; ++j) v[b][j] = *(const GAS f32x4*)(src[b] + 16 * lane + 4 * j); }
#pragma unroll
    for (int b = 0; b < NB; ++b) { m[b] = 0.f;
#pragma unroll
        for (int j = 0; j < 4; ++j) m[b] = fmaxf(m[b], fmaxf(fmaxf(fabsf(v[b][j].x), fabsf(v[b][j].y)), fmaxf(fabsf(v[b][j].z), fabsf(v[b][j].w)))); }
#pragma unroll
    for (int o = 1; o < 64; o <<= 1) {
#pragma unroll
        for (int b = 0; b < NB; ++b) m[b] = fmaxf(m[b], __shfl_xor(m[b], o)); }
#pragma unroll
    for (int b = 0; b < NB; ++b) { const float inv = m[b] > 0.f ? 224.f / m[b] : 0.f, sc = m[b] > 0.f ? m[b] * (1.f / 224.f) : 1.f;
        u32x4 o;
#pragma unroll
        for (int j = 0; j < 4; ++j) { int w = 0; w = __builtin_amdgcn_cvt_pk_fp8_f32(v[b][j].x * inv, v[b][j].y * inv, w, false); w = __builtin_amdgcn_cvt_pk_fp8_f32(v[b][j].z * inv, v[b][j].w * inv, w, true); o[j] = (unsigned)w; }
        *(GAS u32x4*)dst16[b] = o;
        if (lane == 0) *(GAS float*)scale_out[b] = sc; }
}
__device__ __forceinline__ unsigned fp4_code(float t) { const float a = fabsf(t);
    const unsigned c = (unsigned)(a >= 0.25f) + (unsigned)(a >= 0.75f) + (unsigned)(a >= 1.25f) + (unsigned)(a >= 1.75f) + (unsigned)(a >= 2.5f) + (unsigned)(a >= 3.5f) + (unsigned)(a >= 5.f);
    return c | (t < 0.f ? 8u : 0u); }
template <int NB, bool PERMV = false>
__device__ __forceinline__ void cvt_rows_fp4(int lane, const float* const (&src)[NB], unsigned char* const (&dst8)[NB], float* const (&scale_out)[NB]) {
    f32x4 v[NB][4]; float m[NB];
#pragma unroll
    for (int b = 0; b < NB; ++b) {
#pragma unroll
        for (int j = 0; j < 4; ++j) v[b][j] = *(const GAS f32x4*)(src[b] + 16 * lane + 4 * j); }
#pragma unroll
    for (int b = 0; b < NB; ++b) { m[b] = 0.f;
#pragma unroll
        for (int j = 0; j < 4; ++j) m[b] = fmaxf(m[b], fmaxf(fmaxf(fabsf(v[b][j].x), fabsf(v[b][j].y)), fmaxf(fabsf(v[b][j].z), fabsf(v[b][j].w)))); }
#pragma unroll
    for (int o = 1; o < 64; o <<= 1) {
#pragma unroll
        for (int b = 0; b < NB; ++b) m[b] = fmaxf(m[b], __shfl_xor(m[b], o)); }
#pragma unroll
    for (int b = 0; b < NB; ++b) { const float inv = m[b] > 0.f ? 6.f / m[b] : 0.f, sc = m[b] > 0.f ? m[b] * (1.f / 6.f) : 1.f;
        u32x2 o;
#pragma unroll
        for (int h = 0; h < 2; ++h) { unsigned w = 0;
            const f32x4 t0 = v[b][2 * h] * inv, t1 = v[b][2 * h + 1] * inv;
            w = __builtin_amdgcn_cvt_scalef32_pk_fp4_f32(w, t0.x, t0.y, 1.f, 0); w = __builtin_amdgcn_cvt_scalef32_pk_fp4_f32(w, t0.z, t0.w, 1.f, 1);
            w = __builtin_amdgcn_cvt_scalef32_pk_fp4_f32(w, t1.x, t1.y, 1.f, 2); w = __builtin_amdgcn_cvt_scalef32_pk_fp4_f32(w, t1.z, t1.w, 1.f, 3);
            o[h] = w; }
        if (PERMV) { *(GAS unsigned*)(dst8[b] + 16 * ((2 * lane) & 31) + 4 * (lane >> 4)) = o.x; *(GAS unsigned*)(dst8[b] + 16 * ((2 * lane + 1) & 31) + 4 * (lane >> 4)) = o.y; }
        else *(GAS u32x2*)dst8[b] = o;
        if (lane == 0) *(GAS float*)scale_out[b] = sc; }
}
__device__ __forceinline__ void convert_tables(const Frame& F, const Args& A, int wi, int nw) {
    unsigned char* ws = A.ws; const int gw = wi, NGW = nw;
    {
        int mc = gw;
        for (; mc + 3 * NGW < NEXP; mc += 4 * NGW) { const float* src[4]; unsigned char* dst[4]; float* sco[4];
#pragma unroll
            for (int b = 0; b < 4; ++b) { const int e = mc + b * NGW; src[b] = A.in[I_PU] + (size_t)e * D; dst[b] = ws + WS_U8 + (size_t)((e & (UNG - 1)) * (NEXP / UNG) + (e >> UNG_SH)) * 512 + 8 * F.lane; sco[b] = (float*)(ws + WS_SU) + e; }
            cvt_rows_fp4<4>(F.lane, src, dst, sco); }
        for (; mc < NEXP; mc += NGW) { const float* src[1]; unsigned char* dst[1]; float* sco[1];
            const int e = mc; src[0] = A.in[I_PU] + (size_t)e * D; dst[0] = ws + WS_U8 + (size_t)((e & (UNG - 1)) * (NEXP / UNG) + (e >> UNG_SH)) * 512 + 8 * F.lane; sco[0] = (float*)(ws + WS_SU) + e;
            cvt_rows_fp4<1>(F.lane, src, dst, sco); }
    }
    if (V_F4) {
        int mc = gw;
        for (; mc + 3 * NGW < NEXP; mc += 4 * NGW) { const float* src[4]; unsigned char* dst[4]; float* sco[4];
#pragma unroll
            for (int b = 0; b < 4; ++b) { const int e = mc + b * NGW; src[b] = A.in[I_PV] + (size_t)e * D; dst[b] = ws + WS_V8 + (size_t)e * 512; sco[b] = (float*)(ws + WS_SV) + e; }
            cvt_rows_fp4<4, true>(F.lane, src, dst, sco); }
        for (; mc < NEXP; mc += NGW) { const float* src[1]; unsigned char* dst[1]; float* sco[1];
            const int e = mc; src[0] = A.in[I_PV] + (size_t)e * D; dst[0] = ws + WS_V8 + (size_t)e * 512; sco[0] = (float*)(ws + WS_SV) + e;
            cvt_rows_fp4<1, true>(F.lane, src, dst, sco); }
    } else {
        int mc = gw;
        for (; mc + 3 * NGW < NEXP; mc += 4 * NGW) { const float* src[4]; unsigned char* dst[4]; float* sco[4];
#pragma unroll
            for (int b = 0; b < 4; ++b) { const int e = mc + b * NGW; src[b] = A.in[I_PV] + (size_t)e * D; dst[b] = ws + WS_V8 + ((size_t)(F.lane >> 3) * NEXP + e) * 128 + 16 * (F.lane & 7); sco[b] = (float*)(ws + WS_SV) + e; }
            cvt_rows_fp8<4>(F.lane, src, dst, sco); }
        for (; mc < NEXP; mc += NGW) { const float* src[1]; unsigned char* dst[1]; float* sco[1];
            const int e = mc; src[0] = A.in[I_PV] + (size_t)e * D; dst[0] = ws + WS_V8 + ((size_t)(F.lane >> 3) * NEXP + e) * 128 + 16 * (F.lane & 7); sco[0] = (float*)(ws + WS_SV) + e;
            cvt_rows_fp8<1>(F.lane, src, dst, sco); }
    }
}
__device__ __forceinline__ void phase0(const Frame& F, const Args& A) {
    unsigned char* ws = A.ws;
    if (!SC_F8) {
        const int l = F.lane, fr = l & 15, q = l >> 4;
        bf16_t* WQF = (bf16_t*)(ws + WS_WQF);
        for (int it = F.bid * NWAVES + F.wave; it < 2048; it += F.G * NWAVES) {
            const int kh = it & 1, kt = (it >> 1) & 63, hh = it >> 7;
            const float* kX = (hh & 1) ? A.in[I_K2] : A.in[I_K1];
            const float* ap = A.in[I_WQ] + (size_t)(kt * 16 + fr) * 2048 + hh * 128 + 4 * q;
            f32x4 a[8];
#pragma unroll
            for (int t = 0; t < 8; ++t) a[t] = *(const f32x4*)(ap + 16 * t);
#pragma unroll
            for (int kb = 0; kb < 4; ++kb) { const int key0 = kh * 64 + kb * 16;
                const float* bp = kX + (size_t)(key0 + fr) * 128 + 4 * q;
                f32x4 b[8];
#pragma unroll
                for (int t = 0; t < 8; ++t) b[t] = *(const f32x4*)(bp + 16 * t);
                f32x4 d = {0.f, 0.f, 0.f, 0.f};
#pragma unroll
                for (int t = 0; t < 8; ++t)
#pragma unroll
                    for (int c = 0; c < 4; ++c) d = __builtin_amdgcn_mfma_f32_16x16x4f32(a[t][c], b[t][c], d, 0, 0, 0);
                u32x2 o; o.x = pk2(d[0], d[1]); o.y = pk2(d[2], d[3]);
                *(u32x2*)(WQF + (size_t)(hh * 128 + key0 + fr) * 1024 + kt * 16 + 4 * q) = o; }
        }
    } else {
        LAS float* kx = (LAS float*)F.lds;
        LAS float* wt = (LAS float*)(F.lds + 128 * 129 * 4);
        bf16_t* WQF = (bf16_t*)(ws + WS_WQF);
        for (int it = F.bid; it < 512; it += F.G) {
            const int hh = it >> 5, kblk = it & 31, k0 = kblk * 32;
            const float* kX = (hh & 1) ? A.in[I_K2] : A.in[I_K1];
            __syncthreads();
            for (int e = F.tid; e < 128 * 128; e += 512) kx[(e >> 7) * 129 + (e & 127)] = kX[e];
            for (int e = F.tid; e < 32 * 128; e += 512) wt[e] = A.in[I_WQ][(size_t)(k0 + (e >> 7)) * 2048 + hh * 128 + (e & 127)];
            __syncthreads();
            const int key = F.tid & 127, kq = F.tid >> 7;
            float acc[8];
#pragma unroll
            for (int i = 0; i < 8; ++i) acc[i] = 0.f;
            for (int d = 0; d < 128; ++d) { const float b = kx[key * 129 + d];
#pragma unroll
                for (int i = 0; i < 8; ++i) acc[i] += wt[(kq * 8 + i) * 128 + d] * b; }
            if (SC_F8) { u32x2 o;
#pragma unroll
                for (int h2 = 0; h2 < 2; ++h2) { int w = 0; w = __builtin_amdgcn_cvt_pk_fp8_f32(clamp448(acc[4 * h2] * 1024.f), clamp448(acc[4 * h2 + 1] * 1024.f), w, false);
                    w = __builtin_amdgcn_cvt_pk_fp8_f32(clamp448(acc[4 * h2 + 2] * 1024.f), clamp448(acc[4 * h2 + 3] * 1024.f), w, true); o[h2] = (unsigned)w; }
                *(u32x2*)((unsigned char*)WQF + (size_t)(hh * 128 + key) * 1024 + k0 + kq * 8) = o;
            } else {
            u32x4 o; o.x = pk2(acc[0], acc[1]); o.y = pk2(acc[2], acc[3]); o.z = pk2(acc[4], acc[5]); o.w = pk2(acc[6], acc[7]);
            *(u32x4*)(WQF + (size_t)(hh * 128 + key) * 1024 + k0 + kq * 8) = o; }
        }
        __syncthreads();
    }
    LAS float* scr = (LAS float*)(F.lds + F.wave * 16384);
    const int gw = F.bid * NWAVES + F.wave, NGW = F.G * NWAVES;
    constexpr int I_IN = 16 * (NPROJ / 32), I_A = 8 * 32, I_B = 8 * 32, I_O = 16 * 32;
    constexpr int NITEMS = I_IN + I_A + I_B + I_O;
    for (int it = gw; it < NITEMS; it += NGW) {
        int r = it;
        if (r < I_IN) { if ((r % (NPROJ / 32)) * 32 >= F8_LO * 256) p0_transpose_item<1, true>(A.in[I_WIN], 1024, 5136, NPROJ, (bf16_t*)(ws + WS_W8), scr, r, F.lane, 1024.f);
                        else p0_transpose_item<1, false>(A.in[I_WIN], 1024, 5136, NPROJ, (bf16_t*)(ws + WS_WIN), scr, r, F.lane); continue; } r -= I_IN;
        if (r < I_A) { p0_transpose_item<0>(A.in[I_WBA], 512, 1024, 1024, (bf16_t*)(ws + WS_WA), scr, r, F.lane, 1.f, 1024); continue; } r -= I_A;
        if (r < I_B) { p0_transpose_item<0>(A.in[I_WBB], 512, 1024, 1024, (bf16_t*)(ws + WS_WA) + 512, scr, r, F.lane, 1.f, 1024); continue; } r -= I_B;
        p0_transpose_item<0>(A.in[I_WOUT], 1024, 1024, 1024, (bf16_t*)(ws + WS_WOUT), scr, r, F.lane);
    }
    constexpr int OM1 = F8_LO <= 0 ? 2 : (F8_LO >= 21 ? 1 : 3);
    { int m = gw; for (; m + 3 * NGW < T_TOK; m += 4 * NGW) rms_rows_to_bf16<OM1, 4>(F.lane, A.in[I_X] + (size_t)m * D, (size_t)NGW * D, A.in[I_N1G], (bf16_t*)(ws + WS_N1) + (size_t)m * D, (size_t)NGW * D, (unsigned*)(ws + WS_N18) + (size_t)m * 256, (size_t)NGW * 256);
      for (; m < T_TOK; m += NGW) rms_rows_to_bf16<OM1, 1>(F.lane, A.in[I_X] + (size_t)m * D, 0, A.in[I_N1G], (bf16_t*)(ws + WS_N1) + (size_t)m * D, 0, (unsigned*)(ws + WS_N18) + (size_t)m * 256, 0); }
}

__device__ __forceinline__ float log_sigmoid(float z) { return fminf(z, 0.f) - log1pf(__expf(-fabsf(z))); }

template <bool DRY>
__device__ __forceinline__ void gla_chunk_phase(const Frame& F, const Args& A) {
    unsigned char* ws = A.ws;
    const bf16_t* P = (const bf16_t*)(ws + WS_P);
    const float* ALR = (const float*)(ws + WS_ALR);
    LAS float* alr = (LAS float*)F.lds;
    LAS float* tot = (LAS float*)(F.lds + 4096);
    LAS bf16_t* kdT = (LAS bf16_t*)(F.lds + 8192);
    LAS bf16_t* vT = (LAS bf16_t*)(F.lds + 26624);
    LAS bf16_t* stT = (LAS bf16_t*)(F.lds + 45056);
    const int tid = F.tid, kk = tid & 127, seg = tid >> 7;
    const bool hconst = (F.G & 3) == 0;
    int hcur = -1; float w[16]; float bias = 0.f;
#pragma unroll
    for (int j = 0; j < 16; ++j) w[j] = 0.f;
    float na0, na1; bf16_t nk[16], nv[16];
#define GC_LOAD(unit) do { const int h_ = (unit) & 3, c_ = ((unit) >> 2) & 63, b_ = (unit) >> 8; const int t0_ = b_ * SEQ + c_ * 64; \
        na0 = ALR[(size_t)t0_ * 16 + tid]; na1 = ALR[(size_t)t0_ * 16 + 512 + tid]; \
        const bf16_t* kp_ = P + (size_t)(t0_ + 16 * seg) * PLD + PC_K + h_ * 128 + kk; const bf16_t* vp_ = P + (size_t)(t0_ + 16 * seg) * PLD + PC_V + h_ * 128 + kk; \
        _Pragma("unroll") for (int i_ = 0; i_ < 16; ++i_) { nk[i_] = kp_[(size_t)i_ * PLD]; nv[i_] = vp_[(size_t)i_ * PLD]; } } while (0)
    int unit = F.bid;
    if (unit < 2048) GC_LOAD(unit);
    for (; unit < 2048; unit += F.G) {
        const int h = unit & 3;
        if (h != hcur) { hcur = h;
#pragma unroll
            for (int j = 0; j < 16; ++j) w[j] = A.in[I_WGU][(size_t)j * 512 + h * 128 + kk];
            bias = A.in[I_BG][h * 128 + kk]; }
        __syncthreads();
        alr[tid] = na0; alr[512 + tid] = na1;
        bf16_t kr[16], vr[16];
#pragma unroll
        for (int i = 0; i < 16; ++i) { kr[i] = nk[i]; vr[i] = nv[i]; }
        if (unit + F.G < 2048) GC_LOAD(unit + F.G);
        __syncthreads();
        float cum[16]; float run = 0.f;
#pragma unroll
        for (int i = 0; i < 16; ++i) { const LAS f32x4* ap = (const LAS f32x4*)(alr + (16 * seg + i) * 16); float z = bias;
#pragma unroll
            for (int q = 0; q < 4; ++q) { const f32x4 a4 = ap[q]; z += a4.x * w[4 * q] + a4.y * w[4 * q + 1] + a4.z * w[4 * q + 2] + a4.w * w[4 * q + 3]; }
            const float ls = fminf(z, 0.f) - __logf(1.f + __expf(-fabsf(z)));
            run += ls * (1.f / 16.f); cum[i] = run; }
        tot[seg * 128 + kk] = run;
        __syncthreads();
        {
            const float t0s = tot[kk], t1s = tot[128 + kk], t2s = tot[256 + kk], t3s = tot[384 + kk];
            const float total = (t0s + t1s) + (t2s + t3s);
            const float prefix = seg == 0 ? 0.f : (seg == 1 ? t0s : (seg == 2 ? t0s + t1s : t0s + t1s + t2s));
            unsigned kw[8], vw[8];
#pragma unroll
            for (int i = 0; i < 8; ++i) {
                const float e0 = __expf(total - (prefix + cum[2 * i])), e1 = __expf(total - (prefix + cum[2 * i + 1]));
                kw[i] = pk2(bf1(kr[2 * i]) * e0, bf1(kr[2 * i + 1]) * e1); vw[i] = (unsigned)vr[2 * i] | ((unsigned)vr[2 * i + 1] << 16);
            }
            *(LAS u32x4*)(kdT + kk * 72 + 16 * seg) = (u32x4){kw[0], kw[1], kw[2], kw[3]}; *(LAS u32x4*)(kdT + kk * 72 + 16 * seg + 8) = (u32x4){kw[4], kw[5], kw[6], kw[7]};
            *(LAS u32x4*)(vT + kk * 72 + 16 * seg) = (u32x4){vw[0], vw[1], vw[2], vw[3]}; *(LAS u32x4*)(vT + kk * 72 + 16 * seg + 8) = (u32x4){vw[4], vw[5], vw[6], vw[7]};
            if (seg == 0) ((float*)(DRY ? (unsigned char*)A.out + 96 * MiB : ws + WS_DEC))[(size_t)unit * 128 + kk] = __expf(total);
        }
        __syncthreads();
        {
            const int w8 = F.wave, l = F.lane, fr = l & 15, fq = l >> 4;
            f32x4 acc[8];
#pragma unroll
            for (int n = 0; n < 8; ++n) acc[n] = (f32x4){0.f, 0.f, 0.f, 0.f};
#pragma unroll
            for (int ks = 0; ks < 2; ++ks) {
                const bf16x8 a = *(const LAS bf16x8*)(kdT + (16 * w8 + fr) * 72 + 32 * ks + 8 * fq);
#pragma unroll
                for (int n = 0; n < 8; ++n) { const bf16x8 bb = *(const LAS bf16x8*)(vT + (16 * n + fr) * 72 + 32 * ks + 8 * fq);
                    acc[n] = __builtin_amdgcn_mfma_f32_16x16x32_bf16(a, bb, acc[n], 0, 0, 0); }
            }
#pragma unroll
            for (int n = 0; n < 8; ++n) { u32x2 o; o.x = pk2(acc[n][0], acc[n][1]); o.y = pk2(acc[n][2], acc[n][3]);
                *(LAS u32x2*)(stT + (16 * n + fr) * 136 + 16 * w8 + 4 * fq) = o; }
        }
        __syncthreads();
        {
            bf16_t* ST = (bf16_t*)(DRY ? (unsigned char*)A.out : ws + WS_N1) + (size_t)unit * 16384;
            const int vv = tid >> 2, part = tid & 3;
#pragma unroll
            for (int q = 0; q < 4; ++q) *(u32x4*)(ST + (size_t)vv * 128 + 32 * part + 8 * q) = *(const LAS u32x4*)(stT + vv * 136 + 32 * part + 8 * q);
        }
    }
#undef GC_LOAD
    (void)hconst;
}

template <bool DRY>
__device__ __forceinline__ void sgu_unit(const Frame& F, const Args& A, int unit, bool stats) {
    const int g = unit & 3, blk = (unit >> 2) & 31, b = unit >> 7;
    const int t0 = b * SEQ + blk * 128;
    bf16_t* P = (bf16_t*)(A.ws + WS_P);
    LAS bf16_t* wA = (LAS bf16_t*)F.lds;
    LAS bf16_t* vnT = (LAS bf16_t*)(F.lds + 34816);
    LAS float* st = (LAS float*)(F.lds + 69632);
    LAS bf16_t* suS = (LAS bf16_t*)(F.lds + 70656);
    const int tid = F.tid;
    __syncthreads();
    if (stats) {
        const int j = tid >> 2, q = tid & 3;
        const bf16_t* sp = P + (size_t)(t0 + j) * PLD + PC_SV + q * 128;
        float s = 0.f, s2 = 0.f;
#pragma unroll
        for (int i = 0; i < 16; ++i) { const u32x4 w = *(const u32x4*)(sp + 8 * i);
            const float f[8] = {bflo(w.x), bfhi(w.x), bflo(w.y), bfhi(w.y), bflo(w.z), bfhi(w.z), bflo(w.w), bfhi(w.w)};
#pragma unroll
            for (int e = 0; e < 8; ++e) { s += f[e]; s2 += f[e] * f[e]; } }
        s += __shfl_xor(s, 1); s += __shfl_xor(s, 2); s2 += __shfl_xor(s2, 1); s2 += __shfl_xor(s2, 2);
        const float mu = s * (1.f / 512.f); const float var = fmaxf(s2 * (1.f / 512.f) - mu * mu, 0.f);
        if (q == 0) { st[2 * j] = mu; st[2 * j + 1] = 1.f / sqrtf(var + EPS); }
    }
    {
        const int i = tid >> 2, jb = (tid & 3) * 32;
        const float* wp = A.in[I_SW] + (size_t)g * 16384 + (size_t)i * 128 + jb;
        const bf16_t* sup = P + (size_t)(t0 + i) * PLD + PC_SU + g * 128 + jb;
#pragma unroll
        for (int q = 0; q < 4; ++q) { const f32x4 a = *(const f32x4*)(wp + 8 * q), bq = *(const f32x4*)(wp + 8 * q + 4);
            const bool z = (i < 64) && (jb + 8 * q >= 64);
            u32x4 o; o.x = pk2(a.x, a.y); o.y = pk2(a.z, a.w); o.z = pk2(bq.x, bq.y); o.w = pk2(bq.z, bq.w);
            if (z) o = (u32x4){0u, 0u, 0u, 0u};
            *(LAS u32x4*)(wA + i * 136 + jb + 8 * q) = o;
            *(LAS u32x4*)(suS + i * 136 + jb + 8 * q) = *(const u32x4*)(sup + 8 * q); }
    }
    const int cch = tid & 127, seg = tid >> 7;
    bf16_t xr[32];
    { const bf16_t* sp = P + (size_t)(t0 + 32 * seg) * PLD + PC_SV + g * 128 + cch;
#pragma unroll
      for (int i = 0; i < 32; ++i) xr[i] = sp[(size_t)i * PLD]; }
    const float lg = A.in[I_SLNG][g * 128 + cch], lb = A.in[I_SLNB][g * 128 + cch];
    __syncthreads();
    {
        unsigned ow[16];
#pragma unroll
        for (int i = 0; i < 16; ++i) { const int j = 32 * seg + 2 * i; const f32x4 ms = *(const LAS f32x4*)(st + 2 * j);
            ow[i] = pk2((bf1(xr[2 * i]) - ms.x) * ms.y * lg + lb, (bf1(xr[2 * i + 1]) - ms.z) * ms.w * lg + lb); }
#pragma unroll
        for (int q = 0; q < 4; ++q) *(LAS u32x4*)(vnT + cch * 136 + 32 * seg + 8 * q) = (u32x4){ow[4 * q], ow[4 * q + 1], ow[4 * q + 2], ow[4 * q + 3]};
    }
    __syncthreads();
    {
        const int w = F.wave, l = F.lane, fr = l & 15, fq = l >> 4;
        f32x4 acc[8];
#pragma unroll
        for (int n = 0; n < 8; ++n) acc[n] = (f32x4){0.f, 0.f, 0.f, 0.f};
#pragma unroll
        for (int ks = 0; ks < 4; ++ks) {
            const bf16x8 a = *(const LAS bf16x8*)(wA + (16 * w + fr) * 136 + 32 * ks + 8 * fq);
#pragma unroll
            for (int n = 0; n < 8; ++n) { const bf16x8 bb = *(const LAS bf16x8*)(vnT + (16 * n + fr) * 136 + 32 * ks + 8 * fq);
                acc[n] = __builtin_amdgcn_mfma_f32_16x16x32_bf16(a, bb, acc[n], 0, 0, 0); }
        }
#pragma unroll
        for (int jj = 0; jj < 4; ++jj) { const int i = 16 * w + 4 * fq + jj; const float bias = A.in[I_SB][g * 128 + i];
            LAS bf16_t* rp = suS + i * 136 + fr;
#pragma unroll
            for (int n = 0; n < 8; ++n) { const float su = bf1(rp[16 * n]); rp[16 * n] = (bf16_t)f2bf(su * (acc[n][jj] + bias)); } }
    }
    __syncthreads();
    {
        const int i = tid >> 2, jb = (tid & 3) * 32;
        bf16_t* yp = DRY ? (bf16_t*)A.out + (size_t)(t0 + i) * 512 + g * 128 + jb : P + (size_t)(t0 + i) * PLD + PC_SU + g * 128 + jb;
#pragma unroll
        for (int q = 0; q < 4; ++q) *(u32x4*)(yp + 8 * q) = *(const LAS u32x4*)(suS + i * 136 + jb + 8 * q);
    }
}

template <bool DRY>
__device__ __forceinline__ void gla_scan(const Frame& F, const Args& A) {
    bf16_t* ST = (bf16_t*)(A.ws + WS_N1); bf16_t* STO = DRY ? (bf16_t*)A.out : ST; const float* DEC = (const float*)(A.ws + WS_DEC);
    for (int gi = F.bid * 512 + F.tid; gi < 131072; gi += F.G * 512) {
        const int k4 = gi & 31, vv = (gi >> 5) & 127, h = (gi >> 12) & 3, b = gi >> 14;
        float s0 = 0.f, s1 = 0.f, s2 = 0.f, s3 = 0.f;
        u32x2 wa[8], wb[8]; f32x4 da[8], db[8];
#define SCAN_LOAD(W, Dd, c0) do { _Pragma("unroll") for (int i_ = 0; i_ < 8; ++i_) { const size_t u_ = (size_t)((b * 64 + (c0) + i_) * 4 + h); \
            W[i_] = *(const u32x2*)(ST + u_ * 16384 + (size_t)vv * 128 + k4 * 4); Dd[i_] = *(const f32x4*)(DEC + u_ * 128 + k4 * 4); } } while (0)
#define SCAN_STEP(W, Dd, c0) do { _Pragma("unroll") for (int i_ = 0; i_ < 8; ++i_) { const size_t u_ = (size_t)((b * 64 + (c0) + i_) * 4 + h); \
            s0 = Dd[i_].x * s0 + bflo(W[i_].x); s1 = Dd[i_].y * s1 + bfhi(W[i_].x); s2 = Dd[i_].z * s2 + bflo(W[i_].y); s3 = Dd[i_].w * s3 + bfhi(W[i_].y); \
            u32x2 o_; o_.x = pk2(s0, s1); o_.y = pk2(s2, s3); *(u32x2*)(STO + u_ * 16384 + (size_t)vv * 128 + k4 * 4) = o_; } } while (0)
        SCAN_LOAD(wa, da, 0);
#pragma unroll
        for (int c0 = 0; c0 < 64; c0 += 16) {
            SCAN_LOAD(wb, db, c0 + 8);
            SCAN_STEP(wa, da, c0);
            if (c0 + 16 < 64) SCAN_LOAD(wa, da, c0 + 16);
            SCAN_STEP(wb, db, c0 + 8);
        }
#undef SCAN_LOAD
#undef SCAN_STEP
    }
}

template <bool DRY>
__device__ __forceinline__ void gla_out_phase(const Frame& F, const Args& A) {
    bf16_t* P = (bf16_t*)(A.ws + WS_P);
    LAS bf16_t* qA = (LAS bf16_t*)F.lds;
    LAS bf16_t* sB = (LAS bf16_t*)(F.lds + 17408);
    LAS float* oF = (LAS float*)(F.lds + 52224);
    const int tid = F.tid, s = tid >> 3, cb = (tid & 7) * 16, vv = tid >> 2, kb = (tid & 3) * 32;
    u32x4 nq0, nq1, ns0, ns1, ns2, ns3, nr0, nr1;
#define GO_LOAD(unit) do { const int h_ = (unit) & 3, c_ = ((unit) >> 2) & 63, b_ = (unit) >> 8; const int t0_ = b_ * SEQ + c_ * 64; \
        const bf16_t* qp_ = P + (size_t)(t0_ + s) * PLD + PC_Q + h_ * 128 + cb; nq0 = *(const u32x4*)qp_; nq1 = *(const u32x4*)(qp_ + 8); \
        const bf16_t* sp_ = (const bf16_t*)(A.ws + WS_N1) + (size_t)(unit) * 16384 + (size_t)vv * 128 + kb; ns0 = *(const u32x4*)sp_; ns1 = *(const u32x4*)(sp_ + 8); ns2 = *(const u32x4*)(sp_ + 16); ns3 = *(const u32x4*)(sp_ + 24); \
        const bf16_t* rp_ = P + (size_t)(t0_ + s) * PLD + PC_R + h_ * 128 + cb; nr0 = *(const u32x4*)rp_; nr1 = *(const u32x4*)(rp_ + 8); } while (0)
    int unit = F.bid;
    if (unit < 2048) GO_LOAD(unit);
    for (; unit < 2048; unit += F.G) {
        const int h = unit & 3, c = (unit >> 2) & 63, b = unit >> 8;
        const int t0 = b * SEQ + c * 64;
        __syncthreads();
        *(LAS u32x4*)(qA + s * 136 + cb) = nq0; *(LAS u32x4*)(qA + s * 136 + cb + 8) = nq1;
        *(LAS u32x4*)(sB + vv * 136 + kb) = ns0; *(LAS u32x4*)(sB + vv * 136 + kb + 8) = ns1; *(LAS u32x4*)(sB + vv * 136 + kb + 16) = ns2; *(LAS u32x4*)(sB + vv * 136 + kb + 24) = ns3;
        const u32x4 r0 = nr0, r1 = nr1;
        if (unit + F.G < 2048) GO_LOAD(unit + F.G);
        __syncthreads();
        {
            const int w = F.wave, l = F.lane, fr = l & 15, fq = l >> 4, m = w & 3, nh = w >> 2;
            f32x4 acc[4];
#pragma unroll
            for (int n = 0; n < 4; ++n) acc[n] = (f32x4){0.f, 0.f, 0.f, 0.f};
#pragma unroll
            for (int ks = 0; ks < 4; ++ks) {
                const bf16x8 a = *(const LAS bf16x8*)(qA + (16 * m + fr) * 136 + 32 * ks + 8 * fq);
#pragma unroll
                for (int n = 0; n < 4; ++n) { const bf16x8 bb = *(const LAS bf16x8*)(sB + (16 * (4 * nh + n) + fr) * 136 + 32 * ks + 8 * fq);
                    acc[n] = __builtin_amdgcn_mfma_f32_16x16x32_bf16(a, bb, acc[n], 0, 0, 0); }
            }
            const float scale = 0.08838834764831845f;
#pragma unroll
            for (int n = 0; n < 4; ++n)
#pragma unroll
                for (int jj = 0; jj < 4; ++jj) oF[(16 * m + 4 * fq + jj) * 132 + 16 * (4 * nh + n) + fr] = acc[n][jj] * scale;
        }
        __syncthreads();
        {
            float o[16]; float ss = 0.f;
#pragma unroll
            for (int i = 0; i < 16; ++i) { o[i] = oF[s * 132 + cb + i]; ss += o[i] * o[i]; }
            ss += __shfl_xor(ss, 1); ss += __shfl_xor(ss, 2); ss += __shfl_xor(ss, 4);
            const float rstd = 1.f / sqrtf(ss * (1.f / 128.f) + EPS);
            const unsigned rw[8] = {r0.x, r0.y, r0.z, r0.w, r1.x, r1.y, r1.z, r1.w};
            const float* gg = A.in[I_GLAG] + h * 128 + cb;
            unsigned ow[8];
#pragma unroll
            for (int i = 0; i < 8; ++i) { const float y0 = o[2 * i] * rstd * gg[2 * i] * siluf_(bflo(rw[i])), y1 = o[2 * i + 1] * rstd * gg[2 * i + 1] * siluf_(bfhi(rw[i])); ow[i] = pk2(y0, y1); }
            bf16_t* yp = DRY ? (bf16_t*)A.out + (size_t)(t0 + s) * 512 + h * 128 + cb : P + (size_t)(t0 + s) * PLD + PC_R + h * 128 + cb;
            *(u32x4*)yp = (u32x4){ow[0], ow[1], ow[2], ow[3]}; *(u32x4*)(yp + 8) = (u32x4){ow[4], ow[5], ow[6], ow[7]};
        }
    }
#undef GO_LOAD
}

__device__ __forceinline__ unsigned ordkey(float v) { const unsigned u = __builtin_bit_cast(unsigned, v); return u ^ ((unsigned)((int)u >> 31) | 0x80000000u); }
__device__ __forceinline__ float unord(unsigned k) { const unsigned u = (k & 0x80000000u) ? (k & 0x7fffffffu) : ~k; return __builtin_bit_cast(float, u); }
#define INS16(r, xin) do { unsigned _x = (xin); _Pragma("unroll") for (int _i = 0; _i < 16; ++_i) { const unsigned _h = max((r)[_i], _x); _x = min((r)[_i], _x); (r)[_i] = _h; } } while (0)

#define CE(a, b) do { const unsigned _h = max((a), (b)), _l = min((a), (b)); (a) = _h; (b) = _l; } while (0)
#define SORT16(v) do { CE(v[0], v[1]); CE(v[2], v[3]); CE(v[0], v[2]); CE(v[1], v[3]); CE(v[1], v[2]); CE(v[4], v[5]); CE(v[6], v[7]); CE(v[4], v[6]); CE(v[5], v[7]); CE(v[5], v[6]); CE(v[0], v[4]); CE(v[2], v[6]); CE(v[2], v[4]); CE(v[1], v[5]); CE(v[3], v[7]); CE(v[3], v[5]); CE(v[1], v[2]); CE(v[3], v[4]); CE(v[5], v[6]); CE(v[8], v[9]); CE(v[10], v[11]); CE(v[8], v[10]); CE(v[9], v[11]); CE(v[9], v[10]); CE(v[12], v[13]); CE(v[14], v[15]); CE(v[12], v[14]); CE(v[13], v[15]); CE(v[13], v[14]); CE(v[8], v[12]); CE(v[10], v[14]); CE(v[10], v[12]); CE(v[9], v[13]); CE(v[11], v[15]); CE(v[11], v[13]); CE(v[9], v[10]); CE(v[11], v[12]); CE(v[13], v[14]); CE(v[0], v[8]); CE(v[4], v[12]); CE(v[4], v[8]); CE(v[2], v[10]); CE(v[6], v[14]); CE(v[6], v[10]); CE(v[2], v[4]); CE(v[6], v[8]); CE(v[10], v[12]); CE(v[1], v[9]); CE(v[5], v[13]); CE(v[5], v[9]); CE(v[3], v[11]); CE(v[7], v[15]); CE(v[7], v[11]); CE(v[3], v[5]); CE(v[7], v[9]); CE(v[11], v[13]); CE(v[1], v[2]); CE(v[3], v[4]); CE(v[5], v[6]); CE(v[7], v[8]); CE(v[9], v[10]); CE(v[11], v[12]); CE(v[13], v[14]); } while (0)
#define MERGE16(T, S) do { _Pragma("unroll") for (int _i = 0; _i < 16; ++_i) (T)[_i] = max((T)[_i], (S)[15 - _i]); \
    _Pragma("unroll") for (int _d = 8; _d >= 1; _d >>= 1) { _Pragma("unroll") for (int _i = 0; _i < 16; ++_i) if ((_i & _d) == 0) CE((T)[_i], (T)[_i + _d]); } } while (0)
__device__ __forceinline__ void peer_topk(const Frame& F, const Args& A) {
    const bf16_t* SC = (const bf16_t*)(A.ws + WS_P + P_SC);
    int* IDX = (int*)(A.ws + WS_P + P_IDX); float* GATE = (float*)(A.ws + WS_P + P_GATE);
    const int gw = F.bid * NWAVES + F.wave, NGW = F.G * NWAVES;
    for (int it = gw; it < 512 * 8; it += NGW) {
        const int h = it & 7, tb = it >> 3; const int tok = tb * 64 + F.lane;
        unsigned r1[16], r2[16], rc[16];
        const bf16_t* p1 = SC + ((size_t)(tok >> 4) * 256 + h * 32) * 128 + (tok & 15) * 8; const bf16_t* p2 = p1 + 16 * 128;
        {
            float raw[128]; unsigned sg[16];
#pragma unroll
            for (int jq = 0; jq < 16; ++jq) { const u32x4 t4 = *(const u32x4*)(p1 + jq * 128);
#pragma unroll
                for (int c = 0; c < 4; ++c) { raw[8 * jq + 2 * c] = bflo(t4[c]); raw[8 * jq + 2 * c + 1] = bfhi(t4[c]); } }
#pragma unroll
            for (int j = 0; j < 16; ++j) r1[j] = (ordkey(raw[j]) & ~127u) | (unsigned)(127 - j);
            SORT16(r1);
#pragma unroll
            for (int gq = 1; gq < 8; ++gq) {
#pragma unroll
                for (int j = 0; j < 16; ++j) sg[j] = (ordkey(raw[16 * gq + j]) & ~127u) | (unsigned)(127 - (16 * gq + j));
                SORT16(sg); MERGE16(r1, sg); }
#pragma unroll
            for (int jq = 0; jq < 16; ++jq) { const u32x4 t4 = *(const u32x4*)(p2 + jq * 128);
#pragma unroll
                for (int c = 0; c < 4; ++c) { raw[8 * jq + 2 * c] = bflo(t4[c]); raw[8 * jq + 2 * c + 1] = bfhi(t4[c]); } }
#pragma unroll
            for (int j = 0; j < 16; ++j) r2[j] = (ordkey(raw[j]) & ~127u) | (unsigned)(127 - j);
            SORT16(r2);
#pragma unroll
            for (int gq = 1; gq < 8; ++gq) {
#pragma unroll
                for (int j = 0; j < 16; ++j) sg[j] = (ordkey(raw[16 * gq + j]) & ~127u) | (unsigned)(127 - (16 * gq + j));
                SORT16(sg); MERGE16(r2, sg); }
        }
        float v1[16], v2[16];
#pragma unroll
        for (int i = 0; i < 16; ++i) { v1[i] = unord((r1[i] & ~127u) | 64u); v2[i] = unord((r2[i] & ~127u) | 64u); }
        {
            unsigned cg[4][16]; int cn = 0;
#pragma unroll
            for (int a = 0; a < 16; ++a)
#pragma unroll
                for (int bq = 0; bq < 16; ++bq) if ((a + 1) * (bq + 1) <= 16) { cg[cn >> 4][cn & 15] = (ordkey(v1[a] + v2[bq]) & ~255u) | (unsigned)(a * 16 + bq); ++cn; }
#pragma unroll
            for (int z = 50; z < 64; ++z) cg[z >> 4][z & 15] = 0u;
            SORT16(cg[0]); SORT16(cg[1]); SORT16(cg[2]); SORT16(cg[3]);
            MERGE16(cg[0], cg[1]); MERGE16(cg[0], cg[2]); MERGE16(cg[0], cg[3]);
#pragma unroll
            for (int i = 0; i < 16; ++i) rc[i] = cg[0][i];
        }
        float val[16]; int ex[16];
        {
            LAS unsigned* t1 = (LAS unsigned*)(F.lds + F.wave * 8704) + F.lane * 17; LAS unsigned* t2 = t1 + 64 * 17;
#pragma unroll
            for (int i = 0; i < 16; ++i) { t1[i] = r1[i]; t2[i] = r2[i]; }
            LDS_WAIT(); asm volatile("" ::: "memory");
#pragma unroll
            for (int w = 0; w < 16; ++w) {
                const int a = (rc[w] >> 4) & 15, bq = rc[w] & 15;
                const unsigned k1 = t1[a], k2 = t2[bq];
                val[w] = unord((k1 & ~127u) | 64u) + unord((k2 & ~127u) | 64u);
                ex[w] = (127 - (int)(k1 & 127u)) * 128 + (127 - (int)(k2 & 127u));
            }
            LDS_WAIT(); asm volatile("" ::: "memory");
        }
        float mx = val[0];
#pragma unroll
        for (int w = 1; w < 16; ++w) mx = fmaxf(mx, val[w]);
        float sum = 0.f;
#pragma unroll
        for (int w = 0; w < 16; ++w) { val[w] = __expf(val[w] - mx); sum += val[w]; }
        const float inv = 1.f / sum;
        int* ip = IDX + (size_t)tok * 128 + h * 16; float* gp = GATE + (size_t)tok * 128 + h * 16;
#pragma unroll
        for (int q = 0; q < 4; ++q) { *(int4*)(ip + 4 * q) = make_int4(ex[4 * q], ex[4 * q + 1], ex[4 * q + 2], ex[4 * q + 3]);
            *(f32x4*)(gp + 4 * q) = (f32x4){val[4 * q] * inv, val[4 * q + 1] * inv, val[4 * q + 2] * inv, val[4 * q + 3] * inv}; }
    }
}

#define DPP_ADD(v, ctrl) ((v) + __builtin_bit_cast(float, __builtin_amdgcn_mov_dpp(__builtin_bit_cast(int, (v)), (ctrl), 0xf, 0xf, true)))
__device__ __forceinline__ void fp8x16_to_f32x2(const u32x4 r, f32x2* f) {
#pragma unroll
    for (int q = 0; q < 4; ++q) { f[2 * q] = __builtin_amdgcn_cvt_pk_f32_fp8((int)r[q], false); f[2 * q + 1] = __builtin_amdgcn_cvt_pk_f32_fp8((int)r[q], true); }
}
__device__ __forceinline__ void fp8x16_to_f32(const u32x4 r, float* f) {
#pragma unroll
    for (int q = 0; q < 4; ++q) { const f32x2 lo = __builtin_amdgcn_cvt_pk_f32_fp8((int)r[q], false), hi = __builtin_amdgcn_cvt_pk_f32_fp8((int)r[q], true);
        f[4 * q] = lo.x; f[4 * q + 1] = lo.y; f[4 * q + 2] = hi.x; f[4 * q + 3] = hi.y; }
}
__device__ __forceinline__ long lo64(u32x4 v) { return (long)(((unsigned long)v.y << 32) | (unsigned long)v.x); }
__device__ __forceinline__ long hi64(u32x4 v) { return (long)(((unsigned long)v.w << 32) | (unsigned long)v.z); }
template <int MODE>
__device__ __forceinline__ void peer_u_phase(const Frame& F, const Args& A) {
    const unsigned char* X8 = A.ws + WS_P + P_X8;
    const unsigned char* U8 = A.ws + WS_U8; const float* SU = (const float*)(A.ws + WS_SU); const float* SV = (const float*)(A.ws + WS_SV);
    const int* IDX = (const int*)(A.ws + WS_P + P_IDX); const float* GATE = (const float*)(A.ws + WS_P + P_GATE); float* AK = (float*)(MODE == 0 ? A.ws + WS_AK : A.ws + WS_P + P_SC);
    const int g = F.bid & 7, nmem = F.G >> 3, l = F.lane, step = nmem * NWAVES;
    const int loff = 64 * (l & 15) + 16 * (l >> 4);
    const bool dg = ((l & 15) >> 2) == (l >> 4); const int dr = l & 3;
    const float dw0 = (dg && dr == 0) ? 1.f : 0.f, dw1 = (dg && dr == 1) ? 1.f : 0.f, dw2 = (dg && dr == 2) ? 1.f : 0.f, dw3 = (dg && dr == 3) ? 1.f : 0.f;
    LAS int* le = (LAS int*)(F.lds + F.wave * 2048); LAS int* lk = le + 256;
    const bool b5 = (l & 32) != 0, b4 = (l & 16) != 0, b3 = (l & 8) != 0;
    int tok = 2 * ((F.bid >> 3) * NWAVES + F.wave);
    u32x4 nxA, nxB; int neA0, neA1, neB0, neB1; float ngA0, ngA1, ngB0, ngB1;
#define U_PREFETCH(t) do { const size_t _tA = (size_t)(t), _tB = (size_t)(t) + 1; if (MODE == 4) { nxA = (u32x4){(unsigned)_tA, 1u, 2u, 3u}; nxB = nxA; neA0 = (int)((_tA * 37 + l * 11) & 16383); neA1 = (int)((_tA * 53 + l * 7) & 16383); neB0 = (int)((_tB * 37 + l * 13) & 16383); neB1 = (int)((_tB * 29 + l * 3) & 16383); ngA0 = ngA1 = ngB0 = ngB1 = 0.01f; break; } nxA = *(const u32x4*)(X8 + _tA * 1024 + loff); nxB = *(const u32x4*)(X8 + _tB * 1024 + loff); \
        neA0 = IDX[_tA * 128 + l]; neA1 = IDX[_tA * 128 + 64 + l]; neB0 = IDX[_tB * 128 + l]; neB1 = IDX[_tB * 128 + 64 + l]; \
        ngA0 = GATE[_tA * 128 + l]; ngA1 = GATE[_tA * 128 + 64 + l]; ngB0 = GATE[_tB * 128 + l]; ngB1 = GATE[_tB * 128 + 64 + l]; } while (0)
    if (tok + 1 < T_TOK) U_PREFETCH(tok);
    for (; tok + 1 < T_TOK; tok += 2 * step) {
        const int tokA = tok, tokB = tok + 1;
        const u32x4 xA = nxA, xB = nxB;
        const int eA0 = neA0, eA1 = neA1, eB0 = neB0, eB1 = neB1; const float gA0 = ngA0, gA1 = ngA1, gB0 = ngB0, gB1 = ngB1;
        bool pf_done = false;
        const bool oA0 = (eA0 & 7) == g, oA1 = (eA1 & 7) == g, oB0 = (eB0 & 7) == g, oB1 = (eB1 & 7) == g;
        const unsigned long long mA0 = __ballot(oA0), mA1 = __ballot(oA1), mB0 = __ballot(oB0), mB1 = __ballot(oB1);
        const int c0 = __popcll(mA0), c1 = c0 + __popcll(mA1), c2 = c1 + __popcll(mB0), n = c2 + __popcll(mB1);
#define MBC(m) __builtin_amdgcn_mbcnt_hi((unsigned)((m) >> 32), __builtin_amdgcn_mbcnt_lo((unsigned)(m), 0u))
        if (oA0) { const int p = MBC(mA0); le[p] = (eA0 << 8) | l; lk[p] = __builtin_bit_cast(int, gA0); }
        if (oA1) { const int p = c0 + MBC(mA1); le[p] = (eA1 << 8) | (64 + l); lk[p] = __builtin_bit_cast(int, gA1); }
        if (oB0) { const int p = c1 + MBC(mB0); le[p] = (eB0 << 8) | 128 | l; lk[p] = __builtin_bit_cast(int, gB0); }
        if (oB1) { const int p = c2 + MBC(mB1); le[p] = (eB1 << 8) | 128 | (64 + l); lk[p] = __builtin_bit_cast(int, gB1); }
#undef MBC
        LDS_WAIT(); asm volatile("" ::: "memory");
        for (int cb = 0; cb < n || cb == 0; cb += 64) {
        const int nc = min(n, cb + 64);
        const bool fv = (cb + l) < nc;
        const int ent = fv ? le[cb + l] : 0; const float gt = fv ? __builtin_bit_cast(float, lk[cb + l]) : 0.f; float tot = 0.f;
        const float su = SU[ent >> 8], sv = SV[ent >> 8];
        const unsigned long long radr = (unsigned long long)(U8 + (size_t)(((ent >> 8) & 7) * 2048 + (((ent >> 8) >> 3) & (MODE == 2 ? 255 : 2047))) * 1024);
        const int ralo = (int)(unsigned)radr, rahi = (int)(unsigned)(radr >> 32);
        for (int i = cb; i < nc; i += 16) {
            u32x4 row[2][8];
#pragma unroll
            for (int b = 0; b < 2; ++b) if (i + 8 * b < nc) {
#pragma unroll
                for (int j = 0; j < 8; ++j) { const int ln = min(i + 8 * b + j, nc - 1) - cb;
                    const unsigned lo = (unsigned)__builtin_amdgcn_readlane(ralo, ln), hi = (unsigned)__builtin_amdgcn_readlane(rahi, ln);
                    const GAS unsigned char* rp = (const GAS unsigned char*)(((unsigned long long)hi << 32) | lo);
                    row[b][j] = *(const GAS u32x4*)(rp + (unsigned)loff); } }
            if (!pf_done) { pf_done = true; if (tok + 2 * step + 1 < T_TOK) U_PREFETCH(tok + 2 * step); }
#pragma unroll
            for (int b = 0; b < 2; ++b) if (i + 8 * b < nc) {
                float p[8];
                f32x4 accj[8];
                const int base0 = i + 8 * b;
                if (base0 + 8 <= c1) {
#pragma unroll
                    for (int j = 0; j < 8; ++j) accj[j] = __builtin_amdgcn_mfma_f32_16x16x32_fp8_fp8(lo64(row[b][j]), lo64(xA), (f32x4){0.f, 0.f, 0.f, 0.f}, 0, 0, 0);
#pragma unroll
                    for (int j = 0; j < 8; ++j) accj[j] = __builtin_amdgcn_mfma_f32_16x16x32_fp8_fp8(hi64(row[b][j]), hi64(xA), accj[j], 0, 0, 0);
                } else if (base0 >= c1) {
#pragma unroll
                    for (int j = 0; j < 8; ++j) accj[j] = __builtin_amdgcn_mfma_f32_16x16x32_fp8_fp8(lo64(row[b][j]), lo64(xB), (f32x4){0.f, 0.f, 0.f, 0.f}, 0, 0, 0);
#pragma unroll
                    for (int j = 0; j < 8; ++j) accj[j] = __builtin_amdgcn_mfma_f32_16x16x32_fp8_fp8(hi64(row[b][j]), hi64(xB), accj[j], 0, 0, 0);
                } else {
#pragma unroll
                    for (int j = 0; j < 8; ++j) { const u32x4 xs = (base0 + j >= c1) ? xB : xA; accj[j] = __builtin_amdgcn_mfma_f32_16x16x32_fp8_fp8(lo64(row[b][j]), lo64(xs), (f32x4){0.f, 0.f, 0.f, 0.f}, 0, 0, 0);
                        accj[j] = __builtin_amdgcn_mfma_f32_16x16x32_fp8_fp8(hi64(row[b][j]), hi64(xs), accj[j], 0, 0, 0); }
                }
#pragma unroll
                for (int j = 0; j < 8; ++j) p[j] = __builtin_fmaf(accj[j][3], dw3, __builtin_fmaf(accj[j][2], dw2, __builtin_fmaf(accj[j][1], dw1, accj[j][0] * dw0)));
                float q4[4], q2[2], q1;
#pragma unroll
                for (int j = 0; j < 4; ++j) { const float keep = b5 ? p[4 + j] : p[j], send = b5 ? p[j] : p[4 + j]; q4[j] = keep + __shfl_xor(send, 32); }
#pragma unroll
                for (int j = 0; j < 2; ++j) { const float keep = b4 ? q4[2 + j] : q4[j], send = b4 ? q4[j] : q4[2 + j]; q2[j] = keep + __shfl_xor(send, 16); }
                { const float keep = b3 ? q2[1] : q2[0], send = b3 ? q2[0] : q2[1]; q1 = keep + __shfl_xor(send, 8); }
                q1 = DPP_ADD(q1, 0xB1); q1 = DPP_ADD(q1, 0x4E); q1 = DPP_ADD(q1, 0x141);
                const float t = __builtin_bit_cast(float, __builtin_amdgcn_ds_bpermute((l & 7) * 32, __builtin_bit_cast(int, q1)));
                const int base = i + 8 * b;
                if ((l >> 3) == ((base - cb) >> 3)) tot = t;
            }
        }
        if (!pf_done) { if (tok + 2 * step + 1 < T_TOK) U_PREFETCH(tok + 2 * step); }
        if (fv) { const int tk = (ent & 128) ? tokB : tokA; AK[(size_t)tk * 128 + (ent & 127)] = gelu_tanh(tot * su * (1.f / 16.f)) * gt * sv; }
        if (n == 0) break;
        }
        LDS_WAIT(); asm volatile("" ::: "memory");
    }
#undef U_PREFETCH
}
template <int MODE>
__device__ __forceinline__ void peer_u_phase1(const Frame& F, const Args& A) {
    const unsigned char* X8 = A.ws + WS_P + P_X8;
    const unsigned char* U8 = A.ws + WS_U8; const float* SU = (const float*)(A.ws + WS_SU); const float* SV = (const float*)(A.ws + WS_SV);
    const int* IDX = (const int*)(A.ws + WS_P + P_IDX); const float* GATE = (const float*)(A.ws + WS_P + P_GATE); float* AK = (float*)(MODE == 0 ? A.ws + WS_AK : A.ws + WS_P + P_SC);
    const int g = F.bid & (UNG - 1), nmem = F.G >> UNG_SH, l = F.lane, step = nmem * NWAVES;
    const int loff = 64 * (l & 15) + 16 * (l >> 4);
    const bool dg = ((l & 15) >> 2) == (l >> 4); const int dr = l & 3;
    const float dw0 = (dg && dr == 0) ? 1.f : 0.f, dw1 = (dg && dr == 1) ? 1.f : 0.f, dw2 = (dg && dr == 2) ? 1.f : 0.f, dw3 = (dg && dr == 3) ? 1.f : 0.f;
    LAS int* le = (LAS int*)(F.lds + F.wave * 2048); LAS int* lk = le + 256;
    const bool b5 = (l & 32) != 0, b4 = (l & 16) != 0, b3 = (l & 8) != 0;
    int tok = (F.bid >> UNG_SH) * NWAVES + F.wave;
    u32x4 nxA; int neA0, neA1; float ngA0, ngA1;
#define U1_PREFETCH(t) do { const size_t _tA = (size_t)(t); nxA = *(const u32x4*)(X8 + _tA * 1024 + loff); \
        neA0 = IDX[_tA * 128 + l]; neA1 = IDX[_tA * 128 + 64 + l]; ngA0 = GATE[_tA * 128 + l]; ngA1 = GATE[_tA * 128 + 64 + l]; } while (0)
    if (tok < T_TOK) U1_PREFETCH(tok);
    for (; tok < T_TOK; tok += step) {
        const u32x4 xA = nxA;
        const int eA0 = neA0, eA1 = neA1; const float gA0 = ngA0, gA1 = ngA1;
        bool pf_done = false;
        const bool oA0 = (eA0 & (UNG - 1)) == g, oA1 = (eA1 & (UNG - 1)) == g;
        const unsigned long long mA0 = __ballot(oA0), mA1 = __ballot(oA1);
        const int c0 = __popcll(mA0), n = c0 + __popcll(mA1);
#define MBC(m) __builtin_amdgcn_mbcnt_hi((unsigned)((m) >> 32), __builtin_amdgcn_mbcnt_lo((unsigned)(m), 0u))
        if (oA0) { const int p = MBC(mA0); le[p] = (eA0 << 8) | l; lk[p] = __builtin_bit_cast(int, gA0); }
        if (oA1) { const int p = c0 + MBC(mA1); le[p] = (eA1 << 8) | (64 + l); lk[p] = __builtin_bit_cast(int, gA1); }
#undef MBC
        LDS_WAIT(); asm volatile("" ::: "memory");
        for (int cb = 0; cb < n || cb == 0; cb += 64) {
        const int nc = min(n, cb + 64);
        const bool fv = (cb + l) < nc;
        const int ent = fv ? le[cb + l] : 0; const float gt = fv ? __builtin_bit_cast(float, lk[cb + l]) : 0.f; float tot = 0.f;
        const float su = SU[ent >> 8], sv = SV[ent >> 8];
        const unsigned long long radr = (unsigned long long)(U8 + (size_t)(((ent >> 8) & (UNG - 1)) * (NEXP / UNG) + ((ent >> 8) >> UNG_SH)) * 1024);
        const int ralo = (int)(unsigned)radr, rahi = (int)(unsigned)(radr >> 32);
        for (int i = cb; i < nc; i += 16) {
            u32x4 row[2][8];
#pragma unroll
            for (int b = 0; b < 2; ++b) if (i + 8 * b < nc) {
#pragma unroll
                for (int j = 0; j < 8; ++j) { const int ln = min(i + 8 * b + j, nc - 1) - cb;
                    const unsigned lo = (unsigned)__builtin_amdgcn_readlane(ralo, ln), hi = (unsigned)__builtin_amdgcn_readlane(rahi, ln);
                    const GAS unsigned char* rp = (const GAS unsigned char*)(((unsigned long long)hi << 32) | lo);
                    row[b][j] = *(const GAS u32x4*)(rp + (unsigned)loff); } }
            if (!pf_done) { pf_done = true; if (tok + step < T_TOK) U1_PREFETCH(tok + step); }
#pragma unroll
            for (int b = 0; b < 2; ++b) if (i + 8 * b < nc) {
                float p[8]; f32x4 accj[8];
#pragma unroll
                for (int j = 0; j < 8; ++j) accj[j] = __builtin_amdgcn_mfma_f32_16x16x32_fp8_fp8(lo64(row[b][j]), lo64(xA), (f32x4){0.f, 0.f, 0.f, 0.f}, 0, 0, 0);
#pragma unroll
                for (int j = 0; j < 8; ++j) accj[j] = __builtin_amdgcn_mfma_f32_16x16x32_fp8_fp8(hi64(row[b][j]), hi64(xA), accj[j], 0, 0, 0);
#pragma unroll
                for (int j = 0; j < 8; ++j) p[j] = __builtin_fmaf(accj[j][3], dw3, __builtin_fmaf(accj[j][2], dw2, __builtin_fmaf(accj[j][1], dw1, accj[j][0] * dw0)));
                float q4[4], q2[2], q1;
#pragma unroll
                for (int j = 0; j < 4; ++j) { const float keep = b5 ? p[4 + j] : p[j], send = b5 ? p[j] : p[4 + j]; q4[j] = keep + __shfl_xor(send, 32); }
#pragma unroll
                for (int j = 0; j < 2; ++j) { const float keep = b4 ? q4[2 + j] : q4[j], send = b4 ? q4[j] : q4[2 + j]; q2[j] = keep + __shfl_xor(send, 16); }
                { const float keep = b3 ? q2[1] : q2[0], send = b3 ? q2[0] : q2[1]; q1 = keep + __shfl_xor(send, 8); }
                q1 = DPP_ADD(q1, 0xB1); q1 = DPP_ADD(q1, 0x4E); q1 = DPP_ADD(q1, 0x141);
                const float t = __builtin_bit_cast(float, __builtin_amdgcn_ds_bpermute((l & 7) * 32, __builtin_bit_cast(int, q1)));
                const int base = i + 8 * b;
                if ((l >> 3) == ((base - cb) >> 3)) tot = t;
            }
        }
        if (!pf_done) { pf_done = true; if (tok + step < T_TOK) U1_PREFETCH(tok + step); }
        if (fv) AK[(size_t)tok * 128 + (ent & 127)] = gelu_tanh(tot * su * (1.f / 16.f)) * gt * sv;
        if (n == 0) break;
        }
        LDS_WAIT(); asm volatile("" ::: "memory");
    }
#undef U1_PREFETCH
}
template <int MODE>
__device__ __forceinline__ void peer_u4_phase(const Frame& F, const Args& A) {
    const unsigned char* X8 = A.ws + WS_P + P_X8;
    const float* SU = (const float*)(A.ws + WS_SU); const float* SV = (const float*)(A.ws + WS_SV);
    const int* IDX = (const int*)(A.ws + WS_P + P_IDX); const float* GATE = (const float*)(A.ws + WS_P + P_GATE); float* AK = (float*)(MODE == 0 ? A.ws + WS_AK : A.ws + WS_P + P_SC);
    const int g = F.bid & (UNG - 1), nmem = F.G >> UNG_SH, l = F.lane, step = nmem * NWAVES;
    const int m = l & 15, q = l >> 4;
    const GAS unsigned char* ub = (const GAS unsigned char*)(A.ws + WS_U8 + (size_t)g * (NEXP / UNG) * 512);
    const unsigned lconst = 16u * (unsigned)(4 * (m & 7) + q);
    const int xoff = 128 * (m & 7) + 16 * q;
    const bool dg = (m < 8) && ((m >> 2) == (q & 1)); const int dr = m & 3;
    const float dw0 = (dg && dr == 0) ? 1.f : 0.f, dw1 = (dg && dr == 1) ? 1.f : 0.f, dw2 = (dg && dr == 2) ? 1.f : 0.f, dw3 = (dg && dr == 3) ? 1.f : 0.f;
    const int rsel = 4 * (m >> 3);
    const int osrc = 4 * (32 * (l & 1) + 4 * ((l & 15) >> 1));
    const int sc1 = 0x7F7F7F7F;
    LAS int* le = (LAS int*)(F.lds + F.wave * 2048); LAS int* lk = le + 256;
    const bool b4 = (l & 16) != 0, b3 = (l & 8) != 0, b2 = (l & 4) != 0;
    int tok = (F.bid >> UNG_SH) * NWAVES + F.wave;
    u32x4 nx0, nx1; int ne0, ne1; float ng0, ng1;
#define U4_PREFETCH(t) do { const size_t _t = (size_t)(t); nx0 = *(const u32x4*)(X8 + _t * 1024 + xoff); nx1 = *(const u32x4*)(X8 + _t * 1024 + xoff + 64); \
        ne0 = IDX[_t * 128 + l]; ne1 = IDX[_t * 128 + 64 + l]; ng0 = GATE[_t * 128 + l]; ng1 = GATE[_t * 128 + 64 + l]; } while (0)
    if (tok < T_TOK) U4_PREFETCH(tok);
    for (; tok < T_TOK; tok += step) {
        const i32x8 xb = __builtin_shufflevector(__builtin_bit_cast(i32x4, nx0), __builtin_bit_cast(i32x4, nx1), 0, 1, 2, 3, 4, 5, 6, 7);
        const int e0 = ne0, e1 = ne1; const float g0 = ng0, g1 = ng1;
        bool pf_done = false;
        const bool o0 = (e0 & (UNG - 1)) == g, o1 = (e1 & (UNG - 1)) == g;
        const unsigned long long m0 = __ballot(o0), m1 = __ballot(o1);
        const int c0 = __popcll(m0), n = c0 + __popcll(m1);
#define MBC(mm) __builtin_amdgcn_mbcnt_hi((unsigned)((mm) >> 32), __builtin_amdgcn_mbcnt_lo((unsigned)(mm), 0u))
        if (o0) { const int p = MBC(m0); le[p] = (e0 << 8) | l; lk[p] = __builtin_bit_cast(int, g0); }
        if (o1) { const int p = c0 + MBC(m1); le[p] = (e1 << 8) | (64 + l); lk[p] = __builtin_bit_cast(int, g1); }
#undef MBC
        LDS_WAIT(); asm volatile("" ::: "memory");
        for (int cb = 0; cb < n || cb == 0; cb += 64) {
            const int nc = min(n, cb + 64);
            const bool fv = (cb + l) < nc;
            const int ent = fv ? le[cb + l] : 0; const float gt = fv ? __builtin_bit_cast(float, lk[cb + l]) : 0.f; float tot = 0.f;
            const float su = SU[ent >> 8], sv = SV[ent >> 8];
            const int roff = fv ? ((ent >> 8) >> UNG_SH) * 512 : 0;
            for (int i = cb; i < nc; i += 32) {
                u32x4 row[2][8];
#pragma unroll
                for (int b = 0; b < 2; ++b) if (i + 16 * b < nc) {
#pragma unroll
                    for (int j = 0; j < 8; ++j) { const int ro = __builtin_amdgcn_ds_bpermute(rsel + 4 * (i - cb + 16 * b + 2 * j), roff);
                        row[b][j] = *(const GAS u32x4*)(ub + ((unsigned)ro + lconst)); } }
                if (!pf_done) { pf_done = true; if (tok + step < T_TOK) U4_PREFETCH(tok + step); }
#pragma unroll
                for (int b = 0; b < 2; ++b) if (i + 16 * b < nc) {
                    float p[8];
#pragma unroll
                    for (int j = 0; j < 8; ++j) { const i32x4 r4 = __builtin_bit_cast(i32x4, row[b][j]);
                        const f32x4 d = __builtin_amdgcn_mfma_scale_f32_16x16x128_f8f6f4(__builtin_shufflevector(r4, r4, 0, 1, 2, 3, -1, -1, -1, -1), xb, (f32x4){0.f, 0.f, 0.f, 0.f}, 4, 0, 0, sc1, 0, sc1);
                        p[j] = __builtin_fmaf(d[3], dw3, __builtin_fmaf(d[2], dw2, __builtin_fmaf(d[1], dw1, d[0] * dw0))); }
                    float q4[4], q2[2], q1;
#pragma unroll
                    for (int j = 0; j < 4; ++j) { const float keep = b4 ? p[4 + j] : p[j], send = b4 ? p[j] : p[4 + j]; q4[j] = keep + __shfl_xor(send, 16); }
#pragma unroll
                    for (int j = 0; j < 2; ++j) { const float keep = b3 ? q4[2 + j] : q4[j], send = b3 ? q4[j] : q4[2 + j]; q2[j] = keep + __shfl_xor(send, 8); }
                    { const float keep = b2 ? q2[1] : q2[0], send = b2 ? q2[0] : q2[1]; q1 = keep + __shfl_xor(send, 4); }
                    q1 = DPP_ADD(q1, 0xB1); q1 = DPP_ADD(q1, 0x4E);
                    const float t = __builtin_bit_cast(float, __builtin_amdgcn_ds_bpermute(osrc, __builtin_bit_cast(int, q1)));
                    if ((l >> 4) == ((i - cb + 16 * b) >> 4)) tot = t;
                }
            }
            if (!pf_done) { pf_done = true; if (tok + step < T_TOK) U4_PREFETCH(tok + step); }
            if (fv) AK[(size_t)tok * 128 + (ent & 127)] = gelu_tanh(tot * su * (1.f / 16.f)) * gt * sv;
            if (n == 0) break;
        }
        LDS_WAIT(); asm volatile("" ::: "memory");
    }
#undef U4_PREFETCH
}
template <int MODE>
__device__ __forceinline__ void peer_u4_all(const Frame& F, const Args& A) {
    const unsigned char* X8 = A.ws + WS_P + P_X8;
    const float* SU = (const float*)(A.ws + WS_SU); const float* SV = (const float*)(A.ws + WS_SV);
    const int* IDX = (const int*)(A.ws + WS_P + P_IDX); const float* GATE = (const float*)(A.ws + WS_P + P_GATE); float* AK = (float*)(MODE == 0 ? A.ws + WS_AK : A.ws + WS_P + P_SC);
    const int l = F.lane, step = F.G * NWAVES;
    const int m = l & 15, q = l >> 4;
    const GAS unsigned char* ub = (const GAS unsigned char*)(A.ws + WS_U8);
    const unsigned lconst = 16u * (unsigned)(8 * q + (m & 7));
    const int xoff = 256 * (q >> 1) + 32 * (m & 7) + 16 * (q & 1);
    const bool dg = (m < 8) && ((m >> 2) == (q & 1)); const int dr = m & 3;
    const float dw0 = (dg && dr == 0) ? 1.f : 0.f, dw1 = (dg && dr == 1) ? 1.f : 0.f, dw2 = (dg && dr == 2) ? 1.f : 0.f, dw3 = (dg && dr == 3) ? 1.f : 0.f;
    const int rsel = 4 * (m >> 3);
    const int osrc = 4 * (32 * (l & 1) + 4 * ((l & 15) >> 1));
    const int sc1 = 0x7F7F7F7F;
    const bool b4 = (l & 16) != 0, b3 = (l & 8) != 0, b2 = (l & 4) != 0;
    const int lhi = l >> 4;
    int tok = F.bid * NWAVES + F.wave;
    u32x4 nx0, nx1; int ne0, ne1; float ng0, ng1;
#define UA_PREFETCH(t) do { const size_t _t = (size_t)(t); nx0 = *(const u32x4*)(X8 + _t * 1024 + xoff); nx1 = *(const u32x4*)(X8 + _t * 1024 + xoff + 512); \
        ne0 = IDX[_t * 128 + l]; ne1 = IDX[_t * 128 + 64 + l]; ng0 = GATE[_t * 128 + l]; ng1 = GATE[_t * 128 + 64 + l]; } while (0)
#define UA_LOADS(R, ro_, h) do { _Pragma("unroll") for (int j_ = 0; j_ < 16; ++j_) { const int o_ = __builtin_amdgcn_ds_bpermute(rsel + 4 * (32 * (h) + 2 * j_), (ro_)); \
        R[j_] = *(const GAS u32x4*)(ub + ((unsigned)o_ + lconst)); } } while (0)
#define UA_COMPUTE(R, xb_, h, tot_) do { _Pragma("unroll") for (int b_ = 0; b_ < 2; ++b_) { float p_[8]; \
        _Pragma("unroll") for (int j_ = 0; j_ < 8; ++j_) { const i32x4 r4_ = __builtin_bit_cast(i32x4, R[8 * b_ + j_]); \
            const f32x4 d_ = __builtin_amdgcn_mfma_scale_f32_16x16x128_f8f6f4(__builtin_shufflevector(r4_, r4_, 0, 1, 2, 3, -1, -1, -1, -1), (xb_), (f32x4){0.f, 0.f, 0.f, 0.f}, 4, 0, 0, sc1, 0, sc1); \
            p_[j_] = __builtin_fmaf(d_[3], dw3, __builtin_fmaf(d_[2], dw2, __builtin_fmaf(d_[1], dw1, d_[0] * dw0))); } \
        float q4_[4], q2_[2], q1_; \
        _Pragma("unroll") for (int j_ = 0; j_ < 4; ++j_) { const float keep_ = b4 ? p_[4 + j_] : p_[j_], send_ = b4 ? p_[j_] : p_[4 + j_]; q4_[j_] = keep_ + __shfl_xor(send_, 16); } \
        _Pragma("unroll") for (int j_ = 0; j_ < 2; ++j_) { const float keep_ = b3 ? q4_[2 + j_] : q4_[j_], send_ = b3 ? q4_[j_] : q4_[2 + j_]; q2_[j_] = keep_ + __shfl_xor(send_, 8); } \
        { const float keep_ = b2 ? q2_[1] : q2_[0], send_ = b2 ? q2_[0] : q2_[1]; q1_ = keep_ + __shfl_xor(send_, 4); } \
        q1_ = DPP_ADD(q1_, 0xB1); q1_ = DPP_ADD(q1_, 0x4E); \
        const float t_ = __builtin_bit_cast(float, __builtin_amdgcn_ds_bpermute(osrc, __builtin_bit_cast(int, q1_))); \
        if (lhi == 2 * (h) + b_) (tot_) = t_; } } while (0)
    u32x4 RA[16], RB[16];
    if (tok < T_TOK) { UA_PREFETCH(tok); UA_LOADS(RA, ne0 * 512, 0); }
    for (; tok < T_TOK; tok += step) {
        const i32x8 xb = __builtin_shufflevector(__builtin_bit_cast(i32x4, nx0), __builtin_bit_cast(i32x4, nx1), 0, 1, 2, 3, 4, 5, 6, 7);
        const int e0 = ne0, e1 = ne1; const float g0 = ng0, g1 = ng1;
        const int ro0 = e0 * 512, ro1 = e1 * 512;
        const float su0 = SU[e0], sv0 = SV[e0], su1 = SU[e1], sv1 = SV[e1];
        const bool more = tok + step < T_TOK;
        float tot0 = 0.f, tot1 = 0.f;
        UA_LOADS(RB, ro0, 1);
        if (more) UA_PREFETCH(tok + step);
        UA_COMPUTE(RA, xb, 0, tot0);
        UA_LOADS(RA, ro1, 0);
        UA_COMPUTE(RB, xb, 1, tot0);
        UA_LOADS(RB, ro1, 1);
        UA_COMPUTE(RA, xb, 0, tot1);
        if (more) UA_LOADS(RA, ne0 * 512, 0);
        UA_COMPUTE(RB, xb, 1, tot1);
        AK[(size_t)tok * 128 + l] = gelu_tanh(tot0 * su0 * (1.f / 16.f)) * g0 * sv0;
        AK[(size_t)tok * 128 + 64 + l] = gelu_tanh(tot1 * su1 * (1.f / 16.f)) * g1 * sv1;
    }
#undef UA_PREFETCH
#undef UA_LOADS
#undef UA_COMPUTE
}
__device__ __forceinline__ float wave_max_nonneg(float v) {
    unsigned u = __builtin_bit_cast(unsigned, v);
    u = max(u, (unsigned)__builtin_amdgcn_mov_dpp((int)u, 0xB1, 0xf, 0xf, true));
    u = max(u, (unsigned)__builtin_amdgcn_mov_dpp((int)u, 0x4E, 0xf, 0xf, true));
    u = max(u, (unsigned)__builtin_amdgcn_mov_dpp((int)u, 0x141, 0xf, 0xf, true));
    u = max(u, (unsigned)__builtin_amdgcn_mov_dpp((int)u, 0x140, 0xf, 0xf, true));
    const unsigned a = (unsigned)__builtin_amdgcn_readlane((int)u, 0), b = (unsigned)__builtin_amdgcn_readlane((int)u, 16), c = (unsigned)__builtin_amdgcn_readlane((int)u, 32), d = (unsigned)__builtin_amdgcn_readlane((int)u, 48);
    return __builtin_bit_cast(float, max(max(a, b), max(c, d)));
}
template <int MODE>
__device__ __forceinline__ void peer_v_phase(const Frame& F, const Args& A) {
    const unsigned char* V8 = A.ws + WS_V8; const int* IDX = (const int*)(A.ws + WS_P + P_IDX); const float* AK = (const float*)(A.ws + WS_AK);
    float* out = MODE == 0 ? A.out : (float*)(A.ws + WS_P + P_SC);
    const int g = F.bid & 7, nmem = F.G >> 3, l = F.lane, sub = l & 7, rr = l >> 3, n16 = l & 15, q = l >> 4, step = nmem * NWAVES;
    const GAS unsigned char* vb = (const GAS unsigned char*)(V8 + (size_t)g * NEXP * 128);
    LAS unsigned long long* rep = (LAS unsigned long long*)(F.lds + F.wave * 2048);
    const unsigned long long bm = 0xFFull << (8 * (n16 & 7));
    const int repi = 2 * q + (n16 >> 3);
    const bool vl = (n16 < 8) && (q < 2);
    LAS float* stg = (LAS float*)(F.lds + 16384 + F.wave * 512);
    int tok = 2 * ((F.bid >> 3) * NWAVES + F.wave);
    int ne[4]; float na[4];
#define V_PREFETCH(t) do { const size_t _a = (size_t)(t) * 128, _b = ((size_t)(t) + 1) * 128; ne[0] = IDX[_a + l]; ne[1] = IDX[_a + 64 + l]; ne[2] = IDX[_b + l]; ne[3] = IDX[_b + 64 + l]; \
        na[0] = AK[_a + l]; na[1] = AK[_a + 64 + l]; na[2] = AK[_b + l]; na[3] = AK[_b + 64 + l]; } while (0)
    if (tok + 1 < T_TOK) V_PREFETCH(tok);
    for (; tok + 1 < T_TOK; tok += 2 * step) {
        const int e0 = ne[0], e1 = ne[1], e2 = ne[2], e3 = ne[3]; const float a0 = na[0], a1 = na[1], a2 = na[2], a3 = na[3];
        u32x4 rowA[16], rowB[16];
#pragma unroll
        for (int i = 0; i < 16; ++i) { const int src = (8 * (i & 7) + rr) * 4;
            const int ea = __builtin_amdgcn_ds_bpermute(src, i < 8 ? e0 : e1), eb = __builtin_amdgcn_ds_bpermute(src, i < 8 ? e2 : e3);
            rowA[i] = *(const GAS u32x4*)(vb + ((unsigned)ea * 128u + 16u * (unsigned)sub)); rowB[i] = *(const GAS u32x4*)(vb + ((unsigned)eb * 128u + 16u * (unsigned)sub)); }
        f32x4 HA = {0.f, 0.f, 0.f, 0.f}, HB = {0.f, 0.f, 0.f, 0.f};
        if (l < 32) { const float* hpa = out + (size_t)tok * D + g * 128 + 4 * l; HA = *(const f32x4*)hpa; HB = *(const f32x4*)(hpa + D); }
        if (tok + 2 * step + 1 < T_TOK) V_PREFETCH(tok + 2 * step);
        const float amA = wave_max_nonneg(fmaxf(fabsf(a0), fabsf(a1))), amB = wave_max_nonneg(fmaxf(fabsf(a2), fabsf(a3)));
        const float scA = amA > 0.f ? 224.f * __builtin_amdgcn_rcpf(amA) : 0.f, invA = amA * (1.f / 224.f), scB = amB > 0.f ? 224.f * __builtin_amdgcn_rcpf(amB) : 0.f, invB = amB * (1.f / 224.f);
        { const unsigned wA = (unsigned)__builtin_amdgcn_cvt_pk_fp8_f32(a0 * scA, a1 * scA, 0, false), wB = (unsigned)__builtin_amdgcn_cvt_pk_fp8_f32(a2 * scB, a3 * scB, 0, false);
          const unsigned r0 = (wA & 0xffu) * 0x01010101u, r1 = ((wA >> 8) & 0xffu) * 0x01010101u, r2 = (wB & 0xffu) * 0x01010101u, r3 = ((wB >> 8) & 0xffu) * 0x01010101u;
          rep[l] = ((unsigned long long)r0 << 32) | r0; rep[64 + l] = ((unsigned long long)r1 << 32) | r1; rep[128 + l] = ((unsigned long long)r2 << 32) | r2; rep[192 + l] = ((unsigned long long)r3 << 32) | r3; }
        LDS_WAIT(); asm volatile("" ::: "memory");
#pragma unroll
        for (int t2 = 0; t2 < 2; ++t2) {
            f32x4 alo = {0.f, 0.f, 0.f, 0.f}, ahi = {0.f, 0.f, 0.f, 0.f};
#pragma unroll
            for (int i = 0; i < 16; ++i) { const long bop = (long)(rep[128 * t2 + 8 * i + repi] & bm); const u32x4 rw = t2 ? rowB[i] : rowA[i];
                alo = __builtin_amdgcn_mfma_f32_16x16x32_fp8_fp8(lo64(rw), bop, alo, 0, 0, 0);
                ahi = __builtin_amdgcn_mfma_f32_16x16x32_fp8_fp8(hi64(rw), bop, ahi, 0, 0, 0); }
            const float inv = t2 ? invB : invA;
            float vlo[4], vhi[4];
#pragma unroll
            for (int r = 0; r < 4; ++r) { const float tl = alo[r], th = ahi[r];
                vlo[r] = (tl + __builtin_bit_cast(float, __builtin_amdgcn_ds_bpermute(((l + 40) & 63) * 4, __builtin_bit_cast(int, tl)))) * inv;
                vhi[r] = (th + __builtin_bit_cast(float, __builtin_amdgcn_ds_bpermute(((l + 40) & 63) * 4, __builtin_bit_cast(int, th)))) * inv; }
            if (vl) {
#pragma unroll
                for (int r = 0; r < 4; ++r) { stg[64 * q + 16 * r + n16] = vlo[r]; stg[64 * q + 16 * r + n16 + 8] = vhi[r]; } }
            LDS_WAIT(); asm volatile("" ::: "memory");
            if (l < 32) { const f32x4 dv = *(const LAS f32x4*)(stg + 4 * l); *(f32x4*)(out + (size_t)(tok + t2) * D + g * 128 + 4 * l) = (t2 ? HB : HA) + dv; }
            LDS_WAIT(); asm volatile("" ::: "memory");
        }
        LDS_WAIT(); asm volatile("" ::: "memory");
    }
#undef V_PREFETCH
}
typedef float f32x16 __attribute__((ext_vector_type(16)));
template <int MODE>
__device__ __forceinline__ void peer_v4_phase(const Frame& F, const Args& A) {
    const int* IDX = (const int*)(A.ws + WS_P + P_IDX); const float* AK = (const float*)(A.ws + WS_AK);
    float* out = A.out;
    const int l = F.lane, n = l & 31, hq = l >> 5, step = F.G * NWAVES;
    const GAS unsigned char* vb = (const GAS unsigned char*)(A.ws + WS_V8);
    const unsigned lconst = 16u * (unsigned)n;
    const bool diag = ((l >> 4) & 1) == hq;
    const unsigned bytem = diag ? (0xFFu << (8 * (l & 3))) : 0u; const int dsel = (l & 15) >> 2;
    const unsigned M0 = dsel == 0 ? bytem : 0u, M1 = dsel == 1 ? bytem : 0u, M2 = dsel == 2 ? bytem : 0u, M3 = dsel == 3 ? bytem : 0u;
    const int rsel = 4 * hq;
    const int sc1 = 0x7F7F7F7F;
    const int colb = 8 * n + 4 * hq;
    int tok = F.bid * NWAVES + F.wave;
    int ne0, ne1; float na0, na1;
#define V4_PREFETCH(t) do { const size_t _t = (size_t)(t) * 128; ne0 = IDX[_t + l]; ne1 = IDX[_t + 64 + l]; na0 = AK[_t + l]; na1 = AK[_t + 64 + l]; } while (0)
#define V4_LOADS(R, ro_, h) do { int ba_ = rsel + 4 * (16 * (h)); _Pragma("unroll") for (int j_ = 0; j_ < 8; ++j_) { asm volatile("" : "+v"(ba_)); const int o_ = __builtin_amdgcn_ds_bpermute(ba_, (ro_)); ba_ += 8; \
        R[j_] = *(const GAS u32x4*)(vb + ((unsigned)o_ + lconst)); } } while (0)
#define V4_ONE(ACC, R, rep_, h, j_) do { unsigned s0_ = (unsigned)__builtin_amdgcn_readlane((int)(rep_), 16 * (h) + 2 * (j_)), s1_ = (unsigned)__builtin_amdgcn_readlane((int)(rep_), 16 * (h) + 2 * (j_) + 1); \
        asm volatile("" : "+s"(s0_), "+s"(s1_), "+v"(ACC)); \
        const i32x8 a8_ = {(int)(s0_ & M0), (int)(s0_ & M1), (int)(s0_ & M2), (int)(s0_ & M3), (int)(s1_ & M0), (int)(s1_ & M1), (int)(s1_ & M2), (int)(s1_ & M3)}; \
        const i32x4 r4_ = __builtin_bit_cast(i32x4, R[j_]); \
        ACC = __builtin_amdgcn_mfma_scale_f32_32x32x64_f8f6f4(a8_, __builtin_shufflevector(r4_, r4_, 0, 1, 2, 3, -1, -1, -1, -1), ACC, 0, 4, 0, sc1, 0, sc1); } while (0)
#define V4_COMPUTE(R, rep_, h) do { V4_ONE(acc, R, rep_, h, 0); V4_ONE(acc1, R, rep_, h, 1); V4_ONE(acc, R, rep_, h, 2); V4_ONE(acc1, R, rep_, h, 3); \
        V4_ONE(acc, R, rep_, h, 4); V4_ONE(acc1, R, rep_, h, 5); V4_ONE(acc, R, rep_, h, 6); V4_ONE(acc1, R, rep_, h, 7); } while (0)
    u32x4 RA[8], RB[8];
    if (tok < T_TOK) { V4_PREFETCH(tok); V4_LOADS(RA, ne0 * 512, 0); }
    for (; tok < T_TOK; tok += step) {
        const int e0 = ne0, e1 = ne1; const float a0 = na0, a1 = na1;
        const int ro0 = e0 * 512, ro1 = e1 * 512;
        const bool more = tok + step < T_TOK;
        V4_LOADS(RB, ro0, 1);
        if (more) V4_PREFETCH(tok + step);
        const float am = wave_max_nonneg(fmaxf(fabsf(a0), fabsf(a1)));
        const float sc = am > 0.f ? 224.f * __builtin_amdgcn_rcpf(am) : 0.f, inv = am * (1.f / 224.f);
        const unsigned w8 = (unsigned)__builtin_amdgcn_cvt_pk_fp8_f32(a0 * sc, a1 * sc, 0, false);
        const unsigned rep0 = (w8 & 0xffu) * 0x01010101u, rep1 = ((w8 >> 8) & 0xffu) * 0x01010101u;
        f32x16 acc, acc1;
#pragma unroll
        for (int i = 0; i < 16; ++i) { acc[i] = 0.f; acc1[i] = 0.f; }
        V4_COMPUTE(RA, rep0, 0); V4_LOADS(RA, ro0, 2);
        V4_COMPUTE(RB, rep0, 1); V4_LOADS(RB, ro0, 3);
        V4_COMPUTE(RA, rep0, 2); V4_LOADS(RA, ro1, 0);
        V4_COMPUTE(RB, rep0, 3); V4_LOADS(RB, ro1, 1);
        V4_COMPUTE(RA, rep1, 0); V4_LOADS(RA, ro1, 2);
        V4_COMPUTE(RB, rep1, 1); V4_LOADS(RB, ro1, 3);
        f32x4 H[4];
        u32x2 MX[4];
        { const bf16_t* mp = (const bf16_t*)(A.ws + WS_P + P_HB) + (size_t)tok * D + colb;
#pragma unroll
          for (int j = 0; j < 4; ++j) MX[j] = *(const u32x2*)(mp + 256 * j); }
        V4_COMPUTE(RA, rep1, 2);
        if (more) V4_LOADS(RA, ne0 * 512, 0);
        V4_COMPUTE(RB, rep1, 3);
        acc = acc + acc1;
        float ss = 0.f;
#pragma unroll
        for (int j = 0; j < 4; ++j) { H[j] = (f32x4){bflo(MX[j].x), bfhi(MX[j].x), bflo(MX[j].y), bfhi(MX[j].y)} + (f32x4){acc[4 * j], acc[4 * j + 1], acc[4 * j + 2], acc[4 * j + 3]} * inv;
            ss += (H[j].x * H[j].x + H[j].y * H[j].y) + (H[j].z * H[j].z + H[j].w * H[j].w); }
        const float rstd = 1.f / sqrtf(wave_sum(ss) * (1.f / D) + EPS);
        { float* hp = out + (size_t)tok * D + colb;
#pragma unroll
          for (int j = 0; j < 4; ++j) *(f32x4*)(hp + 256 * j) = H[j] * rstd * *(const f32x4*)(A.in[I_FG] + colb + 256 * j); }
    }
#undef V4_PREFETCH
#undef V4_LOADS
#undef V4_COMPUTE
#undef V4_ONE
}
__device__ __forceinline__ void final_norm_phase(const Frame& F, const Args& A) {
    const int gw = F.bid * NWAVES + F.wave, NGW = F.G * NWAVES, l = F.lane; const float* fg = A.in[I_FG];
    const f32x4* gp = (const f32x4*)fg + l;
    int tok = gw;
    for (; tok + 3 * NGW < T_TOK; tok += 4 * NGW) {
        f32x4 v[4][4]; float ss[4];
#pragma unroll
        for (int b = 0; b < 4; ++b) { const f32x4* hp = (const f32x4*)(A.out + (size_t)(tok + b * NGW) * D) + l;
#pragma unroll
            for (int j = 0; j < 4; ++j) v[b][j] = hp[64 * j]; }
#pragma unroll
        for (int b = 0; b < 4; ++b) { ss[b] = 0.f;
#pragma unroll
            for (int j = 0; j < 4; ++j) ss[b] += (v[b][j].x * v[b][j].x + v[b][j].y * v[b][j].y) + (v[b][j].z * v[b][j].z + v[b][j].w * v[b][j].w); }
#pragma unroll
        for (int o = 1; o < 64; o <<= 1) {
#pragma unroll
            for (int b = 0; b < 4; ++b) ss[b] += __shfl_xor(ss[b], o); }
#pragma unroll
        for (int b = 0; b < 4; ++b) { const float rstd = 1.f / sqrtf(ss[b] * (1.f / D) + EPS); f32x4* hp = (f32x4*)(A.out + (size_t)(tok + b * NGW) * D) + l;
#pragma unroll
            for (int j = 0; j < 4; ++j) hp[64 * j] = v[b][j] * rstd * gp[64 * j]; }
    }
    for (; tok < T_TOK; tok += NGW) { f32x4* hp = (f32x4*)(A.out + (size_t)tok * D) + l; f32x4 v[4]; float ss = 0.f;
#pragma unroll
        for (int j = 0; j < 4; ++j) { v[j] = hp[64 * j]; ss += (v[j].x * v[j].x + v[j].y * v[j].y) + (v[j].z * v[j].z + v[j].w * v[j].w); }
        const float rstd = 1.f / sqrtf(wave_sum(ss) * (1.f / D) + EPS);
#pragma unroll
        for (int j = 0; j < 4; ++j) hp[64 * j] = v[j] * rstd * gp[64 * j]; }
}

#ifdef DEBUG_CHECK
constexpr size_t WS_DBG = 472 * MiB;
__device__ __forceinline__ int dbg_tok(int i) { return (i * 509 + 3) & 32767; }
__device__ __forceinline__ float gelu_ref(float x) { return 0.5f * x * (1.f + tanhf(0.7978845608028654f * (x + 0.044715f * x * x * x))); }
__global__ void __launch_bounds__(512) dbg_scores(Args a) {
    __shared__ float n2s[1024]; __shared__ float q[2048];
    const int t = dbg_tok(blockIdx.x), tid = threadIdx.x;
    const bf16_t* N2 = (const bf16_t*)(a.ws + WS_N1); const float* SC = (const float*)(a.ws + WS_P + P_SC); unsigned* dbg = (unsigned*)(a.ws + WS_DBG);
    for (int k = tid; k < 1024; k += 512) n2s[k] = bf1(N2[(size_t)t * 1024 + k]);
    __syncthreads();
    for (int r = 0; r < 4; ++r) { const int c = tid + 512 * r; float s = 0.f; for (int k = 0; k < 1024; ++k) s += n2s[k] * a.in[I_WQ][(size_t)k * 2048 + c]; q[c] = s; }
    __syncthreads();
    float md = 0.f;
    for (int r = 0; r < 4; ++r) { const int n = tid + 512 * r, hh = n >> 7, key = n & 127; const float* kX = (hh & 1) ? a.in[I_K2] : a.in[I_K1];
        float s = 0.f; for (int d = 0; d < 128; ++d) s += q[hh * 128 + d] * kX[key * 128 + d];
        md = fmaxf(md, fabsf(s - SC[(size_t)n * T_TOK + t])); }
    atomicMax(&dbg[0], __builtin_bit_cast(unsigned, md));
}
__global__ void __launch_bounds__(64) dbg_topk(Args a) {
    __shared__ float s1[8][128], s2[8][128], cv[8][256]; __shared__ float t1v[8][16], t2v[8][16]; __shared__ int t1i[8][16], t2i[8][16], exi[8][16]; __shared__ float exv[8][16];
    const int t = dbg_tok(blockIdx.x), h = threadIdx.x;
    const float* SC = (const float*)(a.ws + WS_P + P_SC); const int* IDX = (const int*)(a.ws + WS_P + P_IDX); const float* GATE = (const float*)(a.ws + WS_P + P_GATE); unsigned* dbg = (unsigned*)(a.ws + WS_DBG);
    if (h >= 8) return;
    for (int j = 0; j < 128; ++j) { s1[h][j] = SC[(size_t)(h * 256 + j) * T_TOK + t]; s2[h][j] = SC[(size_t)(h * 256 + 128 + j) * T_TOK + t]; }
    for (int r = 0; r < 16; ++r) { int b1 = 0, b2 = 0; for (int j = 1; j < 128; ++j) { if (s1[h][j] > s1[h][b1]) b1 = j; if (s2[h][j] > s2[h][b2]) b2 = j; }
        t1v[h][r] = s1[h][b1]; t1i[h][r] = b1; s1[h][b1] = -1e30f; t2v[h][r] = s2[h][b2]; t2i[h][r] = b2; s2[h][b2] = -1e30f; }
    for (int c = 0; c < 256; ++c) cv[h][c] = t1v[h][c >> 4] + t2v[h][c & 15];
    for (int r = 0; r < 16; ++r) { int bc = 0; for (int c = 1; c < 256; ++c) if (cv[h][c] > cv[h][bc]) bc = c;
        exv[h][r] = cv[h][bc]; exi[h][r] = t1i[h][bc >> 4] * 128 + t2i[h][bc & 15]; cv[h][bc] = -1e30f; }
    float sum = 0.f; const float mx0 = exv[h][0]; for (int r = 0; r < 16; ++r) { exv[h][r] = expf(exv[h][r] - mx0); } for (int r = 0; r < 16; ++r) sum += exv[h][r];
    unsigned miss = 0; float gd = 0.f;
    for (int w = 0; w < 16; ++w) { const int e = IDX[(size_t)t * 128 + h * 16 + w]; const float g = GATE[(size_t)t * 128 + h * 16 + w]; bool found = false;
        for (int r = 0; r < 16; ++r) if (exi[h][r] == e) { found = true; gd = fmaxf(gd, fabsf(g - exv[h][r] / sum)); }
        if (!found) ++miss; }
    atomicAdd(&dbg[1], miss); atomicMax(&dbg[3], __builtin_bit_cast(unsigned, gd));
}
__global__ void __launch_bounds__(512) dbg_experts_pre(Args a) {
    __shared__ float n2s[1024]; __shared__ float ak[128]; __shared__ int ek[128]; __shared__ float red[8];
    const int t = dbg_tok(blockIdx.x), tid = threadIdx.x, lane = tid & 63, wave = tid >> 6;
    const bf16_t* N2 = (const bf16_t*)(a.ws + WS_N1); const int* IDX = (const int*)(a.ws + WS_P + P_IDX); const float* GATE = (const float*)(a.ws + WS_P + P_GATE);
    float* rows = (float*)(a.ws + WS_DBG + MiB);
    for (int k = tid; k < 1024; k += 512) n2s[k] = bf1(N2[(size_t)t * 1024 + k]);
    if (tid < 128) ek[tid] = IDX[(size_t)t * 128 + tid];
    __syncthreads();
    for (int k = wave * 16; k < wave * 16 + 16; ++k) { const float* u = a.in[I_PU] + (size_t)ek[k] * 1024; float s = 0.f; for (int j = lane; j < 1024; j += 64) s += u[j] * n2s[j];
        s = wave_sum(s); if (lane == 0) ak[k] = gelu_ref(s) * GATE[(size_t)t * 128 + k]; }
    __syncthreads();
    float h2[2]; float ss = 0.f;
    for (int r = 0; r < 2; ++r) { const int d = tid + 512 * r; float o = 0.f; for (int k = 0; k < 128; ++k) o += ak[k] * a.in[I_PV][(size_t)ek[k] * 1024 + d]; h2[r] = a.out[(size_t)t * 1024 + d] + o; ss += h2[r] * h2[r]; }
    ss = wave_sum(ss); if (lane == 0) red[wave] = ss; __syncthreads();
    float tot = 0.f; for (int w = 0; w < 8; ++w) tot += red[w];
    const float rstd = 1.f / sqrtf(tot / 1024.f + EPS);
    for (int r = 0; r < 2; ++r) { const int d = tid + 512 * r; rows[(size_t)blockIdx.x * 1024 + d] = h2[r] * rstd * a.in[I_FG][d]; }
}
__global__ void __launch_bounds__(512) dbg_experts_post(Args a) {
    const int t = dbg_tok(blockIdx.x), tid = threadIdx.x; const float* rows = (const float*)(a.ws + WS_DBG + MiB); float* dbgf = (float*)(a.ws + WS_DBG);
    float e = 0.f, n = 0.f;
    for (int r = 0; r < 2; ++r) { const int d = tid + 512 * r; const float x = rows[(size_t)blockIdx.x * 1024 + d], y = a.out[(size_t)t * 1024 + d]; e += (x - y) * (x - y); n += x * x; }
    e = wave_sum(e); n = wave_sum(n); if ((tid & 63) == 0) { atomicAdd(&dbgf[4], e); atomicAdd(&dbgf[5], n); }
}
__global__ void __launch_bounds__(512) dbg_report(Args a, int which) {
    const unsigned* dbg = (const unsigned*)(a.ws + WS_DBG); const float* dbgf = (const float*)(a.ws + WS_DBG);
    const float mA = dbgf[0], gd = dbgf[3]; const unsigned miss = dbg[1]; const float relC = sqrtf(dbgf[4] / fmaxf(dbgf[5], 1e-30f));
    float X;
    if (which == 0) { int mask = 0; if (mA > 0.05f) mask |= 1; if (miss > 400u) mask |= 2; if (relC > 0.05f) mask |= 4; if (gd > 0.02f) mask |= 8; X = 1000.f + 100.f * mask; }
    else if (which == 1) X = 1e6f * mA; else if (which == 2) X = 100.f + (float)miss; else if (which == 3) X = 1e6f * relC; else X = 1e6f * gd;
    for (size_t i = (size_t)blockIdx.x * 512 + threadIdx.x; i < (size_t)T_TOK * D; i += (size_t)gridDim.x * 512) a.out[i] = (i == 0) ? X : 0.f;
}
#endif

constexpr int NPH = 13;
__global__ void __launch_bounds__(NWAVES * 64, 2) fwd_kernel(Args args) {
    extern __shared__ __attribute__((aligned(16))) unsigned char lds_raw[];
    Frame F;
    F.lds = (LAS unsigned char*)lds_raw;
    F.tid = threadIdx.x; F.lane = F.tid & 63; F.wave = __builtin_amdgcn_readfirstlane(F.tid >> 6);
    F.G = gridDim.x; F.bid = blockIdx.x;
    volatile LAS unsigned* MISC = (volatile LAS unsigned*)(F.lds + MISC_OFF);
    for (int u = F.tid; u < (LDS_BYTES - LDSCTL_OFF) / 4; u += NWAVES * 64) ((LAS unsigned*)(F.lds + LDSCTL_OFF))[u] = 0u;
    __syncthreads();
    unsigned* ctl = (unsigned*)(args.ws + WS_CTL);
    const int lo = args.ph_lo, hi = args.ph_hi;
    XcdBarrier bar; bar.bar = ctl + CW_BAR + args.li * XCD_BAR_WORDS; bar.x = 0; bar.st = nullptr; bar.wave = F.wave;
    if (hi - lo > 1) bar = xcd_barrier_post(ctl + CW_BAR + args.li * XCD_BAR_WORDS, MISC + 8, F.wave);
#define IN(k) (lo <= (k) && (k) < hi)
#ifdef PROBE_TS
#define STAMP(k) do { if (F.bid == 0 && F.tid == 0) ((unsigned long long*)(args.ws + (472u << 20)))[(k)] = __builtin_amdgcn_s_memrealtime(); } while (0)
#else
#define STAMP(k) do { } while (0)
#endif
#define SEAM(k) do { if (IN(k) && IN((k) + 1)) { xcd_barrier(bar); if (XTRA_BAR) xcd_barrier(bar); } STAMP((k) + 1); } while (0)
    unsigned char* ws = args.ws;
    bf16_t* P = (bf16_t*)(ws + WS_P);

#define REFRESH() do { int z_ = 0; asm volatile("" : "+s"(z_)); F.lane = (int)__builtin_amdgcn_mbcnt_hi(~0u, __builtin_amdgcn_mbcnt_lo(~0u, (unsigned)z_)); F.tid = F.wave * 64 + F.lane; } while (0)
    STAMP(0);
    if (IN(0)) { phase0(F, args); SEAM(0); }
    if (IN(1)) { REFRESH();
        if (F8_LO > 0) { pg8::Gemm g{(const bf16_t*)(ws + WS_N1), (const bf16_t*)(ws + WS_WIN), T_TOK, F8_LO * 256, D, D}; pg8::StaticOrder S; S.init(T_TOK, F8_LO * 256, F.G, F.bid);
            pg8::EpiProj E{P, (float*)(ws + WS_ALR), 0}; pg8::gemm_phase<pg8::EpiProj, pg8::StaticOrder, false, true, false>(F.lds, g, S, E, F.wave); }
        if (F8_LO < 21) {
            pg8::Gemm g{(const bf16_t*)(ws + WS_N18), (const bf16_t*)(ws + WS_W8 + (size_t)F8_LO * 256 * 1024), T_TOK, (21 - F8_LO) * 256, D / 2, D / 2, 0x7B7B7B7B, 0x75757575};
            pg8::StaticOrder S; S.init(T_TOK, (21 - F8_LO) * 256, F.G, ((F8_LO * 128) % F.G) != 0 ? F.G - 1 - F.bid : F.bid);
            pg8::EpiProj E{P, (float*)(ws + WS_ALR), F8_LO}; pg8::gemm_phase<pg8::EpiProj, pg8::StaticOrder, false, true, true>(F.lds, g, S, E, F.wave); }
        {
            REFRESH();
            const int nwg = (T_TOK / 256) * (NPROJ / 256), rem = nwg % F.G;
            if (rem == 0) convert_tables(F, args, F.bid * NWAVES + F.wave, F.G * NWAVES);
            else if (F.bid >= rem) convert_tables(F, args, (F.bid - rem) * NWAVES + F.wave, (F.G - rem) * NWAVES);
        }
        SEAM(1);
    }
    if (IN(2)) { REFRESH();
        if (DRY_EXP == 12) { gla_chunk_phase<true>(F, args); for (int it = F.bid; it < 256; it += F.G) for (int g4 = 0; g4 < 4; ++g4) sgu_unit<true>(F, args, 4 * it + g4, g4 == 0); __syncthreads(); }
        gla_chunk_phase<false>(F, args);
        for (int it = F.bid; it < 256; it += F.G) for (int g4 = 0; g4 < 4; ++g4) sgu_unit<false>(F, args, 4 * it + g4, g4 == 0);
        SEAM(2);
    }
    if (IN(3)) { REFRESH(); if (DRY_EXP == 13 || DRY_EXP == 15) { gla_scan<true>(F, args); __syncthreads(); } gla_scan<false>(F, args); SEAM(3); }
    if (IN(4)) { REFRESH(); if (DRY_EXP == 14 || DRY_EXP == 15) { gla_out_phase<true>(F, args); __syncthreads(); } gla_out_phase<false>(F, args); SEAM(4); }
    if (IN(5)) { REFRESH();
        { pg8::Gemm g{P + PC_R, (const bf16_t*)(ws + WS_WA), T_TOK, D, 1024, PLD}; pg8::StaticOrder S; S.init(T_TOK, D, F.G, F.bid);
          pg8::EpiBrAB E{P}; pg8::gemm_phase<pg8::EpiBrAB, pg8::StaticOrder, true, true, false, true>(F.lds, g, S, E, F.wave); }
        SEAM(5);
    }
    if (IN(6)) { REFRESH();
        pg8::Gemm g{P + PC_MRG, (const bf16_t*)(ws + WS_WOUT), T_TOK, D, D, PLD}; pg8::StaticOrder S; S.init(T_TOK, D, F.G, F.bid);
        pg8::EpiOut E{(bf16_t*)(ws + WS_N1)}; pg8::gemm_phase<pg8::EpiOut, pg8::StaticOrder, true, true>(F.lds, g, S, E, F.wave);
        SEAM(6);
    }
    if (IN(7)) { REFRESH();
        const int gw = F.bid * NWAVES + F.wave, NGW = F.G * NWAVES;
        { int m = gw; for (; m + 3 * NGW < T_TOK; m += 4 * NGW) rms_rows_to_bf16<(SC_F8 ? 2 : 3), 4>(F.lane, args.in[I_X] + (size_t)m * D, (size_t)NGW * D, args.in[I_N2G], (bf16_t*)(ws + WS_P + P_N2) + (size_t)m * D, (size_t)NGW * D, (unsigned*)(ws + WS_P + P_X8) + (size_t)m * 256, (size_t)NGW * 256, (const bf16_t*)(ws + WS_N1) + (size_t)m * D, (size_t)NGW * D, (bf16_t*)(ws + WS_P + P_HB) + (size_t)m * D, (size_t)NGW * D);
          for (; m < T_TOK; m += NGW) rms_rows_to_bf16<(SC_F8 ? 2 : 3), 1>(F.lane, args.in[I_X] + (size_t)m * D, 0, args.in[I_N2G], (bf16_t*)(ws + WS_P + P_N2) + (size_t)m * D, 0, (unsigned*)(ws + WS_P + P_X8) + (size_t)m * 256, 0, (const bf16_t*)(ws + WS_N1) + (size_t)m * D, 0, (bf16_t*)(ws + WS_P + P_HB) + (size_t)m * D, 0); }
        SEAM(7);
    }
    if (IN(8)) { REFRESH();
        pg8::StaticOrder S; S.init(T_TOK, 2048, F.G, F.bid); pg8::EpiScores E{(bf16_t*)(ws + WS_P + P_SC)};
        if (SC_F8) { pg8::Gemm g{(const bf16_t*)(ws + WS_P + P_X8), (const bf16_t*)(ws + WS_WQF), T_TOK, 2048, D / 2, D / 2, 0x7B7B7B7B, 0x75757575};
            pg8::gemm_phase<pg8::EpiScores, pg8::StaticOrder, true, true, true>(F.lds, g, S, E, F.wave); }
        else { pg8::Gemm g{(const bf16_t*)(ws + WS_P + P_N2), (const bf16_t*)(ws + WS_WQF), T_TOK, 2048, D, D};
            pg8::gemm_phase<pg8::EpiScores, pg8::StaticOrder, true, true>(F.lds, g, S, E, F.wave); }
        SEAM(8);
    }
    if (IN(9)) { REFRESH(); peer_topk(F, args); SEAM(9); }
    if (IN(10)) { REFRESH(); if constexpr (UNG == 1) peer_u4_all<0>(F, args); else peer_u4_phase<0>(F, args); SEAM(10); }
    if (IN(11)) { REFRESH(); if (V_F4) peer_v4_phase<0>(F, args); else { if (DRY_EXP == 1) { peer_v_phase<1>(F, args); __syncthreads(); } peer_v_phase<0>(F, args); SEAM(11); } }
    if (IN(12)) { REFRESH(); if (!V_F4) final_norm_phase(F, args); }
#undef IN
#undef SEAM
}


#ifdef PROBE_TS
__global__ void __launch_bounds__(512) probe_report(Args a, int pi, int pj) {
    const unsigned long long* ts = (const unsigned long long*)(a.ws + (472u << 20));
    const float X1 = 10.f * (float)(ts[pi + 1] - ts[pi]) * 0.01f, X2 = (float)(ts[pj + 1] - ts[pj]) * 0.01f;
    for (size_t i = (size_t)blockIdx.x * 512 + threadIdx.x; i < (size_t)T_TOK * D; i += (size_t)gridDim.x * 512) a.out[i] = (i == 0) ? X1 : X2;
}
#endif
#ifdef PROBE_MFMA
__global__ void __launch_bounds__(64) probe_mfma(Args a) {
    const int l = threadIdx.x;
    i32x4 av = {0, 0, 0, 0};
    if (l == PROBE_L) av[PROBE_P >> 3] = 0x2 << (4 * (PROBE_P & 7));
    i32x8 b1, b2;
    for (int r = 0; r < 8; ++r) { unsigned w1 = 0, w2 = 0;
        for (int c = 0; c < 4; ++c) { const int b = 4 * r + c; int t = 0;
            t = __builtin_amdgcn_cvt_pk_fp8_f32((float)((b & 15) + 1), (float)(1 + (b >> 4) + 2 * (l >> 4)), 0, false);
            w1 |= ((unsigned)t & 0xffu) << (8 * c); w2 |= (((unsigned)t >> 8) & 0xffu) << (8 * c); }
        b1[r] = (int)w1; b2[r] = (int)w2; }
    const f32x4 z = {0.f, 0.f, 0.f, 0.f};
    const f32x4 d1 = __builtin_amdgcn_mfma_scale_f32_16x16x128_f8f6f4(__builtin_shufflevector(av, av, 0, 1, 2, 3, -1, -1, -1, -1), b1, z, 4, 0, 0, 0x7F7F7F7F, 0, 0x7F7F7F7F);
    const f32x4 d2 = __builtin_amdgcn_mfma_scale_f32_16x16x128_f8f6f4(__builtin_shufflevector(av, av, 0, 1, 2, 3, -1, -1, -1, -1), b2, z, 4, 0, 0, 0x7F7F7F7F, 0, 0x7F7F7F7F);
    float* st = (float*)(a.ws + (472u << 20));
    *(f32x4*)(st + 8 * l) = d1; *(f32x4*)(st + 8 * l + 4) = d2;
}
__global__ void __launch_bounds__(512) probe_mfma_report(Args a) {
    const int row = PROBE_L & 15;
    const float* st = (const float*)(a.ws + (472u << 20)) + 8 * (16 * (row >> 2)) + (row & 3); const float X1 = 10.f * st[0], X2 = st[4];
    for (size_t i = (size_t)blockIdx.x * 512 + threadIdx.x; i < (size_t)T_TOK * D; i += (size_t)gridDim.x * 512) a.out[i] = (i == 0) ? X1 : X2;
}
#endif
extern "C" void kernel_launch(void* const* d_in, const int* in_sizes, int n_in, void* d_out, int out_size, void* d_ws, size_t ws_size, hipStream_t stream) {
    static int grid = 0;
    if (grid == 0) {
        if (n_in != 20 || in_sizes[0] != T_TOK * D || out_size != T_TOK * D || ws_size < WS_END) {
            fprintf(stderr, "kernel_launch: unexpected shapes: n_in %d in0 %d out %d ws %zu (need %zu)\n", n_in, n_in > 0 ? in_sizes[0] : -1, out_size, ws_size, (size_t)WS_END); grid = -1; return; }
        int dev = 0, cus = 0;
        if (hipGetDevice(&dev) != hipSuccess || hipDeviceGetAttribute(&cus, hipDeviceAttributeMultiprocessorCount, dev) != hipSuccess) { grid = -1; return; }
        if (hipFuncSetAttribute((const void*)fwd_kernel, hipFuncAttributeMaxDynamicSharedMemorySize, LDS_BYTES) != hipSuccess) { fprintf(stderr, "kernel_launch: hipFuncSetAttribute failed\n"); grid = -1; return; }
        int per_cu = 0;
        if (hipOccupancyMaxActiveBlocksPerMultiprocessor(&per_cu, (const void*)fwd_kernel, NWAVES * 64, LDS_BYTES) != hipSuccess || per_cu < 1) fprintf(stderr, "kernel_launch: occupancy query says %d\n", per_cu);
        (void)hipGetLastError();
        grid = cus;
    }
    if (grid < 0) return;
    (void)hipMemsetAsync((char*)d_ws + WS_CTL, 0, CTL_ZERO_BYTES, stream);
    Args a{};
    for (int i = 0; i < 20; ++i) a.in[i] = (const float*)d_in[i];
    a.out = (float*)d_out; a.ws = (unsigned char*)d_ws;
#ifdef PROBE_MFMA
    hipLaunchKernelGGL(probe_mfma, dim3(1), dim3(64), 0, stream, a);
    hipLaunchKernelGGL(probe_mfma_report, dim3(1024), dim3(512), 0, stream, a);
    return;
#endif
#ifndef LAUNCH_LIST
#define LAUNCH_LIST {0, NPH}
#endif
    static const int ranges[][2] = { LAUNCH_LIST };
    const int nl = (int)(sizeof(ranges) / sizeof(ranges[0]));
    for (int li = 0; li < nl; ++li) { a.ph_lo = ranges[li][0]; a.ph_hi = ranges[li][1]; a.li = li;
        hipLaunchKernelGGL(fwd_kernel, dim3(grid), dim3(NWAVES * 64), LDS_BYTES, stream, a); }
}
```

```cpp
#include <hip/hip_runtime.h>
#include <cstdio>
#include <cstdint>


#ifndef XTRA_BAR
#define XTRA_BAR 0
#endif
#ifndef DRY_EXP
#define DRY_EXP 0
#endif
#ifndef DUP_PHASE
#define DUP_PHASE -1
#endif
#ifndef MK_N_LAUNCHES
#define MK_N_LAUNCHES 1
#endif

#define LAS __attribute__((address_space(3)))
#define GAS __attribute__((address_space(1)))
typedef unsigned short bf16_t;
typedef short bf16x8 __attribute__((ext_vector_type(8)));
typedef float f32x4 __attribute__((ext_vector_type(4)));
typedef float f32x2 __attribute__((ext_vector_type(2)));
typedef unsigned u32x4 __attribute__((ext_vector_type(4)));
typedef unsigned u32x2 __attribute__((ext_vector_type(2)));
typedef int i32x4 __attribute__((ext_vector_type(4)));
typedef int i32x8 __attribute__((ext_vector_type(8)));
typedef __bf16 bf16x2_t __attribute__((ext_vector_type(2)));

constexpr int T_TOK = 32768, D = 1024, SEQ = 4096, NBATCH = 8;
constexpr int NPROJ = 5376;
constexpr int PLD = 5120;
constexpr int PC_Q = 0, PC_K = 512, PC_V = 1024, PC_R = 1536, PC_SU = 2048, PC_SV = 2560, PC_GA = 3072, PC_GB = 4096;
constexpr int PC_MRG = 512;
constexpr float EPS = 1e-6f;
constexpr int NEXP = 16384;
#ifndef U_NG
#define U_NG 1
#endif
#ifndef V_F4
#define V_F4 1
#endif
#ifndef SC_F8
#define SC_F8 0
#endif
#ifndef F8_LO
#define F8_LO 11
#endif
constexpr int UNG = U_NG, UNG_SH = (U_NG == 8 ? 3 : (U_NG == 4 ? 2 : (U_NG == 2 ? 1 : 0)));

constexpr size_t MiB = 1u << 20;
constexpr size_t WS_CTL = 0, CTL_ZERO_BYTES = 64 * 1024;
constexpr size_t WS_WIN = 1 * MiB;
constexpr size_t WS_WA = 12 * MiB;
constexpr size_t WS_WB = 13 * MiB;
constexpr size_t WS_WOUT = 14 * MiB;
constexpr size_t WS_WQF = 16 * MiB;
constexpr size_t WS_U8 = 20 * MiB;
constexpr size_t WS_V8 = 36 * MiB;
constexpr size_t WS_SU = 52 * MiB;
constexpr size_t WS_SV = 52 * MiB + 65536;
constexpr size_t WS_AK = 53 * MiB;
constexpr size_t WS_DEC = 84 * MiB;
constexpr size_t WS_ALR = 85 * MiB;
constexpr size_t WS_N1 = 87 * MiB;
constexpr size_t WS_P = 151 * MiB;
constexpr size_t WS_W8 = 472 * MiB;
constexpr size_t WS_N18 = 478 * MiB;
constexpr size_t WS_END = 510 * MiB;
constexpr size_t P_HB = 192 * MiB;
constexpr size_t P_N2 = 128 * MiB;
constexpr size_t P_SC = 0, P_IDX = 256 * MiB, P_GATE = 272 * MiB, P_X8 = 288 * MiB;

constexpr int CW_BAR = 4096;

constexpr int RING_BYTES = 131072;
constexpr int LDSCTL_OFF = RING_BYTES, MISC_OFF = LDSCTL_OFF + 320;
constexpr int LDS_BYTES = 147456;
constexpr int NWAVES = 8;

__device__ __forceinline__ unsigned pk2(float lo, float hi) { const f32x2 v = {lo, hi}; const bf16x2_t b = __builtin_convertvector(v, bf16x2_t); return __builtin_bit_cast(unsigned, b); }
__device__ __forceinline__ unsigned f2bf(float f) { return pk2(f, 0.f) & 0xffffu; }
__device__ __forceinline__ float bflo(unsigned w) { return __builtin_bit_cast(float, w << 16); }
__device__ __forceinline__ float bfhi(unsigned w) { return __builtin_bit_cast(float, w & 0xffff0000u); }
__device__ __forceinline__ float bf1(bf16_t h) { return __builtin_bit_cast(float, ((unsigned)h) << 16); }
__device__ __forceinline__ float sigmoidf_(float x) { return __builtin_amdgcn_rcpf(1.f + __expf(-x)); }
__device__ __forceinline__ float gelu_tanh(float x) { const float y = 1.5957691216057308f * (x + 0.044715f * x * x * x); return x * sigmoidf_(y); }
__device__ __forceinline__ float siluf_(float x) { return x * sigmoidf_(x); }
__device__ __forceinline__ float wave_sum(float v) {
#pragma unroll
    for (int o = 1; o < 64; o <<= 1) v += __shfl_xor(v, o);
    return v;
}
#define LDS_WAIT() asm volatile("s_waitcnt lgkmcnt(0)" ::: "memory")
#define VM_WAIT() asm volatile("s_waitcnt vmcnt(0)" ::: "memory")

__device__ __forceinline__ int lane_now() { int z = 0; asm volatile("" : "+s"(z)); return (int)__builtin_amdgcn_mbcnt_hi(~0u, __builtin_amdgcn_mbcnt_lo(~0u, (unsigned)z)); }
namespace pg8 {
constexpr int BM = 256, BK = 64, HALF = 128, HTB = HALF * BK * 2, STAGE_BYTES = 8 * HTB, NXCD = 8, WGM = 8;
__host__ __device__ __forceinline__ int lds_byte(int r, int c) { const int st = (r >> 4) * 2 + (c >> 5), rr = r & 15, cc = c & 31, ob = rr * 64 + cc * 2; return st * 1024 + (ob ^ (((ob >> 9) & 1) << 5)); }
__host__ __device__ __forceinline__ void stage_rc(int b, int& R, int& C) { const int st = b / 1024, sb = b % 1024, swz = sb ^ (((sb >> 9) & 1) << 5); R = (st >> 1) * 16 + swz / 64; C = (st & 1) * 32 + (swz % 64) / 2; }
__host__ __device__ __forceinline__ int perm32(int rho) { const int n = rho >> 4, i = rho & 15; return 8 * (i >> 2) + 4 * n + (i & 3); }

struct Unit { int pm, pn; };
struct Gemm { const bf16_t* A; const bf16_t* Bt; int M, N, K, lda; int sa = 0, sb = 0; };

struct StaticOrder {
    int nM, nN, nwg, G, c;
    __host__ __device__ void init(int M, int N, int G_, int c_) { nM = M / BM; nN = N / BM; nwg = nM * nN; G = G_; c = c_; }
    __host__ __device__ bool next(int i, Unit& u) const {
        const long L = (long)i * G + c; if (L >= nwg) return false;
        int wgid = (int)L; { const int q = nwg / NXCD, r = nwg % NXCD, xcd = wgid % NXCD, off = wgid / NXCD; wgid = (xcd < r ? xcd * (q + 1) : r * (q + 1) + (xcd - r) * q) + off; }
        const int nig = WGM * nN, gid = wgid / nig, fm = gid * WGM, gsz = (nM - fm) < WGM ? (nM - fm) : WGM;
        u.pm = fm + ((wgid % nig) % gsz); u.pn = (wgid % nig) / gsz; return true;
    }
    __device__ __forceinline__ void a_ready(const Unit&) const {}
    __device__ __forceinline__ void done(const Unit&) const {}
};

template <class Epi, class Sched, bool ALIGN_EPI = false, bool SP2 = false, bool F8 = false, bool MID = false>
__device__ __forceinline__ void gemm_phase(LAS unsigned char* lds, const Gemm g, const Sched& S, const Epi& E, int wave_id) {
    const int wid = wave_id, lane = lane_now(), tid = wid * 64 + lane, wr = wid >> 2, wc = wid & 3, fr = lane & 15, fq = lane >> 4;
    const int K = g.K, nt = K / BK, lda = g.lda; const int scAB = (g.sb & 0xff) | ((g.sa & 0xff) << 8); (void)scAB;
    unsigned voffA[1], voffB[1];
    { int R, C; stage_rc(tid * 16, R, C); const int Rb = Epi::PERM ? ((R & ~31) + perm32(R & 31)) : R;
        voffA[0] = (unsigned)(R * lda + C) * 2u; voffB[0] = (unsigned)(Rb * K + C) * 2u; }
    const size_t dltA = (size_t)64 * lda * 2, dltB = (size_t)64 * K * 2;
    const size_t kstep = (size_t)(BK * 2);
    const size_t hstepA = (size_t)HALF * lda * 2, hstepB = (size_t)HALF * K * 2;
    const size_t tstepA = 2 * hstepA, tstepB = 2 * hstepB;
    const unsigned ldsw = (unsigned)wid * 1024u; const unsigned ldsbase = (unsigned)(__UINTPTR_TYPE__)lds + ldsw;
    const int aoff = lds_byte(wr * 64 + fr, fq * 8), boff = lds_byte(wc * 32 + fr, fq * 8);
#define PG8_SA(b, h) (((b) * 2 + (h)) * HTB)
#define PG8_SB(b, h) ((4 + (b) * 2 + (h)) * HTB)
#define PG8_STAGE(bufoff, gbase, voff) do { _Pragma("unroll") for (int _i = 0; _i < 2; ++_i) \
        asm volatile("s_mov_b32 m0, %2\n\ts_nop 0\n\tglobal_load_lds_dwordx4 %0, %1" :: "v"((voff)[0]), "s"((const char*)(gbase) + (size_t)_i * ((voff) == voffA ? dltA : dltB)), "s"(ldsbase + (unsigned)((bufoff) + _i * 8192)) : "memory", "m0"); } while (0)
#define PG8_LDA(dst, b, h) do { _Pragma("unroll") for (int m = 0; m < 4; ++m) _Pragma("unroll") for (int k = 0; k < 2; ++k) dst[m][k] = *(const LAS bf16x8*)(lds + PG8_SA(b, h) + aoff + m * 2048 + k * 1024); } while (0)
#define PG8_LDB(dst, b, h) do { _Pragma("unroll") for (int n = 0; n < 2; ++n) _Pragma("unroll") for (int k = 0; k < 2; ++k) dst[n][k] = *(const LAS bf16x8*)(lds + PG8_SB(b, h) + boff + n * 2048 + k * 1024); } while (0)
#define PG8_CAT(x) __builtin_shufflevector(__builtin_bit_cast(i32x4, (x)[0]), __builtin_bit_cast(i32x4, (x)[1]), 0, 1, 2, 3, 4, 5, 6, 7)
#define PG8_MMA(ai, bj, At, Bt) do { __builtin_amdgcn_s_setprio(1); if constexpr (F8) { _Pragma("unroll") for (int m = 0; m < 4; ++m) _Pragma("unroll") for (int n = 0; n < 2; ++n) \
        acc[ai][bj][m][n] = __builtin_amdgcn_mfma_scale_f32_16x16x128_f8f6f4(PG8_CAT(Bt[n]), PG8_CAT(At[m]), acc[ai][bj][m][n], 0, 0, 0, scAB, 1, scAB); } else { \
        _Pragma("unroll") for (int m = 0; m < 4; ++m) _Pragma("unroll") for (int n = 0; n < 2; ++n) _Pragma("unroll") for (int k = 0; k < 2; ++k) \
        acc[ai][bj][m][n] = __builtin_amdgcn_mfma_f32_16x16x32_bf16(Bt[n][k], At[m][k], acc[ai][bj][m][n], 0, 0, 0); } __builtin_amdgcn_s_setprio(0); } while (0)
#define PG8_WAIT_V(n) asm volatile("s_waitcnt vmcnt(" #n ")" ::: "memory")
#define PG8_WAIT_L(n) asm volatile("s_waitcnt lgkmcnt(" #n ")" ::: "memory")
#define PG8_BAR __builtin_amdgcn_s_barrier()
#define PG8_SCHED __builtin_amdgcn_sched_barrier(0)
    Unit cur, nxt; int ui = 0;
    if (!S.next(0, cur)) return;
    f32x4 acc[2][2][4][2];
#pragma unroll
    for (int a = 0; a < 2; ++a)
#pragma unroll
        for (int b = 0; b < 2; ++b)
#pragma unroll
            for (int m = 0; m < 4; ++m)
#pragma unroll
                for (int n = 0; n < 2; ++n) acc[a][b][m][n] = (f32x4){0.f, 0.f, 0.f, 0.f};
    bf16x8 At[4][2], B0[2][2], B1[2][2];
    const char* cA = (const char*)g.A + (size_t)cur.pm * tstepA; const char* cB = (const char*)g.Bt + (size_t)cur.pn * tstepB;
    S.a_ready(cur);
    if constexpr (SP2) {
        PG8_STAGE(PG8_SB(0, 0), cB, voffB); PG8_STAGE(PG8_SB(0, 1), cB + hstepB, voffB); PG8_STAGE(PG8_SA(0, 0), cA, voffA); PG8_STAGE(PG8_SA(0, 1), cA + hstepA, voffA);
        if (wr == 1) PG8_BAR;
        PG8_WAIT_V(2); PG8_BAR;
        PG8_STAGE(PG8_SB(1, 0), cB + kstep, voffB); PG8_STAGE(PG8_SA(1, 0), cA + kstep, voffA); PG8_STAGE(PG8_SB(1, 1), cB + hstepB + kstep, voffB);
        PG8_WAIT_V(6); PG8_BAR;
    } else {
        PG8_STAGE(PG8_SB(0, 0), cB, voffB); PG8_STAGE(PG8_SA(0, 0), cA, voffA); PG8_STAGE(PG8_SB(0, 1), cB + hstepB, voffB); PG8_STAGE(PG8_SA(0, 1), cA + hstepA, voffA);
        if (wr == 1) PG8_BAR;
        PG8_WAIT_V(4); PG8_BAR;
        PG8_STAGE(PG8_SB(1, 0), cB + kstep, voffB); PG8_STAGE(PG8_SA(1, 0), cA + kstep, voffA); PG8_STAGE(PG8_SB(1, 1), cB + hstepB + kstep, voffB);
        PG8_WAIT_V(6); PG8_BAR;
    }
    for (;;) {
        const bool has_next = S.next(ui + 1, nxt);
        const char* nA = has_next ? (const char*)g.A + (size_t)nxt.pm * tstepA : cA; const char* nB = has_next ? (const char*)g.Bt + (size_t)nxt.pn * tstepB : cB;
#pragma nounroll
        for (int t = 0; t < nt; t += 2) {
            if constexpr (MID) { if (t == (nt >> 1)) E.mid(acc, cur, wr, wc); }
            const bool last = (t == nt - 2);
            const char* a1 = cA + (size_t)(t + 1) * kstep;
            const char* a2 = last ? nA : cA + (size_t)(t + 2) * kstep; const char* b2 = last ? nB : cB + (size_t)(t + 2) * kstep;
            const char* a3 = a2 + kstep; const char* b3 = b2 + kstep;
            if (last && has_next) S.a_ready(nxt);
            if constexpr (SP2) {
            PG8_LDB(B0, 0, 0); PG8_LDB(B1, 0, 1); PG8_SCHED; PG8_LDA(At, 0, 0); PG8_STAGE(PG8_SA(1, 1), a1 + hstepA, voffA);
            PG8_WAIT_V(8); PG8_WAIT_L(0); PG8_BAR; PG8_MMA(0, 0, At, B0); PG8_MMA(0, 1, At, B1); PG8_BAR; PG8_SCHED;
            PG8_LDA(At, 0, 1); PG8_STAGE(PG8_SB(0, 0), b2, voffB); PG8_STAGE(PG8_SB(0, 1), b2 + hstepB, voffB); PG8_STAGE(PG8_SA(0, 0), a2, voffA);
            PG8_WAIT_V(8); PG8_WAIT_L(0); PG8_BAR; PG8_MMA(1, 0, At, B0); PG8_MMA(1, 1, At, B1); PG8_BAR; PG8_SCHED;
            PG8_LDB(B0, 1, 0); PG8_LDB(B1, 1, 1); PG8_SCHED; PG8_LDA(At, 1, 0); PG8_STAGE(PG8_SA(0, 1), a2 + hstepA, voffA);
            PG8_WAIT_V(8); PG8_WAIT_L(0); PG8_BAR; PG8_MMA(0, 0, At, B0); PG8_MMA(0, 1, At, B1); PG8_BAR; PG8_SCHED;
            PG8_LDA(At, 1, 1); PG8_STAGE(PG8_SB(1, 0), b3, voffB); PG8_STAGE(PG8_SB(1, 1), b3 + hstepB, voffB); PG8_STAGE(PG8_SA(1, 0), a3, voffA);
            PG8_WAIT_V(8); PG8_WAIT_L(0); PG8_BAR; PG8_MMA(1, 0, At, B0); PG8_MMA(1, 1, At, B1); PG8_BAR; PG8_SCHED;
            } else {
            PG8_LDB(B0, 0, 0); PG8_SCHED; PG8_LDA(At, 0, 0); PG8_STAGE(PG8_SA(1, 1), a1 + hstepA, voffA);
            PG8_WAIT_L(8); PG8_BAR; PG8_WAIT_L(0); PG8_MMA(0, 0, At, B0); PG8_BAR; PG8_SCHED;
            PG8_LDB(B1, 0, 1); PG8_STAGE(PG8_SB(0, 0), b2, voffB);
            PG8_BAR; PG8_WAIT_L(0); PG8_MMA(0, 1, At, B1); PG8_BAR;
            PG8_LDA(At, 0, 1); PG8_STAGE(PG8_SA(0, 0), a2, voffA);
            PG8_BAR; PG8_WAIT_L(0); PG8_MMA(1, 0, At, B0); PG8_BAR; PG8_SCHED;
            PG8_STAGE(PG8_SB(0, 1), b2 + hstepB, voffB);
            PG8_WAIT_V(6); PG8_BAR; PG8_MMA(1, 1, At, B1); PG8_BAR;
            PG8_LDB(B0, 1, 0); PG8_SCHED; PG8_LDA(At, 1, 0); PG8_STAGE(PG8_SA(0, 1), a2 + hstepA, voffA);
            PG8_WAIT_L(8); PG8_BAR; PG8_WAIT_L(0); PG8_MMA(0, 0, At, B0); PG8_BAR; PG8_SCHED;
            PG8_LDB(B1, 1, 1); PG8_STAGE(PG8_SB(1, 0), b3, voffB);
            PG8_BAR; PG8_WAIT_L(0); PG8_MMA(0, 1, At, B1); PG8_BAR;
            PG8_LDA(At, 1, 1); PG8_STAGE(PG8_SA(1, 0), a3, voffA);
            PG8_BAR; PG8_WAIT_L(0); PG8_MMA(1, 0, At, B0); PG8_BAR; PG8_SCHED;
            PG8_STAGE(PG8_SB(1, 1), b3 + hstepB, voffB);
            PG8_WAIT_V(6); PG8_BAR; PG8_MMA(1, 1, At, B1); PG8_BAR;
            }
        }
        if constexpr (ALIGN_EPI) { if (wr == 0) PG8_BAR; }
        E(acc, cur, wr, wc, fr, fq); S.done(cur);
        if (!has_next) break;
#pragma unroll
        for (int a = 0; a < 2; ++a)
#pragma unroll
            for (int b = 0; b < 2; ++b)
#pragma unroll
                for (int m = 0; m < 4; ++m)
#pragma unroll
                    for (int n = 0; n < 2; ++n) acc[a][b][m][n] = (f32x4){0.f, 0.f, 0.f, 0.f};
        cur = nxt; cA = nA; cB = nB; ++ui;
        if constexpr (ALIGN_EPI) { if (wr == 1) PG8_BAR; }
    }
    PG8_WAIT_V(0);
    if constexpr (!ALIGN_EPI) { if (wr == 0) PG8_BAR; }
    PG8_BAR;
#undef PG8_SA
#undef PG8_SB
#undef PG8_STAGE
#undef PG8_LDA
#undef PG8_LDB
#undef PG8_MMA
#undef PG8_CAT
#undef PG8_WAIT_V
#undef PG8_WAIT_L
#undef PG8_BAR
#undef PG8_SCHED
}

__device__ __forceinline__ u32x4 pack8(f32x4 v0, f32x4 v1) { u32x4 w; w.x = pk2(v0[0], v0[1]); w.y = pk2(v0[2], v0[3]); w.z = pk2(v1[0], v1[1]); w.w = pk2(v1[2], v1[3]); return w; }
__device__ __forceinline__ void unpack8(u32x4 w, f32x4& v0, f32x4& v1) { v0 = (f32x4){bflo(w.x), bfhi(w.x), bflo(w.y), bfhi(w.y)}; v1 = (f32x4){bflo(w.z), bfhi(w.z), bflo(w.w), bfhi(w.w)}; }

struct EpiProj {
    static constexpr bool PERM = true;
    bf16_t* P; float* ALR; int pn0;
    __device__ __forceinline__ void operator()(const f32x4 (&acc)[2][2][4][2], const Unit& u, int wr, int wc, int fr, int fq) const {
        { const int ln = lane_now(); fr = ln & 15; fq = ln >> 4; }
        const int row0 = u.pm * BM + wr * 64 + fr; int pn = u.pn + pn0; const int cl = wc * 32 + 8 * fq;
        if (pn == 10) {
            if (wc == 0 && fq < 2) {
#pragma unroll
                for (int ai = 0; ai < 2; ++ai)
#pragma unroll
                    for (int m = 0; m < 4; ++m) { float* rp = ALR + (size_t)(row0 + ai * HALF + m * 16) * 16 + 8 * fq;
                        *(f32x4*)rp = acc[ai][0][m][0]; *(f32x4*)(rp + 4) = acc[ai][0][m][1]; }
            }
            return;
        }
        if (pn > 10) --pn;
        const int mode = pn < 8 ? 0 : (pn < 12 ? 1 : 2);
#pragma unroll
        for (int ai = 0; ai < 2; ++ai)
#pragma unroll
            for (int m = 0; m < 4; ++m) { bf16_t* rowp = P + (size_t)(row0 + ai * HALF + m * 16) * PLD + pn * BM + cl;
#pragma unroll
                for (int bj = 0; bj < 2; ++bj) { f32x4 v0 = acc[ai][bj][m][0], v1 = acc[ai][bj][m][1];
                    if (mode == 1) {
#pragma unroll
                        for (int i = 0; i < 4; ++i) { v0[i] = gelu_tanh(v0[i]); v1[i] = gelu_tanh(v1[i]); }
                    } else if (mode == 2) {
                        unsigned w0 = 0, w1 = 0;
                        w0 = __builtin_amdgcn_cvt_pk_u8_f32(sigmoidf_(v0[0]) * 255.f, 0, w0); w0 = __builtin_amdgcn_cvt_pk_u8_f32(sigmoidf_(v0[1]) * 255.f, 1, w0); w0 = __builtin_amdgcn_cvt_pk_u8_f32(sigmoidf_(v0[2]) * 255.f, 2, w0); w0 = __builtin_amdgcn_cvt_pk_u8_f32(sigmoidf_(v0[3]) * 255.f, 3, w0);
                        w1 = __builtin_amdgcn_cvt_pk_u8_f32(sigmoidf_(v1[0]) * 255.f, 0, w1); w1 = __builtin_amdgcn_cvt_pk_u8_f32(sigmoidf_(v1[1]) * 255.f, 1, w1); w1 = __builtin_amdgcn_cvt_pk_u8_f32(sigmoidf_(v1[2]) * 255.f, 2, w1); w1 = __builtin_amdgcn_cvt_pk_u8_f32(sigmoidf_(v1[3]) * 255.f, 3, w1);
                        unsigned char* bp = (unsigned char*)(P + (size_t)(row0 + ai * HALF + m * 16) * PLD) + (pn < 16 ? PC_GA * 2 + (pn - 12) * BM : PC_GB * 2 + (pn - 16) * BM) + cl + bj * HALF;
                        *(u32x2*)bp = (u32x2){w0, w1}; continue;
                    }
                    *(u32x4*)(rowp + bj * HALF) = pack8(v0, v1); } }
    }
};
struct EpiBrA {
    static constexpr bool PERM = true;
    bf16_t* P;
    __device__ __forceinline__ void operator()(const f32x4 (&acc)[2][2][4][2], const Unit& u, int wr, int wc, int fr, int fq) const {
        const int row0 = u.pm * BM + wr * 64 + fr; const int c0 = u.pn * BM + wc * 32 + 8 * fq;
#pragma unroll
        for (int ai = 0; ai < 2; ++ai)
#pragma unroll
            for (int m = 0; m < 4; ++m) { bf16_t* rowp = P + (size_t)(row0 + ai * HALF + m * 16) * PLD;
#pragma unroll
                for (int bj = 0; bj < 2; ++bj) { const int c = c0 + bj * HALF; f32x4 g0, g1; unpack8(*(const u32x4*)(rowp + PC_GA + c), g0, g1);
                    *(u32x4*)(rowp + PC_MRG + c) = pack8(acc[ai][bj][m][0] * g0, acc[ai][bj][m][1] * g1); } }
    }
};
struct EpiBrB {
    static constexpr bool PERM = true;
    bf16_t* P;
    __device__ __forceinline__ void operator()(const f32x4 (&acc)[2][2][4][2], const Unit& u, int wr, int wc, int fr, int fq) const {
        const int row0 = u.pm * BM + wr * 64 + fr; const int c0 = u.pn * BM + wc * 32 + 8 * fq;
#pragma unroll
        for (int ai = 0; ai < 2; ++ai)
#pragma unroll
            for (int m = 0; m < 4; ++m) { bf16_t* rowp = P + (size_t)(row0 + ai * HALF + m * 16) * PLD;
#pragma unroll
                for (int bj = 0; bj < 2; ++bj) { const int c = c0 + bj * HALF; f32x4 g0, g1, p0, p1; unpack8(*(const u32x4*)(rowp + PC_GB + c), g0, g1); unpack8(*(const u32x4*)(rowp + PC_MRG + c), p0, p1);
                    *(u32x4*)(rowp + PC_MRG + c) = pack8(p0 + acc[ai][bj][m][0] * g0, p1 + acc[ai][bj][m][1] * g1); } }
    }
};
struct EpiBrAB {
    static constexpr bool PERM = true;
    bf16_t* P;
    static __device__ __forceinline__ void u8x8(const u32x2 w, f32x4& f0, f32x4& f1) {
        f0 = (f32x4){(float)(w.x & 0xffu), (float)((w.x >> 8) & 0xffu), (float)((w.x >> 16) & 0xffu), (float)(w.x >> 24)};
        f1 = (f32x4){(float)(w.y & 0xffu), (float)((w.y >> 8) & 0xffu), (float)((w.y >> 16) & 0xffu), (float)(w.y >> 24)}; }
    __device__ __forceinline__ void mid(f32x4 (&acc)[2][2][4][2], const Unit& u, int wr, int wc) const {
        const int ln = lane_now(), fr = ln & 15, fq = ln >> 4;
        const int row0 = u.pm * BM + wr * 64 + fr; const int c0 = u.pn * BM + wc * 32 + 8 * fq;
#pragma unroll
        for (int ai = 0; ai < 2; ++ai)
#pragma unroll
            for (int m = 0; m < 4; ++m) { const unsigned char* rowb = (const unsigned char*)(P + (size_t)(row0 + ai * HALF + m * 16) * PLD);
#pragma unroll
                for (int bj = 0; bj < 2; ++bj) { const int c = c0 + bj * HALF; f32x4 a0, a1, b0, b1; u8x8(*(const u32x2*)(rowb + PC_GA * 2 + c), a0, a1); u8x8(*(const u32x2*)(rowb + PC_GB * 2 + c), b0, b1);
#pragma unroll
                    for (int i = 0; i < 4; ++i) { acc[ai][bj][m][0][i] *= a0[i] * __builtin_amdgcn_rcpf(fmaxf(b0[i], 1.f)); acc[ai][bj][m][1][i] *= a1[i] * __builtin_amdgcn_rcpf(fmaxf(b1[i], 1.f)); } } }
    }
    __device__ __forceinline__ void operator()(const f32x4 (&acc)[2][2][4][2], const Unit& u, int wr, int wc, int fr, int fq) const {
        { const int ln = lane_now(); fr = ln & 15; fq = ln >> 4; }
        const int row0 = u.pm * BM + wr * 64 + fr; const int c0 = u.pn * BM + wc * 32 + 8 * fq;
#pragma unroll
        for (int ai = 0; ai < 2; ++ai)
#pragma unroll
            for (int m = 0; m < 4; ++m) { bf16_t* rowp = P + (size_t)(row0 + ai * HALF + m * 16) * PLD;
#pragma unroll
                for (int bj = 0; bj < 2; ++bj) { const int c = c0 + bj * HALF; f32x4 g0, g1; u8x8(*(const u32x2*)((const unsigned char*)rowp + PC_GB * 2 + c), g0, g1);
#pragma unroll
                    for (int i = 0; i < 4; ++i) { g0[i] = fmaxf(g0[i], 1.f) * (1.f / 255.f); g1[i] = fmaxf(g1[i], 1.f) * (1.f / 255.f); }
                    *(u32x4*)(rowp + PC_MRG + c) = pack8(acc[ai][bj][m][0] * g0, acc[ai][bj][m][1] * g1); } }
    }
};
struct EpiOut {
    static constexpr bool PERM = true;
    bf16_t* O;
    __device__ __forceinline__ void operator()(const f32x4 (&acc)[2][2][4][2], const Unit& u, int wr, int wc, int fr, int fq) const {
        const int row0 = u.pm * BM + wr * 64 + fr; const int c0 = u.pn * BM + wc * 32 + 8 * fq;
#pragma unroll
        for (int ai = 0; ai < 2; ++ai)
#pragma unroll
            for (int m = 0; m < 4; ++m) { const size_t ro = (size_t)(row0 + ai * HALF + m * 16) * D;
#pragma unroll
                for (int bj = 0; bj < 2; ++bj) *(u32x4*)(O + ro + c0 + bj * HALF) = pack8(acc[ai][bj][m][0], acc[ai][bj][m][1]); }
    }
};
struct EpiScores {
    static constexpr bool PERM = true;
    bf16_t* SC;
    __device__ __forceinline__ void operator()(const f32x4 (&acc)[2][2][4][2], const Unit& u, int wr, int wc, int fr, int fq) const {
        const int tb0 = u.pm * 16 + wr * 4; const int cq0 = (u.pn * BM + wc * 32 + 8 * fq) >> 3;
#pragma unroll
        for (int ai = 0; ai < 2; ++ai)
#pragma unroll
            for (int m = 0; m < 4; ++m) { bf16_t* bp = SC + ((size_t)(tb0 + ai * 8 + m) * 256) * 128 + fr * 8;
#pragma unroll
                for (int bj = 0; bj < 2; ++bj) *(u32x4*)(bp + (size_t)(cq0 + bj * 16) * 128) = pack8(acc[ai][bj][m][0], acc[ai][bj][m][1]); }
    }
};
}

#define XB_TMO      128
#define XB_XCNT(j)  (256  + 64 * (j))
#define XB_XSUB(j)  (1280 + 64 * (j))
#define XB_XGEN(j)  (2304 + 64 * (j))
#define XB_TOP      3328
#define XB_TOPGEN   3392
#define XCD_BAR_WORDS 3456
#define XB_SPIN_CAP (1u << 18)
__device__ __forceinline__ unsigned xb_ld(unsigned* p)              { return __hip_atomic_load(p, __ATOMIC_RELAXED, __HIP_MEMORY_SCOPE_AGENT); }
__device__ __forceinline__ unsigned xb_add(unsigned* p, unsigned v) { return __hip_atomic_fetch_add(p, v, __ATOMIC_RELAXED, __HIP_MEMORY_SCOPE_AGENT); }
__device__ __forceinline__ unsigned xb_xcc_id() { return (unsigned)__builtin_amdgcn_s_getreg((3 << 11) | 20) & 0xFu; }
#define XB_SPIN(cond, bar) do { unsigned _sp = 0; while (cond) { __builtin_amdgcn_s_sleep(1); \
    if ((++_sp & 255u) == 0u) { if (xb_ld(&(bar)[XB_TMO])) break; if (_sp > XB_SPIN_CAP) { atomicAdd(&(bar)[XB_TMO], 1u); break; } } } } while (0)
struct XcdBarrier { unsigned* bar; unsigned x; volatile LAS unsigned* st; int wave; };
__device__ __forceinline__ XcdBarrier xcd_barrier_post(unsigned* bar, volatile LAS unsigned* st, int wave) {
    XcdBarrier b; b.bar = bar; b.x = xb_xcc_id(); b.st = st; b.wave = wave;
    if (wave == 0 && lane_now() == 0) (void)xb_add(&bar[XB_XCNT(b.x)], 1u);
    return b;
}
__device__ __forceinline__ void xcd_barrier_complete(unsigned* bar, unsigned x, unsigned& nloc, unsigned& nx) {
    const unsigned G = gridDim.x * gridDim.y * gridDim.z;
    unsigned sum, cnt, mine, sp = 0u;
    for (;;) {
        sum = 0u; cnt = 0u; mine = 0u;
#pragma unroll
        for (unsigned j = 0; j < 16; ++j) { const unsigned c = xb_ld(&bar[XB_XCNT(j)]); sum += c; cnt += (c > 0u) ? 1u : 0u; mine = (j == x) ? c : mine; }
        if (sum == G) break;
        __builtin_amdgcn_s_sleep(1);
        if ((++sp & 255u) == 0u) { if (xb_ld(&bar[XB_TMO])) break; if (sp > XB_SPIN_CAP) { atomicAdd(&bar[XB_TMO], 1u); break; } }
    }
    nloc = mine > 0u ? mine : 1u; nx = cnt > 0u ? cnt : 1u;
}
__device__ __forceinline__ void xcd_barrier(const XcdBarrier& b) {
    asm volatile("s_waitcnt vmcnt(0)" ::: "memory");
    __syncthreads();
    if (b.wave == 0 && lane_now() == 0) {
        unsigned* bar = b.bar;
        __builtin_amdgcn_s_waitcnt(0);
        unsigned nloc = b.st[0], nx = b.st[1];
        if (nloc == 0u) { xcd_barrier_complete(bar, b.x, nloc, nx); b.st[0] = nloc; b.st[1] = nx; }
        const unsigned old = xb_add(&bar[XB_XSUB(b.x)], 1u);
        const unsigned gen = old / nloc;
        if (old + 1u == (gen + 1u) * nloc) {
            __builtin_amdgcn_fence(__ATOMIC_RELEASE, "agent");
            asm volatile("s_waitcnt vmcnt(0)" ::: "memory");
            const unsigned og = xb_add(&bar[XB_TOP], 1u);
            const unsigned tg = og / nx;
            if (og + 1u == (tg + 1u) * nx) xb_add(&bar[XB_TOPGEN], 1u);
            else XB_SPIN(xb_ld(&bar[XB_TOPGEN]) == tg, bar);
            __builtin_amdgcn_fence(__ATOMIC_ACQUIRE, "agent");
            xb_add(&bar[XB_XGEN(b.x)], 1u);
            asm volatile("s_waitcnt vmcnt(0)" ::: "memory");
        } else {
            XB_SPIN(xb_ld(&bar[XB_XGEN(b.x)]) == gen, bar);
            __builtin_amdgcn_fence(__ATOMIC_ACQUIRE, "agent");
            asm volatile("s_waitcnt vmcnt(0)" ::: "memory");
        }
    }
    __syncthreads();
}

struct Args {
    const float* in[20]; float* out; unsigned char* ws; int ph_lo, ph_hi, li, pad;
};
enum { I_X = 0, I_N1G, I_WIN, I_WGU, I_BG, I_GLAG, I_SLNG, I_SLNB, I_SW, I_SB, I_WBA, I_WBB, I_WOUT, I_N2G, I_WQ, I_K1, I_K2, I_PU, I_PV, I_FG };

struct Frame {
    LAS unsigned char* lds;
    int tid, lane, wave, G, bid;
};

__device__ __forceinline__ float clamp448(float v) { return __builtin_amdgcn_fmed3f(v, -448.f, 448.f); }
template <int MODE, bool F8 = false>
__device__ __forceinline__ void p0_transpose_item(const float* W, int K, int Nsrc, int Ndst, bf16_t* WT, LAS float* scr, int item, int lane, float sc8 = 1.f, int ldk = 0) {
    if (ldk == 0) ldk = K;
    const int nblk = Ndst / 32, kb = item / nblk, nb = item % nblk, k0 = 64 * kb, n0 = 32 * nb;
    const int nd = n0 + (lane & 31);
    int sc = nd; bool valid = true;
    if (MODE == 1) { if (nd < 2048) sc = nd; else if (nd < 2560) sc = nd + 16; else if (nd < 2576) sc = 2048 + (nd - 2560); else if (nd < 2816) { sc = 0; valid = false; } else sc = nd - 240; }
#pragma unroll 8
    for (int i = 0; i < 32; ++i) { const int kk = 2 * i + (lane >> 5); const float v = valid ? W[(size_t)(k0 + kk) * Nsrc + sc] : 0.f; scr[kk * 33 + (lane & 31)] = v; }
    LDS_WAIT(); asm volatile("" ::: "memory");
    if (F8) {
        const int c = lane & 3;
#pragma unroll
        for (int j = 0; j < 2; ++j) { const int n = (lane >> 2) + 16 * j; const LAS float* s = scr + (16 * c) * 33 + n; u32x4 o;
#pragma unroll
            for (int q = 0; q < 4; ++q) { int w = 0; w = __builtin_amdgcn_cvt_pk_fp8_f32(clamp448(s[(4 * q) * 33] * sc8), clamp448(s[(4 * q + 1) * 33] * sc8), w, false);
                w = __builtin_amdgcn_cvt_pk_fp8_f32(clamp448(s[(4 * q + 2) * 33] * sc8), clamp448(s[(4 * q + 3) * 33] * sc8), w, true); o[q] = (unsigned)w; }
            *(u32x4*)((unsigned char*)WT + (size_t)(n0 + n) * ldk + k0 + 16 * c) = o; }
    } else {
    const int c = lane & 7;
#pragma unroll
    for (int j = 0; j < 4; ++j) { const int n = (lane >> 3) + 8 * j; const LAS float* s = scr + (8 * c) * 33 + n;
        u32x4 o; o.x = pk2(s[0 * 33], s[1 * 33]); o.y = pk2(s[2 * 33], s[3 * 33]); o.z = pk2(s[4 * 33], s[5 * 33]); o.w = pk2(s[6 * 33], s[7 * 33]);
        *(u32x4*)(WT + (size_t)(n0 + n) * ldk + k0 + 8 * c) = o; }
    }
    LDS_WAIT(); asm volatile("" ::: "memory");
}
template <int OM, int NB>
__device__ __forceinline__ void rms_rows_to_bf16(int lane, const float* x0, size_t xstride, const float* g, bf16_t* o0, size_t ostride, unsigned* o80 = nullptr, size_t o8stride = 0, const bf16_t* add0 = nullptr, size_t addstride = 0, bf16_t* hb0 = nullptr, size_t hbstride = 0) {
    f32x4 v[NB][4]; float s[NB];
#pragma unroll
    for (int b = 0; b < NB; ++b) { const float* xr = x0 + b * xstride + 8 * lane;
#pragma unroll
        for (int j = 0; j < 2; ++j) { v[b][2 * j] = *(const f32x4*)(xr + 512 * j); v[b][2 * j + 1] = *(const f32x4*)(xr + 512 * j + 4); } }
    if (add0) {
        u32x4 ad[NB][2];
#pragma unroll
        for (int b = 0; b < NB; ++b) { const bf16_t* ar = add0 + b * addstride + 8 * lane;
#pragma unroll
            for (int j = 0; j < 2; ++j) ad[b][j] = *(const u32x4*)(ar + 512 * j); }
#pragma unroll
        for (int b = 0; b < NB; ++b)
#pragma unroll
            for (int j = 0; j < 2; ++j) { v[b][2 * j] = v[b][2 * j] + (f32x4){bflo(ad[b][j].x), bfhi(ad[b][j].x), bflo(ad[b][j].y), bfhi(ad[b][j].y)};
                v[b][2 * j + 1] = v[b][2 * j + 1] + (f32x4){bflo(ad[b][j].z), bfhi(ad[b][j].z), bflo(ad[b][j].w), bfhi(ad[b][j].w)}; }
    }
    if (hb0) {
#pragma unroll
        for (int b = 0; b < NB; ++b)
#pragma unroll
            for (int j = 0; j < 2; ++j) *(u32x4*)(hb0 + b * hbstride + 512 * j + 8 * lane) = pg8::pack8(v[b][2 * j], v[b][2 * j + 1]);
    }
#pragma unroll
    for (int b = 0; b < NB; ++b) { s[b] = 0.f;
#pragma unroll
        for (int j = 0; j < 4; ++j) s[b] += (v[b][j].x * v[b][j].x + v[b][j].y * v[b][j].y) + (v[b][j].z * v[b][j].z + v[b][j].w * v[b][j].w); }
#pragma unroll
    for (int o = 1; o < 64; o <<= 1) {
#pragma unroll
        for (int b = 0; b < NB; ++b) s[b] += __shfl_xor(s[b], o); }
    const float* gr = g + 8 * lane;
#pragma unroll
    for (int b = 0; b < NB; ++b) { const float rstd = 1.f / sqrtf(s[b] * (1.f / D) + EPS);
#pragma unroll
        for (int j = 0; j < 2; ++j) { const f32x4 y0 = v[b][2 * j] * rstd * *(const f32x4*)(gr + 512 * j), y1 = v[b][2 * j + 1] * rstd * *(const f32x4*)(gr + 512 * j + 4);
            const u32x4 o = pg8::pack8(y0, y1);
            if (OM & 1) *(u32x4*)(o0 + b * ostride + 512 * j + 8 * lane) = o;
            if (OM == 3) { u32x2 w8;
#pragma unroll
                for (int h = 0; h < 2; ++h) { int w = 0; w = __builtin_amdgcn_cvt_pk_fp8_f32(clamp448(bflo(o[2 * h]) * 16.f), clamp448(bfhi(o[2 * h]) * 16.f), w, false);
                    w = __builtin_amdgcn_cvt_pk_fp8_f32(clamp448(bflo(o[2 * h + 1]) * 16.f), clamp448(bfhi(o[2 * h + 1]) * 16.f), w, true); w8[h] = (unsigned)w; }
                *(u32x2*)(o80 + b * o8stride + 128 * j + 2 * lane) = w8; }
            if (OM == 2) { u32x2 w8; int w = 0;
                w = __builtin_amdgcn_cvt_pk_fp8_f32(clamp448(y0.x * 16.f), clamp448(y0.y * 16.f), w, false); w = __builtin_amdgcn_cvt_pk_fp8_f32(clamp448(y0.z * 16.f), clamp448(y0.w * 16.f), w, true); w8.x = (unsigned)w;
                w = 0; w = __builtin_amdgcn_cvt_pk_fp8_f32(clamp448(y1.x * 16.f), clamp448(y1.y * 16.f), w, false); w = __builtin_amdgcn_cvt_pk_fp8_f32(clamp448(y1.z * 16.f), clamp448(y1.w * 16.f), w, true); w8.y = (unsigned)w;
                *(u32x2*)(o80 + b * o8stride + 128 * j + 2 * lane) = w8; } } }
}
__device__ __forceinline__ float wave_max(float v) {
#pragma unroll
    for (int o = 1; o < 64; o <<= 1) v = fmaxf(v, __shfl_xor(v, o));
    return v;
}
template <int NB>
__device__ __forceinline__ void cvt_rows_fp8(int lane, const float* const (&src)[NB], unsigned char* const (&dst16)[NB], float* const (&scale_out)[NB]) {
    f32x4 v[NB][4]; float m[NB];
#pragma unroll
    for (int b = 0; b < NB; ++b) {
#pragma unroll
        for (int j = 0; j < 4; ++j) v[b][j] = *(const GAS f32x4*)(src[b] + 16 * lane + 4 * j); }
#pragma unroll
    for (int b = 0; b < NB; ++b) { m[b] = 0.f;
#pragma unroll
        for (int j = 0; j < 4; ++j) m[b] = fmaxf(m[b], fmaxf(fmaxf(fabsf(v[b][j].x), fabsf(v[b][j].y)), fmaxf(fabsf(v[b][j].z), fabsf(v[b][j].w)))); }
#pragma unroll
    for (int o = 1; o < 64; o <<= 1) {
#pragma unroll
        for (int b = 0; b < NB; ++b) m[b] = fmaxf(m[b], __shfl_xor(m[b], o)); }
#pragma unroll
    for (int b = 0; b < NB; ++b) { const float inv = m[b] > 0.f ? 224.f / m[b] : 0.f, sc = m[b] > 0.f ? m[b] * (1.f / 224.f) : 1.f;
        u32x4 o;
#pragma unroll
        for (int j = 0; j < 4; ++j) { int w = 0; w = __builtin_amdgcn_cvt_pk_fp8_f32(v[b][j].x * inv, v[b][j].y * inv, w, false); w = __builtin_amdgcn_cvt_pk_fp8_f32(v[b][j].z * inv, v[b][j].w * inv, w, true); o[j] = (unsigned)w; }
        *(GAS u32x4*)dst16[b] = o;
        if (lane == 0) *(GAS float*)scale_out[b] = sc; }
}
__device__ __forceinline__ unsigned fp4_code(float t) { const float a = fabsf(t);
    const unsigned c = (unsigned)(a >= 0.25f) + (unsigned)(a >= 0.75f) + (unsigned)(a >= 1.25f) + (unsigned)(a >= 1.75f) + (unsigned)(a >= 2.5f) + (unsigned)(a >= 3.5f) + (unsigned)(a >= 5.f);
    return c | (t < 0.f ? 8u : 0u); }
template <int NB, bool PERMV = false>
__device__ __forceinline__ void cvt_rows_fp4(int lane, const float* const (&src)[NB], unsigned char* const (&dst8)[NB], float* const (&scale_out)[NB]) {
    f32x4 v[NB][4]; float m[NB];
#pragma unroll
    for (int b = 0; b < NB; ++b) {
#pragma unroll
        for (int j = 0; j < 4; ++j) v[b][j] = *(const GAS f32x4*)(src[b] + 16 * lane + 4 * j); }
#pragma unroll
    for (int b = 0; b < NB; ++b) { m[b] = 0.f;
#pragma unroll
        for (int j = 0; j < 4; ++j) m[b] = fmaxf(m[b], fmaxf(fmaxf(fabsf(v[b][j].x), fabsf(v[b][j].y)), fmaxf(fabsf(v[b][j].z), fabsf(v[b][j].w)))); }
#pragma unroll
    for (int o = 1; o < 64; o <<= 1) {
#pragma unroll
        for (int b = 0; b < NB; ++b) m[b] = fmaxf(m[b], __shfl_xor(m[b], o)); }
#pragma unroll
    for (int b = 0; b < NB; ++b) { const float inv = m[b] > 0.f ? 6.f / m[b] : 0.f, sc = m[b] > 0.f ? m[b] * (1.f / 6.f) : 1.f;
        u32x2 o;
#pragma unroll
        for (int h = 0; h < 2; ++h) { unsigned w = 0;
            const f32x4 t0 = v[b][2 * h] * inv, t1 = v[b][2 * h + 1] * inv;
            w = __builtin_amdgcn_cvt_scalef32_pk_fp4_f32(w, t0.x, t0.y, 1.f, 0); w = __builtin_amdgcn_cvt_scalef32_pk_fp4_f32(w, t0.z, t0.w, 1.f, 1);
            w = __builtin_amdgcn_cvt_scalef32_pk_fp4_f32(w, t1.x, t1.y, 1.f, 2); w = __builtin_amdgcn_cvt_scalef32_pk_fp4_f32(w, t1.z, t1.w, 1.f, 3);
            o[h] = w; }
        if (PERMV) { *(GAS unsigned*)(dst8[b] + 16 * ((2 * lane) & 31) + 4 * (lane >> 4)) = o.x; *(GAS unsigned*)(dst8[b] + 16 * ((2 * lane + 1) & 31) + 4 * (lane >> 4)) = o.y; }
        else *(GAS u32x2*)dst8[b] = o;
        if (lane == 0) *(GAS float*)scale_out[b] = sc; }
}
__device__ __forceinline__ void convert_tables(const Frame& F, const Args& A, int wi, int nw) {
    unsigned char* ws = A.ws; const int gw = wi, NGW = nw;
    {
        int mc = gw;
        for (; mc + 3 * NGW < NEXP; mc += 4 * NGW) { const float* src[4]; unsigned char* dst[4]; float* sco[4];
#pragma unroll
            for (int b = 0; b < 4; ++b) { const int e = mc + b * NGW; src[b] = A.in[I_PU] + (size_t)e * D; dst[b] = ws + WS_U8 + (size_t)((e & (UNG - 1)) * (NEXP / UNG) + (e >> UNG_SH)) * 512 + 8 * F.lane; sco[b] = (float*)(ws + WS_SU) + e; }
            cvt_rows_fp4<4>(F.lane, src, dst, sco); }
        for (; mc < NEXP; mc += NGW) { const float* src[1]; unsigned char* dst[1]; float* sco[1];
            const int e = mc; src[0] = A.in[I_PU] + (size_t)e * D; dst[0] = ws + WS_U8 + (size_t)((e & (UNG - 1)) * (NEXP / UNG) + (e >> UNG_SH)) * 512 + 8 * F.lane; sco[0] = (float*)(ws + WS_SU) + e;
            cvt_rows_fp4<1>(F.lane, src, dst, sco); }
    }
    if (V_F4) {
        int mc = gw;
        for (; mc + 3 * NGW < NEXP; mc += 4 * NGW) { const float* src[4]; unsigned char* dst[4]; float* sco[4];
#pragma unroll
            for (int b = 0; b < 4; ++b) { const int e = mc + b * NGW; src[b] = A.in[I_PV] + (size_t)e * D; dst[b] = ws + WS_V8 + (size_t)e * 512; sco[b] = (float*)(ws + WS_SV) + e; }
            cvt_rows_fp4<4, true>(F.lane, src, dst, sco); }
        for (; mc < NEXP; mc += NGW) { const float* src[1]; unsigned char* dst[1]; float* sco[1];
            const int e = mc; src[0] = A.in[I_PV] + (size_t)e * D; dst[0] = ws + WS_V8 + (size_t)e * 512; sco[0] = (float*)(ws + WS_SV) + e;
            cvt_rows_fp4<1, true>(F.lane, src, dst, sco); }
    } else {
        int mc = gw;
        for (; mc + 3 * NGW < NEXP; mc += 4 * NGW) { const float* src[4]; unsigned char* dst[4]; float* sco[4];
#pragma unroll
            for (int b = 0; b < 4; ++b) { const int e = mc + b * NGW; src[b] = A.in[I_PV] + (size_t)e * D; dst[b] = ws + WS_V8 + ((size_t)(F.lane >> 3) * NEXP + e) * 128 + 16 * (F.lane & 7); sco[b] = (float*)(ws + WS_SV) + e; }
            cvt_rows_fp8<4>(F.lane, src, dst, sco); }
        for (; mc < NEXP; mc += NGW) { const float* src[1]; unsigned char* dst[1]; float* sco[1];
            const int e = mc; src[0] = A.in[I_PV] + (size_t)e * D; dst[0] = ws + WS_V8 + ((size_t)(F.lane >> 3) * NEXP + e) * 128 + 16 * (F.lane & 7); sco[0] = (float*)(ws + WS_SV) + e;
            cvt_rows_fp8<1>(F.lane, src, dst, sco); }
    }
}
__device__ __forceinline__ void phase0(const Frame& F, const Args& A) {
    unsigned char* ws = A.ws;
    if (!SC_F8) {
        const int l = F.lane, fr = l & 15, q = l >> 4;
        bf16_t* WQF = (bf16_t*)(ws + WS_WQF);
        for (int it = F.bid * NWAVES + F.wave; it < 2048; it += F.G * NWAVES) {
            const int kh = it & 1, kt = (it >> 1) & 63, hh = it >> 7;
            const float* kX = (hh & 1) ? A.in[I_K2] : A.in[I_K1];
            const float* ap = A.in[I_WQ] + (size_t)(kt * 16 + fr) * 2048 + hh * 128 + 4 * q;
            f32x4 a[8];
#pragma unroll
            for (int t = 0; t < 8; ++t) a[t] = *(const f32x4*)(ap + 16 * t);
#pragma unroll
            for (int kb = 0; kb < 4; ++kb) { const int key0 = kh * 64 + kb * 16;
                const float* bp = kX + (size_t)(key0 + fr) * 128 + 4 * q;
                f32x4 b[8];
#pragma unroll
                for (int t = 0; t < 8; ++t) b[t] = *(const f32x4*)(bp + 16 * t);
                f32x4 d = {0.f, 0.f, 0.f, 0.f};
#pragma unroll
                for (int t = 0; t < 8; ++t)
#pragma unroll
                    for (int c = 0; c < 4; ++c) d = __builtin_amdgcn_mfma_f32_16x16x4f32(a[t][c], b[t][c], d, 0, 0, 0);
                u32x2 o; o.x = pk2(d[0], d[1]); o.y = pk2(d[2], d[3]);
                *(u32x2*)(WQF + (size_t)(hh * 128 + key0 + fr) * 1024 + kt * 16 + 4 * q) = o; }
        }
    } else {
        LAS float* kx = (LAS float*)F.lds;
        LAS float* wt = (LAS float*)(F.lds + 128 * 129 * 4);
        bf16_t* WQF = (bf16_t*)(ws + WS_WQF);
        for (int it = F.bid; it < 512; it += F.G) {
            const int hh = it >> 5, kblk = it & 31, k0 = kblk * 32;
            const float* kX = (hh & 1) ? A.in[I_K2] : A.in[I_K1];
            __syncthreads();
            for (int e = F.tid; e < 128 * 128; e += 512) kx[(e >> 7) * 129 + (e & 127)] = kX[e];
            for (int e = F.tid; e < 32 * 128; e += 512) wt[e] = A.in[I_WQ][(size_t)(k0 + (e >> 7)) * 2048 + hh * 128 + (e & 127)];
            __syncthreads();
            const int key = F.tid & 127, kq = F.tid >> 7;
            float acc[8];
#pragma unroll
            for (int i = 0; i < 8; ++i) acc[i] = 0.f;
            for (int d = 0; d < 128; ++d) { const float b = kx[key * 129 + d];
#pragma unroll
                for (int i = 0; i < 8; ++i) acc[i] += wt[(kq * 8 + i) * 128 + d] * b; }
            if (SC_F8) { u32x2 o;
#pragma unroll
                for (int h2 = 0; h2 < 2; ++h2) { int w = 0; w = __builtin_amdgcn_cvt_pk_fp8_f32(clamp448(acc[4 * h2] * 1024.f), clamp448(acc[4 * h2 + 1] * 1024.f), w, false);
                    w = __builtin_amdgcn_cvt_pk_fp8_f32(clamp448(acc[4 * h2 + 2] * 1024.f), clamp448(acc[4 * h2 + 3] * 1024.f), w, true); o[h2] = (unsigned)w; }
                *(u32x2*)((unsigned char*)WQF + (size_t)(hh * 128 + key) * 1024 + k0 + kq * 8) = o;
            } else {
            u32x4 o; o.x = pk2(acc[0], acc[1]); o.y = pk2(acc[2], acc[3]); o.z = pk2(acc[4], acc[5]); o.w = pk2(acc[6], acc[7]);
            *(u32x4*)(WQF + (size_t)(hh * 128 + key) * 1024 + k0 + kq * 8) = o; }
        }
        __syncthreads();
    }
    LAS float* scr = (LAS float*)(F.lds + F.wave * 16384);
    const int gw = F.bid * NWAVES + F.wave, NGW = F.G * NWAVES;
    constexpr int I_IN = 16 * (NPROJ / 32), I_A = 8 * 32, I_B = 8 * 32, I_O = 16 * 32;
    constexpr int NITEMS = I_IN + I_A + I_B + I_O;
    for (int it = gw; it < NITEMS; it += NGW) {
        int r = it;
        if (r < I_IN) { if ((r % (NPROJ / 32)) * 32 >= F8_LO * 256) p0_transpose_item<1, true>(A.in[I_WIN], 1024, 5136, NPROJ, (bf16_t*)(ws + WS_W8), scr, r, F.lane, 1024.f);
                        else p0_transpose_item<1, false>(A.in[I_WIN], 1024, 5136, NPROJ, (bf16_t*)(ws + WS_WIN), scr, r, F.lane); continue; } r -= I_IN;
        if (r < I_A) { p0_transpose_item<0>(A.in[I_WBA], 512, 1024, 1024, (bf16_t*)(ws + WS_WA), scr, r, F.lane, 1.f, 1024); continue; } r -= I_A;
        if (r < I_B) { p0_transpose_item<0>(A.in[I_WBB], 512, 1024, 1024, (bf16_t*)(ws + WS_WA) + 512, scr, r, F.lane, 1.f, 1024); continue; } r -= I_B;
        p0_transpose_item<0>(A.in[I_WOUT], 1024, 1024, 1024, (bf16_t*)(ws + WS_WOUT), scr, r, F.lane);
    }
    constexpr int OM1 = F8_LO <= 0 ? 2 : (F8_LO >= 21 ? 1 : 3);
    { int m = gw; for (; m + 3 * NGW < T_TOK; m += 4 * NGW) rms_rows_to_bf16<OM1, 4>(F.lane, A.in[I_X] + (size_t)m * D, (size_t)NGW * D, A.in[I_N1G], (bf16_t*)(ws + WS_N1) + (size_t)m * D, (size_t)NGW * D, (unsigned*)(ws + WS_N18) + (size_t)m * 256, (size_t)NGW * 256);
      for (; m < T_TOK; m += NGW) rms_rows_to_bf16<OM1, 1>(F.lane, A.in[I_X] + (size_t)m * D, 0, A.in[I_N1G], (bf16_t*)(ws + WS_N1) + (size_t)m * D, 0, (unsigned*)(ws + WS_N18) + (size_t)m * 256, 0); }
}

__device__ __forceinline__ float log_sigmoid(float z) { return fminf(z, 0.f) - log1pf(__expf(-fabsf(z))); }

template <bool DRY>
__device__ __forceinline__ void gla_chunk_phase(const Frame& F, const Args& A) {
    unsigned char* ws = A.ws;
    const bf16_t* P = (const bf16_t*)(ws + WS_P);
    const float* ALR = (const float*)(ws + WS_ALR);
    LAS float* alr = (LAS float*)F.lds;
    LAS float* tot = (LAS float*)(F.lds + 4096);
    LAS bf16_t* kdT = (LAS bf16_t*)(F.lds + 8192);
    LAS bf16_t* vT = (LAS bf16_t*)(F.lds + 26624);
    LAS bf16_t* stT = (LAS bf16_t*)(F.lds + 45056);
    const int tid = F.tid, kk = tid & 127, seg = tid >> 7;
    const bool hconst = (F.G & 3) == 0;
    int hcur = -1; float w[16]; float bias = 0.f;
#pragma unroll
    for (int j = 0; j < 16; ++j) w[j] = 0.f;
    float na0, na1; bf16_t nk[16], nv[16];
#define GC_LOAD(unit) do { const int h_ = (unit) & 3, c_ = ((unit) >> 2) & 63, b_ = (unit) >> 8; const int t0_ = b_ * SEQ + c_ * 64; \
        na0 = ALR[(size_t)t0_ * 16 + tid]; na1 = ALR[(size_t)t0_ * 16 + 512 + tid]; \
        const bf16_t* kp_ = P + (size_t)(t0_ + 16 * seg) * PLD + PC_K + h_ * 128 + kk; const bf16_t* vp_ = P + (size_t)(t0_ + 16 * seg) * PLD + PC_V + h_ * 128 + kk; \
        _Pragma("unroll") for (int i_ = 0; i_ < 16; ++i_) { nk[i_] = kp_[(size_t)i_ * PLD]; nv[i_] = vp_[(size_t)i_ * PLD]; } } while (0)
    int unit = F.bid;
    if (unit < 2048) GC_LOAD(unit);
    for (; unit < 2048; unit += F.G) {
        const int h = unit & 3;
        if (h != hcur) { hcur = h;
#pragma unroll
            for (int j = 0; j < 16; ++j) w[j] = A.in[I_WGU][(size_t)j * 512 + h * 128 + kk];
            bias = A.in[I_BG][h * 128 + kk]; }
        __syncthreads();
        alr[tid] = na0; alr[512 + tid] = na1;
        bf16_t kr[16], vr[16];
#pragma unroll
        for (int i = 0; i < 16; ++i) { kr[i] = nk[i]; vr[i] = nv[i]; }
        if (unit + F.G < 2048) GC_LOAD(unit + F.G);
        __syncthreads();
        float cum[16]; float run = 0.f;
#pragma unroll
        for (int i = 0; i < 16; ++i) { const LAS f32x4* ap = (const LAS f32x4*)(alr + (16 * seg + i) * 16); float z = bias;
#pragma unroll
            for (int q = 0; q < 4; ++q) { const f32x4 a4 = ap[q]; z += a4.x * w[4 * q] + a4.y * w[4 * q + 1] + a4.z * w[4 * q + 2] + a4.w * w[4 * q + 3]; }
            const float ls = fminf(z, 0.f) - __logf(1.f + __expf(-fabsf(z)));
            run += ls * (1.f / 16.f); cum[i] = run; }
        tot[seg * 128 + kk] = run;
        __syncthreads();
        {
            const float t0s = tot[kk], t1s = tot[128 + kk], t2s = tot[256 + kk], t3s = tot[384 + kk];
            const float total = (t0s + t1s) + (t2s + t3s);
            const float prefix = seg == 0 ? 0.f : (seg == 1 ? t0s : (seg == 2 ? t0s + t1s : t0s + t1s + t2s));
            unsigned kw[8], vw[8];
#pragma unroll
            for (int i = 0; i < 8; ++i) {
                const float e0 = __expf(total - (prefix + cum[2 * i])), e1 = __expf(total - (prefix + cum[2 * i + 1]));
                kw[i] = pk2(bf1(kr[2 * i]) * e0, bf1(kr[2 * i + 1]) * e1); vw[i] = (unsigned)vr[2 * i] | ((unsigned)vr[2 * i + 1] << 16);
            }
            *(LAS u32x4*)(kdT + kk * 72 + 16 * seg) = (u32x4){kw[0], kw[1], kw[2], kw[3]}; *(LAS u32x4*)(kdT + kk * 72 + 16 * seg + 8) = (u32x4){kw[4], kw[5], kw[6], kw[7]};
            *(LAS u32x4*)(vT + kk * 72 + 16 * seg) = (u32x4){vw[0], vw[1], vw[2], vw[3]}; *(LAS u32x4*)(vT + kk * 72 + 16 * seg + 8) = (u32x4){vw[4], vw[5], vw[6], vw[7]};
            if (seg == 0) ((float*)(DRY ? (unsigned char*)A.out + 96 * MiB : ws + WS_DEC))[(size_t)unit * 128 + kk] = __expf(total);
        }
        __syncthreads();
        {
            const int w8 = F.wave, l = F.lane, fr = l & 15, fq = l >> 4;
            f32x4 acc[8];
#pragma unroll
            for (int n = 0; n < 8; ++n) acc[n] = (f32x4){0.f, 0.f, 0.f, 0.f};
#pragma unroll
            for (int ks = 0; ks < 2; ++ks) {
                const bf16x8 a = *(const LAS bf16x8*)(kdT + (16 * w8 + fr) * 72 + 32 * ks + 8 * fq);
#pragma unroll
                for (int n = 0; n < 8; ++n) { const bf16x8 bb = *(const LAS bf16x8*)(vT + (16 * n + fr) * 72 + 32 * ks + 8 * fq);
                    acc[n] = __builtin_amdgcn_mfma_f32_16x16x32_bf16(a, bb, acc[n], 0, 0, 0); }
            }
#pragma unroll
            for (int n = 0; n < 8; ++n) { u32x2 o; o.x = pk2(acc[n][0], acc[n][1]); o.y = pk2(acc[n][2], acc[n][3]);
                *(LAS u32x2*)(stT + (16 * n + fr) * 136 + 16 * w8 + 4 * fq) = o; }
        }
        __syncthreads();
        {
            bf16_t* ST = (bf16_t*)(DRY ? (unsigned char*)A.out : ws + WS_N1) + (size_t)unit * 16384;
            const int vv = tid >> 2, part = tid & 3;
#pragma unroll
            for (int q = 0; q < 4; ++q) *(u32x4*)(ST + (size_t)vv * 128 + 32 * part + 8 * q) = *(const LAS u32x4*)(stT + vv * 136 + 32 * part + 8 * q);
        }
    }
#undef GC_LOAD
    (void)hconst;
}

template <bool DRY>
__device__ __forceinline__ void sgu_unit(const Frame& F, const Args& A, int unit, bool stats) {
    const int g = unit & 3, blk = (unit >> 2) & 31, b = unit >> 7;
    const int t0 = b * SEQ + blk * 128;
    bf16_t* P = (bf16_t*)(A.ws + WS_P);
    LAS bf16_t* wA = (LAS bf16_t*)F.lds;
    LAS bf16_t* vnT = (LAS bf16_t*)(F.lds + 34816);
    LAS float* st = (LAS float*)(F.lds + 69632);
    LAS bf16_t* suS = (LAS bf16_t*)(F.lds + 70656);
    const int tid = F.tid;
    __syncthreads();
    if (stats) {
        const int j = tid >> 2, q = tid & 3;
        const bf16_t* sp = P + (size_t)(t0 + j) * PLD + PC_SV + q * 128;
        float s = 0.f, s2 = 0.f;
#pragma unroll
        for (int i = 0; i < 16; ++i) { const u32x4 w = *(const u32x4*)(sp + 8 * i);
            const float f[8] = {bflo(w.x), bfhi(w.x), bflo(w.y), bfhi(w.y), bflo(w.z), bfhi(w.z), bflo(w.w), bfhi(w.w)};
#pragma unroll
            for (int e = 0; e < 8; ++e) { s += f[e]; s2 += f[e] * f[e]; } }
        s += __shfl_xor(s, 1); s += __shfl_xor(s, 2); s2 += __shfl_xor(s2, 1); s2 += __shfl_xor(s2, 2);
        const float mu = s * (1.f / 512.f); const float var = fmaxf(s2 * (1.f / 512.f) - mu * mu, 0.f);
        if (q == 0) { st[2 * j] = mu; st[2 * j + 1] = 1.f / sqrtf(var + EPS); }
    }
    {
        const int i = tid >> 2, jb = (tid & 3) * 32;
        const float* wp = A.in[I_SW] + (size_t)g * 16384 + (size_t)i * 128 + jb;
        const bf16_t* sup = P + (size_t)(t0 + i) * PLD + PC_SU + g * 128 + jb;
#pragma unroll
        for (int q = 0; q < 4; ++q) { const f32x4 a = *(const f32x4*)(wp + 8 * q), bq = *(const f32x4*)(wp + 8 * q + 4);
            const bool z = (i < 64) && (jb + 8 * q >= 64);
            u32x4 o; o.x = pk2(a.x, a.y); o.y = pk2(a.z, a.w); o.z = pk2(bq.x, bq.y); o.w = pk2(bq.z, bq.w);
            if (z) o = (u32x4){0u, 0u, 0u, 0u};
            *(LAS u32x4*)(wA + i * 136 + jb + 8 * q) = o;
            *(LAS u32x4*)(suS + i * 136 + jb + 8 * q) = *(const u32x4*)(sup + 8 * q); }
    }
    const int cch = tid & 127, seg = tid >> 7;
    bf16_t xr[32];
    { const bf16_t* sp = P + (size_t)(t0 + 32 * seg) * PLD + PC_SV + g * 128 + cch;
#pragma unroll
      for (int i = 0; i < 32; ++i) xr[i] = sp[(size_t)i * PLD]; }
    const float lg = A.in[I_SLNG][g * 128 + cch], lb = A.in[I_SLNB][g * 128 + cch];
    __syncthreads();
    {
        unsigned ow[16];
#pragma unroll
        for (int i = 0; i < 16; ++i) { const int j = 32 * seg + 2 * i; const f32x4 ms = *(const LAS f32x4*)(st + 2 * j);
            ow[i] = pk2((bf1(xr[2 * i]) - ms.x) * ms.y * lg + lb, (bf1(xr[2 * i + 1]) - ms.z) * ms.w * lg + lb); }
#pragma unroll
        for (int q = 0; q < 4; ++q) *(LAS u32x4*)(vnT + cch * 136 + 32 * seg + 8 * q) = (u32x4){ow[4 * q], ow[4 * q + 1], ow[4 * q + 2], ow[4 * q + 3]};
    }
    __syncthreads();
    {
        const int w = F.wave, l = F.lane, fr = l & 15, fq = l >> 4;
        f32x4 acc[8];
#pragma unroll
        for (int n = 0; n < 8; ++n) acc[n] = (f32x4){0.f, 0.f, 0.f, 0.f};
#pragma unroll
        for (int ks = 0; ks < 4; ++ks) {
            const bf16x8 a = *(const LAS bf16x8*)(wA + (16 * w + fr) * 136 + 32 * ks + 8 * fq);
#pragma unroll
            for (int n = 0; n < 8; ++n) { const bf16x8 bb = *(const LAS bf16x8*)(vnT + (16 * n + fr) * 136 + 32 * ks + 8 * fq);
                acc[n] = __builtin_amdgcn_mfma_f32_16x16x32_bf16(a, bb, acc[n], 0, 0, 0); }
        }
#pragma unroll
        for (int jj = 0; jj < 4; ++jj) { const int i = 16 * w + 4 * fq + jj; const float bias = A.in[I_SB][g * 128 + i];
            LAS bf16_t* rp = suS + i * 136 + fr;
#pragma unroll
            for (int n = 0; n < 8; ++n) { const float su = bf1(rp[16 * n]); rp[16 * n] = (bf16_t)f2bf(su * (acc[n][jj] + bias)); } }
    }
    __syncthreads();
    {
        const int i = tid >> 2, jb = (tid & 3) * 32;
        bf16_t* yp = DRY ? (bf16_t*)A.out + (size_t)(t0 + i) * 512 + g * 128 + jb : P + (size_t)(t0 + i) * PLD + PC_SU + g * 128 + jb;
#pragma unroll
        for (int q = 0; q < 4; ++q) *(u32x4*)(yp + 8 * q) = *(const LAS u32x4*)(suS + i * 136 + jb + 8 * q);
    }
}

template <bool DRY>
__device__ __forceinline__ void gla_scan(const Frame& F, const Args& A) {
    bf16_t* ST = (bf16_t*)(A.ws + WS_N1); bf16_t* STO = DRY ? (bf16_t*)A.out : ST; const float* DEC = (const float*)(A.ws + WS_DEC);
    for (int gi = F.bid * 512 + F.tid; gi < 131072; gi += F.G * 512) {
        const int k4 = gi & 31, vv = (gi >> 5) & 127, h = (gi >> 12) & 3, b = gi >> 14;
        float s0 = 0.f, s1 = 0.f, s2 = 0.f, s3 = 0.f;
        u32x2 wa[8], wb[8]; f32x4 da[8], db[8];
#define SCAN_LOAD(W, Dd, c0) do { _Pragma("unroll") for (int i_ = 0; i_ < 8; ++i_) { const size_t u_ = (size_t)((b * 64 + (c0) + i_) * 4 + h); \
            W[i_] = *(const u32x2*)(ST + u_ * 16384 + (size_t)vv * 128 + k4 * 4); Dd[i_] = *(const f32x4*)(DEC + u_ * 128 + k4 * 4); } } while (0)
#define SCAN_STEP(W, Dd, c0) do { _Pragma("unroll") for (int i_ = 0; i_ < 8; ++i_) { const size_t u_ = (size_t)((b * 64 + (c0) + i_) * 4 + h); \
            s0 = Dd[i_].x * s0 + bflo(W[i_].x); s1 = Dd[i_].y * s1 + bfhi(W[i_].x); s2 = Dd[i_].z * s2 + bflo(W[i_].y); s3 = Dd[i_].w * s3 + bfhi(W[i_].y); \
            u32x2 o_; o_.x = pk2(s0, s1); o_.y = pk2(s2, s3); *(u32x2*)(STO + u_ * 16384 + (size_t)vv * 128 + k4 * 4) = o_; } } while (0)
        SCAN_LOAD(wa, da, 0);
#pragma unroll
        for (int c0 = 0; c0 < 64; c0 += 16) {
            SCAN_LOAD(wb, db, c0 + 8);
            SCAN_STEP(wa, da, c0);
            if (c0 + 16 < 64) SCAN_LOAD(wa, da, c0 + 16);
            SCAN_STEP(wb, db, c0 + 8);
        }
#undef SCAN_LOAD
#undef SCAN_STEP
    }
}

template <bool DRY>
__device__ __forceinline__ void gla_out_phase(const Frame& F, const Args& A) {
    bf16_t* P = (bf16_t*)(A.ws + WS_P);
    LAS bf16_t* qA = (LAS bf16_t*)F.lds;
    LAS bf16_t* sB = (LAS bf16_t*)(F.lds + 17408);
    LAS float* oF = (LAS float*)(F.lds + 52224);
    const int tid = F.tid, s = tid >> 3, cb = (tid & 7) * 16, vv = tid >> 2, kb = (tid & 3) * 32;
    u32x4 nq0, nq1, ns0, ns1, ns2, ns3, nr0, nr1;
#define GO_LOAD(unit) do { const int h_ = (unit) & 3, c_ = ((unit) >> 2) & 63, b_ = (unit) >> 8; const int t0_ = b_ * SEQ + c_ * 64; \
        const bf16_t* qp_ = P + (size_t)(t0_ + s) * PLD + PC_Q + h_ * 128 + cb; nq0 = *(const u32x4*)qp_; nq1 = *(const u32x4*)(qp_ + 8); \
        const bf16_t* sp_ = (const bf16_t*)(A.ws + WS_N1) + (size_t)(unit) * 16384 + (size_t)vv * 128 + kb; ns0 = *(const u32x4*)sp_; ns1 = *(const u32x4*)(sp_ + 8); ns2 = *(const u32x4*)(sp_ + 16); ns3 = *(const u32x4*)(sp_ + 24); \
        const bf16_t* rp_ = P + (size_t)(t0_ + s) * PLD + PC_R + h_ * 128 + cb; nr0 = *(const u32x4*)rp_; nr1 = *(const u32x4*)(rp_ + 8); } while (0)
    int unit = F.bid;
    if (unit < 2048) GO_LOAD(unit);
    for (; unit < 2048; unit += F.G) {
        const int h = unit & 3, c = (unit >> 2) & 63, b = unit >> 8;
        const int t0 = b * SEQ + c * 64;
        __syncthreads();
        *(LAS u32x4*)(qA + s * 136 + cb) = nq0; *(LAS u32x4*)(qA + s * 136 + cb + 8) = nq1;
        *(LAS u32x4*)(sB + vv * 136 + kb) = ns0; *(LAS u32x4*)(sB + vv * 136 + kb + 8) = ns1; *(LAS u32x4*)(sB + vv * 136 + kb + 16) = ns2; *(LAS u32x4*)(sB + vv * 136 + kb + 24) = ns3;
        const u32x4 r0 = nr0, r1 = nr1;
        if (unit + F.G < 2048) GO_LOAD(unit + F.G);
        __syncthreads();
        {
            const int w = F.wave, l = F.lane, fr = l & 15, fq = l >> 4, m = w & 3, nh = w >> 2;
            f32x4 acc[4];
#pragma unroll
            for (int n = 0; n < 4; ++n) acc[n] = (f32x4){0.f, 0.f, 0.f, 0.f};
#pragma unroll
            for (int ks = 0; ks < 4; ++ks) {
                const bf16x8 a = *(const LAS bf16x8*)(qA + (16 * m + fr) * 136 + 32 * ks + 8 * fq);
#pragma unroll
                for (int n = 0; n < 4; ++n) { const bf16x8 bb = *(const LAS bf16x8*)(sB + (16 * (4 * nh + n) + fr) * 136 + 32 * ks + 8 * fq);
                    acc[n] = __builtin_amdgcn_mfma_f32_16x16x32_bf16(a, bb, acc[n], 0, 0, 0); }
            }
            const float scale = 0.08838834764831845f;
#pragma unroll
            for (int n = 0; n < 4; ++n)
#pragma unroll
                for (int jj = 0; jj < 4; ++jj) oF[(16 * m + 4 * fq + jj) * 132 + 16 * (4 * nh + n) + fr] = acc[n][jj] * scale;
        }
        __syncthreads();
        {
            float o[16]; float ss = 0.f;
#pragma unroll
            for (int i = 0; i < 16; ++i) { o[i] = oF[s * 132 + cb + i]; ss += o[i] * o[i]; }
            ss += __shfl_xor(ss, 1); ss += __shfl_xor(ss, 2); ss += __shfl_xor(ss, 4);
            const float rstd = 1.f / sqrtf(ss * (1.f / 128.f) + EPS);
            const unsigned rw[8] = {r0.x, r0.y, r0.z, r0.w, r1.x, r1.y, r1.z, r1.w};
            const float* gg = A.in[I_GLAG] + h * 128 + cb;
            unsigned ow[8];
#pragma unroll
            for (int i = 0; i < 8; ++i) { const float y0 = o[2 * i] * rstd * gg[2 * i] * siluf_(bflo(rw[i])), y1 = o[2 * i + 1] * rstd * gg[2 * i + 1] * siluf_(bfhi(rw[i])); ow[i] = pk2(y0, y1); }
            bf16_t* yp = DRY ? (bf16_t*)A.out + (size_t)(t0 + s) * 512 + h * 128 + cb : P + (size_t)(t0 + s) * PLD + PC_R + h * 128 + cb;
            *(u32x4*)yp = (u32x4){ow[0], ow[1], ow[2], ow[3]}; *(u32x4*)(yp + 8) = (u32x4){ow[4], ow[5], ow[6], ow[7]};
        }
    }
#undef GO_LOAD
}

__device__ __forceinline__ unsigned ordkey(float v) { const unsigned u = __builtin_bit_cast(unsigned, v); return u ^ ((unsigned)((int)u >> 31) | 0x80000000u); }
__device__ __forceinline__ float unord(unsigned k) { const unsigned u = (k & 0x80000000u) ? (k & 0x7fffffffu) : ~k; return __builtin_bit_cast(float, u); }
#define INS16(r, xin) do { unsigned _x = (xin); _Pragma("unroll") for (int _i = 0; _i < 16; ++_i) { const unsigned _h = max((r)[_i], _x); _x = min((r)[_i], _x); (r)[_i] = _h; } } while (0)

#define CE(a, b) do { const unsigned _h = max((a), (b)), _l = min((a), (b)); (a) = _h; (b) = _l; } while (0)
#define SORT16(v) do { CE(v[0], v[1]); CE(v[2], v[3]); CE(v[0], v[2]); CE(v[1], v[3]); CE(v[1], v[2]); CE(v[4], v[5]); CE(v[6], v[7]); CE(v[4], v[6]); CE(v[5], v[7]); CE(v[5], v[6]); CE(v[0], v[4]); CE(v[2], v[6]); CE(v[2], v[4]); CE(v[1], v[5]); CE(v[3], v[7]); CE(v[3], v[5]); CE(v[1], v[2]); CE(v[3], v[4]); CE(v[5], v[6]); CE(v[8], v[9]); CE(v[10], v[11]); CE(v[8], v[10]); CE(v[9], v[11]); CE(v[9], v[10]); CE(v[12], v[13]); CE(v[14], v[15]); CE(v[12], v[14]); CE(v[13], v[15]); CE(v[13], v[14]); CE(v[8], v[12]); CE(v[10], v[14]); CE(v[10], v[12]); CE(v[9], v[13]); CE(v[11], v[15]); CE(v[11], v[13]); CE(v[9], v[10]); CE(v[11], v[12]); CE(v[13], v[14]); CE(v[0], v[8]); CE(v[4], v[12]); CE(v[4], v[8]); CE(v[2], v[10]); CE(v[6], v[14]); CE(v[6], v[10]); CE(v[2], v[4]); CE(v[6], v[8]); CE(v[10], v[12]); CE(v[1], v[9]); CE(v[5], v[13]); CE(v[5], v[9]); CE(v[3], v[11]); CE(v[7], v[15]); CE(v[7], v[11]); CE(v[3], v[5]); CE(v[7], v[9]); CE(v[11], v[13]); CE(v[1], v[2]); CE(v[3], v[4]); CE(v[5], v[6]); CE(v[7], v[8]); CE(v[9], v[10]); CE(v[11], v[12]); CE(v[13], v[14]); } while (0)
#define MERGE16(T, S) do { _Pragma("unroll") for (int _i = 0; _i < 16; ++_i) (T)[_i] = max((T)[_i], (S)[15 - _i]); \
    _Pragma("unroll") for (int _d = 8; _d >= 1; _d >>= 1) { _Pragma("unroll") for (int _i = 0; _i < 16; ++_i) if ((_i & _d) == 0) CE((T)[_i], (T)[_i + _d]); } } while (0)
__device__ __forceinline__ void peer_topk(const Frame& F, const Args& A) {
    const bf16_t* SC = (const bf16_t*)(A.ws + WS_P + P_SC);
    int* IDX = (int*)(A.ws + WS_P + P_IDX); float* GATE = (float*)(A.ws + WS_P + P_GATE);
    const int gw = F.bid * NWAVES + F.wave, NGW = F.G * NWAVES;
    for (int it = gw; it < 512 * 8; it += NGW) {
        const int h = it & 7, tb = it >> 3; const int tok = tb * 64 + F.lane;
        unsigned r1[16], r2[16], rc[16];
        const bf16_t* p1 = SC + ((size_t)(tok >> 4) * 256 + h * 32) * 128 + (tok & 15) * 8; const bf16_t* p2 = p1 + 16 * 128;
        {
            float raw[128]; unsigned sg[16];
#pragma unroll
            for (int jq = 0; jq < 16; ++jq) { const u32x4 t4 = *(const u32x4*)(p1 + jq * 128);
#pragma unroll
                for (int c = 0; c < 4; ++c) { raw[8 * jq + 2 * c] = bflo(t4[c]); raw[8 * jq + 2 * c + 1] = bfhi(t4[c]); } }
#pragma unroll
            for (int j = 0; j < 16; ++j) r1[j] = (ordkey(raw[j]) & ~127u) | (unsigned)(127 - j);
            SORT16(r1);
#pragma unroll
            for (int gq = 1; gq < 8; ++gq) {
#pragma unroll
                for (int j = 0; j < 16; ++j) sg[j] = (ordkey(raw[16 * gq + j]) & ~127u) | (unsigned)(127 - (16 * gq + j));
                SORT16(sg); MERGE16(r1, sg); }
#pragma unroll
            for (int jq = 0; jq < 16; ++jq) { const u32x4 t4 = *(const u32x4*)(p2 + jq * 128);
#pragma unroll
                for (int c = 0; c < 4; ++c) { raw[8 * jq + 2 * c] = bflo(t4[c]); raw[8 * jq + 2 * c + 1] = bfhi(t4[c]); } }
#pragma unroll
            for (int j = 0; j < 16; ++j) r2[j] = (ordkey(raw[j]) & ~127u) | (unsigned)(127 - j);
            SORT16(r2);
#pragma unroll
            for (int gq = 1; gq < 8; ++gq) {
#pragma unroll
                for (int j = 0; j < 16; ++j) sg[j] = (ordkey(raw[16 * gq + j]) & ~127u) | (unsigned)(127 - (16 * gq + j));
                SORT16(sg); MERGE16(r2, sg); }
        }
        float v1[16], v2[16];
#pragma unroll
        for (int i = 0; i < 16; ++i) { v1[i] = unord((r1[i] & ~127u) | 64u); v2[i] = unord((r2[i] & ~127u) | 64u); }
        {
            unsigned cg[4][16]; int cn = 0;
#pragma unroll
            for (int a = 0; a < 16; ++a)
#pragma unroll
                for (int bq = 0; bq < 16; ++bq) if ((a + 1) * (bq + 1) <= 16) { cg[cn >> 4][cn & 15] = (ordkey(v1[a] + v2[bq]) & ~255u) | (unsigned)(a * 16 + bq); ++cn; }
#pragma unroll
            for (int z = 50; z < 64; ++z) cg[z >> 4][z & 15] = 0u;
            SORT16(cg[0]); SORT16(cg[1]); SORT16(cg[2]); SORT16(cg[3]);
            MERGE16(cg[0], cg[1]); MERGE16(cg[0], cg[2]); MERGE16(cg[0], cg[3]);
#pragma unroll
            for (int i = 0; i < 16; ++i) rc[i] = cg[0][i];
        }
        float val[16]; int ex[16];
        {
            LAS unsigned* t1 = (LAS unsigned*)(F.lds + F.wave * 8704) + F.lane * 17; LAS unsigned* t2 = t1 + 64 * 17;
#pragma unroll
            for (int i = 0; i < 16; ++i) { t1[i] = r1[i]; t2[i] = r2[i]; }
            LDS_WAIT(); asm volatile("" ::: "memory");
#pragma unroll
            for (int w = 0; w < 16; ++w) {
                const int a = (rc[w] >> 4) & 15, bq = rc[w] & 15;
                const unsigned k1 = t1[a], k2 = t2[bq];
                val[w] = unord((k1 & ~127u) | 64u) + unord((k2 & ~127u) | 64u);
                ex[w] = (127 - (int)(k1 & 127u)) * 128 + (127 - (int)(k2 & 127u));
            }
            LDS_WAIT(); asm volatile("" ::: "memory");
        }
        float mx = val[0];
#pragma unroll
        for (int w = 1; w < 16; ++w) mx = fmaxf(mx, val[w]);
        float sum = 0.f;
#pragma unroll
        for (int w = 0; w < 16; ++w) { val[w] = __expf(val[w] - mx); sum += val[w]; }
        const float inv = 1.f / sum;
        int* ip = IDX + (size_t)tok * 128 + h * 16; float* gp = GATE + (size_t)tok * 128 + h * 16;
#pragma unroll
        for (int q = 0; q < 4; ++q) { *(int4*)(ip + 4 * q) = make_int4(ex[4 * q], ex[4 * q + 1], ex[4 * q + 2], ex[4 * q + 3]);
            *(f32x4*)(gp + 4 * q) = (f32x4){val[4 * q] * inv, val[4 * q + 1] * inv, val[4 * q + 2] * inv, val[4 * q + 3] * inv}; }
    }
}

#define DPP_ADD(v, ctrl) ((v) + __builtin_bit_cast(float, __builtin_amdgcn_mov_dpp(__builtin_bit_cast(int, (v)), (ctrl), 0xf, 0xf, true)))
__device__ __forceinline__ void fp8x16_to_f32x2(const u32x4 r, f32x2* f) {
#pragma unroll
    for (int q = 0; q < 4; ++q) { f[2 * q] = __builtin_amdgcn_cvt_pk_f32_fp8((int)r[q], false); f[2 * q + 1] = __builtin_amdgcn_cvt_pk_f32_fp8((int)r[q], true); }
}
__device__ __forceinline__ void fp8x16_to_f32(const u32x4 r, float* f) {
#pragma unroll
    for (int q = 0; q < 4; ++q) { const f32x2 lo = __builtin_amdgcn_cvt_pk_f32_fp8((int)r[q], false), hi = __builtin_amdgcn_cvt_pk_f32_fp8((int)r[q], true);
        f[4 * q] = lo.x; f[4 * q + 1] = lo.y; f[4 * q + 2] = hi.x; f[4 * q + 3] = hi.y; }
}
__device__ __forceinline__ long lo64(u32x4 v) { return (long)(((unsigned long)v.y << 32) | (unsigned long)v.x); }
__device__ __forceinline__ long hi64(u32x4 v) { return (long)(((unsigned long)v.w << 32) | (unsigned long)v.z); }
template <int MODE>
__device__ __forceinline__ void peer_u_phase(const Frame& F, const Args& A) {
    const unsigned char* X8 = A.ws + WS_P + P_X8;
    const unsigned char* U8 = A.ws + WS_U8; const float* SU = (const float*)(A.ws + WS_SU); const float* SV = (const float*)(A.ws + WS_SV);
    const int* IDX = (const int*)(A.ws + WS_P + P_IDX); const float* GATE = (const float*)(A.ws + WS_P + P_GATE); float* AK = (float*)(MODE == 0 ? A.ws + WS_AK : A.ws + WS_P + P_SC);
    const int g = F.bid & 7, nmem = F.G >> 3, l = F.lane, step = nmem * NWAVES;
    const int loff = 64 * (l & 15) + 16 * (l >> 4);
    const bool dg = ((l & 15) >> 2) == (l >> 4); const int dr = l & 3;
    const float dw0 = (dg && dr == 0) ? 1.f : 0.f, dw1 = (dg && dr == 1) ? 1.f : 0.f, dw2 = (dg && dr == 2) ? 1.f : 0.f, dw3 = (dg && dr == 3) ? 1.f : 0.f;
    LAS int* le = (LAS int*)(F.lds + F.wave * 2048); LAS int* lk = le + 256;
    const bool b5 = (l & 32) != 0, b4 = (l & 16) != 0, b3 = (l & 8) != 0;
    int tok = 2 * ((F.bid >> 3) * NWAVES + F.wave);
    u32x4 nxA, nxB; int neA0, neA1, neB0, neB1; float ngA0, ngA1, ngB0, ngB1;
#define U_PREFETCH(t) do { const size_t _tA = (size_t)(t), _tB = (size_t)(t) + 1; if (MODE == 4) { nxA = (u32x4){(unsigned)_tA, 1u, 2u, 3u}; nxB = nxA; neA0 = (int)((_tA * 37 + l * 11) & 16383); neA1 = (int)((_tA * 53 + l * 7) & 16383); neB0 = (int)((_tB * 37 + l * 13) & 16383); neB1 = (int)((_tB * 29 + l * 3) & 16383); ngA0 = ngA1 = ngB0 = ngB1 = 0.01f; break; } nxA = *(const u32x4*)(X8 + _tA * 1024 + loff); nxB = *(const u32x4*)(X8 + _tB * 1024 + loff); \
        neA0 = IDX[_tA * 128 + l]; neA1 = IDX[_tA * 128 + 64 + l]; neB0 = IDX[_tB * 128 + l]; neB1 = IDX[_tB * 128 + 64 + l]; \
        ngA0 = GATE[_tA * 128 + l]; ngA1 = GATE[_tA * 128 + 64 + l]; ngB0 = GATE[_tB * 128 + l]; ngB1 = GATE[_tB * 128 + 64 + l]; } while (0)
    if (tok + 1 < T_TOK) U_PREFETCH(tok);
    for (; tok + 1 < T_TOK; tok += 2 * step) {
        const int tokA = tok, tokB = tok + 1;
        const u32x4 xA = nxA, xB = nxB;
        const int eA0 = neA0, eA1 = neA1, eB0 = neB0, eB1 = neB1; const float gA0 = ngA0, gA1 = ngA1, gB0 = ngB0, gB1 = ngB1;
        bool pf_done = false;
        const bool oA0 = (eA0 & 7) == g, oA1 = (eA1 & 7) == g, oB0 = (eB0 & 7) == g, oB1 = (eB1 & 7) == g;
        const unsigned long long mA0 = __ballot(oA0), mA1 = __ballot(oA1), mB0 = __ballot(oB0), mB1 = __ballot(oB1);
        const int c0 = __popcll(mA0), c1 = c0 + __popcll(mA1), c2 = c1 + __popcll(mB0), n = c2 + __popcll(mB1);
#define MBC(m) __builtin_amdgcn_mbcnt_hi((unsigned)((m) >> 32), __builtin_amdgcn_mbcnt_lo((unsigned)(m), 0u))
        if (oA0) { const int p = MBC(mA0); le[p] = (eA0 << 8) | l; lk[p] = __builtin_bit_cast(int, gA0); }
        if (oA1) { const int p = c0 + MBC(mA1); le[p] = (eA1 << 8) | (64 + l); lk[p] = __builtin_bit_cast(int, gA1); }
        if (oB0) { const int p = c1 + MBC(mB0); le[p] = (eB0 << 8) | 128 | l; lk[p] = __builtin_bit_cast(int, gB0); }
        if (oB1) { const int p = c2 + MBC(mB1); le[p] = (eB1 << 8) | 128 | (64 + l); lk[p] = __builtin_bit_cast(int, gB1); }
#undef MBC
        LDS_WAIT(); asm volatile("" ::: "memory");
        for (int cb = 0; cb < n || cb == 0; cb += 64) {
        const int nc = min(n, cb + 64);
        const bool fv = (cb + l) < nc;
        const int ent = fv ? le[cb + l] : 0; const float gt = fv ? __builtin_bit_cast(float, lk[cb + l]) : 0.f; float tot = 0.f;
        const float su = SU[ent >> 8], sv = SV[ent >> 8];
        const unsigned long long radr = (unsigned long long)(U8 + (size_t)(((ent >> 8) & 7) * 2048 + (((ent >> 8) >> 3) & (MODE == 2 ? 255 : 2047))) * 1024);
        const int ralo = (int)(unsigned)radr, rahi = (int)(unsigned)(radr >> 32);
        for (int i = cb; i < nc; i += 16) {
            u32x4 row[2][8];
#pragma unroll
            for (int b = 0; b < 2; ++b) if (i + 8 * b < nc) {
#pragma unroll
                for (int j = 0; j < 8; ++j) { const int ln = min(i + 8 * b + j, nc - 1) - cb;
                    const unsigned lo = (unsigned)__builtin_amdgcn_readlane(ralo, ln), hi = (unsigned)__builtin_amdgcn_readlane(rahi, ln);
                    const GAS unsigned char* rp = (const GAS unsigned char*)(((unsigned long long)hi << 32) | lo);
                    row[b][j] = *(const GAS u32x4*)(rp + (unsigned)loff); } }
            if (!pf_done) { pf_done = true; if (tok + 2 * step + 1 < T_TOK) U_PREFETCH(tok + 2 * step); }
#pragma unroll
            for (int b = 0; b < 2; ++b) if (i + 8 * b < nc) {
                float p[8];
                f32x4 accj[8];
                const int base0 = i + 8 * b;
                if (base0 + 8 <= c1) {
#pragma unroll
                    for (int j = 0; j < 8; ++j) accj[j] = __builtin_amdgcn_mfma_f32_16x16x32_fp8_fp8(lo64(row[b][j]), lo64(xA), (f32x4){0.f, 0.f, 0.f, 0.f}, 0, 0, 0);
#pragma unroll
                    for (int j = 0; j < 8; ++j) accj[j] = __builtin_amdgcn_mfma_f32_16x16x32_fp8_fp8(hi64(row[b][j]), hi64(xA), accj[j], 0, 0, 0);
                } else if (base0 >= c1) {
#pragma unroll
                    for (int j = 0; j < 8; ++j) accj[j] = __builtin_amdgcn_mfma_f32_16x16x32_fp8_fp8(lo64(row[b][j]), lo64(xB), (f32x4){0.f, 0.f, 0.f, 0.f}, 0, 0, 0);
#pragma unroll
                    for (int j = 0; j < 8; ++j) accj[j] = __builtin_amdgcn_mfma_f32_16x16x32_fp8_fp8(hi64(row[b][j]), hi64(xB), accj[j], 0, 0, 0);
                } else {
#pragma unroll
                    for (int j = 0; j < 8; ++j) { const u32x4 xs = (base0 + j >= c1) ? xB : xA; accj[j] = __builtin_amdgcn_mfma_f32_16x16x32_fp8_fp8(lo64(row[b][j]), lo64(xs), (f32x4){0.f, 0.f, 0.f, 0.f}, 0, 0, 0);
                        accj[j] = __builtin_amdgcn_mfma_f32_16x16x32_fp8_fp8(hi64(row[b][j]), hi64(xs), accj[j], 0, 0, 0); }
                }
#pragma unroll
                for (int j = 0; j < 8; ++j) p[j] = __builtin_fmaf(accj[j][3], dw3, __builtin_fmaf(accj[j][2], dw2, __builtin_fmaf(accj[j][1], dw1, accj[j][0] * dw0)));
                float q4[4], q2[2], q1;
#pragma unroll
                for (int j = 0; j < 4; ++j) { const float keep = b5 ? p[4 + j] : p[j], send = b5 ? p[j] : p[4 + j]; q4[j] = keep + __shfl_xor(send, 32); }
#pragma unroll
                for (int j = 0; j < 2; ++j) { const float keep = b4 ? q4[2 + j] : q4[j], send = b4 ? q4[j] : q4[2 + j]; q2[j] = keep + __shfl_xor(send, 16); }
                { const float keep = b3 ? q2[1] : q2[0], send = b3 ? q2[0] : q2[1]; q1 = keep + __shfl_xor(send, 8); }
                q1 = DPP_ADD(q1, 0xB1); q1 = DPP_ADD(q1, 0x4E); q1 = DPP_ADD(q1, 0x141);
                const float t = __builtin_bit_cast(float, __builtin_amdgcn_ds_bpermute((l & 7) * 32, __builtin_bit_cast(int, q1)));
                const int base = i + 8 * b;
                if ((l >> 3) == ((base - cb) >> 3)) tot = t;
            }
        }
        if (!pf_done) { if (tok + 2 * step + 1 < T_TOK) U_PREFETCH(tok + 2 * step); }
        if (fv) { const int tk = (ent & 128) ? tokB : tokA; AK[(size_t)tk * 128 + (ent & 127)] = gelu_tanh(tot * su * (1.f / 16.f)) * gt * sv; }
        if (n == 0) break;
        }
        LDS_WAIT(); asm volatile("" ::: "memory");
    }
#undef U_PREFETCH
}
template <int MODE>
__device__ __forceinline__ void peer_u_phase1(const Frame& F, const Args& A) {
    const unsigned char* X8 = A.ws + WS_P + P_X8;
    const unsigned char* U8 = A.ws + WS_U8; const float* SU = (const float*)(A.ws + WS_SU); const float* SV = (const float*)(A.ws + WS_SV);
    const int* IDX = (const int*)(A.ws + WS_P + P_IDX); const float* GATE = (const float*)(A.ws + WS_P + P_GATE); float* AK = (float*)(MODE == 0 ? A.ws + WS_AK : A.ws + WS_P + P_SC);
    const int g = F.bid & (UNG - 1), nmem = F.G >> UNG_SH, l = F.lane, step = nmem * NWAVES;
    const int loff = 64 * (l & 15) + 16 * (l >> 4);
    const bool dg = ((l & 15) >> 2) == (l >> 4); const int dr = l & 3;
    const float dw0 = (dg && dr == 0) ? 1.f : 0.f, dw1 = (dg && dr == 1) ? 1.f : 0.f, dw2 = (dg && dr == 2) ? 1.f : 0.f, dw3 = (dg && dr == 3) ? 1.f : 0.f;
    LAS int* le = (LAS int*)(F.lds + F.wave * 2048); LAS int* lk = le + 256;
    const bool b5 = (l & 32) != 0, b4 = (l & 16) != 0, b3 = (l & 8) != 0;
    int tok = (F.bid >> UNG_SH) * NWAVES + F.wave;
    u32x4 nxA; int neA0, neA1; float ngA0, ngA1;
#define U1_PREFETCH(t) do { const size_t _tA = (size_t)(t); nxA = *(const u32x4*)(X8 + _tA * 1024 + loff); \
        neA0 = IDX[_tA * 128 + l]; neA1 = IDX[_tA * 128 + 64 + l]; ngA0 = GATE[_tA * 128 + l]; ngA1 = GATE[_tA * 128 + 64 + l]; } while (0)
    if (tok < T_TOK) U1_PREFETCH(tok);
    for (; tok < T_TOK; tok += step) {
        const u32x4 xA = nxA;
        const int eA0 = neA0, eA1 = neA1; const float gA0 = ngA0, gA1 = ngA1;
        bool pf_done = false;
        const bool oA0 = (eA0 & (UNG - 1)) == g, oA1 = (eA1 & (UNG - 1)) == g;
        const unsigned long long mA0 = __ballot(oA0), mA1 = __ballot(oA1);
        const int c0 = __popcll(mA0), n = c0 + __popcll(mA1);
#define MBC(m) __builtin_amdgcn_mbcnt_hi((unsigned)((m) >> 32), __builtin_amdgcn_mbcnt_lo((unsigned)(m), 0u))
        if (oA0) { const int p = MBC(mA0); le[p] = (eA0 << 8) | l; lk[p] = __builtin_bit_cast(int, gA0); }
        if (oA1) { const int p = c0 + MBC(mA1); le[p] = (eA1 << 8) | (64 + l); lk[p] = __builtin_bit_cast(int, gA1); }
#undef MBC
        LDS_WAIT(); asm volatile("" ::: "memory");
        for (int cb = 0; cb < n || cb == 0; cb += 64) {
        const int nc = min(n, cb + 64);
        const bool fv = (cb + l) < nc;
        const int ent = fv ? le[cb + l] : 0; const float gt = fv ? __builtin_bit_cast(float, lk[cb + l]) : 0.f; float tot = 0.f;
        const float su = SU[ent >> 8], sv = SV[ent >> 8];
        const unsigned long long radr = (unsigned long long)(U8 + (size_t)(((ent >> 8) & (UNG - 1)) * (NEXP / UNG) + ((ent >> 8) >> UNG_SH)) * 1024);
        const int ralo = (int)(unsigned)radr, rahi = (int)(unsigned)(radr >> 32);
        for (int i = cb; i < nc; i += 16) {
            u32x4 row[2][8];
#pragma unroll
            for (int b = 0; b < 2; ++b) if (i + 8 * b < nc) {
#pragma unroll
                for (int j = 0; j < 8; ++j) { const int ln = min(i + 8 * b + j, nc - 1) - cb;
                    const unsigned lo = (unsigned)__builtin_amdgcn_readlane(ralo, ln), hi = (unsigned)__builtin_amdgcn_readlane(rahi, ln);
                    const GAS unsigned char* rp = (const GAS unsigned char*)(((unsigned long long)hi << 32) | lo);
                    row[b][j] = *(const GAS u32x4*)(rp + (unsigned)loff); } }
            if (!pf_done) { pf_done = true; if (tok + step < T_TOK) U1_PREFETCH(tok + step); }
#pragma unroll
            for (int b = 0; b < 2; ++b) if (i + 8 * b < nc) {
                float p[8]; f32x4 accj[8];
#pragma unroll
                for (int j = 0; j < 8; ++j) accj[j] = __builtin_amdgcn_mfma_f32_16x16x32_fp8_fp8(lo64(row[b][j]), lo64(xA), (f32x4){0.f, 0.f, 0.f, 0.f}, 0, 0, 0);
#pragma unroll
                for (int j = 0; j < 8; ++j) accj[j] = __builtin_amdgcn_mfma_f32_16x16x32_fp8_fp8(hi64(row[b][j]), hi64(xA), accj[j], 0, 0, 0);
#pragma unroll
                for (int j = 0; j < 8; ++j) p[j] = __builtin_fmaf(accj[j][3], dw3, __builtin_fmaf(accj[j][2], dw2, __builtin_fmaf(accj[j][1], dw1, accj[j][0] * dw0)));
                float q4[4], q2[2], q1;
#pragma unroll
                for (int j = 0; j < 4; ++j) { const float keep = b5 ? p[4 + j] : p[j], send = b5 ? p[j] : p[4 + j]; q4[j] = keep + __shfl_xor(send, 32); }
#pragma unroll
                for (int j = 0; j < 2; ++j) { const float keep = b4 ? q4[2 + j] : q4[j], send = b4 ? q4[j] : q4[2 + j]; q2[j] = keep + __shfl_xor(send, 16); }
                { const float keep = b3 ? q2[1] : q2[0], send = b3 ? q2[0] : q2[1]; q1 = keep + __shfl_xor(send, 8); }
                q1 = DPP_ADD(q1, 0xB1); q1 = DPP_ADD(q1, 0x4E); q1 = DPP_ADD(q1, 0x141);
                const float t = __builtin_bit_cast(float, __builtin_amdgcn_ds_bpermute((l & 7) * 32, __builtin_bit_cast(int, q1)));
                const int base = i + 8 * b;
                if ((l >> 3) == ((base - cb) >> 3)) tot = t;
            }
        }
        if (!pf_done) { pf_done = true; if (tok + step < T_TOK) U1_PREFETCH(tok + step); }
        if (fv) AK[(size_t)tok * 128 + (ent & 127)] = gelu_tanh(tot * su * (1.f / 16.f)) * gt * sv;
        if (n == 0) break;
        }
        LDS_WAIT(); asm volatile("" ::: "memory");
    }
#undef U1_PREFETCH
}
template <int MODE>
__device__ __forceinline__ void peer_u4_phase(const Frame& F, const Args& A) {
    const unsigned char* X8 = A.ws + WS_P + P_X8;
    const float* SU = (const float*)(A.ws + WS_SU); const float* SV = (const float*)(A.ws + WS_SV);
    const int* IDX = (const int*)(A.ws + WS_P + P_IDX); const float* GATE = (const float*)(A.ws + WS_P + P_GATE); float* AK = (float*)(MODE == 0 ? A.ws + WS_AK : A.ws + WS_P + P_SC);
    const int g = F.bid & (UNG - 1), nmem = F.G >> UNG_SH, l = F.lane, step = nmem * NWAVES;
    const int m = l & 15, q = l >> 4;
    const GAS unsigned char* ub = (const GAS unsigned char*)(A.ws + WS_U8 + (size_t)g * (NEXP / UNG) * 512);
    const unsigned lconst = 16u * (unsigned)(4 * (m & 7) + q);
    const int xoff = 128 * (m & 7) + 16 * q;
    const bool dg = (m < 8) && ((m >> 2) == (q & 1)); const int dr = m & 3;
    const float dw0 = (dg && dr == 0) ? 1.f : 0.f, dw1 = (dg && dr == 1) ? 1.f : 0.f, dw2 = (dg && dr == 2) ? 1.f : 0.f, dw3 = (dg && dr == 3) ? 1.f : 0.f;
    const int rsel = 4 * (m >> 3);
    const int osrc = 4 * (32 * (l & 1) + 4 * ((l & 15) >> 1));
    const int sc1 = 0x7F7F7F7F;
    LAS int* le = (LAS int*)(F.lds + F.wave * 2048); LAS int* lk = le + 256;
    const bool b4 = (l & 16) != 0, b3 = (l & 8) != 0, b2 = (l & 4) != 0;
    int tok = (F.bid >> UNG_SH) * NWAVES + F.wave;
    u32x4 nx0, nx1; int ne0, ne1; float ng0, ng1;
#define U4_PREFETCH(t) do { const size_t _t = (size_t)(t); nx0 = *(const u32x4*)(X8 + _t * 1024 + xoff); nx1 = *(const u32x4*)(X8 + _t * 1024 + xoff + 64); \
        ne0 = IDX[_t * 128 + l]; ne1 = IDX[_t * 128 + 64 + l]; ng0 = GATE[_t * 128 + l]; ng1 = GATE[_t * 128 + 64 + l]; } while (0)
    if (tok < T_TOK) U4_PREFETCH(tok);
    for (; tok < T_TOK; tok += step) {
        const i32x8 xb = __builtin_shufflevector(__builtin_bit_cast(i32x4, nx0), __builtin_bit_cast(i32x4, nx1), 0, 1, 2, 3, 4, 5, 6, 7);
        const int e0 = ne0, e1 = ne1; const float g0 = ng0, g1 = ng1;
        bool pf_done = false;
        const bool o0 = (e0 & (UNG - 1)) == g, o1 = (e1 & (UNG - 1)) == g;
        const unsigned long long m0 = __ballot(o0), m1 = __ballot(o1);
        const int c0 = __popcll(m0), n = c0 + __popcll(m1);
#define MBC(mm) __builtin_amdgcn_mbcnt_hi((unsigned)((mm) >> 32), __builtin_amdgcn_mbcnt_lo((unsigned)(mm), 0u))
        if (o0) { const int p = MBC(m0); le[p] = (e0 << 8) | l; lk[p] = __builtin_bit_cast(int, g0); }
        if (o1) { const int p = c0 + MBC(m1); le[p] = (e1 << 8) | (64 + l); lk[p] = __builtin_bit_cast(int, g1); }
#undef MBC
        LDS_WAIT(); asm volatile("" ::: "memory");
        for (int cb = 0; cb < n || cb == 0; cb += 64) {
            const int nc = min(n, cb + 64);
            const bool fv = (cb + l) < nc;
            const int ent = fv ? le[cb + l] : 0; const float gt = fv ? __builtin_bit_cast(float, lk[cb + l]) : 0.f; float tot = 0.f;
            const float su = SU[ent >> 8], sv = SV[ent >> 8];
            const int roff = fv ? ((ent >> 8) >> UNG_SH) * 512 : 0;
            for (int i = cb; i < nc; i += 32) {
                u32x4 row[2][8];
#pragma unroll
                for (int b = 0; b < 2; ++b) if (i + 16 * b < nc) {
#pragma unroll
                    for (int j = 0; j < 8; ++j) { const int ro = __builtin_amdgcn_ds_bpermute(rsel + 4 * (i - cb + 16 * b + 2 * j), roff);
                        row[b][j] = *(const GAS u32x4*)(ub + ((unsigned)ro + lconst)); } }
                if (!pf_done) { pf_done = true; if (tok + step < T_TOK) U4_PREFETCH(tok + step); }
#pragma unroll
                for (int b = 0; b < 2; ++b) if (i + 16 * b < nc) {
                    float p[8];
#pragma unroll
                    for (int j = 0; j < 8; ++j) { const i32x4 r4 = __builtin_bit_cast(i32x4, row[b][j]);
                        const f32x4 d = __builtin_amdgcn_mfma_scale_f32_16x16x128_f8f6f4(__builtin_shufflevector(r4, r4, 0, 1, 2, 3, -1, -1, -1, -1), xb, (f32x4){0.f, 0.f, 0.f, 0.f}, 4, 0, 0, sc1, 0, sc1);
                        p[j] = __builtin_fmaf(d[3], dw3, __builtin_fmaf(d[2], dw2, __builtin_fmaf(d[1], dw1, d[0] * dw0))); }
                    float q4[4], q2[2], q1;
#pragma unroll
                    for (int j = 0; j < 4; ++j) { const float keep = b4 ? p[4 + j] : p[j], send = b4 ? p[j] : p[4 + j]; q4[j] = keep + __shfl_xor(send, 16); }
#pragma unroll
                    for (int j = 0; j < 2; ++j) { const float keep = b3 ? q4[2 + j] : q4[j], send = b3 ? q4[j] : q4[2 + j]; q2[j] = keep + __shfl_xor(send, 8); }
                    { const float keep = b2 ? q2[1] : q2[0], send = b2 ? q2[0] : q2[1]; q1 = keep + __shfl_xor(send, 4); }
                    q1 = DPP_ADD(q1, 0xB1); q1 = DPP_ADD(q1, 0x4E);
                    const float t = __builtin_bit_cast(float, __builtin_amdgcn_ds_bpermute(osrc, __builtin_bit_cast(int, q1)));
                    if ((l >> 4) == ((i - cb + 16 * b) >> 4)) tot = t;
                }
            }
            if (!pf_done) { pf_done = true; if (tok + step < T_TOK) U4_PREFETCH(tok + step); }
            if (fv) AK[(size_t)tok * 128 + (ent & 127)] = gelu_tanh(tot * su * (1.f / 16.f)) * gt * sv;
            if (n == 0) break;
        }
        LDS_WAIT(); asm volatile("" ::: "memory");
    }
#undef U4_PREFETCH
}
template <int MODE>
__device__ __forceinline__ void peer_u4_all(const Frame& F, const Args& A) {
    const unsigned char* X8 = A.ws + WS_P + P_X8;
    const float* SU = (const float*)(A.ws + WS_SU); const float* SV = (const float*)(A.ws + WS_SV);
    const int* IDX = (const int*)(A.ws + WS_P + P_IDX); const float* GATE = (const float*)(A.ws + WS_P + P_GATE); float* AK = (float*)(MODE == 0 ? A.ws + WS_AK : A.ws + WS_P + P_SC);
    const int l = F.lane, step = F.G * NWAVES;
    const int m = l & 15, q = l >> 4;
    const GAS unsigned char* ub = (const GAS unsigned char*)(A.ws + WS_U8);
    const unsigned lconst = 16u * (unsigned)(8 * q + (m & 7));
    const int xoff = 256 * (q >> 1) + 32 * (m & 7) + 16 * (q & 1);
    const bool dg = (m < 8) && ((m >> 2) == (q & 1)); const int dr = m & 3;
    const float dw0 = (dg && dr == 0) ? 1.f : 0.f, dw1 = (dg && dr == 1) ? 1.f : 0.f, dw2 = (dg && dr == 2) ? 1.f : 0.f, dw3 = (dg && dr == 3) ? 1.f : 0.f;
    const int rsel = 4 * (m >> 3);
    const int osrc = 4 * (32 * (l & 1) + 4 * ((l & 15) >> 1));
    const int sc1 = 0x7F7F7F7F;
    const bool b4 = (l & 16) != 0, b3 = (l & 8) != 0, b2 = (l & 4) != 0;
    const int lhi = l >> 4;
    int tok = F.bid * NWAVES + F.wave;
    u32x4 nx0, nx1; int ne0, ne1; float ng0, ng1;
#define UA_PREFETCH(t) do { const size_t _t = (size_t)(t); nx0 = *(const u32x4*)(X8 + _t * 1024 + xoff); nx1 = *(const u32x4*)(X8 + _t * 1024 + xoff + 512); \
        ne0 = IDX[_t * 128 + l]; ne1 = IDX[_t * 128 + 64 + l]; ng0 = GATE[_t * 128 + l]; ng1 = GATE[_t * 128 + 64 + l]; } while (0)
#define UA_LOADS(R, ro_, h) do { _Pragma("unroll") for (int j_ = 0; j_ < 16; ++j_) { const int o_ = __builtin_amdgcn_ds_bpermute(rsel + 4 * (32 * (h) + 2 * j_), (ro_)); \
        R[j_] = *(const GAS u32x4*)(ub + ((unsigned)o_ + lconst)); } } while (0)
#define UA_COMPUTE(R, xb_, h, tot_) do { _Pragma("unroll") for (int b_ = 0; b_ < 2; ++b_) { float p_[8]; \
        _Pragma("unroll") for (int j_ = 0; j_ < 8; ++j_) { const i32x4 r4_ = __builtin_bit_cast(i32x4, R[8 * b_ + j_]); \
            const f32x4 d_ = __builtin_amdgcn_mfma_scale_f32_16x16x128_f8f6f4(__builtin_shufflevector(r4_, r4_, 0, 1, 2, 3, -1, -1, -1, -1), (xb_), (f32x4){0.f, 0.f, 0.f, 0.f}, 4, 0, 0, sc1, 0, sc1); \
            p_[j_] = __builtin_fmaf(d_[3], dw3, __builtin_fmaf(d_[2], dw2, __builtin_fmaf(d_[1], dw1, d_[0] * dw0))); } \
        float q4_[4], q2_[2], q1_; \
        _Pragma("unroll") for (int j_ = 0; j_ < 4; ++j_) { const float keep_ = b4 ? p_[4 + j_] : p_[j_], send_ = b4 ? p_[j_] : p_[4 + j_]; q4_[j_] = keep_ + __shfl_xor(send_, 16); } \
        _Pragma("unroll") for (int j_ = 0; j_ < 2; ++j_) { const float keep_ = b3 ? q4_[2 + j_] : q4_[j_], send_ = b3 ? q4_[j_] : q4_[2 + j_]; q2_[j_] = keep_ + __shfl_xor(send_, 8); } \
        { const float keep_ = b2 ? q2_[1] : q2_[0], send_ = b2 ? q2_[0] : q2_[1]; q1_ = keep_ + __shfl_xor(send_, 4); } \
        q1_ = DPP_ADD(q1_, 0xB1); q1_ = DPP_ADD(q1_, 0x4E); \
        const float t_ = __builtin_bit_cast(float, __builtin_amdgcn_ds_bpermute(osrc, __builtin_bit_cast(int, q1_))); \
        if (lhi == 2 * (h) + b_) (tot_) = t_; } } while (0)
    u32x4 RA[16], RB[16];
    if (tok < T_TOK) { UA_PREFETCH(tok); UA_LOADS(RA, ne0 * 512, 0); }
    for (; tok < T_TOK; tok += step) {
        const i32x8 xb = __builtin_shufflevector(__builtin_bit_cast(i32x4, nx0), __builtin_bit_cast(i32x4, nx1), 0, 1, 2, 3, 4, 5, 6, 7);
        const int e0 = ne0, e1 = ne1; const float g0 = ng0, g1 = ng1;
        const int ro0 = e0 * 512, ro1 = e1 * 512;
        const float su0 = SU[e0], sv0 = SV[e0], su1 = SU[e1], sv1 = SV[e1];
        const bool more = tok + step < T_TOK;
        float tot0 = 0.f, tot1 = 0.f;
        UA_LOADS(RB, ro0, 1);
        if (more) UA_PREFETCH(tok + step);
        UA_COMPUTE(RA, xb, 0, tot0);
        UA_LOADS(RA, ro1, 0);
        UA_COMPUTE(RB, xb, 1, tot0);
        UA_LOADS(RB, ro1, 1);
        UA_COMPUTE(RA, xb, 0, tot1);
        if (more) UA_LOADS(RA, ne0 * 512, 0);
        UA_COMPUTE(RB, xb, 1, tot1);
        AK[(size_t)tok * 128 + l] = gelu_tanh(tot0 * su0 * (1.f / 16.f)) * g0 * sv0;
        AK[(size_t)tok * 128 + 64 + l] = gelu_tanh(tot1 * su1 * (1.f / 16.f)) * g1 * sv1;
    }
#undef UA_PREFETCH
#undef UA_LOADS
#undef UA_COMPUTE
}
__device__ __forceinline__ float wave_max_nonneg(float v) {
    unsigned u = __builtin_bit_cast(unsigned, v);
    u = max(u, (unsigned)__builtin_amdgcn_mov_dpp((int)u, 0xB1, 0xf, 0xf, true));
    u = max(u, (unsigned)__builtin_amdgcn_mov_dpp((int)u, 0x4E, 0xf, 0xf, true));
    u = max(u, (unsigned)__builtin_amdgcn_mov_dpp((int)u, 0x141, 0xf, 0xf, true));
    u = max(u, (unsigned)__builtin_amdgcn_mov_dpp((int)u, 0x140, 0xf, 0xf, true));
    const unsigned a = (unsigned)__builtin_amdgcn_readlane((int)u, 0), b = (unsigned)__builtin_amdgcn_readlane((int)u, 16), c = (unsigned)__builtin_amdgcn_readlane((int)u, 32), d = (unsigned)__builtin_amdgcn_readlane((int)u, 48);
    return __builtin_bit_cast(float, max(max(a, b), max(c, d)));
}
template <int MODE>
__device__ __forceinline__ void peer_v_phase(const Frame& F, const Args& A) {
    const unsigned char* V8 = A.ws + WS_V8; const int* IDX = (const int*)(A.ws + WS_P + P_IDX); const float* AK = (const float*)(A.ws + WS_AK);
    float* out = MODE == 0 ? A.out : (float*)(A.ws + WS_P + P_SC);
    const int g = F.bid & 7, nmem = F.G >> 3, l = F.lane, sub = l & 7, rr = l >> 3, n16 = l & 15, q = l >> 4, step = nmem * NWAVES;
    const GAS unsigned char* vb = (const GAS unsigned char*)(V8 + (size_t)g * NEXP * 128);
    LAS unsigned long long* rep = (LAS unsigned long long*)(F.lds + F.wave * 2048);
    const unsigned long long bm = 0xFFull << (8 * (n16 & 7));
    const int repi = 2 * q + (n16 >> 3);
    const bool vl = (n16 < 8) && (q < 2);
    LAS float* stg = (LAS float*)(F.lds + 16384 + F.wave * 512);
    int tok = 2 * ((F.bid >> 3) * NWAVES + F.wave);
    int ne[4]; float na[4];
#define V_PREFETCH(t) do { const size_t _a = (size_t)(t) * 128, _b = ((size_t)(t) + 1) * 128; ne[0] = IDX[_a + l]; ne[1] = IDX[_a + 64 + l]; ne[2] = IDX[_b + l]; ne[3] = IDX[_b + 64 + l]; \
        na[0] = AK[_a + l]; na[1] = AK[_a + 64 + l]; na[2] = AK[_b + l]; na[3] = AK[_b + 64 + l]; } while (0)
    if (tok + 1 < T_TOK) V_PREFETCH(tok);
    for (; tok + 1 < T_TOK; tok += 2 * step) {
        const int e0 = ne[0], e1 = ne[1], e2 = ne[2], e3 = ne[3]; const float a0 = na[0], a1 = na[1], a2 = na[2], a3 = na[3];
        u32x4 rowA[16], rowB[16];
#pragma unroll
        for (int i = 0; i < 16; ++i) { const int src = (8 * (i & 7) + rr) * 4;
            const int ea = __builtin_amdgcn_ds_bpermute(src, i < 8 ? e0 : e1), eb = __builtin_amdgcn_ds_bpermute(src, i < 8 ? e2 : e3);
            rowA[i] = *(const GAS u32x4*)(vb + ((unsigned)ea * 128u + 16u * (unsigned)sub)); rowB[i] = *(const GAS u32x4*)(vb + ((unsigned)eb * 128u + 16u * (unsigned)sub)); }
        f32x4 HA = {0.f, 0.f, 0.f, 0.f}, HB = {0.f, 0.f, 0.f, 0.f};
        if (l < 32) { const float* hpa = out + (size_t)tok * D + g * 128 + 4 * l; HA = *(const f32x4*)hpa; HB = *(const f32x4*)(hpa + D); }
        if (tok + 2 * step + 1 < T_TOK) V_PREFETCH(tok + 2 * step);
        const float amA = wave_max_nonneg(fmaxf(fabsf(a0), fabsf(a1))), amB = wave_max_nonneg(fmaxf(fabsf(a2), fabsf(a3)));
        const float scA = amA > 0.f ? 224.f * __builtin_amdgcn_rcpf(amA) : 0.f, invA = amA * (1.f / 224.f), scB = amB > 0.f ? 224.f * __builtin_amdgcn_rcpf(amB) : 0.f, invB = amB * (1.f / 224.f);
        { const unsigned wA = (unsigned)__builtin_amdgcn_cvt_pk_fp8_f32(a0 * scA, a1 * scA, 0, false), wB = (unsigned)__builtin_amdgcn_cvt_pk_fp8_f32(a2 * scB, a3 * scB, 0, false);
          const unsigned r0 = (wA & 0xffu) * 0x01010101u, r1 = ((wA >> 8) & 0xffu) * 0x01010101u, r2 = (wB & 0xffu) * 0x01010101u, r3 = ((wB >> 8) & 0xffu) * 0x01010101u;
          rep[l] = ((unsigned long long)r0 << 32) | r0; rep[64 + l] = ((unsigned long long)r1 << 32) | r1; rep[128 + l] = ((unsigned long long)r2 << 32) | r2; rep[192 + l] = ((unsigned long long)r3 << 32) | r3; }
        LDS_WAIT(); asm volatile("" ::: "memory");
#pragma unroll
        for (int t2 = 0; t2 < 2; ++t2) {
            f32x4 alo = {0.f, 0.f, 0.f, 0.f}, ahi = {0.f, 0.f, 0.f, 0.f};
#pragma unroll
            for (int i = 0; i < 16; ++i) { const long bop = (long)(rep[128 * t2 + 8 * i + repi] & bm); const u32x4 rw = t2 ? rowB[i] : rowA[i];
                alo = __builtin_amdgcn_mfma_f32_16x16x32_fp8_fp8(lo64(rw), bop, alo, 0, 0, 0);
                ahi = __builtin_amdgcn_mfma_f32_16x16x32_fp8_fp8(hi64(rw), bop, ahi, 0, 0, 0); }
            const float inv = t2 ? invB : invA;
            float vlo[4], vhi[4];
#pragma unroll
            for (int r = 0; r < 4; ++r) { const float tl = alo[r], th = ahi[r];
                vlo[r] = (tl + __builtin_bit_cast(float, __builtin_amdgcn_ds_bpermute(((l + 40) & 63) * 4, __builtin_bit_cast(int, tl)))) * inv;
                vhi[r] = (th + __builtin_bit_cast(float, __builtin_amdgcn_ds_bpermute(((l + 40) & 63) * 4, __builtin_bit_cast(int, th)))) * inv; }
            if (vl) {
#pragma unroll
                for (int r = 0; r < 4; ++r) { stg[64 * q + 16 * r + n16] = vlo[r]; stg[64 * q + 16 * r + n16 + 8] = vhi[r]; } }
            LDS_WAIT(); asm volatile("" ::: "memory");
            if (l < 32) { const f32x4 dv = *(const LAS f32x4*)(stg + 4 * l); *(f32x4*)(out + (size_t)(tok + t2) * D + g * 128 + 4 * l) = (t2 ? HB : HA) + dv; }
            LDS_WAIT(); asm volatile("" ::: "memory");
        }
        LDS_WAIT(); asm volatile("" ::: "memory");
    }
#undef V_PREFETCH
}
typedef float f32x16 __attribute__((ext_vector_type(16)));
template <int MODE>
__device__ __forceinline__ void peer_v4_phase(const Frame& F, const Args& A) {
    const int* IDX = (const int*)(A.ws + WS_P + P_IDX); const float* AK = (const float*)(A.ws + WS_AK);
    float* out = A.out;
    const int l = F.lane, n = l & 31, hq = l >> 5, step = F.G * NWAVES;
    const GAS unsigned char* vb = (const GAS unsigned char*)(A.ws + WS_V8);
    const unsigned lconst = 16u * (unsigned)n;
    const bool diag = ((l >> 4) & 1) == hq;
    const unsigned bytem = diag ? (0xFFu << (8 * (l & 3))) : 0u; const int dsel = (l & 15) >> 2;
    const unsigned M0 = dsel == 0 ? bytem : 0u, M1 = dsel == 1 ? bytem : 0u, M2 = dsel == 2 ? bytem : 0u, M3 = dsel == 3 ? bytem : 0u;
    const int rsel = 4 * hq;
    const int sc1 = 0x7F7F7F7F;
    const int colb = 8 * n + 4 * hq;
    int tok = F.bid * NWAVES + F.wave;
    int ne0, ne1; float na0, na1;
#define V4_PREFETCH(t) do { const size_t _t = (size_t)(t) * 128; ne0 = IDX[_t + l]; ne1 = IDX[_t + 64 + l]; na0 = AK[_t + l]; na1 = AK[_t + 64 + l]; } while (0)
#define V4_LOADS(R, ro_, h) do { int ba_ = rsel + 4 * (16 * (h)); _Pragma("unroll") for (int j_ = 0; j_ < 8; ++j_) { asm volatile("" : "+v"(ba_)); const int o_ = __builtin_amdgcn_ds_bpermute(ba_, (ro_)); ba_ += 8; \
        R[j_] = *(const GAS u32x4*)(vb + ((unsigned)o_ + lconst)); } } while (0)
#define V4_ONE(ACC, R, rep_, h, j_) do { unsigned s0_ = (unsigned)__builtin_amdgcn_readlane((int)(rep_), 16 * (h) + 2 * (j_)), s1_ = (unsigned)__builtin_amdgcn_readlane((int)(rep_), 16 * (h) + 2 * (j_) + 1); \
        asm volatile("" : "+s"(s0_), "+s"(s1_), "+v"(ACC)); \
        const i32x8 a8_ = {(int)(s0_ & M0), (int)(s0_ & M1), (int)(s0_ & M2), (int)(s0_ & M3), (int)(s1_ & M0), (int)(s1_ & M1), (int)(s1_ & M2), (int)(s1_ & M3)}; \
        const i32x4 r4_ = __builtin_bit_cast(i32x4, R[j_]); \
        ACC = __builtin_amdgcn_mfma_scale_f32_32x32x64_f8f6f4(a8_, __builtin_shufflevector(r4_, r4_, 0, 1, 2, 3, -1, -1, -1, -1), ACC, 0, 4, 0, sc1, 0, sc1); } while (0)
#define V4_COMPUTE(R, rep_, h) do { V4_ONE(acc, R, rep_, h, 0); V4_ONE(acc1, R, rep_, h, 1); V4_ONE(acc, R, rep_, h, 2); V4_ONE(acc1, R, rep_, h, 3); \
        V4_ONE(acc, R, rep_, h, 4); V4_ONE(acc1, R, rep_, h, 5); V4_ONE(acc, R, rep_, h, 6); V4_ONE(acc1, R, rep_, h, 7); } while (0)
    u32x4 RA[8], RB[8];
    if (tok < T_TOK) { V4_PREFETCH(tok); V4_LOADS(RA, ne0 * 512, 0); }
    for (; tok < T_TOK; tok += step) {
        const int e0 = ne0, e1 = ne1; const float a0 = na0, a1 = na1;
        const int ro0 = e0 * 512, ro1 = e1 * 512;
        const bool more = tok + step < T_TOK;
        V4_LOADS(RB, ro0, 1);
        if (more) V4_PREFETCH(tok + step);
        const float am = wave_max_nonneg(fmaxf(fabsf(a0), fabsf(a1)));
        const float sc = am > 0.f ? 224.f * __builtin_amdgcn_rcpf(am) : 0.f, inv = am * (1.f / 224.f);
        const unsigned w8 = (unsigned)__builtin_amdgcn_cvt_pk_fp8_f32(a0 * sc, a1 * sc, 0, false);
        const unsigned rep0 = (w8 & 0xffu) * 0x01010101u, rep1 = ((w8 >> 8) & 0xffu) * 0x01010101u;
        f32x16 acc, acc1;
#pragma unroll
        for (int i = 0; i < 16; ++i) { acc[i] = 0.f; acc1[i] = 0.f; }
        V4_COMPUTE(RA, rep0, 0); V4_LOADS(RA, ro0, 2);
        V4_COMPUTE(RB, rep0, 1); V4_LOADS(RB, ro0, 3);
        V4_COMPUTE(RA, rep0, 2); V4_LOADS(RA, ro1, 0);
        V4_COMPUTE(RB, rep0, 3); V4_LOADS(RB, ro1, 1);
        V4_COMPUTE(RA, rep1, 0); V4_LOADS(RA, ro1, 2);
        V4_COMPUTE(RB, rep1, 1); V4_LOADS(RB, ro1, 3);
        f32x4 H[4];
        u32x2 MX[4];
        { const bf16_t* mp = (const bf16_t*)(A.ws + WS_P + P_HB) + (size_t)tok * D + colb;
#pragma unroll
          for (int j = 0; j < 4; ++j) MX[j] = *(const u32x2*)(mp + 256 * j); }
        V4_COMPUTE(RA, rep1, 2);
        if (more) V4_LOADS(RA, ne0 * 512, 0);
        V4_COMPUTE(RB, rep1, 3);
        acc = acc + acc1;
        float ss = 0.f;
#pragma unroll
        for (int j = 0; j < 4; ++j) { H[j] = (f32x4){bflo(MX[j].x), bfhi(MX[j].x), bflo(MX[j].y), bfhi(MX[j].y)} + (f32x4){acc[4 * j], acc[4 * j + 1], acc[4 * j + 2], acc[4 * j + 3]} * inv;
            ss += (H[j].x * H[j].x + H[j].y * H[j].y) + (H[j].z * H[j].z + H[j].w * H[j].w); }
        const float rstd = 1.f / sqrtf(wave_sum(ss) * (1.f / D) + EPS);
        { float* hp = out + (size_t)tok * D + colb;
#pragma unroll
          for (int j = 0; j < 4; ++j) *(f32x4*)(hp + 256 * j) = H[j] * rstd * *(const f32x4*)(A.in[I_FG] + colb + 256 * j); }
    }
#undef V4_PREFETCH
#undef V4_LOADS
#undef V4_COMPUTE
#undef V4_ONE
}
__device__ __forceinline__ void final_norm_phase(const Frame& F, const Args& A) {
    const int gw = F.bid * NWAVES + F.wave, NGW = F.G * NWAVES, l = F.lane; const float* fg = A.in[I_FG];
    const f32x4* gp = (const f32x4*)fg + l;
    int tok = gw;
    for (; tok + 3 * NGW < T_TOK; tok += 4 * NGW) {
        f32x4 v[4][4]; float ss[4];
#pragma unroll
        for (int b = 0; b < 4; ++b) { const f32x4* hp = (const f32x4*)(A.out + (size_t)(tok + b * NGW) * D) + l;
#pragma unroll
            for (int j = 0; j < 4; ++j) v[b][j] = hp[64 * j]; }
#pragma unroll
        for (int b = 0; b < 4; ++b) { ss[b] = 0.f;
#pragma unroll
            for (int j = 0; j < 4; ++j) ss[b] += (v[b][j].x * v[b][j].x + v[b][j].y * v[b][j].y) + (v[b][j].z * v[b][j].z + v[b][j].w * v[b][j].w); }
#pragma unroll
        for (int o = 1; o < 64; o <<= 1) {
#pragma unroll
            for (int b = 0; b < 4; ++b) ss[b] += __shfl_xor(ss[b], o); }
#pragma unroll
        for (int b = 0; b < 4; ++b) { const float rstd = 1.f / sqrtf(ss[b] * (1.f / D) + EPS); f32x4* hp = (f32x4*)(A.out + (size_t)(tok + b * NGW) * D) + l;
#pragma unroll
            for (int j = 0; j < 4; ++j) hp[64 * j] = v[b][j] * rstd * gp[64 * j]; }
    }
    for (; tok < T_TOK; tok += NGW) { f32x4* hp = (f32x4*)(A.out + (size_t)tok * D) + l; f32x4 v[4]; float ss = 0.f;
#pragma unroll
        for (int j = 0; j < 4; ++j) { v[j] = hp[64 * j]; ss += (v[j].x * v[j].x + v[j].y * v[j].y) + (v[j].z * v[j].z + v[j].w * v[j].w); }
        const float rstd = 1.f / sqrtf(wave_sum(ss) * (1.f / D) + EPS);
#pragma unroll
        for (int j = 0; j < 4; ++j) hp[64 * j] = v[j] * rstd * gp[64 * j]; }
}

#ifdef DEBUG_CHECK
constexpr size_t WS_DBG = 472 * MiB;
__device__ __forceinline__ int dbg_tok(int i) { return (i * 509 + 3) & 32767; }
__device__ __forceinline__ float gelu_ref(float x) { return 0.5f * x * (1.f + tanhf(0.7978845608028654f * (x + 0.044715f * x * x * x))); }
__global__ void __launch_bounds__(512) dbg_scores(Args a) {
    __shared__ float n2s[1024]; __shared__ float q[2048];
    const int t = dbg_tok(blockIdx.x), tid = threadIdx.x;
    const bf16_t* N2 = (const bf16_t*)(a.ws + WS_N1); const float* SC = (const float*)(a.ws + WS_P + P_SC); unsigned* dbg = (unsigned*)(a.ws + WS_DBG);
    for (int k = tid; k < 1024; k += 512) n2s[k] = bf1(N2[(size_t)t * 1024 + k]);
    __syncthreads();
    for (int r = 0; r < 4; ++r) { const int c = tid + 512 * r; float s = 0.f; for (int k = 0; k < 1024; ++k) s += n2s[k] * a.in[I_WQ][(size_t)k * 2048 + c]; q[c] = s; }
    __syncthreads();
    float md = 0.f;
    for (int r = 0; r < 4; ++r) { const int n = tid + 512 * r, hh = n >> 7, key = n & 127; const float* kX = (hh & 1) ? a.in[I_K2] : a.in[I_K1];
        float s = 0.f; for (int d = 0; d < 128; ++d) s += q[hh * 128 + d] * kX[key * 128 + d];
        md = fmaxf(md, fabsf(s - SC[(size_t)n * T_TOK + t])); }
    atomicMax(&dbg[0], __builtin_bit_cast(unsigned, md));
}
__global__ void __launch_bounds__(64) dbg_topk(Args a) {
    __shared__ float s1[8][128], s2[8][128], cv[8][256]; __shared__ float t1v[8][16], t2v[8][16]; __shared__ int t1i[8][16], t2i[8][16], exi[8][16]; __shared__ float exv[8][16];
    const int t = dbg_tok(blockIdx.x), h = threadIdx.x;
    const float* SC = (const float*)(a.ws + WS_P + P_SC); const int* IDX = (const int*)(a.ws + WS_P + P_IDX); const float* GATE = (const float*)(a.ws + WS_P + P_GATE); unsigned* dbg = (unsigned*)(a.ws + WS_DBG);
    if (h >= 8) return;
    for (int j = 0; j < 128; ++j) { s1[h][j] = SC[(size_t)(h * 256 + j) * T_TOK + t]; s2[h][j] = SC[(size_t)(h * 256 + 128 + j) * T_TOK + t]; }
    for (int r = 0; r < 16; ++r) { int b1 = 0, b2 = 0; for (int j = 1; j < 128; ++j) { if (s1[h][j] > s1[h][b1]) b1 = j; if (s2[h][j] > s2[h][b2]) b2 = j; }
        t1v[h][r] = s1[h][b1]; t1i[h][r] = b1; s1[h][b1] = -1e30f; t2v[h][r] = s2[h][b2]; t2i[h][r] = b2; s2[h][b2] = -1e30f; }
    for (int c = 0; c < 256; ++c) cv[h][c] = t1v[h][c >> 4] + t2v[h][c & 15];
    for (int r = 0; r < 16; ++r) { int bc = 0; for (int c = 1; c < 256; ++c) if (cv[h][c] > cv[h][bc]) bc = c;
        exv[h][r] = cv[h][bc]; exi[h][r] = t1i[h][bc >> 4] * 128 + t2i[h][bc & 15]; cv[h][bc] = -1e30f; }
    float sum = 0.f; const float mx0 = exv[h][0]; for (int r = 0; r < 16; ++r) { exv[h][r] = expf(exv[h][r] - mx0); } for (int r = 0; r < 16; ++r) sum += exv[h][r];
    unsigned miss = 0; float gd = 0.f;
    for (int w = 0; w < 16; ++w) { const int e = IDX[(size_t)t * 128 + h * 16 + w]; const float g = GATE[(size_t)t * 128 + h * 16 + w]; bool found = false;
        for (int r = 0; r < 16; ++r) if (exi[h][r] == e) { found = true; gd = fmaxf(gd, fabsf(g - exv[h][r] / sum)); }
        if (!found) ++miss; }
    atomicAdd(&dbg[1], miss); atomicMax(&dbg[3], __builtin_bit_cast(unsigned, gd));
}
__global__ void __launch_bounds__(512) dbg_experts_pre(Args a) {
    __shared__ float n2s[1024]; __shared__ float ak[128]; __shared__ int ek[128]; __shared__ float red[8];
    const int t = dbg_tok(blockIdx.x), tid = threadIdx.x, lane = tid & 63, wave = tid >> 6;
    const bf16_t* N2 = (const bf16_t*)(a.ws + WS_N1); const int* IDX = (const int*)(a.ws + WS_P + P_IDX); const float* GATE = (const float*)(a.ws + WS_P + P_GATE);
    float* rows = (float*)(a.ws + WS_DBG + MiB);
    for (int k = tid; k < 1024; k += 512) n2s[k] = bf1(N2[(size_t)t * 1024 + k]);
    if (tid < 128) ek[tid] = IDX[(size_t)t * 128 + tid];
    __syncthreads();
    for (int k = wave * 16; k < wave * 16 + 16; ++k) { const float* u = a.in[I_PU] + (size_t)ek[k] * 1024; float s = 0.f; for (int j = lane; j < 1024; j += 64) s += u[j] * n2s[j];
        s = wave_sum(s); if (lane == 0) ak[k] = gelu_ref(s) * GATE[(size_t)t * 128 + k]; }
    __syncthreads();
    float h2[2]; float ss = 0.f;
    for (int r = 0; r < 2; ++r) { const int d = tid + 512 * r; float o = 0.f; for (int k = 0; k < 128; ++k) o += ak[k] * a.in[I_PV][(size_t)ek[k] * 1024 + d]; h2[r] = a.out[(size_t)t * 1024 + d] + o; ss += h2[r] * h2[r]; }
    ss = wave_sum(ss); if (lane == 0) red[wave] = ss; __syncthreads();
    float tot = 0.f; for (int w = 0; w < 8; ++w) tot += red[w];
    const float rstd = 1.f / sqrtf(tot / 1024.f + EPS);
    for (int r = 0; r < 2; ++r) { const int d = tid + 512 * r; rows[(size_t)blockIdx.x * 1024 + d] = h2[r] * rstd * a.in[I_FG][d]; }
}
__global__ void __launch_bounds__(512) dbg_experts_post(Args a) {
    const int t = dbg_tok(blockIdx.x), tid = threadIdx.x; const float* rows = (const float*)(a.ws + WS_DBG + MiB); float* dbgf = (float*)(a.ws + WS_DBG);
    float e = 0.f, n = 0.f;
    for (int r = 0; r < 2; ++r) { const int d = tid + 512 * r; const float x = rows[(size_t)blockIdx.x * 1024 + d], y = a.out[(size_t)t * 1024 + d]; e += (x - y) * (x - y); n += x * x; }
    e = wave_sum(e); n = wave_sum(n); if ((tid & 63) == 0) { atomicAdd(&dbgf[4], e); atomicAdd(&dbgf[5], n); }
}
__global__ void __launch_bounds__(512) dbg_report(Args a, int which) {
    const unsigned* dbg = (const unsigned*)(a.ws + WS_DBG); const float* dbgf = (const float*)(a.ws + WS_DBG);
    const float mA = dbgf[0], gd = dbgf[3]; const unsigned miss = dbg[1]; const float relC = sqrtf(dbgf[4] / fmaxf(dbgf[5], 1e-30f));
    float X;
    if (which == 0) { int mask = 0; if (mA > 0.05f) mask |= 1; if (miss > 400u) mask |= 2; if (relC > 0.05f) mask |= 4; if (gd > 0.02f) mask |= 8; X = 1000.f + 100.f * mask; }
    else if (which == 1) X = 1e6f * mA; else if (which == 2) X = 100.f + (float)miss; else if (which == 3) X = 1e6f * relC; else X = 1e6f * gd;
    for (size_t i = (size_t)blockIdx.x * 512 + threadIdx.x; i < (size_t)T_TOK * D; i += (size_t)gridDim.x * 512) a.out[i] = (i == 0) ? X : 0.f;
}
#endif

constexpr int NPH = 13;
__global__ void __launch_bounds__(NWAVES * 64, 2) fwd_kernel(Args args) {
    extern __shared__ __attribute__((aligned(16))) unsigned char lds_raw[];
    Frame F;
    F.lds = (LAS unsigned char*)lds_raw;
    F.tid = threadIdx.x; F.lane = F.tid & 63; F.wave = __builtin_amdgcn_readfirstlane(F.tid >> 6);
    F.G = gridDim.x; F.bid = blockIdx.x;
    volatile LAS unsigned* MISC = (volatile LAS unsigned*)(F.lds + MISC_OFF);
    for (int u = F.tid; u < (LDS_BYTES - LDSCTL_OFF) / 4; u += NWAVES * 64) ((LAS unsigned*)(F.lds + LDSCTL_OFF))[u] = 0u;
    __syncthreads();
    unsigned* ctl = (unsigned*)(args.ws + WS_CTL);
    const int lo = args.ph_lo, hi = args.ph_hi;
    XcdBarrier bar; bar.bar = ctl + CW_BAR + args.li * XCD_BAR_WORDS; bar.x = 0; bar.st = nullptr; bar.wave = F.wave;
    if (hi - lo > 1) bar = xcd_barrier_post(ctl + CW_BAR + args.li * XCD_BAR_WORDS, MISC + 8, F.wave);
#define IN(k) (lo <= (k) && (k) < hi)
#ifdef PROBE_TS
#define STAMP(k) do { if (F.bid == 0 && F.tid == 0) ((unsigned long long*)(args.ws + (472u << 20)))[(k)] = __builtin_amdgcn_s_memrealtime(); } while (0)
#else
#define STAMP(k) do { } while (0)
#endif
#define SEAM(k) do { if (IN(k) && IN((k) + 1)) { xcd_barrier(bar); if (XTRA_BAR) xcd_barrier(bar); } STAMP((k) + 1); } while (0)
    unsigned char* ws = args.ws;
    bf16_t* P = (bf16_t*)(ws + WS_P);

#define REFRESH() do { int z_ = 0; asm volatile("" : "+s"(z_)); F.lane = (int)__builtin_amdgcn_mbcnt_hi(~0u, __builtin_amdgcn_mbcnt_lo(~0u, (unsigned)z_)); F.tid = F.wave * 64 + F.lane; } while (0)
    STAMP(0);
    if (IN(0)) { phase0(F, args); SEAM(0); }
    if (IN(1)) { REFRESH();
        if (F8_LO > 0) { pg8::Gemm g{(const bf16_t*)(ws + WS_N1), (const bf16_t*)(ws + WS_WIN), T_TOK, F8_LO * 256, D, D}; pg8::StaticOrder S; S.init(T_TOK, F8_LO * 256, F.G, F.bid);
            pg8::EpiProj E{P, (float*)(ws + WS_ALR), 0}; pg8::gemm_phase<pg8::EpiProj, pg8::StaticOrder, false, true, false>(F.lds, g, S, E, F.wave); }
        if (F8_LO < 21) {
            pg8::Gemm g{(const bf16_t*)(ws + WS_N18), (const bf16_t*)(ws + WS_W8 + (size_t)F8_LO * 256 * 1024), T_TOK, (21 - F8_LO) * 256, D / 2, D / 2, 0x7B7B7B7B, 0x75757575};
            pg8::StaticOrder S; S.init(T_TOK, (21 - F8_LO) * 256, F.G, ((F8_LO * 128) % F.G) != 0 ? F.G - 1 - F.bid : F.bid);
            pg8::EpiProj E{P, (float*)(ws + WS_ALR), F8_LO}; pg8::gemm_phase<pg8::EpiProj, pg8::StaticOrder, false, true, true>(F.lds, g, S, E, F.wave); }
        {
            REFRESH();
            const int nwg = (T_TOK / 256) * (NPROJ / 256), rem = nwg % F.G;
            if (rem == 0) convert_tables(F, args, F.bid * NWAVES + F.wave, F.G * NWAVES);
            else if (F.bid >= rem) convert_tables(F, args, (F.bid - rem) * NWAVES + F.wave, (F.G - rem) * NWAVES);
        }
        SEAM(1);
    }
    if (IN(2)) { REFRESH();
        if (DRY_EXP == 12) { gla_chunk_phase<true>(F, args); for (int it = F.bid; it < 256; it += F.G) for (int g4 = 0; g4 < 4; ++g4) sgu_unit<true>(F, args, 4 * it + g4, g4 == 0); __syncthreads(); }
        gla_chunk_phase<false>(F, args);
        for (int it = F.bid; it < 256; it += F.G) for (int g4 = 0; g4 < 4; ++g4) sgu_unit<false>(F, args, 4 * it + g4, g4 == 0);
        SEAM(2);
    }
    if (IN(3)) { REFRESH(); if (DRY_EXP == 13 || DRY_EXP == 15) { gla_scan<true>(F, args); __syncthreads(); } gla_scan<false>(F, args); SEAM(3); }
    if (IN(4)) { REFRESH(); if (DRY_EXP == 14 || DRY_EXP == 15) { gla_out_phase<true>(F, args); __syncthreads(); } gla_out_phase<false>(F, args); SEAM(4); }
    if (IN(5)) { REFRESH();
        { pg8::Gemm g{P + PC_R, (const bf16_t*)(ws + WS_WA), T_TOK, D, 1024, PLD}; pg8::StaticOrder S; S.init(T_TOK, D, F.G, F.bid);
          pg8::EpiBrAB E{P}; pg8::gemm_phase<pg8::EpiBrAB, pg8::StaticOrder, true, true, false, true>(F.lds, g, S, E, F.wave); }
        SEAM(5);
    }
    if (IN(6)) { REFRESH();
        pg8::Gemm g{P + PC_MRG, (const bf16_t*)(ws + WS_WOUT), T_TOK, D, D, PLD}; pg8::StaticOrder S; S.init(T_TOK, D, F.G, F.bid);
        pg8::EpiOut E{(bf16_t*)(ws + WS_N1)}; pg8::gemm_phase<pg8::EpiOut, pg8::StaticOrder, true, true>(F.lds, g, S, E, F.wave);
        SEAM(6);
    }
    if (IN(7)) { REFRESH();
        const int gw = F.bid * NWAVES + F.wave, NGW = F.G * NWAVES;
        { int m = gw; for (; m + 3 * NGW < T_TOK; m += 4 * NGW) rms_rows_to_bf16<(SC_F8 ? 2 : 3), 4>(F.lane, args.in[I_X] + (size_t)m * D, (size_t)NGW * D, args.in[I_N2G], (bf16_t*)(ws + WS_P + P_N2) + (size_t)m * D, (size_t)NGW * D, (unsigned*)(ws + WS_P + P_X8) + (size_t)m * 256, (size_t)NGW * 256, (const bf16_t*)(ws + WS_N1) + (size_t)m * D, (size_t)NGW * D, (bf16_t*)(ws + WS_P + P_HB) + (size_t)m * D, (size_t)NGW * D);
          for (; m < T_TOK; m += NGW) rms_rows_to_bf16<(SC_F8 ? 2 : 3), 1>(F.lane, args.in[I_X] + (size_t)m * D, 0, args.in[I_N2G], (bf16_t*)(ws + WS_P + P_N2) + (size_t)m * D, 0, (unsigned*)(ws + WS_P + P_X8) + (size_t)m * 256, 0, (const bf16_t*)(ws + WS_N1) + (size_t)m * D, 0, (bf16_t*)(ws + WS_P + P_HB) + (size_t)m * D, 0); }
        SEAM(7);
    }
    if (IN(8)) { REFRESH();
        pg8::StaticOrder S; S.init(T_TOK, 2048, F.G, F.bid); pg8::EpiScores E{(bf16_t*)(ws + WS_P + P_SC)};
        if (SC_F8) { pg8::Gemm g{(const bf16_t*)(ws + WS_P + P_X8), (const bf16_t*)(ws + WS_WQF), T_TOK, 2048, D / 2, D / 2, 0x7B7B7B7B, 0x75757575};
            pg8::gemm_phase<pg8::EpiScores, pg8::StaticOrder, true, true, true>(F.lds, g, S, E, F.wave); }
        else { pg8::Gemm g{(const bf16_t*)(ws + WS_P + P_N2), (const bf16_t*)(ws + WS_WQF), T_TOK, 2048, D, D};
            pg8::gemm_phase<pg8::EpiScores, pg8::StaticOrder, true, true>(F.lds, g, S, E, F.wave); }
        SEAM(8);
    }
    if (IN(9)) { REFRESH(); peer_topk(F, args); SEAM(9); }
    if (IN(10)) { REFRESH(); if constexpr (UNG == 1) peer_u4_all<0>(F, args); else peer_u4_phase<0>(F, args); SEAM(10); }
    if (IN(11)) { REFRESH(); if (V_F4) peer_v4_phase<0>(F, args); else { if (DRY_EXP == 1) { peer_v_phase<1>(F, args); __syncthreads(); } peer_v_phase<0>(F, args); SEAM(11); } }
    if (IN(12)) { REFRESH(); if (!V_F4) final_norm_phase(F, args); }
#undef IN
#undef SEAM
}


#ifdef PROBE_TS
__global__ void __launch_bounds__(512) probe_report(Args a, int pi, int pj) {
    const unsigned long long* ts = (const unsigned long long*)(a.ws + (472u << 20));
    const float X1 = 10.f * (float)(ts[pi + 1] - ts[pi]) * 0.01f, X2 = (float)(ts[pj + 1] - ts[pj]) * 0.01f;
    for (size_t i = (size_t)blockIdx.x * 512 + threadIdx.x; i < (size_t)T_TOK * D; i += (size_t)gridDim.x * 512) a.out[i] = (i == 0) ? X1 : X2;
}
#endif
#ifdef PROBE_MFMA
__global__ void __launch_bounds__(64) probe_mfma(Args a) {
    const int l = threadIdx.x;
    i32x4 av = {0, 0, 0, 0};
    if (l == PROBE_L) av[PROBE_P >> 3] = 0x2 << (4 * (PROBE_P & 7));
    i32x8 b1, b2;
    for (int r = 0; r < 8; ++r) { unsigned w1 = 0, w2 = 0;
        for (int c = 0; c < 4; ++c) { const int b = 4 * r + c; int t = 0;
            t = __builtin_amdgcn_cvt_pk_fp8_f32((float)((b & 15) + 1), (float)(1 + (b >> 4) + 2 * (l >> 4)), 0, false);
            w1 |= ((unsigned)t & 0xffu) << (8 * c); w2 |= (((unsigned)t >> 8) & 0xffu) << (8 * c); }
        b1[r] = (int)w1; b2[r] = (int)w2; }
    const f32x4 z = {0.f, 0.f, 0.f, 0.f};
    const f32x4 d1 = __builtin_amdgcn_mfma_scale_f32_16x16x128_f8f6f4(__builtin_shufflevector(av, av, 0, 1, 2, 3, -1, -1, -1, -1), b1, z, 4, 0, 0, 0x7F7F7F7F, 0, 0x7F7F7F7F);
    const f32x4 d2 = __builtin_amdgcn_mfma_scale_f32_16x16x128_f8f6f4(__builtin_shufflevector(av, av, 0, 1, 2, 3, -1, -1, -1, -1), b2, z, 4, 0, 0, 0x7F7F7F7F, 0, 0x7F7F7F7F);
    float* st = (float*)(a.ws + (472u << 20));
    *(f32x4*)(st + 8 * l) = d1; *(f32x4*)(st + 8 * l + 4) = d2;
}
__global__ void __launch_bounds__(512) probe_mfma_report(Args a) {
    const int row = PROBE_L & 15;
    const float* st = (const float*)(a.ws + (472u << 20)) + 8 * (16 * (row >> 2)) + (row & 3); const float X1 = 10.f * st[0], X2 = st[4];
    for (size_t i = (size_t)blockIdx.x * 512 + threadIdx.x; i < (size_t)T_TOK * D; i += (size_t)gridDim.x * 512) a.out[i] = (i == 0) ? X1 : X2;
}
#endif
extern "C" void kernel_launch(void* const* d_in, const int* in_sizes, int n_in, void* d_out, int out_size, void* d_ws, size_t ws_size, hipStream_t stream) {
    static int grid = 0;
    if (grid == 0) {
        if (n_in != 20 || in_sizes[0] != T_TOK * D || out_size != T_TOK * D || ws_size < WS_END) {
            fprintf(stderr, "kernel_launch: unexpected shapes: n_in %d in0 %d out %d ws %zu (need %zu)\n", n_in, n_in > 0 ? in_sizes[0] : -1, out_size, ws_size, (size_t)WS_END); grid = -1; return; }
        int dev = 0, cus = 0;
        if (hipGetDevice(&dev) != hipSuccess || hipDeviceGetAttribute(&cus, hipDeviceAttributeMultiprocessorCount, dev) != hipSuccess) { grid = -1; return; }
        if (hipFuncSetAttribute((const void*)fwd_kernel, hipFuncAttributeMaxDynamicSharedMemorySize, LDS_BYTES) != hipSuccess) { fprintf(stderr, "kernel_launch: hipFuncSetAttribute failed\n"); grid = -1; return; }
        int per_cu = 0;
        if (hipOccupancyMaxActiveBlocksPerMultiprocessor(&per_cu, (const void*)fwd_kernel, NWAVES * 64, LDS_BYTES) != hipSuccess || per_cu < 1) fprintf(stderr, "kernel_launch: occupancy query says %d\n", per_cu);
        (void)hipGetLastError();
        grid = cus;
    }
    if (grid < 0) return;
    (void)hipMemsetAsync((char*)d_ws + WS_CTL, 0, CTL_ZERO_BYTES, stream);
    Args a{};
    for (int i = 0; i < 20; ++i) a.in[i] = (const float*)d_in[i];
    a.out = (float*)d_out; a.ws = (unsigned char*)d_ws;
#ifdef PROBE_MFMA
    hipLaunchKernelGGL(probe_mfma, dim3(1), dim3(64), 0, stream, a);
    hipLaunchKernelGGL(probe_mfma_report, dim3(1024), dim3(512), 0, stream, a);
    return;
#endif
#ifndef LAUNCH_LIST
#define LAUNCH_LIST {0, NPH}
#endif
    static const int ranges[][2] = { LAUNCH_LIST };
    const int nl = (int)(sizeof(ranges) / sizeof(ranges[0]));
    for (int li = 0; li < nl; ++li) { a.ph_lo = ranges[li][0]; a.ph_hi = ranges[li][1]; a.li = li;
        hipLaunchKernelGGL(fwd_kernel, dim3(grid), dim3(NWAVES * 64), LDS_BYTES, stream, a); }
}
```

```cpp
#include <hip/hip_runtime.h>
#include <cstdio>
#include <cstdint>


#ifndef XTRA_BAR
#define XTRA_BAR 0
#endif
#ifndef DRY_EXP
#define DRY_EXP 0
#endif
#ifndef DUP_PHASE
#define DUP_PHASE -1
#endif
#ifndef MK_N_LAUNCHES
#define MK_N_LAUNCHES 1
#endif

#define LAS __attribute__((address_space(3)))
#define GAS __attribute__((address_space(1)))
typedef unsigned short bf16_t;
typedef short bf16x8 __attribute__((ext_vector_type(8)));
typedef float f32x4 __attribute__((ext_vector_type(4)));
typedef float f32x2 __attribute__((ext_vector_type(2)));
typedef unsigned u32x4 __attribute__((ext_vector_type(4)));
typedef unsigned u32x2 __attribute__((ext_vector_type(2)));
typedef int i32x4 __attribute__((ext_vector_type(4)));
typedef int i32x8 __attribute__((ext_vector_type(8)));
typedef __bf16 bf16x2_t __attribute__((ext_vector_type(2)));

constexpr int T_TOK = 32768, D = 1024, SEQ = 4096, NBATCH = 8;
constexpr int NPROJ = 5376;
constexpr int PLD = 5120;
constexpr int PC_Q = 0, PC_K = 512, PC_V = 1024, PC_R = 1536, PC_SU = 2048, PC_SV = 2560, PC_GA = 3072, PC_GB = 4096;
constexpr int PC_MRG = 512;
constexpr float EPS = 1e-6f;
constexpr int NEXP = 16384;
#ifndef U_NG
#define U_NG 1
#endif
#ifndef V_F4
#define V_F4 1
#endif
#ifndef SC_F8
#define SC_F8 0
#endif
#ifndef F8_LO
#define F8_LO 11
#endif
constexpr int UNG = U_NG, UNG_SH = (U_NG == 8 ? 3 : (U_NG == 4 ? 2 : (U_NG == 2 ? 1 : 0)));

constexpr size_t MiB = 1u << 20;
constexpr size_t WS_CTL = 0, CTL_ZERO_BYTES = 64 * 1024;
constexpr size_t WS_WIN = 1 * MiB;
constexpr size_t WS_WA = 12 * MiB;
constexpr size_t WS_WB = 13 * MiB;
constexpr size_t WS_WOUT = 14 * MiB;
constexpr size_t WS_WQF = 16 * MiB;
constexpr size_t WS_U8 = 20 * MiB;
constexpr size_t WS_V8 = 36 * MiB;
constexpr size_t WS_SU = 52 * MiB;
constexpr size_t WS_SV = 52 * MiB + 65536;
constexpr size_t WS_AK = 53 * MiB;
constexpr size_t WS_DEC = 84 * MiB;
constexpr size_t WS_ALR = 85 * MiB;
constexpr size_t WS_N1 = 87 * MiB;
constexpr size_t WS_P = 151 * MiB;
constexpr size_t WS_W8 = 472 * MiB;
constexpr size_t WS_N18 = 478 * MiB;
constexpr size_t WS_END = 510 * MiB;
constexpr size_t P_HB = 192 * MiB;
constexpr size_t P_N2 = 128 * MiB;
constexpr size_t P_SC = 0, P_IDX = 256 * MiB, P_GATE = 272 * MiB, P_X8 = 288 * MiB;

constexpr int CW_BAR = 4096;

constexpr int RING_BYTES = 131072;
constexpr int LDSCTL_OFF = RING_BYTES, MISC_OFF = LDSCTL_OFF + 320;
constexpr int LDS_BYTES = 147456;
constexpr int NWAVES = 8;

__device__ __forceinline__ unsigned pk2(float lo, float hi) { const f32x2 v = {lo, hi}; const bf16x2_t b = __builtin_convertvector(v, bf16x2_t); return __builtin_bit_cast(unsigned, b); }
__device__ __forceinline__ unsigned f2bf(float f) { return pk2(f, 0.f) & 0xffffu; }
__device__ __forceinline__ float bflo(unsigned w) { return __builtin_bit_cast(float, w << 16); }
__device__ __forceinline__ float bfhi(unsigned w) { return __builtin_bit_cast(float, w & 0xffff0000u); }
__device__ __forceinline__ float bf1(bf16_t h) { return __builtin_bit_cast(float, ((unsigned)h) << 16); }
__device__ __forceinline__ float sigmoidf_(float x) { return __builtin_amdgcn_rcpf(1.f + __expf(-x)); }
__device__ __forceinline__ float gelu_tanh(float x) { const float y = 1.5957691216057308f * (x + 0.044715f * x * x * x); return x * sigmoidf_(y); }
__device__ __forceinline__ float siluf_(float x) { return x * sigmoidf_(x); }
__device__ __forceinline__ float wave_sum(float v) {
#pragma unroll
    for (int o = 1; o < 64; o <<= 1) v += __shfl_xor(v, o);
    return v;
}
#define LDS_WAIT() asm volatile("s_waitcnt lgkmcnt(0)" ::: "memory")
#define VM_WAIT() asm volatile("s_waitcnt vmcnt(0)" ::: "memory")

__device__ __forceinline__ int lane_now() { int z = 0; asm volatile("" : "+s"(z)); return (int)__builtin_amdgcn_mbcnt_hi(~0u, __builtin_amdgcn_mbcnt_lo(~0u, (unsigned)z)); }
namespace pg8 {
constexpr int BM = 256, BK = 64, HALF = 128, HTB = HALF * BK * 2, STAGE_BYTES = 8 * HTB, NXCD = 8, WGM = 8;
__host__ __device__ __forceinline__ int lds_byte(int r, int c) { const int st = (r >> 4) * 2 + (c >> 5), rr = r & 15, cc = c & 31, ob = rr * 64 + cc * 2; return st * 1024 + (ob ^ (((ob >> 9) & 1) << 5)); }
__host__ __device__ __forceinline__ void stage_rc(int b, int& R, int& C) { const int st = b / 1024, sb = b % 1024, swz = sb ^ (((sb >> 9) & 1) << 5); R = (st >> 1) * 16 + swz / 64; C = (st & 1) * 32 + (swz % 64) / 2; }
__host__ __device__ __forceinline__ int perm32(int rho) { const int n = rho >> 4, i = rho & 15; return 8 * (i >> 2) + 4 * n + (i & 3); }

struct Unit { int pm, pn; };
struct Gemm { const bf16_t* A; const bf16_t* Bt; int M, N, K, lda; int sa = 0, sb = 0; };

struct StaticOrder {
    int nM, nN, nwg, G, c;
    __host__ __device__ void init(int M, int N, int G_, int c_) { nM = M / BM; nN = N / BM; nwg = nM * nN; G = G_; c = c_; }
    __host__ __device__ bool next(int i, Unit& u) const {
        const long L = (long)i * G + c; if (L >= nwg) return false;
        int wgid = (int)L; { const int q = nwg / NXCD, r = nwg % NXCD, xcd = wgid % NXCD, off = wgid / NXCD; wgid = (xcd < r ? xcd * (q + 1) : r * (q + 1) + (xcd - r) * q) + off; }
        const int nig = WGM * nN, gid = wgid / nig, fm = gid * WGM, gsz = (nM - fm) < WGM ? (nM - fm) : WGM;
        u.pm = fm + ((wgid % nig) % gsz); u.pn = (wgid % nig) / gsz; return true;
    }
    __device__ __forceinline__ void a_ready(const Unit&) const {}
    __device__ __forceinline__ void done(const Unit&) const {}
};

template <class Epi, class Sched, bool ALIGN_EPI = false, bool SP2 = false, bool F8 = false, bool MID = false>
__device__ __forceinline__ void gemm_phase(LAS unsigned char* lds, const Gemm g, const Sched& S, const Epi& E, int wave_id) {
    const int wid = wave_id, lane = lane_now(), tid = wid * 64 + lane, wr = wid >> 2, wc = wid & 3, fr = lane & 15, fq = lane >> 4;
    const int K = g.K, nt = K / BK, lda = g.lda; const int scAB = (g.sb & 0xff) | ((g.sa & 0xff) << 8); (void)scAB;
    unsigned voffA[1], voffB[1];
    { int R, C; stage_rc(tid * 16, R, C); const int Rb = Epi::PERM ? ((R & ~31) + perm32(R & 31)) : R;
        voffA[0] = (unsigned)(R * lda + C) * 2u; voffB[0] = (unsigned)(Rb * K + C) * 2u; }
    const size_t dltA = (size_t)64 * lda * 2, dltB = (size_t)64 * K * 2;
    const size_t kstep = (size_t)(BK * 2);
    const size_t hstepA = (size_t)HALF * lda * 2, hstepB = (size_t)HALF * K * 2;
    const size_t tstepA = 2 * hstepA, tstepB = 2 * hstepB;
    const unsigned ldsw = (unsigned)wid * 1024u; const unsigned ldsbase = (unsigned)(__UINTPTR_TYPE__)lds + ldsw;
    const int aoff = lds_byte(wr * 64 + fr, fq * 8), boff = lds_byte(wc * 32 + fr, fq * 8);
#define PG8_SA(b, h) (((b) * 2 + (h)) * HTB)
#define PG8_SB(b, h) ((4 + (b) * 2 + (h)) * HTB)
#define PG8_STAGE(bufoff, gbase, voff) do { _Pragma("unroll") for (int _i = 0; _i < 2; ++_i) \
        asm volatile("s_mov_b32 m0, %2\n\ts_nop 0\n\tglobal_load_lds_dwordx4 %0, %1" :: "v"((voff)[0]), "s"((const char*)(gbase) + (size_t)_i * ((voff) == voffA ? dltA : dltB)), "s"(ldsbase + (unsigned)((bufoff) + _i * 8192)) : "memory", "m0"); } while (0)
#define PG8_LDA(dst, b, h) do { _Pragma("unroll") for (int m = 0; m < 4; ++m) _Pragma("unroll") for (int k = 0; k < 2; ++k) dst[m][k] = *(const LAS bf16x8*)(lds + PG8_SA(b, h) + aoff + m * 2048 + k * 1024); } while (0)
#define PG8_LDB(dst, b, h) do { _Pragma("unroll") for (int n = 0; n < 2; ++n) _Pragma("unroll") for (int k = 0; k < 2; ++k) dst[n][k] = *(const LAS bf16x8*)(lds + PG8_SB(b, h) + boff + n * 2048 + k * 1024); } while (0)
#define PG8_CAT(x) __builtin_shufflevector(__builtin_bit_cast(i32x4, (x)[0]), __builtin_bit_cast(i32x4, (x)[1]), 0, 1, 2, 3, 4, 5, 6, 7)
#define PG8_MMA(ai, bj, At, Bt) do { __builtin_amdgcn_s_setprio(1); if constexpr (F8) { _Pragma("unroll") for (int m = 0; m < 4; ++m) _Pragma("unroll") for (int n = 0; n < 2; ++n) \
        acc[ai][bj][m][n] = __builtin_amdgcn_mfma_scale_f32_16x16x128_f8f6f4(PG8_CAT(Bt[n]), PG8_CAT(At[m]), acc[ai][bj][m][n], 0, 0, 0, scAB, 1, scAB); } else { \
        _Pragma("unroll") for (int m = 0; m < 4; ++m) _Pragma("unroll") for (int n = 0; n < 2; ++n) _Pragma("unroll") for (int k = 0; k < 2; ++k) \
        acc[ai][bj][m][n] = __builtin_amdgcn_mfma_f32_16x16x32_bf16(Bt[n][k], At[m][k], acc[ai][bj][m][n], 0, 0, 0); } __builtin_amdgcn_s_setprio(0); } while (0)
#define PG8_WAIT_V(n) asm volatile("s_waitcnt vmcnt(" #n ")" ::: "memory")
#define PG8_WAIT_L(n) asm volatile("s_waitcnt lgkmcnt(" #n ")" ::: "memory")
#define PG8_BAR __builtin_amdgcn_s_barrier()
#define PG8_SCHED __builtin_amdgcn_sched_barrier(0)
    Unit cur, nxt; int ui = 0;
    if (!S.next(0, cur)) return;
    f32x4 acc[2][2][4][2];
#pragma unroll
    for (int a = 0; a < 2; ++a)
#pragma unroll
        for (int b = 0; b < 2; ++b)
#pragma unroll
            for (int m = 0; m < 4; ++m)
#pragma unroll
                for (int n = 0; n < 2; ++n) acc[a][b][m][n] = (f32x4){0.f, 0.f, 0.f, 0.f};
    bf16x8 At[4][2], B0[2][2], B1[2][2];
    const char* cA = (const char*)g.A + (size_t)cur.pm * tstepA; const char* cB = (const char*)g.Bt + (size_t)cur.pn * tstepB;
    S.a_ready(cur);
    if constexpr (SP2) {
        PG8_STAGE(PG8_SB(0, 0), cB, voffB); PG8_STAGE(PG8_SB(0, 1), cB + hstepB, voffB); PG8_STAGE(PG8_SA(0, 0), cA, voffA); PG8_STAGE(PG8_SA(0, 1), cA + hstepA, voffA);
        if (wr == 1) PG8_BAR;
        PG8_WAIT_V(2); PG8_BAR;
        PG8_STAGE(PG8_SB(1, 0), cB + kstep, voffB); PG8_STAGE(PG8_SA(1, 0), cA + kstep, voffA); PG8_STAGE(PG8_SB(1, 1), cB + hstepB + kstep, voffB);
        PG8_WAIT_V(6); PG8_BAR;
    } else {
        PG8_STAGE(PG8_SB(0, 0), cB, voffB); PG8_STAGE(PG8_SA(0, 0), cA, voffA); PG8_STAGE(PG8_SB(0, 1), cB + hstepB, voffB); PG8_STAGE(PG8_SA(0, 1), cA + hstepA, voffA);
        if (wr == 1) PG8_BAR;
        PG8_WAIT_V(4); PG8_BAR;
        PG8_STAGE(PG8_SB(1, 0), cB + kstep, voffB); PG8_STAGE(PG8_SA(1, 0), cA + kstep, voffA); PG8_STAGE(PG8_SB(1, 1), cB + hstepB + kstep, voffB);
        PG8_WAIT_V(6); PG8_BAR;
    }
    for (;;) {
        const bool has_next = S.next(ui + 1, nxt);
        const char* nA = has_next ? (const char*)g.A + (size_t)nxt.pm * tstepA : cA; const char* nB = has_next ? (const char*)g.Bt + (size_t)nxt.pn * tstepB : cB;
#pragma nounroll
        for (int t = 0; t < nt; t += 2) {
            if constexpr (MID) { if (t == (nt >> 1)) E.mid(acc, cur, wr, wc); }
            const bool last = (t == nt - 2);
            const char* a1 = cA + (size_t)(t + 1) * kstep;
            const char* a2 = last ? nA : cA + (size_t)(t + 2) * kstep; const char* b2 = last ? nB : cB + (size_t)(t + 2) * kstep;
            const char* a3 = a2 + kstep; const char* b3 = b2 + kstep;
            if (last && has_next) S.a_ready(nxt);
            if constexpr (SP2) {
            PG8_LDB(B0, 0, 0); PG8_LDB(B1, 0, 1); PG8_SCHED; PG8_LDA(At, 0, 0); PG8_STAGE(PG8_SA(1, 1), a1 + hstepA, voffA);
            PG8_WAIT_V(8); PG8_WAIT_L(0); PG8_BAR; PG8_MMA(0, 0, At, B0); PG8_MMA(0, 1, At, B1); PG8_BAR; PG8_SCHED;
            PG8_LDA(At, 0, 1); PG8_STAGE(PG8_SB(0, 0), b2, voffB); PG8_STAGE(PG8_SB(0, 1), b2 + hstepB, voffB); PG8_STAGE(PG8_SA(0, 0), a2, voffA);
            PG8_WAIT_V(8); PG8_WAIT_L(0); PG8_BAR; PG8_MMA(1, 0, At, B0); PG8_MMA(1, 1, At, B1); PG8_BAR; PG8_SCHED;
            PG8_LDB(B0, 1, 0); PG8_LDB(B1, 1, 1); PG8_SCHED; PG8_LDA(At, 1, 0); PG8_STAGE(PG8_SA(0, 1), a2 + hstepA, voffA);
            PG8_WAIT_V(8); PG8_WAIT_L(0); PG8_BAR; PG8_MMA(0, 0, At, B0); PG8_MMA(0, 1, At, B1); PG8_BAR; PG8_SCHED;
            PG8_LDA(At, 1, 1); PG8_STAGE(PG8_SB(1, 0), b3, voffB); PG8_STAGE(PG8_SB(1, 1), b3 + hstepB, voffB); PG8_STAGE(PG8_SA(1, 0), a3, voffA);
            PG8_WAIT_V(8); PG8_WAIT_L(0); PG8_BAR; PG8_MMA(1, 0, At, B0); PG8_MMA(1, 1, At, B1); PG8_BAR; PG8_SCHED;
            } else {
            PG8_LDB(B0, 0, 0); PG8_SCHED; PG8_LDA(At, 0, 0); PG8_STAGE(PG8_SA(1, 1), a1 + hstepA, voffA);
            PG8_WAIT_L(8); PG8_BAR; PG8_WAIT_L(0); PG8_MMA(0, 0, At, B0); PG8_BAR; PG8_SCHED;
            PG8_LDB(B1, 0, 1); PG8_STAGE(PG8_SB(0, 0), b2, voffB);
            PG8_BAR; PG8_WAIT_L(0); PG8_MMA(0, 1, At, B1); PG8_BAR;
            PG8_LDA(At, 0, 1); PG8_STAGE(PG8_SA(0, 0), a2, voffA);
            PG8_BAR; PG8_WAIT_L(0); PG8_MMA(1, 0, At, B0); PG8_BAR; PG8_SCHED;
            PG8_STAGE(PG8_SB(0, 1), b2 + hstepB, voffB);
            PG8_WAIT_V(6); PG8_BAR; PG8_MMA(1, 1, At, B1); PG8_BAR;
            PG8_LDB(B0, 1, 0); PG8_SCHED; PG8_LDA(At, 1, 0); PG8_STAGE(PG8_SA(0, 1), a2 + hstepA, voffA);
            PG8_WAIT_L(8); PG8_BAR; PG8_WAIT_L(0); PG8_MMA(0, 0, At, B0); PG8_BAR; PG8_SCHED;
            PG8_LDB(B1, 1, 1); PG8_STAGE(PG8_SB(1, 0), b3, voffB);
            PG8_BAR; PG8_WAIT_L(0); PG8_MMA(0, 1, At, B1); PG8_BAR;
            PG8_LDA(At, 1, 1); PG8_STAGE(PG8_SA(1, 0), a3, voffA);
            PG8_BAR; PG8_WAIT_L(0); PG8_MMA(1, 0, At, B0); PG8_BAR; PG8_SCHED;
            PG8_STAGE(PG8_SB(1, 1), b3 + hstepB, voffB);
            PG8_WAIT_V(6); PG8_BAR; PG8_MMA(1, 1, At, B1); PG8_BAR;
            }
        }
        if constexpr (ALIGN_EPI) { if (wr == 0) PG8_BAR; }
        E(acc, cur, wr, wc, fr, fq); S.done(cur);
        if (!has_next) break;
#pragma unroll
        for (int a = 0; a < 2; ++a)
#pragma unroll
            for (int b = 0; b < 2; ++b)
#pragma unroll
                for (int m = 0; m < 4; ++m)
#pragma unroll
                    for (int n = 0; n < 2; ++n) acc[a][b][m][n] = (f32x4){0.f, 0.f, 0.f, 0.f};
        cur = nxt; cA = nA; cB = nB; ++ui;
        if constexpr (ALIGN_EPI) { if (wr == 1) PG8_BAR; }
    }
    PG8_WAIT_V(0);
    if constexpr (!ALIGN_EPI) { if (wr == 0) PG8_BAR; }
    PG8_BAR;
#undef PG8_SA
#undef PG8_SB
#undef PG8_STAGE
#undef PG8_LDA
#undef PG8_LDB
#undef PG8_MMA
#undef PG8_CAT
#undef PG8_WAIT_V
#undef PG8_WAIT_L
#undef PG8_BAR
#undef PG8_SCHED
}

__device__ __forceinline__ u32x4 pack8(f32x4 v0, f32x4 v1) { u32x4 w; w.x = pk2(v0[0], v0[1]); w.y = pk2(v0[2], v0[3]); w.z = pk2(v1[0], v1[1]); w.w = pk2(v1[2], v1[3]); return w; }
__device__ __forceinline__ void unpack8(u32x4 w, f32x4& v0, f32x4& v1) { v0 = (f32x4){bflo(w.x), bfhi(w.x), bflo(w.y), bfhi(w.y)}; v1 = (f32x4){bflo(w.z), bfhi(w.z), bflo(w.w), bfhi(w.w)}; }

struct EpiProj {
    static constexpr bool PERM = true;
    bf16_t* P; float* ALR; int pn0;
    __device__ __forceinline__ void operator()(const f32x4 (&acc)[2][2][4][2], const Unit& u, int wr, int wc, int fr, int fq) const {
        { const int ln = lane_now(); fr = ln & 15; fq = ln >> 4; }
        const int row0 = u.pm * BM + wr * 64 + fr; int pn = u.pn + pn0; const int cl = wc * 32 + 8 * fq;
        if (pn == 10) {
            if (wc == 0 && fq < 2) {
#pragma unroll
                for (int ai = 0; ai < 2; ++ai)
#pragma unroll
                    for (int m = 0; m < 4; ++m) { float* rp = ALR + (size_t)(row0 + ai * HALF + m * 16) * 16 + 8 * fq;
                        *(f32x4*)rp = acc[ai][0][m][0]; *(f32x4*)(rp + 4) = acc[ai][0][m][1]; }
            }
            return;
        }
        if (pn > 10) --pn;
        const int mode = pn < 8 ? 0 : (pn < 12 ? 1 : 2);
#pragma unroll
        for (int ai = 0; ai < 2; ++ai)
#pragma unroll
            for (int m = 0; m < 4; ++m) { bf16_t* rowp = P + (size_t)(row0 + ai * HALF + m * 16) * PLD + pn * BM + cl;
#pragma unroll
                for (int bj = 0; bj < 2; ++bj) { f32x4 v0 = acc[ai][bj][m][0], v1 = acc[ai][bj][m][1];
                    if (mode == 1) {
#pragma unroll
                        for (int i = 0; i < 4; ++i) { v0[i] = gelu_tanh(v0[i]); v1[i] = gelu_tanh(v1[i]); }
                    } else if (mode == 2) {
                        unsigned w0 = 0, w1 = 0;
                        w0 = __builtin_amdgcn_cvt_pk_u8_f32(sigmoidf_(v0[0]) * 255.f, 0, w0); w0 = __builtin_amdgcn_cvt_pk_u8_f32(sigmoidf_(v0[1]) * 255.f, 1, w0); w0 = __builtin_amdgcn_cvt_pk_u8_f32(sigmoidf_(v0[2]) * 255.f, 2, w0); w0 = __builtin_amdgcn_cvt_pk_u8_f32(sigmoidf_(v0[3]) * 255.f, 3, w0);
                        w1 = __builtin_amdgcn_cvt_pk_u8_f32(sigmoidf_(v1[0]) * 255.f, 0, w1); w1 = __builtin_amdgcn_cvt_pk_u8_f32(sigmoidf_(v1[1]) * 255.f, 1, w1); w1 = __builtin_amdgcn_cvt_pk_u8_f32(sigmoidf_(v1[2]) * 255.f, 2, w1); w1 = __builtin_amdgcn_cvt_pk_u8_f32(sigmoidf_(v1[3]) * 255.f, 3, w1);
                        unsigned char* bp = (unsigned char*)(P + (size_t)(row0 + ai * HALF + m * 16) * PLD) + (pn < 16 ? PC_GA * 2 + (pn - 12) * BM : PC_GB * 2 + (pn - 16) * BM) + cl + bj * HALF;
                        *(u32x2*)bp = (u32x2){w0, w1}; continue;
                    }
                    *(u32x4*)(rowp + bj * HALF) = pack8(v0, v1); } }
    }
};
struct EpiBrA {
    static constexpr bool PERM = true;
    bf16_t* P;
    __device__ __forceinline__ void operator()(const f32x4 (&acc)[2][2][4][2], const Unit& u, int wr, int wc, int fr, int fq) const {
        const int row0 = u.pm * BM + wr * 64 + fr; const int c0 = u.pn * BM + wc * 32 + 8 * fq;
#pragma unroll
        for (int ai = 0; ai < 2; ++ai)
#pragma unroll
            for (int m = 0; m < 4; ++m) { bf16_t* rowp = P + (size_t)(row0 + ai * HALF + m * 16) * PLD;
#pragma unroll
                for (int bj = 0; bj < 2; ++bj) { const int c = c0 + bj * HALF; f32x4 g0, g1; unpack8(*(const u32x4*)(rowp + PC_GA + c), g0, g1);
                    *(u32x4*)(rowp + PC_MRG + c) = pack8(acc[ai][bj][m][0] * g0, acc[ai][bj][m][1] * g1); } }
    }
};
struct EpiBrB {
    static constexpr bool PERM = true;
    bf16_t* P;
    __device__ __forceinline__ void operator()(const f32x4 (&acc)[2][2][4][2], const Unit& u, int wr, int wc, int fr, int fq) const {
        const int row0 = u.pm * BM + wr * 64 + fr; const int c0 = u.pn * BM + wc * 32 + 8 * fq;
#pragma unroll
        for (int ai = 0; ai < 2; ++ai)
#pragma unroll
            for (int m = 0; m < 4; ++m) { bf16_t* rowp = P + (size_t)(row0 + ai * HALF + m * 16) * PLD;
#pragma unroll
                for (int bj = 0; bj < 2; ++bj) { const int c = c0 + bj * HALF; f32x4 g0, g1, p0, p1; unpack8(*(const u32x4*)(rowp + PC_GB + c), g0, g1); unpack8(*(const u32x4*)(rowp + PC_MRG + c), p0, p1);
                    *(u32x4*)(rowp + PC_MRG + c) = pack8(p0 + acc[ai][bj][m][0] * g0, p1 + acc[ai][bj][m][1] * g1); } }
    }
};
struct EpiBrAB {
    static constexpr bool PERM = true;
    bf16_t* P;
    static __device__ __forceinline__ void u8x8(const u32x2 w, f32x4& f0, f32x4& f1) {
        f0 = (f32x4){(float)(w.x & 0xffu), (float)((w.x >> 8) & 0xffu), (float)((w.x >> 16) & 0xffu), (float)(w.x >> 24)};
        f1 = (f32x4){(float)(w.y & 0xffu), (float)((w.y >> 8) & 0xffu), (float)((w.y >> 16) & 0xffu), (float)(w.y >> 24)}; }
    __device__ __forceinline__ void mid(f32x4 (&acc)[2][2][4][2], const Unit& u, int wr, int wc) const {
        const int ln = lane_now(), fr = ln & 15, fq = ln >> 4;
        const int row0 = u.pm * BM + wr * 64 + fr; const int c0 = u.pn * BM + wc * 32 + 8 * fq;
#pragma unroll
        for (int ai = 0; ai < 2; ++ai)
#pragma unroll
            for (int m = 0; m < 4; ++m) { const unsigned char* rowb = (const unsigned char*)(P + (size_t)(row0 + ai * HALF + m * 16) * PLD);
#pragma unroll
                for (int bj = 0; bj < 2; ++bj) { const int c = c0 + bj * HALF; f32x4 a0, a1, b0, b1; u8x8(*(const u32x2*)(rowb + PC_GA * 2 + c), a0, a1); u8x8(*(const u32x2*)(rowb + PC_GB * 2 + c), b0, b1);
#pragma unroll
                    for (int i = 0; i < 4; ++i) { acc[ai][bj][m][0][i] *= a0[i] * __builtin_amdgcn_rcpf(fmaxf(b0[i], 1.f)); acc[ai][bj][m][1][i] *= a1[i] * __builtin_amdgcn_rcpf(fmaxf(b1[i], 1.f)); } } }
    }
    __device__ __forceinline__ void operator()(const f32x4 (&acc)[2][2][4][2], const Unit& u, int wr, int wc, int fr, int fq) const {
        { const int ln = lane_now(); fr = ln & 15; fq = ln >> 4; }
        const int row0 = u.pm * BM + wr * 64 + fr; const int c0 = u.pn * BM + wc * 32 + 8 * fq;
#pragma unroll
        for (int ai = 0; ai < 2; ++ai)
#pragma unroll
            for (int m = 0; m < 4; ++m) { bf16_t* rowp = P + (size_t)(row0 + ai * HALF + m * 16) * PLD;
#pragma unroll
                for (int bj = 0; bj < 2; ++bj) { const int c = c0 + bj * HALF; f32x4 g0, g1; u8x8(*(const u32x2*)((const unsigned char*)rowp + PC_GB * 2 + c), g0, g1);
#pragma unroll
                    for (int i = 0; i < 4; ++i) { g0[i] = fmaxf(g0[i], 1.f) * (1.f / 255.f); g1[i] = fmaxf(g1[i], 1.f) * (1.f / 255.f); }
                    *(u32x4*)(rowp + PC_MRG + c) = pack8(acc[ai][bj][m][0] * g0, acc[ai][bj][m][1] * g1); } }
    }
};
struct EpiOut {
    static constexpr bool PERM = true;
    bf16_t* O;
    __device__ __forceinline__ void operator()(const f32x4 (&acc)[2][2][4][2], const Unit& u, int wr, int wc, int fr, int fq) const {
        const int row0 = u.pm * BM + wr * 64 + fr; const int c0 = u.pn * BM + wc * 32 + 8 * fq;
#pragma unroll
        for (int ai = 0; ai < 2; ++ai)
#pragma unroll
            for (int m = 0; m < 4; ++m) { const size_t ro = (size_t)(row0 + ai * HALF + m * 16) * D;
#pragma unroll
                for (int bj = 0; bj < 2; ++bj) *(u32x4*)(O + ro + c0 + bj * HALF) = pack8(acc[ai][bj][m][0], acc[ai][bj][m][1]); }
    }
};
struct EpiScores {
    static constexpr bool PERM = true;
    bf16_t* SC;
    __device__ __forceinline__ void operator()(const f32x4 (&acc)[2][2][4][2], const Unit& u, int wr, int wc, int fr, int fq) const {
        const int tb0 = u.pm * 16 + wr * 4; const int cq0 = (u.pn * BM + wc * 32 + 8 * fq) >> 3;
#pragma unroll
        for (int ai = 0; ai < 2; ++ai)
#pragma unroll
            for (int m = 0; m < 4; ++m) { bf16_t* bp = SC + ((size_t)(tb0 + ai * 8 + m) * 256) * 128 + fr * 8;
#pragma unroll
                for (int bj = 0; bj < 2; ++bj) { u32x4 w = pack8(acc[ai][bj][m][0], acc[ai][bj][m][1]);
#pragma unroll
                    for (int c = 0; c < 4; ++c) w[c] ^= (((w[c] >> 15) & 0x00010001u) * 0x7FFFu) | 0x80008000u;
                    *(u32x4*)(bp + (size_t)(cq0 + bj * 16) * 128) = w; } }
    }
};
}

#define XB_TMO      128
#define XB_XCNT(j)  (256  + 64 * (j))
#define XB_XSUB(j)  (1280 + 64 * (j))
#define XB_XGEN(j)  (2304 + 64 * (j))
#define XB_TOP      3328
#define XB_TOPGEN   3392
#define XCD_BAR_WORDS 3456
#define XB_SPIN_CAP (1u << 18)
__device__ __forceinline__ unsigned xb_ld(unsigned* p)              { return __hip_atomic_load(p, __ATOMIC_RELAXED, __HIP_MEMORY_SCOPE_AGENT); }
__device__ __forceinline__ unsigned xb_add(unsigned* p, unsigned v) { return __hip_atomic_fetch_add(p, v, __ATOMIC_RELAXED, __HIP_MEMORY_SCOPE_AGENT); }
__device__ __forceinline__ unsigned xb_xcc_id() { return (unsigned)__builtin_amdgcn_s_getreg((3 << 11) | 20) & 0xFu; }
#define XB_SPIN(cond, bar) do { unsigned _sp = 0; while (cond) { __builtin_amdgcn_s_sleep(1); \
    if ((++_sp & 255u) == 0u) { if (xb_ld(&(bar)[XB_TMO])) break; if (_sp > XB_SPIN_CAP) { atomicAdd(&(bar)[XB_TMO], 1u); break; } } } } while (0)
struct XcdBarrier { unsigned* bar; unsigned x; volatile LAS unsigned* st; int wave; };
__device__ __forceinline__ XcdBarrier xcd_barrier_post(unsigned* bar, volatile LAS unsigned* st, int wave) {
    XcdBarrier b; b.bar = bar; b.x = xb_xcc_id(); b.st = st; b.wave = wave;
    if (wave == 0 && lane_now() == 0) (void)xb_add(&bar[XB_XCNT(b.x)], 1u);
    return b;
}
__device__ __forceinline__ void xcd_barrier_complete(unsigned* bar, unsigned x, unsigned& nloc, unsigned& nx) {
    const unsigned G = gridDim.x * gridDim.y * gridDim.z;
    unsigned sum, cnt, mine, sp = 0u;
    for (;;) {
        sum = 0u; cnt = 0u; mine = 0u;
#pragma unroll
        for (unsigned j = 0; j < 16; ++j) { const unsigned c = xb_ld(&bar[XB_XCNT(j)]); sum += c; cnt += (c > 0u) ? 1u : 0u; mine = (j == x) ? c : mine; }
        if (sum == G) break;
        __builtin_amdgcn_s_sleep(1);
        if ((++sp & 255u) == 0u) { if (xb_ld(&bar[XB_TMO])) break; if (sp > XB_SPIN_CAP) { atomicAdd(&bar[XB_TMO], 1u); break; } }
    }
    nloc = mine > 0u ? mine : 1u; nx = cnt > 0u ? cnt : 1u;
}
__device__ __forceinline__ void xcd_barrier(const XcdBarrier& b) {
    asm volatile("s_waitcnt vmcnt(0)" ::: "memory");
    __syncthreads();
    if (b.wave == 0 && lane_now() == 0) {
        unsigned* bar = b.bar;
        __builtin_amdgcn_s_waitcnt(0);
        unsigned nloc = b.st[0], nx = b.st[1];
        if (nloc == 0u) { xcd_barrier_complete(bar, b.x, nloc, nx); b.st[0] = nloc; b.st[1] = nx; }
        const unsigned old = xb_add(&bar[XB_XSUB(b.x)], 1u);
        const unsigned gen = old / nloc;
        if (old + 1u == (gen + 1u) * nloc) {
            __builtin_amdgcn_fence(__ATOMIC_RELEASE, "agent");
            asm volatile("s_waitcnt vmcnt(0)" ::: "memory");
            const unsigned og = xb_add(&bar[XB_TOP], 1u);
            const unsigned tg = og / nx;
            if (og + 1u == (tg + 1u) * nx) xb_add(&bar[XB_TOPGEN], 1u);
            else XB_SPIN(xb_ld(&bar[XB_TOPGEN]) == tg, bar);
            __builtin_amdgcn_fence(__ATOMIC_ACQUIRE, "agent");
            xb_add(&bar[XB_XGEN(b.x)], 1u);
            asm volatile("s_waitcnt vmcnt(0)" ::: "memory");
        } else {
            XB_SPIN(xb_ld(&bar[XB_XGEN(b.x)]) == gen, bar);
            __builtin_amdgcn_fence(__ATOMIC_ACQUIRE, "agent");
            asm volatile("s_waitcnt vmcnt(0)" ::: "memory");
        }
    }
    __syncthreads();
}

struct Args {
    const float* in[20]; float* out; unsigned char* ws; int ph_lo, ph_hi, li, pad;
};
enum { I_X = 0, I_N1G, I_WIN, I_WGU, I_BG, I_GLAG, I_SLNG, I_SLNB, I_SW, I_SB, I_WBA, I_WBB, I_WOUT, I_N2G, I_WQ, I_K1, I_K2, I_PU, I_PV, I_FG };

struct Frame {
    LAS unsigned char* lds;
    int tid, lane, wave, G, bid;
};

__device__ __forceinline__ float clamp448(float v) { return __builtin_amdgcn_fmed3f(v, -448.f, 448.f); }
template <int MODE, bool F8 = false>
__device__ __forceinline__ void p0_transpose_item(const float* W, int K, int Nsrc, int Ndst, bf16_t* WT, LAS float* scr, int item, int lane, float sc8 = 1.f, int ldk = 0) {
    if (ldk == 0) ldk = K;
    const int nblk = Ndst / 32, kb = item / nblk, nb = item % nblk, k0 = 64 * kb, n0 = 32 * nb;
    const int nd = n0 + (lane & 31);
    int sc = nd; bool valid = true;
    if (MODE == 1) { if (nd < 2048) sc = nd; else if (nd < 2560) sc = nd + 16; else if (nd < 2576) sc = 2048 + (nd - 2560); else if (nd < 2816) { sc = 0; valid = false; } else sc = nd - 240; }
#pragma unroll 8
    for (int i = 0; i < 32; ++i) { const int kk = 2 * i + (lane >> 5); const float v = valid ? W[(size_t)(k0 + kk) * Nsrc + sc] : 0.f; scr[kk * 33 + (lane & 31)] = v; }
    LDS_WAIT(); asm volatile("" ::: "memory");
    if (F8) {
        const int c = lane & 3;
#pragma unroll
        for (int j = 0; j < 2; ++j) { const int n = (lane >> 2) + 16 * j; const LAS float* s = scr + (16 * c) * 33 + n; u32x4 o;
#pragma unroll
            for (int q = 0; q < 4; ++q) { int w = 0; w = __builtin_amdgcn_cvt_pk_fp8_f32(clamp448(s[(4 * q) * 33] * sc8), clamp448(s[(4 * q + 1) * 33] * sc8), w, false);
                w = __builtin_amdgcn_cvt_pk_fp8_f32(clamp448(s[(4 * q + 2) * 33] * sc8), clamp448(s[(4 * q + 3) * 33] * sc8), w, true); o[q] = (unsigned)w; }
            *(u32x4*)((unsigned char*)WT + (size_t)(n0 + n) * ldk + k0 + 16 * c) = o; }
    } else {
    const int c = lane & 7;
#pragma unroll
    for (int j = 0; j < 4; ++j) { const int n = (lane >> 3) + 8 * j; const LAS float* s = scr + (8 * c) * 33 + n;
        u32x4 o; o.x = pk2(s[0 * 33], s[1 * 33]); o.y = pk2(s[2 * 33], s[3 * 33]); o.z = pk2(s[4 * 33], s[5 * 33]); o.w = pk2(s[6 * 33], s[7 * 33]);
        *(u32x4*)(WT + (size_t)(n0 + n) * ldk + k0 + 8 * c) = o; }
    }
    LDS_WAIT(); asm volatile("" ::: "memory");
}
template <int OM, int NB>
__device__ __forceinline__ void rms_rows_to_bf16(int lane, const float* x0, size_t xstride, const float* g, bf16_t* o0, size_t ostride, unsigned* o80 = nullptr, size_t o8stride = 0, const bf16_t* add0 = nullptr, size_t addstride = 0, bf16_t* hb0 = nullptr, size_t hbstride = 0) {
    f32x4 v[NB][4]; float s[NB];
#pragma unroll
    for (int b = 0; b < NB; ++b) { const float* xr = x0 + b * xstride + 8 * lane;
#pragma unroll
        for (int j = 0; j < 2; ++j) { v[b][2 * j] = *(const f32x4*)(xr + 512 * j); v[b][2 * j + 1] = *(const f32x4*)(xr + 512 * j + 4); } }
    if (add0) {
        u32x4 ad[NB][2];
#pragma unroll
        for (int b = 0; b < NB; ++b) { const bf16_t* ar = add0 + b * addstride + 8 * lane;
#pragma unroll
            for (int j = 0; j < 2; ++j) ad[b][j] = *(const u32x4*)(ar + 512 * j); }
#pragma unroll
        for (int b = 0; b < NB; ++b)
#pragma unroll
            for (int j = 0; j < 2; ++j) { v[b][2 * j] = v[b][2 * j] + (f32x4){bflo(ad[b][j].x), bfhi(ad[b][j].x), bflo(ad[b][j].y), bfhi(ad[b][j].y)};
                v[b][2 * j + 1] = v[b][2 * j + 1] + (f32x4){bflo(ad[b][j].z), bfhi(ad[b][j].z), bflo(ad[b][j].w), bfhi(ad[b][j].w)}; }
    }
    if (hb0) {
#pragma unroll
        for (int b = 0; b < NB; ++b)
#pragma unroll
            for (int j = 0; j < 2; ++j) *(u32x4*)(hb0 + b * hbstride + 512 * j + 8 * lane) = pg8::pack8(v[b][2 * j], v[b][2 * j + 1]);
    }
#pragma unroll
    for (int b = 0; b < NB; ++b) { s[b] = 0.f;
#pragma unroll
        for (int j = 0; j < 4; ++j) s[b] += (v[b][j].x * v[b][j].x + v[b][j].y * v[b][j].y) + (v[b][j].z * v[b][j].z + v[b][j].w * v[b][j].w); }
#pragma unroll
    for (int o = 1; o < 64; o <<= 1) {
#pragma unroll
        for (int b = 0; b < NB; ++b) s[b] += __shfl_xor(s[b], o); }
    const float* gr = g + 8 * lane;
#pragma unroll
    for (int b = 0; b < NB; ++b) { const float rstd = 1.f / sqrtf(s[b] * (1.f / D) + EPS);
#pragma unroll
        for (int j = 0; j < 2; ++j) { const f32x4 y0 = v[b][2 * j] * rstd * *(const f32x4*)(gr + 512 * j), y1 = v[b][2 * j + 1] * rstd * *(const f32x4*)(gr + 512 * j + 4);
            const u32x4 o = pg8::pack8(y0, y1);
            if (OM & 1) *(u32x4*)(o0 + b * ostride + 512 * j + 8 * lane) = o;
            if (OM == 3) { u32x2 w8;
#pragma unroll
                for (int h = 0; h < 2; ++h) { int w = 0; w = __builtin_amdgcn_cvt_pk_fp8_f32(clamp448(bflo(o[2 * h]) * 16.f), clamp448(bfhi(o[2 * h]) * 16.f), w, false);
                    w = __builtin_amdgcn_cvt_pk_fp8_f32(clamp448(bflo(o[2 * h + 1]) * 16.f), clamp448(bfhi(o[2 * h + 1]) * 16.f), w, true); w8[h] = (unsigned)w; }
                *(u32x2*)(o80 + b * o8stride + 128 * j + 2 * lane) = w8; }
            if (OM == 2) { u32x2 w8; int w = 0;
                w = __builtin_amdgcn_cvt_pk_fp8_f32(clamp448(y0.x * 16.f), clamp448(y0.y * 16.f), w, false); w = __builtin_amdgcn_cvt_pk_fp8_f32(clamp448(y0.z * 16.f), clamp448(y0.w * 16.f), w, true); w8.x = (unsigned)w;
                w = 0; w = __builtin_amdgcn_cvt_pk_fp8_f32(clamp448(y1.x * 16.f), clamp448(y1.y * 16.f), w, false); w = __builtin_amdgcn_cvt_pk_fp8_f32(clamp448(y1.z * 16.f), clamp448(y1.w * 16.f), w, true); w8.y = (unsigned)w;
                *(u32x2*)(o80 + b * o8stride + 128 * j + 2 * lane) = w8; } } }
}
__device__ __forceinline__ float wave_max(float v) {
#pragma unroll
    for (int o = 1; o < 64; o <<= 1) v = fmaxf(v, __shfl_xor(v, o));
    return v;
}
template <int NB>
__device__ __forceinline__ void cvt_rows_fp8(int lane, const float* const (&src)[NB], unsigned char* const (&dst16)[NB], float* const (&scale_out)[NB]) {
    f32x4 v[NB][4]; float m[NB];
#pragma unroll
    for (int b = 0; b < NB; ++b) {
#pragma unroll
        for (int j = 0; j < 4; ++j) v[b][j] = *(const GAS f32x4*)(src[b] + 16 * lane + 4 * j); }
#pragma unroll
    for (int b = 0; b < NB; ++b) { m[b] = 0.f;
#pragma unroll
        for (int j = 0; j < 4; ++j) m[b] = fmaxf(m[b], fmaxf(fmaxf(fabsf(v[b][j].x), fabsf(v[b][j].y)), fmaxf(fabsf(v[b][j].z), fabsf(v[b][j].w)))); }
#pragma unroll
    for (int o = 1; o < 64; o <<= 1) {
#pragma unroll
        for (int b = 0; b < NB; ++b) m[b] = fmaxf(m[b], __shfl_xor(m[b], o)); }
#pragma unroll
    for (int b = 0; b < NB; ++b) { const float inv = m[b] > 0.f ? 224.f / m[b] : 0.f, sc = m[b] > 0.f ? m[b] * (1.f / 224.f) : 1.f;
        u32x4 o;
#pragma unroll
        for (int j = 0; j < 4; ++j) { int w = 0; w = __builtin_amdgcn_cvt_pk_fp8_f32(v[b][j].x * inv, v[b][j].y * inv, w, false); w = __builtin_amdgcn_cvt_pk_fp8_f32(v[b][j].z * inv, v[b][j].w * inv, w, true); o[j] = (unsigned)w; }
        *(GAS u32x4*)dst16[b] = o;
        if (lane == 0) *(GAS float*)scale_out[b] = sc; }
}
__device__ __forceinline__ unsigned fp4_code(float t) { const float a = fabsf(t);
    const unsigned c = (unsigned)(a >= 0.25f) + (unsigned)(a >= 0.75f) + (unsigned)(a >= 1.25f) + (unsigned)(a >= 1.75f) + (unsigned)(a >= 2.5f) + (unsigned)(a >= 3.5f) + (unsigned)(a >= 5.f);
    return c | (t < 0.f ? 8u : 0u); }
template <int NB, bool PERMV = false>
__device__ __forceinline__ void cvt_rows_fp4(int lane, const float* const (&src)[NB], unsigned char* const (&dst8)[NB], float* const (&scale_out)[NB]) {
    f32x4 v[NB][4]; float m[NB];
#pragma unroll
    for (int b = 0; b < NB; ++b) {
#pragma unroll
        for (int j = 0; j < 4; ++j) v[b][j] = *(const GAS f32x4*)(src[b] + 16 * lane + 4 * j); }
#pragma unroll
    for (int b = 0; b < NB; ++b) { m[b] = 0.f;
#pragma unroll
        for (int j = 0; j < 4; ++j) m[b] = fmaxf(m[b], fmaxf(fmaxf(fabsf(v[b][j].x), fabsf(v[b][j].y)), fmaxf(fabsf(v[b][j].z), fabsf(v[b][j].w)))); }
#pragma unroll
    for (int o = 1; o < 64; o <<= 1) {
#pragma unroll
        for (int b = 0; b < NB; ++b) m[b] = fmaxf(m[b], __shfl_xor(m[b], o)); }
#pragma unroll
    for (int b = 0; b < NB; ++b) { const float inv = m[b] > 0.f ? 6.f / m[b] : 0.f, sc = m[b] > 0.f ? m[b] * (1.f / 6.f) : 1.f;
        u32x2 o;
#pragma unroll
        for (int h = 0; h < 2; ++h) { unsigned w = 0;
            const f32x4 t0 = v[b][2 * h] * inv, t1 = v[b][2 * h + 1] * inv;
            w = __builtin_amdgcn_cvt_scalef32_pk_fp4_f32(w, t0.x, t0.y, 1.f, 0); w = __builtin_amdgcn_cvt_scalef32_pk_fp4_f32(w, t0.z, t0.w, 1.f, 1);
            w = __builtin_amdgcn_cvt_scalef32_pk_fp4_f32(w, t1.x, t1.y, 1.f, 2); w = __builtin_amdgcn_cvt_scalef32_pk_fp4_f32(w, t1.z, t1.w, 1.f, 3);
            o[h] = w; }
        if (PERMV) { *(GAS unsigned*)(dst8[b] + 16 * ((2 * lane) & 31) + 4 * (lane >> 4)) = o.x; *(GAS unsigned*)(dst8[b] + 16 * ((2 * lane + 1) & 31) + 4 * (lane >> 4)) = o.y; }
        else *(GAS u32x2*)dst8[b] = o;
        if (lane == 0) *(GAS float*)scale_out[b] = sc; }
}
__device__ __forceinline__ void convert_tables(const Frame& F, const Args& A, int wi, int nw) {
    unsigned char* ws = A.ws; const int gw = wi, NGW = nw;
    {
        int mc = gw;
        for (; mc + 3 * NGW < NEXP; mc += 4 * NGW) { const float* src[4]; unsigned char* dst[4]; float* sco[4];
#pragma unroll
            for (int b = 0; b < 4; ++b) { const int e = mc + b * NGW; src[b] = A.in[I_PU] + (size_t)e * D; dst[b] = ws + WS_U8 + (size_t)((e & (UNG - 1)) * (NEXP / UNG) + (e >> UNG_SH)) * 512 + 8 * F.lane; sco[b] = (float*)(ws + WS_SU) + e; }
            cvt_rows_fp4<4>(F.lane, src, dst, sco); }
        for (; mc < NEXP; mc += NGW) { const float* src[1]; unsigned char* dst[1]; float* sco[1];
            const int e = mc; src[0] = A.in[I_PU] + (size_t)e * D; dst[0] = ws + WS_U8 + (size_t)((e & (UNG - 1)) * (NEXP / UNG) + (e >> UNG_SH)) * 512 + 8 * F.lane; sco[0] = (float*)(ws + WS_SU) + e;
            cvt_rows_fp4<1>(F.lane, src, dst, sco); }
    }
    if (V_F4) {
        int mc = gw;
        for (; mc + 3 * NGW < NEXP; mc += 4 * NGW) { const float* src[4]; unsigned char* dst[4]; float* sco[4];
#pragma unroll
            for (int b = 0; b < 4; ++b) { const int e = mc + b * NGW; src[b] = A.in[I_PV] + (size_t)e * D; dst[b] = ws + WS_V8 + (size_t)e * 512; sco[b] = (float*)(ws + WS_SV) + e; }
            cvt_rows_fp4<4, true>(F.lane, src, dst, sco); }
        for (; mc < NEXP; mc += NGW) { const float* src[1]; unsigned char* dst[1]; float* sco[1];
            const int e = mc; src[0] = A.in[I_PV] + (size_t)e * D; dst[0] = ws + WS_V8 + (size_t)e * 512; sco[0] = (float*)(ws + WS_SV) + e;
            cvt_rows_fp4<1, true>(F.lane, src, dst, sco); }
    } else {
        int mc = gw;
        for (; mc + 3 * NGW < NEXP; mc += 4 * NGW) { const float* src[4]; unsigned char* dst[4]; float* sco[4];
#pragma unroll
            for (int b = 0; b < 4; ++b) { const int e = mc + b * NGW; src[b] = A.in[I_PV] + (size_t)e * D; dst[b] = ws + WS_V8 + ((size_t)(F.lane >> 3) * NEXP + e) * 128 + 16 * (F.lane & 7); sco[b] = (float*)(ws + WS_SV) + e; }
            cvt_rows_fp8<4>(F.lane, src, dst, sco); }
        for (; mc < NEXP; mc += NGW) { const float* src[1]; unsigned char* dst[1]; float* sco[1];
            const int e = mc; src[0] = A.in[I_PV] + (size_t)e * D; dst[0] = ws + WS_V8 + ((size_t)(F.lane >> 3) * NEXP + e) * 128 + 16 * (F.lane & 7); sco[0] = (float*)(ws + WS_SV) + e;
            cvt_rows_fp8<1>(F.lane, src, dst, sco); }
    }
}
__device__ __forceinline__ void phase0(const Frame& F, const Args& A) {
    unsigned char* ws = A.ws;
    if (!SC_F8) {
        const int l = F.lane, fr = l & 15, q = l >> 4;
        bf16_t* WQF = (bf16_t*)(ws + WS_WQF);
        for (int it = F.bid * NWAVES + F.wave; it < 2048; it += F.G * NWAVES) {
            const int kh = it & 1, kt = (it >> 1) & 63, hh = it >> 7;
            const float* kX = (hh & 1) ? A.in[I_K2] : A.in[I_K1];
            const float* ap = A.in[I_WQ] + (size_t)(kt * 16 + fr) * 2048 + hh * 128 + 4 * q;
            f32x4 a[8];
#pragma unroll
            for (int t = 0; t < 8; ++t) a[t] = *(const f32x4*)(ap + 16 * t);
#pragma unroll
            for (int kb = 0; kb < 4; ++kb) { const int key0 = kh * 64 + kb * 16;
                const float* bp = kX + (size_t)(key0 + fr) * 128 + 4 * q;
                f32x4 b[8];
#pragma unroll
                for (int t = 0; t < 8; ++t) b[t] = *(const f32x4*)(bp + 16 * t);
                f32x4 d = {0.f, 0.f, 0.f, 0.f};
#pragma unroll
                for (int t = 0; t < 8; ++t)
#pragma unroll
                    for (int c = 0; c < 4; ++c) d = __builtin_amdgcn_mfma_f32_16x16x4f32(a[t][c], b[t][c], d, 0, 0, 0);
                u32x2 o; o.x = pk2(d[0], d[1]); o.y = pk2(d[2], d[3]);
                *(u32x2*)(WQF + (size_t)(hh * 128 + key0 + fr) * 1024 + kt * 16 + 4 * q) = o; }
        }
    } else {
        LAS float* kx = (LAS float*)F.lds;
        LAS float* wt = (LAS float*)(F.lds + 128 * 129 * 4);
        bf16_t* WQF = (bf16_t*)(ws + WS_WQF);
        for (int it = F.bid; it < 512; it += F.G) {
            const int hh = it >> 5, kblk = it & 31, k0 = kblk * 32;
            const float* kX = (hh & 1) ? A.in[I_K2] : A.in[I_K1];
            __syncthreads();
            for (int e = F.tid; e < 128 * 128; e += 512) kx[(e >> 7) * 129 + (e & 127)] = kX[e];
            for (int e = F.tid; e < 32 * 128; e += 512) wt[e] = A.in[I_WQ][(size_t)(k0 + (e >> 7)) * 2048 + hh * 128 + (e & 127)];
            __syncthreads();
            const int key = F.tid & 127, kq = F.tid >> 7;
            float acc[8];
#pragma unroll
            for (int i = 0; i < 8; ++i) acc[i] = 0.f;
            for (int d = 0; d < 128; ++d) { const float b = kx[key * 129 + d];
#pragma unroll
                for (int i = 0; i < 8; ++i) acc[i] += wt[(kq * 8 + i) * 128 + d] * b; }
            if (SC_F8) { u32x2 o;
#pragma unroll
                for (int h2 = 0; h2 < 2; ++h2) { int w = 0; w = __builtin_amdgcn_cvt_pk_fp8_f32(clamp448(acc[4 * h2] * 1024.f), clamp448(acc[4 * h2 + 1] * 1024.f), w, false);
                    w = __builtin_amdgcn_cvt_pk_fp8_f32(clamp448(acc[4 * h2 + 2] * 1024.f), clamp448(acc[4 * h2 + 3] * 1024.f), w, true); o[h2] = (unsigned)w; }
                *(u32x2*)((unsigned char*)WQF + (size_t)(hh * 128 + key) * 1024 + k0 + kq * 8) = o;
            } else {
            u32x4 o; o.x = pk2(acc[0], acc[1]); o.y = pk2(acc[2], acc[3]); o.z = pk2(acc[4], acc[5]); o.w = pk2(acc[6], acc[7]);
            *(u32x4*)(WQF + (size_t)(hh * 128 + key) * 1024 + k0 + kq * 8) = o; }
        }
        __syncthreads();
    }
    LAS float* scr = (LAS float*)(F.lds + F.wave * 16384);
    const int gw = F.bid * NWAVES + F.wave, NGW = F.G * NWAVES;
    constexpr int I_IN = 16 * (NPROJ / 32), I_A = 8 * 32, I_B = 8 * 32, I_O = 16 * 32;
    constexpr int NITEMS = I_IN + I_A + I_B + I_O;
    for (int it = gw; it < NITEMS; it += NGW) {
        int r = it;
        if (r < I_IN) { if ((r % (NPROJ / 32)) * 32 >= F8_LO * 256) p0_transpose_item<1, true>(A.in[I_WIN], 1024, 5136, NPROJ, (bf16_t*)(ws + WS_W8), scr, r, F.lane, 1024.f);
                        else p0_transpose_item<1, false>(A.in[I_WIN], 1024, 5136, NPROJ, (bf16_t*)(ws + WS_WIN), scr, r, F.lane); continue; } r -= I_IN;
        if (r < I_A) { p0_transpose_item<0>(A.in[I_WBA], 512, 1024, 1024, (bf16_t*)(ws + WS_WA), scr, r, F.lane, 1.f, 1024); continue; } r -= I_A;
        if (r < I_B) { p0_transpose_item<0>(A.in[I_WBB], 512, 1024, 1024, (bf16_t*)(ws + WS_WA) + 512, scr, r, F.lane, 1.f, 1024); continue; } r -= I_B;
        p0_transpose_item<0>(A.in[I_WOUT], 1024, 1024, 1024, (bf16_t*)(ws + WS_WOUT), scr, r, F.lane);
    }
    constexpr int OM1 = F8_LO <= 0 ? 2 : (F8_LO >= 21 ? 1 : 3);
    { int m = gw; for (; m + 3 * NGW < T_TOK; m += 4 * NGW) rms_rows_to_bf16<OM1, 4>(F.lane, A.in[I_X] + (size_t)m * D, (size_t)NGW * D, A.in[I_N1G], (bf16_t*)(ws + WS_N1) + (size_t)m * D, (size_t)NGW * D, (unsigned*)(ws + WS_N18) + (size_t)m * 256, (size_t)NGW * 256);
      for (; m < T_TOK; m += NGW) rms_rows_to_bf16<OM1, 1>(F.lane, A.in[I_X] + (size_t)m * D, 0, A.in[I_N1G], (bf16_t*)(ws + WS_N1) + (size_t)m * D, 0, (unsigned*)(ws + WS_N18) + (size_t)m * 256, 0); }
}

__device__ __forceinline__ float log_sigmoid(float z) { return fminf(z, 0.f) - log1pf(__expf(-fabsf(z))); }

template <bool DRY>
__device__ __forceinline__ void gla_chunk_phase(const Frame& F, const Args& A) {
    unsigned char* ws = A.ws;
    const bf16_t* P = (const bf16_t*)(ws + WS_P);
    const float* ALR = (const float*)(ws + WS_ALR);
    LAS float* alr = (LAS float*)F.lds;
    LAS float* tot = (LAS float*)(F.lds + 4096);
    LAS bf16_t* kdT = (LAS bf16_t*)(F.lds + 8192);
    LAS bf16_t* vT = (LAS bf16_t*)(F.lds + 26624);
    LAS bf16_t* stT = (LAS bf16_t*)(F.lds + 45056);
    const int tid = F.tid, kk = tid & 127, seg = tid >> 7;
    const bool hconst = (F.G & 3) == 0;
    int hcur = -1; float w[16]; float bias = 0.f;
#pragma unroll
    for (int j = 0; j < 16; ++j) w[j] = 0.f;
    float na0, na1; bf16_t nk[16], nv[16];
#define GC_LOAD(unit) do { const int h_ = (unit) & 3, c_ = ((unit) >> 2) & 63, b_ = (unit) >> 8; const int t0_ = b_ * SEQ + c_ * 64; \
        na0 = ALR[(size_t)t0_ * 16 + tid]; na1 = ALR[(size_t)t0_ * 16 + 512 + tid]; \
        const bf16_t* kp_ = P + (size_t)(t0_ + 16 * seg) * PLD + PC_K + h_ * 128 + kk; const bf16_t* vp_ = P + (size_t)(t0_ + 16 * seg) * PLD + PC_V + h_ * 128 + kk; \
        _Pragma("unroll") for (int i_ = 0; i_ < 16; ++i_) { nk[i_] = kp_[(size_t)i_ * PLD]; nv[i_] = vp_[(size_t)i_ * PLD]; } } while (0)
    int unit = F.bid;
    if (unit < 2048) GC_LOAD(unit);
    for (; unit < 2048; unit += F.G) {
        const int h = unit & 3;
        if (h != hcur) { hcur = h;
#pragma unroll
            for (int j = 0; j < 16; ++j) w[j] = A.in[I_WGU][(size_t)j * 512 + h * 128 + kk];
            bias = A.in[I_BG][h * 128 + kk]; }
        __syncthreads();
        alr[tid] = na0; alr[512 + tid] = na1;
        bf16_t kr[16], vr[16];
#pragma unroll
        for (int i = 0; i < 16; ++i) { kr[i] = nk[i]; vr[i] = nv[i]; }
        if (unit + F.G < 2048) GC_LOAD(unit + F.G);
        __syncthreads();
        float cum[16]; float run = 0.f;
#pragma unroll
        for (int i = 0; i < 16; ++i) { const LAS f32x4* ap = (const LAS f32x4*)(alr + (16 * seg + i) * 16); float z = bias;
#pragma unroll
            for (int q = 0; q < 4; ++q) { const f32x4 a4 = ap[q]; z += a4.x * w[4 * q] + a4.y * w[4 * q + 1] + a4.z * w[4 * q + 2] + a4.w * w[4 * q + 3]; }
            const float ls = fminf(z, 0.f) - __logf(1.f + __expf(-fabsf(z)));
            run += ls * (1.f / 16.f); cum[i] = run; }
        tot[seg * 128 + kk] = run;
        __syncthreads();
        {
            const float t0s = tot[kk], t1s = tot[128 + kk], t2s = tot[256 + kk], t3s = tot[384 + kk];
            const float total = (t0s + t1s) + (t2s + t3s);
            const float prefix = seg == 0 ? 0.f : (seg == 1 ? t0s : (seg == 2 ? t0s + t1s : t0s + t1s + t2s));
            unsigned kw[8], vw[8];
#pragma unroll
            for (int i = 0; i < 8; ++i) {
                const float e0 = __expf(total - (prefix + cum[2 * i])), e1 = __expf(total - (prefix + cum[2 * i + 1]));
                kw[i] = pk2(bf1(kr[2 * i]) * e0, bf1(kr[2 * i + 1]) * e1); vw[i] = (unsigned)vr[2 * i] | ((unsigned)vr[2 * i + 1] << 16);
            }
            *(LAS u32x4*)(kdT + kk * 72 + 16 * seg) = (u32x4){kw[0], kw[1], kw[2], kw[3]}; *(LAS u32x4*)(kdT + kk * 72 + 16 * seg + 8) = (u32x4){kw[4], kw[5], kw[6], kw[7]};
            *(LAS u32x4*)(vT + kk * 72 + 16 * seg) = (u32x4){vw[0], vw[1], vw[2], vw[3]}; *(LAS u32x4*)(vT + kk * 72 + 16 * seg + 8) = (u32x4){vw[4], vw[5], vw[6], vw[7]};
            if (seg == 0) ((float*)(DRY ? (unsigned char*)A.out + 96 * MiB : ws + WS_DEC))[(size_t)unit * 128 + kk] = __expf(total);
        }
        __syncthreads();
        {
            const int w8 = F.wave, l = F.lane, fr = l & 15, fq = l >> 4;
            f32x4 acc[8];
#pragma unroll
            for (int n = 0; n < 8; ++n) acc[n] = (f32x4){0.f, 0.f, 0.f, 0.f};
#pragma unroll
            for (int ks = 0; ks < 2; ++ks) {
                const bf16x8 a = *(const LAS bf16x8*)(kdT + (16 * w8 + fr) * 72 + 32 * ks + 8 * fq);
#pragma unroll
                for (int n = 0; n < 8; ++n) { const bf16x8 bb = *(const LAS bf16x8*)(vT + (16 * n + fr) * 72 + 32 * ks + 8 * fq);
                    acc[n] = __builtin_amdgcn_mfma_f32_16x16x32_bf16(a, bb, acc[n], 0, 0, 0); }
            }
#pragma unroll
            for (int n = 0; n < 8; ++n) { u32x2 o; o.x = pk2(acc[n][0], acc[n][1]); o.y = pk2(acc[n][2], acc[n][3]);
                *(LAS u32x2*)(stT + (16 * n + fr) * 136 + 16 * w8 + 4 * fq) = o; }
        }
        __syncthreads();
        {
            bf16_t* ST = (bf16_t*)(DRY ? (unsigned char*)A.out : ws + WS_N1) + (size_t)unit * 16384;
            const int vv = tid >> 2, part = tid & 3;
#pragma unroll
            for (int q = 0; q < 4; ++q) *(u32x4*)(ST + (size_t)vv * 128 + 32 * part + 8 * q) = *(const LAS u32x4*)(stT + vv * 136 + 32 * part + 8 * q);
        }
    }
#undef GC_LOAD
    (void)hconst;
}

template <bool DRY>
__device__ __forceinline__ void sgu_unit(const Frame& F, const Args& A, int unit, bool stats) {
    const int g = unit & 3, blk = (unit >> 2) & 31, b = unit >> 7;
    const int t0 = b * SEQ + blk * 128;
    bf16_t* P = (bf16_t*)(A.ws + WS_P);
    LAS bf16_t* wA = (LAS bf16_t*)F.lds;
    LAS bf16_t* vnT = (LAS bf16_t*)(F.lds + 34816);
    LAS float* st = (LAS float*)(F.lds + 69632);
    LAS bf16_t* suS = (LAS bf16_t*)(F.lds + 70656);
    const int tid = F.tid;
    __syncthreads();
    if (stats) {
        const int j = tid >> 2, q = tid & 3;
        const bf16_t* sp = P + (size_t)(t0 + j) * PLD + PC_SV + q * 128;
        float s = 0.f, s2 = 0.f;
#pragma unroll
        for (int i = 0; i < 16; ++i) { const u32x4 w = *(const u32x4*)(sp + 8 * i);
            const float f[8] = {bflo(w.x), bfhi(w.x), bflo(w.y), bfhi(w.y), bflo(w.z), bfhi(w.z), bflo(w.w), bfhi(w.w)};
#pragma unroll
            for (int e = 0; e < 8; ++e) { s += f[e]; s2 += f[e] * f[e]; } }
        s += __shfl_xor(s, 1); s += __shfl_xor(s, 2); s2 += __shfl_xor(s2, 1); s2 += __shfl_xor(s2, 2);
        const float mu = s * (1.f / 512.f); const float var = fmaxf(s2 * (1.f / 512.f) - mu * mu, 0.f);
        if (q == 0) { st[2 * j] = mu; st[2 * j + 1] = 1.f / sqrtf(var + EPS); }
    }
    {
        const int i = tid >> 2, jb = (tid & 3) * 32;
        const float* wp = A.in[I_SW] + (size_t)g * 16384 + (size_t)i * 128 + jb;
        const bf16_t* sup = P + (size_t)(t0 + i) * PLD + PC_SU + g * 128 + jb;
#pragma unroll
        for (int q = 0; q < 4; ++q) { const f32x4 a = *(const f32x4*)(wp + 8 * q), bq = *(const f32x4*)(wp + 8 * q + 4);
            const bool z = (i < 64) && (jb + 8 * q >= 64);
            u32x4 o; o.x = pk2(a.x, a.y); o.y = pk2(a.z, a.w); o.z = pk2(bq.x, bq.y); o.w = pk2(bq.z, bq.w);
            if (z) o = (u32x4){0u, 0u, 0u, 0u};
            *(LAS u32x4*)(wA + i * 136 + jb + 8 * q) = o;
            *(LAS u32x4*)(suS + i * 136 + jb + 8 * q) = *(const u32x4*)(sup + 8 * q); }
    }
    const int cch = tid & 127, seg = tid >> 7;
    bf16_t xr[32];
    { const bf16_t* sp = P + (size_t)(t0 + 32 * seg) * PLD + PC_SV + g * 128 + cch;
#pragma unroll
      for (int i = 0; i < 32; ++i) xr[i] = sp[(size_t)i * PLD]; }
    const float lg = A.in[I_SLNG][g * 128 + cch], lb = A.in[I_SLNB][g * 128 + cch];
    __syncthreads();
    {
        unsigned ow[16];
#pragma unroll
        for (int i = 0; i < 16; ++i) { const int j = 32 * seg + 2 * i; const f32x4 ms = *(const LAS f32x4*)(st + 2 * j);
            ow[i] = pk2((bf1(xr[2 * i]) - ms.x) * ms.y * lg + lb, (bf1(xr[2 * i + 1]) - ms.z) * ms.w * lg + lb); }
#pragma unroll
        for (int q = 0; q < 4; ++q) *(LAS u32x4*)(vnT + cch * 136 + 32 * seg + 8 * q) = (u32x4){ow[4 * q], ow[4 * q + 1], ow[4 * q + 2], ow[4 * q + 3]};
    }
    __syncthreads();
    {
        const int w = F.wave, l = F.lane, fr = l & 15, fq = l >> 4;
        f32x4 acc[8];
#pragma unroll
        for (int n = 0; n < 8; ++n) acc[n] = (f32x4){0.f, 0.f, 0.f, 0.f};
#pragma unroll
        for (int ks = 0; ks < 4; ++ks) {
            const bf16x8 a = *(const LAS bf16x8*)(wA + (16 * w + fr) * 136 + 32 * ks + 8 * fq);
#pragma unroll
            for (int n = 0; n < 8; ++n) { const bf16x8 bb = *(const LAS bf16x8*)(vnT + (16 * n + fr) * 136 + 32 * ks + 8 * fq);
                acc[n] = __builtin_amdgcn_mfma_f32_16x16x32_bf16(a, bb, acc[n], 0, 0, 0); }
        }
#pragma unroll
        for (int jj = 0; jj < 4; ++jj) { const int i = 16 * w + 4 * fq + jj; const float bias = A.in[I_SB][g * 128 + i];
            LAS bf16_t* rp = suS + i * 136 + fr;
#pragma unroll
            for (int n = 0; n < 8; ++n) { const float su = bf1(rp[16 * n]); rp[16 * n] = (bf16_t)f2bf(su * (acc[n][jj] + bias)); } }
    }
    __syncthreads();
    {
        const int i = tid >> 2, jb = (tid & 3) * 32;
        bf16_t* yp = DRY ? (bf16_t*)A.out + (size_t)(t0 + i) * 512 + g * 128 + jb : P + (size_t)(t0 + i) * PLD + PC_SU + g * 128 + jb;
#pragma unroll
        for (int q = 0; q < 4; ++q) *(u32x4*)(yp + 8 * q) = *(const LAS u32x4*)(suS + i * 136 + jb + 8 * q);
    }
}

template <bool DRY>
__device__ __forceinline__ void gla_scan(const Frame& F, const Args& A) {
    bf16_t* ST = (bf16_t*)(A.ws + WS_N1); bf16_t* STO = DRY ? (bf16_t*)A.out : ST; const float* DEC = (const float*)(A.ws + WS_DEC);
    for (int gi = F.bid * 512 + F.tid; gi < 131072; gi += F.G * 512) {
        const int k4 = gi & 31, vv = (gi >> 5) & 127, h = (gi >> 12) & 3, b = gi >> 14;
        float s0 = 0.f, s1 = 0.f, s2 = 0.f, s3 = 0.f;
        u32x2 wa[8], wb[8]; f32x4 da[8], db[8];
#define SCAN_LOAD(W, Dd, c0) do { _Pragma("unroll") for (int i_ = 0; i_ < 8; ++i_) { const size_t u_ = (size_t)((b * 64 + (c0) + i_) * 4 + h); \
            W[i_] = *(const u32x2*)(ST + u_ * 16384 + (size_t)vv * 128 + k4 * 4); Dd[i_] = *(const f32x4*)(DEC + u_ * 128 + k4 * 4); } } while (0)
#define SCAN_STEP(W, Dd, c0) do { _Pragma("unroll") for (int i_ = 0; i_ < 8; ++i_) { const size_t u_ = (size_t)((b * 64 + (c0) + i_) * 4 + h); \
            s0 = Dd[i_].x * s0 + bflo(W[i_].x); s1 = Dd[i_].y * s1 + bfhi(W[i_].x); s2 = Dd[i_].z * s2 + bflo(W[i_].y); s3 = Dd[i_].w * s3 + bfhi(W[i_].y); \
            u32x2 o_; o_.x = pk2(s0, s1); o_.y = pk2(s2, s3); *(u32x2*)(STO + u_ * 16384 + (size_t)vv * 128 + k4 * 4) = o_; } } while (0)
        SCAN_LOAD(wa, da, 0);
#pragma unroll
        for (int c0 = 0; c0 < 64; c0 += 16) {
            SCAN_LOAD(wb, db, c0 + 8);
            SCAN_STEP(wa, da, c0);
            if (c0 + 16 < 64) SCAN_LOAD(wa, da, c0 + 16);
            SCAN_STEP(wb, db, c0 + 8);
        }
#undef SCAN_LOAD
#undef SCAN_STEP
    }
}

template <bool DRY>
__device__ __forceinline__ void gla_out_phase(const Frame& F, const Args& A) {
    bf16_t* P = (bf16_t*)(A.ws + WS_P);
    LAS bf16_t* qA = (LAS bf16_t*)F.lds;
    LAS bf16_t* sB = (LAS bf16_t*)(F.lds + 17408);
    LAS float* oF = (LAS float*)(F.lds + 52224);
    const int tid = F.tid, s = tid >> 3, cb = (tid & 7) * 16, vv = tid >> 2, kb = (tid & 3) * 32;
    u32x4 nq0, nq1, ns0, ns1, ns2, ns3, nr0, nr1;
#define GO_LOAD(unit) do { const int h_ = (unit) & 3, c_ = ((unit) >> 2) & 63, b_ = (unit) >> 8; const int t0_ = b_ * SEQ + c_ * 64; \
        const bf16_t* qp_ = P + (size_t)(t0_ + s) * PLD + PC_Q + h_ * 128 + cb; nq0 = *(const u32x4*)qp_; nq1 = *(const u32x4*)(qp_ + 8); \
        const bf16_t* sp_ = (const bf16_t*)(A.ws + WS_N1) + (size_t)(unit) * 16384 + (size_t)vv * 128 + kb; ns0 = *(const u32x4*)sp_; ns1 = *(const u32x4*)(sp_ + 8); ns2 = *(const u32x4*)(sp_ + 16); ns3 = *(const u32x4*)(sp_ + 24); \
        const bf16_t* rp_ = P + (size_t)(t0_ + s) * PLD + PC_R + h_ * 128 + cb; nr0 = *(const u32x4*)rp_; nr1 = *(const u32x4*)(rp_ + 8); } while (0)
    int unit = F.bid;
    if (unit < 2048) GO_LOAD(unit);
    for (; unit < 2048; unit += F.G) {
        const int h = unit & 3, c = (unit >> 2) & 63, b = unit >> 8;
        const int t0 = b * SEQ + c * 64;
        __syncthreads();
        *(LAS u32x4*)(qA + s * 136 + cb) = nq0; *(LAS u32x4*)(qA + s * 136 + cb + 8) = nq1;
        *(LAS u32x4*)(sB + vv * 136 + kb) = ns0; *(LAS u32x4*)(sB + vv * 136 + kb + 8) = ns1; *(LAS u32x4*)(sB + vv * 136 + kb + 16) = ns2; *(LAS u32x4*)(sB + vv * 136 + kb + 24) = ns3;
        const u32x4 r0 = nr0, r1 = nr1;
        if (unit + F.G < 2048) GO_LOAD(unit + F.G);
        __syncthreads();
        {
            const int w = F.wave, l = F.lane, fr = l & 15, fq = l >> 4, m = w & 3, nh = w >> 2;
            f32x4 acc[4];
#pragma unroll
            for (int n = 0; n < 4; ++n) acc[n] = (f32x4){0.f, 0.f, 0.f, 0.f};
#pragma unroll
            for (int ks = 0; ks < 4; ++ks) {
                const bf16x8 a = *(const LAS bf16x8*)(qA + (16 * m + fr) * 136 + 32 * ks + 8 * fq);
#pragma unroll
                for (int n = 0; n < 4; ++n) { const bf16x8 bb = *(const LAS bf16x8*)(sB + (16 * (4 * nh + n) + fr) * 136 + 32 * ks + 8 * fq);
                    acc[n] = __builtin_amdgcn_mfma_f32_16x16x32_bf16(a, bb, acc[n], 0, 0, 0); }
            }
            const float scale = 0.08838834764831845f;
#pragma unroll
            for (int n = 0; n < 4; ++n)
#pragma unroll
                for (int jj = 0; jj < 4; ++jj) oF[(16 * m + 4 * fq + jj) * 132 + 16 * (4 * nh + n) + fr] = acc[n][jj] * scale;
        }
        __syncthreads();
        {
            float o[16]; float ss = 0.f;
#pragma unroll
            for (int i = 0; i < 16; ++i) { o[i] = oF[s * 132 + cb + i]; ss += o[i] * o[i]; }
            ss += __shfl_xor(ss, 1); ss += __shfl_xor(ss, 2); ss += __shfl_xor(ss, 4);
            const float rstd = 1.f / sqrtf(ss * (1.f / 128.f) + EPS);
            const unsigned rw[8] = {r0.x, r0.y, r0.z, r0.w, r1.x, r1.y, r1.z, r1.w};
            const float* gg = A.in[I_GLAG] + h * 128 + cb;
            unsigned ow[8];
#pragma unroll
            for (int i = 0; i < 8; ++i) { const float y0 = o[2 * i] * rstd * gg[2 * i] * siluf_(bflo(rw[i])), y1 = o[2 * i + 1] * rstd * gg[2 * i + 1] * siluf_(bfhi(rw[i])); ow[i] = pk2(y0, y1); }
            bf16_t* yp = DRY ? (bf16_t*)A.out + (size_t)(t0 + s) * 512 + h * 128 + cb : P + (size_t)(t0 + s) * PLD + PC_R + h * 128 + cb;
            *(u32x4*)yp = (u32x4){ow[0], ow[1], ow[2], ow[3]}; *(u32x4*)(yp + 8) = (u32x4){ow[4], ow[5], ow[6], ow[7]};
        }
    }
#undef GO_LOAD
}

__device__ __forceinline__ unsigned ordkey(float v) { const unsigned u = __builtin_bit_cast(unsigned, v); return u ^ ((unsigned)((int)u >> 31) | 0x80000000u); }
__device__ __forceinline__ float unord16(unsigned k) { const unsigned u = ((k & 0x80000000u) ? (k & 0x7fffffffu) : ~k) & 0xffff0000u; return __builtin_bit_cast(float, u); }
__device__ __forceinline__ float unord(unsigned k) { const unsigned u = (k & 0x80000000u) ? (k & 0x7fffffffu) : ~k; return __builtin_bit_cast(float, u); }
#define INS16(r, xin) do { unsigned _x = (xin); _Pragma("unroll") for (int _i = 0; _i < 16; ++_i) { const unsigned _h = max((r)[_i], _x); _x = min((r)[_i], _x); (r)[_i] = _h; } } while (0)

#define CE(a, b) do { const unsigned _h = max((a), (b)), _l = min((a), (b)); (a) = _h; (b) = _l; } while (0)
#define SORT16(v) do { CE(v[0], v[1]); CE(v[2], v[3]); CE(v[0], v[2]); CE(v[1], v[3]); CE(v[1], v[2]); CE(v[4], v[5]); CE(v[6], v[7]); CE(v[4], v[6]); CE(v[5], v[7]); CE(v[5], v[6]); CE(v[0], v[4]); CE(v[2], v[6]); CE(v[2], v[4]); CE(v[1], v[5]); CE(v[3], v[7]); CE(v[3], v[5]); CE(v[1], v[2]); CE(v[3], v[4]); CE(v[5], v[6]); CE(v[8], v[9]); CE(v[10], v[11]); CE(v[8], v[10]); CE(v[9], v[11]); CE(v[9], v[10]); CE(v[12], v[13]); CE(v[14], v[15]); CE(v[12], v[14]); CE(v[13], v[15]); CE(v[13], v[14]); CE(v[8], v[12]); CE(v[10], v[14]); CE(v[10], v[12]); CE(v[9], v[13]); CE(v[11], v[15]); CE(v[11], v[13]); CE(v[9], v[10]); CE(v[11], v[12]); CE(v[13], v[14]); CE(v[0], v[8]); CE(v[4], v[12]); CE(v[4], v[8]); CE(v[2], v[10]); CE(v[6], v[14]); CE(v[6], v[10]); CE(v[2], v[4]); CE(v[6], v[8]); CE(v[10], v[12]); CE(v[1], v[9]); CE(v[5], v[13]); CE(v[5], v[9]); CE(v[3], v[11]); CE(v[7], v[15]); CE(v[7], v[11]); CE(v[3], v[5]); CE(v[7], v[9]); CE(v[11], v[13]); CE(v[1], v[2]); CE(v[3], v[4]); CE(v[5], v[6]); CE(v[7], v[8]); CE(v[9], v[10]); CE(v[11], v[12]); CE(v[13], v[14]); } while (0)
#define MERGE16(T, S) do { _Pragma("unroll") for (int _i = 0; _i < 16; ++_i) (T)[_i] = max((T)[_i], (S)[15 - _i]); \
    _Pragma("unroll") for (int _d = 8; _d >= 1; _d >>= 1) { _Pragma("unroll") for (int _i = 0; _i < 16; ++_i) if ((_i & _d) == 0) CE((T)[_i], (T)[_i + _d]); } } while (0)
__device__ __forceinline__ void peer_topk(const Frame& F, const Args& A) {
    const bf16_t* SC = (const bf16_t*)(A.ws + WS_P + P_SC);
    int* IDX = (int*)(A.ws + WS_P + P_IDX); float* GATE = (float*)(A.ws + WS_P + P_GATE);
    const int gw = F.bid * NWAVES + F.wave, NGW = F.G * NWAVES;
    for (int it = gw; it < 512 * 8; it += NGW) {
        const int h = it & 7, tb = it >> 3; const int tok = tb * 64 + F.lane;
        unsigned r1[16], r2[16], rc[16];
        const bf16_t* p1 = SC + ((size_t)(tok >> 4) * 256 + h * 32) * 128 + (tok & 15) * 8; const bf16_t* p2 = p1 + 16 * 128;
        {
            unsigned raw[128]; unsigned sg[16];
#pragma unroll
            for (int jq = 0; jq < 16; ++jq) { const u32x4 t4 = *(const u32x4*)(p1 + jq * 128);
#pragma unroll
                for (int c = 0; c < 4; ++c) { raw[8 * jq + 2 * c] = t4[c] << 16; raw[8 * jq + 2 * c + 1] = t4[c] & 0xffff0000u; } }
#pragma unroll
            for (int j = 0; j < 16; ++j) r1[j] = raw[j] | (unsigned)(127 - j);
            SORT16(r1);
#pragma unroll
            for (int gq = 1; gq < 8; ++gq) {
#pragma unroll
                for (int j = 0; j < 16; ++j) sg[j] = raw[16 * gq + j] | (unsigned)(127 - (16 * gq + j));
                SORT16(sg); MERGE16(r1, sg); }
#pragma unroll
            for (int jq = 0; jq < 16; ++jq) { const u32x4 t4 = *(const u32x4*)(p2 + jq * 128);
#pragma unroll
                for (int c = 0; c < 4; ++c) { raw[8 * jq + 2 * c] = t4[c] << 16; raw[8 * jq + 2 * c + 1] = t4[c] & 0xffff0000u; } }
#pragma unroll
            for (int j = 0; j < 16; ++j) r2[j] = raw[j] | (unsigned)(127 - j);
            SORT16(r2);
#pragma unroll
            for (int gq = 1; gq < 8; ++gq) {
#pragma unroll
                for (int j = 0; j < 16; ++j) sg[j] = raw[16 * gq + j] | (unsigned)(127 - (16 * gq + j));
                SORT16(sg); MERGE16(r2, sg); }
        }
        float v1[16], v2[16];
#pragma unroll
        for (int i = 0; i < 16; ++i) { v1[i] = unord16(r1[i]); v2[i] = unord16(r2[i]); }
        {
            unsigned cg[4][16]; int cn = 0;
#pragma unroll
            for (int a = 0; a < 16; ++a)
#pragma unroll
                for (int bq = 0; bq < 16; ++bq) if ((a + 1) * (bq + 1) <= 16) { cg[cn >> 4][cn & 15] = (ordkey(v1[a] + v2[bq]) & ~255u) | (unsigned)(a * 16 + bq); ++cn; }
#pragma unroll
            for (int z = 50; z < 64; ++z) cg[z >> 4][z & 15] = 0u;
            SORT16(cg[0]); SORT16(cg[1]); SORT16(cg[2]); SORT16(cg[3]);
            MERGE16(cg[0], cg[1]); MERGE16(cg[0], cg[2]); MERGE16(cg[0], cg[3]);
#pragma unroll
            for (int i = 0; i < 16; ++i) rc[i] = cg[0][i];
        }
        float val[16]; int ex[16];
        {
            LAS unsigned* t1 = (LAS unsigned*)(F.lds + F.wave * 8704) + F.lane * 17; LAS unsigned* t2 = t1 + 64 * 17;
#pragma unroll
            for (int i = 0; i < 16; ++i) { t1[i] = r1[i]; t2[i] = r2[i]; }
            LDS_WAIT(); asm volatile("" ::: "memory");
#pragma unroll
            for (int w = 0; w < 16; ++w) {
                const int a = (rc[w] >> 4) & 15, bq = rc[w] & 15;
                const unsigned k1 = t1[a], k2 = t2[bq];
                val[w] = unord16(k1) + unord16(k2);
                ex[w] = (127 - (int)(k1 & 127u)) * 128 + (127 - (int)(k2 & 127u));
            }
            LDS_WAIT(); asm volatile("" ::: "memory");
        }
        float mx = val[0];
#pragma unroll
        for (int w = 1; w < 16; ++w) mx = fmaxf(mx, val[w]);
        float sum = 0.f;
#pragma unroll
        for (int w = 0; w < 16; ++w) { val[w] = __expf(val[w] - mx); sum += val[w]; }
        const float inv = 1.f / sum;
        int* ip = IDX + (size_t)tok * 128 + h * 16; float* gp = GATE + (size_t)tok * 128 + h * 16;
#pragma unroll
        for (int q = 0; q < 4; ++q) { *(int4*)(ip + 4 * q) = make_int4(ex[4 * q], ex[4 * q + 1], ex[4 * q + 2], ex[4 * q + 3]);
            *(f32x4*)(gp + 4 * q) = (f32x4){val[4 * q] * inv, val[4 * q + 1] * inv, val[4 * q + 2] * inv, val[4 * q + 3] * inv}; }
    }
}

#define DPP_ADD(v, ctrl) ((v) + __builtin_bit_cast(float, __builtin_amdgcn_mov_dpp(__builtin_bit_cast(int, (v)), (ctrl), 0xf, 0xf, true)))
__device__ __forceinline__ void fp8x16_to_f32x2(const u32x4 r, f32x2* f) {
#pragma unroll
    for (int q = 0; q < 4; ++q) { f[2 * q] = __builtin_amdgcn_cvt_pk_f32_fp8((int)r[q], false); f[2 * q + 1] = __builtin_amdgcn_cvt_pk_f32_fp8((int)r[q], true); }
}
__device__ __forceinline__ void fp8x16_to_f32(const u32x4 r, float* f) {
#pragma unroll
    for (int q = 0; q < 4; ++q) { const f32x2 lo = __builtin_amdgcn_cvt_pk_f32_fp8((int)r[q], false), hi = __builtin_amdgcn_cvt_pk_f32_fp8((int)r[q], true);
        f[4 * q] = lo.x; f[4 * q + 1] = lo.y; f[4 * q + 2] = hi.x; f[4 * q + 3] = hi.y; }
}
__device__ __forceinline__ long lo64(u32x4 v) { return (long)(((unsigned long)v.y << 32) | (unsigned long)v.x); }
__device__ __forceinline__ long hi64(u32x4 v) { return (long)(((unsigned long)v.w << 32) | (unsigned long)v.z); }
template <int MODE>
__device__ __forceinline__ void peer_u_phase(const Frame& F, const Args& A) {
    const unsigned char* X8 = A.ws + WS_P + P_X8;
    const unsigned char* U8 = A.ws + WS_U8; const float* SU = (const float*)(A.ws + WS_SU); const float* SV = (const float*)(A.ws + WS_SV);
    const int* IDX = (const int*)(A.ws + WS_P + P_IDX); const float* GATE = (const float*)(A.ws + WS_P + P_GATE); float* AK = (float*)(MODE == 0 ? A.ws + WS_AK : A.ws + WS_P + P_SC);
    const int g = F.bid & 7, nmem = F.G >> 3, l = F.lane, step = nmem * NWAVES;
    const int loff = 64 * (l & 15) + 16 * (l >> 4);
    const bool dg = ((l & 15) >> 2) == (l >> 4); const int dr = l & 3;
    const float dw0 = (dg && dr == 0) ? 1.f : 0.f, dw1 = (dg && dr == 1) ? 1.f : 0.f, dw2 = (dg && dr == 2) ? 1.f : 0.f, dw3 = (dg && dr == 3) ? 1.f : 0.f;
    LAS int* le = (LAS int*)(F.lds + F.wave * 2048); LAS int* lk = le + 256;
    const bool b5 = (l & 32) != 0, b4 = (l & 16) != 0, b3 = (l & 8) != 0;
    int tok = 2 * ((F.bid >> 3) * NWAVES + F.wave);
    u32x4 nxA, nxB; int neA0, neA1, neB0, neB1; float ngA0, ngA1, ngB0, ngB1;
#define U_PREFETCH(t) do { const size_t _tA = (size_t)(t), _tB = (size_t)(t) + 1; if (MODE == 4) { nxA = (u32x4){(unsigned)_tA, 1u, 2u, 3u}; nxB = nxA; neA0 = (int)((_tA * 37 + l * 11) & 16383); neA1 = (int)((_tA * 53 + l * 7) & 16383); neB0 = (int)((_tB * 37 + l * 13) & 16383); neB1 = (int)((_tB * 29 + l * 3) & 16383); ngA0 = ngA1 = ngB0 = ngB1 = 0.01f; break; } nxA = *(const u32x4*)(X8 + _tA * 1024 + loff); nxB = *(const u32x4*)(X8 + _tB * 1024 + loff); \
        neA0 = IDX[_tA * 128 + l]; neA1 = IDX[_tA * 128 + 64 + l]; neB0 = IDX[_tB * 128 + l]; neB1 = IDX[_tB * 128 + 64 + l]; \
        ngA0 = GATE[_tA * 128 + l]; ngA1 = GATE[_tA * 128 + 64 + l]; ngB0 = GATE[_tB * 128 + l]; ngB1 = GATE[_tB * 128 + 64 + l]; } while (0)
    if (tok + 1 < T_TOK) U_PREFETCH(tok);
    for (; tok + 1 < T_TOK; tok += 2 * step) {
        const int tokA = tok, tokB = tok + 1;
        const u32x4 xA = nxA, xB = nxB;
        const int eA0 = neA0, eA1 = neA1, eB0 = neB0, eB1 = neB1; const float gA0 = ngA0, gA1 = ngA1, gB0 = ngB0, gB1 = ngB1;
        bool pf_done = false;
        const bool oA0 = (eA0 & 7) == g, oA1 = (eA1 & 7) == g, oB0 = (eB0 & 7) == g, oB1 = (eB1 & 7) == g;
        const unsigned long long mA0 = __ballot(oA0), mA1 = __ballot(oA1), mB0 = __ballot(oB0), mB1 = __ballot(oB1);
        const int c0 = __popcll(mA0), c1 = c0 + __popcll(mA1), c2 = c1 + __popcll(mB0), n = c2 + __popcll(mB1);
#define MBC(m) __builtin_amdgcn_mbcnt_hi((unsigned)((m) >> 32), __builtin_amdgcn_mbcnt_lo((unsigned)(m), 0u))
        if (oA0) { const int p = MBC(mA0); le[p] = (eA0 << 8) | l; lk[p] = __builtin_bit_cast(int, gA0); }
        if (oA1) { const int p = c0 + MBC(mA1); le[p] = (eA1 << 8) | (64 + l); lk[p] = __builtin_bit_cast(int, gA1); }
        if (oB0) { const int p = c1 + MBC(mB0); le[p] = (eB0 << 8) | 128 | l; lk[p] = __builtin_bit_cast(int, gB0); }
        if (oB1) { const int p = c2 + MBC(mB1); le[p] = (eB1 << 8) | 128 | (64 + l); lk[p] = __builtin_bit_cast(int, gB1); }
#undef MBC
        LDS_WAIT(); asm volatile("" ::: "memory");
        for (int cb = 0; cb < n || cb == 0; cb += 64) {
        const int nc = min(n, cb + 64);
        const bool fv = (cb + l) < nc;
        const int ent = fv ? le[cb + l] : 0; const float gt = fv ? __builtin_bit_cast(float, lk[cb + l]) : 0.f; float tot = 0.f;
        const float su = SU[ent >> 8], sv = SV[ent >> 8];
        const unsigned long long radr = (unsigned long long)(U8 + (size_t)(((ent >> 8) & 7) * 2048 + (((ent >> 8) >> 3) & (MODE == 2 ? 255 : 2047))) * 1024);
        const int ralo = (int)(unsigned)radr, rahi = (int)(unsigned)(radr >> 32);
        for (int i = cb; i < nc; i += 16) {
            u32x4 row[2][8];
#pragma unroll
            for (int b = 0; b < 2; ++b) if (i + 8 * b < nc) {
#pragma unroll
                for (int j = 0; j < 8; ++j) { const int ln = min(i + 8 * b + j, nc - 1) - cb;
                    const unsigned lo = (unsigned)__builtin_amdgcn_readlane(ralo, ln), hi = (unsigned)__builtin_amdgcn_readlane(rahi, ln);
                    const GAS unsigned char* rp = (const GAS unsigned char*)(((unsigned long long)hi << 32) | lo);
                    row[b][j] = *(const GAS u32x4*)(rp + (unsigned)loff); } }
            if (!pf_done) { pf_done = true; if (tok + 2 * step + 1 < T_TOK) U_PREFETCH(tok + 2 * step); }
#pragma unroll
            for (int b = 0; b < 2; ++b) if (i + 8 * b < nc) {
                float p[8];
                f32x4 accj[8];
                const int base0 = i + 8 * b;
                if (base0 + 8 <= c1) {
#pragma unroll
                    for (int j = 0; j < 8; ++j) accj[j] = __builtin_amdgcn_mfma_f32_16x16x32_fp8_fp8(lo64(row[b][j]), lo64(xA), (f32x4){0.f, 0.f, 0.f, 0.f}, 0, 0, 0);
#pragma unroll
                    for (int j = 0; j < 8; ++j) accj[j] = __builtin_amdgcn_mfma_f32_16x16x32_fp8_fp8(hi64(row[b][j]), hi64(xA), accj[j], 0, 0, 0);
                } else if (base0 >= c1) {
#pragma unroll
                    for (int j = 0; j < 8; ++j) accj[j] = __builtin_amdgcn_mfma_f32_16x16x32_fp8_fp8(lo64(row[b][j]), lo64(xB), (f32x4){0.f, 0.f, 0.f, 0.f}, 0, 0, 0);
#pragma unroll
                    for (int j = 0; j < 8; ++j) accj[j] = __builtin_amdgcn_mfma_f32_16x16x32_fp8_fp8(hi64(row[b][j]), hi64(xB), accj[j], 0, 0, 0);
                } else {
#pragma unroll
                    for (int j = 0; j < 8; ++j) { const u32x4 xs = (base0 + j >= c1) ? xB : xA; accj[j] = __builtin_amdgcn_mfma_f32_16x16x32_fp8_fp8(lo64(row[b][j]), lo64(xs), (f32x4){0.f, 0.f, 0.f, 0.f}, 0, 0, 0);
                        accj[j] = __builtin_amdgcn_mfma_f32_16x16x32_fp8_fp8(hi64(row[b][j]), hi64(xs), accj[j], 0, 0, 0); }
                }
#pragma unroll
                for (int j = 0; j < 8; ++j) p[j] = __builtin_fmaf(accj[j][3], dw3, __builtin_fmaf(accj[j][2], dw2, __builtin_fmaf(accj[j][1], dw1, accj[j][0] * dw0)));
                float q4[4], q2[2], q1;
#pragma unroll
                for (int j = 0; j < 4; ++j) { const float keep = b5 ? p[4 + j] : p[j], send = b5 ? p[j] : p[4 + j]; q4[j] = keep + __shfl_xor(send, 32); }
#pragma unroll
                for (int j = 0; j < 2; ++j) { const float keep = b4 ? q4[2 + j] : q4[j], send = b4 ? q4[j] : q4[2 + j]; q2[j] = keep + __shfl_xor(send, 16); }
                { const float keep = b3 ? q2[1] : q2[0], send = b3 ? q2[0] : q2[1]; q1 = keep + __shfl_xor(send, 8); }
                q1 = DPP_ADD(q1, 0xB1); q1 = DPP_ADD(q1, 0x4E); q1 = DPP_ADD(q1, 0x141);
                const float t = __builtin_bit_cast(float, __builtin_amdgcn_ds_bpermute((l & 7) * 32, __builtin_bit_cast(int, q1)));
                const int base = i + 8 * b;
                if ((l >> 3) == ((base - cb) >> 3)) tot = t;
            }
        }
        if (!pf_done) { if (tok + 2 * step + 1 < T_TOK) U_PREFETCH(tok + 2 * step); }
        if (fv) { const int tk = (ent & 128) ? tokB : tokA; AK[(size_t)tk * 128 + (ent & 127)] = gelu_tanh(tot * su * (1.f / 16.f)) * gt * sv; }
        if (n == 0) break;
        }
        LDS_WAIT(); asm volatile("" ::: "memory");
    }
#undef U_PREFETCH
}
template <int MODE>
__device__ __forceinline__ void peer_u_phase1(const Frame& F, const Args& A) {
    const unsigned char* X8 = A.ws + WS_P + P_X8;
    const unsigned char* U8 = A.ws + WS_U8; const float* SU = (const float*)(A.ws + WS_SU); const float* SV = (const float*)(A.ws + WS_SV);
    const int* IDX = (const int*)(A.ws + WS_P + P_IDX); const float* GATE = (const float*)(A.ws + WS_P + P_GATE); float* AK = (float*)(MODE == 0 ? A.ws + WS_AK : A.ws + WS_P + P_SC);
    const int g = F.bid & (UNG - 1), nmem = F.G >> UNG_SH, l = F.lane, step = nmem * NWAVES;
    const int loff = 64 * (l & 15) + 16 * (l >> 4);
    const bool dg = ((l & 15) >> 2) == (l >> 4); const int dr = l & 3;
    const float dw0 = (dg && dr == 0) ? 1.f : 0.f, dw1 = (dg && dr == 1) ? 1.f : 0.f, dw2 = (dg && dr == 2) ? 1.f : 0.f, dw3 = (dg && dr == 3) ? 1.f : 0.f;
    LAS int* le = (LAS int*)(F.lds + F.wave * 2048); LAS int* lk = le + 256;
    const bool b5 = (l & 32) != 0, b4 = (l & 16) != 0, b3 = (l & 8) != 0;
    int tok = (F.bid >> UNG_SH) * NWAVES + F.wave;
    u32x4 nxA; int neA0, neA1; float ngA0, ngA1;
#define U1_PREFETCH(t) do { const size_t _tA = (size_t)(t); nxA = *(const u32x4*)(X8 + _tA * 1024 + loff); \
        neA0 = IDX[_tA * 128 + l]; neA1 = IDX[_tA * 128 + 64 + l]; ngA0 = GATE[_tA * 128 + l]; ngA1 = GATE[_tA * 128 + 64 + l]; } while (0)
    if (tok < T_TOK) U1_PREFETCH(tok);
    for (; tok < T_TOK; tok += step) {
        const u32x4 xA = nxA;
        const int eA0 = neA0, eA1 = neA1; const float gA0 = ngA0, gA1 = ngA1;
        bool pf_done = false;
        const bool oA0 = (eA0 & (UNG - 1)) == g, oA1 = (eA1 & (UNG - 1)) == g;
        const unsigned long long mA0 = __ballot(oA0), mA1 = __ballot(oA1);
        const int c0 = __popcll(mA0), n = c0 + __popcll(mA1);
#define MBC(m) __builtin_amdgcn_mbcnt_hi((unsigned)((m) >> 32), __builtin_amdgcn_mbcnt_lo((unsigned)(m), 0u))
        if (oA0) { const int p = MBC(mA0); le[p] = (eA0 << 8) | l; lk[p] = __builtin_bit_cast(int, gA0); }
        if (oA1) { const int p = c0 + MBC(mA1); le[p] = (eA1 << 8) | (64 + l); lk[p] = __builtin_bit_cast(int, gA1); }
#undef MBC
        LDS_WAIT(); asm volatile("" ::: "memory");
        for (int cb = 0; cb < n || cb == 0; cb += 64) {
        const int nc = min(n, cb + 64);
        const bool fv = (cb + l) < nc;
        const int ent = fv ? le[cb + l] : 0; const float gt = fv ? __builtin_bit_cast(float, lk[cb + l]) : 0.f; float tot = 0.f;
        const float su = SU[ent >> 8], sv = SV[ent >> 8];
        const unsigned long long radr = (unsigned long long)(U8 + (size_t)(((ent >> 8) & (UNG - 1)) * (NEXP / UNG) + ((ent >> 8) >> UNG_SH)) * 1024);
        const int ralo = (int)(unsigned)radr, rahi = (int)(unsigned)(radr >> 32);
        for (int i = cb; i < nc; i += 16) {
            u32x4 row[2][8];
#pragma unroll
            for (int b = 0; b < 2; ++b) if (i + 8 * b < nc) {
#pragma unroll
                for (int j = 0; j < 8; ++j) { const int ln = min(i + 8 * b + j, nc - 1) - cb;
                    const unsigned lo = (unsigned)__builtin_amdgcn_readlane(ralo, ln), hi = (unsigned)__builtin_amdgcn_readlane(rahi, ln);
                    const GAS unsigned char* rp = (const GAS unsigned char*)(((unsigned long long)hi << 32) | lo);
                    row[b][j] = *(const GAS u32x4*)(rp + (unsigned)loff); } }
            if (!pf_done) { pf_done = true; if (tok + step < T_TOK) U1_PREFETCH(tok + step); }
#pragma unroll
            for (int b = 0; b < 2; ++b) if (i + 8 * b < nc) {
                float p[8]; f32x4 accj[8];
#pragma unroll
                for (int j = 0; j < 8; ++j) accj[j] = __builtin_amdgcn_mfma_f32_16x16x32_fp8_fp8(lo64(row[b][j]), lo64(xA), (f32x4){0.f, 0.f, 0.f, 0.f}, 0, 0, 0);
#pragma unroll
                for (int j = 0; j < 8; ++j) accj[j] = __builtin_amdgcn_mfma_f32_16x16x32_fp8_fp8(hi64(row[b][j]), hi64(xA), accj[j], 0, 0, 0);
#pragma unroll
                for (int j = 0; j < 8; ++j) p[j] = __builtin_fmaf(accj[j][3], dw3, __builtin_fmaf(accj[j][2], dw2, __builtin_fmaf(accj[j][1], dw1, accj[j][0] * dw0)));
                float q4[4], q2[2], q1;
#pragma unroll
                for (int j = 0; j < 4; ++j) { const float keep = b5 ? p[4 + j] : p[j], send = b5 ? p[j] : p[4 + j]; q4[j] = keep + __shfl_xor(send, 32); }
#pragma unroll
                for (int j = 0; j < 2; ++j) { const float keep = b4 ? q4[2 + j] : q4[j], send = b4 ? q4[j] : q4[2 + j]; q2[j] = keep + __shfl_xor(send, 16); }
                { const float keep = b3 ? q2[1] : q2[0], send = b3 ? q2[0] : q2[1]; q1 = keep + __shfl_xor(send, 8); }
                q1 = DPP_ADD(q1, 0xB1); q1 = DPP_ADD(q1, 0x4E); q1 = DPP_ADD(q1, 0x141);
                const float t = __builtin_bit_cast(float, __builtin_amdgcn_ds_bpermute((l & 7) * 32, __builtin_bit_cast(int, q1)));
                const int base = i + 8 * b;
                if ((l >> 3) == ((base - cb) >> 3)) tot = t;
            }
        }
        if (!pf_done) { pf_done = true; if (tok + step < T_TOK) U1_PREFETCH(tok + step); }
        if (fv) AK[(size_t)tok * 128 + (ent & 127)] = gelu_tanh(tot * su * (1.f / 16.f)) * gt * sv;
        if (n == 0) break;
        }
        LDS_WAIT(); asm volatile("" ::: "memory");
    }
#undef U1_PREFETCH
}
template <int MODE>
__device__ __forceinline__ void peer_u4_phase(const Frame& F, const Args& A) {
    const unsigned char* X8 = A.ws + WS_P + P_X8;
    const float* SU = (const float*)(A.ws + WS_SU); const float* SV = (const float*)(A.ws + WS_SV);
    const int* IDX = (const int*)(A.ws + WS_P + P_IDX); const float* GATE = (const float*)(A.ws + WS_P + P_GATE); float* AK = (float*)(MODE == 0 ? A.ws + WS_AK : A.ws + WS_P + P_SC);
    const int g = F.bid & (UNG - 1), nmem = F.G >> UNG_SH, l = F.lane, step = nmem * NWAVES;
    const int m = l & 15, q = l >> 4;
    const GAS unsigned char* ub = (const GAS unsigned char*)(A.ws + WS_U8 + (size_t)g * (NEXP / UNG) * 512);
    const unsigned lconst = 16u * (unsigned)(4 * (m & 7) + q);
    const int xoff = 128 * (m & 7) + 16 * q;
    const bool dg = (m < 8) && ((m >> 2) == (q & 1)); const int dr = m & 3;
    const float dw0 = (dg && dr == 0) ? 1.f : 0.f, dw1 = (dg && dr == 1) ? 1.f : 0.f, dw2 = (dg && dr == 2) ? 1.f : 0.f, dw3 = (dg && dr == 3) ? 1.f : 0.f;
    const int rsel = 4 * (m >> 3);
    const int osrc = 4 * (32 * (l & 1) + 4 * ((l & 15) >> 1));
    const int sc1 = 0x7F7F7F7F;
    LAS int* le = (LAS int*)(F.lds + F.wave * 2048); LAS int* lk = le + 256;
    const bool b4 = (l & 16) != 0, b3 = (l & 8) != 0, b2 = (l & 4) != 0;
    int tok = (F.bid >> UNG_SH) * NWAVES + F.wave;
    u32x4 nx0, nx1; int ne0, ne1; float ng0, ng1;
#define U4_PREFETCH(t) do { const size_t _t = (size_t)(t); nx0 = *(const u32x4*)(X8 + _t * 1024 + xoff); nx1 = *(const u32x4*)(X8 + _t * 1024 + xoff + 64); \
        ne0 = IDX[_t * 128 + l]; ne1 = IDX[_t * 128 + 64 + l]; ng0 = GATE[_t * 128 + l]; ng1 = GATE[_t * 128 + 64 + l]; } while (0)
    if (tok < T_TOK) U4_PREFETCH(tok);
    for (; tok < T_TOK; tok += step) {
        const i32x8 xb = __builtin_shufflevector(__builtin_bit_cast(i32x4, nx0), __builtin_bit_cast(i32x4, nx1), 0, 1, 2, 3, 4, 5, 6, 7);
        const int e0 = ne0, e1 = ne1; const float g0 = ng0, g1 = ng1;
        bool pf_done = false;
        const bool o0 = (e0 & (UNG - 1)) == g, o1 = (e1 & (UNG - 1)) == g;
        const unsigned long long m0 = __ballot(o0), m1 = __ballot(o1);
        const int c0 = __popcll(m0), n = c0 + __popcll(m1);
#define MBC(mm) __builtin_amdgcn_mbcnt_hi((unsigned)((mm) >> 32), __builtin_amdgcn_mbcnt_lo((unsigned)(mm), 0u))
        if (o0) { const int p = MBC(m0); le[p] = (e0 << 8) | l; lk[p] = __builtin_bit_cast(int, g0); }
        if (o1) { const int p = c0 + MBC(m1); le[p] = (e1 << 8) | (64 + l); lk[p] = __builtin_bit_cast(int, g1); }
#undef MBC
        LDS_WAIT(); asm volatile("" ::: "memory");
        for (int cb = 0; cb < n || cb == 0; cb += 64) {
            const int nc = min(n, cb + 64);
            const bool fv = (cb + l) < nc;
            const int ent = fv ? le[cb + l] : 0; const float gt = fv ? __builtin_bit_cast(float, lk[cb + l]) : 0.f; float tot = 0.f;
            const float su = SU[ent >> 8], sv = SV[ent >> 8];
            const int roff = fv ? ((ent >> 8) >> UNG_SH) * 512 : 0;
            for (int i = cb; i < nc; i += 32) {
                u32x4 row[2][8];
#pragma unroll
                for (int b = 0; b < 2; ++b) if (i + 16 * b < nc) {
#pragma unroll
                    for (int j = 0; j < 8; ++j) { const int ro = __builtin_amdgcn_ds_bpermute(rsel + 4 * (i - cb + 16 * b + 2 * j), roff);
                        row[b][j] = *(const GAS u32x4*)(ub + ((unsigned)ro + lconst)); } }
                if (!pf_done) { pf_done = true; if (tok + step < T_TOK) U4_PREFETCH(tok + step); }
#pragma unroll
                for (int b = 0; b < 2; ++b) if (i + 16 * b < nc) {
                    float p[8];
#pragma unroll
                    for (int j = 0; j < 8; ++j) { const i32x4 r4 = __builtin_bit_cast(i32x4, row[b][j]);
                        const f32x4 d = __builtin_amdgcn_mfma_scale_f32_16x16x128_f8f6f4(__builtin_shufflevector(r4, r4, 0, 1, 2, 3, -1, -1, -1, -1), xb, (f32x4){0.f, 0.f, 0.f, 0.f}, 4, 0, 0, sc1, 0, sc1);
                        p[j] = __builtin_fmaf(d[3], dw3, __builtin_fmaf(d[2], dw2, __builtin_fmaf(d[1], dw1, d[0] * dw0))); }
                    float q4[4], q2[2], q1;
#pragma unroll
                    for (int j = 0; j < 4; ++j) { const float keep = b4 ? p[4 + j] : p[j], send = b4 ? p[j] : p[4 + j]; q4[j] = keep + __shfl_xor(send, 16); }
#pragma unroll
                    for (int j = 0; j < 2; ++j) { const float keep = b3 ? q4[2 + j] : q4[j], send = b3 ? q4[j] : q4[2 + j]; q2[j] = keep + __shfl_xor(send, 8); }
                    { const float keep = b2 ? q2[1] : q2[0], send = b2 ? q2[0] : q2[1]; q1 = keep + __shfl_xor(send, 4); }
                    q1 = DPP_ADD(q1, 0xB1); q1 = DPP_ADD(q1, 0x4E);
                    const float t = __builtin_bit_cast(float, __builtin_amdgcn_ds_bpermute(osrc, __builtin_bit_cast(int, q1)));
                    if ((l >> 4) == ((i - cb + 16 * b) >> 4)) tot = t;
                }
            }
            if (!pf_done) { pf_done = true; if (tok + step < T_TOK) U4_PREFETCH(tok + step); }
            if (fv) AK[(size_t)tok * 128 + (ent & 127)] = gelu_tanh(tot * su * (1.f / 16.f)) * gt * sv;
            if (n == 0) break;
        }
        LDS_WAIT(); asm volatile("" ::: "memory");
    }
#undef U4_PREFETCH
}
template <int MODE>
__device__ __forceinline__ void peer_u4_all(const Frame& F, const Args& A) {
    const unsigned char* X8 = A.ws + WS_P + P_X8;
    const float* SU = (const float*)(A.ws + WS_SU); const float* SV = (const float*)(A.ws + WS_SV);
    const int* IDX = (const int*)(A.ws + WS_P + P_IDX); const float* GATE = (const float*)(A.ws + WS_P + P_GATE); float* AK = (float*)(MODE == 0 ? A.ws + WS_AK : A.ws + WS_P + P_SC);
    const int l = F.lane, step = F.G * NWAVES;
    const int m = l & 15, q = l >> 4;
    const GAS unsigned char* ub = (const GAS unsigned char*)(A.ws + WS_U8);
    const unsigned lconst = 16u * (unsigned)(8 * q + (m & 7));
    const int xoff = 256 * (q >> 1) + 32 * (m & 7) + 16 * (q & 1);
    const bool dg = (m < 8) && ((m >> 2) == (q & 1)); const int dr = m & 3;
    const float dw0 = (dg && dr == 0) ? 1.f : 0.f, dw1 = (dg && dr == 1) ? 1.f : 0.f, dw2 = (dg && dr == 2) ? 1.f : 0.f, dw3 = (dg && dr == 3) ? 1.f : 0.f;
    const int rsel = 4 * (m >> 3);
    const int osrc = 4 * (32 * (l & 1) + 4 * ((l & 15) >> 1));
    const int sc1 = 0x7F7F7F7F;
    const bool b4 = (l & 16) != 0, b3 = (l & 8) != 0, b2 = (l & 4) != 0;
    const int lhi = l >> 4;
    int tok = F.bid * NWAVES + F.wave;
    u32x4 nx0, nx1; int ne0, ne1; float ng0, ng1;
#define UA_PREFETCH(t) do { const size_t _t = (size_t)(t); nx0 = *(const u32x4*)(X8 + _t * 1024 + xoff); nx1 = *(const u32x4*)(X8 + _t * 1024 + xoff + 512); \
        ne0 = IDX[_t * 128 + l]; ne1 = IDX[_t * 128 + 64 + l]; ng0 = GATE[_t * 128 + l]; ng1 = GATE[_t * 128 + 64 + l]; } while (0)
#define UA_LOADS(R, ro_, h) do { _Pragma("unroll") for (int j_ = 0; j_ < 16; ++j_) { const int o_ = __builtin_amdgcn_ds_bpermute(rsel + 4 * (32 * (h) + 2 * j_), (ro_)); \
        R[j_] = *(const GAS u32x4*)(ub + ((unsigned)o_ + lconst)); } } while (0)
#define UA_COMPUTE(R, xb_, h, tot_) do { _Pragma("unroll") for (int b_ = 0; b_ < 2; ++b_) { float p_[8]; \
        _Pragma("unroll") for (int j_ = 0; j_ < 8; ++j_) { const i32x4 r4_ = __builtin_bit_cast(i32x4, R[8 * b_ + j_]); \
            const f32x4 d_ = __builtin_amdgcn_mfma_scale_f32_16x16x128_f8f6f4(__builtin_shufflevector(r4_, r4_, 0, 1, 2, 3, -1, -1, -1, -1), (xb_), (f32x4){0.f, 0.f, 0.f, 0.f}, 4, 0, 0, sc1, 0, sc1); \
            p_[j_] = __builtin_fmaf(d_[3], dw3, __builtin_fmaf(d_[2], dw2, __builtin_fmaf(d_[1], dw1, d_[0] * dw0))); } \
        float q4_[4], q2_[2], q1_; \
        _Pragma("unroll") for (int j_ = 0; j_ < 4; ++j_) { const float keep_ = b4 ? p_[4 + j_] : p_[j_], send_ = b4 ? p_[j_] : p_[4 + j_]; q4_[j_] = keep_ + __shfl_xor(send_, 16); } \
        _Pragma("unroll") for (int j_ = 0; j_ < 2; ++j_) { const float keep_ = b3 ? q4_[2 + j_] : q4_[j_], send_ = b3 ? q4_[j_] : q4_[2 + j_]; q2_[j_] = keep_ + __shfl_xor(send_, 8); } \
        { const float keep_ = b2 ? q2_[1] : q2_[0], send_ = b2 ? q2_[0] : q2_[1]; q1_ = keep_ + __shfl_xor(send_, 4); } \
        q1_ = DPP_ADD(q1_, 0xB1); q1_ = DPP_ADD(q1_, 0x4E); \
        const float t_ = __builtin_bit_cast(float, __builtin_amdgcn_ds_bpermute(osrc, __builtin_bit_cast(int, q1_))); \
        if (lhi == 2 * (h) + b_) (tot_) = t_; } } while (0)
    u32x4 RA[16], RB[16];
    if (tok < T_TOK) { UA_PREFETCH(tok); UA_LOADS(RA, ne0 * 512, 0); }
    for (; tok < T_TOK; tok += step) {
        const i32x8 xb = __builtin_shufflevector(__builtin_bit_cast(i32x4, nx0), __builtin_bit_cast(i32x4, nx1), 0, 1, 2, 3, 4, 5, 6, 7);
        const int e0 = ne0, e1 = ne1; const float g0 = ng0, g1 = ng1;
        const int ro0 = e0 * 512, ro1 = e1 * 512;
        const float su0 = SU[e0], sv0 = SV[e0], su1 = SU[e1], sv1 = SV[e1];
        const bool more = tok + step < T_TOK;
        float tot0 = 0.f, tot1 = 0.f;
        UA_LOADS(RB, ro0, 1);
        if (more) UA_PREFETCH(tok + step);
        UA_COMPUTE(RA, xb, 0, tot0);
        UA_LOADS(RA, ro1, 0);
        UA_COMPUTE(RB, xb, 1, tot0);
        UA_LOADS(RB, ro1, 1);
        UA_COMPUTE(RA, xb, 0, tot1);
        if (more) UA_LOADS(RA, ne0 * 512, 0);
        UA_COMPUTE(RB, xb, 1, tot1);
        AK[(size_t)tok * 128 + l] = gelu_tanh(tot0 * su0 * (1.f / 16.f)) * g0 * sv0;
        AK[(size_t)tok * 128 + 64 + l] = gelu_tanh(tot1 * su1 * (1.f / 16.f)) * g1 * sv1;
    }
#undef UA_PREFETCH
#undef UA_LOADS
#undef UA_COMPUTE
}
__device__ __forceinline__ float wave_max_nonneg(float v) {
    unsigned u = __builtin_bit_cast(unsigned, v);
    u = max(u, (unsigned)__builtin_amdgcn_mov_dpp((int)u, 0xB1, 0xf, 0xf, true));
    u = max(u, (unsigned)__builtin_amdgcn_mov_dpp((int)u, 0x4E, 0xf, 0xf, true));
    u = max(u, (unsigned)__builtin_amdgcn_mov_dpp((int)u, 0x141, 0xf, 0xf, true));
    u = max(u, (unsigned)__builtin_amdgcn_mov_dpp((int)u, 0x140, 0xf, 0xf, true));
    const unsigned a = (unsigned)__builtin_amdgcn_readlane((int)u, 0), b = (unsigned)__builtin_amdgcn_readlane((int)u, 16), c = (unsigned)__builtin_amdgcn_readlane((int)u, 32), d = (unsigned)__builtin_amdgcn_readlane((int)u, 48);
    return __builtin_bit_cast(float, max(max(a, b), max(c, d)));
}
template <int MODE>
__device__ __forceinline__ void peer_v_phase(const Frame& F, const Args& A) {
    const unsigned char* V8 = A.ws + WS_V8; const int* IDX = (const int*)(A.ws + WS_P + P_IDX); const float* AK = (const float*)(A.ws + WS_AK);
    float* out = MODE == 0 ? A.out : (float*)(A.ws + WS_P + P_SC);
    const int g = F.bid & 7, nmem = F.G >> 3, l = F.lane, sub = l & 7, rr = l >> 3, n16 = l & 15, q = l >> 4, step = nmem * NWAVES;
    const GAS unsigned char* vb = (const GAS unsigned char*)(V8 + (size_t)g * NEXP * 128);
    LAS unsigned long long* rep = (LAS unsigned long long*)(F.lds + F.wave * 2048);
    const unsigned long long bm = 0xFFull << (8 * (n16 & 7));
    const int repi = 2 * q + (n16 >> 3);
    const bool vl = (n16 < 8) && (q < 2);
    LAS float* stg = (LAS float*)(F.lds + 16384 + F.wave * 512);
    int tok = 2 * ((F.bid >> 3) * NWAVES + F.wave);
    int ne[4]; float na[4];
#define V_PREFETCH(t) do { const size_t _a = (size_t)(t) * 128, _b = ((size_t)(t) + 1) * 128; ne[0] = IDX[_a + l]; ne[1] = IDX[_a + 64 + l]; ne[2] = IDX[_b + l]; ne[3] = IDX[_b + 64 + l]; \
        na[0] = AK[_a + l]; na[1] = AK[_a + 64 + l]; na[2] = AK[_b + l]; na[3] = AK[_b + 64 + l]; } while (0)
    if (tok + 1 < T_TOK) V_PREFETCH(tok);
    for (; tok + 1 < T_TOK; tok += 2 * step) {
        const int e0 = ne[0], e1 = ne[1], e2 = ne[2], e3 = ne[3]; const float a0 = na[0], a1 = na[1], a2 = na[2], a3 = na[3];
        u32x4 rowA[16], rowB[16];
#pragma unroll
        for (int i = 0; i < 16; ++i) { const int src = (8 * (i & 7) + rr) * 4;
            const int ea = __builtin_amdgcn_ds_bpermute(src, i < 8 ? e0 : e1), eb = __builtin_amdgcn_ds_bpermute(src, i < 8 ? e2 : e3);
            rowA[i] = *(const GAS u32x4*)(vb + ((unsigned)ea * 128u + 16u * (unsigned)sub)); rowB[i] = *(const GAS u32x4*)(vb + ((unsigned)eb * 128u + 16u * (unsigned)sub)); }
        f32x4 HA = {0.f, 0.f, 0.f, 0.f}, HB = {0.f, 0.f, 0.f, 0.f};
        if (l < 32) { const float* hpa = out + (size_t)tok * D + g * 128 + 4 * l; HA = *(const f32x4*)hpa; HB = *(const f32x4*)(hpa + D); }
        if (tok + 2 * step + 1 < T_TOK) V_PREFETCH(tok + 2 * step);
        const float amA = wave_max_nonneg(fmaxf(fabsf(a0), fabsf(a1))), amB = wave_max_nonneg(fmaxf(fabsf(a2), fabsf(a3)));
        const float scA = amA > 0.f ? 224.f * __builtin_amdgcn_rcpf(amA) : 0.f, invA = amA * (1.f / 224.f), scB = amB > 0.f ? 224.f * __builtin_amdgcn_rcpf(amB) : 0.f, invB = amB * (1.f / 224.f);
        { const unsigned wA = (unsigned)__builtin_amdgcn_cvt_pk_fp8_f32(a0 * scA, a1 * scA, 0, false), wB = (unsigned)__builtin_amdgcn_cvt_pk_fp8_f32(a2 * scB, a3 * scB, 0, false);
          const unsigned r0 = (wA & 0xffu) * 0x01010101u, r1 = ((wA >> 8) & 0xffu) * 0x01010101u, r2 = (wB & 0xffu) * 0x01010101u, r3 = ((wB >> 8) & 0xffu) * 0x01010101u;
          rep[l] = ((unsigned long long)r0 << 32) | r0; rep[64 + l] = ((unsigned long long)r1 << 32) | r1; rep[128 + l] = ((unsigned long long)r2 << 32) | r2; rep[192 + l] = ((unsigned long long)r3 << 32) | r3; }
        LDS_WAIT(); asm volatile("" ::: "memory");
#pragma unroll
        for (int t2 = 0; t2 < 2; ++t2) {
            f32x4 alo = {0.f, 0.f, 0.f, 0.f}, ahi = {0.f, 0.f, 0.f, 0.f};
#pragma unroll
            for (int i = 0; i < 16; ++i) { const long bop = (long)(rep[128 * t2 + 8 * i + repi] & bm); const u32x4 rw = t2 ? rowB[i] : rowA[i];
                alo = __builtin_amdgcn_mfma_f32_16x16x32_fp8_fp8(lo64(rw), bop, alo, 0, 0, 0);
                ahi = __builtin_amdgcn_mfma_f32_16x16x32_fp8_fp8(hi64(rw), bop, ahi, 0, 0, 0); }
            const float inv = t2 ? invB : invA;
            float vlo[4], vhi[4];
#pragma unroll
            for (int r = 0; r < 4; ++r) { const float tl = alo[r], th = ahi[r];
                vlo[r] = (tl + __builtin_bit_cast(float, __builtin_amdgcn_ds_bpermute(((l + 40) & 63) * 4, __builtin_bit_cast(int, tl)))) * inv;
                vhi[r] = (th + __builtin_bit_cast(float, __builtin_amdgcn_ds_bpermute(((l + 40) & 63) * 4, __builtin_bit_cast(int, th)))) * inv; }
            if (vl) {
#pragma unroll
                for (int r = 0; r < 4; ++r) { stg[64 * q + 16 * r + n16] = vlo[r]; stg[64 * q + 16 * r + n16 + 8] = vhi[r]; } }
            LDS_WAIT(); asm volatile("" ::: "memory");
            if (l < 32) { const f32x4 dv = *(const LAS f32x4*)(stg + 4 * l); *(f32x4*)(out + (size_t)(tok + t2) * D + g * 128 + 4 * l) = (t2 ? HB : HA) + dv; }
            LDS_WAIT(); asm volatile("" ::: "memory");
        }
        LDS_WAIT(); asm volatile("" ::: "memory");
    }
#undef V_PREFETCH
}
typedef float f32x16 __attribute__((ext_vector_type(16)));
template <int MODE>
__device__ __forceinline__ void peer_v4_phase(const Frame& F, const Args& A) {
    const int* IDX = (const int*)(A.ws + WS_P + P_IDX); const float* AK = (const float*)(A.ws + WS_AK);
    float* out = A.out;
    const int l = F.lane, n = l & 31, hq = l >> 5, step = F.G * NWAVES;
    const GAS unsigned char* vb = (const GAS unsigned char*)(A.ws + WS_V8);
    const unsigned lconst = 16u * (unsigned)n;
    const bool diag = ((l >> 4) & 1) == hq;
    const unsigned bytem = diag ? (0xFFu << (8 * (l & 3))) : 0u; const int dsel = (l & 15) >> 2;
    const unsigned M0 = dsel == 0 ? bytem : 0u, M1 = dsel == 1 ? bytem : 0u, M2 = dsel == 2 ? bytem : 0u, M3 = dsel == 3 ? bytem : 0u;
    const int rsel = 4 * hq;
    const int sc1 = 0x7F7F7F7F;
    const int colb = 8 * n + 4 * hq;
    int tok = F.bid * NWAVES + F.wave;
    int ne0, ne1; float na0, na1;
#define V4_PREFETCH(t) do { const size_t _t = (size_t)(t) * 128; ne0 = IDX[_t + l]; ne1 = IDX[_t + 64 + l]; na0 = AK[_t + l]; na1 = AK[_t + 64 + l]; } while (0)
#define V4_LOADS(R, ro_, h) do { int ba_ = rsel + 4 * (16 * (h)); _Pragma("unroll") for (int j_ = 0; j_ < 8; ++j_) { asm volatile("" : "+v"(ba_)); const int o_ = __builtin_amdgcn_ds_bpermute(ba_, (ro_)); ba_ += 8; \
        R[j_] = *(const GAS u32x4*)(vb + ((unsigned)o_ + lconst)); } } while (0)
#define V4_ONE(ACC, R, rep_, h, j_) do { unsigned s0_ = (unsigned)__builtin_amdgcn_readlane((int)(rep_), 16 * (h) + 2 * (j_)), s1_ = (unsigned)__builtin_amdgcn_readlane((int)(rep_), 16 * (h) + 2 * (j_) + 1); \
        asm volatile("" : "+s"(s0_), "+s"(s1_), "+v"(ACC)); \
        const i32x8 a8_ = {(int)(s0_ & M0), (int)(s0_ & M1), (int)(s0_ & M2), (int)(s0_ & M3), (int)(s1_ & M0), (int)(s1_ & M1), (int)(s1_ & M2), (int)(s1_ & M3)}; \
        const i32x4 r4_ = __builtin_bit_cast(i32x4, R[j_]); \
        ACC = __builtin_amdgcn_mfma_scale_f32_32x32x64_f8f6f4(a8_, __builtin_shufflevector(r4_, r4_, 0, 1, 2, 3, -1, -1, -1, -1), ACC, 0, 4, 0, sc1, 0, sc1); } while (0)
#define V4_COMPUTE(R, rep_, h) do { V4_ONE(acc, R, rep_, h, 0); V4_ONE(acc1, R, rep_, h, 1); V4_ONE(acc, R, rep_, h, 2); V4_ONE(acc1, R, rep_, h, 3); \
        V4_ONE(acc, R, rep_, h, 4); V4_ONE(acc1, R, rep_, h, 5); V4_ONE(acc, R, rep_, h, 6); V4_ONE(acc1, R, rep_, h, 7); } while (0)
    u32x4 RA[8], RB[8];
    if (tok < T_TOK) { V4_PREFETCH(tok); V4_LOADS(RA, ne0 * 512, 0); }
    for (; tok < T_TOK; tok += step) {
        const int e0 = ne0, e1 = ne1; const float a0 = na0, a1 = na1;
        const int ro0 = e0 * 512, ro1 = e1 * 512;
        const bool more = tok + step < T_TOK;
        V4_LOADS(RB, ro0, 1);
        if (more) V4_PREFETCH(tok + step);
        const float am = wave_max_nonneg(fmaxf(fabsf(a0), fabsf(a1)));
        const float sc = am > 0.f ? 224.f * __builtin_amdgcn_rcpf(am) : 0.f, inv = am * (1.f / 224.f);
        const unsigned w8 = (unsigned)__builtin_amdgcn_cvt_pk_fp8_f32(a0 * sc, a1 * sc, 0, false);
        const unsigned rep0 = (w8 & 0xffu) * 0x01010101u, rep1 = ((w8 >> 8) & 0xffu) * 0x01010101u;
        f32x16 acc, acc1;
#pragma unroll
        for (int i = 0; i < 16; ++i) { acc[i] = 0.f; acc1[i] = 0.f; }
        V4_COMPUTE(RA, rep0, 0); V4_LOADS(RA, ro0, 2);
        V4_COMPUTE(RB, rep0, 1); V4_LOADS(RB, ro0, 3);
        V4_COMPUTE(RA, rep0, 2); V4_LOADS(RA, ro1, 0);
        V4_COMPUTE(RB, rep0, 3); V4_LOADS(RB, ro1, 1);
        V4_COMPUTE(RA, rep1, 0); V4_LOADS(RA, ro1, 2);
        V4_COMPUTE(RB, rep1, 1); V4_LOADS(RB, ro1, 3);
        f32x4 H[4];
        u32x2 MX[4];
        { const bf16_t* mp = (const bf16_t*)(A.ws + WS_P + P_HB) + (size_t)tok * D + colb;
#pragma unroll
          for (int j = 0; j < 4; ++j) MX[j] = *(const u32x2*)(mp + 256 * j); }
        V4_COMPUTE(RA, rep1, 2);
        if (more) V4_LOADS(RA, ne0 * 512, 0);
        V4_COMPUTE(RB, rep1, 3);
        acc = acc + acc1;
        float ss = 0.f;
#pragma unroll
        for (int j = 0; j < 4; ++j) { H[j] = (f32x4){bflo(MX[j].x), bfhi(MX[j].x), bflo(MX[j].y), bfhi(MX[j].y)} + (f32x4){acc[4 * j], acc[4 * j + 1], acc[4 * j + 2], acc[4 * j + 3]} * inv;
            ss += (H[j].x * H[j].x + H[j].y * H[j].y) + (H[j].z * H[j].z + H[j].w * H[j].w); }
        const float rstd = 1.f / sqrtf(wave_sum(ss) * (1.f / D) + EPS);
        { float* hp = out + (size_t)tok * D + colb;
#pragma unroll
          for (int j = 0; j < 4; ++j) *(f32x4*)(hp + 256 * j) = H[j] * rstd * *(const f32x4*)(A.in[I_FG] + colb + 256 * j); }
    }
#undef V4_PREFETCH
#undef V4_LOADS
#undef V4_COMPUTE
#undef V4_ONE
}
__device__ __forceinline__ void final_norm_phase(const Frame& F, const Args& A) {
    const int gw = F.bid * NWAVES + F.wave, NGW = F.G * NWAVES, l = F.lane; const float* fg = A.in[I_FG];
    const f32x4* gp = (const f32x4*)fg + l;
    int tok = gw;
    for (; tok + 3 * NGW < T_TOK; tok += 4 * NGW) {
        f32x4 v[4][4]; float ss[4];
#pragma unroll
        for (int b = 0; b < 4; ++b) { const f32x4* hp = (const f32x4*)(A.out + (size_t)(tok + b * NGW) * D) + l;
#pragma unroll
            for (int j = 0; j < 4; ++j) v[b][j] = hp[64 * j]; }
#pragma unroll
        for (int b = 0; b < 4; ++b) { ss[b] = 0.f;
#pragma unroll
            for (int j = 0; j < 4; ++j) ss[b] += (v[b][j].x * v[b][j].x + v[b][j].y * v[b][j].y) + (v[b][j].z * v[b][j].z + v[b][j].w * v[b][j].w); }
#pragma unroll
        for (int o = 1; o < 64; o <<= 1) {
#pragma unroll
            for (int b = 0; b < 4; ++b) ss[b] += __shfl_xor(ss[b], o); }
#pragma unroll
        for (int b = 0; b < 4; ++b) { const float rstd = 1.f / sqrtf(ss[b] * (1.f / D) + EPS); f32x4* hp = (f32x4*)(A.out + (size_t)(tok + b * NGW) * D) + l;
#pragma unroll
            for (int j = 0; j < 4; ++j) hp[64 * j] = v[b][j] * rstd * gp[64 * j]; }
    }
    for (; tok < T_TOK; tok += NGW) { f32x4* hp = (f32x4*)(A.out + (size_t)tok * D) + l; f32x4 v[4]; float ss = 0.f;
#pragma unroll
        for (int j = 0; j < 4; ++j) { v[j] = hp[64 * j]; ss += (v[j].x * v[j].x + v[j].y * v[j].y) + (v[j].z * v[j].z + v[j].w * v[j].w); }
        const float rstd = 1.f / sqrtf(wave_sum(ss) * (1.f / D) + EPS);
#pragma unroll
        for (int j = 0; j < 4; ++j) hp[64 * j] = v[j] * rstd * gp[64 * j]; }
}

#ifdef DEBUG_CHECK
constexpr size_t WS_DBG = 472 * MiB;
__device__ __forceinline__ int dbg_tok(int i) { return (i * 509 + 3) & 32767; }
__device__ __forceinline__ float gelu_ref(float x) { return 0.5f * x * (1.f + tanhf(0.7978845608028654f * (x + 0.044715f * x * x * x))); }
__global__ void __launch_bounds__(512) dbg_scores(Args a) {
    __shared__ float n2s[1024]; __shared__ float q[2048];
    const int t = dbg_tok(blockIdx.x), tid = threadIdx.x;
    const bf16_t* N2 = (const bf16_t*)(a.ws + WS_N1); const float* SC = (const float*)(a.ws + WS_P + P_SC); unsigned* dbg = (unsigned*)(a.ws + WS_DBG);
    for (int k = tid; k < 1024; k += 512) n2s[k] = bf1(N2[(size_t)t * 1024 + k]);
    __syncthreads();
    for (int r = 0; r < 4; ++r) { const int c = tid + 512 * r; float s = 0.f; for (int k = 0; k < 1024; ++k) s += n2s[k] * a.in[I_WQ][(size_t)k * 2048 + c]; q[c] = s; }
    __syncthreads();
    float md = 0.f;
    for (int r = 0; r < 4; ++r) { const int n = tid + 512 * r, hh = n >> 7, key = n & 127; const float* kX = (hh & 1) ? a.in[I_K2] : a.in[I_K1];
        float s = 0.f; for (int d = 0; d < 128; ++d) s += q[hh * 128 + d] * kX[key * 128 + d];
        md = fmaxf(md, fabsf(s - SC[(size_t)n * T_TOK + t])); }
    atomicMax(&dbg[0], __builtin_bit_cast(unsigned, md));
}
__global__ void __launch_bounds__(64) dbg_topk(Args a) {
    __shared__ float s1[8][128], s2[8][128], cv[8][256]; __shared__ float t1v[8][16], t2v[8][16]; __shared__ int t1i[8][16], t2i[8][16], exi[8][16]; __shared__ float exv[8][16];
    const int t = dbg_tok(blockIdx.x), h = threadIdx.x;
    const float* SC = (const float*)(a.ws + WS_P + P_SC); const int* IDX = (const int*)(a.ws + WS_P + P_IDX); const float* GATE = (const float*)(a.ws + WS_P + P_GATE); unsigned* dbg = (unsigned*)(a.ws + WS_DBG);
    if (h >= 8) return;
    for (int j = 0; j < 128; ++j) { s1[h][j] = SC[(size_t)(h * 256 + j) * T_TOK + t]; s2[h][j] = SC[(size_t)(h * 256 + 128 + j) * T_TOK + t]; }
    for (int r = 0; r < 16; ++r) { int b1 = 0, b2 = 0; for (int j = 1; j < 128; ++j) { if (s1[h][j] > s1[h][b1]) b1 = j; if (s2[h][j] > s2[h][b2]) b2 = j; }
        t1v[h][r] = s1[h][b1]; t1i[h][r] = b1; s1[h][b1] = -1e30f; t2v[h][r] = s2[h][b2]; t2i[h][r] = b2; s2[h][b2] = -1e30f; }
    for (int c = 0; c < 256; ++c) cv[h][c] = t1v[h][c >> 4] + t2v[h][c & 15];
    for (int r = 0; r < 16; ++r) { int bc = 0; for (int c = 1; c < 256; ++c) if (cv[h][c] > cv[h][bc]) bc = c;
        exv[h][r] = cv[h][bc]; exi[h][r] = t1i[h][bc >> 4] * 128 + t2i[h][bc & 15]; cv[h][bc] = -1e30f; }
    float sum = 0.f; const float mx0 = exv[h][0]; for (int r = 0; r < 16; ++r) { exv[h][r] = expf(exv[h][r] - mx0); } for (int r = 0; r < 16; ++r) sum += exv[h][r];
    unsigned miss = 0; float gd = 0.f;
    for (int w = 0; w < 16; ++w) { const int e = IDX[(size_t)t * 128 + h * 16 + w]; const float g = GATE[(size_t)t * 128 + h * 16 + w]; bool found = false;
        for (int r = 0; r < 16; ++r) if (exi[h][r] == e) { found = true; gd = fmaxf(gd, fabsf(g - exv[h][r] / sum)); }
        if (!found) ++miss; }
    atomicAdd(&dbg[1], miss); atomicMax(&dbg[3], __builtin_bit_cast(unsigned, gd));
}
__global__ void __launch_bounds__(512) dbg_experts_pre(Args a) {
    __shared__ float n2s[1024]; __shared__ float ak[128]; __shared__ int ek[128]; __shared__ float red[8];
    const int t = dbg_tok(blockIdx.x), tid = threadIdx.x, lane = tid & 63, wave = tid >> 6;
    const bf16_t* N2 = (const bf16_t*)(a.ws + WS_N1); const int* IDX = (const int*)(a.ws + WS_P + P_IDX); const float* GATE = (const float*)(a.ws + WS_P + P_GATE);
    float* rows = (float*)(a.ws + WS_DBG + MiB);
    for (int k = tid; k < 1024; k += 512) n2s[k] = bf1(N2[(size_t)t * 1024 + k]);
    if (tid < 128) ek[tid] = IDX[(size_t)t * 128 + tid];
    __syncthreads();
    for (int k = wave * 16; k < wave * 16 + 16; ++k) { const float* u = a.in[I_PU] + (size_t)ek[k] * 1024; float s = 0.f; for (int j = lane; j < 1024; j += 64) s += u[j] * n2s[j];
        s = wave_sum(s); if (lane == 0) ak[k] = gelu_ref(s) * GATE[(size_t)t * 128 + k]; }
    __syncthreads();
    float h2[2]; float ss = 0.f;
    for (int r = 0; r < 2; ++r) { const int d = tid + 512 * r; float o = 0.f; for (int k = 0; k < 128; ++k) o += ak[k] * a.in[I_PV][(size_t)ek[k] * 1024 + d]; h2[r] = a.out[(size_t)t * 1024 + d] + o; ss += h2[r] * h2[r]; }
    ss = wave_sum(ss); if (lane == 0) red[wave] = ss; __syncthreads();
    float tot = 0.f; for (int w = 0; w < 8; ++w) tot += red[w];
    const float rstd = 1.f / sqrtf(tot / 1024.f + EPS);
    for (int r = 0; r < 2; ++r) { const int d = tid + 512 * r; rows[(size_t)blockIdx.x * 1024 + d] = h2[r] * rstd * a.in[I_FG][d]; }
}
__global__ void __launch_bounds__(512) dbg_experts_post(Args a) {
    const int t = dbg_tok(blockIdx.x), tid = threadIdx.x; const float* rows = (const float*)(a.ws + WS_DBG + MiB); float* dbgf = (float*)(a.ws + WS_DBG);
    float e = 0.f, n = 0.f;
    for (int r = 0; r < 2; ++r) { const int d = tid + 512 * r; const float x = rows[(size_t)blockIdx.x * 1024 + d], y = a.out[(size_t)t * 1024 + d]; e += (x - y) * (x - y); n += x * x; }
    e = wave_sum(e); n = wave_sum(n); if ((tid & 63) == 0) { atomicAdd(&dbgf[4], e); atomicAdd(&dbgf[5], n); }
}
__global__ void __launch_bounds__(512) dbg_report(Args a, int which) {
    const unsigned* dbg = (const unsigned*)(a.ws + WS_DBG); const float* dbgf = (const float*)(a.ws + WS_DBG);
    const float mA = dbgf[0], gd = dbgf[3]; const unsigned miss = dbg[1]; const float relC = sqrtf(dbgf[4] / fmaxf(dbgf[5], 1e-30f));
    float X;
    if (which == 0) { int mask = 0; if (mA > 0.05f) mask |= 1; if (miss > 400u) mask |= 2; if (relC > 0.05f) mask |= 4; if (gd > 0.02f) mask |= 8; X = 1000.f + 100.f * mask; }
    else if (which == 1) X = 1e6f * mA; else if (which == 2) X = 100.f + (float)miss; else if (which == 3) X = 1e6f * relC; else X = 1e6f * gd;
    for (size_t i = (size_t)blockIdx.x * 512 + threadIdx.x; i < (size_t)T_TOK * D; i += (size_t)gridDim.x * 512) a.out[i] = (i == 0) ? X : 0.f;
}
#endif

constexpr int NPH = 13;
__global__ void __launch_bounds__(NWAVES * 64, 2) fwd_kernel(Args args) {
    extern __shared__ __attribute__((aligned(16))) unsigned char lds_raw[];
    Frame F;
    F.lds = (LAS unsigned char*)lds_raw;
    F.tid = threadIdx.x; F.lane = F.tid & 63; F.wave = __builtin_amdgcn_readfirstlane(F.tid >> 6);
    F.G = gridDim.x; F.bid = blockIdx.x;
    volatile LAS unsigned* MISC = (volatile LAS unsigned*)(F.lds + MISC_OFF);
    for (int u = F.tid; u < (LDS_BYTES - LDSCTL_OFF) / 4; u += NWAVES * 64) ((LAS unsigned*)(F.lds + LDSCTL_OFF))[u] = 0u;
    __syncthreads();
    unsigned* ctl = (unsigned*)(args.ws + WS_CTL);
    const int lo = args.ph_lo, hi = args.ph_hi;
    XcdBarrier bar; bar.bar = ctl + CW_BAR + args.li * XCD_BAR_WORDS; bar.x = 0; bar.st = nullptr; bar.wave = F.wave;
    if (hi - lo > 1) bar = xcd_barrier_post(ctl + CW_BAR + args.li * XCD_BAR_WORDS, MISC + 8, F.wave);
#define IN(k) (lo <= (k) && (k) < hi)
#ifdef PROBE_TS
#define STAMP(k) do { if (F.bid == 0 && F.tid == 0) ((unsigned long long*)(args.ws + (472u << 20)))[(k)] = __builtin_amdgcn_s_memrealtime(); } while (0)
#else
#define STAMP(k) do { } while (0)
#endif
#define SEAM(k) do { if (IN(k) && IN((k) + 1)) { xcd_barrier(bar); if (XTRA_BAR) xcd_barrier(bar); } STAMP((k) + 1); } while (0)
    unsigned char* ws = args.ws;
    bf16_t* P = (bf16_t*)(ws + WS_P);

#define REFRESH() do { int z_ = 0; asm volatile("" : "+s"(z_)); F.lane = (int)__builtin_amdgcn_mbcnt_hi(~0u, __builtin_amdgcn_mbcnt_lo(~0u, (unsigned)z_)); F.tid = F.wave * 64 + F.lane; } while (0)
    STAMP(0);
    if (IN(0)) { phase0(F, args); SEAM(0); }
    if (IN(1)) { REFRESH();
        if (F8_LO > 0) { pg8::Gemm g{(const bf16_t*)(ws + WS_N1), (const bf16_t*)(ws + WS_WIN), T_TOK, F8_LO * 256, D, D}; pg8::StaticOrder S; S.init(T_TOK, F8_LO * 256, F.G, F.bid);
            pg8::EpiProj E{P, (float*)(ws + WS_ALR), 0}; pg8::gemm_phase<pg8::EpiProj, pg8::StaticOrder, false, true, false>(F.lds, g, S, E, F.wave); }
        if (F8_LO < 21) {
            pg8::Gemm g{(const bf16_t*)(ws + WS_N18), (const bf16_t*)(ws + WS_W8 + (size_t)F8_LO * 256 * 1024), T_TOK, (21 - F8_LO) * 256, D / 2, D / 2, 0x7B7B7B7B, 0x75757575};
            pg8::StaticOrder S; S.init(T_TOK, (21 - F8_LO) * 256, F.G, ((F8_LO * 128) % F.G) != 0 ? F.G - 1 - F.bid : F.bid);
            pg8::EpiProj E{P, (float*)(ws + WS_ALR), F8_LO}; pg8::gemm_phase<pg8::EpiProj, pg8::StaticOrder, false, true, true>(F.lds, g, S, E, F.wave); }
        {
            REFRESH();
            const int nwg = (T_TOK / 256) * (NPROJ / 256), rem = nwg % F.G;
            if (rem == 0) convert_tables(F, args, F.bid * NWAVES + F.wave, F.G * NWAVES);
            else if (F.bid >= rem) convert_tables(F, args, (F.bid - rem) * NWAVES + F.wave, (F.G - rem) * NWAVES);
        }
        SEAM(1);
    }
    if (IN(2)) { REFRESH();
        if (DRY_EXP == 12) { gla_chunk_phase<true>(F, args); for (int it = F.bid; it < 256; it += F.G) for (int g4 = 0; g4 < 4; ++g4) sgu_unit<true>(F, args, 4 * it + g4, g4 == 0); __syncthreads(); }
        gla_chunk_phase<false>(F, args);
        for (int it = F.bid; it < 256; it += F.G) for (int g4 = 0; g4 < 4; ++g4) sgu_unit<false>(F, args, 4 * it + g4, g4 == 0);
        SEAM(2);
    }
    if (IN(3)) { REFRESH(); if (DRY_EXP == 13 || DRY_EXP == 15) { gla_scan<true>(F, args); __syncthreads(); } gla_scan<false>(F, args); SEAM(3); }
    if (IN(4)) { REFRESH(); if (DRY_EXP == 14 || DRY_EXP == 15) { gla_out_phase<true>(F, args); __syncthreads(); } gla_out_phase<false>(F, args); SEAM(4); }
    if (IN(5)) { REFRESH();
        { pg8::Gemm g{P + PC_R, (const bf16_t*)(ws + WS_WA), T_TOK, D, 1024, PLD}; pg8::StaticOrder S; S.init(T_TOK, D, F.G, F.bid);
          pg8::EpiBrAB E{P}; pg8::gemm_phase<pg8::EpiBrAB, pg8::StaticOrder, true, true, false, true>(F.lds, g, S, E, F.wave); }
        SEAM(5);
    }
    if (IN(6)) { REFRESH();
        pg8::Gemm g{P + PC_MRG, (const bf16_t*)(ws + WS_WOUT), T_TOK, D, D, PLD}; pg8::StaticOrder S; S.init(T_TOK, D, F.G, F.bid);
        pg8::EpiOut E{(bf16_t*)(ws + WS_N1)}; pg8::gemm_phase<pg8::EpiOut, pg8::StaticOrder, true, true>(F.lds, g, S, E, F.wave);
        SEAM(6);
    }
    if (IN(7)) { REFRESH();
        const int gw = F.bid * NWAVES + F.wave, NGW = F.G * NWAVES;
        { int m = gw; for (; m + 3 * NGW < T_TOK; m += 4 * NGW) rms_rows_to_bf16<(SC_F8 ? 2 : 3), 4>(F.lane, args.in[I_X] + (size_t)m * D, (size_t)NGW * D, args.in[I_N2G], (bf16_t*)(ws + WS_P + P_N2) + (size_t)m * D, (size_t)NGW * D, (unsigned*)(ws + WS_P + P_X8) + (size_t)m * 256, (size_t)NGW * 256, (const bf16_t*)(ws + WS_N1) + (size_t)m * D, (size_t)NGW * D, (bf16_t*)(ws + WS_P + P_HB) + (size_t)m * D, (size_t)NGW * D);
          for (; m < T_TOK; m += NGW) rms_rows_to_bf16<(SC_F8 ? 2 : 3), 1>(F.lane, args.in[I_X] + (size_t)m * D, 0, args.in[I_N2G], (bf16_t*)(ws + WS_P + P_N2) + (size_t)m * D, 0, (unsigned*)(ws + WS_P + P_X8) + (size_t)m * 256, 0, (const bf16_t*)(ws + WS_N1) + (size_t)m * D, 0, (bf16_t*)(ws + WS_P + P_HB) + (size_t)m * D, 0); }
        SEAM(7);
    }
    if (IN(8)) { REFRESH();
        pg8::StaticOrder S; S.init(T_TOK, 2048, F.G, F.bid); pg8::EpiScores E{(bf16_t*)(ws + WS_P + P_SC)};
        if (SC_F8) { pg8::Gemm g{(const bf16_t*)(ws + WS_P + P_X8), (const bf16_t*)(ws + WS_WQF), T_TOK, 2048, D / 2, D / 2, 0x7B7B7B7B, 0x75757575};
            pg8::gemm_phase<pg8::EpiScores, pg8::StaticOrder, true, true, true>(F.lds, g, S, E, F.wave); }
        else { pg8::Gemm g{(const bf16_t*)(ws + WS_P + P_N2), (const bf16_t*)(ws + WS_WQF), T_TOK, 2048, D, D};
            pg8::gemm_phase<pg8::EpiScores, pg8::StaticOrder, true, true>(F.lds, g, S, E, F.wave); }
        SEAM(8);
    }
    if (IN(9)) { REFRESH(); peer_topk(F, args); SEAM(9); }
    if (IN(10)) { REFRESH(); if constexpr (UNG == 1) peer_u4_all<0>(F, args); else peer_u4_phase<0>(F, args); SEAM(10); }
    if (IN(11)) { REFRESH(); if (V_F4) peer_v4_phase<0>(F, args); else { if (DRY_EXP == 1) { peer_v_phase<1>(F, args); __syncthreads(); } peer_v_phase<0>(F, args); SEAM(11); } }
    if (IN(12)) { REFRESH(); if (!V_F4) final_norm_phase(F, args); }
#undef IN
#undef SEAM
}


#ifdef PROBE_TS
__global__ void __launch_bounds__(512) probe_report(Args a, int pi, int pj) {
    const unsigned long long* ts = (const unsigned long long*)(a.ws + (472u << 20));
    const float X1 = 10.f * (float)(ts[pi + 1] - ts[pi]) * 0.01f, X2 = (float)(ts[pj + 1] - ts[pj]) * 0.01f;
    for (size_t i = (size_t)blockIdx.x * 512 + threadIdx.x; i < (size_t)T_TOK * D; i += (size_t)gridDim.x * 512) a.out[i] = (i == 0) ? X1 : X2;
}
#endif
#ifdef PROBE_MFMA
__global__ void __launch_bounds__(64) probe_mfma(Args a) {
    const int l = threadIdx.x;
    i32x4 av = {0, 0, 0, 0};
    if (l == PROBE_L) av[PROBE_P >> 3] = 0x2 << (4 * (PROBE_P & 7));
    i32x8 b1, b2;
    for (int r = 0; r < 8; ++r) { unsigned w1 = 0, w2 = 0;
        for (int c = 0; c < 4; ++c) { const int b = 4 * r + c; int t = 0;
            t = __builtin_amdgcn_cvt_pk_fp8_f32((float)((b & 15) + 1), (float)(1 + (b >> 4) + 2 * (l >> 4)), 0, false);
            w1 |= ((unsigned)t & 0xffu) << (8 * c); w2 |= (((unsigned)t >> 8) & 0xffu) << (8 * c); }
        b1[r] = (int)w1; b2[r] = (int)w2; }
    const f32x4 z = {0.f, 0.f, 0.f, 0.f};
    const f32x4 d1 = __builtin_amdgcn_mfma_scale_f32_16x16x128_f8f6f4(__builtin_shufflevector(av, av, 0, 1, 2, 3, -1, -1, -1, -1), b1, z, 4, 0, 0, 0x7F7F7F7F, 0, 0x7F7F7F7F);
    const f32x4 d2 = __builtin_amdgcn_mfma_scale_f32_16x16x128_f8f6f4(__builtin_shufflevector(av, av, 0, 1, 2, 3, -1, -1, -1, -1), b2, z, 4, 0, 0, 0x7F7F7F7F, 0, 0x7F7F7F7F);
    float* st = (float*)(a.ws + (472u << 20));
    *(f32x4*)(st + 8 * l) = d1; *(f32x4*)(st + 8 * l + 4) = d2;
}
__global__ void __launch_bounds__(512) probe_mfma_report(Args a) {
    const int row = PROBE_L & 15;
    const float* st = (const float*)(a.ws + (472u << 20)) + 8 * (16 * (row >> 2)) + (row & 3); const float X1 = 10.f * st[0], X2 = st[4];
    for (size_t i = (size_t)blockIdx.x * 512 + threadIdx.x; i < (size_t)T_TOK * D; i += (size_t)gridDim.x * 512) a.out[i] = (i == 0) ? X1 : X2;
}
#endif
extern "C" void kernel_launch(void* const* d_in, const int* in_sizes, int n_in, void* d_out, int out_size, void* d_ws, size_t ws_size, hipStream_t stream) {
    static int grid = 0;
    if (grid == 0) {
        if (n_in != 20 || in_sizes[0] != T_TOK * D || out_size != T_TOK * D || ws_size < WS_END) {
            fprintf(stderr, "kernel_launch: unexpected shapes: n_in %d in0 %d out %d ws %zu (need %zu)\n", n_in, n_in > 0 ? in_sizes[0] : -1, out_size, ws_size, (size_t)WS_END); grid = -1; return; }
        int dev = 0, cus = 0;
        if (hipGetDevice(&dev) != hipSuccess || hipDeviceGetAttribute(&cus, hipDeviceAttributeMultiprocessorCount, dev) != hipSuccess) { grid = -1; return; }
        if (hipFuncSetAttribute((const void*)fwd_kernel, hipFuncAttributeMaxDynamicSharedMemorySize, LDS_BYTES) != hipSuccess) { fprintf(stderr, "kernel_launch: hipFuncSetAttribute failed\n"); grid = -1; return; }
        int per_cu = 0;
        if (hipOccupancyMaxActiveBlocksPerMultiprocessor(&per_cu, (const void*)fwd_kernel, NWAVES * 64, LDS_BYTES) != hipSuccess || per_cu < 1) fprintf(stderr, "kernel_launch: occupancy query says %d\n", per_cu);
        (void)hipGetLastError();
        grid = cus;
    }
    if (grid < 0) return;
    (void)hipMemsetAsync((char*)d_ws + WS_CTL, 0, CTL_ZERO_BYTES, stream);
    Args a{};
    for (int i = 0; i < 20; ++i) a.in[i] = (const float*)d_in[i];
    a.out = (float*)d_out; a.ws = (unsigned char*)d_ws;
#ifdef PROBE_MFMA
    hipLaunchKernelGGL(probe_mfma, dim3(1), dim3(64), 0, stream, a);
    hipLaunchKernelGGL(probe_mfma_report, dim3(1024), dim3(512), 0, stream, a);
    return;
#endif
#ifndef LAUNCH_LIST
#define LAUNCH_LIST {0, NPH}
#endif
    static const int ranges[][2] = { LAUNCH_LIST };
    const int nl = (int)(sizeof(ranges) / sizeof(ranges[0]));
    for (int li = 0; li < nl; ++li) { a.ph_lo = ranges[li][0]; a.ph_hi = ranges[li][1]; a.li = li;
        hipLaunchKernelGGL(fwd_kernel, dim3(grid), dim3(NWAVES * 64), LDS_BYTES, stream, a); }
}
```

```cpp
#include <hip/hip_runtime.h>
#include <cstdio>
#include <cstdint>


#ifndef XTRA_BAR
#define XTRA_BAR 0
#endif
#ifndef DRY_EXP
#define DRY_EXP 0
#endif
#ifndef DUP_PHASE
#define DUP_PHASE -1
#endif
#ifndef MK_N_LAUNCHES
#define MK_N_LAUNCHES 1
#endif

#define LAS __attribute__((address_space(3)))
#define GAS __attribute__((address_space(1)))
typedef unsigned short bf16_t;
typedef short bf16x8 __attribute__((ext_vector_type(8)));
typedef float f32x4 __attribute__((ext_vector_type(4)));
typedef float f32x2 __attribute__((ext_vector_type(2)));
typedef unsigned u32x4 __attribute__((ext_vector_type(4)));
typedef unsigned u32x2 __attribute__((ext_vector_type(2)));
typedef int i32x4 __attribute__((ext_vector_type(4)));
typedef int i32x8 __attribute__((ext_vector_type(8)));
typedef __bf16 bf16x2_t __attribute__((ext_vector_type(2)));

constexpr int T_TOK = 32768, D = 1024, SEQ = 4096, NBATCH = 8;
constexpr int NPROJ = 5376;
constexpr int PLD = 5120;
constexpr int PC_Q = 0, PC_K = 512, PC_V = 1024, PC_R = 1536, PC_SU = 2048, PC_SV = 2560, PC_GA = 3072, PC_GB = 4096;
constexpr int PC_MRG = 512;
constexpr float EPS = 1e-6f;
constexpr int NEXP = 16384;
#ifndef U_NG
#define U_NG 1
#endif
#ifndef V_F4
#define V_F4 1
#endif
#ifndef SC_F8
#define SC_F8 0
#endif
#ifndef F8_LO
#define F8_LO 11
#endif
constexpr int UNG = U_NG, UNG_SH = (U_NG == 8 ? 3 : (U_NG == 4 ? 2 : (U_NG == 2 ? 1 : 0)));

constexpr size_t MiB = 1u << 20;
constexpr size_t WS_CTL = 0, CTL_ZERO_BYTES = 64 * 1024;
constexpr size_t WS_WIN = 1 * MiB;
constexpr size_t WS_WA = 12 * MiB;
constexpr size_t WS_WB = 13 * MiB;
constexpr size_t WS_WOUT = 14 * MiB;
constexpr size_t WS_WQF = 16 * MiB;
constexpr size_t WS_U8 = 20 * MiB;
constexpr size_t WS_V8 = 36 * MiB;
constexpr size_t WS_SU = 52 * MiB;
constexpr size_t WS_SV = 52 * MiB + 65536;
constexpr size_t WS_AK = 53 * MiB;
constexpr size_t WS_DEC = 84 * MiB;
constexpr size_t WS_ALR = 85 * MiB;
constexpr size_t WS_N1 = 87 * MiB;
constexpr size_t WS_P = 151 * MiB;
constexpr size_t WS_W8 = 472 * MiB;
constexpr size_t WS_N18 = 478 * MiB;
constexpr size_t WS_END = 510 * MiB;
constexpr size_t P_HB = 192 * MiB;
constexpr size_t P_N2 = 128 * MiB;
constexpr size_t P_SC = 0, P_IDX = 256 * MiB, P_GATE = 272 * MiB, P_X8 = 288 * MiB;

constexpr int CW_BAR = 4096;

constexpr int RING_BYTES = 131072;
constexpr int LDSCTL_OFF = RING_BYTES, MISC_OFF = LDSCTL_OFF + 320;
constexpr int LDS_BYTES = 147456;
constexpr int NWAVES = 8;

__device__ __forceinline__ unsigned pk2(float lo, float hi) { const f32x2 v = {lo, hi}; const bf16x2_t b = __builtin_convertvector(v, bf16x2_t); return __builtin_bit_cast(unsigned, b); }
__device__ __forceinline__ unsigned f2bf(float f) { return pk2(f, 0.f) & 0xffffu; }
__device__ __forceinline__ float bflo(unsigned w) { return __builtin_bit_cast(float, w << 16); }
__device__ __forceinline__ float bfhi(unsigned w) { return __builtin_bit_cast(float, w & 0xffff0000u); }
__device__ __forceinline__ float bf1(bf16_t h) { return __builtin_bit_cast(float, ((unsigned)h) << 16); }
__device__ __forceinline__ float sigmoidf_(float x) { return __builtin_amdgcn_rcpf(1.f + __expf(-x)); }
__device__ __forceinline__ float gelu_tanh(float x) { const float y = 1.5957691216057308f * (x + 0.044715f * x * x * x); return x * sigmoidf_(y); }
__device__ __forceinline__ float siluf_(float x) { return x * sigmoidf_(x); }
__device__ __forceinline__ float wave_sum(float v) {
#pragma unroll
    for (int o = 1; o < 64; o <<= 1) v += __shfl_xor(v, o);
    return v;
}
#define LDS_WAIT() asm volatile("s_waitcnt lgkmcnt(0)" ::: "memory")
#define VM_WAIT() asm volatile("s_waitcnt vmcnt(0)" ::: "memory")

__device__ __forceinline__ int lane_now() { int z = 0; asm volatile("" : "+s"(z)); return (int)__builtin_amdgcn_mbcnt_hi(~0u, __builtin_amdgcn_mbcnt_lo(~0u, (unsigned)z)); }
namespace pg8 {
constexpr int BM = 256, BK = 64, HALF = 128, HTB = HALF * BK * 2, STAGE_BYTES = 8 * HTB, NXCD = 8, WGM = 8;
__host__ __device__ __forceinline__ int lds_byte(int r, int c) { const int st = (r >> 4) * 2 + (c >> 5), rr = r & 15, cc = c & 31, ob = rr * 64 + cc * 2; return st * 1024 + (ob ^ (((ob >> 9) & 1) << 5)); }
__host__ __device__ __forceinline__ void stage_rc(int b, int& R, int& C) { const int st = b / 1024, sb = b % 1024, swz = sb ^ (((sb >> 9) & 1) << 5); R = (st >> 1) * 16 + swz / 64; C = (st & 1) * 32 + (swz % 64) / 2; }
__host__ __device__ __forceinline__ int perm32(int rho) { const int n = rho >> 4, i = rho & 15; return 8 * (i >> 2) + 4 * n + (i & 3); }

struct Unit { int pm, pn; };
struct Gemm { const bf16_t* A; const bf16_t* Bt; int M, N, K, lda; int sa = 0, sb = 0; };

struct StaticOrder {
    int nM, nN, nwg, G, c;
    __host__ __device__ void init(int M, int N, int G_, int c_) { nM = M / BM; nN = N / BM; nwg = nM * nN; G = G_; c = c_; }
    __host__ __device__ bool next(int i, Unit& u) const {
        const long L = (long)i * G + c; if (L >= nwg) return false;
        int wgid = (int)L; { const int q = nwg / NXCD, r = nwg % NXCD, xcd = wgid % NXCD, off = wgid / NXCD; wgid = (xcd < r ? xcd * (q + 1) : r * (q + 1) + (xcd - r) * q) + off; }
        const int nig = WGM * nN, gid = wgid / nig, fm = gid * WGM, gsz = (nM - fm) < WGM ? (nM - fm) : WGM;
        u.pm = fm + ((wgid % nig) % gsz); u.pn = (wgid % nig) / gsz; return true;
    }
    __device__ __forceinline__ void a_ready(const Unit&) const {}
    __device__ __forceinline__ void done(const Unit&) const {}
};

template <class Epi, class Sched, bool ALIGN_EPI = false, bool SP2 = false, bool F8 = false, bool MID = false>
__device__ __forceinline__ void gemm_phase(LAS unsigned char* lds, const Gemm g, const Sched& S, const Epi& E, int wave_id) {
    const int wid = wave_id, lane = lane_now(), tid = wid * 64 + lane, wr = wid >> 2, wc = wid & 3, fr = lane & 15, fq = lane >> 4;
    const int K = g.K, nt = K / BK, lda = g.lda; const int scAB = (g.sb & 0xff) | ((g.sa & 0xff) << 8); (void)scAB;
    unsigned voffA[1], voffB[1];
    { int R, C; stage_rc(tid * 16, R, C); const int Rb = Epi::PERM ? ((R & ~31) + perm32(R & 31)) : R;
        voffA[0] = (unsigned)(R * lda + C) * 2u; voffB[0] = (unsigned)(Rb * K + C) * 2u; }
    const size_t dltA = (size_t)64 * lda * 2, dltB = (size_t)64 * K * 2;
    const size_t kstep = (size_t)(BK * 2);
    const size_t hstepA = (size_t)HALF * lda * 2, hstepB = (size_t)HALF * K * 2;
    const size_t tstepA = 2 * hstepA, tstepB = 2 * hstepB;
    const unsigned ldsw = (unsigned)wid * 1024u; const unsigned ldsbase = (unsigned)(__UINTPTR_TYPE__)lds + ldsw;
    const int aoff = lds_byte(wr * 64 + fr, fq * 8), boff = lds_byte(wc * 32 + fr, fq * 8);
#define PG8_SA(b, h) (((b) * 2 + (h)) * HTB)
#define PG8_SB(b, h) ((4 + (b) * 2 + (h)) * HTB)
#define PG8_STAGE(bufoff, gbase, voff) do { _Pragma("unroll") for (int _i = 0; _i < 2; ++_i) \
        asm volatile("s_mov_b32 m0, %2\n\ts_nop 0\n\tglobal_load_lds_dwordx4 %0, %1" :: "v"((voff)[0]), "s"((const char*)(gbase) + (size_t)_i * ((voff) == voffA ? dltA : dltB)), "s"(ldsbase + (unsigned)((bufoff) + _i * 8192)) : "memory", "m0"); } while (0)
#define PG8_LDA(dst, b, h) do { _Pragma("unroll") for (int m = 0; m < 4; ++m) _Pragma("unroll") for (int k = 0; k < 2; ++k) dst[m][k] = *(const LAS bf16x8*)(lds + PG8_SA(b, h) + aoff + m * 2048 + k * 1024); } while (0)
#define PG8_LDB(dst, b, h) do { _Pragma("unroll") for (int n = 0; n < 2; ++n) _Pragma("unroll") for (int k = 0; k < 2; ++k) dst[n][k] = *(const LAS bf16x8*)(lds + PG8_SB(b, h) + boff + n * 2048 + k * 1024); } while (0)
#define PG8_CAT(x) __builtin_shufflevector(__builtin_bit_cast(i32x4, (x)[0]), __builtin_bit_cast(i32x4, (x)[1]), 0, 1, 2, 3, 4, 5, 6, 7)
#define PG8_MMA(ai, bj, At, Bt) do { __builtin_amdgcn_s_setprio(1); if constexpr (F8) { _Pragma("unroll") for (int m = 0; m < 4; ++m) _Pragma("unroll") for (int n = 0; n < 2; ++n) \
        acc[ai][bj][m][n] = __builtin_amdgcn_mfma_scale_f32_16x16x128_f8f6f4(PG8_CAT(Bt[n]), PG8_CAT(At[m]), acc[ai][bj][m][n], 0, 0, 0, scAB, 1, scAB); } else { \
        _Pragma("unroll") for (int m = 0; m < 4; ++m) _Pragma("unroll") for (int n = 0; n < 2; ++n) _Pragma("unroll") for (int k = 0; k < 2; ++k) \
        acc[ai][bj][m][n] = __builtin_amdgcn_mfma_f32_16x16x32_bf16(Bt[n][k], At[m][k], acc[ai][bj][m][n], 0, 0, 0); } __builtin_amdgcn_s_setprio(0); } while (0)
#define PG8_WAIT_V(n) asm volatile("s_waitcnt vmcnt(" #n ")" ::: "memory")
#define PG8_WAIT_L(n) asm volatile("s_waitcnt lgkmcnt(" #n ")" ::: "memory")
#define PG8_BAR __builtin_amdgcn_s_barrier()
#define PG8_SCHED __builtin_amdgcn_sched_barrier(0)
    Unit cur, nxt; int ui = 0;
    if (!S.next(0, cur)) return;
    f32x4 acc[2][2][4][2];
#pragma unroll
    for (int a = 0; a < 2; ++a)
#pragma unroll
        for (int b = 0; b < 2; ++b)
#pragma unroll
            for (int m = 0; m < 4; ++m)
#pragma unroll
                for (int n = 0; n < 2; ++n) acc[a][b][m][n] = (f32x4){0.f, 0.f, 0.f, 0.f};
    bf16x8 At[4][2], B0[2][2], B1[2][2];
    const char* cA = (const char*)g.A + (size_t)cur.pm * tstepA; const char* cB = (const char*)g.Bt + (size_t)cur.pn * tstepB;
    S.a_ready(cur);
    if constexpr (SP2) {
        PG8_STAGE(PG8_SB(0, 0), cB, voffB); PG8_STAGE(PG8_SB(0, 1), cB + hstepB, voffB); PG8_STAGE(PG8_SA(0, 0), cA, voffA); PG8_STAGE(PG8_SA(0, 1), cA + hstepA, voffA);
        if (wr == 1) PG8_BAR;
        PG8_WAIT_V(2); PG8_BAR;
        PG8_STAGE(PG8_SB(1, 0), cB + kstep, voffB); PG8_STAGE(PG8_SA(1, 0), cA + kstep, voffA); PG8_STAGE(PG8_SB(1, 1), cB + hstepB + kstep, voffB);
        PG8_WAIT_V(6); PG8_BAR;
    } else {
        PG8_STAGE(PG8_SB(0, 0), cB, voffB); PG8_STAGE(PG8_SA(0, 0), cA, voffA); PG8_STAGE(PG8_SB(0, 1), cB + hstepB, voffB); PG8_STAGE(PG8_SA(0, 1), cA + hstepA, voffA);
        if (wr == 1) PG8_BAR;
        PG8_WAIT_V(4); PG8_BAR;
        PG8_STAGE(PG8_SB(1, 0), cB + kstep, voffB); PG8_STAGE(PG8_SA(1, 0), cA + kstep, voffA); PG8_STAGE(PG8_SB(1, 1), cB + hstepB + kstep, voffB);
        PG8_WAIT_V(6); PG8_BAR;
    }
    for (;;) {
        const bool has_next = S.next(ui + 1, nxt);
        const char* nA = has_next ? (const char*)g.A + (size_t)nxt.pm * tstepA : cA; const char* nB = has_next ? (const char*)g.Bt + (size_t)nxt.pn * tstepB : cB;
#pragma nounroll
        for (int t = 0; t < nt; t += 2) {
            if constexpr (MID) { if (t == (nt >> 1)) E.mid(acc, cur, wr, wc); }
            const bool last = (t == nt - 2);
            const char* a1 = cA + (size_t)(t + 1) * kstep;
            const char* a2 = last ? nA : cA + (size_t)(t + 2) * kstep; const char* b2 = last ? nB : cB + (size_t)(t + 2) * kstep;
            const char* a3 = a2 + kstep; const char* b3 = b2 + kstep;
            if (last && has_next) S.a_ready(nxt);
            if constexpr (SP2) {
            PG8_LDB(B0, 0, 0); PG8_LDB(B1, 0, 1); PG8_SCHED; PG8_LDA(At, 0, 0); PG8_STAGE(PG8_SA(1, 1), a1 + hstepA, voffA);
            PG8_WAIT_V(8); PG8_WAIT_L(0); PG8_BAR; PG8_MMA(0, 0, At, B0); PG8_MMA(0, 1, At, B1); PG8_BAR; PG8_SCHED;
            PG8_LDA(At, 0, 1); PG8_STAGE(PG8_SB(0, 0), b2, voffB); PG8_STAGE(PG8_SB(0, 1), b2 + hstepB, voffB); PG8_STAGE(PG8_SA(0, 0), a2, voffA);
            PG8_WAIT_V(8); PG8_WAIT_L(0); PG8_BAR; PG8_MMA(1, 0, At, B0); PG8_MMA(1, 1, At, B1); PG8_BAR; PG8_SCHED;
            PG8_LDB(B0, 1, 0); PG8_LDB(B1, 1, 1); PG8_SCHED; PG8_LDA(At, 1, 0); PG8_STAGE(PG8_SA(0, 1), a2 + hstepA, voffA);
            PG8_WAIT_V(8); PG8_WAIT_L(0); PG8_BAR; PG8_MMA(0, 0, At, B0); PG8_MMA(0, 1, At, B1); PG8_BAR; PG8_SCHED;
            PG8_LDA(At, 1, 1); PG8_STAGE(PG8_SB(1, 0), b3, voffB); PG8_STAGE(PG8_SB(1, 1), b3 + hstepB, voffB); PG8_STAGE(PG8_SA(1, 0), a3, voffA);
            PG8_WAIT_V(8); PG8_WAIT_L(0); PG8_BAR; PG8_MMA(1, 0, At, B0); PG8_MMA(1, 1, At, B1); PG8_BAR; PG8_SCHED;
            } else {
            PG8_LDB(B0, 0, 0); PG8_SCHED; PG8_LDA(At, 0, 0); PG8_STAGE(PG8_SA(1, 1), a1 + hstepA, voffA);
            PG8_WAIT_L(8); PG8_BAR; PG8_WAIT_L(0); PG8_MMA(0, 0, At, B0); PG8_BAR; PG8_SCHED;
            PG8_LDB(B1, 0, 1); PG8_STAGE(PG8_SB(0, 0), b2, voffB);
            PG8_BAR; PG8_WAIT_L(0); PG8_MMA(0, 1, At, B1); PG8_BAR;
            PG8_LDA(At, 0, 1); PG8_STAGE(PG8_SA(0, 0), a2, voffA);
            PG8_BAR; PG8_WAIT_L(0); PG8_MMA(1, 0, At, B0); PG8_BAR; PG8_SCHED;
            PG8_STAGE(PG8_SB(0, 1), b2 + hstepB, voffB);
            PG8_WAIT_V(6); PG8_BAR; PG8_MMA(1, 1, At, B1); PG8_BAR;
            PG8_LDB(B0, 1, 0); PG8_SCHED; PG8_LDA(At, 1, 0); PG8_STAGE(PG8_SA(0, 1), a2 + hstepA, voffA);
            PG8_WAIT_L(8); PG8_BAR; PG8_WAIT_L(0); PG8_MMA(0, 0, At, B0); PG8_BAR; PG8_SCHED;
            PG8_LDB(B1, 1, 1); PG8_STAGE(PG8_SB(1, 0), b3, voffB);
            PG8_BAR; PG8_WAIT_L(0); PG8_MMA(0, 1, At, B1); PG8_BAR;
            PG8_LDA(At, 1, 1); PG8_STAGE(PG8_SA(1, 0), a3, voffA);
            PG8_BAR; PG8_WAIT_L(0); PG8_MMA(1, 0, At, B0); PG8_BAR; PG8_SCHED;
            PG8_STAGE(PG8_SB(1, 1), b3 + hstepB, voffB);
            PG8_WAIT_V(6); PG8_BAR; PG8_MMA(1, 1, At, B1); PG8_BAR;
            }
        }
        if constexpr (ALIGN_EPI) { if (wr == 0) PG8_BAR; }
        E(acc, cur, wr, wc, fr, fq); S.done(cur);
        if (!has_next) break;
#pragma unroll
        for (int a = 0; a < 2; ++a)
#pragma unroll
            for (int b = 0; b < 2; ++b)
#pragma unroll
                for (int m = 0; m < 4; ++m)
#pragma unroll
                    for (int n = 0; n < 2; ++n) acc[a][b][m][n] = (f32x4){0.f, 0.f, 0.f, 0.f};
        cur = nxt; cA = nA; cB = nB; ++ui;
        if constexpr (ALIGN_EPI) { if (wr == 1) PG8_BAR; }
    }
    PG8_WAIT_V(0);
    if constexpr (!ALIGN_EPI) { if (wr == 0) PG8_BAR; }
    PG8_BAR;
#undef PG8_SA
#undef PG8_SB
#undef PG8_STAGE
#undef PG8_LDA
#undef PG8_LDB
#undef PG8_MMA
#undef PG8_CAT
#undef PG8_WAIT_V
#undef PG8_WAIT_L
#undef PG8_BAR
#undef PG8_SCHED
}

__device__ __forceinline__ u32x4 pack8(f32x4 v0, f32x4 v1) { u32x4 w; w.x = pk2(v0[0], v0[1]); w.y = pk2(v0[2], v0[3]); w.z = pk2(v1[0], v1[1]); w.w = pk2(v1[2], v1[3]); return w; }
__device__ __forceinline__ void unpack8(u32x4 w, f32x4& v0, f32x4& v1) { v0 = (f32x4){bflo(w.x), bfhi(w.x), bflo(w.y), bfhi(w.y)}; v1 = (f32x4){bflo(w.z), bfhi(w.z), bflo(w.w), bfhi(w.w)}; }

struct EpiProj {
    static constexpr bool PERM = true;
    bf16_t* P; float* ALR; int pn0;
    __device__ __forceinline__ void operator()(const f32x4 (&acc)[2][2][4][2], const Unit& u, int wr, int wc, int fr, int fq) const {
        { const int ln = lane_now(); fr = ln & 15; fq = ln >> 4; }
        const int row0 = u.pm * BM + wr * 64 + fr; int pn = u.pn + pn0; const int cl = wc * 32 + 8 * fq;
        if (pn == 10) {
            if (wc == 0 && fq < 2) {
#pragma unroll
                for (int ai = 0; ai < 2; ++ai)
#pragma unroll
                    for (int m = 0; m < 4; ++m) { float* rp = ALR + (size_t)(row0 + ai * HALF + m * 16) * 16 + 8 * fq;
                        *(f32x4*)rp = acc[ai][0][m][0]; *(f32x4*)(rp + 4) = acc[ai][0][m][1]; }
            }
            return;
        }
        if (pn > 10) --pn;
        const int mode = pn < 8 ? 0 : (pn < 12 ? 1 : 2);
#pragma unroll
        for (int ai = 0; ai < 2; ++ai)
#pragma unroll
            for (int m = 0; m < 4; ++m) { bf16_t* rowp = P + (size_t)(row0 + ai * HALF + m * 16) * PLD + pn * BM + cl;
#pragma unroll
                for (int bj = 0; bj < 2; ++bj) { f32x4 v0 = acc[ai][bj][m][0], v1 = acc[ai][bj][m][1];
                    if (mode == 1) {
#pragma unroll
                        for (int i = 0; i < 4; ++i) { v0[i] = gelu_tanh(v0[i]); v1[i] = gelu_tanh(v1[i]); }
                    } else if (mode == 2) {
                        unsigned w0 = 0, w1 = 0;
                        w0 = __builtin_amdgcn_cvt_pk_u8_f32(sigmoidf_(v0[0]) * 255.f, 0, w0); w0 = __builtin_amdgcn_cvt_pk_u8_f32(sigmoidf_(v0[1]) * 255.f, 1, w0); w0 = __builtin_amdgcn_cvt_pk_u8_f32(sigmoidf_(v0[2]) * 255.f, 2, w0); w0 = __builtin_amdgcn_cvt_pk_u8_f32(sigmoidf_(v0[3]) * 255.f, 3, w0);
                        w1 = __builtin_amdgcn_cvt_pk_u8_f32(sigmoidf_(v1[0]) * 255.f, 0, w1); w1 = __builtin_amdgcn_cvt_pk_u8_f32(sigmoidf_(v1[1]) * 255.f, 1, w1); w1 = __builtin_amdgcn_cvt_pk_u8_f32(sigmoidf_(v1[2]) * 255.f, 2, w1); w1 = __builtin_amdgcn_cvt_pk_u8_f32(sigmoidf_(v1[3]) * 255.f, 3, w1);
                        unsigned char* bp = (unsigned char*)(P + (size_t)(row0 + ai * HALF + m * 16) * PLD) + (pn < 16 ? PC_GA * 2 + (pn - 12) * BM : PC_GB * 2 + (pn - 16) * BM) + cl + bj * HALF;
                        *(u32x2*)bp = (u32x2){w0, w1}; continue;
                    }
                    *(u32x4*)(rowp + bj * HALF) = pack8(v0, v1); } }
    }
};
struct EpiBrA {
    static constexpr bool PERM = true;
    bf16_t* P;
    __device__ __forceinline__ void operator()(const f32x4 (&acc)[2][2][4][2], const Unit& u, int wr, int wc, int fr, int fq) const {
        const int row0 = u.pm * BM + wr * 64 + fr; const int c0 = u.pn * BM + wc * 32 + 8 * fq;
#pragma unroll
        for (int ai = 0; ai < 2; ++ai)
#pragma unroll
            for (int m = 0; m < 4; ++m) { bf16_t* rowp = P + (size_t)(row0 + ai * HALF + m * 16) * PLD;
#pragma unroll
                for (int bj = 0; bj < 2; ++bj) { const int c = c0 + bj * HALF; f32x4 g0, g1; unpack8(*(const u32x4*)(rowp + PC_GA + c), g0, g1);
                    *(u32x4*)(rowp + PC_MRG + c) = pack8(acc[ai][bj][m][0] * g0, acc[ai][bj][m][1] * g1); } }
    }
};
struct EpiBrB {
    static constexpr bool PERM = true;
    bf16_t* P;
    __device__ __forceinline__ void operator()(const f32x4 (&acc)[2][2][4][2], const Unit& u, int wr, int wc, int fr, int fq) const {
        const int row0 = u.pm * BM + wr * 64 + fr; const int c0 = u.pn * BM + wc * 32 + 8 * fq;
#pragma unroll
        for (int ai = 0; ai < 2; ++ai)
#pragma unroll
            for (int m = 0; m < 4; ++m) { bf16_t* rowp = P + (size_t)(row0 + ai * HALF + m * 16) * PLD;
#pragma unroll
                for (int bj = 0; bj < 2; ++bj) { const int c = c0 + bj * HALF; f32x4 g0, g1, p0, p1; unpack8(*(const u32x4*)(rowp + PC_GB + c), g0, g1); unpack8(*(const u32x4*)(rowp + PC_MRG + c), p0, p1);
                    *(u32x4*)(rowp + PC_MRG + c) = pack8(p0 + acc[ai][bj][m][0] * g0, p1 + acc[ai][bj][m][1] * g1); } }
    }
};
struct EpiBrAB {
    static constexpr bool PERM = true;
    bf16_t* P;
    static __device__ __forceinline__ void u8x8(const u32x2 w, f32x4& f0, f32x4& f1) {
        f0 = (f32x4){(float)(w.x & 0xffu), (float)((w.x >> 8) & 0xffu), (float)((w.x >> 16) & 0xffu), (float)(w.x >> 24)};
        f1 = (f32x4){(float)(w.y & 0xffu), (float)((w.y >> 8) & 0xffu), (float)((w.y >> 16) & 0xffu), (float)(w.y >> 24)}; }
    __device__ __forceinline__ void mid(f32x4 (&acc)[2][2][4][2], const Unit& u, int wr, int wc) const {
        const int ln = lane_now(), fr = ln & 15, fq = ln >> 4;
        const int row0 = u.pm * BM + wr * 64 + fr; const int c0 = u.pn * BM + wc * 32 + 8 * fq;
#pragma unroll
        for (int ai = 0; ai < 2; ++ai)
#pragma unroll
            for (int m = 0; m < 4; ++m) { const unsigned char* rowb = (const unsigned char*)(P + (size_t)(row0 + ai * HALF + m * 16) * PLD);
#pragma unroll
                for (int bj = 0; bj < 2; ++bj) { const int c = c0 + bj * HALF; f32x4 a0, a1, b0, b1; u8x8(*(const u32x2*)(rowb + PC_GA * 2 + c), a0, a1); u8x8(*(const u32x2*)(rowb + PC_GB * 2 + c), b0, b1);
#pragma unroll
                    for (int i = 0; i < 4; ++i) { acc[ai][bj][m][0][i] *= a0[i] * __builtin_amdgcn_rcpf(fmaxf(b0[i], 1.f)); acc[ai][bj][m][1][i] *= a1[i] * __builtin_amdgcn_rcpf(fmaxf(b1[i], 1.f)); } } }
    }
    __device__ __forceinline__ void operator()(const f32x4 (&acc)[2][2][4][2], const Unit& u, int wr, int wc, int fr, int fq) const {
        { const int ln = lane_now(); fr = ln & 15; fq = ln >> 4; }
        const int row0 = u.pm * BM + wr * 64 + fr; const int c0 = u.pn * BM + wc * 32 + 8 * fq;
#pragma unroll
        for (int ai = 0; ai < 2; ++ai)
#pragma unroll
            for (int m = 0; m < 4; ++m) { bf16_t* rowp = P + (size_t)(row0 + ai * HALF + m * 16) * PLD;
#pragma unroll
                for (int bj = 0; bj < 2; ++bj) { const int c = c0 + bj * HALF; f32x4 g0, g1; u8x8(*(const u32x2*)((const unsigned char*)rowp + PC_GB * 2 + c), g0, g1);
#pragma unroll
                    for (int i = 0; i < 4; ++i) { g0[i] = fmaxf(g0[i], 1.f) * (1.f / 255.f); g1[i] = fmaxf(g1[i], 1.f) * (1.f / 255.f); }
                    *(u32x4*)(rowp + PC_MRG + c) = pack8(acc[ai][bj][m][0] * g0, acc[ai][bj][m][1] * g1); } }
    }
};
struct EpiOut {
    static constexpr bool PERM = true;
    bf16_t* O;
    __device__ __forceinline__ void operator()(const f32x4 (&acc)[2][2][4][2], const Unit& u, int wr, int wc, int fr, int fq) const {
        const int row0 = u.pm * BM + wr * 64 + fr; const int c0 = u.pn * BM + wc * 32 + 8 * fq;
#pragma unroll
        for (int ai = 0; ai < 2; ++ai)
#pragma unroll
            for (int m = 0; m < 4; ++m) { const size_t ro = (size_t)(row0 + ai * HALF + m * 16) * D;
#pragma unroll
                for (int bj = 0; bj < 2; ++bj) *(u32x4*)(O + ro + c0 + bj * HALF) = pack8(acc[ai][bj][m][0], acc[ai][bj][m][1]); }
    }
};
struct EpiScores {
    static constexpr bool PERM = true;
    bf16_t* SC;
    __device__ __forceinline__ void operator()(const f32x4 (&acc)[2][2][4][2], const Unit& u, int wr, int wc, int fr, int fq) const {
        const int tb0 = u.pm * 16 + wr * 4; const int cq0 = (u.pn * BM + wc * 32 + 8 * fq) >> 3;
#pragma unroll
        for (int ai = 0; ai < 2; ++ai)
#pragma unroll
            for (int m = 0; m < 4; ++m) { bf16_t* bp = SC + ((size_t)(tb0 + ai * 8 + m) * 256) * 128 + fr * 8;
#pragma unroll
                for (int bj = 0; bj < 2; ++bj) { u32x4 w = pack8(acc[ai][bj][m][0], acc[ai][bj][m][1]);
#pragma unroll
                    for (int c = 0; c < 4; ++c) w[c] ^= (((w[c] >> 15) & 0x00010001u) * 0x7FFFu) | 0x80008000u;
                    *(u32x4*)(bp + (size_t)(cq0 + bj * 16) * 128) = w; } }
    }
};
}

#define XB_TMO      128
#define XB_XCNT(j)  (256  + 64 * (j))
#define XB_XSUB(j)  (1280 + 64 * (j))
#define XB_XGEN(j)  (2304 + 64 * (j))
#define XB_TOP      3328
#define XB_TOPGEN   3392
#define XCD_BAR_WORDS 3456
#define XB_SPIN_CAP (1u << 18)
__device__ __forceinline__ unsigned xb_ld(unsigned* p)              { return __hip_atomic_load(p, __ATOMIC_RELAXED, __HIP_MEMORY_SCOPE_AGENT); }
__device__ __forceinline__ unsigned xb_add(unsigned* p, unsigned v) { return __hip_atomic_fetch_add(p, v, __ATOMIC_RELAXED, __HIP_MEMORY_SCOPE_AGENT); }
__device__ __forceinline__ unsigned xb_xcc_id() { return (unsigned)__builtin_amdgcn_s_getreg((3 << 11) | 20) & 0xFu; }
#define XB_SPIN(cond, bar) do { unsigned _sp = 0; while (cond) { __builtin_amdgcn_s_sleep(1); \
    if ((++_sp & 255u) == 0u) { if (xb_ld(&(bar)[XB_TMO])) break; if (_sp > XB_SPIN_CAP) { atomicAdd(&(bar)[XB_TMO], 1u); break; } } } } while (0)
struct XcdBarrier { unsigned* bar; unsigned x; volatile LAS unsigned* st; int wave; };
__device__ __forceinline__ XcdBarrier xcd_barrier_post(unsigned* bar, volatile LAS unsigned* st, int wave) {
    XcdBarrier b; b.bar = bar; b.x = xb_xcc_id(); b.st = st; b.wave = wave;
    if (wave == 0 && lane_now() == 0) (void)xb_add(&bar[XB_XCNT(b.x)], 1u);
    return b;
}
__device__ __forceinline__ void xcd_barrier_complete(unsigned* bar, unsigned x, unsigned& nloc, unsigned& nx) {
    const unsigned G = gridDim.x * gridDim.y * gridDim.z;
    unsigned sum, cnt, mine, sp = 0u;
    for (;;) {
        sum = 0u; cnt = 0u; mine = 0u;
#pragma unroll
        for (unsigned j = 0; j < 16; ++j) { const unsigned c = xb_ld(&bar[XB_XCNT(j)]); sum += c; cnt += (c > 0u) ? 1u : 0u; mine = (j == x) ? c : mine; }
        if (sum == G) break;
        __builtin_amdgcn_s_sleep(1);
        if ((++sp & 255u) == 0u) { if (xb_ld(&bar[XB_TMO])) break; if (sp > XB_SPIN_CAP) { atomicAdd(&bar[XB_TMO], 1u); break; } }
    }
    nloc = mine > 0u ? mine : 1u; nx = cnt > 0u ? cnt : 1u;
}
__device__ __forceinline__ void xcd_barrier(const XcdBarrier& b) {
    asm volatile("s_waitcnt vmcnt(0)" ::: "memory");
    __syncthreads();
    if (b.wave == 0 && lane_now() == 0) {
        unsigned* bar = b.bar;
        __builtin_amdgcn_s_waitcnt(0);
        unsigned nloc = b.st[0], nx = b.st[1];
        if (nloc == 0u) { xcd_barrier_complete(bar, b.x, nloc, nx); b.st[0] = nloc; b.st[1] = nx; }
        const unsigned old = xb_add(&bar[XB_XSUB(b.x)], 1u);
        const unsigned gen = old / nloc;
        if (old + 1u == (gen + 1u) * nloc) {
            __builtin_amdgcn_fence(__ATOMIC_RELEASE, "agent");
            asm volatile("s_waitcnt vmcnt(0)" ::: "memory");
            const unsigned og = xb_add(&bar[XB_TOP], 1u);
            const unsigned tg = og / nx;
            if (og + 1u == (tg + 1u) * nx) xb_add(&bar[XB_TOPGEN], 1u);
            else XB_SPIN(xb_ld(&bar[XB_TOPGEN]) == tg, bar);
            __builtin_amdgcn_fence(__ATOMIC_ACQUIRE, "agent");
            xb_add(&bar[XB_XGEN(b.x)], 1u);
            asm volatile("s_waitcnt vmcnt(0)" ::: "memory");
        } else {
            XB_SPIN(xb_ld(&bar[XB_XGEN(b.x)]) == gen, bar);
            __builtin_amdgcn_fence(__ATOMIC_ACQUIRE, "agent");
            asm volatile("s_waitcnt vmcnt(0)" ::: "memory");
        }
    }
    __syncthreads();
}

struct Args {
    const float* in[20]; float* out; unsigned char* ws; int ph_lo, ph_hi, li, pad;
};
enum { I_X = 0, I_N1G, I_WIN, I_WGU, I_BG, I_GLAG, I_SLNG, I_SLNB, I_SW, I_SB, I_WBA, I_WBB, I_WOUT, I_N2G, I_WQ, I_K1, I_K2, I_PU, I_PV, I_FG };

struct Frame {
    LAS unsigned char* lds;
    int tid, lane, wave, G, bid;
};

__device__ __forceinline__ float clamp448(float v) { return __builtin_amdgcn_fmed3f(v, -448.f, 448.f); }
template <int MODE, bool F8 = false>
__device__ __forceinline__ void p0_transpose_item(const float* W, int K, int Nsrc, int Ndst, bf16_t* WT, LAS float* scr, int item, int lane, float sc8 = 1.f, int ldk = 0) {
    if (ldk == 0) ldk = K;
    const int nblk = Ndst / 32, kb = item / nblk, nb = item % nblk, k0 = 64 * kb, n0 = 32 * nb;
    const int nd = n0 + (lane & 31);
    int sc = nd; bool valid = true;
    if (MODE == 1) { if (nd < 2048) sc = nd; else if (nd < 2560) sc = nd + 16; else if (nd < 2576) sc = 2048 + (nd - 2560); else if (nd < 2816) { sc = 0; valid = false; } else sc = nd - 240; }
#pragma unroll 8
    for (int i = 0; i < 32; ++i) { const int kk = 2 * i + (lane >> 5); const float v = valid ? W[(size_t)(k0 + kk) * Nsrc + sc] : 0.f; scr[kk * 33 + (lane & 31)] = v; }
    LDS_WAIT(); asm volatile("" ::: "memory");
    if (F8) {
        const int c = lane & 3;
#pragma unroll
        for (int j = 0; j < 2; ++j) { const int n = (lane >> 2) + 16 * j; const LAS float* s = scr + (16 * c) * 33 + n; u32x4 o;
#pragma unroll
            for (int q = 0; q < 4; ++q) { int w = 0; w = __builtin_amdgcn_cvt_pk_fp8_f32(clamp448(s[(4 * q) * 33] * sc8), clamp448(s[(4 * q + 1) * 33] * sc8), w, false);
                w = __builtin_amdgcn_cvt_pk_fp8_f32(clamp448(s[(4 * q + 2) * 33] * sc8), clamp448(s[(4 * q + 3) * 33] * sc8), w, true); o[q] = (unsigned)w; }
            *(u32x4*)((unsigned char*)WT + (size_t)(n0 + n) * ldk + k0 + 16 * c) = o; }
    } else {
    const int c = lane & 7;
#pragma unroll
    for (int j = 0; j < 4; ++j) { const int n = (lane >> 3) + 8 * j; const LAS float* s = scr + (8 * c) * 33 + n;
        u32x4 o; o.x = pk2(s[0 * 33], s[1 * 33]); o.y = pk2(s[2 * 33], s[3 * 33]); o.z = pk2(s[4 * 33], s[5 * 33]); o.w = pk2(s[6 * 33], s[7 * 33]);
        *(u32x4*)(WT + (size_t)(n0 + n) * ldk + k0 + 8 * c) = o; }
    }
    LDS_WAIT(); asm volatile("" ::: "memory");
}
template <int OM, int NB>
__device__ __forceinline__ void rms_rows_to_bf16(int lane, const float* x0, size_t xstride, const float* g, bf16_t* o0, size_t ostride, unsigned* o80 = nullptr, size_t o8stride = 0, const bf16_t* add0 = nullptr, size_t addstride = 0, bf16_t* hb0 = nullptr, size_t hbstride = 0) {
    f32x4 v[NB][4]; float s[NB];
#pragma unroll
    for (int b = 0; b < NB; ++b) { const float* xr = x0 + b * xstride + 8 * lane;
#pragma unroll
        for (int j = 0; j < 2; ++j) { v[b][2 * j] = *(const f32x4*)(xr + 512 * j); v[b][2 * j + 1] = *(const f32x4*)(xr + 512 * j + 4); } }
    if (add0) {
        u32x4 ad[NB][2];
#pragma unroll
        for (int b = 0; b < NB; ++b) { const bf16_t* ar = add0 + b * addstride + 8 * lane;
#pragma unroll
            for (int j = 0; j < 2; ++j) ad[b][j] = *(const u32x4*)(ar + 512 * j); }
#pragma unroll
        for (int b = 0; b < NB; ++b)
#pragma unroll
            for (int j = 0; j < 2; ++j) { v[b][2 * j] = v[b][2 * j] + (f32x4){bflo(ad[b][j].x), bfhi(ad[b][j].x), bflo(ad[b][j].y), bfhi(ad[b][j].y)};
                v[b][2 * j + 1] = v[b][2 * j + 1] + (f32x4){bflo(ad[b][j].z), bfhi(ad[b][j].z), bflo(ad[b][j].w), bfhi(ad[b][j].w)}; }
    }
    if (hb0) {
#pragma unroll
        for (int b = 0; b < NB; ++b)
#pragma unroll
            for (int j = 0; j < 2; ++j) *(u32x4*)(hb0 + b * hbstride + 512 * j + 8 * lane) = pg8::pack8(v[b][2 * j], v[b][2 * j + 1]);
    }
#pragma unroll
    for (int b = 0; b < NB; ++b) { s[b] = 0.f;
#pragma unroll
        for (int j = 0; j < 4; ++j) s[b] += (v[b][j].x * v[b][j].x + v[b][j].y * v[b][j].y) + (v[b][j].z * v[b][j].z + v[b][j].w * v[b][j].w); }
#pragma unroll
    for (int o = 1; o < 64; o <<= 1) {
#pragma unroll
        for (int b = 0; b < NB; ++b) s[b] += __shfl_xor(s[b], o); }
    const float* gr = g + 8 * lane;
#pragma unroll
    for (int b = 0; b < NB; ++b) { const float rstd = 1.f / sqrtf(s[b] * (1.f / D) + EPS);
#pragma unroll
        for (int j = 0; j < 2; ++j) { const f32x4 y0 = v[b][2 * j] * rstd * *(const f32x4*)(gr + 512 * j), y1 = v[b][2 * j + 1] * rstd * *(const f32x4*)(gr + 512 * j + 4);
            const u32x4 o = pg8::pack8(y0, y1);
            if (OM & 1) *(u32x4*)(o0 + b * ostride + 512 * j + 8 * lane) = o;
            if (OM == 3) { u32x2 w8;
#pragma unroll
                for (int h = 0; h < 2; ++h) { int w = 0; w = __builtin_amdgcn_cvt_pk_fp8_f32(clamp448(bflo(o[2 * h]) * 16.f), clamp448(bfhi(o[2 * h]) * 16.f), w, false);
                    w = __builtin_amdgcn_cvt_pk_fp8_f32(clamp448(bflo(o[2 * h + 1]) * 16.f), clamp448(bfhi(o[2 * h + 1]) * 16.f), w, true); w8[h] = (unsigned)w; }
                *(u32x2*)(o80 + b * o8stride + 128 * j + 2 * lane) = w8; }
            if (OM == 2) { u32x2 w8; int w = 0;
                w = __builtin_amdgcn_cvt_pk_fp8_f32(clamp448(y0.x * 16.f), clamp448(y0.y * 16.f), w, false); w = __builtin_amdgcn_cvt_pk_fp8_f32(clamp448(y0.z * 16.f), clamp448(y0.w * 16.f), w, true); w8.x = (unsigned)w;
                w = 0; w = __builtin_amdgcn_cvt_pk_fp8_f32(clamp448(y1.x * 16.f), clamp448(y1.y * 16.f), w, false); w = __builtin_amdgcn_cvt_pk_fp8_f32(clamp448(y1.z * 16.f), clamp448(y1.w * 16.f), w, true); w8.y = (unsigned)w;
                *(u32x2*)(o80 + b * o8stride + 128 * j + 2 * lane) = w8; } } }
}
__device__ __forceinline__ float wave_max(float v) {
#pragma unroll
    for (int o = 1; o < 64; o <<= 1) v = fmaxf(v, __shfl_xor(v, o));
    return v;
}
template <int NB>
__device__ __forceinline__ void cvt_rows_fp8(int lane, const float* const (&src)[NB], unsigned char* const (&dst16)[NB], float* const (&scale_out)[NB]) {
    f32x4 v[NB][4]; float m[NB];
#pragma unroll
    for (int b = 0; b < NB; ++b) {
#pragma unroll
        for (int j = 0; j < 4; ++j) v[b][j] = *(const GAS f32x4*)(src[b] + 16 * lane + 4 * j); }
#pragma unroll
    for (int b = 0; b < NB; ++b) { m[b] = 0.f;
#pragma unroll
        for (int j = 0; j < 4; ++j) m[b] = fmaxf(m[b], fmaxf(fmaxf(fabsf(v[b][j].x), fabsf(v[b][j].y)), fmaxf(fabsf(v[b][j].z), fabsf(v[b][j].w)))); }
#pragma unroll
    for (int o = 1; o < 64; o <<= 1) {
#pragma unroll
        for (int b = 0; b < NB; ++b) m[b] = fmaxf(m[b], __shfl_xor(m[b], o)); }
#pragma unroll
    for (int b = 0; b < NB; ++b) { const float inv = m[b] > 0.f ? 224.f / m[b] : 0.f, sc = m[b] > 0.f ? m[b] * (1.f / 224.f) : 1.f;
        u32x4 o;
#pragma unroll
        for (int j = 0; j < 4; ++j) { int w = 0; w = __builtin_amdgcn_cvt_pk_fp8_f32(v[b][j].x * inv, v[b][j].y * inv, w, false); w = __builtin_amdgcn_cvt_pk_fp8_f32(v[b][j].z * inv, v[b][j].w * inv, w, true); o[j] = (unsigned)w; }
        *(GAS u32x4*)dst16[b] = o;
        if (lane == 0) *(GAS float*)scale_out[b] = sc; }
}
__device__ __forceinline__ unsigned fp4_code(float t) { const float a = fabsf(t);
    const unsigned c = (unsigned)(a >= 0.25f) + (unsigned)(a >= 0.75f) + (unsigned)(a >= 1.25f) + (unsigned)(a >= 1.75f) + (unsigned)(a >= 2.5f) + (unsigned)(a >= 3.5f) + (unsigned)(a >= 5.f);
    return c | (t < 0.f ? 8u : 0u); }
template <int NB, bool PERMV = false>
__device__ __forceinline__ void cvt_rows_fp4(int lane, const float* const (&src)[NB], unsigned char* const (&dst8)[NB], float* const (&scale_out)[NB]) {
    f32x4 v[NB][4]; float m[NB];
#pragma unroll
    for (int b = 0; b < NB; ++b) {
#pragma unroll
        for (int j = 0; j < 4; ++j) v[b][j] = *(const GAS f32x4*)(src[b] + 16 * lane + 4 * j); }
#pragma unroll
    for (int b = 0; b < NB; ++b) { m[b] = 0.f;
#pragma unroll
        for (int j = 0; j < 4; ++j) m[b] = fmaxf(m[b], fmaxf(fmaxf(fabsf(v[b][j].x), fabsf(v[b][j].y)), fmaxf(fabsf(v[b][j].z), fabsf(v[b][j].w)))); }
#pragma unroll
    for (int o = 1; o < 64; o <<= 1) {
#pragma unroll
        for (int b = 0; b < NB; ++b) m[b] = fmaxf(m[b], __shfl_xor(m[b], o)); }
#pragma unroll
    for (int b = 0; b < NB; ++b) { const float inv = m[b] > 0.f ? 6.f / m[b] : 0.f, sc = m[b] > 0.f ? m[b] * (1.f / 6.f) : 1.f;
        u32x2 o;
#pragma unroll
        for (int h = 0; h < 2; ++h) { unsigned w = 0;
            const f32x4 t0 = v[b][2 * h] * inv, t1 = v[b][2 * h + 1] * inv;
            w = __builtin_amdgcn_cvt_scalef32_pk_fp4_f32(w, t0.x, t0.y, 1.f, 0); w = __builtin_amdgcn_cvt_scalef32_pk_fp4_f32(w, t0.z, t0.w, 1.f, 1);
            w = __builtin_amdgcn_cvt_scalef32_pk_fp4_f32(w, t1.x, t1.y, 1.f, 2); w = __builtin_amdgcn_cvt_scalef32_pk_fp4_f32(w, t1.z, t1.w, 1.f, 3);
            o[h] = w; }
        if (PERMV) { *(GAS unsigned*)(dst8[b] + 16 * ((2 * lane) & 31) + 4 * (lane >> 4)) = o.x; *(GAS unsigned*)(dst8[b] + 16 * ((2 * lane + 1) & 31) + 4 * (lane >> 4)) = o.y; }
        else *(GAS u32x2*)dst8[b] = o;
        if (lane == 0) *(GAS float*)scale_out[b] = sc; }
}
__device__ __forceinline__ void convert_tables(const Frame& F, const Args& A, int wi, int nw) {
    unsigned char* ws = A.ws; const int gw = wi, NGW = nw;
    {
        int mc = gw;
        for (; mc + 3 * NGW < NEXP; mc += 4 * NGW) { const float* src[4]; unsigned char* dst[4]; float* sco[4];
#pragma unroll
            for (int b = 0; b < 4; ++b) { const int e = mc + b * NGW; src[b] = A.in[I_PU] + (size_t)e * D; dst[b] = ws + WS_U8 + (size_t)((e & (UNG - 1)) * (NEXP / UNG) + (e >> UNG_SH)) * 512 + 8 * F.lane; sco[b] = (float*)(ws + WS_SU) + e; }
            cvt_rows_fp4<4>(F.lane, src, dst, sco); }
        for (; mc < NEXP; mc += NGW) { const float* src[1]; unsigned char* dst[1]; float* sco[1];
            const int e = mc; src[0] = A.in[I_PU] + (size_t)e * D; dst[0] = ws + WS_U8 + (size_t)((e & (UNG - 1)) * (NEXP / UNG) + (e >> UNG_SH)) * 512 + 8 * F.lane; sco[0] = (float*)(ws + WS_SU) + e;
            cvt_rows_fp4<1>(F.lane, src, dst, sco); }
    }
    if (V_F4) {
        int mc = gw;
        for (; mc + 3 * NGW < NEXP; mc += 4 * NGW) { const float* src[4]; unsigned char* dst[4]; float* sco[4];
#pragma unroll
            for (int b = 0; b < 4; ++b) { const int e = mc + b * NGW; src[b] = A.in[I_PV] + (size_t)e * D; dst[b] = ws + WS_V8 + (size_t)e * 512; sco[b] = (float*)(ws + WS_SV) + e; }
            cvt_rows_fp4<4, true>(F.lane, src, dst, sco); }
        for (; mc < NEXP; mc += NGW) { const float* src[1]; unsigned char* dst[1]; float* sco[1];
            const int e = mc; src[0] = A.in[I_PV] + (size_t)e * D; dst[0] = ws + WS_V8 + (size_t)e * 512; sco[0] = (float*)(ws + WS_SV) + e;
            cvt_rows_fp4<1, true>(F.lane, src, dst, sco); }
    } else {
        int mc = gw;
        for (; mc + 3 * NGW < NEXP; mc += 4 * NGW) { const float* src[4]; unsigned char* dst[4]; float* sco[4];
#pragma unroll
            for (int b = 0; b < 4; ++b) { const int e = mc + b * NGW; src[b] = A.in[I_PV] + (size_t)e * D; dst[b] = ws + WS_V8 + ((size_t)(F.lane >> 3) * NEXP + e) * 128 + 16 * (F.lane & 7); sco[b] = (float*)(ws + WS_SV) + e; }
            cvt_rows_fp8<4>(F.lane, src, dst, sco); }
        for (; mc < NEXP; mc += NGW) { const float* src[1]; unsigned char* dst[1]; float* sco[1];
            const int e = mc; src[0] = A.in[I_PV] + (size_t)e * D; dst[0] = ws + WS_V8 + ((size_t)(F.lane >> 3) * NEXP + e) * 128 + 16 * (F.lane & 7); sco[0] = (float*)(ws + WS_SV) + e;
            cvt_rows_fp8<1>(F.lane, src, dst, sco); }
    }
}
__device__ __forceinline__ void phase0(const Frame& F, const Args& A) {
    unsigned char* ws = A.ws;
    if (!SC_F8) {
        const int l = F.lane, fr = l & 15, q = l >> 4;
        bf16_t* WQF = (bf16_t*)(ws + WS_WQF);
        for (int it = F.bid * NWAVES + F.wave; it < 2048; it += F.G * NWAVES) {
            const int kh = it & 1, kt = (it >> 1) & 63, hh = it >> 7;
            const float* kX = (hh & 1) ? A.in[I_K2] : A.in[I_K1];
            const float* ap = A.in[I_WQ] + (size_t)(kt * 16 + fr) * 2048 + hh * 128 + 4 * q;
            f32x4 a[8];
#pragma unroll
            for (int t = 0; t < 8; ++t) a[t] = *(const f32x4*)(ap + 16 * t);
#pragma unroll
            for (int kb = 0; kb < 4; ++kb) { const int key0 = kh * 64 + kb * 16;
                const float* bp = kX + (size_t)(key0 + fr) * 128 + 4 * q;
                f32x4 b[8];
#pragma unroll
                for (int t = 0; t < 8; ++t) b[t] = *(const f32x4*)(bp + 16 * t);
                f32x4 d = {0.f, 0.f, 0.f, 0.f};
#pragma unroll
                for (int t = 0; t < 8; ++t)
#pragma unroll
                    for (int c = 0; c < 4; ++c) d = __builtin_amdgcn_mfma_f32_16x16x4f32(a[t][c], b[t][c], d, 0, 0, 0);
                u32x2 o; o.x = pk2(d[0], d[1]); o.y = pk2(d[2], d[3]);
                *(u32x2*)(WQF + (size_t)(hh * 128 + key0 + fr) * 1024 + kt * 16 + 4 * q) = o; }
        }
    } else {
        LAS float* kx = (LAS float*)F.lds;
        LAS float* wt = (LAS float*)(F.lds + 128 * 129 * 4);
        bf16_t* WQF = (bf16_t*)(ws + WS_WQF);
        for (int it = F.bid; it < 512; it += F.G) {
            const int hh = it >> 5, kblk = it & 31, k0 = kblk * 32;
            const float* kX = (hh & 1) ? A.in[I_K2] : A.in[I_K1];
            __syncthreads();
            for (int e = F.tid; e < 128 * 128; e += 512) kx[(e >> 7) * 129 + (e & 127)] = kX[e];
            for (int e = F.tid; e < 32 * 128; e += 512) wt[e] = A.in[I_WQ][(size_t)(k0 + (e >> 7)) * 2048 + hh * 128 + (e & 127)];
            __syncthreads();
            const int key = F.tid & 127, kq = F.tid >> 7;
            float acc[8];
#pragma unroll
            for (int i = 0; i < 8; ++i) acc[i] = 0.f;
            for (int d = 0; d < 128; ++d) { const float b = kx[key * 129 + d];
#pragma unroll
                for (int i = 0; i < 8; ++i) acc[i] += wt[(kq * 8 + i) * 128 + d] * b; }
            if (SC_F8) { u32x2 o;
#pragma unroll
                for (int h2 = 0; h2 < 2; ++h2) { int w = 0; w = __builtin_amdgcn_cvt_pk_fp8_f32(clamp448(acc[4 * h2] * 1024.f), clamp448(acc[4 * h2 + 1] * 1024.f), w, false);
                    w = __builtin_amdgcn_cvt_pk_fp8_f32(clamp448(acc[4 * h2 + 2] * 1024.f), clamp448(acc[4 * h2 + 3] * 1024.f), w, true); o[h2] = (unsigned)w; }
                *(u32x2*)((unsigned char*)WQF + (size_t)(hh * 128 + key) * 1024 + k0 + kq * 8) = o;
            } else {
            u32x4 o; o.x = pk2(acc[0], acc[1]); o.y = pk2(acc[2], acc[3]); o.z = pk2(acc[4], acc[5]); o.w = pk2(acc[6], acc[7]);
            *(u32x4*)(WQF + (size_t)(hh * 128 + key) * 1024 + k0 + kq * 8) = o; }
        }
        __syncthreads();
    }
    LAS float* scr = (LAS float*)(F.lds + F.wave * 16384);
    const int gw = F.bid * NWAVES + F.wave, NGW = F.G * NWAVES;
    constexpr int I_IN = 16 * (NPROJ / 32), I_A = 8 * 32, I_B = 8 * 32, I_O = 16 * 32;
    constexpr int NITEMS = I_IN + I_A + I_B + I_O;
    for (int it = gw; it < NITEMS; it += NGW) {
        int r = it;
        if (r < I_IN) { if ((r % (NPROJ / 32)) * 32 >= F8_LO * 256) p0_transpose_item<1, true>(A.in[I_WIN], 1024, 5136, NPROJ, (bf16_t*)(ws + WS_W8), scr, r, F.lane, 1024.f);
                        else p0_transpose_item<1, false>(A.in[I_WIN], 1024, 5136, NPROJ, (bf16_t*)(ws + WS_WIN), scr, r, F.lane); continue; } r -= I_IN;
        if (r < I_A) { p0_transpose_item<0>(A.in[I_WBA], 512, 1024, 1024, (bf16_t*)(ws + WS_WA), scr, r, F.lane, 1.f, 1024); continue; } r -= I_A;
        if (r < I_B) { p0_transpose_item<0>(A.in[I_WBB], 512, 1024, 1024, (bf16_t*)(ws + WS_WA) + 512, scr, r, F.lane, 1.f, 1024); continue; } r -= I_B;
        p0_transpose_item<0>(A.in[I_WOUT], 1024, 1024, 1024, (bf16_t*)(ws + WS_WOUT), scr, r, F.lane);
    }
    constexpr int OM1 = F8_LO <= 0 ? 2 : (F8_LO >= 21 ? 1 : 3);
    { int m = gw; for (; m + 3 * NGW < T_TOK; m += 4 * NGW) rms_rows_to_bf16<OM1, 4>(F.lane, A.in[I_X] + (size_t)m * D, (size_t)NGW * D, A.in[I_N1G], (bf16_t*)(ws + WS_N1) + (size_t)m * D, (size_t)NGW * D, (unsigned*)(ws + WS_N18) + (size_t)m * 256, (size_t)NGW * 256);
      for (; m < T_TOK; m += NGW) rms_rows_to_bf16<OM1, 1>(F.lane, A.in[I_X] + (size_t)m * D, 0, A.in[I_N1G], (bf16_t*)(ws + WS_N1) + (size_t)m * D, 0, (unsigned*)(ws + WS_N18) + (size_t)m * 256, 0); }
}

__device__ __forceinline__ float log_sigmoid(float z) { return fminf(z, 0.f) - log1pf(__expf(-fabsf(z))); }

template <bool DRY>
__device__ __forceinline__ void gla_chunk_phase(const Frame& F, const Args& A) {
    unsigned char* ws = A.ws;
    const bf16_t* P = (const bf16_t*)(ws + WS_P);
    const float* ALR = (const float*)(ws + WS_ALR);
    LAS float* alr = (LAS float*)F.lds;
    LAS float* tot = (LAS float*)(F.lds + 4096);
    LAS bf16_t* kdT = (LAS bf16_t*)(F.lds + 8192);
    LAS bf16_t* vT = (LAS bf16_t*)(F.lds + 26624);
    LAS bf16_t* stT = (LAS bf16_t*)(F.lds + 45056);
    const int tid = F.tid, kk = tid & 127, seg = tid >> 7;
    const bool hconst = (F.G & 3) == 0;
    int hcur = -1; float w[16]; float bias = 0.f;
#pragma unroll
    for (int j = 0; j < 16; ++j) w[j] = 0.f;
    float na0, na1; bf16_t nk[16], nv[16];
#define GC_LOAD(unit) do { const int h_ = (unit) & 3, c_ = ((unit) >> 2) & 63, b_ = (unit) >> 8; const int t0_ = b_ * SEQ + c_ * 64; \
        na0 = ALR[(size_t)t0_ * 16 + tid]; na1 = ALR[(size_t)t0_ * 16 + 512 + tid]; \
        const bf16_t* kp_ = P + (size_t)(t0_ + 16 * seg) * PLD + PC_K + h_ * 128 + kk; const bf16_t* vp_ = P + (size_t)(t0_ + 16 * seg) * PLD + PC_V + h_ * 128 + kk; \
        _Pragma("unroll") for (int i_ = 0; i_ < 16; ++i_) { nk[i_] = kp_[(size_t)i_ * PLD]; nv[i_] = vp_[(size_t)i_ * PLD]; } } while (0)
    int unit = F.bid;
    if (unit < 2048) GC_LOAD(unit);
    for (; unit < 2048; unit += F.G) {
        const int h = unit & 3;
        if (h != hcur) { hcur = h;
#pragma unroll
            for (int j = 0; j < 16; ++j) w[j] = A.in[I_WGU][(size_t)j * 512 + h * 128 + kk];
            bias = A.in[I_BG][h * 128 + kk]; }
        __syncthreads();
        alr[tid] = na0; alr[512 + tid] = na1;
        bf16_t kr[16], vr[16];
#pragma unroll
        for (int i = 0; i < 16; ++i) { kr[i] = nk[i]; vr[i] = nv[i]; }
        if (unit + F.G < 2048) GC_LOAD(unit + F.G);
        __syncthreads();
        float cum[16]; float run = 0.f;
#pragma unroll
        for (int i = 0; i < 16; ++i) { const LAS f32x4* ap = (const LAS f32x4*)(alr + (16 * seg + i) * 16); float z = bias;
#pragma unroll
            for (int q = 0; q < 4; ++q) { const f32x4 a4 = ap[q]; z += a4.x * w[4 * q] + a4.y * w[4 * q + 1] + a4.z * w[4 * q + 2] + a4.w * w[4 * q + 3]; }
            const float ls = fminf(z, 0.f) - __logf(1.f + __expf(-fabsf(z)));
            run += ls * (1.f / 16.f); cum[i] = run; }
        tot[seg * 128 + kk] = run;
        __syncthreads();
        {
            const float t0s = tot[kk], t1s = tot[128 + kk], t2s = tot[256 + kk], t3s = tot[384 + kk];
            const float total = (t0s + t1s) + (t2s + t3s);
            const float prefix = seg == 0 ? 0.f : (seg == 1 ? t0s : (seg == 2 ? t0s + t1s : t0s + t1s + t2s));
            unsigned kw[8], vw[8];
#pragma unroll
            for (int i = 0; i < 8; ++i) {
                const float e0 = __expf(total - (prefix + cum[2 * i])), e1 = __expf(total - (prefix + cum[2 * i + 1]));
                kw[i] = pk2(bf1(kr[2 * i]) * e0, bf1(kr[2 * i + 1]) * e1); vw[i] = (unsigned)vr[2 * i] | ((unsigned)vr[2 * i + 1] << 16);
            }
            *(LAS u32x4*)(kdT + kk * 72 + 16 * seg) = (u32x4){kw[0], kw[1], kw[2], kw[3]}; *(LAS u32x4*)(kdT + kk * 72 + 16 * seg + 8) = (u32x4){kw[4], kw[5], kw[6], kw[7]};
            *(LAS u32x4*)(vT + kk * 72 + 16 * seg) = (u32x4){vw[0], vw[1], vw[2], vw[3]}; *(LAS u32x4*)(vT + kk * 72 + 16 * seg + 8) = (u32x4){vw[4], vw[5], vw[6], vw[7]};
            if (seg == 0) ((float*)(DRY ? (unsigned char*)A.out + 96 * MiB : ws + WS_DEC))[(size_t)unit * 128 + kk] = __expf(total);
        }
        __syncthreads();
        {
            const int w8 = F.wave, l = F.lane, fr = l & 15, fq = l >> 4;
            f32x4 acc[8];
#pragma unroll
            for (int n = 0; n < 8; ++n) acc[n] = (f32x4){0.f, 0.f, 0.f, 0.f};
#pragma unroll
            for (int ks = 0; ks < 2; ++ks) {
                const bf16x8 a = *(const LAS bf16x8*)(kdT + (16 * w8 + fr) * 72 + 32 * ks + 8 * fq);
#pragma unroll
                for (int n = 0; n < 8; ++n) { const bf16x8 bb = *(const LAS bf16x8*)(vT + (16 * n + fr) * 72 + 32 * ks + 8 * fq);
                    acc[n] = __builtin_amdgcn_mfma_f32_16x16x32_bf16(a, bb, acc[n], 0, 0, 0); }
            }
#pragma unroll
            for (int n = 0; n < 8; ++n) { u32x2 o; o.x = pk2(acc[n][0], acc[n][1]); o.y = pk2(acc[n][2], acc[n][3]);
                *(LAS u32x2*)(stT + (16 * n + fr) * 136 + 16 * w8 + 4 * fq) = o; }
        }
        __syncthreads();
        {
            bf16_t* ST = (bf16_t*)(DRY ? (unsigned char*)A.out : ws + WS_N1) + (size_t)unit * 16384;
            const int vv = tid >> 2, part = tid & 3;
#pragma unroll
            for (int q = 0; q < 4; ++q) *(u32x4*)(ST + (size_t)vv * 128 + 32 * part + 8 * q) = *(const LAS u32x4*)(stT + vv * 136 + 32 * part + 8 * q);
        }
    }
#undef GC_LOAD
    (void)hconst;
}

template <bool DRY>
__device__ __forceinline__ void sgu_unit(const Frame& F, const Args& A, int unit, bool stats) {
    const int g = unit & 3, blk = (unit >> 2) & 31, b = unit >> 7;
    const int t0 = b * SEQ + blk * 128;
    bf16_t* P = (bf16_t*)(A.ws + WS_P);
    LAS bf16_t* wA = (LAS bf16_t*)F.lds;
    LAS bf16_t* vnT = (LAS bf16_t*)(F.lds + 34816);
    LAS float* st = (LAS float*)(F.lds + 69632);
    LAS bf16_t* suS = (LAS bf16_t*)(F.lds + 70656);
    const int tid = F.tid;
    __syncthreads();
    if (stats) {
        const int j = tid >> 2, q = tid & 3;
        const bf16_t* sp = P + (size_t)(t0 + j) * PLD + PC_SV + q * 128;
        float s = 0.f, s2 = 0.f;
#pragma unroll
        for (int i = 0; i < 16; ++i) { const u32x4 w = *(const u32x4*)(sp + 8 * i);
            const float f[8] = {bflo(w.x), bfhi(w.x), bflo(w.y), bfhi(w.y), bflo(w.z), bfhi(w.z), bflo(w.w), bfhi(w.w)};
#pragma unroll
            for (int e = 0; e < 8; ++e) { s += f[e]; s2 += f[e] * f[e]; } }
        s += __shfl_xor(s, 1); s += __shfl_xor(s, 2); s2 += __shfl_xor(s2, 1); s2 += __shfl_xor(s2, 2);
        const float mu = s * (1.f / 512.f); const float var = fmaxf(s2 * (1.f / 512.f) - mu * mu, 0.f);
        if (q == 0) { st[2 * j] = mu; st[2 * j + 1] = 1.f / sqrtf(var + EPS); }
    }
    {
        const int i = tid >> 2, jb = (tid & 3) * 32;
        const float* wp = A.in[I_SW] + (size_t)g * 16384 + (size_t)i * 128 + jb;
        const bf16_t* sup = P + (size_t)(t0 + i) * PLD + PC_SU + g * 128 + jb;
#pragma unroll
        for (int q = 0; q < 4; ++q) { const f32x4 a = *(const f32x4*)(wp + 8 * q), bq = *(const f32x4*)(wp + 8 * q + 4);
            const bool z = (i < 64) && (jb + 8 * q >= 64);
            u32x4 o; o.x = pk2(a.x, a.y); o.y = pk2(a.z, a.w); o.z = pk2(bq.x, bq.y); o.w = pk2(bq.z, bq.w);
            if (z) o = (u32x4){0u, 0u, 0u, 0u};
            *(LAS u32x4*)(wA + i * 136 + jb + 8 * q) = o;
            *(LAS u32x4*)(suS + i * 136 + jb + 8 * q) = *(const u32x4*)(sup + 8 * q); }
    }
    const int cch = tid & 127, seg = tid >> 7;
    bf16_t xr[32];
    { const bf16_t* sp = P + (size_t)(t0 + 32 * seg) * PLD + PC_SV + g * 128 + cch;
#pragma unroll
      for (int i = 0; i < 32; ++i) xr[i] = sp[(size_t)i * PLD]; }
    const float lg = A.in[I_SLNG][g * 128 + cch], lb = A.in[I_SLNB][g * 128 + cch];
    __syncthreads();
    {
        unsigned ow[16];
#pragma unroll
        for (int i = 0; i < 16; ++i) { const int j = 32 * seg + 2 * i; const f32x4 ms = *(const LAS f32x4*)(st + 2 * j);
            ow[i] = pk2((bf1(xr[2 * i]) - ms.x) * ms.y * lg + lb, (bf1(xr[2 * i + 1]) - ms.z) * ms.w * lg + lb); }
#pragma unroll
        for (int q = 0; q < 4; ++q) *(LAS u32x4*)(vnT + cch * 136 + 32 * seg + 8 * q) = (u32x4){ow[4 * q], ow[4 * q + 1], ow[4 * q + 2], ow[4 * q + 3]};
    }
    __syncthreads();
    {
        const int w = F.wave, l = F.lane, fr = l & 15, fq = l >> 4;
        f32x4 acc[8];
#pragma unroll
        for (int n = 0; n < 8; ++n) acc[n] = (f32x4){0.f, 0.f, 0.f, 0.f};
#pragma unroll
        for (int ks = 0; ks < 4; ++ks) {
            const bf16x8 a = *(const LAS bf16x8*)(wA + (16 * w + fr) * 136 + 32 * ks + 8 * fq);
#pragma unroll
            for (int n = 0; n < 8; ++n) { const bf16x8 bb = *(const LAS bf16x8*)(vnT + (16 * n + fr) * 136 + 32 * ks + 8 * fq);
                acc[n] = __builtin_amdgcn_mfma_f32_16x16x32_bf16(a, bb, acc[n], 0, 0, 0); }
        }
#pragma unroll
        for (int jj = 0; jj < 4; ++jj) { const int i = 16 * w + 4 * fq + jj; const float bias = A.in[I_SB][g * 128 + i];
            LAS bf16_t* rp = suS + i * 136 + fr;
#pragma unroll
            for (int n = 0; n < 8; ++n) { const float su = bf1(rp[16 * n]); rp[16 * n] = (bf16_t)f2bf(su * (acc[n][jj] + bias)); } }
    }
    __syncthreads();
    {
        const int i = tid >> 2, jb = (tid & 3) * 32;
        bf16_t* yp = DRY ? (bf16_t*)A.out + (size_t)(t0 + i) * 512 + g * 128 + jb : P + (size_t)(t0 + i) * PLD + PC_SU + g * 128 + jb;
#pragma unroll
        for (int q = 0; q < 4; ++q) *(u32x4*)(yp + 8 * q) = *(const LAS u32x4*)(suS + i * 136 + jb + 8 * q);
    }
}

template <bool DRY>
__device__ __forceinline__ void gla_scan(const Frame& F, const Args& A) {
    bf16_t* ST = (bf16_t*)(A.ws + WS_N1); bf16_t* STO = DRY ? (bf16_t*)A.out : ST; const float* DEC = (const float*)(A.ws + WS_DEC);
    for (int gi = F.bid * 512 + F.tid; gi < 131072; gi += F.G * 512) {
        const int k4 = gi & 31, vv = (gi >> 5) & 127, h = (gi >> 12) & 3, b = gi >> 14;
        float s0 = 0.f, s1 = 0.f, s2 = 0.f, s3 = 0.f;
        u32x2 wa[8], wb[8]; f32x4 da[8], db[8];
#define SCAN_LOAD(W, Dd, c0) do { _Pragma("unroll") for (int i_ = 0; i_ < 8; ++i_) { const size_t u_ = (size_t)((b * 64 + (c0) + i_) * 4 + h); \
            W[i_] = *(const u32x2*)(ST + u_ * 16384 + (size_t)vv * 128 + k4 * 4); Dd[i_] = *(const f32x4*)(DEC + u_ * 128 + k4 * 4); } } while (0)
#define SCAN_STEP(W, Dd, c0) do { _Pragma("unroll") for (int i_ = 0; i_ < 8; ++i_) { const size_t u_ = (size_t)((b * 64 + (c0) + i_) * 4 + h); \
            s0 = Dd[i_].x * s0 + bflo(W[i_].x); s1 = Dd[i_].y * s1 + bfhi(W[i_].x); s2 = Dd[i_].z * s2 + bflo(W[i_].y); s3 = Dd[i_].w * s3 + bfhi(W[i_].y); \
            u32x2 o_; o_.x = pk2(s0, s1); o_.y = pk2(s2, s3); *(u32x2*)(STO + u_ * 16384 + (size_t)vv * 128 + k4 * 4) = o_; } } while (0)
        SCAN_LOAD(wa, da, 0);
#pragma unroll
        for (int c0 = 0; c0 < 64; c0 += 16) {
            SCAN_LOAD(wb, db, c0 + 8);
            SCAN_STEP(wa, da, c0);
            if (c0 + 16 < 64) SCAN_LOAD(wa, da, c0 + 16);
            SCAN_STEP(wb, db, c0 + 8);
        }
#undef SCAN_LOAD
#undef SCAN_STEP
    }
}

template <bool DRY>
__device__ __forceinline__ void gla_out_phase(const Frame& F, const Args& A) {
    bf16_t* P = (bf16_t*)(A.ws + WS_P);
    LAS bf16_t* qA = (LAS bf16_t*)F.lds;
    LAS bf16_t* sB = (LAS bf16_t*)(F.lds + 17408);
    LAS float* oF = (LAS float*)(F.lds + 52224);
    const int tid = F.tid, s = tid >> 3, cb = (tid & 7) * 16, vv = tid >> 2, kb = (tid & 3) * 32;
    u32x4 nq0, nq1, ns0, ns1, ns2, ns3, nr0, nr1;
#define GO_LOAD(unit) do { const int h_ = (unit) & 3, c_ = ((unit) >> 2) & 63, b_ = (unit) >> 8; const int t0_ = b_ * SEQ + c_ * 64; \
        const bf16_t* qp_ = P + (size_t)(t0_ + s) * PLD + PC_Q + h_ * 128 + cb; nq0 = *(const u32x4*)qp_; nq1 = *(const u32x4*)(qp_ + 8); \
        const bf16_t* sp_ = (const bf16_t*)(A.ws + WS_N1) + (size_t)(unit) * 16384 + (size_t)vv * 128 + kb; ns0 = *(const u32x4*)sp_; ns1 = *(const u32x4*)(sp_ + 8); ns2 = *(const u32x4*)(sp_ + 16); ns3 = *(const u32x4*)(sp_ + 24); \
        const bf16_t* rp_ = P + (size_t)(t0_ + s) * PLD + PC_R + h_ * 128 + cb; nr0 = *(const u32x4*)rp_; nr1 = *(const u32x4*)(rp_ + 8); } while (0)
    int unit = F.bid;
    if (unit < 2048) GO_LOAD(unit);
    for (; unit < 2048; unit += F.G) {
        const int h = unit & 3, c = (unit >> 2) & 63, b = unit >> 8;
        const int t0 = b * SEQ + c * 64;
        __syncthreads();
        *(LAS u32x4*)(qA + s * 136 + cb) = nq0; *(LAS u32x4*)(qA + s * 136 + cb + 8) = nq1;
        *(LAS u32x4*)(sB + vv * 136 + kb) = ns0; *(LAS u32x4*)(sB + vv * 136 + kb + 8) = ns1; *(LAS u32x4*)(sB + vv * 136 + kb + 16) = ns2; *(LAS u32x4*)(sB + vv * 136 + kb + 24) = ns3;
        const u32x4 r0 = nr0, r1 = nr1;
        if (unit + F.G < 2048) GO_LOAD(unit + F.G);
        __syncthreads();
        {
            const int w = F.wave, l = F.lane, fr = l & 15, fq = l >> 4, m = w & 3, nh = w >> 2;
            f32x4 acc[4];
#pragma unroll
            for (int n = 0; n < 4; ++n) acc[n] = (f32x4){0.f, 0.f, 0.f, 0.f};
#pragma unroll
            for (int ks = 0; ks < 4; ++ks) {
                const bf16x8 a = *(const LAS bf16x8*)(qA + (16 * m + fr) * 136 + 32 * ks + 8 * fq);
#pragma unroll
                for (int n = 0; n < 4; ++n) { const bf16x8 bb = *(const LAS bf16x8*)(sB + (16 * (4 * nh + n) + fr) * 136 + 32 * ks + 8 * fq);
                    acc[n] = __builtin_amdgcn_mfma_f32_16x16x32_bf16(a, bb, acc[n], 0, 0, 0); }
            }
            const float scale = 0.08838834764831845f;
#pragma unroll
            for (int n = 0; n < 4; ++n)
#pragma unroll
                for (int jj = 0; jj < 4; ++jj) oF[(16 * m + 4 * fq + jj) * 132 + 16 * (4 * nh + n) + fr] = acc[n][jj] * scale;
        }
        __syncthreads();
        {
            float o[16]; float ss = 0.f;
#pragma unroll
            for (int i = 0; i < 16; ++i) { o[i] = oF[s * 132 + cb + i]; ss += o[i] * o[i]; }
            ss += __shfl_xor(ss, 1); ss += __shfl_xor(ss, 2); ss += __shfl_xor(ss, 4);
            const float rstd = 1.f / sqrtf(ss * (1.f / 128.f) + EPS);
            const unsigned rw[8] = {r0.x, r0.y, r0.z, r0.w, r1.x, r1.y, r1.z, r1.w};
            const float* gg = A.in[I_GLAG] + h * 128 + cb;
            unsigned ow[8];
#pragma unroll
            for (int i = 0; i < 8; ++i) { const float y0 = o[2 * i] * rstd * gg[2 * i] * siluf_(bflo(rw[i])), y1 = o[2 * i + 1] * rstd * gg[2 * i + 1] * siluf_(bfhi(rw[i])); ow[i] = pk2(y0, y1); }
            bf16_t* yp = DRY ? (bf16_t*)A.out + (size_t)(t0 + s) * 512 + h * 128 + cb : P + (size_t)(t0 + s) * PLD + PC_R + h * 128 + cb;
            *(u32x4*)yp = (u32x4){ow[0], ow[1], ow[2], ow[3]}; *(u32x4*)(yp + 8) = (u32x4){ow[4], ow[5], ow[6], ow[7]};
        }
    }
#undef GO_LOAD
}

__device__ __forceinline__ unsigned ordkey(float v) { const unsigned u = __builtin_bit_cast(unsigned, v); return u ^ ((unsigned)((int)u >> 31) | 0x80000000u); }
__device__ __forceinline__ float unord16(unsigned k) { const unsigned u = ((k & 0x80000000u) ? (k & 0x7fffffffu) : ~k) & 0xffff0000u; return __builtin_bit_cast(float, u); }
__device__ __forceinline__ float unord(unsigned k) { const unsigned u = (k & 0x80000000u) ? (k & 0x7fffffffu) : ~k; return __builtin_bit_cast(float, u); }
#define INS16(r, xin) do { unsigned _x = (xin); _Pragma("unroll") for (int _i = 0; _i < 16; ++_i) { const unsigned _h = max((r)[_i], _x); _x = min((r)[_i], _x); (r)[_i] = _h; } } while (0)

#define CE(a, b) do { const unsigned _h = max((a), (b)), _l = min((a), (b)); (a) = _h; (b) = _l; } while (0)
#define SORT16(v) do { CE(v[0], v[1]); CE(v[2], v[3]); CE(v[0], v[2]); CE(v[1], v[3]); CE(v[1], v[2]); CE(v[4], v[5]); CE(v[6], v[7]); CE(v[4], v[6]); CE(v[5], v[7]); CE(v[5], v[6]); CE(v[0], v[4]); CE(v[2], v[6]); CE(v[2], v[4]); CE(v[1], v[5]); CE(v[3], v[7]); CE(v[3], v[5]); CE(v[1], v[2]); CE(v[3], v[4]); CE(v[5], v[6]); CE(v[8], v[9]); CE(v[10], v[11]); CE(v[8], v[10]); CE(v[9], v[11]); CE(v[9], v[10]); CE(v[12], v[13]); CE(v[14], v[15]); CE(v[12], v[14]); CE(v[13], v[15]); CE(v[13], v[14]); CE(v[8], v[12]); CE(v[10], v[14]); CE(v[10], v[12]); CE(v[9], v[13]); CE(v[11], v[15]); CE(v[11], v[13]); CE(v[9], v[10]); CE(v[11], v[12]); CE(v[13], v[14]); CE(v[0], v[8]); CE(v[4], v[12]); CE(v[4], v[8]); CE(v[2], v[10]); CE(v[6], v[14]); CE(v[6], v[10]); CE(v[2], v[4]); CE(v[6], v[8]); CE(v[10], v[12]); CE(v[1], v[9]); CE(v[5], v[13]); CE(v[5], v[9]); CE(v[3], v[11]); CE(v[7], v[15]); CE(v[7], v[11]); CE(v[3], v[5]); CE(v[7], v[9]); CE(v[11], v[13]); CE(v[1], v[2]); CE(v[3], v[4]); CE(v[5], v[6]); CE(v[7], v[8]); CE(v[9], v[10]); CE(v[11], v[12]); CE(v[13], v[14]); } while (0)
#define MERGE16(T, S) do { _Pragma("unroll") for (int _i = 0; _i < 16; ++_i) (T)[_i] = max((T)[_i], (S)[15 - _i]); \
    _Pragma("unroll") for (int _d = 8; _d >= 1; _d >>= 1) { _Pragma("unroll") for (int _i = 0; _i < 16; ++_i) if ((_i & _d) == 0) CE((T)[_i], (T)[_i + _d]); } } while (0)
__device__ __forceinline__ void peer_topk(const Frame& F, const Args& A) {
    const bf16_t* SC = (const bf16_t*)(A.ws + WS_P + P_SC);
    int* IDX = (int*)(A.ws + WS_P + P_IDX); float* GATE = (float*)(A.ws + WS_P + P_GATE);
    const int gw = F.bid * NWAVES + F.wave, NGW = F.G * NWAVES;
    for (int it = gw; it < 512 * 8; it += NGW) {
        const int h = it & 7, tb = it >> 3; const int tok = tb * 64 + F.lane;
        unsigned r1[16], r2[16], rc[16];
        const bf16_t* p1 = SC + ((size_t)(tok >> 4) * 256 + h * 32) * 128 + (tok & 15) * 8; const bf16_t* p2 = p1 + 16 * 128;
        {
            unsigned raw[128]; unsigned sg[16];
#pragma unroll
            for (int jq = 0; jq < 16; ++jq) { const u32x4 t4 = *(const u32x4*)(p1 + jq * 128);
#pragma unroll
                for (int c = 0; c < 4; ++c) { raw[8 * jq + 2 * c] = t4[c] << 16; raw[8 * jq + 2 * c + 1] = t4[c] & 0xffff0000u; } }
#pragma unroll
            for (int j = 0; j < 16; ++j) r1[j] = raw[j] | (unsigned)(127 - j);
            SORT16(r1);
#pragma unroll
            for (int gq = 1; gq < 8; ++gq) {
#pragma unroll
                for (int j = 0; j < 16; ++j) sg[j] = raw[16 * gq + j] | (unsigned)(127 - (16 * gq + j));
                SORT16(sg); MERGE16(r1, sg); }
#pragma unroll
            for (int jq = 0; jq < 16; ++jq) { const u32x4 t4 = *(const u32x4*)(p2 + jq * 128);
#pragma unroll
                for (int c = 0; c < 4; ++c) { raw[8 * jq + 2 * c] = t4[c] << 16; raw[8 * jq + 2 * c + 1] = t4[c] & 0xffff0000u; } }
#pragma unroll
            for (int j = 0; j < 16; ++j) r2[j] = raw[j] | (unsigned)(127 - j);
            SORT16(r2);
#pragma unroll
            for (int gq = 1; gq < 8; ++gq) {
#pragma unroll
                for (int j = 0; j < 16; ++j) sg[j] = raw[16 * gq + j] | (unsigned)(127 - (16 * gq + j));
                SORT16(sg); MERGE16(r2, sg); }
        }
        float v1[16], v2[16];
#pragma unroll
        for (int i = 0; i < 16; ++i) { v1[i] = unord16(r1[i]); v2[i] = unord16(r2[i]); }
        {
            unsigned cg[4][16]; int cn = 0;
#pragma unroll
            for (int a = 0; a < 16; ++a)
#pragma unroll
                for (int bq = 0; bq < 16; ++bq) if ((a + 1) * (bq + 1) <= 16) { cg[cn >> 4][cn & 15] = (ordkey(v1[a] + v2[bq]) & ~255u) | (unsigned)(a * 16 + bq); ++cn; }
#pragma unroll
            for (int z = 50; z < 64; ++z) cg[z >> 4][z & 15] = 0u;
            SORT16(cg[0]); SORT16(cg[1]); SORT16(cg[2]); SORT16(cg[3]);
            MERGE16(cg[0], cg[1]); MERGE16(cg[0], cg[2]); MERGE16(cg[0], cg[3]);
#pragma unroll
            for (int i = 0; i < 16; ++i) rc[i] = cg[0][i];
        }
        float val[16]; int ex[16];
        {
            LAS unsigned* t1 = (LAS unsigned*)(F.lds + F.wave * 8704) + F.lane * 17; LAS unsigned* t2 = t1 + 64 * 17;
#pragma unroll
            for (int i = 0; i < 16; ++i) { t1[i] = r1[i]; t2[i] = r2[i]; }
            LDS_WAIT(); asm volatile("" ::: "memory");
#pragma unroll
            for (int w = 0; w < 16; ++w) {
                const int a = (rc[w] >> 4) & 15, bq = rc[w] & 15;
                const unsigned k1 = t1[a], k2 = t2[bq];
                val[w] = unord16(k1) + unord16(k2);
                ex[w] = (127 - (int)(k1 & 127u)) * 128 + (127 - (int)(k2 & 127u));
            }
            LDS_WAIT(); asm volatile("" ::: "memory");
        }
        float mx = val[0];
#pragma unroll
        for (int w = 1; w < 16; ++w) mx = fmaxf(mx, val[w]);
        float sum = 0.f;
#pragma unroll
        for (int w = 0; w < 16; ++w) { val[w] = __expf(val[w] - mx); sum += val[w]; }
        const float inv = 1.f / sum;
        int* ip = IDX + (size_t)tok * 128 + h * 16; float* gp = GATE + (size_t)tok * 128 + h * 16;
#pragma unroll
        for (int q = 0; q < 4; ++q) { *(int4*)(ip + 4 * q) = make_int4(ex[4 * q], ex[4 * q + 1], ex[4 * q + 2], ex[4 * q + 3]);
            *(f32x4*)(gp + 4 * q) = (f32x4){val[4 * q] * inv, val[4 * q + 1] * inv, val[4 * q + 2] * inv, val[4 * q + 3] * inv}; }
    }
}

#define DPP_ADD(v, ctrl) ((v) + __builtin_bit_cast(float, __builtin_amdgcn_mov_dpp(__builtin_bit_cast(int, (v)), (ctrl), 0xf, 0xf, true)))
__device__ __forceinline__ void fp8x16_to_f32x2(const u32x4 r, f32x2* f) {
#pragma unroll
    for (int q = 0; q < 4; ++q) { f[2 * q] = __builtin_amdgcn_cvt_pk_f32_fp8((int)r[q], false); f[2 * q + 1] = __builtin_amdgcn_cvt_pk_f32_fp8((int)r[q], true); }
}
__device__ __forceinline__ void fp8x16_to_f32(const u32x4 r, float* f) {
#pragma unroll
    for (int q = 0; q < 4; ++q) { const f32x2 lo = __builtin_amdgcn_cvt_pk_f32_fp8((int)r[q], false), hi = __builtin_amdgcn_cvt_pk_f32_fp8((int)r[q], true);
        f[4 * q] = lo.x; f[4 * q + 1] = lo.y; f[4 * q + 2] = hi.x; f[4 * q + 3] = hi.y; }
}
__device__ __forceinline__ long lo64(u32x4 v) { return (long)(((unsigned long)v.y << 32) | (unsigned long)v.x); }
__device__ __forceinline__ long hi64(u32x4 v) { return (long)(((unsigned long)v.w << 32) | (unsigned long)v.z); }
template <int MODE>
__device__ __forceinline__ void peer_u_phase(const Frame& F, const Args& A) {
    const unsigned char* X8 = A.ws + WS_P + P_X8;
    const unsigned char* U8 = A.ws + WS_U8; const float* SU = (const float*)(A.ws + WS_SU); const float* SV = (const float*)(A.ws + WS_SV);
    const int* IDX = (const int*)(A.ws + WS_P + P_IDX); const float* GATE = (const float*)(A.ws + WS_P + P_GATE); float* AK = (float*)(MODE == 0 ? A.ws + WS_AK : A.ws + WS_P + P_SC);
    const int g = F.bid & 7, nmem = F.G >> 3, l = F.lane, step = nmem * NWAVES;
    const int loff = 64 * (l & 15) + 16 * (l >> 4);
    const bool dg = ((l & 15) >> 2) == (l >> 4); const int dr = l & 3;
    const float dw0 = (dg && dr == 0) ? 1.f : 0.f, dw1 = (dg && dr == 1) ? 1.f : 0.f, dw2 = (dg && dr == 2) ? 1.f : 0.f, dw3 = (dg && dr == 3) ? 1.f : 0.f;
    LAS int* le = (LAS int*)(F.lds + F.wave * 2048); LAS int* lk = le + 256;
    const bool b5 = (l & 32) != 0, b4 = (l & 16) != 0, b3 = (l & 8) != 0;
    int tok = 2 * ((F.bid >> 3) * NWAVES + F.wave);
    u32x4 nxA, nxB; int neA0, neA1, neB0, neB1; float ngA0, ngA1, ngB0, ngB1;
#define U_PREFETCH(t) do { const size_t _tA = (size_t)(t), _tB = (size_t)(t) + 1; if (MODE == 4) { nxA = (u32x4){(unsigned)_tA, 1u, 2u, 3u}; nxB = nxA; neA0 = (int)((_tA * 37 + l * 11) & 16383); neA1 = (int)((_tA * 53 + l * 7) & 16383); neB0 = (int)((_tB * 37 + l * 13) & 16383); neB1 = (int)((_tB * 29 + l * 3) & 16383); ngA0 = ngA1 = ngB0 = ngB1 = 0.01f; break; } nxA = *(const u32x4*)(X8 + _tA * 1024 + loff); nxB = *(const u32x4*)(X8 + _tB * 1024 + loff); \
        neA0 = IDX[_tA * 128 + l]; neA1 = IDX[_tA * 128 + 64 + l]; neB0 = IDX[_tB * 128 + l]; neB1 = IDX[_tB * 128 + 64 + l]; \
        ngA0 = GATE[_tA * 128 + l]; ngA1 = GATE[_tA * 128 + 64 + l]; ngB0 = GATE[_tB * 128 + l]; ngB1 = GATE[_tB * 128 + 64 + l]; } while (0)
    if (tok + 1 < T_TOK) U_PREFETCH(tok);
    for (; tok + 1 < T_TOK; tok += 2 * step) {
        const int tokA = tok, tokB = tok + 1;
        const u32x4 xA = nxA, xB = nxB;
        const int eA0 = neA0, eA1 = neA1, eB0 = neB0, eB1 = neB1; const float gA0 = ngA0, gA1 = ngA1, gB0 = ngB0, gB1 = ngB1;
        bool pf_done = false;
        const bool oA0 = (eA0 & 7) == g, oA1 = (eA1 & 7) == g, oB0 = (eB0 & 7) == g, oB1 = (eB1 & 7) == g;
        const unsigned long long mA0 = __ballot(oA0), mA1 = __ballot(oA1), mB0 = __ballot(oB0), mB1 = __ballot(oB1);
        const int c0 = __popcll(mA0), c1 = c0 + __popcll(mA1), c2 = c1 + __popcll(mB0), n = c2 + __popcll(mB1);
#define MBC(m) __builtin_amdgcn_mbcnt_hi((unsigned)((m) >> 32), __builtin_amdgcn_mbcnt_lo((unsigned)(m), 0u))
        if (oA0) { const int p = MBC(mA0); le[p] = (eA0 << 8) | l; lk[p] = __builtin_bit_cast(int, gA0); }
        if (oA1) { const int p = c0 + MBC(mA1); le[p] = (eA1 << 8) | (64 + l); lk[p] = __builtin_bit_cast(int, gA1); }
        if (oB0) { const int p = c1 + MBC(mB0); le[p] = (eB0 << 8) | 128 | l; lk[p] = __builtin_bit_cast(int, gB0); }
        if (oB1) { const int p = c2 + MBC(mB1); le[p] = (eB1 << 8) | 128 | (64 + l); lk[p] = __builtin_bit_cast(int, gB1); }
#undef MBC
        LDS_WAIT(); asm volatile("" ::: "memory");
        for (int cb = 0; cb < n || cb == 0; cb += 64) {
        const int nc = min(n, cb + 64);
        const bool fv = (cb + l) < nc;
        const int ent = fv ? le[cb + l] : 0; const float gt = fv ? __builtin_bit_cast(float, lk[cb + l]) : 0.f; float tot = 0.f;
        const float su = SU[ent >> 8], sv = SV[ent >> 8];
        const unsigned long long radr = (unsigned long long)(U8 + (size_t)(((ent >> 8) & 7) * 2048 + (((ent >> 8) >> 3) & (MODE == 2 ? 255 : 2047))) * 1024);
        const int ralo = (int)(unsigned)radr, rahi = (int)(unsigned)(radr >> 32);
        for (int i = cb; i < nc; i += 16) {
            u32x4 row[2][8];
#pragma unroll
            for (int b = 0; b < 2; ++b) if (i + 8 * b < nc) {
#pragma unroll
                for (int j = 0; j < 8; ++j) { const int ln = min(i + 8 * b + j, nc - 1) - cb;
                    const unsigned lo = (unsigned)__builtin_amdgcn_readlane(ralo, ln), hi = (unsigned)__builtin_amdgcn_readlane(rahi, ln);
                    const GAS unsigned char* rp = (const GAS unsigned char*)(((unsigned long long)hi << 32) | lo);
                    row[b][j] = *(const GAS u32x4*)(rp + (unsigned)loff); } }
            if (!pf_done) { pf_done = true; if (tok + 2 * step + 1 < T_TOK) U_PREFETCH(tok + 2 * step); }
#pragma unroll
            for (int b = 0; b < 2; ++b) if (i + 8 * b < nc) {
                float p[8];
                f32x4 accj[8];
                const int base0 = i + 8 * b;
                if (base0 + 8 <= c1) {
#pragma unroll
                    for (int j = 0; j < 8; ++j) accj[j] = __builtin_amdgcn_mfma_f32_16x16x32_fp8_fp8(lo64(row[b][j]), lo64(xA), (f32x4){0.f, 0.f, 0.f, 0.f}, 0, 0, 0);
#pragma unroll
                    for (int j = 0; j < 8; ++j) accj[j] = __builtin_amdgcn_mfma_f32_16x16x32_fp8_fp8(hi64(row[b][j]), hi64(xA), accj[j], 0, 0, 0);
                } else if (base0 >= c1) {
#pragma unroll
                    for (int j = 0; j < 8; ++j) accj[j] = __builtin_amdgcn_mfma_f32_16x16x32_fp8_fp8(lo64(row[b][j]), lo64(xB), (f32x4){0.f, 0.f, 0.f, 0.f}, 0, 0, 0);
#pragma unroll
                    for (int j = 0; j < 8; ++j) accj[j] = __builtin_amdgcn_mfma_f32_16x16x32_fp8_fp8(hi64(row[b][j]), hi64(xB), accj[j], 0, 0, 0);
                } else {
#pragma unroll
                    for (int j = 0; j < 8; ++j) { const u32x4 xs = (base0 + j >= c1) ? xB : xA; accj[j] = __builtin_amdgcn_mfma_f32_16x16x32_fp8_fp8(lo64(row[b][j]), lo64(xs), (f32x4){0.f, 0.f, 0.f, 0.f}, 0, 0, 0);
                        accj[j] = __builtin_amdgcn_mfma_f32_16x16x32_fp8_fp8(hi64(row[b][j]), hi64(xs), accj[j], 0, 0, 0); }
                }
#pragma unroll
                for (int j = 0; j < 8; ++j) p[j] = __builtin_fmaf(accj[j][3], dw3, __builtin_fmaf(accj[j][2], dw2, __builtin_fmaf(accj[j][1], dw1, accj[j][0] * dw0)));
                float q4[4], q2[2], q1;
#pragma unroll
                for (int j = 0; j < 4; ++j) { const float keep = b5 ? p[4 + j] : p[j], send = b5 ? p[j] : p[4 + j]; q4[j] = keep + __shfl_xor(send, 32); }
#pragma unroll
                for (int j = 0; j < 2; ++j) { const float keep = b4 ? q4[2 + j] : q4[j], send = b4 ? q4[j] : q4[2 + j]; q2[j] = keep + __shfl_xor(send, 16); }
                { const float keep = b3 ? q2[1] : q2[0], send = b3 ? q2[0] : q2[1]; q1 = keep + __shfl_xor(send, 8); }
                q1 = DPP_ADD(q1, 0xB1); q1 = DPP_ADD(q1, 0x4E); q1 = DPP_ADD(q1, 0x141);
                const float t = __builtin_bit_cast(float, __builtin_amdgcn_ds_bpermute((l & 7) * 32, __builtin_bit_cast(int, q1)));
                const int base = i + 8 * b;
                if ((l >> 3) == ((base - cb) >> 3)) tot = t;
            }
        }
        if (!pf_done) { if (tok + 2 * step + 1 < T_TOK) U_PREFETCH(tok + 2 * step); }
        if (fv) { const int tk = (ent & 128) ? tokB : tokA; AK[(size_t)tk * 128 + (ent & 127)] = gelu_tanh(tot * su * (1.f / 16.f)) * gt * sv; }
        if (n == 0) break;
        }
        LDS_WAIT(); asm volatile("" ::: "memory");
    }
#undef U_PREFETCH
}
template <int MODE>
__device__ __forceinline__ void peer_u_phase1(const Frame& F, const Args& A) {
    const unsigned char* X8 = A.ws + WS_P + P_X8;
    const unsigned char* U8 = A.ws + WS_U8; const float* SU = (const float*)(A.ws + WS_SU); const float* SV = (const float*)(A.ws + WS_SV);
    const int* IDX = (const int*)(A.ws + WS_P + P_IDX); const float* GATE = (const float*)(A.ws + WS_P + P_GATE); float* AK = (float*)(MODE == 0 ? A.ws + WS_AK : A.ws + WS_P + P_SC);
    const int g = F.bid & (UNG - 1), nmem = F.G >> UNG_SH, l = F.lane, step = nmem * NWAVES;
    const int loff = 64 * (l & 15) + 16 * (l >> 4);
    const bool dg = ((l & 15) >> 2) == (l >> 4); const int dr = l & 3;
    const float dw0 = (dg && dr == 0) ? 1.f : 0.f, dw1 = (dg && dr == 1) ? 1.f : 0.f, dw2 = (dg && dr == 2) ? 1.f : 0.f, dw3 = (dg && dr == 3) ? 1.f : 0.f;
    LAS int* le = (LAS int*)(F.lds + F.wave * 2048); LAS int* lk = le + 256;
    const bool b5 = (l & 32) != 0, b4 = (l & 16) != 0, b3 = (l & 8) != 0;
    int tok = (F.bid >> UNG_SH) * NWAVES + F.wave;
    u32x4 nxA; int neA0, neA1; float ngA0, ngA1;
#define U1_PREFETCH(t) do { const size_t _tA = (size_t)(t); nxA = *(const u32x4*)(X8 + _tA * 1024 + loff); \
        neA0 = IDX[_tA * 128 + l]; neA1 = IDX[_tA * 128 + 64 + l]; ngA0 = GATE[_tA * 128 + l]; ngA1 = GATE[_tA * 128 + 64 + l]; } while (0)
    if (tok < T_TOK) U1_PREFETCH(tok);
    for (; tok < T_TOK; tok += step) {
        const u32x4 xA = nxA;
        const int eA0 = neA0, eA1 = neA1; const float gA0 = ngA0, gA1 = ngA1;
        bool pf_done = false;
        const bool oA0 = (eA0 & (UNG - 1)) == g, oA1 = (eA1 & (UNG - 1)) == g;
        const unsigned long long mA0 = __ballot(oA0), mA1 = __ballot(oA1);
        const int c0 = __popcll(mA0), n = c0 + __popcll(mA1);
#define MBC(m) __builtin_amdgcn_mbcnt_hi((unsigned)((m) >> 32), __builtin_amdgcn_mbcnt_lo((unsigned)(m), 0u))
        if (oA0) { const int p = MBC(mA0); le[p] = (eA0 << 8) | l; lk[p] = __builtin_bit_cast(int, gA0); }
        if (oA1) { const int p = c0 + MBC(mA1); le[p] = (eA1 << 8) | (64 + l); lk[p] = __builtin_bit_cast(int, gA1); }
#undef MBC
        LDS_WAIT(); asm volatile("" ::: "memory");
        for (int cb = 0; cb < n || cb == 0; cb += 64) {
        const int nc = min(n, cb + 64);
        const bool fv = (cb + l) < nc;
        const int ent = fv ? le[cb + l] : 0; const float gt = fv ? __builtin_bit_cast(float, lk[cb + l]) : 0.f; float tot = 0.f;
        const float su = SU[ent >> 8], sv = SV[ent >> 8];
        const unsigned long long radr = (unsigned long long)(U8 + (size_t)(((ent >> 8) & (UNG - 1)) * (NEXP / UNG) + ((ent >> 8) >> UNG_SH)) * 1024);
        const int ralo = (int)(unsigned)radr, rahi = (int)(unsigned)(radr >> 32);
        for (int i = cb; i < nc; i += 16) {
            u32x4 row[2][8];
#pragma unroll
            for (int b = 0; b < 2; ++b) if (i + 8 * b < nc) {
#pragma unroll
                for (int j = 0; j < 8; ++j) { const int ln = min(i + 8 * b + j, nc - 1) - cb;
                    const unsigned lo = (unsigned)__builtin_amdgcn_readlane(ralo, ln), hi = (unsigned)__builtin_amdgcn_readlane(rahi, ln);
                    const GAS unsigned char* rp = (const GAS unsigned char*)(((unsigned long long)hi << 32) | lo);
                    row[b][j] = *(const GAS u32x4*)(rp + (unsigned)loff); } }
            if (!pf_done) { pf_done = true; if (tok + step < T_TOK) U1_PREFETCH(tok + step); }
#pragma unroll
            for (int b = 0; b < 2; ++b) if (i + 8 * b < nc) {
                float p[8]; f32x4 accj[8];
#pragma unroll
                for (int j = 0; j < 8; ++j) accj[j] = __builtin_amdgcn_mfma_f32_16x16x32_fp8_fp8(lo64(row[b][j]), lo64(xA), (f32x4){0.f, 0.f, 0.f, 0.f}, 0, 0, 0);
#pragma unroll
                for (int j = 0; j < 8; ++j) accj[j] = __builtin_amdgcn_mfma_f32_16x16x32_fp8_fp8(hi64(row[b][j]), hi64(xA), accj[j], 0, 0, 0);
#pragma unroll
                for (int j = 0; j < 8; ++j) p[j] = __builtin_fmaf(accj[j][3], dw3, __builtin_fmaf(accj[j][2], dw2, __builtin_fmaf(accj[j][1], dw1, accj[j][0] * dw0)));
                float q4[4], q2[2], q1;
#pragma unroll
                for (int j = 0; j < 4; ++j) { const float keep = b5 ? p[4 + j] : p[j], send = b5 ? p[j] : p[4 + j]; q4[j] = keep + __shfl_xor(send, 32); }
#pragma unroll
                for (int j = 0; j < 2; ++j) { const float keep = b4 ? q4[2 + j] : q4[j], send = b4 ? q4[j] : q4[2 + j]; q2[j] = keep + __shfl_xor(send, 16); }
                { const float keep = b3 ? q2[1] : q2[0], send = b3 ? q2[0] : q2[1]; q1 = keep + __shfl_xor(send, 8); }
                q1 = DPP_ADD(q1, 0xB1); q1 = DPP_ADD(q1, 0x4E); q1 = DPP_ADD(q1, 0x141);
                const float t = __builtin_bit_cast(float, __builtin_amdgcn_ds_bpermute((l & 7) * 32, __builtin_bit_cast(int, q1)));
                const int base = i + 8 * b;
                if ((l >> 3) == ((base - cb) >> 3)) tot = t;
            }
        }
        if (!pf_done) { pf_done = true; if (tok + step < T_TOK) U1_PREFETCH(tok + step); }
        if (fv) AK[(size_t)tok * 128 + (ent & 127)] = gelu_tanh(tot * su * (1.f / 16.f)) * gt * sv;
        if (n == 0) break;
        }
        LDS_WAIT(); asm volatile("" ::: "memory");
    }
#undef U1_PREFETCH
}
template <int MODE>
__device__ __forceinline__ void peer_u4_phase(const Frame& F, const Args& A) {
    const unsigned char* X8 = A.ws + WS_P + P_X8;
    const float* SU = (const float*)(A.ws + WS_SU); const float* SV = (const float*)(A.ws + WS_SV);
    const int* IDX = (const int*)(A.ws + WS_P + P_IDX); const float* GATE = (const float*)(A.ws + WS_P + P_GATE); float* AK = (float*)(MODE == 0 ? A.ws + WS_AK : A.ws + WS_P + P_SC);
    const int g = F.bid & (UNG - 1), nmem = F.G >> UNG_SH, l = F.lane, step = nmem * NWAVES;
    const int m = l & 15, q = l >> 4;
    const GAS unsigned char* ub = (const GAS unsigned char*)(A.ws + WS_U8 + (size_t)g * (NEXP / UNG) * 512);
    const unsigned lconst = 16u * (unsigned)(4 * (m & 7) + q);
    const int xoff = 128 * (m & 7) + 16 * q;
    const bool dg = (m < 8) && ((m >> 2) == (q & 1)); const int dr = m & 3;
    const float dw0 = (dg && dr == 0) ? 1.f : 0.f, dw1 = (dg && dr == 1) ? 1.f : 0.f, dw2 = (dg && dr == 2) ? 1.f : 0.f, dw3 = (dg && dr == 3) ? 1.f : 0.f;
    const int rsel = 4 * (m >> 3);
    const int osrc = 4 * (32 * (l & 1) + 4 * ((l & 15) >> 1));
    const int sc1 = 0x7F7F7F7F;
    LAS int* le = (LAS int*)(F.lds + F.wave * 2048); LAS int* lk = le + 256;
    const bool b4 = (l & 16) != 0, b3 = (l & 8) != 0, b2 = (l & 4) != 0;
    int tok = (F.bid >> UNG_SH) * NWAVES + F.wave;
    u32x4 nx0, nx1; int ne0, ne1; float ng0, ng1;
#define U4_PREFETCH(t) do { const size_t _t = (size_t)(t); nx0 = *(const u32x4*)(X8 + _t * 1024 + xoff); nx1 = *(const u32x4*)(X8 + _t * 1024 + xoff + 64); \
        ne0 = IDX[_t * 128 + l]; ne1 = IDX[_t * 128 + 64 + l]; ng0 = GATE[_t * 128 + l]; ng1 = GATE[_t * 128 + 64 + l]; } while (0)
    if (tok < T_TOK) U4_PREFETCH(tok);
    for (; tok < T_TOK; tok += step) {
        const i32x8 xb = __builtin_shufflevector(__builtin_bit_cast(i32x4, nx0), __builtin_bit_cast(i32x4, nx1), 0, 1, 2, 3, 4, 5, 6, 7);
        const int e0 = ne0, e1 = ne1; const float g0 = ng0, g1 = ng1;
        bool pf_done = false;
        const bool o0 = (e0 & (UNG - 1)) == g, o1 = (e1 & (UNG - 1)) == g;
        const unsigned long long m0 = __ballot(o0), m1 = __ballot(o1);
        const int c0 = __popcll(m0), n = c0 + __popcll(m1);
#define MBC(mm) __builtin_amdgcn_mbcnt_hi((unsigned)((mm) >> 32), __builtin_amdgcn_mbcnt_lo((unsigned)(mm), 0u))
        if (o0) { const int p = MBC(m0); le[p] = (e0 << 8) | l; lk[p] = __builtin_bit_cast(int, g0); }
        if (o1) { const int p = c0 + MBC(m1); le[p] = (e1 << 8) | (64 + l); lk[p] = __builtin_bit_cast(int, g1); }
#undef MBC
        LDS_WAIT(); asm volatile("" ::: "memory");
        for (int cb = 0; cb < n || cb == 0; cb += 64) {
            const int nc = min(n, cb + 64);
            const bool fv = (cb + l) < nc;
            const int ent = fv ? le[cb + l] : 0; const float gt = fv ? __builtin_bit_cast(float, lk[cb + l]) : 0.f; float tot = 0.f;
            const float su = SU[ent >> 8], sv = SV[ent >> 8];
            const int roff = fv ? ((ent >> 8) >> UNG_SH) * 512 : 0;
            for (int i = cb; i < nc; i += 32) {
                u32x4 row[2][8];
#pragma unroll
                for (int b = 0; b < 2; ++b) if (i + 16 * b < nc) {
#pragma unroll
                    for (int j = 0; j < 8; ++j) { const int ro = __builtin_amdgcn_ds_bpermute(rsel + 4 * (i - cb + 16 * b + 2 * j), roff);
                        row[b][j] = *(const GAS u32x4*)(ub + ((unsigned)ro + lconst)); } }
                if (!pf_done) { pf_done = true; if (tok + step < T_TOK) U4_PREFETCH(tok + step); }
#pragma unroll
                for (int b = 0; b < 2; ++b) if (i + 16 * b < nc) {
                    float p[8];
#pragma unroll
                    for (int j = 0; j < 8; ++j) { const i32x4 r4 = __builtin_bit_cast(i32x4, row[b][j]);
                        const f32x4 d = __builtin_amdgcn_mfma_scale_f32_16x16x128_f8f6f4(__builtin_shufflevector(r4, r4, 0, 1, 2, 3, -1, -1, -1, -1), xb, (f32x4){0.f, 0.f, 0.f, 0.f}, 4, 0, 0, sc1, 0, sc1);
                        p[j] = __builtin_fmaf(d[3], dw3, __builtin_fmaf(d[2], dw2, __builtin_fmaf(d[1], dw1, d[0] * dw0))); }
                    float q4[4], q2[2], q1;
#pragma unroll
                    for (int j = 0; j < 4; ++j) { const float keep = b4 ? p[4 + j] : p[j], send = b4 ? p[j] : p[4 + j]; q4[j] = keep + __shfl_xor(send, 16); }
#pragma unroll
                    for (int j = 0; j < 2; ++j) { const float keep = b3 ? q4[2 + j] : q4[j], send = b3 ? q4[j] : q4[2 + j]; q2[j] = keep + __shfl_xor(send, 8); }
                    { const float keep = b2 ? q2[1] : q2[0], send = b2 ? q2[0] : q2[1]; q1 = keep + __shfl_xor(send, 4); }
                    q1 = DPP_ADD(q1, 0xB1); q1 = DPP_ADD(q1, 0x4E);
                    const float t = __builtin_bit_cast(float, __builtin_amdgcn_ds_bpermute(osrc, __builtin_bit_cast(int, q1)));
                    if ((l >> 4) == ((i - cb + 16 * b) >> 4)) tot = t;
                }
            }
            if (!pf_done) { pf_done = true; if (tok + step < T_TOK) U4_PREFETCH(tok + step); }
            if (fv) AK[(size_t)tok * 128 + (ent & 127)] = gelu_tanh(tot * su * (1.f / 16.f)) * gt * sv;
            if (n == 0) break;
        }
        LDS_WAIT(); asm volatile("" ::: "memory");
    }
#undef U4_PREFETCH
}
template <int MODE>
__device__ __forceinline__ void peer_u4_all(const Frame& F, const Args& A) {
    const unsigned char* X8 = A.ws + WS_P + P_X8;
    const float* SU = (const float*)(A.ws + WS_SU); const float* SV = (const float*)(A.ws + WS_SV);
    const int* IDX = (const int*)(A.ws + WS_P + P_IDX); const float* GATE = (const float*)(A.ws + WS_P + P_GATE); float* AK = (float*)(MODE == 0 ? A.ws + WS_AK : A.ws + WS_P + P_SC);
    const int l = F.lane, step = F.G * NWAVES;
    const int m = l & 15, q = l >> 4;
    const GAS unsigned char* ub = (const GAS unsigned char*)(A.ws + WS_U8);
    const unsigned lconst = 16u * (unsigned)(8 * q + (m & 7));
    const int xoff = 256 * (q >> 1) + 32 * (m & 7) + 16 * (q & 1);
    const bool dg = (m < 8) && ((m >> 2) == (q & 1)); const int dr = m & 3;
    const float dw0 = (dg && dr == 0) ? 1.f : 0.f, dw1 = (dg && dr == 1) ? 1.f : 0.f, dw2 = (dg && dr == 2) ? 1.f : 0.f, dw3 = (dg && dr == 3) ? 1.f : 0.f;
    const int rsel = 4 * (m >> 3);
    const int osrc = 4 * (32 * (l & 1) + 4 * ((l & 15) >> 1));
    const int sc1 = 0x7F7F7F7F;
    const bool b4 = (l & 16) != 0, b3 = (l & 8) != 0, b2 = (l & 4) != 0;
    const int lhi = l >> 4;
    int tok = F.bid * NWAVES + F.wave;
    u32x4 nx0, nx1; int ne0, ne1; float ng0, ng1;
#define UA_PREFETCH(t) do { const size_t _t = (size_t)(t); nx0 = __builtin_nontemporal_load((const u32x4*)(X8 + _t * 1024 + xoff)); nx1 = __builtin_nontemporal_load((const u32x4*)(X8 + _t * 1024 + xoff + 512)); \
        ne0 = __builtin_nontemporal_load(IDX + _t * 128 + l); ne1 = __builtin_nontemporal_load(IDX + _t * 128 + 64 + l); ng0 = __builtin_nontemporal_load(GATE + _t * 128 + l); ng1 = __builtin_nontemporal_load(GATE + _t * 128 + 64 + l); } while (0)
#define UA_LOADS(R, ro_, h) do { _Pragma("unroll") for (int j_ = 0; j_ < 16; ++j_) { const int o_ = __builtin_amdgcn_ds_bpermute(rsel + 4 * (32 * (h) + 2 * j_), (ro_)); \
        R[j_] = *(const GAS u32x4*)(ub + ((unsigned)o_ + lconst)); } } while (0)
#define UA_COMPUTE(R, xb_, h, tot_) do { _Pragma("unroll") for (int b_ = 0; b_ < 2; ++b_) { float p_[8]; \
        _Pragma("unroll") for (int j_ = 0; j_ < 8; ++j_) { const i32x4 r4_ = __builtin_bit_cast(i32x4, R[8 * b_ + j_]); \
            const f32x4 d_ = __builtin_amdgcn_mfma_scale_f32_16x16x128_f8f6f4(__builtin_shufflevector(r4_, r4_, 0, 1, 2, 3, -1, -1, -1, -1), (xb_), (f32x4){0.f, 0.f, 0.f, 0.f}, 4, 0, 0, sc1, 0, sc1); \
            p_[j_] = __builtin_fmaf(d_[3], dw3, __builtin_fmaf(d_[2], dw2, __builtin_fmaf(d_[1], dw1, d_[0] * dw0))); } \
        float q4_[4], q2_[2], q1_; \
        _Pragma("unroll") for (int j_ = 0; j_ < 4; ++j_) { const float keep_ = b4 ? p_[4 + j_] : p_[j_], send_ = b4 ? p_[j_] : p_[4 + j_]; q4_[j_] = keep_ + __shfl_xor(send_, 16); } \
        _Pragma("unroll") for (int j_ = 0; j_ < 2; ++j_) { const float keep_ = b3 ? q4_[2 + j_] : q4_[j_], send_ = b3 ? q4_[j_] : q4_[2 + j_]; q2_[j_] = keep_ + __shfl_xor(send_, 8); } \
        { const float keep_ = b2 ? q2_[1] : q2_[0], send_ = b2 ? q2_[0] : q2_[1]; q1_ = keep_ + __shfl_xor(send_, 4); } \
        q1_ = DPP_ADD(q1_, 0xB1); q1_ = DPP_ADD(q1_, 0x4E); \
        const float t_ = __builtin_bit_cast(float, __builtin_amdgcn_ds_bpermute(osrc, __builtin_bit_cast(int, q1_))); \
        if (lhi == 2 * (h) + b_) (tot_) = t_; } } while (0)
    u32x4 RA[16], RB[16];
    if (tok < T_TOK) { UA_PREFETCH(tok); UA_LOADS(RA, ne0 * 512, 0); }
    for (; tok < T_TOK; tok += step) {
        const i32x8 xb = __builtin_shufflevector(__builtin_bit_cast(i32x4, nx0), __builtin_bit_cast(i32x4, nx1), 0, 1, 2, 3, 4, 5, 6, 7);
        const int e0 = ne0, e1 = ne1; const float g0 = ng0, g1 = ng1;
        const int ro0 = e0 * 512, ro1 = e1 * 512;
        const float su0 = SU[e0], sv0 = SV[e0], su1 = SU[e1], sv1 = SV[e1];
        const bool more = tok + step < T_TOK;
        float tot0 = 0.f, tot1 = 0.f;
        UA_LOADS(RB, ro0, 1);
        if (more) UA_PREFETCH(tok + step);
        UA_COMPUTE(RA, xb, 0, tot0);
        UA_LOADS(RA, ro1, 0);
        UA_COMPUTE(RB, xb, 1, tot0);
        UA_LOADS(RB, ro1, 1);
        UA_COMPUTE(RA, xb, 0, tot1);
        if (more) UA_LOADS(RA, ne0 * 512, 0);
        UA_COMPUTE(RB, xb, 1, tot1);
        __builtin_nontemporal_store(gelu_tanh(tot0 * su0 * (1.f / 16.f)) * g0 * sv0, AK + (size_t)tok * 128 + l);
        __builtin_nontemporal_store(gelu_tanh(tot1 * su1 * (1.f / 16.f)) * g1 * sv1, AK + (size_t)tok * 128 + 64 + l);
    }
#undef UA_PREFETCH
#undef UA_LOADS
#undef UA_COMPUTE
}
__device__ __forceinline__ float wave_max_nonneg(float v) {
    unsigned u = __builtin_bit_cast(unsigned, v);
    u = max(u, (unsigned)__builtin_amdgcn_mov_dpp((int)u, 0xB1, 0xf, 0xf, true));
    u = max(u, (unsigned)__builtin_amdgcn_mov_dpp((int)u, 0x4E, 0xf, 0xf, true));
    u = max(u, (unsigned)__builtin_amdgcn_mov_dpp((int)u, 0x141, 0xf, 0xf, true));
    u = max(u, (unsigned)__builtin_amdgcn_mov_dpp((int)u, 0x140, 0xf, 0xf, true));
    const unsigned a = (unsigned)__builtin_amdgcn_readlane((int)u, 0), b = (unsigned)__builtin_amdgcn_readlane((int)u, 16), c = (unsigned)__builtin_amdgcn_readlane((int)u, 32), d = (unsigned)__builtin_amdgcn_readlane((int)u, 48);
    return __builtin_bit_cast(float, max(max(a, b), max(c, d)));
}
template <int MODE>
__device__ __forceinline__ void peer_v_phase(const Frame& F, const Args& A) {
    const unsigned char* V8 = A.ws + WS_V8; const int* IDX = (const int*)(A.ws + WS_P + P_IDX); const float* AK = (const float*)(A.ws + WS_AK);
    float* out = MODE == 0 ? A.out : (float*)(A.ws + WS_P + P_SC);
    const int g = F.bid & 7, nmem = F.G >> 3, l = F.lane, sub = l & 7, rr = l >> 3, n16 = l & 15, q = l >> 4, step = nmem * NWAVES;
    const GAS unsigned char* vb = (const GAS unsigned char*)(V8 + (size_t)g * NEXP * 128);
    LAS unsigned long long* rep = (LAS unsigned long long*)(F.lds + F.wave * 2048);
    const unsigned long long bm = 0xFFull << (8 * (n16 & 7));
    const int repi = 2 * q + (n16 >> 3);
    const bool vl = (n16 < 8) && (q < 2);
    LAS float* stg = (LAS float*)(F.lds + 16384 + F.wave * 512);
    int tok = 2 * ((F.bid >> 3) * NWAVES + F.wave);
    int ne[4]; float na[4];
#define V_PREFETCH(t) do { const size_t _a = (size_t)(t) * 128, _b = ((size_t)(t) + 1) * 128; ne[0] = IDX[_a + l]; ne[1] = IDX[_a + 64 + l]; ne[2] = IDX[_b + l]; ne[3] = IDX[_b + 64 + l]; \
        na[0] = AK[_a + l]; na[1] = AK[_a + 64 + l]; na[2] = AK[_b + l]; na[3] = AK[_b + 64 + l]; } while (0)
    if (tok + 1 < T_TOK) V_PREFETCH(tok);
    for (; tok + 1 < T_TOK; tok += 2 * step) {
        const int e0 = ne[0], e1 = ne[1], e2 = ne[2], e3 = ne[3]; const float a0 = na[0], a1 = na[1], a2 = na[2], a3 = na[3];
        u32x4 rowA[16], rowB[16];
#pragma unroll
        for (int i = 0; i < 16; ++i) { const int src = (8 * (i & 7) + rr) * 4;
            const int ea = __builtin_amdgcn_ds_bpermute(src, i < 8 ? e0 : e1), eb = __builtin_amdgcn_ds_bpermute(src, i < 8 ? e2 : e3);
            rowA[i] = *(const GAS u32x4*)(vb + ((unsigned)ea * 128u + 16u * (unsigned)sub)); rowB[i] = *(const GAS u32x4*)(vb + ((unsigned)eb * 128u + 16u * (unsigned)sub)); }
        f32x4 HA = {0.f, 0.f, 0.f, 0.f}, HB = {0.f, 0.f, 0.f, 0.f};
        if (l < 32) { const float* hpa = out + (size_t)tok * D + g * 128 + 4 * l; HA = *(const f32x4*)hpa; HB = *(const f32x4*)(hpa + D); }
        if (tok + 2 * step + 1 < T_TOK) V_PREFETCH(tok + 2 * step);
        const float amA = wave_max_nonneg(fmaxf(fabsf(a0), fabsf(a1))), amB = wave_max_nonneg(fmaxf(fabsf(a2), fabsf(a3)));
        const float scA = amA > 0.f ? 224.f * __builtin_amdgcn_rcpf(amA) : 0.f, invA = amA * (1.f / 224.f), scB = amB > 0.f ? 224.f * __builtin_amdgcn_rcpf(amB) : 0.f, invB = amB * (1.f / 224.f);
        { const unsigned wA = (unsigned)__builtin_amdgcn_cvt_pk_fp8_f32(a0 * scA, a1 * scA, 0, false), wB = (unsigned)__builtin_amdgcn_cvt_pk_fp8_f32(a2 * scB, a3 * scB, 0, false);
          const unsigned r0 = (wA & 0xffu) * 0x01010101u, r1 = ((wA >> 8) & 0xffu) * 0x01010101u, r2 = (wB & 0xffu) * 0x01010101u, r3 = ((wB >> 8) & 0xffu) * 0x01010101u;
          rep[l] = ((unsigned long long)r0 << 32) | r0; rep[64 + l] = ((unsigned long long)r1 << 32) | r1; rep[128 + l] = ((unsigned long long)r2 << 32) | r2; rep[192 + l] = ((unsigned long long)r3 << 32) | r3; }
        LDS_WAIT(); asm volatile("" ::: "memory");
#pragma unroll
        for (int t2 = 0; t2 < 2; ++t2) {
            f32x4 alo = {0.f, 0.f, 0.f, 0.f}, ahi = {0.f, 0.f, 0.f, 0.f};
#pragma unroll
            for (int i = 0; i < 16; ++i) { const long bop = (long)(rep[128 * t2 + 8 * i + repi] & bm); const u32x4 rw = t2 ? rowB[i] : rowA[i];
                alo = __builtin_amdgcn_mfma_f32_16x16x32_fp8_fp8(lo64(rw), bop, alo, 0, 0, 0);
                ahi = __builtin_amdgcn_mfma_f32_16x16x32_fp8_fp8(hi64(rw), bop, ahi, 0, 0, 0); }
            const float inv = t2 ? invB : invA;
            float vlo[4], vhi[4];
#pragma unroll
            for (int r = 0; r < 4; ++r) { const float tl = alo[r], th = ahi[r];
                vlo[r] = (tl + __builtin_bit_cast(float, __builtin_amdgcn_ds_bpermute(((l + 40) & 63) * 4, __builtin_bit_cast(int, tl)))) * inv;
                vhi[r] = (th + __builtin_bit_cast(float, __builtin_amdgcn_ds_bpermute(((l + 40) & 63) * 4, __builtin_bit_cast(int, th)))) * inv; }
            if (vl) {
#pragma unroll
                for (int r = 0; r < 4; ++r) { stg[64 * q + 16 * r + n16] = vlo[r]; stg[64 * q + 16 * r + n16 + 8] = vhi[r]; } }
            LDS_WAIT(); asm volatile("" ::: "memory");
            if (l < 32) { const f32x4 dv = *(const LAS f32x4*)(stg + 4 * l); *(f32x4*)(out + (size_t)(tok + t2) * D + g * 128 + 4 * l) = (t2 ? HB : HA) + dv; }
            LDS_WAIT(); asm volatile("" ::: "memory");
        }
        LDS_WAIT(); asm volatile("" ::: "memory");
    }
#undef V_PREFETCH
}
typedef float f32x16 __attribute__((ext_vector_type(16)));
template <int MODE>
__device__ __forceinline__ void peer_v4_phase(const Frame& F, const Args& A) {
    const int* IDX = (const int*)(A.ws + WS_P + P_IDX); const float* AK = (const float*)(A.ws + WS_AK);
    float* out = A.out;
    const int l = F.lane, n = l & 31, hq = l >> 5, step = F.G * NWAVES;
    const GAS unsigned char* vb = (const GAS unsigned char*)(A.ws + WS_V8);
    const unsigned lconst = 16u * (unsigned)n;
    const bool diag = ((l >> 4) & 1) == hq;
    const unsigned bytem = diag ? (0xFFu << (8 * (l & 3))) : 0u; const int dsel = (l & 15) >> 2;
    const unsigned M0 = dsel == 0 ? bytem : 0u, M1 = dsel == 1 ? bytem : 0u, M2 = dsel == 2 ? bytem : 0u, M3 = dsel == 3 ? bytem : 0u;
    const int rsel = 4 * hq;
    const int sc1 = 0x7F7F7F7F;
    const int colb = 8 * n + 4 * hq;
    int tok = F.bid * NWAVES + F.wave;
    int ne0, ne1; float na0, na1;
#define V4_PREFETCH(t) do { const size_t _t = (size_t)(t) * 128; ne0 = __builtin_nontemporal_load(IDX + _t + l); ne1 = __builtin_nontemporal_load(IDX + _t + 64 + l); na0 = __builtin_nontemporal_load(AK + _t + l); na1 = __builtin_nontemporal_load(AK + _t + 64 + l); } while (0)
#define V4_LOADS(R, ro_, h) do { int ba_ = rsel + 4 * (16 * (h)); _Pragma("unroll") for (int j_ = 0; j_ < 8; ++j_) { asm volatile("" : "+v"(ba_)); const int o_ = __builtin_amdgcn_ds_bpermute(ba_, (ro_)); ba_ += 8; \
        R[j_] = *(const GAS u32x4*)(vb + ((unsigned)o_ + lconst)); } } while (0)
#define V4_ONE(ACC, R, rep_, h, j_) do { unsigned s0_ = (unsigned)__builtin_amdgcn_readlane((int)(rep_), 16 * (h) + 2 * (j_)), s1_ = (unsigned)__builtin_amdgcn_readlane((int)(rep_), 16 * (h) + 2 * (j_) + 1); \
        asm volatile("" : "+s"(s0_), "+s"(s1_), "+v"(ACC)); \
        const i32x8 a8_ = {(int)(s0_ & M0), (int)(s0_ & M1), (int)(s0_ & M2), (int)(s0_ & M3), (int)(s1_ & M0), (int)(s1_ & M1), (int)(s1_ & M2), (int)(s1_ & M3)}; \
        const i32x4 r4_ = __builtin_bit_cast(i32x4, R[j_]); \
        ACC = __builtin_amdgcn_mfma_scale_f32_32x32x64_f8f6f4(a8_, __builtin_shufflevector(r4_, r4_, 0, 1, 2, 3, -1, -1, -1, -1), ACC, 0, 4, 0, sc1, 0, sc1); } while (0)
#define V4_COMPUTE(R, rep_, h) do { V4_ONE(acc, R, rep_, h, 0); V4_ONE(acc1, R, rep_, h, 1); V4_ONE(acc, R, rep_, h, 2); V4_ONE(acc1, R, rep_, h, 3); \
        V4_ONE(acc, R, rep_, h, 4); V4_ONE(acc1, R, rep_, h, 5); V4_ONE(acc, R, rep_, h, 6); V4_ONE(acc1, R, rep_, h, 7); } while (0)
    u32x4 RA[8], RB[8];
    if (tok < T_TOK) { V4_PREFETCH(tok); V4_LOADS(RA, ne0 * 512, 0); }
    for (; tok < T_TOK; tok += step) {
        const int e0 = ne0, e1 = ne1; const float a0 = na0, a1 = na1;
        const int ro0 = e0 * 512, ro1 = e1 * 512;
        const bool more = tok + step < T_TOK;
        V4_LOADS(RB, ro0, 1);
        if (more) V4_PREFETCH(tok + step);
        const float am = wave_max_nonneg(fmaxf(fabsf(a0), fabsf(a1)));
        const float sc = am > 0.f ? 224.f * __builtin_amdgcn_rcpf(am) : 0.f, inv = am * (1.f / 224.f);
        const unsigned w8 = (unsigned)__builtin_amdgcn_cvt_pk_fp8_f32(a0 * sc, a1 * sc, 0, false);
        const unsigned rep0 = (w8 & 0xffu) * 0x01010101u, rep1 = ((w8 >> 8) & 0xffu) * 0x01010101u;
        f32x16 acc, acc1;
#pragma unroll
        for (int i = 0; i < 16; ++i) { acc[i] = 0.f; acc1[i] = 0.f; }
        V4_COMPUTE(RA, rep0, 0); V4_LOADS(RA, ro0, 2);
        V4_COMPUTE(RB, rep0, 1); V4_LOADS(RB, ro0, 3);
        V4_COMPUTE(RA, rep0, 2); V4_LOADS(RA, ro1, 0);
        V4_COMPUTE(RB, rep0, 3); V4_LOADS(RB, ro1, 1);
        V4_COMPUTE(RA, rep1, 0); V4_LOADS(RA, ro1, 2);
        V4_COMPUTE(RB, rep1, 1); V4_LOADS(RB, ro1, 3);
        f32x4 H[4];
        u32x2 MX[4];
        { const bf16_t* mp = (const bf16_t*)(A.ws + WS_P + P_HB) + (size_t)tok * D + colb;
#pragma unroll
          for (int j = 0; j < 4; ++j) MX[j] = __builtin_nontemporal_load((const u32x2*)(mp + 256 * j)); }
        V4_COMPUTE(RA, rep1, 2);
        if (more) V4_LOADS(RA, ne0 * 512, 0);
        V4_COMPUTE(RB, rep1, 3);
        acc = acc + acc1;
        float ss = 0.f;
#pragma unroll
        for (int j = 0; j < 4; ++j) { H[j] = (f32x4){bflo(MX[j].x), bfhi(MX[j].x), bflo(MX[j].y), bfhi(MX[j].y)} + (f32x4){acc[4 * j], acc[4 * j + 1], acc[4 * j + 2], acc[4 * j + 3]} * inv;
            ss += (H[j].x * H[j].x + H[j].y * H[j].y) + (H[j].z * H[j].z + H[j].w * H[j].w); }
        const float rstd = 1.f / sqrtf(wave_sum(ss) * (1.f / D) + EPS);
        { float* hp = out + (size_t)tok * D + colb;
#pragma unroll
          for (int j = 0; j < 4; ++j) __builtin_nontemporal_store(H[j] * rstd * *(const f32x4*)(A.in[I_FG] + colb + 256 * j), (f32x4*)(hp + 256 * j)); }
    }
#undef V4_PREFETCH
#undef V4_LOADS
#undef V4_COMPUTE
#undef V4_ONE
}
__device__ __forceinline__ void final_norm_phase(const Frame& F, const Args& A) {
    const int gw = F.bid * NWAVES + F.wave, NGW = F.G * NWAVES, l = F.lane; const float* fg = A.in[I_FG];
    const f32x4* gp = (const f32x4*)fg + l;
    int tok = gw;
    for (; tok + 3 * NGW < T_TOK; tok += 4 * NGW) {
        f32x4 v[4][4]; float ss[4];
#pragma unroll
        for (int b = 0; b < 4; ++b) { const f32x4* hp = (const f32x4*)(A.out + (size_t)(tok + b * NGW) * D) + l;
#pragma unroll
            for (int j = 0; j < 4; ++j) v[b][j] = hp[64 * j]; }
#pragma unroll
        for (int b = 0; b < 4; ++b) { ss[b] = 0.f;
#pragma unroll
            for (int j = 0; j < 4; ++j) ss[b] += (v[b][j].x * v[b][j].x + v[b][j].y * v[b][j].y) + (v[b][j].z * v[b][j].z + v[b][j].w * v[b][j].w); }
#pragma unroll
        for (int o = 1; o < 64; o <<= 1) {
#pragma unroll
            for (int b = 0; b < 4; ++b) ss[b] += __shfl_xor(ss[b], o); }
#pragma unroll
        for (int b = 0; b < 4; ++b) { const float rstd = 1.f / sqrtf(ss[b] * (1.f / D) + EPS); f32x4* hp = (f32x4*)(A.out + (size_t)(tok + b * NGW) * D) + l;
#pragma unroll
            for (int j = 0; j < 4; ++j) hp[64 * j] = v[b][j] * rstd * gp[64 * j]; }
    }
    for (; tok < T_TOK; tok += NGW) { f32x4* hp = (f32x4*)(A.out + (size_t)tok * D) + l; f32x4 v[4]; float ss = 0.f;
#pragma unroll
        for (int j = 0; j < 4; ++j) { v[j] = hp[64 * j]; ss += (v[j].x * v[j].x + v[j].y * v[j].y) + (v[j].z * v[j].z + v[j].w * v[j].w); }
        const float rstd = 1.f / sqrtf(wave_sum(ss) * (1.f / D) + EPS);
#pragma unroll
        for (int j = 0; j < 4; ++j) hp[64 * j] = v[j] * rstd * gp[64 * j]; }
}

#ifdef DEBUG_CHECK
constexpr size_t WS_DBG = 472 * MiB;
__device__ __forceinline__ int dbg_tok(int i) { return (i * 509 + 3) & 32767; }
__device__ __forceinline__ float gelu_ref(float x) { return 0.5f * x * (1.f + tanhf(0.7978845608028654f * (x + 0.044715f * x * x * x))); }
__global__ void __launch_bounds__(512) dbg_scores(Args a) {
    __shared__ float n2s[1024]; __shared__ float q[2048];
    const int t = dbg_tok(blockIdx.x), tid = threadIdx.x;
    const bf16_t* N2 = (const bf16_t*)(a.ws + WS_N1); const float* SC = (const float*)(a.ws + WS_P + P_SC); unsigned* dbg = (unsigned*)(a.ws + WS_DBG);
    for (int k = tid; k < 1024; k += 512) n2s[k] = bf1(N2[(size_t)t * 1024 + k]);
    __syncthreads();
    for (int r = 0; r < 4; ++r) { const int c = tid + 512 * r; float s = 0.f; for (int k = 0; k < 1024; ++k) s += n2s[k] * a.in[I_WQ][(size_t)k * 2048 + c]; q[c] = s; }
    __syncthreads();
    float md = 0.f;
    for (int r = 0; r < 4; ++r) { const int n = tid + 512 * r, hh = n >> 7, key = n & 127; const float* kX = (hh & 1) ? a.in[I_K2] : a.in[I_K1];
        float s = 0.f; for (int d = 0; d < 128; ++d) s += q[hh * 128 + d] * kX[key * 128 + d];
        md = fmaxf(md, fabsf(s - SC[(size_t)n * T_TOK + t])); }
    atomicMax(&dbg[0], __builtin_bit_cast(unsigned, md));
}
__global__ void __launch_bounds__(64) dbg_topk(Args a) {
    __shared__ float s1[8][128], s2[8][128], cv[8][256]; __shared__ float t1v[8][16], t2v[8][16]; __shared__ int t1i[8][16], t2i[8][16], exi[8][16]; __shared__ float exv[8][16];
    const int t = dbg_tok(blockIdx.x), h = threadIdx.x;
    const float* SC = (const float*)(a.ws + WS_P + P_SC); const int* IDX = (const int*)(a.ws + WS_P + P_IDX); const float* GATE = (const float*)(a.ws + WS_P + P_GATE); unsigned* dbg = (unsigned*)(a.ws + WS_DBG);
    if (h >= 8) return;
    for (int j = 0; j < 128; ++j) { s1[h][j] = SC[(size_t)(h * 256 + j) * T_TOK + t]; s2[h][j] = SC[(size_t)(h * 256 + 128 + j) * T_TOK + t]; }
    for (int r = 0; r < 16; ++r) { int b1 = 0, b2 = 0; for (int j = 1; j < 128; ++j) { if (s1[h][j] > s1[h][b1]) b1 = j; if (s2[h][j] > s2[h][b2]) b2 = j; }
        t1v[h][r] = s1[h][b1]; t1i[h][r] = b1; s1[h][b1] = -1e30f; t2v[h][r] = s2[h][b2]; t2i[h][r] = b2; s2[h][b2] = -1e30f; }
    for (int c = 0; c < 256; ++c) cv[h][c] = t1v[h][c >> 4] + t2v[h][c & 15];
    for (int r = 0; r < 16; ++r) { int bc = 0; for (int c = 1; c < 256; ++c) if (cv[h][c] > cv[h][bc]) bc = c;
        exv[h][r] = cv[h][bc]; exi[h][r] = t1i[h][bc >> 4] * 128 + t2i[h][bc & 15]; cv[h][bc] = -1e30f; }
    float sum = 0.f; const float mx0 = exv[h][0]; for (int r = 0; r < 16; ++r) { exv[h][r] = expf(exv[h][r] - mx0); } for (int r = 0; r < 16; ++r) sum += exv[h][r];
    unsigned miss = 0; float gd = 0.f;
    for (int w = 0; w < 16; ++w) { const int e = IDX[(size_t)t * 128 + h * 16 + w]; const float g = GATE[(size_t)t * 128 + h * 16 + w]; bool found = false;
        for (int r = 0; r < 16; ++r) if (exi[h][r] == e) { found = true; gd = fmaxf(gd, fabsf(g - exv[h][r] / sum)); }
        if (!found) ++miss; }
    atomicAdd(&dbg[1], miss); atomicMax(&dbg[3], __builtin_bit_cast(unsigned, gd));
}
__global__ void __launch_bounds__(512) dbg_experts_pre(Args a) {
    __shared__ float n2s[1024]; __shared__ float ak[128]; __shared__ int ek[128]; __shared__ float red[8];
    const int t = dbg_tok(blockIdx.x), tid = threadIdx.x, lane = tid & 63, wave = tid >> 6;
    const bf16_t* N2 = (const bf16_t*)(a.ws + WS_N1); const int* IDX = (const int*)(a.ws + WS_P + P_IDX); const float* GATE = (const float*)(a.ws + WS_P + P_GATE);
    float* rows = (float*)(a.ws + WS_DBG + MiB);
    for (int k = tid; k < 1024; k += 512) n2s[k] = bf1(N2[(size_t)t * 1024 + k]);
    if (tid < 128) ek[tid] = IDX[(size_t)t * 128 + tid];
    __syncthreads();
    for (int k = wave * 16; k < wave * 16 + 16; ++k) { const float* u = a.in[I_PU] + (size_t)ek[k] * 1024; float s = 0.f; for (int j = lane; j < 1024; j += 64) s += u[j] * n2s[j];
        s = wave_sum(s); if (lane == 0) ak[k] = gelu_ref(s) * GATE[(size_t)t * 128 + k]; }
    __syncthreads();
    float h2[2]; float ss = 0.f;
    for (int r = 0; r < 2; ++r) { const int d = tid + 512 * r; float o = 0.f; for (int k = 0; k < 128; ++k) o += ak[k] * a.in[I_PV][(size_t)ek[k] * 1024 + d]; h2[r] = a.out[(size_t)t * 1024 + d] + o; ss += h2[r] * h2[r]; }
    ss = wave_sum(ss); if (lane == 0) red[wave] = ss; __syncthreads();
    float tot = 0.f; for (int w = 0; w < 8; ++w) tot += red[w];
    const float rstd = 1.f / sqrtf(tot / 1024.f + EPS);
    for (int r = 0; r < 2; ++r) { const int d = tid + 512 * r; rows[(size_t)blockIdx.x * 1024 + d] = h2[r] * rstd * a.in[I_FG][d]; }
}
__global__ void __launch_bounds__(512) dbg_experts_post(Args a) {
    const int t = dbg_tok(blockIdx.x), tid = threadIdx.x; const float* rows = (const float*)(a.ws + WS_DBG + MiB); float* dbgf = (float*)(a.ws + WS_DBG);
    float e = 0.f, n = 0.f;
    for (int r = 0; r < 2; ++r) { const int d = tid + 512 * r; const float x = rows[(size_t)blockIdx.x * 1024 + d], y = a.out[(size_t)t * 1024 + d]; e += (x - y) * (x - y); n += x * x; }
    e = wave_sum(e); n = wave_sum(n); if ((tid & 63) == 0) { atomicAdd(&dbgf[4], e); atomicAdd(&dbgf[5], n); }
}
__global__ void __launch_bounds__(512) dbg_report(Args a, int which) {
    const unsigned* dbg = (const unsigned*)(a.ws + WS_DBG); const float* dbgf = (const float*)(a.ws + WS_DBG);
    const float mA = dbgf[0], gd = dbgf[3]; const unsigned miss = dbg[1]; const float relC = sqrtf(dbgf[4] / fmaxf(dbgf[5], 1e-30f));
    float X;
    if (which == 0) { int mask = 0; if (mA > 0.05f) mask |= 1; if (miss > 400u) mask |= 2; if (relC > 0.05f) mask |= 4; if (gd > 0.02f) mask |= 8; X = 1000.f + 100.f * mask; }
    else if (which == 1) X = 1e6f * mA; else if (which == 2) X = 100.f + (float)miss; else if (which == 3) X = 1e6f * relC; else X = 1e6f * gd;
    for (size_t i = (size_t)blockIdx.x * 512 + threadIdx.x; i < (size_t)T_TOK * D; i += (size_t)gridDim.x * 512) a.out[i] = (i == 0) ? X : 0.f;
}
#endif

constexpr int NPH = 13;
__global__ void __launch_bounds__(NWAVES * 64, 2) fwd_kernel(Args args) {
    extern __shared__ __attribute__((aligned(16))) unsigned char lds_raw[];
    Frame F;
    F.lds = (LAS unsigned char*)lds_raw;
    F.tid = threadIdx.x; F.lane = F.tid & 63; F.wave = __builtin_amdgcn_readfirstlane(F.tid >> 6);
    F.G = gridDim.x; F.bid = blockIdx.x;
    volatile LAS unsigned* MISC = (volatile LAS unsigned*)(F.lds + MISC_OFF);
    for (int u = F.tid; u < (LDS_BYTES - LDSCTL_OFF) / 4; u += NWAVES * 64) ((LAS unsigned*)(F.lds + LDSCTL_OFF))[u] = 0u;
    __syncthreads();
    unsigned* ctl = (unsigned*)(args.ws + WS_CTL);
    const int lo = args.ph_lo, hi = args.ph_hi;
    XcdBarrier bar; bar.bar = ctl + CW_BAR + args.li * XCD_BAR_WORDS; bar.x = 0; bar.st = nullptr; bar.wave = F.wave;
    if (hi - lo > 1) bar = xcd_barrier_post(ctl + CW_BAR + args.li * XCD_BAR_WORDS, MISC + 8, F.wave);
#define IN(k) (lo <= (k) && (k) < hi)
#ifdef PROBE_TS
#define STAMP(k) do { if (F.bid == 0 && F.tid == 0) ((unsigned long long*)(args.ws + (472u << 20)))[(k)] = __builtin_amdgcn_s_memrealtime(); } while (0)
#else
#define STAMP(k) do { } while (0)
#endif
#define SEAM(k) do { if (IN(k) && IN((k) + 1)) { xcd_barrier(bar); if (XTRA_BAR) xcd_barrier(bar); } STAMP((k) + 1); } while (0)
    unsigned char* ws = args.ws;
    bf16_t* P = (bf16_t*)(ws + WS_P);

#define REFRESH() do { int z_ = 0; asm volatile("" : "+s"(z_)); F.lane = (int)__builtin_amdgcn_mbcnt_hi(~0u, __builtin_amdgcn_mbcnt_lo(~0u, (unsigned)z_)); F.tid = F.wave * 64 + F.lane; } while (0)
    STAMP(0);
    if (IN(0)) { phase0(F, args); SEAM(0); }
    if (IN(1)) { REFRESH();
        if (F8_LO > 0) { pg8::Gemm g{(const bf16_t*)(ws + WS_N1), (const bf16_t*)(ws + WS_WIN), T_TOK, F8_LO * 256, D, D}; pg8::StaticOrder S; S.init(T_TOK, F8_LO * 256, F.G, F.bid);
            pg8::EpiProj E{P, (float*)(ws + WS_ALR), 0}; pg8::gemm_phase<pg8::EpiProj, pg8::StaticOrder, false, true, false>(F.lds, g, S, E, F.wave); }
        if (F8_LO < 21) {
            pg8::Gemm g{(const bf16_t*)(ws + WS_N18), (const bf16_t*)(ws + WS_W8 + (size_t)F8_LO * 256 * 1024), T_TOK, (21 - F8_LO) * 256, D / 2, D / 2, 0x7B7B7B7B, 0x75757575};
            pg8::StaticOrder S; S.init(T_TOK, (21 - F8_LO) * 256, F.G, ((F8_LO * 128) % F.G) != 0 ? F.G - 1 - F.bid : F.bid);
            pg8::EpiProj E{P, (float*)(ws + WS_ALR), F8_LO}; pg8::gemm_phase<pg8::EpiProj, pg8::StaticOrder, false, true, true>(F.lds, g, S, E, F.wave); }
        {
            REFRESH();
            const int nwg = (T_TOK / 256) * (NPROJ / 256), rem = nwg % F.G;
            if (rem == 0) convert_tables(F, args, F.bid * NWAVES + F.wave, F.G * NWAVES);
            else if (F.bid >= rem) convert_tables(F, args, (F.bid - rem) * NWAVES + F.wave, (F.G - rem) * NWAVES);
        }
        SEAM(1);
    }
    if (IN(2)) { REFRESH();
        if (DRY_EXP == 12) { gla_chunk_phase<true>(F, args); for (int it = F.bid; it < 256; it += F.G) for (int g4 = 0; g4 < 4; ++g4) sgu_unit<true>(F, args, 4 * it + g4, g4 == 0); __syncthreads(); }
        gla_chunk_phase<false>(F, args);
        for (int it = F.bid; it < 256; it += F.G) for (int g4 = 0; g4 < 4; ++g4) sgu_unit<false>(F, args, 4 * it + g4, g4 == 0);
        SEAM(2);
    }
    if (IN(3)) { REFRESH(); if (DRY_EXP == 13 || DRY_EXP == 15) { gla_scan<true>(F, args); __syncthreads(); } gla_scan<false>(F, args); SEAM(3); }
    if (IN(4)) { REFRESH(); if (DRY_EXP == 14 || DRY_EXP == 15) { gla_out_phase<true>(F, args); __syncthreads(); } gla_out_phase<false>(F, args); SEAM(4); }
    if (IN(5)) { REFRESH();
        { pg8::Gemm g{P + PC_R, (const bf16_t*)(ws + WS_WA), T_TOK, D, 1024, PLD}; pg8::StaticOrder S; S.init(T_TOK, D, F.G, F.bid);
          pg8::EpiBrAB E{P}; pg8::gemm_phase<pg8::EpiBrAB, pg8::StaticOrder, true, true, false, true>(F.lds, g, S, E, F.wave); }
        SEAM(5);
    }
    if (IN(6)) { REFRESH();
        pg8::Gemm g{P + PC_MRG, (const bf16_t*)(ws + WS_WOUT), T_TOK, D, D, PLD}; pg8::StaticOrder S; S.init(T_TOK, D, F.G, F.bid);
        pg8::EpiOut E{(bf16_t*)(ws + WS_N1)}; pg8::gemm_phase<pg8::EpiOut, pg8::StaticOrder, true, true>(F.lds, g, S, E, F.wave);
        SEAM(6);
    }
    if (IN(7)) { REFRESH();
        const int gw = F.bid * NWAVES + F.wave, NGW = F.G * NWAVES;
        { int m = gw; for (; m + 3 * NGW < T_TOK; m += 4 * NGW) rms_rows_to_bf16<(SC_F8 ? 2 : 3), 4>(F.lane, args.in[I_X] + (size_t)m * D, (size_t)NGW * D, args.in[I_N2G], (bf16_t*)(ws + WS_P + P_N2) + (size_t)m * D, (size_t)NGW * D, (unsigned*)(ws + WS_P + P_X8) + (size_t)m * 256, (size_t)NGW * 256, (const bf16_t*)(ws + WS_N1) + (size_t)m * D, (size_t)NGW * D, (bf16_t*)(ws + WS_P + P_HB) + (size_t)m * D, (size_t)NGW * D);
          for (; m < T_TOK; m += NGW) rms_rows_to_bf16<(SC_F8 ? 2 : 3), 1>(F.lane, args.in[I_X] + (size_t)m * D, 0, args.in[I_N2G], (bf16_t*)(ws + WS_P + P_N2) + (size_t)m * D, 0, (unsigned*)(ws + WS_P + P_X8) + (size_t)m * 256, 0, (const bf16_t*)(ws + WS_N1) + (size_t)m * D, 0, (bf16_t*)(ws + WS_P + P_HB) + (size_t)m * D, 0); }
        SEAM(7);
    }
    if (IN(8)) { REFRESH();
        pg8::StaticOrder S; S.init(T_TOK, 2048, F.G, F.bid); pg8::EpiScores E{(bf16_t*)(ws + WS_P + P_SC)};
        if (SC_F8) { pg8::Gemm g{(const bf16_t*)(ws + WS_P + P_X8), (const bf16_t*)(ws + WS_WQF), T_TOK, 2048, D / 2, D / 2, 0x7B7B7B7B, 0x75757575};
            pg8::gemm_phase<pg8::EpiScores, pg8::StaticOrder, true, true, true>(F.lds, g, S, E, F.wave); }
        else { pg8::Gemm g{(const bf16_t*)(ws + WS_P + P_N2), (const bf16_t*)(ws + WS_WQF), T_TOK, 2048, D, D};
            pg8::gemm_phase<pg8::EpiScores, pg8::StaticOrder, true, true>(F.lds, g, S, E, F.wave); }
        SEAM(8);
    }
    if (IN(9)) { REFRESH(); peer_topk(F, args); SEAM(9); }
    if (IN(10)) { REFRESH(); if constexpr (UNG == 1) peer_u4_all<0>(F, args); else peer_u4_phase<0>(F, args); SEAM(10); }
    if (IN(11)) { REFRESH(); if (V_F4) peer_v4_phase<0>(F, args); else { if (DRY_EXP == 1) { peer_v_phase<1>(F, args); __syncthreads(); } peer_v_phase<0>(F, args); SEAM(11); } }
    if (IN(12)) { REFRESH(); if (!V_F4) final_norm_phase(F, args); }
#undef IN
#undef SEAM
}


#ifdef PROBE_TS
__global__ void __launch_bounds__(512) probe_report(Args a, int pi, int pj) {
    const unsigned long long* ts = (const unsigned long long*)(a.ws + (472u << 20));
    const float X1 = 10.f * (float)(ts[pi + 1] - ts[pi]) * 0.01f, X2 = (float)(ts[pj + 1] - ts[pj]) * 0.01f;
    for (size_t i = (size_t)blockIdx.x * 512 + threadIdx.x; i < (size_t)T_TOK * D; i += (size_t)gridDim.x * 512) a.out[i] = (i == 0) ? X1 : X2;
}
#endif
#ifdef PROBE_MFMA
__global__ void __launch_bounds__(64) probe_mfma(Args a) {
    const int l = threadIdx.x;
    i32x4 av = {0, 0, 0, 0};
    if (l == PROBE_L) av[PROBE_P >> 3] = 0x2 << (4 * (PROBE_P & 7));
    i32x8 b1, b2;
    for (int r = 0; r < 8; ++r) { unsigned w1 = 0, w2 = 0;
        for (int c = 0; c < 4; ++c) { const int b = 4 * r + c; int t = 0;
            t = __builtin_amdgcn_cvt_pk_fp8_f32((float)((b & 15) + 1), (float)(1 + (b >> 4) + 2 * (l >> 4)), 0, false);
            w1 |= ((unsigned)t & 0xffu) << (8 * c); w2 |= (((unsigned)t >> 8) & 0xffu) << (8 * c); }
        b1[r] = (int)w1; b2[r] = (int)w2; }
    const f32x4 z = {0.f, 0.f, 0.f, 0.f};
    const f32x4 d1 = __builtin_amdgcn_mfma_scale_f32_16x16x128_f8f6f4(__builtin_shufflevector(av, av, 0, 1, 2, 3, -1, -1, -1, -1), b1, z, 4, 0, 0, 0x7F7F7F7F, 0, 0x7F7F7F7F);
    const f32x4 d2 = __builtin_amdgcn_mfma_scale_f32_16x16x128_f8f6f4(__builtin_shufflevector(av, av, 0, 1, 2, 3, -1, -1, -1, -1), b2, z, 4, 0, 0, 0x7F7F7F7F, 0, 0x7F7F7F7F);
    float* st = (float*)(a.ws + (472u << 20));
    *(f32x4*)(st + 8 * l) = d1; *(f32x4*)(st + 8 * l + 4) = d2;
}
__global__ void __launch_bounds__(512) probe_mfma_report(Args a) {
    const int row = PROBE_L & 15;
    const float* st = (const float*)(a.ws + (472u << 20)) + 8 * (16 * (row >> 2)) + (row & 3); const float X1 = 10.f * st[0], X2 = st[4];
    for (size_t i = (size_t)blockIdx.x * 512 + threadIdx.x; i < (size_t)T_TOK * D; i += (size_t)gridDim.x * 512) a.out[i] = (i == 0) ? X1 : X2;
}
#endif
extern "C" void kernel_launch(void* const* d_in, const int* in_sizes, int n_in, void* d_out, int out_size, void* d_ws, size_t ws_size, hipStream_t stream) {
    static int grid = 0;
    if (grid == 0) {
        if (n_in != 20 || in_sizes[0] != T_TOK * D || out_size != T_TOK * D || ws_size < WS_END) {
            fprintf(stderr, "kernel_launch: unexpected shapes: n_in %d in0 %d out %d ws %zu (need %zu)\n", n_in, n_in > 0 ? in_sizes[0] : -1, out_size, ws_size, (size_t)WS_END); grid = -1; return; }
        int dev = 0, cus = 0;
        if (hipGetDevice(&dev) != hipSuccess || hipDeviceGetAttribute(&cus, hipDeviceAttributeMultiprocessorCount, dev) != hipSuccess) { grid = -1; return; }
        if (hipFuncSetAttribute((const void*)fwd_kernel, hipFuncAttributeMaxDynamicSharedMemorySize, LDS_BYTES) != hipSuccess) { fprintf(stderr, "kernel_launch: hipFuncSetAttribute failed\n"); grid = -1; return; }
        int per_cu = 0;
        if (hipOccupancyMaxActiveBlocksPerMultiprocessor(&per_cu, (const void*)fwd_kernel, NWAVES * 64, LDS_BYTES) != hipSuccess || per_cu < 1) fprintf(stderr, "kernel_launch: occupancy query says %d\n", per_cu);
        (void)hipGetLastError();
        grid = cus;
    }
    if (grid < 0) return;
    (void)hipMemsetAsync((char*)d_ws + WS_CTL, 0, CTL_ZERO_BYTES, stream);
    Args a{};
    for (int i = 0; i < 20; ++i) a.in[i] = (const float*)d_in[i];
    a.out = (float*)d_out; a.ws = (unsigned char*)d_ws;
#ifdef PROBE_MFMA
    hipLaunchKernelGGL(probe_mfma, dim3(1), dim3(64), 0, stream, a);
    hipLaunchKernelGGL(probe_mfma_report, dim3(1024), dim3(512), 0, stream, a);
    return;
#endif
#ifndef LAUNCH_LIST
#define LAUNCH_LIST {0, NPH}
#endif
    static const int ranges[][2] = { LAUNCH_LIST };
    const int nl = (int)(sizeof(ranges) / sizeof(ranges[0]));
    for (int li = 0; li < nl; ++li) { a.ph_lo = ranges[li][0]; a.ph_hi = ranges[li][1]; a.li = li;
        hipLaunchKernelGGL(fwd_kernel, dim3(grid), dim3(NWAVES * 64), LDS_BYTES, stream, a); }
}
```

```cpp
#include <hip/hip_runtime.h>
#include <cstdio>
#include <cstdint>


#ifndef XTRA_BAR
#define XTRA_BAR 0
#endif
#ifndef DRY_EXP
#define DRY_EXP 0
#endif
#ifndef DUP_PHASE
#define DUP_PHASE -1
#endif
#ifndef MK_N_LAUNCHES
#define MK_N_LAUNCHES 1
#endif

#define LAS __attribute__((address_space(3)))
#define GAS __attribute__((address_space(1)))
typedef unsigned short bf16_t;
typedef short bf16x8 __attribute__((ext_vector_type(8)));
typedef float f32x4 __attribute__((ext_vector_type(4)));
typedef float f32x2 __attribute__((ext_vector_type(2)));
typedef unsigned u32x4 __attribute__((ext_vector_type(4)));
typedef unsigned u32x2 __attribute__((ext_vector_type(2)));
typedef int i32x4 __attribute__((ext_vector_type(4)));
typedef int i32x8 __attribute__((ext_vector_type(8)));
typedef __bf16 bf16x2_t __attribute__((ext_vector_type(2)));

constexpr int T_TOK = 32768, D = 1024, SEQ = 4096, NBATCH = 8;
constexpr int NPROJ = 5376;
constexpr int PLD = 5120;
constexpr int PC_Q = 0, PC_K = 512, PC_V = 1024, PC_R = 1536, PC_SU = 2048, PC_SV = 2560, PC_GA = 3072, PC_GB = 4096;
constexpr int PC_MRG = 512;
constexpr float EPS = 1e-6f;
constexpr int NEXP = 16384;
#ifndef U_NG
#define U_NG 1
#endif
#ifndef V_F4
#define V_F4 1
#endif
#ifndef SC_F8
#define SC_F8 0
#endif
#ifndef F8_LO
#define F8_LO 11
#endif
static_assert(U_NG == 1, "only the one-group U phase applies RMSNorm-2's rstd");
constexpr int UNG = U_NG, UNG_SH = (U_NG == 8 ? 3 : (U_NG == 4 ? 2 : (U_NG == 2 ? 1 : 0)));

constexpr size_t MiB = 1u << 20;
constexpr size_t WS_RSS = 64 * 1024;
constexpr size_t WS_CTL = 0, CTL_ZERO_BYTES = 64 * 1024 + 128 * 1024;
constexpr size_t WS_WIN = 1 * MiB;
constexpr size_t WS_WA = 12 * MiB;
constexpr size_t WS_WB = 13 * MiB;
constexpr size_t WS_WOUT = 14 * MiB;
constexpr size_t WS_WQF = 16 * MiB;
constexpr size_t WS_U8 = 20 * MiB;
constexpr size_t WS_V8 = 36 * MiB;
constexpr size_t WS_SU = 52 * MiB;
constexpr size_t WS_SV = 52 * MiB + 65536;
constexpr size_t WS_AK = 53 * MiB;
constexpr size_t WS_DEC = 84 * MiB;
constexpr size_t WS_ALR = 85 * MiB;
constexpr size_t WS_N1 = 87 * MiB;
constexpr size_t WS_P = 151 * MiB;
constexpr size_t WS_W8 = 472 * MiB;
constexpr size_t WS_N18 = 478 * MiB;
constexpr size_t WS_END = 510 * MiB;
constexpr size_t P_HB = 192 * MiB;
constexpr size_t P_N2 = 128 * MiB;
constexpr size_t P_SC = 0, P_IDX = 256 * MiB, P_GATE = 272 * MiB, P_X8 = 288 * MiB;

constexpr int CW_BAR = 4096;

constexpr int RING_BYTES = 131072;
constexpr int LDSCTL_OFF = RING_BYTES, MISC_OFF = LDSCTL_OFF + 320;
constexpr int LDS_BYTES = 147456;
constexpr int NWAVES = 8;

__device__ __forceinline__ unsigned pk2(float lo, float hi) { const f32x2 v = {lo, hi}; const bf16x2_t b = __builtin_convertvector(v, bf16x2_t); return __builtin_bit_cast(unsigned, b); }
__device__ __forceinline__ unsigned f2bf(float f) { return pk2(f, 0.f) & 0xffffu; }
__device__ __forceinline__ float bflo(unsigned w) { return __builtin_bit_cast(float, w << 16); }
__device__ __forceinline__ float bfhi(unsigned w) { return __builtin_bit_cast(float, w & 0xffff0000u); }
__device__ __forceinline__ float bf1(bf16_t h) { return __builtin_bit_cast(float, ((unsigned)h) << 16); }
__device__ __forceinline__ float sigmoidf_(float x) { return __builtin_amdgcn_rcpf(1.f + __expf(-x)); }
__device__ __forceinline__ float gelu_tanh(float x) { const float y = 1.5957691216057308f * (x + 0.044715f * x * x * x); return x * sigmoidf_(y); }
__device__ __forceinline__ float siluf_(float x) { return x * sigmoidf_(x); }
__device__ __forceinline__ float wave_sum(float v) {
#pragma unroll
    for (int o = 1; o < 64; o <<= 1) v += __shfl_xor(v, o);
    return v;
}
#define LDS_WAIT() asm volatile("s_waitcnt lgkmcnt(0)" ::: "memory")
#define VM_WAIT() asm volatile("s_waitcnt vmcnt(0)" ::: "memory")

__device__ __forceinline__ int lane_now() { int z = 0; asm volatile("" : "+s"(z)); return (int)__builtin_amdgcn_mbcnt_hi(~0u, __builtin_amdgcn_mbcnt_lo(~0u, (unsigned)z)); }
namespace pg8 {
constexpr int BM = 256, BK = 64, HALF = 128, HTB = HALF * BK * 2, STAGE_BYTES = 8 * HTB, NXCD = 8, WGM = 8;
__host__ __device__ __forceinline__ int lds_byte(int r, int c) { const int st = (r >> 4) * 2 + (c >> 5), rr = r & 15, cc = c & 31, ob = rr * 64 + cc * 2; return st * 1024 + (ob ^ (((ob >> 9) & 1) << 5)); }
__host__ __device__ __forceinline__ void stage_rc(int b, int& R, int& C) { const int st = b / 1024, sb = b % 1024, swz = sb ^ (((sb >> 9) & 1) << 5); R = (st >> 1) * 16 + swz / 64; C = (st & 1) * 32 + (swz % 64) / 2; }
__host__ __device__ __forceinline__ int perm32(int rho) { const int n = rho >> 4, i = rho & 15; return 8 * (i >> 2) + 4 * n + (i & 3); }

struct Unit { int pm, pn; };
struct Gemm { const bf16_t* A; const bf16_t* Bt; int M, N, K, lda; int sa = 0, sb = 0; };

struct StaticOrder {
    int nM, nN, nwg, G, c;
    __host__ __device__ void init(int M, int N, int G_, int c_) { nM = M / BM; nN = N / BM; nwg = nM * nN; G = G_; c = c_; }
    __host__ __device__ bool next(int i, Unit& u) const {
        const long L = (long)i * G + c; if (L >= nwg) return false;
        int wgid = (int)L; { const int q = nwg / NXCD, r = nwg % NXCD, xcd = wgid % NXCD, off = wgid / NXCD; wgid = (xcd < r ? xcd * (q + 1) : r * (q + 1) + (xcd - r) * q) + off; }
        const int nig = WGM * nN, gid = wgid / nig, fm = gid * WGM, gsz = (nM - fm) < WGM ? (nM - fm) : WGM;
        u.pm = fm + ((wgid % nig) % gsz); u.pn = (wgid % nig) / gsz; return true;
    }
    __device__ __forceinline__ void a_ready(const Unit&) const {}
    __device__ __forceinline__ void done(const Unit&) const {}
};

template <class Epi, class Sched, bool ALIGN_EPI = false, bool SP2 = false, bool F8 = false, bool MID = false>
__device__ __forceinline__ void gemm_phase(LAS unsigned char* lds, const Gemm g, const Sched& S, const Epi& E, int wave_id) {
    const int wid = wave_id, lane = lane_now(), tid = wid * 64 + lane, wr = wid >> 2, wc = wid & 3, fr = lane & 15, fq = lane >> 4;
    const int K = g.K, nt = K / BK, lda = g.lda; const int scAB = (g.sb & 0xff) | ((g.sa & 0xff) << 8); (void)scAB;
    unsigned voffA[1], voffB[1];
    { int R, C; stage_rc(tid * 16, R, C); const int Rb = Epi::PERM ? ((R & ~31) + perm32(R & 31)) : R;
        voffA[0] = (unsigned)(R * lda + C) * 2u; voffB[0] = (unsigned)(Rb * K + C) * 2u; }
    const size_t dltA = (size_t)64 * lda * 2, dltB = (size_t)64 * K * 2;
    const size_t kstep = (size_t)(BK * 2);
    const size_t hstepA = (size_t)HALF * lda * 2, hstepB = (size_t)HALF * K * 2;
    const size_t tstepA = 2 * hstepA, tstepB = 2 * hstepB;
    const unsigned ldsw = (unsigned)wid * 1024u; const unsigned ldsbase = (unsigned)(__UINTPTR_TYPE__)lds + ldsw;
    const int aoff = lds_byte(wr * 64 + fr, fq * 8), boff = lds_byte(wc * 32 + fr, fq * 8);
#define PG8_SA(b, h) (((b) * 2 + (h)) * HTB)
#define PG8_SB(b, h) ((4 + (b) * 2 + (h)) * HTB)
#define PG8_STAGE(bufoff, gbase, voff) do { _Pragma("unroll") for (int _i = 0; _i < 2; ++_i) \
        asm volatile("s_mov_b32 m0, %2\n\ts_nop 0\n\tglobal_load_lds_dwordx4 %0, %1" :: "v"((voff)[0]), "s"((const char*)(gbase) + (size_t)_i * ((voff) == voffA ? dltA : dltB)), "s"(ldsbase + (unsigned)((bufoff) + _i * 8192)) : "memory", "m0"); } while (0)
#define PG8_LDA(dst, b, h) do { _Pragma("unroll") for (int m = 0; m < 4; ++m) _Pragma("unroll") for (int k = 0; k < 2; ++k) dst[m][k] = *(const LAS bf16x8*)(lds + PG8_SA(b, h) + aoff + m * 2048 + k * 1024); } while (0)
#define PG8_LDB(dst, b, h) do { _Pragma("unroll") for (int n = 0; n < 2; ++n) _Pragma("unroll") for (int k = 0; k < 2; ++k) dst[n][k] = *(const LAS bf16x8*)(lds + PG8_SB(b, h) + boff + n * 2048 + k * 1024); } while (0)
#define PG8_CAT(x) __builtin_shufflevector(__builtin_bit_cast(i32x4, (x)[0]), __builtin_bit_cast(i32x4, (x)[1]), 0, 1, 2, 3, 4, 5, 6, 7)
#define PG8_MMA(ai, bj, At, Bt) do { __builtin_amdgcn_s_setprio(1); if constexpr (F8) { _Pragma("unroll") for (int m = 0; m < 4; ++m) _Pragma("unroll") for (int n = 0; n < 2; ++n) \
        acc[ai][bj][m][n] = __builtin_amdgcn_mfma_scale_f32_16x16x128_f8f6f4(PG8_CAT(Bt[n]), PG8_CAT(At[m]), acc[ai][bj][m][n], 0, 0, 0, scAB, 1, scAB); } else { \
        _Pragma("unroll") for (int m = 0; m < 4; ++m) _Pragma("unroll") for (int n = 0; n < 2; ++n) _Pragma("unroll") for (int k = 0; k < 2; ++k) \
        acc[ai][bj][m][n] = __builtin_amdgcn_mfma_f32_16x16x32_bf16(Bt[n][k], At[m][k], acc[ai][bj][m][n], 0, 0, 0); } __builtin_amdgcn_s_setprio(0); } while (0)
#define PG8_WAIT_V(n) asm volatile("s_waitcnt vmcnt(" #n ")" ::: "memory")
#define PG8_WAIT_L(n) asm volatile("s_waitcnt lgkmcnt(" #n ")" ::: "memory")
#define PG8_BAR __builtin_amdgcn_s_barrier()
#define PG8_SCHED __builtin_amdgcn_sched_barrier(0)
    Unit cur, nxt; int ui = 0;
    if (!S.next(0, cur)) return;
    f32x4 acc[2][2][4][2];
#pragma unroll
    for (int a = 0; a < 2; ++a)
#pragma unroll
        for (int b = 0; b < 2; ++b)
#pragma unroll
            for (int m = 0; m < 4; ++m)
#pragma unroll
                for (int n = 0; n < 2; ++n) acc[a][b][m][n] = (f32x4){0.f, 0.f, 0.f, 0.f};
    bf16x8 At[4][2], B0[2][2], B1[2][2];
    const char* cA = (const char*)g.A + (size_t)cur.pm * tstepA; const char* cB = (const char*)g.Bt + (size_t)cur.pn * tstepB;
    S.a_ready(cur);
    if constexpr (SP2) {
        PG8_STAGE(PG8_SB(0, 0), cB, voffB); PG8_STAGE(PG8_SB(0, 1), cB + hstepB, voffB); PG8_STAGE(PG8_SA(0, 0), cA, voffA); PG8_STAGE(PG8_SA(0, 1), cA + hstepA, voffA);
        if (wr == 1) PG8_BAR;
        PG8_WAIT_V(2); PG8_BAR;
        PG8_STAGE(PG8_SB(1, 0), cB + kstep, voffB); PG8_STAGE(PG8_SA(1, 0), cA + kstep, voffA); PG8_STAGE(PG8_SB(1, 1), cB + hstepB + kstep, voffB);
        PG8_WAIT_V(6); PG8_BAR;
    } else {
        PG8_STAGE(PG8_SB(0, 0), cB, voffB); PG8_STAGE(PG8_SA(0, 0), cA, voffA); PG8_STAGE(PG8_SB(0, 1), cB + hstepB, voffB); PG8_STAGE(PG8_SA(0, 1), cA + hstepA, voffA);
        if (wr == 1) PG8_BAR;
        PG8_WAIT_V(4); PG8_BAR;
        PG8_STAGE(PG8_SB(1, 0), cB + kstep, voffB); PG8_STAGE(PG8_SA(1, 0), cA + kstep, voffA); PG8_STAGE(PG8_SB(1, 1), cB + hstepB + kstep, voffB);
        PG8_WAIT_V(6); PG8_BAR;
    }
    for (;;) {
        const bool has_next = S.next(ui + 1, nxt);
        const char* nA = has_next ? (const char*)g.A + (size_t)nxt.pm * tstepA : cA; const char* nB = has_next ? (const char*)g.Bt + (size_t)nxt.pn * tstepB : cB;
#pragma nounroll
        for (int t = 0; t < nt; t += 2) {
            if constexpr (MID) { if (t == (nt >> 1)) E.mid(acc, cur, wr, wc); }
            const bool last = (t == nt - 2);
            const char* a1 = cA + (size_t)(t + 1) * kstep;
            const char* a2 = last ? nA : cA + (size_t)(t + 2) * kstep; const char* b2 = last ? nB : cB + (size_t)(t + 2) * kstep;
            const char* a3 = a2 + kstep; const char* b3 = b2 + kstep;
            if (last && has_next) S.a_ready(nxt);
            if constexpr (SP2) {
            PG8_LDB(B0, 0, 0); PG8_LDB(B1, 0, 1); PG8_SCHED; PG8_LDA(At, 0, 0); PG8_STAGE(PG8_SA(1, 1), a1 + hstepA, voffA);
            PG8_WAIT_V(8); PG8_WAIT_L(0); PG8_BAR; PG8_MMA(0, 0, At, B0); PG8_MMA(0, 1, At, B1); PG8_BAR; PG8_SCHED;
            PG8_LDA(At, 0, 1); PG8_STAGE(PG8_SB(0, 0), b2, voffB); PG8_STAGE(PG8_SB(0, 1), b2 + hstepB, voffB); PG8_STAGE(PG8_SA(0, 0), a2, voffA);
            PG8_WAIT_V(8); PG8_WAIT_L(0); PG8_BAR; PG8_MMA(1, 0, At, B0); PG8_MMA(1, 1, At, B1); PG8_BAR; PG8_SCHED;
            PG8_LDB(B0, 1, 0); PG8_LDB(B1, 1, 1); PG8_SCHED; PG8_LDA(At, 1, 0); PG8_STAGE(PG8_SA(0, 1), a2 + hstepA, voffA);
            PG8_WAIT_V(8); PG8_WAIT_L(0); PG8_BAR; PG8_MMA(0, 0, At, B0); PG8_MMA(0, 1, At, B1); PG8_BAR; PG8_SCHED;
            PG8_LDA(At, 1, 1); PG8_STAGE(PG8_SB(1, 0), b3, voffB); PG8_STAGE(PG8_SB(1, 1), b3 + hstepB, voffB); PG8_STAGE(PG8_SA(1, 0), a3, voffA);
            PG8_WAIT_V(8); PG8_WAIT_L(0); PG8_BAR; PG8_MMA(1, 0, At, B0); PG8_MMA(1, 1, At, B1); PG8_BAR; PG8_SCHED;
            } else {
            PG8_LDB(B0, 0, 0); PG8_SCHED; PG8_LDA(At, 0, 0); PG8_STAGE(PG8_SA(1, 1), a1 + hstepA, voffA);
            PG8_WAIT_L(8); PG8_BAR; PG8_WAIT_L(0); PG8_MMA(0, 0, At, B0); PG8_BAR; PG8_SCHED;
            PG8_LDB(B1, 0, 1); PG8_STAGE(PG8_SB(0, 0), b2, voffB);
            PG8_BAR; PG8_WAIT_L(0); PG8_MMA(0, 1, At, B1); PG8_BAR;
            PG8_LDA(At, 0, 1); PG8_STAGE(PG8_SA(0, 0), a2, voffA);
            PG8_BAR; PG8_WAIT_L(0); PG8_MMA(1, 0, At, B0); PG8_BAR; PG8_SCHED;
            PG8_STAGE(PG8_SB(0, 1), b2 + hstepB, voffB);
            PG8_WAIT_V(6); PG8_BAR; PG8_MMA(1, 1, At, B1); PG8_BAR;
            PG8_LDB(B0, 1, 0); PG8_SCHED; PG8_LDA(At, 1, 0); PG8_STAGE(PG8_SA(0, 1), a2 + hstepA, voffA);
            PG8_WAIT_L(8); PG8_BAR; PG8_WAIT_L(0); PG8_MMA(0, 0, At, B0); PG8_BAR; PG8_SCHED;
            PG8_LDB(B1, 1, 1); PG8_STAGE(PG8_SB(1, 0), b3, voffB);
            PG8_BAR; PG8_WAIT_L(0); PG8_MMA(0, 1, At, B1); PG8_BAR;
            PG8_LDA(At, 1, 1); PG8_STAGE(PG8_SA(1, 0), a3, voffA);
            PG8_BAR; PG8_WAIT_L(0); PG8_MMA(1, 0, At, B0); PG8_BAR; PG8_SCHED;
            PG8_STAGE(PG8_SB(1, 1), b3 + hstepB, voffB);
            PG8_WAIT_V(6); PG8_BAR; PG8_MMA(1, 1, At, B1); PG8_BAR;
            }
        }
        if constexpr (ALIGN_EPI) { if (wr == 0) PG8_BAR; }
        E(acc, cur, wr, wc, fr, fq); S.done(cur);
        if (!has_next) break;
#pragma unroll
        for (int a = 0; a < 2; ++a)
#pragma unroll
            for (int b = 0; b < 2; ++b)
#pragma unroll
                for (int m = 0; m < 4; ++m)
#pragma unroll
                    for (int n = 0; n < 2; ++n) acc[a][b][m][n] = (f32x4){0.f, 0.f, 0.f, 0.f};
        cur = nxt; cA = nA; cB = nB; ++ui;
        if constexpr (ALIGN_EPI) { if (wr == 1) PG8_BAR; }
    }
    PG8_WAIT_V(0);
    if constexpr (!ALIGN_EPI) { if (wr == 0) PG8_BAR; }
    PG8_BAR;
#undef PG8_SA
#undef PG8_SB
#undef PG8_STAGE
#undef PG8_LDA
#undef PG8_LDB
#undef PG8_MMA
#undef PG8_CAT
#undef PG8_WAIT_V
#undef PG8_WAIT_L
#undef PG8_BAR
#undef PG8_SCHED
}

__device__ __forceinline__ u32x4 pack8(f32x4 v0, f32x4 v1) { u32x4 w; w.x = pk2(v0[0], v0[1]); w.y = pk2(v0[2], v0[3]); w.z = pk2(v1[0], v1[1]); w.w = pk2(v1[2], v1[3]); return w; }
__device__ __forceinline__ void unpack8(u32x4 w, f32x4& v0, f32x4& v1) { v0 = (f32x4){bflo(w.x), bfhi(w.x), bflo(w.y), bfhi(w.y)}; v1 = (f32x4){bflo(w.z), bfhi(w.z), bflo(w.w), bfhi(w.w)}; }

struct EpiProj {
    static constexpr bool PERM = true;
    bf16_t* P; float* ALR; int pn0;
    __device__ __forceinline__ void operator()(const f32x4 (&acc)[2][2][4][2], const Unit& u, int wr, int wc, int fr, int fq) const {
        { const int ln = lane_now(); fr = ln & 15; fq = ln >> 4; }
        const int row0 = u.pm * BM + wr * 64 + fr; int pn = u.pn + pn0; const int cl = wc * 32 + 8 * fq;
        if (pn == 10) {
            if (wc == 0 && fq < 2) {
#pragma unroll
                for (int ai = 0; ai < 2; ++ai)
#pragma unroll
                    for (int m = 0; m < 4; ++m) { float* rp = ALR + (size_t)(row0 + ai * HALF + m * 16) * 16 + 8 * fq;
                        *(f32x4*)rp = acc[ai][0][m][0]; *(f32x4*)(rp + 4) = acc[ai][0][m][1]; }
            }
            return;
        }
        if (pn > 10) --pn;
        const int mode = pn < 8 ? 0 : (pn < 12 ? 1 : 2);
#pragma unroll
        for (int ai = 0; ai < 2; ++ai)
#pragma unroll
            for (int m = 0; m < 4; ++m) { bf16_t* rowp = P + (size_t)(row0 + ai * HALF + m * 16) * PLD + pn * BM + cl;
#pragma unroll
                for (int bj = 0; bj < 2; ++bj) { f32x4 v0 = acc[ai][bj][m][0], v1 = acc[ai][bj][m][1];
                    if (mode == 1) {
#pragma unroll
                        for (int i = 0; i < 4; ++i) { v0[i] = gelu_tanh(v0[i]); v1[i] = gelu_tanh(v1[i]); }
                    } else if (mode == 2) {
                        unsigned w0 = 0, w1 = 0;
                        w0 = __builtin_amdgcn_cvt_pk_u8_f32(sigmoidf_(v0[0]) * 255.f, 0, w0); w0 = __builtin_amdgcn_cvt_pk_u8_f32(sigmoidf_(v0[1]) * 255.f, 1, w0); w0 = __builtin_amdgcn_cvt_pk_u8_f32(sigmoidf_(v0[2]) * 255.f, 2, w0); w0 = __builtin_amdgcn_cvt_pk_u8_f32(sigmoidf_(v0[3]) * 255.f, 3, w0);
                        w1 = __builtin_amdgcn_cvt_pk_u8_f32(sigmoidf_(v1[0]) * 255.f, 0, w1); w1 = __builtin_amdgcn_cvt_pk_u8_f32(sigmoidf_(v1[1]) * 255.f, 1, w1); w1 = __builtin_amdgcn_cvt_pk_u8_f32(sigmoidf_(v1[2]) * 255.f, 2, w1); w1 = __builtin_amdgcn_cvt_pk_u8_f32(sigmoidf_(v1[3]) * 255.f, 3, w1);
                        unsigned char* bp = (unsigned char*)(P + (size_t)(row0 + ai * HALF + m * 16) * PLD) + (pn < 16 ? PC_GA * 2 + (pn - 12) * BM : PC_GB * 2 + (pn - 16) * BM) + cl + bj * HALF;
                        *(u32x2*)bp = (u32x2){w0, w1}; continue;
                    }
                    *(u32x4*)(rowp + bj * HALF) = pack8(v0, v1); } }
    }
};
struct EpiBrA {
    static constexpr bool PERM = true;
    bf16_t* P;
    __device__ __forceinline__ void operator()(const f32x4 (&acc)[2][2][4][2], const Unit& u, int wr, int wc, int fr, int fq) const {
        const int row0 = u.pm * BM + wr * 64 + fr; const int c0 = u.pn * BM + wc * 32 + 8 * fq;
#pragma unroll
        for (int ai = 0; ai < 2; ++ai)
#pragma unroll
            for (int m = 0; m < 4; ++m) { bf16_t* rowp = P + (size_t)(row0 + ai * HALF + m * 16) * PLD;
#pragma unroll
                for (int bj = 0; bj < 2; ++bj) { const int c = c0 + bj * HALF; f32x4 g0, g1; unpack8(*(const u32x4*)(rowp + PC_GA + c), g0, g1);
                    *(u32x4*)(rowp + PC_MRG + c) = pack8(acc[ai][bj][m][0] * g0, acc[ai][bj][m][1] * g1); } }
    }
};
struct EpiBrB {
    static constexpr bool PERM = true;
    bf16_t* P;
    __device__ __forceinline__ void operator()(const f32x4 (&acc)[2][2][4][2], const Unit& u, int wr, int wc, int fr, int fq) const {
        const int row0 = u.pm * BM + wr * 64 + fr; const int c0 = u.pn * BM + wc * 32 + 8 * fq;
#pragma unroll
        for (int ai = 0; ai < 2; ++ai)
#pragma unroll
            for (int m = 0; m < 4; ++m) { bf16_t* rowp = P + (size_t)(row0 + ai * HALF + m * 16) * PLD;
#pragma unroll
                for (int bj = 0; bj < 2; ++bj) { const int c = c0 + bj * HALF; f32x4 g0, g1, p0, p1; unpack8(*(const u32x4*)(rowp + PC_GB + c), g0, g1); unpack8(*(const u32x4*)(rowp + PC_MRG + c), p0, p1);
                    *(u32x4*)(rowp + PC_MRG + c) = pack8(p0 + acc[ai][bj][m][0] * g0, p1 + acc[ai][bj][m][1] * g1); } }
    }
};
struct EpiBrAB {
    static constexpr bool PERM = true;
    bf16_t* P;
    static __device__ __forceinline__ void u8x8(const u32x2 w, f32x4& f0, f32x4& f1) {
        f0 = (f32x4){(float)(w.x & 0xffu), (float)((w.x >> 8) & 0xffu), (float)((w.x >> 16) & 0xffu), (float)(w.x >> 24)};
        f1 = (f32x4){(float)(w.y & 0xffu), (float)((w.y >> 8) & 0xffu), (float)((w.y >> 16) & 0xffu), (float)(w.y >> 24)}; }
    __device__ __forceinline__ void mid(f32x4 (&acc)[2][2][4][2], const Unit& u, int wr, int wc) const {
        const int ln = lane_now(), fr = ln & 15, fq = ln >> 4;
        const int row0 = u.pm * BM + wr * 64 + fr; const int c0 = u.pn * BM + wc * 32 + 8 * fq;
#pragma unroll
        for (int ai = 0; ai < 2; ++ai)
#pragma unroll
            for (int m = 0; m < 4; ++m) { const unsigned char* rowb = (const unsigned char*)(P + (size_t)(row0 + ai * HALF + m * 16) * PLD);
#pragma unroll
                for (int bj = 0; bj < 2; ++bj) { const int c = c0 + bj * HALF; f32x4 a0, a1, b0, b1; u8x8(*(const u32x2*)(rowb + PC_GA * 2 + c), a0, a1); u8x8(*(const u32x2*)(rowb + PC_GB * 2 + c), b0, b1);
#pragma unroll
                    for (int i = 0; i < 4; ++i) { acc[ai][bj][m][0][i] *= a0[i] * __builtin_amdgcn_rcpf(fmaxf(b0[i], 1.f)); acc[ai][bj][m][1][i] *= a1[i] * __builtin_amdgcn_rcpf(fmaxf(b1[i], 1.f)); } } }
    }
    __device__ __forceinline__ void operator()(const f32x4 (&acc)[2][2][4][2], const Unit& u, int wr, int wc, int fr, int fq) const {
        { const int ln = lane_now(); fr = ln & 15; fq = ln >> 4; }
        const int row0 = u.pm * BM + wr * 64 + fr; const int c0 = u.pn * BM + wc * 32 + 8 * fq;
#pragma unroll
        for (int ai = 0; ai < 2; ++ai)
#pragma unroll
            for (int m = 0; m < 4; ++m) { bf16_t* rowp = P + (size_t)(row0 + ai * HALF + m * 16) * PLD;
#pragma unroll
                for (int bj = 0; bj < 2; ++bj) { const int c = c0 + bj * HALF; f32x4 g0, g1; u8x8(*(const u32x2*)((const unsigned char*)rowp + PC_GB * 2 + c), g0, g1);
#pragma unroll
                    for (int i = 0; i < 4; ++i) { g0[i] = fmaxf(g0[i], 1.f) * (1.f / 255.f); g1[i] = fmaxf(g1[i], 1.f) * (1.f / 255.f); }
                    *(u32x4*)(rowp + PC_MRG + c) = pack8(acc[ai][bj][m][0] * g0, acc[ai][bj][m][1] * g1); } }
    }
};
struct EpiOut {
    static constexpr bool PERM = true;
    const float* X; bf16_t* HB; unsigned char* X8; float* RSS;
    __device__ __forceinline__ void operator()(const f32x4 (&acc)[2][2][4][2], const Unit& u, int wr, int wc, int fr, int fq) const {
        { const int ln = lane_now(); fr = ln & 15; fq = ln >> 4; }
        const int row0 = u.pm * BM + wr * 64 + fr; const int c0 = u.pn * BM + wc * 32 + 8 * fq;
#pragma unroll
        for (int ai = 0; ai < 2; ++ai)
#pragma unroll
            for (int m = 0; m < 4; ++m) { const int row = row0 + ai * HALF + m * 16; const size_t ro = (size_t)row * D; float ss = 0.f;
#pragma unroll
                for (int bj = 0; bj < 2; ++bj) { const int c = c0 + bj * HALF;
                    const f32x4 h0 = *(const f32x4*)(X + ro + c) + acc[ai][bj][m][0], h1 = *(const f32x4*)(X + ro + c + 4) + acc[ai][bj][m][1];
                    ss += (h0.x * h0.x + h0.y * h0.y) + (h0.z * h0.z + h0.w * h0.w) + (h1.x * h1.x + h1.y * h1.y) + (h1.z * h1.z + h1.w * h1.w);
                    *(u32x4*)(HB + ro + c) = pack8(h0, h1);
                    u32x2 w8; int w = 0;
                    w = __builtin_amdgcn_cvt_pk_fp8_f32(__builtin_amdgcn_fmed3f(h0.x * 16.f, -448.f, 448.f), __builtin_amdgcn_fmed3f(h0.y * 16.f, -448.f, 448.f), w, false); w = __builtin_amdgcn_cvt_pk_fp8_f32(__builtin_amdgcn_fmed3f(h0.z * 16.f, -448.f, 448.f), __builtin_amdgcn_fmed3f(h0.w * 16.f, -448.f, 448.f), w, true); w8.x = (unsigned)w;
                    w = 0; w = __builtin_amdgcn_cvt_pk_fp8_f32(__builtin_amdgcn_fmed3f(h1.x * 16.f, -448.f, 448.f), __builtin_amdgcn_fmed3f(h1.y * 16.f, -448.f, 448.f), w, false); w = __builtin_amdgcn_cvt_pk_fp8_f32(__builtin_amdgcn_fmed3f(h1.z * 16.f, -448.f, 448.f), __builtin_amdgcn_fmed3f(h1.w * 16.f, -448.f, 448.f), w, true); w8.y = (unsigned)w;
                    *(u32x2*)(X8 + ro + c) = w8; }
                ss += __shfl_xor(ss, 16); ss += __shfl_xor(ss, 32);
                if (fq == 0) (void)__hip_atomic_fetch_add(RSS + row, ss, __ATOMIC_RELAXED, __HIP_MEMORY_SCOPE_AGENT); }
    }
};
struct EpiScores {
    static constexpr bool PERM = true;
    bf16_t* SC;
    const float* RSS;
    __device__ __forceinline__ void operator()(const f32x4 (&acc)[2][2][4][2], const Unit& u, int wr, int wc, int fr, int fq) const {
        const int tb0 = u.pm * 16 + wr * 4; const int cq0 = (u.pn * BM + wc * 32 + 8 * fq) >> 3;
#pragma unroll
        for (int ai = 0; ai < 2; ++ai)
#pragma unroll
            for (int m = 0; m < 4; ++m) { bf16_t* bp = SC + ((size_t)(tb0 + ai * 8 + m) * 256) * 128 + fr * 8;
                const float rs = 1.f / sqrtf(RSS[(tb0 + ai * 8 + m) * 16 + fr] * (1.f / D) + EPS);
#pragma unroll
                for (int bj = 0; bj < 2; ++bj) { u32x4 w = pack8(acc[ai][bj][m][0] * rs, acc[ai][bj][m][1] * rs);
#pragma unroll
                    for (int c = 0; c < 4; ++c) w[c] ^= (((w[c] >> 15) & 0x00010001u) * 0x7FFFu) | 0x80008000u;
                    *(u32x4*)(bp + (size_t)(cq0 + bj * 16) * 128) = w; } }
    }
};
}

#define XB_TMO      128
#define XB_XCNT(j)  (256  + 64 * (j))
#define XB_XSUB(j)  (1280 + 64 * (j))
#define XB_XGEN(j)  (2304 + 64 * (j))
#define XB_TOP      3328
#define XB_TOPGEN   3392
#define XCD_BAR_WORDS 3456
#define XB_SPIN_CAP (1u << 18)
__device__ __forceinline__ unsigned xb_ld(unsigned* p)              { return __hip_atomic_load(p, __ATOMIC_RELAXED, __HIP_MEMORY_SCOPE_AGENT); }
__device__ __forceinline__ unsigned xb_add(unsigned* p, unsigned v) { return __hip_atomic_fetch_add(p, v, __ATOMIC_RELAXED, __HIP_MEMORY_SCOPE_AGENT); }
__device__ __forceinline__ unsigned xb_xcc_id() { return (unsigned)__builtin_amdgcn_s_getreg((3 << 11) | 20) & 0xFu; }
#define XB_SPIN(cond, bar) do { unsigned _sp = 0; while (cond) { __builtin_amdgcn_s_sleep(1); \
    if ((++_sp & 255u) == 0u) { if (xb_ld(&(bar)[XB_TMO])) break; if (_sp > XB_SPIN_CAP) { atomicAdd(&(bar)[XB_TMO], 1u); break; } } } } while (0)
struct XcdBarrier { unsigned* bar; unsigned x; volatile LAS unsigned* st; int wave; };
__device__ __forceinline__ XcdBarrier xcd_barrier_post(unsigned* bar, volatile LAS unsigned* st, int wave) {
    XcdBarrier b; b.bar = bar; b.x = xb_xcc_id(); b.st = st; b.wave = wave;
    if (wave == 0 && lane_now() == 0) (void)xb_add(&bar[XB_XCNT(b.x)], 1u);
    return b;
}
__device__ __forceinline__ void xcd_barrier_complete(unsigned* bar, unsigned x, unsigned& nloc, unsigned& nx) {
    const unsigned G = gridDim.x * gridDim.y * gridDim.z;
    unsigned sum, cnt, mine, sp = 0u;
    for (;;) {
        sum = 0u; cnt = 0u; mine = 0u;
#pragma unroll
        for (unsigned j = 0; j < 16; ++j) { const unsigned c = xb_ld(&bar[XB_XCNT(j)]); sum += c; cnt += (c > 0u) ? 1u : 0u; mine = (j == x) ? c : mine; }
        if (sum == G) break;
        __builtin_amdgcn_s_sleep(1);
        if ((++sp & 255u) == 0u) { if (xb_ld(&bar[XB_TMO])) break; if (sp > XB_SPIN_CAP) { atomicAdd(&bar[XB_TMO], 1u); break; } }
    }
    nloc = mine > 0u ? mine : 1u; nx = cnt > 0u ? cnt : 1u;
}
__device__ __forceinline__ void xcd_barrier(const XcdBarrier& b) {
    asm volatile("s_waitcnt vmcnt(0)" ::: "memory");
    __syncthreads();
    if (b.wave == 0 && lane_now() == 0) {
        unsigned* bar = b.bar;
        __builtin_amdgcn_s_waitcnt(0);
        unsigned nloc = b.st[0], nx = b.st[1];
        if (nloc == 0u) { xcd_barrier_complete(bar, b.x, nloc, nx); b.st[0] = nloc; b.st[1] = nx; }
        const unsigned old = xb_add(&bar[XB_XSUB(b.x)], 1u);
        const unsigned gen = old / nloc;
        if (old + 1u == (gen + 1u) * nloc) {
            __builtin_amdgcn_fence(__ATOMIC_RELEASE, "agent");
            asm volatile("s_waitcnt vmcnt(0)" ::: "memory");
            const unsigned og = xb_add(&bar[XB_TOP], 1u);
            const unsigned tg = og / nx;
            if (og + 1u == (tg + 1u) * nx) xb_add(&bar[XB_TOPGEN], 1u);
            else XB_SPIN(xb_ld(&bar[XB_TOPGEN]) == tg, bar);
            __builtin_amdgcn_fence(__ATOMIC_ACQUIRE, "agent");
            xb_add(&bar[XB_XGEN(b.x)], 1u);
            asm volatile("s_waitcnt vmcnt(0)" ::: "memory");
        } else {
            XB_SPIN(xb_ld(&bar[XB_XGEN(b.x)]) == gen, bar);
            __builtin_amdgcn_fence(__ATOMIC_ACQUIRE, "agent");
            asm volatile("s_waitcnt vmcnt(0)" ::: "memory");
        }
    }
    __syncthreads();
}

struct Args {
    const float* in[20]; float* out; unsigned char* ws; int ph_lo, ph_hi, li, pad;
};
enum { I_X = 0, I_N1G, I_WIN, I_WGU, I_BG, I_GLAG, I_SLNG, I_SLNB, I_SW, I_SB, I_WBA, I_WBB, I_WOUT, I_N2G, I_WQ, I_K1, I_K2, I_PU, I_PV, I_FG };

struct Frame {
    LAS unsigned char* lds;
    int tid, lane, wave, G, bid;
};

__device__ __forceinline__ float clamp448(float v) { return __builtin_amdgcn_fmed3f(v, -448.f, 448.f); }
template <int MODE, bool F8 = false>
__device__ __forceinline__ void p0_transpose_item(const float* W, int K, int Nsrc, int Ndst, bf16_t* WT, LAS float* scr, int item, int lane, float sc8 = 1.f, int ldk = 0) {
    if (ldk == 0) ldk = K;
    const int nblk = Ndst / 32, kb = item / nblk, nb = item % nblk, k0 = 64 * kb, n0 = 32 * nb;
    const int nd = n0 + (lane & 31);
    int sc = nd; bool valid = true;
    if (MODE == 1) { if (nd < 2048) sc = nd; else if (nd < 2560) sc = nd + 16; else if (nd < 2576) sc = 2048 + (nd - 2560); else if (nd < 2816) { sc = 0; valid = false; } else sc = nd - 240; }
#pragma unroll 8
    for (int i = 0; i < 32; ++i) { const int kk = 2 * i + (lane >> 5); const float v = valid ? W[(size_t)(k0 + kk) * Nsrc + sc] : 0.f; scr[kk * 33 + (lane & 31)] = v; }
    LDS_WAIT(); asm volatile("" ::: "memory");
    if (F8) {
        const int c = lane & 3;
#pragma unroll
        for (int j = 0; j < 2; ++j) { const int n = (lane >> 2) + 16 * j; const LAS float* s = scr + (16 * c) * 33 + n; u32x4 o;
#pragma unroll
            for (int q = 0; q < 4; ++q) { int w = 0; w = __builtin_amdgcn_cvt_pk_fp8_f32(clamp448(s[(4 * q) * 33] * sc8), clamp448(s[(4 * q + 1) * 33] * sc8), w, false);
                w = __builtin_amdgcn_cvt_pk_fp8_f32(clamp448(s[(4 * q + 2) * 33] * sc8), clamp448(s[(4 * q + 3) * 33] * sc8), w, true); o[q] = (unsigned)w; }
            *(u32x4*)((unsigned char*)WT + (size_t)(n0 + n) * ldk + k0 + 16 * c) = o; }
    } else {
    const int c = lane & 7;
#pragma unroll
    for (int j = 0; j < 4; ++j) { const int n = (lane >> 3) + 8 * j; const LAS float* s = scr + (8 * c) * 33 + n;
        u32x4 o; o.x = pk2(s[0 * 33], s[1 * 33]); o.y = pk2(s[2 * 33], s[3 * 33]); o.z = pk2(s[4 * 33], s[5 * 33]); o.w = pk2(s[6 * 33], s[7 * 33]);
        *(u32x4*)(WT + (size_t)(n0 + n) * ldk + k0 + 8 * c) = o; }
    }
    LDS_WAIT(); asm volatile("" ::: "memory");
}
template <int OM, int NB>
__device__ __forceinline__ void rms_rows_to_bf16(int lane, const float* x0, size_t xstride, const float* g, bf16_t* o0, size_t ostride, unsigned* o80 = nullptr, size_t o8stride = 0, const bf16_t* add0 = nullptr, size_t addstride = 0, bf16_t* hb0 = nullptr, size_t hbstride = 0) {
    f32x4 v[NB][4]; float s[NB];
#pragma unroll
    for (int b = 0; b < NB; ++b) { const float* xr = x0 + b * xstride + 8 * lane;
#pragma unroll
        for (int j = 0; j < 2; ++j) { v[b][2 * j] = *(const f32x4*)(xr + 512 * j); v[b][2 * j + 1] = *(const f32x4*)(xr + 512 * j + 4); } }
    if (add0) {
        u32x4 ad[NB][2];
#pragma unroll
        for (int b = 0; b < NB; ++b) { const bf16_t* ar = add0 + b * addstride + 8 * lane;
#pragma unroll
            for (int j = 0; j < 2; ++j) ad[b][j] = *(const u32x4*)(ar + 512 * j); }
#pragma unroll
        for (int b = 0; b < NB; ++b)
#pragma unroll
            for (int j = 0; j < 2; ++j) { v[b][2 * j] = v[b][2 * j] + (f32x4){bflo(ad[b][j].x), bfhi(ad[b][j].x), bflo(ad[b][j].y), bfhi(ad[b][j].y)};
                v[b][2 * j + 1] = v[b][2 * j + 1] + (f32x4){bflo(ad[b][j].z), bfhi(ad[b][j].z), bflo(ad[b][j].w), bfhi(ad[b][j].w)}; }
    }
    if (hb0) {
#pragma unroll
        for (int b = 0; b < NB; ++b)
#pragma unroll
            for (int j = 0; j < 2; ++j) *(u32x4*)(hb0 + b * hbstride + 512 * j + 8 * lane) = pg8::pack8(v[b][2 * j], v[b][2 * j + 1]);
    }
#pragma unroll
    for (int b = 0; b < NB; ++b) { s[b] = 0.f;
#pragma unroll
        for (int j = 0; j < 4; ++j) s[b] += (v[b][j].x * v[b][j].x + v[b][j].y * v[b][j].y) + (v[b][j].z * v[b][j].z + v[b][j].w * v[b][j].w); }
#pragma unroll
    for (int o = 1; o < 64; o <<= 1) {
#pragma unroll
        for (int b = 0; b < NB; ++b) s[b] += __shfl_xor(s[b], o); }
    const float* gr = g + 8 * lane;
#pragma unroll
    for (int b = 0; b < NB; ++b) { const float rstd = 1.f / sqrtf(s[b] * (1.f / D) + EPS);
#pragma unroll
        for (int j = 0; j < 2; ++j) { const f32x4 y0 = v[b][2 * j] * rstd * *(const f32x4*)(gr + 512 * j), y1 = v[b][2 * j + 1] * rstd * *(const f32x4*)(gr + 512 * j + 4);
            const u32x4 o = pg8::pack8(y0, y1);
            if (OM & 1) *(u32x4*)(o0 + b * ostride + 512 * j + 8 * lane) = o;
            if (OM == 3) { u32x2 w8;
#pragma unroll
                for (int h = 0; h < 2; ++h) { int w = 0; w = __builtin_amdgcn_cvt_pk_fp8_f32(clamp448(bflo(o[2 * h]) * 16.f), clamp448(bfhi(o[2 * h]) * 16.f), w, false);
                    w = __builtin_amdgcn_cvt_pk_fp8_f32(clamp448(bflo(o[2 * h + 1]) * 16.f), clamp448(bfhi(o[2 * h + 1]) * 16.f), w, true); w8[h] = (unsigned)w; }
                *(u32x2*)(o80 + b * o8stride + 128 * j + 2 * lane) = w8; }
            if (OM == 2) { u32x2 w8; int w = 0;
                w = __builtin_amdgcn_cvt_pk_fp8_f32(clamp448(y0.x * 16.f), clamp448(y0.y * 16.f), w, false); w = __builtin_amdgcn_cvt_pk_fp8_f32(clamp448(y0.z * 16.f), clamp448(y0.w * 16.f), w, true); w8.x = (unsigned)w;
                w = 0; w = __builtin_amdgcn_cvt_pk_fp8_f32(clamp448(y1.x * 16.f), clamp448(y1.y * 16.f), w, false); w = __builtin_amdgcn_cvt_pk_fp8_f32(clamp448(y1.z * 16.f), clamp448(y1.w * 16.f), w, true); w8.y = (unsigned)w;
                *(u32x2*)(o80 + b * o8stride + 128 * j + 2 * lane) = w8; } } }
}
__device__ __forceinline__ float wave_max(float v) {
#pragma unroll
    for (int o = 1; o < 64; o <<= 1) v = fmaxf(v, __shfl_xor(v, o));
    return v;
}
template <int NB>
__device__ __forceinline__ void cvt_rows_fp8(int lane, const float* const (&src)[NB], unsigned char* const (&dst16)[NB], float* const (&scale_out)[NB]) {
    f32x4 v[NB][4]; float m[NB];
#pragma unroll
    for (int b = 0; b < NB; ++b) {
#pragma unroll
        for (int j = 0; j < 4; ++j) v[b][j] = *(const GAS f32x4*)(src[b] + 16 * lane + 4 * j); }
#pragma unroll
    for (int b = 0; b < NB; ++b) { m[b] = 0.f;
#pragma unroll
        for (int j = 0; j < 4; ++j) m[b] = fmaxf(m[b], fmaxf(fmaxf(fabsf(v[b][j].x), fabsf(v[b][j].y)), fmaxf(fabsf(v[b][j].z), fabsf(v[b][j].w)))); }
#pragma unroll
    for (int o = 1; o < 64; o <<= 1) {
#pragma unroll
        for (int b = 0; b < NB; ++b) m[b] = fmaxf(m[b], __shfl_xor(m[b], o)); }
#pragma unroll
    for (int b = 0; b < NB; ++b) { const float inv = m[b] > 0.f ? 224.f / m[b] : 0.f, sc = m[b] > 0.f ? m[b] * (1.f / 224.f) : 1.f;
        u32x4 o;
#pragma unroll
        for (int j = 0; j < 4; ++j) { int w = 0; w = __builtin_amdgcn_cvt_pk_fp8_f32(v[b][j].x * inv, v[b][j].y * inv, w, false); w = __builtin_amdgcn_cvt_pk_fp8_f32(v[b][j].z * inv, v[b][j].w * inv, w, true); o[j] = (unsigned)w; }
        *(GAS u32x4*)dst16[b] = o;
        if (lane == 0) *(GAS float*)scale_out[b] = sc; }
}
__device__ __forceinline__ unsigned fp4_code(float t) { const float a = fabsf(t);
    const unsigned c = (unsigned)(a >= 0.25f) + (unsigned)(a >= 0.75f) + (unsigned)(a >= 1.25f) + (unsigned)(a >= 1.75f) + (unsigned)(a >= 2.5f) + (unsigned)(a >= 3.5f) + (unsigned)(a >= 5.f);
    return c | (t < 0.f ? 8u : 0u); }
template <int NB, bool PERMV = false>
__device__ __forceinline__ void cvt_rows_fp4(int lane, const float* const (&src)[NB], unsigned char* const (&dst8)[NB], float* const (&scale_out)[NB], const float* colmul = nullptr) {
    f32x4 v[NB][4]; float m[NB];
#pragma unroll
    for (int b = 0; b < NB; ++b) {
#pragma unroll
        for (int j = 0; j < 4; ++j) v[b][j] = *(const GAS f32x4*)(src[b] + 16 * lane + 4 * j); }
    if (colmul) {
#pragma unroll
        for (int j = 0; j < 4; ++j) { const f32x4 cm = *(const f32x4*)(colmul + 16 * lane + 4 * j);
#pragma unroll
            for (int b = 0; b < NB; ++b) v[b][j] = v[b][j] * cm; } }
#pragma unroll
    for (int b = 0; b < NB; ++b) { m[b] = 0.f;
#pragma unroll
        for (int j = 0; j < 4; ++j) m[b] = fmaxf(m[b], fmaxf(fmaxf(fabsf(v[b][j].x), fabsf(v[b][j].y)), fmaxf(fabsf(v[b][j].z), fabsf(v[b][j].w)))); }
#pragma unroll
    for (int o = 1; o < 64; o <<= 1) {
#pragma unroll
        for (int b = 0; b < NB; ++b) m[b] = fmaxf(m[b], __shfl_xor(m[b], o)); }
#pragma unroll
    for (int b = 0; b < NB; ++b) { const float inv = m[b] > 0.f ? 6.f / m[b] : 0.f, sc = m[b] > 0.f ? m[b] * (1.f / 6.f) : 1.f;
        u32x2 o;
#pragma unroll
        for (int h = 0; h < 2; ++h) { unsigned w = 0;
            const f32x4 t0 = v[b][2 * h] * inv, t1 = v[b][2 * h + 1] * inv;
            w = __builtin_amdgcn_cvt_scalef32_pk_fp4_f32(w, t0.x, t0.y, 1.f, 0); w = __builtin_amdgcn_cvt_scalef32_pk_fp4_f32(w, t0.z, t0.w, 1.f, 1);
            w = __builtin_amdgcn_cvt_scalef32_pk_fp4_f32(w, t1.x, t1.y, 1.f, 2); w = __builtin_amdgcn_cvt_scalef32_pk_fp4_f32(w, t1.z, t1.w, 1.f, 3);
            o[h] = w; }
        if (PERMV) { *(GAS unsigned*)(dst8[b] + 16 * ((2 * lane) & 31) + 4 * (lane >> 4)) = o.x; *(GAS unsigned*)(dst8[b] + 16 * ((2 * lane + 1) & 31) + 4 * (lane >> 4)) = o.y; }
        else *(GAS u32x2*)dst8[b] = o;
        if (lane == 0) *(GAS float*)scale_out[b] = sc; }
}
__device__ __forceinline__ void convert_tables(const Frame& F, const Args& A, int wi, int nw) {
    unsigned char* ws = A.ws; const int gw = wi, NGW = nw;
    {
        int mc = gw;
        for (; mc + 3 * NGW < NEXP; mc += 4 * NGW) { const float* src[4]; unsigned char* dst[4]; float* sco[4];
#pragma unroll
            for (int b = 0; b < 4; ++b) { const int e = mc + b * NGW; src[b] = A.in[I_PU] + (size_t)e * D; dst[b] = ws + WS_U8 + (size_t)((e & (UNG - 1)) * (NEXP / UNG) + (e >> UNG_SH)) * 512 + 8 * F.lane; sco[b] = (float*)(ws + WS_SU) + e; }
            cvt_rows_fp4<4>(F.lane, src, dst, sco, A.in[I_N2G]); }
        for (; mc < NEXP; mc += NGW) { const float* src[1]; unsigned char* dst[1]; float* sco[1];
            const int e = mc; src[0] = A.in[I_PU] + (size_t)e * D; dst[0] = ws + WS_U8 + (size_t)((e & (UNG - 1)) * (NEXP / UNG) + (e >> UNG_SH)) * 512 + 8 * F.lane; sco[0] = (float*)(ws + WS_SU) + e;
            cvt_rows_fp4<1>(F.lane, src, dst, sco, A.in[I_N2G]); }
    }
    if (V_F4) {
        int mc = gw;
        for (; mc + 3 * NGW < NEXP; mc += 4 * NGW) { const float* src[4]; unsigned char* dst[4]; float* sco[4];
#pragma unroll
            for (int b = 0; b < 4; ++b) { const int e = mc + b * NGW; src[b] = A.in[I_PV] + (size_t)e * D; dst[b] = ws + WS_V8 + (size_t)e * 512; sco[b] = (float*)(ws + WS_SV) + e; }
            cvt_rows_fp4<4, true>(F.lane, src, dst, sco); }
        for (; mc < NEXP; mc += NGW) { const float* src[1]; unsigned char* dst[1]; float* sco[1];
            const int e = mc; src[0] = A.in[I_PV] + (size_t)e * D; dst[0] = ws + WS_V8 + (size_t)e * 512; sco[0] = (float*)(ws + WS_SV) + e;
            cvt_rows_fp4<1, true>(F.lane, src, dst, sco); }
    } else {
        int mc = gw;
        for (; mc + 3 * NGW < NEXP; mc += 4 * NGW) { const float* src[4]; unsigned char* dst[4]; float* sco[4];
#pragma unroll
            for (int b = 0; b < 4; ++b) { const int e = mc + b * NGW; src[b] = A.in[I_PV] + (size_t)e * D; dst[b] = ws + WS_V8 + ((size_t)(F.lane >> 3) * NEXP + e) * 128 + 16 * (F.lane & 7); sco[b] = (float*)(ws + WS_SV) + e; }
            cvt_rows_fp8<4>(F.lane, src, dst, sco); }
        for (; mc < NEXP; mc += NGW) { const float* src[1]; unsigned char* dst[1]; float* sco[1];
            const int e = mc; src[0] = A.in[I_PV] + (size_t)e * D; dst[0] = ws + WS_V8 + ((size_t)(F.lane >> 3) * NEXP + e) * 128 + 16 * (F.lane & 7); sco[0] = (float*)(ws + WS_SV) + e;
            cvt_rows_fp8<1>(F.lane, src, dst, sco); }
    }
}
__device__ __forceinline__ void phase0(const Frame& F, const Args& A) {
    unsigned char* ws = A.ws;
    if (!SC_F8) {
        const int l = F.lane, fr = l & 15, q = l >> 4;
        bf16_t* WQF = (bf16_t*)(ws + WS_WQF);
        for (int it = F.bid * NWAVES + F.wave; it < 2048; it += F.G * NWAVES) {
            const int kh = it & 1, kt = (it >> 1) & 63, hh = it >> 7;
            const float* kX = (hh & 1) ? A.in[I_K2] : A.in[I_K1];
            const float* ap = A.in[I_WQ] + (size_t)(kt * 16 + fr) * 2048 + hh * 128 + 4 * q;
            f32x4 a[8];
#pragma unroll
            for (int t = 0; t < 8; ++t) a[t] = *(const f32x4*)(ap + 16 * t);
#pragma unroll
            for (int kb = 0; kb < 4; ++kb) { const int key0 = kh * 64 + kb * 16;
                const float* bp = kX + (size_t)(key0 + fr) * 128 + 4 * q;
                f32x4 b[8];
#pragma unroll
                for (int t = 0; t < 8; ++t) b[t] = *(const f32x4*)(bp + 16 * t);
                f32x4 d = {0.f, 0.f, 0.f, 0.f};
#pragma unroll
                for (int t = 0; t < 8; ++t)
#pragma unroll
                    for (int c = 0; c < 4; ++c) d = __builtin_amdgcn_mfma_f32_16x16x4f32(a[t][c], b[t][c], d, 0, 0, 0);
                const f32x4 g2 = *(const f32x4*)(A.in[I_N2G] + kt * 16 + 4 * q);
                u32x2 o; o.x = pk2(d[0] * g2.x, d[1] * g2.y); o.y = pk2(d[2] * g2.z, d[3] * g2.w);
                *(u32x2*)(WQF + (size_t)(hh * 128 + key0 + fr) * 1024 + kt * 16 + 4 * q) = o; }
        }
    } else {
        LAS float* kx = (LAS float*)F.lds;
        LAS float* wt = (LAS float*)(F.lds + 128 * 129 * 4);
        bf16_t* WQF = (bf16_t*)(ws + WS_WQF);
        for (int it = F.bid; it < 512; it += F.G) {
            const int hh = it >> 5, kblk = it & 31, k0 = kblk * 32;
            const float* kX = (hh & 1) ? A.in[I_K2] : A.in[I_K1];
            __syncthreads();
            for (int e = F.tid; e < 128 * 128; e += 512) kx[(e >> 7) * 129 + (e & 127)] = kX[e];
            for (int e = F.tid; e < 32 * 128; e += 512) wt[e] = A.in[I_WQ][(size_t)(k0 + (e >> 7)) * 2048 + hh * 128 + (e & 127)];
            __syncthreads();
            const int key = F.tid & 127, kq = F.tid >> 7;
            float acc[8];
#pragma unroll
            for (int i = 0; i < 8; ++i) acc[i] = 0.f;
            for (int d = 0; d < 128; ++d) { const float b = kx[key * 129 + d];
#pragma unroll
                for (int i = 0; i < 8; ++i) acc[i] += wt[(kq * 8 + i) * 128 + d] * b; }
            if (SC_F8) { u32x2 o;
#pragma unroll
                for (int h2 = 0; h2 < 2; ++h2) { int w = 0; w = __builtin_amdgcn_cvt_pk_fp8_f32(clamp448(acc[4 * h2] * 1024.f), clamp448(acc[4 * h2 + 1] * 1024.f), w, false);
                    w = __builtin_amdgcn_cvt_pk_fp8_f32(clamp448(acc[4 * h2 + 2] * 1024.f), clamp448(acc[4 * h2 + 3] * 1024.f), w, true); o[h2] = (unsigned)w; }
                *(u32x2*)((unsigned char*)WQF + (size_t)(hh * 128 + key) * 1024 + k0 + kq * 8) = o;
            } else {
            u32x4 o; o.x = pk2(acc[0], acc[1]); o.y = pk2(acc[2], acc[3]); o.z = pk2(acc[4], acc[5]); o.w = pk2(acc[6], acc[7]);
            *(u32x4*)(WQF + (size_t)(hh * 128 + key) * 1024 + k0 + kq * 8) = o; }
        }
        __syncthreads();
    }
    LAS float* scr = (LAS float*)(F.lds + F.wave * 16384);
    const int gw = F.bid * NWAVES + F.wave, NGW = F.G * NWAVES;
    constexpr int I_IN = 16 * (NPROJ / 32), I_A = 8 * 32, I_B = 8 * 32, I_O = 16 * 32;
    constexpr int NITEMS = I_IN + I_A + I_B + I_O;
    for (int it = gw; it < NITEMS; it += NGW) {
        int r = it;
        if (r < I_IN) { if ((r % (NPROJ / 32)) * 32 >= F8_LO * 256) p0_transpose_item<1, true>(A.in[I_WIN], 1024, 5136, NPROJ, (bf16_t*)(ws + WS_W8), scr, r, F.lane, 1024.f);
                        else p0_transpose_item<1, false>(A.in[I_WIN], 1024, 5136, NPROJ, (bf16_t*)(ws + WS_WIN), scr, r, F.lane); continue; } r -= I_IN;
        if (r < I_A) { p0_transpose_item<0>(A.in[I_WBA], 512, 1024, 1024, (bf16_t*)(ws + WS_WA), scr, r, F.lane, 1.f, 1024); continue; } r -= I_A;
        if (r < I_B) { p0_transpose_item<0>(A.in[I_WBB], 512, 1024, 1024, (bf16_t*)(ws + WS_WA) + 512, scr, r, F.lane, 1.f, 1024); continue; } r -= I_B;
        p0_transpose_item<0>(A.in[I_WOUT], 1024, 1024, 1024, (bf16_t*)(ws + WS_WOUT), scr, r, F.lane);
    }
    constexpr int OM1 = F8_LO <= 0 ? 2 : (F8_LO >= 21 ? 1 : 3);
    { int m = gw; for (; m + 3 * NGW < T_TOK; m += 4 * NGW) rms_rows_to_bf16<OM1, 4>(F.lane, A.in[I_X] + (size_t)m * D, (size_t)NGW * D, A.in[I_N1G], (bf16_t*)(ws + WS_N1) + (size_t)m * D, (size_t)NGW * D, (unsigned*)(ws + WS_N18) + (size_t)m * 256, (size_t)NGW * 256);
      for (; m < T_TOK; m += NGW) rms_rows_to_bf16<OM1, 1>(F.lane, A.in[I_X] + (size_t)m * D, 0, A.in[I_N1G], (bf16_t*)(ws + WS_N1) + (size_t)m * D, 0, (unsigned*)(ws + WS_N18) + (size_t)m * 256, 0); }
}

__device__ __forceinline__ float log_sigmoid(float z) { return fminf(z, 0.f) - log1pf(__expf(-fabsf(z))); }

template <bool DRY>
__device__ __forceinline__ void gla_chunk_phase(const Frame& F, const Args& A) {
    unsigned char* ws = A.ws;
    const bf16_t* P = (const bf16_t*)(ws + WS_P);
    const float* ALR = (const float*)(ws + WS_ALR);
    LAS float* alr = (LAS float*)F.lds;
    LAS float* tot = (LAS float*)(F.lds + 4096);
    LAS bf16_t* kdT = (LAS bf16_t*)(F.lds + 8192);
    LAS bf16_t* vT = (LAS bf16_t*)(F.lds + 26624);
    LAS bf16_t* stT = (LAS bf16_t*)(F.lds + 45056);
    const int tid = F.tid, kk = tid & 127, seg = tid >> 7;
    const bool hconst = (F.G & 3) == 0;
    int hcur = -1; float w[16]; float bias = 0.f;
#pragma unroll
    for (int j = 0; j < 16; ++j) w[j] = 0.f;
    float na0, na1; bf16_t nk[16], nv[16];
#define GC_LOAD(unit) do { const int h_ = (unit) & 3, c_ = ((unit) >> 2) & 63, b_ = (unit) >> 8; const int t0_ = b_ * SEQ + c_ * 64; \
        na0 = ALR[(size_t)t0_ * 16 + tid]; na1 = ALR[(size_t)t0_ * 16 + 512 + tid]; \
        const bf16_t* kp_ = P + (size_t)(t0_ + 16 * seg) * PLD + PC_K + h_ * 128 + kk; const bf16_t* vp_ = P + (size_t)(t0_ + 16 * seg) * PLD + PC_V + h_ * 128 + kk; \
        _Pragma("unroll") for (int i_ = 0; i_ < 16; ++i_) { nk[i_] = kp_[(size_t)i_ * PLD]; nv[i_] = vp_[(size_t)i_ * PLD]; } } while (0)
    int unit = F.bid;
    if (unit < 2048) GC_LOAD(unit);
    for (; unit < 2048; unit += F.G) {
        const int h = unit & 3;
        if (h != hcur) { hcur = h;
#pragma unroll
            for (int j = 0; j < 16; ++j) w[j] = A.in[I_WGU][(size_t)j * 512 + h * 128 + kk];
            bias = A.in[I_BG][h * 128 + kk]; }
        __syncthreads();
        alr[tid] = na0; alr[512 + tid] = na1;
        bf16_t kr[16], vr[16];
#pragma unroll
        for (int i = 0; i < 16; ++i) { kr[i] = nk[i]; vr[i] = nv[i]; }
        if (unit + F.G < 2048) GC_LOAD(unit + F.G);
        __syncthreads();
        float cum[16]; float run = 0.f;
#pragma unroll
        for (int i = 0; i < 16; ++i) { const LAS f32x4* ap = (const LAS f32x4*)(alr + (16 * seg + i) * 16); float z = bias;
#pragma unroll
            for (int q = 0; q < 4; ++q) { const f32x4 a4 = ap[q]; z += a4.x * w[4 * q] + a4.y * w[4 * q + 1] + a4.z * w[4 * q + 2] + a4.w * w[4 * q + 3]; }
            const float ls = fminf(z, 0.f) - __logf(1.f + __expf(-fabsf(z)));
            run += ls * (1.f / 16.f); cum[i] = run; }
        tot[seg * 128 + kk] = run;
        __syncthreads();
        {
            const float t0s = tot[kk], t1s = tot[128 + kk], t2s = tot[256 + kk], t3s = tot[384 + kk];
            const float total = (t0s + t1s) + (t2s + t3s);
            const float prefix = seg == 0 ? 0.f : (seg == 1 ? t0s : (seg == 2 ? t0s + t1s : t0s + t1s + t2s));
            unsigned kw[8], vw[8];
#pragma unroll
            for (int i = 0; i < 8; ++i) {
                const float e0 = __expf(total - (prefix + cum[2 * i])), e1 = __expf(total - (prefix + cum[2 * i + 1]));
                kw[i] = pk2(bf1(kr[2 * i]) * e0, bf1(kr[2 * i + 1]) * e1); vw[i] = (unsigned)vr[2 * i] | ((unsigned)vr[2 * i + 1] << 16);
            }
            *(LAS u32x4*)(kdT + kk * 72 + 16 * seg) = (u32x4){kw[0], kw[1], kw[2], kw[3]}; *(LAS u32x4*)(kdT + kk * 72 + 16 * seg + 8) = (u32x4){kw[4], kw[5], kw[6], kw[7]};
            *(LAS u32x4*)(vT + kk * 72 + 16 * seg) = (u32x4){vw[0], vw[1], vw[2], vw[3]}; *(LAS u32x4*)(vT + kk * 72 + 16 * seg + 8) = (u32x4){vw[4], vw[5], vw[6], vw[7]};
            if (seg == 0) ((float*)(DRY ? (unsigned char*)A.out + 96 * MiB : ws + WS_DEC))[(size_t)unit * 128 + kk] = __expf(total);
        }
        __syncthreads();
        {
            const int w8 = F.wave, l = F.lane, fr = l & 15, fq = l >> 4;
            f32x4 acc[8];
#pragma unroll
            for (int n = 0; n < 8; ++n) acc[n] = (f32x4){0.f, 0.f, 0.f, 0.f};
#pragma unroll
            for (int ks = 0; ks < 2; ++ks) {
                const bf16x8 a = *(const LAS bf16x8*)(kdT + (16 * w8 + fr) * 72 + 32 * ks + 8 * fq);
#pragma unroll
                for (int n = 0; n < 8; ++n) { const bf16x8 bb = *(const LAS bf16x8*)(vT + (16 * n + fr) * 72 + 32 * ks + 8 * fq);
                    acc[n] = __builtin_amdgcn_mfma_f32_16x16x32_bf16(a, bb, acc[n], 0, 0, 0); }
            }
#pragma unroll
            for (int n = 0; n < 8; ++n) { u32x2 o; o.x = pk2(acc[n][0], acc[n][1]); o.y = pk2(acc[n][2], acc[n][3]);
                *(LAS u32x2*)(stT + (16 * n + fr) * 136 + 16 * w8 + 4 * fq) = o; }
        }
        __syncthreads();
        {
            bf16_t* ST = (bf16_t*)(DRY ? (unsigned char*)A.out : ws + WS_N1) + (size_t)unit * 16384;
            const int vv = tid >> 2, part = tid & 3;
#pragma unroll
            for (int q = 0; q < 4; ++q) *(u32x4*)(ST + (size_t)vv * 128 + 32 * part + 8 * q) = *(const LAS u32x4*)(stT + vv * 136 + 32 * part + 8 * q);
        }
    }
#undef GC_LOAD
    (void)hconst;
}

template <bool DRY>
__device__ __forceinline__ void sgu_unit(const Frame& F, const Args& A, int unit, bool stats) {
    const int g = unit & 3, blk = (unit >> 2) & 31, b = unit >> 7;
    const int t0 = b * SEQ + blk * 128;
    bf16_t* P = (bf16_t*)(A.ws + WS_P);
    LAS bf16_t* wA = (LAS bf16_t*)F.lds;
    LAS bf16_t* vnT = (LAS bf16_t*)(F.lds + 34816);
    LAS float* st = (LAS float*)(F.lds + 69632);
    LAS bf16_t* suS = (LAS bf16_t*)(F.lds + 70656);
    const int tid = F.tid;
    __syncthreads();
    if (stats) {
        const int j = tid >> 2, q = tid & 3;
        const bf16_t* sp = P + (size_t)(t0 + j) * PLD + PC_SV + q * 128;
        float s = 0.f, s2 = 0.f;
#pragma unroll
        for (int i = 0; i < 16; ++i) { const u32x4 w = *(const u32x4*)(sp + 8 * i);
            const float f[8] = {bflo(w.x), bfhi(w.x), bflo(w.y), bfhi(w.y), bflo(w.z), bfhi(w.z), bflo(w.w), bfhi(w.w)};
#pragma unroll
            for (int e = 0; e < 8; ++e) { s += f[e]; s2 += f[e] * f[e]; } }
        s += __shfl_xor(s, 1); s += __shfl_xor(s, 2); s2 += __shfl_xor(s2, 1); s2 += __shfl_xor(s2, 2);
        const float mu = s * (1.f / 512.f); const float var = fmaxf(s2 * (1.f / 512.f) - mu * mu, 0.f);
        if (q == 0) { st[2 * j] = mu; st[2 * j + 1] = 1.f / sqrtf(var + EPS); }
    }
    {
        const int i = tid >> 2, jb = (tid & 3) * 32;
        const float* wp = A.in[I_SW] + (size_t)g * 16384 + (size_t)i * 128 + jb;
        const bf16_t* sup = P + (size_t)(t0 + i) * PLD + PC_SU + g * 128 + jb;
#pragma unroll
        for (int q = 0; q < 4; ++q) { const f32x4 a = *(const f32x4*)(wp + 8 * q), bq = *(const f32x4*)(wp + 8 * q + 4);
            const bool z = (i < 64) && (jb + 8 * q >= 64);
            u32x4 o; o.x = pk2(a.x, a.y); o.y = pk2(a.z, a.w); o.z = pk2(bq.x, bq.y); o.w = pk2(bq.z, bq.w);
            if (z) o = (u32x4){0u, 0u, 0u, 0u};
            *(LAS u32x4*)(wA + i * 136 + jb + 8 * q) = o;
            *(LAS u32x4*)(suS + i * 136 + jb + 8 * q) = *(const u32x4*)(sup + 8 * q); }
    }
    const int cch = tid & 127, seg = tid >> 7;
    bf16_t xr[32];
    { const bf16_t* sp = P + (size_t)(t0 + 32 * seg) * PLD + PC_SV + g * 128 + cch;
#pragma unroll
      for (int i = 0; i < 32; ++i) xr[i] = sp[(size_t)i * PLD]; }
    const float lg = A.in[I_SLNG][g * 128 + cch], lb = A.in[I_SLNB][g * 128 + cch];
    __syncthreads();
    {
        unsigned ow[16];
#pragma unroll
        for (int i = 0; i < 16; ++i) { const int j = 32 * seg + 2 * i; const f32x4 ms = *(const LAS f32x4*)(st + 2 * j);
            ow[i] = pk2((bf1(xr[2 * i]) - ms.x) * ms.y * lg + lb, (bf1(xr[2 * i + 1]) - ms.z) * ms.w * lg + lb); }
#pragma unroll
        for (int q = 0; q < 4; ++q) *(LAS u32x4*)(vnT + cch * 136 + 32 * seg + 8 * q) = (u32x4){ow[4 * q], ow[4 * q + 1], ow[4 * q + 2], ow[4 * q + 3]};
    }
    __syncthreads();
    {
        const int w = F.wave, l = F.lane, fr = l & 15, fq = l >> 4;
        f32x4 acc[8];
#pragma unroll
        for (int n = 0; n < 8; ++n) acc[n] = (f32x4){0.f, 0.f, 0.f, 0.f};
#pragma unroll
        for (int ks = 0; ks < 4; ++ks) {
            const bf16x8 a = *(const LAS bf16x8*)(wA + (16 * w + fr) * 136 + 32 * ks + 8 * fq);
#pragma unroll
            for (int n = 0; n < 8; ++n) { const bf16x8 bb = *(const LAS bf16x8*)(vnT + (16 * n + fr) * 136 + 32 * ks + 8 * fq);
                acc[n] = __builtin_amdgcn_mfma_f32_16x16x32_bf16(a, bb, acc[n], 0, 0, 0); }
        }
#pragma unroll
        for (int jj = 0; jj < 4; ++jj) { const int i = 16 * w + 4 * fq + jj; const float bias = A.in[I_SB][g * 128 + i];
            LAS bf16_t* rp = suS + i * 136 + fr;
#pragma unroll
            for (int n = 0; n < 8; ++n) { const float su = bf1(rp[16 * n]); rp[16 * n] = (bf16_t)f2bf(su * (acc[n][jj] + bias)); } }
    }
    __syncthreads();
    {
        const int i = tid >> 2, jb = (tid & 3) * 32;
        bf16_t* yp = DRY ? (bf16_t*)A.out + (size_t)(t0 + i) * 512 + g * 128 + jb : P + (size_t)(t0 + i) * PLD + PC_SU + g * 128 + jb;
#pragma unroll
        for (int q = 0; q < 4; ++q) *(u32x4*)(yp + 8 * q) = *(const LAS u32x4*)(suS + i * 136 + jb + 8 * q);
    }
}

template <bool DRY>
__device__ __forceinline__ void gla_scan(const Frame& F, const Args& A) {
    bf16_t* ST = (bf16_t*)(A.ws + WS_N1); bf16_t* STO = DRY ? (bf16_t*)A.out : ST; const float* DEC = (const float*)(A.ws + WS_DEC);
    for (int gi = F.bid * 512 + F.tid; gi < 131072; gi += F.G * 512) {
        const int k4 = gi & 31, vv = (gi >> 5) & 127, h = (gi >> 12) & 3, b = gi >> 14;
        float s0 = 0.f, s1 = 0.f, s2 = 0.f, s3 = 0.f;
        u32x2 wa[8], wb[8]; f32x4 da[8], db[8];
#define SCAN_LOAD(W, Dd, c0) do { _Pragma("unroll") for (int i_ = 0; i_ < 8; ++i_) { const size_t u_ = (size_t)((b * 64 + (c0) + i_) * 4 + h); \
            W[i_] = *(const u32x2*)(ST + u_ * 16384 + (size_t)vv * 128 + k4 * 4); Dd[i_] = *(const f32x4*)(DEC + u_ * 128 + k4 * 4); } } while (0)
#define SCAN_STEP(W, Dd, c0) do { _Pragma("unroll") for (int i_ = 0; i_ < 8; ++i_) { const size_t u_ = (size_t)((b * 64 + (c0) + i_) * 4 + h); \
            s0 = Dd[i_].x * s0 + bflo(W[i_].x); s1 = Dd[i_].y * s1 + bfhi(W[i_].x); s2 = Dd[i_].z * s2 + bflo(W[i_].y); s3 = Dd[i_].w * s3 + bfhi(W[i_].y); \
            u32x2 o_; o_.x = pk2(s0, s1); o_.y = pk2(s2, s3); *(u32x2*)(STO + u_ * 16384 + (size_t)vv * 128 + k4 * 4) = o_; } } while (0)
        SCAN_LOAD(wa, da, 0);
#pragma unroll
        for (int c0 = 0; c0 < 64; c0 += 16) {
            SCAN_LOAD(wb, db, c0 + 8);
            SCAN_STEP(wa, da, c0);
            if (c0 + 16 < 64) SCAN_LOAD(wa, da, c0 + 16);
            SCAN_STEP(wb, db, c0 + 8);
        }
#undef SCAN_LOAD
#undef SCAN_STEP
    }
}

template <bool DRY>
__device__ __forceinline__ void gla_out_phase(const Frame& F, const Args& A) {
    bf16_t* P = (bf16_t*)(A.ws + WS_P);
    LAS bf16_t* qA = (LAS bf16_t*)F.lds;
    LAS bf16_t* sB = (LAS bf16_t*)(F.lds + 17408);
    LAS float* oF = (LAS float*)(F.lds + 52224);
    const int tid = F.tid, s = tid >> 3, cb = (tid & 7) * 16, vv = tid >> 2, kb = (tid & 3) * 32;
    u32x4 nq0, nq1, ns0, ns1, ns2, ns3, nr0, nr1;
#define GO_LOAD(unit) do { const int h_ = (unit) & 3, c_ = ((unit) >> 2) & 63, b_ = (unit) >> 8; const int t0_ = b_ * SEQ + c_ * 64; \
        const bf16_t* qp_ = P + (size_t)(t0_ + s) * PLD + PC_Q + h_ * 128 + cb; nq0 = *(const u32x4*)qp_; nq1 = *(const u32x4*)(qp_ + 8); \
        const bf16_t* sp_ = (const bf16_t*)(A.ws + WS_N1) + (size_t)(unit) * 16384 + (size_t)vv * 128 + kb; ns0 = *(const u32x4*)sp_; ns1 = *(const u32x4*)(sp_ + 8); ns2 = *(const u32x4*)(sp_ + 16); ns3 = *(const u32x4*)(sp_ + 24); \
        const bf16_t* rp_ = P + (size_t)(t0_ + s) * PLD + PC_R + h_ * 128 + cb; nr0 = *(const u32x4*)rp_; nr1 = *(const u32x4*)(rp_ + 8); } while (0)
    int unit = F.bid;
    if (unit < 2048) GO_LOAD(unit);
    for (; unit < 2048; unit += F.G) {
        const int h = unit & 3, c = (unit >> 2) & 63, b = unit >> 8;
        const int t0 = b * SEQ + c * 64;
        __syncthreads();
        *(LAS u32x4*)(qA + s * 136 + cb) = nq0; *(LAS u32x4*)(qA + s * 136 + cb + 8) = nq1;
        *(LAS u32x4*)(sB + vv * 136 + kb) = ns0; *(LAS u32x4*)(sB + vv * 136 + kb + 8) = ns1; *(LAS u32x4*)(sB + vv * 136 + kb + 16) = ns2; *(LAS u32x4*)(sB + vv * 136 + kb + 24) = ns3;
        const u32x4 r0 = nr0, r1 = nr1;
        if (unit + F.G < 2048) GO_LOAD(unit + F.G);
        __syncthreads();
        {
            const int w = F.wave, l = F.lane, fr = l & 15, fq = l >> 4, m = w & 3, nh = w >> 2;
            f32x4 acc[4];
#pragma unroll
            for (int n = 0; n < 4; ++n) acc[n] = (f32x4){0.f, 0.f, 0.f, 0.f};
#pragma unroll
            for (int ks = 0; ks < 4; ++ks) {
                const bf16x8 a = *(const LAS bf16x8*)(qA + (16 * m + fr) * 136 + 32 * ks + 8 * fq);
#pragma unroll
                for (int n = 0; n < 4; ++n) { const bf16x8 bb = *(const LAS bf16x8*)(sB + (16 * (4 * nh + n) + fr) * 136 + 32 * ks + 8 * fq);
                    acc[n] = __builtin_amdgcn_mfma_f32_16x16x32_bf16(a, bb, acc[n], 0, 0, 0); }
            }
            const float scale = 0.08838834764831845f;
#pragma unroll
            for (int n = 0; n < 4; ++n)
#pragma unroll
                for (int jj = 0; jj < 4; ++jj) oF[(16 * m + 4 * fq + jj) * 132 + 16 * (4 * nh + n) + fr] = acc[n][jj] * scale;
        }
        __syncthreads();
        {
            float o[16]; float ss = 0.f;
#pragma unroll
            for (int i = 0; i < 16; ++i) { o[i] = oF[s * 132 + cb + i]; ss += o[i] * o[i]; }
            ss += __shfl_xor(ss, 1); ss += __shfl_xor(ss, 2); ss += __shfl_xor(ss, 4);
            const float rstd = 1.f / sqrtf(ss * (1.f / 128.f) + EPS);
            const unsigned rw[8] = {r0.x, r0.y, r0.z, r0.w, r1.x, r1.y, r1.z, r1.w};
            const float* gg = A.in[I_GLAG] + h * 128 + cb;
            unsigned ow[8];
#pragma unroll
            for (int i = 0; i < 8; ++i) { const float y0 = o[2 * i] * rstd * gg[2 * i] * siluf_(bflo(rw[i])), y1 = o[2 * i + 1] * rstd * gg[2 * i + 1] * siluf_(bfhi(rw[i])); ow[i] = pk2(y0, y1); }
            bf16_t* yp = DRY ? (bf16_t*)A.out + (size_t)(t0 + s) * 512 + h * 128 + cb : P + (size_t)(t0 + s) * PLD + PC_R + h * 128 + cb;
            *(u32x4*)yp = (u32x4){ow[0], ow[1], ow[2], ow[3]}; *(u32x4*)(yp + 8) = (u32x4){ow[4], ow[5], ow[6], ow[7]};
        }
    }
#undef GO_LOAD
}

__device__ __forceinline__ unsigned ordkey(float v) { const unsigned u = __builtin_bit_cast(unsigned, v); return u ^ ((unsigned)((int)u >> 31) | 0x80000000u); }
__device__ __forceinline__ float unord16(unsigned k) { const unsigned u = ((k & 0x80000000u) ? (k & 0x7fffffffu) : ~k) & 0xffff0000u; return __builtin_bit_cast(float, u); }
__device__ __forceinline__ float unord(unsigned k) { const unsigned u = (k & 0x80000000u) ? (k & 0x7fffffffu) : ~k; return __builtin_bit_cast(float, u); }
#define INS16(r, xin) do { unsigned _x = (xin); _Pragma("unroll") for (int _i = 0; _i < 16; ++_i) { const unsigned _h = max((r)[_i], _x); _x = min((r)[_i], _x); (r)[_i] = _h; } } while (0)

#define CE(a, b) do { const unsigned _h = max((a), (b)), _l = min((a), (b)); (a) = _h; (b) = _l; } while (0)
#define SORT16(v) do { CE(v[0], v[1]); CE(v[2], v[3]); CE(v[0], v[2]); CE(v[1], v[3]); CE(v[1], v[2]); CE(v[4], v[5]); CE(v[6], v[7]); CE(v[4], v[6]); CE(v[5], v[7]); CE(v[5], v[6]); CE(v[0], v[4]); CE(v[2], v[6]); CE(v[2], v[4]); CE(v[1], v[5]); CE(v[3], v[7]); CE(v[3], v[5]); CE(v[1], v[2]); CE(v[3], v[4]); CE(v[5], v[6]); CE(v[8], v[9]); CE(v[10], v[11]); CE(v[8], v[10]); CE(v[9], v[11]); CE(v[9], v[10]); CE(v[12], v[13]); CE(v[14], v[15]); CE(v[12], v[14]); CE(v[13], v[15]); CE(v[13], v[14]); CE(v[8], v[12]); CE(v[10], v[14]); CE(v[10], v[12]); CE(v[9], v[13]); CE(v[11], v[15]); CE(v[11], v[13]); CE(v[9], v[10]); CE(v[11], v[12]); CE(v[13], v[14]); CE(v[0], v[8]); CE(v[4], v[12]); CE(v[4], v[8]); CE(v[2], v[10]); CE(v[6], v[14]); CE(v[6], v[10]); CE(v[2], v[4]); CE(v[6], v[8]); CE(v[10], v[12]); CE(v[1], v[9]); CE(v[5], v[13]); CE(v[5], v[9]); CE(v[3], v[11]); CE(v[7], v[15]); CE(v[7], v[11]); CE(v[3], v[5]); CE(v[7], v[9]); CE(v[11], v[13]); CE(v[1], v[2]); CE(v[3], v[4]); CE(v[5], v[6]); CE(v[7], v[8]); CE(v[9], v[10]); CE(v[11], v[12]); CE(v[13], v[14]); } while (0)
#define MERGE16(T, S) do { _Pragma("unroll") for (int _i = 0; _i < 16; ++_i) (T)[_i] = max((T)[_i], (S)[15 - _i]); \
    _Pragma("unroll") for (int _d = 8; _d >= 1; _d >>= 1) { _Pragma("unroll") for (int _i = 0; _i < 16; ++_i) if ((_i & _d) == 0) CE((T)[_i], (T)[_i + _d]); } } while (0)
__device__ __forceinline__ void peer_topk(const Frame& F, const Args& A) {
    const bf16_t* SC = (const bf16_t*)(A.ws + WS_P + P_SC);
    int* IDX = (int*)(A.ws + WS_P + P_IDX); float* GATE = (float*)(A.ws + WS_P + P_GATE);
    const int gw = F.bid * NWAVES + F.wave, NGW = F.G * NWAVES;
    for (int it = gw; it < 512 * 8; it += NGW) {
        const int h = it & 7, tb = it >> 3; const int tok = tb * 64 + F.lane;
        unsigned r1[16], r2[16], rc[16];
        const bf16_t* p1 = SC + ((size_t)(tok >> 4) * 256 + h * 32) * 128 + (tok & 15) * 8; const bf16_t* p2 = p1 + 16 * 128;
        {
            unsigned raw[128]; unsigned sg[16];
#pragma unroll
            for (int jq = 0; jq < 16; ++jq) { const u32x4 t4 = *(const u32x4*)(p1 + jq * 128);
#pragma unroll
                for (int c = 0; c < 4; ++c) { raw[8 * jq + 2 * c] = t4[c] << 16; raw[8 * jq + 2 * c + 1] = t4[c] & 0xffff0000u; } }
#pragma unroll
            for (int j = 0; j < 16; ++j) r1[j] = raw[j] | (unsigned)(127 - j);
            SORT16(r1);
#pragma unroll
            for (int gq = 1; gq < 8; ++gq) {
#pragma unroll
                for (int j = 0; j < 16; ++j) sg[j] = raw[16 * gq + j] | (unsigned)(127 - (16 * gq + j));
                SORT16(sg); MERGE16(r1, sg); }
#pragma unroll
            for (int jq = 0; jq < 16; ++jq) { const u32x4 t4 = *(const u32x4*)(p2 + jq * 128);
#pragma unroll
                for (int c = 0; c < 4; ++c) { raw[8 * jq + 2 * c] = t4[c] << 16; raw[8 * jq + 2 * c + 1] = t4[c] & 0xffff0000u; } }
#pragma unroll
            for (int j = 0; j < 16; ++j) r2[j] = raw[j] | (unsigned)(127 - j);
            SORT16(r2);
#pragma unroll
            for (int gq = 1; gq < 8; ++gq) {
#pragma unroll
                for (int j = 0; j < 16; ++j) sg[j] = raw[16 * gq + j] | (unsigned)(127 - (16 * gq + j));
                SORT16(sg); MERGE16(r2, sg); }
        }
        float v1[16], v2[16];
#pragma unroll
        for (int i = 0; i < 16; ++i) { v1[i] = unord16(r1[i]); v2[i] = unord16(r2[i]); }
        {
            unsigned cg[4][16]; int cn = 0;
#pragma unroll
            for (int a = 0; a < 16; ++a)
#pragma unroll
                for (int bq = 0; bq < 16; ++bq) if ((a + 1) * (bq + 1) <= 16) { cg[cn >> 4][cn & 15] = (ordkey(v1[a] + v2[bq]) & ~255u) | (unsigned)(a * 16 + bq); ++cn; }
#pragma unroll
            for (int z = 50; z < 64; ++z) cg[z >> 4][z & 15] = 0u;
            SORT16(cg[0]); SORT16(cg[1]); SORT16(cg[2]); SORT16(cg[3]);
            MERGE16(cg[0], cg[1]); MERGE16(cg[0], cg[2]); MERGE16(cg[0], cg[3]);
#pragma unroll
            for (int i = 0; i < 16; ++i) rc[i] = cg[0][i];
        }
        float val[16]; int ex[16];
        {
            LAS unsigned* t1 = (LAS unsigned*)(F.lds + F.wave * 8704) + F.lane * 17; LAS unsigned* t2 = t1 + 64 * 17;
#pragma unroll
            for (int i = 0; i < 16; ++i) { t1[i] = r1[i]; t2[i] = r2[i]; }
            LDS_WAIT(); asm volatile("" ::: "memory");
#pragma unroll
            for (int w = 0; w < 16; ++w) {
                const int a = (rc[w] >> 4) & 15, bq = rc[w] & 15;
                const unsigned k1 = t1[a], k2 = t2[bq];
                val[w] = unord16(k1) + unord16(k2);
                ex[w] = (127 - (int)(k1 & 127u)) * 128 + (127 - (int)(k2 & 127u));
            }
            LDS_WAIT(); asm volatile("" ::: "memory");
        }
        float mx = val[0];
#pragma unroll
        for (int w = 1; w < 16; ++w) mx = fmaxf(mx, val[w]);
        float sum = 0.f;
#pragma unroll
        for (int w = 0; w < 16; ++w) { val[w] = __expf(val[w] - mx); sum += val[w]; }
        const float inv = 1.f / sum;
        int* ip = IDX + (size_t)tok * 128 + h * 16; float* gp = GATE + (size_t)tok * 128 + h * 16;
#pragma unroll
        for (int q = 0; q < 4; ++q) { *(int4*)(ip + 4 * q) = make_int4(ex[4 * q], ex[4 * q + 1], ex[4 * q + 2], ex[4 * q + 3]);
            *(f32x4*)(gp + 4 * q) = (f32x4){val[4 * q] * inv, val[4 * q + 1] * inv, val[4 * q + 2] * inv, val[4 * q + 3] * inv}; }
    }
}

#define DPP_ADD(v, ctrl) ((v) + __builtin_bit_cast(float, __builtin_amdgcn_mov_dpp(__builtin_bit_cast(int, (v)), (ctrl), 0xf, 0xf, true)))
__device__ __forceinline__ void fp8x16_to_f32x2(const u32x4 r, f32x2* f) {
#pragma unroll
    for (int q = 0; q < 4; ++q) { f[2 * q] = __builtin_amdgcn_cvt_pk_f32_fp8((int)r[q], false); f[2 * q + 1] = __builtin_amdgcn_cvt_pk_f32_fp8((int)r[q], true); }
}
__device__ __forceinline__ void fp8x16_to_f32(const u32x4 r, float* f) {
#pragma unroll
    for (int q = 0; q < 4; ++q) { const f32x2 lo = __builtin_amdgcn_cvt_pk_f32_fp8((int)r[q], false), hi = __builtin_amdgcn_cvt_pk_f32_fp8((int)r[q], true);
        f[4 * q] = lo.x; f[4 * q + 1] = lo.y; f[4 * q + 2] = hi.x; f[4 * q + 3] = hi.y; }
}
__device__ __forceinline__ long lo64(u32x4 v) { return (long)(((unsigned long)v.y << 32) | (unsigned long)v.x); }
__device__ __forceinline__ long hi64(u32x4 v) { return (long)(((unsigned long)v.w << 32) | (unsigned long)v.z); }
template <int MODE>
__device__ __forceinline__ void peer_u_phase(const Frame& F, const Args& A) {
    const unsigned char* X8 = A.ws + WS_N18;
    const unsigned char* U8 = A.ws + WS_U8; const float* SU = (const float*)(A.ws + WS_SU); const float* SV = (const float*)(A.ws + WS_SV);
    const int* IDX = (const int*)(A.ws + WS_P + P_IDX); const float* GATE = (const float*)(A.ws + WS_P + P_GATE); float* AK = (float*)(MODE == 0 ? A.ws + WS_AK : A.ws + WS_P + P_SC);
    const int g = F.bid & 7, nmem = F.G >> 3, l = F.lane, step = nmem * NWAVES;
    const int loff = 64 * (l & 15) + 16 * (l >> 4);
    const bool dg = ((l & 15) >> 2) == (l >> 4); const int dr = l & 3;
    const float dw0 = (dg && dr == 0) ? 1.f : 0.f, dw1 = (dg && dr == 1) ? 1.f : 0.f, dw2 = (dg && dr == 2) ? 1.f : 0.f, dw3 = (dg && dr == 3) ? 1.f : 0.f;
    LAS int* le = (LAS int*)(F.lds + F.wave * 2048); LAS int* lk = le + 256;
    const bool b5 = (l & 32) != 0, b4 = (l & 16) != 0, b3 = (l & 8) != 0;
    int tok = 2 * ((F.bid >> 3) * NWAVES + F.wave);
    u32x4 nxA, nxB; int neA0, neA1, neB0, neB1; float ngA0, ngA1, ngB0, ngB1;
#define U_PREFETCH(t) do { const size_t _tA = (size_t)(t), _tB = (size_t)(t) + 1; if (MODE == 4) { nxA = (u32x4){(unsigned)_tA, 1u, 2u, 3u}; nxB = nxA; neA0 = (int)((_tA * 37 + l * 11) & 16383); neA1 = (int)((_tA * 53 + l * 7) & 16383); neB0 = (int)((_tB * 37 + l * 13) & 16383); neB1 = (int)((_tB * 29 + l * 3) & 16383); ngA0 = ngA1 = ngB0 = ngB1 = 0.01f; break; } nxA = *(const u32x4*)(X8 + _tA * 1024 + loff); nxB = *(const u32x4*)(X8 + _tB * 1024 + loff); \
        neA0 = IDX[_tA * 128 + l]; neA1 = IDX[_tA * 128 + 64 + l]; neB0 = IDX[_tB * 128 + l]; neB1 = IDX[_tB * 128 + 64 + l]; \
        ngA0 = GATE[_tA * 128 + l]; ngA1 = GATE[_tA * 128 + 64 + l]; ngB0 = GATE[_tB * 128 + l]; ngB1 = GATE[_tB * 128 + 64 + l]; } while (0)
    if (tok + 1 < T_TOK) U_PREFETCH(tok);
    for (; tok + 1 < T_TOK; tok += 2 * step) {
        const int tokA = tok, tokB = tok + 1;
        const u32x4 xA = nxA, xB = nxB;
        const int eA0 = neA0, eA1 = neA1, eB0 = neB0, eB1 = neB1; const float gA0 = ngA0, gA1 = ngA1, gB0 = ngB0, gB1 = ngB1;
        bool pf_done = false;
        const bool oA0 = (eA0 & 7) == g, oA1 = (eA1 & 7) == g, oB0 = (eB0 & 7) == g, oB1 = (eB1 & 7) == g;
        const unsigned long long mA0 = __ballot(oA0), mA1 = __ballot(oA1), mB0 = __ballot(oB0), mB1 = __ballot(oB1);
        const int c0 = __popcll(mA0), c1 = c0 + __popcll(mA1), c2 = c1 + __popcll(mB0), n = c2 + __popcll(mB1);
#define MBC(m) __builtin_amdgcn_mbcnt_hi((unsigned)((m) >> 32), __builtin_amdgcn_mbcnt_lo((unsigned)(m), 0u))
        if (oA0) { const int p = MBC(mA0); le[p] = (eA0 << 8) | l; lk[p] = __builtin_bit_cast(int, gA0); }
        if (oA1) { const int p = c0 + MBC(mA1); le[p] = (eA1 << 8) | (64 + l); lk[p] = __builtin_bit_cast(int, gA1); }
        if (oB0) { const int p = c1 + MBC(mB0); le[p] = (eB0 << 8) | 128 | l; lk[p] = __builtin_bit_cast(int, gB0); }
        if (oB1) { const int p = c2 + MBC(mB1); le[p] = (eB1 << 8) | 128 | (64 + l); lk[p] = __builtin_bit_cast(int, gB1); }
#undef MBC
        LDS_WAIT(); asm volatile("" ::: "memory");
        for (int cb = 0; cb < n || cb == 0; cb += 64) {
        const int nc = min(n, cb + 64);
        const bool fv = (cb + l) < nc;
        const int ent = fv ? le[cb + l] : 0; const float gt = fv ? __builtin_bit_cast(float, lk[cb + l]) : 0.f; float tot = 0.f;
        const float su = SU[ent >> 8], sv = SV[ent >> 8];
        const unsigned long long radr = (unsigned long long)(U8 + (size_t)(((ent >> 8) & 7) * 2048 + (((ent >> 8) >> 3) & (MODE == 2 ? 255 : 2047))) * 1024);
        const int ralo = (int)(unsigned)radr, rahi = (int)(unsigned)(radr >> 32);
        for (int i = cb; i < nc; i += 16) {
            u32x4 row[2][8];
#pragma unroll
            for (int b = 0; b < 2; ++b) if (i + 8 * b < nc) {
#pragma unroll
                for (int j = 0; j < 8; ++j) { const int ln = min(i + 8 * b + j, nc - 1) - cb;
                    const unsigned lo = (unsigned)__builtin_amdgcn_readlane(ralo, ln), hi = (unsigned)__builtin_amdgcn_readlane(rahi, ln);
                    const GAS unsigned char* rp = (const GAS unsigned char*)(((unsigned long long)hi << 32) | lo);
                    row[b][j] = *(const GAS u32x4*)(rp + (unsigned)loff); } }
            if (!pf_done) { pf_done = true; if (tok + 2 * step + 1 < T_TOK) U_PREFETCH(tok + 2 * step); }
#pragma unroll
            for (int b = 0; b < 2; ++b) if (i + 8 * b < nc) {
                float p[8];
                f32x4 accj[8];
                const int base0 = i + 8 * b;
                if (base0 + 8 <= c1) {
#pragma unroll
                    for (int j = 0; j < 8; ++j) accj[j] = __builtin_amdgcn_mfma_f32_16x16x32_fp8_fp8(lo64(row[b][j]), lo64(xA), (f32x4){0.f, 0.f, 0.f, 0.f}, 0, 0, 0);
#pragma unroll
                    for (int j = 0; j < 8; ++j) accj[j] = __builtin_amdgcn_mfma_f32_16x16x32_fp8_fp8(hi64(row[b][j]), hi64(xA), accj[j], 0, 0, 0);
                } else if (base0 >= c1) {
#pragma unroll
                    for (int j = 0; j < 8; ++j) accj[j] = __builtin_amdgcn_mfma_f32_16x16x32_fp8_fp8(lo64(row[b][j]), lo64(xB), (f32x4){0.f, 0.f, 0.f, 0.f}, 0, 0, 0);
#pragma unroll
                    for (int j = 0; j < 8; ++j) accj[j] = __builtin_amdgcn_mfma_f32_16x16x32_fp8_fp8(hi64(row[b][j]), hi64(xB), accj[j], 0, 0, 0);
                } else {
#pragma unroll
                    for (int j = 0; j < 8; ++j) { const u32x4 xs = (base0 + j >= c1) ? xB : xA; accj[j] = __builtin_amdgcn_mfma_f32_16x16x32_fp8_fp8(lo64(row[b][j]), lo64(xs), (f32x4){0.f, 0.f, 0.f, 0.f}, 0, 0, 0);
                        accj[j] = __builtin_amdgcn_mfma_f32_16x16x32_fp8_fp8(hi64(row[b][j]), hi64(xs), accj[j], 0, 0, 0); }
                }
#pragma unroll
                for (int j = 0; j < 8; ++j) p[j] = __builtin_fmaf(accj[j][3], dw3, __builtin_fmaf(accj[j][2], dw2, __builtin_fmaf(accj[j][1], dw1, accj[j][0] * dw0)));
                float q4[4], q2[2], q1;
#pragma unroll
                for (int j = 0; j < 4; ++j) { const float keep = b5 ? p[4 + j] : p[j], send = b5 ? p[j] : p[4 + j]; q4[j] = keep + __shfl_xor(send, 32); }
#pragma unroll
                for (int j = 0; j < 2; ++j) { const float keep = b4 ? q4[2 + j] : q4[j], send = b4 ? q4[j] : q4[2 + j]; q2[j] = keep + __shfl_xor(send, 16); }
                { const float keep = b3 ? q2[1] : q2[0], send = b3 ? q2[0] : q2[1]; q1 = keep + __shfl_xor(send, 8); }
                q1 = DPP_ADD(q1, 0xB1); q1 = DPP_ADD(q1, 0x4E); q1 = DPP_ADD(q1, 0x141);
                const float t = __builtin_bit_cast(float, __builtin_amdgcn_ds_bpermute((l & 7) * 32, __builtin_bit_cast(int, q1)));
                const int base = i + 8 * b;
                if ((l >> 3) == ((base - cb) >> 3)) tot = t;
            }
        }
        if (!pf_done) { if (tok + 2 * step + 1 < T_TOK) U_PREFETCH(tok + 2 * step); }
        if (fv) { const int tk = (ent & 128) ? tokB : tokA; AK[(size_t)tk * 128 + (ent & 127)] = gelu_tanh(tot * su * (1.f / 16.f)) * gt * sv; }
        if (n == 0) break;
        }
        LDS_WAIT(); asm volatile("" ::: "memory");
    }
#undef U_PREFETCH
}
template <int MODE>
__device__ __forceinline__ void peer_u_phase1(const Frame& F, const Args& A) {
    const unsigned char* X8 = A.ws + WS_N18;
    const unsigned char* U8 = A.ws + WS_U8; const float* SU = (const float*)(A.ws + WS_SU); const float* SV = (const float*)(A.ws + WS_SV);
    const int* IDX = (const int*)(A.ws + WS_P + P_IDX); const float* GATE = (const float*)(A.ws + WS_P + P_GATE); float* AK = (float*)(MODE == 0 ? A.ws + WS_AK : A.ws + WS_P + P_SC);
    const int g = F.bid & (UNG - 1), nmem = F.G >> UNG_SH, l = F.lane, step = nmem * NWAVES;
    const int loff = 64 * (l & 15) + 16 * (l >> 4);
    const bool dg = ((l & 15) >> 2) == (l >> 4); const int dr = l & 3;
    const float dw0 = (dg && dr == 0) ? 1.f : 0.f, dw1 = (dg && dr == 1) ? 1.f : 0.f, dw2 = (dg && dr == 2) ? 1.f : 0.f, dw3 = (dg && dr == 3) ? 1.f : 0.f;
    LAS int* le = (LAS int*)(F.lds + F.wave * 2048); LAS int* lk = le + 256;
    const bool b5 = (l & 32) != 0, b4 = (l & 16) != 0, b3 = (l & 8) != 0;
    int tok = (F.bid >> UNG_SH) * NWAVES + F.wave;
    u32x4 nxA; int neA0, neA1; float ngA0, ngA1;
#define U1_PREFETCH(t) do { const size_t _tA = (size_t)(t); nxA = *(const u32x4*)(X8 + _tA * 1024 + loff); \
        neA0 = IDX[_tA * 128 + l]; neA1 = IDX[_tA * 128 + 64 + l]; ngA0 = GATE[_tA * 128 + l]; ngA1 = GATE[_tA * 128 + 64 + l]; } while (0)
    if (tok < T_TOK) U1_PREFETCH(tok);
    for (; tok < T_TOK; tok += step) {
        const u32x4 xA = nxA;
        const int eA0 = neA0, eA1 = neA1; const float gA0 = ngA0, gA1 = ngA1;
        bool pf_done = false;
        const bool oA0 = (eA0 & (UNG - 1)) == g, oA1 = (eA1 & (UNG - 1)) == g;
        const unsigned long long mA0 = __ballot(oA0), mA1 = __ballot(oA1);
        const int c0 = __popcll(mA0), n = c0 + __popcll(mA1);
#define MBC(m) __builtin_amdgcn_mbcnt_hi((unsigned)((m) >> 32), __builtin_amdgcn_mbcnt_lo((unsigned)(m), 0u))
        if (oA0) { const int p = MBC(mA0); le[p] = (eA0 << 8) | l; lk[p] = __builtin_bit_cast(int, gA0); }
        if (oA1) { const int p = c0 + MBC(mA1); le[p] = (eA1 << 8) | (64 + l); lk[p] = __builtin_bit_cast(int, gA1); }
#undef MBC
        LDS_WAIT(); asm volatile("" ::: "memory");
        for (int cb = 0; cb < n || cb == 0; cb += 64) {
        const int nc = min(n, cb + 64);
        const bool fv = (cb + l) < nc;
        const int ent = fv ? le[cb + l] : 0; const float gt = fv ? __builtin_bit_cast(float, lk[cb + l]) : 0.f; float tot = 0.f;
        const float su = SU[ent >> 8], sv = SV[ent >> 8];
        const unsigned long long radr = (unsigned long long)(U8 + (size_t)(((ent >> 8) & (UNG - 1)) * (NEXP / UNG) + ((ent >> 8) >> UNG_SH)) * 1024);
        const int ralo = (int)(unsigned)radr, rahi = (int)(unsigned)(radr >> 32);
        for (int i = cb; i < nc; i += 16) {
            u32x4 row[2][8];
#pragma unroll
            for (int b = 0; b < 2; ++b) if (i + 8 * b < nc) {
#pragma unroll
                for (int j = 0; j < 8; ++j) { const int ln = min(i + 8 * b + j, nc - 1) - cb;
                    const unsigned lo = (unsigned)__builtin_amdgcn_readlane(ralo, ln), hi = (unsigned)__builtin_amdgcn_readlane(rahi, ln);
                    const GAS unsigned char* rp = (const GAS unsigned char*)(((unsigned long long)hi << 32) | lo);
                    row[b][j] = *(const GAS u32x4*)(rp + (unsigned)loff); } }
            if (!pf_done) { pf_done = true; if (tok + step < T_TOK) U1_PREFETCH(tok + step); }
#pragma unroll
            for (int b = 0; b < 2; ++b) if (i + 8 * b < nc) {
                float p[8]; f32x4 accj[8];
#pragma unroll
                for (int j = 0; j < 8; ++j) accj[j] = __builtin_amdgcn_mfma_f32_16x16x32_fp8_fp8(lo64(row[b][j]), lo64(xA), (f32x4){0.f, 0.f, 0.f, 0.f}, 0, 0, 0);
#pragma unroll
                for (int j = 0; j < 8; ++j) accj[j] = __builtin_amdgcn_mfma_f32_16x16x32_fp8_fp8(hi64(row[b][j]), hi64(xA), accj[j], 0, 0, 0);
#pragma unroll
                for (int j = 0; j < 8; ++j) p[j] = __builtin_fmaf(accj[j][3], dw3, __builtin_fmaf(accj[j][2], dw2, __builtin_fmaf(accj[j][1], dw1, accj[j][0] * dw0)));
                float q4[4], q2[2], q1;
#pragma unroll
                for (int j = 0; j < 4; ++j) { const float keep = b5 ? p[4 + j] : p[j], send = b5 ? p[j] : p[4 + j]; q4[j] = keep + __shfl_xor(send, 32); }
#pragma unroll
                for (int j = 0; j < 2; ++j) { const float keep = b4 ? q4[2 + j] : q4[j], send = b4 ? q4[j] : q4[2 + j]; q2[j] = keep + __shfl_xor(send, 16); }
                { const float keep = b3 ? q2[1] : q2[0], send = b3 ? q2[0] : q2[1]; q1 = keep + __shfl_xor(send, 8); }
                q1 = DPP_ADD(q1, 0xB1); q1 = DPP_ADD(q1, 0x4E); q1 = DPP_ADD(q1, 0x141);
                const float t = __builtin_bit_cast(float, __builtin_amdgcn_ds_bpermute((l & 7) * 32, __builtin_bit_cast(int, q1)));
                const int base = i + 8 * b;
                if ((l >> 3) == ((base - cb) >> 3)) tot = t;
            }
        }
        if (!pf_done) { pf_done = true; if (tok + step < T_TOK) U1_PREFETCH(tok + step); }
        if (fv) AK[(size_t)tok * 128 + (ent & 127)] = gelu_tanh(tot * su * (1.f / 16.f)) * gt * sv;
        if (n == 0) break;
        }
        LDS_WAIT(); asm volatile("" ::: "memory");
    }
#undef U1_PREFETCH
}
template <int MODE>
__device__ __forceinline__ void peer_u4_phase(const Frame& F, const Args& A) {
    const unsigned char* X8 = A.ws + WS_N18;
    const float* SU = (const float*)(A.ws + WS_SU); const float* SV = (const float*)(A.ws + WS_SV);
    const int* IDX = (const int*)(A.ws + WS_P + P_IDX); const float* GATE = (const float*)(A.ws + WS_P + P_GATE); float* AK = (float*)(MODE == 0 ? A.ws + WS_AK : A.ws + WS_P + P_SC);
    const int g = F.bid & (UNG - 1), nmem = F.G >> UNG_SH, l = F.lane, step = nmem * NWAVES;
    const int m = l & 15, q = l >> 4;
    const GAS unsigned char* ub = (const GAS unsigned char*)(A.ws + WS_U8 + (size_t)g * (NEXP / UNG) * 512);
    const unsigned lconst = 16u * (unsigned)(4 * (m & 7) + q);
    const int xoff = 128 * (m & 7) + 16 * q;
    const bool dg = (m < 8) && ((m >> 2) == (q & 1)); const int dr = m & 3;
    const float dw0 = (dg && dr == 0) ? 1.f : 0.f, dw1 = (dg && dr == 1) ? 1.f : 0.f, dw2 = (dg && dr == 2) ? 1.f : 0.f, dw3 = (dg && dr == 3) ? 1.f : 0.f;
    const int rsel = 4 * (m >> 3);
    const int osrc = 4 * (32 * (l & 1) + 4 * ((l & 15) >> 1));
    const int sc1 = 0x7F7F7F7F;
    LAS int* le = (LAS int*)(F.lds + F.wave * 2048); LAS int* lk = le + 256;
    const bool b4 = (l & 16) != 0, b3 = (l & 8) != 0, b2 = (l & 4) != 0;
    int tok = (F.bid >> UNG_SH) * NWAVES + F.wave;
    u32x4 nx0, nx1; int ne0, ne1; float ng0, ng1;
#define U4_PREFETCH(t) do { const size_t _t = (size_t)(t); nx0 = *(const u32x4*)(X8 + _t * 1024 + xoff); nx1 = *(const u32x4*)(X8 + _t * 1024 + xoff + 64); \
        ne0 = IDX[_t * 128 + l]; ne1 = IDX[_t * 128 + 64 + l]; ng0 = GATE[_t * 128 + l]; ng1 = GATE[_t * 128 + 64 + l]; } while (0)
    if (tok < T_TOK) U4_PREFETCH(tok);
    for (; tok < T_TOK; tok += step) {
        const i32x8 xb = __builtin_shufflevector(__builtin_bit_cast(i32x4, nx0), __builtin_bit_cast(i32x4, nx1), 0, 1, 2, 3, 4, 5, 6, 7);
        const int e0 = ne0, e1 = ne1; const float g0 = ng0, g1 = ng1;
        bool pf_done = false;
        const bool o0 = (e0 & (UNG - 1)) == g, o1 = (e1 & (UNG - 1)) == g;
        const unsigned long long m0 = __ballot(o0), m1 = __ballot(o1);
        const int c0 = __popcll(m0), n = c0 + __popcll(m1);
#define MBC(mm) __builtin_amdgcn_mbcnt_hi((unsigned)((mm) >> 32), __builtin_amdgcn_mbcnt_lo((unsigned)(mm), 0u))
        if (o0) { const int p = MBC(m0); le[p] = (e0 << 8) | l; lk[p] = __builtin_bit_cast(int, g0); }
        if (o1) { const int p = c0 + MBC(m1); le[p] = (e1 << 8) | (64 + l); lk[p] = __builtin_bit_cast(int, g1); }
#undef MBC
        LDS_WAIT(); asm volatile("" ::: "memory");
        for (int cb = 0; cb < n || cb == 0; cb += 64) {
            const int nc = min(n, cb + 64);
            const bool fv = (cb + l) < nc;
            const int ent = fv ? le[cb + l] : 0; const float gt = fv ? __builtin_bit_cast(float, lk[cb + l]) : 0.f; float tot = 0.f;
            const float su = SU[ent >> 8], sv = SV[ent >> 8];
            const int roff = fv ? ((ent >> 8) >> UNG_SH) * 512 : 0;
            for (int i = cb; i < nc; i += 32) {
                u32x4 row[2][8];
#pragma unroll
                for (int b = 0; b < 2; ++b) if (i + 16 * b < nc) {
#pragma unroll
                    for (int j = 0; j < 8; ++j) { const int ro = __builtin_amdgcn_ds_bpermute(rsel + 4 * (i - cb + 16 * b + 2 * j), roff);
                        row[b][j] = *(const GAS u32x4*)(ub + ((unsigned)ro + lconst)); } }
                if (!pf_done) { pf_done = true; if (tok + step < T_TOK) U4_PREFETCH(tok + step); }
#pragma unroll
                for (int b = 0; b < 2; ++b) if (i + 16 * b < nc) {
                    float p[8];
#pragma unroll
                    for (int j = 0; j < 8; ++j) { const i32x4 r4 = __builtin_bit_cast(i32x4, row[b][j]);
                        const f32x4 d = __builtin_amdgcn_mfma_scale_f32_16x16x128_f8f6f4(__builtin_shufflevector(r4, r4, 0, 1, 2, 3, -1, -1, -1, -1), xb, (f32x4){0.f, 0.f, 0.f, 0.f}, 4, 0, 0, sc1, 0, sc1);
                        p[j] = __builtin_fmaf(d[3], dw3, __builtin_fmaf(d[2], dw2, __builtin_fmaf(d[1], dw1, d[0] * dw0))); }
                    float q4[4], q2[2], q1;
#pragma unroll
                    for (int j = 0; j < 4; ++j) { const float keep = b4 ? p[4 + j] : p[j], send = b4 ? p[j] : p[4 + j]; q4[j] = keep + __shfl_xor(send, 16); }
#pragma unroll
                    for (int j = 0; j < 2; ++j) { const float keep = b3 ? q4[2 + j] : q4[j], send = b3 ? q4[j] : q4[2 + j]; q2[j] = keep + __shfl_xor(send, 8); }
                    { const float keep = b2 ? q2[1] : q2[0], send = b2 ? q2[0] : q2[1]; q1 = keep + __shfl_xor(send, 4); }
                    q1 = DPP_ADD(q1, 0xB1); q1 = DPP_ADD(q1, 0x4E);
                    const float t = __builtin_bit_cast(float, __builtin_amdgcn_ds_bpermute(osrc, __builtin_bit_cast(int, q1)));
                    if ((l >> 4) == ((i - cb + 16 * b) >> 4)) tot = t;
                }
            }
            if (!pf_done) { pf_done = true; if (tok + step < T_TOK) U4_PREFETCH(tok + step); }
            if (fv) AK[(size_t)tok * 128 + (ent & 127)] = gelu_tanh(tot * su * (1.f / 16.f)) * gt * sv;
            if (n == 0) break;
        }
        LDS_WAIT(); asm volatile("" ::: "memory");
    }
#undef U4_PREFETCH
}
template <int MODE>
__device__ __forceinline__ void peer_u4_all(const Frame& F, const Args& A) {
    const unsigned char* X8 = A.ws + WS_N18;
    const float* SU = (const float*)(A.ws + WS_SU); const float* SV = (const float*)(A.ws + WS_SV);
    const int* IDX = (const int*)(A.ws + WS_P + P_IDX); const float* GATE = (const float*)(A.ws + WS_P + P_GATE); float* AK = (float*)(MODE == 0 ? A.ws + WS_AK : A.ws + WS_P + P_SC);
    const int l = F.lane, step = F.G * NWAVES;
    const int m = l & 15, q = l >> 4;
    const GAS unsigned char* ub = (const GAS unsigned char*)(A.ws + WS_U8);
    const unsigned lconst = 16u * (unsigned)(8 * q + (m & 7));
    const int xoff = 256 * (q >> 1) + 32 * (m & 7) + 16 * (q & 1);
    const bool dg = (m < 8) && ((m >> 2) == (q & 1)); const int dr = m & 3;
    const float dw0 = (dg && dr == 0) ? 1.f : 0.f, dw1 = (dg && dr == 1) ? 1.f : 0.f, dw2 = (dg && dr == 2) ? 1.f : 0.f, dw3 = (dg && dr == 3) ? 1.f : 0.f;
    const int rsel = 4 * (m >> 3);
    const int osrc = 4 * (32 * (l & 1) + 4 * ((l & 15) >> 1));
    const int sc1 = 0x7F7F7F7F;
    const bool b4 = (l & 16) != 0, b3 = (l & 8) != 0, b2 = (l & 4) != 0;
    const int lhi = l >> 4;
    int tok = F.bid * NWAVES + F.wave;
    u32x4 nx0, nx1; int ne0, ne1; float ng0, ng1, nrss;
    const float* RSS = (const float*)(A.ws + WS_RSS);
#define UA_PREFETCH(t) do { const size_t _t = (size_t)(t); nx0 = __builtin_nontemporal_load((const u32x4*)(X8 + _t * 1024 + xoff)); nx1 = __builtin_nontemporal_load((const u32x4*)(X8 + _t * 1024 + xoff + 512)); \
        ne0 = __builtin_nontemporal_load(IDX + _t * 128 + l); ne1 = __builtin_nontemporal_load(IDX + _t * 128 + 64 + l); ng0 = __builtin_nontemporal_load(GATE + _t * 128 + l); ng1 = __builtin_nontemporal_load(GATE + _t * 128 + 64 + l); nrss = RSS[_t]; } while (0)
#define UA_LOADS(R, ro_, h) do { _Pragma("unroll") for (int j_ = 0; j_ < 16; ++j_) { const int o_ = __builtin_amdgcn_ds_bpermute(rsel + 4 * (32 * (h) + 2 * j_), (ro_)); \
        R[j_] = *(const GAS u32x4*)(ub + ((unsigned)o_ + lconst)); } } while (0)
#define UA_COMPUTE(R, xb_, h, tot_) do { _Pragma("unroll") for (int b_ = 0; b_ < 2; ++b_) { float p_[8]; \
        _Pragma("unroll") for (int j_ = 0; j_ < 8; ++j_) { const i32x4 r4_ = __builtin_bit_cast(i32x4, R[8 * b_ + j_]); \
            const f32x4 d_ = __builtin_amdgcn_mfma_scale_f32_16x16x128_f8f6f4(__builtin_shufflevector(r4_, r4_, 0, 1, 2, 3, -1, -1, -1, -1), (xb_), (f32x4){0.f, 0.f, 0.f, 0.f}, 4, 0, 0, sc1, 0, sc1); \
            p_[j_] = __builtin_fmaf(d_[3], dw3, __builtin_fmaf(d_[2], dw2, __builtin_fmaf(d_[1], dw1, d_[0] * dw0))); } \
        float q4_[4], q2_[2], q1_; \
        _Pragma("unroll") for (int j_ = 0; j_ < 4; ++j_) { const float keep_ = b4 ? p_[4 + j_] : p_[j_], send_ = b4 ? p_[j_] : p_[4 + j_]; q4_[j_] = keep_ + __shfl_xor(send_, 16); } \
        _Pragma("unroll") for (int j_ = 0; j_ < 2; ++j_) { const float keep_ = b3 ? q4_[2 + j_] : q4_[j_], send_ = b3 ? q4_[j_] : q4_[2 + j_]; q2_[j_] = keep_ + __shfl_xor(send_, 8); } \
        { const float keep_ = b2 ? q2_[1] : q2_[0], send_ = b2 ? q2_[0] : q2_[1]; q1_ = keep_ + __shfl_xor(send_, 4); } \
        q1_ = DPP_ADD(q1_, 0xB1); q1_ = DPP_ADD(q1_, 0x4E); \
        const float t_ = __builtin_bit_cast(float, __builtin_amdgcn_ds_bpermute(osrc, __builtin_bit_cast(int, q1_))); \
        if (lhi == 2 * (h) + b_) (tot_) = t_; } } while (0)
    u32x4 RA[16], RB[16];
    if (tok < T_TOK) { UA_PREFETCH(tok); UA_LOADS(RA, ne0 * 512, 0); }
    for (; tok < T_TOK; tok += step) {
        const i32x8 xb = __builtin_shufflevector(__builtin_bit_cast(i32x4, nx0), __builtin_bit_cast(i32x4, nx1), 0, 1, 2, 3, 4, 5, 6, 7);
        const int e0 = ne0, e1 = ne1; const float g0 = ng0, g1 = ng1;
        const float rs16 = (1.f / 16.f) / sqrtf(nrss * (1.f / D) + EPS);
        const int ro0 = e0 * 512, ro1 = e1 * 512;
        const float su0 = SU[e0], sv0 = SV[e0], su1 = SU[e1], sv1 = SV[e1];
        const bool more = tok + step < T_TOK;
        float tot0 = 0.f, tot1 = 0.f;
        UA_LOADS(RB, ro0, 1);
        if (more) UA_PREFETCH(tok + step);
        UA_COMPUTE(RA, xb, 0, tot0);
        UA_LOADS(RA, ro1, 0);
        UA_COMPUTE(RB, xb, 1, tot0);
        UA_LOADS(RB, ro1, 1);
        UA_COMPUTE(RA, xb, 0, tot1);
        if (more) UA_LOADS(RA, ne0 * 512, 0);
        UA_COMPUTE(RB, xb, 1, tot1);
        __builtin_nontemporal_store(gelu_tanh(tot0 * su0 * rs16) * g0 * sv0, AK + (size_t)tok * 128 + l);
        __builtin_nontemporal_store(gelu_tanh(tot1 * su1 * rs16) * g1 * sv1, AK + (size_t)tok * 128 + 64 + l);
    }
#undef UA_PREFETCH
#undef UA_LOADS
#undef UA_COMPUTE
}
__device__ __forceinline__ float wave_max_nonneg(float v) {
    unsigned u = __builtin_bit_cast(unsigned, v);
    u = max(u, (unsigned)__builtin_amdgcn_mov_dpp((int)u, 0xB1, 0xf, 0xf, true));
    u = max(u, (unsigned)__builtin_amdgcn_mov_dpp((int)u, 0x4E, 0xf, 0xf, true));
    u = max(u, (unsigned)__builtin_amdgcn_mov_dpp((int)u, 0x141, 0xf, 0xf, true));
    u = max(u, (unsigned)__builtin_amdgcn_mov_dpp((int)u, 0x140, 0xf, 0xf, true));
    const unsigned a = (unsigned)__builtin_amdgcn_readlane((int)u, 0), b = (unsigned)__builtin_amdgcn_readlane((int)u, 16), c = (unsigned)__builtin_amdgcn_readlane((int)u, 32), d = (unsigned)__builtin_amdgcn_readlane((int)u, 48);
    return __builtin_bit_cast(float, max(max(a, b), max(c, d)));
}
template <int MODE>
__device__ __forceinline__ void peer_v_phase(const Frame& F, const Args& A) {
    const unsigned char* V8 = A.ws + WS_V8; const int* IDX = (const int*)(A.ws + WS_P + P_IDX); const float* AK = (const float*)(A.ws + WS_AK);
    float* out = MODE == 0 ? A.out : (float*)(A.ws + WS_P + P_SC);
    const int g = F.bid & 7, nmem = F.G >> 3, l = F.lane, sub = l & 7, rr = l >> 3, n16 = l & 15, q = l >> 4, step = nmem * NWAVES;
    const GAS unsigned char* vb = (const GAS unsigned char*)(V8 + (size_t)g * NEXP * 128);
    LAS unsigned long long* rep = (LAS unsigned long long*)(F.lds + F.wave * 2048);
    const unsigned long long bm = 0xFFull << (8 * (n16 & 7));
    const int repi = 2 * q + (n16 >> 3);
    const bool vl = (n16 < 8) && (q < 2);
    LAS float* stg = (LAS float*)(F.lds + 16384 + F.wave * 512);
    int tok = 2 * ((F.bid >> 3) * NWAVES + F.wave);
    int ne[4]; float na[4];
#define V_PREFETCH(t) do { const size_t _a = (size_t)(t) * 128, _b = ((size_t)(t) + 1) * 128; ne[0] = IDX[_a + l]; ne[1] = IDX[_a + 64 + l]; ne[2] = IDX[_b + l]; ne[3] = IDX[_b + 64 + l]; \
        na[0] = AK[_a + l]; na[1] = AK[_a + 64 + l]; na[2] = AK[_b + l]; na[3] = AK[_b + 64 + l]; } while (0)
    if (tok + 1 < T_TOK) V_PREFETCH(tok);
    for (; tok + 1 < T_TOK; tok += 2 * step) {
        const int e0 = ne[0], e1 = ne[1], e2 = ne[2], e3 = ne[3]; const float a0 = na[0], a1 = na[1], a2 = na[2], a3 = na[3];
        u32x4 rowA[16], rowB[16];
#pragma unroll
        for (int i = 0; i < 16; ++i) { const int src = (8 * (i & 7) + rr) * 4;
            const int ea = __builtin_amdgcn_ds_bpermute(src, i < 8 ? e0 : e1), eb = __builtin_amdgcn_ds_bpermute(src, i < 8 ? e2 : e3);
            rowA[i] = *(const GAS u32x4*)(vb + ((unsigned)ea * 128u + 16u * (unsigned)sub)); rowB[i] = *(const GAS u32x4*)(vb + ((unsigned)eb * 128u + 16u * (unsigned)sub)); }
        f32x4 HA = {0.f, 0.f, 0.f, 0.f}, HB = {0.f, 0.f, 0.f, 0.f};
        if (l < 32) { const float* hpa = out + (size_t)tok * D + g * 128 + 4 * l; HA = *(const f32x4*)hpa; HB = *(const f32x4*)(hpa + D); }
        if (tok + 2 * step + 1 < T_TOK) V_PREFETCH(tok + 2 * step);
        const float amA = wave_max_nonneg(fmaxf(fabsf(a0), fabsf(a1))), amB = wave_max_nonneg(fmaxf(fabsf(a2), fabsf(a3)));
        const float scA = amA > 0.f ? 224.f * __builtin_amdgcn_rcpf(amA) : 0.f, invA = amA * (1.f / 224.f), scB = amB > 0.f ? 224.f * __builtin_amdgcn_rcpf(amB) : 0.f, invB = amB * (1.f / 224.f);
        { const unsigned wA = (unsigned)__builtin_amdgcn_cvt_pk_fp8_f32(a0 * scA, a1 * scA, 0, false), wB = (unsigned)__builtin_amdgcn_cvt_pk_fp8_f32(a2 * scB, a3 * scB, 0, false);
          const unsigned r0 = (wA & 0xffu) * 0x01010101u, r1 = ((wA >> 8) & 0xffu) * 0x01010101u, r2 = (wB & 0xffu) * 0x01010101u, r3 = ((wB >> 8) & 0xffu) * 0x01010101u;
          rep[l] = ((unsigned long long)r0 << 32) | r0; rep[64 + l] = ((unsigned long long)r1 << 32) | r1; rep[128 + l] = ((unsigned long long)r2 << 32) | r2; rep[192 + l] = ((unsigned long long)r3 << 32) | r3; }
        LDS_WAIT(); asm volatile("" ::: "memory");
#pragma unroll
        for (int t2 = 0; t2 < 2; ++t2) {
            f32x4 alo = {0.f, 0.f, 0.f, 0.f}, ahi = {0.f, 0.f, 0.f, 0.f};
#pragma unroll
            for (int i = 0; i < 16; ++i) { const long bop = (long)(rep[128 * t2 + 8 * i + repi] & bm); const u32x4 rw = t2 ? rowB[i] : rowA[i];
                alo = __builtin_amdgcn_mfma_f32_16x16x32_fp8_fp8(lo64(rw), bop, alo, 0, 0, 0);
                ahi = __builtin_amdgcn_mfma_f32_16x16x32_fp8_fp8(hi64(rw), bop, ahi, 0, 0, 0); }
            const float inv = t2 ? invB : invA;
            float vlo[4], vhi[4];
#pragma unroll
            for (int r = 0; r < 4; ++r) { const float tl = alo[r], th = ahi[r];
                vlo[r] = (tl + __builtin_bit_cast(float, __builtin_amdgcn_ds_bpermute(((l + 40) & 63) * 4, __builtin_bit_cast(int, tl)))) * inv;
                vhi[r] = (th + __builtin_bit_cast(float, __builtin_amdgcn_ds_bpermute(((l + 40) & 63) * 4, __builtin_bit_cast(int, th)))) * inv; }
            if (vl) {
#pragma unroll
                for (int r = 0; r < 4; ++r) { stg[64 * q + 16 * r + n16] = vlo[r]; stg[64 * q + 16 * r + n16 + 8] = vhi[r]; } }
            LDS_WAIT(); asm volatile("" ::: "memory");
            if (l < 32) { const f32x4 dv = *(const LAS f32x4*)(stg + 4 * l); *(f32x4*)(out + (size_t)(tok + t2) * D + g * 128 + 4 * l) = (t2 ? HB : HA) + dv; }
            LDS_WAIT(); asm volatile("" ::: "memory");
        }
        LDS_WAIT(); asm volatile("" ::: "memory");
    }
#undef V_PREFETCH
}
typedef float f32x16 __attribute__((ext_vector_type(16)));
template <int MODE>
__device__ __forceinline__ void peer_v4_phase(const Frame& F, const Args& A) {
    const int* IDX = (const int*)(A.ws + WS_P + P_IDX); const float* AK = (const float*)(A.ws + WS_AK);
    float* out = A.out;
    const int l = F.lane, n = l & 31, hq = l >> 5, step = F.G * NWAVES;
    const GAS unsigned char* vb = (const GAS unsigned char*)(A.ws + WS_V8);
    const unsigned lconst = 16u * (unsigned)n;
    const bool diag = ((l >> 4) & 1) == hq;
    const unsigned bytem = diag ? (0xFFu << (8 * (l & 3))) : 0u; const int dsel = (l & 15) >> 2;
    const unsigned M0 = dsel == 0 ? bytem : 0u, M1 = dsel == 1 ? bytem : 0u, M2 = dsel == 2 ? bytem : 0u, M3 = dsel == 3 ? bytem : 0u;
    const int rsel = 4 * hq;
    const int sc1 = 0x7F7F7F7F;
    const int colb = 8 * n + 4 * hq;
    int tok = F.bid * NWAVES + F.wave;
    int ne0, ne1; float na0, na1;
#define V4_PREFETCH(t) do { const size_t _t = (size_t)(t) * 128; ne0 = __builtin_nontemporal_load(IDX + _t + l); ne1 = __builtin_nontemporal_load(IDX + _t + 64 + l); na0 = __builtin_nontemporal_load(AK + _t + l); na1 = __builtin_nontemporal_load(AK + _t + 64 + l); } while (0)
#define V4_LOADS(R, ro_, h) do { int ba_ = rsel + 4 * (16 * (h)); _Pragma("unroll") for (int j_ = 0; j_ < 8; ++j_) { asm volatile("" : "+v"(ba_)); const int o_ = __builtin_amdgcn_ds_bpermute(ba_, (ro_)); ba_ += 8; \
        R[j_] = *(const GAS u32x4*)(vb + ((unsigned)o_ + lconst)); } } while (0)
#define V4_ONE(ACC, R, rep_, h, j_) do { unsigned s0_ = (unsigned)__builtin_amdgcn_readlane((int)(rep_), 16 * (h) + 2 * (j_)), s1_ = (unsigned)__builtin_amdgcn_readlane((int)(rep_), 16 * (h) + 2 * (j_) + 1); \
        asm volatile("" : "+s"(s0_), "+s"(s1_), "+v"(ACC)); \
        const i32x8 a8_ = {(int)(s0_ & M0), (int)(s0_ & M1), (int)(s0_ & M2), (int)(s0_ & M3), (int)(s1_ & M0), (int)(s1_ & M1), (int)(s1_ & M2), (int)(s1_ & M3)}; \
        const i32x4 r4_ = __builtin_bit_cast(i32x4, R[j_]); \
        ACC = __builtin_amdgcn_mfma_scale_f32_32x32x64_f8f6f4(a8_, __builtin_shufflevector(r4_, r4_, 0, 1, 2, 3, -1, -1, -1, -1), ACC, 0, 4, 0, sc1, 0, sc1); } while (0)
#define V4_COMPUTE(R, rep_, h) do { V4_ONE(acc, R, rep_, h, 0); V4_ONE(acc1, R, rep_, h, 1); V4_ONE(acc, R, rep_, h, 2); V4_ONE(acc1, R, rep_, h, 3); \
        V4_ONE(acc, R, rep_, h, 4); V4_ONE(acc1, R, rep_, h, 5); V4_ONE(acc, R, rep_, h, 6); V4_ONE(acc1, R, rep_, h, 7); } while (0)
    u32x4 RA[8], RB[8];
    if (tok < T_TOK) { V4_PREFETCH(tok); V4_LOADS(RA, ne0 * 512, 0); }
    for (; tok < T_TOK; tok += step) {
        const int e0 = ne0, e1 = ne1; const float a0 = na0, a1 = na1;
        const int ro0 = e0 * 512, ro1 = e1 * 512;
        const bool more = tok + step < T_TOK;
        V4_LOADS(RB, ro0, 1);
        if (more) V4_PREFETCH(tok + step);
        const float am = wave_max_nonneg(fmaxf(fabsf(a0), fabsf(a1)));
        const float sc = am > 0.f ? 224.f * __builtin_amdgcn_rcpf(am) : 0.f, inv = am * (1.f / 224.f);
        const unsigned w8 = (unsigned)__builtin_amdgcn_cvt_pk_fp8_f32(a0 * sc, a1 * sc, 0, false);
        const unsigned rep0 = (w8 & 0xffu) * 0x01010101u, rep1 = ((w8 >> 8) & 0xffu) * 0x01010101u;
        f32x16 acc, acc1;
#pragma unroll
        for (int i = 0; i < 16; ++i) { acc[i] = 0.f; acc1[i] = 0.f; }
        V4_COMPUTE(RA, rep0, 0); V4_LOADS(RA, ro0, 2);
        V4_COMPUTE(RB, rep0, 1); V4_LOADS(RB, ro0, 3);
        V4_COMPUTE(RA, rep0, 2); V4_LOADS(RA, ro1, 0);
        V4_COMPUTE(RB, rep0, 3); V4_LOADS(RB, ro1, 1);
        V4_COMPUTE(RA, rep1, 0); V4_LOADS(RA, ro1, 2);
        V4_COMPUTE(RB, rep1, 1); V4_LOADS(RB, ro1, 3);
        f32x4 H[4];
        u32x2 MX[4];
        { const bf16_t* mp = (const bf16_t*)(A.ws + WS_N1) + (size_t)tok * D + colb;
#pragma unroll
          for (int j = 0; j < 4; ++j) MX[j] = __builtin_nontemporal_load((const u32x2*)(mp + 256 * j)); }
        V4_COMPUTE(RA, rep1, 2);
        if (more) V4_LOADS(RA, ne0 * 512, 0);
        V4_COMPUTE(RB, rep1, 3);
        acc = acc + acc1;
        float ss = 0.f;
#pragma unroll
        for (int j = 0; j < 4; ++j) { H[j] = (f32x4){bflo(MX[j].x), bfhi(MX[j].x), bflo(MX[j].y), bfhi(MX[j].y)} + (f32x4){acc[4 * j], acc[4 * j + 1], acc[4 * j + 2], acc[4 * j + 3]} * inv;
            ss += (H[j].x * H[j].x + H[j].y * H[j].y) + (H[j].z * H[j].z + H[j].w * H[j].w); }
        const float rstd = 1.f / sqrtf(wave_sum(ss) * (1.f / D) + EPS);
        { float* hp = out + (size_t)tok * D + colb;
#pragma unroll
          for (int j = 0; j < 4; ++j) __builtin_nontemporal_store(H[j] * rstd * *(const f32x4*)(A.in[I_FG] + colb + 256 * j), (f32x4*)(hp + 256 * j)); }
    }
#undef V4_PREFETCH
#undef V4_LOADS
#undef V4_COMPUTE
#undef V4_ONE
}
__device__ __forceinline__ void final_norm_phase(const Frame& F, const Args& A) {
    const int gw = F.bid * NWAVES + F.wave, NGW = F.G * NWAVES, l = F.lane; const float* fg = A.in[I_FG];
    const f32x4* gp = (const f32x4*)fg + l;
    int tok = gw;
    for (; tok + 3 * NGW < T_TOK; tok += 4 * NGW) {
        f32x4 v[4][4]; float ss[4];
#pragma unroll
        for (int b = 0; b < 4; ++b) { const f32x4* hp = (const f32x4*)(A.out + (size_t)(tok + b * NGW) * D) + l;
#pragma unroll
            for (int j = 0; j < 4; ++j) v[b][j] = hp[64 * j]; }
#pragma unroll
        for (int b = 0; b < 4; ++b) { ss[b] = 0.f;
#pragma unroll
            for (int j = 0; j < 4; ++j) ss[b] += (v[b][j].x * v[b][j].x + v[b][j].y * v[b][j].y) + (v[b][j].z * v[b][j].z + v[b][j].w * v[b][j].w); }
#pragma unroll
        for (int o = 1; o < 64; o <<= 1) {
#pragma unroll
            for (int b = 0; b < 4; ++b) ss[b] += __shfl_xor(ss[b], o); }
#pragma unroll
        for (int b = 0; b < 4; ++b) { const float rstd = 1.f / sqrtf(ss[b] * (1.f / D) + EPS); f32x4* hp = (f32x4*)(A.out + (size_t)(tok + b * NGW) * D) + l;
#pragma unroll
            for (int j = 0; j < 4; ++j) hp[64 * j] = v[b][j] * rstd * gp[64 * j]; }
    }
    for (; tok < T_TOK; tok += NGW) { f32x4* hp = (f32x4*)(A.out + (size_t)tok * D) + l; f32x4 v[4]; float ss = 0.f;
#pragma unroll
        for (int j = 0; j < 4; ++j) { v[j] = hp[64 * j]; ss += (v[j].x * v[j].x + v[j].y * v[j].y) + (v[j].z * v[j].z + v[j].w * v[j].w); }
        const float rstd = 1.f / sqrtf(wave_sum(ss) * (1.f / D) + EPS);
#pragma unroll
        for (int j = 0; j < 4; ++j) hp[64 * j] = v[j] * rstd * gp[64 * j]; }
}

#ifdef DEBUG_CHECK
constexpr size_t WS_DBG = 472 * MiB;
__device__ __forceinline__ int dbg_tok(int i) { return (i * 509 + 3) & 32767; }
__device__ __forceinline__ float gelu_ref(float x) { return 0.5f * x * (1.f + tanhf(0.7978845608028654f * (x + 0.044715f * x * x * x))); }
__global__ void __launch_bounds__(512) dbg_scores(Args a) {
    __shared__ float n2s[1024]; __shared__ float q[2048];
    const int t = dbg_tok(blockIdx.x), tid = threadIdx.x;
    const bf16_t* N2 = (const bf16_t*)(a.ws + WS_N1); const float* SC = (const float*)(a.ws + WS_P + P_SC); unsigned* dbg = (unsigned*)(a.ws + WS_DBG);
    for (int k = tid; k < 1024; k += 512) n2s[k] = bf1(N2[(size_t)t * 1024 + k]);
    __syncthreads();
    for (int r = 0; r < 4; ++r) { const int c = tid + 512 * r; float s = 0.f; for (int k = 0; k < 1024; ++k) s += n2s[k] * a.in[I_WQ][(size_t)k * 2048 + c]; q[c] = s; }
    __syncthreads();
    float md = 0.f;
    for (int r = 0; r < 4; ++r) { const int n = tid + 512 * r, hh = n >> 7, key = n & 127; const float* kX = (hh & 1) ? a.in[I_K2] : a.in[I_K1];
        float s = 0.f; for (int d = 0; d < 128; ++d) s += q[hh * 128 + d] * kX[key * 128 + d];
        md = fmaxf(md, fabsf(s - SC[(size_t)n * T_TOK + t])); }
    atomicMax(&dbg[0], __builtin_bit_cast(unsigned, md));
}
__global__ void __launch_bounds__(64) dbg_topk(Args a) {
    __shared__ float s1[8][128], s2[8][128], cv[8][256]; __shared__ float t1v[8][16], t2v[8][16]; __shared__ int t1i[8][16], t2i[8][16], exi[8][16]; __shared__ float exv[8][16];
    const int t = dbg_tok(blockIdx.x), h = threadIdx.x;
    const float* SC = (const float*)(a.ws + WS_P + P_SC); const int* IDX = (const int*)(a.ws + WS_P + P_IDX); const float* GATE = (const float*)(a.ws + WS_P + P_GATE); unsigned* dbg = (unsigned*)(a.ws + WS_DBG);
    if (h >= 8) return;
    for (int j = 0; j < 128; ++j) { s1[h][j] = SC[(size_t)(h * 256 + j) * T_TOK + t]; s2[h][j] = SC[(size_t)(h * 256 + 128 + j) * T_TOK + t]; }
    for (int r = 0; r < 16; ++r) { int b1 = 0, b2 = 0; for (int j = 1; j < 128; ++j) { if (s1[h][j] > s1[h][b1]) b1 = j; if (s2[h][j] > s2[h][b2]) b2 = j; }
        t1v[h][r] = s1[h][b1]; t1i[h][r] = b1; s1[h][b1] = -1e30f; t2v[h][r] = s2[h][b2]; t2i[h][r] = b2; s2[h][b2] = -1e30f; }
    for (int c = 0; c < 256; ++c) cv[h][c] = t1v[h][c >> 4] + t2v[h][c & 15];
    for (int r = 0; r < 16; ++r) { int bc = 0; for (int c = 1; c < 256; ++c) if (cv[h][c] > cv[h][bc]) bc = c;
        exv[h][r] = cv[h][bc]; exi[h][r] = t1i[h][bc >> 4] * 128 + t2i[h][bc & 15]; cv[h][bc] = -1e30f; }
    float sum = 0.f; const float mx0 = exv[h][0]; for (int r = 0; r < 16; ++r) { exv[h][r] = expf(exv[h][r] - mx0); } for (int r = 0; r < 16; ++r) sum += exv[h][r];
    unsigned miss = 0; float gd = 0.f;
    for (int w = 0; w < 16; ++w) { const int e = IDX[(size_t)t * 128 + h * 16 + w]; const float g = GATE[(size_t)t * 128 + h * 16 + w]; bool found = false;
        for (int r = 0; r < 16; ++r) if (exi[h][r] == e) { found = true; gd = fmaxf(gd, fabsf(g - exv[h][r] / sum)); }
        if (!found) ++miss; }
    atomicAdd(&dbg[1], miss); atomicMax(&dbg[3], __builtin_bit_cast(unsigned, gd));
}
__global__ void __launch_bounds__(512) dbg_experts_pre(Args a) {
    __shared__ float n2s[1024]; __shared__ float ak[128]; __shared__ int ek[128]; __shared__ float red[8];
    const int t = dbg_tok(blockIdx.x), tid = threadIdx.x, lane = tid & 63, wave = tid >> 6;
    const bf16_t* N2 = (const bf16_t*)(a.ws + WS_N1); const int* IDX = (const int*)(a.ws + WS_P + P_IDX); const float* GATE = (const float*)(a.ws + WS_P + P_GATE);
    float* rows = (float*)(a.ws + WS_DBG + MiB);
    for (int k = tid; k < 1024; k += 512) n2s[k] = bf1(N2[(size_t)t * 1024 + k]);
    if (tid < 128) ek[tid] = IDX[(size_t)t * 128 + tid];
    __syncthreads();
    for (int k = wave * 16; k < wave * 16 + 16; ++k) { const float* u = a.in[I_PU] + (size_t)ek[k] * 1024; float s = 0.f; for (int j = lane; j < 1024; j += 64) s += u[j] * n2s[j];
        s = wave_sum(s); if (lane == 0) ak[k] = gelu_ref(s) * GATE[(size_t)t * 128 + k]; }
    __syncthreads();
    float h2[2]; float ss = 0.f;
    for (int r = 0; r < 2; ++r) { const int d = tid + 512 * r; float o = 0.f; for (int k = 0; k < 128; ++k) o += ak[k] * a.in[I_PV][(size_t)ek[k] * 1024 + d]; h2[r] = a.out[(size_t)t * 1024 + d] + o; ss += h2[r] * h2[r]; }
    ss = wave_sum(ss); if (lane == 0) red[wave] = ss; __syncthreads();
    float tot = 0.f; for (int w = 0; w < 8; ++w) tot += red[w];
    const float rstd = 1.f / sqrtf(tot / 1024.f + EPS);
    for (int r = 0; r < 2; ++r) { const int d = tid + 512 * r; rows[(size_t)blockIdx.x * 1024 + d] = h2[r] * rstd * a.in[I_FG][d]; }
}
__global__ void __launch_bounds__(512) dbg_experts_post(Args a) {
    const int t = dbg_tok(blockIdx.x), tid = threadIdx.x; const float* rows = (const float*)(a.ws + WS_DBG + MiB); float* dbgf = (float*)(a.ws + WS_DBG);
    float e = 0.f, n = 0.f;
    for (int r = 0; r < 2; ++r) { const int d = tid + 512 * r; const float x = rows[(size_t)blockIdx.x * 1024 + d], y = a.out[(size_t)t * 1024 + d]; e += (x - y) * (x - y); n += x * x; }
    e = wave_sum(e); n = wave_sum(n); if ((tid & 63) == 0) { atomicAdd(&dbgf[4], e); atomicAdd(&dbgf[5], n); }
}
__global__ void __launch_bounds__(512) dbg_report(Args a, int which) {
    const unsigned* dbg = (const unsigned*)(a.ws + WS_DBG); const float* dbgf = (const float*)(a.ws + WS_DBG);
    const float mA = dbgf[0], gd = dbgf[3]; const unsigned miss = dbg[1]; const float relC = sqrtf(dbgf[4] / fmaxf(dbgf[5], 1e-30f));
    float X;
    if (which == 0) { int mask = 0; if (mA > 0.05f) mask |= 1; if (miss > 400u) mask |= 2; if (relC > 0.05f) mask |= 4; if (gd > 0.02f) mask |= 8; X = 1000.f + 100.f * mask; }
    else if (which == 1) X = 1e6f * mA; else if (which == 2) X = 100.f + (float)miss; else if (which == 3) X = 1e6f * relC; else X = 1e6f * gd;
    for (size_t i = (size_t)blockIdx.x * 512 + threadIdx.x; i < (size_t)T_TOK * D; i += (size_t)gridDim.x * 512) a.out[i] = (i == 0) ? X : 0.f;
}
#endif

constexpr int NPH = 13;
__global__ void __launch_bounds__(NWAVES * 64, 2) fwd_kernel(Args args) {
    extern __shared__ __attribute__((aligned(16))) unsigned char lds_raw[];
    Frame F;
    F.lds = (LAS unsigned char*)lds_raw;
    F.tid = threadIdx.x; F.lane = F.tid & 63; F.wave = __builtin_amdgcn_readfirstlane(F.tid >> 6);
    F.G = gridDim.x; F.bid = blockIdx.x;
    volatile LAS unsigned* MISC = (volatile LAS unsigned*)(F.lds + MISC_OFF);
    for (int u = F.tid; u < (LDS_BYTES - LDSCTL_OFF) / 4; u += NWAVES * 64) ((LAS unsigned*)(F.lds + LDSCTL_OFF))[u] = 0u;
    __syncthreads();
    unsigned* ctl = (unsigned*)(args.ws + WS_CTL);
    const int lo = args.ph_lo, hi = args.ph_hi;
    XcdBarrier bar; bar.bar = ctl + CW_BAR + args.li * XCD_BAR_WORDS; bar.x = 0; bar.st = nullptr; bar.wave = F.wave;
    if (hi - lo > 1) bar = xcd_barrier_post(ctl + CW_BAR + args.li * XCD_BAR_WORDS, MISC + 8, F.wave);
#define IN(k) (lo <= (k) && (k) < hi)
#ifdef PROBE_TS
#define STAMP(k) do { if (F.bid == 0 && F.tid == 0) ((unsigned long long*)(args.ws + (472u << 20)))[(k)] = __builtin_amdgcn_s_memrealtime(); } while (0)
#else
#define STAMP(k) do { } while (0)
#endif
#define SEAM(k) do { if (IN(k) && IN((k) + 1)) { xcd_barrier(bar); if (XTRA_BAR) xcd_barrier(bar); } STAMP((k) + 1); } while (0)
    unsigned char* ws = args.ws;
    bf16_t* P = (bf16_t*)(ws + WS_P);

#define REFRESH() do { int z_ = 0; asm volatile("" : "+s"(z_)); F.lane = (int)__builtin_amdgcn_mbcnt_hi(~0u, __builtin_amdgcn_mbcnt_lo(~0u, (unsigned)z_)); F.tid = F.wave * 64 + F.lane; } while (0)
    STAMP(0);
    if (IN(0)) { phase0(F, args); SEAM(0); }
    if (IN(1)) { REFRESH();
        if (F8_LO > 0) { pg8::Gemm g{(const bf16_t*)(ws + WS_N1), (const bf16_t*)(ws + WS_WIN), T_TOK, F8_LO * 256, D, D}; pg8::StaticOrder S; S.init(T_TOK, F8_LO * 256, F.G, F.bid);
            pg8::EpiProj E{P, (float*)(ws + WS_ALR), 0}; pg8::gemm_phase<pg8::EpiProj, pg8::StaticOrder, false, true, false>(F.lds, g, S, E, F.wave); }
        if (F8_LO < 21) {
            pg8::Gemm g{(const bf16_t*)(ws + WS_N18), (const bf16_t*)(ws + WS_W8 + (size_t)F8_LO * 256 * 1024), T_TOK, (21 - F8_LO) * 256, D / 2, D / 2, 0x7B7B7B7B, 0x75757575};
            pg8::StaticOrder S; S.init(T_TOK, (21 - F8_LO) * 256, F.G, ((F8_LO * 128) % F.G) != 0 ? F.G - 1 - F.bid : F.bid);
            pg8::EpiProj E{P, (float*)(ws + WS_ALR), F8_LO}; pg8::gemm_phase<pg8::EpiProj, pg8::StaticOrder, false, true, true>(F.lds, g, S, E, F.wave); }
        {
            REFRESH();
            const int nwg = (T_TOK / 256) * (NPROJ / 256), rem = nwg % F.G;
            if (rem == 0) convert_tables(F, args, F.bid * NWAVES + F.wave, F.G * NWAVES);
            else if (F.bid >= rem) convert_tables(F, args, (F.bid - rem) * NWAVES + F.wave, (F.G - rem) * NWAVES);
        }
        SEAM(1);
    }
    if (IN(2)) { REFRESH();
        if (DRY_EXP == 12) { gla_chunk_phase<true>(F, args); for (int it = F.bid; it < 256; it += F.G) for (int g4 = 0; g4 < 4; ++g4) sgu_unit<true>(F, args, 4 * it + g4, g4 == 0); __syncthreads(); }
        gla_chunk_phase<false>(F, args);
        for (int it = F.bid; it < 256; it += F.G) for (int g4 = 0; g4 < 4; ++g4) sgu_unit<false>(F, args, 4 * it + g4, g4 == 0);
        SEAM(2);
    }
    if (IN(3)) { REFRESH(); if (DRY_EXP == 13 || DRY_EXP == 15) { gla_scan<true>(F, args); __syncthreads(); } gla_scan<false>(F, args); SEAM(3); }
    if (IN(4)) { REFRESH(); if (DRY_EXP == 14 || DRY_EXP == 15) { gla_out_phase<true>(F, args); __syncthreads(); } gla_out_phase<false>(F, args); SEAM(4); }
    if (IN(5)) { REFRESH();
        { pg8::Gemm g{P + PC_R, (const bf16_t*)(ws + WS_WA), T_TOK, D, 1024, PLD}; pg8::StaticOrder S; S.init(T_TOK, D, F.G, F.bid);
          pg8::EpiBrAB E{P}; pg8::gemm_phase<pg8::EpiBrAB, pg8::StaticOrder, true, true, false, true>(F.lds, g, S, E, F.wave); }
        SEAM(5);
    }
    if (IN(6)) { REFRESH();
        pg8::Gemm g{P + PC_MRG, (const bf16_t*)(ws + WS_WOUT), T_TOK, D, D, PLD}; pg8::StaticOrder S; S.init(T_TOK, D, F.G, F.bid);
        pg8::EpiOut E{args.in[I_X], (bf16_t*)(ws + WS_N1), ws + WS_N18, (float*)(ws + WS_RSS)}; pg8::gemm_phase<pg8::EpiOut, pg8::StaticOrder, true, true>(F.lds, g, S, E, F.wave);
        SEAM(6);
    }
    if (IN(8)) { REFRESH();
        pg8::StaticOrder S; S.init(T_TOK, 2048, F.G, F.bid); pg8::EpiScores E{(bf16_t*)(ws + WS_P + P_SC), (const float*)(ws + WS_RSS)};
        if (SC_F8) { pg8::Gemm g{(const bf16_t*)(ws + WS_N18), (const bf16_t*)(ws + WS_WQF), T_TOK, 2048, D / 2, D / 2, 0x7B7B7B7B, 0x75757575};
            pg8::gemm_phase<pg8::EpiScores, pg8::StaticOrder, true, true, true>(F.lds, g, S, E, F.wave); }
        else { pg8::Gemm g{(const bf16_t*)(ws + WS_N1), (const bf16_t*)(ws + WS_WQF), T_TOK, 2048, D, D};
            pg8::gemm_phase<pg8::EpiScores, pg8::StaticOrder, true, true>(F.lds, g, S, E, F.wave); }
        SEAM(8);
    }
    if (IN(9)) { REFRESH(); peer_topk(F, args); SEAM(9); }
    if (IN(10)) { REFRESH(); if constexpr (UNG == 1) peer_u4_all<0>(F, args); else peer_u4_phase<0>(F, args); SEAM(10); }
    if (IN(11)) { REFRESH(); if (V_F4) peer_v4_phase<0>(F, args); else { if (DRY_EXP == 1) { peer_v_phase<1>(F, args); __syncthreads(); } peer_v_phase<0>(F, args); SEAM(11); } }
    if (IN(12)) { REFRESH(); if (!V_F4) final_norm_phase(F, args); }
#undef IN
#undef SEAM
}


#ifdef PROBE_TS
__global__ void __launch_bounds__(512) probe_report(Args a, int pi, int pj) {
    const unsigned long long* ts = (const unsigned long long*)(a.ws + (472u << 20));
    const float X1 = 10.f * (float)(ts[pi + 1] - ts[pi]) * 0.01f, X2 = (float)(ts[pj + 1] - ts[pj]) * 0.01f;
    for (size_t i = (size_t)blockIdx.x * 512 + threadIdx.x; i < (size_t)T_TOK * D; i += (size_t)gridDim.x * 512) a.out[i] = (i == 0) ? X1 : X2;
}
#endif
#ifdef PROBE_MFMA
__global__ void __launch_bounds__(64) probe_mfma(Args a) {
    const int l = threadIdx.x;
    i32x4 av = {0, 0, 0, 0};
    if (l == PROBE_L) av[PROBE_P >> 3] = 0x2 << (4 * (PROBE_P & 7));
    i32x8 b1, b2;
    for (int r = 0; r < 8; ++r) { unsigned w1 = 0, w2 = 0;
        for (int c = 0; c < 4; ++c) { const int b = 4 * r + c; int t = 0;
            t = __builtin_amdgcn_cvt_pk_fp8_f32((float)((b & 15) + 1), (float)(1 + (b >> 4) + 2 * (l >> 4)), 0, false);
            w1 |= ((unsigned)t & 0xffu) << (8 * c); w2 |= (((unsigned)t >> 8) & 0xffu) << (8 * c); }
        b1[r] = (int)w1; b2[r] = (int)w2; }
    const f32x4 z = {0.f, 0.f, 0.f, 0.f};
    const f32x4 d1 = __builtin_amdgcn_mfma_scale_f32_16x16x128_f8f6f4(__builtin_shufflevector(av, av, 0, 1, 2, 3, -1, -1, -1, -1), b1, z, 4, 0, 0, 0x7F7F7F7F, 0, 0x7F7F7F7F);
    const f32x4 d2 = __builtin_amdgcn_mfma_scale_f32_16x16x128_f8f6f4(__builtin_shufflevector(av, av, 0, 1, 2, 3, -1, -1, -1, -1), b2, z, 4, 0, 0, 0x7F7F7F7F, 0, 0x7F7F7F7F);
    float* st = (float*)(a.ws + (472u << 20));
    *(f32x4*)(st + 8 * l) = d1; *(f32x4*)(st + 8 * l + 4) = d2;
}
__global__ void __launch_bounds__(512) probe_mfma_report(Args a) {
    const int row = PROBE_L & 15;
    const float* st = (const float*)(a.ws + (472u << 20)) + 8 * (16 * (row >> 2)) + (row & 3); const float X1 = 10.f * st[0], X2 = st[4];
    for (size_t i = (size_t)blockIdx.x * 512 + threadIdx.x; i < (size_t)T_TOK * D; i += (size_t)gridDim.x * 512) a.out[i] = (i == 0) ? X1 : X2;
}
#endif
extern "C" void kernel_launch(void* const* d_in, const int* in_sizes, int n_in, void* d_out, int out_size, void* d_ws, size_t ws_size, hipStream_t stream) {
    static int grid = 0;
    if (grid == 0) {
        if (n_in != 20 || in_sizes[0] != T_TOK * D || out_size != T_TOK * D || ws_size < WS_END) {
            fprintf(stderr, "kernel_launch: unexpected shapes: n_in %d in0 %d out %d ws %zu (need %zu)\n", n_in, n_in > 0 ? in_sizes[0] : -1, out_size, ws_size, (size_t)WS_END); grid = -1; return; }
        int dev = 0, cus = 0;
        if (hipGetDevice(&dev) != hipSuccess || hipDeviceGetAttribute(&cus, hipDeviceAttributeMultiprocessorCount, dev) != hipSuccess) { grid = -1; return; }
        if (hipFuncSetAttribute((const void*)fwd_kernel, hipFuncAttributeMaxDynamicSharedMemorySize, LDS_BYTES) != hipSuccess) { fprintf(stderr, "kernel_launch: hipFuncSetAttribute failed\n"); grid = -1; return; }
        int per_cu = 0;
        if (hipOccupancyMaxActiveBlocksPerMultiprocessor(&per_cu, (const void*)fwd_kernel, NWAVES * 64, LDS_BYTES) != hipSuccess || per_cu < 1) fprintf(stderr, "kernel_launch: occupancy query says %d\n", per_cu);
        (void)hipGetLastError();
        grid = cus;
    }
    if (grid < 0) return;
    (void)hipMemsetAsync((char*)d_ws + WS_CTL, 0, CTL_ZERO_BYTES, stream);
    Args a{};
    for (int i = 0; i < 20; ++i) a.in[i] = (const float*)d_in[i];
    a.out = (float*)d_out; a.ws = (unsigned char*)d_ws;
#ifdef PROBE_MFMA
    hipLaunchKernelGGL(probe_mfma, dim3(1), dim3(64), 0, stream, a);
    hipLaunchKernelGGL(probe_mfma_report, dim3(1024), dim3(512), 0, stream, a);
    return;
#endif
#ifndef LAUNCH_LIST
#define LAUNCH_LIST {0, NPH}
#endif
    static const int ranges[][2] = { LAUNCH_LIST };
    const int nl = (int)(sizeof(ranges) / sizeof(ranges[0]));
    for (int li = 0; li < nl; ++li) { a.ph_lo = ranges[li][0]; a.ph_hi = ranges[li][1]; a.li = li;
        hipLaunchKernelGGL(fwd_kernel, dim3(grid), dim3(NWAVES * 64), LDS_BYTES, stream, a); }
}
```

```cpp
#include <hip/hip_runtime.h>
#include <cstdio>
#include <cstdint>


#ifndef XTRA_BAR
#define XTRA_BAR 0
#endif
#ifndef DRY_EXP
#define DRY_EXP 0
#endif
#ifndef DUP_PHASE
#define DUP_PHASE -1
#endif
#ifndef MK_N_LAUNCHES
#define MK_N_LAUNCHES 1
#endif

#define LAS __attribute__((address_space(3)))
#define GAS __attribute__((address_space(1)))
typedef unsigned short bf16_t;
typedef short bf16x8 __attribute__((ext_vector_type(8)));
typedef float f32x4 __attribute__((ext_vector_type(4)));
typedef float f32x2 __attribute__((ext_vector_type(2)));
typedef unsigned u32x4 __attribute__((ext_vector_type(4)));
typedef unsigned u32x2 __attribute__((ext_vector_type(2)));
typedef int i32x4 __attribute__((ext_vector_type(4)));
typedef int i32x8 __attribute__((ext_vector_type(8)));
typedef __bf16 bf16x2_t __attribute__((ext_vector_type(2)));

constexpr int T_TOK = 32768, D = 1024, SEQ = 4096, NBATCH = 8;
constexpr int NPROJ = 5376;
constexpr int PLD = 5120;
constexpr int PC_Q = 0, PC_K = 512, PC_V = 1024, PC_R = 1536, PC_SU = 2048, PC_SV = 2560, PC_GA = 3072, PC_GB = 4096;
constexpr int PC_MRG = 512;
constexpr float EPS = 1e-6f;
constexpr int NEXP = 16384;
#ifndef U_NG
#define U_NG 1
#endif
#ifndef V_F4
#define V_F4 1
#endif
#ifndef SC_F8
#define SC_F8 0
#endif
#ifndef F8_LO
#define F8_LO 11
#endif
static_assert(U_NG == 1, "only the one-group U phase applies RMSNorm-2's rstd");
constexpr int UNG = U_NG, UNG_SH = (U_NG == 8 ? 3 : (U_NG == 4 ? 2 : (U_NG == 2 ? 1 : 0)));

constexpr size_t MiB = 1u << 20;
constexpr size_t WS_RSS = 64 * 1024;
constexpr size_t WS_CTL = 0, CTL_ZERO_BYTES = 64 * 1024 + 128 * 1024;
constexpr size_t WS_WIN = 1 * MiB;
constexpr size_t WS_WA = 12 * MiB;
constexpr size_t WS_WB = 13 * MiB;
constexpr size_t WS_WOUT = 14 * MiB;
constexpr size_t WS_WQF = 16 * MiB;
constexpr size_t WS_U8 = 20 * MiB;
constexpr size_t WS_V8 = 36 * MiB;
constexpr size_t WS_SU = 52 * MiB;
constexpr size_t WS_SV = 52 * MiB + 65536;
constexpr size_t WS_AK = 53 * MiB;
constexpr size_t WS_DEC = 84 * MiB;
constexpr size_t WS_ALR = 85 * MiB;
constexpr size_t WS_N1 = 87 * MiB;
constexpr size_t WS_P = 151 * MiB;
constexpr size_t WS_W8 = 472 * MiB;
constexpr size_t WS_N18 = 478 * MiB;
constexpr size_t WS_END = 510 * MiB;
constexpr size_t P_HB = 192 * MiB;
constexpr size_t P_N2 = 128 * MiB;
constexpr size_t P_SC = 0, P_IDX = 256 * MiB, P_GATE = 272 * MiB, P_X8 = 288 * MiB;

constexpr int CW_BAR = 4096;

constexpr int RING_BYTES = 131072;
constexpr int LDSCTL_OFF = RING_BYTES, MISC_OFF = LDSCTL_OFF + 320;
constexpr int LDS_BYTES = 147456;
constexpr int NWAVES = 8;

__device__ __forceinline__ unsigned pk2(float lo, float hi) { const f32x2 v = {lo, hi}; const bf16x2_t b = __builtin_convertvector(v, bf16x2_t); return __builtin_bit_cast(unsigned, b); }
__device__ __forceinline__ unsigned f2bf(float f) { return pk2(f, 0.f) & 0xffffu; }
__device__ __forceinline__ float bflo(unsigned w) { return __builtin_bit_cast(float, w << 16); }
__device__ __forceinline__ float bfhi(unsigned w) { return __builtin_bit_cast(float, w & 0xffff0000u); }
__device__ __forceinline__ float bf1(bf16_t h) { return __builtin_bit_cast(float, ((unsigned)h) << 16); }
__device__ __forceinline__ float sigmoidf_(float x) { return __builtin_amdgcn_rcpf(1.f + __expf(-x)); }
__device__ __forceinline__ float gelu_tanh(float x) { const float y = 1.5957691216057308f * (x + 0.044715f * x * x * x); return x * sigmoidf_(y); }
__device__ __forceinline__ float siluf_(float x) { return x * sigmoidf_(x); }
__device__ __forceinline__ float wave_sum(float v) {
#pragma unroll
    for (int o = 1; o < 64; o <<= 1) v += __shfl_xor(v, o);
    return v;
}
#define LDS_WAIT() asm volatile("s_waitcnt lgkmcnt(0)" ::: "memory")
#define VM_WAIT() asm volatile("s_waitcnt vmcnt(0)" ::: "memory")

__device__ __forceinline__ int lane_now() { int z = 0; asm volatile("" : "+s"(z)); return (int)__builtin_amdgcn_mbcnt_hi(~0u, __builtin_amdgcn_mbcnt_lo(~0u, (unsigned)z)); }
namespace pg8 {
constexpr int BM = 256, BK = 64, HALF = 128, HTB = HALF * BK * 2, STAGE_BYTES = 8 * HTB, NXCD = 8, WGM = 8;
__host__ __device__ __forceinline__ int lds_byte(int r, int c) { const int st = (r >> 4) * 2 + (c >> 5), rr = r & 15, cc = c & 31, ob = rr * 64 + cc * 2; return st * 1024 + (ob ^ (((ob >> 9) & 1) << 5)); }
__host__ __device__ __forceinline__ void stage_rc(int b, int& R, int& C) { const int st = b / 1024, sb = b % 1024, swz = sb ^ (((sb >> 9) & 1) << 5); R = (st >> 1) * 16 + swz / 64; C = (st & 1) * 32 + (swz % 64) / 2; }
__host__ __device__ __forceinline__ int perm32(int rho) { const int n = rho >> 4, i = rho & 15; return 8 * (i >> 2) + 4 * n + (i & 3); }

struct Unit { int pm, pn; };
struct Gemm { const bf16_t* A; const bf16_t* Bt; int M, N, K, lda; int sa = 0, sb = 0; };

struct StaticOrder {
    int nM, nN, nwg, G, c;
    __host__ __device__ void init(int M, int N, int G_, int c_) { nM = M / BM; nN = N / BM; nwg = nM * nN; G = G_; c = c_; }
    __host__ __device__ bool next(int i, Unit& u) const {
        const long L = (long)i * G + c; if (L >= nwg) return false;
        int wgid = (int)L; { const int q = nwg / NXCD, r = nwg % NXCD, xcd = wgid % NXCD, off = wgid / NXCD; wgid = (xcd < r ? xcd * (q + 1) : r * (q + 1) + (xcd - r) * q) + off; }
        const int nig = WGM * nN, gid = wgid / nig, fm = gid * WGM, gsz = (nM - fm) < WGM ? (nM - fm) : WGM;
        u.pm = fm + ((wgid % nig) % gsz); u.pn = (wgid % nig) / gsz; return true;
    }
    __device__ __forceinline__ void a_ready(const Unit&) const {}
    __device__ __forceinline__ void done(const Unit&) const {}
};

template <class Epi, class Sched, bool ALIGN_EPI = false, bool SP2 = false, bool F8 = false, bool MID = false>
__device__ __forceinline__ void gemm_phase(LAS unsigned char* lds, const Gemm g, const Sched& S, const Epi& E, int wave_id) {
    const int wid = wave_id, lane = lane_now(), tid = wid * 64 + lane, wr = wid >> 2, wc = wid & 3, fr = lane & 15, fq = lane >> 4;
    const int K = g.K, nt = K / BK, lda = g.lda; const int scAB = (g.sb & 0xff) | ((g.sa & 0xff) << 8); (void)scAB;
    unsigned voffA[1], voffB[1];
    { int R, C; stage_rc(tid * 16, R, C); const int Rb = Epi::PERM ? ((R & ~31) + perm32(R & 31)) : R;
        voffA[0] = (unsigned)(R * lda + C) * 2u; voffB[0] = (unsigned)(Rb * K + C) * 2u; }
    const size_t dltA = (size_t)64 * lda * 2, dltB = (size_t)64 * K * 2;
    const size_t kstep = (size_t)(BK * 2);
    const size_t hstepA = (size_t)HALF * lda * 2, hstepB = (size_t)HALF * K * 2;
    const size_t tstepA = 2 * hstepA, tstepB = 2 * hstepB;
    const unsigned ldsw = (unsigned)wid * 1024u; const unsigned ldsbase = (unsigned)(__UINTPTR_TYPE__)lds + ldsw;
    const int aoff = lds_byte(wr * 64 + fr, fq * 8), boff = lds_byte(wc * 32 + fr, fq * 8);
#define PG8_SA(b, h) (((b) * 2 + (h)) * HTB)
#define PG8_SB(b, h) ((4 + (b) * 2 + (h)) * HTB)
#define PG8_STAGE(bufoff, gbase, voff) do { _Pragma("unroll") for (int _i = 0; _i < 2; ++_i) \
        asm volatile("s_mov_b32 m0, %2\n\ts_nop 0\n\tglobal_load_lds_dwordx4 %0, %1" :: "v"((voff)[0]), "s"((const char*)(gbase) + (size_t)_i * ((voff) == voffA ? dltA : dltB)), "s"(ldsbase + (unsigned)((bufoff) + _i * 8192)) : "memory", "m0"); } while (0)
#define PG8_LDA(dst, b, h) do { _Pragma("unroll") for (int m = 0; m < 4; ++m) _Pragma("unroll") for (int k = 0; k < 2; ++k) dst[m][k] = *(const LAS bf16x8*)(lds + PG8_SA(b, h) + aoff + m * 2048 + k * 1024); } while (0)
#define PG8_LDB(dst, b, h) do { _Pragma("unroll") for (int n = 0; n < 2; ++n) _Pragma("unroll") for (int k = 0; k < 2; ++k) dst[n][k] = *(const LAS bf16x8*)(lds + PG8_SB(b, h) + boff + n * 2048 + k * 1024); } while (0)
#define PG8_CAT(x) __builtin_shufflevector(__builtin_bit_cast(i32x4, (x)[0]), __builtin_bit_cast(i32x4, (x)[1]), 0, 1, 2, 3, 4, 5, 6, 7)
#define PG8_MMA(ai, bj, At, Bt) do { __builtin_amdgcn_s_setprio(1); if constexpr (F8) { _Pragma("unroll") for (int m = 0; m < 4; ++m) _Pragma("unroll") for (int n = 0; n < 2; ++n) \
        acc[ai][bj][m][n] = __builtin_amdgcn_mfma_scale_f32_16x16x128_f8f6f4(PG8_CAT(Bt[n]), PG8_CAT(At[m]), acc[ai][bj][m][n], 0, 0, 0, scAB, 1, scAB); } else { \
        _Pragma("unroll") for (int m = 0; m < 4; ++m) _Pragma("unroll") for (int n = 0; n < 2; ++n) _Pragma("unroll") for (int k = 0; k < 2; ++k) \
        acc[ai][bj][m][n] = __builtin_amdgcn_mfma_f32_16x16x32_bf16(Bt[n][k], At[m][k], acc[ai][bj][m][n], 0, 0, 0); } __builtin_amdgcn_s_setprio(0); } while (0)
#define PG8_WAIT_V(n) asm volatile("s_waitcnt vmcnt(" #n ")" ::: "memory")
#define PG8_WAIT_L(n) asm volatile("s_waitcnt lgkmcnt(" #n ")" ::: "memory")
#define PG8_BAR __builtin_amdgcn_s_barrier()
#define PG8_SCHED __builtin_amdgcn_sched_barrier(0)
    Unit cur, nxt; int ui = 0;
    if (!S.next(0, cur)) return;
    f32x4 acc[2][2][4][2];
#pragma unroll
    for (int a = 0; a < 2; ++a)
#pragma unroll
        for (int b = 0; b < 2; ++b)
#pragma unroll
            for (int m = 0; m < 4; ++m)
#pragma unroll
                for (int n = 0; n < 2; ++n) acc[a][b][m][n] = (f32x4){0.f, 0.f, 0.f, 0.f};
    bf16x8 At[4][2], B0[2][2], B1[2][2];
    const char* cA = (const char*)g.A + (size_t)cur.pm * tstepA; const char* cB = (const char*)g.Bt + (size_t)cur.pn * tstepB;
    S.a_ready(cur);
    if constexpr (SP2) {
        PG8_STAGE(PG8_SB(0, 0), cB, voffB); PG8_STAGE(PG8_SB(0, 1), cB + hstepB, voffB); PG8_STAGE(PG8_SA(0, 0), cA, voffA); PG8_STAGE(PG8_SA(0, 1), cA + hstepA, voffA);
        if (wr == 1) PG8_BAR;
        PG8_WAIT_V(2); PG8_BAR;
        PG8_STAGE(PG8_SB(1, 0), cB + kstep, voffB); PG8_STAGE(PG8_SA(1, 0), cA + kstep, voffA); PG8_STAGE(PG8_SB(1, 1), cB + hstepB + kstep, voffB);
        PG8_WAIT_V(6); PG8_BAR;
    } else {
        PG8_STAGE(PG8_SB(0, 0), cB, voffB); PG8_STAGE(PG8_SA(0, 0), cA, voffA); PG8_STAGE(PG8_SB(0, 1), cB + hstepB, voffB); PG8_STAGE(PG8_SA(0, 1), cA + hstepA, voffA);
        if (wr == 1) PG8_BAR;
        PG8_WAIT_V(4); PG8_BAR;
        PG8_STAGE(PG8_SB(1, 0), cB + kstep, voffB); PG8_STAGE(PG8_SA(1, 0), cA + kstep, voffA); PG8_STAGE(PG8_SB(1, 1), cB + hstepB + kstep, voffB);
        PG8_WAIT_V(6); PG8_BAR;
    }
    for (;;) {
        const bool has_next = S.next(ui + 1, nxt);
        const char* nA = has_next ? (const char*)g.A + (size_t)nxt.pm * tstepA : cA; const char* nB = has_next ? (const char*)g.Bt + (size_t)nxt.pn * tstepB : cB;
#pragma nounroll
        for (int t = 0; t < nt; t += 2) {
            if constexpr (MID) { if (t == (nt >> 1)) E.mid(acc, cur, wr, wc); }
            const bool last = (t == nt - 2);
            const char* a1 = cA + (size_t)(t + 1) * kstep;
            const char* a2 = last ? nA : cA + (size_t)(t + 2) * kstep; const char* b2 = last ? nB : cB + (size_t)(t + 2) * kstep;
            const char* a3 = a2 + kstep; const char* b3 = b2 + kstep;
            if (last && has_next) S.a_ready(nxt);
            if constexpr (SP2) {
            PG8_LDB(B0, 0, 0); PG8_LDB(B1, 0, 1); PG8_SCHED; PG8_LDA(At, 0, 0); PG8_STAGE(PG8_SA(1, 1), a1 + hstepA, voffA);
            PG8_WAIT_V(8); PG8_WAIT_L(0); PG8_BAR; PG8_MMA(0, 0, At, B0); PG8_MMA(0, 1, At, B1); PG8_BAR; PG8_SCHED;
            PG8_LDA(At, 0, 1); PG8_STAGE(PG8_SB(0, 0), b2, voffB); PG8_STAGE(PG8_SB(0, 1), b2 + hstepB, voffB); PG8_STAGE(PG8_SA(0, 0), a2, voffA);
            PG8_WAIT_V(8); PG8_WAIT_L(0); PG8_BAR; PG8_MMA(1, 0, At, B0); PG8_MMA(1, 1, At, B1); PG8_BAR; PG8_SCHED;
            PG8_LDB(B0, 1, 0); PG8_LDB(B1, 1, 1); PG8_SCHED; PG8_LDA(At, 1, 0); PG8_STAGE(PG8_SA(0, 1), a2 + hstepA, voffA);
            PG8_WAIT_V(8); PG8_WAIT_L(0); PG8_BAR; PG8_MMA(0, 0, At, B0); PG8_MMA(0, 1, At, B1); PG8_BAR; PG8_SCHED;
            PG8_LDA(At, 1, 1); PG8_STAGE(PG8_SB(1, 0), b3, voffB); PG8_STAGE(PG8_SB(1, 1), b3 + hstepB, voffB); PG8_STAGE(PG8_SA(1, 0), a3, voffA);
            PG8_WAIT_V(8); PG8_WAIT_L(0); PG8_BAR; PG8_MMA(1, 0, At, B0); PG8_MMA(1, 1, At, B1); PG8_BAR; PG8_SCHED;
            } else {
            PG8_LDB(B0, 0, 0); PG8_SCHED; PG8_LDA(At, 0, 0); PG8_STAGE(PG8_SA(1, 1), a1 + hstepA, voffA);
            PG8_WAIT_L(8); PG8_BAR; PG8_WAIT_L(0); PG8_MMA(0, 0, At, B0); PG8_BAR; PG8_SCHED;
            PG8_LDB(B1, 0, 1); PG8_STAGE(PG8_SB(0, 0), b2, voffB);
            PG8_BAR; PG8_WAIT_L(0); PG8_MMA(0, 1, At, B1); PG8_BAR;
            PG8_LDA(At, 0, 1); PG8_STAGE(PG8_SA(0, 0), a2, voffA);
            PG8_BAR; PG8_WAIT_L(0); PG8_MMA(1, 0, At, B0); PG8_BAR; PG8_SCHED;
            PG8_STAGE(PG8_SB(0, 1), b2 + hstepB, voffB);
            PG8_WAIT_V(6); PG8_BAR; PG8_MMA(1, 1, At, B1); PG8_BAR;
            PG8_LDB(B0, 1, 0); PG8_SCHED; PG8_LDA(At, 1, 0); PG8_STAGE(PG8_SA(0, 1), a2 + hstepA, voffA);
            PG8_WAIT_L(8); PG8_BAR; PG8_WAIT_L(0); PG8_MMA(0, 0, At, B0); PG8_BAR; PG8_SCHED;
            PG8_LDB(B1, 1, 1); PG8_STAGE(PG8_SB(1, 0), b3, voffB);
            PG8_BAR; PG8_WAIT_L(0); PG8_MMA(0, 1, At, B1); PG8_BAR;
            PG8_LDA(At, 1, 1); PG8_STAGE(PG8_SA(1, 0), a3, voffA);
            PG8_BAR; PG8_WAIT_L(0); PG8_MMA(1, 0, At, B0); PG8_BAR; PG8_SCHED;
            PG8_STAGE(PG8_SB(1, 1), b3 + hstepB, voffB);
            PG8_WAIT_V(6); PG8_BAR; PG8_MMA(1, 1, At, B1); PG8_BAR;
            }
        }
        if constexpr (ALIGN_EPI) { if (wr == 0) PG8_BAR; }
        E(acc, cur, wr, wc, fr, fq); S.done(cur);
        if (!has_next) break;
#pragma unroll
        for (int a = 0; a < 2; ++a)
#pragma unroll
            for (int b = 0; b < 2; ++b)
#pragma unroll
                for (int m = 0; m < 4; ++m)
#pragma unroll
                    for (int n = 0; n < 2; ++n) acc[a][b][m][n] = (f32x4){0.f, 0.f, 0.f, 0.f};
        cur = nxt; cA = nA; cB = nB; ++ui;
        if constexpr (ALIGN_EPI) { if (wr == 1) PG8_BAR; }
    }
    PG8_WAIT_V(0);
    if constexpr (!ALIGN_EPI) { if (wr == 0) PG8_BAR; }
    PG8_BAR;
#undef PG8_SA
#undef PG8_SB
#undef PG8_STAGE
#undef PG8_LDA
#undef PG8_LDB
#undef PG8_MMA
#undef PG8_CAT
#undef PG8_WAIT_V
#undef PG8_WAIT_L
#undef PG8_BAR
#undef PG8_SCHED
}

__device__ __forceinline__ u32x4 pack8(f32x4 v0, f32x4 v1) { u32x4 w; w.x = pk2(v0[0], v0[1]); w.y = pk2(v0[2], v0[3]); w.z = pk2(v1[0], v1[1]); w.w = pk2(v1[2], v1[3]); return w; }
__device__ __forceinline__ void unpack8(u32x4 w, f32x4& v0, f32x4& v1) { v0 = (f32x4){bflo(w.x), bfhi(w.x), bflo(w.y), bfhi(w.y)}; v1 = (f32x4){bflo(w.z), bfhi(w.z), bflo(w.w), bfhi(w.w)}; }

struct EpiProj {
    static constexpr bool PERM = true;
    bf16_t* P; float* ALR; int pn0;
    __device__ __forceinline__ void operator()(const f32x4 (&acc)[2][2][4][2], const Unit& u, int wr, int wc, int fr, int fq) const {
        { const int ln = lane_now(); fr = ln & 15; fq = ln >> 4; }
        const int row0 = u.pm * BM + wr * 64 + fr; int pn = u.pn + pn0; const int cl = wc * 32 + 8 * fq;
        if (pn == 10) {
            if (wc == 0 && fq < 2) {
#pragma unroll
                for (int ai = 0; ai < 2; ++ai)
#pragma unroll
                    for (int m = 0; m < 4; ++m) { float* rp = ALR + (size_t)(row0 + ai * HALF + m * 16) * 16 + 8 * fq;
                        *(f32x4*)rp = acc[ai][0][m][0]; *(f32x4*)(rp + 4) = acc[ai][0][m][1]; }
            }
            return;
        }
        if (pn > 10) --pn;
        const int mode = pn < 8 ? 0 : (pn < 12 ? 1 : 2);
#pragma unroll
        for (int ai = 0; ai < 2; ++ai)
#pragma unroll
            for (int m = 0; m < 4; ++m) { bf16_t* rowp = P + (size_t)(row0 + ai * HALF + m * 16) * PLD + pn * BM + cl;
#pragma unroll
                for (int bj = 0; bj < 2; ++bj) { f32x4 v0 = acc[ai][bj][m][0], v1 = acc[ai][bj][m][1];
                    if (mode == 1) {
#pragma unroll
                        for (int i = 0; i < 4; ++i) { v0[i] = gelu_tanh(v0[i]); v1[i] = gelu_tanh(v1[i]); }
                    } else if (mode == 2) {
                        unsigned w0 = 0, w1 = 0;
                        w0 = __builtin_amdgcn_cvt_pk_u8_f32(sigmoidf_(v0[0]) * 255.f, 0, w0); w0 = __builtin_amdgcn_cvt_pk_u8_f32(sigmoidf_(v0[1]) * 255.f, 1, w0); w0 = __builtin_amdgcn_cvt_pk_u8_f32(sigmoidf_(v0[2]) * 255.f, 2, w0); w0 = __builtin_amdgcn_cvt_pk_u8_f32(sigmoidf_(v0[3]) * 255.f, 3, w0);
                        w1 = __builtin_amdgcn_cvt_pk_u8_f32(sigmoidf_(v1[0]) * 255.f, 0, w1); w1 = __builtin_amdgcn_cvt_pk_u8_f32(sigmoidf_(v1[1]) * 255.f, 1, w1); w1 = __builtin_amdgcn_cvt_pk_u8_f32(sigmoidf_(v1[2]) * 255.f, 2, w1); w1 = __builtin_amdgcn_cvt_pk_u8_f32(sigmoidf_(v1[3]) * 255.f, 3, w1);
                        unsigned char* bp = (unsigned char*)(P + (size_t)(row0 + ai * HALF + m * 16) * PLD) + (pn < 16 ? PC_GA * 2 + (pn - 12) * BM : PC_GB * 2 + (pn - 16) * BM) + cl + bj * HALF;
                        *(u32x2*)bp = (u32x2){w0, w1}; continue;
                    }
                    *(u32x4*)(rowp + bj * HALF) = pack8(v0, v1); } }
    }
};
struct EpiBrA {
    static constexpr bool PERM = true;
    bf16_t* P;
    __device__ __forceinline__ void operator()(const f32x4 (&acc)[2][2][4][2], const Unit& u, int wr, int wc, int fr, int fq) const {
        const int row0 = u.pm * BM + wr * 64 + fr; const int c0 = u.pn * BM + wc * 32 + 8 * fq;
#pragma unroll
        for (int ai = 0; ai < 2; ++ai)
#pragma unroll
            for (int m = 0; m < 4; ++m) { bf16_t* rowp = P + (size_t)(row0 + ai * HALF + m * 16) * PLD;
#pragma unroll
                for (int bj = 0; bj < 2; ++bj) { const int c = c0 + bj * HALF; f32x4 g0, g1; unpack8(*(const u32x4*)(rowp + PC_GA + c), g0, g1);
                    *(u32x4*)(rowp + PC_MRG + c) = pack8(acc[ai][bj][m][0] * g0, acc[ai][bj][m][1] * g1); } }
    }
};
struct EpiBrB {
    static constexpr bool PERM = true;
    bf16_t* P;
    __device__ __forceinline__ void operator()(const f32x4 (&acc)[2][2][4][2], const Unit& u, int wr, int wc, int fr, int fq) const {
        const int row0 = u.pm * BM + wr * 64 + fr; const int c0 = u.pn * BM + wc * 32 + 8 * fq;
#pragma unroll
        for (int ai = 0; ai < 2; ++ai)
#pragma unroll
            for (int m = 0; m < 4; ++m) { bf16_t* rowp = P + (size_t)(row0 + ai * HALF + m * 16) * PLD;
#pragma unroll
                for (int bj = 0; bj < 2; ++bj) { const int c = c0 + bj * HALF; f32x4 g0, g1, p0, p1; unpack8(*(const u32x4*)(rowp + PC_GB + c), g0, g1); unpack8(*(const u32x4*)(rowp + PC_MRG + c), p0, p1);
                    *(u32x4*)(rowp + PC_MRG + c) = pack8(p0 + acc[ai][bj][m][0] * g0, p1 + acc[ai][bj][m][1] * g1); } }
    }
};
struct EpiBrAB {
    static constexpr bool PERM = true;
    bf16_t* P;
    static __device__ __forceinline__ void u8x8(const u32x2 w, f32x4& f0, f32x4& f1) {
        f0 = (f32x4){(float)(w.x & 0xffu), (float)((w.x >> 8) & 0xffu), (float)((w.x >> 16) & 0xffu), (float)(w.x >> 24)};
        f1 = (f32x4){(float)(w.y & 0xffu), (float)((w.y >> 8) & 0xffu), (float)((w.y >> 16) & 0xffu), (float)(w.y >> 24)}; }
    __device__ __forceinline__ void mid(f32x4 (&acc)[2][2][4][2], const Unit& u, int wr, int wc) const {
        const int ln = lane_now(), fr = ln & 15, fq = ln >> 4;
        const int row0 = u.pm * BM + wr * 64 + fr; const int c0 = u.pn * BM + wc * 32 + 8 * fq;
#pragma unroll
        for (int ai = 0; ai < 2; ++ai)
#pragma unroll
            for (int m = 0; m < 4; ++m) { const unsigned char* rowb = (const unsigned char*)(P + (size_t)(row0 + ai * HALF + m * 16) * PLD);
#pragma unroll
                for (int bj = 0; bj < 2; ++bj) { const int c = c0 + bj * HALF; f32x4 a0, a1, b0, b1; u8x8(*(const u32x2*)(rowb + PC_GA * 2 + c), a0, a1); u8x8(*(const u32x2*)(rowb + PC_GB * 2 + c), b0, b1);
#pragma unroll
                    for (int i = 0; i < 4; ++i) { acc[ai][bj][m][0][i] *= a0[i] * __builtin_amdgcn_rcpf(fmaxf(b0[i], 1.f)); acc[ai][bj][m][1][i] *= a1[i] * __builtin_amdgcn_rcpf(fmaxf(b1[i], 1.f)); } } }
    }
    __device__ __forceinline__ void operator()(const f32x4 (&acc)[2][2][4][2], const Unit& u, int wr, int wc, int fr, int fq) const {
        { const int ln = lane_now(); fr = ln & 15; fq = ln >> 4; }
        const int row0 = u.pm * BM + wr * 64 + fr; const int c0 = u.pn * BM + wc * 32 + 8 * fq;
#pragma unroll
        for (int ai = 0; ai < 2; ++ai)
#pragma unroll
            for (int m = 0; m < 4; ++m) { bf16_t* rowp = P + (size_t)(row0 + ai * HALF + m * 16) * PLD;
#pragma unroll
                for (int bj = 0; bj < 2; ++bj) { const int c = c0 + bj * HALF; f32x4 g0, g1; u8x8(*(const u32x2*)((const unsigned char*)rowp + PC_GB * 2 + c), g0, g1);
#pragma unroll
                    for (int i = 0; i < 4; ++i) { g0[i] = fmaxf(g0[i], 1.f) * (1.f / 255.f); g1[i] = fmaxf(g1[i], 1.f) * (1.f / 255.f); }
                    *(u32x4*)(rowp + PC_MRG + c) = pack8(acc[ai][bj][m][0] * g0, acc[ai][bj][m][1] * g1); } }
    }
};
struct EpiOut {
    static constexpr bool PERM = true;
    const float* X; bf16_t* HB; unsigned char* X8; float* RSS;
    __device__ __forceinline__ void operator()(const f32x4 (&acc)[2][2][4][2], const Unit& u, int wr, int wc, int fr, int fq) const {
        { const int ln = lane_now(); fr = ln & 15; fq = ln >> 4; }
        const int row0 = u.pm * BM + wr * 64 + fr; const int c0 = u.pn * BM + wc * 32 + 8 * fq;
#pragma unroll
        for (int ai = 0; ai < 2; ++ai)
#pragma unroll
            for (int m = 0; m < 4; ++m) { const int row = row0 + ai * HALF + m * 16; const size_t ro = (size_t)row * D; float ss = 0.f;
#pragma unroll
                for (int bj = 0; bj < 2; ++bj) { const int c = c0 + bj * HALF;
                    const f32x4 h0 = *(const f32x4*)(X + ro + c) + acc[ai][bj][m][0], h1 = *(const f32x4*)(X + ro + c + 4) + acc[ai][bj][m][1];
                    ss += (h0.x * h0.x + h0.y * h0.y) + (h0.z * h0.z + h0.w * h0.w) + (h1.x * h1.x + h1.y * h1.y) + (h1.z * h1.z + h1.w * h1.w);
                    *(u32x4*)(HB + ro + c) = pack8(h0, h1);
                    u32x2 w8; int w = 0;
                    w = __builtin_amdgcn_cvt_pk_fp8_f32(__builtin_amdgcn_fmed3f(h0.x * 16.f, -448.f, 448.f), __builtin_amdgcn_fmed3f(h0.y * 16.f, -448.f, 448.f), w, false); w = __builtin_amdgcn_cvt_pk_fp8_f32(__builtin_amdgcn_fmed3f(h0.z * 16.f, -448.f, 448.f), __builtin_amdgcn_fmed3f(h0.w * 16.f, -448.f, 448.f), w, true); w8.x = (unsigned)w;
                    w = 0; w = __builtin_amdgcn_cvt_pk_fp8_f32(__builtin_amdgcn_fmed3f(h1.x * 16.f, -448.f, 448.f), __builtin_amdgcn_fmed3f(h1.y * 16.f, -448.f, 448.f), w, false); w = __builtin_amdgcn_cvt_pk_fp8_f32(__builtin_amdgcn_fmed3f(h1.z * 16.f, -448.f, 448.f), __builtin_amdgcn_fmed3f(h1.w * 16.f, -448.f, 448.f), w, true); w8.y = (unsigned)w;
                    *(u32x2*)(X8 + ro + c) = w8; }
                ss += __shfl_xor(ss, 16); ss += __shfl_xor(ss, 32);
                if (fq == 0) (void)__hip_atomic_fetch_add(RSS + row, ss, __ATOMIC_RELAXED, __HIP_MEMORY_SCOPE_AGENT); }
    }
};
struct EpiScores {
    static constexpr bool PERM = true;
    bf16_t* SC;
    const float* RSS;
    __device__ __forceinline__ void operator()(const f32x4 (&acc)[2][2][4][2], const Unit& u, int wr, int wc, int fr, int fq) const {
        const int tb0 = u.pm * 16 + wr * 4; const int cq0 = (u.pn * BM + wc * 32 + 8 * fq) >> 3;
#pragma unroll
        for (int ai = 0; ai < 2; ++ai)
#pragma unroll
            for (int m = 0; m < 4; ++m) { bf16_t* bp = SC + ((size_t)(tb0 + ai * 8 + m) * 256) * 128 + fr * 8;
                const float rs = 1.f / sqrtf(RSS[(tb0 + ai * 8 + m) * 16 + fr] * (1.f / D) + EPS);
#pragma unroll
                for (int bj = 0; bj < 2; ++bj) { u32x4 w = pack8(acc[ai][bj][m][0] * rs, acc[ai][bj][m][1] * rs);
#pragma unroll
                    for (int c = 0; c < 4; ++c) w[c] ^= (((w[c] >> 15) & 0x00010001u) * 0x7FFFu) | 0x80008000u;
                    *(u32x4*)(bp + (size_t)(cq0 + bj * 16) * 128) = w; } }
    }
};
}

#define XB_TMO      128
#define XB_XCNT(j)  (256  + 64 * (j))
#define XB_XSUB(j)  (1280 + 64 * (j))
#define XB_XGEN(j)  (2304 + 64 * (j))
#define XB_TOP      3328
#define XB_TOPGEN   3392
#define XCD_BAR_WORDS 3456
#define XB_SPIN_CAP (1u << 18)
__device__ __forceinline__ unsigned xb_ld(unsigned* p)              { return __hip_atomic_load(p, __ATOMIC_RELAXED, __HIP_MEMORY_SCOPE_AGENT); }
__device__ __forceinline__ unsigned xb_add(unsigned* p, unsigned v) { return __hip_atomic_fetch_add(p, v, __ATOMIC_RELAXED, __HIP_MEMORY_SCOPE_AGENT); }
__device__ __forceinline__ unsigned xb_xcc_id() { return (unsigned)__builtin_amdgcn_s_getreg((3 << 11) | 20) & 0xFu; }
#define XB_SPIN(cond, bar) do { unsigned _sp = 0; while (cond) { __builtin_amdgcn_s_sleep(1); \
    if ((++_sp & 255u) == 0u) { if (xb_ld(&(bar)[XB_TMO])) break; if (_sp > XB_SPIN_CAP) { atomicAdd(&(bar)[XB_TMO], 1u); break; } } } } while (0)
struct XcdBarrier { unsigned* bar; unsigned x; volatile LAS unsigned* st; int wave; };
__device__ __forceinline__ XcdBarrier xcd_barrier_post(unsigned* bar, volatile LAS unsigned* st, int wave) {
    XcdBarrier b; b.bar = bar; b.x = xb_xcc_id(); b.st = st; b.wave = wave;
    if (wave == 0 && lane_now() == 0) (void)xb_add(&bar[XB_XCNT(b.x)], 1u);
    return b;
}
__device__ __forceinline__ void xcd_barrier_complete(unsigned* bar, unsigned x, unsigned& nloc, unsigned& nx) {
    const unsigned G = gridDim.x * gridDim.y * gridDim.z;
    unsigned sum, cnt, mine, sp = 0u;
    for (;;) {
        sum = 0u; cnt = 0u; mine = 0u;
#pragma unroll
        for (unsigned j = 0; j < 16; ++j) { const unsigned c = xb_ld(&bar[XB_XCNT(j)]); sum += c; cnt += (c > 0u) ? 1u : 0u; mine = (j == x) ? c : mine; }
        if (sum == G) break;
        __builtin_amdgcn_s_sleep(1);
        if ((++sp & 255u) == 0u) { if (xb_ld(&bar[XB_TMO])) break; if (sp > XB_SPIN_CAP) { atomicAdd(&bar[XB_TMO], 1u); break; } }
    }
    nloc = mine > 0u ? mine : 1u; nx = cnt > 0u ? cnt : 1u;
}
__device__ __forceinline__ void xcd_barrier(const XcdBarrier& b) {
    asm volatile("s_waitcnt vmcnt(0)" ::: "memory");
    __syncthreads();
    if (b.wave == 0 && lane_now() == 0) {
        unsigned* bar = b.bar;
        __builtin_amdgcn_s_waitcnt(0);
        unsigned nloc = b.st[0], nx = b.st[1];
        if (nloc == 0u) { xcd_barrier_complete(bar, b.x, nloc, nx); b.st[0] = nloc; b.st[1] = nx; }
        const unsigned old = xb_add(&bar[XB_XSUB(b.x)], 1u);
        const unsigned gen = old / nloc;
        if (old + 1u == (gen + 1u) * nloc) {
            __builtin_amdgcn_fence(__ATOMIC_RELEASE, "agent");
            asm volatile("s_waitcnt vmcnt(0)" ::: "memory");
            const unsigned og = xb_add(&bar[XB_TOP], 1u);
            const unsigned tg = og / nx;
            if (og + 1u == (tg + 1u) * nx) xb_add(&bar[XB_TOPGEN], 1u);
            else XB_SPIN(xb_ld(&bar[XB_TOPGEN]) == tg, bar);
            __builtin_amdgcn_fence(__ATOMIC_ACQUIRE, "agent");
            xb_add(&bar[XB_XGEN(b.x)], 1u);
            asm volatile("s_waitcnt vmcnt(0)" ::: "memory");
        } else {
            XB_SPIN(xb_ld(&bar[XB_XGEN(b.x)]) == gen, bar);
            __builtin_amdgcn_fence(__ATOMIC_ACQUIRE, "agent");
            asm volatile("s_waitcnt vmcnt(0)" ::: "memory");
        }
    }
    __syncthreads();
}

struct Args {
    const float* in[20]; float* out; unsigned char* ws; int ph_lo, ph_hi, li, pad;
};
enum { I_X = 0, I_N1G, I_WIN, I_WGU, I_BG, I_GLAG, I_SLNG, I_SLNB, I_SW, I_SB, I_WBA, I_WBB, I_WOUT, I_N2G, I_WQ, I_K1, I_K2, I_PU, I_PV, I_FG };

struct Frame {
    LAS unsigned char* lds;
    int tid, lane, wave, G, bid;
};

__device__ __forceinline__ float clamp448(float v) { return __builtin_amdgcn_fmed3f(v, -448.f, 448.f); }
template <int MODE, bool F8 = false>
__device__ __forceinline__ void p0_transpose_item(const float* W, int K, int Nsrc, int Ndst, bf16_t* WT, LAS float* scr, int item, int lane, float sc8 = 1.f, int ldk = 0) {
    if (ldk == 0) ldk = K;
    const int nblk = Ndst / 32, kb = item / nblk, nb = item % nblk, k0 = 64 * kb, n0 = 32 * nb;
    const int nd = n0 + (lane & 31);
    int sc = nd; bool valid = true;
    if (MODE == 1) { if (nd < 2048) sc = nd; else if (nd < 2560) sc = nd + 16; else if (nd < 2576) sc = 2048 + (nd - 2560); else if (nd < 2816) { sc = 0; valid = false; } else sc = nd - 240; }
    float tv[32];
#pragma unroll
    for (int i = 0; i < 32; ++i) { const int kk = 2 * i + (lane >> 5); tv[i] = valid ? W[(size_t)(k0 + kk) * Nsrc + sc] : 0.f; }
#pragma unroll
    for (int i = 0; i < 32; ++i) { const int kk = 2 * i + (lane >> 5); scr[kk * 33 + (lane & 31)] = tv[i]; }
    LDS_WAIT(); asm volatile("" ::: "memory");
    if (F8) {
        const int c = lane & 3;
#pragma unroll
        for (int j = 0; j < 2; ++j) { const int n = (lane >> 2) + 16 * j; const LAS float* s = scr + (16 * c) * 33 + n; u32x4 o;
#pragma unroll
            for (int q = 0; q < 4; ++q) { int w = 0; w = __builtin_amdgcn_cvt_pk_fp8_f32(clamp448(s[(4 * q) * 33] * sc8), clamp448(s[(4 * q + 1) * 33] * sc8), w, false);
                w = __builtin_amdgcn_cvt_pk_fp8_f32(clamp448(s[(4 * q + 2) * 33] * sc8), clamp448(s[(4 * q + 3) * 33] * sc8), w, true); o[q] = (unsigned)w; }
            *(u32x4*)((unsigned char*)WT + (size_t)(n0 + n) * ldk + k0 + 16 * c) = o; }
    } else {
    const int c = lane & 7;
#pragma unroll
    for (int j = 0; j < 4; ++j) { const int n = (lane >> 3) + 8 * j; const LAS float* s = scr + (8 * c) * 33 + n;
        u32x4 o; o.x = pk2(s[0 * 33], s[1 * 33]); o.y = pk2(s[2 * 33], s[3 * 33]); o.z = pk2(s[4 * 33], s[5 * 33]); o.w = pk2(s[6 * 33], s[7 * 33]);
        *(u32x4*)(WT + (size_t)(n0 + n) * ldk + k0 + 8 * c) = o; }
    }
    LDS_WAIT(); asm volatile("" ::: "memory");
}
template <int OM, int NB>
__device__ __forceinline__ void rms_rows_to_bf16(int lane, const float* x0, size_t xstride, const float* g, bf16_t* o0, size_t ostride, unsigned* o80 = nullptr, size_t o8stride = 0, const bf16_t* add0 = nullptr, size_t addstride = 0, bf16_t* hb0 = nullptr, size_t hbstride = 0) {
    f32x4 v[NB][4]; float s[NB];
#pragma unroll
    for (int b = 0; b < NB; ++b) { const float* xr = x0 + b * xstride + 8 * lane;
#pragma unroll
        for (int j = 0; j < 2; ++j) { v[b][2 * j] = *(const f32x4*)(xr + 512 * j); v[b][2 * j + 1] = *(const f32x4*)(xr + 512 * j + 4); } }
    if (add0) {
        u32x4 ad[NB][2];
#pragma unroll
        for (int b = 0; b < NB; ++b) { const bf16_t* ar = add0 + b * addstride + 8 * lane;
#pragma unroll
            for (int j = 0; j < 2; ++j) ad[b][j] = *(const u32x4*)(ar + 512 * j); }
#pragma unroll
        for (int b = 0; b < NB; ++b)
#pragma unroll
            for (int j = 0; j < 2; ++j) { v[b][2 * j] = v[b][2 * j] + (f32x4){bflo(ad[b][j].x), bfhi(ad[b][j].x), bflo(ad[b][j].y), bfhi(ad[b][j].y)};
                v[b][2 * j + 1] = v[b][2 * j + 1] + (f32x4){bflo(ad[b][j].z), bfhi(ad[b][j].z), bflo(ad[b][j].w), bfhi(ad[b][j].w)}; }
    }
    if (hb0) {
#pragma unroll
        for (int b = 0; b < NB; ++b)
#pragma unroll
            for (int j = 0; j < 2; ++j) *(u32x4*)(hb0 + b * hbstride + 512 * j + 8 * lane) = pg8::pack8(v[b][2 * j], v[b][2 * j + 1]);
    }
#pragma unroll
    for (int b = 0; b < NB; ++b) { s[b] = 0.f;
#pragma unroll
        for (int j = 0; j < 4; ++j) s[b] += (v[b][j].x * v[b][j].x + v[b][j].y * v[b][j].y) + (v[b][j].z * v[b][j].z + v[b][j].w * v[b][j].w); }
#pragma unroll
    for (int o = 1; o < 64; o <<= 1) {
#pragma unroll
        for (int b = 0; b < NB; ++b) s[b] += __shfl_xor(s[b], o); }
    const float* gr = g + 8 * lane;
#pragma unroll
    for (int b = 0; b < NB; ++b) { const float rstd = 1.f / sqrtf(s[b] * (1.f / D) + EPS);
#pragma unroll
        for (int j = 0; j < 2; ++j) { const f32x4 y0 = v[b][2 * j] * rstd * *(const f32x4*)(gr + 512 * j), y1 = v[b][2 * j + 1] * rstd * *(const f32x4*)(gr + 512 * j + 4);
            const u32x4 o = pg8::pack8(y0, y1);
            if (OM & 1) *(u32x4*)(o0 + b * ostride + 512 * j + 8 * lane) = o;
            if (OM == 3) { u32x2 w8;
#pragma unroll
                for (int h = 0; h < 2; ++h) { int w = 0; w = __builtin_amdgcn_cvt_pk_fp8_f32(clamp448(bflo(o[2 * h]) * 16.f), clamp448(bfhi(o[2 * h]) * 16.f), w, false);
                    w = __builtin_amdgcn_cvt_pk_fp8_f32(clamp448(bflo(o[2 * h + 1]) * 16.f), clamp448(bfhi(o[2 * h + 1]) * 16.f), w, true); w8[h] = (unsigned)w; }
                *(u32x2*)(o80 + b * o8stride + 128 * j + 2 * lane) = w8; }
            if (OM == 2) { u32x2 w8; int w = 0;
                w = __builtin_amdgcn_cvt_pk_fp8_f32(clamp448(y0.x * 16.f), clamp448(y0.y * 16.f), w, false); w = __builtin_amdgcn_cvt_pk_fp8_f32(clamp448(y0.z * 16.f), clamp448(y0.w * 16.f), w, true); w8.x = (unsigned)w;
                w = 0; w = __builtin_amdgcn_cvt_pk_fp8_f32(clamp448(y1.x * 16.f), clamp448(y1.y * 16.f), w, false); w = __builtin_amdgcn_cvt_pk_fp8_f32(clamp448(y1.z * 16.f), clamp448(y1.w * 16.f), w, true); w8.y = (unsigned)w;
                *(u32x2*)(o80 + b * o8stride + 128 * j + 2 * lane) = w8; } } }
}
__device__ __forceinline__ float wave_max(float v) {
#pragma unroll
    for (int o = 1; o < 64; o <<= 1) v = fmaxf(v, __shfl_xor(v, o));
    return v;
}
template <int NB>
__device__ __forceinline__ void cvt_rows_fp8(int lane, const float* const (&src)[NB], unsigned char* const (&dst16)[NB], float* const (&scale_out)[NB]) {
    f32x4 v[NB][4]; float m[NB];
#pragma unroll
    for (int b = 0; b < NB; ++b) {
#pragma unroll
        for (int j = 0; j < 4; ++j) v[b][j] = *(const GAS f32x4*)(src[b] + 16 * lane + 4 * j); }
#pragma unroll
    for (int b = 0; b < NB; ++b) { m[b] = 0.f;
#pragma unroll
        for (int j = 0; j < 4; ++j) m[b] = fmaxf(m[b], fmaxf(fmaxf(fabsf(v[b][j].x), fabsf(v[b][j].y)), fmaxf(fabsf(v[b][j].z), fabsf(v[b][j].w)))); }
#pragma unroll
    for (int o = 1; o < 64; o <<= 1) {
#pragma unroll
        for (int b = 0; b < NB; ++b) m[b] = fmaxf(m[b], __shfl_xor(m[b], o)); }
#pragma unroll
    for (int b = 0; b < NB; ++b) { const float inv = m[b] > 0.f ? 224.f / m[b] : 0.f, sc = m[b] > 0.f ? m[b] * (1.f / 224.f) : 1.f;
        u32x4 o;
#pragma unroll
        for (int j = 0; j < 4; ++j) { int w = 0; w = __builtin_amdgcn_cvt_pk_fp8_f32(v[b][j].x * inv, v[b][j].y * inv, w, false); w = __builtin_amdgcn_cvt_pk_fp8_f32(v[b][j].z * inv, v[b][j].w * inv, w, true); o[j] = (unsigned)w; }
        *(GAS u32x4*)dst16[b] = o;
        if (lane == 0) *(GAS float*)scale_out[b] = sc; }
}
__device__ __forceinline__ unsigned fp4_code(float t) { const float a = fabsf(t);
    const unsigned c = (unsigned)(a >= 0.25f) + (unsigned)(a >= 0.75f) + (unsigned)(a >= 1.25f) + (unsigned)(a >= 1.75f) + (unsigned)(a >= 2.5f) + (unsigned)(a >= 3.5f) + (unsigned)(a >= 5.f);
    return c | (t < 0.f ? 8u : 0u); }
template <int NB, bool PERMV = false>
__device__ __forceinline__ void cvt_rows_fp4(int lane, const float* const (&src)[NB], unsigned char* const (&dst8)[NB], float* const (&scale_out)[NB], const float* colmul = nullptr) {
    f32x4 v[NB][4]; float m[NB];
#pragma unroll
    for (int b = 0; b < NB; ++b) {
#pragma unroll
        for (int j = 0; j < 4; ++j) v[b][j] = *(const GAS f32x4*)(src[b] + 16 * lane + 4 * j); }
    if (colmul) {
#pragma unroll
        for (int j = 0; j < 4; ++j) { const f32x4 cm = *(const f32x4*)(colmul + 16 * lane + 4 * j);
#pragma unroll
            for (int b = 0; b < NB; ++b) v[b][j] = v[b][j] * cm; } }
#pragma unroll
    for (int b = 0; b < NB; ++b) { m[b] = 0.f;
#pragma unroll
        for (int j = 0; j < 4; ++j) m[b] = fmaxf(m[b], fmaxf(fmaxf(fabsf(v[b][j].x), fabsf(v[b][j].y)), fmaxf(fabsf(v[b][j].z), fabsf(v[b][j].w)))); }
#pragma unroll
    for (int o = 1; o < 64; o <<= 1) {
#pragma unroll
        for (int b = 0; b < NB; ++b) m[b] = fmaxf(m[b], __shfl_xor(m[b], o)); }
#pragma unroll
    for (int b = 0; b < NB; ++b) { const float inv = m[b] > 0.f ? 6.f / m[b] : 0.f, sc = m[b] > 0.f ? m[b] * (1.f / 6.f) : 1.f;
        u32x2 o;
#pragma unroll
        for (int h = 0; h < 2; ++h) { unsigned w = 0;
            const f32x4 t0 = v[b][2 * h] * inv, t1 = v[b][2 * h + 1] * inv;
            w = __builtin_amdgcn_cvt_scalef32_pk_fp4_f32(w, t0.x, t0.y, 1.f, 0); w = __builtin_amdgcn_cvt_scalef32_pk_fp4_f32(w, t0.z, t0.w, 1.f, 1);
            w = __builtin_amdgcn_cvt_scalef32_pk_fp4_f32(w, t1.x, t1.y, 1.f, 2); w = __builtin_amdgcn_cvt_scalef32_pk_fp4_f32(w, t1.z, t1.w, 1.f, 3);
            o[h] = w; }
        if (PERMV) { *(GAS unsigned*)(dst8[b] + 16 * ((2 * lane) & 31) + 4 * (lane >> 4)) = o.x; *(GAS unsigned*)(dst8[b] + 16 * ((2 * lane + 1) & 31) + 4 * (lane >> 4)) = o.y; }
        else *(GAS u32x2*)dst8[b] = o;
        if (lane == 0) *(GAS float*)scale_out[b] = sc; }
}
__device__ __forceinline__ void convert_tables(const Frame& F, const Args& A, int wi, int nw) {
    unsigned char* ws = A.ws; const int gw = wi, NGW = nw;
    {
        int mc = gw;
        for (; mc + 3 * NGW < NEXP; mc += 4 * NGW) { const float* src[4]; unsigned char* dst[4]; float* sco[4];
#pragma unroll
            for (int b = 0; b < 4; ++b) { const int e = mc + b * NGW; src[b] = A.in[I_PU] + (size_t)e * D; dst[b] = ws + WS_U8 + (size_t)((e & (UNG - 1)) * (NEXP / UNG) + (e >> UNG_SH)) * 512 + 8 * F.lane; sco[b] = (float*)(ws + WS_SU) + e; }
            cvt_rows_fp4<4>(F.lane, src, dst, sco, A.in[I_N2G]); }
        for (; mc < NEXP; mc += NGW) { const float* src[1]; unsigned char* dst[1]; float* sco[1];
            const int e = mc; src[0] = A.in[I_PU] + (size_t)e * D; dst[0] = ws + WS_U8 + (size_t)((e & (UNG - 1)) * (NEXP / UNG) + (e >> UNG_SH)) * 512 + 8 * F.lane; sco[0] = (float*)(ws + WS_SU) + e;
            cvt_rows_fp4<1>(F.lane, src, dst, sco, A.in[I_N2G]); }
    }
    if (V_F4) {
        int mc = gw;
        for (; mc + 3 * NGW < NEXP; mc += 4 * NGW) { const float* src[4]; unsigned char* dst[4]; float* sco[4];
#pragma unroll
            for (int b = 0; b < 4; ++b) { const int e = mc + b * NGW; src[b] = A.in[I_PV] + (size_t)e * D; dst[b] = ws + WS_V8 + (size_t)e * 512; sco[b] = (float*)(ws + WS_SV) + e; }
            cvt_rows_fp4<4, true>(F.lane, src, dst, sco); }
        for (; mc < NEXP; mc += NGW) { const float* src[1]; unsigned char* dst[1]; float* sco[1];
            const int e = mc; src[0] = A.in[I_PV] + (size_t)e * D; dst[0] = ws + WS_V8 + (size_t)e * 512; sco[0] = (float*)(ws + WS_SV) + e;
            cvt_rows_fp4<1, true>(F.lane, src, dst, sco); }
    } else {
        int mc = gw;
        for (; mc + 3 * NGW < NEXP; mc += 4 * NGW) { const float* src[4]; unsigned char* dst[4]; float* sco[4];
#pragma unroll
            for (int b = 0; b < 4; ++b) { const int e = mc + b * NGW; src[b] = A.in[I_PV] + (size_t)e * D; dst[b] = ws + WS_V8 + ((size_t)(F.lane >> 3) * NEXP + e) * 128 + 16 * (F.lane & 7); sco[b] = (float*)(ws + WS_SV) + e; }
            cvt_rows_fp8<4>(F.lane, src, dst, sco); }
        for (; mc < NEXP; mc += NGW) { const float* src[1]; unsigned char* dst[1]; float* sco[1];
            const int e = mc; src[0] = A.in[I_PV] + (size_t)e * D; dst[0] = ws + WS_V8 + ((size_t)(F.lane >> 3) * NEXP + e) * 128 + 16 * (F.lane & 7); sco[0] = (float*)(ws + WS_SV) + e;
            cvt_rows_fp8<1>(F.lane, src, dst, sco); }
    }
}
__device__ __forceinline__ void phase0(const Frame& F, const Args& A) {
    unsigned char* ws = A.ws;
    if (!SC_F8) {
        const int l = F.lane, fr = l & 15, q = l >> 4;
        bf16_t* WQF = (bf16_t*)(ws + WS_WQF);
        for (int it = F.bid * NWAVES + F.wave; it < 2048; it += F.G * NWAVES) {
            const int kh = it & 1, kt = (it >> 1) & 63, hh = it >> 7;
            const float* kX = (hh & 1) ? A.in[I_K2] : A.in[I_K1];
            const float* ap = A.in[I_WQ] + (size_t)(kt * 16 + fr) * 2048 + hh * 128 + 4 * q;
            f32x4 a[8];
#pragma unroll
            for (int t = 0; t < 8; ++t) a[t] = *(const f32x4*)(ap + 16 * t);
#pragma unroll
            for (int kb = 0; kb < 4; ++kb) { const int key0 = kh * 64 + kb * 16;
                const float* bp = kX + (size_t)(key0 + fr) * 128 + 4 * q;
                f32x4 b[8];
#pragma unroll
                for (int t = 0; t < 8; ++t) b[t] = *(const f32x4*)(bp + 16 * t);
                f32x4 d = {0.f, 0.f, 0.f, 0.f};
#pragma unroll
                for (int t = 0; t < 8; ++t)
#pragma unroll
                    for (int c = 0; c < 4; ++c) d = __builtin_amdgcn_mfma_f32_16x16x4f32(a[t][c], b[t][c], d, 0, 0, 0);
                const f32x4 g2 = *(const f32x4*)(A.in[I_N2G] + kt * 16 + 4 * q);
                u32x2 o; o.x = pk2(d[0] * g2.x, d[1] * g2.y); o.y = pk2(d[2] * g2.z, d[3] * g2.w);
                *(u32x2*)(WQF + (size_t)(hh * 128 + key0 + fr) * 1024 + kt * 16 + 4 * q) = o; }
        }
    } else {
        LAS float* kx = (LAS float*)F.lds;
        LAS float* wt = (LAS float*)(F.lds + 128 * 129 * 4);
        bf16_t* WQF = (bf16_t*)(ws + WS_WQF);
        for (int it = F.bid; it < 512; it += F.G) {
            const int hh = it >> 5, kblk = it & 31, k0 = kblk * 32;
            const float* kX = (hh & 1) ? A.in[I_K2] : A.in[I_K1];
            __syncthreads();
            for (int e = F.tid; e < 128 * 128; e += 512) kx[(e >> 7) * 129 + (e & 127)] = kX[e];
            for (int e = F.tid; e < 32 * 128; e += 512) wt[e] = A.in[I_WQ][(size_t)(k0 + (e >> 7)) * 2048 + hh * 128 + (e & 127)];
            __syncthreads();
            const int key = F.tid & 127, kq = F.tid >> 7;
            float acc[8];
#pragma unroll
            for (int i = 0; i < 8; ++i) acc[i] = 0.f;
            for (int d = 0; d < 128; ++d) { const float b = kx[key * 129 + d];
#pragma unroll
                for (int i = 0; i < 8; ++i) acc[i] += wt[(kq * 8 + i) * 128 + d] * b; }
            if (SC_F8) { u32x2 o;
#pragma unroll
                for (int h2 = 0; h2 < 2; ++h2) { int w = 0; w = __builtin_amdgcn_cvt_pk_fp8_f32(clamp448(acc[4 * h2] * 1024.f), clamp448(acc[4 * h2 + 1] * 1024.f), w, false);
                    w = __builtin_amdgcn_cvt_pk_fp8_f32(clamp448(acc[4 * h2 + 2] * 1024.f), clamp448(acc[4 * h2 + 3] * 1024.f), w, true); o[h2] = (unsigned)w; }
                *(u32x2*)((unsigned char*)WQF + (size_t)(hh * 128 + key) * 1024 + k0 + kq * 8) = o;
            } else {
            u32x4 o; o.x = pk2(acc[0], acc[1]); o.y = pk2(acc[2], acc[3]); o.z = pk2(acc[4], acc[5]); o.w = pk2(acc[6], acc[7]);
            *(u32x4*)(WQF + (size_t)(hh * 128 + key) * 1024 + k0 + kq * 8) = o; }
        }
        __syncthreads();
    }
    LAS float* scr = (LAS float*)(F.lds + F.wave * 16384);
    const int gw = F.bid * NWAVES + F.wave, NGW = F.G * NWAVES;
    constexpr int I_IN = 16 * (NPROJ / 32), I_A = 8 * 32, I_B = 8 * 32, I_O = 16 * 32;
    constexpr int NITEMS = I_IN + I_A + I_B + I_O;
    for (int it = gw; it < NITEMS; it += NGW) {
        int r = it;
        if (r < I_IN) { if ((r % (NPROJ / 32)) * 32 >= F8_LO * 256) p0_transpose_item<1, true>(A.in[I_WIN], 1024, 5136, NPROJ, (bf16_t*)(ws + WS_W8), scr, r, F.lane, 1024.f);
                        else p0_transpose_item<1, false>(A.in[I_WIN], 1024, 5136, NPROJ, (bf16_t*)(ws + WS_WIN), scr, r, F.lane); continue; } r -= I_IN;
        if (r < I_A) { p0_transpose_item<0>(A.in[I_WBA], 512, 1024, 1024, (bf16_t*)(ws + WS_WA), scr, r, F.lane, 1.f, 1024); continue; } r -= I_A;
        if (r < I_B) { p0_transpose_item<0>(A.in[I_WBB], 512, 1024, 1024, (bf16_t*)(ws + WS_WA) + 512, scr, r, F.lane, 1.f, 1024); continue; } r -= I_B;
        p0_transpose_item<0>(A.in[I_WOUT], 1024, 1024, 1024, (bf16_t*)(ws + WS_WOUT), scr, r, F.lane);
    }
    constexpr int OM1 = F8_LO <= 0 ? 2 : (F8_LO >= 21 ? 1 : 3);
    { int m = gw; for (; m + 3 * NGW < T_TOK; m += 4 * NGW) rms_rows_to_bf16<OM1, 4>(F.lane, A.in[I_X] + (size_t)m * D, (size_t)NGW * D, A.in[I_N1G], (bf16_t*)(ws + WS_N1) + (size_t)m * D, (size_t)NGW * D, (unsigned*)(ws + WS_N18) + (size_t)m * 256, (size_t)NGW * 256);
      for (; m < T_TOK; m += NGW) rms_rows_to_bf16<OM1, 1>(F.lane, A.in[I_X] + (size_t)m * D, 0, A.in[I_N1G], (bf16_t*)(ws + WS_N1) + (size_t)m * D, 0, (unsigned*)(ws + WS_N18) + (size_t)m * 256, 0); }
}

__device__ __forceinline__ float log_sigmoid(float z) { return fminf(z, 0.f) - log1pf(__expf(-fabsf(z))); }

template <bool DRY>
__device__ __forceinline__ void gla_chunk_phase(const Frame& F, const Args& A) {
    unsigned char* ws = A.ws;
    const bf16_t* P = (const bf16_t*)(ws + WS_P);
    const float* ALR = (const float*)(ws + WS_ALR);
    LAS float* alr = (LAS float*)F.lds;
    LAS float* tot = (LAS float*)(F.lds + 4096);
    LAS bf16_t* kdT = (LAS bf16_t*)(F.lds + 8192);
    LAS bf16_t* vT = (LAS bf16_t*)(F.lds + 26624);
    LAS bf16_t* stT = (LAS bf16_t*)(F.lds + 45056);
    const int tid = F.tid, kk = tid & 127, seg = tid >> 7;
    const bool hconst = (F.G & 3) == 0;
    int hcur = -1; float w[16]; float bias = 0.f;
#pragma unroll
    for (int j = 0; j < 16; ++j) w[j] = 0.f;
    float na0, na1; bf16_t nk[16], nv[16];
#define GC_LOAD(unit) do { const int h_ = (unit) & 3, c_ = ((unit) >> 2) & 63, b_ = (unit) >> 8; const int t0_ = b_ * SEQ + c_ * 64; \
        na0 = ALR[(size_t)t0_ * 16 + tid]; na1 = ALR[(size_t)t0_ * 16 + 512 + tid]; \
        const bf16_t* kp_ = P + (size_t)(t0_ + 16 * seg) * PLD + PC_K + h_ * 128 + kk; const bf16_t* vp_ = P + (size_t)(t0_ + 16 * seg) * PLD + PC_V + h_ * 128 + kk; \
        _Pragma("unroll") for (int i_ = 0; i_ < 16; ++i_) { nk[i_] = kp_[(size_t)i_ * PLD]; nv[i_] = vp_[(size_t)i_ * PLD]; } } while (0)
    int unit = F.bid;
    if (unit < 2048) GC_LOAD(unit);
    for (; unit < 2048; unit += F.G) {
        const int h = unit & 3;
        if (h != hcur) { hcur = h;
#pragma unroll
            for (int j = 0; j < 16; ++j) w[j] = A.in[I_WGU][(size_t)j * 512 + h * 128 + kk];
            bias = A.in[I_BG][h * 128 + kk]; }
        __syncthreads();
        alr[tid] = na0; alr[512 + tid] = na1;
        bf16_t kr[16], vr[16];
#pragma unroll
        for (int i = 0; i < 16; ++i) { kr[i] = nk[i]; vr[i] = nv[i]; }
        if (unit + F.G < 2048) GC_LOAD(unit + F.G);
        __syncthreads();
        float cum[16]; float run = 0.f;
#pragma unroll
        for (int i = 0; i < 16; ++i) { const LAS f32x4* ap = (const LAS f32x4*)(alr + (16 * seg + i) * 16); float z = bias;
#pragma unroll
            for (int q = 0; q < 4; ++q) { const f32x4 a4 = ap[q]; z += a4.x * w[4 * q] + a4.y * w[4 * q + 1] + a4.z * w[4 * q + 2] + a4.w * w[4 * q + 3]; }
            const float ls = fminf(z, 0.f) - __logf(1.f + __expf(-fabsf(z)));
            run += ls * (1.f / 16.f); cum[i] = run; }
        tot[seg * 128 + kk] = run;
        __syncthreads();
        {
            const float t0s = tot[kk], t1s = tot[128 + kk], t2s = tot[256 + kk], t3s = tot[384 + kk];
            const float total = (t0s + t1s) + (t2s + t3s);
            const float prefix = seg == 0 ? 0.f : (seg == 1 ? t0s : (seg == 2 ? t0s + t1s : t0s + t1s + t2s));
            unsigned kw[8], vw[8];
#pragma unroll
            for (int i = 0; i < 8; ++i) {
                const float e0 = __expf(total - (prefix + cum[2 * i])), e1 = __expf(total - (prefix + cum[2 * i + 1]));
                kw[i] = pk2(bf1(kr[2 * i]) * e0, bf1(kr[2 * i + 1]) * e1); vw[i] = (unsigned)vr[2 * i] | ((unsigned)vr[2 * i + 1] << 16);
            }
            *(LAS u32x4*)(kdT + kk * 72 + 16 * seg) = (u32x4){kw[0], kw[1], kw[2], kw[3]}; *(LAS u32x4*)(kdT + kk * 72 + 16 * seg + 8) = (u32x4){kw[4], kw[5], kw[6], kw[7]};
            *(LAS u32x4*)(vT + kk * 72 + 16 * seg) = (u32x4){vw[0], vw[1], vw[2], vw[3]}; *(LAS u32x4*)(vT + kk * 72 + 16 * seg + 8) = (u32x4){vw[4], vw[5], vw[6], vw[7]};
            if (seg == 0) ((float*)(DRY ? (unsigned char*)A.out + 96 * MiB : ws + WS_DEC))[(size_t)unit * 128 + kk] = __expf(total);
        }
        __syncthreads();
        {
            const int w8 = F.wave, l = F.lane, fr = l & 15, fq = l >> 4;
            f32x4 acc[8];
#pragma unroll
            for (int n = 0; n < 8; ++n) acc[n] = (f32x4){0.f, 0.f, 0.f, 0.f};
#pragma unroll
            for (int ks = 0; ks < 2; ++ks) {
                const bf16x8 a = *(const LAS bf16x8*)(kdT + (16 * w8 + fr) * 72 + 32 * ks + 8 * fq);
#pragma unroll
                for (int n = 0; n < 8; ++n) { const bf16x8 bb = *(const LAS bf16x8*)(vT + (16 * n + fr) * 72 + 32 * ks + 8 * fq);
                    acc[n] = __builtin_amdgcn_mfma_f32_16x16x32_bf16(a, bb, acc[n], 0, 0, 0); }
            }
#pragma unroll
            for (int n = 0; n < 8; ++n) { u32x2 o; o.x = pk2(acc[n][0], acc[n][1]); o.y = pk2(acc[n][2], acc[n][3]);
                *(LAS u32x2*)(stT + (16 * n + fr) * 136 + 16 * w8 + 4 * fq) = o; }
        }
        __syncthreads();
        {
            bf16_t* ST = (bf16_t*)(DRY ? (unsigned char*)A.out : ws + WS_N1) + (size_t)unit * 16384;
            const int vv = tid >> 2, part = tid & 3;
#pragma unroll
            for (int q = 0; q < 4; ++q) *(u32x4*)(ST + (size_t)vv * 128 + 32 * part + 8 * q) = *(const LAS u32x4*)(stT + vv * 136 + 32 * part + 8 * q);
        }
    }
#undef GC_LOAD
    (void)hconst;
}

template <bool DRY>
__device__ __forceinline__ void sgu_unit(const Frame& F, const Args& A, int unit, bool stats) {
    const int g = unit & 3, blk = (unit >> 2) & 31, b = unit >> 7;
    const int t0 = b * SEQ + blk * 128;
    bf16_t* P = (bf16_t*)(A.ws + WS_P);
    LAS bf16_t* wA = (LAS bf16_t*)F.lds;
    LAS bf16_t* vnT = (LAS bf16_t*)(F.lds + 34816);
    LAS float* st = (LAS float*)(F.lds + 69632);
    LAS bf16_t* suS = (LAS bf16_t*)(F.lds + 70656);
    const int tid = F.tid;
    __syncthreads();
    if (stats) {
        const int j = tid >> 2, q = tid & 3;
        const bf16_t* sp = P + (size_t)(t0 + j) * PLD + PC_SV + q * 128;
        float s = 0.f, s2 = 0.f;
#pragma unroll
        for (int i = 0; i < 16; ++i) { const u32x4 w = *(const u32x4*)(sp + 8 * i);
            const float f[8] = {bflo(w.x), bfhi(w.x), bflo(w.y), bfhi(w.y), bflo(w.z), bfhi(w.z), bflo(w.w), bfhi(w.w)};
#pragma unroll
            for (int e = 0; e < 8; ++e) { s += f[e]; s2 += f[e] * f[e]; } }
        s += __shfl_xor(s, 1); s += __shfl_xor(s, 2); s2 += __shfl_xor(s2, 1); s2 += __shfl_xor(s2, 2);
        const float mu = s * (1.f / 512.f); const float var = fmaxf(s2 * (1.f / 512.f) - mu * mu, 0.f);
        if (q == 0) { st[2 * j] = mu; st[2 * j + 1] = 1.f / sqrtf(var + EPS); }
    }
    {
        const int i = tid >> 2, jb = (tid & 3) * 32;
        const float* wp = A.in[I_SW] + (size_t)g * 16384 + (size_t)i * 128 + jb;
        const bf16_t* sup = P + (size_t)(t0 + i) * PLD + PC_SU + g * 128 + jb;
#pragma unroll
        for (int q = 0; q < 4; ++q) { const f32x4 a = *(const f32x4*)(wp + 8 * q), bq = *(const f32x4*)(wp + 8 * q + 4);
            const bool z = (i < 64) && (jb + 8 * q >= 64);
            u32x4 o; o.x = pk2(a.x, a.y); o.y = pk2(a.z, a.w); o.z = pk2(bq.x, bq.y); o.w = pk2(bq.z, bq.w);
            if (z) o = (u32x4){0u, 0u, 0u, 0u};
            *(LAS u32x4*)(wA + i * 136 + jb + 8 * q) = o;
            *(LAS u32x4*)(suS + i * 136 + jb + 8 * q) = *(const u32x4*)(sup + 8 * q); }
    }
    const int cch = tid & 127, seg = tid >> 7;
    bf16_t xr[32];
    { const bf16_t* sp = P + (size_t)(t0 + 32 * seg) * PLD + PC_SV + g * 128 + cch;
#pragma unroll
      for (int i = 0; i < 32; ++i) xr[i] = sp[(size_t)i * PLD]; }
    const float lg = A.in[I_SLNG][g * 128 + cch], lb = A.in[I_SLNB][g * 128 + cch];
    __syncthreads();
    {
        unsigned ow[16];
#pragma unroll
        for (int i = 0; i < 16; ++i) { const int j = 32 * seg + 2 * i; const f32x4 ms = *(const LAS f32x4*)(st + 2 * j);
            ow[i] = pk2((bf1(xr[2 * i]) - ms.x) * ms.y * lg + lb, (bf1(xr[2 * i + 1]) - ms.z) * ms.w * lg + lb); }
#pragma unroll
        for (int q = 0; q < 4; ++q) *(LAS u32x4*)(vnT + cch * 136 + 32 * seg + 8 * q) = (u32x4){ow[4 * q], ow[4 * q + 1], ow[4 * q + 2], ow[4 * q + 3]};
    }
    __syncthreads();
    {
        const int w = F.wave, l = F.lane, fr = l & 15, fq = l >> 4;
        f32x4 acc[8];
#pragma unroll
        for (int n = 0; n < 8; ++n) acc[n] = (f32x4){0.f, 0.f, 0.f, 0.f};
#pragma unroll
        for (int ks = 0; ks < 4; ++ks) {
            const bf16x8 a = *(const LAS bf16x8*)(wA + (16 * w + fr) * 136 + 32 * ks + 8 * fq);
#pragma unroll
            for (int n = 0; n < 8; ++n) { const bf16x8 bb = *(const LAS bf16x8*)(vnT + (16 * n + fr) * 136 + 32 * ks + 8 * fq);
                acc[n] = __builtin_amdgcn_mfma_f32_16x16x32_bf16(a, bb, acc[n], 0, 0, 0); }
        }
#pragma unroll
        for (int jj = 0; jj < 4; ++jj) { const int i = 16 * w + 4 * fq + jj; const float bias = A.in[I_SB][g * 128 + i];
            LAS bf16_t* rp = suS + i * 136 + fr;
#pragma unroll
            for (int n = 0; n < 8; ++n) { const float su = bf1(rp[16 * n]); rp[16 * n] = (bf16_t)f2bf(su * (acc[n][jj] + bias)); } }
    }
    __syncthreads();
    {
        const int i = tid >> 2, jb = (tid & 3) * 32;
        bf16_t* yp = DRY ? (bf16_t*)A.out + (size_t)(t0 + i) * 512 + g * 128 + jb : P + (size_t)(t0 + i) * PLD + PC_SU + g * 128 + jb;
#pragma unroll
        for (int q = 0; q < 4; ++q) *(u32x4*)(yp + 8 * q) = *(const LAS u32x4*)(suS + i * 136 + jb + 8 * q);
    }
}

template <bool DRY>
__device__ __forceinline__ void gla_scan(const Frame& F, const Args& A) {
    bf16_t* ST = (bf16_t*)(A.ws + WS_N1); bf16_t* STO = DRY ? (bf16_t*)A.out : ST; const float* DEC = (const float*)(A.ws + WS_DEC);
    for (int gi = F.bid * 512 + F.tid; gi < 131072; gi += F.G * 512) {
        const int k4 = gi & 31, vv = (gi >> 5) & 127, h = (gi >> 12) & 3, b = gi >> 14;
        float s0 = 0.f, s1 = 0.f, s2 = 0.f, s3 = 0.f;
        u32x2 wa[8], wb[8]; f32x4 da[8], db[8];
#define SCAN_LOAD(W, Dd, c0) do { _Pragma("unroll") for (int i_ = 0; i_ < 8; ++i_) { const size_t u_ = (size_t)((b * 64 + (c0) + i_) * 4 + h); \
            W[i_] = *(const u32x2*)(ST + u_ * 16384 + (size_t)vv * 128 + k4 * 4); Dd[i_] = *(const f32x4*)(DEC + u_ * 128 + k4 * 4); } } while (0)
#define SCAN_STEP(W, Dd, c0) do { _Pragma("unroll") for (int i_ = 0; i_ < 8; ++i_) { const size_t u_ = (size_t)((b * 64 + (c0) + i_) * 4 + h); \
            s0 = Dd[i_].x * s0 + bflo(W[i_].x); s1 = Dd[i_].y * s1 + bfhi(W[i_].x); s2 = Dd[i_].z * s2 + bflo(W[i_].y); s3 = Dd[i_].w * s3 + bfhi(W[i_].y); \
            u32x2 o_; o_.x = pk2(s0, s1); o_.y = pk2(s2, s3); *(u32x2*)(STO + u_ * 16384 + (size_t)vv * 128 + k4 * 4) = o_; } } while (0)
        SCAN_LOAD(wa, da, 0);
#pragma unroll
        for (int c0 = 0; c0 < 64; c0 += 16) {
            SCAN_LOAD(wb, db, c0 + 8);
            SCAN_STEP(wa, da, c0);
            if (c0 + 16 < 64) SCAN_LOAD(wa, da, c0 + 16);
            SCAN_STEP(wb, db, c0 + 8);
        }
#undef SCAN_LOAD
#undef SCAN_STEP
    }
}

template <bool DRY>
__device__ __forceinline__ void gla_out_phase(const Frame& F, const Args& A) {
    bf16_t* P = (bf16_t*)(A.ws + WS_P);
    LAS bf16_t* qA = (LAS bf16_t*)F.lds;
    LAS bf16_t* sB = (LAS bf16_t*)(F.lds + 17408);
    LAS float* oF = (LAS float*)(F.lds + 52224);
    const int tid = F.tid, s = tid >> 3, cb = (tid & 7) * 16, vv = tid >> 2, kb = (tid & 3) * 32;
    u32x4 nq0, nq1, ns0, ns1, ns2, ns3, nr0, nr1;
#define GO_LOAD(unit) do { const int h_ = (unit) & 3, c_ = ((unit) >> 2) & 63, b_ = (unit) >> 8; const int t0_ = b_ * SEQ + c_ * 64; \
        const bf16_t* qp_ = P + (size_t)(t0_ + s) * PLD + PC_Q + h_ * 128 + cb; nq0 = *(const u32x4*)qp_; nq1 = *(const u32x4*)(qp_ + 8); \
        const bf16_t* sp_ = (const bf16_t*)(A.ws + WS_N1) + (size_t)(unit) * 16384 + (size_t)vv * 128 + kb; ns0 = *(const u32x4*)sp_; ns1 = *(const u32x4*)(sp_ + 8); ns2 = *(const u32x4*)(sp_ + 16); ns3 = *(const u32x4*)(sp_ + 24); \
        const bf16_t* rp_ = P + (size_t)(t0_ + s) * PLD + PC_R + h_ * 128 + cb; nr0 = *(const u32x4*)rp_; nr1 = *(const u32x4*)(rp_ + 8); } while (0)
    int unit = F.bid;
    if (unit < 2048) GO_LOAD(unit);
    for (; unit < 2048; unit += F.G) {
        const int h = unit & 3, c = (unit >> 2) & 63, b = unit >> 8;
        const int t0 = b * SEQ + c * 64;
        __syncthreads();
        *(LAS u32x4*)(qA + s * 136 + cb) = nq0; *(LAS u32x4*)(qA + s * 136 + cb + 8) = nq1;
        *(LAS u32x4*)(sB + vv * 136 + kb) = ns0; *(LAS u32x4*)(sB + vv * 136 + kb + 8) = ns1; *(LAS u32x4*)(sB + vv * 136 + kb + 16) = ns2; *(LAS u32x4*)(sB + vv * 136 + kb + 24) = ns3;
        const u32x4 r0 = nr0, r1 = nr1;
        if (unit + F.G < 2048) GO_LOAD(unit + F.G);
        __syncthreads();
        {
            const int w = F.wave, l = F.lane, fr = l & 15, fq = l >> 4, m = w & 3, nh = w >> 2;
            f32x4 acc[4];
#pragma unroll
            for (int n = 0; n < 4; ++n) acc[n] = (f32x4){0.f, 0.f, 0.f, 0.f};
#pragma unroll
            for (int ks = 0; ks < 4; ++ks) {
                const bf16x8 a = *(const LAS bf16x8*)(qA + (16 * m + fr) * 136 + 32 * ks + 8 * fq);
#pragma unroll
                for (int n = 0; n < 4; ++n) { const bf16x8 bb = *(const LAS bf16x8*)(sB + (16 * (4 * nh + n) + fr) * 136 + 32 * ks + 8 * fq);
                    acc[n] = __builtin_amdgcn_mfma_f32_16x16x32_bf16(a, bb, acc[n], 0, 0, 0); }
            }
            const float scale = 0.08838834764831845f;
#pragma unroll
            for (int n = 0; n < 4; ++n)
#pragma unroll
                for (int jj = 0; jj < 4; ++jj) oF[(16 * m + 4 * fq + jj) * 132 + 16 * (4 * nh + n) + fr] = acc[n][jj] * scale;
        }
        __syncthreads();
        {
            float o[16]; float ss = 0.f;
#pragma unroll
            for (int i = 0; i < 16; ++i) { o[i] = oF[s * 132 + cb + i]; ss += o[i] * o[i]; }
            ss += __shfl_xor(ss, 1); ss += __shfl_xor(ss, 2); ss += __shfl_xor(ss, 4);
            const float rstd = 1.f / sqrtf(ss * (1.f / 128.f) + EPS);
            const unsigned rw[8] = {r0.x, r0.y, r0.z, r0.w, r1.x, r1.y, r1.z, r1.w};
            const float* gg = A.in[I_GLAG] + h * 128 + cb;
            unsigned ow[8];
#pragma unroll
            for (int i = 0; i < 8; ++i) { const float y0 = o[2 * i] * rstd * gg[2 * i] * siluf_(bflo(rw[i])), y1 = o[2 * i + 1] * rstd * gg[2 * i + 1] * siluf_(bfhi(rw[i])); ow[i] = pk2(y0, y1); }
            bf16_t* yp = DRY ? (bf16_t*)A.out + (size_t)(t0 + s) * 512 + h * 128 + cb : P + (size_t)(t0 + s) * PLD + PC_R + h * 128 + cb;
            *(u32x4*)yp = (u32x4){ow[0], ow[1], ow[2], ow[3]}; *(u32x4*)(yp + 8) = (u32x4){ow[4], ow[5], ow[6], ow[7]};
        }
    }
#undef GO_LOAD
}

__device__ __forceinline__ unsigned ordkey(float v) { const unsigned u = __builtin_bit_cast(unsigned, v); return u ^ ((unsigned)((int)u >> 31) | 0x80000000u); }
__device__ __forceinline__ float unord16(unsigned k) { const unsigned u = ((k & 0x80000000u) ? (k & 0x7fffffffu) : ~k) & 0xffff0000u; return __builtin_bit_cast(float, u); }
__device__ __forceinline__ float unord(unsigned k) { const unsigned u = (k & 0x80000000u) ? (k & 0x7fffffffu) : ~k; return __builtin_bit_cast(float, u); }
#define INS16(r, xin) do { unsigned _x = (xin); _Pragma("unroll") for (int _i = 0; _i < 16; ++_i) { const unsigned _h = max((r)[_i], _x); _x = min((r)[_i], _x); (r)[_i] = _h; } } while (0)

#define CE(a, b) do { const unsigned _h = max((a), (b)), _l = min((a), (b)); (a) = _h; (b) = _l; } while (0)
#define SORT16(v) do { CE(v[0], v[1]); CE(v[2], v[3]); CE(v[0], v[2]); CE(v[1], v[3]); CE(v[1], v[2]); CE(v[4], v[5]); CE(v[6], v[7]); CE(v[4], v[6]); CE(v[5], v[7]); CE(v[5], v[6]); CE(v[0], v[4]); CE(v[2], v[6]); CE(v[2], v[4]); CE(v[1], v[5]); CE(v[3], v[7]); CE(v[3], v[5]); CE(v[1], v[2]); CE(v[3], v[4]); CE(v[5], v[6]); CE(v[8], v[9]); CE(v[10], v[11]); CE(v[8], v[10]); CE(v[9], v[11]); CE(v[9], v[10]); CE(v[12], v[13]); CE(v[14], v[15]); CE(v[12], v[14]); CE(v[13], v[15]); CE(v[13], v[14]); CE(v[8], v[12]); CE(v[10], v[14]); CE(v[10], v[12]); CE(v[9], v[13]); CE(v[11], v[15]); CE(v[11], v[13]); CE(v[9], v[10]); CE(v[11], v[12]); CE(v[13], v[14]); CE(v[0], v[8]); CE(v[4], v[12]); CE(v[4], v[8]); CE(v[2], v[10]); CE(v[6], v[14]); CE(v[6], v[10]); CE(v[2], v[4]); CE(v[6], v[8]); CE(v[10], v[12]); CE(v[1], v[9]); CE(v[5], v[13]); CE(v[5], v[9]); CE(v[3], v[11]); CE(v[7], v[15]); CE(v[7], v[11]); CE(v[3], v[5]); CE(v[7], v[9]); CE(v[11], v[13]); CE(v[1], v[2]); CE(v[3], v[4]); CE(v[5], v[6]); CE(v[7], v[8]); CE(v[9], v[10]); CE(v[11], v[12]); CE(v[13], v[14]); } while (0)
#define MERGE16(T, S) do { _Pragma("unroll") for (int _i = 0; _i < 16; ++_i) (T)[_i] = max((T)[_i], (S)[15 - _i]); \
    _Pragma("unroll") for (int _d = 8; _d >= 1; _d >>= 1) { _Pragma("unroll") for (int _i = 0; _i < 16; ++_i) if ((_i & _d) == 0) CE((T)[_i], (T)[_i + _d]); } } while (0)
__device__ __forceinline__ void peer_topk(const Frame& F, const Args& A) {
    const bf16_t* SC = (const bf16_t*)(A.ws + WS_P + P_SC);
    int* IDX = (int*)(A.ws + WS_P + P_IDX); float* GATE = (float*)(A.ws + WS_P + P_GATE);
    const int gw = F.bid * NWAVES + F.wave, NGW = F.G * NWAVES;
    for (int it = gw; it < 512 * 8; it += NGW) {
        const int h = it & 7, tb = it >> 3; const int tok = tb * 64 + F.lane;
        unsigned r1[16], r2[16], rc[16];
        const bf16_t* p1 = SC + ((size_t)(tok >> 4) * 256 + h * 32) * 128 + (tok & 15) * 8; const bf16_t* p2 = p1 + 16 * 128;
        {
            unsigned raw[128]; unsigned sg[16];
#pragma unroll
            for (int jq = 0; jq < 16; ++jq) { const u32x4 t4 = *(const u32x4*)(p1 + jq * 128);
#pragma unroll
                for (int c = 0; c < 4; ++c) { raw[8 * jq + 2 * c] = t4[c] << 16; raw[8 * jq + 2 * c + 1] = t4[c] & 0xffff0000u; } }
#pragma unroll
            for (int j = 0; j < 16; ++j) r1[j] = raw[j] | (unsigned)(127 - j);
            SORT16(r1);
#pragma unroll
            for (int gq = 1; gq < 8; ++gq) {
#pragma unroll
                for (int j = 0; j < 16; ++j) sg[j] = raw[16 * gq + j] | (unsigned)(127 - (16 * gq + j));
                SORT16(sg); MERGE16(r1, sg); }
#pragma unroll
            for (int jq = 0; jq < 16; ++jq) { const u32x4 t4 = *(const u32x4*)(p2 + jq * 128);
#pragma unroll
                for (int c = 0; c < 4; ++c) { raw[8 * jq + 2 * c] = t4[c] << 16; raw[8 * jq + 2 * c + 1] = t4[c] & 0xffff0000u; } }
#pragma unroll
            for (int j = 0; j < 16; ++j) r2[j] = raw[j] | (unsigned)(127 - j);
            SORT16(r2);
#pragma unroll
            for (int gq = 1; gq < 8; ++gq) {
#pragma unroll
                for (int j = 0; j < 16; ++j) sg[j] = raw[16 * gq + j] | (unsigned)(127 - (16 * gq + j));
                SORT16(sg); MERGE16(r2, sg); }
        }
        float v1[16], v2[16];
#pragma unroll
        for (int i = 0; i < 16; ++i) { v1[i] = unord16(r1[i]); v2[i] = unord16(r2[i]); }
        {
            unsigned cg[4][16]; int cn = 0;
#pragma unroll
            for (int a = 0; a < 16; ++a)
#pragma unroll
                for (int bq = 0; bq < 16; ++bq) if ((a + 1) * (bq + 1) <= 16) { cg[cn >> 4][cn & 15] = (ordkey(v1[a] + v2[bq]) & ~255u) | (unsigned)(a * 16 + bq); ++cn; }
#pragma unroll
            for (int z = 50; z < 64; ++z) cg[z >> 4][z & 15] = 0u;
            SORT16(cg[0]); SORT16(cg[1]); SORT16(cg[2]); SORT16(cg[3]);
            MERGE16(cg[0], cg[1]); MERGE16(cg[0], cg[2]); MERGE16(cg[0], cg[3]);
#pragma unroll
            for (int i = 0; i < 16; ++i) rc[i] = cg[0][i];
        }
        float val[16]; int ex[16];
        {
            LAS unsigned* t1 = (LAS unsigned*)(F.lds + F.wave * 8704) + F.lane * 17; LAS unsigned* t2 = t1 + 64 * 17;
#pragma unroll
            for (int i = 0; i < 16; ++i) { t1[i] = r1[i]; t2[i] = r2[i]; }
            LDS_WAIT(); asm volatile("" ::: "memory");
#pragma unroll
            for (int w = 0; w < 16; ++w) {
                const int a = (rc[w] >> 4) & 15, bq = rc[w] & 15;
                const unsigned k1 = t1[a], k2 = t2[bq];
                val[w] = unord16(k1) + unord16(k2);
                ex[w] = (127 - (int)(k1 & 127u)) * 128 + (127 - (int)(k2 & 127u));
            }
            LDS_WAIT(); asm volatile("" ::: "memory");
        }
        float mx = val[0];
#pragma unroll
        for (int w = 1; w < 16; ++w) mx = fmaxf(mx, val[w]);
        float sum = 0.f;
#pragma unroll
        for (int w = 0; w < 16; ++w) { val[w] = __expf(val[w] - mx); sum += val[w]; }
        const float inv = 1.f / sum;
        int* ip = IDX + (size_t)tok * 128 + h * 16; float* gp = GATE + (size_t)tok * 128 + h * 16;
#pragma unroll
        for (int q = 0; q < 4; ++q) { *(int4*)(ip + 4 * q) = make_int4(ex[4 * q], ex[4 * q + 1], ex[4 * q + 2], ex[4 * q + 3]);
            *(f32x4*)(gp + 4 * q) = (f32x4){val[4 * q] * inv, val[4 * q + 1] * inv, val[4 * q + 2] * inv, val[4 * q + 3] * inv}; }
    }
}

#define DPP_ADD(v, ctrl) ((v) + __builtin_bit_cast(float, __builtin_amdgcn_mov_dpp(__builtin_bit_cast(int, (v)), (ctrl), 0xf, 0xf, true)))
__device__ __forceinline__ void fp8x16_to_f32x2(const u32x4 r, f32x2* f) {
#pragma unroll
    for (int q = 0; q < 4; ++q) { f[2 * q] = __builtin_amdgcn_cvt_pk_f32_fp8((int)r[q], false); f[2 * q + 1] = __builtin_amdgcn_cvt_pk_f32_fp8((int)r[q], true); }
}
__device__ __forceinline__ void fp8x16_to_f32(const u32x4 r, float* f) {
#pragma unroll
    for (int q = 0; q < 4; ++q) { const f32x2 lo = __builtin_amdgcn_cvt_pk_f32_fp8((int)r[q], false), hi = __builtin_amdgcn_cvt_pk_f32_fp8((int)r[q], true);
        f[4 * q] = lo.x; f[4 * q + 1] = lo.y; f[4 * q + 2] = hi.x; f[4 * q + 3] = hi.y; }
}
__device__ __forceinline__ long lo64(u32x4 v) { return (long)(((unsigned long)v.y << 32) | (unsigned long)v.x); }
__device__ __forceinline__ long hi64(u32x4 v) { return (long)(((unsigned long)v.w << 32) | (unsigned long)v.z); }
template <int MODE>
__device__ __forceinline__ void peer_u_phase(const Frame& F, const Args& A) {
    const unsigned char* X8 = A.ws + WS_N18;
    const unsigned char* U8 = A.ws + WS_U8; const float* SU = (const float*)(A.ws + WS_SU); const float* SV = (const float*)(A.ws + WS_SV);
    const int* IDX = (const int*)(A.ws + WS_P + P_IDX); const float* GATE = (const float*)(A.ws + WS_P + P_GATE); float* AK = (float*)(MODE == 0 ? A.ws + WS_AK : A.ws + WS_P + P_SC);
    const int g = F.bid & 7, nmem = F.G >> 3, l = F.lane, step = nmem * NWAVES;
    const int loff = 64 * (l & 15) + 16 * (l >> 4);
    const bool dg = ((l & 15) >> 2) == (l >> 4); const int dr = l & 3;
    const float dw0 = (dg && dr == 0) ? 1.f : 0.f, dw1 = (dg && dr == 1) ? 1.f : 0.f, dw2 = (dg && dr == 2) ? 1.f : 0.f, dw3 = (dg && dr == 3) ? 1.f : 0.f;
    LAS int* le = (LAS int*)(F.lds + F.wave * 2048); LAS int* lk = le + 256;
    const bool b5 = (l & 32) != 0, b4 = (l & 16) != 0, b3 = (l & 8) != 0;
    int tok = 2 * ((F.bid >> 3) * NWAVES + F.wave);
    u32x4 nxA, nxB; int neA0, neA1, neB0, neB1; float ngA0, ngA1, ngB0, ngB1;
#define U_PREFETCH(t) do { const size_t _tA = (size_t)(t), _tB = (size_t)(t) + 1; if (MODE == 4) { nxA = (u32x4){(unsigned)_tA, 1u, 2u, 3u}; nxB = nxA; neA0 = (int)((_tA * 37 + l * 11) & 16383); neA1 = (int)((_tA * 53 + l * 7) & 16383); neB0 = (int)((_tB * 37 + l * 13) & 16383); neB1 = (int)((_tB * 29 + l * 3) & 16383); ngA0 = ngA1 = ngB0 = ngB1 = 0.01f; break; } nxA = *(const u32x4*)(X8 + _tA * 1024 + loff); nxB = *(const u32x4*)(X8 + _tB * 1024 + loff); \
        neA0 = IDX[_tA * 128 + l]; neA1 = IDX[_tA * 128 + 64 + l]; neB0 = IDX[_tB * 128 + l]; neB1 = IDX[_tB * 128 + 64 + l]; \
        ngA0 = GATE[_tA * 128 + l]; ngA1 = GATE[_tA * 128 + 64 + l]; ngB0 = GATE[_tB * 128 + l]; ngB1 = GATE[_tB * 128 + 64 + l]; } while (0)
    if (tok + 1 < T_TOK) U_PREFETCH(tok);
    for (; tok + 1 < T_TOK; tok += 2 * step) {
        const int tokA = tok, tokB = tok + 1;
        const u32x4 xA = nxA, xB = nxB;
        const int eA0 = neA0, eA1 = neA1, eB0 = neB0, eB1 = neB1; const float gA0 = ngA0, gA1 = ngA1, gB0 = ngB0, gB1 = ngB1;
        bool pf_done = false;
        const bool oA0 = (eA0 & 7) == g, oA1 = (eA1 & 7) == g, oB0 = (eB0 & 7) == g, oB1 = (eB1 & 7) == g;
        const unsigned long long mA0 = __ballot(oA0), mA1 = __ballot(oA1), mB0 = __ballot(oB0), mB1 = __ballot(oB1);
        const int c0 = __popcll(mA0), c1 = c0 + __popcll(mA1), c2 = c1 + __popcll(mB0), n = c2 + __popcll(mB1);
#define MBC(m) __builtin_amdgcn_mbcnt_hi((unsigned)((m) >> 32), __builtin_amdgcn_mbcnt_lo((unsigned)(m), 0u))
        if (oA0) { const int p = MBC(mA0); le[p] = (eA0 << 8) | l; lk[p] = __builtin_bit_cast(int, gA0); }
        if (oA1) { const int p = c0 + MBC(mA1); le[p] = (eA1 << 8) | (64 + l); lk[p] = __builtin_bit_cast(int, gA1); }
        if (oB0) { const int p = c1 + MBC(mB0); le[p] = (eB0 << 8) | 128 | l; lk[p] = __builtin_bit_cast(int, gB0); }
        if (oB1) { const int p = c2 + MBC(mB1); le[p] = (eB1 << 8) | 128 | (64 + l); lk[p] = __builtin_bit_cast(int, gB1); }
#undef MBC
        LDS_WAIT(); asm volatile("" ::: "memory");
        for (int cb = 0; cb < n || cb == 0; cb += 64) {
        const int nc = min(n, cb + 64);
        const bool fv = (cb + l) < nc;
        const int ent = fv ? le[cb + l] : 0; const float gt = fv ? __builtin_bit_cast(float, lk[cb + l]) : 0.f; float tot = 0.f;
        const float su = SU[ent >> 8], sv = SV[ent >> 8];
        const unsigned long long radr = (unsigned long long)(U8 + (size_t)(((ent >> 8) & 7) * 2048 + (((ent >> 8) >> 3) & (MODE == 2 ? 255 : 2047))) * 1024);
        const int ralo = (int)(unsigned)radr, rahi = (int)(unsigned)(radr >> 32);
        for (int i = cb; i < nc; i += 16) {
            u32x4 row[2][8];
#pragma unroll
            for (int b = 0; b < 2; ++b) if (i + 8 * b < nc) {
#pragma unroll
                for (int j = 0; j < 8; ++j) { const int ln = min(i + 8 * b + j, nc - 1) - cb;
                    const unsigned lo = (unsigned)__builtin_amdgcn_readlane(ralo, ln), hi = (unsigned)__builtin_amdgcn_readlane(rahi, ln);
                    const GAS unsigned char* rp = (const GAS unsigned char*)(((unsigned long long)hi << 32) | lo);
                    row[b][j] = *(const GAS u32x4*)(rp + (unsigned)loff); } }
            if (!pf_done) { pf_done = true; if (tok + 2 * step + 1 < T_TOK) U_PREFETCH(tok + 2 * step); }
#pragma unroll
            for (int b = 0; b < 2; ++b) if (i + 8 * b < nc) {
                float p[8];
                f32x4 accj[8];
                const int base0 = i + 8 * b;
                if (base0 + 8 <= c1) {
#pragma unroll
                    for (int j = 0; j < 8; ++j) accj[j] = __builtin_amdgcn_mfma_f32_16x16x32_fp8_fp8(lo64(row[b][j]), lo64(xA), (f32x4){0.f, 0.f, 0.f, 0.f}, 0, 0, 0);
#pragma unroll
                    for (int j = 0; j < 8; ++j) accj[j] = __builtin_amdgcn_mfma_f32_16x16x32_fp8_fp8(hi64(row[b][j]), hi64(xA), accj[j], 0, 0, 0);
                } else if (base0 >= c1) {
#pragma unroll
                    for (int j = 0; j < 8; ++j) accj[j] = __builtin_amdgcn_mfma_f32_16x16x32_fp8_fp8(lo64(row[b][j]), lo64(xB), (f32x4){0.f, 0.f, 0.f, 0.f}, 0, 0, 0);
#pragma unroll
                    for (int j = 0; j < 8; ++j) accj[j] = __builtin_amdgcn_mfma_f32_16x16x32_fp8_fp8(hi64(row[b][j]), hi64(xB), accj[j], 0, 0, 0);
                } else {
#pragma unroll
                    for (int j = 0; j < 8; ++j) { const u32x4 xs = (base0 + j >= c1) ? xB : xA; accj[j] = __builtin_amdgcn_mfma_f32_16x16x32_fp8_fp8(lo64(row[b][j]), lo64(xs), (f32x4){0.f, 0.f, 0.f, 0.f}, 0, 0, 0);
                        accj[j] = __builtin_amdgcn_mfma_f32_16x16x32_fp8_fp8(hi64(row[b][j]), hi64(xs), accj[j], 0, 0, 0); }
                }
#pragma unroll
                for (int j = 0; j < 8; ++j) p[j] = __builtin_fmaf(accj[j][3], dw3, __builtin_fmaf(accj[j][2], dw2, __builtin_fmaf(accj[j][1], dw1, accj[j][0] * dw0)));
                float q4[4], q2[2], q1;
#pragma unroll
                for (int j = 0; j < 4; ++j) { const float keep = b5 ? p[4 + j] : p[j], send = b5 ? p[j] : p[4 + j]; q4[j] = keep + __shfl_xor(send, 32); }
#pragma unroll
                for (int j = 0; j < 2; ++j) { const float keep = b4 ? q4[2 + j] : q4[j], send = b4 ? q4[j] : q4[2 + j]; q2[j] = keep + __shfl_xor(send, 16); }
                { const float keep = b3 ? q2[1] : q2[0], send = b3 ? q2[0] : q2[1]; q1 = keep + __shfl_xor(send, 8); }
                q1 = DPP_ADD(q1, 0xB1); q1 = DPP_ADD(q1, 0x4E); q1 = DPP_ADD(q1, 0x141);
                const float t = __builtin_bit_cast(float, __builtin_amdgcn_ds_bpermute((l & 7) * 32, __builtin_bit_cast(int, q1)));
                const int base = i + 8 * b;
                if ((l >> 3) == ((base - cb) >> 3)) tot = t;
            }
        }
        if (!pf_done) { if (tok + 2 * step + 1 < T_TOK) U_PREFETCH(tok + 2 * step); }
        if (fv) { const int tk = (ent & 128) ? tokB : tokA; AK[(size_t)tk * 128 + (ent & 127)] = gelu_tanh(tot * su * (1.f / 16.f)) * gt * sv; }
        if (n == 0) break;
        }
        LDS_WAIT(); asm volatile("" ::: "memory");
    }
#undef U_PREFETCH
}
template <int MODE>
__device__ __forceinline__ void peer_u_phase1(const Frame& F, const Args& A) {
    const unsigned char* X8 = A.ws + WS_N18;
    const unsigned char* U8 = A.ws + WS_U8; const float* SU = (const float*)(A.ws + WS_SU); const float* SV = (const float*)(A.ws + WS_SV);
    const int* IDX = (const int*)(A.ws + WS_P + P_IDX); const float* GATE = (const float*)(A.ws + WS_P + P_GATE); float* AK = (float*)(MODE == 0 ? A.ws + WS_AK : A.ws + WS_P + P_SC);
    const int g = F.bid & (UNG - 1), nmem = F.G >> UNG_SH, l = F.lane, step = nmem * NWAVES;
    const int loff = 64 * (l & 15) + 16 * (l >> 4);
    const bool dg = ((l & 15) >> 2) == (l >> 4); const int dr = l & 3;
    const float dw0 = (dg && dr == 0) ? 1.f : 0.f, dw1 = (dg && dr == 1) ? 1.f : 0.f, dw2 = (dg && dr == 2) ? 1.f : 0.f, dw3 = (dg && dr == 3) ? 1.f : 0.f;
    LAS int* le = (LAS int*)(F.lds + F.wave * 2048); LAS int* lk = le + 256;
    const bool b5 = (l & 32) != 0, b4 = (l & 16) != 0, b3 = (l & 8) != 0;
    int tok = (F.bid >> UNG_SH) * NWAVES + F.wave;
    u32x4 nxA; int neA0, neA1; float ngA0, ngA1;
#define U1_PREFETCH(t) do { const size_t _tA = (size_t)(t); nxA = *(const u32x4*)(X8 + _tA * 1024 + loff); \
        neA0 = IDX[_tA * 128 + l]; neA1 = IDX[_tA * 128 + 64 + l]; ngA0 = GATE[_tA * 128 + l]; ngA1 = GATE[_tA * 128 + 64 + l]; } while (0)
    if (tok < T_TOK) U1_PREFETCH(tok);
    for (; tok < T_TOK; tok += step) {
        const u32x4 xA = nxA;
        const int eA0 = neA0, eA1 = neA1; const float gA0 = ngA0, gA1 = ngA1;
        bool pf_done = false;
        const bool oA0 = (eA0 & (UNG - 1)) == g, oA1 = (eA1 & (UNG - 1)) == g;
        const unsigned long long mA0 = __ballot(oA0), mA1 = __ballot(oA1);
        const int c0 = __popcll(mA0), n = c0 + __popcll(mA1);
#define MBC(m) __builtin_amdgcn_mbcnt_hi((unsigned)((m) >> 32), __builtin_amdgcn_mbcnt_lo((unsigned)(m), 0u))
        if (oA0) { const int p = MBC(mA0); le[p] = (eA0 << 8) | l; lk[p] = __builtin_bit_cast(int, gA0); }
        if (oA1) { const int p = c0 + MBC(mA1); le[p] = (eA1 << 8) | (64 + l); lk[p] = __builtin_bit_cast(int, gA1); }
#undef MBC
        LDS_WAIT(); asm volatile("" ::: "memory");
        for (int cb = 0; cb < n || cb == 0; cb += 64) {
        const int nc = min(n, cb + 64);
        const bool fv = (cb + l) < nc;
        const int ent = fv ? le[cb + l] : 0; const float gt = fv ? __builtin_bit_cast(float, lk[cb + l]) : 0.f; float tot = 0.f;
        const float su = SU[ent >> 8], sv = SV[ent >> 8];
        const unsigned long long radr = (unsigned long long)(U8 + (size_t)(((ent >> 8) & (UNG - 1)) * (NEXP / UNG) + ((ent >> 8) >> UNG_SH)) * 1024);
        const int ralo = (int)(unsigned)radr, rahi = (int)(unsigned)(radr >> 32);
        for (int i = cb; i < nc; i += 16) {
            u32x4 row[2][8];
#pragma unroll
            for (int b = 0; b < 2; ++b) if (i + 8 * b < nc) {
#pragma unroll
                for (int j = 0; j < 8; ++j) { const int ln = min(i + 8 * b + j, nc - 1) - cb;
                    const unsigned lo = (unsigned)__builtin_amdgcn_readlane(ralo, ln), hi = (unsigned)__builtin_amdgcn_readlane(rahi, ln);
                    const GAS unsigned char* rp = (const GAS unsigned char*)(((unsigned long long)hi << 32) | lo);
                    row[b][j] = *(const GAS u32x4*)(rp + (unsigned)loff); } }
            if (!pf_done) { pf_done = true; if (tok + step < T_TOK) U1_PREFETCH(tok + step); }
#pragma unroll
            for (int b = 0; b < 2; ++b) if (i + 8 * b < nc) {
                float p[8]; f32x4 accj[8];
#pragma unroll
                for (int j = 0; j < 8; ++j) accj[j] = __builtin_amdgcn_mfma_f32_16x16x32_fp8_fp8(lo64(row[b][j]), lo64(xA), (f32x4){0.f, 0.f, 0.f, 0.f}, 0, 0, 0);
#pragma unroll
                for (int j = 0; j < 8; ++j) accj[j] = __builtin_amdgcn_mfma_f32_16x16x32_fp8_fp8(hi64(row[b][j]), hi64(xA), accj[j], 0, 0, 0);
#pragma unroll
                for (int j = 0; j < 8; ++j) p[j] = __builtin_fmaf(accj[j][3], dw3, __builtin_fmaf(accj[j][2], dw2, __builtin_fmaf(accj[j][1], dw1, accj[j][0] * dw0)));
                float q4[4], q2[2], q1;
#pragma unroll
                for (int j = 0; j < 4; ++j) { const float keep = b5 ? p[4 + j] : p[j], send = b5 ? p[j] : p[4 + j]; q4[j] = keep + __shfl_xor(send, 32); }
#pragma unroll
                for (int j = 0; j < 2; ++j) { const float keep = b4 ? q4[2 + j] : q4[j], send = b4 ? q4[j] : q4[2 + j]; q2[j] = keep + __shfl_xor(send, 16); }
                { const float keep = b3 ? q2[1] : q2[0], send = b3 ? q2[0] : q2[1]; q1 = keep + __shfl_xor(send, 8); }
                q1 = DPP_ADD(q1, 0xB1); q1 = DPP_ADD(q1, 0x4E); q1 = DPP_ADD(q1, 0x141);
                const float t = __builtin_bit_cast(float, __builtin_amdgcn_ds_bpermute((l & 7) * 32, __builtin_bit_cast(int, q1)));
                const int base = i + 8 * b;
                if ((l >> 3) == ((base - cb) >> 3)) tot = t;
            }
        }
        if (!pf_done) { pf_done = true; if (tok + step < T_TOK) U1_PREFETCH(tok + step); }
        if (fv) AK[(size_t)tok * 128 + (ent & 127)] = gelu_tanh(tot * su * (1.f / 16.f)) * gt * sv;
        if (n == 0) break;
        }
        LDS_WAIT(); asm volatile("" ::: "memory");
    }
#undef U1_PREFETCH
}
template <int MODE>
__device__ __forceinline__ void peer_u4_phase(const Frame& F, const Args& A) {
    const unsigned char* X8 = A.ws + WS_N18;
    const float* SU = (const float*)(A.ws + WS_SU); const float* SV = (const float*)(A.ws + WS_SV);
    const int* IDX = (const int*)(A.ws + WS_P + P_IDX); const float* GATE = (const float*)(A.ws + WS_P + P_GATE); float* AK = (float*)(MODE == 0 ? A.ws + WS_AK : A.ws + WS_P + P_SC);
    const int g = F.bid & (UNG - 1), nmem = F.G >> UNG_SH, l = F.lane, step = nmem * NWAVES;
    const int m = l & 15, q = l >> 4;
    const GAS unsigned char* ub = (const GAS unsigned char*)(A.ws + WS_U8 + (size_t)g * (NEXP / UNG) * 512);
    const unsigned lconst = 16u * (unsigned)(4 * (m & 7) + q);
    const int xoff = 128 * (m & 7) + 16 * q;
    const bool dg = (m < 8) && ((m >> 2) == (q & 1)); const int dr = m & 3;
    const float dw0 = (dg && dr == 0) ? 1.f : 0.f, dw1 = (dg && dr == 1) ? 1.f : 0.f, dw2 = (dg && dr == 2) ? 1.f : 0.f, dw3 = (dg && dr == 3) ? 1.f : 0.f;
    const int rsel = 4 * (m >> 3);
    const int osrc = 4 * (32 * (l & 1) + 4 * ((l & 15) >> 1));
    const int sc1 = 0x7F7F7F7F;
    LAS int* le = (LAS int*)(F.lds + F.wave * 2048); LAS int* lk = le + 256;
    const bool b4 = (l & 16) != 0, b3 = (l & 8) != 0, b2 = (l & 4) != 0;
    int tok = (F.bid >> UNG_SH) * NWAVES + F.wave;
    u32x4 nx0, nx1; int ne0, ne1; float ng0, ng1;
#define U4_PREFETCH(t) do { const size_t _t = (size_t)(t); nx0 = *(const u32x4*)(X8 + _t * 1024 + xoff); nx1 = *(const u32x4*)(X8 + _t * 1024 + xoff + 64); \
        ne0 = IDX[_t * 128 + l]; ne1 = IDX[_t * 128 + 64 + l]; ng0 = GATE[_t * 128 + l]; ng1 = GATE[_t * 128 + 64 + l]; } while (0)
    if (tok < T_TOK) U4_PREFETCH(tok);
    for (; tok < T_TOK; tok += step) {
        const i32x8 xb = __builtin_shufflevector(__builtin_bit_cast(i32x4, nx0), __builtin_bit_cast(i32x4, nx1), 0, 1, 2, 3, 4, 5, 6, 7);
        const int e0 = ne0, e1 = ne1; const float g0 = ng0, g1 = ng1;
        bool pf_done = false;
        const bool o0 = (e0 & (UNG - 1)) == g, o1 = (e1 & (UNG - 1)) == g;
        const unsigned long long m0 = __ballot(o0), m1 = __ballot(o1);
        const int c0 = __popcll(m0), n = c0 + __popcll(m1);
#define MBC(mm) __builtin_amdgcn_mbcnt_hi((unsigned)((mm) >> 32), __builtin_amdgcn_mbcnt_lo((unsigned)(mm), 0u))
        if (o0) { const int p = MBC(m0); le[p] = (e0 << 8) | l; lk[p] = __builtin_bit_cast(int, g0); }
        if (o1) { const int p = c0 + MBC(m1); le[p] = (e1 << 8) | (64 + l); lk[p] = __builtin_bit_cast(int, g1); }
#undef MBC
        LDS_WAIT(); asm volatile("" ::: "memory");
        for (int cb = 0; cb < n || cb == 0; cb += 64) {
            const int nc = min(n, cb + 64);
            const bool fv = (cb + l) < nc;
            const int ent = fv ? le[cb + l] : 0; const float gt = fv ? __builtin_bit_cast(float, lk[cb + l]) : 0.f; float tot = 0.f;
            const float su = SU[ent >> 8], sv = SV[ent >> 8];
            const int roff = fv ? ((ent >> 8) >> UNG_SH) * 512 : 0;
            for (int i = cb; i < nc; i += 32) {
                u32x4 row[2][8];
#pragma unroll
                for (int b = 0; b < 2; ++b) if (i + 16 * b < nc) {
#pragma unroll
                    for (int j = 0; j < 8; ++j) { const int ro = __builtin_amdgcn_ds_bpermute(rsel + 4 * (i - cb + 16 * b + 2 * j), roff);
                        row[b][j] = *(const GAS u32x4*)(ub + ((unsigned)ro + lconst)); } }
                if (!pf_done) { pf_done = true; if (tok + step < T_TOK) U4_PREFETCH(tok + step); }
#pragma unroll
                for (int b = 0; b < 2; ++b) if (i + 16 * b < nc) {
                    float p[8];
#pragma unroll
                    for (int j = 0; j < 8; ++j) { const i32x4 r4 = __builtin_bit_cast(i32x4, row[b][j]);
                        const f32x4 d = __builtin_amdgcn_mfma_scale_f32_16x16x128_f8f6f4(__builtin_shufflevector(r4, r4, 0, 1, 2, 3, -1, -1, -1, -1), xb, (f32x4){0.f, 0.f, 0.f, 0.f}, 4, 0, 0, sc1, 0, sc1);
                        p[j] = __builtin_fmaf(d[3], dw3, __builtin_fmaf(d[2], dw2, __builtin_fmaf(d[1], dw1, d[0] * dw0))); }
                    float q4[4], q2[2], q1;
#pragma unroll
                    for (int j = 0; j < 4; ++j) { const float keep = b4 ? p[4 + j] : p[j], send = b4 ? p[j] : p[4 + j]; q4[j] = keep + __shfl_xor(send, 16); }
#pragma unroll
                    for (int j = 0; j < 2; ++j) { const float keep = b3 ? q4[2 + j] : q4[j], send = b3 ? q4[j] : q4[2 + j]; q2[j] = keep + __shfl_xor(send, 8); }
                    { const float keep = b2 ? q2[1] : q2[0], send = b2 ? q2[0] : q2[1]; q1 = keep + __shfl_xor(send, 4); }
                    q1 = DPP_ADD(q1, 0xB1); q1 = DPP_ADD(q1, 0x4E);
                    const float t = __builtin_bit_cast(float, __builtin_amdgcn_ds_bpermute(osrc, __builtin_bit_cast(int, q1)));
                    if ((l >> 4) == ((i - cb + 16 * b) >> 4)) tot = t;
                }
            }
            if (!pf_done) { pf_done = true; if (tok + step < T_TOK) U4_PREFETCH(tok + step); }
            if (fv) AK[(size_t)tok * 128 + (ent & 127)] = gelu_tanh(tot * su * (1.f / 16.f)) * gt * sv;
            if (n == 0) break;
        }
        LDS_WAIT(); asm volatile("" ::: "memory");
    }
#undef U4_PREFETCH
}
template <int MODE>
__device__ __forceinline__ void peer_u4_all(const Frame& F, const Args& A) {
    const unsigned char* X8 = A.ws + WS_N18;
    const float* SU = (const float*)(A.ws + WS_SU); const float* SV = (const float*)(A.ws + WS_SV);
    const int* IDX = (const int*)(A.ws + WS_P + P_IDX); const float* GATE = (const float*)(A.ws + WS_P + P_GATE); float* AK = (float*)(MODE == 0 ? A.ws + WS_AK : A.ws + WS_P + P_SC);
    const int l = F.lane, step = F.G * NWAVES;
    const int m = l & 15, q = l >> 4;
    const GAS unsigned char* ub = (const GAS unsigned char*)(A.ws + WS_U8);
    const unsigned lconst = 16u * (unsigned)(8 * q + (m & 7));
    const int xoff = 256 * (q >> 1) + 32 * (m & 7) + 16 * (q & 1);
    const bool dg = (m < 8) && ((m >> 2) == (q & 1)); const int dr = m & 3;
    const float dw0 = (dg && dr == 0) ? 1.f : 0.f, dw1 = (dg && dr == 1) ? 1.f : 0.f, dw2 = (dg && dr == 2) ? 1.f : 0.f, dw3 = (dg && dr == 3) ? 1.f : 0.f;
    const int rsel = 4 * (m >> 3);
    const int osrc = 4 * (32 * (l & 1) + 4 * ((l & 15) >> 1));
    const int sc1 = 0x7F7F7F7F;
    const bool b4 = (l & 16) != 0, b3 = (l & 8) != 0, b2 = (l & 4) != 0;
    const int lhi = l >> 4;
    int tok = F.bid * NWAVES + F.wave;
    u32x4 nx0, nx1; int ne0, ne1; float ng0, ng1, nrss;
    const float* RSS = (const float*)(A.ws + WS_RSS);
#define UA_PREFETCH(t) do { const size_t _t = (size_t)(t); nx0 = __builtin_nontemporal_load((const u32x4*)(X8 + _t * 1024 + xoff)); nx1 = __builtin_nontemporal_load((const u32x4*)(X8 + _t * 1024 + xoff + 512)); \
        ne0 = __builtin_nontemporal_load(IDX + _t * 128 + l); ne1 = __builtin_nontemporal_load(IDX + _t * 128 + 64 + l); ng0 = __builtin_nontemporal_load(GATE + _t * 128 + l); ng1 = __builtin_nontemporal_load(GATE + _t * 128 + 64 + l); nrss = RSS[_t]; } while (0)
#define UA_LOADS(R, ro_, h) do { _Pragma("unroll") for (int j_ = 0; j_ < 16; ++j_) { const int o_ = __builtin_amdgcn_ds_bpermute(rsel + 4 * (32 * (h) + 2 * j_), (ro_)); \
        R[j_] = *(const GAS u32x4*)(ub + ((unsigned)o_ + lconst)); } } while (0)
#define UA_COMPUTE(R, xb_, h, tot_) do { _Pragma("unroll") for (int b_ = 0; b_ < 2; ++b_) { float p_[8]; \
        _Pragma("unroll") for (int j_ = 0; j_ < 8; ++j_) { const i32x4 r4_ = __builtin_bit_cast(i32x4, R[8 * b_ + j_]); \
            const f32x4 d_ = __builtin_amdgcn_mfma_scale_f32_16x16x128_f8f6f4(__builtin_shufflevector(r4_, r4_, 0, 1, 2, 3, -1, -1, -1, -1), (xb_), (f32x4){0.f, 0.f, 0.f, 0.f}, 4, 0, 0, sc1, 0, sc1); \
            p_[j_] = __builtin_fmaf(d_[3], dw3, __builtin_fmaf(d_[2], dw2, __builtin_fmaf(d_[1], dw1, d_[0] * dw0))); } \
        float q4_[4], q2_[2], q1_; \
        _Pragma("unroll") for (int j_ = 0; j_ < 4; ++j_) { const float keep_ = b4 ? p_[4 + j_] : p_[j_], send_ = b4 ? p_[j_] : p_[4 + j_]; q4_[j_] = keep_ + __shfl_xor(send_, 16); } \
        _Pragma("unroll") for (int j_ = 0; j_ < 2; ++j_) { const float keep_ = b3 ? q4_[2 + j_] : q4_[j_], send_ = b3 ? q4_[j_] : q4_[2 + j_]; q2_[j_] = keep_ + __shfl_xor(send_, 8); } \
        { const float keep_ = b2 ? q2_[1] : q2_[0], send_ = b2 ? q2_[0] : q2_[1]; q1_ = keep_ + __shfl_xor(send_, 4); } \
        q1_ = DPP_ADD(q1_, 0xB1); q1_ = DPP_ADD(q1_, 0x4E); \
        const float t_ = __builtin_bit_cast(float, __builtin_amdgcn_ds_bpermute(osrc, __builtin_bit_cast(int, q1_))); \
        if (lhi == 2 * (h) + b_) (tot_) = t_; } } while (0)
    u32x4 RA[16], RB[16];
    if (tok < T_TOK) { UA_PREFETCH(tok); UA_LOADS(RA, ne0 * 512, 0); }
    for (; tok < T_TOK; tok += step) {
        const i32x8 xb = __builtin_shufflevector(__builtin_bit_cast(i32x4, nx0), __builtin_bit_cast(i32x4, nx1), 0, 1, 2, 3, 4, 5, 6, 7);
        const int e0 = ne0, e1 = ne1; const float g0 = ng0, g1 = ng1;
        const float rs16 = (1.f / 16.f) / sqrtf(nrss * (1.f / D) + EPS);
        const int ro0 = e0 * 512, ro1 = e1 * 512;
        const float su0 = SU[e0], sv0 = SV[e0], su1 = SU[e1], sv1 = SV[e1];
        const bool more = tok + step < T_TOK;
        float tot0 = 0.f, tot1 = 0.f;
        UA_LOADS(RB, ro0, 1);
        if (more) UA_PREFETCH(tok + step);
        UA_COMPUTE(RA, xb, 0, tot0);
        UA_LOADS(RA, ro1, 0);
        UA_COMPUTE(RB, xb, 1, tot0);
        UA_LOADS(RB, ro1, 1);
        UA_COMPUTE(RA, xb, 0, tot1);
        if (more) UA_LOADS(RA, ne0 * 512, 0);
        UA_COMPUTE(RB, xb, 1, tot1);
        __builtin_nontemporal_store(gelu_tanh(tot0 * su0 * rs16) * g0 * sv0, AK + (size_t)tok * 128 + l);
        __builtin_nontemporal_store(gelu_tanh(tot1 * su1 * rs16) * g1 * sv1, AK + (size_t)tok * 128 + 64 + l);
    }
#undef UA_PREFETCH
#undef UA_LOADS
#undef UA_COMPUTE
}
__device__ __forceinline__ float wave_max_nonneg(float v) {
    unsigned u = __builtin_bit_cast(unsigned, v);
    u = max(u, (unsigned)__builtin_amdgcn_mov_dpp((int)u, 0xB1, 0xf, 0xf, true));
    u = max(u, (unsigned)__builtin_amdgcn_mov_dpp((int)u, 0x4E, 0xf, 0xf, true));
    u = max(u, (unsigned)__builtin_amdgcn_mov_dpp((int)u, 0x141, 0xf, 0xf, true));
    u = max(u, (unsigned)__builtin_amdgcn_mov_dpp((int)u, 0x140, 0xf, 0xf, true));
    const unsigned a = (unsigned)__builtin_amdgcn_readlane((int)u, 0), b = (unsigned)__builtin_amdgcn_readlane((int)u, 16), c = (unsigned)__builtin_amdgcn_readlane((int)u, 32), d = (unsigned)__builtin_amdgcn_readlane((int)u, 48);
    return __builtin_bit_cast(float, max(max(a, b), max(c, d)));
}
template <int MODE>
__device__ __forceinline__ void peer_v_phase(const Frame& F, const Args& A) {
    const unsigned char* V8 = A.ws + WS_V8; const int* IDX = (const int*)(A.ws + WS_P + P_IDX); const float* AK = (const float*)(A.ws + WS_AK);
    float* out = MODE == 0 ? A.out : (float*)(A.ws + WS_P + P_SC);
    const int g = F.bid & 7, nmem = F.G >> 3, l = F.lane, sub = l & 7, rr = l >> 3, n16 = l & 15, q = l >> 4, step = nmem * NWAVES;
    const GAS unsigned char* vb = (const GAS unsigned char*)(V8 + (size_t)g * NEXP * 128);
    LAS unsigned long long* rep = (LAS unsigned long long*)(F.lds + F.wave * 2048);
    const unsigned long long bm = 0xFFull << (8 * (n16 & 7));
    const int repi = 2 * q + (n16 >> 3);
    const bool vl = (n16 < 8) && (q < 2);
    LAS float* stg = (LAS float*)(F.lds + 16384 + F.wave * 512);
    int tok = 2 * ((F.bid >> 3) * NWAVES + F.wave);
    int ne[4]; float na[4];
#define V_PREFETCH(t) do { const size_t _a = (size_t)(t) * 128, _b = ((size_t)(t) + 1) * 128; ne[0] = IDX[_a + l]; ne[1] = IDX[_a + 64 + l]; ne[2] = IDX[_b + l]; ne[3] = IDX[_b + 64 + l]; \
        na[0] = AK[_a + l]; na[1] = AK[_a + 64 + l]; na[2] = AK[_b + l]; na[3] = AK[_b + 64 + l]; } while (0)
    if (tok + 1 < T_TOK) V_PREFETCH(tok);
    for (; tok + 1 < T_TOK; tok += 2 * step) {
        const int e0 = ne[0], e1 = ne[1], e2 = ne[2], e3 = ne[3]; const float a0 = na[0], a1 = na[1], a2 = na[2], a3 = na[3];
        u32x4 rowA[16], rowB[16];
#pragma unroll
        for (int i = 0; i < 16; ++i) { const int src = (8 * (i & 7) + rr) * 4;
            const int ea = __builtin_amdgcn_ds_bpermute(src, i < 8 ? e0 : e1), eb = __builtin_amdgcn_ds_bpermute(src, i < 8 ? e2 : e3);
            rowA[i] = *(const GAS u32x4*)(vb + ((unsigned)ea * 128u + 16u * (unsigned)sub)); rowB[i] = *(const GAS u32x4*)(vb + ((unsigned)eb * 128u + 16u * (unsigned)sub)); }
        f32x4 HA = {0.f, 0.f, 0.f, 0.f}, HB = {0.f, 0.f, 0.f, 0.f};
        if (l < 32) { const float* hpa = out + (size_t)tok * D + g * 128 + 4 * l; HA = *(const f32x4*)hpa; HB = *(const f32x4*)(hpa + D); }
        if (tok + 2 * step + 1 < T_TOK) V_PREFETCH(tok + 2 * step);
        const float amA = wave_max_nonneg(fmaxf(fabsf(a0), fabsf(a1))), amB = wave_max_nonneg(fmaxf(fabsf(a2), fabsf(a3)));
        const float scA = amA > 0.f ? 224.f * __builtin_amdgcn_rcpf(amA) : 0.f, invA = amA * (1.f / 224.f), scB = amB > 0.f ? 224.f * __builtin_amdgcn_rcpf(amB) : 0.f, invB = amB * (1.f / 224.f);
        { const unsigned wA = (unsigned)__builtin_amdgcn_cvt_pk_fp8_f32(a0 * scA, a1 * scA, 0, false), wB = (unsigned)__builtin_amdgcn_cvt_pk_fp8_f32(a2 * scB, a3 * scB, 0, false);
          const unsigned r0 = (wA & 0xffu) * 0x01010101u, r1 = ((wA >> 8) & 0xffu) * 0x01010101u, r2 = (wB & 0xffu) * 0x01010101u, r3 = ((wB >> 8) & 0xffu) * 0x01010101u;
          rep[l] = ((unsigned long long)r0 << 32) | r0; rep[64 + l] = ((unsigned long long)r1 << 32) | r1; rep[128 + l] = ((unsigned long long)r2 << 32) | r2; rep[192 + l] = ((unsigned long long)r3 << 32) | r3; }
        LDS_WAIT(); asm volatile("" ::: "memory");
#pragma unroll
        for (int t2 = 0; t2 < 2; ++t2) {
            f32x4 alo = {0.f, 0.f, 0.f, 0.f}, ahi = {0.f, 0.f, 0.f, 0.f};
#pragma unroll
            for (int i = 0; i < 16; ++i) { const long bop = (long)(rep[128 * t2 + 8 * i + repi] & bm); const u32x4 rw = t2 ? rowB[i] : rowA[i];
                alo = __builtin_amdgcn_mfma_f32_16x16x32_fp8_fp8(lo64(rw), bop, alo, 0, 0, 0);
                ahi = __builtin_amdgcn_mfma_f32_16x16x32_fp8_fp8(hi64(rw), bop, ahi, 0, 0, 0); }
            const float inv = t2 ? invB : invA;
            float vlo[4], vhi[4];
#pragma unroll
            for (int r = 0; r < 4; ++r) { const float tl = alo[r], th = ahi[r];
                vlo[r] = (tl + __builtin_bit_cast(float, __builtin_amdgcn_ds_bpermute(((l + 40) & 63) * 4, __builtin_bit_cast(int, tl)))) * inv;
                vhi[r] = (th + __builtin_bit_cast(float, __builtin_amdgcn_ds_bpermute(((l + 40) & 63) * 4, __builtin_bit_cast(int, th)))) * inv; }
            if (vl) {
#pragma unroll
                for (int r = 0; r < 4; ++r) { stg[64 * q + 16 * r + n16] = vlo[r]; stg[64 * q + 16 * r + n16 + 8] = vhi[r]; } }
            LDS_WAIT(); asm volatile("" ::: "memory");
            if (l < 32) { const f32x4 dv = *(const LAS f32x4*)(stg + 4 * l); *(f32x4*)(out + (size_t)(tok + t2) * D + g * 128 + 4 * l) = (t2 ? HB : HA) + dv; }
            LDS_WAIT(); asm volatile("" ::: "memory");
        }
        LDS_WAIT(); asm volatile("" ::: "memory");
    }
#undef V_PREFETCH
}
typedef float f32x16 __attribute__((ext_vector_type(16)));
template <int MODE>
__device__ __forceinline__ void peer_v4_phase(const Frame& F, const Args& A) {
    const int* IDX = (const int*)(A.ws + WS_P + P_IDX); const float* AK = (const float*)(A.ws + WS_AK);
    float* out = A.out;
    const int l = F.lane, n = l & 31, hq = l >> 5, step = F.G * NWAVES;
    const GAS unsigned char* vb = (const GAS unsigned char*)(A.ws + WS_V8);
    const unsigned lconst = 16u * (unsigned)n;
    const bool diag = ((l >> 4) & 1) == hq;
    const unsigned bytem = diag ? (0xFFu << (8 * (l & 3))) : 0u; const int dsel = (l & 15) >> 2;
    const unsigned M0 = dsel == 0 ? bytem : 0u, M1 = dsel == 1 ? bytem : 0u, M2 = dsel == 2 ? bytem : 0u, M3 = dsel == 3 ? bytem : 0u;
    const int rsel = 4 * hq;
    const int sc1 = 0x7F7F7F7F;
    const int colb = 8 * n + 4 * hq;
    int tok = F.bid * NWAVES + F.wave;
    int ne0, ne1; float na0, na1;
#define V4_PREFETCH(t) do { const size_t _t = (size_t)(t) * 128; ne0 = __builtin_nontemporal_load(IDX + _t + l); ne1 = __builtin_nontemporal_load(IDX + _t + 64 + l); na0 = __builtin_nontemporal_load(AK + _t + l); na1 = __builtin_nontemporal_load(AK + _t + 64 + l); } while (0)
#define V4_LOADS(R, ro_, h) do { int ba_ = rsel + 4 * (16 * (h)); _Pragma("unroll") for (int j_ = 0; j_ < 8; ++j_) { asm volatile("" : "+v"(ba_)); const int o_ = __builtin_amdgcn_ds_bpermute(ba_, (ro_)); ba_ += 8; \
        R[j_] = *(const GAS u32x4*)(vb + ((unsigned)o_ + lconst)); } } while (0)
#define V4_ONE(ACC, R, rep_, h, j_) do { unsigned s0_ = (unsigned)__builtin_amdgcn_readlane((int)(rep_), 16 * (h) + 2 * (j_)), s1_ = (unsigned)__builtin_amdgcn_readlane((int)(rep_), 16 * (h) + 2 * (j_) + 1); \
        asm volatile("" : "+s"(s0_), "+s"(s1_), "+v"(ACC)); \
        const i32x8 a8_ = {(int)(s0_ & M0), (int)(s0_ & M1), (int)(s0_ & M2), (int)(s0_ & M3), (int)(s1_ & M0), (int)(s1_ & M1), (int)(s1_ & M2), (int)(s1_ & M3)}; \
        const i32x4 r4_ = __builtin_bit_cast(i32x4, R[j_]); \
        ACC = __builtin_amdgcn_mfma_scale_f32_32x32x64_f8f6f4(a8_, __builtin_shufflevector(r4_, r4_, 0, 1, 2, 3, -1, -1, -1, -1), ACC, 0, 4, 0, sc1, 0, sc1); } while (0)
#define V4_COMPUTE(R, rep_, h) do { V4_ONE(acc, R, rep_, h, 0); V4_ONE(acc1, R, rep_, h, 1); V4_ONE(acc, R, rep_, h, 2); V4_ONE(acc1, R, rep_, h, 3); \
        V4_ONE(acc, R, rep_, h, 4); V4_ONE(acc1, R, rep_, h, 5); V4_ONE(acc, R, rep_, h, 6); V4_ONE(acc1, R, rep_, h, 7); } while (0)
    u32x4 RA[8], RB[8];
    if (tok < T_TOK) { V4_PREFETCH(tok); V4_LOADS(RA, ne0 * 512, 0); }
    for (; tok < T_TOK; tok += step) {
        const int e0 = ne0, e1 = ne1; const float a0 = na0, a1 = na1;
        const int ro0 = e0 * 512, ro1 = e1 * 512;
        const bool more = tok + step < T_TOK;
        V4_LOADS(RB, ro0, 1);
        if (more) V4_PREFETCH(tok + step);
        const float am = wave_max_nonneg(fmaxf(fabsf(a0), fabsf(a1)));
        const float sc = am > 0.f ? 224.f * __builtin_amdgcn_rcpf(am) : 0.f, inv = am * (1.f / 224.f);
        const unsigned w8 = (unsigned)__builtin_amdgcn_cvt_pk_fp8_f32(a0 * sc, a1 * sc, 0, false);
        const unsigned rep0 = (w8 & 0xffu) * 0x01010101u, rep1 = ((w8 >> 8) & 0xffu) * 0x01010101u;
        f32x16 acc, acc1;
#pragma unroll
        for (int i = 0; i < 16; ++i) { acc[i] = 0.f; acc1[i] = 0.f; }
        V4_COMPUTE(RA, rep0, 0); V4_LOADS(RA, ro0, 2);
        V4_COMPUTE(RB, rep0, 1); V4_LOADS(RB, ro0, 3);
        V4_COMPUTE(RA, rep0, 2); V4_LOADS(RA, ro1, 0);
        V4_COMPUTE(RB, rep0, 3); V4_LOADS(RB, ro1, 1);
        V4_COMPUTE(RA, rep1, 0); V4_LOADS(RA, ro1, 2);
        V4_COMPUTE(RB, rep1, 1); V4_LOADS(RB, ro1, 3);
        f32x4 H[4];
        u32x2 MX[4];
        { const bf16_t* mp = (const bf16_t*)(A.ws + WS_N1) + (size_t)tok * D + colb;
#pragma unroll
          for (int j = 0; j < 4; ++j) MX[j] = __builtin_nontemporal_load((const u32x2*)(mp + 256 * j)); }
        V4_COMPUTE(RA, rep1, 2);
        if (more) V4_LOADS(RA, ne0 * 512, 0);
        V4_COMPUTE(RB, rep1, 3);
        acc = acc + acc1;
        float ss = 0.f;
#pragma unroll
        for (int j = 0; j < 4; ++j) { H[j] = (f32x4){bflo(MX[j].x), bfhi(MX[j].x), bflo(MX[j].y), bfhi(MX[j].y)} + (f32x4){acc[4 * j], acc[4 * j + 1], acc[4 * j + 2], acc[4 * j + 3]} * inv;
            ss += (H[j].x * H[j].x + H[j].y * H[j].y) + (H[j].z * H[j].z + H[j].w * H[j].w); }
        const float rstd = 1.f / sqrtf(wave_sum(ss) * (1.f / D) + EPS);
        { float* hp = out + (size_t)tok * D + colb;
#pragma unroll
          for (int j = 0; j < 4; ++j) __builtin_nontemporal_store(H[j] * rstd * *(const f32x4*)(A.in[I_FG] + colb + 256 * j), (f32x4*)(hp + 256 * j)); }
    }
#undef V4_PREFETCH
#undef V4_LOADS
#undef V4_COMPUTE
#undef V4_ONE
}
__device__ __forceinline__ void final_norm_phase(const Frame& F, const Args& A) {
    const int gw = F.bid * NWAVES + F.wave, NGW = F.G * NWAVES, l = F.lane; const float* fg = A.in[I_FG];
    const f32x4* gp = (const f32x4*)fg + l;
    int tok = gw;
    for (; tok + 3 * NGW < T_TOK; tok += 4 * NGW) {
        f32x4 v[4][4]; float ss[4];
#pragma unroll
        for (int b = 0; b < 4; ++b) { const f32x4* hp = (const f32x4*)(A.out + (size_t)(tok + b * NGW) * D) + l;
#pragma unroll
            for (int j = 0; j < 4; ++j) v[b][j] = hp[64 * j]; }
#pragma unroll
        for (int b = 0; b < 4; ++b) { ss[b] = 0.f;
#pragma unroll
            for (int j = 0; j < 4; ++j) ss[b] += (v[b][j].x * v[b][j].x + v[b][j].y * v[b][j].y) + (v[b][j].z * v[b][j].z + v[b][j].w * v[b][j].w); }
#pragma unroll
        for (int o = 1; o < 64; o <<= 1) {
#pragma unroll
            for (int b = 0; b < 4; ++b) ss[b] += __shfl_xor(ss[b], o); }
#pragma unroll
        for (int b = 0; b < 4; ++b) { const float rstd = 1.f / sqrtf(ss[b] * (1.f / D) + EPS); f32x4* hp = (f32x4*)(A.out + (size_t)(tok + b * NGW) * D) + l;
#pragma unroll
            for (int j = 0; j < 4; ++j) hp[64 * j] = v[b][j] * rstd * gp[64 * j]; }
    }
    for (; tok < T_TOK; tok += NGW) { f32x4* hp = (f32x4*)(A.out + (size_t)tok * D) + l; f32x4 v[4]; float ss = 0.f;
#pragma unroll
        for (int j = 0; j < 4; ++j) { v[j] = hp[64 * j]; ss += (v[j].x * v[j].x + v[j].y * v[j].y) + (v[j].z * v[j].z + v[j].w * v[j].w); }
        const float rstd = 1.f / sqrtf(wave_sum(ss) * (1.f / D) + EPS);
#pragma unroll
        for (int j = 0; j < 4; ++j) hp[64 * j] = v[j] * rstd * gp[64 * j]; }
}

#ifdef DEBUG_CHECK
constexpr size_t WS_DBG = 472 * MiB;
__device__ __forceinline__ int dbg_tok(int i) { return (i * 509 + 3) & 32767; }
__device__ __forceinline__ float gelu_ref(float x) { return 0.5f * x * (1.f + tanhf(0.7978845608028654f * (x + 0.044715f * x * x * x))); }
__global__ void __launch_bounds__(512) dbg_scores(Args a) {
    __shared__ float n2s[1024]; __shared__ float q[2048];
    const int t = dbg_tok(blockIdx.x), tid = threadIdx.x;
    const bf16_t* N2 = (const bf16_t*)(a.ws + WS_N1); const float* SC = (const float*)(a.ws + WS_P + P_SC); unsigned* dbg = (unsigned*)(a.ws + WS_DBG);
    for (int k = tid; k < 1024; k += 512) n2s[k] = bf1(N2[(size_t)t * 1024 + k]);
    __syncthreads();
    for (int r = 0; r < 4; ++r) { const int c = tid + 512 * r; float s = 0.f; for (int k = 0; k < 1024; ++k) s += n2s[k] * a.in[I_WQ][(size_t)k * 2048 + c]; q[c] = s; }
    __syncthreads();
    float md = 0.f;
    for (int r = 0; r < 4; ++r) { const int n = tid + 512 * r, hh = n >> 7, key = n & 127; const float* kX = (hh & 1) ? a.in[I_K2] : a.in[I_K1];
        float s = 0.f; for (int d = 0; d < 128; ++d) s += q[hh * 128 + d] * kX[key * 128 + d];
        md = fmaxf(md, fabsf(s - SC[(size_t)n * T_TOK + t])); }
    atomicMax(&dbg[0], __builtin_bit_cast(unsigned, md));
}
__global__ void __launch_bounds__(64) dbg_topk(Args a) {
    __shared__ float s1[8][128], s2[8][128], cv[8][256]; __shared__ float t1v[8][16], t2v[8][16]; __shared__ int t1i[8][16], t2i[8][16], exi[8][16]; __shared__ float exv[8][16];
    const int t = dbg_tok(blockIdx.x), h = threadIdx.x;
    const float* SC = (const float*)(a.ws + WS_P + P_SC); const int* IDX = (const int*)(a.ws + WS_P + P_IDX); const float* GATE = (const float*)(a.ws + WS_P + P_GATE); unsigned* dbg = (unsigned*)(a.ws + WS_DBG);
    if (h >= 8) return;
    for (int j = 0; j < 128; ++j) { s1[h][j] = SC[(size_t)(h * 256 + j) * T_TOK + t]; s2[h][j] = SC[(size_t)(h * 256 + 128 + j) * T_TOK + t]; }
    for (int r = 0; r < 16; ++r) { int b1 = 0, b2 = 0; for (int j = 1; j < 128; ++j) { if (s1[h][j] > s1[h][b1]) b1 = j; if (s2[h][j] > s2[h][b2]) b2 = j; }
        t1v[h][r] = s1[h][b1]; t1i[h][r] = b1; s1[h][b1] = -1e30f; t2v[h][r] = s2[h][b2]; t2i[h][r] = b2; s2[h][b2] = -1e30f; }
    for (int c = 0; c < 256; ++c) cv[h][c] = t1v[h][c >> 4] + t2v[h][c & 15];
    for (int r = 0; r < 16; ++r) { int bc = 0; for (int c = 1; c < 256; ++c) if (cv[h][c] > cv[h][bc]) bc = c;
        exv[h][r] = cv[h][bc]; exi[h][r] = t1i[h][bc >> 4] * 128 + t2i[h][bc & 15]; cv[h][bc] = -1e30f; }
    float sum = 0.f; const float mx0 = exv[h][0]; for (int r = 0; r < 16; ++r) { exv[h][r] = expf(exv[h][r] - mx0); } for (int r = 0; r < 16; ++r) sum += exv[h][r];
    unsigned miss = 0; float gd = 0.f;
    for (int w = 0; w < 16; ++w) { const int e = IDX[(size_t)t * 128 + h * 16 + w]; const float g = GATE[(size_t)t * 128 + h * 16 + w]; bool found = false;
        for (int r = 0; r < 16; ++r) if (exi[h][r] == e) { found = true; gd = fmaxf(gd, fabsf(g - exv[h][r] / sum)); }
        if (!found) ++miss; }
    atomicAdd(&dbg[1], miss); atomicMax(&dbg[3], __builtin_bit_cast(unsigned, gd));
}
__global__ void __launch_bounds__(512) dbg_experts_pre(Args a) {
    __shared__ float n2s[1024]; __shared__ float ak[128]; __shared__ int ek[128]; __shared__ float red[8];
    const int t = dbg_tok(blockIdx.x), tid = threadIdx.x, lane = tid & 63, wave = tid >> 6;
    const bf16_t* N2 = (const bf16_t*)(a.ws + WS_N1); const int* IDX = (const int*)(a.ws + WS_P + P_IDX); const float* GATE = (const float*)(a.ws + WS_P + P_GATE);
    float* rows = (float*)(a.ws + WS_DBG + MiB);
    for (int k = tid; k < 1024; k += 512) n2s[k] = bf1(N2[(size_t)t * 1024 + k]);
    if (tid < 128) ek[tid] = IDX[(size_t)t * 128 + tid];
    __syncthreads();
    for (int k = wave * 16; k < wave * 16 + 16; ++k) { const float* u = a.in[I_PU] + (size_t)ek[k] * 1024; float s = 0.f; for (int j = lane; j < 1024; j += 64) s += u[j] * n2s[j];
        s = wave_sum(s); if (lane == 0) ak[k] = gelu_ref(s) * GATE[(size_t)t * 128 + k]; }
    __syncthreads();
    float h2[2]; float ss = 0.f;
    for (int r = 0; r < 2; ++r) { const int d = tid + 512 * r; float o = 0.f; for (int k = 0; k < 128; ++k) o += ak[k] * a.in[I_PV][(size_t)ek[k] * 1024 + d]; h2[r] = a.out[(size_t)t * 1024 + d] + o; ss += h2[r] * h2[r]; }
    ss = wave_sum(ss); if (lane == 0) red[wave] = ss; __syncthreads();
    float tot = 0.f; for (int w = 0; w < 8; ++w) tot += red[w];
    const float rstd = 1.f / sqrtf(tot / 1024.f + EPS);
    for (int r = 0; r < 2; ++r) { const int d = tid + 512 * r; rows[(size_t)blockIdx.x * 1024 + d] = h2[r] * rstd * a.in[I_FG][d]; }
}
__global__ void __launch_bounds__(512) dbg_experts_post(Args a) {
    const int t = dbg_tok(blockIdx.x), tid = threadIdx.x; const float* rows = (const float*)(a.ws + WS_DBG + MiB); float* dbgf = (float*)(a.ws + WS_DBG);
    float e = 0.f, n = 0.f;
    for (int r = 0; r < 2; ++r) { const int d = tid + 512 * r; const float x = rows[(size_t)blockIdx.x * 1024 + d], y = a.out[(size_t)t * 1024 + d]; e += (x - y) * (x - y); n += x * x; }
    e = wave_sum(e); n = wave_sum(n); if ((tid & 63) == 0) { atomicAdd(&dbgf[4], e); atomicAdd(&dbgf[5], n); }
}
__global__ void __launch_bounds__(512) dbg_report(Args a, int which) {
    const unsigned* dbg = (const unsigned*)(a.ws + WS_DBG); const float* dbgf = (const float*)(a.ws + WS_DBG);
    const float mA = dbgf[0], gd = dbgf[3]; const unsigned miss = dbg[1]; const float relC = sqrtf(dbgf[4] / fmaxf(dbgf[5], 1e-30f));
    float X;
    if (which == 0) { int mask = 0; if (mA > 0.05f) mask |= 1; if (miss > 400u) mask |= 2; if (relC > 0.05f) mask |= 4; if (gd > 0.02f) mask |= 8; X = 1000.f + 100.f * mask; }
    else if (which == 1) X = 1e6f * mA; else if (which == 2) X = 100.f + (float)miss; else if (which == 3) X = 1e6f * relC; else X = 1e6f * gd;
    for (size_t i = (size_t)blockIdx.x * 512 + threadIdx.x; i < (size_t)T_TOK * D; i += (size_t)gridDim.x * 512) a.out[i] = (i == 0) ? X : 0.f;
}
#endif

constexpr int NPH = 13;
__global__ void __launch_bounds__(NWAVES * 64, 2) fwd_kernel(Args args) {
    extern __shared__ __attribute__((aligned(16))) unsigned char lds_raw[];
    Frame F;
    F.lds = (LAS unsigned char*)lds_raw;
    F.tid = threadIdx.x; F.lane = F.tid & 63; F.wave = __builtin_amdgcn_readfirstlane(F.tid >> 6);
    F.G = gridDim.x; F.bid = blockIdx.x;
    volatile LAS unsigned* MISC = (volatile LAS unsigned*)(F.lds + MISC_OFF);
    for (int u = F.tid; u < (LDS_BYTES - LDSCTL_OFF) / 4; u += NWAVES * 64) ((LAS unsigned*)(F.lds + LDSCTL_OFF))[u] = 0u;
    __syncthreads();
    unsigned* ctl = (unsigned*)(args.ws + WS_CTL);
    const int lo = args.ph_lo, hi = args.ph_hi;
    XcdBarrier bar; bar.bar = ctl + CW_BAR + args.li * XCD_BAR_WORDS; bar.x = 0; bar.st = nullptr; bar.wave = F.wave;
    if (hi - lo > 1) bar = xcd_barrier_post(ctl + CW_BAR + args.li * XCD_BAR_WORDS, MISC + 8, F.wave);
#define IN(k) (lo <= (k) && (k) < hi)
#ifdef PROBE_TS
#define STAMP(k) do { if (F.bid == 0 && F.tid == 0) ((unsigned long long*)(args.ws + (472u << 20)))[(k)] = __builtin_amdgcn_s_memrealtime(); } while (0)
#else
#define STAMP(k) do { } while (0)
#endif
#define SEAM(k) do { if (IN(k) && IN((k) + 1)) { xcd_barrier(bar); if (XTRA_BAR) xcd_barrier(bar); } STAMP((k) + 1); } while (0)
    unsigned char* ws = args.ws;
    bf16_t* P = (bf16_t*)(ws + WS_P);

#define REFRESH() do { int z_ = 0; asm volatile("" : "+s"(z_)); F.lane = (int)__builtin_amdgcn_mbcnt_hi(~0u, __builtin_amdgcn_mbcnt_lo(~0u, (unsigned)z_)); F.tid = F.wave * 64 + F.lane; } while (0)
    STAMP(0);
    if (IN(0)) { phase0(F, args); SEAM(0); }
    if (IN(1)) { REFRESH();
        if (F8_LO > 0) { pg8::Gemm g{(const bf16_t*)(ws + WS_N1), (const bf16_t*)(ws + WS_WIN), T_TOK, F8_LO * 256, D, D}; pg8::StaticOrder S; S.init(T_TOK, F8_LO * 256, F.G, F.bid);
            pg8::EpiProj E{P, (float*)(ws + WS_ALR), 0}; pg8::gemm_phase<pg8::EpiProj, pg8::StaticOrder, false, true, false>(F.lds, g, S, E, F.wave); }
        if (F8_LO < 21) {
            pg8::Gemm g{(const bf16_t*)(ws + WS_N18), (const bf16_t*)(ws + WS_W8 + (size_t)F8_LO * 256 * 1024), T_TOK, (21 - F8_LO) * 256, D / 2, D / 2, 0x7B7B7B7B, 0x75757575};
            pg8::StaticOrder S; S.init(T_TOK, (21 - F8_LO) * 256, F.G, ((F8_LO * 128) % F.G) != 0 ? F.G - 1 - F.bid : F.bid);
            pg8::EpiProj E{P, (float*)(ws + WS_ALR), F8_LO}; pg8::gemm_phase<pg8::EpiProj, pg8::StaticOrder, false, true, true>(F.lds, g, S, E, F.wave); }
        {
            REFRESH();
            const int nwg = (T_TOK / 256) * (NPROJ / 256), rem = nwg % F.G;
            if (rem == 0) convert_tables(F, args, F.bid * NWAVES + F.wave, F.G * NWAVES);
            else if (F.bid >= rem) convert_tables(F, args, (F.bid - rem) * NWAVES + F.wave, (F.G - rem) * NWAVES);
        }
        SEAM(1);
    }
    if (IN(2)) { REFRESH();
        if (DRY_EXP == 12) { gla_chunk_phase<true>(F, args); for (int it = F.bid; it < 256; it += F.G) for (int g4 = 0; g4 < 4; ++g4) sgu_unit<true>(F, args, 4 * it + g4, g4 == 0); __syncthreads(); }
        gla_chunk_phase<false>(F, args);
        for (int it = F.bid; it < 256; it += F.G) for (int g4 = 0; g4 < 4; ++g4) sgu_unit<false>(F, args, 4 * it + g4, g4 == 0);
        SEAM(2);
    }
    if (IN(3)) { REFRESH(); if (DRY_EXP == 13 || DRY_EXP == 15) { gla_scan<true>(F, args); __syncthreads(); } gla_scan<false>(F, args); SEAM(3); }
    if (IN(4)) { REFRESH(); if (DRY_EXP == 14 || DRY_EXP == 15) { gla_out_phase<true>(F, args); __syncthreads(); } gla_out_phase<false>(F, args); SEAM(4); }
    if (IN(5)) { REFRESH();
        { pg8::Gemm g{P + PC_R, (const bf16_t*)(ws + WS_WA), T_TOK, D, 1024, PLD}; pg8::StaticOrder S; S.init(T_TOK, D, F.G, F.bid);
          pg8::EpiBrAB E{P}; pg8::gemm_phase<pg8::EpiBrAB, pg8::StaticOrder, true, true, false, true>(F.lds, g, S, E, F.wave); }
        SEAM(5);
    }
    if (IN(6)) { REFRESH();
        pg8::Gemm g{P + PC_MRG, (const bf16_t*)(ws + WS_WOUT), T_TOK, D, D, PLD}; pg8::StaticOrder S; S.init(T_TOK, D, F.G, F.bid);
        pg8::EpiOut E{args.in[I_X], (bf16_t*)(ws + WS_N1), ws + WS_N18, (float*)(ws + WS_RSS)}; pg8::gemm_phase<pg8::EpiOut, pg8::StaticOrder, true, true>(F.lds, g, S, E, F.wave);
        SEAM(6);
    }
    if (IN(8)) { REFRESH();
        pg8::StaticOrder S; S.init(T_TOK, 2048, F.G, F.bid); pg8::EpiScores E{(bf16_t*)(ws + WS_P + P_SC), (const float*)(ws + WS_RSS)};
        if (SC_F8) { pg8::Gemm g{(const bf16_t*)(ws + WS_N18), (const bf16_t*)(ws + WS_WQF), T_TOK, 2048, D / 2, D / 2, 0x7B7B7B7B, 0x75757575};
            pg8::gemm_phase<pg8::EpiScores, pg8::StaticOrder, true, true, true>(F.lds, g, S, E, F.wave); }
        else { pg8::Gemm g{(const bf16_t*)(ws + WS_N1), (const bf16_t*)(ws + WS_WQF), T_TOK, 2048, D, D};
            pg8::gemm_phase<pg8::EpiScores, pg8::StaticOrder, true, true>(F.lds, g, S, E, F.wave); }
        SEAM(8);
    }
    if (IN(9)) { REFRESH(); peer_topk(F, args); SEAM(9); }
    if (IN(10)) { REFRESH(); if constexpr (UNG == 1) peer_u4_all<0>(F, args); else peer_u4_phase<0>(F, args); SEAM(10); }
    if (IN(11)) { REFRESH(); if (V_F4) peer_v4_phase<0>(F, args); else { if (DRY_EXP == 1) { peer_v_phase<1>(F, args); __syncthreads(); } peer_v_phase<0>(F, args); SEAM(11); } }
    if (IN(12)) { REFRESH(); if (!V_F4) final_norm_phase(F, args); }
#undef IN
#undef SEAM
}


#ifdef PROBE_TS
__global__ void __launch_bounds__(512) probe_report(Args a, int pi, int pj) {
    const unsigned long long* ts = (const unsigned long long*)(a.ws + (472u << 20));
    const float X1 = 10.f * (float)(ts[pi + 1] - ts[pi]) * 0.01f, X2 = (float)(ts[pj + 1] - ts[pj]) * 0.01f;
    for (size_t i = (size_t)blockIdx.x * 512 + threadIdx.x; i < (size_t)T_TOK * D; i += (size_t)gridDim.x * 512) a.out[i] = (i == 0) ? X1 : X2;
}
#endif
#ifdef PROBE_MFMA
__global__ void __launch_bounds__(64) probe_mfma(Args a) {
    const int l = threadIdx.x;
    i32x4 av = {0, 0, 0, 0};
    if (l == PROBE_L) av[PROBE_P >> 3] = 0x2 << (4 * (PROBE_P & 7));
    i32x8 b1, b2;
    for (int r = 0; r < 8; ++r) { unsigned w1 = 0, w2 = 0;
        for (int c = 0; c < 4; ++c) { const int b = 4 * r + c; int t = 0;
            t = __builtin_amdgcn_cvt_pk_fp8_f32((float)((b & 15) + 1), (float)(1 + (b >> 4) + 2 * (l >> 4)), 0, false);
            w1 |= ((unsigned)t & 0xffu) << (8 * c); w2 |= (((unsigned)t >> 8) & 0xffu) << (8 * c); }
        b1[r] = (int)w1; b2[r] = (int)w2; }
    const f32x4 z = {0.f, 0.f, 0.f, 0.f};
    const f32x4 d1 = __builtin_amdgcn_mfma_scale_f32_16x16x128_f8f6f4(__builtin_shufflevector(av, av, 0, 1, 2, 3, -1, -1, -1, -1), b1, z, 4, 0, 0, 0x7F7F7F7F, 0, 0x7F7F7F7F);
    const f32x4 d2 = __builtin_amdgcn_mfma_scale_f32_16x16x128_f8f6f4(__builtin_shufflevector(av, av, 0, 1, 2, 3, -1, -1, -1, -1), b2, z, 4, 0, 0, 0x7F7F7F7F, 0, 0x7F7F7F7F);
    float* st = (float*)(a.ws + (472u << 20));
    *(f32x4*)(st + 8 * l) = d1; *(f32x4*)(st + 8 * l + 4) = d2;
}
__global__ void __launch_bounds__(512) probe_mfma_report(Args a) {
    const int row = PROBE_L & 15;
    const float* st = (const float*)(a.ws + (472u << 20)) + 8 * (16 * (row >> 2)) + (row & 3); const float X1 = 10.f * st[0], X2 = st[4];
    for (size_t i = (size_t)blockIdx.x * 512 + threadIdx.x; i < (size_t)T_TOK * D; i += (size_t)gridDim.x * 512) a.out[i] = (i == 0) ? X1 : X2;
}
#endif
extern "C" void kernel_launch(void* const* d_in, const int* in_sizes, int n_in, void* d_out, int out_size, void* d_ws, size_t ws_size, hipStream_t stream) {
    static int grid = 0;
    if (grid == 0) {
        if (n_in != 20 || in_sizes[0] != T_TOK * D || out_size != T_TOK * D || ws_size < WS_END) {
            fprintf(stderr, "kernel_launch: unexpected shapes: n_in %d in0 %d out %d ws %zu (need %zu)\n", n_in, n_in > 0 ? in_sizes[0] : -1, out_size, ws_size, (size_t)WS_END); grid = -1; return; }
        int dev = 0, cus = 0;
        if (hipGetDevice(&dev) != hipSuccess || hipDeviceGetAttribute(&cus, hipDeviceAttributeMultiprocessorCount, dev) != hipSuccess) { grid = -1; return; }
        if (hipFuncSetAttribute((const void*)fwd_kernel, hipFuncAttributeMaxDynamicSharedMemorySize, LDS_BYTES) != hipSuccess) { fprintf(stderr, "kernel_launch: hipFuncSetAttribute failed\n"); grid = -1; return; }
        int per_cu = 0;
        if (hipOccupancyMaxActiveBlocksPerMultiprocessor(&per_cu, (const void*)fwd_kernel, NWAVES * 64, LDS_BYTES) != hipSuccess || per_cu < 1) fprintf(stderr, "kernel_launch: occupancy query says %d\n", per_cu);
        (void)hipGetLastError();
        grid = cus;
    }
    if (grid < 0) return;
    (void)hipMemsetAsync((char*)d_ws + WS_CTL, 0, CTL_ZERO_BYTES, stream);
    Args a{};
    for (int i = 0; i < 20; ++i) a.in[i] = (const float*)d_in[i];
    a.out = (float*)d_out; a.ws = (unsigned char*)d_ws;
#ifdef PROBE_MFMA
    hipLaunchKernelGGL(probe_mfma, dim3(1), dim3(64), 0, stream, a);
    hipLaunchKernelGGL(probe_mfma_report, dim3(1024), dim3(512), 0, stream, a);
    return;
#endif
#ifndef LAUNCH_LIST
#define LAUNCH_LIST {0, NPH}
#endif
    static const int ranges[][2] = { LAUNCH_LIST };
    const int nl = (int)(sizeof(ranges) / sizeof(ranges[0]));
    for (int li = 0; li < nl; ++li) { a.ph_lo = ranges[li][0]; a.ph_hi = ranges[li][1]; a.li = li;
        hipLaunchKernelGGL(fwd_kernel, dim3(grid), dim3(NWAVES * 64), LDS_BYTES, stream, a); }
}
```

```cpp
#include <hip/hip_runtime.h>
#include <cstdio>
#include <cstdint>


#ifndef XTRA_BAR
#define XTRA_BAR 0
#endif
#ifndef DRY_EXP
#define DRY_EXP 0
#endif
#ifndef DUP_PHASE
#define DUP_PHASE -1
#endif
#ifndef MK_N_LAUNCHES
#define MK_N_LAUNCHES 1
#endif

#define LAS __attribute__((address_space(3)))
#define GAS __attribute__((address_space(1)))
typedef unsigned short bf16_t;
typedef short bf16x8 __attribute__((ext_vector_type(8)));
typedef float f32x4 __attribute__((ext_vector_type(4)));
typedef float f32x2 __attribute__((ext_vector_type(2)));
typedef unsigned u32x4 __attribute__((ext_vector_type(4)));
typedef unsigned u32x2 __attribute__((ext_vector_type(2)));
typedef int i32x4 __attribute__((ext_vector_type(4)));
typedef int i32x8 __attribute__((ext_vector_type(8)));
typedef __bf16 bf16x2_t __attribute__((ext_vector_type(2)));

constexpr int T_TOK = 32768, D = 1024, SEQ = 4096, NBATCH = 8;
constexpr int NPROJ = 5376;
constexpr int PLD = 5120;
constexpr int PC_Q = 0, PC_K = 512, PC_V = 1024, PC_R = 1536, PC_SU = 2048, PC_SV = 2560, PC_GA = 3072, PC_GB = 4096;
constexpr int PC_MRG = 512;
constexpr float EPS = 1e-6f;
constexpr int NEXP = 16384;
#ifndef U_NG
#define U_NG 1
#endif
#ifndef ST_F8
#define ST_F8 1
#endif
#ifndef TOPK_LOCAL
#define TOPK_LOCAL 1
#endif
#ifndef V_F4
#define V_F4 1
#endif
#ifndef SC_F8
#define SC_F8 0
#endif
#ifndef F8_LO
#define F8_LO 8
#endif
static_assert(U_NG == 1, "only the one-group U phase applies RMSNorm-2's rstd");
constexpr int UNG = U_NG, UNG_SH = (U_NG == 8 ? 3 : (U_NG == 4 ? 2 : (U_NG == 2 ? 1 : 0)));

constexpr size_t MiB = 1u << 20;
constexpr size_t WS_RSS = 64 * 1024;
constexpr size_t WS_LNS = 192 * 1024;
constexpr size_t WS_CTL = 0, CTL_ZERO_BYTES = 64 * 1024 + 128 * 1024 + 256 * 1024;
constexpr size_t WS_WIN = 1 * MiB;
constexpr size_t WS_WA = 12 * MiB;
constexpr size_t WS_WB = 13 * MiB;
constexpr size_t WS_WOUT = 14 * MiB;
constexpr size_t WS_WQF = 16 * MiB;
constexpr size_t WS_U8 = 20 * MiB;
constexpr size_t WS_V8 = 36 * MiB;
constexpr size_t WS_SU = 52 * MiB;
constexpr size_t WS_SV = 52 * MiB + 65536;
constexpr size_t WS_AK = 53 * MiB;
constexpr size_t WS_DEC = 84 * MiB;
constexpr size_t WS_ALR = 85 * MiB;
constexpr size_t WS_N1 = 87 * MiB;
constexpr size_t WS_P = 151 * MiB;
constexpr size_t WS_W8 = 472 * MiB;
constexpr size_t WS_N18 = 478 * MiB;
constexpr size_t WS_END = 510 * MiB;
constexpr size_t P_HB = 192 * MiB;
constexpr size_t P_N2 = 128 * MiB;
constexpr size_t P_SC = 0, P_IDX = 256 * MiB, P_GATE = 272 * MiB, P_X8 = 288 * MiB;

constexpr int CW_BAR = 4096;

constexpr int RING_BYTES = 131072;
constexpr int LDSCTL_OFF = RING_BYTES, MISC_OFF = LDSCTL_OFF + 320;
constexpr int LDS_BYTES = 147456;
constexpr int NWAVES = 8;

__device__ __forceinline__ unsigned pk2(float lo, float hi) { const f32x2 v = {lo, hi}; const bf16x2_t b = __builtin_convertvector(v, bf16x2_t); return __builtin_bit_cast(unsigned, b); }
__device__ __forceinline__ unsigned f2bf(float f) { return pk2(f, 0.f) & 0xffffu; }
__device__ __forceinline__ float bflo(unsigned w) { return __builtin_bit_cast(float, w << 16); }
__device__ __forceinline__ float bfhi(unsigned w) { return __builtin_bit_cast(float, w & 0xffff0000u); }
__device__ __forceinline__ float bf1(bf16_t h) { return __builtin_bit_cast(float, ((unsigned)h) << 16); }
__device__ __forceinline__ float sigmoidf_(float x) { return __builtin_amdgcn_rcpf(1.f + __expf(-x)); }
__device__ __forceinline__ float gelu_tanh(float x) { const float y = 1.5957691216057308f * (x + 0.044715f * x * x * x); return x * sigmoidf_(y); }
__device__ __forceinline__ float siluf_(float x) { return x * sigmoidf_(x); }
__device__ __forceinline__ float wave_sum(float v) {
#pragma unroll
    for (int o = 1; o < 64; o <<= 1) v += __shfl_xor(v, o);
    return v;
}
#define LDS_WAIT() asm volatile("s_waitcnt lgkmcnt(0)" ::: "memory")
#define VM_WAIT() asm volatile("s_waitcnt vmcnt(0)" ::: "memory")

__device__ __forceinline__ int lane_now() { int z = 0; asm volatile("" : "+s"(z)); return (int)__builtin_amdgcn_mbcnt_hi(~0u, __builtin_amdgcn_mbcnt_lo(~0u, (unsigned)z)); }
namespace pg8 {
constexpr int BM = 256, BK = 64, HALF = 128, HTB = HALF * BK * 2, STAGE_BYTES = 8 * HTB, NXCD = 8, WGM = 8;
__host__ __device__ __forceinline__ int lds_byte(int r, int c) { const int st = (r >> 4) * 2 + (c >> 5), rr = r & 15, cc = c & 31, ob = rr * 64 + cc * 2; return st * 1024 + (ob ^ (((ob >> 9) & 1) << 5)); }
__host__ __device__ __forceinline__ void stage_rc(int b, int& R, int& C) { const int st = b / 1024, sb = b % 1024, swz = sb ^ (((sb >> 9) & 1) << 5); R = (st >> 1) * 16 + swz / 64; C = (st & 1) * 32 + (swz % 64) / 2; }
__host__ __device__ __forceinline__ int perm32(int rho) { const int n = rho >> 4, i = rho & 15; return 8 * (i >> 2) + 4 * n + (i & 3); }

struct Unit { int pm, pn; };
struct Gemm { const bf16_t* A; const bf16_t* Bt; int M, N, K, lda; int sa = 0, sb = 0; };

struct StaticOrder {
    int nM, nN, nwg, G, c;
    __host__ __device__ void init(int M, int N, int G_, int c_) { nM = M / BM; nN = N / BM; nwg = nM * nN; G = G_; c = c_; }
    __host__ __device__ bool next(int i, Unit& u) const {
        const long L = (long)i * G + c; if (L >= nwg) return false;
        int wgid = (int)L; { const int q = nwg / NXCD, r = nwg % NXCD, xcd = wgid % NXCD, off = wgid / NXCD; wgid = (xcd < r ? xcd * (q + 1) : r * (q + 1) + (xcd - r) * q) + off; }
        const int nig = WGM * nN, gid = wgid / nig, fm = gid * WGM, gsz = (nM - fm) < WGM ? (nM - fm) : WGM;
        u.pm = fm + ((wgid % nig) % gsz); u.pn = (wgid % nig) / gsz; return true;
    }
    __device__ __forceinline__ void a_ready(const Unit&) const {}
    __device__ __forceinline__ void done(const Unit&) const {}
};

template <class Epi, class Sched, bool ALIGN_EPI = false, bool SP2 = false, bool F8 = false, bool MID = false>
__device__ __forceinline__ void gemm_phase(LAS unsigned char* lds, const Gemm g, const Sched& S, const Epi& E, int wave_id) {
    const int wid = wave_id, lane = lane_now(), tid = wid * 64 + lane, wr = wid >> 2, wc = wid & 3, fr = lane & 15, fq = lane >> 4;
    const int K = g.K, nt = K / BK, lda = g.lda; const int scAB = (g.sb & 0xff) | ((g.sa & 0xff) << 8); (void)scAB;
    unsigned voffA[1], voffB[1];
    { int R, C; stage_rc(tid * 16, R, C); const int Rb = Epi::PERM ? ((R & ~31) + perm32(R & 31)) : R;
        voffA[0] = (unsigned)(R * lda + C) * 2u; voffB[0] = (unsigned)(Rb * K + C) * 2u; }
    const size_t dltA = (size_t)64 * lda * 2, dltB = (size_t)64 * K * 2;
    const size_t kstep = (size_t)(BK * 2);
    const size_t hstepA = (size_t)HALF * lda * 2, hstepB = (size_t)HALF * K * 2;
    const size_t tstepA = 2 * hstepA, tstepB = 2 * hstepB;
    const unsigned ldsw = (unsigned)wid * 1024u; const unsigned ldsbase = (unsigned)(__UINTPTR_TYPE__)lds + ldsw;
    const int aoff = lds_byte(wr * 64 + fr, fq * 8), boff = lds_byte(wc * 32 + fr, fq * 8);
#define PG8_SA(b, h) (((b) * 2 + (h)) * HTB)
#define PG8_SB(b, h) ((4 + (b) * 2 + (h)) * HTB)
#define PG8_STAGE(bufoff, gbase, voff) do { _Pragma("unroll") for (int _i = 0; _i < 2; ++_i) \
        asm volatile("s_mov_b32 m0, %2\n\ts_nop 0\n\tglobal_load_lds_dwordx4 %0, %1" :: "v"((voff)[0]), "s"((const char*)(gbase) + (size_t)_i * ((voff) == voffA ? dltA : dltB)), "s"(ldsbase + (unsigned)((bufoff) + _i * 8192)) : "memory", "m0"); } while (0)
#define PG8_LDA(dst, b, h) do { _Pragma("unroll") for (int m = 0; m < 4; ++m) _Pragma("unroll") for (int k = 0; k < 2; ++k) dst[m][k] = *(const LAS bf16x8*)(lds + PG8_SA(b, h) + aoff + m * 2048 + k * 1024); } while (0)
#define PG8_LDB(dst, b, h) do { _Pragma("unroll") for (int n = 0; n < 2; ++n) _Pragma("unroll") for (int k = 0; k < 2; ++k) dst[n][k] = *(const LAS bf16x8*)(lds + PG8_SB(b, h) + boff + n * 2048 + k * 1024); } while (0)
#define PG8_CAT(x) __builtin_shufflevector(__builtin_bit_cast(i32x4, (x)[0]), __builtin_bit_cast(i32x4, (x)[1]), 0, 1, 2, 3, 4, 5, 6, 7)
#define PG8_MMA(ai, bj, At, Bt) do { __builtin_amdgcn_s_setprio(1); if constexpr (F8) { _Pragma("unroll") for (int m = 0; m < 4; ++m) _Pragma("unroll") for (int n = 0; n < 2; ++n) \
        acc[ai][bj][m][n] = __builtin_amdgcn_mfma_scale_f32_16x16x128_f8f6f4(PG8_CAT(Bt[n]), PG8_CAT(At[m]), acc[ai][bj][m][n], 0, 0, 0, scAB, 1, scAB); } else { \
        _Pragma("unroll") for (int m = 0; m < 4; ++m) _Pragma("unroll") for (int n = 0; n < 2; ++n) _Pragma("unroll") for (int k = 0; k < 2; ++k) \
        acc[ai][bj][m][n] = __builtin_amdgcn_mfma_f32_16x16x32_bf16(Bt[n][k], At[m][k], acc[ai][bj][m][n], 0, 0, 0); } __builtin_amdgcn_s_setprio(0); } while (0)
#define PG8_WAIT_V(n) asm volatile("s_waitcnt vmcnt(" #n ")" ::: "memory")
#define PG8_WAIT_L(n) asm volatile("s_waitcnt lgkmcnt(" #n ")" ::: "memory")
#define PG8_BAR __builtin_amdgcn_s_barrier()
#define PG8_SCHED __builtin_amdgcn_sched_barrier(0)
    Unit cur, nxt; int ui = 0;
    if (!S.next(0, cur)) return;
    f32x4 acc[2][2][4][2];
#pragma unroll
    for (int a = 0; a < 2; ++a)
#pragma unroll
        for (int b = 0; b < 2; ++b)
#pragma unroll
            for (int m = 0; m < 4; ++m)
#pragma unroll
                for (int n = 0; n < 2; ++n) acc[a][b][m][n] = (f32x4){0.f, 0.f, 0.f, 0.f};
    bf16x8 At[4][2], B0[2][2], B1[2][2];
    const char* cA = (const char*)g.A + (size_t)cur.pm * tstepA; const char* cB = (const char*)g.Bt + (size_t)cur.pn * tstepB;
    S.a_ready(cur);
    if constexpr (SP2) {
        PG8_STAGE(PG8_SB(0, 0), cB, voffB); PG8_STAGE(PG8_SB(0, 1), cB + hstepB, voffB); PG8_STAGE(PG8_SA(0, 0), cA, voffA); PG8_STAGE(PG8_SA(0, 1), cA + hstepA, voffA);
        if (wr == 1) PG8_BAR;
        PG8_WAIT_V(2); PG8_BAR;
        PG8_STAGE(PG8_SB(1, 0), cB + kstep, voffB); PG8_STAGE(PG8_SA(1, 0), cA + kstep, voffA); PG8_STAGE(PG8_SB(1, 1), cB + hstepB + kstep, voffB);
        PG8_WAIT_V(6); PG8_BAR;
    } else {
        PG8_STAGE(PG8_SB(0, 0), cB, voffB); PG8_STAGE(PG8_SA(0, 0), cA, voffA); PG8_STAGE(PG8_SB(0, 1), cB + hstepB, voffB); PG8_STAGE(PG8_SA(0, 1), cA + hstepA, voffA);
        if (wr == 1) PG8_BAR;
        PG8_WAIT_V(4); PG8_BAR;
        PG8_STAGE(PG8_SB(1, 0), cB + kstep, voffB); PG8_STAGE(PG8_SA(1, 0), cA + kstep, voffA); PG8_STAGE(PG8_SB(1, 1), cB + hstepB + kstep, voffB);
        PG8_WAIT_V(6); PG8_BAR;
    }
    for (;;) {
        const bool has_next = S.next(ui + 1, nxt);
        const char* nA = has_next ? (const char*)g.A + (size_t)nxt.pm * tstepA : cA; const char* nB = has_next ? (const char*)g.Bt + (size_t)nxt.pn * tstepB : cB;
#pragma nounroll
        for (int t = 0; t < nt; t += 2) {
            if constexpr (MID) { if (t == (nt >> 1)) E.mid(acc, cur, wr, wc); }
            const bool last = (t == nt - 2);
            const char* a1 = cA + (size_t)(t + 1) * kstep;
            const char* a2 = last ? nA : cA + (size_t)(t + 2) * kstep; const char* b2 = last ? nB : cB + (size_t)(t + 2) * kstep;
            const char* a3 = a2 + kstep; const char* b3 = b2 + kstep;
            if (last && has_next) S.a_ready(nxt);
            if constexpr (SP2) {
            PG8_LDB(B0, 0, 0); PG8_LDB(B1, 0, 1); PG8_SCHED; PG8_LDA(At, 0, 0); PG8_STAGE(PG8_SA(1, 1), a1 + hstepA, voffA);
            PG8_WAIT_V(8); PG8_WAIT_L(0); PG8_BAR; PG8_MMA(0, 0, At, B0); PG8_MMA(0, 1, At, B1); PG8_BAR; PG8_SCHED;
            PG8_LDA(At, 0, 1); PG8_STAGE(PG8_SB(0, 0), b2, voffB); PG8_STAGE(PG8_SB(0, 1), b2 + hstepB, voffB); PG8_STAGE(PG8_SA(0, 0), a2, voffA);
            PG8_WAIT_V(8); PG8_WAIT_L(0); PG8_BAR; PG8_MMA(1, 0, At, B0); PG8_MMA(1, 1, At, B1); PG8_BAR; PG8_SCHED;
            PG8_LDB(B0, 1, 0); PG8_LDB(B1, 1, 1); PG8_SCHED; PG8_LDA(At, 1, 0); PG8_STAGE(PG8_SA(0, 1), a2 + hstepA, voffA);
            PG8_WAIT_V(8); PG8_WAIT_L(0); PG8_BAR; PG8_MMA(0, 0, At, B0); PG8_MMA(0, 1, At, B1); PG8_BAR; PG8_SCHED;
            PG8_LDA(At, 1, 1); PG8_STAGE(PG8_SB(1, 0), b3, voffB); PG8_STAGE(PG8_SB(1, 1), b3 + hstepB, voffB); PG8_STAGE(PG8_SA(1, 0), a3, voffA);
            PG8_WAIT_V(8); PG8_WAIT_L(0); PG8_BAR; PG8_MMA(1, 0, At, B0); PG8_MMA(1, 1, At, B1); PG8_BAR; PG8_SCHED;
            } else {
            PG8_LDB(B0, 0, 0); PG8_SCHED; PG8_LDA(At, 0, 0); PG8_STAGE(PG8_SA(1, 1), a1 + hstepA, voffA);
            PG8_WAIT_L(8); PG8_BAR; PG8_WAIT_L(0); PG8_MMA(0, 0, At, B0); PG8_BAR; PG8_SCHED;
            PG8_LDB(B1, 0, 1); PG8_STAGE(PG8_SB(0, 0), b2, voffB);
            PG8_BAR; PG8_WAIT_L(0); PG8_MMA(0, 1, At, B1); PG8_BAR;
            PG8_LDA(At, 0, 1); PG8_STAGE(PG8_SA(0, 0), a2, voffA);
            PG8_BAR; PG8_WAIT_L(0); PG8_MMA(1, 0, At, B0); PG8_BAR; PG8_SCHED;
            PG8_STAGE(PG8_SB(0, 1), b2 + hstepB, voffB);
            PG8_WAIT_V(6); PG8_BAR; PG8_MMA(1, 1, At, B1); PG8_BAR;
            PG8_LDB(B0, 1, 0); PG8_SCHED; PG8_LDA(At, 1, 0); PG8_STAGE(PG8_SA(0, 1), a2 + hstepA, voffA);
            PG8_WAIT_L(8); PG8_BAR; PG8_WAIT_L(0); PG8_MMA(0, 0, At, B0); PG8_BAR; PG8_SCHED;
            PG8_LDB(B1, 1, 1); PG8_STAGE(PG8_SB(1, 0), b3, voffB);
            PG8_BAR; PG8_WAIT_L(0); PG8_MMA(0, 1, At, B1); PG8_BAR;
            PG8_LDA(At, 1, 1); PG8_STAGE(PG8_SA(1, 0), a3, voffA);
            PG8_BAR; PG8_WAIT_L(0); PG8_MMA(1, 0, At, B0); PG8_BAR; PG8_SCHED;
            PG8_STAGE(PG8_SB(1, 1), b3 + hstepB, voffB);
            PG8_WAIT_V(6); PG8_BAR; PG8_MMA(1, 1, At, B1); PG8_BAR;
            }
        }
        if constexpr (ALIGN_EPI) { if (wr == 0) PG8_BAR; }
        E(acc, cur, wr, wc, fr, fq); S.done(cur);
        if (!has_next) break;
#pragma unroll
        for (int a = 0; a < 2; ++a)
#pragma unroll
            for (int b = 0; b < 2; ++b)
#pragma unroll
                for (int m = 0; m < 4; ++m)
#pragma unroll
                    for (int n = 0; n < 2; ++n) acc[a][b][m][n] = (f32x4){0.f, 0.f, 0.f, 0.f};
        cur = nxt; cA = nA; cB = nB; ++ui;
        if constexpr (ALIGN_EPI) { if (wr == 1) PG8_BAR; }
    }
    PG8_WAIT_V(0);
    if constexpr (!ALIGN_EPI) { if (wr == 0) PG8_BAR; }
    PG8_BAR;
#undef PG8_SA
#undef PG8_SB
#undef PG8_STAGE
#undef PG8_LDA
#undef PG8_LDB
#undef PG8_MMA
#undef PG8_CAT
#undef PG8_WAIT_V
#undef PG8_WAIT_L
#undef PG8_BAR
#undef PG8_SCHED
}

__device__ __forceinline__ u32x4 pack8(f32x4 v0, f32x4 v1) { u32x4 w; w.x = pk2(v0[0], v0[1]); w.y = pk2(v0[2], v0[3]); w.z = pk2(v1[0], v1[1]); w.w = pk2(v1[2], v1[3]); return w; }
__device__ __forceinline__ void unpack8(u32x4 w, f32x4& v0, f32x4& v1) { v0 = (f32x4){bflo(w.x), bfhi(w.x), bflo(w.y), bfhi(w.y)}; v1 = (f32x4){bflo(w.z), bfhi(w.z), bflo(w.w), bfhi(w.w)}; }

struct EpiProj {
    static constexpr bool PERM = true;
    bf16_t* P; float* ALR; int pn0; float* LNS;
    __device__ __forceinline__ void operator()(const f32x4 (&acc)[2][2][4][2], const Unit& u, int wr, int wc, int fr, int fq) const {
        { const int ln = lane_now(); fr = ln & 15; fq = ln >> 4; }
        const int row0 = u.pm * BM + wr * 64 + fr; int pn = u.pn + pn0; const int cl = wc * 32 + 8 * fq;
        if (pn == 10) {
            if (wc == 0 && fq < 2) {
#pragma unroll
                for (int ai = 0; ai < 2; ++ai)
#pragma unroll
                    for (int m = 0; m < 4; ++m) { float* rp = ALR + (size_t)(row0 + ai * HALF + m * 16) * 16 + 8 * fq;
                        *(f32x4*)rp = acc[ai][0][m][0]; *(f32x4*)(rp + 4) = acc[ai][0][m][1]; }
            }
            return;
        }
        if (pn > 10) --pn;
        const int mode = pn < 8 ? 0 : (pn < 12 ? 1 : 2);
#pragma unroll
        for (int ai = 0; ai < 2; ++ai)
#pragma unroll
            for (int m = 0; m < 4; ++m) { bf16_t* rowp = P + (size_t)(row0 + ai * HALF + m * 16) * PLD + pn * BM + cl; float ls = 0.f, ls2 = 0.f;
#pragma unroll
                for (int bj = 0; bj < 2; ++bj) { f32x4 v0 = acc[ai][bj][m][0], v1 = acc[ai][bj][m][1];
                    if (mode == 1) {
#pragma unroll
                        for (int i = 0; i < 4; ++i) { v0[i] = gelu_tanh(v0[i]); v1[i] = gelu_tanh(v1[i]); }
                        if (pn >= 10) {
#pragma unroll
                            for (int i = 0; i < 4; ++i) { ls += v0[i] + v1[i]; ls2 += v0[i] * v0[i] + v1[i] * v1[i]; } }
                        if (bj == 1 && pn >= 10) { ls += __shfl_xor(ls, 16); ls += __shfl_xor(ls, 32); ls2 += __shfl_xor(ls2, 16); ls2 += __shfl_xor(ls2, 32);
                            if (fq == 0) { float* lp = LNS + (size_t)(row0 + ai * HALF + m * 16) * 2; (void)__hip_atomic_fetch_add(lp, ls, __ATOMIC_RELAXED, __HIP_MEMORY_SCOPE_AGENT); (void)__hip_atomic_fetch_add(lp + 1, ls2, __ATOMIC_RELAXED, __HIP_MEMORY_SCOPE_AGENT); } }
                    } else if (mode == 2) {
                        unsigned w0 = 0, w1 = 0;
                        w0 = __builtin_amdgcn_cvt_pk_u8_f32(sigmoidf_(v0[0]) * 255.f, 0, w0); w0 = __builtin_amdgcn_cvt_pk_u8_f32(sigmoidf_(v0[1]) * 255.f, 1, w0); w0 = __builtin_amdgcn_cvt_pk_u8_f32(sigmoidf_(v0[2]) * 255.f, 2, w0); w0 = __builtin_amdgcn_cvt_pk_u8_f32(sigmoidf_(v0[3]) * 255.f, 3, w0);
                        w1 = __builtin_amdgcn_cvt_pk_u8_f32(sigmoidf_(v1[0]) * 255.f, 0, w1); w1 = __builtin_amdgcn_cvt_pk_u8_f32(sigmoidf_(v1[1]) * 255.f, 1, w1); w1 = __builtin_amdgcn_cvt_pk_u8_f32(sigmoidf_(v1[2]) * 255.f, 2, w1); w1 = __builtin_amdgcn_cvt_pk_u8_f32(sigmoidf_(v1[3]) * 255.f, 3, w1);
                        unsigned char* bp = (unsigned char*)(P + (size_t)(row0 + ai * HALF + m * 16) * PLD) + (pn < 16 ? PC_GA * 2 + (pn - 12) * BM : PC_GB * 2 + (pn - 16) * BM) + cl + bj * HALF;
                        *(u32x2*)bp = (u32x2){w0, w1}; continue;
                    }
                    *(u32x4*)(rowp + bj * HALF) = pack8(v0, v1); } }
    }
};
struct EpiBrA {
    static constexpr bool PERM = true;
    bf16_t* P;
    __device__ __forceinline__ void operator()(const f32x4 (&acc)[2][2][4][2], const Unit& u, int wr, int wc, int fr, int fq) const {
        const int row0 = u.pm * BM + wr * 64 + fr; const int c0 = u.pn * BM + wc * 32 + 8 * fq;
#pragma unroll
        for (int ai = 0; ai < 2; ++ai)
#pragma unroll
            for (int m = 0; m < 4; ++m) { bf16_t* rowp = P + (size_t)(row0 + ai * HALF + m * 16) * PLD;
#pragma unroll
                for (int bj = 0; bj < 2; ++bj) { const int c = c0 + bj * HALF; f32x4 g0, g1; unpack8(*(const u32x4*)(rowp + PC_GA + c), g0, g1);
                    *(u32x4*)(rowp + PC_MRG + c) = pack8(acc[ai][bj][m][0] * g0, acc[ai][bj][m][1] * g1); } }
    }
};
struct EpiBrB {
    static constexpr bool PERM = true;
    bf16_t* P;
    __device__ __forceinline__ void operator()(const f32x4 (&acc)[2][2][4][2], const Unit& u, int wr, int wc, int fr, int fq) const {
        const int row0 = u.pm * BM + wr * 64 + fr; const int c0 = u.pn * BM + wc * 32 + 8 * fq;
#pragma unroll
        for (int ai = 0; ai < 2; ++ai)
#pragma unroll
            for (int m = 0; m < 4; ++m) { bf16_t* rowp = P + (size_t)(row0 + ai * HALF + m * 16) * PLD;
#pragma unroll
                for (int bj = 0; bj < 2; ++bj) { const int c = c0 + bj * HALF; f32x4 g0, g1, p0, p1; unpack8(*(const u32x4*)(rowp + PC_GB + c), g0, g1); unpack8(*(const u32x4*)(rowp + PC_MRG + c), p0, p1);
                    *(u32x4*)(rowp + PC_MRG + c) = pack8(p0 + acc[ai][bj][m][0] * g0, p1 + acc[ai][bj][m][1] * g1); } }
    }
};
struct EpiBrAB {
    static constexpr bool PERM = true;
    bf16_t* P;
    static __device__ __forceinline__ void u8x8(const u32x2 w, f32x4& f0, f32x4& f1) {
        f0 = (f32x4){(float)(w.x & 0xffu), (float)((w.x >> 8) & 0xffu), (float)((w.x >> 16) & 0xffu), (float)(w.x >> 24)};
        f1 = (f32x4){(float)(w.y & 0xffu), (float)((w.y >> 8) & 0xffu), (float)((w.y >> 16) & 0xffu), (float)(w.y >> 24)}; }
    __device__ __forceinline__ void mid(f32x4 (&acc)[2][2][4][2], const Unit& u, int wr, int wc) const {
        const int ln = lane_now(), fr = ln & 15, fq = ln >> 4;
        const int row0 = u.pm * BM + wr * 64 + fr; const int c0 = u.pn * BM + wc * 32 + 8 * fq;
#pragma unroll
        for (int ai = 0; ai < 2; ++ai)
#pragma unroll
            for (int m = 0; m < 4; ++m) { const unsigned char* rowb = (const unsigned char*)(P + (size_t)(row0 + ai * HALF + m * 16) * PLD);
#pragma unroll
                for (int bj = 0; bj < 2; ++bj) { const int c = c0 + bj * HALF; f32x4 a0, a1, b0, b1; u8x8(*(const u32x2*)(rowb + PC_GA * 2 + c), a0, a1); u8x8(*(const u32x2*)(rowb + PC_GB * 2 + c), b0, b1);
#pragma unroll
                    for (int i = 0; i < 4; ++i) { acc[ai][bj][m][0][i] *= a0[i] * __builtin_amdgcn_rcpf(fmaxf(b0[i], 1.f)); acc[ai][bj][m][1][i] *= a1[i] * __builtin_amdgcn_rcpf(fmaxf(b1[i], 1.f)); } } }
    }
    __device__ __forceinline__ void operator()(const f32x4 (&acc)[2][2][4][2], const Unit& u, int wr, int wc, int fr, int fq) const {
        { const int ln = lane_now(); fr = ln & 15; fq = ln >> 4; }
        const int row0 = u.pm * BM + wr * 64 + fr; const int c0 = u.pn * BM + wc * 32 + 8 * fq;
#pragma unroll
        for (int ai = 0; ai < 2; ++ai)
#pragma unroll
            for (int m = 0; m < 4; ++m) { bf16_t* rowp = P + (size_t)(row0 + ai * HALF + m * 16) * PLD;
#pragma unroll
                for (int bj = 0; bj < 2; ++bj) { const int c = c0 + bj * HALF; f32x4 g0, g1; u8x8(*(const u32x2*)((const unsigned char*)rowp + PC_GB * 2 + c), g0, g1);
#pragma unroll
                    for (int i = 0; i < 4; ++i) { g0[i] = fmaxf(g0[i], 1.f) * (1.f / 255.f); g1[i] = fmaxf(g1[i], 1.f) * (1.f / 255.f); }
                    *(u32x4*)(rowp + PC_MRG + c) = pack8(acc[ai][bj][m][0] * g0, acc[ai][bj][m][1] * g1); } }
    }
};
struct EpiOut {
    static constexpr bool PERM = true;
    const float* X; bf16_t* HB; unsigned char* X8; float* RSS;
    __device__ __forceinline__ void operator()(const f32x4 (&acc)[2][2][4][2], const Unit& u, int wr, int wc, int fr, int fq) const {
        { const int ln = lane_now(); fr = ln & 15; fq = ln >> 4; }
        const int row0 = u.pm * BM + wr * 64 + fr; const int c0 = u.pn * BM + wc * 32 + 8 * fq;
#pragma unroll
        for (int ai = 0; ai < 2; ++ai)
#pragma unroll
            for (int m = 0; m < 4; ++m) { const int row = row0 + ai * HALF + m * 16; const size_t ro = (size_t)row * D; float ss = 0.f;
#pragma unroll
                for (int bj = 0; bj < 2; ++bj) { const int c = c0 + bj * HALF;
                    const f32x4 h0 = *(const f32x4*)(X + ro + c) + acc[ai][bj][m][0], h1 = *(const f32x4*)(X + ro + c + 4) + acc[ai][bj][m][1];
                    ss += (h0.x * h0.x + h0.y * h0.y) + (h0.z * h0.z + h0.w * h0.w) + (h1.x * h1.x + h1.y * h1.y) + (h1.z * h1.z + h1.w * h1.w);
                    *(u32x4*)(HB + ro + c) = pack8(h0, h1);
                    u32x2 w8; int w = 0;
                    w = __builtin_amdgcn_cvt_pk_fp8_f32(__builtin_amdgcn_fmed3f(h0.x * 16.f, -448.f, 448.f), __builtin_amdgcn_fmed3f(h0.y * 16.f, -448.f, 448.f), w, false); w = __builtin_amdgcn_cvt_pk_fp8_f32(__builtin_amdgcn_fmed3f(h0.z * 16.f, -448.f, 448.f), __builtin_amdgcn_fmed3f(h0.w * 16.f, -448.f, 448.f), w, true); w8.x = (unsigned)w;
                    w = 0; w = __builtin_amdgcn_cvt_pk_fp8_f32(__builtin_amdgcn_fmed3f(h1.x * 16.f, -448.f, 448.f), __builtin_amdgcn_fmed3f(h1.y * 16.f, -448.f, 448.f), w, false); w = __builtin_amdgcn_cvt_pk_fp8_f32(__builtin_amdgcn_fmed3f(h1.z * 16.f, -448.f, 448.f), __builtin_amdgcn_fmed3f(h1.w * 16.f, -448.f, 448.f), w, true); w8.y = (unsigned)w;
                    *(u32x2*)(X8 + ro + c) = w8; }
                ss += __shfl_xor(ss, 16); ss += __shfl_xor(ss, 32);
                if (fq == 0) (void)__hip_atomic_fetch_add(RSS + row, ss, __ATOMIC_RELAXED, __HIP_MEMORY_SCOPE_AGENT); }
    }
};
struct EpiScores {
    static constexpr bool PERM = true;
    bf16_t* SC;
    const float* RSS;
    __device__ __forceinline__ void operator()(const f32x4 (&acc)[2][2][4][2], const Unit& u, int wr, int wc, int fr, int fq) const {
        const int tb0 = u.pm * 16 + wr * 4; const int cq0 = (u.pn * BM + wc * 32 + 8 * fq) >> 3;
#pragma unroll
        for (int ai = 0; ai < 2; ++ai)
#pragma unroll
            for (int m = 0; m < 4; ++m) { bf16_t* bp = SC + ((size_t)(tb0 + ai * 8 + m) * 256) * 128 + fr * 8;
                const float rs = 1.f / sqrtf(RSS[(tb0 + ai * 8 + m) * 16 + fr] * (1.f / D) + EPS);
#pragma unroll
                for (int bj = 0; bj < 2; ++bj) { u32x4 w = pack8(acc[ai][bj][m][0] * rs, acc[ai][bj][m][1] * rs);
#pragma unroll
                    for (int c = 0; c < 4; ++c) w[c] ^= (((w[c] >> 15) & 0x00010001u) * 0x7FFFu) | 0x80008000u;
                    *(u32x4*)(bp + (size_t)(cq0 + bj * 16) * 128) = w; } }
    }
};
}

#define XB_TMO      128
#define XB_XCNT(j)  (256  + 64 * (j))
#define XB_XSUB(j)  (1280 + 64 * (j))
#define XB_XGEN(j)  (2304 + 64 * (j))
#define XB_TOP      3328
#define XB_TOPGEN   3392
#define XCD_BAR_WORDS 3456
#define XB_SPIN_CAP (1u << 18)
__device__ __forceinline__ unsigned xb_ld(unsigned* p)              { return __hip_atomic_load(p, __ATOMIC_RELAXED, __HIP_MEMORY_SCOPE_AGENT); }
__device__ __forceinline__ unsigned xb_add(unsigned* p, unsigned v) { return __hip_atomic_fetch_add(p, v, __ATOMIC_RELAXED, __HIP_MEMORY_SCOPE_AGENT); }
__device__ __forceinline__ unsigned xb_xcc_id() { return (unsigned)__builtin_amdgcn_s_getreg((3 << 11) | 20) & 0xFu; }
#define XB_SPIN(cond, bar) do { unsigned _sp = 0; while (cond) { __builtin_amdgcn_s_sleep(1); \
    if ((++_sp & 255u) == 0u) { if (xb_ld(&(bar)[XB_TMO])) break; if (_sp > XB_SPIN_CAP) { atomicAdd(&(bar)[XB_TMO], 1u); break; } } } } while (0)
struct XcdBarrier { unsigned* bar; unsigned x; volatile LAS unsigned* st; int wave; };
__device__ __forceinline__ XcdBarrier xcd_barrier_post(unsigned* bar, volatile LAS unsigned* st, int wave) {
    XcdBarrier b; b.bar = bar; b.x = xb_xcc_id(); b.st = st; b.wave = wave;
    if (wave == 0 && lane_now() == 0) (void)xb_add(&bar[XB_XCNT(b.x)], 1u);
    return b;
}
__device__ __forceinline__ void xcd_barrier_complete(unsigned* bar, unsigned x, unsigned& nloc, unsigned& nx) {
    const unsigned G = gridDim.x * gridDim.y * gridDim.z;
    unsigned sum, cnt, mine, sp = 0u;
    for (;;) {
        sum = 0u; cnt = 0u; mine = 0u;
#pragma unroll
        for (unsigned j = 0; j < 16; ++j) { const unsigned c = xb_ld(&bar[XB_XCNT(j)]); sum += c; cnt += (c > 0u) ? 1u : 0u; mine = (j == x) ? c : mine; }
        if (sum == G) break;
        __builtin_amdgcn_s_sleep(1);
        if ((++sp & 255u) == 0u) { if (xb_ld(&bar[XB_TMO])) break; if (sp > XB_SPIN_CAP) { atomicAdd(&bar[XB_TMO], 1u); break; } }
    }
    nloc = mine > 0u ? mine : 1u; nx = cnt > 0u ? cnt : 1u;
}
__device__ __forceinline__ void xcd_barrier(const XcdBarrier& b) {
    asm volatile("s_waitcnt vmcnt(0)" ::: "memory");
    __syncthreads();
    if (b.wave == 0 && lane_now() == 0) {
        unsigned* bar = b.bar;
        __builtin_amdgcn_s_waitcnt(0);
        unsigned nloc = b.st[0], nx = b.st[1];
        if (nloc == 0u) { xcd_barrier_complete(bar, b.x, nloc, nx); b.st[0] = nloc; b.st[1] = nx; }
        const unsigned old = xb_add(&bar[XB_XSUB(b.x)], 1u);
        const unsigned gen = old / nloc;
        if (old + 1u == (gen + 1u) * nloc) {
            __builtin_amdgcn_fence(__ATOMIC_RELEASE, "agent");
            asm volatile("s_waitcnt vmcnt(0)" ::: "memory");
            const unsigned og = xb_add(&bar[XB_TOP], 1u);
            const unsigned tg = og / nx;
            if (og + 1u == (tg + 1u) * nx) xb_add(&bar[XB_TOPGEN], 1u);
            else XB_SPIN(xb_ld(&bar[XB_TOPGEN]) == tg, bar);
            __builtin_amdgcn_fence(__ATOMIC_ACQUIRE, "agent");
            xb_add(&bar[XB_XGEN(b.x)], 1u);
            asm volatile("s_waitcnt vmcnt(0)" ::: "memory");
        } else {
            XB_SPIN(xb_ld(&bar[XB_XGEN(b.x)]) == gen, bar);
            __builtin_amdgcn_fence(__ATOMIC_ACQUIRE, "agent");
            asm volatile("s_waitcnt vmcnt(0)" ::: "memory");
        }
    }
    __syncthreads();
}

struct Args {
    const float* in[20]; float* out; unsigned char* ws; int ph_lo, ph_hi, li, pad;
};
enum { I_X = 0, I_N1G, I_WIN, I_WGU, I_BG, I_GLAG, I_SLNG, I_SLNB, I_SW, I_SB, I_WBA, I_WBB, I_WOUT, I_N2G, I_WQ, I_K1, I_K2, I_PU, I_PV, I_FG };

struct Frame {
    LAS unsigned char* lds;
    int tid, lane, wave, G, bid;
};

__device__ __forceinline__ float clamp448(float v) { return __builtin_amdgcn_fmed3f(v, -448.f, 448.f); }
template <int MODE, bool F8 = false>
__device__ __forceinline__ void p0_transpose_item(const float* W, int K, int Nsrc, int Ndst, bf16_t* WT, LAS float* scr, int item, int lane, float sc8 = 1.f, int ldk = 0) {
    if (ldk == 0) ldk = K;
    const int nblk = Ndst / 32, kb = item / nblk, nb = item % nblk, k0 = 64 * kb, n0 = 32 * nb;
    const int nd = n0 + (lane & 31);
    int sc = nd; bool valid = true;
    if (MODE == 1) { if (nd < 2048) sc = nd; else if (nd < 2560) sc = nd + 16; else if (nd < 2576) sc = 2048 + (nd - 2560); else if (nd < 2816) { sc = 0; valid = false; } else sc = nd - 240; }
    float tv[32];
#pragma unroll
    for (int i = 0; i < 32; ++i) { const int kk = 2 * i + (lane >> 5); tv[i] = valid ? W[(size_t)(k0 + kk) * Nsrc + sc] : 0.f; }
#pragma unroll
    for (int i = 0; i < 32; ++i) { const int kk = 2 * i + (lane >> 5); scr[kk * 33 + (lane & 31)] = tv[i]; }
    LDS_WAIT(); asm volatile("" ::: "memory");
    if (F8) {
        const int c = lane & 3;
#pragma unroll
        for (int j = 0; j < 2; ++j) { const int n = (lane >> 2) + 16 * j; const LAS float* s = scr + (16 * c) * 33 + n; u32x4 o;
#pragma unroll
            for (int q = 0; q < 4; ++q) { int w = 0; w = __builtin_amdgcn_cvt_pk_fp8_f32(clamp448(s[(4 * q) * 33] * sc8), clamp448(s[(4 * q + 1) * 33] * sc8), w, false);
                w = __builtin_amdgcn_cvt_pk_fp8_f32(clamp448(s[(4 * q + 2) * 33] * sc8), clamp448(s[(4 * q + 3) * 33] * sc8), w, true); o[q] = (unsigned)w; }
            *(u32x4*)((unsigned char*)WT + (size_t)(n0 + n) * ldk + k0 + 16 * c) = o; }
    } else {
    const int c = lane & 7;
#pragma unroll
    for (int j = 0; j < 4; ++j) { const int n = (lane >> 3) + 8 * j; const LAS float* s = scr + (8 * c) * 33 + n;
        u32x4 o; o.x = pk2(s[0 * 33], s[1 * 33]); o.y = pk2(s[2 * 33], s[3 * 33]); o.z = pk2(s[4 * 33], s[5 * 33]); o.w = pk2(s[6 * 33], s[7 * 33]);
        *(u32x4*)(WT + (size_t)(n0 + n) * ldk + k0 + 8 * c) = o; }
    }
    LDS_WAIT(); asm volatile("" ::: "memory");
}
template <int OM, int NB>
__device__ __forceinline__ void rms_rows_to_bf16(int lane, const float* x0, size_t xstride, const float* g, bf16_t* o0, size_t ostride, unsigned* o80 = nullptr, size_t o8stride = 0, const bf16_t* add0 = nullptr, size_t addstride = 0, bf16_t* hb0 = nullptr, size_t hbstride = 0) {
    f32x4 v[NB][4]; float s[NB];
#pragma unroll
    for (int b = 0; b < NB; ++b) { const float* xr = x0 + b * xstride + 8 * lane;
#pragma unroll
        for (int j = 0; j < 2; ++j) { v[b][2 * j] = *(const f32x4*)(xr + 512 * j); v[b][2 * j + 1] = *(const f32x4*)(xr + 512 * j + 4); } }
    if (add0) {
        u32x4 ad[NB][2];
#pragma unroll
        for (int b = 0; b < NB; ++b) { const bf16_t* ar = add0 + b * addstride + 8 * lane;
#pragma unroll
            for (int j = 0; j < 2; ++j) ad[b][j] = *(const u32x4*)(ar + 512 * j); }
#pragma unroll
        for (int b = 0; b < NB; ++b)
#pragma unroll
            for (int j = 0; j < 2; ++j) { v[b][2 * j] = v[b][2 * j] + (f32x4){bflo(ad[b][j].x), bfhi(ad[b][j].x), bflo(ad[b][j].y), bfhi(ad[b][j].y)};
                v[b][2 * j + 1] = v[b][2 * j + 1] + (f32x4){bflo(ad[b][j].z), bfhi(ad[b][j].z), bflo(ad[b][j].w), bfhi(ad[b][j].w)}; }
    }
    if (hb0) {
#pragma unroll
        for (int b = 0; b < NB; ++b)
#pragma unroll
            for (int j = 0; j < 2; ++j) *(u32x4*)(hb0 + b * hbstride + 512 * j + 8 * lane) = pg8::pack8(v[b][2 * j], v[b][2 * j + 1]);
    }
#pragma unroll
    for (int b = 0; b < NB; ++b) { s[b] = 0.f;
#pragma unroll
        for (int j = 0; j < 4; ++j) s[b] += (v[b][j].x * v[b][j].x + v[b][j].y * v[b][j].y) + (v[b][j].z * v[b][j].z + v[b][j].w * v[b][j].w); }
#pragma unroll
    for (int o = 1; o < 64; o <<= 1) {
#pragma unroll
        for (int b = 0; b < NB; ++b) s[b] += __shfl_xor(s[b], o); }
    const float* gr = g + 8 * lane;
#pragma unroll
    for (int b = 0; b < NB; ++b) { const float rstd = 1.f / sqrtf(s[b] * (1.f / D) + EPS);
#pragma unroll
        for (int j = 0; j < 2; ++j) { const f32x4 y0 = v[b][2 * j] * rstd * *(const f32x4*)(gr + 512 * j), y1 = v[b][2 * j + 1] * rstd * *(const f32x4*)(gr + 512 * j + 4);
            const u32x4 o = pg8::pack8(y0, y1);
            if (OM & 1) *(u32x4*)(o0 + b * ostride + 512 * j + 8 * lane) = o;
            if (OM == 3) { u32x2 w8;
#pragma unroll
                for (int h = 0; h < 2; ++h) { int w = 0; w = __builtin_amdgcn_cvt_pk_fp8_f32(clamp448(bflo(o[2 * h]) * 16.f), clamp448(bfhi(o[2 * h]) * 16.f), w, false);
                    w = __builtin_amdgcn_cvt_pk_fp8_f32(clamp448(bflo(o[2 * h + 1]) * 16.f), clamp448(bfhi(o[2 * h + 1]) * 16.f), w, true); w8[h] = (unsigned)w; }
                *(u32x2*)(o80 + b * o8stride + 128 * j + 2 * lane) = w8; }
            if (OM == 2) { u32x2 w8; int w = 0;
                w = __builtin_amdgcn_cvt_pk_fp8_f32(clamp448(y0.x * 16.f), clamp448(y0.y * 16.f), w, false); w = __builtin_amdgcn_cvt_pk_fp8_f32(clamp448(y0.z * 16.f), clamp448(y0.w * 16.f), w, true); w8.x = (unsigned)w;
                w = 0; w = __builtin_amdgcn_cvt_pk_fp8_f32(clamp448(y1.x * 16.f), clamp448(y1.y * 16.f), w, false); w = __builtin_amdgcn_cvt_pk_fp8_f32(clamp448(y1.z * 16.f), clamp448(y1.w * 16.f), w, true); w8.y = (unsigned)w;
                *(u32x2*)(o80 + b * o8stride + 128 * j + 2 * lane) = w8; } } }
}
__device__ __forceinline__ float wave_max(float v) {
#pragma unroll
    for (int o = 1; o < 64; o <<= 1) v = fmaxf(v, __shfl_xor(v, o));
    return v;
}
template <int NB>
__device__ __forceinline__ void cvt_rows_fp8(int lane, const float* const (&src)[NB], unsigned char* const (&dst16)[NB], float* const (&scale_out)[NB]) {
    f32x4 v[NB][4]; float m[NB];
#pragma unroll
    for (int b = 0; b < NB; ++b) {
#pragma unroll
        for (int j = 0; j < 4; ++j) v[b][j] = *(const GAS f32x4*)(src[b] + 16 * lane + 4 * j); }
#pragma unroll
    for (int b = 0; b < NB; ++b) { m[b] = 0.f;
#pragma unroll
        for (int j = 0; j < 4; ++j) m[b] = fmaxf(m[b], fmaxf(fmaxf(fabsf(v[b][j].x), fabsf(v[b][j].y)), fmaxf(fabsf(v[b][j].z), fabsf(v[b][j].w)))); }
#pragma unroll
    for (int o = 1; o < 64; o <<= 1) {
#pragma unroll
        for (int b = 0; b < NB; ++b) m[b] = fmaxf(m[b], __shfl_xor(m[b], o)); }
#pragma unroll
    for (int b = 0; b < NB; ++b) { const float inv = m[b] > 0.f ? 224.f / m[b] : 0.f, sc = m[b] > 0.f ? m[b] * (1.f / 224.f) : 1.f;
        u32x4 o;
#pragma unroll
        for (int j = 0; j < 4; ++j) { int w = 0; w = __builtin_amdgcn_cvt_pk_fp8_f32(v[b][j].x * inv, v[b][j].y * inv, w, false); w = __builtin_amdgcn_cvt_pk_fp8_f32(v[b][j].z * inv, v[b][j].w * inv, w, true); o[j] = (unsigned)w; }
        *(GAS u32x4*)dst16[b] = o;
        if (lane == 0) *(GAS float*)scale_out[b] = sc; }
}
__device__ __forceinline__ unsigned fp4_code(float t) { const float a = fabsf(t);
    const unsigned c = (unsigned)(a >= 0.25f) + (unsigned)(a >= 0.75f) + (unsigned)(a >= 1.25f) + (unsigned)(a >= 1.75f) + (unsigned)(a >= 2.5f) + (unsigned)(a >= 3.5f) + (unsigned)(a >= 5.f);
    return c | (t < 0.f ? 8u : 0u); }
template <int NB, bool PERMV = false>
__device__ __forceinline__ void cvt_rows_fp4(int lane, const float* const (&src)[NB], unsigned char* const (&dst8)[NB], float* const (&scale_out)[NB], const float* colmul = nullptr) {
    f32x4 v[NB][4]; float m[NB];
#pragma unroll
    for (int b = 0; b < NB; ++b) {
#pragma unroll
        for (int j = 0; j < 4; ++j) v[b][j] = *(const GAS f32x4*)(src[b] + 16 * lane + 4 * j); }
    if (colmul) {
#pragma unroll
        for (int j = 0; j < 4; ++j) { const f32x4 cm = *(const f32x4*)(colmul + 16 * lane + 4 * j);
#pragma unroll
            for (int b = 0; b < NB; ++b) v[b][j] = v[b][j] * cm; } }
#pragma unroll
    for (int b = 0; b < NB; ++b) { m[b] = 0.f;
#pragma unroll
        for (int j = 0; j < 4; ++j) m[b] = fmaxf(m[b], fmaxf(fmaxf(fabsf(v[b][j].x), fabsf(v[b][j].y)), fmaxf(fabsf(v[b][j].z), fabsf(v[b][j].w)))); }
#pragma unroll
    for (int o = 1; o < 64; o <<= 1) {
#pragma unroll
        for (int b = 0; b < NB; ++b) m[b] = fmaxf(m[b], __shfl_xor(m[b], o)); }
#pragma unroll
    for (int b = 0; b < NB; ++b) { const float inv = m[b] > 0.f ? 6.f / m[b] : 0.f, sc = m[b] > 0.f ? m[b] * (1.f / 6.f) : 1.f;
        u32x2 o;
#pragma unroll
        for (int h = 0; h < 2; ++h) { unsigned w = 0;
            const f32x4 t0 = v[b][2 * h] * inv, t1 = v[b][2 * h + 1] * inv;
            w = __builtin_amdgcn_cvt_scalef32_pk_fp4_f32(w, t0.x, t0.y, 1.f, 0); w = __builtin_amdgcn_cvt_scalef32_pk_fp4_f32(w, t0.z, t0.w, 1.f, 1);
            w = __builtin_amdgcn_cvt_scalef32_pk_fp4_f32(w, t1.x, t1.y, 1.f, 2); w = __builtin_amdgcn_cvt_scalef32_pk_fp4_f32(w, t1.z, t1.w, 1.f, 3);
            o[h] = w; }
        if (PERMV) { *(GAS unsigned*)(dst8[b] + 16 * ((2 * lane) & 31) + 4 * (lane >> 4)) = o.x; *(GAS unsigned*)(dst8[b] + 16 * ((2 * lane + 1) & 31) + 4 * (lane >> 4)) = o.y; }
        else *(GAS u32x2*)dst8[b] = o;
        if (lane == 0) *(GAS float*)scale_out[b] = sc; }
}
__device__ __forceinline__ void convert_tables(const Frame& F, const Args& A, int wi, int nw) {
    unsigned char* ws = A.ws; const int gw = wi, NGW = nw;
    {
        int mc = gw;
        for (; mc + 3 * NGW < NEXP; mc += 4 * NGW) { const float* src[4]; unsigned char* dst[4]; float* sco[4];
#pragma unroll
            for (int b = 0; b < 4; ++b) { const int e = mc + b * NGW; src[b] = A.in[I_PU] + (size_t)e * D; dst[b] = ws + WS_U8 + (size_t)((e & (UNG - 1)) * (NEXP / UNG) + (e >> UNG_SH)) * 512 + 8 * F.lane; sco[b] = (float*)(ws + WS_SU) + e; }
            cvt_rows_fp4<4>(F.lane, src, dst, sco, A.in[I_N2G]); }
        for (; mc < NEXP; mc += NGW) { const float* src[1]; unsigned char* dst[1]; float* sco[1];
            const int e = mc; src[0] = A.in[I_PU] + (size_t)e * D; dst[0] = ws + WS_U8 + (size_t)((e & (UNG - 1)) * (NEXP / UNG) + (e >> UNG_SH)) * 512 + 8 * F.lane; sco[0] = (float*)(ws + WS_SU) + e;
            cvt_rows_fp4<1>(F.lane, src, dst, sco, A.in[I_N2G]); }
    }
    if (V_F4) {
        int mc = gw;
        for (; mc + 3 * NGW < NEXP; mc += 4 * NGW) { const float* src[4]; unsigned char* dst[4]; float* sco[4];
#pragma unroll
            for (int b = 0; b < 4; ++b) { const int e = mc + b * NGW; src[b] = A.in[I_PV] + (size_t)e * D; dst[b] = ws + WS_V8 + (size_t)e * 512; sco[b] = (float*)(ws + WS_SV) + e; }
            cvt_rows_fp4<4, true>(F.lane, src, dst, sco); }
        for (; mc < NEXP; mc += NGW) { const float* src[1]; unsigned char* dst[1]; float* sco[1];
            const int e = mc; src[0] = A.in[I_PV] + (size_t)e * D; dst[0] = ws + WS_V8 + (size_t)e * 512; sco[0] = (float*)(ws + WS_SV) + e;
            cvt_rows_fp4<1, true>(F.lane, src, dst, sco); }
    } else {
        int mc = gw;
        for (; mc + 3 * NGW < NEXP; mc += 4 * NGW) { const float* src[4]; unsigned char* dst[4]; float* sco[4];
#pragma unroll
            for (int b = 0; b < 4; ++b) { const int e = mc + b * NGW; src[b] = A.in[I_PV] + (size_t)e * D; dst[b] = ws + WS_V8 + ((size_t)(F.lane >> 3) * NEXP + e) * 128 + 16 * (F.lane & 7); sco[b] = (float*)(ws + WS_SV) + e; }
            cvt_rows_fp8<4>(F.lane, src, dst, sco); }
        for (; mc < NEXP; mc += NGW) { const float* src[1]; unsigned char* dst[1]; float* sco[1];
            const int e = mc; src[0] = A.in[I_PV] + (size_t)e * D; dst[0] = ws + WS_V8 + ((size_t)(F.lane >> 3) * NEXP + e) * 128 + 16 * (F.lane & 7); sco[0] = (float*)(ws + WS_SV) + e;
            cvt_rows_fp8<1>(F.lane, src, dst, sco); }
    }
}
__device__ __forceinline__ void phase0(const Frame& F, const Args& A) {
    unsigned char* ws = A.ws;
    if (!SC_F8) {
        const int l = F.lane, fr = l & 15, q = l >> 4;
        bf16_t* WQF = (bf16_t*)(ws + WS_WQF);
        for (int it = F.bid * NWAVES + F.wave; it < 2048; it += F.G * NWAVES) {
            const int kh = it & 1, kt = (it >> 1) & 63, hh = it >> 7;
            const float* kX = (hh & 1) ? A.in[I_K2] : A.in[I_K1];
            const float* ap = A.in[I_WQ] + (size_t)(kt * 16 + fr) * 2048 + hh * 128 + 4 * q;
            f32x4 a[8];
#pragma unroll
            for (int t = 0; t < 8; ++t) a[t] = *(const f32x4*)(ap + 16 * t);
#pragma unroll
            for (int kb = 0; kb < 4; ++kb) { const int key0 = kh * 64 + kb * 16;
                const float* bp = kX + (size_t)(key0 + fr) * 128 + 4 * q;
                f32x4 b[8];
#pragma unroll
                for (int t = 0; t < 8; ++t) b[t] = *(const f32x4*)(bp + 16 * t);
                f32x4 d = {0.f, 0.f, 0.f, 0.f};
#pragma unroll
                for (int t = 0; t < 8; ++t)
#pragma unroll
                    for (int c = 0; c < 4; ++c) d = __builtin_amdgcn_mfma_f32_16x16x4f32(a[t][c], b[t][c], d, 0, 0, 0);
                const f32x4 g2 = *(const f32x4*)(A.in[I_N2G] + kt * 16 + 4 * q);
                u32x2 o; o.x = pk2(d[0] * g2.x, d[1] * g2.y); o.y = pk2(d[2] * g2.z, d[3] * g2.w);
                *(u32x2*)(WQF + (size_t)(hh * 128 + key0 + fr) * 1024 + kt * 16 + 4 * q) = o; }
        }
    } else {
        LAS float* kx = (LAS float*)F.lds;
        LAS float* wt = (LAS float*)(F.lds + 128 * 129 * 4);
        bf16_t* WQF = (bf16_t*)(ws + WS_WQF);
        for (int it = F.bid; it < 512; it += F.G) {
            const int hh = it >> 5, kblk = it & 31, k0 = kblk * 32;
            const float* kX = (hh & 1) ? A.in[I_K2] : A.in[I_K1];
            __syncthreads();
            for (int e = F.tid; e < 128 * 128; e += 512) kx[(e >> 7) * 129 + (e & 127)] = kX[e];
            for (int e = F.tid; e < 32 * 128; e += 512) wt[e] = A.in[I_WQ][(size_t)(k0 + (e >> 7)) * 2048 + hh * 128 + (e & 127)];
            __syncthreads();
            const int key = F.tid & 127, kq = F.tid >> 7;
            float acc[8];
#pragma unroll
            for (int i = 0; i < 8; ++i) acc[i] = 0.f;
            for (int d = 0; d < 128; ++d) { const float b = kx[key * 129 + d];
#pragma unroll
                for (int i = 0; i < 8; ++i) acc[i] += wt[(kq * 8 + i) * 128 + d] * b; }
            if (SC_F8) { u32x2 o;
#pragma unroll
                for (int h2 = 0; h2 < 2; ++h2) { int w = 0; w = __builtin_amdgcn_cvt_pk_fp8_f32(clamp448(acc[4 * h2] * 1024.f), clamp448(acc[4 * h2 + 1] * 1024.f), w, false);
                    w = __builtin_amdgcn_cvt_pk_fp8_f32(clamp448(acc[4 * h2 + 2] * 1024.f), clamp448(acc[4 * h2 + 3] * 1024.f), w, true); o[h2] = (unsigned)w; }
                *(u32x2*)((unsigned char*)WQF + (size_t)(hh * 128 + key) * 1024 + k0 + kq * 8) = o;
            } else {
            u32x4 o; o.x = pk2(acc[0], acc[1]); o.y = pk2(acc[2], acc[3]); o.z = pk2(acc[4], acc[5]); o.w = pk2(acc[6], acc[7]);
            *(u32x4*)(WQF + (size_t)(hh * 128 + key) * 1024 + k0 + kq * 8) = o; }
        }
        __syncthreads();
    }
    LAS float* scr = (LAS float*)(F.lds + F.wave * 16384);
    const int gw = F.bid * NWAVES + F.wave, NGW = F.G * NWAVES;
    constexpr int I_IN = 16 * (NPROJ / 32), I_A = 8 * 32, I_B = 8 * 32, I_O = 16 * 32;
    constexpr int NITEMS = I_IN + I_A + I_B + I_O;
    for (int it = gw; it < NITEMS; it += NGW) {
        int r = it;
        if (r < I_IN) { if ((r % (NPROJ / 32)) * 32 >= F8_LO * 256) p0_transpose_item<1, true>(A.in[I_WIN], 1024, 5136, NPROJ, (bf16_t*)(ws + WS_W8), scr, r, F.lane, 1024.f);
                        else p0_transpose_item<1, false>(A.in[I_WIN], 1024, 5136, NPROJ, (bf16_t*)(ws + WS_WIN), scr, r, F.lane); continue; } r -= I_IN;
        if (r < I_A) { p0_transpose_item<0>(A.in[I_WBA], 512, 1024, 1024, (bf16_t*)(ws + WS_WA), scr, r, F.lane, 1.f, 1024); continue; } r -= I_A;
        if (r < I_B) { p0_transpose_item<0>(A.in[I_WBB], 512, 1024, 1024, (bf16_t*)(ws + WS_WA) + 512, scr, r, F.lane, 1.f, 1024); continue; } r -= I_B;
        p0_transpose_item<0>(A.in[I_WOUT], 1024, 1024, 1024, (bf16_t*)(ws + WS_WOUT), scr, r, F.lane);
    }
    constexpr int OM1 = F8_LO <= 0 ? 2 : (F8_LO >= 21 ? 1 : 3);
    { int m = gw; for (; m + 3 * NGW < T_TOK; m += 4 * NGW) rms_rows_to_bf16<OM1, 4>(F.lane, A.in[I_X] + (size_t)m * D, (size_t)NGW * D, A.in[I_N1G], (bf16_t*)(ws + WS_N1) + (size_t)m * D, (size_t)NGW * D, (unsigned*)(ws + WS_N18) + (size_t)m * 256, (size_t)NGW * 256);
      for (; m < T_TOK; m += NGW) rms_rows_to_bf16<OM1, 1>(F.lane, A.in[I_X] + (size_t)m * D, 0, A.in[I_N1G], (bf16_t*)(ws + WS_N1) + (size_t)m * D, 0, (unsigned*)(ws + WS_N18) + (size_t)m * 256, 0); }
}

__device__ __forceinline__ float log_sigmoid(float z) { return fminf(z, 0.f) - log1pf(__expf(-fabsf(z))); }

__device__ __forceinline__ unsigned f32x4_to_fp8x4(float a, float b, float c, float d) { int w = 0;
    w = __builtin_amdgcn_cvt_pk_fp8_f32(__builtin_amdgcn_fmed3f(a, -448.f, 448.f), __builtin_amdgcn_fmed3f(b, -448.f, 448.f), w, false);
    w = __builtin_amdgcn_cvt_pk_fp8_f32(__builtin_amdgcn_fmed3f(c, -448.f, 448.f), __builtin_amdgcn_fmed3f(d, -448.f, 448.f), w, true); return (unsigned)w; }
__device__ __forceinline__ u32x2 fp8x4_to_bf16x4(unsigned w) { const f32x2 lo = __builtin_amdgcn_cvt_pk_f32_fp8((int)w, false), hi = __builtin_amdgcn_cvt_pk_f32_fp8((int)w, true);
    u32x2 o; o.x = pk2(lo.x, lo.y); o.y = pk2(hi.x, hi.y); return o; }
template <bool DRY>
__device__ __forceinline__ void gla_chunk_phase(const Frame& F, const Args& A) {
    unsigned char* ws = A.ws;
    const bf16_t* P = (const bf16_t*)(ws + WS_P);
    const float* ALR = (const float*)(ws + WS_ALR);
    LAS float* alr = (LAS float*)F.lds;
    LAS float* tot = (LAS float*)(F.lds + 4096);
    LAS bf16_t* kdT = (LAS bf16_t*)(F.lds + 8192);
    LAS bf16_t* vT = (LAS bf16_t*)(F.lds + 26624);
    LAS bf16_t* stT = (LAS bf16_t*)(F.lds + 45056);
    const int tid = F.tid, kk = tid & 127, seg = tid >> 7;
    const bool hconst = (F.G & 3) == 0;
    int hcur = -1; float w[16]; float bias = 0.f;
#pragma unroll
    for (int j = 0; j < 16; ++j) w[j] = 0.f;
    float na0, na1; bf16_t nk[16], nv[16];
#define GC_LOAD(unit) do { const int h_ = (unit) & 3, c_ = ((unit) >> 2) & 63, b_ = (unit) >> 8; const int t0_ = b_ * SEQ + c_ * 64; \
        na0 = ALR[(size_t)t0_ * 16 + tid]; na1 = ALR[(size_t)t0_ * 16 + 512 + tid]; \
        const bf16_t* kp_ = P + (size_t)(t0_ + 16 * seg) * PLD + PC_K + h_ * 128 + kk; const bf16_t* vp_ = P + (size_t)(t0_ + 16 * seg) * PLD + PC_V + h_ * 128 + kk; \
        _Pragma("unroll") for (int i_ = 0; i_ < 16; ++i_) { nk[i_] = kp_[(size_t)i_ * PLD]; nv[i_] = vp_[(size_t)i_ * PLD]; } } while (0)
    int unit = F.bid;
    if (unit < 2048) GC_LOAD(unit);
    for (; unit < 2048; unit += F.G) {
        const int h = unit & 3;
        if (h != hcur) { hcur = h;
#pragma unroll
            for (int j = 0; j < 16; ++j) w[j] = A.in[I_WGU][(size_t)j * 512 + h * 128 + kk];
            bias = A.in[I_BG][h * 128 + kk]; }
        __syncthreads();
        alr[tid] = na0; alr[512 + tid] = na1;
        bf16_t kr[16], vr[16];
#pragma unroll
        for (int i = 0; i < 16; ++i) { kr[i] = nk[i]; vr[i] = nv[i]; }
        if (unit + F.G < 2048) GC_LOAD(unit + F.G);
        __syncthreads();
        float cum[16]; float run = 0.f;
#pragma unroll
        for (int i = 0; i < 16; ++i) { const LAS f32x4* ap = (const LAS f32x4*)(alr + (16 * seg + i) * 16); float z = bias;
#pragma unroll
            for (int q = 0; q < 4; ++q) { const f32x4 a4 = ap[q]; z += a4.x * w[4 * q] + a4.y * w[4 * q + 1] + a4.z * w[4 * q + 2] + a4.w * w[4 * q + 3]; }
            const float ls = fminf(z, 0.f) - __logf(1.f + __expf(-fabsf(z)));
            run += ls * (1.f / 16.f); cum[i] = run; }
        tot[seg * 128 + kk] = run;
        __syncthreads();
        {
            const float t0s = tot[kk], t1s = tot[128 + kk], t2s = tot[256 + kk], t3s = tot[384 + kk];
            const float total = (t0s + t1s) + (t2s + t3s);
            const float prefix = seg == 0 ? 0.f : (seg == 1 ? t0s : (seg == 2 ? t0s + t1s : t0s + t1s + t2s));
            unsigned kw[8], vw[8];
#pragma unroll
            for (int i = 0; i < 8; ++i) {
                const float e0 = __expf(total - (prefix + cum[2 * i])), e1 = __expf(total - (prefix + cum[2 * i + 1]));
                kw[i] = pk2(bf1(kr[2 * i]) * e0, bf1(kr[2 * i + 1]) * e1); vw[i] = (unsigned)vr[2 * i] | ((unsigned)vr[2 * i + 1] << 16);
            }
            *(LAS u32x4*)(kdT + kk * 72 + 16 * seg) = (u32x4){kw[0], kw[1], kw[2], kw[3]}; *(LAS u32x4*)(kdT + kk * 72 + 16 * seg + 8) = (u32x4){kw[4], kw[5], kw[6], kw[7]};
            *(LAS u32x4*)(vT + kk * 72 + 16 * seg) = (u32x4){vw[0], vw[1], vw[2], vw[3]}; *(LAS u32x4*)(vT + kk * 72 + 16 * seg + 8) = (u32x4){vw[4], vw[5], vw[6], vw[7]};
            if (seg == 0) ((float*)(DRY ? (unsigned char*)A.out + 96 * MiB : ws + WS_DEC))[(size_t)unit * 128 + kk] = __expf(total);
        }
        __syncthreads();
        {
            const int w8 = F.wave, l = F.lane, fr = l & 15, fq = l >> 4;
            f32x4 acc[8];
#pragma unroll
            for (int n = 0; n < 8; ++n) acc[n] = (f32x4){0.f, 0.f, 0.f, 0.f};
#pragma unroll
            for (int ks = 0; ks < 2; ++ks) {
                const bf16x8 a = *(const LAS bf16x8*)(kdT + (16 * w8 + fr) * 72 + 32 * ks + 8 * fq);
#pragma unroll
                for (int n = 0; n < 8; ++n) { const bf16x8 bb = *(const LAS bf16x8*)(vT + (16 * n + fr) * 72 + 32 * ks + 8 * fq);
                    acc[n] = __builtin_amdgcn_mfma_f32_16x16x32_bf16(a, bb, acc[n], 0, 0, 0); }
            }
#pragma unroll
            for (int n = 0; n < 8; ++n) {
                if (ST_F8) *(LAS unsigned*)((LAS unsigned char*)stT + (16 * n + fr) * 144 + 16 * w8 + 4 * fq) = f32x4_to_fp8x4(acc[n][0], acc[n][1], acc[n][2], acc[n][3]);
                else { u32x2 o; o.x = pk2(acc[n][0], acc[n][1]); o.y = pk2(acc[n][2], acc[n][3]); *(LAS u32x2*)(stT + (16 * n + fr) * 136 + 16 * w8 + 4 * fq) = o; } }
        }
        __syncthreads();
        {
            const int vv = tid >> 2, part = tid & 3;
            if (ST_F8) { unsigned char* ST8 = (DRY ? (unsigned char*)A.out : ws + WS_N1) + (size_t)unit * 16384;
#pragma unroll
                for (int q = 0; q < 2; ++q) *(u32x4*)(ST8 + (size_t)vv * 128 + 32 * part + 16 * q) = *(const LAS u32x4*)((const LAS unsigned char*)stT + vv * 144 + 32 * part + 16 * q);
            } else {
            bf16_t* ST = (bf16_t*)(DRY ? (unsigned char*)A.out : ws + WS_N1) + (size_t)unit * 16384;
#pragma unroll
            for (int q = 0; q < 4; ++q) *(u32x4*)(ST + (size_t)vv * 128 + 32 * part + 8 * q) = *(const LAS u32x4*)(stT + vv * 136 + 32 * part + 8 * q);
            }
        }
    }
#undef GC_LOAD
    (void)hconst;
}

template <bool DRY>
__device__ __forceinline__ void sgu_unit(const Frame& F, const Args& A, int unit, bool stats) {
    const int g = unit & 3, blk = (unit >> 2) & 31, b = unit >> 7;
    const int t0 = b * SEQ + blk * 128;
    bf16_t* P = (bf16_t*)(A.ws + WS_P);
    LAS bf16_t* wA = (LAS bf16_t*)F.lds;
    LAS bf16_t* vnT = (LAS bf16_t*)(F.lds + 34816);
    LAS float* st = (LAS float*)(F.lds + 69632);
    LAS bf16_t* suS = (LAS bf16_t*)(F.lds + 70656);
    const int tid = F.tid;
    __syncthreads();
    if (stats) {
        if (tid < 128) { const float* lp = (const float*)(A.ws + WS_LNS) + (size_t)(t0 + tid) * 2; const float sm = lp[0], s2 = lp[1];
            const float mu = sm * (1.f / 512.f); const float var = fmaxf(s2 * (1.f / 512.f) - mu * mu, 0.f);
            st[2 * tid] = mu; st[2 * tid + 1] = 1.f / sqrtf(var + EPS); }
    }
    {
        const int i = tid >> 2, jb = (tid & 3) * 32;
        const float* wp = A.in[I_SW] + (size_t)g * 16384 + (size_t)i * 128 + jb;
        const bf16_t* sup = P + (size_t)(t0 + i) * PLD + PC_SU + g * 128 + jb;
#pragma unroll
        for (int q = 0; q < 4; ++q) { const f32x4 a = *(const f32x4*)(wp + 8 * q), bq = *(const f32x4*)(wp + 8 * q + 4);
            const bool z = (i < 64) && (jb + 8 * q >= 64);
            u32x4 o; o.x = pk2(a.x, a.y); o.y = pk2(a.z, a.w); o.z = pk2(bq.x, bq.y); o.w = pk2(bq.z, bq.w);
            if (z) o = (u32x4){0u, 0u, 0u, 0u};
            *(LAS u32x4*)(wA + i * 136 + jb + 8 * q) = o;
            *(LAS u32x4*)(suS + i * 136 + jb + 8 * q) = *(const u32x4*)(sup + 8 * q); }
    }
    const int cch = tid & 127, seg = tid >> 7;
    bf16_t xr[32];
    { const bf16_t* sp = P + (size_t)(t0 + 32 * seg) * PLD + PC_SV + g * 128 + cch;
#pragma unroll
      for (int i = 0; i < 32; ++i) xr[i] = sp[(size_t)i * PLD]; }
    const float lg = A.in[I_SLNG][g * 128 + cch], lb = A.in[I_SLNB][g * 128 + cch];
    __syncthreads();
    {
        unsigned ow[16];
#pragma unroll
        for (int i = 0; i < 16; ++i) { const int j = 32 * seg + 2 * i; const f32x4 ms = *(const LAS f32x4*)(st + 2 * j);
            ow[i] = pk2((bf1(xr[2 * i]) - ms.x) * ms.y * lg + lb, (bf1(xr[2 * i + 1]) - ms.z) * ms.w * lg + lb); }
#pragma unroll
        for (int q = 0; q < 4; ++q) *(LAS u32x4*)(vnT + cch * 136 + 32 * seg + 8 * q) = (u32x4){ow[4 * q], ow[4 * q + 1], ow[4 * q + 2], ow[4 * q + 3]};
    }
    __syncthreads();
    {
        const int w = F.wave, l = F.lane, fr = l & 15, fq = l >> 4;
        f32x4 acc[8];
#pragma unroll
        for (int n = 0; n < 8; ++n) acc[n] = (f32x4){0.f, 0.f, 0.f, 0.f};
#pragma unroll
        for (int ks = 0; ks < 4; ++ks) {
            const bf16x8 a = *(const LAS bf16x8*)(wA + (16 * w + fr) * 136 + 32 * ks + 8 * fq);
#pragma unroll
            for (int n = 0; n < 8; ++n) { const bf16x8 bb = *(const LAS bf16x8*)(vnT + (16 * n + fr) * 136 + 32 * ks + 8 * fq);
                acc[n] = __builtin_amdgcn_mfma_f32_16x16x32_bf16(a, bb, acc[n], 0, 0, 0); }
        }
#pragma unroll
        for (int jj = 0; jj < 4; ++jj) { const int i = 16 * w + 4 * fq + jj; const float bias = A.in[I_SB][g * 128 + i];
            LAS bf16_t* rp = suS + i * 136 + fr;
#pragma unroll
            for (int n = 0; n < 8; ++n) { const float su = bf1(rp[16 * n]); rp[16 * n] = (bf16_t)f2bf(su * (acc[n][jj] + bias)); } }
    }
    __syncthreads();
    {
        const int i = tid >> 2, jb = (tid & 3) * 32;
        bf16_t* yp = DRY ? (bf16_t*)A.out + (size_t)(t0 + i) * 512 + g * 128 + jb : P + (size_t)(t0 + i) * PLD + PC_SU + g * 128 + jb;
#pragma unroll
        for (int q = 0; q < 4; ++q) *(u32x4*)(yp + 8 * q) = *(const LAS u32x4*)(suS + i * 136 + jb + 8 * q);
    }
}

template <bool DRY>
__device__ __forceinline__ void gla_scan(const Frame& F, const Args& A) {
    const float* DEC = (const float*)(A.ws + WS_DEC);
    if (ST_F8) {
        unsigned char* S8 = A.ws + WS_N1; unsigned char* SO8 = DRY ? (unsigned char*)A.out : S8;
        if (F.tid < 256) for (int gi = F.bid * 256 + F.tid; gi < 65536; gi += F.G * 256) {
            const int k8 = gi & 15, vv = (gi >> 4) & 127, h = (gi >> 11) & 3, b = gi >> 13;
            float st[8];
#pragma unroll
            for (int i = 0; i < 8; ++i) st[i] = 0.f;
            u32x2 wa[4], wb[4]; f32x4 da[4][2], db[4][2];
#define SCAN8_LOAD(W, Dd, c0) do { _Pragma("unroll") for (int i_ = 0; i_ < 4; ++i_) { const size_t u_ = (size_t)((b * 64 + (c0) + i_) * 4 + h); \
                W[i_] = *(const u32x2*)(S8 + u_ * 16384 + (size_t)vv * 128 + k8 * 8); Dd[i_][0] = *(const f32x4*)(DEC + u_ * 128 + k8 * 8); Dd[i_][1] = *(const f32x4*)(DEC + u_ * 128 + k8 * 8 + 4); } } while (0)
#define SCAN8_STEP(W, Dd, c0) do { _Pragma("unroll") for (int i_ = 0; i_ < 4; ++i_) { const size_t u_ = (size_t)((b * 64 + (c0) + i_) * 4 + h); \
                const f32x2 a0_ = __builtin_amdgcn_cvt_pk_f32_fp8((int)W[i_].x, false), a1_ = __builtin_amdgcn_cvt_pk_f32_fp8((int)W[i_].x, true), a2_ = __builtin_amdgcn_cvt_pk_f32_fp8((int)W[i_].y, false), a3_ = __builtin_amdgcn_cvt_pk_f32_fp8((int)W[i_].y, true); \
                st[0] = Dd[i_][0].x * st[0] + a0_.x; st[1] = Dd[i_][0].y * st[1] + a0_.y; st[2] = Dd[i_][0].z * st[2] + a1_.x; st[3] = Dd[i_][0].w * st[3] + a1_.y; \
                st[4] = Dd[i_][1].x * st[4] + a2_.x; st[5] = Dd[i_][1].y * st[5] + a2_.y; st[6] = Dd[i_][1].z * st[6] + a3_.x; st[7] = Dd[i_][1].w * st[7] + a3_.y; \
                u32x2 o_; o_.x = f32x4_to_fp8x4(st[0], st[1], st[2], st[3]); o_.y = f32x4_to_fp8x4(st[4], st[5], st[6], st[7]); *(u32x2*)(SO8 + u_ * 16384 + (size_t)vv * 128 + k8 * 8) = o_; } } while (0)
            SCAN8_LOAD(wa, da, 0);
#pragma nounroll
            for (int c0 = 0; c0 < 64; c0 += 8) {
                SCAN8_LOAD(wb, db, c0 + 4);
                SCAN8_STEP(wa, da, c0);
                if (c0 + 8 < 64) SCAN8_LOAD(wa, da, c0 + 8);
                SCAN8_STEP(wb, db, c0 + 4);
            }
#undef SCAN8_LOAD
#undef SCAN8_STEP
        }
        return;
    }
    bf16_t* ST = (bf16_t*)(A.ws + WS_N1); bf16_t* STO = DRY ? (bf16_t*)A.out : ST;
    for (int gi = F.bid * 512 + F.tid; gi < 131072; gi += F.G * 512) {
        const int k4 = gi & 31, vv = (gi >> 5) & 127, h = (gi >> 12) & 3, b = gi >> 14;
        float s0 = 0.f, s1 = 0.f, s2 = 0.f, s3 = 0.f;
        u32x2 wa[8], wb[8]; f32x4 da[8], db[8];
#define SCAN_LOAD(W, Dd, c0) do { _Pragma("unroll") for (int i_ = 0; i_ < 8; ++i_) { const size_t u_ = (size_t)((b * 64 + (c0) + i_) * 4 + h); \
            W[i_] = *(const u32x2*)(ST + u_ * 16384 + (size_t)vv * 128 + k4 * 4); Dd[i_] = *(const f32x4*)(DEC + u_ * 128 + k4 * 4); } } while (0)
#define SCAN_STEP(W, Dd, c0) do { _Pragma("unroll") for (int i_ = 0; i_ < 8; ++i_) { const size_t u_ = (size_t)((b * 64 + (c0) + i_) * 4 + h); \
            s0 = Dd[i_].x * s0 + bflo(W[i_].x); s1 = Dd[i_].y * s1 + bfhi(W[i_].x); s2 = Dd[i_].z * s2 + bflo(W[i_].y); s3 = Dd[i_].w * s3 + bfhi(W[i_].y); \
            u32x2 o_; o_.x = pk2(s0, s1); o_.y = pk2(s2, s3); *(u32x2*)(STO + u_ * 16384 + (size_t)vv * 128 + k4 * 4) = o_; } } while (0)
        SCAN_LOAD(wa, da, 0);
#pragma unroll
        for (int c0 = 0; c0 < 64; c0 += 16) {
            SCAN_LOAD(wb, db, c0 + 8);
            SCAN_STEP(wa, da, c0);
            if (c0 + 16 < 64) SCAN_LOAD(wa, da, c0 + 16);
            SCAN_STEP(wb, db, c0 + 8);
        }
#undef SCAN_LOAD
#undef SCAN_STEP
    }
}

template <bool DRY>
__device__ __forceinline__ void gla_out_phase(const Frame& F, const Args& A) {
    bf16_t* P = (bf16_t*)(A.ws + WS_P);
    LAS bf16_t* qA = (LAS bf16_t*)F.lds;
    LAS bf16_t* sB = (LAS bf16_t*)(F.lds + 17408);
    LAS float* oF = (LAS float*)(F.lds + 52224);
    const int tid = F.tid, s = tid >> 3, cb = (tid & 7) * 16, vv = tid >> 2, kb = (tid & 3) * 32;
    u32x4 nq0, nq1, ns0, ns1, ns2, ns3, nr0, nr1;
#define GO_LOAD(unit) do { const int h_ = (unit) & 3, c_ = ((unit) >> 2) & 63, b_ = (unit) >> 8; const int t0_ = b_ * SEQ + c_ * 64; \
        const bf16_t* qp_ = P + (size_t)(t0_ + s) * PLD + PC_Q + h_ * 128 + cb; nq0 = *(const u32x4*)qp_; nq1 = *(const u32x4*)(qp_ + 8); \
        if (ST_F8) { const unsigned char* sp8_ = A.ws + WS_N1 + (size_t)(unit) * 16384 + (size_t)vv * 128 + kb; ns0 = *(const u32x4*)sp8_; ns1 = *(const u32x4*)(sp8_ + 16); ns2 = ns0; ns3 = ns0; } else { \
        const bf16_t* sp_ = (const bf16_t*)(A.ws + WS_N1) + (size_t)(unit) * 16384 + (size_t)vv * 128 + kb; ns0 = *(const u32x4*)sp_; ns1 = *(const u32x4*)(sp_ + 8); ns2 = *(const u32x4*)(sp_ + 16); ns3 = *(const u32x4*)(sp_ + 24); } \
        const bf16_t* rp_ = P + (size_t)(t0_ + s) * PLD + PC_R + h_ * 128 + cb; nr0 = *(const u32x4*)rp_; nr1 = *(const u32x4*)(rp_ + 8); } while (0)
    int unit = F.bid;
    if (unit < 2048) GO_LOAD(unit);
    for (; unit < 2048; unit += F.G) {
        const int h = unit & 3, c = (unit >> 2) & 63, b = unit >> 8;
        const int t0 = b * SEQ + c * 64;
        __syncthreads();
        *(LAS u32x4*)(qA + s * 136 + cb) = nq0; *(LAS u32x4*)(qA + s * 136 + cb + 8) = nq1;
        if (ST_F8) {
#pragma unroll
            for (int hh = 0; hh < 2; ++hh) { const u32x4 w8 = hh ? ns1 : ns0; const u32x2 c0 = fp8x4_to_bf16x4(w8.x), c1 = fp8x4_to_bf16x4(w8.y), c2 = fp8x4_to_bf16x4(w8.z), c3 = fp8x4_to_bf16x4(w8.w);
                *(LAS u32x4*)(sB + vv * 136 + kb + 16 * hh) = (u32x4){c0.x, c0.y, c1.x, c1.y}; *(LAS u32x4*)(sB + vv * 136 + kb + 16 * hh + 8) = (u32x4){c2.x, c2.y, c3.x, c3.y}; }
        } else {
        *(LAS u32x4*)(sB + vv * 136 + kb) = ns0; *(LAS u32x4*)(sB + vv * 136 + kb + 8) = ns1; *(LAS u32x4*)(sB + vv * 136 + kb + 16) = ns2; *(LAS u32x4*)(sB + vv * 136 + kb + 24) = ns3; }
        const u32x4 r0 = nr0, r1 = nr1;
        if (unit + F.G < 2048) GO_LOAD(unit + F.G);
        __syncthreads();
        {
            const int w = F.wave, l = F.lane, fr = l & 15, fq = l >> 4, m = w & 3, nh = w >> 2;
            f32x4 acc[4];
#pragma unroll
            for (int n = 0; n < 4; ++n) acc[n] = (f32x4){0.f, 0.f, 0.f, 0.f};
#pragma unroll
            for (int ks = 0; ks < 4; ++ks) {
                const bf16x8 a = *(const LAS bf16x8*)(qA + (16 * m + fr) * 136 + 32 * ks + 8 * fq);
#pragma unroll
                for (int n = 0; n < 4; ++n) { const bf16x8 bb = *(const LAS bf16x8*)(sB + (16 * (4 * nh + n) + fr) * 136 + 32 * ks + 8 * fq);
                    acc[n] = __builtin_amdgcn_mfma_f32_16x16x32_bf16(a, bb, acc[n], 0, 0, 0); }
            }
            const float scale = 0.08838834764831845f;
#pragma unroll
            for (int n = 0; n < 4; ++n)
#pragma unroll
                for (int jj = 0; jj < 4; ++jj) oF[(16 * m + 4 * fq + jj) * 132 + 16 * (4 * nh + n) + fr] = acc[n][jj] * scale;
        }
        __syncthreads();
        {
            float o[16]; float ss = 0.f;
#pragma unroll
            for (int i = 0; i < 16; ++i) { o[i] = oF[s * 132 + cb + i]; ss += o[i] * o[i]; }
            ss += __shfl_xor(ss, 1); ss += __shfl_xor(ss, 2); ss += __shfl_xor(ss, 4);
            const float rstd = 1.f / sqrtf(ss * (1.f / 128.f) + EPS);
            const unsigned rw[8] = {r0.x, r0.y, r0.z, r0.w, r1.x, r1.y, r1.z, r1.w};
            const float* gg = A.in[I_GLAG] + h * 128 + cb;
            unsigned ow[8];
#pragma unroll
            for (int i = 0; i < 8; ++i) { const float y0 = o[2 * i] * rstd * gg[2 * i] * siluf_(bflo(rw[i])), y1 = o[2 * i + 1] * rstd * gg[2 * i + 1] * siluf_(bfhi(rw[i])); ow[i] = pk2(y0, y1); }
            bf16_t* yp = DRY ? (bf16_t*)A.out + (size_t)(t0 + s) * 512 + h * 128 + cb : P + (size_t)(t0 + s) * PLD + PC_R + h * 128 + cb;
            *(u32x4*)yp = (u32x4){ow[0], ow[1], ow[2], ow[3]}; *(u32x4*)(yp + 8) = (u32x4){ow[4], ow[5], ow[6], ow[7]};
        }
    }
#undef GO_LOAD
}

__device__ __forceinline__ unsigned ordkey(float v) { const unsigned u = __builtin_bit_cast(unsigned, v); return u ^ ((unsigned)((int)u >> 31) | 0x80000000u); }
__device__ __forceinline__ float unord16(unsigned k) { const unsigned u = ((k & 0x80000000u) ? (k & 0x7fffffffu) : ~k) & 0xffff0000u; return __builtin_bit_cast(float, u); }
__device__ __forceinline__ float unord(unsigned k) { const unsigned u = (k & 0x80000000u) ? (k & 0x7fffffffu) : ~k; return __builtin_bit_cast(float, u); }
#define INS16(r, xin) do { unsigned _x = (xin); _Pragma("unroll") for (int _i = 0; _i < 16; ++_i) { const unsigned _h = max((r)[_i], _x); _x = min((r)[_i], _x); (r)[_i] = _h; } } while (0)

#define CE(a, b) do { const unsigned _h = max((a), (b)), _l = min((a), (b)); (a) = _h; (b) = _l; } while (0)
#define SORT16(v) do { CE(v[0], v[1]); CE(v[2], v[3]); CE(v[0], v[2]); CE(v[1], v[3]); CE(v[1], v[2]); CE(v[4], v[5]); CE(v[6], v[7]); CE(v[4], v[6]); CE(v[5], v[7]); CE(v[5], v[6]); CE(v[0], v[4]); CE(v[2], v[6]); CE(v[2], v[4]); CE(v[1], v[5]); CE(v[3], v[7]); CE(v[3], v[5]); CE(v[1], v[2]); CE(v[3], v[4]); CE(v[5], v[6]); CE(v[8], v[9]); CE(v[10], v[11]); CE(v[8], v[10]); CE(v[9], v[11]); CE(v[9], v[10]); CE(v[12], v[13]); CE(v[14], v[15]); CE(v[12], v[14]); CE(v[13], v[15]); CE(v[13], v[14]); CE(v[8], v[12]); CE(v[10], v[14]); CE(v[10], v[12]); CE(v[9], v[13]); CE(v[11], v[15]); CE(v[11], v[13]); CE(v[9], v[10]); CE(v[11], v[12]); CE(v[13], v[14]); CE(v[0], v[8]); CE(v[4], v[12]); CE(v[4], v[8]); CE(v[2], v[10]); CE(v[6], v[14]); CE(v[6], v[10]); CE(v[2], v[4]); CE(v[6], v[8]); CE(v[10], v[12]); CE(v[1], v[9]); CE(v[5], v[13]); CE(v[5], v[9]); CE(v[3], v[11]); CE(v[7], v[15]); CE(v[7], v[11]); CE(v[3], v[5]); CE(v[7], v[9]); CE(v[11], v[13]); CE(v[1], v[2]); CE(v[3], v[4]); CE(v[5], v[6]); CE(v[7], v[8]); CE(v[9], v[10]); CE(v[11], v[12]); CE(v[13], v[14]); } while (0)
#define MERGE16(T, S) do { _Pragma("unroll") for (int _i = 0; _i < 16; ++_i) (T)[_i] = max((T)[_i], (S)[15 - _i]); \
    _Pragma("unroll") for (int _d = 8; _d >= 1; _d >>= 1) { _Pragma("unroll") for (int _i = 0; _i < 16; ++_i) if ((_i & _d) == 0) CE((T)[_i], (T)[_i + _d]); } } while (0)
template <bool LOCAL>
__device__ __forceinline__ void peer_topk(const Frame& F, const Args& A) {
    const bf16_t* SC = (const bf16_t*)(A.ws + WS_P + P_SC);
    int* IDX = (int*)(A.ws + WS_P + P_IDX); float* GATE = (float*)(A.ws + WS_P + P_GATE);
    const int gw = F.bid * NWAVES + F.wave, NGW = F.G * NWAVES;
    pg8::StaticOrder S; S.init(T_TOK, 2048, F.G, F.bid);
    for (int it = LOCAL ? F.wave : gw; ; it += LOCAL ? NWAVES : NGW) {
        int h, tb;
        if (LOCAL) { pg8::Unit u; if (!S.next(it >> 2, u)) break; h = u.pn; tb = 4 * u.pm + (it & 3); }
        else { if (it >= 512 * 8) break; h = it & 7; tb = it >> 3; }
        const int tok = tb * 64 + F.lane;
        unsigned r1[16], r2[16], rc[16];
        const bf16_t* p1 = SC + ((size_t)(tok >> 4) * 256 + h * 32) * 128 + (tok & 15) * 8; const bf16_t* p2 = p1 + 16 * 128;
        {
            unsigned raw[128]; unsigned sg[16];
#pragma unroll
            for (int jq = 0; jq < 16; ++jq) { const u32x4 t4 = *(const u32x4*)(p1 + jq * 128);
#pragma unroll
                for (int c = 0; c < 4; ++c) { raw[8 * jq + 2 * c] = t4[c] << 16; raw[8 * jq + 2 * c + 1] = t4[c] & 0xffff0000u; } }
#pragma unroll
            for (int j = 0; j < 16; ++j) r1[j] = raw[j] | (unsigned)(127 - j);
            SORT16(r1);
#pragma unroll
            for (int gq = 1; gq < 8; ++gq) {
#pragma unroll
                for (int j = 0; j < 16; ++j) sg[j] = raw[16 * gq + j] | (unsigned)(127 - (16 * gq + j));
                SORT16(sg); MERGE16(r1, sg); }
#pragma unroll
            for (int jq = 0; jq < 16; ++jq) { const u32x4 t4 = *(const u32x4*)(p2 + jq * 128);
#pragma unroll
                for (int c = 0; c < 4; ++c) { raw[8 * jq + 2 * c] = t4[c] << 16; raw[8 * jq + 2 * c + 1] = t4[c] & 0xffff0000u; } }
#pragma unroll
            for (int j = 0; j < 16; ++j) r2[j] = raw[j] | (unsigned)(127 - j);
            SORT16(r2);
#pragma unroll
            for (int gq = 1; gq < 8; ++gq) {
#pragma unroll
                for (int j = 0; j < 16; ++j) sg[j] = raw[16 * gq + j] | (unsigned)(127 - (16 * gq + j));
                SORT16(sg); MERGE16(r2, sg); }
        }
        float v1[16], v2[16];
#pragma unroll
        for (int i = 0; i < 16; ++i) { v1[i] = unord16(r1[i]); v2[i] = unord16(r2[i]); }
        {
            unsigned cg[4][16]; int cn = 0;
#pragma unroll
            for (int a = 0; a < 16; ++a)
#pragma unroll
                for (int bq = 0; bq < 16; ++bq) if ((a + 1) * (bq + 1) <= 16) { cg[cn >> 4][cn & 15] = (ordkey(v1[a] + v2[bq]) & ~255u) | (unsigned)(a * 16 + bq); ++cn; }
#pragma unroll
            for (int z = 50; z < 64; ++z) cg[z >> 4][z & 15] = 0u;
            SORT16(cg[0]); SORT16(cg[1]); SORT16(cg[2]); SORT16(cg[3]);
            MERGE16(cg[0], cg[1]); MERGE16(cg[0], cg[2]); MERGE16(cg[0], cg[3]);
#pragma unroll
            for (int i = 0; i < 16; ++i) rc[i] = cg[0][i];
        }
        float val[16]; int ex[16];
        {
            LAS unsigned* t1 = (LAS unsigned*)(F.lds + F.wave * 8704) + F.lane * 17; LAS unsigned* t2 = t1 + 64 * 17;
#pragma unroll
            for (int i = 0; i < 16; ++i) { t1[i] = r1[i]; t2[i] = r2[i]; }
            LDS_WAIT(); asm volatile("" ::: "memory");
#pragma unroll
            for (int w = 0; w < 16; ++w) {
                const int a = (rc[w] >> 4) & 15, bq = rc[w] & 15;
                const unsigned k1 = t1[a], k2 = t2[bq];
                val[w] = unord16(k1) + unord16(k2);
                ex[w] = (127 - (int)(k1 & 127u)) * 128 + (127 - (int)(k2 & 127u));
            }
            LDS_WAIT(); asm volatile("" ::: "memory");
        }
        float mx = val[0];
#pragma unroll
        for (int w = 1; w < 16; ++w) mx = fmaxf(mx, val[w]);
        float sum = 0.f;
#pragma unroll
        for (int w = 0; w < 16; ++w) { val[w] = __expf(val[w] - mx); sum += val[w]; }
        const float inv = 1.f / sum;
        int* ip = IDX + (size_t)tok * 128 + h * 16; float* gp = GATE + (size_t)tok * 128 + h * 16;
#pragma unroll
        for (int q = 0; q < 4; ++q) { *(int4*)(ip + 4 * q) = make_int4(ex[4 * q], ex[4 * q + 1], ex[4 * q + 2], ex[4 * q + 3]);
            *(f32x4*)(gp + 4 * q) = (f32x4){val[4 * q] * inv, val[4 * q + 1] * inv, val[4 * q + 2] * inv, val[4 * q + 3] * inv}; }
    }
}

#define DPP_ADD(v, ctrl) ((v) + __builtin_bit_cast(float, __builtin_amdgcn_mov_dpp(__builtin_bit_cast(int, (v)), (ctrl), 0xf, 0xf, true)))
__device__ __forceinline__ void fp8x16_to_f32x2(const u32x4 r, f32x2* f) {
#pragma unroll
    for (int q = 0; q < 4; ++q) { f[2 * q] = __builtin_amdgcn_cvt_pk_f32_fp8((int)r[q], false); f[2 * q + 1] = __builtin_amdgcn_cvt_pk_f32_fp8((int)r[q], true); }
}
__device__ __forceinline__ void fp8x16_to_f32(const u32x4 r, float* f) {
#pragma unroll
    for (int q = 0; q < 4; ++q) { const f32x2 lo = __builtin_amdgcn_cvt_pk_f32_fp8((int)r[q], false), hi = __builtin_amdgcn_cvt_pk_f32_fp8((int)r[q], true);
        f[4 * q] = lo.x; f[4 * q + 1] = lo.y; f[4 * q + 2] = hi.x; f[4 * q + 3] = hi.y; }
}
__device__ __forceinline__ long lo64(u32x4 v) { return (long)(((unsigned long)v.y << 32) | (unsigned long)v.x); }
__device__ __forceinline__ long hi64(u32x4 v) { return (long)(((unsigned long)v.w << 32) | (unsigned long)v.z); }
template <int MODE>
__device__ __forceinline__ void peer_u_phase(const Frame& F, const Args& A) {
    const unsigned char* X8 = A.ws + WS_N18;
    const unsigned char* U8 = A.ws + WS_U8; const float* SU = (const float*)(A.ws + WS_SU); const float* SV = (const float*)(A.ws + WS_SV);
    const int* IDX = (const int*)(A.ws + WS_P + P_IDX); const float* GATE = (const float*)(A.ws + WS_P + P_GATE); float* AK = (float*)(MODE == 0 ? A.ws + WS_AK : A.ws + WS_P + P_SC);
    const int g = F.bid & 7, nmem = F.G >> 3, l = F.lane, step = nmem * NWAVES;
    const int loff = 64 * (l & 15) + 16 * (l >> 4);
    const bool dg = ((l & 15) >> 2) == (l >> 4); const int dr = l & 3;
    const float dw0 = (dg && dr == 0) ? 1.f : 0.f, dw1 = (dg && dr == 1) ? 1.f : 0.f, dw2 = (dg && dr == 2) ? 1.f : 0.f, dw3 = (dg && dr == 3) ? 1.f : 0.f;
    LAS int* le = (LAS int*)(F.lds + F.wave * 2048); LAS int* lk = le + 256;
    const bool b5 = (l & 32) != 0, b4 = (l & 16) != 0, b3 = (l & 8) != 0;
    int tok = 2 * ((F.bid >> 3) * NWAVES + F.wave);
    u32x4 nxA, nxB; int neA0, neA1, neB0, neB1; float ngA0, ngA1, ngB0, ngB1;
#define U_PREFETCH(t) do { const size_t _tA = (size_t)(t), _tB = (size_t)(t) + 1; if (MODE == 4) { nxA = (u32x4){(unsigned)_tA, 1u, 2u, 3u}; nxB = nxA; neA0 = (int)((_tA * 37 + l * 11) & 16383); neA1 = (int)((_tA * 53 + l * 7) & 16383); neB0 = (int)((_tB * 37 + l * 13) & 16383); neB1 = (int)((_tB * 29 + l * 3) & 16383); ngA0 = ngA1 = ngB0 = ngB1 = 0.01f; break; } nxA = *(const u32x4*)(X8 + _tA * 1024 + loff); nxB = *(const u32x4*)(X8 + _tB * 1024 + loff); \
        neA0 = IDX[_tA * 128 + l]; neA1 = IDX[_tA * 128 + 64 + l]; neB0 = IDX[_tB * 128 + l]; neB1 = IDX[_tB * 128 + 64 + l]; \
        ngA0 = GATE[_tA * 128 + l]; ngA1 = GATE[_tA * 128 + 64 + l]; ngB0 = GATE[_tB * 128 + l]; ngB1 = GATE[_tB * 128 + 64 + l]; } while (0)
    if (tok + 1 < T_TOK) U_PREFETCH(tok);
    for (; tok + 1 < T_TOK; tok += 2 * step) {
        const int tokA = tok, tokB = tok + 1;
        const u32x4 xA = nxA, xB = nxB;
        const int eA0 = neA0, eA1 = neA1, eB0 = neB0, eB1 = neB1; const float gA0 = ngA0, gA1 = ngA1, gB0 = ngB0, gB1 = ngB1;
        bool pf_done = false;
        const bool oA0 = (eA0 & 7) == g, oA1 = (eA1 & 7) == g, oB0 = (eB0 & 7) == g, oB1 = (eB1 & 7) == g;
        const unsigned long long mA0 = __ballot(oA0), mA1 = __ballot(oA1), mB0 = __ballot(oB0), mB1 = __ballot(oB1);
        const int c0 = __popcll(mA0), c1 = c0 + __popcll(mA1), c2 = c1 + __popcll(mB0), n = c2 + __popcll(mB1);
#define MBC(m) __builtin_amdgcn_mbcnt_hi((unsigned)((m) >> 32), __builtin_amdgcn_mbcnt_lo((unsigned)(m), 0u))
        if (oA0) { const int p = MBC(mA0); le[p] = (eA0 << 8) | l; lk[p] = __builtin_bit_cast(int, gA0); }
        if (oA1) { const int p = c0 + MBC(mA1); le[p] = (eA1 << 8) | (64 + l); lk[p] = __builtin_bit_cast(int, gA1); }
        if (oB0) { const int p = c1 + MBC(mB0); le[p] = (eB0 << 8) | 128 | l; lk[p] = __builtin_bit_cast(int, gB0); }
        if (oB1) { const int p = c2 + MBC(mB1); le[p] = (eB1 << 8) | 128 | (64 + l); lk[p] = __builtin_bit_cast(int, gB1); }
#undef MBC
        LDS_WAIT(); asm volatile("" ::: "memory");
        for (int cb = 0; cb < n || cb == 0; cb += 64) {
        const int nc = min(n, cb + 64);
        const bool fv = (cb + l) < nc;
        const int ent = fv ? le[cb + l] : 0; const float gt = fv ? __builtin_bit_cast(float, lk[cb + l]) : 0.f; float tot = 0.f;
        const float su = SU[ent >> 8], sv = SV[ent >> 8];
        const unsigned long long radr = (unsigned long long)(U8 + (size_t)(((ent >> 8) & 7) * 2048 + (((ent >> 8) >> 3) & (MODE == 2 ? 255 : 2047))) * 1024);
        const int ralo = (int)(unsigned)radr, rahi = (int)(unsigned)(radr >> 32);
        for (int i = cb; i < nc; i += 16) {
            u32x4 row[2][8];
#pragma unroll
            for (int b = 0; b < 2; ++b) if (i + 8 * b < nc) {
#pragma unroll
                for (int j = 0; j < 8; ++j) { const int ln = min(i + 8 * b + j, nc - 1) - cb;
                    const unsigned lo = (unsigned)__builtin_amdgcn_readlane(ralo, ln), hi = (unsigned)__builtin_amdgcn_readlane(rahi, ln);
                    const GAS unsigned char* rp = (const GAS unsigned char*)(((unsigned long long)hi << 32) | lo);
                    row[b][j] = *(const GAS u32x4*)(rp + (unsigned)loff); } }
            if (!pf_done) { pf_done = true; if (tok + 2 * step + 1 < T_TOK) U_PREFETCH(tok + 2 * step); }
#pragma unroll
            for (int b = 0; b < 2; ++b) if (i + 8 * b < nc) {
                float p[8];
                f32x4 accj[8];
                const int base0 = i + 8 * b;
                if (base0 + 8 <= c1) {
#pragma unroll
                    for (int j = 0; j < 8; ++j) accj[j] = __builtin_amdgcn_mfma_f32_16x16x32_fp8_fp8(lo64(row[b][j]), lo64(xA), (f32x4){0.f, 0.f, 0.f, 0.f}, 0, 0, 0);
#pragma unroll
                    for (int j = 0; j < 8; ++j) accj[j] = __builtin_amdgcn_mfma_f32_16x16x32_fp8_fp8(hi64(row[b][j]), hi64(xA), accj[j], 0, 0, 0);
                } else if (base0 >= c1) {
#pragma unroll
                    for (int j = 0; j < 8; ++j) accj[j] = __builtin_amdgcn_mfma_f32_16x16x32_fp8_fp8(lo64(row[b][j]), lo64(xB), (f32x4){0.f, 0.f, 0.f, 0.f}, 0, 0, 0);
#pragma unroll
                    for (int j = 0; j < 8; ++j) accj[j] = __builtin_amdgcn_mfma_f32_16x16x32_fp8_fp8(hi64(row[b][j]), hi64(xB), accj[j], 0, 0, 0);
                } else {
#pragma unroll
                    for (int j = 0; j < 8; ++j) { const u32x4 xs = (base0 + j >= c1) ? xB : xA; accj[j] = __builtin_amdgcn_mfma_f32_16x16x32_fp8_fp8(lo64(row[b][j]), lo64(xs), (f32x4){0.f, 0.f, 0.f, 0.f}, 0, 0, 0);
                        accj[j] = __builtin_amdgcn_mfma_f32_16x16x32_fp8_fp8(hi64(row[b][j]), hi64(xs), accj[j], 0, 0, 0); }
                }
#pragma unroll
                for (int j = 0; j < 8; ++j) p[j] = __builtin_fmaf(accj[j][3], dw3, __builtin_fmaf(accj[j][2], dw2, __builtin_fmaf(accj[j][1], dw1, accj[j][0] * dw0)));
                float q4[4], q2[2], q1;
#pragma unroll
                for (int j = 0; j < 4; ++j) { const float keep = b5 ? p[4 + j] : p[j], send = b5 ? p[j] : p[4 + j]; q4[j] = keep + __shfl_xor(send, 32); }
#pragma unroll
                for (int j = 0; j < 2; ++j) { const float keep = b4 ? q4[2 + j] : q4[j], send = b4 ? q4[j] : q4[2 + j]; q2[j] = keep + __shfl_xor(send, 16); }
                { const float keep = b3 ? q2[1] : q2[0], send = b3 ? q2[0] : q2[1]; q1 = keep + __shfl_xor(send, 8); }
                q1 = DPP_ADD(q1, 0xB1); q1 = DPP_ADD(q1, 0x4E); q1 = DPP_ADD(q1, 0x141);
                const float t = __builtin_bit_cast(float, __builtin_amdgcn_ds_bpermute((l & 7) * 32, __builtin_bit_cast(int, q1)));
                const int base = i + 8 * b;
                if ((l >> 3) == ((base - cb) >> 3)) tot = t;
            }
        }
        if (!pf_done) { if (tok + 2 * step + 1 < T_TOK) U_PREFETCH(tok + 2 * step); }
        if (fv) { const int tk = (ent & 128) ? tokB : tokA; AK[(size_t)tk * 128 + (ent & 127)] = gelu_tanh(tot * su * (1.f / 16.f)) * gt * sv; }
        if (n == 0) break;
        }
        LDS_WAIT(); asm volatile("" ::: "memory");
    }
#undef U_PREFETCH
}
template <int MODE>
__device__ __forceinline__ void peer_u_phase1(const Frame& F, const Args& A) {
    const unsigned char* X8 = A.ws + WS_N18;
    const unsigned char* U8 = A.ws + WS_U8; const float* SU = (const float*)(A.ws + WS_SU); const float* SV = (const float*)(A.ws + WS_SV);
    const int* IDX = (const int*)(A.ws + WS_P + P_IDX); const float* GATE = (const float*)(A.ws + WS_P + P_GATE); float* AK = (float*)(MODE == 0 ? A.ws + WS_AK : A.ws + WS_P + P_SC);
    const int g = F.bid & (UNG - 1), nmem = F.G >> UNG_SH, l = F.lane, step = nmem * NWAVES;
    const int loff = 64 * (l & 15) + 16 * (l >> 4);
    const bool dg = ((l & 15) >> 2) == (l >> 4); const int dr = l & 3;
    const float dw0 = (dg && dr == 0) ? 1.f : 0.f, dw1 = (dg && dr == 1) ? 1.f : 0.f, dw2 = (dg && dr == 2) ? 1.f : 0.f, dw3 = (dg && dr == 3) ? 1.f : 0.f;
    LAS int* le = (LAS int*)(F.lds + F.wave * 2048); LAS int* lk = le + 256;
    const bool b5 = (l & 32) != 0, b4 = (l & 16) != 0, b3 = (l & 8) != 0;
    int tok = (F.bid >> UNG_SH) * NWAVES + F.wave;
    u32x4 nxA; int neA0, neA1; float ngA0, ngA1;
#define U1_PREFETCH(t) do { const size_t _tA = (size_t)(t); nxA = *(const u32x4*)(X8 + _tA * 1024 + loff); \
        neA0 = IDX[_tA * 128 + l]; neA1 = IDX[_tA * 128 + 64 + l]; ngA0 = GATE[_tA * 128 + l]; ngA1 = GATE[_tA * 128 + 64 + l]; } while (0)
    if (tok < T_TOK) U1_PREFETCH(tok);
    for (; tok < T_TOK; tok += step) {
        const u32x4 xA = nxA;
        const int eA0 = neA0, eA1 = neA1; const float gA0 = ngA0, gA1 = ngA1;
        bool pf_done = false;
        const bool oA0 = (eA0 & (UNG - 1)) == g, oA1 = (eA1 & (UNG - 1)) == g;
        const unsigned long long mA0 = __ballot(oA0), mA1 = __ballot(oA1);
        const int c0 = __popcll(mA0), n = c0 + __popcll(mA1);
#define MBC(m) __builtin_amdgcn_mbcnt_hi((unsigned)((m) >> 32), __builtin_amdgcn_mbcnt_lo((unsigned)(m), 0u))
        if (oA0) { const int p = MBC(mA0); le[p] = (eA0 << 8) | l; lk[p] = __builtin_bit_cast(int, gA0); }
        if (oA1) { const int p = c0 + MBC(mA1); le[p] = (eA1 << 8) | (64 + l); lk[p] = __builtin_bit_cast(int, gA1); }
#undef MBC
        LDS_WAIT(); asm volatile("" ::: "memory");
        for (int cb = 0; cb < n || cb == 0; cb += 64) {
        const int nc = min(n, cb + 64);
        const bool fv = (cb + l) < nc;
        const int ent = fv ? le[cb + l] : 0; const float gt = fv ? __builtin_bit_cast(float, lk[cb + l]) : 0.f; float tot = 0.f;
        const float su = SU[ent >> 8], sv = SV[ent >> 8];
        const unsigned long long radr = (unsigned long long)(U8 + (size_t)(((ent >> 8) & (UNG - 1)) * (NEXP / UNG) + ((ent >> 8) >> UNG_SH)) * 1024);
        const int ralo = (int)(unsigned)radr, rahi = (int)(unsigned)(radr >> 32);
        for (int i = cb; i < nc; i += 16) {
            u32x4 row[2][8];
#pragma unroll
            for (int b = 0; b < 2; ++b) if (i + 8 * b < nc) {
#pragma unroll
                for (int j = 0; j < 8; ++j) { const int ln = min(i + 8 * b + j, nc - 1) - cb;
                    const unsigned lo = (unsigned)__builtin_amdgcn_readlane(ralo, ln), hi = (unsigned)__builtin_amdgcn_readlane(rahi, ln);
                    const GAS unsigned char* rp = (const GAS unsigned char*)(((unsigned long long)hi << 32) | lo);
                    row[b][j] = *(const GAS u32x4*)(rp + (unsigned)loff); } }
            if (!pf_done) { pf_done = true; if (tok + step < T_TOK) U1_PREFETCH(tok + step); }
#pragma unroll
            for (int b = 0; b < 2; ++b) if (i + 8 * b < nc) {
                float p[8]; f32x4 accj[8];
#pragma unroll
                for (int j = 0; j < 8; ++j) accj[j] = __builtin_amdgcn_mfma_f32_16x16x32_fp8_fp8(lo64(row[b][j]), lo64(xA), (f32x4){0.f, 0.f, 0.f, 0.f}, 0, 0, 0);
#pragma unroll
                for (int j = 0; j < 8; ++j) accj[j] = __builtin_amdgcn_mfma_f32_16x16x32_fp8_fp8(hi64(row[b][j]), hi64(xA), accj[j], 0, 0, 0);
#pragma unroll
                for (int j = 0; j < 8; ++j) p[j] = __builtin_fmaf(accj[j][3], dw3, __builtin_fmaf(accj[j][2], dw2, __builtin_fmaf(accj[j][1], dw1, accj[j][0] * dw0)));
                float q4[4], q2[2], q1;
#pragma unroll
                for (int j = 0; j < 4; ++j) { const float keep = b5 ? p[4 + j] : p[j], send = b5 ? p[j] : p[4 + j]; q4[j] = keep + __shfl_xor(send, 32); }
#pragma unroll
                for (int j = 0; j < 2; ++j) { const float keep = b4 ? q4[2 + j] : q4[j], send = b4 ? q4[j] : q4[2 + j]; q2[j] = keep + __shfl_xor(send, 16); }
                { const float keep = b3 ? q2[1] : q2[0], send = b3 ? q2[0] : q2[1]; q1 = keep + __shfl_xor(send, 8); }
                q1 = DPP_ADD(q1, 0xB1); q1 = DPP_ADD(q1, 0x4E); q1 = DPP_ADD(q1, 0x141);
                const float t = __builtin_bit_cast(float, __builtin_amdgcn_ds_bpermute((l & 7) * 32, __builtin_bit_cast(int, q1)));
                const int base = i + 8 * b;
                if ((l >> 3) == ((base - cb) >> 3)) tot = t;
            }
        }
        if (!pf_done) { pf_done = true; if (tok + step < T_TOK) U1_PREFETCH(tok + step); }
        if (fv) AK[(size_t)tok * 128 + (ent & 127)] = gelu_tanh(tot * su * (1.f / 16.f)) * gt * sv;
        if (n == 0) break;
        }
        LDS_WAIT(); asm volatile("" ::: "memory");
    }
#undef U1_PREFETCH
}
template <int MODE>
__device__ __forceinline__ void peer_u4_phase(const Frame& F, const Args& A) {
    const unsigned char* X8 = A.ws + WS_N18;
    const float* SU = (const float*)(A.ws + WS_SU); const float* SV = (const float*)(A.ws + WS_SV);
    const int* IDX = (const int*)(A.ws + WS_P + P_IDX); const float* GATE = (const float*)(A.ws + WS_P + P_GATE); float* AK = (float*)(MODE == 0 ? A.ws + WS_AK : A.ws + WS_P + P_SC);
    const int g = F.bid & (UNG - 1), nmem = F.G >> UNG_SH, l = F.lane, step = nmem * NWAVES;
    const int m = l & 15, q = l >> 4;
    const GAS unsigned char* ub = (const GAS unsigned char*)(A.ws + WS_U8 + (size_t)g * (NEXP / UNG) * 512);
    const unsigned lconst = 16u * (unsigned)(4 * (m & 7) + q);
    const int xoff = 128 * (m & 7) + 16 * q;
    const bool dg = (m < 8) && ((m >> 2) == (q & 1)); const int dr = m & 3;
    const float dw0 = (dg && dr == 0) ? 1.f : 0.f, dw1 = (dg && dr == 1) ? 1.f : 0.f, dw2 = (dg && dr == 2) ? 1.f : 0.f, dw3 = (dg && dr == 3) ? 1.f : 0.f;
    const int rsel = 4 * (m >> 3);
    const int osrc = 4 * (32 * (l & 1) + 4 * ((l & 15) >> 1));
    const int sc1 = 0x7F7F7F7F;
    LAS int* le = (LAS int*)(F.lds + F.wave * 2048); LAS int* lk = le + 256;
    const bool b4 = (l & 16) != 0, b3 = (l & 8) != 0, b2 = (l & 4) != 0;
    int tok = (F.bid >> UNG_SH) * NWAVES + F.wave;
    u32x4 nx0, nx1; int ne0, ne1; float ng0, ng1;
#define U4_PREFETCH(t) do { const size_t _t = (size_t)(t); nx0 = *(const u32x4*)(X8 + _t * 1024 + xoff); nx1 = *(const u32x4*)(X8 + _t * 1024 + xoff + 64); \
        ne0 = IDX[_t * 128 + l]; ne1 = IDX[_t * 128 + 64 + l]; ng0 = GATE[_t * 128 + l]; ng1 = GATE[_t * 128 + 64 + l]; } while (0)
    if (tok < T_TOK) U4_PREFETCH(tok);
    for (; tok < T_TOK; tok += step) {
        const i32x8 xb = __builtin_shufflevector(__builtin_bit_cast(i32x4, nx0), __builtin_bit_cast(i32x4, nx1), 0, 1, 2, 3, 4, 5, 6, 7);
        const int e0 = ne0, e1 = ne1; const float g0 = ng0, g1 = ng1;
        bool pf_done = false;
        const bool o0 = (e0 & (UNG - 1)) == g, o1 = (e1 & (UNG - 1)) == g;
        const unsigned long long m0 = __ballot(o0), m1 = __ballot(o1);
        const int c0 = __popcll(m0), n = c0 + __popcll(m1);
#define MBC(mm) __builtin_amdgcn_mbcnt_hi((unsigned)((mm) >> 32), __builtin_amdgcn_mbcnt_lo((unsigned)(mm), 0u))
        if (o0) { const int p = MBC(m0); le[p] = (e0 << 8) | l; lk[p] = __builtin_bit_cast(int, g0); }
        if (o1) { const int p = c0 + MBC(m1); le[p] = (e1 << 8) | (64 + l); lk[p] = __builtin_bit_cast(int, g1); }
#undef MBC
        LDS_WAIT(); asm volatile("" ::: "memory");
        for (int cb = 0; cb < n || cb == 0; cb += 64) {
            const int nc = min(n, cb + 64);
            const bool fv = (cb + l) < nc;
            const int ent = fv ? le[cb + l] : 0; const float gt = fv ? __builtin_bit_cast(float, lk[cb + l]) : 0.f; float tot = 0.f;
            const float su = SU[ent >> 8], sv = SV[ent >> 8];
            const int roff = fv ? ((ent >> 8) >> UNG_SH) * 512 : 0;
            for (int i = cb; i < nc; i += 32) {
                u32x4 row[2][8];
#pragma unroll
                for (int b = 0; b < 2; ++b) if (i + 16 * b < nc) {
#pragma unroll
                    for (int j = 0; j < 8; ++j) { const int ro = __builtin_amdgcn_ds_bpermute(rsel + 4 * (i - cb + 16 * b + 2 * j), roff);
                        row[b][j] = *(const GAS u32x4*)(ub + ((unsigned)ro + lconst)); } }
                if (!pf_done) { pf_done = true; if (tok + step < T_TOK) U4_PREFETCH(tok + step); }
#pragma unroll
                for (int b = 0; b < 2; ++b) if (i + 16 * b < nc) {
                    float p[8];
#pragma unroll
                    for (int j = 0; j < 8; ++j) { const i32x4 r4 = __builtin_bit_cast(i32x4, row[b][j]);
                        const f32x4 d = __builtin_amdgcn_mfma_scale_f32_16x16x128_f8f6f4(__builtin_shufflevector(r4, r4, 0, 1, 2, 3, -1, -1, -1, -1), xb, (f32x4){0.f, 0.f, 0.f, 0.f}, 4, 0, 0, sc1, 0, sc1);
                        p[j] = __builtin_fmaf(d[3], dw3, __builtin_fmaf(d[2], dw2, __builtin_fmaf(d[1], dw1, d[0] * dw0))); }
                    float q4[4], q2[2], q1;
#pragma unroll
                    for (int j = 0; j < 4; ++j) { const float keep = b4 ? p[4 + j] : p[j], send = b4 ? p[j] : p[4 + j]; q4[j] = keep + __shfl_xor(send, 16); }
#pragma unroll
                    for (int j = 0; j < 2; ++j) { const float keep = b3 ? q4[2 + j] : q4[j], send = b3 ? q4[j] : q4[2 + j]; q2[j] = keep + __shfl_xor(send, 8); }
                    { const float keep = b2 ? q2[1] : q2[0], send = b2 ? q2[0] : q2[1]; q1 = keep + __shfl_xor(send, 4); }
                    q1 = DPP_ADD(q1, 0xB1); q1 = DPP_ADD(q1, 0x4E);
                    const float t = __builtin_bit_cast(float, __builtin_amdgcn_ds_bpermute(osrc, __builtin_bit_cast(int, q1)));
                    if ((l >> 4) == ((i - cb + 16 * b) >> 4)) tot = t;
                }
            }
            if (!pf_done) { pf_done = true; if (tok + step < T_TOK) U4_PREFETCH(tok + step); }
            if (fv) AK[(size_t)tok * 128 + (ent & 127)] = gelu_tanh(tot * su * (1.f / 16.f)) * gt * sv;
            if (n == 0) break;
        }
        LDS_WAIT(); asm volatile("" ::: "memory");
    }
#undef U4_PREFETCH
}
template <int MODE>
__device__ __forceinline__ void peer_u4_all(const Frame& F, const Args& A) {
    const unsigned char* X8 = A.ws + WS_N18;
    const float* SU = (const float*)(A.ws + WS_SU); const float* SV = (const float*)(A.ws + WS_SV);
    const int* IDX = (const int*)(A.ws + WS_P + P_IDX); const float* GATE = (const float*)(A.ws + WS_P + P_GATE); float* AK = (float*)(MODE == 0 ? A.ws + WS_AK : A.ws + WS_P + P_SC);
    const int l = F.lane, step = F.G * NWAVES;
    const int m = l & 15, q = l >> 4;
    const GAS unsigned char* ub = (const GAS unsigned char*)(A.ws + WS_U8);
    const unsigned lconst = 16u * (unsigned)(8 * q + (m & 7));
    const int xoff = 256 * (q >> 1) + 32 * (m & 7) + 16 * (q & 1);
    const bool dg = (m < 8) && ((m >> 2) == (q & 1)); const int dr = m & 3;
    const float dw0 = (dg && dr == 0) ? 1.f : 0.f, dw1 = (dg && dr == 1) ? 1.f : 0.f, dw2 = (dg && dr == 2) ? 1.f : 0.f, dw3 = (dg && dr == 3) ? 1.f : 0.f;
    const int rsel = 4 * (m >> 3);
    const int osrc = 4 * (32 * (l & 1) + 4 * ((l & 15) >> 1));
    const int sc1 = 0x7F7F7F7F;
    const bool b4 = (l & 16) != 0, b3 = (l & 8) != 0, b2 = (l & 4) != 0;
    const int lhi = l >> 4;
    int tok = F.bid * NWAVES + F.wave;
    u32x4 nx0, nx1; int ne0, ne1; float ng0, ng1, nrss;
    const float* RSS = (const float*)(A.ws + WS_RSS);
#define UA_PREFETCH(t) do { const size_t _t = (size_t)(t); nx0 = __builtin_nontemporal_load((const u32x4*)(X8 + _t * 1024 + xoff)); nx1 = __builtin_nontemporal_load((const u32x4*)(X8 + _t * 1024 + xoff + 512)); \
        ne0 = __builtin_nontemporal_load(IDX + _t * 128 + l); ne1 = __builtin_nontemporal_load(IDX + _t * 128 + 64 + l); ng0 = __builtin_nontemporal_load(GATE + _t * 128 + l); ng1 = __builtin_nontemporal_load(GATE + _t * 128 + 64 + l); nrss = RSS[_t]; } while (0)
#define UA_LOADS(R, ro_, h) do { _Pragma("unroll") for (int j_ = 0; j_ < 16; ++j_) { const int o_ = __builtin_amdgcn_ds_bpermute(rsel + 4 * (32 * (h) + 2 * j_), (ro_)); \
        R[j_] = *(const GAS u32x4*)(ub + ((unsigned)o_ + lconst)); } } while (0)
#define UA_COMPUTE(R, xb_, h, tot_) do { _Pragma("unroll") for (int b_ = 0; b_ < 2; ++b_) { float p_[8]; \
        _Pragma("unroll") for (int j_ = 0; j_ < 8; ++j_) { const i32x4 r4_ = __builtin_bit_cast(i32x4, R[8 * b_ + j_]); \
            const f32x4 d_ = __builtin_amdgcn_mfma_scale_f32_16x16x128_f8f6f4(__builtin_shufflevector(r4_, r4_, 0, 1, 2, 3, -1, -1, -1, -1), (xb_), (f32x4){0.f, 0.f, 0.f, 0.f}, 4, 0, 0, sc1, 0, sc1); \
            p_[j_] = __builtin_fmaf(d_[3], dw3, __builtin_fmaf(d_[2], dw2, __builtin_fmaf(d_[1], dw1, d_[0] * dw0))); } \
        float q4_[4], q2_[2], q1_; \
        _Pragma("unroll") for (int j_ = 0; j_ < 4; ++j_) { const float keep_ = b4 ? p_[4 + j_] : p_[j_], send_ = b4 ? p_[j_] : p_[4 + j_]; q4_[j_] = keep_ + __shfl_xor(send_, 16); } \
        _Pragma("unroll") for (int j_ = 0; j_ < 2; ++j_) { const float keep_ = b3 ? q4_[2 + j_] : q4_[j_], send_ = b3 ? q4_[j_] : q4_[2 + j_]; q2_[j_] = keep_ + __shfl_xor(send_, 8); } \
        { const float keep_ = b2 ? q2_[1] : q2_[0], send_ = b2 ? q2_[0] : q2_[1]; q1_ = keep_ + __shfl_xor(send_, 4); } \
        q1_ = DPP_ADD(q1_, 0xB1); q1_ = DPP_ADD(q1_, 0x4E); \
        const float t_ = __builtin_bit_cast(float, __builtin_amdgcn_ds_bpermute(osrc, __builtin_bit_cast(int, q1_))); \
        if (lhi == 2 * (h) + b_) (tot_) = t_; } } while (0)
    u32x4 RA[16], RB[16];
    if (tok < T_TOK) { UA_PREFETCH(tok); UA_LOADS(RA, ne0 * 512, 0); }
    for (; tok < T_TOK; tok += step) {
        const i32x8 xb = __builtin_shufflevector(__builtin_bit_cast(i32x4, nx0), __builtin_bit_cast(i32x4, nx1), 0, 1, 2, 3, 4, 5, 6, 7);
        const int e0 = ne0, e1 = ne1; const float g0 = ng0, g1 = ng1;
        const float rs16 = (1.f / 16.f) / sqrtf(nrss * (1.f / D) + EPS);
        const int ro0 = e0 * 512, ro1 = e1 * 512;
        const float su0 = SU[e0], sv0 = SV[e0], su1 = SU[e1], sv1 = SV[e1];
        const bool more = tok + step < T_TOK;
        float tot0 = 0.f, tot1 = 0.f;
        UA_LOADS(RB, ro0, 1);
        if (more) UA_PREFETCH(tok + step);
        UA_COMPUTE(RA, xb, 0, tot0);
        UA_LOADS(RA, ro1, 0);
        UA_COMPUTE(RB, xb, 1, tot0);
        UA_LOADS(RB, ro1, 1);
        UA_COMPUTE(RA, xb, 0, tot1);
        if (more) UA_LOADS(RA, ne0 * 512, 0);
        UA_COMPUTE(RB, xb, 1, tot1);
        __builtin_nontemporal_store(gelu_tanh(tot0 * su0 * rs16) * g0 * sv0, AK + (size_t)tok * 128 + l);
        __builtin_nontemporal_store(gelu_tanh(tot1 * su1 * rs16) * g1 * sv1, AK + (size_t)tok * 128 + 64 + l);
    }
#undef UA_PREFETCH
#undef UA_LOADS
#undef UA_COMPUTE
}
__device__ __forceinline__ float wave_max_nonneg(float v) {
    unsigned u = __builtin_bit_cast(unsigned, v);
    u = max(u, (unsigned)__builtin_amdgcn_mov_dpp((int)u, 0xB1, 0xf, 0xf, true));
    u = max(u, (unsigned)__builtin_amdgcn_mov_dpp((int)u, 0x4E, 0xf, 0xf, true));
    u = max(u, (unsigned)__builtin_amdgcn_mov_dpp((int)u, 0x141, 0xf, 0xf, true));
    u = max(u, (unsigned)__builtin_amdgcn_mov_dpp((int)u, 0x140, 0xf, 0xf, true));
    const unsigned a = (unsigned)__builtin_amdgcn_readlane((int)u, 0), b = (unsigned)__builtin_amdgcn_readlane((int)u, 16), c = (unsigned)__builtin_amdgcn_readlane((int)u, 32), d = (unsigned)__builtin_amdgcn_readlane((int)u, 48);
    return __builtin_bit_cast(float, max(max(a, b), max(c, d)));
}
template <int MODE>
__device__ __forceinline__ void peer_v_phase(const Frame& F, const Args& A) {
    const unsigned char* V8 = A.ws + WS_V8; const int* IDX = (const int*)(A.ws + WS_P + P_IDX); const float* AK = (const float*)(A.ws + WS_AK);
    float* out = MODE == 0 ? A.out : (float*)(A.ws + WS_P + P_SC);
    const int g = F.bid & 7, nmem = F.G >> 3, l = F.lane, sub = l & 7, rr = l >> 3, n16 = l & 15, q = l >> 4, step = nmem * NWAVES;
    const GAS unsigned char* vb = (const GAS unsigned char*)(V8 + (size_t)g * NEXP * 128);
    LAS unsigned long long* rep = (LAS unsigned long long*)(F.lds + F.wave * 2048);
    const unsigned long long bm = 0xFFull << (8 * (n16 & 7));
    const int repi = 2 * q + (n16 >> 3);
    const bool vl = (n16 < 8) && (q < 2);
    LAS float* stg = (LAS float*)(F.lds + 16384 + F.wave * 512);
    int tok = 2 * ((F.bid >> 3) * NWAVES + F.wave);
    int ne[4]; float na[4];
#define V_PREFETCH(t) do { const size_t _a = (size_t)(t) * 128, _b = ((size_t)(t) + 1) * 128; ne[0] = IDX[_a + l]; ne[1] = IDX[_a + 64 + l]; ne[2] = IDX[_b + l]; ne[3] = IDX[_b + 64 + l]; \
        na[0] = AK[_a + l]; na[1] = AK[_a + 64 + l]; na[2] = AK[_b + l]; na[3] = AK[_b + 64 + l]; } while (0)
    if (tok + 1 < T_TOK) V_PREFETCH(tok);
    for (; tok + 1 < T_TOK; tok += 2 * step) {
        const int e0 = ne[0], e1 = ne[1], e2 = ne[2], e3 = ne[3]; const float a0 = na[0], a1 = na[1], a2 = na[2], a3 = na[3];
        u32x4 rowA[16], rowB[16];
#pragma unroll
        for (int i = 0; i < 16; ++i) { const int src = (8 * (i & 7) + rr) * 4;
            const int ea = __builtin_amdgcn_ds_bpermute(src, i < 8 ? e0 : e1), eb = __builtin_amdgcn_ds_bpermute(src, i < 8 ? e2 : e3);
            rowA[i] = *(const GAS u32x4*)(vb + ((unsigned)ea * 128u + 16u * (unsigned)sub)); rowB[i] = *(const GAS u32x4*)(vb + ((unsigned)eb * 128u + 16u * (unsigned)sub)); }
        f32x4 HA = {0.f, 0.f, 0.f, 0.f}, HB = {0.f, 0.f, 0.f, 0.f};
        if (l < 32) { const float* hpa = out + (size_t)tok * D + g * 128 + 4 * l; HA = *(const f32x4*)hpa; HB = *(const f32x4*)(hpa + D); }
        if (tok + 2 * step + 1 < T_TOK) V_PREFETCH(tok + 2 * step);
        const float amA = wave_max_nonneg(fmaxf(fabsf(a0), fabsf(a1))), amB = wave_max_nonneg(fmaxf(fabsf(a2), fabsf(a3)));
        const float scA = amA > 0.f ? 224.f * __builtin_amdgcn_rcpf(amA) : 0.f, invA = amA * (1.f / 224.f), scB = amB > 0.f ? 224.f * __builtin_amdgcn_rcpf(amB) : 0.f, invB = amB * (1.f / 224.f);
        { const unsigned wA = (unsigned)__builtin_amdgcn_cvt_pk_fp8_f32(a0 * scA, a1 * scA, 0, false), wB = (unsigned)__builtin_amdgcn_cvt_pk_fp8_f32(a2 * scB, a3 * scB, 0, false);
          const unsigned r0 = (wA & 0xffu) * 0x01010101u, r1 = ((wA >> 8) & 0xffu) * 0x01010101u, r2 = (wB & 0xffu) * 0x01010101u, r3 = ((wB >> 8) & 0xffu) * 0x01010101u;
          rep[l] = ((unsigned long long)r0 << 32) | r0; rep[64 + l] = ((unsigned long long)r1 << 32) | r1; rep[128 + l] = ((unsigned long long)r2 << 32) | r2; rep[192 + l] = ((unsigned long long)r3 << 32) | r3; }
        LDS_WAIT(); asm volatile("" ::: "memory");
#pragma unroll
        for (int t2 = 0; t2 < 2; ++t2) {
            f32x4 alo = {0.f, 0.f, 0.f, 0.f}, ahi = {0.f, 0.f, 0.f, 0.f};
#pragma unroll
            for (int i = 0; i < 16; ++i) { const long bop = (long)(rep[128 * t2 + 8 * i + repi] & bm); const u32x4 rw = t2 ? rowB[i] : rowA[i];
                alo = __builtin_amdgcn_mfma_f32_16x16x32_fp8_fp8(lo64(rw), bop, alo, 0, 0, 0);
                ahi = __builtin_amdgcn_mfma_f32_16x16x32_fp8_fp8(hi64(rw), bop, ahi, 0, 0, 0); }
            const float inv = t2 ? invB : invA;
            float vlo[4], vhi[4];
#pragma unroll
            for (int r = 0; r < 4; ++r) { const float tl = alo[r], th = ahi[r];
                vlo[r] = (tl + __builtin_bit_cast(float, __builtin_amdgcn_ds_bpermute(((l + 40) & 63) * 4, __builtin_bit_cast(int, tl)))) * inv;
                vhi[r] = (th + __builtin_bit_cast(float, __builtin_amdgcn_ds_bpermute(((l + 40) & 63) * 4, __builtin_bit_cast(int, th)))) * inv; }
            if (vl) {
#pragma unroll
                for (int r = 0; r < 4; ++r) { stg[64 * q + 16 * r + n16] = vlo[r]; stg[64 * q + 16 * r + n16 + 8] = vhi[r]; } }
            LDS_WAIT(); asm volatile("" ::: "memory");
            if (l < 32) { const f32x4 dv = *(const LAS f32x4*)(stg + 4 * l); *(f32x4*)(out + (size_t)(tok + t2) * D + g * 128 + 4 * l) = (t2 ? HB : HA) + dv; }
            LDS_WAIT(); asm volatile("" ::: "memory");
        }
        LDS_WAIT(); asm volatile("" ::: "memory");
    }
#undef V_PREFETCH
}
typedef float f32x16 __attribute__((ext_vector_type(16)));
template <int MODE>
__device__ __forceinline__ void peer_v4_phase(const Frame& F, const Args& A) {
    const int* IDX = (const int*)(A.ws + WS_P + P_IDX); const float* AK = (const float*)(A.ws + WS_AK);
    float* out = A.out;
    const int l = F.lane, n = l & 31, hq = l >> 5, step = F.G * NWAVES;
    const GAS unsigned char* vb = (const GAS unsigned char*)(A.ws + WS_V8);
    const unsigned lconst = 16u * (unsigned)n;
    const bool diag = ((l >> 4) & 1) == hq;
    const unsigned bytem = diag ? (0xFFu << (8 * (l & 3))) : 0u; const int dsel = (l & 15) >> 2;
    const unsigned M0 = dsel == 0 ? bytem : 0u, M1 = dsel == 1 ? bytem : 0u, M2 = dsel == 2 ? bytem : 0u, M3 = dsel == 3 ? bytem : 0u;
    const int rsel = 4 * hq;
    const int sc1 = 0x7F7F7F7F;
    const int colb = 8 * n + 4 * hq;
    int tok = F.bid * NWAVES + F.wave;
    int ne0, ne1; float na0, na1;
#define V4_PREFETCH(t) do { const size_t _t = (size_t)(t) * 128; ne0 = __builtin_nontemporal_load(IDX + _t + l); ne1 = __builtin_nontemporal_load(IDX + _t + 64 + l); na0 = __builtin_nontemporal_load(AK + _t + l); na1 = __builtin_nontemporal_load(AK + _t + 64 + l); } while (0)
#define V4_LOADS(R, ro_, h) do { int ba_ = rsel + 4 * (16 * (h)); _Pragma("unroll") for (int j_ = 0; j_ < 8; ++j_) { asm volatile("" : "+v"(ba_)); const int o_ = __builtin_amdgcn_ds_bpermute(ba_, (ro_)); ba_ += 8; \
        R[j_] = *(const GAS u32x4*)(vb + ((unsigned)o_ + lconst)); } } while (0)
#define V4_ONE(ACC, R, rep_, h, j_) do { unsigned s0_ = (unsigned)__builtin_amdgcn_readlane((int)(rep_), 16 * (h) + 2 * (j_)), s1_ = (unsigned)__builtin_amdgcn_readlane((int)(rep_), 16 * (h) + 2 * (j_) + 1); \
        asm volatile("" : "+s"(s0_), "+s"(s1_), "+v"(ACC)); \
        const i32x8 a8_ = {(int)(s0_ & M0), (int)(s0_ & M1), (int)(s0_ & M2), (int)(s0_ & M3), (int)(s1_ & M0), (int)(s1_ & M1), (int)(s1_ & M2), (int)(s1_ & M3)}; \
        const i32x4 r4_ = __builtin_bit_cast(i32x4, R[j_]); \
        ACC = __builtin_amdgcn_mfma_scale_f32_32x32x64_f8f6f4(a8_, __builtin_shufflevector(r4_, r4_, 0, 1, 2, 3, -1, -1, -1, -1), ACC, 0, 4, 0, sc1, 0, sc1); } while (0)
#define V4_COMPUTE(R, rep_, h) do { V4_ONE(acc, R, rep_, h, 0); V4_ONE(acc1, R, rep_, h, 1); V4_ONE(acc, R, rep_, h, 2); V4_ONE(acc1, R, rep_, h, 3); \
        V4_ONE(acc, R, rep_, h, 4); V4_ONE(acc1, R, rep_, h, 5); V4_ONE(acc, R, rep_, h, 6); V4_ONE(acc1, R, rep_, h, 7); } while (0)
    u32x4 RA[8], RB[8];
    if (tok < T_TOK) { V4_PREFETCH(tok); V4_LOADS(RA, ne0 * 512, 0); }
    for (; tok < T_TOK; tok += step) {
        const int e0 = ne0, e1 = ne1; const float a0 = na0, a1 = na1;
        const int ro0 = e0 * 512, ro1 = e1 * 512;
        const bool more = tok + step < T_TOK;
        V4_LOADS(RB, ro0, 1);
        if (more) V4_PREFETCH(tok + step);
        const float am = wave_max_nonneg(fmaxf(fabsf(a0), fabsf(a1)));
        const float sc = am > 0.f ? 224.f * __builtin_amdgcn_rcpf(am) : 0.f, inv = am * (1.f / 224.f);
        const unsigned w8 = (unsigned)__builtin_amdgcn_cvt_pk_fp8_f32(a0 * sc, a1 * sc, 0, false);
        const unsigned rep0 = (w8 & 0xffu) * 0x01010101u, rep1 = ((w8 >> 8) & 0xffu) * 0x01010101u;
        f32x16 acc, acc1;
#pragma unroll
        for (int i = 0; i < 16; ++i) { acc[i] = 0.f; acc1[i] = 0.f; }
        V4_COMPUTE(RA, rep0, 0); V4_LOADS(RA, ro0, 2);
        V4_COMPUTE(RB, rep0, 1); V4_LOADS(RB, ro0, 3);
        V4_COMPUTE(RA, rep0, 2); V4_LOADS(RA, ro1, 0);
        V4_COMPUTE(RB, rep0, 3); V4_LOADS(RB, ro1, 1);
        V4_COMPUTE(RA, rep1, 0); V4_LOADS(RA, ro1, 2);
        V4_COMPUTE(RB, rep1, 1); V4_LOADS(RB, ro1, 3);
        f32x4 H[4];
        u32x2 MX[4];
        { const bf16_t* mp = (const bf16_t*)(A.ws + WS_N1) + (size_t)tok * D + colb;
#pragma unroll
          for (int j = 0; j < 4; ++j) MX[j] = __builtin_nontemporal_load((const u32x2*)(mp + 256 * j)); }
        V4_COMPUTE(RA, rep1, 2);
        if (more) V4_LOADS(RA, ne0 * 512, 0);
        V4_COMPUTE(RB, rep1, 3);
        acc = acc + acc1;
        float ss = 0.f;
#pragma unroll
        for (int j = 0; j < 4; ++j) { H[j] = (f32x4){bflo(MX[j].x), bfhi(MX[j].x), bflo(MX[j].y), bfhi(MX[j].y)} + (f32x4){acc[4 * j], acc[4 * j + 1], acc[4 * j + 2], acc[4 * j + 3]} * inv;
            ss += (H[j].x * H[j].x + H[j].y * H[j].y) + (H[j].z * H[j].z + H[j].w * H[j].w); }
        const float rstd = 1.f / sqrtf(wave_sum(ss) * (1.f / D) + EPS);
        { float* hp = out + (size_t)tok * D + colb;
#pragma unroll
          for (int j = 0; j < 4; ++j) __builtin_nontemporal_store(H[j] * rstd * *(const f32x4*)(A.in[I_FG] + colb + 256 * j), (f32x4*)(hp + 256 * j)); }
    }
#undef V4_PREFETCH
#undef V4_LOADS
#undef V4_COMPUTE
#undef V4_ONE
}
__device__ __forceinline__ void final_norm_phase(const Frame& F, const Args& A) {
    const int gw = F.bid * NWAVES + F.wave, NGW = F.G * NWAVES, l = F.lane; const float* fg = A.in[I_FG];
    const f32x4* gp = (const f32x4*)fg + l;
    int tok = gw;
    for (; tok + 3 * NGW < T_TOK; tok += 4 * NGW) {
        f32x4 v[4][4]; float ss[4];
#pragma unroll
        for (int b = 0; b < 4; ++b) { const f32x4* hp = (const f32x4*)(A.out + (size_t)(tok + b * NGW) * D) + l;
#pragma unroll
            for (int j = 0; j < 4; ++j) v[b][j] = hp[64 * j]; }
#pragma unroll
        for (int b = 0; b < 4; ++b) { ss[b] = 0.f;
#pragma unroll
            for (int j = 0; j < 4; ++j) ss[b] += (v[b][j].x * v[b][j].x + v[b][j].y * v[b][j].y) + (v[b][j].z * v[b][j].z + v[b][j].w * v[b][j].w); }
#pragma unroll
        for (int o = 1; o < 64; o <<= 1) {
#pragma unroll
            for (int b = 0; b < 4; ++b) ss[b] += __shfl_xor(ss[b], o); }
#pragma unroll
        for (int b = 0; b < 4; ++b) { const float rstd = 1.f / sqrtf(ss[b] * (1.f / D) + EPS); f32x4* hp = (f32x4*)(A.out + (size_t)(tok + b * NGW) * D) + l;
#pragma unroll
            for (int j = 0; j < 4; ++j) hp[64 * j] = v[b][j] * rstd * gp[64 * j]; }
    }
    for (; tok < T_TOK; tok += NGW) { f32x4* hp = (f32x4*)(A.out + (size_t)tok * D) + l; f32x4 v[4]; float ss = 0.f;
#pragma unroll
        for (int j = 0; j < 4; ++j) { v[j] = hp[64 * j]; ss += (v[j].x * v[j].x + v[j].y * v[j].y) + (v[j].z * v[j].z + v[j].w * v[j].w); }
        const float rstd = 1.f / sqrtf(wave_sum(ss) * (1.f / D) + EPS);
#pragma unroll
        for (int j = 0; j < 4; ++j) hp[64 * j] = v[j] * rstd * gp[64 * j]; }
}

#ifdef DEBUG_CHECK
constexpr size_t WS_DBG = 472 * MiB;
__device__ __forceinline__ int dbg_tok(int i) { return (i * 509 + 3) & 32767; }
__device__ __forceinline__ float gelu_ref(float x) { return 0.5f * x * (1.f + tanhf(0.7978845608028654f * (x + 0.044715f * x * x * x))); }
__global__ void __launch_bounds__(512) dbg_scores(Args a) {
    __shared__ float n2s[1024]; __shared__ float q[2048];
    const int t = dbg_tok(blockIdx.x), tid = threadIdx.x;
    const bf16_t* N2 = (const bf16_t*)(a.ws + WS_N1); const float* SC = (const float*)(a.ws + WS_P + P_SC); unsigned* dbg = (unsigned*)(a.ws + WS_DBG);
    for (int k = tid; k < 1024; k += 512) n2s[k] = bf1(N2[(size_t)t * 1024 + k]);
    __syncthreads();
    for (int r = 0; r < 4; ++r) { const int c = tid + 512 * r; float s = 0.f; for (int k = 0; k < 1024; ++k) s += n2s[k] * a.in[I_WQ][(size_t)k * 2048 + c]; q[c] = s; }
    __syncthreads();
    float md = 0.f;
    for (int r = 0; r < 4; ++r) { const int n = tid + 512 * r, hh = n >> 7, key = n & 127; const float* kX = (hh & 1) ? a.in[I_K2] : a.in[I_K1];
        float s = 0.f; for (int d = 0; d < 128; ++d) s += q[hh * 128 + d] * kX[key * 128 + d];
        md = fmaxf(md, fabsf(s - SC[(size_t)n * T_TOK + t])); }
    atomicMax(&dbg[0], __builtin_bit_cast(unsigned, md));
}
__global__ void __launch_bounds__(64) dbg_topk(Args a) {
    __shared__ float s1[8][128], s2[8][128], cv[8][256]; __shared__ float t1v[8][16], t2v[8][16]; __shared__ int t1i[8][16], t2i[8][16], exi[8][16]; __shared__ float exv[8][16];
    const int t = dbg_tok(blockIdx.x), h = threadIdx.x;
    const float* SC = (const float*)(a.ws + WS_P + P_SC); const int* IDX = (const int*)(a.ws + WS_P + P_IDX); const float* GATE = (const float*)(a.ws + WS_P + P_GATE); unsigned* dbg = (unsigned*)(a.ws + WS_DBG);
    if (h >= 8) return;
    for (int j = 0; j < 128; ++j) { s1[h][j] = SC[(size_t)(h * 256 + j) * T_TOK + t]; s2[h][j] = SC[(size_t)(h * 256 + 128 + j) * T_TOK + t]; }
    for (int r = 0; r < 16; ++r) { int b1 = 0, b2 = 0; for (int j = 1; j < 128; ++j) { if (s1[h][j] > s1[h][b1]) b1 = j; if (s2[h][j] > s2[h][b2]) b2 = j; }
        t1v[h][r] = s1[h][b1]; t1i[h][r] = b1; s1[h][b1] = -1e30f; t2v[h][r] = s2[h][b2]; t2i[h][r] = b2; s2[h][b2] = -1e30f; }
    for (int c = 0; c < 256; ++c) cv[h][c] = t1v[h][c >> 4] + t2v[h][c & 15];
    for (int r = 0; r < 16; ++r) { int bc = 0; for (int c = 1; c < 256; ++c) if (cv[h][c] > cv[h][bc]) bc = c;
        exv[h][r] = cv[h][bc]; exi[h][r] = t1i[h][bc >> 4] * 128 + t2i[h][bc & 15]; cv[h][bc] = -1e30f; }
    float sum = 0.f; const float mx0 = exv[h][0]; for (int r = 0; r < 16; ++r) { exv[h][r] = expf(exv[h][r] - mx0); } for (int r = 0; r < 16; ++r) sum += exv[h][r];
    unsigned miss = 0; float gd = 0.f;
    for (int w = 0; w < 16; ++w) { const int e = IDX[(size_t)t * 128 + h * 16 + w]; const float g = GATE[(size_t)t * 128 + h * 16 + w]; bool found = false;
        for (int r = 0; r < 16; ++r) if (exi[h][r] == e) { found = true; gd = fmaxf(gd, fabsf(g - exv[h][r] / sum)); }
        if (!found) ++miss; }
    atomicAdd(&dbg[1], miss); atomicMax(&dbg[3], __builtin_bit_cast(unsigned, gd));
}
__global__ void __launch_bounds__(512) dbg_experts_pre(Args a) {
    __shared__ float n2s[1024]; __shared__ float ak[128]; __shared__ int ek[128]; __shared__ float red[8];
    const int t = dbg_tok(blockIdx.x), tid = threadIdx.x, lane = tid & 63, wave = tid >> 6;
    const bf16_t* N2 = (const bf16_t*)(a.ws + WS_N1); const int* IDX = (const int*)(a.ws + WS_P + P_IDX); const float* GATE = (const float*)(a.ws + WS_P + P_GATE);
    float* rows = (float*)(a.ws + WS_DBG + MiB);
    for (int k = tid; k < 1024; k += 512) n2s[k] = bf1(N2[(size_t)t * 1024 + k]);
    if (tid < 128) ek[tid] = IDX[(size_t)t * 128 + tid];
    __syncthreads();
    for (int k = wave * 16; k < wave * 16 + 16; ++k) { const float* u = a.in[I_PU] + (size_t)ek[k] * 1024; float s = 0.f; for (int j = lane; j < 1024; j += 64) s += u[j] * n2s[j];
        s = wave_sum(s); if (lane == 0) ak[k] = gelu_ref(s) * GATE[(size_t)t * 128 + k]; }
    __syncthreads();
    float h2[2]; float ss = 0.f;
    for (int r = 0; r < 2; ++r) { const int d = tid + 512 * r; float o = 0.f; for (int k = 0; k < 128; ++k) o += ak[k] * a.in[I_PV][(size_t)ek[k] * 1024 + d]; h2[r] = a.out[(size_t)t * 1024 + d] + o; ss += h2[r] * h2[r]; }
    ss = wave_sum(ss); if (lane == 0) red[wave] = ss; __syncthreads();
    float tot = 0.f; for (int w = 0; w < 8; ++w) tot += red[w];
    const float rstd = 1.f / sqrtf(tot / 1024.f + EPS);
    for (int r = 0; r < 2; ++r) { const int d = tid + 512 * r; rows[(size_t)blockIdx.x * 1024 + d] = h2[r] * rstd * a.in[I_FG][d]; }
}
__global__ void __launch_bounds__(512) dbg_experts_post(Args a) {
    const int t = dbg_tok(blockIdx.x), tid = threadIdx.x; const float* rows = (const float*)(a.ws + WS_DBG + MiB); float* dbgf = (float*)(a.ws + WS_DBG);
    float e = 0.f, n = 0.f;
    for (int r = 0; r < 2; ++r) { const int d = tid + 512 * r; const float x = rows[(size_t)blockIdx.x * 1024 + d], y = a.out[(size_t)t * 1024 + d]; e += (x - y) * (x - y); n += x * x; }
    e = wave_sum(e); n = wave_sum(n); if ((tid & 63) == 0) { atomicAdd(&dbgf[4], e); atomicAdd(&dbgf[5], n); }
}
__global__ void __launch_bounds__(512) dbg_report(Args a, int which) {
    const unsigned* dbg = (const unsigned*)(a.ws + WS_DBG); const float* dbgf = (const float*)(a.ws + WS_DBG);
    const float mA = dbgf[0], gd = dbgf[3]; const unsigned miss = dbg[1]; const float relC = sqrtf(dbgf[4] / fmaxf(dbgf[5], 1e-30f));
    float X;
    if (which == 0) { int mask = 0; if (mA > 0.05f) mask |= 1; if (miss > 400u) mask |= 2; if (relC > 0.05f) mask |= 4; if (gd > 0.02f) mask |= 8; X = 1000.f + 100.f * mask; }
    else if (which == 1) X = 1e6f * mA; else if (which == 2) X = 100.f + (float)miss; else if (which == 3) X = 1e6f * relC; else X = 1e6f * gd;
    for (size_t i = (size_t)blockIdx.x * 512 + threadIdx.x; i < (size_t)T_TOK * D; i += (size_t)gridDim.x * 512) a.out[i] = (i == 0) ? X : 0.f;
}
#endif

constexpr int NPH = 13;
__device__ unsigned g_bar[4 * XCD_BAR_WORDS];
__global__ void __launch_bounds__(NWAVES * 64, 2) fwd_kernel(Args args) {
    extern __shared__ __attribute__((aligned(16))) unsigned char lds_raw[];
    Frame F;
    F.lds = (LAS unsigned char*)lds_raw;
    F.tid = threadIdx.x; F.lane = F.tid & 63; F.wave = __builtin_amdgcn_readfirstlane(F.tid >> 6);
    F.G = gridDim.x; F.bid = blockIdx.x;
    volatile LAS unsigned* MISC = (volatile LAS unsigned*)(F.lds + MISC_OFF);
    for (int u = F.tid; u < (LDS_BYTES - LDSCTL_OFF) / 4; u += NWAVES * 64) ((LAS unsigned*)(F.lds + LDSCTL_OFF))[u] = 0u;
    __syncthreads();
    unsigned* ctl = g_bar - CW_BAR;
    const int lo = args.ph_lo, hi = args.ph_hi;
    XcdBarrier bar; bar.bar = ctl + CW_BAR + args.li * XCD_BAR_WORDS; bar.x = 0; bar.st = nullptr; bar.wave = F.wave;
    if (hi - lo > 1) bar = xcd_barrier_post(ctl + CW_BAR + args.li * XCD_BAR_WORDS, MISC + 8, F.wave);
#define IN(k) (lo <= (k) && (k) < hi)
#ifdef PROBE_TS
#define STAMP(k) do { if (F.bid == 0 && F.tid == 0) ((unsigned long long*)(args.ws + (472u << 20)))[(k)] = __builtin_amdgcn_s_memrealtime(); } while (0)
#else
#define STAMP(k) do { } while (0)
#endif
#define SEAM(k) do { if (IN(k) && IN((k) + 1)) { xcd_barrier(bar); if (XTRA_BAR) xcd_barrier(bar); } STAMP((k) + 1); } while (0)
    unsigned char* ws = args.ws;
    bf16_t* P = (bf16_t*)(ws + WS_P);

#define REFRESH() do { int z_ = 0; asm volatile("" : "+s"(z_)); F.lane = (int)__builtin_amdgcn_mbcnt_hi(~0u, __builtin_amdgcn_mbcnt_lo(~0u, (unsigned)z_)); F.tid = F.wave * 64 + F.lane; } while (0)
    STAMP(0);
    if (IN(0)) {
        for (int i = F.bid * (NWAVES * 64) + F.tid; i < (int)((CTL_ZERO_BYTES - WS_RSS) / 4); i += F.G * (NWAVES * 64)) ((unsigned*)(args.ws + WS_RSS))[i] = 0u;
        phase0(F, args); SEAM(0); }
    if (IN(1)) { REFRESH();
        if (F8_LO > 0) { pg8::Gemm g{(const bf16_t*)(ws + WS_N1), (const bf16_t*)(ws + WS_WIN), T_TOK, F8_LO * 256, D, D}; pg8::StaticOrder S; S.init(T_TOK, F8_LO * 256, F.G, F.bid);
            pg8::EpiProj E{P, (float*)(ws + WS_ALR), 0, (float*)(ws + WS_LNS)}; pg8::gemm_phase<pg8::EpiProj, pg8::StaticOrder, false, true, false>(F.lds, g, S, E, F.wave); }
        if (F8_LO < 21) {
            pg8::Gemm g{(const bf16_t*)(ws + WS_N18), (const bf16_t*)(ws + WS_W8 + (size_t)F8_LO * 256 * 1024), T_TOK, (21 - F8_LO) * 256, D / 2, D / 2, 0x7B7B7B7B, 0x75757575};
            pg8::StaticOrder S; S.init(T_TOK, (21 - F8_LO) * 256, F.G, ((F8_LO * 128) % F.G) != 0 ? F.G - 1 - F.bid : F.bid);
            pg8::EpiProj E{P, (float*)(ws + WS_ALR), F8_LO, (float*)(ws + WS_LNS)}; pg8::gemm_phase<pg8::EpiProj, pg8::StaticOrder, true, true, true>(F.lds, g, S, E, F.wave); }
        {
            REFRESH();
            const int nwg = (T_TOK / 256) * (NPROJ / 256), rem = nwg % F.G;
            if (rem == 0) convert_tables(F, args, F.bid * NWAVES + F.wave, F.G * NWAVES);
            else if (F.bid >= rem) convert_tables(F, args, (F.bid - rem) * NWAVES + F.wave, (F.G - rem) * NWAVES);
        }
        SEAM(1);
    }
    if (IN(2)) { REFRESH();
        if (DRY_EXP == 12) { gla_chunk_phase<true>(F, args); for (int it = F.bid; it < 256; it += F.G) for (int g4 = 0; g4 < 4; ++g4) sgu_unit<true>(F, args, 4 * it + g4, g4 == 0); __syncthreads(); }
        gla_chunk_phase<false>(F, args);
        for (int it = F.bid; it < 256; it += F.G) for (int g4 = 0; g4 < 4; ++g4) sgu_unit<false>(F, args, 4 * it + g4, g4 == 0);
        SEAM(2);
    }
    if (IN(3)) { REFRESH(); if (DRY_EXP == 13 || DRY_EXP == 15) { gla_scan<true>(F, args); __syncthreads(); } gla_scan<false>(F, args); SEAM(3); }
    if (IN(4)) { REFRESH(); if (DRY_EXP == 14 || DRY_EXP == 15) { gla_out_phase<true>(F, args); __syncthreads(); } gla_out_phase<false>(F, args); SEAM(4); }
    if (IN(5)) { REFRESH();
        { pg8::Gemm g{P + PC_R, (const bf16_t*)(ws + WS_WA), T_TOK, D, 1024, PLD}; pg8::StaticOrder S; S.init(T_TOK, D, F.G, F.bid);
          pg8::EpiBrAB E{P}; pg8::gemm_phase<pg8::EpiBrAB, pg8::StaticOrder, true, true, false, true>(F.lds, g, S, E, F.wave); }
        SEAM(5);
    }
    if (IN(6)) { REFRESH();
        pg8::Gemm g{P + PC_MRG, (const bf16_t*)(ws + WS_WOUT), T_TOK, D, D, PLD}; pg8::StaticOrder S; S.init(T_TOK, D, F.G, F.bid);
        pg8::EpiOut E{args.in[I_X], (bf16_t*)(ws + WS_N1), ws + WS_N18, (float*)(ws + WS_RSS)}; pg8::gemm_phase<pg8::EpiOut, pg8::StaticOrder, true, true>(F.lds, g, S, E, F.wave);
        SEAM(6);
    }
    if (IN(8)) { REFRESH();
        pg8::StaticOrder S; S.init(T_TOK, 2048, F.G, F.bid); pg8::EpiScores E{(bf16_t*)(ws + WS_P + P_SC), (const float*)(ws + WS_RSS)};
        if (SC_F8) { pg8::Gemm g{(const bf16_t*)(ws + WS_N18), (const bf16_t*)(ws + WS_WQF), T_TOK, 2048, D / 2, D / 2, 0x7B7B7B7B, 0x75757575};
            pg8::gemm_phase<pg8::EpiScores, pg8::StaticOrder, true, true, true>(F.lds, g, S, E, F.wave); }
        else { pg8::Gemm g{(const bf16_t*)(ws + WS_N1), (const bf16_t*)(ws + WS_WQF), T_TOK, 2048, D, D};
            pg8::gemm_phase<pg8::EpiScores, pg8::StaticOrder, true, true>(F.lds, g, S, E, F.wave); }
        if (TOPK_LOCAL) { if (IN(8) && IN(9)) { asm volatile("s_waitcnt vmcnt(0)" ::: "memory"); __syncthreads(); __builtin_amdgcn_fence(__ATOMIC_ACQUIRE, "agent"); } STAMP(9); }
        else SEAM(8);
    }
    if (IN(9)) { REFRESH(); peer_topk<TOPK_LOCAL != 0>(F, args); SEAM(9); }
    if (IN(10)) { REFRESH(); if constexpr (UNG == 1) peer_u4_all<0>(F, args); else peer_u4_phase<0>(F, args); SEAM(10); }
    if (IN(11)) { REFRESH(); if (V_F4) peer_v4_phase<0>(F, args); else { if (DRY_EXP == 1) { peer_v_phase<1>(F, args); __syncthreads(); } peer_v_phase<0>(F, args); SEAM(11); } }
    if (IN(12)) { REFRESH(); if (!V_F4) final_norm_phase(F, args); }
    if (hi - lo > 1 && F.wave == 0) {
        unsigned* b = bar.bar; const int l = lane_now(); unsigned last = 0u;
        if (l == 0) last = (xb_add(&b[0], 1u) == (unsigned)F.G - 1u) ? 1u : 0u;
        last = (unsigned)__builtin_amdgcn_readfirstlane((int)last);
        if (last) {
            if (l < 16) { __hip_atomic_store(&b[XB_XCNT(l)], 0u, __ATOMIC_RELAXED, __HIP_MEMORY_SCOPE_AGENT); __hip_atomic_store(&b[XB_XSUB(l)], 0u, __ATOMIC_RELAXED, __HIP_MEMORY_SCOPE_AGENT);
                          __hip_atomic_store(&b[XB_XGEN(l)], 0u, __ATOMIC_RELAXED, __HIP_MEMORY_SCOPE_AGENT); }
            if (l == 16) { __hip_atomic_store(&b[XB_TOP], 0u, __ATOMIC_RELAXED, __HIP_MEMORY_SCOPE_AGENT); __hip_atomic_store(&b[XB_TOPGEN], 0u, __ATOMIC_RELAXED, __HIP_MEMORY_SCOPE_AGENT);
                           __hip_atomic_store(&b[XB_TMO], 0u, __ATOMIC_RELAXED, __HIP_MEMORY_SCOPE_AGENT); __hip_atomic_store(&b[0], 0u, __ATOMIC_RELAXED, __HIP_MEMORY_SCOPE_AGENT); }
        }
    }
#undef IN
#undef SEAM
}


#ifdef PROBE_TS
__global__ void __launch_bounds__(512) probe_report(Args a, int pi, int pj) {
    const unsigned long long* ts = (const unsigned long long*)(a.ws + (472u << 20));
    const float X1 = 10.f * (float)(ts[pi + 1] - ts[pi]) * 0.01f, X2 = (float)(ts[pj + 1] - ts[pj]) * 0.01f;
    for (size_t i = (size_t)blockIdx.x * 512 + threadIdx.x; i < (size_t)T_TOK * D; i += (size_t)gridDim.x * 512) a.out[i] = (i == 0) ? X1 : X2;
}
#endif
#ifdef PROBE_MFMA
__global__ void __launch_bounds__(64) probe_mfma(Args a) {
    const int l = threadIdx.x;
    i32x4 av = {0, 0, 0, 0};
    if (l == PROBE_L) av[PROBE_P >> 3] = 0x2 << (4 * (PROBE_P & 7));
    i32x8 b1, b2;
    for (int r = 0; r < 8; ++r) { unsigned w1 = 0, w2 = 0;
        for (int c = 0; c < 4; ++c) { const int b = 4 * r + c; int t = 0;
            t = __builtin_amdgcn_cvt_pk_fp8_f32((float)((b & 15) + 1), (float)(1 + (b >> 4) + 2 * (l >> 4)), 0, false);
            w1 |= ((unsigned)t & 0xffu) << (8 * c); w2 |= (((unsigned)t >> 8) & 0xffu) << (8 * c); }
        b1[r] = (int)w1; b2[r] = (int)w2; }
    const f32x4 z = {0.f, 0.f, 0.f, 0.f};
    const f32x4 d1 = __builtin_amdgcn_mfma_scale_f32_16x16x128_f8f6f4(__builtin_shufflevector(av, av, 0, 1, 2, 3, -1, -1, -1, -1), b1, z, 4, 0, 0, 0x7F7F7F7F, 0, 0x7F7F7F7F);
    const f32x4 d2 = __builtin_amdgcn_mfma_scale_f32_16x16x128_f8f6f4(__builtin_shufflevector(av, av, 0, 1, 2, 3, -1, -1, -1, -1), b2, z, 4, 0, 0, 0x7F7F7F7F, 0, 0x7F7F7F7F);
    float* st = (float*)(a.ws + (472u << 20));
    *(f32x4*)(st + 8 * l) = d1; *(f32x4*)(st + 8 * l + 4) = d2;
}
__global__ void __launch_bounds__(512) probe_mfma_report(Args a) {
    const int row = PROBE_L & 15;
    const float* st = (const float*)(a.ws + (472u << 20)) + 8 * (16 * (row >> 2)) + (row & 3); const float X1 = 10.f * st[0], X2 = st[4];
    for (size_t i = (size_t)blockIdx.x * 512 + threadIdx.x; i < (size_t)T_TOK * D; i += (size_t)gridDim.x * 512) a.out[i] = (i == 0) ? X1 : X2;
}
#endif
extern "C" void kernel_launch(void* const* d_in, const int* in_sizes, int n_in, void* d_out, int out_size, void* d_ws, size_t ws_size, hipStream_t stream) {
    static int grid = 0;
    if (grid == 0) {
        if (n_in != 20 || in_sizes[0] != T_TOK * D || out_size != T_TOK * D || ws_size < WS_END) {
            fprintf(stderr, "kernel_launch: unexpected shapes: n_in %d in0 %d out %d ws %zu (need %zu)\n", n_in, n_in > 0 ? in_sizes[0] : -1, out_size, ws_size, (size_t)WS_END); grid = -1; return; }
        int dev = 0, cus = 0;
        if (hipGetDevice(&dev) != hipSuccess || hipDeviceGetAttribute(&cus, hipDeviceAttributeMultiprocessorCount, dev) != hipSuccess) { grid = -1; return; }
        if (hipFuncSetAttribute((const void*)fwd_kernel, hipFuncAttributeMaxDynamicSharedMemorySize, LDS_BYTES) != hipSuccess) { fprintf(stderr, "kernel_launch: hipFuncSetAttribute failed\n"); grid = -1; return; }
        int per_cu = 0;
        if (hipOccupancyMaxActiveBlocksPerMultiprocessor(&per_cu, (const void*)fwd_kernel, NWAVES * 64, LDS_BYTES) != hipSuccess || per_cu < 1) fprintf(stderr, "kernel_launch: occupancy query says %d\n", per_cu);
        (void)hipGetLastError();
        grid = cus;
    }
    if (grid < 0) return;
    Args a{};
    for (int i = 0; i < 20; ++i) a.in[i] = (const float*)d_in[i];
    a.out = (float*)d_out; a.ws = (unsigned char*)d_ws;
#ifdef PROBE_MFMA
    hipLaunchKernelGGL(probe_mfma, dim3(1), dim3(64), 0, stream, a);
    hipLaunchKernelGGL(probe_mfma_report, dim3(1024), dim3(512), 0, stream, a);
    return;
#endif
#ifndef LAUNCH_LIST
#define LAUNCH_LIST {0, NPH}
#endif
    static const int ranges[][2] = { LAUNCH_LIST };
    const int nl = (int)(sizeof(ranges) / sizeof(ranges[0]));
    for (int li = 0; li < nl; ++li) { a.ph_lo = ranges[li][0]; a.ph_hi = ranges[li][1]; a.li = li;
        hipLaunchKernelGGL(fwd_kernel, dim3(grid), dim3(NWAVES * 64), LDS_BYTES, stream, a); }
}
```
